# Optimizing an MI355X kernel written in HIP

```python
import math
import jax, jax.numpy as jnp
from jax import lax
import numpy as np

D_MODEL = 1024
BATCH = 8
SEQ = 4096
DEPTH = 2

GRID_W = 64
CTX_LEN = 256
N_MIXERS = 2
RET_HEADS = 4
RET_QK_DIM = D_MODEL // RET_HEADS
RET_V_DIM = 2 * RET_QK_DIM
RET_CHUNK = 128
RET_IN_WIDTH = 2 * RET_HEADS * RET_QK_DIM + 3 * RET_HEADS * RET_V_DIM
DIFF_HEADS = 8
DIFF_HEAD_DIM = D_MODEL // DIFF_HEADS // 2
DIFF_IN_WIDTH = 3 * D_MODEL
Q_BLOCK = 128
ROPE_BASE = 10000.0
D_FF = 2816
N_EXPERTS = 8
TOP_K = 2
D_FF_EXPERT = 3584
EPS = 1e-6

kernel_name = "hybrid_retention_diffattn_moe_dit"


def _rms(x, g):
    xf = x.astype(jnp.float32)
    y = xf * lax.rsqrt(jnp.mean(xf * xf, axis=-1, keepdims=True) + EPS)
    return (y * g.astype(jnp.float32)).astype(x.dtype)


def _head_norm(u):
    return u * lax.rsqrt(jnp.mean(u * u, axis=-1, keepdims=True) + EPS)


def _modulate(h, shift, scale):
    return h * (1.0 + scale) + shift


def _axial_rope_tables(rows, head_dim):
    pos_r = jnp.repeat(jnp.arange(rows, dtype=jnp.float32), GRID_W)
    pos_c = jnp.tile(jnp.arange(GRID_W, dtype=jnp.float32), rows)
    axis_dim = head_dim // 2
    freqs = ROPE_BASE ** (-jnp.arange(0, axis_dim, 2, dtype=jnp.float32) / axis_dim)
    ang_r = pos_r[:, None] * freqs[None, :]
    ang_c = pos_c[:, None] * freqs[None, :]
    return (jnp.cos(ang_r), jnp.sin(ang_r), jnp.cos(ang_c), jnp.sin(ang_c))


def _rope_half(x, cos, sin):
    h = x.shape[-1] // 2
    x1, x2 = x[..., :h], x[..., h:]
    cos = cos.astype(x.dtype)
    sin = sin.astype(x.dtype)
    return jnp.concatenate([x1 * cos - x2 * sin, x2 * cos + x1 * sin], axis=-1)


def _apply_axial_rope(x, tabs):
    cr, sr, cc, sc = tabs
    a = x.shape[-1] // 2
    return jnp.concatenate([_rope_half(x[..., :a], cr, sr), _rope_half(x[..., a:], cc, sc)], axis=-1)


def _retention_chunks(q, k, v, log_gamma, state0):
    b, h, t, _ = q.shape
    dv = v.shape[-1]
    n = t // RET_CHUNK

    def to_chunks(z):
        return z.reshape(b, h, n, RET_CHUNK, z.shape[-1]).transpose(2, 0, 1, 3, 4)

    idx = jnp.arange(RET_CHUNK, dtype=jnp.float32)
    diff = idx[:, None] - idx[None, :]
    intra = jnp.where(diff >= 0, jnp.exp(log_gamma[:, None, None] * jnp.maximum(diff, 0.0)), 0.0)
    q_dec = jnp.exp(log_gamma[:, None] * (idx + 1.0))[:, :, None]
    k_dec = jnp.exp(log_gamma[:, None] * (RET_CHUNK - 1.0 - idx))[:, :, None]
    c_dec = jnp.exp(log_gamma * RET_CHUNK)[:, None, None]

    def step(state, chunk):
        qc, kc, vc = chunk
        scores = jnp.einsum('bhid,bhjd->bhij', qc, kc) * intra
        out = (jnp.einsum('bhij,bhjv->bhiv', scores, vc)
               + jnp.einsum('bhid,bhdv->bhiv', qc * q_dec, state))
        state = state * c_dec + jnp.einsum('bhjd,bhjv->bhdv', kc * k_dec, vc)
        return state, out

    state, out = lax.scan(step, state0, (to_chunks(q), to_chunks(k), to_chunks(v)))
    out = out.transpose(1, 2, 0, 3, 4).reshape(b, h, t, dv)
    return out, state


def _retention_mixer(h_lat, h_ctx, w_in, decay_logit, w_out, rope_tabs, need_ctx):
    hk = RET_HEADS * RET_QK_DIM
    hv = RET_HEADS * RET_V_DIM
    splits = [hk, 2 * hk, 2 * hk + hv, 2 * hk + 2 * hv]

    def project(hs):
        b, t, _ = hs.shape
        z = (hs @ w_in).astype(jnp.float32)
        q, k, v, gf, gb = jnp.split(z, splits, axis=-1)

        def heads(u):
            return u.reshape(b, t, RET_HEADS, -1).transpose(0, 2, 1, 3)
        return heads(q), heads(k) * RET_QK_DIM ** -0.5, heads(v), heads(gf), heads(gb)

    q_l, k_l, v_l, gf_l, gb_l = project(h_lat)
    q_c, k_c, v_c, gf_c, gb_c = project(h_ctx)
    q_l = _apply_axial_rope(q_l, rope_tabs)
    k_l = _apply_axial_rope(k_l, rope_tabs)
    log_g = jax.nn.log_sigmoid(decay_logit.astype(jnp.float32))
    zero = jnp.zeros((h_lat.shape[0], RET_HEADS, RET_QK_DIM, RET_V_DIM), jnp.float32)

    def rev(u):
        return jnp.flip(u, axis=2)

    o_cf, s_f = _retention_chunks(q_c, k_c, v_c, log_g[0], zero)
    o_lf, _ = _retention_chunks(q_l, k_l, v_l, log_g[0], s_f)
    o_cb, s_b = _retention_chunks(rev(q_c), rev(k_c), rev(v_c), log_g[1], zero)
    o_lb, _ = _retention_chunks(rev(q_l), rev(k_l), rev(v_l), log_g[1], s_b)

    def merge(of, ob, gf, gb, dtype):
        y = jax.nn.silu(gf) * _head_norm(of) + jax.nn.silu(gb) * _head_norm(rev(ob))
        bb, _, t, _ = y.shape
        return y.transpose(0, 2, 1, 3).reshape(bb, t, hv).astype(dtype) @ w_out

    y_lat = merge(o_lf, o_lb, gf_l, gb_l, h_lat.dtype)
    y_ctx = merge(o_cf, o_cb, gf_c, gb_c, h_ctx.dtype) if need_ctx else None
    return y_lat, y_ctx


def _diff_attention_block(q, k, v, lam):
    s = jnp.einsum('bhqd,bhkd->bhqk', q, k).astype(jnp.float32) * DIFF_HEAD_DIM ** -0.5
    p = jax.nn.softmax(s, axis=-1)
    b, _, nq, nk = p.shape
    p = p.reshape(b, DIFF_HEADS, 2, nq, nk)
    a = p[:, :, 0] - lam * p[:, :, 1]
    return jnp.einsum('bhqk,bhkv->bhqv', a.astype(v.dtype), v)


def _diff_attn_mixer(h_lat, h_ctx, w_in, lam_params, subln, w_out, lambda_init, rope_tabs, need_ctx):
    hq = 2 * DIFF_HEADS * DIFF_HEAD_DIM

    def project(hs):
        b, t, _ = hs.shape
        q, k, v = jnp.split(hs @ w_in, [hq, 2 * hq], axis=-1)
        q = q.reshape(b, t, 2 * DIFF_HEADS, DIFF_HEAD_DIM).transpose(0, 2, 1, 3)
        k = k.reshape(b, t, 2 * DIFF_HEADS, DIFF_HEAD_DIM).transpose(0, 2, 1, 3)
        v = v.reshape(b, t, DIFF_HEADS, 2 * DIFF_HEAD_DIM).transpose(0, 2, 1, 3)
        return q, k, v

    lp = lam_params.astype(jnp.float32)
    lam = jnp.exp(jnp.sum(lp[0] * lp[1])) - jnp.exp(jnp.sum(lp[2] * lp[3])) + lambda_init

    q_l, k_l, v_l = project(h_lat)
    q_c, k_c, v_c = project(h_ctx)
    q_l = _apply_axial_rope(q_l, rope_tabs)
    k_l = _apply_axial_rope(k_l, rope_tabs)

    k_all = jnp.concatenate([k_l, k_c], axis=2)
    v_all = jnp.concatenate([v_l, v_c], axis=2)
    b, _, t, d = q_l.shape
    n = t // Q_BLOCK
    q_blocks = q_l.reshape(b, 2 * DIFF_HEADS, n, Q_BLOCK, d).transpose(2, 0, 1, 3, 4)
    o_blocks = lax.map(lambda qb: _diff_attention_block(qb, k_all, v_all, lam), q_blocks)
    o_l = o_blocks.transpose(1, 2, 0, 3, 4).reshape(b, DIFF_HEADS, t, 2 * DIFF_HEAD_DIM)

    def finish(o, dtype):
        o = _rms(o, subln) * (1.0 - lambda_init)
        bb, _, tt, _ = o.shape
        return o.transpose(0, 2, 1, 3).reshape(bb, tt, D_MODEL).astype(dtype) @ w_out

    y_lat = finish(o_l, h_lat.dtype)
    y_ctx = finish(_diff_attention_block(q_c, k_c, v_c, lam), h_ctx.dtype) if need_ctx else None
    return y_lat, y_ctx


def _swiglu(h, w_gu, w_down):
    g, u = jnp.split(h @ w_gu, 2, axis=-1)
    return (jax.nn.silu(g) * u) @ w_down


def _moe(h, router_w, router_b, w_gu, w_down):
    logits = (h @ router_w).astype(jnp.float32) + router_b.astype(jnp.float32)
    top_v, top_i = lax.top_k(logits, TOP_K)
    top_w = jax.nn.softmax(top_v, axis=-1)
    combine = jnp.sum(jax.nn.one_hot(top_i, N_EXPERTS, dtype=jnp.float32) * top_w[..., None], axis=-2)
    out = jnp.zeros(h.shape, jnp.float32)
    for e in range(N_EXPERTS):
        out = out + combine[..., e:e + 1] * _swiglu(h, w_gu[e], w_down[e]).astype(jnp.float32)
    return out.astype(h.dtype)


def setup_inputs(seed: int = 0) -> dict:
    key = jax.random.key(seed)
    ks = jax.random.split(key, 40)

    def dense(k, shape, fan_in):
        return jax.random.normal(k, shape, jnp.float32) * fan_in ** -0.5

    def gain(k, n):
        return 1.0 + 0.05 * jax.random.normal(k, (n,), jnp.float32)

    gamma0 = 1.0 - 2.0 ** (-5.0 - np.arange(RET_HEADS))
    logit0 = jnp.asarray(np.log(gamma0 / (1.0 - gamma0)), jnp.float32)
    decay_logit = logit0[None, :] + 0.1 * jax.random.normal(ks[8], (2, RET_HEADS), jnp.float32)

    return {
        'x': jax.random.normal(ks[0], (BATCH, SEQ, D_MODEL), jnp.float32),
        'c': jax.random.normal(ks[1], (BATCH, D_MODEL), jnp.float32),
        'ctx': jax.random.normal(ks[2], (BATCH, CTX_LEN, D_MODEL), jnp.float32),
        'c_ctx': jax.random.normal(ks[3], (D_MODEL,), jnp.float32),
        'l0_w_mod': dense(ks[4], (D_MODEL, 6 * D_MODEL), D_MODEL),
        'l0_b_mod': 0.01 * jax.random.normal(ks[5], (6 * D_MODEL,), jnp.float32),
        'l0_norm_pre_mix': gain(ks[6], D_MODEL),
        'l0_norm_post_mix': gain(ks[7], D_MODEL),
        'l0_norm_pre_ffn': gain(ks[9], D_MODEL),
        'l0_norm_post_ffn': gain(ks[10], D_MODEL),
        'l0_ret_w_in': dense(ks[11], (D_MODEL, RET_IN_WIDTH), D_MODEL),
        'l0_ret_decay_logit': decay_logit,
        'l0_ret_w_out': dense(ks[12], (RET_HEADS * RET_V_DIM, D_MODEL), RET_HEADS * RET_V_DIM),
        'l0_ffn_w_gate_up': dense(ks[13], (D_MODEL, 2 * D_FF), D_MODEL),
        'l0_ffn_w_down': dense(ks[14], (D_FF, D_MODEL), D_FF),
        'l1_w_mod': dense(ks[15], (D_MODEL, 6 * D_MODEL), D_MODEL),
        'l1_b_mod': 0.01 * jax.random.normal(ks[16], (6 * D_MODEL,), jnp.float32),
        'l1_norm_pre_mix': gain(ks[17], D_MODEL),
        'l1_norm_post_mix': gain(ks[18], D_MODEL),
        'l1_norm_pre_ffn': gain(ks[19], D_MODEL),
        'l1_norm_post_ffn': gain(ks[20], D_MODEL),
        'l1_attn_w_in': dense(ks[21], (D_MODEL, DIFF_IN_WIDTH), D_MODEL),
        'l1_attn_lambda': 0.1 * jax.random.normal(ks[22], (4, DIFF_HEAD_DIM), jnp.float32),
        'l1_attn_subln': gain(ks[23], 2 * DIFF_HEAD_DIM),
        'l1_attn_w_out': dense(ks[24], (D_MODEL, D_MODEL), D_MODEL),
        'l1_router_w': dense(ks[25], (D_MODEL, N_EXPERTS), D_MODEL),
        'l1_router_b': 0.01 * jax.random.normal(ks[26], (N_EXPERTS,), jnp.float32),
        'l1_moe_w_gate_up': dense(ks[27], (N_EXPERTS, D_MODEL, 2 * D_FF_EXPERT), D_MODEL),
        'l1_moe_w_down': dense(ks[28], (N_EXPERTS, D_FF_EXPERT, D_MODEL), D_FF_EXPERT),
    }


def reference(x, c, ctx, c_ctx,
              l0_w_mod, l0_b_mod, l0_norm_pre_mix, l0_norm_post_mix, l0_norm_pre_ffn, l0_norm_post_ffn,
              l0_ret_w_in, l0_ret_decay_logit, l0_ret_w_out, l0_ffn_w_gate_up, l0_ffn_w_down,
              l1_w_mod, l1_b_mod, l1_norm_pre_mix, l1_norm_post_mix, l1_norm_pre_ffn, l1_norm_post_ffn,
              l1_attn_w_in, l1_attn_lambda, l1_attn_subln, l1_attn_w_out,
              l1_router_w, l1_router_b, l1_moe_w_gate_up, l1_moe_w_down):
    rows = x.shape[1] // GRID_W
    tabs_ret = _axial_rope_tables(rows, RET_QK_DIM)
    tabs_diff = _axial_rope_tables(rows, DIFF_HEAD_DIM)

    layers = (
        dict(w_mod=l0_w_mod, b_mod=l0_b_mod,
             norms=(l0_norm_pre_mix, l0_norm_post_mix, l0_norm_pre_ffn, l0_norm_post_ffn),
             mixer=(l0_ret_w_in, l0_ret_decay_logit, l0_ret_w_out),
             ffn=(l0_ffn_w_gate_up, l0_ffn_w_down)),
        dict(w_mod=l1_w_mod, b_mod=l1_b_mod,
             norms=(l1_norm_pre_mix, l1_norm_post_mix, l1_norm_pre_ffn, l1_norm_post_ffn),
             mixer=(l1_attn_w_in, l1_attn_lambda, l1_attn_subln, l1_attn_w_out),
             ffn=(l1_router_w, l1_router_b, l1_moe_w_gate_up, l1_moe_w_down)),
    )

    for i in range(DEPTH):
        p = layers[i]
        need_ctx = i < DEPTH - 1
        n_pre_mix, n_post_mix, n_pre_ffn, n_post_ffn = p['norms']
        m_lat = (jax.nn.silu(c) @ p['w_mod'] + p['b_mod'])[:, None, :]
        m_ctx = (jax.nn.silu(c_ctx) @ p['w_mod'] + p['b_mod'])[None, None, :]
        sh1, sc1, g1, sh2, sc2, g2 = jnp.split(m_lat, 6, axis=-1)
        sh1c, sc1c, g1c, sh2c, sc2c, g2c = jnp.split(m_ctx, 6, axis=-1)

        h_l = _modulate(_rms(x, n_pre_mix), sh1, sc1)
        h_c = _modulate(_rms(ctx, n_pre_mix), sh1c, sc1c)
        if i % N_MIXERS == 0:
            w_in, decay_logit, w_out = p['mixer']
            y_l, y_c = _retention_mixer(h_l, h_c, w_in, decay_logit, w_out, tabs_ret, need_ctx)
        else:
            w_in, lam_params, subln, w_out = p['mixer']
            lambda_init = 0.8 - 0.6 * math.exp(-0.3 * i)
            y_l, y_c = _diff_attn_mixer(h_l, h_c, w_in, lam_params, subln, w_out, lambda_init, tabs_diff, need_ctx)
        x = x + g1 * _rms(y_l, n_post_mix)
        if need_ctx:
            ctx = ctx + g1c * _rms(y_c, n_post_mix)

        h_l = _modulate(_rms(x, n_pre_ffn), sh2, sc2)
        if i % 2 == 0:
            ffn = lambda h: _swiglu(h, *p['ffn'])
        else:
            ffn = lambda h: _moe(h, *p['ffn'])
        x = x + g2 * _rms(ffn(h_l), n_post_ffn)
        if need_ctx:
            h_c = _modulate(_rms(ctx, n_pre_ffn), sh2c, sc2c)
            ctx = ctx + g2c * _rms(ffn(h_c), n_post_ffn)
    return x
```

```cpp
#include <hip/hip_runtime.h>
#include <cstdio>
#include <cstdint>
namespace pg8 {
#define PG8_LAS __attribute__((address_space(3)))
typedef unsigned short bf16_t;
typedef short bf16x8 __attribute__((ext_vector_type(8)));
typedef float f32x4 __attribute__((ext_vector_type(4)));
typedef unsigned u32x4 __attribute__((ext_vector_type(4)));
constexpr int BM = 256, BK = 64, HALF = 128, HTB = HALF * BK * 2  , STAGE_BYTES = 8 * HTB, NXCD = 8, WGM = 8;

__host__ __device__ __forceinline__ int lds_byte(int r, int c) { const int st = (r >> 4) * 2 + (c >> 5), rr = r & 15, cc = c & 31, ob = rr * 64 + cc * 2; return st * 1024 + (ob ^ (((ob >> 9) & 1) << 5)); }
__host__ __device__ __forceinline__ void stage_rc(int b, int& R, int& C) { const int st = b / 1024, sb = b % 1024, swz = sb ^ (((sb >> 9) & 1) << 5); R = (st >> 1) * 16 + swz / 64; C = (st & 1) * 32 + (swz % 64) / 2; }
__host__ __device__ __forceinline__ int perm32(int rho) { const int n = rho >> 4, i = rho & 15; return 8 * (i >> 2) + 4 * n + (i & 3); }

struct Unit { int pm, pn, pc; };
struct Gemm { const bf16_t* A; const bf16_t* Bt; int M, N, K, lda; };

struct StaticOrder {
    int nM, nN, nwg, G, c;
    __host__ __device__ void init(int M, int N, int G_, int c_) { nM = M / BM; nN = N / BM; nwg = nM * nN; G = G_; c = c_; }
    __host__ __device__ bool next(int i, Unit& u) const {
        const long L = (long)i * G + c; if (L >= nwg) return false;
        int wgid = (int)L; { const int q = nwg / NXCD, r = nwg % NXCD, xcd = wgid % NXCD, off = wgid / NXCD; wgid = (xcd < r ? xcd * (q + 1) : r * (q + 1) + (xcd - r) * q) + off; }
        const int nig = WGM * nN, gid = wgid / nig, fm = gid * WGM, gsz = (nM - fm) < WGM ? (nM - fm) : WGM;
        u.pm = fm + ((wgid % nig) % gsz); u.pn = (wgid % nig) / gsz; u.pc = u.pn; return true;
    }
    __device__ __forceinline__ void a_ready(const Unit&) const {}
    __device__ __forceinline__ void done(const Unit&) const {}
};

__device__ __forceinline__ unsigned cvt_pk_bf16(float lo, float hi) { unsigned r; asm volatile("v_cvt_pk_bf16_f32 %0, %1, %2" : "=v"(r) : "v"(lo), "v"(hi)); return r; }
typedef float f32x2 __attribute__((ext_vector_type(2)));
template <class Epi, class Sched, bool ALIGN_EPI = false, bool SP2 = false>
__device__ __forceinline__ void gemm_phase(PG8_LAS unsigned char* lds, const Gemm g, const Sched& S, const Epi& E) {
    const int tid = threadIdx.x, wid = __builtin_amdgcn_readfirstlane(tid >> 6), lane = tid & 63, wr = wid >> 2, wc = wid & 3, fr = lane & 15, fq = lane >> 4;
    const int K = g.K, nt = K / BK;
    unsigned voffA[2], voffB[2];
#pragma unroll
    for (int i = 0; i < 2; ++i) { int R, C; stage_rc(tid * 16 + i * 8192, R, C); const int Rb = Epi::PERM ? ((R & ~31) + perm32(R & 31)) : R;
        voffA[i] = (unsigned)(R * g.lda + C) * 2u; voffB[i] = (unsigned)(Rb * K + C) * 2u; }
    const size_t kstep = (size_t)(BK * 2);
    const size_t hstepA = (size_t)HALF * g.lda * 2, hstepB = (size_t)HALF * K * 2;
    const size_t tstepA = 2 * hstepA, tstepB = 2 * hstepB;
    const unsigned ldsw = (unsigned)wid * 1024u;
    const int aoff = lds_byte(wr * 64 + fr, fq * 8), boff = lds_byte(wc * 32 + fr, fq * 8);
#define PG8_SA(b, h) (((b) * 2 + (h)) * HTB)
#define PG8_SB(b, h) ((4 + (b) * 2 + (h)) * HTB)
#define PG8_STAGE(bufoff, gbase, voff) do { _Pragma("unroll") for (int _i = 0; _i < 2; ++_i) \
        __builtin_amdgcn_global_load_lds((const unsigned*)((const char*)(gbase) + (voff)[_i]), (PG8_LAS unsigned*)(lds + (bufoff) + ldsw + _i * 8192), 16, 0, 0); } while (0)
#define PG8_LDA(dst, b, h) do { _Pragma("unroll") for (int m = 0; m < 4; ++m) _Pragma("unroll") for (int k = 0; k < 2; ++k) dst[m][k] = *(const PG8_LAS bf16x8*)(lds + PG8_SA(b, h) + aoff + m * 2048 + k * 1024); } while (0)
#define PG8_LDB(dst, b, h) do { _Pragma("unroll") for (int n = 0; n < 2; ++n) _Pragma("unroll") for (int k = 0; k < 2; ++k) dst[n][k] = *(const PG8_LAS bf16x8*)(lds + PG8_SB(b, h) + boff + n * 2048 + k * 1024); } while (0)
#define PG8_MMA(ai, bj, At, Bt) do { __builtin_amdgcn_s_setprio(1); _Pragma("unroll") for (int m = 0; m < 4; ++m) _Pragma("unroll") for (int n = 0; n < 2; ++n) _Pragma("unroll") for (int k = 0; k < 2; ++k) \
        acc[ai][bj][m][n] = __builtin_amdgcn_mfma_f32_16x16x32_bf16(Bt[n][k], At[m][k], acc[ai][bj][m][n], 0, 0, 0); __builtin_amdgcn_s_setprio(0); } while (0)
#define PG8_WAIT_V(n) asm volatile("s_waitcnt vmcnt(" #n ")" ::: "memory")
#define PG8_WAIT_L(n) asm volatile("s_waitcnt lgkmcnt(" #n ")" ::: "memory")
#define PG8_BAR __builtin_amdgcn_s_barrier()
#define PG8_SCHED __builtin_amdgcn_sched_barrier(0)
    Unit cur, nxt; int ui = 0;
    if (!S.next(0, cur)) return;
    f32x4 acc[2][2][4][2];
#pragma unroll
    for (int a = 0; a < 2; ++a)
#pragma unroll
        for (int b = 0; b < 2; ++b)
#pragma unroll
            for (int m = 0; m < 4; ++m)
#pragma unroll
                for (int n = 0; n < 2; ++n) acc[a][b][m][n] = (f32x4){0.f, 0.f, 0.f, 0.f};
    bf16x8 At[4][2], B0[2][2], B1[2][2];
    const char* cA = (const char*)g.A + (size_t)cur.pm * tstepA; const char* cB = (const char*)g.Bt + (size_t)cur.pn * tstepB;
    S.a_ready(cur);
    if constexpr (SP2) {
        PG8_STAGE(PG8_SB(0, 0), cB, voffB); PG8_STAGE(PG8_SB(0, 1), cB + hstepB, voffB); PG8_STAGE(PG8_SA(0, 0), cA, voffA); PG8_STAGE(PG8_SA(0, 1), cA + hstepA, voffA);
        if (wr == 1) PG8_BAR;
        PG8_WAIT_V(2); PG8_BAR;
        PG8_STAGE(PG8_SB(1, 0), cB + kstep, voffB); PG8_STAGE(PG8_SA(1, 0), cA + kstep, voffA); PG8_STAGE(PG8_SB(1, 1), cB + hstepB + kstep, voffB);
        PG8_WAIT_V(6); PG8_BAR;
    } else {
        PG8_STAGE(PG8_SB(0, 0), cB, voffB); PG8_STAGE(PG8_SA(0, 0), cA, voffA); PG8_STAGE(PG8_SB(0, 1), cB + hstepB, voffB); PG8_STAGE(PG8_SA(0, 1), cA + hstepA, voffA);
        if (wr == 1) PG8_BAR;
        PG8_WAIT_V(4); PG8_BAR;
        PG8_STAGE(PG8_SB(1, 0), cB + kstep, voffB); PG8_STAGE(PG8_SA(1, 0), cA + kstep, voffA); PG8_STAGE(PG8_SB(1, 1), cB + hstepB + kstep, voffB);
        PG8_WAIT_V(6); PG8_BAR;
    }
    for (;;) {
        const bool has_next = S.next(ui + 1, nxt);
        const char* nA = has_next ? (const char*)g.A + (size_t)nxt.pm * tstepA : cA; const char* nB = has_next ? (const char*)g.Bt + (size_t)nxt.pn * tstepB : cB;
        for (int t = 0; t < nt; t += 2) {
            const bool last = (t == nt - 2);
            const char* a1 = cA + (size_t)(t + 1) * kstep;
            const char* a2 = last ? nA : cA + (size_t)(t + 2) * kstep; const char* b2 = last ? nB : cB + (size_t)(t + 2) * kstep;
            const char* a3 = a2 + kstep; const char* b3 = b2 + kstep;
            if (last && has_next) S.a_ready(nxt);
            if constexpr (SP2) {
            PG8_LDB(B0, 0, 0); PG8_LDB(B1, 0, 1); PG8_SCHED; PG8_LDA(At, 0, 0); PG8_STAGE(PG8_SA(1, 1), a1 + hstepA, voffA);
            PG8_WAIT_V(8); PG8_WAIT_L(0); PG8_BAR; PG8_MMA(0, 0, At, B0); PG8_MMA(0, 1, At, B1); PG8_BAR; PG8_SCHED;
            PG8_LDA(At, 0, 1); PG8_STAGE(PG8_SB(0, 0), b2, voffB); PG8_STAGE(PG8_SB(0, 1), b2 + hstepB, voffB); PG8_STAGE(PG8_SA(0, 0), a2, voffA);
            PG8_WAIT_V(8); PG8_WAIT_L(0); PG8_BAR; PG8_MMA(1, 0, At, B0); PG8_MMA(1, 1, At, B1); PG8_BAR; PG8_SCHED;
            PG8_LDB(B0, 1, 0); PG8_LDB(B1, 1, 1); PG8_SCHED; PG8_LDA(At, 1, 0); PG8_STAGE(PG8_SA(0, 1), a2 + hstepA, voffA);
            PG8_WAIT_V(8); PG8_WAIT_L(0); PG8_BAR; PG8_MMA(0, 0, At, B0); PG8_MMA(0, 1, At, B1); PG8_BAR; PG8_SCHED;
            PG8_LDA(At, 1, 1); PG8_STAGE(PG8_SB(1, 0), b3, voffB); PG8_STAGE(PG8_SB(1, 1), b3 + hstepB, voffB); PG8_STAGE(PG8_SA(1, 0), a3, voffA);
            PG8_WAIT_V(8); PG8_WAIT_L(0); PG8_BAR; PG8_MMA(1, 0, At, B0); PG8_MMA(1, 1, At, B1); PG8_BAR; PG8_SCHED;
            } else {
            PG8_LDB(B0, 0, 0); PG8_SCHED; PG8_LDA(At, 0, 0); PG8_STAGE(PG8_SA(1, 1), a1 + hstepA, voffA);
            PG8_WAIT_L(8); PG8_BAR; PG8_WAIT_L(0); PG8_MMA(0, 0, At, B0); PG8_BAR; PG8_SCHED;
            PG8_LDB(B1, 0, 1); PG8_STAGE(PG8_SB(0, 0), b2, voffB);
            PG8_BAR; PG8_WAIT_L(0); PG8_MMA(0, 1, At, B1); PG8_BAR;
            PG8_LDA(At, 0, 1); PG8_STAGE(PG8_SA(0, 0), a2, voffA);
            PG8_BAR; PG8_WAIT_L(0); PG8_MMA(1, 0, At, B0); PG8_BAR; PG8_SCHED;
            PG8_STAGE(PG8_SB(0, 1), b2 + hstepB, voffB);
            PG8_WAIT_V(6); PG8_BAR; PG8_MMA(1, 1, At, B1); PG8_BAR;
            PG8_LDB(B0, 1, 0); PG8_SCHED; PG8_LDA(At, 1, 0); PG8_STAGE(PG8_SA(0, 1), a2 + hstepA, voffA);
            PG8_WAIT_L(8); PG8_BAR; PG8_WAIT_L(0); PG8_MMA(0, 0, At, B0); PG8_BAR; PG8_SCHED;
            PG8_LDB(B1, 1, 1); PG8_STAGE(PG8_SB(1, 0), b3, voffB);
            PG8_BAR; PG8_WAIT_L(0); PG8_MMA(0, 1, At, B1); PG8_BAR;
            PG8_LDA(At, 1, 1); PG8_STAGE(PG8_SA(1, 0), a3, voffA);
            PG8_BAR; PG8_WAIT_L(0); PG8_MMA(1, 0, At, B0); PG8_BAR; PG8_SCHED;
            PG8_STAGE(PG8_SB(1, 1), b3 + hstepB, voffB);
            PG8_WAIT_V(6); PG8_BAR; PG8_MMA(1, 1, At, B1); PG8_BAR;
            }
        }
        if constexpr (ALIGN_EPI) { if (wr == 0) PG8_BAR; }
        if constexpr (!Epi::AFTER_DRAIN) { E(acc, cur, wr, wc, fr, fq); S.done(cur); }
        if (!has_next) break;
#pragma unroll
        for (int a = 0; a < 2; ++a)
#pragma unroll
            for (int b = 0; b < 2; ++b)
#pragma unroll
                for (int m = 0; m < 4; ++m)
#pragma unroll
                    for (int n = 0; n < 2; ++n) acc[a][b][m][n] = (f32x4){0.f, 0.f, 0.f, 0.f};
        cur = nxt; cA = nA; cB = nB; ++ui;
        if constexpr (ALIGN_EPI) { if (wr == 1) PG8_BAR; }
    }
    PG8_WAIT_V(0);
    if constexpr (!ALIGN_EPI) { if (wr == 0) PG8_BAR; }
    PG8_BAR;
    if constexpr (Epi::AFTER_DRAIN) { E.fused(acc, cur, wr, wc, fr, fq, lds, wid, lane); S.done(cur); }
#undef PG8_SA
#undef PG8_SB
#undef PG8_STAGE
#undef PG8_LDA
#undef PG8_LDB
#undef PG8_MMA
#undef PG8_WAIT_V
#undef PG8_WAIT_L
#undef PG8_BAR
#undef PG8_SCHED
}
}

#ifndef MK_PER_PHASE
#define MK_PER_PHASE 1
#endif
constexpr int D = 1024, NBATCH = 8, SEQ = 4096, NLAT = NBATCH * SEQ, CTXL = 256, NCTX = NBATCH * CTXL, MALL = NLAT + NCTX;
constexpr int RH = 4, RQK = 256, RV = 512;
constexpr int DFF = 2816, NE = 8, DFE = 3584;
constexpr float EPS = 1e-6f;
constexpr float LAMBDA_INIT = 0.3555090675909693f;
constexpr float LOG2E = 1.4426950408889634f;
constexpr int NWAVES = 8, NTHREADS = 512;
constexpr int MOE_ROWS = 2 * NLAT + NE * 256;

enum { I_X = 0, I_C, I_CTX, I_CCTX, I_L0_WMOD, I_L0_BMOD, I_L0_NPREMIX, I_L0_NPOSTMIX, I_L0_NPREFFN, I_L0_NPOSTFFN, I_L0_WIN, I_L0_DECAY, I_L0_WOUT, I_L0_WGU, I_L0_WDN,
       I_L1_WMOD, I_L1_BMOD, I_L1_NPREMIX, I_L1_NPOSTMIX, I_L1_NPREFFN, I_L1_NPOSTFFN, I_L1_WIN, I_L1_LAMBDA, I_L1_SUBLN, I_L1_WOUT, I_L1_RW, I_L1_RB, I_L1_MGU, I_L1_MDN, N_IN };

constexpr size_t MiB = 1u << 20;
constexpr size_t WS_CTL = 0, CTL_ZERO_BYTES = 1 * MiB;
constexpr size_t WS_MODV = 1 * MiB;
constexpr size_t WS_TAB0 = 1 * MiB + 512 * 1024;
constexpr size_t WS_TAB1 = WS_TAB0 + 32 * 1024;
constexpr size_t WS_LAM = WS_TAB1 + 8 * 1024;
constexpr size_t WS_ROUTE = 2 * MiB;
constexpr size_t WS_XCTX = 3 * MiB;
constexpr size_t WS_W0IN = 11 * MiB, WS_W0OUT = 27 * MiB, WS_W0GU = 31 * MiB, WS_W0DN = 42 * MiB, WS_W1IN = 48 * MiB, WS_W1OUT = 54 * MiB, WS_WMGU = 56 * MiB, WS_WMDN = 168 * MiB;
constexpr size_t WS_H = 224 * MiB;
constexpr size_t WS_A = 292 * MiB, WS_B = 564 * MiB;
constexpr size_t WS_OF = WS_B, WS_OB = WS_B + 136 * MiB;
constexpr size_t WS_HP = WS_A, WS_ACT1 = 424 * MiB, WS_Y1 = WS_A;
constexpr size_t WS_END = 886 * MiB;
static_assert(WS_ACT1 + (size_t)MOE_ROWS * DFE * 2 <= WS_END, "ws map");
static_assert(WS_HP + (size_t)MOE_ROWS * D * 2 <= WS_ACT1, "ws map");
constexpr int CW_TMO = 0;
constexpr int CW_BAR = 4096;
constexpr int CW_MOECNT = 16384;

constexpr int RING_BYTES = 131072;
constexpr int MISC_OFF = RING_BYTES;
constexpr int LDS_BYTES = 147456;

#define GAS __attribute__((address_space(1)))
#define LAS __attribute__((address_space(3)))
typedef unsigned short bf16;
typedef unsigned v4u __attribute__((ext_vector_type(4)));
typedef unsigned v2u __attribute__((ext_vector_type(2)));
typedef float f32x4 __attribute__((ext_vector_type(4)));
typedef float f32x2 __attribute__((ext_vector_type(2)));
typedef short bf16x8 __attribute__((ext_vector_type(8)));
typedef GAS unsigned gu32;
#define RLX_AGENT __ATOMIC_RELAXED, __HIP_MEMORY_SCOPE_AGENT
#define LDS_WAIT() asm volatile("s_waitcnt lgkmcnt(0)" ::: "memory")
#define VM_WAIT() asm volatile("s_waitcnt vmcnt(0)" ::: "memory")
__device__ __forceinline__ unsigned f2bf(float f) { unsigned u = __builtin_bit_cast(unsigned, f); return (u + 0x7fffu + ((u >> 16) & 1u)) >> 16; }
__device__ __forceinline__ unsigned pk2(float lo, float hi) { return f2bf(lo) | (f2bf(hi) << 16); }
__device__ __forceinline__ float bf2f(unsigned b) { return __builtin_bit_cast(float, b << 16); }
__device__ __forceinline__ float bflo(unsigned w) { return __builtin_bit_cast(float, w << 16); }
__device__ __forceinline__ float bfhi(unsigned w) { return __builtin_bit_cast(float, w & 0xffff0000u); }
__device__ __forceinline__ float fast_exp2(float x) { return __builtin_amdgcn_exp2f(x); }
__device__ __forceinline__ float silu_f(float g) { return g * __builtin_amdgcn_rcpf(1.0f + __builtin_amdgcn_exp2f(-g * LOG2E)); }
__device__ __forceinline__ float wave_sum(float v) {
#pragma unroll
    for (int o = 1; o < 64; o <<= 1) v += __shfl_xor(v, o);
    return v;
}

#define XB_TMO      128
#define XB_XCNT(j)  (256  + 64 * (j))
#define XB_XSUB(j)  (1280 + 64 * (j))
#define XB_XGEN(j)  (2304 + 64 * (j))
#define XB_TOP      3328
#define XB_TOPGEN   3392
#define XCD_BAR_WORDS 3456
#define XB_SPIN_CAP (1u << 24)

__device__ __forceinline__ unsigned xb_ld(unsigned* p)              { return __hip_atomic_load(p, __ATOMIC_RELAXED, __HIP_MEMORY_SCOPE_AGENT); }
__device__ __forceinline__ unsigned xb_add(unsigned* p, unsigned v) { return __hip_atomic_fetch_add(p, v, __ATOMIC_RELAXED, __HIP_MEMORY_SCOPE_AGENT); }
__device__ __forceinline__ unsigned xb_xcc_id() { return (unsigned)__builtin_amdgcn_s_getreg((3 << 11) | 20) & 0xFu; }
#define XB_SPIN(cond, bar) do { unsigned _sp = 0; while (cond) { __builtin_amdgcn_s_sleep(1); \
    if ((++_sp & 255u) == 0u) { if (xb_ld(&(bar)[XB_TMO])) break; if (_sp > XB_SPIN_CAP) { atomicAdd(&(bar)[XB_TMO], 1u); break; } } } } while (0)

struct XcdBarrier {
    unsigned* bar; unsigned x;
    volatile LAS unsigned* st;
};

__device__ __forceinline__ XcdBarrier xcd_barrier_post(unsigned* bar, volatile LAS unsigned* st) {
    XcdBarrier b; b.bar = bar; b.x = xb_xcc_id(); b.st = st;
    if (threadIdx.x == 0) (void)xb_add(&bar[XB_XCNT(b.x)], 1u);
    return b;
}
__device__ __forceinline__ void xcd_barrier_complete(unsigned* bar, unsigned x, unsigned& nloc, unsigned& nx) {
    const unsigned G = gridDim.x * gridDim.y * gridDim.z;
    unsigned sum, cnt, mine, sp = 0u;
    for (;;) {
        sum = 0u; cnt = 0u; mine = 0u;
#pragma unroll
        for (unsigned j = 0; j < 16; ++j) { const unsigned c = xb_ld(&bar[XB_XCNT(j)]); sum += c; cnt += (c > 0u) ? 1u : 0u; mine = (j == x) ? c : mine; }
        if (sum == G) break;
        __builtin_amdgcn_s_sleep(1);
        if ((++sp & 255u) == 0u) { if (xb_ld(&bar[XB_TMO])) break; if (sp > XB_SPIN_CAP) { atomicAdd(&bar[XB_TMO], 1u); break; } }
    }
    nloc = mine > 0u ? mine : 1u; nx = cnt > 0u ? cnt : 1u;
}

__device__ __forceinline__ void xcd_barrier(const XcdBarrier& b) {
    asm volatile("s_waitcnt vmcnt(0)" ::: "memory");
    __syncthreads();
    if (threadIdx.x == 0) {
        unsigned* bar = b.bar;
        __builtin_amdgcn_s_waitcnt(0);
        unsigned nloc = b.st[0], nx = b.st[1];
        if (nloc == 0u) { xcd_barrier_complete(bar, b.x, nloc, nx); b.st[0] = nloc; b.st[1] = nx; }
        const unsigned old = xb_add(&bar[XB_XSUB(b.x)], 1u);
        const unsigned gen = old / nloc;
        if (old + 1u == (gen + 1u) * nloc) {
            __builtin_amdgcn_fence(__ATOMIC_RELEASE, "agent");
            asm volatile("s_waitcnt vmcnt(0)" ::: "memory");
            const unsigned og = xb_add(&bar[XB_TOP], 1u);
            const unsigned tg = og / nx;
            if (og + 1u == (tg + 1u) * nx) xb_add(&bar[XB_TOPGEN], 1u);
            else XB_SPIN(xb_ld(&bar[XB_TOPGEN]) == tg, bar);
            __builtin_amdgcn_fence(__ATOMIC_ACQUIRE, "agent");
            xb_add(&bar[XB_XGEN(b.x)], 1u);
            asm volatile("s_waitcnt vmcnt(0)" ::: "memory");
        } else {
            XB_SPIN(xb_ld(&bar[XB_XGEN(b.x)]) == gen, bar);
            __builtin_amdgcn_fence(__ATOMIC_ACQUIRE, "agent");
            asm volatile("s_waitcnt vmcnt(0)" ::: "memory");
        }
    }
    __syncthreads();
}


struct Args { const float* in[N_IN]; float* out; unsigned char* ws; int ph_lo, ph_hi; };

struct Frame {
    LAS unsigned char* lds;
    volatile LAS unsigned* MISC;
    gu32* ctl;
    int tid, lane, wave, vcu, G;
    unsigned char* ws;
};

namespace pg8 {
struct EpiStore {
    static constexpr bool PERM = true, AFTER_DRAIN = false;
    bf16_t* O; int ldc;
    __device__ __forceinline__ void operator()(const f32x4 (&acc)[2][2][4][2], const Unit& u, int wr, int wc, int fr, int fq) const {
        const int row0 = u.pm * BM + wr * 64 + fr; const int col0 = u.pc * BM + wc * 32 + 8 * fq;
#pragma unroll
        for (int ai = 0; ai < 2; ++ai)
#pragma unroll
            for (int m = 0; m < 4; ++m) { bf16_t* rowp = O + (size_t)(row0 + ai * HALF + m * 16) * ldc + col0;
#pragma unroll
                for (int bj = 0; bj < 2; ++bj) { const f32x4 v0 = acc[ai][bj][m][0], v1 = acc[ai][bj][m][1];
                    u32x4 w; w.x = cvt_pk_bf16(v0[0], v0[1]); w.y = cvt_pk_bf16(v0[2], v0[3]); w.z = cvt_pk_bf16(v1[0], v1[1]); w.w = cvt_pk_bf16(v1[2], v1[3]);
                    *(u32x4*)(rowp + bj * HALF) = w; } }
    }
};
struct EpiSwiglu {
    static constexpr bool PERM = true, AFTER_DRAIN = false;
    bf16_t* O; int ldc;
    __device__ __forceinline__ void operator()(const f32x4 (&acc)[2][2][4][2], const Unit& u, int wr, int wc, int fr, int fq) const {
        const int row0 = u.pm * BM + wr * 64 + fr; const int col0 = u.pc * HALF + wc * 32 + 8 * fq;
#pragma unroll
        for (int ai = 0; ai < 2; ++ai)
#pragma unroll
            for (int m = 0; m < 4; ++m) { bf16_t* rowp = O + (size_t)(row0 + ai * HALF + m * 16) * ldc + col0;
                f32x4 a0, a1;
#pragma unroll
                for (int e = 0; e < 4; ++e) { a0[e] = silu_f(acc[ai][0][m][0][e]) * acc[ai][1][m][0][e]; a1[e] = silu_f(acc[ai][0][m][1][e]) * acc[ai][1][m][1][e]; }
                u32x4 w; w.x = cvt_pk_bf16(a0[0], a0[1]); w.y = cvt_pk_bf16(a0[2], a0[3]); w.z = cvt_pk_bf16(a1[0], a1[1]); w.w = cvt_pk_bf16(a1[2], a1[3]);
                *(u32x4*)rowp = w; }
    }
};
struct MoeOrder {
    int nM, nN, nwg, G, c; int t1, t2, t3, t4, t5, t6, t7;
    __device__ bool next(int i, Unit& u) const {
        const long L = (long)i * G + c; if (L >= nwg) return false;
        int wgid = (int)L; { const int q = nwg / NXCD, r = nwg % NXCD, xcd = wgid % NXCD, off = wgid / NXCD; wgid = (xcd < r ? xcd * (q + 1) : r * (q + 1) + (xcd - r) * q) + off; }
        const int nig = WGM * nN, gid = wgid / nig, fm = gid * WGM, gsz = (nM - fm) < WGM ? (nM - fm) : WGM;
        u.pm = fm + ((wgid % nig) % gsz); u.pc = (wgid % nig) / gsz;
        const int e = (u.pm >= t1) + (u.pm >= t2) + (u.pm >= t3) + (u.pm >= t4) + (u.pm >= t5) + (u.pm >= t6) + (u.pm >= t7);
        u.pn = e * nN + u.pc; return true;
    }
    __device__ __forceinline__ void a_ready(const Unit&) const {}
    __device__ __forceinline__ void done(const Unit&) const {}
};
}

__device__ __forceinline__ void p0_transpose_item(const float* W, int K, int N, bf16* WT, int drow0, LAS float* scr, int k0, int n0, int lane) {
#pragma unroll 8
    for (int i = 0; i < 32; ++i) { const int kk = 2 * i + (lane >> 5); scr[kk * 33 + (lane & 31)] = W[(size_t)(k0 + kk) * N + n0 + (lane & 31)]; }
    LDS_WAIT(); asm volatile("" ::: "memory");
    const int c = lane & 7;
#pragma unroll
    for (int j = 0; j < 4; ++j) { const int n = (lane >> 3) + 8 * j; const LAS float* s = scr + (8 * c) * 33 + n;
        v4u o; o.x = pk2(s[0 * 33], s[1 * 33]); o.y = pk2(s[2 * 33], s[3 * 33]); o.z = pk2(s[4 * 33], s[5 * 33]); o.w = pk2(s[6 * 33], s[7 * 33]);
        *(GAS v4u*)(WT + (size_t)(drow0 + n) * K + k0 + 8 * c) = o; }
    LDS_WAIT(); asm volatile("" ::: "memory");
}
__device__ __forceinline__ int swiglu_row(int n0, int F) { const int bj = n0 / F, w = n0 % F; return 256 * (w >> 7) + 128 * bj + (w & 127); }

__device__ __forceinline__ void p0_prologue(Frame& F, const Args& a) {
    LAS float* scr = (LAS float*)(F.lds + F.wave * 16384);
    const int gw = F.vcu * NWAVES + F.wave, NGW = F.G * NWAVES;
    constexpr int I0 = (D / 64) * (8192 / 32), I1 = (2048 / 64) * (D / 32), I2 = (D / 64) * (2 * DFF / 32), I3 = (DFF / 64) * (D / 32), I4 = (D / 64) * (3072 / 32), I5 = (D / 64) * (D / 32);
    constexpr int I6E = (D / 64) * (2 * DFE / 32), I7E = (DFE / 64) * (D / 32);
    constexpr int NITEMS = I0 + I1 + I2 + I3 + I4 + I5 + NE * I6E + NE * I7E;
    for (int it = gw; it < NITEMS; it += NGW) {
        int r = it;
        if (r < I0) { const int nb = r % (8192 / 32), kb = r / (8192 / 32); p0_transpose_item(a.in[I_L0_WIN], D, 8192, (bf16*)(F.ws + WS_W0IN), 32 * nb, scr, 64 * kb, 32 * nb, F.lane); continue; } r -= I0;
        if (r < I1) { const int nb = r % (D / 32), kb = r / (D / 32); p0_transpose_item(a.in[I_L0_WOUT], 2048, D, (bf16*)(F.ws + WS_W0OUT), 32 * nb, scr, 64 * kb, 32 * nb, F.lane); continue; } r -= I1;
        if (r < I2) { const int nb = r % (2 * DFF / 32), kb = r / (2 * DFF / 32); p0_transpose_item(a.in[I_L0_WGU], D, 2 * DFF, (bf16*)(F.ws + WS_W0GU), swiglu_row(32 * nb, DFF), scr, 64 * kb, 32 * nb, F.lane); continue; } r -= I2;
        if (r < I3) { const int nb = r % (D / 32), kb = r / (D / 32); p0_transpose_item(a.in[I_L0_WDN], DFF, D, (bf16*)(F.ws + WS_W0DN), 32 * nb, scr, 64 * kb, 32 * nb, F.lane); continue; } r -= I3;
        if (r < I4) { const int nb = r % (3072 / 32), kb = r / (3072 / 32); p0_transpose_item(a.in[I_L1_WIN], D, 3072, (bf16*)(F.ws + WS_W1IN), 32 * nb, scr, 64 * kb, 32 * nb, F.lane); continue; } r -= I4;
        if (r < I5) { const int nb = r % (D / 32), kb = r / (D / 32); p0_transpose_item(a.in[I_L1_WOUT], D, D, (bf16*)(F.ws + WS_W1OUT), 32 * nb, scr, 64 * kb, 32 * nb, F.lane); continue; } r -= I5;
        if (r < NE * I6E) { const int e = r / I6E, rr = r % I6E; const int nb = rr % (2 * DFE / 32), kb = rr / (2 * DFE / 32);
            p0_transpose_item(a.in[I_L1_MGU] + (size_t)e * D * 2 * DFE, D, 2 * DFE, (bf16*)(F.ws + WS_WMGU) + (size_t)e * 2 * DFE * D, swiglu_row(32 * nb, DFE), scr, 64 * kb, 32 * nb, F.lane); continue; } r -= NE * I6E;
        { const int e = r / I7E, rr = r % I7E; const int nb = rr % (D / 32), kb = rr / (D / 32);
            p0_transpose_item(a.in[I_L1_MDN] + (size_t)e * DFE * D, DFE, D, (bf16*)(F.ws + WS_WMDN) + (size_t)e * D * DFE, 32 * nb, scr, 64 * kb, 32 * nb, F.lane); }
    }
    __syncthreads();
    {
        LAS float* sc = (LAS float*)F.lds;
        LAS float* part = (LAS float*)(F.lds + 9 * 1024 * 4);
        bool loaded = false;
        for (int grp = F.vcu; grp < 2 * (6 * D / 64); grp += F.G) {
            if (!loaded) { for (int i = F.tid; i < 9 * 1024; i += NTHREADS) { const float cv = (i < 8 * 1024) ? a.in[I_C][i] : a.in[I_CCTX][i - 8 * 1024]; sc[i] = silu_f(cv); } loaded = true; }
            __syncthreads();
            const int layer = grp / (6 * D / 64), cb = (grp % (6 * D / 64)) * 64;
            const float* W = a.in[layer ? I_L1_WMOD : I_L0_WMOD]; const float* bm = a.in[layer ? I_L1_BMOD : I_L0_BMOD];
            const int ks = F.tid >> 6, col = F.tid & 63;
            float acc[9];
#pragma unroll
            for (int b = 0; b < 9; ++b) acc[b] = 0.f;
            for (int k = ks * 128; k < ks * 128 + 128; ++k) { const float w = W[(size_t)k * (6 * D) + cb + col];
#pragma unroll
                for (int b = 0; b < 9; ++b) acc[b] += sc[b * 1024 + k] * w; }
#pragma unroll
            for (int b = 0; b < 9; ++b) part[(ks * 9 + b) * 64 + col] = acc[b];
            __syncthreads();
            for (int o = F.tid; o < 9 * 64; o += NTHREADS) { const int b = o >> 6, cc = o & 63; float s = bm[cb + cc];
#pragma unroll
                for (int k2 = 0; k2 < 8; ++k2) s += part[(k2 * 9 + b) * 64 + cc];
                ((float*)(F.ws + WS_MODV))[((size_t)layer * 9 + b) * (6 * D) + cb + cc] = s; }
            __syncthreads();
        }
    }
    {
        const int gt = F.vcu * NTHREADS + F.tid;
        if (gt < 64 * 64 + 64 * 16) {
            int pos, i; float ex;
            if (gt < 4096) { pos = gt >> 6; i = gt & 63; ex = (float)(2 * i) / 128.0f; } else { const int q = gt - 4096; pos = q >> 4; i = q & 15; ex = (float)(2 * i) / 32.0f; }
            const float freq = __builtin_amdgcn_exp2f(-ex * 13.287712379549449f);
            const float rev = (float)pos * freq * 0.15915494309189535f;
            const float cs = __builtin_amdgcn_cosf(rev), sn = __builtin_amdgcn_sinf(rev);
            f32x2* t = (f32x2*)(F.ws + (gt < 4096 ? WS_TAB0 : WS_TAB1)); t[gt < 4096 ? gt : gt - 4096] = (f32x2){cs, sn};
        }
        if (gt == 0) { const float* lp = a.in[I_L1_LAMBDA]; float s1 = 0.f, s2 = 0.f; for (int i = 0; i < 64; ++i) { s1 += lp[i] * lp[64 + i]; s2 += lp[128 + i] * lp[192 + i]; }
            *(float*)(F.ws + WS_LAM) = __expf(s1) - __expf(s2) + LAMBDA_INIT; }
    }
}

struct RowPass {
    int nrows;
    const float* xin_lat; const float* xin_ctx; float* xout_lat; float* xout_ctx;
    const bf16* br;
    const float* gpost;
    const float* gate;
    const float* gpre;
    const float* shift; const float* scale;
    bf16* hout;
};
template <bool BR, bool MOEBR, bool WH, bool ROUTE>
__device__ __forceinline__ void row_pass(Frame& F, const Args& a, const RowPass& P) {
    const int gw = F.vcu * NWAVES + F.wave, NGW = F.G * NWAVES;
    const int l4 = F.lane * 4;
    for (int r = gw; r < P.nrows; r += NGW) {
        const bool lat = r < NLAT; const int rc = lat ? r : r - NLAT; const int midx = lat ? (r >> 12) : 8;
        const float* xin = (lat ? P.xin_lat : P.xin_ctx) + (size_t)rc * D;
        float* xout = (lat ? P.xout_lat : P.xout_ctx) + (size_t)rc * D;
        f32x4 v[4];
#pragma unroll
        for (int j = 0; j < 4; ++j) v[j] = *(const GAS f32x4*)(xin + l4 + 256 * j);
        if constexpr (BR || MOEBR) {
            f32x4 y[4];
            if constexpr (BR) {
#pragma unroll
                for (int j = 0; j < 4; ++j) { const v2u w = *(const GAS v2u*)(P.br + (size_t)r * D + l4 + 256 * j); y[j] = (f32x4){bflo(w.x), bfhi(w.x), bflo(w.y), bfhi(w.y)}; }
            } else {
                const int* tpos = (const int*)(F.ws + WS_ROUTE + (size_t)NLAT * 8); const float* tw = (const float*)(F.ws + WS_ROUTE + (size_t)NLAT * 16);
                const int s0 = tpos[2 * r], s1 = tpos[2 * r + 1]; const float w0 = tw[2 * r], w1 = tw[2 * r + 1];
#pragma unroll
                for (int j = 0; j < 4; ++j) { const v2u p = *(const GAS v2u*)(P.br + (size_t)s0 * D + l4 + 256 * j); const v2u q = *(const GAS v2u*)(P.br + (size_t)s1 * D + l4 + 256 * j);
                    y[j] = (f32x4){w0 * bflo(p.x) + w1 * bflo(q.x), w0 * bfhi(p.x) + w1 * bfhi(q.x), w0 * bflo(p.y) + w1 * bflo(q.y), w0 * bfhi(p.y) + w1 * bfhi(q.y)}; }
            }
            float ss = 0.f;
#pragma unroll
            for (int j = 0; j < 4; ++j) ss += (y[j].x * y[j].x + y[j].y * y[j].y) + (y[j].z * y[j].z + y[j].w * y[j].w);
            const float rstd = 1.0f / sqrtf(wave_sum(ss) * (1.0f / D) + EPS);
#pragma unroll
            for (int j = 0; j < 4; ++j) { const f32x4 gp = *(const GAS f32x4*)(P.gpost + l4 + 256 * j); const f32x4 gt = *(const GAS f32x4*)(P.gate + (size_t)midx * 6 * D + l4 + 256 * j);
                v[j] = v[j] + gt * (y[j] * rstd * gp); }
#pragma unroll
            for (int j = 0; j < 4; ++j) *(GAS f32x4*)(xout + l4 + 256 * j) = v[j];
        }
        if constexpr (WH) {
            float ss = 0.f;
#pragma unroll
            for (int j = 0; j < 4; ++j) ss += (v[j].x * v[j].x + v[j].y * v[j].y) + (v[j].z * v[j].z + v[j].w * v[j].w);
            const float rstd = 1.0f / sqrtf(wave_sum(ss) * (1.0f / D) + EPS);
            f32x4 h[4];
#pragma unroll
            for (int j = 0; j < 4; ++j) { const f32x4 gp = *(const GAS f32x4*)(P.gpre + l4 + 256 * j); const f32x4 sc = *(const GAS f32x4*)(P.scale + (size_t)midx * 6 * D + l4 + 256 * j);
                const f32x4 sh = *(const GAS f32x4*)(P.shift + (size_t)midx * 6 * D + l4 + 256 * j);
                h[j] = (v[j] * rstd * gp) * (1.0f + sc) + sh;
                v2u w; w.x = pk2(h[j].x, h[j].y); w.y = pk2(h[j].z, h[j].w); *(GAS v2u*)(P.hout + (size_t)r * D + l4 + 256 * j) = w; }
            if constexpr (ROUTE) {
                const float* rw = a.in[I_L1_RW];
                float lg[8];
#pragma unroll
                for (int e = 0; e < 8; ++e) lg[e] = 0.f;
#pragma unroll
                for (int j = 0; j < 4; ++j)
#pragma unroll
                    for (int q = 0; q < 4; ++q) { const int k = l4 + 256 * j + q; const f32x4 wa = *(const GAS f32x4*)(rw + (size_t)k * 8), wb = *(const GAS f32x4*)(rw + (size_t)k * 8 + 4); const float hv = h[j][q];
                        lg[0] += hv * wa.x; lg[1] += hv * wa.y; lg[2] += hv * wa.z; lg[3] += hv * wa.w; lg[4] += hv * wb.x; lg[5] += hv * wb.y; lg[6] += hv * wb.z; lg[7] += hv * wb.w; }
#pragma unroll
                for (int e = 0; e < 8; ++e) lg[e] = wave_sum(lg[e]) + a.in[I_L1_RB][e];
                float v1 = lg[0]; int i1 = 0;
#pragma unroll
                for (int e = 1; e < 8; ++e) if (lg[e] > v1) { v1 = lg[e]; i1 = e; }
                float v2 = -3.0e38f; int i2 = 0;
#pragma unroll
                for (int e = 0; e < 8; ++e) if (e != i1 && lg[e] > v2) { v2 = lg[e]; i2 = e; }
                const float w1 = 1.0f / (1.0f + __expf(v2 - v1)), w2 = 1.0f - w1;
                if (F.lane == 0) {
                    int* te = (int*)(F.ws + WS_ROUTE); int* tpos = (int*)(F.ws + WS_ROUTE + (size_t)NLAT * 8); float* tw = (float*)(F.ws + WS_ROUTE + (size_t)NLAT * 16);
                    const unsigned p1 = __hip_atomic_fetch_add((unsigned*)(F.ctl + CW_MOECNT + 64 * i1), 1u, RLX_AGENT);
                    const unsigned p2 = __hip_atomic_fetch_add((unsigned*)(F.ctl + CW_MOECNT + 64 * i2), 1u, RLX_AGENT);
                    te[2 * r] = i1; te[2 * r + 1] = i2; tpos[2 * r] = (int)p1; tpos[2 * r + 1] = (int)p2; tw[2 * r] = w1; tw[2 * r + 1] = w2;
                }
            }
        }
    }
}

__device__ __forceinline__ void rope0_pass(Frame& F) {
    bf16* z = (bf16*)(F.ws + WS_A); const f32x2* tab = (const f32x2*)(F.ws + WS_TAB0);
    const int gw = F.vcu * NWAVES + F.wave, NGW = F.G * NWAVES; const int i = F.lane;
    for (int r = gw; r < MALL; r += NGW) {
        const bool lat = r < NLAT; const int t = r & (SEQ - 1);
        bf16* zr = z + (size_t)r * 4096;
#pragma unroll
        for (int T = 0; T < 2; ++T)
#pragma unroll
            for (int h = 0; h < RH; ++h)
#pragma unroll
                for (int hf = 0; hf < 2; ++hf) {
                    const int base = T * 1024 + h * 256 + hf * 128; const float sc = T ? 0.0625f : 1.0f;
                    float x1 = bf2f(zr[base + i]), x2 = bf2f(zr[base + 64 + i]);
                    if (lat) { const int pos = hf ? (t & 63) : (t >> 6); const f32x2 cs = tab[pos * 64 + i]; const float y1 = x1 * cs.x - x2 * cs.y, y2 = x2 * cs.x + x1 * cs.y; x1 = y1; x2 = y2; }
                    zr[base + i] = (bf16)f2bf(x1 * sc); zr[base + 64 + i] = (bf16)f2bf(x2 * sc);
                }
    }
}
__device__ __forceinline__ void rope1_pass(Frame& F) {
    bf16* z = (bf16*)(F.ws + WS_A); const f32x2* tab = (const f32x2*)(F.ws + WS_TAB1);
    const int gw = F.vcu * NWAVES + F.wave, NGW = F.G * NWAVES;
    for (int r = gw; r < MALL; r += NGW) {
        const bool lat = r < NLAT; const int t = r & (SEQ - 1);
        bf16* zr = z + (size_t)r * 3072;
#pragma unroll
        for (int T = 0; T < 2; ++T)
#pragma unroll
            for (int jj = 0; jj < 8; ++jj) {
                const int pp = F.lane + 64 * jj; const int head = pp >> 5, hf = (pp >> 4) & 1, i = pp & 15;
                const int base = T * 1024 + head * 64 + hf * 32; const float sc = T ? 1.0f : 0.125f * LOG2E;
                float x1 = bf2f(zr[base + i]), x2 = bf2f(zr[base + 16 + i]);
                if (lat) { const int pos = hf ? (t & 63) : (t >> 6); const f32x2 cs = tab[pos * 16 + i]; const float y1 = x1 * cs.x - x2 * cs.y, y2 = x2 * cs.x + x1 * cs.y; x1 = y1; x2 = y2; }
                zr[base + i] = (bf16)f2bf(x1 * sc); zr[base + 16 + i] = (bf16)f2bf(x2 * sc);
            }
    }
}
__device__ __forceinline__ void merge_pass(Frame& F) {
    const bf16* zg = (const bf16*)(F.ws + WS_A); bf16* of = (bf16*)(F.ws + WS_OF); const bf16* ob = (const bf16*)(F.ws + WS_OB);
    const int gw = F.vcu * NWAVES + F.wave, NGW = F.G * NWAVES;
    for (int r = gw; r < MALL; r += NGW) {
#pragma unroll
        for (int h = 0; h < RH; ++h) {
            const size_t o = (size_t)r * 2048 + h * 512 + F.lane * 8;
            const v4u a = *(const GAS v4u*)(of + o), b = *(const GAS v4u*)(ob + o);
            const v4u gf = *(const GAS v4u*)(zg + (size_t)r * 4096 + h * 512 + F.lane * 8), gb = *(const GAS v4u*)(zg + (size_t)r * 4096 + 2048 + h * 512 + F.lane * 8);
            float av[8], bv[8], gfv[8], gbv[8];
#pragma unroll
            for (int q = 0; q < 4; ++q) { av[2 * q] = bflo(a[q]); av[2 * q + 1] = bfhi(a[q]); bv[2 * q] = bflo(b[q]); bv[2 * q + 1] = bfhi(b[q]);
                gfv[2 * q] = bflo(gf[q]); gfv[2 * q + 1] = bfhi(gf[q]); gbv[2 * q] = bflo(gb[q]); gbv[2 * q + 1] = bfhi(gb[q]); }
            float sa = 0.f, sb = 0.f;
#pragma unroll
            for (int q = 0; q < 8; ++q) { sa += av[q] * av[q]; sb += bv[q] * bv[q]; }
            const float ra = 1.0f / sqrtf(wave_sum(sa) * (1.0f / RV) + EPS), rb = 1.0f / sqrtf(wave_sum(sb) * (1.0f / RV) + EPS);
            float y[8];
#pragma unroll
            for (int q = 0; q < 8; ++q) y[q] = silu_f(gfv[q]) * (av[q] * ra) + silu_f(gbv[q]) * (bv[q] * rb);
            v4u w; w.x = pk2(y[0], y[1]); w.y = pk2(y[2], y[3]); w.z = pk2(y[4], y[5]); w.w = pk2(y[6], y[7]);
            *(GAS v4u*)(of + o) = w;
        }
    }
}

__device__ __forceinline__ void ret_naive(Frame& F, const Args& a) {
    const bf16* z = (const bf16*)(F.ws + WS_A);
    LAS bf16* qk = (LAS bf16*)F.lds;
    LAS bf16* vb = (LAS bf16*)(F.lds + 32768);
    LAS float* part = (LAS float*)(F.lds + 32768 + 2048);
    const int half = F.tid >> 8, d = F.tid & 255;
    for (int unit = F.vcu; unit < NBATCH * RH * 2 * 16; unit += F.G) {
        const int vs = unit & 15, dir = (unit >> 4) & 1, h = (unit >> 5) & 3, b = unit >> 7;
        const float logit = a.in[I_L0_DECAY][dir * RH + h];
        const float gamma = 1.0f / (1.0f + __expf(-logit));
        float S[16];
#pragma unroll
        for (int v = 0; v < 16; ++v) S[v] = 0.f;
        bf16* outp = (bf16*)(F.ws + (dir ? WS_OB : WS_OF));
        for (int s = 0; s < 136; ++s) {
            int blk; size_t row0;
            if (s < 8) { blk = dir ? 7 - s : s; row0 = (size_t)NLAT + b * CTXL + blk * 32; } else { blk = dir ? 127 - (s - 8) : (s - 8); row0 = (size_t)b * SEQ + blk * 32; }
            __syncthreads();
            for (int i = F.tid; i < 32 * 64; i += NTHREADS) { const int tk = i >> 6, c8 = i & 63;
                const bf16* src = z + (row0 + tk) * 4096 + (c8 < 32 ? h * 256 + c8 * 8 : 1024 + h * 256 + (c8 - 32) * 8);
                *(LAS v4u*)(qk + tk * 512 + c8 * 8) = *(const GAS v4u*)src; }
            if (F.tid < 128) { const int tk = F.tid >> 2, c8 = F.tid & 3; *(LAS v4u*)(vb + tk * 32 + c8 * 8) = *(const GAS v4u*)(z + (row0 + tk) * 4096 + 2048 + h * 512 + vs * 32 + c8 * 8); }
            __syncthreads();
            for (int i = 0; i < 32; ++i) {
                const int tk = dir ? 31 - i : i;
                const float qv = bf2f(qk[tk * 512 + d]), kv = bf2f(qk[tk * 512 + 256 + d]);
                float p[16];
#pragma unroll
                for (int v = 0; v < 16; ++v) { const float vv = bf2f(vb[tk * 32 + half * 16 + v]); S[v] = gamma * S[v] + kv * vv; p[v] = qv * S[v]; }
                const int ln = F.lane;
                float p8[8], p4[4], p2[2], p1;
#pragma unroll
                for (int j = 0; j < 8; ++j) { const bool up = (ln & 32) != 0; const float keep = up ? p[j + 8] : p[j], send = up ? p[j] : p[j + 8]; p8[j] = keep + __shfl_xor(send, 32); }
#pragma unroll
                for (int j = 0; j < 4; ++j) { const bool up = (ln & 16) != 0; const float keep = up ? p8[j + 4] : p8[j], send = up ? p8[j] : p8[j + 4]; p4[j] = keep + __shfl_xor(send, 16); }
#pragma unroll
                for (int j = 0; j < 2; ++j) { const bool up = (ln & 8) != 0; const float keep = up ? p4[j + 2] : p4[j], send = up ? p4[j] : p4[j + 2]; p2[j] = keep + __shfl_xor(send, 8); }
                { const bool up = (ln & 4) != 0; const float keep = up ? p2[1] : p2[0], send = up ? p2[0] : p2[1]; p1 = keep + __shfl_xor(send, 4); }
                p1 += __shfl_xor(p1, 1); p1 += __shfl_xor(p1, 2);
                if ((ln & 3) == 0) { const int vi = ((ln >> 5) & 1) * 8 + ((ln >> 4) & 1) * 4 + ((ln >> 3) & 1) * 2 + ((ln >> 2) & 1); part[(tk * 8 + F.wave) * 16 + vi] = p1; }
            }
            __syncthreads();
            for (int o = F.tid; o < 32 * 32; o += NTHREADS) { const int tk = o >> 5, v = o & 31, hf = v >> 4, vi = v & 15;
                float sum = 0.f;
#pragma unroll
                for (int w = 0; w < 4; ++w) sum += part[(tk * 8 + hf * 4 + w) * 16 + vi];
                outp[(row0 + tk) * 2048 + h * 512 + vs * 32 + v] = (bf16)f2bf(sum); }
        }
    }
}

__device__ __forceinline__ void attn_naive(Frame& F, const Args& a) {
    const bf16* z = (const bf16*)(F.ws + WS_A);
    bf16* ao = (bf16*)(F.ws + WS_B);
    LAS float* Kt = (LAS float*)F.lds;
    LAS float* Vt = (LAS float*)(F.lds + 8192);
    LAS float* xs = (LAS float*)(F.lds + 8192 + 16384);
    const float lam = *(const float*)(F.ws + WS_LAM);
    const int half = F.tid >> 8, rl = F.tid & 255;
    for (int unit = F.vcu; unit < NBATCH * 8 * 16; unit += F.G) {
        const int qb = unit & 15, hp = (unit >> 4) & 7, b = unit >> 7;
        const size_t qrow = (size_t)b * SEQ + qb * 256 + rl;
        float o1[64];
#pragma unroll 1
        for (int hh = 0; hh < 2; ++hh) {
            const int qh = 2 * hp + hh;
            float q[64];
#pragma unroll
            for (int c = 0; c < 8; ++c) { const v4u w = *(const GAS v4u*)(z + qrow * 3072 + qh * 64 + c * 8);
#pragma unroll
                for (int e = 0; e < 4; ++e) { q[c * 8 + 2 * e] = bflo(w[e]); q[c * 8 + 2 * e + 1] = bfhi(w[e]); } }
            float o[64];
#pragma unroll
            for (int i = 0; i < 64; ++i) o[i] = 0.f;
            float m = -1.0e30f, l = 0.f;
            for (int kt = 0; kt < 136; ++kt) {
                const size_t krow0 = kt < 128 ? (size_t)b * SEQ + kt * 32 : (size_t)NLAT + b * CTXL + (kt - 128) * 32;
                __syncthreads();
                { const int key = F.tid >> 4, c4 = F.tid & 15;
                    const v2u w = *(const GAS v2u*)(z + (krow0 + key) * 3072 + 1024 + qh * 64 + c4 * 4);
                    *(LAS f32x4*)(Kt + key * 64 + c4 * 4) = (f32x4){bflo(w.x), bfhi(w.x), bflo(w.y), bfhi(w.y)};
                    const v4u u = *(const GAS v4u*)(z + (krow0 + key) * 3072 + 2048 + hp * 128 + c4 * 8);
                    *(LAS f32x4*)(Vt + key * 128 + c4 * 8) = (f32x4){bflo(u.x), bfhi(u.x), bflo(u.y), bfhi(u.y)};
                    *(LAS f32x4*)(Vt + key * 128 + c4 * 8 + 4) = (f32x4){bflo(u.z), bfhi(u.z), bflo(u.w), bfhi(u.w)}; }
                __syncthreads();
                for (int key = 0; key < 32; ++key) {
                    float s = 0.f;
#pragma unroll
                    for (int c = 0; c < 16; ++c) { const f32x4 kv = *(const LAS f32x4*)(Kt + key * 64 + c * 4); s += q[4 * c] * kv.x + q[4 * c + 1] * kv.y + q[4 * c + 2] * kv.z + q[4 * c + 3] * kv.w; }
                    const float mn = fmaxf(m, s); const float al = fast_exp2(m - mn), p = fast_exp2(s - mn); m = mn; l = l * al + p;
#pragma unroll
                    for (int c = 0; c < 16; ++c) { const f32x4 vv = *(const LAS f32x4*)(Vt + key * 128 + half * 64 + c * 4);
                        o[4 * c] = o[4 * c] * al + p * vv.x; o[4 * c + 1] = o[4 * c + 1] * al + p * vv.y; o[4 * c + 2] = o[4 * c + 2] * al + p * vv.z; o[4 * c + 3] = o[4 * c + 3] * al + p * vv.w; }
                }
            }
            const float rl_ = 1.0f / l;
            if (hh == 0) {
#pragma unroll
                for (int i = 0; i < 64; ++i) o1[i] = o[i] * rl_;
            } else {
#pragma unroll
                for (int i = 0; i < 64; ++i) o1[i] = o1[i] - lam * (o[i] * rl_);
            }
        }
        float ss = 0.f;
#pragma unroll
        for (int i = 0; i < 64; ++i) ss += o1[i] * o1[i];
        __syncthreads();
        xs[F.tid] = ss;
        __syncthreads();
        const float tot = xs[rl] + xs[256 + rl];
        const float rstd = 1.0f / sqrtf(tot * (1.0f / 128.0f) + EPS) * (1.0f - LAMBDA_INIT);
        const float* sub = a.in[I_L1_SUBLN];
#pragma unroll
        for (int c = 0; c < 8; ++c) { v4u w;
#pragma unroll
            for (int e = 0; e < 4; ++e) { const int i0 = c * 8 + 2 * e; w[e] = pk2(o1[i0] * rstd * sub[half * 64 + i0], o1[i0 + 1] * rstd * sub[half * 64 + i0 + 1]); }
            *(GAS v4u*)(ao + qrow * 1024 + hp * 128 + half * 64 + c * 8) = w; }
    }
}

__device__ __forceinline__ void moe_counts(Frame& F, int (&cnt)[NE]) {
#pragma unroll
    for (int e = 0; e < NE; ++e) cnt[e] = (int)__hip_atomic_load((unsigned*)(F.ctl + CW_MOECNT + 64 * e), RLX_AGENT);
}
__device__ __forceinline__ void moe_gather(Frame& F) {
    int cnt[NE]; moe_counts(F, cnt);
    int base[NE]; int acc = 0;
#pragma unroll
    for (int e = 0; e < NE; ++e) { base[e] = acc; acc += (cnt[e] + 255) & ~255; }
    const int* te = (const int*)(F.ws + WS_ROUTE); int* tpos = (int*)(F.ws + WS_ROUTE + (size_t)NLAT * 8);
    const bf16* hb = (const bf16*)(F.ws + WS_H); bf16* hp = (bf16*)(F.ws + WS_HP);
    const int gw = F.vcu * NWAVES + F.wave, NGW = F.G * NWAVES;
    for (int r = gw; r < NLAT; r += NGW) {
        const int e0 = te[2 * r], e1 = te[2 * r + 1]; const int p0 = tpos[2 * r], p1 = tpos[2 * r + 1];
        int b0 = 0, b1 = 0;
#pragma unroll
        for (int e = 0; e < NE; ++e) { b0 = (e0 == e) ? base[e] : b0; b1 = (e1 == e) ? base[e] : b1; }
        const int s0 = b0 + p0, s1 = b1 + p1;
        const v4u x0 = *(const GAS v4u*)(hb + (size_t)r * D + F.lane * 8), x1 = *(const GAS v4u*)(hb + (size_t)r * D + 512 + F.lane * 8);
        *(GAS v4u*)(hp + (size_t)s0 * D + F.lane * 8) = x0; *(GAS v4u*)(hp + (size_t)s0 * D + 512 + F.lane * 8) = x1;
        *(GAS v4u*)(hp + (size_t)s1 * D + F.lane * 8) = x0; *(GAS v4u*)(hp + (size_t)s1 * D + 512 + F.lane * 8) = x1;
        if (F.lane == 0) { tpos[2 * r] = s0; tpos[2 * r + 1] = s1; }
    }
}
__device__ __forceinline__ void moe_order(Frame& F, pg8::MoeOrder& S, int nN) {
    int cnt[NE]; moe_counts(F, cnt);
    int ts[NE + 1]; ts[0] = 0;
#pragma unroll
    for (int e = 0; e < NE; ++e) ts[e + 1] = ts[e] + ((cnt[e] + 255) >> 8);
    S.nM = ts[NE]; S.nN = nN; S.nwg = S.nM * nN; S.G = F.G; S.c = (int)blockIdx.x;
    S.t1 = ts[1]; S.t2 = ts[2]; S.t3 = ts[3]; S.t4 = ts[4]; S.t5 = ts[5]; S.t6 = ts[6]; S.t7 = ts[7];
}

constexpr int N_PHASES = 21;
__global__ void __launch_bounds__(NTHREADS, 2) fwd(Args args) {
    extern __shared__ __attribute__((aligned(16))) unsigned char lds[];
    Frame F;
    F.lds = (LAS unsigned char*)lds; F.MISC = (volatile LAS unsigned*)(F.lds + MISC_OFF);
    F.tid = threadIdx.x; F.lane = F.tid & 63; F.wave = __builtin_amdgcn_readfirstlane(F.tid >> 6);
    F.G = gridDim.x; { const int bx = blockIdx.x; F.vcu = (F.G % 8 == 0) ? (bx % 8) * (F.G / 8) + bx / 8 : bx; }
    F.ws = args.ws; F.ctl = (gu32*)(args.ws + WS_CTL);
    for (int u = F.tid; u < 64; u += NTHREADS) ((LAS unsigned*)(F.lds + MISC_OFF))[u] = 0u;
    __syncthreads();
#if MK_PER_PHASE
    XcdBarrier bar; bar.bar = (unsigned*)(F.ctl + CW_BAR); bar.x = 0; bar.st = nullptr;
#define GRID_BAR() do { } while (0)
#else
    XcdBarrier bar = xcd_barrier_post((unsigned*)(F.ctl + CW_BAR), F.MISC + 8);
#define GRID_BAR() xcd_barrier(bar)
#endif
    const int lo = args.ph_lo, hi = args.ph_hi;
#define IN(k) (lo <= (k) && (k) < hi)
#define SEAM(k) do { if (IN(k) && IN((k) + 1)) GRID_BAR(); } while (0)
    unsigned char* ws = args.ws;
    float* modv = (float*)(ws + WS_MODV);
    float* modv1 = modv + 9 * 6 * D;
    bf16* hbuf = (bf16*)(ws + WS_H);
    float* xctx = (float*)(ws + WS_XCTX);
    using pg8::Gemm; using pg8::StaticOrder;

    if (IN(0)) { p0_prologue(F, args); SEAM(0); }
    if (IN(1)) { RowPass P{MALL, args.in[I_X], args.in[I_CTX], nullptr, nullptr, nullptr, nullptr, nullptr, args.in[I_L0_NPREMIX], modv + 0 * D, modv + 1 * D, hbuf};
        row_pass<false, false, true, false>(F, args, P); SEAM(1); }
    if (IN(2)) { Gemm g{hbuf, (const bf16*)(ws + WS_W0IN), MALL, 4096, D, D}; StaticOrder S; S.init(MALL, 4096, F.G, (int)blockIdx.x);
        pg8::EpiStore E{(bf16*)(ws + WS_A), 4096};
        pg8::gemm_phase<pg8::EpiStore, StaticOrder, true, true>(F.lds, g, S, E); SEAM(2); }
    if (IN(3)) { rope0_pass(F); SEAM(3); }
    if (IN(4)) { ret_naive(F, args); SEAM(4); }
    if (IN(5)) { Gemm g{hbuf, (const bf16*)(ws + WS_W0IN) + (size_t)4096 * D, MALL, 4096, D, D}; StaticOrder S; S.init(MALL, 4096, F.G, (int)blockIdx.x);
        pg8::EpiStore E{(bf16*)(ws + WS_A), 4096};
        pg8::gemm_phase<pg8::EpiStore, StaticOrder, true, true>(F.lds, g, S, E); SEAM(5); }
    if (IN(6)) { merge_pass(F); SEAM(6); }
    if (IN(7)) { Gemm g{(const bf16*)(ws + WS_OF), (const bf16*)(ws + WS_W0OUT), MALL, D, 2048, 2048}; StaticOrder S; S.init(MALL, D, F.G, (int)blockIdx.x);
        pg8::EpiStore E{(bf16*)(ws + WS_A), D};
        pg8::gemm_phase<pg8::EpiStore, StaticOrder, true, true>(F.lds, g, S, E); SEAM(7); }
    if (IN(8)) { RowPass P{MALL, args.in[I_X], args.in[I_CTX], args.out, xctx, (const bf16*)(ws + WS_A), args.in[I_L0_NPOSTMIX], modv + 2 * D, args.in[I_L0_NPREFFN], modv + 3 * D, modv + 4 * D, hbuf};
        row_pass<true, false, true, false>(F, args, P); SEAM(8); }
    if (IN(9)) { Gemm g{hbuf, (const bf16*)(ws + WS_W0GU), MALL, 2 * DFF, D, D}; StaticOrder S; S.init(MALL, 2 * DFF, F.G, (int)blockIdx.x);
        pg8::EpiSwiglu E{(bf16*)(ws + WS_B), DFF};
        pg8::gemm_phase<pg8::EpiSwiglu, StaticOrder, true, true>(F.lds, g, S, E); SEAM(9); }
    if (IN(10)) { Gemm g{(const bf16*)(ws + WS_B), (const bf16*)(ws + WS_W0DN), MALL, D, DFF, DFF}; StaticOrder S; S.init(MALL, D, F.G, (int)blockIdx.x);
        pg8::EpiStore E{(bf16*)(ws + WS_A), D};
        pg8::gemm_phase<pg8::EpiStore, StaticOrder, true, true>(F.lds, g, S, E); SEAM(10); }
    if (IN(11)) { RowPass P{MALL, args.out, xctx, args.out, xctx, (const bf16*)(ws + WS_A), args.in[I_L0_NPOSTFFN], modv + 5 * D, args.in[I_L1_NPREMIX], modv1 + 0 * D, modv1 + 1 * D, hbuf};
        row_pass<true, false, true, false>(F, args, P); SEAM(11); }
    if (IN(12)) { Gemm g{hbuf, (const bf16*)(ws + WS_W1IN), MALL, 3072, D, D}; StaticOrder S; S.init(MALL, 3072, F.G, (int)blockIdx.x);
        pg8::EpiStore E{(bf16*)(ws + WS_A), 3072};
        pg8::gemm_phase<pg8::EpiStore, StaticOrder, true, true>(F.lds, g, S, E); SEAM(12); }
    if (IN(13)) { rope1_pass(F); SEAM(13); }
    if (IN(14)) { attn_naive(F, args); SEAM(14); }
    if (IN(15)) { Gemm g{(const bf16*)(ws + WS_B), (const bf16*)(ws + WS_W1OUT), NLAT, D, D, D}; StaticOrder S; S.init(NLAT, D, F.G, (int)blockIdx.x);
        pg8::EpiStore E{(bf16*)(ws + WS_A), D};
        pg8::gemm_phase<pg8::EpiStore, StaticOrder, true, true>(F.lds, g, S, E); SEAM(15); }
    if (IN(16)) { RowPass P{NLAT, args.out, xctx, args.out, xctx, (const bf16*)(ws + WS_A), args.in[I_L1_NPOSTMIX], modv1 + 2 * D, args.in[I_L1_NPREFFN], modv1 + 3 * D, modv1 + 4 * D, hbuf};
        row_pass<true, false, true, true>(F, args, P); SEAM(16); }
    if (IN(17)) { moe_gather(F); SEAM(17); }
    if (IN(18)) { Gemm g{(const bf16*)(ws + WS_HP), (const bf16*)(ws + WS_WMGU), MOE_ROWS, 2 * DFE, D, D}; pg8::MoeOrder S; moe_order(F, S, 2 * DFE / 256);
        pg8::EpiSwiglu E{(bf16*)(ws + WS_ACT1), DFE};
        pg8::gemm_phase<pg8::EpiSwiglu, pg8::MoeOrder, true, true>(F.lds, g, S, E); SEAM(18); }
    if (IN(19)) { Gemm g{(const bf16*)(ws + WS_ACT1), (const bf16*)(ws + WS_WMDN), MOE_ROWS, D, DFE, DFE}; pg8::MoeOrder S; moe_order(F, S, D / 256);
        pg8::EpiStore E{(bf16*)(ws + WS_Y1), D};
        pg8::gemm_phase<pg8::EpiStore, pg8::MoeOrder, true, true>(F.lds, g, S, E); SEAM(19); }
    if (IN(20)) { RowPass P{NLAT, args.out, xctx, args.out, xctx, (const bf16*)(ws + WS_Y1), args.in[I_L1_NPOSTFFN], modv1 + 5 * D, nullptr, nullptr, nullptr, nullptr};
        row_pass<false, true, false, false>(F, args, P); }
#undef IN
#undef SEAM
}

extern "C" void kernel_launch(void* const* d_in, const int* in_sizes, int n_in, void* d_out, int out_size, void* d_ws, size_t ws_size, hipStream_t stream) {
    static int grid = 0;
    if (grid == 0) {
        if (n_in != N_IN || out_size != NLAT * D || ws_size < WS_END) { fprintf(stderr, "kernel_launch: unexpected shapes n_in %d out %d ws %zu\n", n_in, out_size, ws_size); grid = -1; return; }
        int dev = 0, cus = 0, per_cu = 0;
        if (hipGetDevice(&dev) != hipSuccess || hipDeviceGetAttribute(&cus, hipDeviceAttributeMultiprocessorCount, dev) != hipSuccess) { grid = -1; return; }
        if (hipFuncSetAttribute((const void*)fwd, hipFuncAttributeMaxDynamicSharedMemorySize, LDS_BYTES) != hipSuccess) { fprintf(stderr, "kernel_launch: hipFuncSetAttribute failed\n"); grid = -1; return; }
        if (hipOccupancyMaxActiveBlocksPerMultiprocessor(&per_cu, (const void*)fwd, NTHREADS, LDS_BYTES) != hipSuccess || per_cu < 1) fprintf(stderr, "kernel_launch: occupancy query says %d\n", per_cu);
        (void)hipGetLastError();
        grid = cus;
    }
    if (grid < 0) return;
    (void)hipMemsetAsync((char*)d_ws + WS_CTL, 0, CTL_ZERO_BYTES, stream);
    Args a{};
    for (int i = 0; i < N_IN; ++i) a.in[i] = (const float*)d_in[i];
    a.out = (float*)d_out; a.ws = (unsigned char*)d_ws;
#if MK_PER_PHASE
    for (int p = 0; p < N_PHASES; ++p) { a.ph_lo = p; a.ph_hi = p + 1; hipLaunchKernelGGL(fwd, dim3(grid), dim3(NTHREADS), LDS_BYTES, stream, a); }
#else
    a.ph_lo = 0; a.ph_hi = N_PHASES; hipLaunchKernelGGL(fwd, dim3(grid), dim3(NTHREADS), LDS_BYTES, stream, a);
#endif
}
```

```cpp
#include <hip/hip_runtime.h>
#include <cstdio>
#include <cstdint>
namespace pg8 {
#define PG8_LAS __attribute__((address_space(3)))
typedef unsigned short bf16_t;
typedef short bf16x8 __attribute__((ext_vector_type(8)));
typedef float f32x4 __attribute__((ext_vector_type(4)));
typedef unsigned u32x4 __attribute__((ext_vector_type(4)));
constexpr int BM = 256, BK = 64, HALF = 128, HTB = HALF * BK * 2  , STAGE_BYTES = 8 * HTB, NXCD = 8, WGM = 8;

__host__ __device__ __forceinline__ int lds_byte(int r, int c) { const int st = (r >> 4) * 2 + (c >> 5), rr = r & 15, cc = c & 31, ob = rr * 64 + cc * 2; return st * 1024 + (ob ^ (((ob >> 9) & 1) << 5)); }
__host__ __device__ __forceinline__ void stage_rc(int b, int& R, int& C) { const int st = b / 1024, sb = b % 1024, swz = sb ^ (((sb >> 9) & 1) << 5); R = (st >> 1) * 16 + swz / 64; C = (st & 1) * 32 + (swz % 64) / 2; }
__host__ __device__ __forceinline__ int perm32(int rho) { const int n = rho >> 4, i = rho & 15; return 8 * (i >> 2) + 4 * n + (i & 3); }

struct Unit { int pm, pn, pc; };
struct Gemm { const bf16_t* A; const bf16_t* Bt; int M, N, K, lda; };

struct StaticOrder {
    int nM, nN, nwg, G, c;
    __host__ __device__ void init(int M, int N, int G_, int c_) { nM = M / BM; nN = N / BM; nwg = nM * nN; G = G_; c = c_; }
    __host__ __device__ bool next(int i, Unit& u) const {
        const long L = (long)i * G + c; if (L >= nwg) return false;
        int wgid = (int)L; { const int q = nwg / NXCD, r = nwg % NXCD, xcd = wgid % NXCD, off = wgid / NXCD; wgid = (xcd < r ? xcd * (q + 1) : r * (q + 1) + (xcd - r) * q) + off; }
        const int nig = WGM * nN, gid = wgid / nig, fm = gid * WGM, gsz = (nM - fm) < WGM ? (nM - fm) : WGM;
        u.pm = fm + ((wgid % nig) % gsz); u.pn = (wgid % nig) / gsz; u.pc = u.pn; return true;
    }
    __device__ __forceinline__ void a_ready(const Unit&) const {}
    __device__ __forceinline__ void done(const Unit&) const {}
};

__device__ __forceinline__ unsigned cvt_pk_bf16(float lo, float hi) { unsigned r; asm volatile("v_cvt_pk_bf16_f32 %0, %1, %2" : "=v"(r) : "v"(lo), "v"(hi)); return r; }
typedef float f32x2 __attribute__((ext_vector_type(2)));
template <class Epi, class Sched, bool ALIGN_EPI = false, bool SP2 = false>
__device__ __forceinline__ void gemm_phase(PG8_LAS unsigned char* lds, const Gemm g, const Sched& S, const Epi& E) {
    const int tid = threadIdx.x, wid = __builtin_amdgcn_readfirstlane(tid >> 6), lane = tid & 63, wr = wid >> 2, wc = wid & 3, fr = lane & 15, fq = lane >> 4;
    const int K = g.K, nt = K / BK;
    unsigned voffA[2], voffB[2];
#pragma unroll
    for (int i = 0; i < 2; ++i) { int R, C; stage_rc(tid * 16 + i * 8192, R, C); const int Rb = Epi::PERM ? ((R & ~31) + perm32(R & 31)) : R;
        voffA[i] = (unsigned)(R * g.lda + C) * 2u; voffB[i] = (unsigned)(Rb * K + C) * 2u; }
    const size_t kstep = (size_t)(BK * 2);
    const size_t hstepA = (size_t)HALF * g.lda * 2, hstepB = (size_t)HALF * K * 2;
    const size_t tstepA = 2 * hstepA, tstepB = 2 * hstepB;
    const unsigned ldsw = (unsigned)wid * 1024u;
    const int aoff = lds_byte(wr * 64 + fr, fq * 8), boff = lds_byte(wc * 32 + fr, fq * 8);
#define PG8_SA(b, h) (((b) * 2 + (h)) * HTB)
#define PG8_SB(b, h) ((4 + (b) * 2 + (h)) * HTB)
#define PG8_STAGE(bufoff, gbase, voff) do { _Pragma("unroll") for (int _i = 0; _i < 2; ++_i) \
        __builtin_amdgcn_global_load_lds((const unsigned*)((const char*)(gbase) + (voff)[_i]), (PG8_LAS unsigned*)(lds + (bufoff) + ldsw + _i * 8192), 16, 0, 0); } while (0)
#define PG8_LDA(dst, b, h) do { _Pragma("unroll") for (int m = 0; m < 4; ++m) _Pragma("unroll") for (int k = 0; k < 2; ++k) dst[m][k] = *(const PG8_LAS bf16x8*)(lds + PG8_SA(b, h) + aoff + m * 2048 + k * 1024); } while (0)
#define PG8_LDB(dst, b, h) do { _Pragma("unroll") for (int n = 0; n < 2; ++n) _Pragma("unroll") for (int k = 0; k < 2; ++k) dst[n][k] = *(const PG8_LAS bf16x8*)(lds + PG8_SB(b, h) + boff + n * 2048 + k * 1024); } while (0)
#define PG8_MMA(ai, bj, At, Bt) do { __builtin_amdgcn_s_setprio(1); _Pragma("unroll") for (int m = 0; m < 4; ++m) _Pragma("unroll") for (int n = 0; n < 2; ++n) _Pragma("unroll") for (int k = 0; k < 2; ++k) \
        acc[ai][bj][m][n] = __builtin_amdgcn_mfma_f32_16x16x32_bf16(Bt[n][k], At[m][k], acc[ai][bj][m][n], 0, 0, 0); __builtin_amdgcn_s_setprio(0); } while (0)
#define PG8_WAIT_V(n) asm volatile("s_waitcnt vmcnt(" #n ")" ::: "memory")
#define PG8_WAIT_L(n) asm volatile("s_waitcnt lgkmcnt(" #n ")" ::: "memory")
#define PG8_BAR __builtin_amdgcn_s_barrier()
#define PG8_SCHED __builtin_amdgcn_sched_barrier(0)
    Unit cur, nxt; int ui = 0;
    if (!S.next(0, cur)) return;
    f32x4 acc[2][2][4][2];
#pragma unroll
    for (int a = 0; a < 2; ++a)
#pragma unroll
        for (int b = 0; b < 2; ++b)
#pragma unroll
            for (int m = 0; m < 4; ++m)
#pragma unroll
                for (int n = 0; n < 2; ++n) acc[a][b][m][n] = (f32x4){0.f, 0.f, 0.f, 0.f};
    bf16x8 At[4][2], B0[2][2], B1[2][2];
    const char* cA = (const char*)g.A + (size_t)cur.pm * tstepA; const char* cB = (const char*)g.Bt + (size_t)cur.pn * tstepB;
    S.a_ready(cur);
    if constexpr (SP2) {
        PG8_STAGE(PG8_SB(0, 0), cB, voffB); PG8_STAGE(PG8_SB(0, 1), cB + hstepB, voffB); PG8_STAGE(PG8_SA(0, 0), cA, voffA); PG8_STAGE(PG8_SA(0, 1), cA + hstepA, voffA);
        if (wr == 1) PG8_BAR;
        PG8_WAIT_V(2); PG8_BAR;
        PG8_STAGE(PG8_SB(1, 0), cB + kstep, voffB); PG8_STAGE(PG8_SA(1, 0), cA + kstep, voffA); PG8_STAGE(PG8_SB(1, 1), cB + hstepB + kstep, voffB);
        PG8_WAIT_V(6); PG8_BAR;
    } else {
        PG8_STAGE(PG8_SB(0, 0), cB, voffB); PG8_STAGE(PG8_SA(0, 0), cA, voffA); PG8_STAGE(PG8_SB(0, 1), cB + hstepB, voffB); PG8_STAGE(PG8_SA(0, 1), cA + hstepA, voffA);
        if (wr == 1) PG8_BAR;
        PG8_WAIT_V(4); PG8_BAR;
        PG8_STAGE(PG8_SB(1, 0), cB + kstep, voffB); PG8_STAGE(PG8_SA(1, 0), cA + kstep, voffA); PG8_STAGE(PG8_SB(1, 1), cB + hstepB + kstep, voffB);
        PG8_WAIT_V(6); PG8_BAR;
    }
    for (;;) {
        const bool has_next = S.next(ui + 1, nxt);
        const char* nA = has_next ? (const char*)g.A + (size_t)nxt.pm * tstepA : cA; const char* nB = has_next ? (const char*)g.Bt + (size_t)nxt.pn * tstepB : cB;
        for (int t = 0; t < nt; t += 2) {
            const bool last = (t == nt - 2);
            const char* a1 = cA + (size_t)(t + 1) * kstep;
            const char* a2 = last ? nA : cA + (size_t)(t + 2) * kstep; const char* b2 = last ? nB : cB + (size_t)(t + 2) * kstep;
            const char* a3 = a2 + kstep; const char* b3 = b2 + kstep;
            if (last && has_next) S.a_ready(nxt);
            if constexpr (SP2) {
            PG8_LDB(B0, 0, 0); PG8_LDB(B1, 0, 1); PG8_SCHED; PG8_LDA(At, 0, 0); PG8_STAGE(PG8_SA(1, 1), a1 + hstepA, voffA);
            PG8_WAIT_V(8); PG8_WAIT_L(0); PG8_BAR; PG8_MMA(0, 0, At, B0); PG8_MMA(0, 1, At, B1); PG8_BAR; PG8_SCHED;
            PG8_LDA(At, 0, 1); PG8_STAGE(PG8_SB(0, 0), b2, voffB); PG8_STAGE(PG8_SB(0, 1), b2 + hstepB, voffB); PG8_STAGE(PG8_SA(0, 0), a2, voffA);
            PG8_WAIT_V(8); PG8_WAIT_L(0); PG8_BAR; PG8_MMA(1, 0, At, B0); PG8_MMA(1, 1, At, B1); PG8_BAR; PG8_SCHED;
            PG8_LDB(B0, 1, 0); PG8_LDB(B1, 1, 1); PG8_SCHED; PG8_LDA(At, 1, 0); PG8_STAGE(PG8_SA(0, 1), a2 + hstepA, voffA);
            PG8_WAIT_V(8); PG8_WAIT_L(0); PG8_BAR; PG8_MMA(0, 0, At, B0); PG8_MMA(0, 1, At, B1); PG8_BAR; PG8_SCHED;
            PG8_LDA(At, 1, 1); PG8_STAGE(PG8_SB(1, 0), b3, voffB); PG8_STAGE(PG8_SB(1, 1), b3 + hstepB, voffB); PG8_STAGE(PG8_SA(1, 0), a3, voffA);
            PG8_WAIT_V(8); PG8_WAIT_L(0); PG8_BAR; PG8_MMA(1, 0, At, B0); PG8_MMA(1, 1, At, B1); PG8_BAR; PG8_SCHED;
            } else {
            PG8_LDB(B0, 0, 0); PG8_SCHED; PG8_LDA(At, 0, 0); PG8_STAGE(PG8_SA(1, 1), a1 + hstepA, voffA);
            PG8_WAIT_L(8); PG8_BAR; PG8_WAIT_L(0); PG8_MMA(0, 0, At, B0); PG8_BAR; PG8_SCHED;
            PG8_LDB(B1, 0, 1); PG8_STAGE(PG8_SB(0, 0), b2, voffB);
            PG8_BAR; PG8_WAIT_L(0); PG8_MMA(0, 1, At, B1); PG8_BAR;
            PG8_LDA(At, 0, 1); PG8_STAGE(PG8_SA(0, 0), a2, voffA);
            PG8_BAR; PG8_WAIT_L(0); PG8_MMA(1, 0, At, B0); PG8_BAR; PG8_SCHED;
            PG8_STAGE(PG8_SB(0, 1), b2 + hstepB, voffB);
            PG8_WAIT_V(6); PG8_BAR; PG8_MMA(1, 1, At, B1); PG8_BAR;
            PG8_LDB(B0, 1, 0); PG8_SCHED; PG8_LDA(At, 1, 0); PG8_STAGE(PG8_SA(0, 1), a2 + hstepA, voffA);
            PG8_WAIT_L(8); PG8_BAR; PG8_WAIT_L(0); PG8_MMA(0, 0, At, B0); PG8_BAR; PG8_SCHED;
            PG8_LDB(B1, 1, 1); PG8_STAGE(PG8_SB(1, 0), b3, voffB);
            PG8_BAR; PG8_WAIT_L(0); PG8_MMA(0, 1, At, B1); PG8_BAR;
            PG8_LDA(At, 1, 1); PG8_STAGE(PG8_SA(1, 0), a3, voffA);
            PG8_BAR; PG8_WAIT_L(0); PG8_MMA(1, 0, At, B0); PG8_BAR; PG8_SCHED;
            PG8_STAGE(PG8_SB(1, 1), b3 + hstepB, voffB);
            PG8_WAIT_V(6); PG8_BAR; PG8_MMA(1, 1, At, B1); PG8_BAR;
            }
        }
        if constexpr (ALIGN_EPI) { if (wr == 0) PG8_BAR; }
        if constexpr (!Epi::AFTER_DRAIN) { E(acc, cur, wr, wc, fr, fq); S.done(cur); }
        if (!has_next) break;
#pragma unroll
        for (int a = 0; a < 2; ++a)
#pragma unroll
            for (int b = 0; b < 2; ++b)
#pragma unroll
                for (int m = 0; m < 4; ++m)
#pragma unroll
                    for (int n = 0; n < 2; ++n) acc[a][b][m][n] = (f32x4){0.f, 0.f, 0.f, 0.f};
        cur = nxt; cA = nA; cB = nB; ++ui;
        if constexpr (ALIGN_EPI) { if (wr == 1) PG8_BAR; }
    }
    PG8_WAIT_V(0);
    if constexpr (!ALIGN_EPI) { if (wr == 0) PG8_BAR; }
    PG8_BAR;
    if constexpr (Epi::AFTER_DRAIN) { E.fused(acc, cur, wr, wc, fr, fq, lds, wid, lane); S.done(cur); }
#undef PG8_SA
#undef PG8_SB
#undef PG8_STAGE
#undef PG8_LDA
#undef PG8_LDB
#undef PG8_MMA
#undef PG8_WAIT_V
#undef PG8_WAIT_L
#undef PG8_BAR
#undef PG8_SCHED
}
}

#ifndef MK_PER_PHASE
#define MK_PER_PHASE 0
#endif
constexpr int D = 1024, NBATCH = 8, SEQ = 4096, NLAT = NBATCH * SEQ, CTXL = 256, NCTX = NBATCH * CTXL, MALL = NLAT + NCTX;
constexpr int RH = 4, RQK = 256, RV = 512;
constexpr int DFF = 2816, NE = 8, DFE = 3584;
constexpr float EPS = 1e-6f;
constexpr float LAMBDA_INIT = 0.3555090675909693f;
constexpr float LOG2E = 1.4426950408889634f;
constexpr int NWAVES = 8, NTHREADS = 512;
constexpr int MOE_ROWS = 2 * NLAT + NE * 256;

enum { I_X = 0, I_C, I_CTX, I_CCTX, I_L0_WMOD, I_L0_BMOD, I_L0_NPREMIX, I_L0_NPOSTMIX, I_L0_NPREFFN, I_L0_NPOSTFFN, I_L0_WIN, I_L0_DECAY, I_L0_WOUT, I_L0_WGU, I_L0_WDN,
       I_L1_WMOD, I_L1_BMOD, I_L1_NPREMIX, I_L1_NPOSTMIX, I_L1_NPREFFN, I_L1_NPOSTFFN, I_L1_WIN, I_L1_LAMBDA, I_L1_SUBLN, I_L1_WOUT, I_L1_RW, I_L1_RB, I_L1_MGU, I_L1_MDN, N_IN };

constexpr size_t MiB = 1u << 20;
constexpr size_t WS_CTL = 0, CTL_ZERO_BYTES = 1 * MiB;
constexpr size_t WS_MODV = 1 * MiB;
constexpr size_t WS_TAB0 = 1 * MiB + 512 * 1024;
constexpr size_t WS_TAB1 = WS_TAB0 + 32 * 1024;
constexpr size_t WS_LAM = WS_TAB1 + 8 * 1024;
constexpr size_t WS_ROUTE = 2 * MiB;
constexpr size_t WS_XCTX = 3 * MiB;
constexpr size_t WS_W0IN = 11 * MiB, WS_W0OUT = 27 * MiB, WS_W0GU = 31 * MiB, WS_W0DN = 42 * MiB, WS_W1IN = 48 * MiB, WS_W1OUT = 54 * MiB, WS_WMGU = 56 * MiB, WS_WMDN = 168 * MiB;
constexpr size_t WS_H = 224 * MiB;
constexpr size_t WS_A = 292 * MiB, WS_B = 564 * MiB;
constexpr size_t WS_OF = WS_B, WS_OB = WS_B + 136 * MiB;
constexpr size_t WS_HP = WS_A, WS_ACT1 = 424 * MiB, WS_Y1 = WS_A;
constexpr size_t WS_END = 886 * MiB;
static_assert(WS_ACT1 + (size_t)MOE_ROWS * DFE * 2 <= WS_END, "ws map");
static_assert(WS_HP + (size_t)MOE_ROWS * D * 2 <= WS_ACT1, "ws map");
constexpr int CW_TMO = 0;
constexpr int CW_BAR = 4096;
constexpr int CW_MOECNT = 16384;

constexpr int RING_BYTES = 131072;
constexpr int MISC_OFF = RING_BYTES;
constexpr int LDS_BYTES = 147456;

#define GAS __attribute__((address_space(1)))
#define LAS __attribute__((address_space(3)))
typedef unsigned short bf16;
typedef unsigned v4u __attribute__((ext_vector_type(4)));
typedef unsigned v2u __attribute__((ext_vector_type(2)));
typedef float f32x4 __attribute__((ext_vector_type(4)));
typedef float f32x2 __attribute__((ext_vector_type(2)));
typedef short bf16x8 __attribute__((ext_vector_type(8)));
typedef GAS unsigned gu32;
#define RLX_AGENT __ATOMIC_RELAXED, __HIP_MEMORY_SCOPE_AGENT
#define LDS_WAIT() asm volatile("s_waitcnt lgkmcnt(0)" ::: "memory")
#define VM_WAIT() asm volatile("s_waitcnt vmcnt(0)" ::: "memory")
__device__ __forceinline__ unsigned f2bf(float f) { unsigned u = __builtin_bit_cast(unsigned, f); return (u + 0x7fffu + ((u >> 16) & 1u)) >> 16; }
__device__ __forceinline__ unsigned pk2(float lo, float hi) { return f2bf(lo) | (f2bf(hi) << 16); }
__device__ __forceinline__ float bf2f(unsigned b) { return __builtin_bit_cast(float, b << 16); }
__device__ __forceinline__ float bflo(unsigned w) { return __builtin_bit_cast(float, w << 16); }
__device__ __forceinline__ float bfhi(unsigned w) { return __builtin_bit_cast(float, w & 0xffff0000u); }
__device__ __forceinline__ float fast_exp2(float x) { return __builtin_amdgcn_exp2f(x); }
__device__ __forceinline__ float silu_f(float g) { return g * __builtin_amdgcn_rcpf(1.0f + __builtin_amdgcn_exp2f(-g * LOG2E)); }
__device__ __forceinline__ float wave_sum(float v) {
#pragma unroll
    for (int o = 1; o < 64; o <<= 1) v += __shfl_xor(v, o);
    return v;
}

#define XB_TMO      128
#define XB_XCNT(j)  (256  + 64 * (j))
#define XB_XSUB(j)  (1280 + 64 * (j))
#define XB_XGEN(j)  (2304 + 64 * (j))
#define XB_TOP      3328
#define XB_TOPGEN   3392
#define XCD_BAR_WORDS 3456
#define XB_SPIN_CAP (1u << 24)

__device__ __forceinline__ unsigned xb_ld(unsigned* p)              { return __hip_atomic_load(p, __ATOMIC_RELAXED, __HIP_MEMORY_SCOPE_AGENT); }
__device__ __forceinline__ unsigned xb_add(unsigned* p, unsigned v) { return __hip_atomic_fetch_add(p, v, __ATOMIC_RELAXED, __HIP_MEMORY_SCOPE_AGENT); }
__device__ __forceinline__ unsigned xb_xcc_id() { return (unsigned)__builtin_amdgcn_s_getreg((3 << 11) | 20) & 0xFu; }
#define XB_SPIN(cond, bar) do { unsigned _sp = 0; while (cond) { __builtin_amdgcn_s_sleep(1); \
    if ((++_sp & 255u) == 0u) { if (xb_ld(&(bar)[XB_TMO])) break; if (_sp > XB_SPIN_CAP) { atomicAdd(&(bar)[XB_TMO], 1u); break; } } } } while (0)

struct XcdBarrier {
    unsigned* bar; unsigned x;
    volatile LAS unsigned* st;
};

__device__ __forceinline__ XcdBarrier xcd_barrier_post(unsigned* bar, volatile LAS unsigned* st) {
    XcdBarrier b; b.bar = bar; b.x = xb_xcc_id(); b.st = st;
    if (threadIdx.x == 0) (void)xb_add(&bar[XB_XCNT(b.x)], 1u);
    return b;
}
__device__ __forceinline__ void xcd_barrier_complete(unsigned* bar, unsigned x, unsigned& nloc, unsigned& nx) {
    const unsigned G = gridDim.x * gridDim.y * gridDim.z;
    unsigned sum, cnt, mine, sp = 0u;
    for (;;) {
        sum = 0u; cnt = 0u; mine = 0u;
#pragma unroll
        for (unsigned j = 0; j < 16; ++j) { const unsigned c = xb_ld(&bar[XB_XCNT(j)]); sum += c; cnt += (c > 0u) ? 1u : 0u; mine = (j == x) ? c : mine; }
        if (sum == G) break;
        __builtin_amdgcn_s_sleep(1);
        if ((++sp & 255u) == 0u) { if (xb_ld(&bar[XB_TMO])) break; if (sp > XB_SPIN_CAP) { atomicAdd(&bar[XB_TMO], 1u); break; } }
    }
    nloc = mine > 0u ? mine : 1u; nx = cnt > 0u ? cnt : 1u;
}

__device__ __forceinline__ void xcd_barrier(const XcdBarrier& b) {
    asm volatile("s_waitcnt vmcnt(0)" ::: "memory");
    __syncthreads();
    if (threadIdx.x == 0) {
        unsigned* bar = b.bar;
        __builtin_amdgcn_s_waitcnt(0);
        unsigned nloc = b.st[0], nx = b.st[1];
        if (nloc == 0u) { xcd_barrier_complete(bar, b.x, nloc, nx); b.st[0] = nloc; b.st[1] = nx; }
        const unsigned old = xb_add(&bar[XB_XSUB(b.x)], 1u);
        const unsigned gen = old / nloc;
        if (old + 1u == (gen + 1u) * nloc) {
            __builtin_amdgcn_fence(__ATOMIC_RELEASE, "agent");
            asm volatile("s_waitcnt vmcnt(0)" ::: "memory");
            const unsigned og = xb_add(&bar[XB_TOP], 1u);
            const unsigned tg = og / nx;
            if (og + 1u == (tg + 1u) * nx) xb_add(&bar[XB_TOPGEN], 1u);
            else XB_SPIN(xb_ld(&bar[XB_TOPGEN]) == tg, bar);
            __builtin_amdgcn_fence(__ATOMIC_ACQUIRE, "agent");
            xb_add(&bar[XB_XGEN(b.x)], 1u);
            asm volatile("s_waitcnt vmcnt(0)" ::: "memory");
        } else {
            XB_SPIN(xb_ld(&bar[XB_XGEN(b.x)]) == gen, bar);
            __builtin_amdgcn_fence(__ATOMIC_ACQUIRE, "agent");
            asm volatile("s_waitcnt vmcnt(0)" ::: "memory");
        }
    }
    __syncthreads();
}


struct Args { const float* in[N_IN]; float* out; unsigned char* ws; int ph_lo, ph_hi; };

struct Frame {
    LAS unsigned char* lds;
    volatile LAS unsigned* MISC;
    gu32* ctl;
    int tid, lane, wave, vcu, G;
    unsigned char* ws;
};

namespace pg8 {
struct EpiStore {
    static constexpr bool PERM = true, AFTER_DRAIN = false;
    bf16_t* O; int ldc;
    __device__ __forceinline__ void operator()(const f32x4 (&acc)[2][2][4][2], const Unit& u, int wr, int wc, int fr, int fq) const {
        const int row0 = u.pm * BM + wr * 64 + fr; const int col0 = u.pc * BM + wc * 32 + 8 * fq;
#pragma unroll
        for (int ai = 0; ai < 2; ++ai)
#pragma unroll
            for (int m = 0; m < 4; ++m) { bf16_t* rowp = O + (size_t)(row0 + ai * HALF + m * 16) * ldc + col0;
#pragma unroll
                for (int bj = 0; bj < 2; ++bj) { const f32x4 v0 = acc[ai][bj][m][0], v1 = acc[ai][bj][m][1];
                    u32x4 w; w.x = cvt_pk_bf16(v0[0], v0[1]); w.y = cvt_pk_bf16(v0[2], v0[3]); w.z = cvt_pk_bf16(v1[0], v1[1]); w.w = cvt_pk_bf16(v1[2], v1[3]);
                    *(u32x4*)(rowp + bj * HALF) = w; } }
    }
};
struct EpiSwiglu {
    static constexpr bool PERM = true, AFTER_DRAIN = false;
    bf16_t* O; int ldc;
    __device__ __forceinline__ void operator()(const f32x4 (&acc)[2][2][4][2], const Unit& u, int wr, int wc, int fr, int fq) const {
        const int row0 = u.pm * BM + wr * 64 + fr; const int col0 = u.pc * HALF + wc * 32 + 8 * fq;
#pragma unroll
        for (int ai = 0; ai < 2; ++ai)
#pragma unroll
            for (int m = 0; m < 4; ++m) { bf16_t* rowp = O + (size_t)(row0 + ai * HALF + m * 16) * ldc + col0;
                f32x4 a0, a1;
#pragma unroll
                for (int e = 0; e < 4; ++e) { a0[e] = silu_f(acc[ai][0][m][0][e]) * acc[ai][1][m][0][e]; a1[e] = silu_f(acc[ai][0][m][1][e]) * acc[ai][1][m][1][e]; }
                u32x4 w; w.x = cvt_pk_bf16(a0[0], a0[1]); w.y = cvt_pk_bf16(a0[2], a0[3]); w.z = cvt_pk_bf16(a1[0], a1[1]); w.w = cvt_pk_bf16(a1[2], a1[3]);
                *(u32x4*)rowp = w; }
    }
};
struct MoeOrder {
    int nM, nN, nwg, G, c; int t1, t2, t3, t4, t5, t6, t7;
    __device__ bool next(int i, Unit& u) const {
        const long L = (long)i * G + c; if (L >= nwg) return false;
        int wgid = (int)L; { const int q = nwg / NXCD, r = nwg % NXCD, xcd = wgid % NXCD, off = wgid / NXCD; wgid = (xcd < r ? xcd * (q + 1) : r * (q + 1) + (xcd - r) * q) + off; }
        const int nig = WGM * nN, gid = wgid / nig, fm = gid * WGM, gsz = (nM - fm) < WGM ? (nM - fm) : WGM;
        u.pm = fm + ((wgid % nig) % gsz); u.pc = (wgid % nig) / gsz;
        const int e = (u.pm >= t1) + (u.pm >= t2) + (u.pm >= t3) + (u.pm >= t4) + (u.pm >= t5) + (u.pm >= t6) + (u.pm >= t7);
        u.pn = e * nN + u.pc; return true;
    }
    __device__ __forceinline__ void a_ready(const Unit&) const {}
    __device__ __forceinline__ void done(const Unit&) const {}
};
}

__device__ __forceinline__ void p0_transpose_item(const float* W, int K, int N, bf16* WT, int drow0, LAS float* scr, int k0, int n0, int lane) {
#pragma unroll 8
    for (int i = 0; i < 32; ++i) { const int kk = 2 * i + (lane >> 5); scr[kk * 33 + (lane & 31)] = W[(size_t)(k0 + kk) * N + n0 + (lane & 31)]; }
    LDS_WAIT(); asm volatile("" ::: "memory");
    const int c = lane & 7;
#pragma unroll
    for (int j = 0; j < 4; ++j) { const int n = (lane >> 3) + 8 * j; const LAS float* s = scr + (8 * c) * 33 + n;
        v4u o; o.x = pk2(s[0 * 33], s[1 * 33]); o.y = pk2(s[2 * 33], s[3 * 33]); o.z = pk2(s[4 * 33], s[5 * 33]); o.w = pk2(s[6 * 33], s[7 * 33]);
        *(GAS v4u*)(WT + (size_t)(drow0 + n) * K + k0 + 8 * c) = o; }
    LDS_WAIT(); asm volatile("" ::: "memory");
}
__device__ __forceinline__ int swiglu_row(int n0, int F) { const int bj = n0 / F, w = n0 % F; return 256 * (w >> 7) + 128 * bj + (w & 127); }

__device__ __forceinline__ void p0_prologue(Frame& F, const Args& a) {
    LAS float* scr = (LAS float*)(F.lds + F.wave * 16384);
    const int gw = F.vcu * NWAVES + F.wave, NGW = F.G * NWAVES;
    constexpr int I0 = (D / 64) * (8192 / 32), I1 = (2048 / 64) * (D / 32), I2 = (D / 64) * (2 * DFF / 32), I3 = (DFF / 64) * (D / 32), I4 = (D / 64) * (3072 / 32), I5 = (D / 64) * (D / 32);
    constexpr int I6E = (D / 64) * (2 * DFE / 32), I7E = (DFE / 64) * (D / 32);
    constexpr int NITEMS = I0 + I1 + I2 + I3 + I4 + I5 + NE * I6E + NE * I7E;
    for (int it = gw; it < NITEMS; it += NGW) {
        int r = it;
        if (r < I0) { const int nb = r % (8192 / 32), kb = r / (8192 / 32); p0_transpose_item(a.in[I_L0_WIN], D, 8192, (bf16*)(F.ws + WS_W0IN), 32 * nb, scr, 64 * kb, 32 * nb, F.lane); continue; } r -= I0;
        if (r < I1) { const int nb = r % (D / 32), kb = r / (D / 32); p0_transpose_item(a.in[I_L0_WOUT], 2048, D, (bf16*)(F.ws + WS_W0OUT), 32 * nb, scr, 64 * kb, 32 * nb, F.lane); continue; } r -= I1;
        if (r < I2) { const int nb = r % (2 * DFF / 32), kb = r / (2 * DFF / 32); p0_transpose_item(a.in[I_L0_WGU], D, 2 * DFF, (bf16*)(F.ws + WS_W0GU), swiglu_row(32 * nb, DFF), scr, 64 * kb, 32 * nb, F.lane); continue; } r -= I2;
        if (r < I3) { const int nb = r % (D / 32), kb = r / (D / 32); p0_transpose_item(a.in[I_L0_WDN], DFF, D, (bf16*)(F.ws + WS_W0DN), 32 * nb, scr, 64 * kb, 32 * nb, F.lane); continue; } r -= I3;
        if (r < I4) { const int nb = r % (3072 / 32), kb = r / (3072 / 32); p0_transpose_item(a.in[I_L1_WIN], D, 3072, (bf16*)(F.ws + WS_W1IN), 32 * nb, scr, 64 * kb, 32 * nb, F.lane); continue; } r -= I4;
        if (r < I5) { const int nb = r % (D / 32), kb = r / (D / 32); p0_transpose_item(a.in[I_L1_WOUT], D, D, (bf16*)(F.ws + WS_W1OUT), 32 * nb, scr, 64 * kb, 32 * nb, F.lane); continue; } r -= I5;
        if (r < NE * I6E) { const int e = r / I6E, rr = r % I6E; const int nb = rr % (2 * DFE / 32), kb = rr / (2 * DFE / 32);
            p0_transpose_item(a.in[I_L1_MGU] + (size_t)e * D * 2 * DFE, D, 2 * DFE, (bf16*)(F.ws + WS_WMGU) + (size_t)e * 2 * DFE * D, swiglu_row(32 * nb, DFE), scr, 64 * kb, 32 * nb, F.lane); continue; } r -= NE * I6E;
        { const int e = r / I7E, rr = r % I7E; const int nb = rr % (D / 32), kb = rr / (D / 32);
            p0_transpose_item(a.in[I_L1_MDN] + (size_t)e * DFE * D, DFE, D, (bf16*)(F.ws + WS_WMDN) + (size_t)e * D * DFE, 32 * nb, scr, 64 * kb, 32 * nb, F.lane); }
    }
    __syncthreads();
    {
        LAS float* sc = (LAS float*)F.lds;
        LAS float* part = (LAS float*)(F.lds + 9 * 1024 * 4);
        bool loaded = false;
        for (int grp = F.vcu; grp < 2 * (6 * D / 64); grp += F.G) {
            if (!loaded) { for (int i = F.tid; i < 9 * 1024; i += NTHREADS) { const float cv = (i < 8 * 1024) ? a.in[I_C][i] : a.in[I_CCTX][i - 8 * 1024]; sc[i] = silu_f(cv); } loaded = true; }
            __syncthreads();
            const int layer = grp / (6 * D / 64), cb = (grp % (6 * D / 64)) * 64;
            const float* W = a.in[layer ? I_L1_WMOD : I_L0_WMOD]; const float* bm = a.in[layer ? I_L1_BMOD : I_L0_BMOD];
            const int ks = F.tid >> 6, col = F.tid & 63;
            float acc[9];
#pragma unroll
            for (int b = 0; b < 9; ++b) acc[b] = 0.f;
            for (int k = ks * 128; k < ks * 128 + 128; ++k) { const float w = W[(size_t)k * (6 * D) + cb + col];
#pragma unroll
                for (int b = 0; b < 9; ++b) acc[b] += sc[b * 1024 + k] * w; }
#pragma unroll
            for (int b = 0; b < 9; ++b) part[(ks * 9 + b) * 64 + col] = acc[b];
            __syncthreads();
            for (int o = F.tid; o < 9 * 64; o += NTHREADS) { const int b = o >> 6, cc = o & 63; float s = bm[cb + cc];
#pragma unroll
                for (int k2 = 0; k2 < 8; ++k2) s += part[(k2 * 9 + b) * 64 + cc];
                ((float*)(F.ws + WS_MODV))[((size_t)layer * 9 + b) * (6 * D) + cb + cc] = s; }
            __syncthreads();
        }
    }
    {
        const int gt = F.vcu * NTHREADS + F.tid;
        if (gt < 64 * 64 + 64 * 16) {
            int pos, i; float ex;
            if (gt < 4096) { pos = gt >> 6; i = gt & 63; ex = (float)(2 * i) / 128.0f; } else { const int q = gt - 4096; pos = q >> 4; i = q & 15; ex = (float)(2 * i) / 32.0f; }
            const float freq = __builtin_amdgcn_exp2f(-ex * 13.287712379549449f);
            const float rev = (float)pos * freq * 0.15915494309189535f;
            const float cs = __builtin_amdgcn_cosf(rev), sn = __builtin_amdgcn_sinf(rev);
            f32x2* t = (f32x2*)(F.ws + (gt < 4096 ? WS_TAB0 : WS_TAB1)); t[gt < 4096 ? gt : gt - 4096] = (f32x2){cs, sn};
        }
        if (gt == 0) { const float* lp = a.in[I_L1_LAMBDA]; float s1 = 0.f, s2 = 0.f; for (int i = 0; i < 64; ++i) { s1 += lp[i] * lp[64 + i]; s2 += lp[128 + i] * lp[192 + i]; }
            *(float*)(F.ws + WS_LAM) = __expf(s1) - __expf(s2) + LAMBDA_INIT; }
    }
}

struct RowPass {
    int nrows;
    const float* xin_lat; const float* xin_ctx; float* xout_lat; float* xout_ctx;
    const bf16* br;
    const float* gpost;
    const float* gate;
    const float* gpre;
    const float* shift; const float* scale;
    bf16* hout;
};
template <bool BR, bool MOEBR, bool WH, bool ROUTE>
__device__ __forceinline__ void row_pass(Frame& F, const Args& a, const RowPass& P) {
    const int gw = F.vcu * NWAVES + F.wave, NGW = F.G * NWAVES;
    const int l4 = F.lane * 4;
    for (int r = gw; r < P.nrows; r += NGW) {
        const bool lat = r < NLAT; const int rc = lat ? r : r - NLAT; const int midx = lat ? (r >> 12) : 8;
        const float* xin = (lat ? P.xin_lat : P.xin_ctx) + (size_t)rc * D;
        float* xout = (lat ? P.xout_lat : P.xout_ctx) + (size_t)rc * D;
        f32x4 v[4];
#pragma unroll
        for (int j = 0; j < 4; ++j) v[j] = *(const GAS f32x4*)(xin + l4 + 256 * j);
        if constexpr (BR || MOEBR) {
            f32x4 y[4];
            if constexpr (BR) {
#pragma unroll
                for (int j = 0; j < 4; ++j) { const v2u w = *(const GAS v2u*)(P.br + (size_t)r * D + l4 + 256 * j); y[j] = (f32x4){bflo(w.x), bfhi(w.x), bflo(w.y), bfhi(w.y)}; }
            } else {
                const int* tpos = (const int*)(F.ws + WS_ROUTE + (size_t)NLAT * 8); const float* tw = (const float*)(F.ws + WS_ROUTE + (size_t)NLAT * 16);
                const int s0 = tpos[2 * r], s1 = tpos[2 * r + 1]; const float w0 = tw[2 * r], w1 = tw[2 * r + 1];
#pragma unroll
                for (int j = 0; j < 4; ++j) { const v2u p = *(const GAS v2u*)(P.br + (size_t)s0 * D + l4 + 256 * j); const v2u q = *(const GAS v2u*)(P.br + (size_t)s1 * D + l4 + 256 * j);
                    y[j] = (f32x4){w0 * bflo(p.x) + w1 * bflo(q.x), w0 * bfhi(p.x) + w1 * bfhi(q.x), w0 * bflo(p.y) + w1 * bflo(q.y), w0 * bfhi(p.y) + w1 * bfhi(q.y)}; }
            }
            float ss = 0.f;
#pragma unroll
            for (int j = 0; j < 4; ++j) ss += (y[j].x * y[j].x + y[j].y * y[j].y) + (y[j].z * y[j].z + y[j].w * y[j].w);
            const float rstd = 1.0f / sqrtf(wave_sum(ss) * (1.0f / D) + EPS);
#pragma unroll
            for (int j = 0; j < 4; ++j) { const f32x4 gp = *(const GAS f32x4*)(P.gpost + l4 + 256 * j); const f32x4 gt = *(const GAS f32x4*)(P.gate + (size_t)midx * 6 * D + l4 + 256 * j);
                v[j] = v[j] + gt * (y[j] * rstd * gp); }
#pragma unroll
            for (int j = 0; j < 4; ++j) *(GAS f32x4*)(xout + l4 + 256 * j) = v[j];
        }
        if constexpr (WH) {
            float ss = 0.f;
#pragma unroll
            for (int j = 0; j < 4; ++j) ss += (v[j].x * v[j].x + v[j].y * v[j].y) + (v[j].z * v[j].z + v[j].w * v[j].w);
            const float rstd = 1.0f / sqrtf(wave_sum(ss) * (1.0f / D) + EPS);
            f32x4 h[4];
#pragma unroll
            for (int j = 0; j < 4; ++j) { const f32x4 gp = *(const GAS f32x4*)(P.gpre + l4 + 256 * j); const f32x4 sc = *(const GAS f32x4*)(P.scale + (size_t)midx * 6 * D + l4 + 256 * j);
                const f32x4 sh = *(const GAS f32x4*)(P.shift + (size_t)midx * 6 * D + l4 + 256 * j);
                h[j] = (v[j] * rstd * gp) * (1.0f + sc) + sh;
                v2u w; w.x = pk2(h[j].x, h[j].y); w.y = pk2(h[j].z, h[j].w); *(GAS v2u*)(P.hout + (size_t)r * D + l4 + 256 * j) = w; }
            if constexpr (ROUTE) {
                const float* rw = a.in[I_L1_RW];
                float lg[8];
#pragma unroll
                for (int e = 0; e < 8; ++e) lg[e] = 0.f;
#pragma unroll
                for (int j = 0; j < 4; ++j)
#pragma unroll
                    for (int q = 0; q < 4; ++q) { const int k = l4 + 256 * j + q; const f32x4 wa = *(const GAS f32x4*)(rw + (size_t)k * 8), wb = *(const GAS f32x4*)(rw + (size_t)k * 8 + 4); const float hv = h[j][q];
                        lg[0] += hv * wa.x; lg[1] += hv * wa.y; lg[2] += hv * wa.z; lg[3] += hv * wa.w; lg[4] += hv * wb.x; lg[5] += hv * wb.y; lg[6] += hv * wb.z; lg[7] += hv * wb.w; }
#pragma unroll
                for (int e = 0; e < 8; ++e) lg[e] = wave_sum(lg[e]) + a.in[I_L1_RB][e];
                float v1 = lg[0]; int i1 = 0;
#pragma unroll
                for (int e = 1; e < 8; ++e) if (lg[e] > v1) { v1 = lg[e]; i1 = e; }
                float v2 = -3.0e38f; int i2 = 0;
#pragma unroll
                for (int e = 0; e < 8; ++e) if (e != i1 && lg[e] > v2) { v2 = lg[e]; i2 = e; }
                const float w1 = 1.0f / (1.0f + __expf(v2 - v1)), w2 = 1.0f - w1;
                if (F.lane == 0) {
                    int* te = (int*)(F.ws + WS_ROUTE); int* tpos = (int*)(F.ws + WS_ROUTE + (size_t)NLAT * 8); float* tw = (float*)(F.ws + WS_ROUTE + (size_t)NLAT * 16);
                    const unsigned p1 = __hip_atomic_fetch_add((unsigned*)(F.ctl + CW_MOECNT + 64 * i1), 1u, RLX_AGENT);
                    const unsigned p2 = __hip_atomic_fetch_add((unsigned*)(F.ctl + CW_MOECNT + 64 * i2), 1u, RLX_AGENT);
                    te[2 * r] = i1; te[2 * r + 1] = i2; tpos[2 * r] = (int)p1; tpos[2 * r + 1] = (int)p2; tw[2 * r] = w1; tw[2 * r + 1] = w2;
                }
            }
        }
    }
}

__device__ __forceinline__ void rope0_pass(Frame& F) {
    bf16* z = (bf16*)(F.ws + WS_A); const f32x2* tab = (const f32x2*)(F.ws + WS_TAB0);
    const int gw = F.vcu * NWAVES + F.wave, NGW = F.G * NWAVES; const int i = F.lane;
    for (int r = gw; r < MALL; r += NGW) {
        const bool lat = r < NLAT; const int t = r & (SEQ - 1);
        bf16* zr = z + (size_t)r * 4096;
#pragma unroll
        for (int T = 0; T < 2; ++T)
#pragma unroll
            for (int h = 0; h < RH; ++h)
#pragma unroll
                for (int hf = 0; hf < 2; ++hf) {
                    const int base = T * 1024 + h * 256 + hf * 128; const float sc = T ? 0.0625f : 1.0f;
                    float x1 = bf2f(zr[base + i]), x2 = bf2f(zr[base + 64 + i]);
                    if (lat) { const int pos = hf ? (t & 63) : (t >> 6); const f32x2 cs = tab[pos * 64 + i]; const float y1 = x1 * cs.x - x2 * cs.y, y2 = x2 * cs.x + x1 * cs.y; x1 = y1; x2 = y2; }
                    zr[base + i] = (bf16)f2bf(x1 * sc); zr[base + 64 + i] = (bf16)f2bf(x2 * sc);
                }
    }
}
__device__ __forceinline__ void rope1_pass(Frame& F) {
    bf16* z = (bf16*)(F.ws + WS_A); const f32x2* tab = (const f32x2*)(F.ws + WS_TAB1);
    const int gw = F.vcu * NWAVES + F.wave, NGW = F.G * NWAVES;
    for (int r = gw; r < MALL; r += NGW) {
        const bool lat = r < NLAT; const int t = r & (SEQ - 1);
        bf16* zr = z + (size_t)r * 3072;
#pragma unroll
        for (int T = 0; T < 2; ++T)
#pragma unroll
            for (int jj = 0; jj < 8; ++jj) {
                const int pp = F.lane + 64 * jj; const int head = pp >> 5, hf = (pp >> 4) & 1, i = pp & 15;
                const int base = T * 1024 + head * 64 + hf * 32; const float sc = T ? 1.0f : 0.125f * LOG2E;
                float x1 = bf2f(zr[base + i]), x2 = bf2f(zr[base + 16 + i]);
                if (lat) { const int pos = hf ? (t & 63) : (t >> 6); const f32x2 cs = tab[pos * 16 + i]; const float y1 = x1 * cs.x - x2 * cs.y, y2 = x2 * cs.x + x1 * cs.y; x1 = y1; x2 = y2; }
                zr[base + i] = (bf16)f2bf(x1 * sc); zr[base + 16 + i] = (bf16)f2bf(x2 * sc);
            }
    }
}
__device__ __forceinline__ void merge_pass(Frame& F) {
    const bf16* zg = (const bf16*)(F.ws + WS_A); bf16* of = (bf16*)(F.ws + WS_OF); const bf16* ob = (const bf16*)(F.ws + WS_OB);
    const int gw = F.vcu * NWAVES + F.wave, NGW = F.G * NWAVES;
    for (int r = gw; r < MALL; r += NGW) {
#pragma unroll
        for (int h = 0; h < RH; ++h) {
            const size_t o = (size_t)r * 2048 + h * 512 + F.lane * 8;
            const v4u a = *(const GAS v4u*)(of + o), b = *(const GAS v4u*)(ob + o);
            const v4u gf = *(const GAS v4u*)(zg + (size_t)r * 4096 + h * 512 + F.lane * 8), gb = *(const GAS v4u*)(zg + (size_t)r * 4096 + 2048 + h * 512 + F.lane * 8);
            float av[8], bv[8], gfv[8], gbv[8];
#pragma unroll
            for (int q = 0; q < 4; ++q) { av[2 * q] = bflo(a[q]); av[2 * q + 1] = bfhi(a[q]); bv[2 * q] = bflo(b[q]); bv[2 * q + 1] = bfhi(b[q]);
                gfv[2 * q] = bflo(gf[q]); gfv[2 * q + 1] = bfhi(gf[q]); gbv[2 * q] = bflo(gb[q]); gbv[2 * q + 1] = bfhi(gb[q]); }
            float sa = 0.f, sb = 0.f;
#pragma unroll
            for (int q = 0; q < 8; ++q) { sa += av[q] * av[q]; sb += bv[q] * bv[q]; }
            const float ra = 1.0f / sqrtf(wave_sum(sa) * (1.0f / RV) + EPS), rb = 1.0f / sqrtf(wave_sum(sb) * (1.0f / RV) + EPS);
            float y[8];
#pragma unroll
            for (int q = 0; q < 8; ++q) y[q] = silu_f(gfv[q]) * (av[q] * ra) + silu_f(gbv[q]) * (bv[q] * rb);
            v4u w; w.x = pk2(y[0], y[1]); w.y = pk2(y[2], y[3]); w.z = pk2(y[4], y[5]); w.w = pk2(y[6], y[7]);
            *(GAS v4u*)(of + o) = w;
        }
    }
}

__device__ __forceinline__ void ret_naive(Frame& F, const Args& a) {
    const bf16* z = (const bf16*)(F.ws + WS_A);
    LAS bf16* qk = (LAS bf16*)F.lds;
    LAS bf16* vb = (LAS bf16*)(F.lds + 32768);
    LAS float* part = (LAS float*)(F.lds + 32768 + 2048);
    const int half = F.tid >> 8, d = F.tid & 255;
    for (int unit = F.vcu; unit < NBATCH * RH * 2 * 16; unit += F.G) {
        const int vs = unit & 15, dir = (unit >> 4) & 1, h = (unit >> 5) & 3, b = unit >> 7;
        const float logit = a.in[I_L0_DECAY][dir * RH + h];
        const float gamma = 1.0f / (1.0f + __expf(-logit));
        float S[16];
#pragma unroll
        for (int v = 0; v < 16; ++v) S[v] = 0.f;
        bf16* outp = (bf16*)(F.ws + (dir ? WS_OB : WS_OF));
        for (int s = 0; s < 136; ++s) {
            int blk; size_t row0;
            if (s < 8) { blk = dir ? 7 - s : s; row0 = (size_t)NLAT + b * CTXL + blk * 32; } else { blk = dir ? 127 - (s - 8) : (s - 8); row0 = (size_t)b * SEQ + blk * 32; }
            __syncthreads();
            for (int i = F.tid; i < 32 * 64; i += NTHREADS) { const int tk = i >> 6, c8 = i & 63;
                const bf16* src = z + (row0 + tk) * 4096 + (c8 < 32 ? h * 256 + c8 * 8 : 1024 + h * 256 + (c8 - 32) * 8);
                *(LAS v4u*)(qk + tk * 512 + c8 * 8) = *(const GAS v4u*)src; }
            if (F.tid < 128) { const int tk = F.tid >> 2, c8 = F.tid & 3; *(LAS v4u*)(vb + tk * 32 + c8 * 8) = *(const GAS v4u*)(z + (row0 + tk) * 4096 + 2048 + h * 512 + vs * 32 + c8 * 8); }
            __syncthreads();
            for (int i = 0; i < 32; ++i) {
                const int tk = dir ? 31 - i : i;
                const float qv = bf2f(qk[tk * 512 + d]), kv = bf2f(qk[tk * 512 + 256 + d]);
                float p[16];
#pragma unroll
                for (int v = 0; v < 16; ++v) { const float vv = bf2f(vb[tk * 32 + half * 16 + v]); S[v] = gamma * S[v] + kv * vv; p[v] = qv * S[v]; }
                const int ln = F.lane;
                float p8[8], p4[4], p2[2], p1;
#pragma unroll
                for (int j = 0; j < 8; ++j) { const bool up = (ln & 32) != 0; const float keep = up ? p[j + 8] : p[j], send = up ? p[j] : p[j + 8]; p8[j] = keep + __shfl_xor(send, 32); }
#pragma unroll
                for (int j = 0; j < 4; ++j) { const bool up = (ln & 16) != 0; const float keep = up ? p8[j + 4] : p8[j], send = up ? p8[j] : p8[j + 4]; p4[j] = keep + __shfl_xor(send, 16); }
#pragma unroll
                for (int j = 0; j < 2; ++j) { const bool up = (ln & 8) != 0; const float keep = up ? p4[j + 2] : p4[j], send = up ? p4[j] : p4[j + 2]; p2[j] = keep + __shfl_xor(send, 8); }
                { const bool up = (ln & 4) != 0; const float keep = up ? p2[1] : p2[0], send = up ? p2[0] : p2[1]; p1 = keep + __shfl_xor(send, 4); }
                p1 += __shfl_xor(p1, 1); p1 += __shfl_xor(p1, 2);
                if ((ln & 3) == 0) { const int vi = ((ln >> 5) & 1) * 8 + ((ln >> 4) & 1) * 4 + ((ln >> 3) & 1) * 2 + ((ln >> 2) & 1); part[(tk * 8 + F.wave) * 16 + vi] = p1; }
            }
            __syncthreads();
            for (int o = F.tid; o < 32 * 32; o += NTHREADS) { const int tk = o >> 5, v = o & 31, hf = v >> 4, vi = v & 15;
                float sum = 0.f;
#pragma unroll
                for (int w = 0; w < 4; ++w) sum += part[(tk * 8 + hf * 4 + w) * 16 + vi];
                outp[(row0 + tk) * 2048 + h * 512 + vs * 32 + v] = (bf16)f2bf(sum); }
        }
    }
}

__device__ __forceinline__ void attn_naive(Frame& F, const Args& a) {
    const bf16* z = (const bf16*)(F.ws + WS_A);
    bf16* ao = (bf16*)(F.ws + WS_B);
    LAS float* Kt = (LAS float*)F.lds;
    LAS float* Vt = (LAS float*)(F.lds + 8192);
    LAS float* xs = (LAS float*)(F.lds + 8192 + 16384);
    const float lam = *(const float*)(F.ws + WS_LAM);
    const int half = F.tid >> 8, rl = F.tid & 255;
    for (int unit = F.vcu; unit < NBATCH * 8 * 16; unit += F.G) {
        const int qb = unit & 15, hp = (unit >> 4) & 7, b = unit >> 7;
        const size_t qrow = (size_t)b * SEQ + qb * 256 + rl;
        float o1[64];
#pragma unroll 1
        for (int hh = 0; hh < 2; ++hh) {
            const int qh = 2 * hp + hh;
            float q[64];
#pragma unroll
            for (int c = 0; c < 8; ++c) { const v4u w = *(const GAS v4u*)(z + qrow * 3072 + qh * 64 + c * 8);
#pragma unroll
                for (int e = 0; e < 4; ++e) { q[c * 8 + 2 * e] = bflo(w[e]); q[c * 8 + 2 * e + 1] = bfhi(w[e]); } }
            float o[64];
#pragma unroll
            for (int i = 0; i < 64; ++i) o[i] = 0.f;
            float m = -1.0e30f, l = 0.f;
            for (int kt = 0; kt < 136; ++kt) {
                const size_t krow0 = kt < 128 ? (size_t)b * SEQ + kt * 32 : (size_t)NLAT + b * CTXL + (kt - 128) * 32;
                __syncthreads();
                { const int key = F.tid >> 4, c4 = F.tid & 15;
                    const v2u w = *(const GAS v2u*)(z + (krow0 + key) * 3072 + 1024 + qh * 64 + c4 * 4);
                    *(LAS f32x4*)(Kt + key * 64 + c4 * 4) = (f32x4){bflo(w.x), bfhi(w.x), bflo(w.y), bfhi(w.y)};
                    const v4u u = *(const GAS v4u*)(z + (krow0 + key) * 3072 + 2048 + hp * 128 + c4 * 8);
                    *(LAS f32x4*)(Vt + key * 128 + c4 * 8) = (f32x4){bflo(u.x), bfhi(u.x), bflo(u.y), bfhi(u.y)};
                    *(LAS f32x4*)(Vt + key * 128 + c4 * 8 + 4) = (f32x4){bflo(u.z), bfhi(u.z), bflo(u.w), bfhi(u.w)}; }
                __syncthreads();
                for (int key = 0; key < 32; ++key) {
                    float s = 0.f;
#pragma unroll
                    for (int c = 0; c < 16; ++c) { const f32x4 kv = *(const LAS f32x4*)(Kt + key * 64 + c * 4); s += q[4 * c] * kv.x + q[4 * c + 1] * kv.y + q[4 * c + 2] * kv.z + q[4 * c + 3] * kv.w; }
                    const float mn = fmaxf(m, s); const float al = fast_exp2(m - mn), p = fast_exp2(s - mn); m = mn; l = l * al + p;
#pragma unroll
                    for (int c = 0; c < 16; ++c) { const f32x4 vv = *(const LAS f32x4*)(Vt + key * 128 + half * 64 + c * 4);
                        o[4 * c] = o[4 * c] * al + p * vv.x; o[4 * c + 1] = o[4 * c + 1] * al + p * vv.y; o[4 * c + 2] = o[4 * c + 2] * al + p * vv.z; o[4 * c + 3] = o[4 * c + 3] * al + p * vv.w; }
                }
            }
            const float rl_ = 1.0f / l;
            if (hh == 0) {
#pragma unroll
                for (int i = 0; i < 64; ++i) o1[i] = o[i] * rl_;
            } else {
#pragma unroll
                for (int i = 0; i < 64; ++i) o1[i] = o1[i] - lam * (o[i] * rl_);
            }
        }
        float ss = 0.f;
#pragma unroll
        for (int i = 0; i < 64; ++i) ss += o1[i] * o1[i];
        __syncthreads();
        xs[F.tid] = ss;
        __syncthreads();
        const float tot = xs[rl] + xs[256 + rl];
        const float rstd = 1.0f / sqrtf(tot * (1.0f / 128.0f) + EPS) * (1.0f - LAMBDA_INIT);
        const float* sub = a.in[I_L1_SUBLN];
#pragma unroll
        for (int c = 0; c < 8; ++c) { v4u w;
#pragma unroll
            for (int e = 0; e < 4; ++e) { const int i0 = c * 8 + 2 * e; w[e] = pk2(o1[i0] * rstd * sub[half * 64 + i0], o1[i0 + 1] * rstd * sub[half * 64 + i0 + 1]); }
            *(GAS v4u*)(ao + qrow * 1024 + hp * 128 + half * 64 + c * 8) = w; }
    }
}

__device__ __forceinline__ void moe_counts(Frame& F, int (&cnt)[NE]) {
#pragma unroll
    for (int e = 0; e < NE; ++e) cnt[e] = (int)__hip_atomic_load((unsigned*)(F.ctl + CW_MOECNT + 64 * e), RLX_AGENT);
}
__device__ __forceinline__ void moe_gather(Frame& F) {
    int cnt[NE]; moe_counts(F, cnt);
    int base[NE]; int acc = 0;
#pragma unroll
    for (int e = 0; e < NE; ++e) { base[e] = acc; acc += (cnt[e] + 255) & ~255; }
    const int* te = (const int*)(F.ws + WS_ROUTE); int* tpos = (int*)(F.ws + WS_ROUTE + (size_t)NLAT * 8);
    const bf16* hb = (const bf16*)(F.ws + WS_H); bf16* hp = (bf16*)(F.ws + WS_HP);
    const int gw = F.vcu * NWAVES + F.wave, NGW = F.G * NWAVES;
    for (int r = gw; r < NLAT; r += NGW) {
        const int e0 = te[2 * r], e1 = te[2 * r + 1]; const int p0 = tpos[2 * r], p1 = tpos[2 * r + 1];
        int b0 = 0, b1 = 0;
#pragma unroll
        for (int e = 0; e < NE; ++e) { b0 = (e0 == e) ? base[e] : b0; b1 = (e1 == e) ? base[e] : b1; }
        const int s0 = b0 + p0, s1 = b1 + p1;
        const v4u x0 = *(const GAS v4u*)(hb + (size_t)r * D + F.lane * 8), x1 = *(const GAS v4u*)(hb + (size_t)r * D + 512 + F.lane * 8);
        *(GAS v4u*)(hp + (size_t)s0 * D + F.lane * 8) = x0; *(GAS v4u*)(hp + (size_t)s0 * D + 512 + F.lane * 8) = x1;
        *(GAS v4u*)(hp + (size_t)s1 * D + F.lane * 8) = x0; *(GAS v4u*)(hp + (size_t)s1 * D + 512 + F.lane * 8) = x1;
        if (F.lane == 0) { tpos[2 * r] = s0; tpos[2 * r + 1] = s1; }
    }
}
__device__ __forceinline__ void moe_order(Frame& F, pg8::MoeOrder& S, int nN) {
    int cnt[NE]; moe_counts(F, cnt);
    int ts[NE + 1]; ts[0] = 0;
#pragma unroll
    for (int e = 0; e < NE; ++e) ts[e + 1] = ts[e] + ((cnt[e] + 255) >> 8);
    S.nM = ts[NE]; S.nN = nN; S.nwg = S.nM * nN; S.G = F.G; S.c = (int)blockIdx.x;
    S.t1 = ts[1]; S.t2 = ts[2]; S.t3 = ts[3]; S.t4 = ts[4]; S.t5 = ts[5]; S.t6 = ts[6]; S.t7 = ts[7];
}

constexpr int N_PHASES = 21;
__global__ void __launch_bounds__(NTHREADS, 2) fwd(Args args) {
    extern __shared__ __attribute__((aligned(16))) unsigned char lds[];
    Frame F;
    F.lds = (LAS unsigned char*)lds; F.MISC = (volatile LAS unsigned*)(F.lds + MISC_OFF);
    F.tid = threadIdx.x; F.lane = F.tid & 63; F.wave = __builtin_amdgcn_readfirstlane(F.tid >> 6);
    F.G = gridDim.x; { const int bx = blockIdx.x; F.vcu = (F.G % 8 == 0) ? (bx % 8) * (F.G / 8) + bx / 8 : bx; }
    F.ws = args.ws; F.ctl = (gu32*)(args.ws + WS_CTL);
    for (int u = F.tid; u < 64; u += NTHREADS) ((LAS unsigned*)(F.lds + MISC_OFF))[u] = 0u;
    __syncthreads();
#if MK_PER_PHASE
    XcdBarrier bar; bar.bar = (unsigned*)(F.ctl + CW_BAR); bar.x = 0; bar.st = nullptr;
#define GRID_BAR() do { } while (0)
#else
    XcdBarrier bar = xcd_barrier_post((unsigned*)(F.ctl + CW_BAR), F.MISC + 8);
#define GRID_BAR() xcd_barrier(bar)
#endif
    const int lo = args.ph_lo, hi = args.ph_hi;
#define IN(k) (lo <= (k) && (k) < hi)
#define SEAM(k) do { if (IN(k) && IN((k) + 1)) GRID_BAR(); } while (0)
    unsigned char* ws = args.ws;
    float* modv = (float*)(ws + WS_MODV);
    float* modv1 = modv + 9 * 6 * D;
    bf16* hbuf = (bf16*)(ws + WS_H);
    float* xctx = (float*)(ws + WS_XCTX);
    using pg8::Gemm; using pg8::StaticOrder;

    if (IN(0)) { p0_prologue(F, args); SEAM(0); }
    if (IN(1)) { RowPass P{MALL, args.in[I_X], args.in[I_CTX], nullptr, nullptr, nullptr, nullptr, nullptr, args.in[I_L0_NPREMIX], modv + 0 * D, modv + 1 * D, hbuf};
        row_pass<false, false, true, false>(F, args, P); SEAM(1); }
    if (IN(2)) { Gemm g{hbuf, (const bf16*)(ws + WS_W0IN), MALL, 4096, D, D}; StaticOrder S; S.init(MALL, 4096, F.G, (int)blockIdx.x);
        pg8::EpiStore E{(bf16*)(ws + WS_A), 4096};
        pg8::gemm_phase<pg8::EpiStore, StaticOrder, true, true>(F.lds, g, S, E); SEAM(2); }
    if (IN(3)) { rope0_pass(F); SEAM(3); }
    if (IN(4)) { ret_naive(F, args); SEAM(4); }
    if (IN(5)) { Gemm g{hbuf, (const bf16*)(ws + WS_W0IN) + (size_t)4096 * D, MALL, 4096, D, D}; StaticOrder S; S.init(MALL, 4096, F.G, (int)blockIdx.x);
        pg8::EpiStore E{(bf16*)(ws + WS_A), 4096};
        pg8::gemm_phase<pg8::EpiStore, StaticOrder, true, true>(F.lds, g, S, E); SEAM(5); }
    if (IN(6)) { merge_pass(F); SEAM(6); }
    if (IN(7)) { Gemm g{(const bf16*)(ws + WS_OF), (const bf16*)(ws + WS_W0OUT), MALL, D, 2048, 2048}; StaticOrder S; S.init(MALL, D, F.G, (int)blockIdx.x);
        pg8::EpiStore E{(bf16*)(ws + WS_A), D};
        pg8::gemm_phase<pg8::EpiStore, StaticOrder, true, true>(F.lds, g, S, E); SEAM(7); }
    if (IN(8)) { RowPass P{MALL, args.in[I_X], args.in[I_CTX], args.out, xctx, (const bf16*)(ws + WS_A), args.in[I_L0_NPOSTMIX], modv + 2 * D, args.in[I_L0_NPREFFN], modv + 3 * D, modv + 4 * D, hbuf};
        row_pass<true, false, true, false>(F, args, P); SEAM(8); }
    if (IN(9)) { Gemm g{hbuf, (const bf16*)(ws + WS_W0GU), MALL, 2 * DFF, D, D}; StaticOrder S; S.init(MALL, 2 * DFF, F.G, (int)blockIdx.x);
        pg8::EpiSwiglu E{(bf16*)(ws + WS_B), DFF};
        pg8::gemm_phase<pg8::EpiSwiglu, StaticOrder, true, true>(F.lds, g, S, E); SEAM(9); }
    if (IN(10)) { Gemm g{(const bf16*)(ws + WS_B), (const bf16*)(ws + WS_W0DN), MALL, D, DFF, DFF}; StaticOrder S; S.init(MALL, D, F.G, (int)blockIdx.x);
        pg8::EpiStore E{(bf16*)(ws + WS_A), D};
        pg8::gemm_phase<pg8::EpiStore, StaticOrder, true, true>(F.lds, g, S, E); SEAM(10); }
    if (IN(11)) { RowPass P{MALL, args.out, xctx, args.out, xctx, (const bf16*)(ws + WS_A), args.in[I_L0_NPOSTFFN], modv + 5 * D, args.in[I_L1_NPREMIX], modv1 + 0 * D, modv1 + 1 * D, hbuf};
        row_pass<true, false, true, false>(F, args, P); SEAM(11); }
    if (IN(12)) { Gemm g{hbuf, (const bf16*)(ws + WS_W1IN), MALL, 3072, D, D}; StaticOrder S; S.init(MALL, 3072, F.G, (int)blockIdx.x);
        pg8::EpiStore E{(bf16*)(ws + WS_A), 3072};
        pg8::gemm_phase<pg8::EpiStore, StaticOrder, true, true>(F.lds, g, S, E); SEAM(12); }
    if (IN(13)) { rope1_pass(F); SEAM(13); }
    if (IN(14)) { attn_naive(F, args); SEAM(14); }
    if (IN(15)) { Gemm g{(const bf16*)(ws + WS_B), (const bf16*)(ws + WS_W1OUT), NLAT, D, D, D}; StaticOrder S; S.init(NLAT, D, F.G, (int)blockIdx.x);
        pg8::EpiStore E{(bf16*)(ws + WS_A), D};
        pg8::gemm_phase<pg8::EpiStore, StaticOrder, true, true>(F.lds, g, S, E); SEAM(15); }
    if (IN(16)) { RowPass P{NLAT, args.out, xctx, args.out, xctx, (const bf16*)(ws + WS_A), args.in[I_L1_NPOSTMIX], modv1 + 2 * D, args.in[I_L1_NPREFFN], modv1 + 3 * D, modv1 + 4 * D, hbuf};
        row_pass<true, false, true, true>(F, args, P); SEAM(16); }
    if (IN(17)) { moe_gather(F); SEAM(17); }
    if (IN(18)) { Gemm g{(const bf16*)(ws + WS_HP), (const bf16*)(ws + WS_WMGU), MOE_ROWS, 2 * DFE, D, D}; pg8::MoeOrder S; moe_order(F, S, 2 * DFE / 256);
        pg8::EpiSwiglu E{(bf16*)(ws + WS_ACT1), DFE};
        pg8::gemm_phase<pg8::EpiSwiglu, pg8::MoeOrder, true, true>(F.lds, g, S, E); SEAM(18); }
    if (IN(19)) { Gemm g{(const bf16*)(ws + WS_ACT1), (const bf16*)(ws + WS_WMDN), MOE_ROWS, D, DFE, DFE}; pg8::MoeOrder S; moe_order(F, S, D / 256);
        pg8::EpiStore E{(bf16*)(ws + WS_Y1), D};
        pg8::gemm_phase<pg8::EpiStore, pg8::MoeOrder, true, true>(F.lds, g, S, E); SEAM(19); }
    if (IN(20)) { RowPass P{NLAT, args.out, xctx, args.out, xctx, (const bf16*)(ws + WS_Y1), args.in[I_L1_NPOSTFFN], modv1 + 5 * D, nullptr, nullptr, nullptr, nullptr};
        row_pass<false, true, false, false>(F, args, P); }
#undef IN
#undef SEAM
}

extern "C" void kernel_launch(void* const* d_in, const int* in_sizes, int n_in, void* d_out, int out_size, void* d_ws, size_t ws_size, hipStream_t stream) {
    static int grid = 0;
    if (grid == 0) {
        if (n_in != N_IN || out_size != NLAT * D || ws_size < WS_END) { fprintf(stderr, "kernel_launch: unexpected shapes n_in %d out %d ws %zu\n", n_in, out_size, ws_size); grid = -1; return; }
        int dev = 0, cus = 0, per_cu = 0;
        if (hipGetDevice(&dev) != hipSuccess || hipDeviceGetAttribute(&cus, hipDeviceAttributeMultiprocessorCount, dev) != hipSuccess) { grid = -1; return; }
        if (hipFuncSetAttribute((const void*)fwd, hipFuncAttributeMaxDynamicSharedMemorySize, LDS_BYTES) != hipSuccess) { fprintf(stderr, "kernel_launch: hipFuncSetAttribute failed\n"); grid = -1; return; }
        if (hipOccupancyMaxActiveBlocksPerMultiprocessor(&per_cu, (const void*)fwd, NTHREADS, LDS_BYTES) != hipSuccess || per_cu < 1) fprintf(stderr, "kernel_launch: occupancy query says %d\n", per_cu);
        (void)hipGetLastError();
        grid = cus;
    }
    if (grid < 0) return;
    (void)hipMemsetAsync((char*)d_ws + WS_CTL, 0, CTL_ZERO_BYTES, stream);
    Args a{};
    for (int i = 0; i < N_IN; ++i) a.in[i] = (const float*)d_in[i];
    a.out = (float*)d_out; a.ws = (unsigned char*)d_ws;
#if MK_PER_PHASE
    for (int p = 0; p < N_PHASES; ++p) { a.ph_lo = p; a.ph_hi = p + 1; hipLaunchKernelGGL(fwd, dim3(grid), dim3(NTHREADS), LDS_BYTES, stream, a); }
#else
    a.ph_lo = 0; a.ph_hi = N_PHASES; hipLaunchKernelGGL(fwd, dim3(grid), dim3(NTHREADS), LDS_BYTES, stream, a);
#endif
}
```

```cpp
#include <hip/hip_runtime.h>
#include <cstdio>
#include <cstdint>
namespace pg8 {
#define PG8_LAS __attribute__((address_space(3)))
typedef unsigned short bf16_t;
typedef short bf16x8 __attribute__((ext_vector_type(8)));
typedef float f32x4 __attribute__((ext_vector_type(4)));
typedef unsigned u32x4 __attribute__((ext_vector_type(4)));
constexpr int BM = 256, BK = 64, HALF = 128, HTB = HALF * BK * 2  , STAGE_BYTES = 8 * HTB, NXCD = 8, WGM = 8;

__host__ __device__ __forceinline__ int lds_byte(int r, int c) { const int st = (r >> 4) * 2 + (c >> 5), rr = r & 15, cc = c & 31, ob = rr * 64 + cc * 2; return st * 1024 + (ob ^ (((ob >> 9) & 1) << 5)); }
__host__ __device__ __forceinline__ void stage_rc(int b, int& R, int& C) { const int st = b / 1024, sb = b % 1024, swz = sb ^ (((sb >> 9) & 1) << 5); R = (st >> 1) * 16 + swz / 64; C = (st & 1) * 32 + (swz % 64) / 2; }
__host__ __device__ __forceinline__ int perm32(int rho) { const int n = rho >> 4, i = rho & 15; return 8 * (i >> 2) + 4 * n + (i & 3); }

struct Unit { int pm, pn, pc; };
struct Gemm { const bf16_t* A; const bf16_t* Bt; int M, N, K, lda; };

struct StaticOrder {
    int nM, nN, nwg, G, c;
    __host__ __device__ void init(int M, int N, int G_, int c_) { nM = M / BM; nN = N / BM; nwg = nM * nN; G = G_; c = c_; }
    __host__ __device__ bool next(int i, Unit& u) const {
        const long L = (long)i * G + c; if (L >= nwg) return false;
        int wgid = (int)L; { const int q = nwg / NXCD, r = nwg % NXCD, xcd = wgid % NXCD, off = wgid / NXCD; wgid = (xcd < r ? xcd * (q + 1) : r * (q + 1) + (xcd - r) * q) + off; }
        const int nig = WGM * nN, gid = wgid / nig, fm = gid * WGM, gsz = (nM - fm) < WGM ? (nM - fm) : WGM;
        u.pm = fm + ((wgid % nig) % gsz); u.pn = (wgid % nig) / gsz; u.pc = u.pn; return true;
    }
    __device__ __forceinline__ void a_ready(const Unit&) const {}
    __device__ __forceinline__ void done(const Unit&) const {}
};

__device__ __forceinline__ unsigned cvt_pk_bf16(float lo, float hi) { unsigned r; asm volatile("v_cvt_pk_bf16_f32 %0, %1, %2" : "=v"(r) : "v"(lo), "v"(hi)); return r; }
typedef float f32x2 __attribute__((ext_vector_type(2)));
template <class Epi, class Sched, bool ALIGN_EPI = false, bool SP2 = false>
__device__ __forceinline__ void gemm_phase(PG8_LAS unsigned char* lds, const Gemm g, const Sched& S, const Epi& E) {
    const int tid = threadIdx.x, wid = __builtin_amdgcn_readfirstlane(tid >> 6), lane = tid & 63, wr = wid >> 2, wc = wid & 3, fr = lane & 15, fq = lane >> 4;
    const int K = g.K, nt = K / BK;
    unsigned voffA[2], voffB[2];
#pragma unroll
    for (int i = 0; i < 2; ++i) { int R, C; stage_rc(tid * 16 + i * 8192, R, C); const int Rb = Epi::PERM ? ((R & ~31) + perm32(R & 31)) : R;
        voffA[i] = (unsigned)(R * g.lda + C) * 2u; voffB[i] = (unsigned)(Rb * K + C) * 2u; }
    const size_t kstep = (size_t)(BK * 2);
    const size_t hstepA = (size_t)HALF * g.lda * 2, hstepB = (size_t)HALF * K * 2;
    const size_t tstepA = 2 * hstepA, tstepB = 2 * hstepB;
    const unsigned ldsw = (unsigned)wid * 1024u;
    const int aoff = lds_byte(wr * 64 + fr, fq * 8), boff = lds_byte(wc * 32 + fr, fq * 8);
#define PG8_SA(b, h) (((b) * 2 + (h)) * HTB)
#define PG8_SB(b, h) ((4 + (b) * 2 + (h)) * HTB)
#define PG8_STAGE(bufoff, gbase, voff) do { _Pragma("unroll") for (int _i = 0; _i < 2; ++_i) \
        __builtin_amdgcn_global_load_lds((const unsigned*)((const char*)(gbase) + (voff)[_i]), (PG8_LAS unsigned*)(lds + (bufoff) + ldsw + _i * 8192), 16, 0, 0); } while (0)
#define PG8_LDA(dst, b, h) do { _Pragma("unroll") for (int m = 0; m < 4; ++m) _Pragma("unroll") for (int k = 0; k < 2; ++k) dst[m][k] = *(const PG8_LAS bf16x8*)(lds + PG8_SA(b, h) + aoff + m * 2048 + k * 1024); } while (0)
#define PG8_LDB(dst, b, h) do { _Pragma("unroll") for (int n = 0; n < 2; ++n) _Pragma("unroll") for (int k = 0; k < 2; ++k) dst[n][k] = *(const PG8_LAS bf16x8*)(lds + PG8_SB(b, h) + boff + n * 2048 + k * 1024); } while (0)
#define PG8_MMA(ai, bj, At, Bt) do { __builtin_amdgcn_s_setprio(1); _Pragma("unroll") for (int m = 0; m < 4; ++m) _Pragma("unroll") for (int n = 0; n < 2; ++n) _Pragma("unroll") for (int k = 0; k < 2; ++k) \
        acc[ai][bj][m][n] = __builtin_amdgcn_mfma_f32_16x16x32_bf16(Bt[n][k], At[m][k], acc[ai][bj][m][n], 0, 0, 0); __builtin_amdgcn_s_setprio(0); } while (0)
#define PG8_WAIT_V(n) asm volatile("s_waitcnt vmcnt(" #n ")" ::: "memory")
#define PG8_WAIT_L(n) asm volatile("s_waitcnt lgkmcnt(" #n ")" ::: "memory")
#define PG8_BAR __builtin_amdgcn_s_barrier()
#define PG8_SCHED __builtin_amdgcn_sched_barrier(0)
    Unit cur, nxt; int ui = 0;
    if (!S.next(0, cur)) return;
    f32x4 acc[2][2][4][2];
#pragma unroll
    for (int a = 0; a < 2; ++a)
#pragma unroll
        for (int b = 0; b < 2; ++b)
#pragma unroll
            for (int m = 0; m < 4; ++m)
#pragma unroll
                for (int n = 0; n < 2; ++n) acc[a][b][m][n] = (f32x4){0.f, 0.f, 0.f, 0.f};
    bf16x8 At[4][2], B0[2][2], B1[2][2];
    const char* cA = (const char*)g.A + (size_t)cur.pm * tstepA; const char* cB = (const char*)g.Bt + (size_t)cur.pn * tstepB;
    S.a_ready(cur);
    if constexpr (SP2) {
        PG8_STAGE(PG8_SB(0, 0), cB, voffB); PG8_STAGE(PG8_SB(0, 1), cB + hstepB, voffB); PG8_STAGE(PG8_SA(0, 0), cA, voffA); PG8_STAGE(PG8_SA(0, 1), cA + hstepA, voffA);
        if (wr == 1) PG8_BAR;
        PG8_WAIT_V(2); PG8_BAR;
        PG8_STAGE(PG8_SB(1, 0), cB + kstep, voffB); PG8_STAGE(PG8_SA(1, 0), cA + kstep, voffA); PG8_STAGE(PG8_SB(1, 1), cB + hstepB + kstep, voffB);
        PG8_WAIT_V(6); PG8_BAR;
    } else {
        PG8_STAGE(PG8_SB(0, 0), cB, voffB); PG8_STAGE(PG8_SA(0, 0), cA, voffA); PG8_STAGE(PG8_SB(0, 1), cB + hstepB, voffB); PG8_STAGE(PG8_SA(0, 1), cA + hstepA, voffA);
        if (wr == 1) PG8_BAR;
        PG8_WAIT_V(4); PG8_BAR;
        PG8_STAGE(PG8_SB(1, 0), cB + kstep, voffB); PG8_STAGE(PG8_SA(1, 0), cA + kstep, voffA); PG8_STAGE(PG8_SB(1, 1), cB + hstepB + kstep, voffB);
        PG8_WAIT_V(6); PG8_BAR;
    }
    for (;;) {
        const bool has_next = S.next(ui + 1, nxt);
        const char* nA = has_next ? (const char*)g.A + (size_t)nxt.pm * tstepA : cA; const char* nB = has_next ? (const char*)g.Bt + (size_t)nxt.pn * tstepB : cB;
        for (int t = 0; t < nt; t += 2) {
            const bool last = (t == nt - 2);
            const char* a1 = cA + (size_t)(t + 1) * kstep;
            const char* a2 = last ? nA : cA + (size_t)(t + 2) * kstep; const char* b2 = last ? nB : cB + (size_t)(t + 2) * kstep;
            const char* a3 = a2 + kstep; const char* b3 = b2 + kstep;
            if (last && has_next) S.a_ready(nxt);
            if constexpr (SP2) {
            PG8_LDB(B0, 0, 0); PG8_LDB(B1, 0, 1); PG8_SCHED; PG8_LDA(At, 0, 0); PG8_STAGE(PG8_SA(1, 1), a1 + hstepA, voffA);
            PG8_WAIT_V(8); PG8_WAIT_L(0); PG8_BAR; PG8_MMA(0, 0, At, B0); PG8_MMA(0, 1, At, B1); PG8_BAR; PG8_SCHED;
            PG8_LDA(At, 0, 1); PG8_STAGE(PG8_SB(0, 0), b2, voffB); PG8_STAGE(PG8_SB(0, 1), b2 + hstepB, voffB); PG8_STAGE(PG8_SA(0, 0), a2, voffA);
            PG8_WAIT_V(8); PG8_WAIT_L(0); PG8_BAR; PG8_MMA(1, 0, At, B0); PG8_MMA(1, 1, At, B1); PG8_BAR; PG8_SCHED;
            PG8_LDB(B0, 1, 0); PG8_LDB(B1, 1, 1); PG8_SCHED; PG8_LDA(At, 1, 0); PG8_STAGE(PG8_SA(0, 1), a2 + hstepA, voffA);
            PG8_WAIT_V(8); PG8_WAIT_L(0); PG8_BAR; PG8_MMA(0, 0, At, B0); PG8_MMA(0, 1, At, B1); PG8_BAR; PG8_SCHED;
            PG8_LDA(At, 1, 1); PG8_STAGE(PG8_SB(1, 0), b3, voffB); PG8_STAGE(PG8_SB(1, 1), b3 + hstepB, voffB); PG8_STAGE(PG8_SA(1, 0), a3, voffA);
            PG8_WAIT_V(8); PG8_WAIT_L(0); PG8_BAR; PG8_MMA(1, 0, At, B0); PG8_MMA(1, 1, At, B1); PG8_BAR; PG8_SCHED;
            } else {
            PG8_LDB(B0, 0, 0); PG8_SCHED; PG8_LDA(At, 0, 0); PG8_STAGE(PG8_SA(1, 1), a1 + hstepA, voffA);
            PG8_WAIT_L(8); PG8_BAR; PG8_WAIT_L(0); PG8_MMA(0, 0, At, B0); PG8_BAR; PG8_SCHED;
            PG8_LDB(B1, 0, 1); PG8_STAGE(PG8_SB(0, 0), b2, voffB);
            PG8_BAR; PG8_WAIT_L(0); PG8_MMA(0, 1, At, B1); PG8_BAR;
            PG8_LDA(At, 0, 1); PG8_STAGE(PG8_SA(0, 0), a2, voffA);
            PG8_BAR; PG8_WAIT_L(0); PG8_MMA(1, 0, At, B0); PG8_BAR; PG8_SCHED;
            PG8_STAGE(PG8_SB(0, 1), b2 + hstepB, voffB);
            PG8_WAIT_V(6); PG8_BAR; PG8_MMA(1, 1, At, B1); PG8_BAR;
            PG8_LDB(B0, 1, 0); PG8_SCHED; PG8_LDA(At, 1, 0); PG8_STAGE(PG8_SA(0, 1), a2 + hstepA, voffA);
            PG8_WAIT_L(8); PG8_BAR; PG8_WAIT_L(0); PG8_MMA(0, 0, At, B0); PG8_BAR; PG8_SCHED;
            PG8_LDB(B1, 1, 1); PG8_STAGE(PG8_SB(1, 0), b3, voffB);
            PG8_BAR; PG8_WAIT_L(0); PG8_MMA(0, 1, At, B1); PG8_BAR;
            PG8_LDA(At, 1, 1); PG8_STAGE(PG8_SA(1, 0), a3, voffA);
            PG8_BAR; PG8_WAIT_L(0); PG8_MMA(1, 0, At, B0); PG8_BAR; PG8_SCHED;
            PG8_STAGE(PG8_SB(1, 1), b3 + hstepB, voffB);
            PG8_WAIT_V(6); PG8_BAR; PG8_MMA(1, 1, At, B1); PG8_BAR;
            }
        }
        if constexpr (ALIGN_EPI) { if (wr == 0) PG8_BAR; }
        if constexpr (!Epi::AFTER_DRAIN) { E(acc, cur, wr, wc, fr, fq); S.done(cur); }
        if (!has_next) break;
#pragma unroll
        for (int a = 0; a < 2; ++a)
#pragma unroll
            for (int b = 0; b < 2; ++b)
#pragma unroll
                for (int m = 0; m < 4; ++m)
#pragma unroll
                    for (int n = 0; n < 2; ++n) acc[a][b][m][n] = (f32x4){0.f, 0.f, 0.f, 0.f};
        cur = nxt; cA = nA; cB = nB; ++ui;
        if constexpr (ALIGN_EPI) { if (wr == 1) PG8_BAR; }
    }
    PG8_WAIT_V(0);
    if constexpr (!ALIGN_EPI) { if (wr == 0) PG8_BAR; }
    PG8_BAR;
    if constexpr (Epi::AFTER_DRAIN) { E.fused(acc, cur, wr, wc, fr, fq, lds, wid, lane); S.done(cur); }
#undef PG8_SA
#undef PG8_SB
#undef PG8_STAGE
#undef PG8_LDA
#undef PG8_LDB
#undef PG8_MMA
#undef PG8_WAIT_V
#undef PG8_WAIT_L
#undef PG8_BAR
#undef PG8_SCHED
}
}

#ifndef MK_PER_PHASE
#define MK_PER_PHASE 0
#endif
constexpr int D = 1024, NBATCH = 8, SEQ = 4096, NLAT = NBATCH * SEQ, CTXL = 256, NCTX = NBATCH * CTXL, MALL = NLAT + NCTX;
constexpr int RH = 4, RQK = 256, RV = 512;
constexpr int DFF = 2816, NE = 8, DFE = 3584;
constexpr float EPS = 1e-6f;
constexpr float LAMBDA_INIT = 0.3555090675909693f;
constexpr float LOG2E = 1.4426950408889634f;
constexpr int NWAVES = 8, NTHREADS = 512;
constexpr int MOE_ROWS = 2 * NLAT + NE * 256;

enum { I_X = 0, I_C, I_CTX, I_CCTX, I_L0_WMOD, I_L0_BMOD, I_L0_NPREMIX, I_L0_NPOSTMIX, I_L0_NPREFFN, I_L0_NPOSTFFN, I_L0_WIN, I_L0_DECAY, I_L0_WOUT, I_L0_WGU, I_L0_WDN,
       I_L1_WMOD, I_L1_BMOD, I_L1_NPREMIX, I_L1_NPOSTMIX, I_L1_NPREFFN, I_L1_NPOSTFFN, I_L1_WIN, I_L1_LAMBDA, I_L1_SUBLN, I_L1_WOUT, I_L1_RW, I_L1_RB, I_L1_MGU, I_L1_MDN, N_IN };

constexpr size_t MiB = 1u << 20;
constexpr size_t WS_CTL = 0, CTL_ZERO_BYTES = 1 * MiB;
constexpr size_t WS_MODV = 1 * MiB;
constexpr size_t WS_TAB0 = 1 * MiB + 512 * 1024;
constexpr size_t WS_TAB1 = WS_TAB0 + 32 * 1024;
constexpr size_t WS_LAM = WS_TAB1 + 8 * 1024;
constexpr size_t WS_ROUTE = 2 * MiB;
constexpr size_t WS_XCTX = 3 * MiB;
constexpr size_t WS_W0IN = 11 * MiB, WS_W0OUT = 27 * MiB, WS_W0GU = 31 * MiB, WS_W0DN = 42 * MiB, WS_W1IN = 48 * MiB, WS_W1OUT = 54 * MiB, WS_WMGU = 56 * MiB, WS_WMDN = 168 * MiB;
constexpr size_t WS_H = 224 * MiB;
constexpr size_t WS_A = 292 * MiB, WS_B = 564 * MiB;
constexpr size_t WS_OF = WS_B, WS_OB = WS_B + 136 * MiB;
constexpr size_t WS_HP = WS_A, WS_ACT1 = 424 * MiB, WS_Y1 = WS_A;
constexpr size_t WS_END = 886 * MiB;
static_assert(WS_ACT1 + (size_t)MOE_ROWS * DFE * 2 <= WS_END, "ws map");
static_assert(WS_HP + (size_t)MOE_ROWS * D * 2 <= WS_ACT1, "ws map");
constexpr int CW_TMO = 0;
constexpr int CW_BAR = 4096;
constexpr int CW_MOECNT = 16384;

constexpr int RING_BYTES = 131072;
constexpr int LDS_BYTES = 163840;
constexpr int MISC_OFF = LDS_BYTES - 256;

#define GAS __attribute__((address_space(1)))
#define LAS __attribute__((address_space(3)))
typedef unsigned short bf16;
typedef unsigned v4u __attribute__((ext_vector_type(4)));
typedef unsigned v2u __attribute__((ext_vector_type(2)));
typedef float f32x4 __attribute__((ext_vector_type(4)));
typedef float f32x2 __attribute__((ext_vector_type(2)));
typedef short bf16x8 __attribute__((ext_vector_type(8)));
typedef GAS unsigned gu32;
#define RLX_AGENT __ATOMIC_RELAXED, __HIP_MEMORY_SCOPE_AGENT
#define LDS_WAIT() asm volatile("s_waitcnt lgkmcnt(0)" ::: "memory")
#define VM_WAIT() asm volatile("s_waitcnt vmcnt(0)" ::: "memory")
__device__ __forceinline__ unsigned f2bf(float f) { unsigned u = __builtin_bit_cast(unsigned, f); return (u + 0x7fffu + ((u >> 16) & 1u)) >> 16; }
__device__ __forceinline__ unsigned pk2(float lo, float hi) { return f2bf(lo) | (f2bf(hi) << 16); }
__device__ __forceinline__ float bf2f(unsigned b) { return __builtin_bit_cast(float, b << 16); }
__device__ __forceinline__ float bflo(unsigned w) { return __builtin_bit_cast(float, w << 16); }
__device__ __forceinline__ float bfhi(unsigned w) { return __builtin_bit_cast(float, w & 0xffff0000u); }
__device__ __forceinline__ float fast_exp2(float x) { return __builtin_amdgcn_exp2f(x); }
__device__ __forceinline__ float silu_f(float g) { return g * __builtin_amdgcn_rcpf(1.0f + __builtin_amdgcn_exp2f(-g * LOG2E)); }
__device__ __forceinline__ float wave_sum(float v) {
#pragma unroll
    for (int o = 1; o < 64; o <<= 1) v += __shfl_xor(v, o);
    return v;
}

#define XB_TMO      128
#define XB_XCNT(j)  (256  + 64 * (j))
#define XB_XSUB(j)  (1280 + 64 * (j))
#define XB_XGEN(j)  (2304 + 64 * (j))
#define XB_TOP      3328
#define XB_TOPGEN   3392
#define XCD_BAR_WORDS 3456
#define XB_SPIN_CAP (1u << 24)

__device__ __forceinline__ unsigned xb_ld(unsigned* p)              { return __hip_atomic_load(p, __ATOMIC_RELAXED, __HIP_MEMORY_SCOPE_AGENT); }
__device__ __forceinline__ unsigned xb_add(unsigned* p, unsigned v) { return __hip_atomic_fetch_add(p, v, __ATOMIC_RELAXED, __HIP_MEMORY_SCOPE_AGENT); }
__device__ __forceinline__ unsigned xb_xcc_id() { return (unsigned)__builtin_amdgcn_s_getreg((3 << 11) | 20) & 0xFu; }
#define XB_SPIN(cond, bar) do { unsigned _sp = 0; while (cond) { __builtin_amdgcn_s_sleep(1); \
    if ((++_sp & 255u) == 0u) { if (xb_ld(&(bar)[XB_TMO])) break; if (_sp > XB_SPIN_CAP) { atomicAdd(&(bar)[XB_TMO], 1u); break; } } } } while (0)

struct XcdBarrier {
    unsigned* bar; unsigned x;
    volatile LAS unsigned* st;
};

__device__ __forceinline__ XcdBarrier xcd_barrier_post(unsigned* bar, volatile LAS unsigned* st) {
    XcdBarrier b; b.bar = bar; b.x = xb_xcc_id(); b.st = st;
    if (threadIdx.x == 0) (void)xb_add(&bar[XB_XCNT(b.x)], 1u);
    return b;
}
__device__ __forceinline__ void xcd_barrier_complete(unsigned* bar, unsigned x, unsigned& nloc, unsigned& nx) {
    const unsigned G = gridDim.x * gridDim.y * gridDim.z;
    unsigned sum, cnt, mine, sp = 0u;
    for (;;) {
        sum = 0u; cnt = 0u; mine = 0u;
#pragma unroll
        for (unsigned j = 0; j < 16; ++j) { const unsigned c = xb_ld(&bar[XB_XCNT(j)]); sum += c; cnt += (c > 0u) ? 1u : 0u; mine = (j == x) ? c : mine; }
        if (sum == G) break;
        __builtin_amdgcn_s_sleep(1);
        if ((++sp & 255u) == 0u) { if (xb_ld(&bar[XB_TMO])) break; if (sp > XB_SPIN_CAP) { atomicAdd(&bar[XB_TMO], 1u); break; } }
    }
    nloc = mine > 0u ? mine : 1u; nx = cnt > 0u ? cnt : 1u;
}

__device__ __forceinline__ void xcd_barrier(const XcdBarrier& b) {
    asm volatile("s_waitcnt vmcnt(0)" ::: "memory");
    __syncthreads();
    if (threadIdx.x == 0) {
        unsigned* bar = b.bar;
        __builtin_amdgcn_s_waitcnt(0);
        unsigned nloc = b.st[0], nx = b.st[1];
        if (nloc == 0u) { xcd_barrier_complete(bar, b.x, nloc, nx); b.st[0] = nloc; b.st[1] = nx; }
        const unsigned old = xb_add(&bar[XB_XSUB(b.x)], 1u);
        const unsigned gen = old / nloc;
        if (old + 1u == (gen + 1u) * nloc) {
            __builtin_amdgcn_fence(__ATOMIC_RELEASE, "agent");
            asm volatile("s_waitcnt vmcnt(0)" ::: "memory");
            const unsigned og = xb_add(&bar[XB_TOP], 1u);
            const unsigned tg = og / nx;
            if (og + 1u == (tg + 1u) * nx) xb_add(&bar[XB_TOPGEN], 1u);
            else XB_SPIN(xb_ld(&bar[XB_TOPGEN]) == tg, bar);
            __builtin_amdgcn_fence(__ATOMIC_ACQUIRE, "agent");
            xb_add(&bar[XB_XGEN(b.x)], 1u);
            asm volatile("s_waitcnt vmcnt(0)" ::: "memory");
        } else {
            XB_SPIN(xb_ld(&bar[XB_XGEN(b.x)]) == gen, bar);
            __builtin_amdgcn_fence(__ATOMIC_ACQUIRE, "agent");
            asm volatile("s_waitcnt vmcnt(0)" ::: "memory");
        }
    }
    __syncthreads();
}


struct Args { const float* in[N_IN]; float* out; unsigned char* ws; int ph_lo, ph_hi; };

struct Frame {
    LAS unsigned char* lds;
    volatile LAS unsigned* MISC;
    gu32* ctl;
    int tid, lane, wave, vcu, G;
    unsigned char* ws;
};

namespace pg8 {
struct EpiStore {
    static constexpr bool PERM = true, AFTER_DRAIN = false;
    bf16_t* O; int ldc;
    __device__ __forceinline__ void operator()(const f32x4 (&acc)[2][2][4][2], const Unit& u, int wr, int wc, int fr, int fq) const {
        const int row0 = u.pm * BM + wr * 64 + fr; const int col0 = u.pc * BM + wc * 32 + 8 * fq;
#pragma unroll
        for (int ai = 0; ai < 2; ++ai)
#pragma unroll
            for (int m = 0; m < 4; ++m) { bf16_t* rowp = O + (size_t)(row0 + ai * HALF + m * 16) * ldc + col0;
#pragma unroll
                for (int bj = 0; bj < 2; ++bj) { const f32x4 v0 = acc[ai][bj][m][0], v1 = acc[ai][bj][m][1];
                    u32x4 w; w.x = cvt_pk_bf16(v0[0], v0[1]); w.y = cvt_pk_bf16(v0[2], v0[3]); w.z = cvt_pk_bf16(v1[0], v1[1]); w.w = cvt_pk_bf16(v1[2], v1[3]);
                    *(u32x4*)(rowp + bj * HALF) = w; } }
    }
};
struct EpiSwiglu {
    static constexpr bool PERM = true, AFTER_DRAIN = false;
    bf16_t* O; int ldc;
    __device__ __forceinline__ void operator()(const f32x4 (&acc)[2][2][4][2], const Unit& u, int wr, int wc, int fr, int fq) const {
        const int row0 = u.pm * BM + wr * 64 + fr; const int col0 = u.pc * HALF + wc * 32 + 8 * fq;
#pragma unroll
        for (int ai = 0; ai < 2; ++ai)
#pragma unroll
            for (int m = 0; m < 4; ++m) { bf16_t* rowp = O + (size_t)(row0 + ai * HALF + m * 16) * ldc + col0;
                f32x4 a0, a1;
#pragma unroll
                for (int e = 0; e < 4; ++e) { a0[e] = silu_f(acc[ai][0][m][0][e]) * acc[ai][1][m][0][e]; a1[e] = silu_f(acc[ai][0][m][1][e]) * acc[ai][1][m][1][e]; }
                u32x4 w; w.x = cvt_pk_bf16(a0[0], a0[1]); w.y = cvt_pk_bf16(a0[2], a0[3]); w.z = cvt_pk_bf16(a1[0], a1[1]); w.w = cvt_pk_bf16(a1[2], a1[3]);
                *(u32x4*)rowp = w; }
    }
};
struct MoeOrder {
    int nM, nN, nwg, G, c; int t1, t2, t3, t4, t5, t6, t7;
    __device__ bool next(int i, Unit& u) const {
        const long L = (long)i * G + c; if (L >= nwg) return false;
        int wgid = (int)L; { const int q = nwg / NXCD, r = nwg % NXCD, xcd = wgid % NXCD, off = wgid / NXCD; wgid = (xcd < r ? xcd * (q + 1) : r * (q + 1) + (xcd - r) * q) + off; }
        const int nig = WGM * nN, gid = wgid / nig, fm = gid * WGM, gsz = (nM - fm) < WGM ? (nM - fm) : WGM;
        u.pm = fm + ((wgid % nig) % gsz); u.pc = (wgid % nig) / gsz;
        const int e = (u.pm >= t1) + (u.pm >= t2) + (u.pm >= t3) + (u.pm >= t4) + (u.pm >= t5) + (u.pm >= t6) + (u.pm >= t7);
        u.pn = e * nN + u.pc; return true;
    }
    __device__ __forceinline__ void a_ready(const Unit&) const {}
    __device__ __forceinline__ void done(const Unit&) const {}
};
}

__device__ __forceinline__ void p0_transpose_item(const float* W, int K, int N, bf16* WT, int drow0, LAS float* scr, int k0, int n0, int lane) {
#pragma unroll 8
    for (int i = 0; i < 32; ++i) { const int kk = 2 * i + (lane >> 5); scr[kk * 33 + (lane & 31)] = W[(size_t)(k0 + kk) * N + n0 + (lane & 31)]; }
    LDS_WAIT(); asm volatile("" ::: "memory");
    const int c = lane & 7;
#pragma unroll
    for (int j = 0; j < 4; ++j) { const int n = (lane >> 3) + 8 * j; const LAS float* s = scr + (8 * c) * 33 + n;
        v4u o; o.x = pk2(s[0 * 33], s[1 * 33]); o.y = pk2(s[2 * 33], s[3 * 33]); o.z = pk2(s[4 * 33], s[5 * 33]); o.w = pk2(s[6 * 33], s[7 * 33]);
        *(GAS v4u*)(WT + (size_t)(drow0 + n) * K + k0 + 8 * c) = o; }
    LDS_WAIT(); asm volatile("" ::: "memory");
}
__device__ __forceinline__ int swiglu_row(int n0, int F) { const int bj = n0 / F, w = n0 % F; return 256 * (w >> 7) + 128 * bj + (w & 127); }

__device__ __forceinline__ void p0_prologue(Frame& F, const Args& a) {
    LAS float* scr = (LAS float*)(F.lds + F.wave * 16384);
    const int gw = F.vcu * NWAVES + F.wave, NGW = F.G * NWAVES;
    constexpr int I0 = (D / 64) * (8192 / 32), I1 = (2048 / 64) * (D / 32), I2 = (D / 64) * (2 * DFF / 32), I3 = (DFF / 64) * (D / 32), I4 = (D / 64) * (3072 / 32), I5 = (D / 64) * (D / 32);
    constexpr int I6E = (D / 64) * (2 * DFE / 32), I7E = (DFE / 64) * (D / 32);
    constexpr int NITEMS = I0 + I1 + I2 + I3 + I4 + I5 + NE * I6E + NE * I7E;
    for (int it = gw; it < NITEMS; it += NGW) {
        int r = it;
        if (r < I0) { const int nb = r % (8192 / 32), kb = r / (8192 / 32); p0_transpose_item(a.in[I_L0_WIN], D, 8192, (bf16*)(F.ws + WS_W0IN), 32 * nb, scr, 64 * kb, 32 * nb, F.lane); continue; } r -= I0;
        if (r < I1) { const int nb = r % (D / 32), kb = r / (D / 32); p0_transpose_item(a.in[I_L0_WOUT], 2048, D, (bf16*)(F.ws + WS_W0OUT), 32 * nb, scr, 64 * kb, 32 * nb, F.lane); continue; } r -= I1;
        if (r < I2) { const int nb = r % (2 * DFF / 32), kb = r / (2 * DFF / 32); p0_transpose_item(a.in[I_L0_WGU], D, 2 * DFF, (bf16*)(F.ws + WS_W0GU), swiglu_row(32 * nb, DFF), scr, 64 * kb, 32 * nb, F.lane); continue; } r -= I2;
        if (r < I3) { const int nb = r % (D / 32), kb = r / (D / 32); p0_transpose_item(a.in[I_L0_WDN], DFF, D, (bf16*)(F.ws + WS_W0DN), 32 * nb, scr, 64 * kb, 32 * nb, F.lane); continue; } r -= I3;
        if (r < I4) { const int nb = r % (3072 / 32), kb = r / (3072 / 32); p0_transpose_item(a.in[I_L1_WIN], D, 3072, (bf16*)(F.ws + WS_W1IN), 32 * nb, scr, 64 * kb, 32 * nb, F.lane); continue; } r -= I4;
        if (r < I5) { const int nb = r % (D / 32), kb = r / (D / 32); p0_transpose_item(a.in[I_L1_WOUT], D, D, (bf16*)(F.ws + WS_W1OUT), 32 * nb, scr, 64 * kb, 32 * nb, F.lane); continue; } r -= I5;
        if (r < NE * I6E) { const int e = r / I6E, rr = r % I6E; const int nb = rr % (2 * DFE / 32), kb = rr / (2 * DFE / 32);
            p0_transpose_item(a.in[I_L1_MGU] + (size_t)e * D * 2 * DFE, D, 2 * DFE, (bf16*)(F.ws + WS_WMGU) + (size_t)e * 2 * DFE * D, swiglu_row(32 * nb, DFE), scr, 64 * kb, 32 * nb, F.lane); continue; } r -= NE * I6E;
        { const int e = r / I7E, rr = r % I7E; const int nb = rr % (D / 32), kb = rr / (D / 32);
            p0_transpose_item(a.in[I_L1_MDN] + (size_t)e * DFE * D, DFE, D, (bf16*)(F.ws + WS_WMDN) + (size_t)e * D * DFE, 32 * nb, scr, 64 * kb, 32 * nb, F.lane); }
    }
    __syncthreads();
    {
        LAS float* sc = (LAS float*)F.lds;
        LAS float* part = (LAS float*)(F.lds + 9 * 1024 * 4);
        bool loaded = false;
        for (int grp = F.vcu; grp < 2 * (6 * D / 64); grp += F.G) {
            if (!loaded) { for (int i = F.tid; i < 9 * 1024; i += NTHREADS) { const float cv = (i < 8 * 1024) ? a.in[I_C][i] : a.in[I_CCTX][i - 8 * 1024]; sc[i] = silu_f(cv); } loaded = true; }
            __syncthreads();
            const int layer = grp / (6 * D / 64), cb = (grp % (6 * D / 64)) * 64;
            const float* W = a.in[layer ? I_L1_WMOD : I_L0_WMOD]; const float* bm = a.in[layer ? I_L1_BMOD : I_L0_BMOD];
            const int ks = F.tid >> 6, col = F.tid & 63;
            float acc[9];
#pragma unroll
            for (int b = 0; b < 9; ++b) acc[b] = 0.f;
            for (int k = ks * 128; k < ks * 128 + 128; ++k) { const float w = W[(size_t)k * (6 * D) + cb + col];
#pragma unroll
                for (int b = 0; b < 9; ++b) acc[b] += sc[b * 1024 + k] * w; }
#pragma unroll
            for (int b = 0; b < 9; ++b) part[(ks * 9 + b) * 64 + col] = acc[b];
            __syncthreads();
            for (int o = F.tid; o < 9 * 64; o += NTHREADS) { const int b = o >> 6, cc = o & 63; float s = bm[cb + cc];
#pragma unroll
                for (int k2 = 0; k2 < 8; ++k2) s += part[(k2 * 9 + b) * 64 + cc];
                ((float*)(F.ws + WS_MODV))[((size_t)layer * 9 + b) * (6 * D) + cb + cc] = s; }
            __syncthreads();
        }
    }
    {
        const int gt = F.vcu * NTHREADS + F.tid;
        if (gt < 64 * 64 + 64 * 16) {
            int pos, i; float ex;
            if (gt < 4096) { pos = gt >> 6; i = gt & 63; ex = (float)(2 * i) / 128.0f; } else { const int q = gt - 4096; pos = q >> 4; i = q & 15; ex = (float)(2 * i) / 32.0f; }
            const float freq = __builtin_amdgcn_exp2f(-ex * 13.287712379549449f);
            const float rev = (float)pos * freq * 0.15915494309189535f;
            const float cs = __builtin_amdgcn_cosf(rev), sn = __builtin_amdgcn_sinf(rev);
            f32x2* t = (f32x2*)(F.ws + (gt < 4096 ? WS_TAB0 : WS_TAB1)); t[gt < 4096 ? gt : gt - 4096] = (f32x2){cs, sn};
        }
        if (gt == 0) { const float* lp = a.in[I_L1_LAMBDA]; float s1 = 0.f, s2 = 0.f; for (int i = 0; i < 64; ++i) { s1 += lp[i] * lp[64 + i]; s2 += lp[128 + i] * lp[192 + i]; }
            *(float*)(F.ws + WS_LAM) = __expf(s1) - __expf(s2) + LAMBDA_INIT; }
    }
}

struct RowPass {
    int nrows;
    const float* xin_lat; const float* xin_ctx; float* xout_lat; float* xout_ctx;
    const bf16* br;
    const float* gpost;
    const float* gate;
    const float* gpre;
    const float* shift; const float* scale;
    bf16* hout;
};
template <bool BR, bool MOEBR, bool WH, bool ROUTE>
__device__ __forceinline__ void row_pass(Frame& F, const Args& a, const RowPass& P) {
    const int gw = F.vcu * NWAVES + F.wave, NGW = F.G * NWAVES;
    const int l4 = F.lane * 4;
    for (int r = gw; r < P.nrows; r += NGW) {
        const bool lat = r < NLAT; const int rc = lat ? r : r - NLAT; const int midx = lat ? (r >> 12) : 8;
        const float* xin = (lat ? P.xin_lat : P.xin_ctx) + (size_t)rc * D;
        float* xout = (lat ? P.xout_lat : P.xout_ctx) + (size_t)rc * D;
        f32x4 v[4];
#pragma unroll
        for (int j = 0; j < 4; ++j) v[j] = *(const GAS f32x4*)(xin + l4 + 256 * j);
        if constexpr (BR || MOEBR) {
            f32x4 y[4];
            if constexpr (BR) {
#pragma unroll
                for (int j = 0; j < 4; ++j) { const v2u w = *(const GAS v2u*)(P.br + (size_t)r * D + l4 + 256 * j); y[j] = (f32x4){bflo(w.x), bfhi(w.x), bflo(w.y), bfhi(w.y)}; }
            } else {
                const int* tpos = (const int*)(F.ws + WS_ROUTE + (size_t)NLAT * 8); const float* tw = (const float*)(F.ws + WS_ROUTE + (size_t)NLAT * 16);
                const int s0 = tpos[2 * r], s1 = tpos[2 * r + 1]; const float w0 = tw[2 * r], w1 = tw[2 * r + 1];
#pragma unroll
                for (int j = 0; j < 4; ++j) { const v2u p = *(const GAS v2u*)(P.br + (size_t)s0 * D + l4 + 256 * j); const v2u q = *(const GAS v2u*)(P.br + (size_t)s1 * D + l4 + 256 * j);
                    y[j] = (f32x4){w0 * bflo(p.x) + w1 * bflo(q.x), w0 * bfhi(p.x) + w1 * bfhi(q.x), w0 * bflo(p.y) + w1 * bflo(q.y), w0 * bfhi(p.y) + w1 * bfhi(q.y)}; }
            }
            float ss = 0.f;
#pragma unroll
            for (int j = 0; j < 4; ++j) ss += (y[j].x * y[j].x + y[j].y * y[j].y) + (y[j].z * y[j].z + y[j].w * y[j].w);
            const float rstd = 1.0f / sqrtf(wave_sum(ss) * (1.0f / D) + EPS);
#pragma unroll
            for (int j = 0; j < 4; ++j) { const f32x4 gp = *(const GAS f32x4*)(P.gpost + l4 + 256 * j); const f32x4 gt = *(const GAS f32x4*)(P.gate + (size_t)midx * 6 * D + l4 + 256 * j);
                v[j] = v[j] + gt * (y[j] * rstd * gp); }
#pragma unroll
            for (int j = 0; j < 4; ++j) *(GAS f32x4*)(xout + l4 + 256 * j) = v[j];
        }
        if constexpr (WH) {
            float ss = 0.f;
#pragma unroll
            for (int j = 0; j < 4; ++j) ss += (v[j].x * v[j].x + v[j].y * v[j].y) + (v[j].z * v[j].z + v[j].w * v[j].w);
            const float rstd = 1.0f / sqrtf(wave_sum(ss) * (1.0f / D) + EPS);
            f32x4 h[4];
#pragma unroll
            for (int j = 0; j < 4; ++j) { const f32x4 gp = *(const GAS f32x4*)(P.gpre + l4 + 256 * j); const f32x4 sc = *(const GAS f32x4*)(P.scale + (size_t)midx * 6 * D + l4 + 256 * j);
                const f32x4 sh = *(const GAS f32x4*)(P.shift + (size_t)midx * 6 * D + l4 + 256 * j);
                h[j] = (v[j] * rstd * gp) * (1.0f + sc) + sh;
                v2u w; w.x = pk2(h[j].x, h[j].y); w.y = pk2(h[j].z, h[j].w); *(GAS v2u*)(P.hout + (size_t)r * D + l4 + 256 * j) = w; }
            if constexpr (ROUTE) {
                const float* rw = a.in[I_L1_RW];
                float lg[8];
#pragma unroll
                for (int e = 0; e < 8; ++e) lg[e] = 0.f;
#pragma unroll
                for (int j = 0; j < 4; ++j)
#pragma unroll
                    for (int q = 0; q < 4; ++q) { const int k = l4 + 256 * j + q; const f32x4 wa = *(const GAS f32x4*)(rw + (size_t)k * 8), wb = *(const GAS f32x4*)(rw + (size_t)k * 8 + 4); const float hv = h[j][q];
                        lg[0] += hv * wa.x; lg[1] += hv * wa.y; lg[2] += hv * wa.z; lg[3] += hv * wa.w; lg[4] += hv * wb.x; lg[5] += hv * wb.y; lg[6] += hv * wb.z; lg[7] += hv * wb.w; }
#pragma unroll
                for (int e = 0; e < 8; ++e) lg[e] = wave_sum(lg[e]) + a.in[I_L1_RB][e];
                float v1 = lg[0]; int i1 = 0;
#pragma unroll
                for (int e = 1; e < 8; ++e) if (lg[e] > v1) { v1 = lg[e]; i1 = e; }
                float v2 = -3.0e38f; int i2 = 0;
#pragma unroll
                for (int e = 0; e < 8; ++e) if (e != i1 && lg[e] > v2) { v2 = lg[e]; i2 = e; }
                const float w1 = 1.0f / (1.0f + __expf(v2 - v1)), w2 = 1.0f - w1;
                if (F.lane == 0) {
                    int* te = (int*)(F.ws + WS_ROUTE); int* tpos = (int*)(F.ws + WS_ROUTE + (size_t)NLAT * 8); float* tw = (float*)(F.ws + WS_ROUTE + (size_t)NLAT * 16);
                    const unsigned p1 = __hip_atomic_fetch_add((unsigned*)(F.ctl + CW_MOECNT + 64 * i1), 1u, RLX_AGENT);
                    const unsigned p2 = __hip_atomic_fetch_add((unsigned*)(F.ctl + CW_MOECNT + 64 * i2), 1u, RLX_AGENT);
                    te[2 * r] = i1; te[2 * r + 1] = i2; tpos[2 * r] = (int)p1; tpos[2 * r + 1] = (int)p2; tw[2 * r] = w1; tw[2 * r + 1] = w2;
                }
            }
        }
    }
}

__device__ __forceinline__ void rope0_pass(Frame& F) {
    bf16* z = (bf16*)(F.ws + WS_A); const f32x2* tab = (const f32x2*)(F.ws + WS_TAB0);
    const int gw = F.vcu * NWAVES + F.wave, NGW = F.G * NWAVES; const int i = F.lane;
    for (int r = gw; r < MALL; r += NGW) {
        const bool lat = r < NLAT; const int t = r & (SEQ - 1);
        bf16* zr = z + (size_t)r * 4096;
#pragma unroll
        for (int T = 0; T < 2; ++T)
#pragma unroll
            for (int h = 0; h < RH; ++h)
#pragma unroll
                for (int hf = 0; hf < 2; ++hf) {
                    const int base = T * 1024 + h * 256 + hf * 128; const float sc = T ? 0.0625f : 1.0f;
                    float x1 = bf2f(zr[base + i]), x2 = bf2f(zr[base + 64 + i]);
                    if (lat) { const int pos = hf ? (t & 63) : (t >> 6); const f32x2 cs = tab[pos * 64 + i]; const float y1 = x1 * cs.x - x2 * cs.y, y2 = x2 * cs.x + x1 * cs.y; x1 = y1; x2 = y2; }
                    zr[base + i] = (bf16)f2bf(x1 * sc); zr[base + 64 + i] = (bf16)f2bf(x2 * sc);
                }
    }
}
__device__ __forceinline__ void rope1_pass(Frame& F) {
    bf16* z = (bf16*)(F.ws + WS_A); const f32x2* tab = (const f32x2*)(F.ws + WS_TAB1);
    const int gw = F.vcu * NWAVES + F.wave, NGW = F.G * NWAVES;
    for (int r = gw; r < MALL; r += NGW) {
        const bool lat = r < NLAT; const int t = r & (SEQ - 1);
        bf16* zr = z + (size_t)r * 3072;
#pragma unroll
        for (int T = 0; T < 2; ++T)
#pragma unroll
            for (int jj = 0; jj < 8; ++jj) {
                const int pp = F.lane + 64 * jj; const int head = pp >> 5, hf = (pp >> 4) & 1, i = pp & 15;
                const int base = T * 1024 + head * 64 + hf * 32; const float sc = T ? 1.0f : 0.125f * LOG2E;
                float x1 = bf2f(zr[base + i]), x2 = bf2f(zr[base + 16 + i]);
                if (lat) { const int pos = hf ? (t & 63) : (t >> 6); const f32x2 cs = tab[pos * 16 + i]; const float y1 = x1 * cs.x - x2 * cs.y, y2 = x2 * cs.x + x1 * cs.y; x1 = y1; x2 = y2; }
                zr[base + i] = (bf16)f2bf(x1 * sc); zr[base + 16 + i] = (bf16)f2bf(x2 * sc);
            }
    }
}
__device__ __forceinline__ void merge_pass(Frame& F) {
    const bf16* zg = (const bf16*)(F.ws + WS_A); bf16* of = (bf16*)(F.ws + WS_OF); const bf16* ob = (const bf16*)(F.ws + WS_OB);
    const int gw = F.vcu * NWAVES + F.wave, NGW = F.G * NWAVES;
    for (int r = gw; r < MALL; r += NGW) {
#pragma unroll
        for (int h = 0; h < RH; ++h) {
            const size_t o = (size_t)r * 2048 + h * 512 + F.lane * 8;
            const v4u a = *(const GAS v4u*)(of + o), b = *(const GAS v4u*)(ob + o);
            const v4u gf = *(const GAS v4u*)(zg + (size_t)r * 4096 + h * 512 + F.lane * 8), gb = *(const GAS v4u*)(zg + (size_t)r * 4096 + 2048 + h * 512 + F.lane * 8);
            float av[8], bv[8], gfv[8], gbv[8];
#pragma unroll
            for (int q = 0; q < 4; ++q) { av[2 * q] = bflo(a[q]); av[2 * q + 1] = bfhi(a[q]); bv[2 * q] = bflo(b[q]); bv[2 * q + 1] = bfhi(b[q]);
                gfv[2 * q] = bflo(gf[q]); gfv[2 * q + 1] = bfhi(gf[q]); gbv[2 * q] = bflo(gb[q]); gbv[2 * q + 1] = bfhi(gb[q]); }
            float sa = 0.f, sb = 0.f;
#pragma unroll
            for (int q = 0; q < 8; ++q) { sa += av[q] * av[q]; sb += bv[q] * bv[q]; }
            const float ra = 1.0f / sqrtf(wave_sum(sa) * (1.0f / RV) + EPS), rb = 1.0f / sqrtf(wave_sum(sb) * (1.0f / RV) + EPS);
            float y[8];
#pragma unroll
            for (int q = 0; q < 8; ++q) y[q] = silu_f(gfv[q]) * (av[q] * ra) + silu_f(gbv[q]) * (bv[q] * rb);
            v4u w; w.x = pk2(y[0], y[1]); w.y = pk2(y[2], y[3]); w.z = pk2(y[4], y[5]); w.w = pk2(y[6], y[7]);
            *(GAS v4u*)(of + o) = w;
        }
    }
}

__device__ __forceinline__ void ret_naive(Frame& F, const Args& a) {
    const bf16* z = (const bf16*)(F.ws + WS_A);
    LAS bf16* qk = (LAS bf16*)F.lds;
    LAS bf16* vb = (LAS bf16*)(F.lds + 32768);
    LAS float* part = (LAS float*)(F.lds + 32768 + 2048);
    const int half = F.tid >> 8, d = F.tid & 255;
    for (int unit = F.vcu; unit < NBATCH * RH * 2 * 16; unit += F.G) {
        const int vs = unit & 15, dir = (unit >> 4) & 1, h = (unit >> 5) & 3, b = unit >> 7;
        const float logit = a.in[I_L0_DECAY][dir * RH + h];
        const float gamma = 1.0f / (1.0f + __expf(-logit));
        float S[16];
#pragma unroll
        for (int v = 0; v < 16; ++v) S[v] = 0.f;
        bf16* outp = (bf16*)(F.ws + (dir ? WS_OB : WS_OF));
        for (int s = 0; s < 136; ++s) {
            int blk; size_t row0;
            if (s < 8) { blk = dir ? 7 - s : s; row0 = (size_t)NLAT + b * CTXL + blk * 32; } else { blk = dir ? 127 - (s - 8) : (s - 8); row0 = (size_t)b * SEQ + blk * 32; }
            __syncthreads();
            for (int i = F.tid; i < 32 * 64; i += NTHREADS) { const int tk = i >> 6, c8 = i & 63;
                const bf16* src = z + (row0 + tk) * 4096 + (c8 < 32 ? h * 256 + c8 * 8 : 1024 + h * 256 + (c8 - 32) * 8);
                *(LAS v4u*)(qk + tk * 512 + c8 * 8) = *(const GAS v4u*)src; }
            if (F.tid < 128) { const int tk = F.tid >> 2, c8 = F.tid & 3; *(LAS v4u*)(vb + tk * 32 + c8 * 8) = *(const GAS v4u*)(z + (row0 + tk) * 4096 + 2048 + h * 512 + vs * 32 + c8 * 8); }
            __syncthreads();
            for (int i = 0; i < 32; ++i) {
                const int tk = dir ? 31 - i : i;
                const float qv = bf2f(qk[tk * 512 + d]), kv = bf2f(qk[tk * 512 + 256 + d]);
                float p[16];
#pragma unroll
                for (int v = 0; v < 16; ++v) { const float vv = bf2f(vb[tk * 32 + half * 16 + v]); S[v] = gamma * S[v] + kv * vv; p[v] = qv * S[v]; }
                const int ln = F.lane;
                float p8[8], p4[4], p2[2], p1;
#pragma unroll
                for (int j = 0; j < 8; ++j) { const bool up = (ln & 32) != 0; const float keep = up ? p[j + 8] : p[j], send = up ? p[j] : p[j + 8]; p8[j] = keep + __shfl_xor(send, 32); }
#pragma unroll
                for (int j = 0; j < 4; ++j) { const bool up = (ln & 16) != 0; const float keep = up ? p8[j + 4] : p8[j], send = up ? p8[j] : p8[j + 4]; p4[j] = keep + __shfl_xor(send, 16); }
#pragma unroll
                for (int j = 0; j < 2; ++j) { const bool up = (ln & 8) != 0; const float keep = up ? p4[j + 2] : p4[j], send = up ? p4[j] : p4[j + 2]; p2[j] = keep + __shfl_xor(send, 8); }
                { const bool up = (ln & 4) != 0; const float keep = up ? p2[1] : p2[0], send = up ? p2[0] : p2[1]; p1 = keep + __shfl_xor(send, 4); }
                p1 += __shfl_xor(p1, 1); p1 += __shfl_xor(p1, 2);
                if ((ln & 3) == 0) { const int vi = ((ln >> 5) & 1) * 8 + ((ln >> 4) & 1) * 4 + ((ln >> 3) & 1) * 2 + ((ln >> 2) & 1); part[(tk * 8 + F.wave) * 16 + vi] = p1; }
            }
            __syncthreads();
            for (int o = F.tid; o < 32 * 32; o += NTHREADS) { const int tk = o >> 5, v = o & 31, hf = v >> 4, vi = v & 15;
                float sum = 0.f;
#pragma unroll
                for (int w = 0; w < 4; ++w) sum += part[(tk * 8 + hf * 4 + w) * 16 + vi];
                outp[(row0 + tk) * 2048 + h * 512 + vs * 32 + v] = (bf16)f2bf(sum); }
        }
    }
}

__device__ __forceinline__ void attn_naive(Frame& F, const Args& a) {
    const bf16* z = (const bf16*)(F.ws + WS_A);
    bf16* ao = (bf16*)(F.ws + WS_B);
    LAS float* Kt = (LAS float*)F.lds;
    LAS float* Vt = (LAS float*)(F.lds + 8192);
    LAS float* xs = (LAS float*)(F.lds + 8192 + 16384);
    const float lam = *(const float*)(F.ws + WS_LAM);
    const int half = F.tid >> 8, rl = F.tid & 255;
    for (int unit = F.vcu; unit < NBATCH * 8 * 16; unit += F.G) {
        const int qb = unit & 15, hp = (unit >> 4) & 7, b = unit >> 7;
        const size_t qrow = (size_t)b * SEQ + qb * 256 + rl;
        float o1[64];
#pragma unroll 1
        for (int hh = 0; hh < 2; ++hh) {
            const int qh = 2 * hp + hh;
            float q[64];
#pragma unroll
            for (int c = 0; c < 8; ++c) { const v4u w = *(const GAS v4u*)(z + qrow * 3072 + qh * 64 + c * 8);
#pragma unroll
                for (int e = 0; e < 4; ++e) { q[c * 8 + 2 * e] = bflo(w[e]); q[c * 8 + 2 * e + 1] = bfhi(w[e]); } }
            float o[64];
#pragma unroll
            for (int i = 0; i < 64; ++i) o[i] = 0.f;
            float m = -1.0e30f, l = 0.f;
            for (int kt = 0; kt < 136; ++kt) {
                const size_t krow0 = kt < 128 ? (size_t)b * SEQ + kt * 32 : (size_t)NLAT + b * CTXL + (kt - 128) * 32;
                __syncthreads();
                { const int key = F.tid >> 4, c4 = F.tid & 15;
                    const v2u w = *(const GAS v2u*)(z + (krow0 + key) * 3072 + 1024 + qh * 64 + c4 * 4);
                    *(LAS f32x4*)(Kt + key * 64 + c4 * 4) = (f32x4){bflo(w.x), bfhi(w.x), bflo(w.y), bfhi(w.y)};
                    const v4u u = *(const GAS v4u*)(z + (krow0 + key) * 3072 + 2048 + hp * 128 + c4 * 8);
                    *(LAS f32x4*)(Vt + key * 128 + c4 * 8) = (f32x4){bflo(u.x), bfhi(u.x), bflo(u.y), bfhi(u.y)};
                    *(LAS f32x4*)(Vt + key * 128 + c4 * 8 + 4) = (f32x4){bflo(u.z), bfhi(u.z), bflo(u.w), bfhi(u.w)}; }
                __syncthreads();
                for (int key = 0; key < 32; ++key) {
                    float s = 0.f;
#pragma unroll
                    for (int c = 0; c < 16; ++c) { const f32x4 kv = *(const LAS f32x4*)(Kt + key * 64 + c * 4); s += q[4 * c] * kv.x + q[4 * c + 1] * kv.y + q[4 * c + 2] * kv.z + q[4 * c + 3] * kv.w; }
                    const float mn = fmaxf(m, s); const float al = fast_exp2(m - mn), p = fast_exp2(s - mn); m = mn; l = l * al + p;
#pragma unroll
                    for (int c = 0; c < 16; ++c) { const f32x4 vv = *(const LAS f32x4*)(Vt + key * 128 + half * 64 + c * 4);
                        o[4 * c] = o[4 * c] * al + p * vv.x; o[4 * c + 1] = o[4 * c + 1] * al + p * vv.y; o[4 * c + 2] = o[4 * c + 2] * al + p * vv.z; o[4 * c + 3] = o[4 * c + 3] * al + p * vv.w; }
                }
            }
            const float rl_ = 1.0f / l;
            if (hh == 0) {
#pragma unroll
                for (int i = 0; i < 64; ++i) o1[i] = o[i] * rl_;
            } else {
#pragma unroll
                for (int i = 0; i < 64; ++i) o1[i] = o1[i] - lam * (o[i] * rl_);
            }
        }
        float ss = 0.f;
#pragma unroll
        for (int i = 0; i < 64; ++i) ss += o1[i] * o1[i];
        __syncthreads();
        xs[F.tid] = ss;
        __syncthreads();
        const float tot = xs[rl] + xs[256 + rl];
        const float rstd = 1.0f / sqrtf(tot * (1.0f / 128.0f) + EPS) * (1.0f - LAMBDA_INIT);
        const float* sub = a.in[I_L1_SUBLN];
#pragma unroll
        for (int c = 0; c < 8; ++c) { v4u w;
#pragma unroll
            for (int e = 0; e < 4; ++e) { const int i0 = c * 8 + 2 * e; w[e] = pk2(o1[i0] * rstd * sub[half * 64 + i0], o1[i0 + 1] * rstd * sub[half * 64 + i0 + 1]); }
            *(GAS v4u*)(ao + qrow * 1024 + hp * 128 + half * 64 + c * 8) = w; }
    }
}


namespace att {
using s16x4  = __attribute__((ext_vector_type(4))) short;
using f32x16 = __attribute__((ext_vector_type(16))) float;
using u32x4  = __attribute__((ext_vector_type(4))) unsigned;
constexpr int LDZ = 3072, KVBLK = 64, NT = (SEQ + CTXL) / KVBLK;
constexpr int SHM_V = KVBLK * 128 * 2, SHM_K = KVBLK * 64 * 2;
constexpr int OFF_V = 0, OFF_K = 2 * SHM_V, OFF_WS = OFF_K + 2 * SHM_K, OFF_O1 = OFF_WS + NWAVES * 64 * 4, ATT_LDS = OFF_O1 + NWAVES * 8192;
constexpr float THR = 8.0f;
#define ATT_SBAR() __builtin_amdgcn_sched_barrier(0)
#define KSWZ64(row, colB) ((row) * 128 + ((colB) ^ ((((row) >> 1) & 7) << 4)))
__device__ __forceinline__ int crow(int r, int hi) { return (r & 3) + 8 * (r >> 2) + 4 * hi; }
__device__ __forceinline__ unsigned cvtpk(float lo, float hi) { unsigned r; asm volatile("v_cvt_pk_bf16_f32 %0, %1, %2" : "=v"(r) : "v"(lo), "v"(hi)); return r; }

__device__ __forceinline__ void partialSM(f32x16& p0, f32x16& p1, float& m_reg, float& alpha) {
    float pmax = p0[0];
#pragma unroll
    for (int r = 1; r < 16; ++r) pmax = fmaxf(pmax, p0[r]);
#pragma unroll
    for (int r = 0; r < 16; ++r) pmax = fmaxf(pmax, p1[r]);
    { auto rr = __builtin_amdgcn_permlane32_swap(__float_as_uint(pmax), __float_as_uint(pmax), false, false); pmax = fmaxf(__uint_as_float(rr[0]), __uint_as_float(rr[1])); }
    float mn;
    if (__builtin_expect(__all(pmax - m_reg <= THR), 1)) { mn = m_reg; alpha = 1.f; }
    else { mn = fmaxf(m_reg, pmax); alpha = __builtin_amdgcn_exp2f(m_reg - mn); m_reg = mn; }
#pragma unroll
    for (int r = 0; r < 16; ++r) p0[r] = p0[r] - mn;
#pragma unroll
    for (int r = 0; r < 16; ++r) p1[r] = p1[r] - mn;
#pragma unroll
    for (int r = 0; r < 16; ++r) p0[r] = __builtin_amdgcn_exp2f(p0[r]);
}
__device__ __forceinline__ void finishSM(f32x16& p0, f32x16& p1, float alpha, float& l_reg, bf16x8& pa0, bf16x8& pa1, bf16x8& pa2, bf16x8& pa3) {
#pragma unroll
    for (int r = 0; r < 16; ++r) p1[r] = __builtin_amdgcn_exp2f(p1[r]);
    float ps = 0;
#pragma unroll
    for (int r = 0; r < 16; ++r) ps += p0[r];
#pragma unroll
    for (int r = 0; r < 16; ++r) ps += p1[r];
    { auto rr = __builtin_amdgcn_permlane32_swap(__float_as_uint(ps), __float_as_uint(ps), false, false); ps = __uint_as_float(rr[0]) + __uint_as_float(rr[1]); }
    l_reg = l_reg * alpha + ps;
#define ATT_PK4(P, BASE, OUT) do { unsigned a0 = cvtpk(P[BASE + 0], P[BASE + 1]), a1 = cvtpk(P[BASE + 2], P[BASE + 3]);   \
    unsigned b0 = cvtpk(P[BASE + 4], P[BASE + 5]), b1 = cvtpk(P[BASE + 6], P[BASE + 7]);                              \
    auto r0 = __builtin_amdgcn_permlane32_swap(a0, b0, false, false); auto r1 = __builtin_amdgcn_permlane32_swap(a1, b1, false, false); \
    u32x4 w = {r0[0], r1[0], r0[1], r1[1]}; OUT = *reinterpret_cast<bf16x8*>(&w); } while (0)
    ATT_PK4(p0, 0, pa0); ATT_PK4(p0, 8, pa1); ATT_PK4(p1, 0, pa2); ATT_PK4(p1, 8, pa3);
#undef ATT_PK4
}
__device__ __forceinline__ void qkt(f32x16& p0, f32x16& p1, const char* Ks, const bf16x8* qr, int r32, int hi) {
    p0 = f32x16{}; p1 = f32x16{};
#pragma unroll
    for (int d0 = 0; d0 < 4; ++d0) { const int cb = (d0 * 16 + hi * 8) * 2;
        const bf16x8 b0 = *reinterpret_cast<const bf16x8*>(Ks + KSWZ64(r32, cb));
        const bf16x8 b1 = *reinterpret_cast<const bf16x8*>(Ks + KSWZ64(32 + r32, cb));
        p0 = __builtin_amdgcn_mfma_f32_32x32x16_bf16(b0, qr[d0], p0, 0, 0, 0);
        p1 = __builtin_amdgcn_mfma_f32_32x32x16_bf16(b1, qr[d0], p1, 0, 0, 0); }
}
__device__ __forceinline__ int v_st(int k, int c) { const int kk = (k & ~0xC) | ((k & 4) << 1) | ((k & 8) >> 1); return ((kk >> 3) * 4 + (c >> 5)) * 512 + ((kk & 7) * 32 + (c & 31)) * 2; }
__device__ __forceinline__ int v_rd_base(int lane) { return ((lane & 3) << 3) | (((lane >> 2) & 3) << 6) | (((lane >> 4) & 1) << 5) | (((lane >> 5) & 1) << 8); }
constexpr int v_rd_off(int d0, int ks, int half) { return d0 * 512 + ks * 4096 + half * 2048; }
template <int OFF> __device__ __forceinline__ s16x4 tr_read(int vb) { s16x4 r; asm volatile("ds_read_b64_tr_b16 %0, %1 offset:%2" : "=&v"(r) : "v"(vb), "i"(OFF) : "memory"); return r; }
template <int D0> __device__ __forceinline__ void pv_one(f32x16& od, int vb, bf16x8 pa0, bf16x8 pa1, bf16x8 pa2, bf16x8 pa3) {
    const s16x4 l0 = tr_read<v_rd_off(D0, 0, 0)>(vb), h0 = tr_read<v_rd_off(D0, 0, 1)>(vb), l1 = tr_read<v_rd_off(D0, 1, 0)>(vb), h1 = tr_read<v_rd_off(D0, 1, 1)>(vb);
    const s16x4 l2 = tr_read<v_rd_off(D0, 2, 0)>(vb), h2 = tr_read<v_rd_off(D0, 2, 1)>(vb), l3 = tr_read<v_rd_off(D0, 3, 0)>(vb), h3 = tr_read<v_rd_off(D0, 3, 1)>(vb);
    asm volatile("s_waitcnt lgkmcnt(0)" ::: "memory"); ATT_SBAR();
#define ATT_PK(L, H) (bf16x8){L[0], L[1], L[2], L[3], H[0], H[1], H[2], H[3]}
    od = __builtin_amdgcn_mfma_f32_32x32x16_bf16(pa0, ATT_PK(l0, h0), od, 0, 0, 0);
    od = __builtin_amdgcn_mfma_f32_32x32x16_bf16(pa1, ATT_PK(l1, h1), od, 0, 0, 0);
    od = __builtin_amdgcn_mfma_f32_32x32x16_bf16(pa2, ATT_PK(l2, h2), od, 0, 0, 0);
    od = __builtin_amdgcn_mfma_f32_32x32x16_bf16(pa3, ATT_PK(l3, h3), od, 0, 0, 0);
#undef ATT_PK
}
__device__ __forceinline__ void pv_d0(f32x16* o, int vb, bf16x8 pa0, bf16x8 pa1, bf16x8 pa2, bf16x8 pa3) {
    pv_one<0>(o[0], vb, pa0, pa1, pa2, pa3); pv_one<1>(o[1], vb, pa0, pa1, pa2, pa3); pv_one<2>(o[2], vb, pa0, pa1, pa2, pa3); pv_one<3>(o[3], vb, pa0, pa1, pa2, pa3);
}
__device__ __forceinline__ size_t kvrow(int b, int t) { return t < 64 ? (size_t)b * SEQ + (size_t)t * 64 : (size_t)NLAT + (size_t)b * CTXL + (size_t)(t - 64) * 64; }

__device__ __forceinline__ void head_pass(const bf16* __restrict__ z, int b, int qh, int hp, size_t qrow0, char* lds, f32x16 (&o)[4], float& l_out) {
    int tid_ = threadIdx.x; asm volatile("" : "+v"(tid_));
    const int tid = tid_, wid = tid >> 6, lane = tid & 63, r32 = lane & 31, hi = lane >> 5;
    char* V_lds = lds + OFF_V; char* K_lds = lds + OFF_K;
    float* wsf = (float*)(lds + OFF_WS) + wid * 64; float* al_l = wsf + 32;
    float m_reg = -1e30f, l_reg = 0.f;
#pragma unroll
    for (int d = 0; d < 4; ++d) o[d] = f32x16{};
    bf16x8 qr[4];
    const bf16* Qw = z + (qrow0 + wid * 32 + r32) * LDZ + qh * 64 + hi * 8;
#pragma unroll
    for (int d0 = 0; d0 < 4; ++d0) qr[d0] = *reinterpret_cast<const bf16x8*>(Qw + d0 * 16);
    const bf16* Kh = z + 1024 + qh * 64; const bf16* Vh = z + 2048 + hp * 128;
    const int sr = tid >> 4, sc = (tid & 15) * 8, vst0 = v_st(sr, sc), vst1 = v_st(32 + sr, sc);
    const int kr = tid >> 3, kc = (tid & 7) * 8, kst = KSWZ64(kr, kc * 2);
    const int vb0 = (int)(uintptr_t)V_lds + v_rd_base(lane);
    struct { bf16x8 vs0, vs1, ks; } sr_[2];
#define ATT_SLOAD(i, t) do { const size_t rb_ = kvrow(b, (t)); sr_[i].vs0 = *reinterpret_cast<const bf16x8*>(&Vh[(rb_ + sr) * LDZ + sc]); sr_[i].vs1 = *reinterpret_cast<const bf16x8*>(&Vh[(rb_ + 32 + sr) * LDZ + sc]); \
    sr_[i].ks = *reinterpret_cast<const bf16x8*>(&Kh[(rb_ + kr) * LDZ + kc]); } while (0)
#define ATT_SWRITE(bu, i) do { *(bf16x8*)(V_lds + (bu) * SHM_V + vst0) = sr_[i].vs0; *(bf16x8*)(V_lds + (bu) * SHM_V + vst1) = sr_[i].vs1; *(bf16x8*)(K_lds + (bu) * SHM_K + kst) = sr_[i].ks; } while (0)
#define ATT_SWAIT() asm volatile("s_waitcnt vmcnt(3)" ::: "memory")
#define ATT_RESC(al) do { if (__any((al) < 1.f)) { if (hi == 0) al_l[r32] = (al); asm volatile("s_waitcnt lgkmcnt(0)" ::: "memory"); \
    _Pragma("unroll") for (int d = 0; d < 4; ++d) _Pragma("unroll") for (int r = 0; r < 16; ++r) o[d][r] *= al_l[crow(r, hi)]; } } while (0)
    f32x16 pA0, pA1, pB0, pB1; float alA, alB; bf16x8 pa0, pa1, pa2, pa3;
    ATT_SLOAD(0, 0); asm volatile("s_waitcnt vmcnt(0)" ::: "memory"); ATT_SWRITE(0, 0); __syncthreads();
    qkt(pA0, pA1, K_lds, qr, r32, hi); partialSM(pA0, pA1, m_reg, alA);
    ATT_SLOAD(1, 1); ATT_SLOAD(0, 2);
    ATT_SWAIT(); ATT_SWRITE(1, 1); __syncthreads();
    for (int j = 1; j + 1 < NT; j += 2) {
        ATT_SBAR(); qkt(pB0, pB1, K_lds + SHM_K, qr, r32, hi);
        finishSM(pA0, pA1, alA, l_reg, pa0, pa1, pa2, pa3); ATT_SBAR();
        ATT_SLOAD(1, j + 2); ATT_SBAR();
        pv_d0(o, vb0, pa0, pa1, pa2, pa3); partialSM(pB0, pB1, m_reg, alB);
        __syncthreads(); ATT_SWAIT(); ATT_SWRITE(0, 0);
        ATT_RESC(alB); __syncthreads();
        ATT_SBAR(); qkt(pA0, pA1, K_lds, qr, r32, hi);
        finishSM(pB0, pB1, alB, l_reg, pa0, pa1, pa2, pa3); ATT_SBAR();
        if (j + 3 < NT) ATT_SLOAD(0, j + 3); ATT_SBAR();
        pv_d0(o, vb0 + SHM_V, pa0, pa1, pa2, pa3); partialSM(pA0, pA1, m_reg, alA);
        __syncthreads(); ATT_SWAIT(); ATT_SWRITE(1, 1);
        ATT_RESC(alA); __syncthreads();
    }
    ATT_SBAR(); qkt(pB0, pB1, K_lds + SHM_K, qr, r32, hi);
    finishSM(pA0, pA1, alA, l_reg, pa0, pa1, pa2, pa3); ATT_SBAR();
    pv_d0(o, vb0, pa0, pa1, pa2, pa3); partialSM(pB0, pB1, m_reg, alB);
    __syncthreads(); ATT_RESC(alB);
    finishSM(pB0, pB1, alB, l_reg, pa0, pa1, pa2, pa3); ATT_SBAR();
    pv_d0(o, vb0 + SHM_V, pa0, pa1, pa2, pa3);
    l_out = l_reg;
#undef ATT_SLOAD
#undef ATT_SWRITE
#undef ATT_SWAIT
#undef ATT_RESC
}

__device__ __forceinline__ void attn_unit(const bf16* __restrict__ z, bf16* __restrict__ ao, int b, int hp, int qb, char* lds, const float* lamp, const float* subln) {
    int tid_ = threadIdx.x; asm volatile("" : "+v"(tid_));
    const int tid = tid_, wid = tid >> 6, lane = tid & 63, r32 = lane & 31, hi = lane >> 5;
    float* wsf = (float*)(lds + OFF_WS) + wid * 64;
    unsigned* o1s = (unsigned*)(lds + OFF_O1 + wid * 8192);
    const size_t qrow0 = (size_t)b * SEQ + (size_t)qb * 256;
    f32x16 o[4]; float l;
    float ssq[16];
#pragma unroll 1
    for (int hh = 0; hh < 2; ++hh) {
        head_pass(z, b, 2 * hp + hh, hp, qrow0, lds, o, l);
        if (hi == 0) wsf[r32] = l; asm volatile("s_waitcnt lgkmcnt(0)" ::: "memory");
        float rli[16];
#pragma unroll
        for (int r = 0; r < 16; ++r) { rli[r] = __builtin_amdgcn_rcpf(wsf[crow(r, hi)]); ssq[r] = 0.f; }
        if (hh == 0) {
#pragma unroll
            for (int d0 = 0; d0 < 4; ++d0)
#pragma unroll
                for (int r = 0; r < 16; r += 2) o1s[(d0 * 8 + (r >> 1)) * 64 + lane] = cvtpk(o[d0][r] * rli[r], o[d0][r + 1] * rli[r + 1]);
            __syncthreads();
        } else {
            asm volatile("" : "+s"(lamp)); const float lam = *lamp;
#pragma unroll
            for (int d0 = 0; d0 < 4; ++d0)
#pragma unroll
                for (int r = 0; r < 16; r += 2) { const unsigned w = o1s[(d0 * 8 + (r >> 1)) * 64 + lane];
                    const float a0 = bflo(w) - lam * (o[d0][r] * rli[r]), a1 = bfhi(w) - lam * (o[d0][r + 1] * rli[r + 1]);
                    o[d0][r] = a0; o[d0][r + 1] = a1; ssq[r] += a0 * a0; ssq[r + 1] += a1 * a1; }
        }
    }
#pragma unroll
    for (int r = 0; r < 16; ++r) { float s = ssq[r];
        s += __shfl_xor(s, 1); s += __shfl_xor(s, 2); s += __shfl_xor(s, 4); s += __shfl_xor(s, 8); s += __shfl_xor(s, 16);
        ssq[r] = 1.0f / sqrtf(s * (1.0f / 128.0f) + EPS) * (1.0f - LAMBDA_INIT); }
    asm volatile("s_waitcnt lgkmcnt(0)" ::: "memory");
    bf16* stg = (bf16*)o1s;
    asm volatile("" : "+s"(subln));
#pragma unroll
    for (int d0 = 0; d0 < 4; ++d0) { const float g = subln[d0 * 32 + r32];
#pragma unroll
        for (int r = 0; r < 16; ++r) stg[crow(r, hi) * 128 + d0 * 32 + r32] = (bf16)f2bf(o[d0][r] * ssq[r] * g); }
    asm volatile("s_waitcnt lgkmcnt(0)" ::: "memory");
    bf16* Ow = ao + (qrow0 + wid * 32) * D + hp * 128;
#pragma unroll
    for (int i = 0; i < 8; ++i) { const int row = i * 4 + (lane >> 4), ch = lane & 15; const u32x4 v = *(const u32x4*)(stg + row * 128 + ch * 8); *(u32x4*)(Ow + (size_t)row * D + ch * 8) = v; }
    asm volatile("s_waitcnt lgkmcnt(0)" ::: "memory");
    __syncthreads();
}
#undef ATT_SBAR
}

__device__ __forceinline__ void attn_phase(Frame& F, const Args& a) {
    const bf16* z = (const bf16*)(F.ws + WS_A); bf16* ao = (bf16*)(F.ws + WS_B);
    const float* lamp = (const float*)(F.ws + WS_LAM);
    for (int unit = F.vcu; unit < NBATCH * 8 * 16; unit += F.G) {
        const int qb = unit & 15, hp = (unit >> 4) & 7, b = unit >> 7;
        att::attn_unit(z, ao, b, hp, qb, (char*)F.lds, lamp, a.in[I_L1_SUBLN]);
    }
}


namespace ret {
using s16x4  = __attribute__((ext_vector_type(4))) short;
using f32x16 = __attribute__((ext_vector_type(16))) float;
typedef short v4i16_t __attribute__((ext_vector_type(4)));
constexpr int LDZ = 4096, C = 32, NSTEP = (SEQ + CTXL) / C;
constexpr int ST_Q = 0, ST_K = 16384, ST_V = 32768, ST_SC = 40960, ST_BYTES = 43008, NSTAGE = 3;
constexpr int XBUF_OFF = NSTAGE * ST_BYTES, RET_LDS = XBUF_OFF + NWAVES * 2048;
constexpr size_t WS_SC = 842 * MiB;

__device__ __forceinline__ void glds16(const void* gsrc, unsigned lds_dst) { unsigned keep;
    asm volatile("s_mov_b32 %0, m0\n\ts_mov_b32 m0, %2\n\ts_nop 0\n\tglobal_load_lds_dwordx4 %1, off\n\ts_mov_b32 m0, %0" : "=&s"(keep) : "v"(gsrc), "s"(lds_dst) : "memory"); }
__device__ __forceinline__ s16x4 vtr(const LAS char* p) { return __builtin_bit_cast(s16x4, __builtin_amdgcn_ds_read_tr16_b64_v4i16((LAS v4i16_t*)p)); }

__device__ __forceinline__ void ret_scores(Frame& F) {
    const bf16* z = (const bf16*)(F.ws + WS_A); bf16* sc = (bf16*)(F.ws + WS_SC);
    const int gw = F.vcu * NWAVES + F.wave, NGW = F.G * NWAVES;
    const int r32 = F.lane & 31, hh = F.lane >> 5;
    for (int task = gw; task < (MALL / C) * RH; task += NGW) {
        const int h = task & 3, ch = task >> 2;
        const bf16* qp = z + ((size_t)ch * C + r32) * LDZ + h * 256 + hh * 8;
        const bf16* kp = qp + 1024;
        f32x16 acc = f32x16{};
        bf16x8 a[16], b[16];
#pragma unroll
        for (int s = 0; s < 16; ++s) { a[s] = *reinterpret_cast<const bf16x8*>(qp + s * 16); b[s] = *reinterpret_cast<const bf16x8*>(kp + s * 16); }
#pragma unroll
        for (int s = 0; s < 16; ++s) acc = __builtin_amdgcn_mfma_f32_32x32x16_bf16(a[s], b[s], acc, 0, 0, 0);
        bf16* tp = sc + (size_t)task * 1024;
#pragma unroll
        for (int r = 0; r < 16; ++r) { const int i = (r & 3) + 8 * (r >> 2) + 4 * hh; tp[i * 32 + r32] = (bf16)f2bf(acc[r]); }
    }
}

__device__ __forceinline__ size_t step_row0(int b, int dir, int t) {
    if (t < 8) { const int blk = dir ? 7 - t : t; return (size_t)NLAT + (size_t)b * CTXL + (size_t)blk * C; }
    const int blk = dir ? 127 - (t - 8) : (t - 8); return (size_t)b * SEQ + (size_t)blk * C;
}

__device__ __forceinline__ void ret_scan(Frame& F, const Args& a) {
    const char* zb = (const char*)(F.ws + WS_A); const char* scb = (const char*)(F.ws + WS_SC);
    for (int unit = F.vcu; unit < NBATCH * RH * 2 * 4; unit += F.G) {
        int tid_ = threadIdx.x; asm volatile("" : "+v"(tid_));
        const int tid = tid_, lane = tid & 63, w = __builtin_amdgcn_readfirstlane(tid >> 6), dh = w >> 2, vs = w & 3, r32 = lane & 31, hh = lane >> 5;
        const int vq = unit & 3, dir = (unit >> 2) & 1, h = (unit >> 3) & 3, b = unit >> 5;
        const float logit = a.in[I_L0_DECAY][dir * RH + h];
        const float lg2 = -__builtin_amdgcn_logf(1.0f + __builtin_amdgcn_exp2f(-logit * LOG2E));
        const float gC = __builtin_amdgcn_exp2f(lg2 * (float)C);
        float kd[2][8];
#pragma unroll
        for (int s = 0; s < 2; ++s)
#pragma unroll
            for (int jj = 0; jj < 8; ++jj) { const int j = 16 * s + 8 * hh + jj; kd[s][jj] = __builtin_amdgcn_exp2f(lg2 * (float)(dir ? j : 31 - j)); }
        float rsc[8];
#pragma unroll
        for (int q = 0; q < 8; ++q) { const int r = 8 * dh + q; const int m = (r & 3) + 8 * (r >> 2) + 4 * hh; rsc[q] = __builtin_amdgcn_exp2f(-lg2 * (float)(dir ? m : 31 - m)); }
        unsigned pm[4];
#pragma unroll
        for (int e = 0; e < 4; ++e) { const int j0 = 16 * dh + 8 * hh + 2 * e, j1 = j0 + 1; const bool k0 = dir ? (j0 >= r32) : (j0 <= r32), k1 = dir ? (j1 >= r32) : (j1 <= r32);
            pm[e] = (k0 ? 0x0000ffffu : 0u) | (k1 ? 0xffff0000u : 0u); }
        const size_t colq = (size_t)h * 512, colk = 2048 + (size_t)h * 512, colv = 4096 + (size_t)h * 1024 + (size_t)vq * 256;
        unsigned offq[2], offk[2];
#pragma unroll
        for (int p = 0; p < 2; ++p) { const int i = 2 * (2 * w + p) + (lane >> 5), cp = lane & 31;
            offq[p] = (unsigned)(i * LDZ * 2 + (int)colq + ((cp ^ (i & 15)) << 4)); offk[p] = (unsigned)(i * LDZ * 2 + (int)colk + ((cp ^ ((i & 3) << 2)) << 4)); }
        unsigned offv; { const int j = 4 * w + (lane >> 4), cp = lane & 15; offv = (unsigned)(j * LDZ * 2 + (int)colv + ((cp ^ ((j & 3) << 2)) << 4)); }
        unsigned offs; { const int i = 16 * (w & 1) + (lane >> 2), cp = lane & 3; offs = (unsigned)(i * 64 + ((cp ^ ((i >> 2) & 3)) << 4)); }
        LAS unsigned char* L = F.lds;
        const unsigned lbase = (unsigned)(uintptr_t)L;
#define RET_ISSUE(t_) do { const int t__ = (t_); const unsigned sb_ = lbase + (unsigned)((t__ % NSTAGE) * ST_BYTES); const size_t r0_ = step_row0(b, dir, t__); const char* gb_ = zb + r0_ * (LDZ * 2); \
        glds16(gb_ + offq[0], (unsigned)__builtin_amdgcn_readfirstlane(sb_ + ST_Q + (2 * w) * 1024)); \
        glds16(gb_ + offq[1], (unsigned)__builtin_amdgcn_readfirstlane(sb_ + ST_Q + (2 * w + 1) * 1024)); \
        glds16(gb_ + offk[0], (unsigned)__builtin_amdgcn_readfirstlane(sb_ + ST_K + (2 * w) * 1024)); \
        glds16(gb_ + offk[1], (unsigned)__builtin_amdgcn_readfirstlane(sb_ + ST_K + (2 * w + 1) * 1024)); \
        glds16(gb_ + offv, (unsigned)__builtin_amdgcn_readfirstlane(sb_ + ST_V + w * 1024)); \
        if (w < 2) glds16(scb + ((r0_ >> 5) * 4 + h) * 2048 + offs, (unsigned)__builtin_amdgcn_readfirstlane(sb_ + ST_SC + w * 1024)); } while (0)
        const int qrow = ST_Q + r32 * 512; const int qx = r32 & 15;
        const int G = lane >> 4, il = lane & 15, tq = il >> 2, tp = il & 3;
        const int kcolb = (128 * dh + 16 * (G & 1) + 8 * (tp & 1) + 4 * (tp >> 1)) * 2;
        const int vcolb = (32 * vs + 16 * (G & 1) + 4 * tp) * 2;
        f32x16 S[4];
#pragma unroll
        for (int T = 0; T < 4; ++T) S[T] = f32x16{};
        bf16* outp = (bf16*)(F.ws + (dir ? WS_OB : WS_OF));
        LAS float* xb_mine = (LAS float*)(L + XBUF_OFF + w * 2048); LAS float* xb_part = (LAS float*)(L + XBUF_OFF + (w ^ 4) * 2048);

        __builtin_amdgcn_s_barrier();
        RET_ISSUE(0); RET_ISSUE(1);
        for (int t = 0; t < NSTEP; ++t) {
            if (t == 0) { if (w < 2) asm volatile("s_waitcnt vmcnt(6)" ::: "memory"); else asm volatile("s_waitcnt vmcnt(5)" ::: "memory"); }
            else        { if (w < 2) asm volatile("s_waitcnt vmcnt(14)" ::: "memory"); else asm volatile("s_waitcnt vmcnt(13)" ::: "memory"); }
            __builtin_amdgcn_s_barrier(); asm volatile("" ::: "memory");
            if (t + 2 < NSTEP) RET_ISSUE(t + 2);
            const LAS char* sb = (const LAS char*)(L + (t % NSTAGE) * ST_BYTES);
            bf16x8 vd[2];
#pragma unroll
            for (int s = 0; s < 2; ++s) {
                const int j0 = 16 * s + 8 * (G >> 1) + tq;
                const int cph = (((vcolb >> 4) ^ (tq << 2)) << 4) + (vcolb & 8);
                const s16x4 lo = vtr(sb + ST_V + j0 * 256 + cph), hi = vtr(sb + ST_V + (j0 + 4) * 256 + cph);
                float f[8];
#pragma unroll
                for (int e = 0; e < 4; ++e) { f[e] = bf2f((unsigned short)lo[e]) * kd[s][e]; f[4 + e] = bf2f((unsigned short)hi[e]) * kd[s][4 + e]; }
                v4u pk; pk.x = pk2(f[0], f[1]); pk.y = pk2(f[2], f[3]); pk.z = pk2(f[4], f[5]); pk.w = pk2(f[6], f[7]);
                vd[s] = __builtin_bit_cast(bf16x8, pk);
            }
#pragma unroll
            for (int T = 0; T < 4; ++T) S[T] = S[T] * gC;
            f32x16 acc = f32x16{};
#pragma unroll
            for (int T = 0; T < 4; ++T)
#pragma unroll
                for (int s = 0; s < 2; ++s) {
                    const int cL = 16 * dh + 4 * T + 2 * s + hh;
                    const bf16x8 qa = *(const LAS bf16x8*)(sb + qrow + ((cL ^ qx) << 4));
                    v4u pk; pk.x = pk2(S[T][8 * s + 0], S[T][8 * s + 1]); pk.y = pk2(S[T][8 * s + 2], S[T][8 * s + 3]); pk.z = pk2(S[T][8 * s + 4], S[T][8 * s + 5]); pk.w = pk2(S[T][8 * s + 6], S[T][8 * s + 7]);
                    acc = __builtin_amdgcn_mfma_f32_32x32x16_bf16(qa, __builtin_bit_cast(bf16x8, pk), acc, 0, 0, 0);
                }
            {
                const int cL = 2 * dh + hh;
                v4u pw = *(const LAS v4u*)(sb + ST_SC + r32 * 64 + ((cL ^ ((r32 >> 2) & 3)) << 4));
                pw.x &= pm[0]; pw.y &= pm[1]; pw.z &= pm[2]; pw.w &= pm[3];
                acc = __builtin_amdgcn_mfma_f32_32x32x16_bf16(__builtin_bit_cast(bf16x8, pw), dh ? vd[1] : vd[0], acc, 0, 0, 0);
            }
#pragma unroll
            for (int T = 0; T < 4; ++T)
#pragma unroll
                for (int s = 0; s < 2; ++s) {
                    const int j0 = 16 * s + 8 * (G >> 1) + tq;
                    const int cb = kcolb + 64 * T;
                    const int cph = (((cb >> 4) ^ (tq << 2)) << 4) + (cb & 8);
                    const s16x4 lo = vtr(sb + ST_K + j0 * 512 + cph), hi = vtr(sb + ST_K + (j0 + 4) * 512 + cph);
                    const bf16x8 ka = (bf16x8){lo[0], lo[1], lo[2], lo[3], hi[0], hi[1], hi[2], hi[3]};
                    S[T] = __builtin_amdgcn_mfma_f32_32x32x16_bf16(ka, vd[s], S[T], 0, 0, 0);
                }
#pragma unroll
            for (int q = 0; q < 8; ++q) xb_mine[q * 64 + lane] = dh ? acc[q] : acc[8 + q];
            asm volatile("s_waitcnt lgkmcnt(0)" ::: "memory");
            __builtin_amdgcn_s_barrier(); asm volatile("" ::: "memory");
            const size_t r0 = step_row0(b, dir, t);
#pragma unroll
            for (int q = 0; q < 8; ++q) {
                const float mine = dh ? acc[8 + q] : acc[q];
                const float v = (mine + xb_part[q * 64 + lane]) * rsc[q];
                const int r = 8 * dh + q; const int m = (r & 3) + 8 * (r >> 2) + 4 * hh;
                outp[(r0 + m) * 2048 + h * 512 + vq * 128 + vs * 32 + r32] = (bf16)f2bf(v);
            }
            asm volatile("s_waitcnt lgkmcnt(0)" ::: "memory");
        }
        asm volatile("s_waitcnt vmcnt(0)" ::: "memory");
#undef RET_ISSUE
    }
    __builtin_amdgcn_s_barrier();
}
}

__device__ __forceinline__ void moe_counts(Frame& F, int (&cnt)[NE]) {
#pragma unroll
    for (int e = 0; e < NE; ++e) cnt[e] = (int)__hip_atomic_load((unsigned*)(F.ctl + CW_MOECNT + 64 * e), RLX_AGENT);
}
__device__ __forceinline__ void moe_gather(Frame& F) {
    int cnt[NE]; moe_counts(F, cnt);
    int base[NE]; int acc = 0;
#pragma unroll
    for (int e = 0; e < NE; ++e) { base[e] = acc; acc += (cnt[e] + 255) & ~255; }
    const int* te = (const int*)(F.ws + WS_ROUTE); int* tpos = (int*)(F.ws + WS_ROUTE + (size_t)NLAT * 8);
    const bf16* hb = (const bf16*)(F.ws + WS_H); bf16* hp = (bf16*)(F.ws + WS_HP);
    const int gw = F.vcu * NWAVES + F.wave, NGW = F.G * NWAVES;
    for (int r = gw; r < NLAT; r += NGW) {
        const int e0 = te[2 * r], e1 = te[2 * r + 1]; const int p0 = tpos[2 * r], p1 = tpos[2 * r + 1];
        int b0 = 0, b1 = 0;
#pragma unroll
        for (int e = 0; e < NE; ++e) { b0 = (e0 == e) ? base[e] : b0; b1 = (e1 == e) ? base[e] : b1; }
        const int s0 = b0 + p0, s1 = b1 + p1;
        const v4u x0 = *(const GAS v4u*)(hb + (size_t)r * D + F.lane * 8), x1 = *(const GAS v4u*)(hb + (size_t)r * D + 512 + F.lane * 8);
        *(GAS v4u*)(hp + (size_t)s0 * D + F.lane * 8) = x0; *(GAS v4u*)(hp + (size_t)s0 * D + 512 + F.lane * 8) = x1;
        *(GAS v4u*)(hp + (size_t)s1 * D + F.lane * 8) = x0; *(GAS v4u*)(hp + (size_t)s1 * D + 512 + F.lane * 8) = x1;
        if (F.lane == 0) { tpos[2 * r] = s0; tpos[2 * r + 1] = s1; }
    }
}
__device__ __forceinline__ void moe_order(Frame& F, pg8::MoeOrder& S, int nN) {
    int cnt[NE]; moe_counts(F, cnt);
    int ts[NE + 1]; ts[0] = 0;
#pragma unroll
    for (int e = 0; e < NE; ++e) ts[e + 1] = ts[e] + ((cnt[e] + 255) >> 8);
    S.nM = ts[NE]; S.nN = nN; S.nwg = S.nM * nN; S.G = F.G; S.c = (int)blockIdx.x;
    S.t1 = ts[1]; S.t2 = ts[2]; S.t3 = ts[3]; S.t4 = ts[4]; S.t5 = ts[5]; S.t6 = ts[6]; S.t7 = ts[7];
}

constexpr int N_PHASES = 22;
__global__ void __launch_bounds__(NTHREADS, 2) fwd(Args args) {
    extern __shared__ __attribute__((aligned(16))) unsigned char lds[];
    Frame F;
    F.lds = (LAS unsigned char*)lds; F.MISC = (volatile LAS unsigned*)(F.lds + MISC_OFF);
    F.tid = threadIdx.x; F.lane = F.tid & 63; F.wave = __builtin_amdgcn_readfirstlane(F.tid >> 6);
    F.G = gridDim.x; { const int bx = blockIdx.x; F.vcu = (F.G % 8 == 0) ? (bx % 8) * (F.G / 8) + bx / 8 : bx; }
    F.ws = args.ws; F.ctl = (gu32*)(args.ws + WS_CTL);
    for (int u = F.tid; u < 64; u += NTHREADS) ((LAS unsigned*)(F.lds + MISC_OFF))[u] = 0u;
    __syncthreads();
#if MK_PER_PHASE
    XcdBarrier bar; bar.bar = (unsigned*)(F.ctl + CW_BAR); bar.x = 0; bar.st = nullptr;
#define GRID_BAR() do { } while (0)
#else
    XcdBarrier bar = xcd_barrier_post((unsigned*)(F.ctl + CW_BAR), F.MISC + 8);
#define GRID_BAR() xcd_barrier(bar)
#endif
    const int lo = args.ph_lo, hi = args.ph_hi;
#define IN(k) (lo <= (k) && (k) < hi)
#define SEAM(k) do { if (IN(k) && IN((k) + 1)) GRID_BAR(); } while (0)
    unsigned char* ws = args.ws;
    float* modv = (float*)(ws + WS_MODV);
    float* modv1 = modv + 9 * 6 * D;
    bf16* hbuf = (bf16*)(ws + WS_H);
    float* xctx = (float*)(ws + WS_XCTX);
    using pg8::Gemm; using pg8::StaticOrder;

    if (IN(0)) { p0_prologue(F, args); SEAM(0); }
    if (IN(1)) { RowPass P{MALL, args.in[I_X], args.in[I_CTX], nullptr, nullptr, nullptr, nullptr, nullptr, args.in[I_L0_NPREMIX], modv + 0 * D, modv + 1 * D, hbuf};
        row_pass<false, false, true, false>(F, args, P); SEAM(1); }
    if (IN(2)) { Gemm g{hbuf, (const bf16*)(ws + WS_W0IN), MALL, 4096, D, D}; StaticOrder S; S.init(MALL, 4096, F.G, (int)blockIdx.x);
        pg8::EpiStore E{(bf16*)(ws + WS_A), 4096};
        pg8::gemm_phase<pg8::EpiStore, StaticOrder, true, true>(F.lds, g, S, E); SEAM(2); }
    if (IN(3)) { rope0_pass(F); SEAM(3); }
    if (IN(4)) { ret::ret_scores(F); SEAM(4); }
    if (IN(5)) { ret::ret_scan(F, args); SEAM(5); }
    if (IN(6)) { Gemm g{hbuf, (const bf16*)(ws + WS_W0IN) + (size_t)4096 * D, MALL, 4096, D, D}; StaticOrder S; S.init(MALL, 4096, F.G, (int)blockIdx.x);
        pg8::EpiStore E{(bf16*)(ws + WS_A), 4096};
        pg8::gemm_phase<pg8::EpiStore, StaticOrder, true, true>(F.lds, g, S, E); SEAM(6); }
    if (IN(7)) { merge_pass(F); SEAM(7); }
    if (IN(8)) { Gemm g{(const bf16*)(ws + WS_OF), (const bf16*)(ws + WS_W0OUT), MALL, D, 2048, 2048}; StaticOrder S; S.init(MALL, D, F.G, (int)blockIdx.x);
        pg8::EpiStore E{(bf16*)(ws + WS_A), D};
        pg8::gemm_phase<pg8::EpiStore, StaticOrder, true, true>(F.lds, g, S, E); SEAM(8); }
    if (IN(9)) { RowPass P{MALL, args.in[I_X], args.in[I_CTX], args.out, xctx, (const bf16*)(ws + WS_A), args.in[I_L0_NPOSTMIX], modv + 2 * D, args.in[I_L0_NPREFFN], modv + 3 * D, modv + 4 * D, hbuf};
        row_pass<true, false, true, false>(F, args, P); SEAM(9); }
    if (IN(10)) { Gemm g{hbuf, (const bf16*)(ws + WS_W0GU), MALL, 2 * DFF, D, D}; StaticOrder S; S.init(MALL, 2 * DFF, F.G, (int)blockIdx.x);
        pg8::EpiSwiglu E{(bf16*)(ws + WS_B), DFF};
        pg8::gemm_phase<pg8::EpiSwiglu, StaticOrder, true, true>(F.lds, g, S, E); SEAM(10); }
    if (IN(11)) { Gemm g{(const bf16*)(ws + WS_B), (const bf16*)(ws + WS_W0DN), MALL, D, DFF, DFF}; StaticOrder S; S.init(MALL, D, F.G, (int)blockIdx.x);
        pg8::EpiStore E{(bf16*)(ws + WS_A), D};
        pg8::gemm_phase<pg8::EpiStore, StaticOrder, true, true>(F.lds, g, S, E); SEAM(11); }
    if (IN(12)) { RowPass P{MALL, args.out, xctx, args.out, xctx, (const bf16*)(ws + WS_A), args.in[I_L0_NPOSTFFN], modv + 5 * D, args.in[I_L1_NPREMIX], modv1 + 0 * D, modv1 + 1 * D, hbuf};
        row_pass<true, false, true, false>(F, args, P); SEAM(12); }
    if (IN(13)) { Gemm g{hbuf, (const bf16*)(ws + WS_W1IN), MALL, 3072, D, D}; StaticOrder S; S.init(MALL, 3072, F.G, (int)blockIdx.x);
        pg8::EpiStore E{(bf16*)(ws + WS_A), 3072};
        pg8::gemm_phase<pg8::EpiStore, StaticOrder, true, true>(F.lds, g, S, E); SEAM(13); }
    if (IN(14)) { rope1_pass(F); SEAM(14); }
    if (IN(15)) { attn_phase(F, args); SEAM(15); }
    if (IN(16)) { Gemm g{(const bf16*)(ws + WS_B), (const bf16*)(ws + WS_W1OUT), NLAT, D, D, D}; StaticOrder S; S.init(NLAT, D, F.G, (int)blockIdx.x);
        pg8::EpiStore E{(bf16*)(ws + WS_A), D};
        pg8::gemm_phase<pg8::EpiStore, StaticOrder, true, true>(F.lds, g, S, E); SEAM(16); }
    if (IN(17)) { RowPass P{NLAT, args.out, xctx, args.out, xctx, (const bf16*)(ws + WS_A), args.in[I_L1_NPOSTMIX], modv1 + 2 * D, args.in[I_L1_NPREFFN], modv1 + 3 * D, modv1 + 4 * D, hbuf};
        row_pass<true, false, true, true>(F, args, P); SEAM(17); }
    if (IN(18)) { moe_gather(F); SEAM(18); }
    if (IN(19)) { Gemm g{(const bf16*)(ws + WS_HP), (const bf16*)(ws + WS_WMGU), MOE_ROWS, 2 * DFE, D, D}; pg8::MoeOrder S; moe_order(F, S, 2 * DFE / 256);
        pg8::EpiSwiglu E{(bf16*)(ws + WS_ACT1), DFE};
        pg8::gemm_phase<pg8::EpiSwiglu, pg8::MoeOrder, true, true>(F.lds, g, S, E); SEAM(19); }
    if (IN(20)) { Gemm g{(const bf16*)(ws + WS_ACT1), (const bf16*)(ws + WS_WMDN), MOE_ROWS, D, DFE, DFE}; pg8::MoeOrder S; moe_order(F, S, D / 256);
        pg8::EpiStore E{(bf16*)(ws + WS_Y1), D};
        pg8::gemm_phase<pg8::EpiStore, pg8::MoeOrder, true, true>(F.lds, g, S, E); SEAM(20); }
    if (IN(21)) { RowPass P{NLAT, args.out, xctx, args.out, xctx, (const bf16*)(ws + WS_Y1), args.in[I_L1_NPOSTFFN], modv1 + 5 * D, nullptr, nullptr, nullptr, nullptr};
        row_pass<false, true, false, false>(F, args, P); }
#undef IN
#undef SEAM
}

extern "C" void kernel_launch(void* const* d_in, const int* in_sizes, int n_in, void* d_out, int out_size, void* d_ws, size_t ws_size, hipStream_t stream) {
    static int grid = 0;
    if (grid == 0) {
        if (n_in != N_IN || out_size != NLAT * D || ws_size < WS_END) { fprintf(stderr, "kernel_launch: unexpected shapes n_in %d out %d ws %zu\n", n_in, out_size, ws_size); grid = -1; return; }
        int dev = 0, cus = 0, per_cu = 0;
        if (hipGetDevice(&dev) != hipSuccess || hipDeviceGetAttribute(&cus, hipDeviceAttributeMultiprocessorCount, dev) != hipSuccess) { grid = -1; return; }
        if (hipFuncSetAttribute((const void*)fwd, hipFuncAttributeMaxDynamicSharedMemorySize, LDS_BYTES) != hipSuccess) { fprintf(stderr, "kernel_launch: hipFuncSetAttribute failed\n"); grid = -1; return; }
        if (hipOccupancyMaxActiveBlocksPerMultiprocessor(&per_cu, (const void*)fwd, NTHREADS, LDS_BYTES) != hipSuccess || per_cu < 1) fprintf(stderr, "kernel_launch: occupancy query says %d\n", per_cu);
        (void)hipGetLastError();
        grid = cus;
    }
    if (grid < 0) return;
    (void)hipMemsetAsync((char*)d_ws + WS_CTL, 0, CTL_ZERO_BYTES, stream);
    Args a{};
    for (int i = 0; i < N_IN; ++i) a.in[i] = (const float*)d_in[i];
    a.out = (float*)d_out; a.ws = (unsigned char*)d_ws;
#if MK_PER_PHASE
    for (int p = 0; p < N_PHASES; ++p) { a.ph_lo = p; a.ph_hi = p + 1; hipLaunchKernelGGL(fwd, dim3(grid), dim3(NTHREADS), LDS_BYTES, stream, a); }
#else
    a.ph_lo = 0; a.ph_hi = N_PHASES; hipLaunchKernelGGL(fwd, dim3(grid), dim3(NTHREADS), LDS_BYTES, stream, a);
#endif
}
```

```cpp
#include <hip/hip_runtime.h>
#include <cstdio>
#include <cstdint>
namespace pg8 {
#define PG8_LAS __attribute__((address_space(3)))
typedef unsigned short bf16_t;
typedef short bf16x8 __attribute__((ext_vector_type(8)));
typedef float f32x4 __attribute__((ext_vector_type(4)));
typedef unsigned u32x4 __attribute__((ext_vector_type(4)));
constexpr int BM = 256, BK = 64, HALF = 128, HTB = HALF * BK * 2  , STAGE_BYTES = 8 * HTB, NXCD = 8, WGM = 8;

__host__ __device__ __forceinline__ int lds_byte(int r, int c) { const int st = (r >> 4) * 2 + (c >> 5), rr = r & 15, cc = c & 31, ob = rr * 64 + cc * 2; return st * 1024 + (ob ^ (((ob >> 9) & 1) << 5)); }
__host__ __device__ __forceinline__ void stage_rc(int b, int& R, int& C) { const int st = b / 1024, sb = b % 1024, swz = sb ^ (((sb >> 9) & 1) << 5); R = (st >> 1) * 16 + swz / 64; C = (st & 1) * 32 + (swz % 64) / 2; }
__host__ __device__ __forceinline__ int perm32(int rho) { const int n = rho >> 4, i = rho & 15; return 8 * (i >> 2) + 4 * n + (i & 3); }

struct Unit { int pm, pn, pc; };
struct Gemm { const bf16_t* A; const bf16_t* Bt; int M, N, K, lda; int sA, sB; };

struct StaticOrder {
    int nM, nN, nwg, G, c;
    __host__ __device__ void init(int M, int N, int G_, int c_) { nM = M / BM; nN = N / BM; nwg = nM * nN; G = G_; c = c_; }
    __host__ __device__ bool next(int i, Unit& u) const {
        const long L = (long)i * G + c; if (L >= nwg) return false;
        int wgid = (int)L; { const int q = nwg / NXCD, r = nwg % NXCD, xcd = wgid % NXCD, off = wgid / NXCD; wgid = (xcd < r ? xcd * (q + 1) : r * (q + 1) + (xcd - r) * q) + off; }
        const int nig = WGM * nN, gid = wgid / nig, fm = gid * WGM, gsz = (nM - fm) < WGM ? (nM - fm) : WGM;
        u.pm = fm + ((wgid % nig) % gsz); u.pn = (wgid % nig) / gsz; u.pc = u.pn; return true;
    }
    __device__ __forceinline__ void a_ready(const Unit&) const {}
    __device__ __forceinline__ void done(const Unit&) const {}
};

__device__ __forceinline__ unsigned cvt_pk_bf16(float lo, float hi) { unsigned r; asm volatile("v_cvt_pk_bf16_f32 %0, %1, %2" : "=v"(r) : "v"(lo), "v"(hi)); return r; }
typedef float f32x2 __attribute__((ext_vector_type(2)));
typedef int v4i_t __attribute__((ext_vector_type(4))); typedef int v8i_t __attribute__((ext_vector_type(8)));
template <class Epi, class Sched, bool ALIGN_EPI = false, bool SP2 = false, bool FP8 = false>
__device__ __forceinline__ void gemm_phase(PG8_LAS unsigned char* lds, const Gemm g, const Sched& S, const Epi& E) {
    const int tid = threadIdx.x, wid = __builtin_amdgcn_readfirstlane(tid >> 6), lane = tid & 63, wr = wid >> 2, wc = wid & 3, fr = lane & 15, fq = lane >> 4;
    const int K = g.K, nt = K / BK;
    unsigned voffA[2], voffB[2];
#pragma unroll
    for (int i = 0; i < 2; ++i) { int R, C; stage_rc(tid * 16 + i * 8192, R, C); const int Rb = Epi::PERM ? ((R & ~31) + perm32(R & 31)) : R;
        voffA[i] = (unsigned)(R * g.lda + C) * 2u; voffB[i] = (unsigned)(Rb * K + C) * 2u; }
    const size_t kstep = (size_t)(BK * 2);
    const size_t hstepA = (size_t)HALF * g.lda * 2, hstepB = (size_t)HALF * K * 2;
    const size_t tstepA = 2 * hstepA, tstepB = 2 * hstepB;
    const unsigned ldsw = (unsigned)wid * 1024u;
    const int aoff = lds_byte(wr * 64 + fr, fq * 8), boff = lds_byte(wc * 32 + fr, fq * 8);
#define PG8_SA(b, h) (((b) * 2 + (h)) * HTB)
#define PG8_SB(b, h) ((4 + (b) * 2 + (h)) * HTB)
#define PG8_STAGE(bufoff, gbase, voff) do { _Pragma("unroll") for (int _i = 0; _i < 2; ++_i) \
        __builtin_amdgcn_global_load_lds((const unsigned*)((const char*)(gbase) + (voff)[_i]), (PG8_LAS unsigned*)(lds + (bufoff) + ldsw + _i * 8192), 16, 0, 0); } while (0)
#define PG8_LDA(dst, b, h) do { if constexpr (FP8) { _Pragma("unroll") for (int m = 0; m < 4; ++m) { const v4i_t lo_ = *(const PG8_LAS v4i_t*)(lds + PG8_SA(b, h) + aoff + m * 2048), hi_ = *(const PG8_LAS v4i_t*)(lds + PG8_SA(b, h) + aoff + m * 2048 + 1024); \
        dst##8[m] = __builtin_shufflevector(lo_, hi_, 0, 1, 2, 3, 4, 5, 6, 7); } } \
    else { _Pragma("unroll") for (int m = 0; m < 4; ++m) _Pragma("unroll") for (int k = 0; k < 2; ++k) dst[m][k] = *(const PG8_LAS bf16x8*)(lds + PG8_SA(b, h) + aoff + m * 2048 + k * 1024); } } while (0)
#define PG8_LDB(dst, b, h) do { if constexpr (FP8) { _Pragma("unroll") for (int n = 0; n < 2; ++n) { const v4i_t lo_ = *(const PG8_LAS v4i_t*)(lds + PG8_SB(b, h) + boff + n * 2048), hi_ = *(const PG8_LAS v4i_t*)(lds + PG8_SB(b, h) + boff + n * 2048 + 1024); \
        dst##8[n] = __builtin_shufflevector(lo_, hi_, 0, 1, 2, 3, 4, 5, 6, 7); } } \
    else { _Pragma("unroll") for (int n = 0; n < 2; ++n) _Pragma("unroll") for (int k = 0; k < 2; ++k) dst[n][k] = *(const PG8_LAS bf16x8*)(lds + PG8_SB(b, h) + boff + n * 2048 + k * 1024); } } while (0)
#define PG8_MMA(ai, bj, At, Bt) do { __builtin_amdgcn_s_setprio(1); _Pragma("unroll") for (int m = 0; m < 4; ++m) _Pragma("unroll") for (int n = 0; n < 2; ++n) { \
        if constexpr (FP8) { asm volatile("v_mfma_scale_f32_16x16x128_f8f6f4 %0, %1, %2, %0, %3, %4 op_sel_hi:[0,0,0]" : "+v"(acc[ai][bj][m][n]) : "v"(Bt##8[n]), "v"(At##8[m]), "v"(sB_), "v"(sA_)); } \
        else { _Pragma("unroll") for (int k = 0; k < 2; ++k) acc[ai][bj][m][n] = __builtin_amdgcn_mfma_f32_16x16x32_bf16(Bt[n][k], At[m][k], acc[ai][bj][m][n], 0, 0, 0); } } \
        __builtin_amdgcn_s_setprio(0); } while (0)
#define PG8_WAIT_V(n) asm volatile("s_waitcnt vmcnt(" #n ")" ::: "memory")
#define PG8_WAIT_L(n) asm volatile("s_waitcnt lgkmcnt(" #n ")" ::: "memory")
#define PG8_BAR __builtin_amdgcn_s_barrier()
#define PG8_SCHED __builtin_amdgcn_sched_barrier(0)
    Unit cur, nxt; int ui = 0;
    if (!S.next(0, cur)) return;
    const int sA_ = g.sA, sB_ = g.sB;
    f32x4 acc[2][2][4][2];
#pragma unroll
    for (int a = 0; a < 2; ++a)
#pragma unroll
        for (int b = 0; b < 2; ++b)
#pragma unroll
            for (int m = 0; m < 4; ++m)
#pragma unroll
                for (int n = 0; n < 2; ++n) acc[a][b][m][n] = (f32x4){0.f, 0.f, 0.f, 0.f};
    bf16x8 At[4][2], B0[2][2], B1[2][2]; v8i_t At8[4], B08[2], B18[2];
    const char* cA = (const char*)g.A + (size_t)cur.pm * tstepA; const char* cB = (const char*)g.Bt + (size_t)cur.pn * tstepB;
    S.a_ready(cur);
    if constexpr (SP2) {
        PG8_STAGE(PG8_SB(0, 0), cB, voffB); PG8_STAGE(PG8_SB(0, 1), cB + hstepB, voffB); PG8_STAGE(PG8_SA(0, 0), cA, voffA); PG8_STAGE(PG8_SA(0, 1), cA + hstepA, voffA);
        if (wr == 1) PG8_BAR;
        PG8_WAIT_V(2); PG8_BAR;
        PG8_STAGE(PG8_SB(1, 0), cB + kstep, voffB); PG8_STAGE(PG8_SA(1, 0), cA + kstep, voffA); PG8_STAGE(PG8_SB(1, 1), cB + hstepB + kstep, voffB);
        PG8_WAIT_V(6); PG8_BAR;
    } else {
        PG8_STAGE(PG8_SB(0, 0), cB, voffB); PG8_STAGE(PG8_SA(0, 0), cA, voffA); PG8_STAGE(PG8_SB(0, 1), cB + hstepB, voffB); PG8_STAGE(PG8_SA(0, 1), cA + hstepA, voffA);
        if (wr == 1) PG8_BAR;
        PG8_WAIT_V(4); PG8_BAR;
        PG8_STAGE(PG8_SB(1, 0), cB + kstep, voffB); PG8_STAGE(PG8_SA(1, 0), cA + kstep, voffA); PG8_STAGE(PG8_SB(1, 1), cB + hstepB + kstep, voffB);
        PG8_WAIT_V(6); PG8_BAR;
    }
    for (;;) {
        const bool has_next = S.next(ui + 1, nxt);
        const char* nA = has_next ? (const char*)g.A + (size_t)nxt.pm * tstepA : cA; const char* nB = has_next ? (const char*)g.Bt + (size_t)nxt.pn * tstepB : cB;
#pragma unroll 1
        for (int t = 0; t < nt; t += 2) {
            const bool last = (t == nt - 2);
            const char* a1 = cA + (size_t)(t + 1) * kstep;
            const char* a2 = last ? nA : cA + (size_t)(t + 2) * kstep; const char* b2 = last ? nB : cB + (size_t)(t + 2) * kstep;
            const char* a3 = a2 + kstep; const char* b3 = b2 + kstep;
            if (last && has_next) S.a_ready(nxt);
            if constexpr (SP2) {
            PG8_LDB(B0, 0, 0); PG8_LDB(B1, 0, 1); PG8_SCHED; PG8_LDA(At, 0, 0); PG8_STAGE(PG8_SA(1, 1), a1 + hstepA, voffA);
            PG8_WAIT_V(8); PG8_WAIT_L(0); PG8_BAR; PG8_MMA(0, 0, At, B0); PG8_MMA(0, 1, At, B1); PG8_BAR; PG8_SCHED;
            PG8_LDA(At, 0, 1); PG8_STAGE(PG8_SB(0, 0), b2, voffB); PG8_STAGE(PG8_SB(0, 1), b2 + hstepB, voffB); PG8_STAGE(PG8_SA(0, 0), a2, voffA);
            PG8_WAIT_V(8); PG8_WAIT_L(0); PG8_BAR; PG8_MMA(1, 0, At, B0); PG8_MMA(1, 1, At, B1); PG8_BAR; PG8_SCHED;
            PG8_LDB(B0, 1, 0); PG8_LDB(B1, 1, 1); PG8_SCHED; PG8_LDA(At, 1, 0); PG8_STAGE(PG8_SA(0, 1), a2 + hstepA, voffA);
            PG8_WAIT_V(8); PG8_WAIT_L(0); PG8_BAR; PG8_MMA(0, 0, At, B0); PG8_MMA(0, 1, At, B1); PG8_BAR; PG8_SCHED;
            PG8_LDA(At, 1, 1); PG8_STAGE(PG8_SB(1, 0), b3, voffB); PG8_STAGE(PG8_SB(1, 1), b3 + hstepB, voffB); PG8_STAGE(PG8_SA(1, 0), a3, voffA);
            PG8_WAIT_V(8); PG8_WAIT_L(0); PG8_BAR; PG8_MMA(1, 0, At, B0); PG8_MMA(1, 1, At, B1); PG8_BAR; PG8_SCHED;
            } else {
            PG8_LDB(B0, 0, 0); PG8_SCHED; PG8_LDA(At, 0, 0); PG8_STAGE(PG8_SA(1, 1), a1 + hstepA, voffA);
            PG8_WAIT_L(8); PG8_BAR; PG8_WAIT_L(0); PG8_MMA(0, 0, At, B0); PG8_BAR; PG8_SCHED;
            PG8_LDB(B1, 0, 1); PG8_STAGE(PG8_SB(0, 0), b2, voffB);
            PG8_BAR; PG8_WAIT_L(0); PG8_MMA(0, 1, At, B1); PG8_BAR;
            PG8_LDA(At, 0, 1); PG8_STAGE(PG8_SA(0, 0), a2, voffA);
            PG8_BAR; PG8_WAIT_L(0); PG8_MMA(1, 0, At, B0); PG8_BAR; PG8_SCHED;
            PG8_STAGE(PG8_SB(0, 1), b2 + hstepB, voffB);
            PG8_WAIT_V(6); PG8_BAR; PG8_MMA(1, 1, At, B1); PG8_BAR;
            PG8_LDB(B0, 1, 0); PG8_SCHED; PG8_LDA(At, 1, 0); PG8_STAGE(PG8_SA(0, 1), a2 + hstepA, voffA);
            PG8_WAIT_L(8); PG8_BAR; PG8_WAIT_L(0); PG8_MMA(0, 0, At, B0); PG8_BAR; PG8_SCHED;
            PG8_LDB(B1, 1, 1); PG8_STAGE(PG8_SB(1, 0), b3, voffB);
            PG8_BAR; PG8_WAIT_L(0); PG8_MMA(0, 1, At, B1); PG8_BAR;
            PG8_LDA(At, 1, 1); PG8_STAGE(PG8_SA(1, 0), a3, voffA);
            PG8_BAR; PG8_WAIT_L(0); PG8_MMA(1, 0, At, B0); PG8_BAR; PG8_SCHED;
            PG8_STAGE(PG8_SB(1, 1), b3 + hstepB, voffB);
            PG8_WAIT_V(6); PG8_BAR; PG8_MMA(1, 1, At, B1); PG8_BAR;
            }
        }
        if constexpr (FP8) asm volatile("s_nop 15\n\ts_nop 15" ::: "memory");
        if constexpr (ALIGN_EPI) { if (wr == 0) PG8_BAR; }
        if constexpr (!Epi::AFTER_DRAIN) { E(acc, cur, wr, wc, fr, fq); S.done(cur); }
        if (!has_next) break;
#pragma unroll
        for (int a = 0; a < 2; ++a)
#pragma unroll
            for (int b = 0; b < 2; ++b)
#pragma unroll
                for (int m = 0; m < 4; ++m)
#pragma unroll
                    for (int n = 0; n < 2; ++n) acc[a][b][m][n] = (f32x4){0.f, 0.f, 0.f, 0.f};
        cur = nxt; cA = nA; cB = nB; ++ui;
        if constexpr (ALIGN_EPI) { if (wr == 1) PG8_BAR; }
    }
    PG8_WAIT_V(0);
    if constexpr (!ALIGN_EPI) { if (wr == 0) PG8_BAR; }
    PG8_BAR;
    if constexpr (Epi::AFTER_DRAIN) { E.fused(acc, cur, wr, wc, fr, fq, lds, wid, lane); S.done(cur); }
#undef PG8_SA
#undef PG8_SB
#undef PG8_STAGE
#undef PG8_LDA
#undef PG8_LDB
#undef PG8_MMA
#undef PG8_WAIT_V
#undef PG8_WAIT_L
#undef PG8_BAR
#undef PG8_SCHED
}
}

#ifndef PROBE_DUP
#define PROBE_DUP 0
#endif
#ifndef MK_PER_PHASE
#define MK_PER_PHASE 0
#endif
constexpr int D = 1024, NBATCH = 8, SEQ = 4096, NLAT = NBATCH * SEQ, CTXL = 256, NCTX = NBATCH * CTXL, MALL = NLAT + NCTX;
constexpr int RH = 4, RQK = 256, RV = 512;
constexpr int DFF = 2816, NE = 8, DFE = 3584;
constexpr float EPS = 1e-6f;
constexpr float LAMBDA_INIT = 0.3555090675909693f;
constexpr float LOG2E = 1.4426950408889634f;
constexpr int NWAVES = 8, NTHREADS = 512;
constexpr float MOE_WSCALE = 64.0f; constexpr int MOE_SB = 0x79797979, MOE_SA = 0x7f7f7f7f;
constexpr int MOE_ROWS = 2 * NLAT + NE * 256;

enum { I_X = 0, I_C, I_CTX, I_CCTX, I_L0_WMOD, I_L0_BMOD, I_L0_NPREMIX, I_L0_NPOSTMIX, I_L0_NPREFFN, I_L0_NPOSTFFN, I_L0_WIN, I_L0_DECAY, I_L0_WOUT, I_L0_WGU, I_L0_WDN,
       I_L1_WMOD, I_L1_BMOD, I_L1_NPREMIX, I_L1_NPOSTMIX, I_L1_NPREFFN, I_L1_NPOSTFFN, I_L1_WIN, I_L1_LAMBDA, I_L1_SUBLN, I_L1_WOUT, I_L1_RW, I_L1_RB, I_L1_MGU, I_L1_MDN, N_IN };

constexpr size_t MiB = 1u << 20;
constexpr size_t WS_CTL = 0, CTL_ZERO_BYTES = 1 * MiB;
constexpr size_t WS_MODV = 1 * MiB;
constexpr size_t WS_TAB0 = 1 * MiB + 512 * 1024;
constexpr size_t WS_TAB1 = WS_TAB0 + 32 * 1024;
constexpr size_t WS_LAM = WS_TAB1 + 8 * 1024;
constexpr size_t WS_ROUTE = 2 * MiB;
constexpr size_t WS_XCTX = 3 * MiB;
constexpr size_t WS_W0IN = 11 * MiB, WS_W0OUT = 27 * MiB, WS_W0GU = 31 * MiB, WS_W0DN = 42 * MiB, WS_W1IN = 48 * MiB, WS_W1OUT = 54 * MiB, WS_WMGU = 56 * MiB, WS_WMDN = 168 * MiB;
constexpr size_t WS_H = 224 * MiB;
constexpr size_t WS_A = 292 * MiB, WS_B = 564 * MiB;
constexpr size_t WS_OF = WS_B, WS_OB = WS_B + 136 * MiB;
constexpr size_t WS_QH0 = WS_A, WS_KH0 = WS_A + 68 * MiB, WS_VQ0 = WS_A + 136 * MiB;
constexpr size_t WS_QH1 = WS_A, WS_KH1 = WS_A + 68 * MiB, WS_VH1 = WS_A + 136 * MiB;
constexpr size_t WS_HP = WS_A, WS_ACT1 = 424 * MiB, WS_Y1 = WS_A;
constexpr size_t WS_END = 886 * MiB;
static_assert(WS_ACT1 + (size_t)MOE_ROWS * DFE * 2 <= WS_END, "ws map");
static_assert(WS_HP + (size_t)MOE_ROWS * D * 2 <= WS_ACT1, "ws map");
constexpr int CW_TMO = 0;
constexpr int CW_BAR = 4096;
constexpr int CW_XRANK = 12288;
constexpr int CW_MOECNT = 16384;

constexpr int RING_BYTES = 131072;
constexpr int LDS_BYTES = 163840;
constexpr int MISC_OFF = LDS_BYTES - 256;

#define GAS __attribute__((address_space(1)))
#define LAS __attribute__((address_space(3)))
typedef unsigned short bf16;
typedef unsigned v4u __attribute__((ext_vector_type(4)));
typedef unsigned v2u __attribute__((ext_vector_type(2)));
typedef float f32x4 __attribute__((ext_vector_type(4)));
typedef float f32x2 __attribute__((ext_vector_type(2)));
typedef short bf16x8 __attribute__((ext_vector_type(8)));
typedef GAS unsigned gu32;
#define RLX_AGENT __ATOMIC_RELAXED, __HIP_MEMORY_SCOPE_AGENT
#define LDS_WAIT() asm volatile("s_waitcnt lgkmcnt(0)" ::: "memory")
#define VM_WAIT() asm volatile("s_waitcnt vmcnt(0)" ::: "memory")
__device__ __forceinline__ unsigned pk2(float lo, float hi);
__device__ __forceinline__ unsigned f2bf(float f) { return pk2(f, 0.f) & 0xffffu; }
typedef float f32x2_cv __attribute__((ext_vector_type(2))); typedef __bf16 bf16x2_cv __attribute__((ext_vector_type(2)));
__device__ __forceinline__ unsigned pk2(float lo, float hi) { f32x2_cv v = {lo, hi}; bf16x2_cv b = __builtin_convertvector(v, bf16x2_cv); return __builtin_bit_cast(unsigned, b); }
__device__ __forceinline__ float bf2f(unsigned b) { return __builtin_bit_cast(float, b << 16); }
__device__ __forceinline__ float bflo(unsigned w) { return __builtin_bit_cast(float, w << 16); }
__device__ __forceinline__ float bfhi(unsigned w) { return __builtin_bit_cast(float, w & 0xffff0000u); }
__device__ __forceinline__ unsigned pk4_fp8(float a, float b, float c, float d) {
    a = __builtin_fminf(__builtin_fmaxf(a, -448.f), 448.f); b = __builtin_fminf(__builtin_fmaxf(b, -448.f), 448.f); c = __builtin_fminf(__builtin_fmaxf(c, -448.f), 448.f); d = __builtin_fminf(__builtin_fmaxf(d, -448.f), 448.f);
    int w = 0; w = __builtin_amdgcn_cvt_pk_fp8_f32(a, b, w, false); w = __builtin_amdgcn_cvt_pk_fp8_f32(c, d, w, true); return (unsigned)w; }
__device__ __forceinline__ float fast_exp2(float x) { return __builtin_amdgcn_exp2f(x); }
__device__ __forceinline__ float silu_f(float g) { return g * __builtin_amdgcn_rcpf(1.0f + __builtin_amdgcn_exp2f(-g * LOG2E)); }
__device__ __forceinline__ float wave_sum(float v) {
#pragma unroll
    for (int o = 1; o < 64; o <<= 1) v += __shfl_xor(v, o);
    return v;
}

#define XB_TMO      128
#define XB_XCNT(j)  (256  + 64 * (j))
#define XB_XSUB(j)  (1280 + 64 * (j))
#define XB_XGEN(j)  (2304 + 64 * (j))
#define XB_TOP      3328
#define XB_TOPGEN   3392
#define XCD_BAR_WORDS 3456
#define XB_SPIN_CAP (1u << 24)

__device__ __forceinline__ unsigned xb_ld(unsigned* p)              { return __hip_atomic_load(p, __ATOMIC_RELAXED, __HIP_MEMORY_SCOPE_AGENT); }
__device__ __forceinline__ unsigned xb_add(unsigned* p, unsigned v) { return __hip_atomic_fetch_add(p, v, __ATOMIC_RELAXED, __HIP_MEMORY_SCOPE_AGENT); }
__device__ __forceinline__ unsigned xb_xcc_id() { return (unsigned)__builtin_amdgcn_s_getreg((3 << 11) | 20) & 0xFu; }
#define XB_SPIN(cond, bar) do { unsigned _sp = 0; while (cond) { __builtin_amdgcn_s_sleep(1); \
    if ((++_sp & 255u) == 0u) { if (xb_ld(&(bar)[XB_TMO])) break; if (_sp > XB_SPIN_CAP) { atomicAdd(&(bar)[XB_TMO], 1u); break; } } } } while (0)

struct XcdBarrier {
    unsigned* bar; unsigned x;
    volatile LAS unsigned* st;
};

__device__ __forceinline__ XcdBarrier xcd_barrier_post(unsigned* bar, volatile LAS unsigned* st) {
    XcdBarrier b; b.bar = bar; b.x = xb_xcc_id(); b.st = st;
    if (threadIdx.x == 0) (void)xb_add(&bar[XB_XCNT(b.x)], 1u);
    return b;
}
__device__ __forceinline__ void xcd_barrier_complete(unsigned* bar, unsigned x, unsigned& nloc, unsigned& nx) {
    const unsigned G = gridDim.x * gridDim.y * gridDim.z;
    unsigned sum, cnt, mine, sp = 0u;
    for (;;) {
        sum = 0u; cnt = 0u; mine = 0u;
#pragma unroll
        for (unsigned j = 0; j < 16; ++j) { const unsigned c = xb_ld(&bar[XB_XCNT(j)]); sum += c; cnt += (c > 0u) ? 1u : 0u; mine = (j == x) ? c : mine; }
        if (sum == G) break;
        __builtin_amdgcn_s_sleep(1);
        if ((++sp & 255u) == 0u) { if (xb_ld(&bar[XB_TMO])) break; if (sp > XB_SPIN_CAP) { atomicAdd(&bar[XB_TMO], 1u); break; } }
    }
    nloc = mine > 0u ? mine : 1u; nx = cnt > 0u ? cnt : 1u;
}

__device__ __forceinline__ void xcd_barrier(const XcdBarrier& b) {
    asm volatile("s_waitcnt vmcnt(0)" ::: "memory");
    __syncthreads();
    if (threadIdx.x == 0) {
        unsigned* bar = b.bar;
        __builtin_amdgcn_s_waitcnt(0);
        unsigned nloc = b.st[0], nx = b.st[1];
        if (nloc == 0u) { xcd_barrier_complete(bar, b.x, nloc, nx); b.st[0] = nloc; b.st[1] = nx; }
        const unsigned old = xb_add(&bar[XB_XSUB(b.x)], 1u);
        const unsigned gen = old / nloc;
        if (old + 1u == (gen + 1u) * nloc) {
            __builtin_amdgcn_fence(__ATOMIC_RELEASE, "agent");
            asm volatile("s_waitcnt vmcnt(0)" ::: "memory");
            const unsigned og = xb_add(&bar[XB_TOP], 1u);
            const unsigned tg = og / nx;
            if (og + 1u == (tg + 1u) * nx) xb_add(&bar[XB_TOPGEN], 1u);
            else XB_SPIN(xb_ld(&bar[XB_TOPGEN]) == tg, bar);
            __builtin_amdgcn_fence(__ATOMIC_ACQUIRE, "agent");
            xb_add(&bar[XB_XGEN(b.x)], 1u);
            asm volatile("s_waitcnt vmcnt(0)" ::: "memory");
        } else {
            XB_SPIN(xb_ld(&bar[XB_XGEN(b.x)]) == gen, bar);
            __builtin_amdgcn_fence(__ATOMIC_ACQUIRE, "agent");
            asm volatile("s_waitcnt vmcnt(0)" ::: "memory");
        }
    }
    __syncthreads();
}


struct Args { const float* in[N_IN]; float* out; unsigned char* ws; int ph_lo, ph_hi; };

struct Frame {
    LAS unsigned char* lds;
    volatile LAS unsigned* MISC;
    gu32* ctl;
    int tid, lane, wave, vcu, G, cid;
    unsigned char* ws;
};

namespace pg8 {
struct EpiStore {
    static constexpr bool PERM = true, AFTER_DRAIN = false;
    bf16_t* O; int ldc;
    __device__ __forceinline__ void operator()(const f32x4 (&acc)[2][2][4][2], const Unit& u, int wr, int wc, int fr, int fq) const {
        const int row0 = u.pm * BM + wr * 64 + fr; const int col0 = u.pc * BM + wc * 32 + 8 * fq;
#pragma unroll
        for (int ai = 0; ai < 2; ++ai)
#pragma unroll
            for (int m = 0; m < 4; ++m) { bf16_t* rowp = O + (size_t)(row0 + ai * HALF + m * 16) * ldc + col0;
#pragma unroll
                for (int bj = 0; bj < 2; ++bj) { const f32x4 v0 = acc[ai][bj][m][0], v1 = acc[ai][bj][m][1];
                    u32x4 w; w.x = cvt_pk_bf16(v0[0], v0[1]); w.y = cvt_pk_bf16(v0[2], v0[3]); w.z = cvt_pk_bf16(v1[0], v1[1]); w.w = cvt_pk_bf16(v1[2], v1[3]);
                    *(u32x4*)(rowp + bj * HALF) = w; } }
    }
};
struct EpiSwiglu {
    static constexpr bool PERM = true, AFTER_DRAIN = false;
    bf16_t* O; int ldc;
    __device__ __forceinline__ void operator()(const f32x4 (&acc)[2][2][4][2], const Unit& u, int wr, int wc, int fr, int fq) const {
        const int row0 = u.pm * BM + wr * 64 + fr; const int col0 = u.pc * HALF + wc * 32 + 8 * fq;
#pragma unroll
        for (int ai = 0; ai < 2; ++ai)
#pragma unroll
            for (int m = 0; m < 4; ++m) { bf16_t* rowp = O + (size_t)(row0 + ai * HALF + m * 16) * ldc + col0;
                f32x4 a0, a1;
#pragma unroll
                for (int e = 0; e < 4; ++e) { a0[e] = silu_f(acc[ai][0][m][0][e]) * acc[ai][1][m][0][e]; a1[e] = silu_f(acc[ai][0][m][1][e]) * acc[ai][1][m][1][e]; }
                u32x4 w; w.x = cvt_pk_bf16(a0[0], a0[1]); w.y = cvt_pk_bf16(a0[2], a0[3]); w.z = cvt_pk_bf16(a1[0], a1[1]); w.w = cvt_pk_bf16(a1[2], a1[3]);
                *(u32x4*)rowp = w; }
    }
};

struct EpiQKV0 {
    static constexpr bool PERM = true, AFTER_DRAIN = false;
    bf16_t* Qh; bf16_t* Kh; bf16_t* Vq; const float* tab;
    __device__ __forceinline__ void operator()(const f32x4 (&acc)[2][2][4][2], const Unit& u, int wr, int wc, int fr, int fq) const {
        const int row0 = u.pm * BM + wr * 64 + fr, pc = u.pc;
        if (pc < 8) {
            bf16_t* base = pc < 4 ? Qh + (size_t)pc * MALL * 256 : Kh + (size_t)(pc - 4) * MALL * 256; const float sc = pc < 4 ? 1.0f : 0.0625f; const bool lat = u.pm < NLAT / BM;
            const int col0 = wc * 32 + 8 * fq;
#pragma unroll
            for (int ai = 0; ai < 2; ++ai)
#pragma unroll
                for (int m = 0; m < 4; ++m) { const int row = row0 + ai * HALF + m * 16, t = row & (SEQ - 1);
#pragma unroll
                    for (int bj = 0; bj < 2; ++bj) { f32x4 v0 = acc[ai][bj][m][0], v1 = acc[ai][bj][m][1];
                        if (lat) { const int pos = bj ? (t & 63) : (t >> 6); const float* tp = tab + (size_t)(pos * 64 + 16 * wc + 4 * fq) * 2;
                            const f32x4 c0 = *(const f32x4*)tp, c1 = *(const f32x4*)(tp + 4);
                            v0 = (f32x4){v0[0] * c0[0] - v0[1] * c0[1], v0[1] * c0[0] + v0[0] * c0[1], v0[2] * c0[2] - v0[3] * c0[3], v0[3] * c0[2] + v0[2] * c0[3]};
                            v1 = (f32x4){v1[0] * c1[0] - v1[1] * c1[1], v1[1] * c1[0] + v1[0] * c1[1], v1[2] * c1[2] - v1[3] * c1[3], v1[3] * c1[2] + v1[2] * c1[3]}; }
                        v0 = v0 * sc; v1 = v1 * sc;
                        u32x4 w; w.x = cvt_pk_bf16(v0[0], v0[1]); w.y = cvt_pk_bf16(v0[2], v0[3]); w.z = cvt_pk_bf16(v1[0], v1[1]); w.w = cvt_pk_bf16(v1[2], v1[3]);
                        *(u32x4*)(base + (size_t)row * 256 + col0 + bj * HALF) = w; } }
        } else {
#pragma unroll
            for (int ai = 0; ai < 2; ++ai)
#pragma unroll
                for (int m = 0; m < 4; ++m) { const int row = row0 + ai * HALF + m * 16;
#pragma unroll
                    for (int bj = 0; bj < 2; ++bj) { const f32x4 v0 = acc[ai][bj][m][0], v1 = acc[ai][bj][m][1];
                        u32x4 w; w.x = cvt_pk_bf16(v0[0], v0[1]); w.y = cvt_pk_bf16(v0[2], v0[3]); w.z = cvt_pk_bf16(v1[0], v1[1]); w.w = cvt_pk_bf16(v1[2], v1[3]);
                        *(u32x4*)(Vq + ((size_t)((pc - 8) * 2 + bj) * MALL + row) * 128 + wc * 32 + 8 * fq) = w; } }
        }
    }
};
struct EpiQKV1 {
    static constexpr bool PERM = true, AFTER_DRAIN = false;
    bf16_t* Qh; bf16_t* Kh; bf16_t* Vh; const float* tab;
    __device__ __forceinline__ void operator()(const f32x4 (&acc)[2][2][4][2], const Unit& u, int wr, int wc, int fr, int fq) const {
        const int row0 = u.pm * BM + wr * 64 + fr, pc = u.pc;
        if (pc < 8) {
            bf16_t* base = pc < 4 ? Qh : Kh; const float sc = pc < 4 ? 0.125f * LOG2E : 1.0f; const bool lat = u.pm < NLAT / BM;
            const int hf = wc & 1, p0 = 32 * hf + 8 * fq;
#pragma unroll
            for (int ai = 0; ai < 2; ++ai)
#pragma unroll
                for (int m = 0; m < 4; ++m) { const int row = row0 + ai * HALF + m * 16, t = row & (SEQ - 1);
                    const int pos = hf ? (t & 63) : (t >> 6); const float* tp = tab + (size_t)(pos * 16 + 4 * fq) * 2;
                    f32x4 c0 = (f32x4){1.f, 0.f, 1.f, 0.f}, c1 = c0;
                    if (lat) { c0 = *(const f32x4*)tp; c1 = *(const f32x4*)(tp + 4); }
#pragma unroll
                    for (int bj = 0; bj < 2; ++bj) { f32x4 v0 = acc[ai][bj][m][0], v1 = acc[ai][bj][m][1];
                        v0 = (f32x4){v0[0] * c0[0] - v0[1] * c0[1], v0[1] * c0[0] + v0[0] * c0[1], v0[2] * c0[2] - v0[3] * c0[3], v0[3] * c0[2] + v0[2] * c0[3]};
                        v1 = (f32x4){v1[0] * c1[0] - v1[1] * c1[1], v1[1] * c1[0] + v1[0] * c1[1], v1[2] * c1[2] - v1[3] * c1[3], v1[3] * c1[2] + v1[2] * c1[3]};
                        v0 = v0 * sc; v1 = v1 * sc;
                        const int head = (pc & 3) * 4 + 2 * bj + (wc >> 1);
                        u32x4 w; w.x = cvt_pk_bf16(v0[0], v0[1]); w.y = cvt_pk_bf16(v0[2], v0[3]); w.z = cvt_pk_bf16(v1[0], v1[1]); w.w = cvt_pk_bf16(v1[2], v1[3]);
                        *(u32x4*)(base + ((size_t)head * MALL + row) * 64 + p0) = w; } }
        } else {
#pragma unroll
            for (int ai = 0; ai < 2; ++ai)
#pragma unroll
                for (int m = 0; m < 4; ++m) { const int row = row0 + ai * HALF + m * 16;
#pragma unroll
                    for (int bj = 0; bj < 2; ++bj) { const f32x4 v0 = acc[ai][bj][m][0], v1 = acc[ai][bj][m][1];
                        u32x4 w; w.x = cvt_pk_bf16(v0[0], v0[1]); w.y = cvt_pk_bf16(v0[2], v0[3]); w.z = cvt_pk_bf16(v1[0], v1[1]); w.w = cvt_pk_bf16(v1[2], v1[3]);
                        *(u32x4*)(Vh + ((size_t)((pc - 8) * 2 + bj) * MALL + row) * 128 + wc * 32 + 8 * fq) = w; } }
        }
    }
};
struct EpiSwiglu8 {
    static constexpr bool PERM = true, AFTER_DRAIN = false;
    unsigned char* O; int ldc;
    __device__ __forceinline__ void operator()(const f32x4 (&acc)[2][2][4][2], const Unit& u, int wr, int wc, int fr, int fq) const {
        const int row0 = u.pm * BM + wr * 64 + fr; const int col0 = u.pc * HALF + wc * 32 + 8 * fq;
#pragma unroll
        for (int ai = 0; ai < 2; ++ai)
#pragma unroll
            for (int m = 0; m < 4; ++m) { unsigned char* rowp = O + (size_t)(row0 + ai * HALF + m * 16) * ldc + col0;
                f32x4 a0, a1;
#pragma unroll
                for (int e = 0; e < 4; ++e) { a0[e] = silu_f(acc[ai][0][m][0][e]) * acc[ai][1][m][0][e]; a1[e] = silu_f(acc[ai][0][m][1][e]) * acc[ai][1][m][1][e]; }
                v2u w; w.x = pk4_fp8(a0[0], a0[1], a0[2], a0[3]); w.y = pk4_fp8(a1[0], a1[1], a1[2], a1[3]);
                *(v2u*)rowp = w; }
    }
};
struct MoeOrder {
    int nM, nN, nwg, G, c; int t1, t2, t3, t4, t5, t6, t7;
    __device__ bool next(int i, Unit& u) const {
        const long L = (long)i * G + c; if (L >= nwg) return false;
        int wgid = (int)L; { const int q = nwg / NXCD, r = nwg % NXCD, xcd = wgid % NXCD, off = wgid / NXCD; wgid = (xcd < r ? xcd * (q + 1) : r * (q + 1) + (xcd - r) * q) + off; }
        const int nig = WGM * nN, gid = wgid / nig, fm = gid * WGM, gsz = (nM - fm) < WGM ? (nM - fm) : WGM;
        u.pm = fm + ((wgid % nig) % gsz); u.pc = (wgid % nig) / gsz;
        const int e = (u.pm >= t1) + (u.pm >= t2) + (u.pm >= t3) + (u.pm >= t4) + (u.pm >= t5) + (u.pm >= t6) + (u.pm >= t7);
        u.pn = e * nN + u.pc; return true;
    }
    __device__ __forceinline__ void a_ready(const Unit&) const {}
    __device__ __forceinline__ void done(const Unit&) const {}
};
}

__device__ __forceinline__ void p0_transpose_item(const float* W, int K, int N, bf16* WT, int drow0, LAS float* scr, int k0, int n0, int lane, int mode = 0) {
#pragma unroll 8
    for (int i = 0; i < 32; ++i) { const int kk = 2 * i + (lane >> 5); scr[kk * 33 + (lane & 31)] = W[(size_t)(k0 + kk) * N + n0 + (lane & 31)]; }
    LDS_WAIT(); asm volatile("" ::: "memory");
    const int c = lane & 7;
#pragma unroll
    for (int j = 0; j < 4; ++j) { const int n = (lane >> 3) + 8 * j; const LAS float* s = scr + (8 * c) * 33 + n;
        v4u o; o.x = pk2(s[0 * 33], s[1 * 33]); o.y = pk2(s[2 * 33], s[3 * 33]); o.z = pk2(s[4 * 33], s[5 * 33]); o.w = pk2(s[6 * 33], s[7 * 33]);
        const int dr = mode == 0 ? n : (mode == 1 ? 2 * n : 2 * (n & 15) + (n >> 4));
        *(GAS v4u*)(WT + (size_t)(drow0 + dr) * K + k0 + 8 * c) = o; }
    LDS_WAIT(); asm volatile("" ::: "memory");
}
__device__ __forceinline__ void p0_transpose_item8(const float* W, int K, int N, unsigned char* WT, int drow0, LAS float* scr, int k0, int n0, int lane, float wscale) {
#pragma unroll 8
    for (int i = 0; i < 32; ++i) { const int kk = 2 * i + (lane >> 5); scr[kk * 33 + (lane & 31)] = W[(size_t)(k0 + kk) * N + n0 + (lane & 31)]; }
    LDS_WAIT(); asm volatile("" ::: "memory");
    const int n = lane >> 1, kh = (lane & 1) * 32; const LAS float* sp = scr + kh * 33 + n;
    v4u o0, o1;
#pragma unroll
    for (int q = 0; q < 4; ++q) { o0[q] = pk4_fp8(sp[(4 * q) * 33] * wscale, sp[(4 * q + 1) * 33] * wscale, sp[(4 * q + 2) * 33] * wscale, sp[(4 * q + 3) * 33] * wscale);
        o1[q] = pk4_fp8(sp[(16 + 4 * q) * 33] * wscale, sp[(17 + 4 * q) * 33] * wscale, sp[(18 + 4 * q) * 33] * wscale, sp[(19 + 4 * q) * 33] * wscale); }
    GAS v4u* dst = (GAS v4u*)(WT + (size_t)(drow0 + n) * K + k0 + kh); dst[0] = o0; dst[1] = o1;
    LDS_WAIT(); asm volatile("" ::: "memory");
}
__device__ __forceinline__ int swiglu_row(int n0, int F) { const int bj = n0 / F, w = n0 % F; return 256 * (w >> 7) + 128 * bj + (w & 127); }

__device__ __forceinline__ void p0_prologue(Frame& F, const Args& a) {
    LAS float* scr = (LAS float*)(F.lds + F.wave * 16384);
    const int gw = F.vcu * NWAVES + F.wave, NGW = F.G * NWAVES;
    constexpr int I0 = (D / 64) * (8192 / 32), I1 = (2048 / 64) * (D / 32), I2 = (D / 64) * (2 * DFF / 32), I3 = (DFF / 64) * (D / 32), I4 = (D / 64) * (3072 / 32), I5 = (D / 64) * (D / 32);
    constexpr int I6E = (D / 64) * (2 * DFE / 32), I7E = (DFE / 64) * (D / 32);
    constexpr int NITEMS = I0 + I1 + I2 + I3 + I4 + I5 + NE * I6E + NE * I7E;
    for (int it = gw; it < NITEMS; it += NGW) {
        int r = it;
        if (r < I0) { const int nb = r % (8192 / 32), kb = r / (8192 / 32); const int n0 = 32 * nb; int dr0 = n0, md = 0;
            if (n0 < 2048) { const int d0 = n0 & 255, hf = d0 >> 7, e = d0 & 127, sx = e >> 6, i0 = e & 63; dr0 = (n0 - d0) + 2 * (hf * 64 + i0) + sx; md = 1; }
            p0_transpose_item(a.in[I_L0_WIN], D, 8192, (bf16*)(F.ws + WS_W0IN), dr0, scr, 64 * kb, n0, F.lane, md); continue; } r -= I0;
        if (r < I1) { const int nb = r % (D / 32), kb = r / (D / 32); p0_transpose_item(a.in[I_L0_WOUT], 2048, D, (bf16*)(F.ws + WS_W0OUT), 32 * nb, scr, 64 * kb, 32 * nb, F.lane); continue; } r -= I1;
        if (r < I2) { const int nb = r % (2 * DFF / 32), kb = r / (2 * DFF / 32); p0_transpose_item(a.in[I_L0_WGU], D, 2 * DFF, (bf16*)(F.ws + WS_W0GU), swiglu_row(32 * nb, DFF), scr, 64 * kb, 32 * nb, F.lane); continue; } r -= I2;
        if (r < I3) { const int nb = r % (D / 32), kb = r / (D / 32); p0_transpose_item(a.in[I_L0_WDN], DFF, D, (bf16*)(F.ws + WS_W0DN), 32 * nb, scr, 64 * kb, 32 * nb, F.lane); continue; } r -= I3;
        if (r < I4) { const int nb = r % (3072 / 32), kb = r / (3072 / 32); const int n0 = 32 * nb; int dr0 = n0, md = 0;
            if (n0 < 2048) { md = 2; }
            p0_transpose_item(a.in[I_L1_WIN], D, 3072, (bf16*)(F.ws + WS_W1IN), dr0, scr, 64 * kb, n0, F.lane, md); continue; } r -= I4;
        if (r < I5) { const int nb = r % (D / 32), kb = r / (D / 32); p0_transpose_item(a.in[I_L1_WOUT], D, D, (bf16*)(F.ws + WS_W1OUT), 32 * nb, scr, 64 * kb, 32 * nb, F.lane); continue; } r -= I5;
        if (r < NE * I6E) { const int e = r / I6E, rr = r % I6E; const int nb = rr % (2 * DFE / 32), kb = rr / (2 * DFE / 32);
            p0_transpose_item8(a.in[I_L1_MGU] + (size_t)e * D * 2 * DFE, D, 2 * DFE, (unsigned char*)(F.ws + WS_WMGU) + (size_t)e * 2 * DFE * D, swiglu_row(32 * nb, DFE), scr, 64 * kb, 32 * nb, F.lane, MOE_WSCALE); continue; } r -= NE * I6E;
        { const int e = r / I7E, rr = r % I7E; const int nb = rr % (D / 32), kb = rr / (D / 32);
            p0_transpose_item8(a.in[I_L1_MDN] + (size_t)e * DFE * D, DFE, D, (unsigned char*)(F.ws + WS_WMDN) + (size_t)e * D * DFE, 32 * nb, scr, 64 * kb, 32 * nb, F.lane, MOE_WSCALE); }
    }
    __syncthreads();
    {
        LAS float* sc = (LAS float*)F.lds;
        LAS float* part = (LAS float*)(F.lds + 9 * 1024 * 4);
        bool loaded = false;
        for (int grp = F.vcu; grp < 2 * (6 * D / 64); grp += F.G) {
            if (!loaded) { for (int i = F.tid; i < 9 * 1024; i += NTHREADS) { const float cv = (i < 8 * 1024) ? a.in[I_C][i] : a.in[I_CCTX][i - 8 * 1024]; sc[i] = silu_f(cv); } loaded = true; }
            __syncthreads();
            const int layer = grp / (6 * D / 64), cb = (grp % (6 * D / 64)) * 64;
            const float* W = a.in[layer ? I_L1_WMOD : I_L0_WMOD]; const float* bm = a.in[layer ? I_L1_BMOD : I_L0_BMOD];
            const int ks = F.tid >> 6, col = F.tid & 63;
            float acc[9];
#pragma unroll
            for (int b = 0; b < 9; ++b) acc[b] = 0.f;
            for (int k = ks * 128; k < ks * 128 + 128; ++k) { const float w = W[(size_t)k * (6 * D) + cb + col];
#pragma unroll
                for (int b = 0; b < 9; ++b) acc[b] += sc[b * 1024 + k] * w; }
#pragma unroll
            for (int b = 0; b < 9; ++b) part[(ks * 9 + b) * 64 + col] = acc[b];
            __syncthreads();
            for (int o = F.tid; o < 9 * 64; o += NTHREADS) { const int b = o >> 6, cc = o & 63; float s = bm[cb + cc];
#pragma unroll
                for (int k2 = 0; k2 < 8; ++k2) s += part[(k2 * 9 + b) * 64 + cc];
                ((float*)(F.ws + WS_MODV))[((size_t)layer * 9 + b) * (6 * D) + cb + cc] = s; }
            __syncthreads();
        }
    }
    {
        const int gt = F.vcu * NTHREADS + F.tid;
        if (gt < 64 * 64 + 64 * 16) {
            int pos, i; float ex;
            if (gt < 4096) { pos = gt >> 6; i = gt & 63; ex = (float)(2 * i) / 128.0f; } else { const int q = gt - 4096; pos = q >> 4; i = q & 15; ex = (float)(2 * i) / 32.0f; }
            const float freq = __builtin_amdgcn_exp2f(-ex * 13.287712379549449f);
            const float rev = (float)pos * freq * 0.15915494309189535f;
            const float cs = __builtin_amdgcn_cosf(rev), sn = __builtin_amdgcn_sinf(rev);
            f32x2* t = (f32x2*)(F.ws + (gt < 4096 ? WS_TAB0 : WS_TAB1)); t[gt < 4096 ? gt : gt - 4096] = (f32x2){cs, sn};
        }
        if (gt == 0) { const float* lp = a.in[I_L1_LAMBDA]; float s1 = 0.f, s2 = 0.f; for (int i = 0; i < 64; ++i) { s1 += lp[i] * lp[64 + i]; s2 += lp[128 + i] * lp[192 + i]; }
            *(float*)(F.ws + WS_LAM) = __expf(s1) - __expf(s2) + LAMBDA_INIT; }
    }
}

struct RowPass {
    int nrows;
    const float* xin_lat; const float* xin_ctx; float* xout_lat; float* xout_ctx;
    const bf16* br;
    const float* gpost;
    const float* gate;
    const float* gpre;
    const float* shift; const float* scale;
    bf16* hout;
};
template <bool BR, bool MOEBR, bool WH, bool ROUTE, bool H8 = false>
__device__ __forceinline__ void row_pass(Frame& F, const Args& a, const RowPass& P) {
    const int gw = F.vcu * NWAVES + F.wave, NGW = F.G * NWAVES;
    const int l4 = F.lane * 4;
    for (int r = gw; r < P.nrows; r += NGW) {
        const bool lat = r < NLAT; const int rc = lat ? r : r - NLAT; const int midx = lat ? (r >> 12) : 8;
        const float* xin = (lat ? P.xin_lat : P.xin_ctx) + (size_t)rc * D;
        float* xout = (lat ? P.xout_lat : P.xout_ctx) + (size_t)rc * D;
        f32x4 v[4];
#pragma unroll
        for (int j = 0; j < 4; ++j) v[j] = *(const GAS f32x4*)(xin + l4 + 256 * j);
        if constexpr (BR || MOEBR) {
            f32x4 y[4];
            if constexpr (BR) {
#pragma unroll
                for (int j = 0; j < 4; ++j) { const v2u w = *(const GAS v2u*)(P.br + (size_t)r * D + l4 + 256 * j); y[j] = (f32x4){bflo(w.x), bfhi(w.x), bflo(w.y), bfhi(w.y)}; }
            } else {
                const int* tpos = (const int*)(F.ws + WS_ROUTE + (size_t)NLAT * 8); const float* tw = (const float*)(F.ws + WS_ROUTE + (size_t)NLAT * 16);
                const int s0 = tpos[2 * r], s1 = tpos[2 * r + 1]; const float w0 = tw[2 * r], w1 = tw[2 * r + 1];
#pragma unroll
                for (int j = 0; j < 4; ++j) { const v2u p = *(const GAS v2u*)(P.br + (size_t)s0 * D + l4 + 256 * j); const v2u q = *(const GAS v2u*)(P.br + (size_t)s1 * D + l4 + 256 * j);
                    y[j] = (f32x4){w0 * bflo(p.x) + w1 * bflo(q.x), w0 * bfhi(p.x) + w1 * bfhi(q.x), w0 * bflo(p.y) + w1 * bflo(q.y), w0 * bfhi(p.y) + w1 * bfhi(q.y)}; }
            }
            float ss = 0.f;
#pragma unroll
            for (int j = 0; j < 4; ++j) ss += (y[j].x * y[j].x + y[j].y * y[j].y) + (y[j].z * y[j].z + y[j].w * y[j].w);
            const float rstd = 1.0f / sqrtf(wave_sum(ss) * (1.0f / D) + EPS);
#pragma unroll
            for (int j = 0; j < 4; ++j) { const f32x4 gp = *(const GAS f32x4*)(P.gpost + l4 + 256 * j); const f32x4 gt = *(const GAS f32x4*)(P.gate + (size_t)midx * 6 * D + l4 + 256 * j);
                v[j] = v[j] + gt * (y[j] * rstd * gp); }
#pragma unroll
            for (int j = 0; j < 4; ++j) *(GAS f32x4*)(xout + l4 + 256 * j) = v[j];
        }
        if constexpr (WH) {
            float ss = 0.f;
#pragma unroll
            for (int j = 0; j < 4; ++j) ss += (v[j].x * v[j].x + v[j].y * v[j].y) + (v[j].z * v[j].z + v[j].w * v[j].w);
            const float rstd = 1.0f / sqrtf(wave_sum(ss) * (1.0f / D) + EPS);
            f32x4 h[4];
#pragma unroll
            for (int j = 0; j < 4; ++j) { const f32x4 gp = *(const GAS f32x4*)(P.gpre + l4 + 256 * j); const f32x4 sc = *(const GAS f32x4*)(P.scale + (size_t)midx * 6 * D + l4 + 256 * j);
                const f32x4 sh = *(const GAS f32x4*)(P.shift + (size_t)midx * 6 * D + l4 + 256 * j);
                h[j] = (v[j] * rstd * gp) * (1.0f + sc) + sh;
                if constexpr (H8) { *(GAS unsigned*)((unsigned char*)P.hout + (size_t)r * D + l4 + 256 * j) = pk4_fp8(h[j].x, h[j].y, h[j].z, h[j].w); }
                else { v2u w; w.x = pk2(h[j].x, h[j].y); w.y = pk2(h[j].z, h[j].w); *(GAS v2u*)(P.hout + (size_t)r * D + l4 + 256 * j) = w; } }
            if constexpr (ROUTE) {
                const float* rw = a.in[I_L1_RW];
                float lg[8];
#pragma unroll
                for (int e = 0; e < 8; ++e) lg[e] = 0.f;
#pragma unroll
                for (int j = 0; j < 4; ++j)
#pragma unroll
                    for (int q = 0; q < 4; ++q) { const int k = l4 + 256 * j + q; const f32x4 wa = *(const GAS f32x4*)(rw + (size_t)k * 8), wb = *(const GAS f32x4*)(rw + (size_t)k * 8 + 4); const float hv = h[j][q];
                        lg[0] += hv * wa.x; lg[1] += hv * wa.y; lg[2] += hv * wa.z; lg[3] += hv * wa.w; lg[4] += hv * wb.x; lg[5] += hv * wb.y; lg[6] += hv * wb.z; lg[7] += hv * wb.w; }
#pragma unroll
                for (int e = 0; e < 8; ++e) lg[e] = wave_sum(lg[e]) + a.in[I_L1_RB][e];
                float v1 = lg[0]; int i1 = 0;
#pragma unroll
                for (int e = 1; e < 8; ++e) if (lg[e] > v1) { v1 = lg[e]; i1 = e; }
                float v2 = -3.0e38f; int i2 = 0;
#pragma unroll
                for (int e = 0; e < 8; ++e) if (e != i1 && lg[e] > v2) { v2 = lg[e]; i2 = e; }
                const float w1 = 1.0f / (1.0f + __expf(v2 - v1)), w2 = 1.0f - w1;
                if (F.lane == 0) {
                    int* te = (int*)(F.ws + WS_ROUTE); int* tpos = (int*)(F.ws + WS_ROUTE + (size_t)NLAT * 8); float* tw = (float*)(F.ws + WS_ROUTE + (size_t)NLAT * 16);
                    const unsigned p1 = __hip_atomic_fetch_add((unsigned*)(F.ctl + CW_MOECNT + 64 * i1), 1u, RLX_AGENT);
                    const unsigned p2 = __hip_atomic_fetch_add((unsigned*)(F.ctl + CW_MOECNT + 64 * i2), 1u, RLX_AGENT);
                    te[2 * r] = i1; te[2 * r + 1] = i2; tpos[2 * r] = (int)p1; tpos[2 * r + 1] = (int)p2; tw[2 * r] = w1; tw[2 * r + 1] = w2;
                }
            }
        }
    }
}

__device__ __forceinline__ void merge_pass(Frame& F) {
    const bf16* zg = (const bf16*)(F.ws + WS_A); bf16* of = (bf16*)(F.ws + WS_OF); const bf16* ob = (const bf16*)(F.ws + WS_OB);
    const int gw = F.vcu * NWAVES + F.wave, NGW = F.G * NWAVES;
    for (int r = gw; r < MALL; r += NGW) {
#pragma unroll
        for (int h = 0; h < RH; ++h) {
            const size_t o = (size_t)r * 2048 + h * 512 + F.lane * 8;
            const v4u a = *(const GAS v4u*)(of + o), b = *(const GAS v4u*)(ob + o);
            const v4u gf = *(const GAS v4u*)(zg + (size_t)r * 4096 + h * 512 + F.lane * 8), gb = *(const GAS v4u*)(zg + (size_t)r * 4096 + 2048 + h * 512 + F.lane * 8);
            float av[8], bv[8], gfv[8], gbv[8];
#pragma unroll
            for (int q = 0; q < 4; ++q) { av[2 * q] = bflo(a[q]); av[2 * q + 1] = bfhi(a[q]); bv[2 * q] = bflo(b[q]); bv[2 * q + 1] = bfhi(b[q]);
                gfv[2 * q] = bflo(gf[q]); gfv[2 * q + 1] = bfhi(gf[q]); gbv[2 * q] = bflo(gb[q]); gbv[2 * q + 1] = bfhi(gb[q]); }
            float sa = 0.f, sb = 0.f;
#pragma unroll
            for (int q = 0; q < 8; ++q) { sa += av[q] * av[q]; sb += bv[q] * bv[q]; }
            const float ra = 1.0f / sqrtf(wave_sum(sa) * (1.0f / RV) + EPS), rb = 1.0f / sqrtf(wave_sum(sb) * (1.0f / RV) + EPS);
            float y[8];
#pragma unroll
            for (int q = 0; q < 8; ++q) y[q] = silu_f(gfv[q]) * (av[q] * ra) + silu_f(gbv[q]) * (bv[q] * rb);
            v4u w; w.x = pk2(y[0], y[1]); w.y = pk2(y[2], y[3]); w.z = pk2(y[4], y[5]); w.w = pk2(y[6], y[7]);
            *(GAS v4u*)(of + o) = w;
        }
    }
}


namespace att {
using s16x4  = __attribute__((ext_vector_type(4))) short;
using f32x16 = __attribute__((ext_vector_type(16))) float;
using u32x4  = __attribute__((ext_vector_type(4))) unsigned;
constexpr int KVBLK = 64, NT = (SEQ + CTXL) / KVBLK;
constexpr int SHM_V = KVBLK * 128 * 2, SHM_K = KVBLK * 64 * 2;
constexpr int OFF_V = 0, OFF_K = 2 * SHM_V, OFF_WS = OFF_K + 2 * SHM_K, OFF_O1 = OFF_WS + NWAVES * 64 * 4, ATT_LDS = OFF_O1 + NWAVES * 8192;
constexpr float THR = 8.0f;
#define ATT_SBAR() __builtin_amdgcn_sched_barrier(0)
#define KSWZ64(row, colB) ((row) * 128 + ((colB) ^ ((((row) >> 1) & 7) << 4)))
__device__ __forceinline__ int crow(int r, int hi) { return (r & 3) + 8 * (r >> 2) + 4 * hi; }
__device__ __forceinline__ unsigned cvtpk(float lo, float hi) { unsigned r; asm volatile("v_cvt_pk_bf16_f32 %0, %1, %2" : "=v"(r) : "v"(lo), "v"(hi)); return r; }

__device__ __forceinline__ void partialSM(f32x16& p0, f32x16& p1, float& m_reg, float& alpha) {
    float pmax = p0[0];
#pragma unroll
    for (int r = 1; r < 16; ++r) pmax = fmaxf(pmax, p0[r]);
#pragma unroll
    for (int r = 0; r < 16; ++r) pmax = fmaxf(pmax, p1[r]);
    { auto rr = __builtin_amdgcn_permlane32_swap(__float_as_uint(pmax), __float_as_uint(pmax), false, false); pmax = fmaxf(__uint_as_float(rr[0]), __uint_as_float(rr[1])); }
    float mn;
    if (__builtin_expect(__all(pmax - m_reg <= THR), 1)) { mn = m_reg; alpha = 1.f; }
    else { mn = fmaxf(m_reg, pmax); alpha = __builtin_amdgcn_exp2f(m_reg - mn); m_reg = mn; }
#pragma unroll
    for (int r = 0; r < 16; ++r) p0[r] = p0[r] - mn;
#pragma unroll
    for (int r = 0; r < 16; ++r) p1[r] = p1[r] - mn;
#pragma unroll
    for (int r = 0; r < 16; ++r) p0[r] = __builtin_amdgcn_exp2f(p0[r]);
}
__device__ __forceinline__ void finishSM(f32x16& p0, f32x16& p1, float alpha, float& l_reg, bf16x8& pa0, bf16x8& pa1, bf16x8& pa2, bf16x8& pa3) {
#pragma unroll
    for (int r = 0; r < 16; ++r) p1[r] = __builtin_amdgcn_exp2f(p1[r]);
    float ps = 0;
#pragma unroll
    for (int r = 0; r < 16; ++r) ps += p0[r];
#pragma unroll
    for (int r = 0; r < 16; ++r) ps += p1[r];
    { auto rr = __builtin_amdgcn_permlane32_swap(__float_as_uint(ps), __float_as_uint(ps), false, false); ps = __uint_as_float(rr[0]) + __uint_as_float(rr[1]); }
    l_reg = l_reg * alpha + ps;
#define ATT_PK4(P, BASE, OUT) do { unsigned a0 = cvtpk(P[BASE + 0], P[BASE + 1]), a1 = cvtpk(P[BASE + 2], P[BASE + 3]);   \
    unsigned b0 = cvtpk(P[BASE + 4], P[BASE + 5]), b1 = cvtpk(P[BASE + 6], P[BASE + 7]);                              \
    auto r0 = __builtin_amdgcn_permlane32_swap(a0, b0, false, false); auto r1 = __builtin_amdgcn_permlane32_swap(a1, b1, false, false); \
    u32x4 w = {r0[0], r1[0], r0[1], r1[1]}; OUT = *reinterpret_cast<bf16x8*>(&w); } while (0)
    ATT_PK4(p0, 0, pa0); ATT_PK4(p0, 8, pa1); ATT_PK4(p1, 0, pa2); ATT_PK4(p1, 8, pa3);
#undef ATT_PK4
}
__device__ __forceinline__ void qkt(f32x16& p0, f32x16& p1, const char* Ks, const bf16x8* qr, int r32, int hi) {
    p0 = f32x16{}; p1 = f32x16{};
#pragma unroll
    for (int d0 = 0; d0 < 4; ++d0) { const int cb = (d0 * 16 + hi * 8) * 2;
        const bf16x8 b0 = *reinterpret_cast<const bf16x8*>(Ks + KSWZ64(r32, cb));
        const bf16x8 b1 = *reinterpret_cast<const bf16x8*>(Ks + KSWZ64(32 + r32, cb));
        p0 = __builtin_amdgcn_mfma_f32_32x32x16_bf16(b0, qr[d0], p0, 0, 0, 0);
        p1 = __builtin_amdgcn_mfma_f32_32x32x16_bf16(b1, qr[d0], p1, 0, 0, 0); }
}
__device__ __forceinline__ int v_st(int k, int c) { const int kk = (k & ~0xC) | ((k & 4) << 1) | ((k & 8) >> 1); return ((kk >> 3) * 4 + (c >> 5)) * 512 + ((kk & 7) * 32 + (c & 31)) * 2; }
__device__ __forceinline__ int v_rd_base(int lane) { return ((lane & 3) << 3) | (((lane >> 2) & 3) << 6) | (((lane >> 4) & 1) << 5) | (((lane >> 5) & 1) << 8); }
constexpr int v_rd_off(int d0, int ks, int half) { return d0 * 512 + ks * 4096 + half * 2048; }
template <int OFF> __device__ __forceinline__ s16x4 tr_read(int vb) { s16x4 r; asm volatile("ds_read_b64_tr_b16 %0, %1 offset:%2" : "=&v"(r) : "v"(vb), "i"(OFF) : "memory"); return r; }
template <int D0> __device__ __forceinline__ void pv_one(f32x16& od, int vb, bf16x8 pa0, bf16x8 pa1, bf16x8 pa2, bf16x8 pa3) {
    const s16x4 l0 = tr_read<v_rd_off(D0, 0, 0)>(vb), h0 = tr_read<v_rd_off(D0, 0, 1)>(vb), l1 = tr_read<v_rd_off(D0, 1, 0)>(vb), h1 = tr_read<v_rd_off(D0, 1, 1)>(vb);
    const s16x4 l2 = tr_read<v_rd_off(D0, 2, 0)>(vb), h2 = tr_read<v_rd_off(D0, 2, 1)>(vb), l3 = tr_read<v_rd_off(D0, 3, 0)>(vb), h3 = tr_read<v_rd_off(D0, 3, 1)>(vb);
    asm volatile("s_waitcnt lgkmcnt(0)" ::: "memory"); ATT_SBAR();
#define ATT_PK(L, H) (bf16x8){L[0], L[1], L[2], L[3], H[0], H[1], H[2], H[3]}
    od = __builtin_amdgcn_mfma_f32_32x32x16_bf16(pa0, ATT_PK(l0, h0), od, 0, 0, 0);
    od = __builtin_amdgcn_mfma_f32_32x32x16_bf16(pa1, ATT_PK(l1, h1), od, 0, 0, 0);
    od = __builtin_amdgcn_mfma_f32_32x32x16_bf16(pa2, ATT_PK(l2, h2), od, 0, 0, 0);
    od = __builtin_amdgcn_mfma_f32_32x32x16_bf16(pa3, ATT_PK(l3, h3), od, 0, 0, 0);
#undef ATT_PK
}
__device__ __forceinline__ void pv_d0(f32x16* o, int vb, bf16x8 pa0, bf16x8 pa1, bf16x8 pa2, bf16x8 pa3) {
    pv_one<0>(o[0], vb, pa0, pa1, pa2, pa3); pv_one<1>(o[1], vb, pa0, pa1, pa2, pa3); pv_one<2>(o[2], vb, pa0, pa1, pa2, pa3); pv_one<3>(o[3], vb, pa0, pa1, pa2, pa3);
}
__device__ __forceinline__ size_t kvrow(int b, int t) { return t < 64 ? (size_t)b * SEQ + (size_t)t * 64 : (size_t)NLAT + (size_t)b * CTXL + (size_t)(t - 64) * 64; }

__device__ __forceinline__ void head_pass(const bf16* __restrict__ Q1, const bf16* __restrict__ K1, const bf16* __restrict__ V1, int b, int qh, int hp, size_t qrow0, char* lds, f32x16 (&o)[4], float& l_out) {
    int tid_ = threadIdx.x; asm volatile("" : "+v"(tid_));
    const int tid = tid_, wid = tid >> 6, lane = tid & 63, r32 = lane & 31, hi = lane >> 5;
    char* V_lds = lds + OFF_V; char* K_lds = lds + OFF_K;
    float* wsf = (float*)(lds + OFF_WS) + wid * 64; float* al_l = wsf + 32;
    float m_reg = -1e30f, l_reg = 0.f;
#pragma unroll
    for (int d = 0; d < 4; ++d) o[d] = f32x16{};
    bf16x8 qr[4];
    const bf16* Qw = Q1 + ((size_t)qh * MALL + qrow0 + wid * 32 + r32) * 64 + hi * 8;
#pragma unroll
    for (int d0 = 0; d0 < 4; ++d0) qr[d0] = *reinterpret_cast<const bf16x8*>(Qw + d0 * 16);
    const bf16* Kh = K1 + (size_t)qh * MALL * 64; const bf16* Vh = V1 + (size_t)hp * MALL * 128;
    const int sr = tid >> 4, sc = (tid & 15) * 8, vst0 = v_st(sr, sc), vst1 = v_st(32 + sr, sc);
    const int kr = tid >> 3, kc = (tid & 7) * 8, kst = KSWZ64(kr, kc * 2);
    const int vb0 = (int)(uintptr_t)V_lds + v_rd_base(lane);
    struct { bf16x8 vs0, vs1, ks; } sr_[2];
#define ATT_SLOAD(i, t) do { const size_t rb_ = kvrow(b, (t)); sr_[i].vs0 = *reinterpret_cast<const bf16x8*>(&Vh[(rb_ + sr) * 128 + sc]); sr_[i].vs1 = *reinterpret_cast<const bf16x8*>(&Vh[(rb_ + 32 + sr) * 128 + sc]); \
    sr_[i].ks = *reinterpret_cast<const bf16x8*>(&Kh[(rb_ + kr) * 64 + kc]); } while (0)
#define ATT_SWRITE(bu, i) do { *(bf16x8*)(V_lds + (bu) * SHM_V + vst0) = sr_[i].vs0; *(bf16x8*)(V_lds + (bu) * SHM_V + vst1) = sr_[i].vs1; *(bf16x8*)(K_lds + (bu) * SHM_K + kst) = sr_[i].ks; } while (0)
#define ATT_SWAIT() asm volatile("s_waitcnt vmcnt(3)" ::: "memory")
#define ATT_RESC(al) do { if (__any((al) < 1.f)) { if (hi == 0) al_l[r32] = (al); asm volatile("s_waitcnt lgkmcnt(0)" ::: "memory"); \
    _Pragma("unroll") for (int d = 0; d < 4; ++d) _Pragma("unroll") for (int r = 0; r < 16; ++r) o[d][r] *= al_l[crow(r, hi)]; } } while (0)
    f32x16 pA0, pA1, pB0, pB1; float alA, alB; bf16x8 pa0, pa1, pa2, pa3;
    ATT_SLOAD(0, 0); asm volatile("s_waitcnt vmcnt(0)" ::: "memory"); ATT_SWRITE(0, 0); __syncthreads();
    qkt(pA0, pA1, K_lds, qr, r32, hi); partialSM(pA0, pA1, m_reg, alA);
    ATT_SLOAD(1, 1); ATT_SLOAD(0, 2);
    ATT_SWAIT(); ATT_SWRITE(1, 1); __syncthreads();
    for (int j = 1; j + 1 < NT; j += 2) {
        ATT_SBAR(); qkt(pB0, pB1, K_lds + SHM_K, qr, r32, hi);
        finishSM(pA0, pA1, alA, l_reg, pa0, pa1, pa2, pa3); ATT_SBAR();
        ATT_SLOAD(1, j + 2); ATT_SBAR();
        pv_d0(o, vb0, pa0, pa1, pa2, pa3); partialSM(pB0, pB1, m_reg, alB);
        __syncthreads(); ATT_SWAIT(); ATT_SWRITE(0, 0);
        ATT_RESC(alB); __syncthreads();
        ATT_SBAR(); qkt(pA0, pA1, K_lds, qr, r32, hi);
        finishSM(pB0, pB1, alB, l_reg, pa0, pa1, pa2, pa3); ATT_SBAR();
        if (j + 3 < NT) ATT_SLOAD(0, j + 3); ATT_SBAR();
        pv_d0(o, vb0 + SHM_V, pa0, pa1, pa2, pa3); partialSM(pA0, pA1, m_reg, alA);
        __syncthreads(); ATT_SWAIT(); ATT_SWRITE(1, 1);
        ATT_RESC(alA); __syncthreads();
    }
    ATT_SBAR(); qkt(pB0, pB1, K_lds + SHM_K, qr, r32, hi);
    finishSM(pA0, pA1, alA, l_reg, pa0, pa1, pa2, pa3); ATT_SBAR();
    pv_d0(o, vb0, pa0, pa1, pa2, pa3); partialSM(pB0, pB1, m_reg, alB);
    __syncthreads(); ATT_RESC(alB);
    finishSM(pB0, pB1, alB, l_reg, pa0, pa1, pa2, pa3); ATT_SBAR();
    pv_d0(o, vb0 + SHM_V, pa0, pa1, pa2, pa3);
    l_out = l_reg;
#undef ATT_SLOAD
#undef ATT_SWRITE
#undef ATT_SWAIT
#undef ATT_RESC
}

__device__ __forceinline__ void attn_unit(const bf16* __restrict__ Q1, const bf16* __restrict__ K1, const bf16* __restrict__ V1, bf16* __restrict__ ao, int b, int hp, int qb, char* lds, const float* lamp, const float* subln) {
    int tid_ = threadIdx.x; asm volatile("" : "+v"(tid_));
    const int tid = tid_, wid = tid >> 6, lane = tid & 63, r32 = lane & 31, hi = lane >> 5;
    float* wsf = (float*)(lds + OFF_WS) + wid * 64;
    unsigned* o1s = (unsigned*)(lds + OFF_O1 + wid * 8192);
    const size_t qrow0 = (size_t)b * SEQ + (size_t)qb * 256;
    f32x16 o[4]; float l;
    float ssq[16];
#pragma unroll 1
    for (int hh = 0; hh < 2; ++hh) {
        head_pass(Q1, K1, V1, b, 2 * hp + hh, hp, qrow0, lds, o, l);
        if (hi == 0) wsf[r32] = l; asm volatile("s_waitcnt lgkmcnt(0)" ::: "memory");
        float rli[16];
#pragma unroll
        for (int r = 0; r < 16; ++r) { rli[r] = __builtin_amdgcn_rcpf(wsf[crow(r, hi)]); ssq[r] = 0.f; }
        if (hh == 0) {
#pragma unroll
            for (int d0 = 0; d0 < 4; ++d0)
#pragma unroll
                for (int r = 0; r < 16; r += 2) o1s[(d0 * 8 + (r >> 1)) * 64 + lane] = cvtpk(o[d0][r] * rli[r], o[d0][r + 1] * rli[r + 1]);
            __syncthreads();
        } else {
            asm volatile("" : "+s"(lamp)); const float lam = *lamp;
#pragma unroll
            for (int d0 = 0; d0 < 4; ++d0)
#pragma unroll
                for (int r = 0; r < 16; r += 2) { const unsigned w = o1s[(d0 * 8 + (r >> 1)) * 64 + lane];
                    const float a0 = bflo(w) - lam * (o[d0][r] * rli[r]), a1 = bfhi(w) - lam * (o[d0][r + 1] * rli[r + 1]);
                    o[d0][r] = a0; o[d0][r + 1] = a1; ssq[r] += a0 * a0; ssq[r + 1] += a1 * a1; }
        }
    }
#pragma unroll
    for (int r = 0; r < 16; ++r) { float s = ssq[r];
        s += __shfl_xor(s, 1); s += __shfl_xor(s, 2); s += __shfl_xor(s, 4); s += __shfl_xor(s, 8); s += __shfl_xor(s, 16);
        ssq[r] = 1.0f / sqrtf(s * (1.0f / 128.0f) + EPS) * (1.0f - LAMBDA_INIT); }
    asm volatile("s_waitcnt lgkmcnt(0)" ::: "memory");
    bf16* stg = (bf16*)o1s;
    asm volatile("" : "+s"(subln));
#pragma unroll
    for (int d0 = 0; d0 < 4; ++d0) { const float g = subln[d0 * 32 + r32];
#pragma unroll
        for (int r = 0; r < 16; ++r) stg[crow(r, hi) * 128 + d0 * 32 + r32] = (bf16)f2bf(o[d0][r] * ssq[r] * g); }
    asm volatile("s_waitcnt lgkmcnt(0)" ::: "memory");
    bf16* Ow = ao + (qrow0 + wid * 32) * D + hp * 128;
#pragma unroll
    for (int i = 0; i < 8; ++i) { const int row = i * 4 + (lane >> 4), ch = lane & 15; const u32x4 v = *(const u32x4*)(stg + row * 128 + ch * 8); *(u32x4*)(Ow + (size_t)row * D + ch * 8) = v; }
    asm volatile("s_waitcnt lgkmcnt(0)" ::: "memory");
    __syncthreads();
}
#undef ATT_SBAR
}

__device__ __forceinline__ void attn_phase(Frame& F, const Args& a) {
    const bf16* Q1 = (const bf16*)(F.ws + WS_QH1); const bf16* K1 = (const bf16*)(F.ws + WS_KH1); const bf16* V1 = (const bf16*)(F.ws + WS_VH1); bf16* ao = (bf16*)(F.ws + WS_B);
    const float* lamp = (const float*)(F.ws + WS_LAM);
    for (int unit = F.vcu; unit < NBATCH * 8 * 16; unit += F.G) {
        const int qb = unit & 15, hp = (unit >> 4) & 7, b = unit >> 7;
        att::attn_unit(Q1, K1, V1, ao, b, hp, qb, (char*)F.lds, lamp, a.in[I_L1_SUBLN]);
    }
}


namespace ret {
using s16x4  = __attribute__((ext_vector_type(4))) short;
using f32x16 = __attribute__((ext_vector_type(16))) float;
typedef short v4i16_t __attribute__((ext_vector_type(4)));
constexpr int C = 32, NSTEP = (SEQ + CTXL) / C;
constexpr int ST_Q = 0, ST_K = 16384, ST_V = 32768, ST_SC = 40960, ST_BYTES = 43008, NSTAGE = 3;
constexpr int XBUF_OFF = NSTAGE * ST_BYTES, RET_LDS = XBUF_OFF + NWAVES * 4096;
constexpr size_t WS_SSQ = 836 * MiB;
constexpr size_t WS_SC = 842 * MiB;

__device__ __forceinline__ void glds16(const void* gsrc, unsigned lds_dst) { unsigned keep;
    asm volatile("s_mov_b32 %0, m0\n\ts_mov_b32 m0, %2\n\ts_nop 0\n\tglobal_load_lds_dwordx4 %1, off\n\ts_mov_b32 m0, %0" : "=&s"(keep) : "v"(gsrc), "s"(lds_dst) : "memory"); }
__device__ __forceinline__ s16x4 vtr(const LAS char* p) { return __builtin_bit_cast(s16x4, __builtin_amdgcn_ds_read_tr16_b64_v4i16((LAS v4i16_t*)p)); }

__device__ __forceinline__ void ret_scores(Frame& F) {
    const bf16* Qh = (const bf16*)(F.ws + WS_QH0); const bf16* Kh = (const bf16*)(F.ws + WS_KH0); bf16* sc = (bf16*)(F.ws + WS_SC);
    const int gw = F.vcu * NWAVES + F.wave, NGW = F.G * NWAVES;
    const int r32 = F.lane & 31, hh = F.lane >> 5;
    for (int task = gw; task < (MALL / C) * RH; task += NGW) {
        const int h = task & 3, ch = task >> 2;
        const bf16* qp = Qh + ((size_t)h * MALL + (size_t)ch * C + r32) * 256 + hh * 8;
        const bf16* kp = Kh + ((size_t)h * MALL + (size_t)ch * C + r32) * 256 + hh * 8;
        f32x16 acc = f32x16{};
        bf16x8 a[16], b[16];
#pragma unroll
        for (int s = 0; s < 16; ++s) { a[s] = *reinterpret_cast<const bf16x8*>(qp + s * 16); b[s] = *reinterpret_cast<const bf16x8*>(kp + s * 16); }
#pragma unroll
        for (int s = 0; s < 16; ++s) acc = __builtin_amdgcn_mfma_f32_32x32x16_bf16(a[s], b[s], acc, 0, 0, 0);
        bf16* tp = sc + (size_t)task * 1024;
#pragma unroll
        for (int r = 0; r < 16; ++r) { const int i = (r & 3) + 8 * (r >> 2) + 4 * hh; tp[i * 32 + r32] = (bf16)f2bf(acc[r]); }
    }
}

__device__ __forceinline__ size_t step_row0(int b, int dir, int t) {
    if (t < 8) { const int blk = dir ? 7 - t : t; return (size_t)NLAT + (size_t)b * CTXL + (size_t)blk * C; }
    const int blk = dir ? 127 - (t - 8) : (t - 8); return (size_t)b * SEQ + (size_t)blk * C;
}

__device__ __forceinline__ void ret_scan(Frame& F, const Args& a) {
    const char* qb = (const char*)(F.ws + WS_QH0); const char* kb = (const char*)(F.ws + WS_KH0); const char* vb = (const char*)(F.ws + WS_VQ0); const char* scb = (const char*)(F.ws + WS_SC);
    for (int unit = F.vcu; unit < NBATCH * RH * 2 * 4; unit += F.G) {
        int tid_ = threadIdx.x; asm volatile("" : "+v"(tid_));
        const int tid = tid_, lane = tid & 63, w = __builtin_amdgcn_readfirstlane(tid >> 6), dh = w >> 2, vs = w & 3, r32 = lane & 31, hh = lane >> 5;
        const int vq = unit & 3, dir = (unit >> 2) & 1, h = (unit >> 3) & 3, b = unit >> 5;
        const float logit = a.in[I_L0_DECAY][dir * RH + h];
        const float lg2 = -__builtin_amdgcn_logf(1.0f + __builtin_amdgcn_exp2f(-logit * LOG2E));
        const float gC = __builtin_amdgcn_exp2f(lg2 * (float)C);
        float kd[2][8];
#pragma unroll
        for (int s = 0; s < 2; ++s)
#pragma unroll
            for (int jj = 0; jj < 8; ++jj) { const int j = 16 * s + 8 * hh + jj; kd[s][jj] = __builtin_amdgcn_exp2f(lg2 * (float)(dir ? j : 31 - j)); }
        const int om = 4 * w + (lane >> 4);
        const float rsc = __builtin_amdgcn_exp2f(-lg2 * (float)(dir ? om : 31 - om));
        unsigned pm[4];
#pragma unroll
        for (int e = 0; e < 4; ++e) { const int j0 = 16 * dh + 8 * hh + 2 * e, j1 = j0 + 1; const bool k0 = dir ? (j0 >= r32) : (j0 <= r32), k1 = dir ? (j1 >= r32) : (j1 <= r32);
            pm[e] = (k0 ? 0x0000ffffu : 0u) | (k1 ? 0xffff0000u : 0u); }
        unsigned offq[2], offk[2];
#pragma unroll
        for (int p = 0; p < 2; ++p) { const int i = 2 * (2 * w + p) + (lane >> 5), cp = lane & 31;
            offq[p] = (unsigned)(i * 512 + ((cp ^ (i & 15)) << 4)); offk[p] = (unsigned)(i * 512 + ((cp ^ ((i & 3) << 2)) << 4)); }
        unsigned offv; { const int j = 4 * w + (lane >> 4), cp = lane & 15; offv = (unsigned)(j * 256 + ((cp ^ ((j & 3) << 2)) << 4)); }
        const char* qhb = qb + (size_t)h * MALL * 512; const char* khb = kb + (size_t)h * MALL * 512; const char* vhb = vb + (size_t)(h * 4 + vq) * MALL * 256;
        unsigned offs; { const int i = 16 * (w & 1) + (lane >> 2), cp = lane & 3; offs = (unsigned)(i * 64 + ((cp ^ ((i >> 2) & 3)) << 4)); }
        LAS unsigned char* L = F.lds;
        const unsigned lbase = (unsigned)(uintptr_t)L;
#define RET_ISSUE(t_) do { const int t__ = (t_); const unsigned sb_ = lbase + (unsigned)((t__ % NSTAGE) * ST_BYTES); const size_t r0_ = step_row0(b, dir, t__); const char* gq_ = qhb + r0_ * 512; const char* gk_ = khb + r0_ * 512; const char* gv_ = vhb + r0_ * 256; \
        glds16(gq_ + offq[0], (unsigned)__builtin_amdgcn_readfirstlane(sb_ + ST_Q + (2 * w) * 1024)); \
        glds16(gq_ + offq[1], (unsigned)__builtin_amdgcn_readfirstlane(sb_ + ST_Q + (2 * w + 1) * 1024)); \
        glds16(gk_ + offk[0], (unsigned)__builtin_amdgcn_readfirstlane(sb_ + ST_K + (2 * w) * 1024)); \
        glds16(gk_ + offk[1], (unsigned)__builtin_amdgcn_readfirstlane(sb_ + ST_K + (2 * w + 1) * 1024)); \
        glds16(gv_ + offv, (unsigned)__builtin_amdgcn_readfirstlane(sb_ + ST_V + w * 1024)); \
        if (w < 2) glds16(scb + ((r0_ >> 5) * 4 + h) * 2048 + offs, (unsigned)__builtin_amdgcn_readfirstlane(sb_ + ST_SC + w * 1024)); } while (0)
        const int qrow = ST_Q + r32 * 512; const int qx = r32 & 15;
        const int G = lane >> 4, il = lane & 15, tq = il >> 2, tp = il & 3;
        const int kcolb = (128 * dh + 16 * (G & 1) + 8 * (tp & 1) + 4 * (tp >> 1)) * 2;
        const int vcolb = (32 * vs + 16 * (G & 1) + 4 * tp) * 2;
        f32x16 S[4];
#pragma unroll
        for (int T = 0; T < 4; ++T) S[T] = f32x16{};
        bf16* outp = (bf16*)(F.ws + (dir ? WS_OB : WS_OF));
        LAS float* xb_mine = (LAS float*)(L + XBUF_OFF + w * 4096);
        float* ssqp = (float*)(F.ws + WS_SSQ);

        __builtin_amdgcn_s_barrier();
        RET_ISSUE(0); RET_ISSUE(1);
        for (int t = 0; t < NSTEP; ++t) {
            if (t == 0) { if (w < 2) asm volatile("s_waitcnt vmcnt(6)" ::: "memory"); else asm volatile("s_waitcnt vmcnt(5)" ::: "memory"); }
            else if (t == NSTEP - 1) asm volatile("s_waitcnt vmcnt(4)" ::: "memory");
            else        { if (w < 2) asm volatile("s_waitcnt vmcnt(8)" ::: "memory"); else asm volatile("s_waitcnt vmcnt(7)" ::: "memory"); }
            __builtin_amdgcn_s_barrier(); asm volatile("" ::: "memory");
            if (t + 2 < NSTEP) RET_ISSUE(t + 2);
            const LAS char* sb = (const LAS char*)(L + (t % NSTAGE) * ST_BYTES);
            bf16x8 vd[2];
#pragma unroll
            for (int s = 0; s < 2; ++s) {
                const int j0 = 16 * s + 8 * (G >> 1) + tq;
                const int cph = (((vcolb >> 4) ^ (tq << 2)) << 4) + (vcolb & 8);
                const s16x4 lo = vtr(sb + ST_V + j0 * 256 + cph), hi = vtr(sb + ST_V + (j0 + 4) * 256 + cph);
                float f[8];
#pragma unroll
                for (int e = 0; e < 4; ++e) { f[e] = bf2f((unsigned short)lo[e]) * kd[s][e]; f[4 + e] = bf2f((unsigned short)hi[e]) * kd[s][4 + e]; }
                v4u pk; pk.x = pk2(f[0], f[1]); pk.y = pk2(f[2], f[3]); pk.z = pk2(f[4], f[5]); pk.w = pk2(f[6], f[7]);
                vd[s] = __builtin_bit_cast(bf16x8, pk);
            }
#pragma unroll
            for (int T = 0; T < 4; ++T) S[T] = S[T] * gC;
            f32x16 acc = f32x16{};
#pragma unroll
            for (int T = 0; T < 4; ++T)
#pragma unroll
                for (int s = 0; s < 2; ++s) {
                    const int cL = 16 * dh + 4 * T + 2 * s + hh;
                    const bf16x8 qa = *(const LAS bf16x8*)(sb + qrow + ((cL ^ qx) << 4));
                    v4u pk; pk.x = pk2(S[T][8 * s + 0], S[T][8 * s + 1]); pk.y = pk2(S[T][8 * s + 2], S[T][8 * s + 3]); pk.z = pk2(S[T][8 * s + 4], S[T][8 * s + 5]); pk.w = pk2(S[T][8 * s + 6], S[T][8 * s + 7]);
                    acc = __builtin_amdgcn_mfma_f32_32x32x16_bf16(qa, __builtin_bit_cast(bf16x8, pk), acc, 0, 0, 0);
                }
            {
                const int cL = 2 * dh + hh;
                v4u pw = *(const LAS v4u*)(sb + ST_SC + r32 * 64 + ((cL ^ ((r32 >> 2) & 3)) << 4));
                pw.x &= pm[0]; pw.y &= pm[1]; pw.z &= pm[2]; pw.w &= pm[3];
                acc = __builtin_amdgcn_mfma_f32_32x32x16_bf16(__builtin_bit_cast(bf16x8, pw), dh ? vd[1] : vd[0], acc, 0, 0, 0);
            }
#pragma unroll
            for (int T = 0; T < 4; ++T)
#pragma unroll
                for (int s = 0; s < 2; ++s) {
                    const int j0 = 16 * s + 8 * (G >> 1) + tq;
                    const int cb = kcolb + 64 * T;
                    const int cph = (((cb >> 4) ^ (tq << 2)) << 4) + (cb & 8);
                    const s16x4 lo = vtr(sb + ST_K + j0 * 512 + cph), hi = vtr(sb + ST_K + (j0 + 4) * 512 + cph);
                    const bf16x8 ka = (bf16x8){lo[0], lo[1], lo[2], lo[3], hi[0], hi[1], hi[2], hi[3]};
                    S[T] = __builtin_amdgcn_mfma_f32_32x32x16_bf16(ka, vd[s], S[T], 0, 0, 0);
                }
#pragma unroll
            for (int r = 0; r < 16; ++r) xb_mine[r * 64 + lane] = acc[r];
            asm volatile("s_waitcnt lgkmcnt(0)" ::: "memory");
            __builtin_amdgcn_s_barrier(); asm volatile("" ::: "memory");
            {
                const int v0 = (lane & 15) * 8, svs = v0 >> 5, c32 = v0 & 31, rr = (om & 3) + 4 * (om >> 3), sh = (om >> 2) & 1;
                const LAS float* p0 = (const LAS float*)(L + XBUF_OFF + svs * 4096) + rr * 64 + sh * 32 + c32;
                const LAS float* p1 = (const LAS float*)(L + XBUF_OFF + (4 + svs) * 4096) + rr * 64 + sh * 32 + c32;
                const f32x4 a0 = *(const LAS f32x4*)p0, a1 = *(const LAS f32x4*)(p0 + 4), b0 = *(const LAS f32x4*)p1, b1 = *(const LAS f32x4*)(p1 + 4);
                const f32x4 o0 = (a0 + b0) * rsc, o1 = (a1 + b1) * rsc;
                float ss = (o0.x * o0.x + o0.y * o0.y) + (o0.z * o0.z + o0.w * o0.w) + (o1.x * o1.x + o1.y * o1.y) + (o1.z * o1.z + o1.w * o1.w);
                ss += __shfl_xor(ss, 1); ss += __shfl_xor(ss, 2); ss += __shfl_xor(ss, 4); ss += __shfl_xor(ss, 8);
                const size_t r0 = step_row0(b, dir, t);
                v4u pk; pk.x = pk2(o0.x, o0.y); pk.y = pk2(o0.z, o0.w); pk.z = pk2(o1.x, o1.y); pk.w = pk2(o1.z, o1.w);
                *(GAS v4u*)(outp + (r0 + om) * 2048 + h * 512 + vq * 128 + v0) = pk;
                if ((lane & 15) == 0) ssqp[(((r0 + om) * RH + h) * 2 + dir) * 4 + vq] = ss;
            }
            asm volatile("s_waitcnt lgkmcnt(0)" ::: "memory");
        }
        asm volatile("s_waitcnt vmcnt(0)" ::: "memory");
#undef RET_ISSUE
    }
    __builtin_amdgcn_s_barrier();
}
}

__device__ __forceinline__ void moe_counts(Frame& F, int (&cnt)[NE]) {
#pragma unroll
    for (int e = 0; e < NE; ++e) cnt[e] = __builtin_amdgcn_readfirstlane((int)__hip_atomic_load((unsigned*)(F.ctl + CW_MOECNT + 64 * e), RLX_AGENT));
}
__device__ __forceinline__ void moe_gather(Frame& F) {
    int cnt[NE]; moe_counts(F, cnt);
    int base[NE]; int acc = 0;
#pragma unroll
    for (int e = 0; e < NE; ++e) { base[e] = acc; acc += (cnt[e] + 255) & ~255; }
    const int* te = (const int*)(F.ws + WS_ROUTE); int* tpos = (int*)(F.ws + WS_ROUTE + (size_t)NLAT * 8);
    const bf16* hb = (const bf16*)(F.ws + WS_H); bf16* hp = (bf16*)(F.ws + WS_HP);
    const int gw = F.vcu * NWAVES + F.wave, NGW = F.G * NWAVES;
    for (int r = gw; r < NLAT; r += NGW) {
        const int e0 = te[2 * r], e1 = te[2 * r + 1]; const int p0 = tpos[2 * r], p1 = tpos[2 * r + 1];
        int b0 = 0, b1 = 0;
#pragma unroll
        for (int e = 0; e < NE; ++e) { b0 = (e0 == e) ? base[e] : b0; b1 = (e1 == e) ? base[e] : b1; }
        const int s0 = b0 + p0, s1 = b1 + p1;
        const v4u x0 = *(const GAS v4u*)((const unsigned char*)hb + (size_t)r * D + F.lane * 16);
        *(GAS v4u*)((unsigned char*)hp + (size_t)s0 * D + F.lane * 16) = x0; *(GAS v4u*)((unsigned char*)hp + (size_t)s1 * D + F.lane * 16) = x0;
        if (F.lane == 0) { tpos[2 * r] = s0; tpos[2 * r + 1] = s1; }
    }
}
__device__ __forceinline__ void moe_order(Frame& F, pg8::MoeOrder& S, int nN) {
    int cnt[NE]; moe_counts(F, cnt);
    int ts[NE + 1]; ts[0] = 0;
#pragma unroll
    for (int e = 0; e < NE; ++e) ts[e + 1] = ts[e] + ((cnt[e] + 255) >> 8);
    S.nM = ts[NE]; S.nN = nN; S.nwg = S.nM * nN; S.G = F.G; S.c = F.cid;
    S.t1 = ts[1]; S.t2 = ts[2]; S.t3 = ts[3]; S.t4 = ts[4]; S.t5 = ts[5]; S.t6 = ts[6]; S.t7 = ts[7];
}

constexpr int N_PHASES = 22;
__global__ void __launch_bounds__(NTHREADS, 2) fwd(Args args) {
    extern __shared__ __attribute__((aligned(16))) unsigned char lds[];
    Frame F;
    F.lds = (LAS unsigned char*)lds; F.MISC = (volatile LAS unsigned*)(F.lds + MISC_OFF);
    F.tid = threadIdx.x; F.lane = F.tid & 63; F.wave = __builtin_amdgcn_readfirstlane(F.tid >> 6);
    F.G = gridDim.x; { const int bx = blockIdx.x; F.vcu = (F.G % 8 == 0) ? (bx % 8) * (F.G / 8) + bx / 8 : bx; F.cid = bx; }
    F.ws = args.ws; F.ctl = (gu32*)(args.ws + WS_CTL);
    for (int u = F.tid; u < 64; u += NTHREADS) ((LAS unsigned*)(F.lds + MISC_OFF))[u] = 0u;
    __syncthreads();
#if MK_PER_PHASE
    XcdBarrier bar; bar.bar = (unsigned*)(F.ctl + CW_BAR); bar.x = 0; bar.st = nullptr;
#define GRID_BAR() do { } while (0)
#else
    XcdBarrier bar = xcd_barrier_post((unsigned*)(F.ctl + CW_BAR), F.MISC + 8);
#define GRID_BAR() xcd_barrier(bar)
    if (F.tid == 0) { const unsigned x = xb_xcc_id(); F.MISC[16] = x; F.MISC[17] = __hip_atomic_fetch_add((unsigned*)(F.ctl + CW_XRANK + 64 * x), 1u, RLX_AGENT); }
#endif
    const int lo = args.ph_lo, hi = args.ph_hi;
#define IN(k) (lo <= (k) && (k) < hi)
#define SEAM(k) do { if (IN(k) && IN((k) + 1)) GRID_BAR(); } while (0)
    unsigned char* ws = args.ws;
    float* modv = (float*)(ws + WS_MODV);
    float* modv1 = modv + 9 * 6 * D;
    bf16* hbuf = (bf16*)(ws + WS_H);
    float* xctx = (float*)(ws + WS_XCTX);
    using pg8::Gemm; using pg8::StaticOrder;

    if (IN(0)) { for (int rep_ = 0; rep_ < ((PROBE_DUP & 1) ? 2 : 1); ++rep_) { p0_prologue(F, args); __syncthreads(); } SEAM(0); }
#if !MK_PER_PHASE
    if (IN(0) && IN(1)) {
        if (F.tid == 0) { const unsigned x = F.MISC[16]; unsigned pre = 0;
            for (unsigned j = 0; j < 16; ++j) { const unsigned c = __hip_atomic_load((unsigned*)(F.ctl + CW_XRANK + 64 * j), RLX_AGENT); pre += (j < x) ? c : 0u; }
            F.MISC[18] = pre + F.MISC[17]; }
        __syncthreads();
        F.vcu = __builtin_amdgcn_readfirstlane((int)F.MISC[18]); F.cid = (F.G % 8 == 0) ? (F.vcu % (F.G / 8)) * 8 + F.vcu / (F.G / 8) : F.vcu;
    }
#endif
    if (IN(1)) { RowPass P{MALL, args.in[I_X], args.in[I_CTX], nullptr, nullptr, nullptr, nullptr, nullptr, args.in[I_L0_NPREMIX], modv + 0 * D, modv + 1 * D, hbuf};
        row_pass<false, false, true, false>(F, args, P); SEAM(1); }
    if (IN(2)) { Gemm g{hbuf, (const bf16*)(ws + WS_W0IN), MALL, 4096, D, D}; StaticOrder S; S.init(MALL, 4096, F.G, F.cid);
        pg8::EpiQKV0 E{(bf16*)(ws + WS_QH0), (bf16*)(ws + WS_KH0), (bf16*)(ws + WS_VQ0), (const float*)(ws + WS_TAB0)};
        for (int rep_ = 0; rep_ < ((PROBE_DUP & 2) ? 2 : 1); ++rep_) { pg8::gemm_phase<pg8::EpiQKV0, StaticOrder, true, true>(F.lds, g, S, E); } if (IN(2) && IN(4)) GRID_BAR(); }
    if (IN(4)) { ret::ret_scores(F); SEAM(4); }
    if (IN(5)) { for (int rep_ = 0; rep_ < ((PROBE_DUP & 8) ? 2 : 1); ++rep_) ret::ret_scan(F, args); SEAM(5); }
    if (IN(6)) { Gemm g{hbuf, (const bf16*)(ws + WS_W0IN) + (size_t)4096 * D, MALL, 4096, D, D}; StaticOrder S; S.init(MALL, 4096, F.G, F.cid);
        pg8::EpiStore E{(bf16*)(ws + WS_A), 4096};
        for (int rep_ = 0; rep_ < ((PROBE_DUP & 2) ? 2 : 1); ++rep_) { pg8::gemm_phase<pg8::EpiStore, StaticOrder, true, true>(F.lds, g, S, E); } SEAM(6); }
    if (IN(7)) { merge_pass(F); SEAM(7); }
    if (IN(8)) { Gemm g{(const bf16*)(ws + WS_OF), (const bf16*)(ws + WS_W0OUT), MALL, D, 2048, 2048}; StaticOrder S; S.init(MALL, D, F.G, F.cid);
        pg8::EpiStore E{(bf16*)(ws + WS_A), D};
        for (int rep_ = 0; rep_ < ((PROBE_DUP & 2) ? 2 : 1); ++rep_) { pg8::gemm_phase<pg8::EpiStore, StaticOrder, true, true>(F.lds, g, S, E); } SEAM(8); }
    if (IN(9)) { RowPass P{MALL, args.in[I_X], args.in[I_CTX], args.out, xctx, (const bf16*)(ws + WS_A), args.in[I_L0_NPOSTMIX], modv + 2 * D, args.in[I_L0_NPREFFN], modv + 3 * D, modv + 4 * D, hbuf};
        row_pass<true, false, true, false>(F, args, P); SEAM(9); }
    if (IN(10)) { Gemm g{hbuf, (const bf16*)(ws + WS_W0GU), MALL, 2 * DFF, D, D}; StaticOrder S; S.init(MALL, 2 * DFF, F.G, F.cid);
        pg8::EpiSwiglu E{(bf16*)(ws + WS_B), DFF};
        for (int rep_ = 0; rep_ < ((PROBE_DUP & 2) ? 2 : 1); ++rep_) { pg8::gemm_phase<pg8::EpiSwiglu, StaticOrder, true, true>(F.lds, g, S, E); } SEAM(10); }
    if (IN(11)) { Gemm g{(const bf16*)(ws + WS_B), (const bf16*)(ws + WS_W0DN), MALL, D, DFF, DFF}; StaticOrder S; S.init(MALL, D, F.G, F.cid);
        pg8::EpiStore E{(bf16*)(ws + WS_A), D};
        for (int rep_ = 0; rep_ < ((PROBE_DUP & 2) ? 2 : 1); ++rep_) { pg8::gemm_phase<pg8::EpiStore, StaticOrder, true, true>(F.lds, g, S, E); } SEAM(11); }
    if (IN(12)) { RowPass P{MALL, args.out, xctx, args.out, xctx, (const bf16*)(ws + WS_A), args.in[I_L0_NPOSTFFN], modv + 5 * D, args.in[I_L1_NPREMIX], modv1 + 0 * D, modv1 + 1 * D, hbuf};
        row_pass<true, false, true, false>(F, args, P); SEAM(12); }
    if (IN(13)) { Gemm g{hbuf, (const bf16*)(ws + WS_W1IN), MALL, 3072, D, D}; StaticOrder S; S.init(MALL, 3072, F.G, F.cid);
        pg8::EpiQKV1 E{(bf16*)(ws + WS_QH1), (bf16*)(ws + WS_KH1), (bf16*)(ws + WS_VH1), (const float*)(ws + WS_TAB1)};
        for (int rep_ = 0; rep_ < ((PROBE_DUP & 2) ? 2 : 1); ++rep_) { pg8::gemm_phase<pg8::EpiQKV1, StaticOrder, true, true>(F.lds, g, S, E); } if (IN(13) && IN(15)) GRID_BAR(); }
    if (IN(15)) { for (int rep_ = 0; rep_ < ((PROBE_DUP & 4) ? 2 : 1); ++rep_) attn_phase(F, args); SEAM(15); }
    if (IN(16)) { Gemm g{(const bf16*)(ws + WS_B), (const bf16*)(ws + WS_W1OUT), NLAT, D, D, D}; StaticOrder S; S.init(NLAT, D, F.G, F.cid);
        pg8::EpiStore E{(bf16*)(ws + WS_A), D};
        for (int rep_ = 0; rep_ < ((PROBE_DUP & 2) ? 2 : 1); ++rep_) { pg8::gemm_phase<pg8::EpiStore, StaticOrder, true, true>(F.lds, g, S, E); } SEAM(16); }
    if (IN(17)) { RowPass P{NLAT, args.out, xctx, args.out, xctx, (const bf16*)(ws + WS_A), args.in[I_L1_NPOSTMIX], modv1 + 2 * D, args.in[I_L1_NPREFFN], modv1 + 3 * D, modv1 + 4 * D, hbuf};
        row_pass<true, false, true, true, true>(F, args, P); SEAM(17); }
    if (IN(18)) { moe_gather(F); SEAM(18); }
    if (IN(19)) { Gemm g{(const bf16*)(ws + WS_HP), (const bf16*)(ws + WS_WMGU), MOE_ROWS, 2 * DFE, D / 2, D / 2, MOE_SA, MOE_SB}; pg8::MoeOrder S; moe_order(F, S, 2 * DFE / 256);
        pg8::EpiSwiglu8 E{(unsigned char*)(ws + WS_ACT1), DFE};
        for (int rep_ = 0; rep_ < ((PROBE_DUP & 16) ? 2 : 1); ++rep_) { pg8::gemm_phase<pg8::EpiSwiglu8, pg8::MoeOrder, true, true, true>(F.lds, g, S, E); } SEAM(19); }
    if (IN(20)) { Gemm g{(const bf16*)(ws + WS_ACT1), (const bf16*)(ws + WS_WMDN), MOE_ROWS, D, DFE / 2, DFE / 2, MOE_SA, MOE_SB}; pg8::MoeOrder S; moe_order(F, S, D / 256);
        pg8::EpiStore E{(bf16*)(ws + WS_Y1), D};
        for (int rep_ = 0; rep_ < ((PROBE_DUP & 16) ? 2 : 1); ++rep_) { pg8::gemm_phase<pg8::EpiStore, pg8::MoeOrder, true, true, true>(F.lds, g, S, E); } SEAM(20); }
    if (IN(21)) { RowPass P{NLAT, args.out, xctx, args.out, xctx, (const bf16*)(ws + WS_Y1), args.in[I_L1_NPOSTFFN], modv1 + 5 * D, nullptr, nullptr, nullptr, nullptr};
        row_pass<false, true, false, false>(F, args, P); }
#undef IN
#undef SEAM
}

extern "C" void kernel_launch(void* const* d_in, const int* in_sizes, int n_in, void* d_out, int out_size, void* d_ws, size_t ws_size, hipStream_t stream) {
    static int grid = 0;
    if (grid == 0) {
        if (n_in != N_IN || out_size != NLAT * D || ws_size < WS_END) { fprintf(stderr, "kernel_launch: unexpected shapes n_in %d out %d ws %zu\n", n_in, out_size, ws_size); grid = -1; return; }
        int dev = 0, cus = 0, per_cu = 0;
        if (hipGetDevice(&dev) != hipSuccess || hipDeviceGetAttribute(&cus, hipDeviceAttributeMultiprocessorCount, dev) != hipSuccess) { grid = -1; return; }
        if (hipFuncSetAttribute((const void*)fwd, hipFuncAttributeMaxDynamicSharedMemorySize, LDS_BYTES) != hipSuccess) { fprintf(stderr, "kernel_launch: hipFuncSetAttribute failed\n"); grid = -1; return; }
        if (hipOccupancyMaxActiveBlocksPerMultiprocessor(&per_cu, (const void*)fwd, NTHREADS, LDS_BYTES) != hipSuccess || per_cu < 1) fprintf(stderr, "kernel_launch: occupancy query says %d\n", per_cu);
        (void)hipGetLastError();
        grid = cus;
    }
    if (grid < 0) return;
    (void)hipMemsetAsync((char*)d_ws + WS_CTL, 0, CTL_ZERO_BYTES, stream);
    Args a{};
    for (int i = 0; i < N_IN; ++i) a.in[i] = (const float*)d_in[i];
    a.out = (float*)d_out; a.ws = (unsigned char*)d_ws;
#if MK_PER_PHASE
    for (int p = 0; p < N_PHASES; ++p) { a.ph_lo = p; a.ph_hi = p + 1; hipLaunchKernelGGL(fwd, dim3(grid), dim3(NTHREADS), LDS_BYTES, stream, a); }
#else
    a.ph_lo = 0; a.ph_hi = N_PHASES; hipLaunchKernelGGL(fwd, dim3(grid), dim3(NTHREADS), LDS_BYTES, stream, a);
#endif
}
```

```cpp
#include <hip/hip_runtime.h>
#include <cstdio>
#include <cstdint>
namespace pg8 {
#define PG8_LAS __attribute__((address_space(3)))
typedef unsigned short bf16_t;
typedef short bf16x8 __attribute__((ext_vector_type(8)));
typedef float f32x4 __attribute__((ext_vector_type(4)));
typedef unsigned u32x4 __attribute__((ext_vector_type(4)));
constexpr int BM = 256, BK = 64, HALF = 128, HTB = HALF * BK * 2  , STAGE_BYTES = 8 * HTB, NXCD = 8, WGM = 8;

__host__ __device__ __forceinline__ int lds_byte(int r, int c) { const int st = (r >> 4) * 2 + (c >> 5), rr = r & 15, cc = c & 31, ob = rr * 64 + cc * 2; return st * 1024 + (ob ^ (((ob >> 9) & 1) << 5)); }
__host__ __device__ __forceinline__ void stage_rc(int b, int& R, int& C) { const int st = b / 1024, sb = b % 1024, swz = sb ^ (((sb >> 9) & 1) << 5); R = (st >> 1) * 16 + swz / 64; C = (st & 1) * 32 + (swz % 64) / 2; }
__host__ __device__ __forceinline__ int perm32(int rho) { const int n = rho >> 4, i = rho & 15; return 8 * (i >> 2) + 4 * n + (i & 3); }

struct Unit { int pm, pn, pc, k0, nt, ks; };
struct Gemm { const bf16_t* A; const bf16_t* Bt; int M, N, K, lda; int sA, sB; };

struct StaticOrder {
    int nM, nN, nwg, G, c;
    __host__ __device__ void init(int M, int N, int G_, int c_) { nM = M / BM; nN = N / BM; nwg = nM * nN; G = G_; c = c_; }
    __host__ __device__ bool next(int i, Unit& u) const {
        const long L = (long)i * G + c; if (L >= nwg) return false;
        int wgid = (int)L; { const int q = nwg / NXCD, r = nwg % NXCD, xcd = wgid % NXCD, off = wgid / NXCD; wgid = (xcd < r ? xcd * (q + 1) : r * (q + 1) + (xcd - r) * q) + off; }
        const int nig = WGM * nN, gid = wgid / nig, fm = gid * WGM, gsz = (nM - fm) < WGM ? (nM - fm) : WGM;
        u.pm = fm + ((wgid % nig) % gsz); u.pn = (wgid % nig) / gsz; u.pc = u.pn; u.k0 = 0; u.nt = 0; u.ks = -1; return true;
    }
    __device__ __forceinline__ void a_ready(const Unit&) const {}
    __device__ __forceinline__ void done(const Unit&) const {}
};

__device__ __forceinline__ unsigned cvt_pk_bf16(float lo, float hi) { unsigned r; asm volatile("v_cvt_pk_bf16_f32 %0, %1, %2" : "=v"(r) : "v"(lo), "v"(hi)); return r; }
typedef float f32x2 __attribute__((ext_vector_type(2)));
typedef int v4i_t __attribute__((ext_vector_type(4))); typedef int v8i_t __attribute__((ext_vector_type(8)));
template <class Epi, class Sched, bool ALIGN_EPI = false, bool SP2 = false, bool FP8 = false>
__device__ __forceinline__ void gemm_phase(PG8_LAS unsigned char* lds, const Gemm g, const Sched& S, const Epi& E) {
    const int tid = threadIdx.x, wid = __builtin_amdgcn_readfirstlane(tid >> 6), lane = tid & 63, wr = wid >> 2, wc = wid & 3, fr = lane & 15, fq = lane >> 4;
    const int K = g.K; int nt = K / BK;
    unsigned voffA[2], voffB[2];
#pragma unroll
    for (int i = 0; i < 2; ++i) { int R, C; stage_rc(tid * 16 + i * 8192, R, C); const int Rb = Epi::PERM ? ((R & ~31) + perm32(R & 31)) : R;
        voffA[i] = (unsigned)(R * g.lda + C) * 2u; voffB[i] = (unsigned)(Rb * K + C) * 2u; }
    const size_t kstep = (size_t)(BK * 2);
    const size_t hstepA = (size_t)HALF * g.lda * 2, hstepB = (size_t)HALF * K * 2;
    const size_t tstepA = 2 * hstepA, tstepB = 2 * hstepB;
    const unsigned ldsw = (unsigned)wid * 1024u;
    const int aoff = lds_byte(wr * 64 + fr, fq * 8), boff = lds_byte(wc * 32 + fr, fq * 8);
#define PG8_SA(b, h) (((b) * 2 + (h)) * HTB)
#define PG8_SB(b, h) ((4 + (b) * 2 + (h)) * HTB)
#define PG8_STAGE(bufoff, gbase, voff) do { _Pragma("unroll") for (int _i = 0; _i < 2; ++_i) \
        __builtin_amdgcn_global_load_lds((const unsigned*)((const char*)(gbase) + (voff)[_i]), (PG8_LAS unsigned*)(lds + (bufoff) + ldsw + _i * 8192), 16, 0, 0); } while (0)
#define PG8_LDA(dst, b, h) do { if constexpr (FP8) { _Pragma("unroll") for (int m = 0; m < 4; ++m) { const v4i_t lo_ = *(const PG8_LAS v4i_t*)(lds + PG8_SA(b, h) + aoff + m * 2048), hi_ = *(const PG8_LAS v4i_t*)(lds + PG8_SA(b, h) + aoff + m * 2048 + 1024); \
        dst##8[m] = __builtin_shufflevector(lo_, hi_, 0, 1, 2, 3, 4, 5, 6, 7); } } \
    else { _Pragma("unroll") for (int m = 0; m < 4; ++m) _Pragma("unroll") for (int k = 0; k < 2; ++k) dst[m][k] = *(const PG8_LAS bf16x8*)(lds + PG8_SA(b, h) + aoff + m * 2048 + k * 1024); } } while (0)
#define PG8_LDB(dst, b, h) do { if constexpr (FP8) { _Pragma("unroll") for (int n = 0; n < 2; ++n) { const v4i_t lo_ = *(const PG8_LAS v4i_t*)(lds + PG8_SB(b, h) + boff + n * 2048), hi_ = *(const PG8_LAS v4i_t*)(lds + PG8_SB(b, h) + boff + n * 2048 + 1024); \
        dst##8[n] = __builtin_shufflevector(lo_, hi_, 0, 1, 2, 3, 4, 5, 6, 7); } } \
    else { _Pragma("unroll") for (int n = 0; n < 2; ++n) _Pragma("unroll") for (int k = 0; k < 2; ++k) dst[n][k] = *(const PG8_LAS bf16x8*)(lds + PG8_SB(b, h) + boff + n * 2048 + k * 1024); } } while (0)
#define PG8_MMA(ai, bj, At, Bt) do { __builtin_amdgcn_s_setprio(1); _Pragma("unroll") for (int m = 0; m < 4; ++m) _Pragma("unroll") for (int n = 0; n < 2; ++n) { \
        if constexpr (FP8) { asm volatile("v_mfma_scale_f32_16x16x128_f8f6f4 %0, %1, %2, %0, %3, %4 op_sel_hi:[0,0,0]" : "+v"(acc[ai][bj][m][n]) : "v"(Bt##8[n]), "v"(At##8[m]), "v"(sB_), "v"(sA_)); } \
        else { _Pragma("unroll") for (int k = 0; k < 2; ++k) acc[ai][bj][m][n] = __builtin_amdgcn_mfma_f32_16x16x32_bf16(Bt[n][k], At[m][k], acc[ai][bj][m][n], 0, 0, 0); } } \
        __builtin_amdgcn_s_setprio(0); } while (0)
#define PG8_WAIT_V(n) asm volatile("s_waitcnt vmcnt(" #n ")" ::: "memory")
#define PG8_WAIT_L(n) asm volatile("s_waitcnt lgkmcnt(" #n ")" ::: "memory")
#define PG8_BAR __builtin_amdgcn_s_barrier()
#define PG8_SCHED __builtin_amdgcn_sched_barrier(0)
    Unit cur, nxt; int ui = 0;
    if (!S.next(0, cur)) return;
    const int sA_ = g.sA, sB_ = g.sB;
    f32x4 acc[2][2][4][2];
#pragma unroll
    for (int a = 0; a < 2; ++a)
#pragma unroll
        for (int b = 0; b < 2; ++b)
#pragma unroll
            for (int m = 0; m < 4; ++m)
#pragma unroll
                for (int n = 0; n < 2; ++n) acc[a][b][m][n] = (f32x4){0.f, 0.f, 0.f, 0.f};
    bf16x8 At[4][2], B0[2][2], B1[2][2]; v8i_t At8[4], B08[2], B18[2];
    if (cur.nt) nt = cur.nt;
    const char* cA = (const char*)g.A + (size_t)cur.pm * tstepA + (size_t)cur.k0 * 2; const char* cB = (const char*)g.Bt + (size_t)cur.pn * tstepB + (size_t)cur.k0 * 2;
    S.a_ready(cur);
    if constexpr (SP2) {
        PG8_STAGE(PG8_SB(0, 0), cB, voffB); PG8_STAGE(PG8_SB(0, 1), cB + hstepB, voffB); PG8_STAGE(PG8_SA(0, 0), cA, voffA); PG8_STAGE(PG8_SA(0, 1), cA + hstepA, voffA);
        if (wr == 1) PG8_BAR;
        PG8_WAIT_V(2); PG8_BAR;
        PG8_STAGE(PG8_SB(1, 0), cB + kstep, voffB); PG8_STAGE(PG8_SA(1, 0), cA + kstep, voffA); PG8_STAGE(PG8_SB(1, 1), cB + hstepB + kstep, voffB);
        PG8_WAIT_V(6); PG8_BAR;
    } else {
        PG8_STAGE(PG8_SB(0, 0), cB, voffB); PG8_STAGE(PG8_SA(0, 0), cA, voffA); PG8_STAGE(PG8_SB(0, 1), cB + hstepB, voffB); PG8_STAGE(PG8_SA(0, 1), cA + hstepA, voffA);
        if (wr == 1) PG8_BAR;
        PG8_WAIT_V(4); PG8_BAR;
        PG8_STAGE(PG8_SB(1, 0), cB + kstep, voffB); PG8_STAGE(PG8_SA(1, 0), cA + kstep, voffA); PG8_STAGE(PG8_SB(1, 1), cB + hstepB + kstep, voffB);
        PG8_WAIT_V(6); PG8_BAR;
    }
    for (;;) {
        const bool has_next = S.next(ui + 1, nxt);
        const char* nA = has_next ? (const char*)g.A + (size_t)nxt.pm * tstepA + (size_t)nxt.k0 * 2 : cA; const char* nB = has_next ? (const char*)g.Bt + (size_t)nxt.pn * tstepB + (size_t)nxt.k0 * 2 : cB;
#pragma unroll 1
        for (int t = 0; t < nt; t += 2) {
            const bool last = (t == nt - 2);
            const char* a1 = cA + (size_t)(t + 1) * kstep;
            const char* a2 = last ? nA : cA + (size_t)(t + 2) * kstep; const char* b2 = last ? nB : cB + (size_t)(t + 2) * kstep;
            const char* a3 = a2 + kstep; const char* b3 = b2 + kstep;
            if (last && has_next) S.a_ready(nxt);
            if constexpr (SP2) {
            PG8_LDB(B0, 0, 0); PG8_LDB(B1, 0, 1); PG8_SCHED; PG8_LDA(At, 0, 0); PG8_STAGE(PG8_SA(1, 1), a1 + hstepA, voffA);
            PG8_WAIT_V(8); PG8_WAIT_L(0); PG8_BAR; PG8_MMA(0, 0, At, B0); PG8_MMA(0, 1, At, B1); PG8_BAR; PG8_SCHED;
            PG8_LDA(At, 0, 1); PG8_STAGE(PG8_SB(0, 0), b2, voffB); PG8_STAGE(PG8_SB(0, 1), b2 + hstepB, voffB); PG8_STAGE(PG8_SA(0, 0), a2, voffA);
            PG8_WAIT_V(8); PG8_WAIT_L(0); PG8_BAR; PG8_MMA(1, 0, At, B0); PG8_MMA(1, 1, At, B1); PG8_BAR; PG8_SCHED;
            PG8_LDB(B0, 1, 0); PG8_LDB(B1, 1, 1); PG8_SCHED; PG8_LDA(At, 1, 0); PG8_STAGE(PG8_SA(0, 1), a2 + hstepA, voffA);
            PG8_WAIT_V(8); PG8_WAIT_L(0); PG8_BAR; PG8_MMA(0, 0, At, B0); PG8_MMA(0, 1, At, B1); PG8_BAR; PG8_SCHED;
            PG8_LDA(At, 1, 1); PG8_STAGE(PG8_SB(1, 0), b3, voffB); PG8_STAGE(PG8_SB(1, 1), b3 + hstepB, voffB); PG8_STAGE(PG8_SA(1, 0), a3, voffA);
            PG8_WAIT_V(8); PG8_WAIT_L(0); PG8_BAR; PG8_MMA(1, 0, At, B0); PG8_MMA(1, 1, At, B1); PG8_BAR; PG8_SCHED;
            } else {
            PG8_LDB(B0, 0, 0); PG8_SCHED; PG8_LDA(At, 0, 0); PG8_STAGE(PG8_SA(1, 1), a1 + hstepA, voffA);
            PG8_WAIT_L(8); PG8_BAR; PG8_WAIT_L(0); PG8_MMA(0, 0, At, B0); PG8_BAR; PG8_SCHED;
            PG8_LDB(B1, 0, 1); PG8_STAGE(PG8_SB(0, 0), b2, voffB);
            PG8_BAR; PG8_WAIT_L(0); PG8_MMA(0, 1, At, B1); PG8_BAR;
            PG8_LDA(At, 0, 1); PG8_STAGE(PG8_SA(0, 0), a2, voffA);
            PG8_BAR; PG8_WAIT_L(0); PG8_MMA(1, 0, At, B0); PG8_BAR; PG8_SCHED;
            PG8_STAGE(PG8_SB(0, 1), b2 + hstepB, voffB);
            PG8_WAIT_V(6); PG8_BAR; PG8_MMA(1, 1, At, B1); PG8_BAR;
            PG8_LDB(B0, 1, 0); PG8_SCHED; PG8_LDA(At, 1, 0); PG8_STAGE(PG8_SA(0, 1), a2 + hstepA, voffA);
            PG8_WAIT_L(8); PG8_BAR; PG8_WAIT_L(0); PG8_MMA(0, 0, At, B0); PG8_BAR; PG8_SCHED;
            PG8_LDB(B1, 1, 1); PG8_STAGE(PG8_SB(1, 0), b3, voffB);
            PG8_BAR; PG8_WAIT_L(0); PG8_MMA(0, 1, At, B1); PG8_BAR;
            PG8_LDA(At, 1, 1); PG8_STAGE(PG8_SA(1, 0), a3, voffA);
            PG8_BAR; PG8_WAIT_L(0); PG8_MMA(1, 0, At, B0); PG8_BAR; PG8_SCHED;
            PG8_STAGE(PG8_SB(1, 1), b3 + hstepB, voffB);
            PG8_WAIT_V(6); PG8_BAR; PG8_MMA(1, 1, At, B1); PG8_BAR;
            }
        }
        if constexpr (FP8) asm volatile("s_nop 15\n\ts_nop 15" ::: "memory");
        if constexpr (ALIGN_EPI) { if (wr == 0) PG8_BAR; }
        if constexpr (!Epi::AFTER_DRAIN) { E(acc, cur, wr, wc, fr, fq); S.done(cur); }
        if (!has_next) break;
#pragma unroll
        for (int a = 0; a < 2; ++a)
#pragma unroll
            for (int b = 0; b < 2; ++b)
#pragma unroll
                for (int m = 0; m < 4; ++m)
#pragma unroll
                    for (int n = 0; n < 2; ++n) acc[a][b][m][n] = (f32x4){0.f, 0.f, 0.f, 0.f};
        cur = nxt; cA = nA; cB = nB; ++ui; nt = cur.nt ? cur.nt : K / BK;
        if constexpr (ALIGN_EPI) { if (wr == 1) PG8_BAR; }
    }
    PG8_WAIT_V(0);
    if constexpr (!ALIGN_EPI) { if (wr == 0) PG8_BAR; }
    PG8_BAR;
    if constexpr (Epi::AFTER_DRAIN) { E.fused(acc, cur, wr, wc, fr, fq, lds, wid, lane); S.done(cur); }
#undef PG8_SA
#undef PG8_SB
#undef PG8_STAGE
#undef PG8_LDA
#undef PG8_LDB
#undef PG8_MMA
#undef PG8_WAIT_V
#undef PG8_WAIT_L
#undef PG8_BAR
#undef PG8_SCHED
}
}

#ifndef PROBE_DUP
#define PROBE_DUP 0
#endif
#ifndef USE_SPLITK
#define USE_SPLITK 0
#endif
#ifndef MK_PER_PHASE
#define MK_PER_PHASE 0
#endif
constexpr int D = 1024, NBATCH = 8, SEQ = 4096, NLAT = NBATCH * SEQ, CTXL = 256, NCTX = NBATCH * CTXL, MALL = NLAT + NCTX;
constexpr int RH = 4, RQK = 256, RV = 512;
constexpr int DFF = 2816, NE = 8, DFE = 3584;
constexpr float EPS = 1e-6f;
constexpr float LAMBDA_INIT = 0.3555090675909693f;
constexpr float LOG2E = 1.4426950408889634f;
constexpr int NWAVES = 8, NTHREADS = 512;
constexpr float MOE_WSCALE = 64.0f; constexpr int MOE_SB = 0x79797979, MOE_SA = 0x7f7f7f7f;
constexpr int MOE_ROWS = 2 * NLAT + NE * 256;

enum { I_X = 0, I_C, I_CTX, I_CCTX, I_L0_WMOD, I_L0_BMOD, I_L0_NPREMIX, I_L0_NPOSTMIX, I_L0_NPREFFN, I_L0_NPOSTFFN, I_L0_WIN, I_L0_DECAY, I_L0_WOUT, I_L0_WGU, I_L0_WDN,
       I_L1_WMOD, I_L1_BMOD, I_L1_NPREMIX, I_L1_NPOSTMIX, I_L1_NPREFFN, I_L1_NPOSTFFN, I_L1_WIN, I_L1_LAMBDA, I_L1_SUBLN, I_L1_WOUT, I_L1_RW, I_L1_RB, I_L1_MGU, I_L1_MDN, N_IN };

constexpr size_t MiB = 1u << 20;
constexpr size_t WS_CTL = 0, CTL_ZERO_BYTES = 1 * MiB;
constexpr size_t WS_MODV = 1 * MiB;
constexpr size_t WS_TAB0 = 1 * MiB + 512 * 1024;
constexpr size_t WS_TAB1 = WS_TAB0 + 32 * 1024;
constexpr size_t WS_LAM = WS_TAB1 + 8 * 1024;
constexpr size_t WS_ROUTE = 2 * MiB;
constexpr size_t WS_XCTX = 3 * MiB;
constexpr size_t WS_W0IN = 11 * MiB, WS_W0OUT = 27 * MiB, WS_W0GU = 31 * MiB, WS_W0DN = 42 * MiB, WS_W1IN = 48 * MiB, WS_W1OUT = 54 * MiB, WS_WMGU = 56 * MiB, WS_WMDN = 168 * MiB;
constexpr size_t WS_H = 224 * MiB;
constexpr size_t WS_A = 292 * MiB, WS_B = 564 * MiB;
constexpr size_t WS_OF = WS_B, WS_OB = WS_B + 136 * MiB;
constexpr size_t WS_QH0 = WS_A, WS_KH0 = WS_A + 68 * MiB, WS_VQ0 = WS_A + 136 * MiB;
constexpr size_t WS_QH1 = WS_A, WS_KH1 = WS_A + 68 * MiB, WS_VH1 = WS_A + 136 * MiB;
constexpr size_t WS_HP = WS_A, WS_ACT1 = 424 * MiB, WS_Y1 = WS_A;
constexpr size_t WS_PART = WS_A + 128 * MiB;
constexpr size_t WS_END = 886 * MiB;
static_assert(WS_ACT1 + (size_t)MOE_ROWS * DFE * 2 <= WS_END, "ws map");
static_assert(WS_HP + (size_t)MOE_ROWS * D * 2 <= WS_ACT1, "ws map");
constexpr int CW_TMO = 0;
constexpr int CW_BAR = 4096;
constexpr int CW_XRANK = 12288;
constexpr int CW_MOECNT = 16384;

constexpr int RING_BYTES = 131072;
constexpr int LDS_BYTES = 163840;
constexpr int MISC_OFF = LDS_BYTES - 256;

#define GAS __attribute__((address_space(1)))
#define LAS __attribute__((address_space(3)))
typedef unsigned short bf16;
typedef unsigned v4u __attribute__((ext_vector_type(4)));
typedef unsigned v2u __attribute__((ext_vector_type(2)));
typedef float f32x4 __attribute__((ext_vector_type(4)));
typedef float f32x2 __attribute__((ext_vector_type(2)));
typedef short bf16x8 __attribute__((ext_vector_type(8)));
typedef GAS unsigned gu32;
#define RLX_AGENT __ATOMIC_RELAXED, __HIP_MEMORY_SCOPE_AGENT
#define LDS_WAIT() asm volatile("s_waitcnt lgkmcnt(0)" ::: "memory")
#define VM_WAIT() asm volatile("s_waitcnt vmcnt(0)" ::: "memory")
__device__ __forceinline__ unsigned pk2(float lo, float hi);
__device__ __forceinline__ unsigned f2bf(float f) { return pk2(f, 0.f) & 0xffffu; }
typedef float f32x2_cv __attribute__((ext_vector_type(2))); typedef __bf16 bf16x2_cv __attribute__((ext_vector_type(2)));
__device__ __forceinline__ unsigned pk2(float lo, float hi) { f32x2_cv v = {lo, hi}; bf16x2_cv b = __builtin_convertvector(v, bf16x2_cv); return __builtin_bit_cast(unsigned, b); }
__device__ __forceinline__ float bf2f(unsigned b) { return __builtin_bit_cast(float, b << 16); }
__device__ __forceinline__ float bflo(unsigned w) { return __builtin_bit_cast(float, w << 16); }
__device__ __forceinline__ float bfhi(unsigned w) { return __builtin_bit_cast(float, w & 0xffff0000u); }
__device__ __forceinline__ unsigned pk4_fp8(float a, float b, float c, float d) {
    a = __builtin_fminf(__builtin_fmaxf(a, -448.f), 448.f); b = __builtin_fminf(__builtin_fmaxf(b, -448.f), 448.f); c = __builtin_fminf(__builtin_fmaxf(c, -448.f), 448.f); d = __builtin_fminf(__builtin_fmaxf(d, -448.f), 448.f);
    int w = 0; w = __builtin_amdgcn_cvt_pk_fp8_f32(a, b, w, false); w = __builtin_amdgcn_cvt_pk_fp8_f32(c, d, w, true); return (unsigned)w; }
__device__ __forceinline__ float fast_exp2(float x) { return __builtin_amdgcn_exp2f(x); }
__device__ __forceinline__ float silu_f(float g) { return g * __builtin_amdgcn_rcpf(1.0f + __builtin_amdgcn_exp2f(-g * LOG2E)); }
__device__ __forceinline__ float wave_sum(float v) {
#pragma unroll
    for (int o = 1; o < 64; o <<= 1) v += __shfl_xor(v, o);
    return v;
}

#define XB_TMO      128
#define XB_XCNT(j)  (256  + 64 * (j))
#define XB_XSUB(j)  (1280 + 64 * (j))
#define XB_XGEN(j)  (2304 + 64 * (j))
#define XB_TOP      3328
#define XB_TOPGEN   3392
#define XCD_BAR_WORDS 3456
#define XB_SPIN_CAP (1u << 24)

__device__ __forceinline__ unsigned xb_ld(unsigned* p)              { return __hip_atomic_load(p, __ATOMIC_RELAXED, __HIP_MEMORY_SCOPE_AGENT); }
__device__ __forceinline__ unsigned xb_add(unsigned* p, unsigned v) { return __hip_atomic_fetch_add(p, v, __ATOMIC_RELAXED, __HIP_MEMORY_SCOPE_AGENT); }
__device__ __forceinline__ unsigned xb_xcc_id() { return (unsigned)__builtin_amdgcn_s_getreg((3 << 11) | 20) & 0xFu; }
#define XB_SPIN(cond, bar) do { unsigned _sp = 0; while (cond) { __builtin_amdgcn_s_sleep(1); \
    if ((++_sp & 255u) == 0u) { if (xb_ld(&(bar)[XB_TMO])) break; if (_sp > XB_SPIN_CAP) { atomicAdd(&(bar)[XB_TMO], 1u); break; } } } } while (0)

struct XcdBarrier {
    unsigned* bar; unsigned x;
    volatile LAS unsigned* st;
};

__device__ __forceinline__ XcdBarrier xcd_barrier_post(unsigned* bar, volatile LAS unsigned* st) {
    XcdBarrier b; b.bar = bar; b.x = xb_xcc_id(); b.st = st;
    if (threadIdx.x == 0) (void)xb_add(&bar[XB_XCNT(b.x)], 1u);
    return b;
}
__device__ __forceinline__ void xcd_barrier_complete(unsigned* bar, unsigned x, unsigned& nloc, unsigned& nx) {
    const unsigned G = gridDim.x * gridDim.y * gridDim.z;
    unsigned sum, cnt, mine, sp = 0u;
    for (;;) {
        sum = 0u; cnt = 0u; mine = 0u;
#pragma unroll
        for (unsigned j = 0; j < 16; ++j) { const unsigned c = xb_ld(&bar[XB_XCNT(j)]); sum += c; cnt += (c > 0u) ? 1u : 0u; mine = (j == x) ? c : mine; }
        if (sum == G) break;
        __builtin_amdgcn_s_sleep(1);
        if ((++sp & 255u) == 0u) { if (xb_ld(&bar[XB_TMO])) break; if (sp > XB_SPIN_CAP) { atomicAdd(&bar[XB_TMO], 1u); break; } }
    }
    nloc = mine > 0u ? mine : 1u; nx = cnt > 0u ? cnt : 1u;
}

__device__ __forceinline__ void xcd_barrier(const XcdBarrier& b) {
    asm volatile("s_waitcnt vmcnt(0)" ::: "memory");
    __syncthreads();
    if (threadIdx.x == 0) {
        unsigned* bar = b.bar;
        __builtin_amdgcn_s_waitcnt(0);
        unsigned nloc = b.st[0], nx = b.st[1];
        if (nloc == 0u) { xcd_barrier_complete(bar, b.x, nloc, nx); b.st[0] = nloc; b.st[1] = nx; }
        const unsigned old = xb_add(&bar[XB_XSUB(b.x)], 1u);
        const unsigned gen = old / nloc;
        if (old + 1u == (gen + 1u) * nloc) {
            __builtin_amdgcn_fence(__ATOMIC_RELEASE, "agent");
            asm volatile("s_waitcnt vmcnt(0)" ::: "memory");
            const unsigned og = xb_add(&bar[XB_TOP], 1u);
            const unsigned tg = og / nx;
            if (og + 1u == (tg + 1u) * nx) xb_add(&bar[XB_TOPGEN], 1u);
            else XB_SPIN(xb_ld(&bar[XB_TOPGEN]) == tg, bar);
            __builtin_amdgcn_fence(__ATOMIC_ACQUIRE, "agent");
            xb_add(&bar[XB_XGEN(b.x)], 1u);
            asm volatile("s_waitcnt vmcnt(0)" ::: "memory");
        } else {
            XB_SPIN(xb_ld(&bar[XB_XGEN(b.x)]) == gen, bar);
            __builtin_amdgcn_fence(__ATOMIC_ACQUIRE, "agent");
            asm volatile("s_waitcnt vmcnt(0)" ::: "memory");
        }
    }
    __syncthreads();
}


struct Args { const float* in[N_IN]; float* out; unsigned char* ws; int ph_lo, ph_hi; };

struct Frame {
    LAS unsigned char* lds;
    volatile LAS unsigned* MISC;
    gu32* ctl;
    int tid, lane, wave, vcu, G, cid;
    unsigned char* ws;
};

namespace pg8 {
struct EpiStore {
    static constexpr bool PERM = true, AFTER_DRAIN = false;
    bf16_t* O; int ldc;
    __device__ __forceinline__ void operator()(const f32x4 (&acc)[2][2][4][2], const Unit& u, int wr, int wc, int fr, int fq) const {
        const int row0 = u.pm * BM + wr * 64 + fr; const int col0 = u.pc * BM + wc * 32 + 8 * fq;
#pragma unroll
        for (int ai = 0; ai < 2; ++ai)
#pragma unroll
            for (int m = 0; m < 4; ++m) { bf16_t* rowp = O + (size_t)(row0 + ai * HALF + m * 16) * ldc + col0;
#pragma unroll
                for (int bj = 0; bj < 2; ++bj) { const f32x4 v0 = acc[ai][bj][m][0], v1 = acc[ai][bj][m][1];
                    u32x4 w; w.x = cvt_pk_bf16(v0[0], v0[1]); w.y = cvt_pk_bf16(v0[2], v0[3]); w.z = cvt_pk_bf16(v1[0], v1[1]); w.w = cvt_pk_bf16(v1[2], v1[3]);
                    *(u32x4*)(rowp + bj * HALF) = w; } }
    }
};
struct EpiSwiglu {
    static constexpr bool PERM = true, AFTER_DRAIN = false;
    bf16_t* O; int ldc;
    __device__ __forceinline__ void operator()(const f32x4 (&acc)[2][2][4][2], const Unit& u, int wr, int wc, int fr, int fq) const {
        const int row0 = u.pm * BM + wr * 64 + fr; const int col0 = u.pc * HALF + wc * 32 + 8 * fq;
#pragma unroll
        for (int ai = 0; ai < 2; ++ai)
#pragma unroll
            for (int m = 0; m < 4; ++m) { bf16_t* rowp = O + (size_t)(row0 + ai * HALF + m * 16) * ldc + col0;
                f32x4 a0, a1;
#pragma unroll
                for (int e = 0; e < 4; ++e) { a0[e] = silu_f(acc[ai][0][m][0][e]) * acc[ai][1][m][0][e]; a1[e] = silu_f(acc[ai][0][m][1][e]) * acc[ai][1][m][1][e]; }
                u32x4 w; w.x = cvt_pk_bf16(a0[0], a0[1]); w.y = cvt_pk_bf16(a0[2], a0[3]); w.z = cvt_pk_bf16(a1[0], a1[1]); w.w = cvt_pk_bf16(a1[2], a1[3]);
                *(u32x4*)rowp = w; }
    }
};

struct EpiQKV0 {
    static constexpr bool PERM = true, AFTER_DRAIN = false;
    bf16_t* Qh; bf16_t* Kh; bf16_t* Vq; const float* tab;
    __device__ __forceinline__ void operator()(const f32x4 (&acc)[2][2][4][2], const Unit& u, int wr, int wc, int fr, int fq) const {
        const int row0 = u.pm * BM + wr * 64 + fr, pc = u.pc;
        if (pc < 8) {
            bf16_t* base = pc < 4 ? Qh + (size_t)pc * MALL * 256 : Kh + (size_t)(pc - 4) * MALL * 256; const float sc = pc < 4 ? 1.0f : 0.0625f; const bool lat = u.pm < NLAT / BM;
            const int col0 = wc * 32 + 8 * fq;
#pragma unroll
            for (int ai = 0; ai < 2; ++ai)
#pragma unroll
                for (int m = 0; m < 4; ++m) { const int row = row0 + ai * HALF + m * 16, t = row & (SEQ - 1);
#pragma unroll
                    for (int bj = 0; bj < 2; ++bj) { f32x4 v0 = acc[ai][bj][m][0], v1 = acc[ai][bj][m][1];
                        if (lat) { const int pos = bj ? (t & 63) : (t >> 6); const float* tp = tab + (size_t)(pos * 64 + 16 * wc + 4 * fq) * 2;
                            const f32x4 c0 = *(const f32x4*)tp, c1 = *(const f32x4*)(tp + 4);
                            v0 = (f32x4){v0[0] * c0[0] - v0[1] * c0[1], v0[1] * c0[0] + v0[0] * c0[1], v0[2] * c0[2] - v0[3] * c0[3], v0[3] * c0[2] + v0[2] * c0[3]};
                            v1 = (f32x4){v1[0] * c1[0] - v1[1] * c1[1], v1[1] * c1[0] + v1[0] * c1[1], v1[2] * c1[2] - v1[3] * c1[3], v1[3] * c1[2] + v1[2] * c1[3]}; }
                        v0 = v0 * sc; v1 = v1 * sc;
                        u32x4 w; w.x = cvt_pk_bf16(v0[0], v0[1]); w.y = cvt_pk_bf16(v0[2], v0[3]); w.z = cvt_pk_bf16(v1[0], v1[1]); w.w = cvt_pk_bf16(v1[2], v1[3]);
                        *(u32x4*)(base + (size_t)row * 256 + col0 + bj * HALF) = w; } }
        } else {
#pragma unroll
            for (int ai = 0; ai < 2; ++ai)
#pragma unroll
                for (int m = 0; m < 4; ++m) { const int row = row0 + ai * HALF + m * 16;
#pragma unroll
                    for (int bj = 0; bj < 2; ++bj) { const f32x4 v0 = acc[ai][bj][m][0], v1 = acc[ai][bj][m][1];
                        u32x4 w; w.x = cvt_pk_bf16(v0[0], v0[1]); w.y = cvt_pk_bf16(v0[2], v0[3]); w.z = cvt_pk_bf16(v1[0], v1[1]); w.w = cvt_pk_bf16(v1[2], v1[3]);
                        *(u32x4*)(Vq + ((size_t)((pc - 8) * 2 + bj) * MALL + row) * 128 + wc * 32 + 8 * fq) = w; } }
        }
    }
};
struct EpiQKV1 {
    static constexpr bool PERM = true, AFTER_DRAIN = false;
    bf16_t* Qh; bf16_t* Kh; bf16_t* Vh; const float* tab;
    __device__ __forceinline__ void operator()(const f32x4 (&acc)[2][2][4][2], const Unit& u, int wr, int wc, int fr, int fq) const {
        const int row0 = u.pm * BM + wr * 64 + fr, pc = u.pc;
        if (pc < 8) {
            bf16_t* base = pc < 4 ? Qh : Kh; const float sc = pc < 4 ? 0.125f * LOG2E : 1.0f; const bool lat = u.pm < NLAT / BM;
            const int hf = wc & 1, p0 = 32 * hf + 8 * fq;
#pragma unroll
            for (int ai = 0; ai < 2; ++ai)
#pragma unroll
                for (int m = 0; m < 4; ++m) { const int row = row0 + ai * HALF + m * 16, t = row & (SEQ - 1);
                    const int pos = hf ? (t & 63) : (t >> 6); const float* tp = tab + (size_t)(pos * 16 + 4 * fq) * 2;
                    f32x4 c0 = (f32x4){1.f, 0.f, 1.f, 0.f}, c1 = c0;
                    if (lat) { c0 = *(const f32x4*)tp; c1 = *(const f32x4*)(tp + 4); }
#pragma unroll
                    for (int bj = 0; bj < 2; ++bj) { f32x4 v0 = acc[ai][bj][m][0], v1 = acc[ai][bj][m][1];
                        v0 = (f32x4){v0[0] * c0[0] - v0[1] * c0[1], v0[1] * c0[0] + v0[0] * c0[1], v0[2] * c0[2] - v0[3] * c0[3], v0[3] * c0[2] + v0[2] * c0[3]};
                        v1 = (f32x4){v1[0] * c1[0] - v1[1] * c1[1], v1[1] * c1[0] + v1[0] * c1[1], v1[2] * c1[2] - v1[3] * c1[3], v1[3] * c1[2] + v1[2] * c1[3]};
                        v0 = v0 * sc; v1 = v1 * sc;
                        const int head = (pc & 3) * 4 + 2 * bj + (wc >> 1);
                        u32x4 w; w.x = cvt_pk_bf16(v0[0], v0[1]); w.y = cvt_pk_bf16(v0[2], v0[3]); w.z = cvt_pk_bf16(v1[0], v1[1]); w.w = cvt_pk_bf16(v1[2], v1[3]);
                        *(u32x4*)(base + ((size_t)head * MALL + row) * 64 + p0) = w; } }
        } else {
#pragma unroll
            for (int ai = 0; ai < 2; ++ai)
#pragma unroll
                for (int m = 0; m < 4; ++m) { const int row = row0 + ai * HALF + m * 16;
#pragma unroll
                    for (int bj = 0; bj < 2; ++bj) { const f32x4 v0 = acc[ai][bj][m][0], v1 = acc[ai][bj][m][1];
                        u32x4 w; w.x = cvt_pk_bf16(v0[0], v0[1]); w.y = cvt_pk_bf16(v0[2], v0[3]); w.z = cvt_pk_bf16(v1[0], v1[1]); w.w = cvt_pk_bf16(v1[2], v1[3]);
                        *(u32x4*)(Vh + ((size_t)((pc - 8) * 2 + bj) * MALL + row) * 128 + wc * 32 + 8 * fq) = w; } }
        }
    }
};

struct EpiGateMerge {
    static constexpr bool PERM = true, AFTER_DRAIN = false;
    bf16_t* Of; const bf16_t* Ob; const float* ssq;
    __device__ __forceinline__ void operator()(const f32x4 (&acc)[2][2][4][2], const Unit& u, int wr, int wc, int fr, int fq) const {
        const int row0 = u.pm * BM + wr * 64 + fr; const int col0 = u.pc * HALF + wc * 32 + 8 * fq; const int head = u.pc >> 2;
#pragma unroll
        for (int ai = 0; ai < 2; ++ai)
#pragma unroll
            for (int m = 0; m < 4; ++m) { const size_t row = (size_t)(row0 + ai * HALF + m * 16);
                const f32x4 sf = *(const f32x4*)(ssq + (row * RH + head) * 8), sb = *(const f32x4*)(ssq + (row * RH + head) * 8 + 4);
                const float rf = __builtin_amdgcn_rsqf(((sf[0] + sf[1]) + (sf[2] + sf[3])) * (1.0f / RV) + EPS), rb = __builtin_amdgcn_rsqf(((sb[0] + sb[1]) + (sb[2] + sb[3])) * (1.0f / RV) + EPS);
                const u32x4 of = *(const u32x4*)(Of + row * 2048 + col0), ob = *(const u32x4*)(Ob + row * 2048 + col0);
                float y[8];
#pragma unroll
                for (int e = 0; e < 4; ++e) {
                    const float gf0 = acc[ai][0][m][e >> 1][2 * (e & 1)], gf1 = acc[ai][0][m][e >> 1][2 * (e & 1) + 1], gb0 = acc[ai][1][m][e >> 1][2 * (e & 1)], gb1 = acc[ai][1][m][e >> 1][2 * (e & 1) + 1];
                    y[2 * e] = silu_f(gf0) * (bflo(of[e]) * rf) + silu_f(gb0) * (bflo(ob[e]) * rb);
                    y[2 * e + 1] = silu_f(gf1) * (bfhi(of[e]) * rf) + silu_f(gb1) * (bfhi(ob[e]) * rb); }
                u32x4 w; w.x = cvt_pk_bf16(y[0], y[1]); w.y = cvt_pk_bf16(y[2], y[3]); w.z = cvt_pk_bf16(y[4], y[5]); w.w = cvt_pk_bf16(y[6], y[7]);
                *(u32x4*)(Of + row * 2048 + col0) = w; }
    }
};

struct SplitOrder {
    StaticOrder lat; int G, c, KS, ntS, nN, nl;
    __device__ void init(int N, int G_, int c_, int KS_, int ntS_) { lat.init(KS_ ? NLAT : MALL, N, G_, c_); G = G_; c = c_; KS = KS_; ntS = ntS_; nN = N / BM; nl = (lat.nwg > c_) ? (lat.nwg - 1 - c_) / G_ + 1 : 0; }
    __device__ bool next(int i, Unit& u) const {
        if (i < nl) return lat.next(i, u);
        const long j = (long)(i - nl) * G + c; if (j >= (long)(NCTX / BM) * nN * KS) return false;
        const int tile = (int)(j / KS), ks = (int)(j % KS);
        u.pm = NLAT / BM + tile / nN; u.pn = tile % nN; u.pc = u.pn; u.k0 = ks * ntS * BK; u.nt = ntS; u.ks = ks; return true;
    }
    __device__ __forceinline__ void a_ready(const Unit&) const {}
    __device__ __forceinline__ void done(const Unit&) const {}
};
struct EpiStoreSplit {
    static constexpr bool PERM = true, AFTER_DRAIN = false;
    bf16_t* O; int ldc; float* P;
    __device__ __forceinline__ void operator()(const f32x4 (&acc)[2][2][4][2], const Unit& u, int wr, int wc, int fr, int fq) const {
        const int row0 = u.pm * BM + wr * 64 + fr; const int col0 = u.pc * BM + wc * 32 + 8 * fq;
        if (u.ks < 0) {
#pragma unroll
            for (int ai = 0; ai < 2; ++ai)
#pragma unroll
                for (int m = 0; m < 4; ++m) { bf16_t* rowp = O + (size_t)(row0 + ai * HALF + m * 16) * ldc + col0;
#pragma unroll
                    for (int bj = 0; bj < 2; ++bj) { const f32x4 v0 = acc[ai][bj][m][0], v1 = acc[ai][bj][m][1];
                        u32x4 w; w.x = cvt_pk_bf16(v0[0], v0[1]); w.y = cvt_pk_bf16(v0[2], v0[3]); w.z = cvt_pk_bf16(v1[0], v1[1]); w.w = cvt_pk_bf16(v1[2], v1[3]);
                        *(u32x4*)(rowp + bj * HALF) = w; } }
        } else {
            float* pb = P + (size_t)u.ks * NCTX * ldc;
#pragma unroll
            for (int ai = 0; ai < 2; ++ai)
#pragma unroll
                for (int m = 0; m < 4; ++m) { float* rowp = pb + (size_t)(row0 - NLAT + ai * HALF + m * 16) * ldc + col0;
#pragma unroll
                    for (int bj = 0; bj < 2; ++bj) { *(f32x4*)(rowp + bj * HALF) = acc[ai][bj][m][0]; *(f32x4*)(rowp + bj * HALF + 4) = acc[ai][bj][m][1]; } }
        }
    }
};
struct EpiSwiglu8 {
    static constexpr bool PERM = true, AFTER_DRAIN = false;
    unsigned char* O; int ldc;
    __device__ __forceinline__ void operator()(const f32x4 (&acc)[2][2][4][2], const Unit& u, int wr, int wc, int fr, int fq) const {
        const int row0 = u.pm * BM + wr * 64 + fr; const int col0 = u.pc * HALF + wc * 32 + 8 * fq;
#pragma unroll
        for (int ai = 0; ai < 2; ++ai)
#pragma unroll
            for (int m = 0; m < 4; ++m) { unsigned char* rowp = O + (size_t)(row0 + ai * HALF + m * 16) * ldc + col0;
                f32x4 a0, a1;
#pragma unroll
                for (int e = 0; e < 4; ++e) { a0[e] = silu_f(acc[ai][0][m][0][e]) * acc[ai][1][m][0][e]; a1[e] = silu_f(acc[ai][0][m][1][e]) * acc[ai][1][m][1][e]; }
                v2u w; w.x = pk4_fp8(a0[0], a0[1], a0[2], a0[3]); w.y = pk4_fp8(a1[0], a1[1], a1[2], a1[3]);
                *(v2u*)rowp = w; }
    }
};
struct MoeOrder {
    int nM, nN, nwg, G, c; int t1, t2, t3, t4, t5, t6, t7;
    __device__ bool next(int i, Unit& u) const {
        const long L = (long)i * G + c; if (L >= nwg) return false;
        int wgid = (int)L; { const int q = nwg / NXCD, r = nwg % NXCD, xcd = wgid % NXCD, off = wgid / NXCD; wgid = (xcd < r ? xcd * (q + 1) : r * (q + 1) + (xcd - r) * q) + off; }
        const int nig = WGM * nN, gid = wgid / nig, fm = gid * WGM, gsz = (nM - fm) < WGM ? (nM - fm) : WGM;
        u.pm = fm + ((wgid % nig) % gsz); u.pc = (wgid % nig) / gsz;
        const int e = (u.pm >= t1) + (u.pm >= t2) + (u.pm >= t3) + (u.pm >= t4) + (u.pm >= t5) + (u.pm >= t6) + (u.pm >= t7);
        u.pn = e * nN + u.pc; u.k0 = 0; u.nt = 0; u.ks = -1; return true;
    }
    __device__ __forceinline__ void a_ready(const Unit&) const {}
    __device__ __forceinline__ void done(const Unit&) const {}
};
}

__device__ __forceinline__ void p0_transpose_item(const float* W, int K, int N, bf16* WT, int drow0, LAS float* scr, int k0, int n0, int lane, int mode = 0) {
#pragma unroll 8
    for (int i = 0; i < 32; ++i) { const int kk = 2 * i + (lane >> 5); scr[kk * 33 + (lane & 31)] = W[(size_t)(k0 + kk) * N + n0 + (lane & 31)]; }
    LDS_WAIT(); asm volatile("" ::: "memory");
    const int c = lane & 7;
#pragma unroll
    for (int j = 0; j < 4; ++j) { const int n = (lane >> 3) + 8 * j; const LAS float* s = scr + (8 * c) * 33 + n;
        v4u o; o.x = pk2(s[0 * 33], s[1 * 33]); o.y = pk2(s[2 * 33], s[3 * 33]); o.z = pk2(s[4 * 33], s[5 * 33]); o.w = pk2(s[6 * 33], s[7 * 33]);
        const int dr = mode == 0 ? n : (mode == 1 ? 2 * n : 2 * (n & 15) + (n >> 4));
        *(GAS v4u*)(WT + (size_t)(drow0 + dr) * K + k0 + 8 * c) = o; }
    LDS_WAIT(); asm volatile("" ::: "memory");
}
__device__ __forceinline__ void p0_transpose_item8(const float* W, int K, int N, unsigned char* WT, int drow0, LAS float* scr, int k0, int n0, int lane, float wscale) {
#pragma unroll 8
    for (int i = 0; i < 32; ++i) { const int kk = 2 * i + (lane >> 5); scr[kk * 33 + (lane & 31)] = W[(size_t)(k0 + kk) * N + n0 + (lane & 31)]; }
    LDS_WAIT(); asm volatile("" ::: "memory");
    const int n = lane >> 1, kh = (lane & 1) * 32; const LAS float* sp = scr + kh * 33 + n;
    v4u o0, o1;
#pragma unroll
    for (int q = 0; q < 4; ++q) { o0[q] = pk4_fp8(sp[(4 * q) * 33] * wscale, sp[(4 * q + 1) * 33] * wscale, sp[(4 * q + 2) * 33] * wscale, sp[(4 * q + 3) * 33] * wscale);
        o1[q] = pk4_fp8(sp[(16 + 4 * q) * 33] * wscale, sp[(17 + 4 * q) * 33] * wscale, sp[(18 + 4 * q) * 33] * wscale, sp[(19 + 4 * q) * 33] * wscale); }
    GAS v4u* dst = (GAS v4u*)(WT + (size_t)(drow0 + n) * K + k0 + kh); dst[0] = o0; dst[1] = o1;
    LDS_WAIT(); asm volatile("" ::: "memory");
}
__device__ __forceinline__ int swiglu_row(int n0, int F) { const int bj = n0 / F, w = n0 % F; return 256 * (w >> 7) + 128 * bj + (w & 127); }

__device__ __forceinline__ void p0_prologue(Frame& F, const Args& a) {
    LAS float* scr = (LAS float*)(F.lds + F.wave * 16384);
    const int gw = F.vcu * NWAVES + F.wave, NGW = F.G * NWAVES;
    constexpr int I0 = (D / 64) * (8192 / 32), I1 = (2048 / 64) * (D / 32), I2 = (D / 64) * (2 * DFF / 32), I3 = (DFF / 64) * (D / 32), I4 = (D / 64) * (3072 / 32), I5 = (D / 64) * (D / 32);
    constexpr int I6E = (D / 64) * (2 * DFE / 32), I7E = (DFE / 64) * (D / 32);
    constexpr int NITEMS = I0 + I1 + I2 + I3 + I4 + I5 + NE * I6E + NE * I7E;
    for (int it = gw; it < NITEMS; it += NGW) {
        int r = it;
        if (r < I0) { const int nb = r % (8192 / 32), kb = r / (8192 / 32); const int n0 = 32 * nb; int dr0 = n0, md = 0;
            if (n0 < 2048) { const int d0 = n0 & 255, hf = d0 >> 7, e = d0 & 127, sx = e >> 6, i0 = e & 63; dr0 = (n0 - d0) + 2 * (hf * 64 + i0) + sx; md = 1; }
            else if (n0 >= 4096) { dr0 = 4096 + swiglu_row(n0 - 4096, 2048); }
            p0_transpose_item(a.in[I_L0_WIN], D, 8192, (bf16*)(F.ws + WS_W0IN), dr0, scr, 64 * kb, n0, F.lane, md); continue; } r -= I0;
        if (r < I1) { const int nb = r % (D / 32), kb = r / (D / 32); p0_transpose_item(a.in[I_L0_WOUT], 2048, D, (bf16*)(F.ws + WS_W0OUT), 32 * nb, scr, 64 * kb, 32 * nb, F.lane); continue; } r -= I1;
        if (r < I2) { const int nb = r % (2 * DFF / 32), kb = r / (2 * DFF / 32); p0_transpose_item(a.in[I_L0_WGU], D, 2 * DFF, (bf16*)(F.ws + WS_W0GU), swiglu_row(32 * nb, DFF), scr, 64 * kb, 32 * nb, F.lane); continue; } r -= I2;
        if (r < I3) { const int nb = r % (D / 32), kb = r / (D / 32); p0_transpose_item(a.in[I_L0_WDN], DFF, D, (bf16*)(F.ws + WS_W0DN), 32 * nb, scr, 64 * kb, 32 * nb, F.lane); continue; } r -= I3;
        if (r < I4) { const int nb = r % (3072 / 32), kb = r / (3072 / 32); const int n0 = 32 * nb; int dr0 = n0, md = 0;
            if (n0 < 2048) { md = 2; }
            p0_transpose_item(a.in[I_L1_WIN], D, 3072, (bf16*)(F.ws + WS_W1IN), dr0, scr, 64 * kb, n0, F.lane, md); continue; } r -= I4;
        if (r < I5) { const int nb = r % (D / 32), kb = r / (D / 32); p0_transpose_item(a.in[I_L1_WOUT], D, D, (bf16*)(F.ws + WS_W1OUT), 32 * nb, scr, 64 * kb, 32 * nb, F.lane); continue; } r -= I5;
        if (r < NE * I6E) { const int e = r / I6E, rr = r % I6E; const int nb = rr % (2 * DFE / 32), kb = rr / (2 * DFE / 32);
            p0_transpose_item8(a.in[I_L1_MGU] + (size_t)e * D * 2 * DFE, D, 2 * DFE, (unsigned char*)(F.ws + WS_WMGU) + (size_t)e * 2 * DFE * D, swiglu_row(32 * nb, DFE), scr, 64 * kb, 32 * nb, F.lane, MOE_WSCALE); continue; } r -= NE * I6E;
        { const int e = r / I7E, rr = r % I7E; const int nb = rr % (D / 32), kb = rr / (D / 32);
            p0_transpose_item8(a.in[I_L1_MDN] + (size_t)e * DFE * D, DFE, D, (unsigned char*)(F.ws + WS_WMDN) + (size_t)e * D * DFE, 32 * nb, scr, 64 * kb, 32 * nb, F.lane, MOE_WSCALE); }
    }
    __syncthreads();
    {
        LAS float* sc = (LAS float*)F.lds;
        LAS float* part = (LAS float*)(F.lds + 9 * 1024 * 4);
        bool loaded = false;
        for (int grp = F.vcu; grp < 2 * (6 * D / 64); grp += F.G) {
            if (!loaded) { for (int i = F.tid; i < 9 * 1024; i += NTHREADS) { const float cv = (i < 8 * 1024) ? a.in[I_C][i] : a.in[I_CCTX][i - 8 * 1024]; sc[i] = silu_f(cv); } loaded = true; }
            __syncthreads();
            const int layer = grp / (6 * D / 64), cb = (grp % (6 * D / 64)) * 64;
            const float* W = a.in[layer ? I_L1_WMOD : I_L0_WMOD]; const float* bm = a.in[layer ? I_L1_BMOD : I_L0_BMOD];
            const int ks = F.tid >> 6, col = F.tid & 63;
            float acc[9];
#pragma unroll
            for (int b = 0; b < 9; ++b) acc[b] = 0.f;
            for (int k = ks * 128; k < ks * 128 + 128; ++k) { const float w = W[(size_t)k * (6 * D) + cb + col];
#pragma unroll
                for (int b = 0; b < 9; ++b) acc[b] += sc[b * 1024 + k] * w; }
#pragma unroll
            for (int b = 0; b < 9; ++b) part[(ks * 9 + b) * 64 + col] = acc[b];
            __syncthreads();
            for (int o = F.tid; o < 9 * 64; o += NTHREADS) { const int b = o >> 6, cc = o & 63; float s = bm[cb + cc];
#pragma unroll
                for (int k2 = 0; k2 < 8; ++k2) s += part[(k2 * 9 + b) * 64 + cc];
                ((float*)(F.ws + WS_MODV))[((size_t)layer * 9 + b) * (6 * D) + cb + cc] = s; }
            __syncthreads();
        }
    }
    {
        const int gt = F.vcu * NTHREADS + F.tid;
        if (gt < 64 * 64 + 64 * 16) {
            int pos, i; float ex;
            if (gt < 4096) { pos = gt >> 6; i = gt & 63; ex = (float)(2 * i) / 128.0f; } else { const int q = gt - 4096; pos = q >> 4; i = q & 15; ex = (float)(2 * i) / 32.0f; }
            const float freq = __builtin_amdgcn_exp2f(-ex * 13.287712379549449f);
            const float rev = (float)pos * freq * 0.15915494309189535f;
            const float cs = __builtin_amdgcn_cosf(rev), sn = __builtin_amdgcn_sinf(rev);
            f32x2* t = (f32x2*)(F.ws + (gt < 4096 ? WS_TAB0 : WS_TAB1)); t[gt < 4096 ? gt : gt - 4096] = (f32x2){cs, sn};
        }
        if (gt == 0) { const float* lp = a.in[I_L1_LAMBDA]; float s1 = 0.f, s2 = 0.f; for (int i = 0; i < 64; ++i) { s1 += lp[i] * lp[64 + i]; s2 += lp[128 + i] * lp[192 + i]; }
            *(float*)(F.ws + WS_LAM) = __expf(s1) - __expf(s2) + LAMBDA_INIT; }
    }
}

struct RowPass {
    int nrows;
    const float* xin_lat; const float* xin_ctx; float* xout_lat; float* xout_ctx;
    const bf16* br;
    const float* gpost;
    const float* gate;
    const float* gpre;
    const float* shift; const float* scale;
    bf16* hout;
    const float* part;
};
template <bool BR, bool MOEBR, bool WH, bool ROUTE, bool H8 = false, int KSPL = 0>
__device__ __forceinline__ void row_pass(Frame& F, const Args& a, const RowPass& P) {
    const int gw = F.vcu * NWAVES + F.wave, NGW = F.G * NWAVES;
    const int l4 = F.lane * 4;
    for (int r = gw; r < P.nrows; r += NGW) {
        const bool lat = r < NLAT; const int rc = lat ? r : r - NLAT; const int midx = lat ? (r >> 12) : 8;
        const float* xin = (lat ? P.xin_lat : P.xin_ctx) + (size_t)rc * D;
        float* xout = (lat ? P.xout_lat : P.xout_ctx) + (size_t)rc * D;
        f32x4 v[4];
#pragma unroll
        for (int j = 0; j < 4; ++j) v[j] = *(const GAS f32x4*)(xin + l4 + 256 * j);
        if constexpr (BR || MOEBR) {
            f32x4 y[4];
            if constexpr (BR) {
                if (KSPL > 0 && !lat) {
#pragma unroll
                    for (int j = 0; j < 4; ++j) y[j] = (f32x4){0.f, 0.f, 0.f, 0.f};
                    for (int ks = 0; ks < KSPL; ++ks) { const float* pr = P.part + ((size_t)ks * NCTX + rc) * D + l4;
#pragma unroll
                        for (int j = 0; j < 4; ++j) y[j] = y[j] + *(const GAS f32x4*)(pr + 256 * j); }
                } else {
#pragma unroll
                for (int j = 0; j < 4; ++j) { const v2u w = *(const GAS v2u*)(P.br + (size_t)r * D + l4 + 256 * j); y[j] = (f32x4){bflo(w.x), bfhi(w.x), bflo(w.y), bfhi(w.y)}; }
                }
            } else {
                const int* tpos = (const int*)(F.ws + WS_ROUTE + (size_t)NLAT * 8); const float* tw = (const float*)(F.ws + WS_ROUTE + (size_t)NLAT * 16);
                const int s0 = tpos[2 * r], s1 = tpos[2 * r + 1]; const float w0 = tw[2 * r], w1 = tw[2 * r + 1];
#pragma unroll
                for (int j = 0; j < 4; ++j) { const v2u p = *(const GAS v2u*)(P.br + (size_t)s0 * D + l4 + 256 * j); const v2u q = *(const GAS v2u*)(P.br + (size_t)s1 * D + l4 + 256 * j);
                    y[j] = (f32x4){w0 * bflo(p.x) + w1 * bflo(q.x), w0 * bfhi(p.x) + w1 * bfhi(q.x), w0 * bflo(p.y) + w1 * bflo(q.y), w0 * bfhi(p.y) + w1 * bfhi(q.y)}; }
            }
            float ss = 0.f;
#pragma unroll
            for (int j = 0; j < 4; ++j) ss += (y[j].x * y[j].x + y[j].y * y[j].y) + (y[j].z * y[j].z + y[j].w * y[j].w);
            const float rstd = 1.0f / sqrtf(wave_sum(ss) * (1.0f / D) + EPS);
#pragma unroll
            for (int j = 0; j < 4; ++j) { const f32x4 gp = *(const GAS f32x4*)(P.gpost + l4 + 256 * j); const f32x4 gt = *(const GAS f32x4*)(P.gate + (size_t)midx * 6 * D + l4 + 256 * j);
                v[j] = v[j] + gt * (y[j] * rstd * gp); }
#pragma unroll
            for (int j = 0; j < 4; ++j) *(GAS f32x4*)(xout + l4 + 256 * j) = v[j];
        }
        if constexpr (WH) {
            float ss = 0.f;
#pragma unroll
            for (int j = 0; j < 4; ++j) ss += (v[j].x * v[j].x + v[j].y * v[j].y) + (v[j].z * v[j].z + v[j].w * v[j].w);
            const float rstd = 1.0f / sqrtf(wave_sum(ss) * (1.0f / D) + EPS);
            f32x4 h[4];
#pragma unroll
            for (int j = 0; j < 4; ++j) { const f32x4 gp = *(const GAS f32x4*)(P.gpre + l4 + 256 * j); const f32x4 sc = *(const GAS f32x4*)(P.scale + (size_t)midx * 6 * D + l4 + 256 * j);
                const f32x4 sh = *(const GAS f32x4*)(P.shift + (size_t)midx * 6 * D + l4 + 256 * j);
                h[j] = (v[j] * rstd * gp) * (1.0f + sc) + sh;
                if constexpr (H8) { *(GAS unsigned*)((unsigned char*)P.hout + (size_t)r * D + l4 + 256 * j) = pk4_fp8(h[j].x, h[j].y, h[j].z, h[j].w); }
                else { v2u w; w.x = pk2(h[j].x, h[j].y); w.y = pk2(h[j].z, h[j].w); *(GAS v2u*)(P.hout + (size_t)r * D + l4 + 256 * j) = w; } }
            if constexpr (ROUTE) {
                const float* rw = a.in[I_L1_RW];
                float lg[8];
#pragma unroll
                for (int e = 0; e < 8; ++e) lg[e] = 0.f;
#pragma unroll
                for (int j = 0; j < 4; ++j)
#pragma unroll
                    for (int q = 0; q < 4; ++q) { const int k = l4 + 256 * j + q; const f32x4 wa = *(const GAS f32x4*)(rw + (size_t)k * 8), wb = *(const GAS f32x4*)(rw + (size_t)k * 8 + 4); const float hv = h[j][q];
                        lg[0] += hv * wa.x; lg[1] += hv * wa.y; lg[2] += hv * wa.z; lg[3] += hv * wa.w; lg[4] += hv * wb.x; lg[5] += hv * wb.y; lg[6] += hv * wb.z; lg[7] += hv * wb.w; }
#pragma unroll
                for (int e = 0; e < 8; ++e) lg[e] = wave_sum(lg[e]) + a.in[I_L1_RB][e];
                float v1 = lg[0]; int i1 = 0;
#pragma unroll
                for (int e = 1; e < 8; ++e) if (lg[e] > v1) { v1 = lg[e]; i1 = e; }
                float v2 = -3.0e38f; int i2 = 0;
#pragma unroll
                for (int e = 0; e < 8; ++e) if (e != i1 && lg[e] > v2) { v2 = lg[e]; i2 = e; }
                const float w1 = 1.0f / (1.0f + __expf(v2 - v1)), w2 = 1.0f - w1;
                if (F.lane == 0) {
                    int* te = (int*)(F.ws + WS_ROUTE); int* tpos = (int*)(F.ws + WS_ROUTE + (size_t)NLAT * 8); float* tw = (float*)(F.ws + WS_ROUTE + (size_t)NLAT * 16);
                    const unsigned p1 = __hip_atomic_fetch_add((unsigned*)(F.ctl + CW_MOECNT + 64 * i1), 1u, RLX_AGENT);
                    const unsigned p2 = __hip_atomic_fetch_add((unsigned*)(F.ctl + CW_MOECNT + 64 * i2), 1u, RLX_AGENT);
                    te[2 * r] = i1; te[2 * r + 1] = i2; tpos[2 * r] = (int)p1; tpos[2 * r + 1] = (int)p2; tw[2 * r] = w1; tw[2 * r + 1] = w2;
                }
            }
        }
    }
}


namespace att {
using s16x4  = __attribute__((ext_vector_type(4))) short;
using f32x16 = __attribute__((ext_vector_type(16))) float;
using u32x4  = __attribute__((ext_vector_type(4))) unsigned;
constexpr int KVBLK = 64, NT = (SEQ + CTXL) / KVBLK;
constexpr int SHM_V = KVBLK * 128 * 2, SHM_K = KVBLK * 64 * 2;
constexpr int OFF_V = 0, OFF_K = 2 * SHM_V, OFF_WS = OFF_K + 2 * SHM_K, OFF_O1 = OFF_WS + NWAVES * 64 * 4, ATT_LDS = OFF_O1 + NWAVES * 8192;
constexpr float THR = 8.0f;
#define ATT_SBAR() __builtin_amdgcn_sched_barrier(0)
#define KSWZ64(row, colB) ((row) * 128 + ((colB) ^ ((((row) >> 1) & 7) << 4)))
__device__ __forceinline__ int crow(int r, int hi) { return (r & 3) + 8 * (r >> 2) + 4 * hi; }
__device__ __forceinline__ unsigned cvtpk(float lo, float hi) { unsigned r; asm volatile("v_cvt_pk_bf16_f32 %0, %1, %2" : "=v"(r) : "v"(lo), "v"(hi)); return r; }

__device__ __forceinline__ void partialSM(f32x16& p0, f32x16& p1, float& m_reg, float& alpha) {
    float pmax = p0[0];
#pragma unroll
    for (int r = 1; r < 16; ++r) pmax = fmaxf(pmax, p0[r]);
#pragma unroll
    for (int r = 0; r < 16; ++r) pmax = fmaxf(pmax, p1[r]);
    { auto rr = __builtin_amdgcn_permlane32_swap(__float_as_uint(pmax), __float_as_uint(pmax), false, false); pmax = fmaxf(__uint_as_float(rr[0]), __uint_as_float(rr[1])); }
    float mn;
    if (__builtin_expect(__all(pmax - m_reg <= THR), 1)) { mn = m_reg; alpha = 1.f; }
    else { mn = fmaxf(m_reg, pmax); alpha = __builtin_amdgcn_exp2f(m_reg - mn); m_reg = mn; }
#pragma unroll
    for (int r = 0; r < 16; ++r) p0[r] = p0[r] - mn;
#pragma unroll
    for (int r = 0; r < 16; ++r) p1[r] = p1[r] - mn;
#pragma unroll
    for (int r = 0; r < 16; ++r) p0[r] = __builtin_amdgcn_exp2f(p0[r]);
}
__device__ __forceinline__ void finishSM(f32x16& p0, f32x16& p1, float alpha, float& l_reg, bf16x8& pa0, bf16x8& pa1, bf16x8& pa2, bf16x8& pa3) {
#pragma unroll
    for (int r = 0; r < 16; ++r) p1[r] = __builtin_amdgcn_exp2f(p1[r]);
    float ps = 0;
#pragma unroll
    for (int r = 0; r < 16; ++r) ps += p0[r];
#pragma unroll
    for (int r = 0; r < 16; ++r) ps += p1[r];
    { auto rr = __builtin_amdgcn_permlane32_swap(__float_as_uint(ps), __float_as_uint(ps), false, false); ps = __uint_as_float(rr[0]) + __uint_as_float(rr[1]); }
    l_reg = l_reg * alpha + ps;
#define ATT_PK4(P, BASE, OUT) do { unsigned a0 = cvtpk(P[BASE + 0], P[BASE + 1]), a1 = cvtpk(P[BASE + 2], P[BASE + 3]);   \
    unsigned b0 = cvtpk(P[BASE + 4], P[BASE + 5]), b1 = cvtpk(P[BASE + 6], P[BASE + 7]);                              \
    auto r0 = __builtin_amdgcn_permlane32_swap(a0, b0, false, false); auto r1 = __builtin_amdgcn_permlane32_swap(a1, b1, false, false); \
    u32x4 w = {r0[0], r1[0], r0[1], r1[1]}; OUT = *reinterpret_cast<bf16x8*>(&w); } while (0)
    ATT_PK4(p0, 0, pa0); ATT_PK4(p0, 8, pa1); ATT_PK4(p1, 0, pa2); ATT_PK4(p1, 8, pa3);
#undef ATT_PK4
}
__device__ __forceinline__ void qkt(f32x16& p0, f32x16& p1, const char* Ks, const bf16x8* qr, int r32, int hi) {
    p0 = f32x16{}; p1 = f32x16{};
#pragma unroll
    for (int d0 = 0; d0 < 4; ++d0) { const int cb = (d0 * 16 + hi * 8) * 2;
        const bf16x8 b0 = *reinterpret_cast<const bf16x8*>(Ks + KSWZ64(r32, cb));
        const bf16x8 b1 = *reinterpret_cast<const bf16x8*>(Ks + KSWZ64(32 + r32, cb));
        p0 = __builtin_amdgcn_mfma_f32_32x32x16_bf16(b0, qr[d0], p0, 0, 0, 0);
        p1 = __builtin_amdgcn_mfma_f32_32x32x16_bf16(b1, qr[d0], p1, 0, 0, 0); }
}
__device__ __forceinline__ int v_st(int k, int c) { const int kk = (k & ~0xC) | ((k & 4) << 1) | ((k & 8) >> 1); return ((kk >> 3) * 4 + (c >> 5)) * 512 + ((kk & 7) * 32 + (c & 31)) * 2; }
__device__ __forceinline__ int v_rd_base(int lane) { return ((lane & 3) << 3) | (((lane >> 2) & 3) << 6) | (((lane >> 4) & 1) << 5) | (((lane >> 5) & 1) << 8); }
constexpr int v_rd_off(int d0, int ks, int half) { return d0 * 512 + ks * 4096 + half * 2048; }
template <int OFF> __device__ __forceinline__ s16x4 tr_read(int vb) { s16x4 r; asm volatile("ds_read_b64_tr_b16 %0, %1 offset:%2" : "=&v"(r) : "v"(vb), "i"(OFF) : "memory"); return r; }
template <int D0> __device__ __forceinline__ void pv_one(f32x16& od, int vb, bf16x8 pa0, bf16x8 pa1, bf16x8 pa2, bf16x8 pa3) {
    const s16x4 l0 = tr_read<v_rd_off(D0, 0, 0)>(vb), h0 = tr_read<v_rd_off(D0, 0, 1)>(vb), l1 = tr_read<v_rd_off(D0, 1, 0)>(vb), h1 = tr_read<v_rd_off(D0, 1, 1)>(vb);
    const s16x4 l2 = tr_read<v_rd_off(D0, 2, 0)>(vb), h2 = tr_read<v_rd_off(D0, 2, 1)>(vb), l3 = tr_read<v_rd_off(D0, 3, 0)>(vb), h3 = tr_read<v_rd_off(D0, 3, 1)>(vb);
    asm volatile("s_waitcnt lgkmcnt(0)" ::: "memory"); ATT_SBAR();
#define ATT_PK(L, H) (bf16x8){L[0], L[1], L[2], L[3], H[0], H[1], H[2], H[3]}
    od = __builtin_amdgcn_mfma_f32_32x32x16_bf16(pa0, ATT_PK(l0, h0), od, 0, 0, 0);
    od = __builtin_amdgcn_mfma_f32_32x32x16_bf16(pa1, ATT_PK(l1, h1), od, 0, 0, 0);
    od = __builtin_amdgcn_mfma_f32_32x32x16_bf16(pa2, ATT_PK(l2, h2), od, 0, 0, 0);
    od = __builtin_amdgcn_mfma_f32_32x32x16_bf16(pa3, ATT_PK(l3, h3), od, 0, 0, 0);
#undef ATT_PK
}
__device__ __forceinline__ void pv_d0(f32x16* o, int vb, bf16x8 pa0, bf16x8 pa1, bf16x8 pa2, bf16x8 pa3) {
    pv_one<0>(o[0], vb, pa0, pa1, pa2, pa3); pv_one<1>(o[1], vb, pa0, pa1, pa2, pa3); pv_one<2>(o[2], vb, pa0, pa1, pa2, pa3); pv_one<3>(o[3], vb, pa0, pa1, pa2, pa3);
}
__device__ __forceinline__ size_t kvrow(int b, int t) { return t < 64 ? (size_t)b * SEQ + (size_t)t * 64 : (size_t)NLAT + (size_t)b * CTXL + (size_t)(t - 64) * 64; }

__device__ __forceinline__ void head_pass(const bf16* __restrict__ Q1, const bf16* __restrict__ K1, const bf16* __restrict__ V1, int b, int qh, int hp, size_t qrow0, char* lds, f32x16 (&o)[4], float& l_out) {
    int tid_ = threadIdx.x; asm volatile("" : "+v"(tid_));
    const int tid = tid_, wid = tid >> 6, lane = tid & 63, r32 = lane & 31, hi = lane >> 5;
    char* V_lds = lds + OFF_V; char* K_lds = lds + OFF_K;
    float* wsf = (float*)(lds + OFF_WS) + wid * 64; float* al_l = wsf + 32;
    float m_reg = -1e30f, l_reg = 0.f;
#pragma unroll
    for (int d = 0; d < 4; ++d) o[d] = f32x16{};
    bf16x8 qr[4];
    const bf16* Qw = Q1 + ((size_t)qh * MALL + qrow0 + wid * 32 + r32) * 64 + hi * 8;
#pragma unroll
    for (int d0 = 0; d0 < 4; ++d0) qr[d0] = *reinterpret_cast<const bf16x8*>(Qw + d0 * 16);
    const bf16* Kh = K1 + (size_t)qh * MALL * 64; const bf16* Vh = V1 + (size_t)hp * MALL * 128;
    const int sr = tid >> 4, sc = (tid & 15) * 8, vst0 = v_st(sr, sc), vst1 = v_st(32 + sr, sc);
    const int kr = tid >> 3, kc = (tid & 7) * 8, kst = KSWZ64(kr, kc * 2);
    const int vb0 = (int)(uintptr_t)V_lds + v_rd_base(lane);
    struct { bf16x8 vs0, vs1, ks; } sr_[2];
#define ATT_SLOAD(i, t) do { const size_t rb_ = kvrow(b, (t)); sr_[i].vs0 = *reinterpret_cast<const bf16x8*>(&Vh[(rb_ + sr) * 128 + sc]); sr_[i].vs1 = *reinterpret_cast<const bf16x8*>(&Vh[(rb_ + 32 + sr) * 128 + sc]); \
    sr_[i].ks = *reinterpret_cast<const bf16x8*>(&Kh[(rb_ + kr) * 64 + kc]); } while (0)
#define ATT_SWRITE(bu, i) do { *(bf16x8*)(V_lds + (bu) * SHM_V + vst0) = sr_[i].vs0; *(bf16x8*)(V_lds + (bu) * SHM_V + vst1) = sr_[i].vs1; *(bf16x8*)(K_lds + (bu) * SHM_K + kst) = sr_[i].ks; } while (0)
#define ATT_SWAIT() asm volatile("s_waitcnt vmcnt(3)" ::: "memory")
#define ATT_RESC(al) do { if (__any((al) < 1.f)) { if (hi == 0) al_l[r32] = (al); asm volatile("s_waitcnt lgkmcnt(0)" ::: "memory"); \
    _Pragma("unroll") for (int d = 0; d < 4; ++d) _Pragma("unroll") for (int r = 0; r < 16; ++r) o[d][r] *= al_l[crow(r, hi)]; } } while (0)
    f32x16 pA0, pA1, pB0, pB1; float alA, alB; bf16x8 pa0, pa1, pa2, pa3;
    ATT_SLOAD(0, 0); asm volatile("s_waitcnt vmcnt(0)" ::: "memory"); ATT_SWRITE(0, 0); __syncthreads();
    qkt(pA0, pA1, K_lds, qr, r32, hi); partialSM(pA0, pA1, m_reg, alA);
    ATT_SLOAD(1, 1); ATT_SLOAD(0, 2);
    ATT_SWAIT(); ATT_SWRITE(1, 1); __syncthreads();
    for (int j = 1; j + 1 < NT; j += 2) {
        ATT_SBAR(); qkt(pB0, pB1, K_lds + SHM_K, qr, r32, hi);
        finishSM(pA0, pA1, alA, l_reg, pa0, pa1, pa2, pa3); ATT_SBAR();
        ATT_SLOAD(1, j + 2); ATT_SBAR();
        pv_d0(o, vb0, pa0, pa1, pa2, pa3); partialSM(pB0, pB1, m_reg, alB);
        __syncthreads(); ATT_SWAIT(); ATT_SWRITE(0, 0);
        ATT_RESC(alB); __syncthreads();
        ATT_SBAR(); qkt(pA0, pA1, K_lds, qr, r32, hi);
        finishSM(pB0, pB1, alB, l_reg, pa0, pa1, pa2, pa3); ATT_SBAR();
        if (j + 3 < NT) ATT_SLOAD(0, j + 3); ATT_SBAR();
        pv_d0(o, vb0 + SHM_V, pa0, pa1, pa2, pa3); partialSM(pA0, pA1, m_reg, alA);
        __syncthreads(); ATT_SWAIT(); ATT_SWRITE(1, 1);
        ATT_RESC(alA); __syncthreads();
    }
    ATT_SBAR(); qkt(pB0, pB1, K_lds + SHM_K, qr, r32, hi);
    finishSM(pA0, pA1, alA, l_reg, pa0, pa1, pa2, pa3); ATT_SBAR();
    pv_d0(o, vb0, pa0, pa1, pa2, pa3); partialSM(pB0, pB1, m_reg, alB);
    __syncthreads(); ATT_RESC(alB);
    finishSM(pB0, pB1, alB, l_reg, pa0, pa1, pa2, pa3); ATT_SBAR();
    pv_d0(o, vb0 + SHM_V, pa0, pa1, pa2, pa3);
    l_out = l_reg;
#undef ATT_SLOAD
#undef ATT_SWRITE
#undef ATT_SWAIT
#undef ATT_RESC
}

__device__ __forceinline__ void attn_unit(const bf16* __restrict__ Q1, const bf16* __restrict__ K1, const bf16* __restrict__ V1, bf16* __restrict__ ao, int b, int hp, int qb, char* lds, const float* lamp, const float* subln) {
    int tid_ = threadIdx.x; asm volatile("" : "+v"(tid_));
    const int tid = tid_, wid = tid >> 6, lane = tid & 63, r32 = lane & 31, hi = lane >> 5;
    float* wsf = (float*)(lds + OFF_WS) + wid * 64;
    unsigned* o1s = (unsigned*)(lds + OFF_O1 + wid * 8192);
    const size_t qrow0 = (size_t)b * SEQ + (size_t)qb * 256;
    f32x16 o[4]; float l;
    float ssq[16];
#pragma unroll 1
    for (int hh = 0; hh < 2; ++hh) {
        head_pass(Q1, K1, V1, b, 2 * hp + hh, hp, qrow0, lds, o, l);
        if (hi == 0) wsf[r32] = l; asm volatile("s_waitcnt lgkmcnt(0)" ::: "memory");
        float rli[16];
#pragma unroll
        for (int r = 0; r < 16; ++r) { rli[r] = __builtin_amdgcn_rcpf(wsf[crow(r, hi)]); ssq[r] = 0.f; }
        if (hh == 0) {
#pragma unroll
            for (int d0 = 0; d0 < 4; ++d0)
#pragma unroll
                for (int r = 0; r < 16; r += 2) o1s[(d0 * 8 + (r >> 1)) * 64 + lane] = cvtpk(o[d0][r] * rli[r], o[d0][r + 1] * rli[r + 1]);
            __syncthreads();
        } else {
            asm volatile("" : "+s"(lamp)); const float lam = *lamp;
#pragma unroll
            for (int d0 = 0; d0 < 4; ++d0)
#pragma unroll
                for (int r = 0; r < 16; r += 2) { const unsigned w = o1s[(d0 * 8 + (r >> 1)) * 64 + lane];
                    const float a0 = bflo(w) - lam * (o[d0][r] * rli[r]), a1 = bfhi(w) - lam * (o[d0][r + 1] * rli[r + 1]);
                    o[d0][r] = a0; o[d0][r + 1] = a1; ssq[r] += a0 * a0; ssq[r + 1] += a1 * a1; }
        }
    }
#pragma unroll
    for (int r = 0; r < 16; ++r) { float s = ssq[r];
        s += __shfl_xor(s, 1); s += __shfl_xor(s, 2); s += __shfl_xor(s, 4); s += __shfl_xor(s, 8); s += __shfl_xor(s, 16);
        ssq[r] = 1.0f / sqrtf(s * (1.0f / 128.0f) + EPS) * (1.0f - LAMBDA_INIT); }
    asm volatile("s_waitcnt lgkmcnt(0)" ::: "memory");
    bf16* stg = (bf16*)o1s;
    asm volatile("" : "+s"(subln));
#pragma unroll
    for (int d0 = 0; d0 < 4; ++d0) { const float g = subln[d0 * 32 + r32];
#pragma unroll
        for (int r = 0; r < 16; ++r) stg[crow(r, hi) * 128 + d0 * 32 + r32] = (bf16)f2bf(o[d0][r] * ssq[r] * g); }
    asm volatile("s_waitcnt lgkmcnt(0)" ::: "memory");
    bf16* Ow = ao + (qrow0 + wid * 32) * D + hp * 128;
#pragma unroll
    for (int i = 0; i < 8; ++i) { const int row = i * 4 + (lane >> 4), ch = lane & 15; const u32x4 v = *(const u32x4*)(stg + row * 128 + ch * 8); *(u32x4*)(Ow + (size_t)row * D + ch * 8) = v; }
    asm volatile("s_waitcnt lgkmcnt(0)" ::: "memory");
    __syncthreads();
}
#undef ATT_SBAR
}

__device__ __forceinline__ void attn_phase(Frame& F, const Args& a) {
    const bf16* Q1 = (const bf16*)(F.ws + WS_QH1); const bf16* K1 = (const bf16*)(F.ws + WS_KH1); const bf16* V1 = (const bf16*)(F.ws + WS_VH1); bf16* ao = (bf16*)(F.ws + WS_B);
    const float* lamp = (const float*)(F.ws + WS_LAM);
    for (int unit = F.vcu; unit < NBATCH * 8 * 16; unit += F.G) {
        const int qb = unit & 15, hp = (unit >> 4) & 7, b = unit >> 7;
        att::attn_unit(Q1, K1, V1, ao, b, hp, qb, (char*)F.lds, lamp, a.in[I_L1_SUBLN]);
    }
}


namespace ret {
using s16x4  = __attribute__((ext_vector_type(4))) short;
using f32x16 = __attribute__((ext_vector_type(16))) float;
typedef short v4i16_t __attribute__((ext_vector_type(4)));
constexpr int C = 32, NSTEP = (SEQ + CTXL) / C;
constexpr int ST_Q = 0, ST_K = 16384, ST_V = 32768, ST_SC = 40960, ST_BYTES = 43008, NSTAGE = 3;
constexpr int XBUF_OFF = NSTAGE * ST_BYTES, RET_LDS = XBUF_OFF + NWAVES * 4096;
constexpr size_t WS_SSQ = 836 * MiB;
constexpr size_t WS_SC = 842 * MiB;

__device__ __forceinline__ void glds16(const void* gsrc, unsigned lds_dst) { unsigned keep;
    asm volatile("s_mov_b32 %0, m0\n\ts_mov_b32 m0, %2\n\ts_nop 0\n\tglobal_load_lds_dwordx4 %1, off\n\ts_mov_b32 m0, %0" : "=&s"(keep) : "v"(gsrc), "s"(lds_dst) : "memory"); }
__device__ __forceinline__ s16x4 vtr(const LAS char* p) { return __builtin_bit_cast(s16x4, __builtin_amdgcn_ds_read_tr16_b64_v4i16((LAS v4i16_t*)p)); }

__device__ __forceinline__ void ret_scores(Frame& F) {
    const bf16* Qh = (const bf16*)(F.ws + WS_QH0); const bf16* Kh = (const bf16*)(F.ws + WS_KH0); bf16* sc = (bf16*)(F.ws + WS_SC);
    const int gw = F.vcu * NWAVES + F.wave, NGW = F.G * NWAVES;
    const int r32 = F.lane & 31, hh = F.lane >> 5;
    for (int task = gw; task < (MALL / C) * RH; task += NGW) {
        const int h = task & 3, ch = task >> 2;
        const bf16* qp = Qh + ((size_t)h * MALL + (size_t)ch * C + r32) * 256 + hh * 8;
        const bf16* kp = Kh + ((size_t)h * MALL + (size_t)ch * C + r32) * 256 + hh * 8;
        f32x16 acc = f32x16{};
        bf16x8 a[16], b[16];
#pragma unroll
        for (int s = 0; s < 16; ++s) { a[s] = *reinterpret_cast<const bf16x8*>(qp + s * 16); b[s] = *reinterpret_cast<const bf16x8*>(kp + s * 16); }
#pragma unroll
        for (int s = 0; s < 16; ++s) acc = __builtin_amdgcn_mfma_f32_32x32x16_bf16(a[s], b[s], acc, 0, 0, 0);
        bf16* tp = sc + (size_t)task * 1024;
#pragma unroll
        for (int r = 0; r < 16; ++r) { const int i = (r & 3) + 8 * (r >> 2) + 4 * hh; tp[i * 32 + r32] = (bf16)f2bf(acc[r]); }
    }
}

__device__ __forceinline__ size_t step_row0(int b, int dir, int t) {
    if (t < 8) { const int blk = dir ? 7 - t : t; return (size_t)NLAT + (size_t)b * CTXL + (size_t)blk * C; }
    const int blk = dir ? 127 - (t - 8) : (t - 8); return (size_t)b * SEQ + (size_t)blk * C;
}

__device__ __forceinline__ void ret_scan(Frame& F, const Args& a) {
    const char* qb = (const char*)(F.ws + WS_QH0); const char* kb = (const char*)(F.ws + WS_KH0); const char* vb = (const char*)(F.ws + WS_VQ0); const char* scb = (const char*)(F.ws + WS_SC);
    for (int unit = F.vcu; unit < NBATCH * RH * 2 * 4; unit += F.G) {
        int tid_ = threadIdx.x; asm volatile("" : "+v"(tid_));
        const int tid = tid_, lane = tid & 63, w = __builtin_amdgcn_readfirstlane(tid >> 6), dh = w >> 2, vs = w & 3, r32 = lane & 31, hh = lane >> 5;
        const int vq = unit & 3, dir = (unit >> 2) & 1, h = (unit >> 3) & 3, b = unit >> 5;
        const float logit = a.in[I_L0_DECAY][dir * RH + h];
        const float lg2 = -__builtin_amdgcn_logf(1.0f + __builtin_amdgcn_exp2f(-logit * LOG2E));
        const float gC = __builtin_amdgcn_exp2f(lg2 * (float)C);
        float kd[2][8];
#pragma unroll
        for (int s = 0; s < 2; ++s)
#pragma unroll
            for (int jj = 0; jj < 8; ++jj) { const int j = 16 * s + 8 * hh + jj; kd[s][jj] = __builtin_amdgcn_exp2f(lg2 * (float)(dir ? j : 31 - j)); }
        const int om = 4 * w + (lane >> 4);
        const float rsc = __builtin_amdgcn_exp2f(-lg2 * (float)(dir ? om : 31 - om));
        unsigned pm[4];
#pragma unroll
        for (int e = 0; e < 4; ++e) { const int j0 = 16 * dh + 8 * hh + 2 * e, j1 = j0 + 1; const bool k0 = dir ? (j0 >= r32) : (j0 <= r32), k1 = dir ? (j1 >= r32) : (j1 <= r32);
            pm[e] = (k0 ? 0x0000ffffu : 0u) | (k1 ? 0xffff0000u : 0u); }
        unsigned offq[2], offk[2];
#pragma unroll
        for (int p = 0; p < 2; ++p) { const int i = 2 * (2 * w + p) + (lane >> 5), cp = lane & 31;
            offq[p] = (unsigned)(i * 512 + ((cp ^ (i & 15)) << 4)); offk[p] = (unsigned)(i * 512 + ((cp ^ ((i & 3) << 2)) << 4)); }
        unsigned offv; { const int j = 4 * w + (lane >> 4), cp = lane & 15; offv = (unsigned)(j * 256 + ((cp ^ ((j & 3) << 2)) << 4)); }
        const char* qhb = qb + (size_t)h * MALL * 512; const char* khb = kb + (size_t)h * MALL * 512; const char* vhb = vb + (size_t)(h * 4 + vq) * MALL * 256;
        unsigned offs; { const int i = 16 * (w & 1) + (lane >> 2), cp = lane & 3; offs = (unsigned)(i * 64 + ((cp ^ ((i >> 2) & 3)) << 4)); }
        LAS unsigned char* L = F.lds;
        const unsigned lbase = (unsigned)(uintptr_t)L;
#define RET_ISSUE(t_) do { const int t__ = (t_); const unsigned sb_ = lbase + (unsigned)((t__ % NSTAGE) * ST_BYTES); const size_t r0_ = step_row0(b, dir, t__); const char* gq_ = qhb + r0_ * 512; const char* gk_ = khb + r0_ * 512; const char* gv_ = vhb + r0_ * 256; \
        glds16(gq_ + offq[0], (unsigned)__builtin_amdgcn_readfirstlane(sb_ + ST_Q + (2 * w) * 1024)); \
        glds16(gq_ + offq[1], (unsigned)__builtin_amdgcn_readfirstlane(sb_ + ST_Q + (2 * w + 1) * 1024)); \
        glds16(gk_ + offk[0], (unsigned)__builtin_amdgcn_readfirstlane(sb_ + ST_K + (2 * w) * 1024)); \
        glds16(gk_ + offk[1], (unsigned)__builtin_amdgcn_readfirstlane(sb_ + ST_K + (2 * w + 1) * 1024)); \
        glds16(gv_ + offv, (unsigned)__builtin_amdgcn_readfirstlane(sb_ + ST_V + w * 1024)); \
        if (w < 2) glds16(scb + ((r0_ >> 5) * 4 + h) * 2048 + offs, (unsigned)__builtin_amdgcn_readfirstlane(sb_ + ST_SC + w * 1024)); } while (0)
        const int qrow = ST_Q + r32 * 512; const int qx = r32 & 15;
        const int G = lane >> 4, il = lane & 15, tq = il >> 2, tp = il & 3;
        const int kcolb = (128 * dh + 16 * (G & 1) + 8 * (tp & 1) + 4 * (tp >> 1)) * 2;
        const int vcolb = (32 * vs + 16 * (G & 1) + 4 * tp) * 2;
        f32x16 S[4];
#pragma unroll
        for (int T = 0; T < 4; ++T) S[T] = f32x16{};
        bf16* outp = (bf16*)(F.ws + (dir ? WS_OB : WS_OF));
        LAS float* xb_mine = (LAS float*)(L + XBUF_OFF + w * 4096);
        float* ssqp = (float*)(F.ws + WS_SSQ);

        __builtin_amdgcn_s_barrier();
        RET_ISSUE(0); RET_ISSUE(1);
        for (int t = 0; t < NSTEP; ++t) {
            if (t == 0) { if (w < 2) asm volatile("s_waitcnt vmcnt(6)" ::: "memory"); else asm volatile("s_waitcnt vmcnt(5)" ::: "memory"); }
            else if (t == NSTEP - 1) asm volatile("s_waitcnt vmcnt(4)" ::: "memory");
            else        { if (w < 2) asm volatile("s_waitcnt vmcnt(8)" ::: "memory"); else asm volatile("s_waitcnt vmcnt(7)" ::: "memory"); }
            __builtin_amdgcn_s_barrier(); asm volatile("" ::: "memory");
            if (t + 2 < NSTEP) RET_ISSUE(t + 2);
            const LAS char* sb = (const LAS char*)(L + (t % NSTAGE) * ST_BYTES);
            bf16x8 vd[2];
#pragma unroll
            for (int s = 0; s < 2; ++s) {
                const int j0 = 16 * s + 8 * (G >> 1) + tq;
                const int cph = (((vcolb >> 4) ^ (tq << 2)) << 4) + (vcolb & 8);
                const s16x4 lo = vtr(sb + ST_V + j0 * 256 + cph), hi = vtr(sb + ST_V + (j0 + 4) * 256 + cph);
                float f[8];
#pragma unroll
                for (int e = 0; e < 4; ++e) { f[e] = bf2f((unsigned short)lo[e]) * kd[s][e]; f[4 + e] = bf2f((unsigned short)hi[e]) * kd[s][4 + e]; }
                v4u pk; pk.x = pk2(f[0], f[1]); pk.y = pk2(f[2], f[3]); pk.z = pk2(f[4], f[5]); pk.w = pk2(f[6], f[7]);
                vd[s] = __builtin_bit_cast(bf16x8, pk);
            }
#pragma unroll
            for (int T = 0; T < 4; ++T) S[T] = S[T] * gC;
            f32x16 acc = f32x16{};
#pragma unroll
            for (int T = 0; T < 4; ++T)
#pragma unroll
                for (int s = 0; s < 2; ++s) {
                    const int cL = 16 * dh + 4 * T + 2 * s + hh;
                    const bf16x8 qa = *(const LAS bf16x8*)(sb + qrow + ((cL ^ qx) << 4));
                    v4u pk; pk.x = pk2(S[T][8 * s + 0], S[T][8 * s + 1]); pk.y = pk2(S[T][8 * s + 2], S[T][8 * s + 3]); pk.z = pk2(S[T][8 * s + 4], S[T][8 * s + 5]); pk.w = pk2(S[T][8 * s + 6], S[T][8 * s + 7]);
                    acc = __builtin_amdgcn_mfma_f32_32x32x16_bf16(qa, __builtin_bit_cast(bf16x8, pk), acc, 0, 0, 0);
                }
            {
                const int cL = 2 * dh + hh;
                v4u pw = *(const LAS v4u*)(sb + ST_SC + r32 * 64 + ((cL ^ ((r32 >> 2) & 3)) << 4));
                pw.x &= pm[0]; pw.y &= pm[1]; pw.z &= pm[2]; pw.w &= pm[3];
                acc = __builtin_amdgcn_mfma_f32_32x32x16_bf16(__builtin_bit_cast(bf16x8, pw), dh ? vd[1] : vd[0], acc, 0, 0, 0);
            }
#pragma unroll
            for (int T = 0; T < 4; ++T)
#pragma unroll
                for (int s = 0; s < 2; ++s) {
                    const int j0 = 16 * s + 8 * (G >> 1) + tq;
                    const int cb = kcolb + 64 * T;
                    const int cph = (((cb >> 4) ^ (tq << 2)) << 4) + (cb & 8);
                    const s16x4 lo = vtr(sb + ST_K + j0 * 512 + cph), hi = vtr(sb + ST_K + (j0 + 4) * 512 + cph);
                    const bf16x8 ka = (bf16x8){lo[0], lo[1], lo[2], lo[3], hi[0], hi[1], hi[2], hi[3]};
                    S[T] = __builtin_amdgcn_mfma_f32_32x32x16_bf16(ka, vd[s], S[T], 0, 0, 0);
                }
#pragma unroll
            for (int r = 0; r < 16; ++r) xb_mine[r * 64 + lane] = acc[r];
            asm volatile("s_waitcnt lgkmcnt(0)" ::: "memory");
            __builtin_amdgcn_s_barrier(); asm volatile("" ::: "memory");
            {
                const int v0 = (lane & 15) * 8, svs = v0 >> 5, c32 = v0 & 31, rr = (om & 3) + 4 * (om >> 3), sh = (om >> 2) & 1;
                const LAS float* p0 = (const LAS float*)(L + XBUF_OFF + svs * 4096) + rr * 64 + sh * 32 + c32;
                const LAS float* p1 = (const LAS float*)(L + XBUF_OFF + (4 + svs) * 4096) + rr * 64 + sh * 32 + c32;
                const f32x4 a0 = *(const LAS f32x4*)p0, a1 = *(const LAS f32x4*)(p0 + 4), b0 = *(const LAS f32x4*)p1, b1 = *(const LAS f32x4*)(p1 + 4);
                const f32x4 o0 = (a0 + b0) * rsc, o1 = (a1 + b1) * rsc;
                float ss = (o0.x * o0.x + o0.y * o0.y) + (o0.z * o0.z + o0.w * o0.w) + (o1.x * o1.x + o1.y * o1.y) + (o1.z * o1.z + o1.w * o1.w);
                ss += __shfl_xor(ss, 1); ss += __shfl_xor(ss, 2); ss += __shfl_xor(ss, 4); ss += __shfl_xor(ss, 8);
                const size_t r0 = step_row0(b, dir, t);
                v4u pk; pk.x = pk2(o0.x, o0.y); pk.y = pk2(o0.z, o0.w); pk.z = pk2(o1.x, o1.y); pk.w = pk2(o1.z, o1.w);
                *(GAS v4u*)(outp + (r0 + om) * 2048 + h * 512 + vq * 128 + v0) = pk;
                if ((lane & 15) == 0) ssqp[(((r0 + om) * RH + h) * 2 + dir) * 4 + vq] = ss;
            }
            asm volatile("s_waitcnt lgkmcnt(0)" ::: "memory");
        }
        asm volatile("s_waitcnt vmcnt(0)" ::: "memory");
#undef RET_ISSUE
    }
    __builtin_amdgcn_s_barrier();
}
}

__device__ __forceinline__ void moe_counts(Frame& F, int (&cnt)[NE]) {
#pragma unroll
    for (int e = 0; e < NE; ++e) cnt[e] = __builtin_amdgcn_readfirstlane((int)__hip_atomic_load((unsigned*)(F.ctl + CW_MOECNT + 64 * e), RLX_AGENT));
}
__device__ __forceinline__ void moe_gather(Frame& F) {
    int cnt[NE]; moe_counts(F, cnt);
    int base[NE]; int acc = 0;
#pragma unroll
    for (int e = 0; e < NE; ++e) { base[e] = acc; acc += (cnt[e] + 255) & ~255; }
    const int* te = (const int*)(F.ws + WS_ROUTE); int* tpos = (int*)(F.ws + WS_ROUTE + (size_t)NLAT * 8);
    const bf16* hb = (const bf16*)(F.ws + WS_H); bf16* hp = (bf16*)(F.ws + WS_HP);
    const int gw = F.vcu * NWAVES + F.wave, NGW = F.G * NWAVES;
    for (int r = gw; r < NLAT; r += NGW) {
        const int e0 = te[2 * r], e1 = te[2 * r + 1]; const int p0 = tpos[2 * r], p1 = tpos[2 * r + 1];
        int b0 = 0, b1 = 0;
#pragma unroll
        for (int e = 0; e < NE; ++e) { b0 = (e0 == e) ? base[e] : b0; b1 = (e1 == e) ? base[e] : b1; }
        const int s0 = b0 + p0, s1 = b1 + p1;
        const v4u x0 = *(const GAS v4u*)((const unsigned char*)hb + (size_t)r * D + F.lane * 16);
        *(GAS v4u*)((unsigned char*)hp + (size_t)s0 * D + F.lane * 16) = x0; *(GAS v4u*)((unsigned char*)hp + (size_t)s1 * D + F.lane * 16) = x0;
        if (F.lane == 0) { tpos[2 * r] = s0; tpos[2 * r + 1] = s1; }
    }
}
__device__ __forceinline__ void moe_order(Frame& F, pg8::MoeOrder& S, int nN) {
    int cnt[NE]; moe_counts(F, cnt);
    int ts[NE + 1]; ts[0] = 0;
#pragma unroll
    for (int e = 0; e < NE; ++e) ts[e + 1] = ts[e] + ((cnt[e] + 255) >> 8);
    S.nM = ts[NE]; S.nN = nN; S.nwg = S.nM * nN; S.G = F.G; S.c = F.cid;
    S.t1 = ts[1]; S.t2 = ts[2]; S.t3 = ts[3]; S.t4 = ts[4]; S.t5 = ts[5]; S.t6 = ts[6]; S.t7 = ts[7];
}

constexpr int N_PHASES = 22;
__global__ void __launch_bounds__(NTHREADS, 2) fwd(Args args) {
    extern __shared__ __attribute__((aligned(16))) unsigned char lds[];
    Frame F;
    F.lds = (LAS unsigned char*)lds; F.MISC = (volatile LAS unsigned*)(F.lds + MISC_OFF);
    F.tid = threadIdx.x; F.lane = F.tid & 63; F.wave = __builtin_amdgcn_readfirstlane(F.tid >> 6);
    F.G = gridDim.x; { const int bx = blockIdx.x; F.vcu = (F.G % 8 == 0) ? (bx % 8) * (F.G / 8) + bx / 8 : bx; F.cid = bx; }
    F.ws = args.ws; F.ctl = (gu32*)(args.ws + WS_CTL);
    for (int u = F.tid; u < 64; u += NTHREADS) ((LAS unsigned*)(F.lds + MISC_OFF))[u] = 0u;
    __syncthreads();
#if MK_PER_PHASE
    XcdBarrier bar; bar.bar = (unsigned*)(F.ctl + CW_BAR); bar.x = 0; bar.st = nullptr;
#define GRID_BAR() do { } while (0)
#else
    XcdBarrier bar = xcd_barrier_post((unsigned*)(F.ctl + CW_BAR), F.MISC + 8);
#define GRID_BAR() xcd_barrier(bar)
    if (F.tid == 0) { const unsigned x = xb_xcc_id(); F.MISC[16] = x; F.MISC[17] = __hip_atomic_fetch_add((unsigned*)(F.ctl + CW_XRANK + 64 * x), 1u, RLX_AGENT); }
#endif
    const int lo = args.ph_lo, hi = args.ph_hi;
#define IN(k) (lo <= (k) && (k) < hi)
#define SEAM(k) do { if (IN(k) && IN((k) + 1)) GRID_BAR(); } while (0)
    unsigned char* ws = args.ws;
    float* modv = (float*)(ws + WS_MODV);
    float* modv1 = modv + 9 * 6 * D;
    bf16* hbuf = (bf16*)(ws + WS_H);
    float* xctx = (float*)(ws + WS_XCTX);
    using pg8::Gemm; using pg8::StaticOrder;

    if (IN(0)) { for (int rep_ = 0; rep_ < ((PROBE_DUP & 1) ? 2 : 1); ++rep_) { p0_prologue(F, args); __syncthreads(); } SEAM(0); }
#if !MK_PER_PHASE
    if (IN(0) && IN(1)) {
        if (F.tid == 0) { const unsigned x = F.MISC[16]; unsigned pre = 0;
            for (unsigned j = 0; j < 16; ++j) { const unsigned c = __hip_atomic_load((unsigned*)(F.ctl + CW_XRANK + 64 * j), RLX_AGENT); pre += (j < x) ? c : 0u; }
            F.MISC[18] = pre + F.MISC[17]; }
        __syncthreads();
        F.vcu = __builtin_amdgcn_readfirstlane((int)F.MISC[18]); F.cid = (F.G % 8 == 0) ? (F.vcu % (F.G / 8)) * 8 + F.vcu / (F.G / 8) : F.vcu;
    }
#endif
    if (IN(1)) { RowPass P{MALL, args.in[I_X], args.in[I_CTX], nullptr, nullptr, nullptr, nullptr, nullptr, args.in[I_L0_NPREMIX], modv + 0 * D, modv + 1 * D, hbuf};
        row_pass<false, false, true, false>(F, args, P); SEAM(1); }
    if (IN(2)) { Gemm g{hbuf, (const bf16*)(ws + WS_W0IN), MALL, 4096, D, D}; StaticOrder S; S.init(MALL, 4096, F.G, F.cid);
        pg8::EpiQKV0 E{(bf16*)(ws + WS_QH0), (bf16*)(ws + WS_KH0), (bf16*)(ws + WS_VQ0), (const float*)(ws + WS_TAB0)};
        for (int rep_ = 0; rep_ < ((PROBE_DUP & 2) ? 2 : 1); ++rep_) { pg8::gemm_phase<pg8::EpiQKV0, StaticOrder, true, true>(F.lds, g, S, E); } if (IN(2) && IN(4)) GRID_BAR(); }
    if (IN(4)) { ret::ret_scores(F); SEAM(4); }
    if (IN(5)) { for (int rep_ = 0; rep_ < ((PROBE_DUP & 8) ? 2 : 1); ++rep_) ret::ret_scan(F, args); SEAM(5); }
    if (IN(6)) { Gemm g{hbuf, (const bf16*)(ws + WS_W0IN) + (size_t)4096 * D, MALL, 4096, D, D}; StaticOrder S; S.init(MALL, 4096, F.G, F.cid);
        pg8::EpiGateMerge E{(bf16*)(ws + WS_OF), (const bf16*)(ws + WS_OB), (const float*)(ws + ret::WS_SSQ)};
        pg8::gemm_phase<pg8::EpiGateMerge, StaticOrder, true, true>(F.lds, g, S, E); if (IN(6) && IN(8)) GRID_BAR(); }
    if (IN(8)) { Gemm g{(const bf16*)(ws + WS_OF), (const bf16*)(ws + WS_W0OUT), MALL, D, 2048, 2048}; pg8::SplitOrder S; S.init(D, F.G, F.cid, USE_SPLITK ? 8 : 0, 4);
        pg8::EpiStoreSplit E{(bf16*)(ws + WS_A), D, (float*)(ws + WS_PART)};
        for (int rep_ = 0; rep_ < ((PROBE_DUP & 32) ? 2 : 1); ++rep_) { pg8::gemm_phase<pg8::EpiStoreSplit, pg8::SplitOrder, true, true>(F.lds, g, S, E); } SEAM(8); }
    if (IN(9)) { RowPass P{MALL, args.in[I_X], args.in[I_CTX], args.out, xctx, (const bf16*)(ws + WS_A), args.in[I_L0_NPOSTMIX], modv + 2 * D, args.in[I_L0_NPREFFN], modv + 3 * D, modv + 4 * D, hbuf, (const float*)(ws + WS_PART)};
        row_pass<true, false, true, false, false, USE_SPLITK ? 8 : 0>(F, args, P); SEAM(9); }
    if (IN(10)) { Gemm g{hbuf, (const bf16*)(ws + WS_W0GU), MALL, 2 * DFF, D, D}; StaticOrder S; S.init(MALL, 2 * DFF, F.G, F.cid);
        pg8::EpiSwiglu E{(bf16*)(ws + WS_B), DFF};
        for (int rep_ = 0; rep_ < ((PROBE_DUP & 2) ? 2 : 1); ++rep_) { pg8::gemm_phase<pg8::EpiSwiglu, StaticOrder, true, true>(F.lds, g, S, E); } SEAM(10); }
    if (IN(11)) { Gemm g{(const bf16*)(ws + WS_B), (const bf16*)(ws + WS_W0DN), MALL, D, DFF, DFF}; pg8::SplitOrder S; S.init(D, F.G, F.cid, USE_SPLITK ? 11 : 0, 4);
        pg8::EpiStoreSplit E{(bf16*)(ws + WS_A), D, (float*)(ws + WS_PART)};
        for (int rep_ = 0; rep_ < ((PROBE_DUP & 32) ? 2 : 1); ++rep_) { pg8::gemm_phase<pg8::EpiStoreSplit, pg8::SplitOrder, true, true>(F.lds, g, S, E); } SEAM(11); }
    if (IN(12)) { RowPass P{MALL, args.out, xctx, args.out, xctx, (const bf16*)(ws + WS_A), args.in[I_L0_NPOSTFFN], modv + 5 * D, args.in[I_L1_NPREMIX], modv1 + 0 * D, modv1 + 1 * D, hbuf, (const float*)(ws + WS_PART)};
        row_pass<true, false, true, false, false, USE_SPLITK ? 11 : 0>(F, args, P); SEAM(12); }
    if (IN(13)) { Gemm g{hbuf, (const bf16*)(ws + WS_W1IN), MALL, 3072, D, D}; StaticOrder S; S.init(MALL, 3072, F.G, F.cid);
        pg8::EpiQKV1 E{(bf16*)(ws + WS_QH1), (bf16*)(ws + WS_KH1), (bf16*)(ws + WS_VH1), (const float*)(ws + WS_TAB1)};
        for (int rep_ = 0; rep_ < ((PROBE_DUP & 2) ? 2 : 1); ++rep_) { pg8::gemm_phase<pg8::EpiQKV1, StaticOrder, true, true>(F.lds, g, S, E); } if (IN(13) && IN(15)) GRID_BAR(); }
    if (IN(15)) { for (int rep_ = 0; rep_ < ((PROBE_DUP & 4) ? 2 : 1); ++rep_) attn_phase(F, args); SEAM(15); }
    if (IN(16)) { Gemm g{(const bf16*)(ws + WS_B), (const bf16*)(ws + WS_W1OUT), NLAT, D, D, D}; StaticOrder S; S.init(NLAT, D, F.G, F.cid);
        pg8::EpiStore E{(bf16*)(ws + WS_A), D};
        for (int rep_ = 0; rep_ < ((PROBE_DUP & 2) ? 2 : 1); ++rep_) { pg8::gemm_phase<pg8::EpiStore, StaticOrder, true, true>(F.lds, g, S, E); } SEAM(16); }
    if (IN(17)) { RowPass P{NLAT, args.out, xctx, args.out, xctx, (const bf16*)(ws + WS_A), args.in[I_L1_NPOSTMIX], modv1 + 2 * D, args.in[I_L1_NPREFFN], modv1 + 3 * D, modv1 + 4 * D, hbuf};
        row_pass<true, false, true, true, true>(F, args, P); SEAM(17); }
    if (IN(18)) { moe_gather(F); SEAM(18); }
    if (IN(19)) { Gemm g{(const bf16*)(ws + WS_HP), (const bf16*)(ws + WS_WMGU), MOE_ROWS, 2 * DFE, D / 2, D / 2, MOE_SA, MOE_SB}; pg8::MoeOrder S; moe_order(F, S, 2 * DFE / 256);
        pg8::EpiSwiglu8 E{(unsigned char*)(ws + WS_ACT1), DFE};
        for (int rep_ = 0; rep_ < ((PROBE_DUP & 16) ? 2 : 1); ++rep_) { pg8::gemm_phase<pg8::EpiSwiglu8, pg8::MoeOrder, true, true, true>(F.lds, g, S, E); } SEAM(19); }
    if (IN(20)) { Gemm g{(const bf16*)(ws + WS_ACT1), (const bf16*)(ws + WS_WMDN), MOE_ROWS, D, DFE / 2, DFE / 2, MOE_SA, MOE_SB}; pg8::MoeOrder S; moe_order(F, S, D / 256);
        pg8::EpiStore E{(bf16*)(ws + WS_Y1), D};
        for (int rep_ = 0; rep_ < ((PROBE_DUP & 16) ? 2 : 1); ++rep_) { pg8::gemm_phase<pg8::EpiStore, pg8::MoeOrder, true, true, true>(F.lds, g, S, E); } SEAM(20); }
    if (IN(21)) { RowPass P{NLAT, args.out, xctx, args.out, xctx, (const bf16*)(ws + WS_Y1), args.in[I_L1_NPOSTFFN], modv1 + 5 * D, nullptr, nullptr, nullptr, nullptr};
        row_pass<false, true, false, false>(F, args, P); }
#undef IN
#undef SEAM
}

extern "C" void kernel_launch(void* const* d_in, const int* in_sizes, int n_in, void* d_out, int out_size, void* d_ws, size_t ws_size, hipStream_t stream) {
    static int grid = 0;
    if (grid == 0) {
        if (n_in != N_IN || out_size != NLAT * D || ws_size < WS_END) { fprintf(stderr, "kernel_launch: unexpected shapes n_in %d out %d ws %zu\n", n_in, out_size, ws_size); grid = -1; return; }
        int dev = 0, cus = 0, per_cu = 0;
        if (hipGetDevice(&dev) != hipSuccess || hipDeviceGetAttribute(&cus, hipDeviceAttributeMultiprocessorCount, dev) != hipSuccess) { grid = -1; return; }
        if (hipFuncSetAttribute((const void*)fwd, hipFuncAttributeMaxDynamicSharedMemorySize, LDS_BYTES) != hipSuccess) { fprintf(stderr, "kernel_launch: hipFuncSetAttribute failed\n"); grid = -1; return; }
        if (hipOccupancyMaxActiveBlocksPerMultiprocessor(&per_cu, (const void*)fwd, NTHREADS, LDS_BYTES) != hipSuccess || per_cu < 1) fprintf(stderr, "kernel_launch: occupancy query says %d\n", per_cu);
        (void)hipGetLastError();
        grid = cus;
    }
    if (grid < 0) return;
    (void)hipMemsetAsync((char*)d_ws + WS_CTL, 0, CTL_ZERO_BYTES, stream);
    Args a{};
    for (int i = 0; i < N_IN; ++i) a.in[i] = (const float*)d_in[i];
    a.out = (float*)d_out; a.ws = (unsigned char*)d_ws;
#if MK_PER_PHASE
    for (int p = 0; p < N_PHASES; ++p) { a.ph_lo = p; a.ph_hi = p + 1; hipLaunchKernelGGL(fwd, dim3(grid), dim3(NTHREADS), LDS_BYTES, stream, a); }
#else
    a.ph_lo = 0; a.ph_hi = N_PHASES; hipLaunchKernelGGL(fwd, dim3(grid), dim3(NTHREADS), LDS_BYTES, stream, a);
#endif
}
```

```cpp
#include <hip/hip_runtime.h>
#include <cstdio>
#include <cstdint>
namespace pg8 {
#define PG8_LAS __attribute__((address_space(3)))
typedef unsigned short bf16_t;
typedef short bf16x8 __attribute__((ext_vector_type(8)));
typedef float f32x4 __attribute__((ext_vector_type(4)));
typedef unsigned u32x4 __attribute__((ext_vector_type(4)));
constexpr int BM = 256, BK = 64, HALF = 128, HTB = HALF * BK * 2  , STAGE_BYTES = 8 * HTB, NXCD = 8, WGM = 8;

__host__ __device__ __forceinline__ int lds_byte(int r, int c) { const int st = (r >> 4) * 2 + (c >> 5), rr = r & 15, cc = c & 31, ob = rr * 64 + cc * 2; return st * 1024 + (ob ^ (((ob >> 9) & 1) << 5)); }
__host__ __device__ __forceinline__ void stage_rc(int b, int& R, int& C) { const int st = b / 1024, sb = b % 1024, swz = sb ^ (((sb >> 9) & 1) << 5); R = (st >> 1) * 16 + swz / 64; C = (st & 1) * 32 + (swz % 64) / 2; }
__host__ __device__ __forceinline__ int perm32(int rho) { const int n = rho >> 4, i = rho & 15; return 8 * (i >> 2) + 4 * n + (i & 3); }

struct Unit { int pm, pn, pc, k0, nt, ks; };
struct Gemm { const bf16_t* A; const bf16_t* Bt; int M, N, K, lda; int sA, sB; };

struct StaticOrder {
    int nM, nN, nwg, G, c;
    __host__ __device__ void init(int M, int N, int G_, int c_) { nM = M / BM; nN = N / BM; nwg = nM * nN; G = G_; c = c_; }
    __host__ __device__ bool next(int i, Unit& u) const {
        const long L = (long)i * G + c; if (L >= nwg) return false;
        int wgid = (int)L; { const int q = nwg / NXCD, r = nwg % NXCD, xcd = wgid % NXCD, off = wgid / NXCD; wgid = (xcd < r ? xcd * (q + 1) : r * (q + 1) + (xcd - r) * q) + off; }
        const int nig = WGM * nN, gid = wgid / nig, fm = gid * WGM, gsz = (nM - fm) < WGM ? (nM - fm) : WGM;
        u.pm = fm + ((wgid % nig) % gsz); u.pn = (wgid % nig) / gsz; u.pc = u.pn; u.k0 = 0; u.nt = 0; u.ks = -1; return true;
    }
    __device__ __forceinline__ void a_ready(const Unit&) const {}
    __device__ __forceinline__ void done(const Unit&) const {}
};

__device__ __forceinline__ unsigned cvt_pk_bf16(float lo, float hi) { unsigned r; asm volatile("v_cvt_pk_bf16_f32 %0, %1, %2" : "=v"(r) : "v"(lo), "v"(hi)); return r; }
typedef float f32x2 __attribute__((ext_vector_type(2)));
typedef int v4i_t __attribute__((ext_vector_type(4))); typedef int v8i_t __attribute__((ext_vector_type(8)));
template <class Epi, class Sched, bool ALIGN_EPI = false, bool SP2 = false, bool FP8 = false>
__device__ __forceinline__ void gemm_phase(PG8_LAS unsigned char* lds, const Gemm g, const Sched& S, const Epi& E) {
    const int tid = threadIdx.x, wid = __builtin_amdgcn_readfirstlane(tid >> 6), lane = tid & 63, wr = wid >> 2, wc = wid & 3, fr = lane & 15, fq = lane >> 4;
    const int K = g.K; int nt = K / BK;
    unsigned voffA[2], voffB[2];
#pragma unroll
    for (int i = 0; i < 2; ++i) { int R, C; stage_rc(tid * 16 + i * 8192, R, C); const int Rb = Epi::PERM ? ((R & ~31) + perm32(R & 31)) : R;
        voffA[i] = (unsigned)(R * g.lda + C) * 2u; voffB[i] = (unsigned)(Rb * K + C) * 2u; }
    const size_t kstep = (size_t)(BK * 2);
    const size_t hstepA = (size_t)HALF * g.lda * 2, hstepB = (size_t)HALF * K * 2;
    const size_t tstepA = 2 * hstepA, tstepB = 2 * hstepB;
    const unsigned ldsw = (unsigned)wid * 1024u;
    const int aoff = lds_byte(wr * 64 + fr, fq * 8), boff = lds_byte(wc * 32 + fr, fq * 8);
#define PG8_SA(b, h) (((b) * 2 + (h)) * HTB)
#define PG8_SB(b, h) ((4 + (b) * 2 + (h)) * HTB)
#define PG8_STAGE(bufoff, gbase, voff) do { _Pragma("unroll") for (int _i = 0; _i < 2; ++_i) \
        __builtin_amdgcn_global_load_lds((const unsigned*)((const char*)(gbase) + (voff)[_i]), (PG8_LAS unsigned*)(lds + (bufoff) + ldsw + _i * 8192), 16, 0, 0); } while (0)
#define PG8_LDA(dst, b, h) do { if constexpr (FP8) { _Pragma("unroll") for (int m = 0; m < 4; ++m) { const v4i_t lo_ = *(const PG8_LAS v4i_t*)(lds + PG8_SA(b, h) + aoff + m * 2048), hi_ = *(const PG8_LAS v4i_t*)(lds + PG8_SA(b, h) + aoff + m * 2048 + 1024); \
        dst##8[m] = __builtin_shufflevector(lo_, hi_, 0, 1, 2, 3, 4, 5, 6, 7); } } \
    else { _Pragma("unroll") for (int m = 0; m < 4; ++m) _Pragma("unroll") for (int k = 0; k < 2; ++k) dst[m][k] = *(const PG8_LAS bf16x8*)(lds + PG8_SA(b, h) + aoff + m * 2048 + k * 1024); } } while (0)
#define PG8_LDB(dst, b, h) do { if constexpr (FP8) { _Pragma("unroll") for (int n = 0; n < 2; ++n) { const v4i_t lo_ = *(const PG8_LAS v4i_t*)(lds + PG8_SB(b, h) + boff + n * 2048), hi_ = *(const PG8_LAS v4i_t*)(lds + PG8_SB(b, h) + boff + n * 2048 + 1024); \
        dst##8[n] = __builtin_shufflevector(lo_, hi_, 0, 1, 2, 3, 4, 5, 6, 7); } } \
    else { _Pragma("unroll") for (int n = 0; n < 2; ++n) _Pragma("unroll") for (int k = 0; k < 2; ++k) dst[n][k] = *(const PG8_LAS bf16x8*)(lds + PG8_SB(b, h) + boff + n * 2048 + k * 1024); } } while (0)
#define PG8_MMA(ai, bj, At, Bt) do { __builtin_amdgcn_s_setprio(1); _Pragma("unroll") for (int m = 0; m < 4; ++m) _Pragma("unroll") for (int n = 0; n < 2; ++n) { \
        if constexpr (FP8) { asm volatile("v_mfma_scale_f32_16x16x128_f8f6f4 %0, %1, %2, %0, %3, %4 op_sel_hi:[0,0,0]" : "+v"(acc[ai][bj][m][n]) : "v"(Bt##8[n]), "v"(At##8[m]), "v"(sB_), "v"(sA_)); } \
        else { _Pragma("unroll") for (int k = 0; k < 2; ++k) acc[ai][bj][m][n] = __builtin_amdgcn_mfma_f32_16x16x32_bf16(Bt[n][k], At[m][k], acc[ai][bj][m][n], 0, 0, 0); } } \
        __builtin_amdgcn_s_setprio(0); } while (0)
#define PG8_WAIT_V(n) asm volatile("s_waitcnt vmcnt(" #n ")" ::: "memory")
#define PG8_WAIT_L(n) asm volatile("s_waitcnt lgkmcnt(" #n ")" ::: "memory")
#define PG8_BAR __builtin_amdgcn_s_barrier()
#define PG8_SCHED __builtin_amdgcn_sched_barrier(0)
    Unit cur, nxt; int ui = 0;
    if (!S.next(0, cur)) return;
    const int sA_ = g.sA, sB_ = g.sB;
    f32x4 acc[2][2][4][2];
#pragma unroll
    for (int a = 0; a < 2; ++a)
#pragma unroll
        for (int b = 0; b < 2; ++b)
#pragma unroll
            for (int m = 0; m < 4; ++m)
#pragma unroll
                for (int n = 0; n < 2; ++n) acc[a][b][m][n] = (f32x4){0.f, 0.f, 0.f, 0.f};
    bf16x8 At[4][2], B0[2][2], B1[2][2]; v8i_t At8[4], B08[2], B18[2];
    if (cur.nt) nt = cur.nt;
    const char* cA = (const char*)g.A + (size_t)cur.pm * tstepA + (size_t)cur.k0 * 2; const char* cB = (const char*)g.Bt + (size_t)cur.pn * tstepB + (size_t)cur.k0 * 2;
    S.a_ready(cur);
    if constexpr (SP2) {
        PG8_STAGE(PG8_SB(0, 0), cB, voffB); PG8_STAGE(PG8_SB(0, 1), cB + hstepB, voffB); PG8_STAGE(PG8_SA(0, 0), cA, voffA); PG8_STAGE(PG8_SA(0, 1), cA + hstepA, voffA);
        if (wr == 1) PG8_BAR;
        PG8_WAIT_V(2); PG8_BAR;
        PG8_STAGE(PG8_SB(1, 0), cB + kstep, voffB); PG8_STAGE(PG8_SA(1, 0), cA + kstep, voffA); PG8_STAGE(PG8_SB(1, 1), cB + hstepB + kstep, voffB);
        PG8_WAIT_V(6); PG8_BAR;
    } else {
        PG8_STAGE(PG8_SB(0, 0), cB, voffB); PG8_STAGE(PG8_SA(0, 0), cA, voffA); PG8_STAGE(PG8_SB(0, 1), cB + hstepB, voffB); PG8_STAGE(PG8_SA(0, 1), cA + hstepA, voffA);
        if (wr == 1) PG8_BAR;
        PG8_WAIT_V(4); PG8_BAR;
        PG8_STAGE(PG8_SB(1, 0), cB + kstep, voffB); PG8_STAGE(PG8_SA(1, 0), cA + kstep, voffA); PG8_STAGE(PG8_SB(1, 1), cB + hstepB + kstep, voffB);
        PG8_WAIT_V(6); PG8_BAR;
    }
    for (;;) {
        const bool has_next = S.next(ui + 1, nxt);
        const char* nA = has_next ? (const char*)g.A + (size_t)nxt.pm * tstepA + (size_t)nxt.k0 * 2 : cA; const char* nB = has_next ? (const char*)g.Bt + (size_t)nxt.pn * tstepB + (size_t)nxt.k0 * 2 : cB;
#pragma unroll 1
        for (int t = 0; t < nt; t += 2) {
            const bool last = (t == nt - 2);
            const char* a1 = cA + (size_t)(t + 1) * kstep;
            const char* a2 = last ? nA : cA + (size_t)(t + 2) * kstep; const char* b2 = last ? nB : cB + (size_t)(t + 2) * kstep;
            const char* a3 = a2 + kstep; const char* b3 = b2 + kstep;
            if (last && has_next) S.a_ready(nxt);
            if constexpr (SP2) {
            PG8_LDB(B0, 0, 0); PG8_LDB(B1, 0, 1); PG8_SCHED; PG8_LDA(At, 0, 0); PG8_STAGE(PG8_SA(1, 1), a1 + hstepA, voffA);
            PG8_WAIT_V(8); PG8_WAIT_L(0); PG8_BAR; PG8_MMA(0, 0, At, B0); PG8_MMA(0, 1, At, B1); PG8_BAR; PG8_SCHED;
            PG8_LDA(At, 0, 1); PG8_STAGE(PG8_SB(0, 0), b2, voffB); PG8_STAGE(PG8_SB(0, 1), b2 + hstepB, voffB); PG8_STAGE(PG8_SA(0, 0), a2, voffA);
            PG8_WAIT_V(8); PG8_WAIT_L(0); PG8_BAR; PG8_MMA(1, 0, At, B0); PG8_MMA(1, 1, At, B1); PG8_BAR; PG8_SCHED;
            PG8_LDB(B0, 1, 0); PG8_LDB(B1, 1, 1); PG8_SCHED; PG8_LDA(At, 1, 0); PG8_STAGE(PG8_SA(0, 1), a2 + hstepA, voffA);
            PG8_WAIT_V(8); PG8_WAIT_L(0); PG8_BAR; PG8_MMA(0, 0, At, B0); PG8_MMA(0, 1, At, B1); PG8_BAR; PG8_SCHED;
            PG8_LDA(At, 1, 1); PG8_STAGE(PG8_SB(1, 0), b3, voffB); PG8_STAGE(PG8_SB(1, 1), b3 + hstepB, voffB); PG8_STAGE(PG8_SA(1, 0), a3, voffA);
            PG8_WAIT_V(8); PG8_WAIT_L(0); PG8_BAR; PG8_MMA(1, 0, At, B0); PG8_MMA(1, 1, At, B1); PG8_BAR; PG8_SCHED;
            } else {
            PG8_LDB(B0, 0, 0); PG8_SCHED; PG8_LDA(At, 0, 0); PG8_STAGE(PG8_SA(1, 1), a1 + hstepA, voffA);
            PG8_WAIT_L(8); PG8_BAR; PG8_WAIT_L(0); PG8_MMA(0, 0, At, B0); PG8_BAR; PG8_SCHED;
            PG8_LDB(B1, 0, 1); PG8_STAGE(PG8_SB(0, 0), b2, voffB);
            PG8_BAR; PG8_WAIT_L(0); PG8_MMA(0, 1, At, B1); PG8_BAR;
            PG8_LDA(At, 0, 1); PG8_STAGE(PG8_SA(0, 0), a2, voffA);
            PG8_BAR; PG8_WAIT_L(0); PG8_MMA(1, 0, At, B0); PG8_BAR; PG8_SCHED;
            PG8_STAGE(PG8_SB(0, 1), b2 + hstepB, voffB);
            PG8_WAIT_V(6); PG8_BAR; PG8_MMA(1, 1, At, B1); PG8_BAR;
            PG8_LDB(B0, 1, 0); PG8_SCHED; PG8_LDA(At, 1, 0); PG8_STAGE(PG8_SA(0, 1), a2 + hstepA, voffA);
            PG8_WAIT_L(8); PG8_BAR; PG8_WAIT_L(0); PG8_MMA(0, 0, At, B0); PG8_BAR; PG8_SCHED;
            PG8_LDB(B1, 1, 1); PG8_STAGE(PG8_SB(1, 0), b3, voffB);
            PG8_BAR; PG8_WAIT_L(0); PG8_MMA(0, 1, At, B1); PG8_BAR;
            PG8_LDA(At, 1, 1); PG8_STAGE(PG8_SA(1, 0), a3, voffA);
            PG8_BAR; PG8_WAIT_L(0); PG8_MMA(1, 0, At, B0); PG8_BAR; PG8_SCHED;
            PG8_STAGE(PG8_SB(1, 1), b3 + hstepB, voffB);
            PG8_WAIT_V(6); PG8_BAR; PG8_MMA(1, 1, At, B1); PG8_BAR;
            }
        }
        if constexpr (FP8) asm volatile("s_nop 15\n\ts_nop 15" ::: "memory");
        if constexpr (ALIGN_EPI) { if (wr == 0) PG8_BAR; }
        if constexpr (!Epi::AFTER_DRAIN) { E(acc, cur, wr, wc, fr, fq); S.done(cur); }
        if (!has_next) break;
#pragma unroll
        for (int a = 0; a < 2; ++a)
#pragma unroll
            for (int b = 0; b < 2; ++b)
#pragma unroll
                for (int m = 0; m < 4; ++m)
#pragma unroll
                    for (int n = 0; n < 2; ++n) acc[a][b][m][n] = (f32x4){0.f, 0.f, 0.f, 0.f};
        cur = nxt; cA = nA; cB = nB; ++ui; nt = cur.nt ? cur.nt : K / BK;
        if constexpr (ALIGN_EPI) { if (wr == 1) PG8_BAR; }
    }
    PG8_WAIT_V(0);
    if constexpr (!ALIGN_EPI) { if (wr == 0) PG8_BAR; }
    PG8_BAR;
    if constexpr (Epi::AFTER_DRAIN) { E.fused(acc, cur, wr, wc, fr, fq, lds, wid, lane); S.done(cur); }
#undef PG8_SA
#undef PG8_SB
#undef PG8_STAGE
#undef PG8_LDA
#undef PG8_LDB
#undef PG8_MMA
#undef PG8_WAIT_V
#undef PG8_WAIT_L
#undef PG8_BAR
#undef PG8_SCHED
}
}

#ifndef PROBE_DUP
#define PROBE_DUP 0
#endif
#ifndef USE_SPLITK
#define USE_SPLITK 0
#endif
#ifndef MK_PER_PHASE
#define MK_PER_PHASE 0
#endif
constexpr int D = 1024, NBATCH = 8, SEQ = 4096, NLAT = NBATCH * SEQ, CTXL = 256, NCTX = NBATCH * CTXL, MALL = NLAT + NCTX;
constexpr int RH = 4, RQK = 256, RV = 512;
constexpr int DFF = 2816, NE = 8, DFE = 3584;
constexpr float EPS = 1e-6f;
constexpr float LAMBDA_INIT = 0.3555090675909693f;
constexpr float LOG2E = 1.4426950408889634f;
constexpr int NWAVES = 8, NTHREADS = 512;
constexpr float MOE_WSCALE = 64.0f; constexpr int MOE_SB = 0x79797979, MOE_SA = 0x7f7f7f7f;
constexpr int MOE_ROWS = 2 * NLAT + NE * 256;

enum { I_X = 0, I_C, I_CTX, I_CCTX, I_L0_WMOD, I_L0_BMOD, I_L0_NPREMIX, I_L0_NPOSTMIX, I_L0_NPREFFN, I_L0_NPOSTFFN, I_L0_WIN, I_L0_DECAY, I_L0_WOUT, I_L0_WGU, I_L0_WDN,
       I_L1_WMOD, I_L1_BMOD, I_L1_NPREMIX, I_L1_NPOSTMIX, I_L1_NPREFFN, I_L1_NPOSTFFN, I_L1_WIN, I_L1_LAMBDA, I_L1_SUBLN, I_L1_WOUT, I_L1_RW, I_L1_RB, I_L1_MGU, I_L1_MDN, N_IN };

constexpr size_t MiB = 1u << 20;
constexpr size_t WS_CTL = 0, CTL_ZERO_BYTES = 1 * MiB;
constexpr size_t WS_MODV = 1 * MiB;
constexpr size_t WS_TAB0 = 1 * MiB + 512 * 1024;
constexpr size_t WS_TAB1 = WS_TAB0 + 32 * 1024;
constexpr size_t WS_LAM = WS_TAB1 + 8 * 1024;
constexpr size_t WS_ROUTE = 2 * MiB;
constexpr size_t WS_XCTX = 3 * MiB;
constexpr size_t WS_W0IN = 11 * MiB, WS_W0OUT = 27 * MiB, WS_W0GU = 31 * MiB, WS_W0DN = 42 * MiB, WS_W1IN = 48 * MiB, WS_W1OUT = 54 * MiB, WS_WMGU = 56 * MiB, WS_WMDN = 168 * MiB;
constexpr size_t WS_H = 224 * MiB;
constexpr size_t WS_A = 292 * MiB, WS_B = 564 * MiB;
constexpr size_t WS_OF = WS_B, WS_OB = WS_B + 136 * MiB;
constexpr size_t WS_QH0 = WS_A, WS_KH0 = WS_A + 68 * MiB, WS_VQ0 = WS_A + 136 * MiB;
constexpr size_t WS_QH1 = WS_A, WS_KH1 = WS_A + 68 * MiB, WS_VH1 = WS_A + 136 * MiB;
constexpr size_t WS_HP = WS_A, WS_ACT1 = 424 * MiB, WS_Y1 = WS_A;
constexpr size_t WS_PART = WS_A + 128 * MiB;
constexpr size_t WS_END = 886 * MiB;
static_assert(WS_ACT1 + (size_t)MOE_ROWS * DFE * 2 <= WS_END, "ws map");
static_assert(WS_HP + (size_t)MOE_ROWS * D * 2 <= WS_ACT1, "ws map");
constexpr int CW_TMO = 0;
constexpr int CW_BAR = 4096;
constexpr int CW_XRANK = 12288;
constexpr int CW_MOECNT = 16384;

constexpr int RING_BYTES = 131072;
constexpr int LDS_BYTES = 163840;
constexpr int MISC_OFF = LDS_BYTES - 256;

#define GAS __attribute__((address_space(1)))
#define LAS __attribute__((address_space(3)))
typedef unsigned short bf16;
typedef unsigned v4u __attribute__((ext_vector_type(4)));
typedef unsigned v2u __attribute__((ext_vector_type(2)));
typedef float f32x4 __attribute__((ext_vector_type(4)));
typedef float f32x2 __attribute__((ext_vector_type(2)));
typedef short bf16x8 __attribute__((ext_vector_type(8)));
typedef GAS unsigned gu32;
#define RLX_AGENT __ATOMIC_RELAXED, __HIP_MEMORY_SCOPE_AGENT
#define LDS_WAIT() asm volatile("s_waitcnt lgkmcnt(0)" ::: "memory")
#define VM_WAIT() asm volatile("s_waitcnt vmcnt(0)" ::: "memory")
__device__ __forceinline__ unsigned pk2(float lo, float hi);
__device__ __forceinline__ unsigned f2bf(float f) { return pk2(f, 0.f) & 0xffffu; }
typedef float f32x2_cv __attribute__((ext_vector_type(2))); typedef __bf16 bf16x2_cv __attribute__((ext_vector_type(2)));
__device__ __forceinline__ unsigned pk2(float lo, float hi) { f32x2_cv v = {lo, hi}; bf16x2_cv b = __builtin_convertvector(v, bf16x2_cv); return __builtin_bit_cast(unsigned, b); }
__device__ __forceinline__ float bf2f(unsigned b) { return __builtin_bit_cast(float, b << 16); }
__device__ __forceinline__ float bflo(unsigned w) { return __builtin_bit_cast(float, w << 16); }
__device__ __forceinline__ float bfhi(unsigned w) { return __builtin_bit_cast(float, w & 0xffff0000u); }
__device__ __forceinline__ unsigned pk4_fp8(float a, float b, float c, float d) {
    a = __builtin_amdgcn_fmed3f(a, -448.f, 448.f); b = __builtin_amdgcn_fmed3f(b, -448.f, 448.f); c = __builtin_amdgcn_fmed3f(c, -448.f, 448.f); d = __builtin_amdgcn_fmed3f(d, -448.f, 448.f);
    int w = 0; w = __builtin_amdgcn_cvt_pk_fp8_f32(a, b, w, false); w = __builtin_amdgcn_cvt_pk_fp8_f32(c, d, w, true); return (unsigned)w; }
__device__ __forceinline__ float fast_exp2(float x) { return __builtin_amdgcn_exp2f(x); }
__device__ __forceinline__ float silu_f(float g) { return g * __builtin_amdgcn_rcpf(1.0f + __builtin_amdgcn_exp2f(-g * LOG2E)); }
__device__ __forceinline__ float wave_sum(float v) {
#pragma unroll
    for (int o = 1; o < 64; o <<= 1) v += __shfl_xor(v, o);
    return v;
}

#define XB_TMO      128
#define XB_XCNT(j)  (256  + 64 * (j))
#define XB_XSUB(j)  (1280 + 64 * (j))
#define XB_XGEN(j)  (2304 + 64 * (j))
#define XB_TOP      3328
#define XB_TOPGEN   3392
#define XCD_BAR_WORDS 3456
#define XB_SPIN_CAP (1u << 24)

__device__ __forceinline__ unsigned xb_ld(unsigned* p)              { return __hip_atomic_load(p, __ATOMIC_RELAXED, __HIP_MEMORY_SCOPE_AGENT); }
__device__ __forceinline__ unsigned xb_add(unsigned* p, unsigned v) { return __hip_atomic_fetch_add(p, v, __ATOMIC_RELAXED, __HIP_MEMORY_SCOPE_AGENT); }
__device__ __forceinline__ unsigned xb_xcc_id() { return (unsigned)__builtin_amdgcn_s_getreg((3 << 11) | 20) & 0xFu; }
#define XB_SPIN(cond, bar) do { unsigned _sp = 0; while (cond) { __builtin_amdgcn_s_sleep(1); \
    if ((++_sp & 255u) == 0u) { if (xb_ld(&(bar)[XB_TMO])) break; if (_sp > XB_SPIN_CAP) { atomicAdd(&(bar)[XB_TMO], 1u); break; } } } } while (0)

struct XcdBarrier {
    unsigned* bar; unsigned x;
    volatile LAS unsigned* st;
};

__device__ __forceinline__ XcdBarrier xcd_barrier_post(unsigned* bar, volatile LAS unsigned* st) {
    XcdBarrier b; b.bar = bar; b.x = xb_xcc_id(); b.st = st;
    if (threadIdx.x == 0) (void)xb_add(&bar[XB_XCNT(b.x)], 1u);
    return b;
}
__device__ __forceinline__ void xcd_barrier_complete(unsigned* bar, unsigned x, unsigned& nloc, unsigned& nx) {
    const unsigned G = gridDim.x * gridDim.y * gridDim.z;
    unsigned sum, cnt, mine, sp = 0u;
    for (;;) {
        sum = 0u; cnt = 0u; mine = 0u;
#pragma unroll
        for (unsigned j = 0; j < 16; ++j) { const unsigned c = xb_ld(&bar[XB_XCNT(j)]); sum += c; cnt += (c > 0u) ? 1u : 0u; mine = (j == x) ? c : mine; }
        if (sum == G) break;
        __builtin_amdgcn_s_sleep(1);
        if ((++sp & 255u) == 0u) { if (xb_ld(&bar[XB_TMO])) break; if (sp > XB_SPIN_CAP) { atomicAdd(&bar[XB_TMO], 1u); break; } }
    }
    nloc = mine > 0u ? mine : 1u; nx = cnt > 0u ? cnt : 1u;
}

__device__ __forceinline__ void xcd_barrier(const XcdBarrier& b) {
    asm volatile("s_waitcnt vmcnt(0)" ::: "memory");
    __syncthreads();
    if (threadIdx.x == 0) {
        unsigned* bar = b.bar;
        __builtin_amdgcn_s_waitcnt(0);
        unsigned nloc = b.st[0], nx = b.st[1];
        if (nloc == 0u) { xcd_barrier_complete(bar, b.x, nloc, nx); b.st[0] = nloc; b.st[1] = nx; }
        const unsigned old = xb_add(&bar[XB_XSUB(b.x)], 1u);
        const unsigned gen = old / nloc;
        if (old + 1u == (gen + 1u) * nloc) {
            __builtin_amdgcn_fence(__ATOMIC_RELEASE, "agent");
            asm volatile("s_waitcnt vmcnt(0)" ::: "memory");
            const unsigned og = xb_add(&bar[XB_TOP], 1u);
            const unsigned tg = og / nx;
            if (og + 1u == (tg + 1u) * nx) xb_add(&bar[XB_TOPGEN], 1u);
            else XB_SPIN(xb_ld(&bar[XB_TOPGEN]) == tg, bar);
            __builtin_amdgcn_fence(__ATOMIC_ACQUIRE, "agent");
            xb_add(&bar[XB_XGEN(b.x)], 1u);
            asm volatile("s_waitcnt vmcnt(0)" ::: "memory");
        } else {
            XB_SPIN(xb_ld(&bar[XB_XGEN(b.x)]) == gen, bar);
            __builtin_amdgcn_fence(__ATOMIC_ACQUIRE, "agent");
            asm volatile("s_waitcnt vmcnt(0)" ::: "memory");
        }
    }
    __syncthreads();
}


struct Args { const float* in[N_IN]; float* out; unsigned char* ws; int ph_lo, ph_hi; };

struct Frame {
    LAS unsigned char* lds;
    volatile LAS unsigned* MISC;
    gu32* ctl;
    int tid, lane, wave, vcu, G, cid;
    unsigned char* ws;
};

namespace pg8 {
struct EpiStore {
    static constexpr bool PERM = true, AFTER_DRAIN = false;
    bf16_t* O; int ldc;
    __device__ __forceinline__ void operator()(const f32x4 (&acc)[2][2][4][2], const Unit& u, int wr, int wc, int fr, int fq) const {
        const int row0 = u.pm * BM + wr * 64 + fr; const int col0 = u.pc * BM + wc * 32 + 8 * fq;
#pragma unroll
        for (int ai = 0; ai < 2; ++ai)
#pragma unroll
            for (int m = 0; m < 4; ++m) { bf16_t* rowp = O + (size_t)(row0 + ai * HALF + m * 16) * ldc + col0;
#pragma unroll
                for (int bj = 0; bj < 2; ++bj) { const f32x4 v0 = acc[ai][bj][m][0], v1 = acc[ai][bj][m][1];
                    u32x4 w; w.x = cvt_pk_bf16(v0[0], v0[1]); w.y = cvt_pk_bf16(v0[2], v0[3]); w.z = cvt_pk_bf16(v1[0], v1[1]); w.w = cvt_pk_bf16(v1[2], v1[3]);
                    *(u32x4*)(rowp + bj * HALF) = w; } }
    }
};
struct EpiSwiglu {
    static constexpr bool PERM = true, AFTER_DRAIN = false;
    bf16_t* O; int ldc;
    __device__ __forceinline__ void operator()(const f32x4 (&acc)[2][2][4][2], const Unit& u, int wr, int wc, int fr, int fq) const {
        const int row0 = u.pm * BM + wr * 64 + fr; const int col0 = u.pc * HALF + wc * 32 + 8 * fq;
#pragma unroll
        for (int ai = 0; ai < 2; ++ai)
#pragma unroll
            for (int m = 0; m < 4; ++m) { bf16_t* rowp = O + (size_t)(row0 + ai * HALF + m * 16) * ldc + col0;
                f32x4 a0, a1;
#pragma unroll
                for (int e = 0; e < 4; ++e) { a0[e] = silu_f(acc[ai][0][m][0][e]) * acc[ai][1][m][0][e]; a1[e] = silu_f(acc[ai][0][m][1][e]) * acc[ai][1][m][1][e]; }
                u32x4 w; w.x = cvt_pk_bf16(a0[0], a0[1]); w.y = cvt_pk_bf16(a0[2], a0[3]); w.z = cvt_pk_bf16(a1[0], a1[1]); w.w = cvt_pk_bf16(a1[2], a1[3]);
                *(u32x4*)rowp = w; }
    }
};

struct EpiQKV0 {
    static constexpr bool PERM = true, AFTER_DRAIN = false;
    bf16_t* Qh; bf16_t* Kh; bf16_t* Vq; const float* tab;
    __device__ __forceinline__ void operator()(const f32x4 (&acc)[2][2][4][2], const Unit& u, int wr, int wc, int fr, int fq) const {
        const int row0 = u.pm * BM + wr * 64 + fr, pc = u.pc;
        if (pc < 8) {
            bf16_t* base = pc < 4 ? Qh + (size_t)pc * MALL * 256 : Kh + (size_t)(pc - 4) * MALL * 256; const float sc = pc < 4 ? 1.0f : 0.0625f; const bool lat = u.pm < NLAT / BM;
            const int col0 = wc * 32 + 8 * fq;
#pragma unroll
            for (int ai = 0; ai < 2; ++ai)
#pragma unroll
                for (int m = 0; m < 4; ++m) { const int row = row0 + ai * HALF + m * 16, t = row & (SEQ - 1);
#pragma unroll
                    for (int bj = 0; bj < 2; ++bj) { f32x4 v0 = acc[ai][bj][m][0], v1 = acc[ai][bj][m][1];
                        if (lat) { const int pos = bj ? (t & 63) : (t >> 6); const float* tp = tab + (size_t)(pos * 64 + 16 * wc + 4 * fq) * 2;
                            const f32x4 c0 = *(const f32x4*)tp, c1 = *(const f32x4*)(tp + 4);
                            v0 = (f32x4){v0[0] * c0[0] - v0[1] * c0[1], v0[1] * c0[0] + v0[0] * c0[1], v0[2] * c0[2] - v0[3] * c0[3], v0[3] * c0[2] + v0[2] * c0[3]};
                            v1 = (f32x4){v1[0] * c1[0] - v1[1] * c1[1], v1[1] * c1[0] + v1[0] * c1[1], v1[2] * c1[2] - v1[3] * c1[3], v1[3] * c1[2] + v1[2] * c1[3]}; }
                        v0 = v0 * sc; v1 = v1 * sc;
                        u32x4 w; w.x = cvt_pk_bf16(v0[0], v0[1]); w.y = cvt_pk_bf16(v0[2], v0[3]); w.z = cvt_pk_bf16(v1[0], v1[1]); w.w = cvt_pk_bf16(v1[2], v1[3]);
                        *(u32x4*)(base + (size_t)row * 256 + col0 + bj * HALF) = w; } }
        } else {
#pragma unroll
            for (int ai = 0; ai < 2; ++ai)
#pragma unroll
                for (int m = 0; m < 4; ++m) { const int row = row0 + ai * HALF + m * 16;
#pragma unroll
                    for (int bj = 0; bj < 2; ++bj) { const f32x4 v0 = acc[ai][bj][m][0], v1 = acc[ai][bj][m][1];
                        u32x4 w; w.x = cvt_pk_bf16(v0[0], v0[1]); w.y = cvt_pk_bf16(v0[2], v0[3]); w.z = cvt_pk_bf16(v1[0], v1[1]); w.w = cvt_pk_bf16(v1[2], v1[3]);
                        *(u32x4*)(Vq + ((size_t)((pc - 8) * 2 + bj) * MALL + row) * 128 + wc * 32 + 8 * fq) = w; } }
        }
    }
};
struct EpiQKV1 {
    static constexpr bool PERM = true, AFTER_DRAIN = false;
    bf16_t* Qh; bf16_t* Kh; bf16_t* Vh; const float* tab;
    __device__ __forceinline__ void operator()(const f32x4 (&acc)[2][2][4][2], const Unit& u, int wr, int wc, int fr, int fq) const {
        const int row0 = u.pm * BM + wr * 64 + fr, pc = u.pc;
        if (pc < 8) {
            bf16_t* base = pc < 4 ? Qh : Kh; const float sc = pc < 4 ? 0.125f * LOG2E : 1.0f; const bool lat = u.pm < NLAT / BM;
            const int hf = wc & 1, p0 = 32 * hf + 8 * fq;
#pragma unroll
            for (int ai = 0; ai < 2; ++ai)
#pragma unroll
                for (int m = 0; m < 4; ++m) { const int row = row0 + ai * HALF + m * 16, t = row & (SEQ - 1);
                    const int pos = hf ? (t & 63) : (t >> 6); const float* tp = tab + (size_t)(pos * 16 + 4 * fq) * 2;
                    f32x4 c0 = (f32x4){1.f, 0.f, 1.f, 0.f}, c1 = c0;
                    if (lat) { c0 = *(const f32x4*)tp; c1 = *(const f32x4*)(tp + 4); }
#pragma unroll
                    for (int bj = 0; bj < 2; ++bj) { f32x4 v0 = acc[ai][bj][m][0], v1 = acc[ai][bj][m][1];
                        v0 = (f32x4){v0[0] * c0[0] - v0[1] * c0[1], v0[1] * c0[0] + v0[0] * c0[1], v0[2] * c0[2] - v0[3] * c0[3], v0[3] * c0[2] + v0[2] * c0[3]};
                        v1 = (f32x4){v1[0] * c1[0] - v1[1] * c1[1], v1[1] * c1[0] + v1[0] * c1[1], v1[2] * c1[2] - v1[3] * c1[3], v1[3] * c1[2] + v1[2] * c1[3]};
                        v0 = v0 * sc; v1 = v1 * sc;
                        const int head = (pc & 3) * 4 + 2 * bj + (wc >> 1);
                        u32x4 w; w.x = cvt_pk_bf16(v0[0], v0[1]); w.y = cvt_pk_bf16(v0[2], v0[3]); w.z = cvt_pk_bf16(v1[0], v1[1]); w.w = cvt_pk_bf16(v1[2], v1[3]);
                        *(u32x4*)(base + ((size_t)head * MALL + row) * 64 + p0) = w; } }
        } else {
#pragma unroll
            for (int ai = 0; ai < 2; ++ai)
#pragma unroll
                for (int m = 0; m < 4; ++m) { const int row = row0 + ai * HALF + m * 16;
#pragma unroll
                    for (int bj = 0; bj < 2; ++bj) { const f32x4 v0 = acc[ai][bj][m][0], v1 = acc[ai][bj][m][1];
                        u32x4 w; w.x = cvt_pk_bf16(v0[0], v0[1]); w.y = cvt_pk_bf16(v0[2], v0[3]); w.z = cvt_pk_bf16(v1[0], v1[1]); w.w = cvt_pk_bf16(v1[2], v1[3]);
                        *(u32x4*)(Vh + ((size_t)((pc - 8) * 2 + bj) * MALL + row) * 128 + wc * 32 + 8 * fq) = w; } }
        }
    }
};

struct EpiGateMerge {
    static constexpr bool PERM = true, AFTER_DRAIN = false;
    bf16_t* Of; const bf16_t* Ob; const float* ssq;
    __device__ __forceinline__ void operator()(const f32x4 (&acc)[2][2][4][2], const Unit& u, int wr, int wc, int fr, int fq) const {
        const int row0 = u.pm * BM + wr * 64 + fr; const int col0 = u.pc * HALF + wc * 32 + 8 * fq; const int head = u.pc >> 2;
#pragma unroll
        for (int ai = 0; ai < 2; ++ai)
#pragma unroll
            for (int m = 0; m < 4; ++m) { const size_t row = (size_t)(row0 + ai * HALF + m * 16);
                const f32x4 sf = *(const f32x4*)(ssq + (row * RH + head) * 8), sb = *(const f32x4*)(ssq + (row * RH + head) * 8 + 4);
                const float rf = __builtin_amdgcn_rsqf(((sf[0] + sf[1]) + (sf[2] + sf[3])) * (1.0f / RV) + EPS), rb = __builtin_amdgcn_rsqf(((sb[0] + sb[1]) + (sb[2] + sb[3])) * (1.0f / RV) + EPS);
                const u32x4 of = *(const u32x4*)(Of + row * 2048 + col0), ob = *(const u32x4*)(Ob + row * 2048 + col0);
                float y[8];
#pragma unroll
                for (int e = 0; e < 4; ++e) {
                    const float gf0 = acc[ai][0][m][e >> 1][2 * (e & 1)], gf1 = acc[ai][0][m][e >> 1][2 * (e & 1) + 1], gb0 = acc[ai][1][m][e >> 1][2 * (e & 1)], gb1 = acc[ai][1][m][e >> 1][2 * (e & 1) + 1];
                    y[2 * e] = silu_f(gf0) * (bflo(of[e]) * rf) + silu_f(gb0) * (bflo(ob[e]) * rb);
                    y[2 * e + 1] = silu_f(gf1) * (bfhi(of[e]) * rf) + silu_f(gb1) * (bfhi(ob[e]) * rb); }
                u32x4 w; w.x = cvt_pk_bf16(y[0], y[1]); w.y = cvt_pk_bf16(y[2], y[3]); w.z = cvt_pk_bf16(y[4], y[5]); w.w = cvt_pk_bf16(y[6], y[7]);
                *(u32x4*)(Of + row * 2048 + col0) = w; }
    }
};

struct SplitOrder {
    StaticOrder lat; int G, c, KS, ntS, nN, nl;
    __device__ void init(int N, int G_, int c_, int KS_, int ntS_) { lat.init(KS_ ? NLAT : MALL, N, G_, c_); G = G_; c = c_; KS = KS_; ntS = ntS_; nN = N / BM; nl = (lat.nwg > c_) ? (lat.nwg - 1 - c_) / G_ + 1 : 0; }
    __device__ bool next(int i, Unit& u) const {
        if (i < nl) return lat.next(i, u);
        const long j = (long)(i - nl) * G + c; if (j >= (long)(NCTX / BM) * nN * KS) return false;
        const int tile = (int)(j / KS), ks = (int)(j % KS);
        u.pm = NLAT / BM + tile / nN; u.pn = tile % nN; u.pc = u.pn; u.k0 = ks * ntS * BK; u.nt = ntS; u.ks = ks; return true;
    }
    __device__ __forceinline__ void a_ready(const Unit&) const {}
    __device__ __forceinline__ void done(const Unit&) const {}
};
struct EpiStoreSplit {
    static constexpr bool PERM = true, AFTER_DRAIN = false;
    bf16_t* O; int ldc; float* P;
    __device__ __forceinline__ void operator()(const f32x4 (&acc)[2][2][4][2], const Unit& u, int wr, int wc, int fr, int fq) const {
        const int row0 = u.pm * BM + wr * 64 + fr; const int col0 = u.pc * BM + wc * 32 + 8 * fq;
        if (u.ks < 0) {
#pragma unroll
            for (int ai = 0; ai < 2; ++ai)
#pragma unroll
                for (int m = 0; m < 4; ++m) { bf16_t* rowp = O + (size_t)(row0 + ai * HALF + m * 16) * ldc + col0;
#pragma unroll
                    for (int bj = 0; bj < 2; ++bj) { const f32x4 v0 = acc[ai][bj][m][0], v1 = acc[ai][bj][m][1];
                        u32x4 w; w.x = cvt_pk_bf16(v0[0], v0[1]); w.y = cvt_pk_bf16(v0[2], v0[3]); w.z = cvt_pk_bf16(v1[0], v1[1]); w.w = cvt_pk_bf16(v1[2], v1[3]);
                        *(u32x4*)(rowp + bj * HALF) = w; } }
        } else {
            float* pb = P + (size_t)u.ks * NCTX * ldc;
#pragma unroll
            for (int ai = 0; ai < 2; ++ai)
#pragma unroll
                for (int m = 0; m < 4; ++m) { float* rowp = pb + (size_t)(row0 - NLAT + ai * HALF + m * 16) * ldc + col0;
#pragma unroll
                    for (int bj = 0; bj < 2; ++bj) { *(f32x4*)(rowp + bj * HALF) = acc[ai][bj][m][0]; *(f32x4*)(rowp + bj * HALF + 4) = acc[ai][bj][m][1]; } }
        }
    }
};
struct EpiSwiglu8 {
    static constexpr bool PERM = true, AFTER_DRAIN = false;
    unsigned char* O; int ldc;
    __device__ __forceinline__ void operator()(const f32x4 (&acc)[2][2][4][2], const Unit& u, int wr, int wc, int fr, int fq) const {
        const int row0 = u.pm * BM + wr * 64 + fr; const int col0 = u.pc * HALF + wc * 32 + 8 * fq;
#pragma unroll
        for (int ai = 0; ai < 2; ++ai)
#pragma unroll
            for (int m = 0; m < 4; ++m) { unsigned char* rowp = O + (size_t)(row0 + ai * HALF + m * 16) * ldc + col0;
                f32x4 a0, a1;
#pragma unroll
                for (int e = 0; e < 4; ++e) { a0[e] = silu_f(acc[ai][0][m][0][e]) * acc[ai][1][m][0][e]; a1[e] = silu_f(acc[ai][0][m][1][e]) * acc[ai][1][m][1][e]; }
                v2u w; w.x = pk4_fp8(a0[0], a0[1], a0[2], a0[3]); w.y = pk4_fp8(a1[0], a1[1], a1[2], a1[3]);
                *(v2u*)rowp = w; }
    }
};
struct MoeOrder {
    int nM, nN, nwg, G, c; int t1, t2, t3, t4, t5, t6, t7;
    __device__ bool next(int i, Unit& u) const {
        const long L = (long)i * G + c; if (L >= nwg) return false;
        int wgid = (int)L; { const int q = nwg / NXCD, r = nwg % NXCD, xcd = wgid % NXCD, off = wgid / NXCD; wgid = (xcd < r ? xcd * (q + 1) : r * (q + 1) + (xcd - r) * q) + off; }
        const int nig = WGM * nN, gid = wgid / nig, fm = gid * WGM, gsz = (nM - fm) < WGM ? (nM - fm) : WGM;
        u.pm = fm + ((wgid % nig) % gsz); u.pc = (wgid % nig) / gsz;
        const int e = (u.pm >= t1) + (u.pm >= t2) + (u.pm >= t3) + (u.pm >= t4) + (u.pm >= t5) + (u.pm >= t6) + (u.pm >= t7);
        u.pn = e * nN + u.pc; u.k0 = 0; u.nt = 0; u.ks = -1; return true;
    }
    __device__ __forceinline__ void a_ready(const Unit&) const {}
    __device__ __forceinline__ void done(const Unit&) const {}
};
}

__device__ __forceinline__ void p0_transpose_item(const float* W, int K, int N, bf16* WT, int drow0, LAS float* scr, int k0, int n0, int lane, int mode = 0) {
#pragma unroll 8
    for (int i = 0; i < 32; ++i) { const int kk = 2 * i + (lane >> 5); scr[kk * 33 + (lane & 31)] = W[(size_t)(k0 + kk) * N + n0 + (lane & 31)]; }
    LDS_WAIT(); asm volatile("" ::: "memory");
    const int c = lane & 7;
#pragma unroll
    for (int j = 0; j < 4; ++j) { const int n = (lane >> 3) + 8 * j; const LAS float* s = scr + (8 * c) * 33 + n;
        v4u o; o.x = pk2(s[0 * 33], s[1 * 33]); o.y = pk2(s[2 * 33], s[3 * 33]); o.z = pk2(s[4 * 33], s[5 * 33]); o.w = pk2(s[6 * 33], s[7 * 33]);
        const int dr = mode == 0 ? n : (mode == 1 ? 2 * n : 2 * (n & 15) + (n >> 4));
        *(GAS v4u*)(WT + (size_t)(drow0 + dr) * K + k0 + 8 * c) = o; }
    LDS_WAIT(); asm volatile("" ::: "memory");
}
__device__ __forceinline__ void p0_transpose_item8(const float* W, int K, int N, unsigned char* WT, int drow0, LAS float* scr, int k0, int n0, int lane, float wscale, int mode = 0) {
#pragma unroll 8
    for (int i = 0; i < 32; ++i) { const int kk = 2 * i + (lane >> 5); scr[kk * 33 + (lane & 31)] = W[(size_t)(k0 + kk) * N + n0 + (lane & 31)]; }
    LDS_WAIT(); asm volatile("" ::: "memory");
    const int n = lane >> 1, kh = (lane & 1) * 32; const LAS float* sp = scr + kh * 33 + n;
    v4u o0, o1;
#pragma unroll
    for (int q = 0; q < 4; ++q) { o0[q] = pk4_fp8(sp[(4 * q) * 33] * wscale, sp[(4 * q + 1) * 33] * wscale, sp[(4 * q + 2) * 33] * wscale, sp[(4 * q + 3) * 33] * wscale);
        o1[q] = pk4_fp8(sp[(16 + 4 * q) * 33] * wscale, sp[(17 + 4 * q) * 33] * wscale, sp[(18 + 4 * q) * 33] * wscale, sp[(19 + 4 * q) * 33] * wscale); }
    const int dr = mode == 0 ? n : (mode == 1 ? 2 * n : 2 * (n & 15) + (n >> 4));
    GAS v4u* dst = (GAS v4u*)(WT + (size_t)(drow0 + dr) * K + k0 + kh); dst[0] = o0; dst[1] = o1;
    LDS_WAIT(); asm volatile("" ::: "memory");
}
__device__ __forceinline__ int swiglu_row(int n0, int F) { const int bj = n0 / F, w = n0 % F; return 256 * (w >> 7) + 128 * bj + (w & 127); }

__device__ __forceinline__ void p0_prologue(Frame& F, const Args& a) {
    LAS float* scr = (LAS float*)(F.lds + F.wave * 16384);
    const int gw = F.vcu * NWAVES + F.wave, NGW = F.G * NWAVES;
    constexpr int I0 = (D / 64) * (8192 / 32), I1 = (2048 / 64) * (D / 32), I2 = (D / 64) * (2 * DFF / 32), I3 = (DFF / 64) * (D / 32), I4 = (D / 64) * (3072 / 32), I5 = (D / 64) * (D / 32);
    constexpr int I6E = (D / 64) * (2 * DFE / 32), I7E = (DFE / 64) * (D / 32);
    constexpr int NITEMS = I0 + I1 + I2 + I3 + I4 + I5 + NE * I6E + NE * I7E;
    for (int it = gw; it < NITEMS; it += NGW) {
        int r = it;
        if (r < I0) { const int nb = r % (8192 / 32), kb = r / (8192 / 32); const int n0 = 32 * nb; int dr0 = n0, md = 0;
            if (n0 < 2048) { const int d0 = n0 & 255, hf = d0 >> 7, e = d0 & 127, sx = e >> 6, i0 = e & 63; dr0 = (n0 - d0) + 2 * (hf * 64 + i0) + sx; md = 1; }
            else if (n0 >= 4096) { dr0 = 4096 + swiglu_row(n0 - 4096, 2048); }
            p0_transpose_item(a.in[I_L0_WIN], D, 8192, (bf16*)(F.ws + WS_W0IN), dr0, scr, 64 * kb, n0, F.lane, md); continue; } r -= I0;
        if (r < I1) { const int nb = r % (D / 32), kb = r / (D / 32); p0_transpose_item(a.in[I_L0_WOUT], 2048, D, (bf16*)(F.ws + WS_W0OUT), 32 * nb, scr, 64 * kb, 32 * nb, F.lane); continue; } r -= I1;
        if (r < I2) { const int nb = r % (2 * DFF / 32), kb = r / (2 * DFF / 32); p0_transpose_item(a.in[I_L0_WGU], D, 2 * DFF, (bf16*)(F.ws + WS_W0GU), swiglu_row(32 * nb, DFF), scr, 64 * kb, 32 * nb, F.lane); continue; } r -= I2;
        if (r < I3) { const int nb = r % (D / 32), kb = r / (D / 32); p0_transpose_item(a.in[I_L0_WDN], DFF, D, (bf16*)(F.ws + WS_W0DN), 32 * nb, scr, 64 * kb, 32 * nb, F.lane); continue; } r -= I3;
        if (r < I4) { const int nb = r % (3072 / 32), kb = r / (3072 / 32); const int n0 = 32 * nb; int dr0 = n0, md = 0;
            if (n0 < 2048) { md = 2; }
            p0_transpose_item8(a.in[I_L1_WIN], D, 3072, (unsigned char*)(F.ws + WS_W1IN), dr0, scr, 64 * kb, n0, F.lane, MOE_WSCALE, md); continue; } r -= I4;
        if (r < I5) { const int nb = r % (D / 32), kb = r / (D / 32); p0_transpose_item(a.in[I_L1_WOUT], D, D, (bf16*)(F.ws + WS_W1OUT), 32 * nb, scr, 64 * kb, 32 * nb, F.lane); continue; } r -= I5;
        if (r < NE * I6E) { const int e = r / I6E, rr = r % I6E; const int nb = rr % (2 * DFE / 32), kb = rr / (2 * DFE / 32);
            p0_transpose_item8(a.in[I_L1_MGU] + (size_t)e * D * 2 * DFE, D, 2 * DFE, (unsigned char*)(F.ws + WS_WMGU) + (size_t)e * 2 * DFE * D, swiglu_row(32 * nb, DFE), scr, 64 * kb, 32 * nb, F.lane, MOE_WSCALE); continue; } r -= NE * I6E;
        { const int e = r / I7E, rr = r % I7E; const int nb = rr % (D / 32), kb = rr / (D / 32);
            p0_transpose_item8(a.in[I_L1_MDN] + (size_t)e * DFE * D, DFE, D, (unsigned char*)(F.ws + WS_WMDN) + (size_t)e * D * DFE, 32 * nb, scr, 64 * kb, 32 * nb, F.lane, MOE_WSCALE); }
    }
    __syncthreads();
    {
        LAS float* sc = (LAS float*)F.lds;
        LAS float* part = (LAS float*)(F.lds + 9 * 1024 * 4);
        bool loaded = false;
        for (int grp = F.vcu; grp < 2 * (6 * D / 64); grp += F.G) {
            if (!loaded) { for (int i = F.tid; i < 9 * 1024; i += NTHREADS) { const float cv = (i < 8 * 1024) ? a.in[I_C][i] : a.in[I_CCTX][i - 8 * 1024]; sc[i] = silu_f(cv); } loaded = true; }
            __syncthreads();
            const int layer = grp / (6 * D / 64), cb = (grp % (6 * D / 64)) * 64;
            const float* W = a.in[layer ? I_L1_WMOD : I_L0_WMOD]; const float* bm = a.in[layer ? I_L1_BMOD : I_L0_BMOD];
            const int ks = F.tid >> 6, col = F.tid & 63;
            float acc[9];
#pragma unroll
            for (int b = 0; b < 9; ++b) acc[b] = 0.f;
            for (int k = ks * 128; k < ks * 128 + 128; ++k) { const float w = W[(size_t)k * (6 * D) + cb + col];
#pragma unroll
                for (int b = 0; b < 9; ++b) acc[b] += sc[b * 1024 + k] * w; }
#pragma unroll
            for (int b = 0; b < 9; ++b) part[(ks * 9 + b) * 64 + col] = acc[b];
            __syncthreads();
            for (int o = F.tid; o < 9 * 64; o += NTHREADS) { const int b = o >> 6, cc = o & 63; float s = bm[cb + cc];
#pragma unroll
                for (int k2 = 0; k2 < 8; ++k2) s += part[(k2 * 9 + b) * 64 + cc];
                ((float*)(F.ws + WS_MODV))[((size_t)layer * 9 + b) * (6 * D) + cb + cc] = s; }
            __syncthreads();
        }
    }
    {
        const int gt = F.vcu * NTHREADS + F.tid;
        if (gt < 64 * 64 + 64 * 16) {
            int pos, i; float ex;
            if (gt < 4096) { pos = gt >> 6; i = gt & 63; ex = (float)(2 * i) / 128.0f; } else { const int q = gt - 4096; pos = q >> 4; i = q & 15; ex = (float)(2 * i) / 32.0f; }
            const float freq = __builtin_amdgcn_exp2f(-ex * 13.287712379549449f);
            const float rev = (float)pos * freq * 0.15915494309189535f;
            const float cs = __builtin_amdgcn_cosf(rev), sn = __builtin_amdgcn_sinf(rev);
            f32x2* t = (f32x2*)(F.ws + (gt < 4096 ? WS_TAB0 : WS_TAB1)); t[gt < 4096 ? gt : gt - 4096] = (f32x2){cs, sn};
        }
        if (gt == 0) { const float* lp = a.in[I_L1_LAMBDA]; float s1 = 0.f, s2 = 0.f; for (int i = 0; i < 64; ++i) { s1 += lp[i] * lp[64 + i]; s2 += lp[128 + i] * lp[192 + i]; }
            *(float*)(F.ws + WS_LAM) = __expf(s1) - __expf(s2) + LAMBDA_INIT; }
    }
}

struct RowPass {
    int nrows;
    const float* xin_lat; const float* xin_ctx; float* xout_lat; float* xout_ctx;
    const bf16* br;
    const float* gpost;
    const float* gate;
    const float* gpre;
    const float* shift; const float* scale;
    bf16* hout;
    const float* part;
};
template <bool BR, bool MOEBR, bool WH, bool ROUTE, bool H8 = false, int KSPL = 0>
__device__ __forceinline__ void row_pass(Frame& F, const Args& a, const RowPass& P) {
    const int gw = F.vcu * NWAVES + F.wave, NGW = F.G * NWAVES;
    const int l4 = F.lane * 4;
    for (int r = gw; r < P.nrows; r += NGW) {
        const bool lat = r < NLAT; const int rc = lat ? r : r - NLAT; const int midx = lat ? (r >> 12) : 8;
        const float* xin = (lat ? P.xin_lat : P.xin_ctx) + (size_t)rc * D;
        float* xout = (lat ? P.xout_lat : P.xout_ctx) + (size_t)rc * D;
        f32x4 v[4];
#pragma unroll
        for (int j = 0; j < 4; ++j) v[j] = *(const GAS f32x4*)(xin + l4 + 256 * j);
        if constexpr (BR || MOEBR) {
            f32x4 y[4];
            if constexpr (BR) {
                if (KSPL > 0 && !lat) {
#pragma unroll
                    for (int j = 0; j < 4; ++j) y[j] = (f32x4){0.f, 0.f, 0.f, 0.f};
                    for (int ks = 0; ks < KSPL; ++ks) { const float* pr = P.part + ((size_t)ks * NCTX + rc) * D + l4;
#pragma unroll
                        for (int j = 0; j < 4; ++j) y[j] = y[j] + *(const GAS f32x4*)(pr + 256 * j); }
                } else {
#pragma unroll
                for (int j = 0; j < 4; ++j) { const v2u w = *(const GAS v2u*)(P.br + (size_t)r * D + l4 + 256 * j); y[j] = (f32x4){bflo(w.x), bfhi(w.x), bflo(w.y), bfhi(w.y)}; }
                }
            } else {
                const int* tpos = (const int*)(F.ws + WS_ROUTE + (size_t)NLAT * 8); const float* tw = (const float*)(F.ws + WS_ROUTE + (size_t)NLAT * 16);
                const int s0 = tpos[2 * r], s1 = tpos[2 * r + 1]; const float w0 = tw[2 * r], w1 = tw[2 * r + 1];
#pragma unroll
                for (int j = 0; j < 4; ++j) { const v2u p = *(const GAS v2u*)(P.br + (size_t)s0 * D + l4 + 256 * j); const v2u q = *(const GAS v2u*)(P.br + (size_t)s1 * D + l4 + 256 * j);
                    y[j] = (f32x4){w0 * bflo(p.x) + w1 * bflo(q.x), w0 * bfhi(p.x) + w1 * bfhi(q.x), w0 * bflo(p.y) + w1 * bflo(q.y), w0 * bfhi(p.y) + w1 * bfhi(q.y)}; }
            }
            float ss = 0.f;
#pragma unroll
            for (int j = 0; j < 4; ++j) ss += (y[j].x * y[j].x + y[j].y * y[j].y) + (y[j].z * y[j].z + y[j].w * y[j].w);
            const float rstd = 1.0f / sqrtf(wave_sum(ss) * (1.0f / D) + EPS);
#pragma unroll
            for (int j = 0; j < 4; ++j) { const f32x4 gp = *(const GAS f32x4*)(P.gpost + l4 + 256 * j); const f32x4 gt = *(const GAS f32x4*)(P.gate + (size_t)midx * 6 * D + l4 + 256 * j);
                v[j] = v[j] + gt * (y[j] * rstd * gp); }
#pragma unroll
            for (int j = 0; j < 4; ++j) *(GAS f32x4*)(xout + l4 + 256 * j) = v[j];
        }
        if constexpr (WH) {
            float ss = 0.f;
#pragma unroll
            for (int j = 0; j < 4; ++j) ss += (v[j].x * v[j].x + v[j].y * v[j].y) + (v[j].z * v[j].z + v[j].w * v[j].w);
            const float rstd = 1.0f / sqrtf(wave_sum(ss) * (1.0f / D) + EPS);
            f32x4 h[4];
#pragma unroll
            for (int j = 0; j < 4; ++j) { const f32x4 gp = *(const GAS f32x4*)(P.gpre + l4 + 256 * j); const f32x4 sc = *(const GAS f32x4*)(P.scale + (size_t)midx * 6 * D + l4 + 256 * j);
                const f32x4 sh = *(const GAS f32x4*)(P.shift + (size_t)midx * 6 * D + l4 + 256 * j);
                h[j] = (v[j] * rstd * gp) * (1.0f + sc) + sh;
                if constexpr (H8) { *(GAS unsigned*)((unsigned char*)P.hout + (size_t)r * D + l4 + 256 * j) = pk4_fp8(h[j].x, h[j].y, h[j].z, h[j].w); }
                else { v2u w; w.x = pk2(h[j].x, h[j].y); w.y = pk2(h[j].z, h[j].w); *(GAS v2u*)(P.hout + (size_t)r * D + l4 + 256 * j) = w; } }
            if constexpr (ROUTE) {
                const float* rw = a.in[I_L1_RW];
                float lg[8];
#pragma unroll
                for (int e = 0; e < 8; ++e) lg[e] = 0.f;
#pragma unroll
                for (int j = 0; j < 4; ++j)
#pragma unroll
                    for (int q = 0; q < 4; ++q) { const int k = l4 + 256 * j + q; const f32x4 wa = *(const GAS f32x4*)(rw + (size_t)k * 8), wb = *(const GAS f32x4*)(rw + (size_t)k * 8 + 4); const float hv = h[j][q];
                        lg[0] += hv * wa.x; lg[1] += hv * wa.y; lg[2] += hv * wa.z; lg[3] += hv * wa.w; lg[4] += hv * wb.x; lg[5] += hv * wb.y; lg[6] += hv * wb.z; lg[7] += hv * wb.w; }
#pragma unroll
                for (int e = 0; e < 8; ++e) lg[e] = wave_sum(lg[e]) + a.in[I_L1_RB][e];
                float v1 = lg[0]; int i1 = 0;
#pragma unroll
                for (int e = 1; e < 8; ++e) if (lg[e] > v1) { v1 = lg[e]; i1 = e; }
                float v2 = -3.0e38f; int i2 = 0;
#pragma unroll
                for (int e = 0; e < 8; ++e) if (e != i1 && lg[e] > v2) { v2 = lg[e]; i2 = e; }
                const float w1 = 1.0f / (1.0f + __expf(v2 - v1)), w2 = 1.0f - w1;
                if (F.lane == 0) {
                    int* te = (int*)(F.ws + WS_ROUTE); int* tpos = (int*)(F.ws + WS_ROUTE + (size_t)NLAT * 8); float* tw = (float*)(F.ws + WS_ROUTE + (size_t)NLAT * 16);
                    const unsigned p1 = __hip_atomic_fetch_add((unsigned*)(F.ctl + CW_MOECNT + 64 * i1), 1u, RLX_AGENT);
                    const unsigned p2 = __hip_atomic_fetch_add((unsigned*)(F.ctl + CW_MOECNT + 64 * i2), 1u, RLX_AGENT);
                    te[2 * r] = i1; te[2 * r + 1] = i2; tpos[2 * r] = (int)p1; tpos[2 * r + 1] = (int)p2; tw[2 * r] = w1; tw[2 * r + 1] = w2;
                }
            }
        }
    }
}


namespace att {
using s16x4  = __attribute__((ext_vector_type(4))) short;
using f32x16 = __attribute__((ext_vector_type(16))) float;
using u32x4  = __attribute__((ext_vector_type(4))) unsigned;
constexpr int KVBLK = 64, NT = (SEQ + CTXL) / KVBLK;
constexpr int SHM_V = KVBLK * 128 * 2, SHM_K = KVBLK * 64 * 2;
constexpr int NSLOT_K = 3, NSLOT_V = 4;
constexpr int OFF_V = 0, OFF_K = NSLOT_V * SHM_V, OFF_WS = OFF_K + NSLOT_K * SHM_K, OFF_O1 = OFF_WS + NWAVES * 64 * 4, ATT_LDS = OFF_O1 + NWAVES * 8192;
constexpr float THR = 8.0f;
#define ATT_SBAR() __builtin_amdgcn_sched_barrier(0)
#define ATT_PIPE_PV() do { __builtin_amdgcn_sched_group_barrier(0x100, 2, 0); \
    _Pragma("unroll") for (int i_ = 0; i_ < 16; ++i_) { __builtin_amdgcn_sched_group_barrier(0x008, 1, 0); __builtin_amdgcn_sched_group_barrier(0x100, 2, 0); __builtin_amdgcn_sched_group_barrier(0x002, 7, 0); } } while (0)
#define KSWZ64(row, colB) ((row) * 128 + ((colB) ^ ((((row) >> 1) & 7) << 4)))
__device__ __forceinline__ int crow(int r, int hi) { return (r & 3) + 8 * (r >> 2) + 4 * hi; }
__device__ __forceinline__ unsigned cvtpk(float lo, float hi) { return pk2(lo, hi); }

template <int VAR = 0> __device__ __forceinline__ void partialSM(f32x16& p0, f32x16& p1, float& m_reg, f32x16& negm, float& alpha) {
    float mx[4];
#pragma unroll
    for (int c = 0; c < 4; ++c) mx[c] = fmaxf(fmaxf(p0[4 * c], p0[4 * c + 1]), fmaxf(p0[4 * c + 2], p0[4 * c + 3]));
#pragma unroll
    for (int c = 0; c < 4; ++c) mx[c] = fmaxf(mx[c], fmaxf(fmaxf(p1[4 * c], p1[4 * c + 1]), fmaxf(p1[4 * c + 2], p1[4 * c + 3])));
    float pmax = fmaxf(fmaxf(mx[0], mx[1]), fmaxf(mx[2], mx[3]));
    { auto rr = __builtin_amdgcn_permlane32_swap(__float_as_uint(pmax), __float_as_uint(pmax), false, false); pmax = fmaxf(__uint_as_float(rr[0]), __uint_as_float(rr[1])); }
    alpha = 1.f; m_reg = pmax;
#pragma unroll
    for (int r = 0; r < 16; ++r) { negm[r] = -pmax; p0[r] = __builtin_amdgcn_exp2f(p0[r] - pmax); p1[r] = __builtin_amdgcn_exp2f(p1[r] - pmax); }
}
template <int VAR = 0> __device__ __forceinline__ void finishSM(f32x16& p0, f32x16& p1, float alpha, float& l_reg, bf16x8& pa0, bf16x8& pa1, bf16x8& pa2, bf16x8& pa3) {
    if (VAR != 2) {
    f32x2 s2[4];
#pragma unroll
    for (int c = 0; c < 4; ++c) s2[c] = (f32x2){p0[4 * c], p0[4 * c + 1]} + (f32x2){p0[4 * c + 2], p0[4 * c + 3]};
#pragma unroll
    for (int c = 0; c < 4; ++c) s2[c] = s2[c] + ((f32x2){p1[4 * c], p1[4 * c + 1]} + (f32x2){p1[4 * c + 2], p1[4 * c + 3]});
    const f32x2 s2t = (s2[0] + s2[1]) + (s2[2] + s2[3]);
    float ps = s2t[0] + s2t[1];
    { auto rr = __builtin_amdgcn_permlane32_swap(__float_as_uint(ps), __float_as_uint(ps), false, false); ps = __uint_as_float(rr[0]) + __uint_as_float(rr[1]); }
    l_reg = l_reg * alpha + ps;
    } else { l_reg = 1.f; }
#define ATT_PK4(P, BASE, OUT) do { u32x4 w = {cvtpk(P[BASE + 0], P[BASE + 1]), cvtpk(P[BASE + 2], P[BASE + 3]), cvtpk(P[BASE + 4], P[BASE + 5]), cvtpk(P[BASE + 6], P[BASE + 7])}; OUT = *reinterpret_cast<bf16x8*>(&w); } while (0)
    ATT_PK4(p0, 0, pa0); ATT_PK4(p0, 8, pa1); ATT_PK4(p1, 0, pa2); ATT_PK4(p1, 8, pa3);
#undef ATT_PK4
}
__device__ __forceinline__ void qkt(f32x16& p0, f32x16& p1, const char* Ks, const bf16x8* qr, const f32x16& negm, int r32, int hi) {
#pragma unroll
    for (int d0 = 0; d0 < 4; ++d0) { const int cb = (d0 * 16 + hi * 8) * 2;
        const bf16x8 b0 = *reinterpret_cast<const bf16x8*>(Ks + KSWZ64(r32, cb));
        const bf16x8 b1 = *reinterpret_cast<const bf16x8*>(Ks + KSWZ64(32 + r32, cb));
        if (d0 == 0) { p0 = __builtin_amdgcn_mfma_f32_32x32x16_bf16(b0, qr[0], negm, 0, 0, 0); p1 = __builtin_amdgcn_mfma_f32_32x32x16_bf16(b1, qr[0], negm, 0, 0, 0); }
        else { p0 = __builtin_amdgcn_mfma_f32_32x32x16_bf16(b0, qr[d0], p0, 0, 0, 0); p1 = __builtin_amdgcn_mfma_f32_32x32x16_bf16(b1, qr[d0], p1, 0, 0, 0); } }
}
__device__ __forceinline__ int v_st(int k, int c) { const int kk = (k & ~0xC) | ((k & 4) << 1) | ((k & 8) >> 1); return ((kk >> 3) * 4 + (c >> 5)) * 512 + ((kk & 7) * 32 + (c & 31)) * 2; }
__device__ __forceinline__ int v_rd_base(int lane) { return ((lane & 3) << 3) | (((lane >> 2) & 3) << 6) | (((lane >> 4) & 1) << 5) | (((lane >> 5) & 1) << 8); }
constexpr int v_rd_off(int d0, int ks, int half) { return d0 * 512 + ks * 4096 + half * 2048; }
typedef short v4i16a_t __attribute__((ext_vector_type(4)));
template <int OFF> __device__ __forceinline__ s16x4 tr_read(int vb) { return __builtin_bit_cast(s16x4, __builtin_amdgcn_ds_read_tr16_b64_v4i16((LAS v4i16a_t*)(unsigned)(vb + OFF))); }
#define ATT_PK(L, H) (bf16x8){L[0], L[1], L[2], L[3], H[0], H[1], H[2], H[3]}
template <int D0> __device__ __forceinline__ void pv_one(f32x16& od, int vb, bf16x8 pa0, bf16x8 pa1, bf16x8 pa2, bf16x8 pa3) {
    const s16x4 l0 = tr_read<v_rd_off(D0, 0, 0)>(vb), h0 = tr_read<v_rd_off(D0, 0, 1)>(vb), l1 = tr_read<v_rd_off(D0, 1, 0)>(vb), h1 = tr_read<v_rd_off(D0, 1, 1)>(vb);
    const s16x4 l2 = tr_read<v_rd_off(D0, 2, 0)>(vb), h2 = tr_read<v_rd_off(D0, 2, 1)>(vb), l3 = tr_read<v_rd_off(D0, 3, 0)>(vb), h3 = tr_read<v_rd_off(D0, 3, 1)>(vb);
    od = __builtin_amdgcn_mfma_f32_32x32x16_bf16(pa0, ATT_PK(l0, h0), od, 0, 0, 0);
    od = __builtin_amdgcn_mfma_f32_32x32x16_bf16(pa1, ATT_PK(l1, h1), od, 0, 0, 0);
    od = __builtin_amdgcn_mfma_f32_32x32x16_bf16(pa2, ATT_PK(l2, h2), od, 0, 0, 0);
    od = __builtin_amdgcn_mfma_f32_32x32x16_bf16(pa3, ATT_PK(l3, h3), od, 0, 0, 0);
}
#undef ATT_PK
__device__ __forceinline__ void pv_d0(f32x16* o, int vb, bf16x8 pa0, bf16x8 pa1, bf16x8 pa2, bf16x8 pa3) {
    pv_one<0>(o[0], vb, pa0, pa1, pa2, pa3); pv_one<1>(o[1], vb, pa0, pa1, pa2, pa3); pv_one<2>(o[2], vb, pa0, pa1, pa2, pa3); pv_one<3>(o[3], vb, pa0, pa1, pa2, pa3);
}
struct VH { s16x4 l0, h0, l1, h1; };
template <int D0, int KS0> __device__ __forceinline__ void vh_load(VH& f, int vb) {
    f.l0 = tr_read<v_rd_off(D0, KS0, 0)>(vb); f.h0 = tr_read<v_rd_off(D0, KS0, 1)>(vb); f.l1 = tr_read<v_rd_off(D0, KS0 + 1, 0)>(vb); f.h1 = tr_read<v_rd_off(D0, KS0 + 1, 1)>(vb);
}
#define ATT_PKV(L, H) (bf16x8){L[0], L[1], L[2], L[3], H[0], H[1], H[2], H[3]}
#define ATT_E3(P, B) do { P[B] = __builtin_amdgcn_exp2f(P[B]); P[(B) + 1] = __builtin_amdgcn_exp2f(P[(B) + 1]); P[(B) + 2] = __builtin_amdgcn_exp2f(P[(B) + 2]); } while (0)
#define ATT_MM(D, PA, L, H) o[D] = __builtin_amdgcn_mfma_f32_32x32x16_bf16(PA, ATT_PKV(L, H), o[D], 0, 0, 0)
#define ATT_PIN(x) asm volatile("" : "+v"(x))
__device__ __forceinline__ void pv_partial(f32x16* o, int vb, bf16x8 pa0, bf16x8 pa1, bf16x8 pa2, bf16x8 pa3, f32x16& p0, f32x16& p1, float& m_reg, f32x16& negm, float& alpha) {
    VH fa, fb; float mx[4];
    vh_load<0, 0>(fa, vb); vh_load<0, 2>(fb, vb);
    ATT_SBAR();
    ATT_MM(0, pa0, fa.l0, fa.h0);
    mx[0] = fmaxf(fmaxf(p0[0], p0[1]), fmaxf(p0[2], p0[3])); mx[1] = fmaxf(fmaxf(p0[4], p0[5]), fmaxf(p0[6], p0[7])); ATT_PIN(mx[0]); ATT_PIN(mx[1]); ATT_SBAR();
    ATT_MM(0, pa1, fa.l1, fa.h1); vh_load<1, 0>(fa, vb);
    mx[2] = fmaxf(fmaxf(p0[8], p0[9]), fmaxf(p0[10], p0[11])); mx[3] = fmaxf(fmaxf(p0[12], p0[13]), fmaxf(p0[14], p0[15])); ATT_PIN(mx[2]); ATT_PIN(mx[3]); ATT_SBAR();
    ATT_MM(0, pa2, fb.l0, fb.h0);
    mx[0] = fmaxf(mx[0], fmaxf(fmaxf(p1[0], p1[1]), fmaxf(p1[2], p1[3]))); mx[1] = fmaxf(mx[1], fmaxf(fmaxf(p1[4], p1[5]), fmaxf(p1[6], p1[7]))); ATT_PIN(mx[0]); ATT_PIN(mx[1]); ATT_SBAR();
    ATT_MM(0, pa3, fb.l1, fb.h1); vh_load<1, 2>(fb, vb);
    mx[2] = fmaxf(mx[2], fmaxf(fmaxf(p1[8], p1[9]), fmaxf(p1[10], p1[11]))); mx[3] = fmaxf(mx[3], fmaxf(fmaxf(p1[12], p1[13]), fmaxf(p1[14], p1[15]))); ATT_PIN(mx[2]); ATT_PIN(mx[3]); ATT_SBAR();
    ATT_MM(1, pa0, fa.l0, fa.h0);
    { float pmax = fmaxf(fmaxf(mx[0], mx[1]), fmaxf(mx[2], mx[3]));
      auto rr = __builtin_amdgcn_permlane32_swap(__float_as_uint(pmax), __float_as_uint(pmax), false, false); pmax = fmaxf(__uint_as_float(rr[0]), __uint_as_float(rr[1]));
      const bool need = pmax > THR; alpha = 1.f;
      if (__any(need)) { const float delta = need ? pmax : 0.f; alpha = __builtin_amdgcn_exp2f(-delta); m_reg += delta;
#pragma unroll
          for (int r = 0; r < 16; ++r) { p0[r] -= delta; p1[r] -= delta; negm[r] -= delta; } } } ATT_PIN(alpha); ATT_SBAR();
    ATT_MM(1, pa1, fa.l1, fa.h1); vh_load<2, 0>(fa, vb); ATT_E3(p0, 0); ATT_PIN(p0); ATT_SBAR();
    ATT_MM(1, pa2, fb.l0, fb.h0); ATT_E3(p0, 3); ATT_PIN(p0); ATT_SBAR();
    ATT_MM(1, pa3, fb.l1, fb.h1); vh_load<2, 2>(fb, vb); ATT_E3(p0, 6); ATT_PIN(p0); ATT_SBAR();
    ATT_MM(2, pa0, fa.l0, fa.h0); ATT_E3(p0, 9); ATT_PIN(p0); ATT_SBAR();
    ATT_MM(2, pa1, fa.l1, fa.h1); vh_load<3, 0>(fa, vb); ATT_E3(p0, 12); ATT_PIN(p0); ATT_SBAR();
    ATT_MM(2, pa2, fb.l0, fb.h0); p0[15] = __builtin_amdgcn_exp2f(p0[15]); p1[0] = __builtin_amdgcn_exp2f(p1[0]); p1[1] = __builtin_amdgcn_exp2f(p1[1]); ATT_PIN(p0); ATT_PIN(p1); ATT_SBAR();
    ATT_MM(2, pa3, fb.l1, fb.h1); vh_load<3, 2>(fb, vb); ATT_E3(p1, 2); ATT_PIN(p1); ATT_SBAR();
    ATT_MM(3, pa0, fa.l0, fa.h0); ATT_E3(p1, 5); ATT_PIN(p1); ATT_SBAR();
    ATT_MM(3, pa1, fa.l1, fa.h1); ATT_E3(p1, 8); ATT_PIN(p1); ATT_SBAR();
    ATT_MM(3, pa2, fb.l0, fb.h0); ATT_E3(p1, 11); ATT_PIN(p1); ATT_SBAR();
    ATT_MM(3, pa3, fb.l1, fb.h1); p1[14] = __builtin_amdgcn_exp2f(p1[14]); p1[15] = __builtin_amdgcn_exp2f(p1[15]); ATT_PIN(p1); ATT_SBAR();
}
#undef ATT_MM
#undef ATT_PIN
#undef ATT_E3
#undef ATT_PKV
__device__ __forceinline__ size_t kvrow(int b, int t) { return t < 64 ? (size_t)b * SEQ + (size_t)t * 64 : (size_t)NLAT + (size_t)b * CTXL + (size_t)(t - 64) * 64; }

__device__ __forceinline__ void glds16(const void* gsrc, unsigned lds_dst) { unsigned keep;
    asm volatile("s_mov_b32 %0, m0\n\ts_mov_b32 m0, %2\n\ts_nop 0\n\tglobal_load_lds_dwordx4 %1, off\n\ts_mov_b32 m0, %0" : "=&s"(keep) : "v"(gsrc), "s"(lds_dst) : "memory"); }
template <int VAR> __device__ __forceinline__ void head_pass(const bf16* __restrict__ Q1, const bf16* __restrict__ K1, const bf16* __restrict__ V1, int b, int qh, int hp, size_t qrow0, char* lds, f32x16 (&o)[4], float& l_out) {
    int tid_ = threadIdx.x; asm volatile("" : "+v"(tid_));
    const int tid = tid_, wid = __builtin_amdgcn_readfirstlane(tid >> 6), lane = tid & 63, r32 = lane & 31, hi = lane >> 5;
    char* V_lds = lds + OFF_V; char* K_lds = lds + OFF_K;
    float* wsf = (float*)(lds + OFF_WS) + wid * 64; float* al_l = wsf + 32;
    float m_reg = 0.f, l_reg = 0.f; f32x16 negm = f32x16{};
#pragma unroll
    for (int d = 0; d < 4; ++d) o[d] = f32x16{};
    const bf16* Kh = K1 + (size_t)qh * MALL * 64; const bf16* Vh = V1 + (size_t)hp * MALL * 128;
    const int kr = 8 * wid + (lane >> 3); const unsigned koff = (unsigned)(kr * 128 + (((lane & 7) ^ ((kr >> 1) & 7)) << 4));
    unsigned voff[2];
#pragma unroll
    for (int p = 0; p < 2; ++p) { const int st = 2 * (2 * wid + p) + (lane >> 5), kk = 8 * (st >> 2) + ((lane & 31) >> 2), cch = 32 * (st & 3) + 8 * (lane & 3);
        voff[p] = (unsigned)(kk * 256 + cch * 2); }
    const unsigned lbase = (unsigned)(uintptr_t)lds;
#define ATT_ISSUE(t_, ks_, vs_) do { const size_t rb_ = kvrow(b, (t_)); const char* kb_ = (const char*)(Kh + rb_ * 64); const char* vb_ = (const char*)(Vh + rb_ * 128); \
    glds16(kb_ + koff, (unsigned)__builtin_amdgcn_readfirstlane(lbase + OFF_K + (ks_) * SHM_K + wid * 1024)); \
    glds16(vb_ + voff[0], (unsigned)__builtin_amdgcn_readfirstlane(lbase + OFF_V + (vs_) * SHM_V + (2 * wid) * 1024)); \
    glds16(vb_ + voff[1], (unsigned)__builtin_amdgcn_readfirstlane(lbase + OFF_V + (vs_) * SHM_V + (2 * wid + 1) * 1024)); } while (0)
#define ATT_WAITBAR(N) do { asm volatile("s_waitcnt vmcnt(" #N ")" ::: "memory"); __builtin_amdgcn_s_barrier(); asm volatile("" ::: "memory"); } while (0)
#define ATT_RESC(al) do { if (__any((al) < 1.f)) { if (hi == 0) al_l[r32] = (al); asm volatile("s_waitcnt lgkmcnt(0)" ::: "memory"); \
    _Pragma("unroll") for (int d = 0; d < 4; ++d) _Pragma("unroll") for (int r = 0; r < 16; ++r) o[d][r] *= al_l[crow(r, hi)]; } } while (0)
    bf16x8 qr[4];
    const bf16* Qw = Q1 + ((size_t)qh * MALL + qrow0 + wid * 32 + r32) * 64 + hi * 8;
#pragma unroll
    for (int d0 = 0; d0 < 4; ++d0) qr[d0] = *reinterpret_cast<const bf16x8*>(Qw + d0 * 16);
    const int vb0 = (int)(uintptr_t)V_lds + v_rd_base(lane);
    f32x16 pA0, pA1, pB0, pB1; float alA = 1.f, alB = 1.f; bf16x8 pa0, pa1, pa2, pa3;
    int kq = 1, ki = 2, vA = 0, vB = 3, vi = 2;
#define ATT_ADV() do { kq = ki; ki = (ki == 2) ? 0 : ki + 1; vB = vA; vA = (vA + 1) & 3; vi = (vi + 1) & 3; } while (0)
    ATT_ISSUE(0, 0, 0); ATT_ISSUE(1, 1, 1);
    ATT_WAITBAR(3);
    {
        qkt(pA0, pA1, K_lds, qr, negm, r32, hi); partialSM<VAR>(pA0, pA1, m_reg, negm, alA);
        ATT_WAITBAR(2);
#define ATT_STEP_A(PC0, PC1, ALC, PN0, PN1, ALN, j_) do { \
        ATT_ISSUE((j_) + 2, ki, vi); \
        ATT_SBAR(); qkt(PN0, PN1, K_lds + kq * SHM_K, qr, negm, r32, hi); \
        finishSM<VAR>(PC0, PC1, ALC, l_reg, pa0, pa1, pa2, pa3); ATT_SBAR(); \
        pv_partial(o, vb0 + vA * SHM_V, pa0, pa1, pa2, pa3, PN0, PN1, m_reg, negm, ALN); \
        ATT_RESC(ALN); \
        ATT_WAITBAR(2); ATT_ADV(); } while (0)
        for (int j = 0; j + 2 < NT; j += 2) {
            ATT_STEP_A(pA0, pA1, alA, pB0, pB1, alB, j);
            ATT_STEP_A(pB0, pB1, alB, pA0, pA1, alA, j + 1);
        }
        ATT_SBAR(); qkt(pB0, pB1, K_lds + kq * SHM_K, qr, negm, r32, hi);
        finishSM<VAR>(pA0, pA1, alA, l_reg, pa0, pa1, pa2, pa3); ATT_SBAR();
        pv_partial(o, vb0 + vA * SHM_V, pa0, pa1, pa2, pa3, pB0, pB1, m_reg, negm, alB);
        ATT_RESC(alB);
        ATT_WAITBAR(0);
        finishSM<VAR>(pB0, pB1, alB, l_reg, pa0, pa1, pa2, pa3); ATT_SBAR();
        if (VAR != 1) pv_d0(o, vb0 + ((vA + 1) & 3) * SHM_V, pa0, pa1, pa2, pa3);
#undef ATT_STEP_A
    }
    l_out = l_reg;
    asm volatile("s_waitcnt lgkmcnt(0)" ::: "memory"); __builtin_amdgcn_s_barrier(); asm volatile("" ::: "memory");
#undef ATT_ADV
#undef ATT_ISSUE
#undef ATT_WAITBAR
#undef ATT_RESC
}

template <int VAR> __device__ __forceinline__ void attn_unit(const bf16* __restrict__ Q1, const bf16* __restrict__ K1, const bf16* __restrict__ V1, bf16* __restrict__ ao, int b, int hp, int qb, char* lds, const float* lamp, const float* subln) {
    int tid_ = threadIdx.x; asm volatile("" : "+v"(tid_));
    const int tid = tid_, wid = tid >> 6, lane = tid & 63, r32 = lane & 31, hi = lane >> 5;
    float* wsf = (float*)(lds + OFF_WS) + wid * 64;
    unsigned* o1s = (unsigned*)(lds + OFF_O1 + wid * 8192);
    const size_t qrow0 = (size_t)b * SEQ + (size_t)qb * 256;
    f32x16 o[4]; float l;
    float ssq[16];
#pragma unroll 1
    for (int hh = 0; hh < 2; ++hh) {
        head_pass<VAR>(Q1, K1, V1, b, 2 * hp + hh, hp, qrow0, lds, o, l);
        if (hi == 0) wsf[r32] = l; asm volatile("s_waitcnt lgkmcnt(0)" ::: "memory");
        float rli[16];
#pragma unroll
        for (int r = 0; r < 16; ++r) { rli[r] = __builtin_amdgcn_rcpf(wsf[crow(r, hi)]); ssq[r] = 0.f; }
        if (hh == 0) {
#pragma unroll
            for (int d0 = 0; d0 < 4; ++d0)
#pragma unroll
                for (int r = 0; r < 16; r += 2) o1s[(d0 * 8 + (r >> 1)) * 64 + lane] = cvtpk(o[d0][r] * rli[r], o[d0][r + 1] * rli[r + 1]);
            __syncthreads();
        } else {
            asm volatile("" : "+s"(lamp)); const float lam = *lamp;
#pragma unroll
            for (int d0 = 0; d0 < 4; ++d0)
#pragma unroll
                for (int r = 0; r < 16; r += 2) { const unsigned w = o1s[(d0 * 8 + (r >> 1)) * 64 + lane];
                    const float a0 = bflo(w) - lam * (o[d0][r] * rli[r]), a1 = bfhi(w) - lam * (o[d0][r + 1] * rli[r + 1]);
                    o[d0][r] = a0; o[d0][r + 1] = a1; ssq[r] += a0 * a0; ssq[r + 1] += a1 * a1; }
        }
    }
#pragma unroll
    for (int r = 0; r < 16; ++r) { float s = ssq[r];
        s += __shfl_xor(s, 1); s += __shfl_xor(s, 2); s += __shfl_xor(s, 4); s += __shfl_xor(s, 8); s += __shfl_xor(s, 16);
        ssq[r] = 1.0f / sqrtf(s * (1.0f / 128.0f) + EPS) * (1.0f - LAMBDA_INIT); }
    asm volatile("s_waitcnt lgkmcnt(0)" ::: "memory");
    bf16* stg = (bf16*)o1s;
    asm volatile("" : "+s"(subln));
#pragma unroll
    for (int d0 = 0; d0 < 4; ++d0) { const float g = subln[d0 * 32 + r32];
#pragma unroll
        for (int r = 0; r < 16; ++r) stg[crow(r, hi) * 128 + d0 * 32 + r32] = (bf16)f2bf(o[d0][r] * ssq[r] * g); }
    asm volatile("s_waitcnt lgkmcnt(0)" ::: "memory");
    bf16* Ow = ao + (qrow0 + wid * 32) * D + hp * 128;
#pragma unroll
    for (int i = 0; i < 8; ++i) { const int row = i * 4 + (lane >> 4), ch = lane & 15; const u32x4 v = *(const u32x4*)(stg + row * 128 + ch * 8); *(u32x4*)(Ow + (size_t)row * D + ch * 8) = v; }
    asm volatile("s_waitcnt lgkmcnt(0)" ::: "memory");
    __syncthreads();
}
#undef ATT_SBAR
}

template <int VAR> __device__ __forceinline__ void attn_phase(Frame& F, const Args& a, bf16* ao) {
    const bf16* Q1 = (const bf16*)(F.ws + WS_QH1); const bf16* K1 = (const bf16*)(F.ws + WS_KH1); const bf16* V1 = (const bf16*)(F.ws + WS_VH1);
    const float* lamp = (const float*)(F.ws + WS_LAM);
    for (int unit = F.vcu; unit < NBATCH * 8 * 16; unit += F.G) {
        const int qb = unit & 15, hp = (unit >> 4) & 7, b = unit >> 7;
        att::attn_unit<VAR>(Q1, K1, V1, ao, b, hp, qb, (char*)F.lds, lamp, a.in[I_L1_SUBLN]);
    }
}


namespace ret {
using s16x4  = __attribute__((ext_vector_type(4))) short;
using f32x16 = __attribute__((ext_vector_type(16))) float;
typedef short v4i16_t __attribute__((ext_vector_type(4)));
constexpr int C = 32, NSTEP = (SEQ + CTXL) / C;
constexpr int ST_Q = 0, ST_K = 16384, ST_V = 32768, ST_SC = 40960, ST_BYTES = 43008, NSTAGE = 3;
constexpr int XBUF_OFF = NSTAGE * ST_BYTES, RET_LDS = XBUF_OFF + NWAVES * 4096;
constexpr size_t WS_SSQ = 836 * MiB;
constexpr size_t WS_SC = 842 * MiB;

__device__ __forceinline__ void glds16(const void* gsrc, unsigned lds_dst) { unsigned keep;
    asm volatile("s_mov_b32 %0, m0\n\ts_mov_b32 m0, %2\n\ts_nop 0\n\tglobal_load_lds_dwordx4 %1, off\n\ts_mov_b32 m0, %0" : "=&s"(keep) : "v"(gsrc), "s"(lds_dst) : "memory"); }
__device__ __forceinline__ s16x4 vtr(const LAS char* p) { return __builtin_bit_cast(s16x4, __builtin_amdgcn_ds_read_tr16_b64_v4i16((LAS v4i16_t*)p)); }

__device__ __forceinline__ void ret_scores(Frame& F) {
    const bf16* Qh = (const bf16*)(F.ws + WS_QH0); const bf16* Kh = (const bf16*)(F.ws + WS_KH0); bf16* sc = (bf16*)(F.ws + WS_SC);
    const int gw = F.vcu * NWAVES + F.wave, NGW = F.G * NWAVES;
    const int r32 = F.lane & 31, hh = F.lane >> 5;
    for (int task = gw; task < (MALL / C) * RH; task += NGW) {
        const int h = task & 3, ch = task >> 2;
        const bf16* qp = Qh + ((size_t)h * MALL + (size_t)ch * C + r32) * 256 + hh * 8;
        const bf16* kp = Kh + ((size_t)h * MALL + (size_t)ch * C + r32) * 256 + hh * 8;
        f32x16 acc = f32x16{};
        bf16x8 a[16], b[16];
#pragma unroll
        for (int s = 0; s < 16; ++s) { a[s] = *reinterpret_cast<const bf16x8*>(qp + s * 16); b[s] = *reinterpret_cast<const bf16x8*>(kp + s * 16); }
#pragma unroll
        for (int s = 0; s < 16; ++s) acc = __builtin_amdgcn_mfma_f32_32x32x16_bf16(a[s], b[s], acc, 0, 0, 0);
        bf16* tp = sc + (size_t)task * 1024;
#pragma unroll
        for (int r = 0; r < 16; ++r) { const int i = (r & 3) + 8 * (r >> 2) + 4 * hh; tp[i * 32 + r32] = (bf16)f2bf(acc[r]); }
    }
}

__device__ __forceinline__ size_t step_row0(int b, int dir, int t) {
    if (t < 8) { const int blk = dir ? 7 - t : t; return (size_t)NLAT + (size_t)b * CTXL + (size_t)blk * C; }
    const int blk = dir ? 127 - (t - 8) : (t - 8); return (size_t)b * SEQ + (size_t)blk * C;
}

__device__ __forceinline__ void ret_scan(Frame& F, const Args& a) {
    const char* qb = (const char*)(F.ws + WS_QH0); const char* kb = (const char*)(F.ws + WS_KH0); const char* vb = (const char*)(F.ws + WS_VQ0); const char* scb = (const char*)(F.ws + WS_SC);
    for (int unit = F.vcu; unit < NBATCH * RH * 2 * 4; unit += F.G) {
        int tid_ = threadIdx.x; asm volatile("" : "+v"(tid_));
        const int tid = tid_, lane = tid & 63, w = __builtin_amdgcn_readfirstlane(tid >> 6), dh = w >> 2, vs = w & 3, r32 = lane & 31, hh = lane >> 5;
        const int vq = unit & 3, dir = (unit >> 2) & 1, h = (unit >> 3) & 3, b = unit >> 5;
        const float logit = a.in[I_L0_DECAY][dir * RH + h];
        const float lg2 = -__builtin_amdgcn_logf(1.0f + __builtin_amdgcn_exp2f(-logit * LOG2E));
        const float gC = __builtin_amdgcn_exp2f(lg2 * (float)C);
        float kd[2][8];
#pragma unroll
        for (int s = 0; s < 2; ++s)
#pragma unroll
            for (int jj = 0; jj < 8; ++jj) { const int j = 16 * s + 8 * hh + jj; kd[s][jj] = __builtin_amdgcn_exp2f(lg2 * (float)(dir ? j : 31 - j)); }
        const int om = 4 * w + (lane >> 4);
        const float rsc = __builtin_amdgcn_exp2f(-lg2 * (float)(dir ? om : 31 - om));
        unsigned pm[4];
#pragma unroll
        for (int e = 0; e < 4; ++e) { const int j0 = 16 * dh + 8 * hh + 2 * e, j1 = j0 + 1; const bool k0 = dir ? (j0 >= r32) : (j0 <= r32), k1 = dir ? (j1 >= r32) : (j1 <= r32);
            pm[e] = (k0 ? 0x0000ffffu : 0u) | (k1 ? 0xffff0000u : 0u); }
        unsigned offq[2], offk[2];
#pragma unroll
        for (int p = 0; p < 2; ++p) { const int i = 2 * (2 * w + p) + (lane >> 5), cp = lane & 31;
            offq[p] = (unsigned)(i * 512 + ((cp ^ (i & 15)) << 4)); offk[p] = (unsigned)(i * 512 + ((cp ^ ((i & 3) << 2)) << 4)); }
        unsigned offv; { const int j = 4 * w + (lane >> 4), cp = lane & 15; offv = (unsigned)(j * 256 + ((cp ^ ((j & 3) << 2)) << 4)); }
        const char* qhb = qb + (size_t)h * MALL * 512; const char* khb = kb + (size_t)h * MALL * 512; const char* vhb = vb + (size_t)(h * 4 + vq) * MALL * 256;
        unsigned offs; { const int i = 16 * (w & 1) + (lane >> 2), cp = lane & 3; offs = (unsigned)(i * 64 + ((cp ^ ((i >> 2) & 3)) << 4)); }
        LAS unsigned char* L = F.lds;
        const unsigned lbase = (unsigned)(uintptr_t)L;
#define RET_ISSUE(t_) do { const int t__ = (t_); const unsigned sb_ = lbase + (unsigned)((t__ % NSTAGE) * ST_BYTES); const size_t r0_ = step_row0(b, dir, t__); const char* gq_ = qhb + r0_ * 512; const char* gk_ = khb + r0_ * 512; const char* gv_ = vhb + r0_ * 256; \
        glds16(gq_ + offq[0], (unsigned)__builtin_amdgcn_readfirstlane(sb_ + ST_Q + (2 * w) * 1024)); \
        glds16(gq_ + offq[1], (unsigned)__builtin_amdgcn_readfirstlane(sb_ + ST_Q + (2 * w + 1) * 1024)); \
        glds16(gk_ + offk[0], (unsigned)__builtin_amdgcn_readfirstlane(sb_ + ST_K + (2 * w) * 1024)); \
        glds16(gk_ + offk[1], (unsigned)__builtin_amdgcn_readfirstlane(sb_ + ST_K + (2 * w + 1) * 1024)); \
        glds16(gv_ + offv, (unsigned)__builtin_amdgcn_readfirstlane(sb_ + ST_V + w * 1024)); \
        if (w < 2) glds16(scb + ((r0_ >> 5) * 4 + h) * 2048 + offs, (unsigned)__builtin_amdgcn_readfirstlane(sb_ + ST_SC + w * 1024)); } while (0)
        const int qrow = ST_Q + r32 * 512; const int qx = r32 & 15;
        const int G = lane >> 4, il = lane & 15, tq = il >> 2, tp = il & 3;
        const int kcolb = (128 * dh + 16 * (G & 1) + 8 * (tp & 1) + 4 * (tp >> 1)) * 2;
        const int vcolb = (32 * vs + 16 * (G & 1) + 4 * tp) * 2;
        f32x16 S[4];
#pragma unroll
        for (int T = 0; T < 4; ++T) S[T] = f32x16{};
        bf16* outp = (bf16*)(F.ws + (dir ? WS_OB : WS_OF));
        LAS float* xb_mine = (LAS float*)(L + XBUF_OFF + w * 4096);
        float* ssqp = (float*)(F.ws + WS_SSQ);

        __builtin_amdgcn_s_barrier();
        RET_ISSUE(0); RET_ISSUE(1);
        for (int t = 0; t < NSTEP; ++t) {
            if (t == 0) { if (w < 2) asm volatile("s_waitcnt vmcnt(6)" ::: "memory"); else asm volatile("s_waitcnt vmcnt(5)" ::: "memory"); }
            else if (t == NSTEP - 1) asm volatile("s_waitcnt vmcnt(4)" ::: "memory");
            else        { if (w < 2) asm volatile("s_waitcnt vmcnt(8)" ::: "memory"); else asm volatile("s_waitcnt vmcnt(7)" ::: "memory"); }
            __builtin_amdgcn_s_barrier(); asm volatile("" ::: "memory");
            if (t + 2 < NSTEP) RET_ISSUE(t + 2);
            const LAS char* sb = (const LAS char*)(L + (t % NSTAGE) * ST_BYTES);
            bf16x8 vd[2];
#pragma unroll
            for (int s = 0; s < 2; ++s) {
                const int j0 = 16 * s + 8 * (G >> 1) + tq;
                const int cph = (((vcolb >> 4) ^ (tq << 2)) << 4) + (vcolb & 8);
                const s16x4 lo = vtr(sb + ST_V + j0 * 256 + cph), hi = vtr(sb + ST_V + (j0 + 4) * 256 + cph);
                float f[8];
#pragma unroll
                for (int e = 0; e < 4; ++e) { f[e] = bf2f((unsigned short)lo[e]) * kd[s][e]; f[4 + e] = bf2f((unsigned short)hi[e]) * kd[s][4 + e]; }
                v4u pk; pk.x = pk2(f[0], f[1]); pk.y = pk2(f[2], f[3]); pk.z = pk2(f[4], f[5]); pk.w = pk2(f[6], f[7]);
                vd[s] = __builtin_bit_cast(bf16x8, pk);
            }
#pragma unroll
            for (int T = 0; T < 4; ++T) S[T] = S[T] * gC;
            f32x16 acc = f32x16{};
#pragma unroll
            for (int T = 0; T < 4; ++T)
#pragma unroll
                for (int s = 0; s < 2; ++s) {
                    const int cL = 16 * dh + 4 * T + 2 * s + hh;
                    const bf16x8 qa = *(const LAS bf16x8*)(sb + qrow + ((cL ^ qx) << 4));
                    v4u pk; pk.x = pk2(S[T][8 * s + 0], S[T][8 * s + 1]); pk.y = pk2(S[T][8 * s + 2], S[T][8 * s + 3]); pk.z = pk2(S[T][8 * s + 4], S[T][8 * s + 5]); pk.w = pk2(S[T][8 * s + 6], S[T][8 * s + 7]);
                    acc = __builtin_amdgcn_mfma_f32_32x32x16_bf16(qa, __builtin_bit_cast(bf16x8, pk), acc, 0, 0, 0);
                }
            {
                const int cL = 2 * dh + hh;
                v4u pw = *(const LAS v4u*)(sb + ST_SC + r32 * 64 + ((cL ^ ((r32 >> 2) & 3)) << 4));
                pw.x &= pm[0]; pw.y &= pm[1]; pw.z &= pm[2]; pw.w &= pm[3];
                acc = __builtin_amdgcn_mfma_f32_32x32x16_bf16(__builtin_bit_cast(bf16x8, pw), dh ? vd[1] : vd[0], acc, 0, 0, 0);
            }
#pragma unroll
            for (int T = 0; T < 4; ++T)
#pragma unroll
                for (int s = 0; s < 2; ++s) {
                    const int j0 = 16 * s + 8 * (G >> 1) + tq;
                    const int cb = kcolb + 64 * T;
                    const int cph = (((cb >> 4) ^ (tq << 2)) << 4) + (cb & 8);
                    const s16x4 lo = vtr(sb + ST_K + j0 * 512 + cph), hi = vtr(sb + ST_K + (j0 + 4) * 512 + cph);
                    const bf16x8 ka = (bf16x8){lo[0], lo[1], lo[2], lo[3], hi[0], hi[1], hi[2], hi[3]};
                    S[T] = __builtin_amdgcn_mfma_f32_32x32x16_bf16(ka, vd[s], S[T], 0, 0, 0);
                }
#pragma unroll
            for (int r = 0; r < 16; ++r) xb_mine[r * 64 + lane] = acc[r];
            asm volatile("s_waitcnt lgkmcnt(0)" ::: "memory");
            __builtin_amdgcn_s_barrier(); asm volatile("" ::: "memory");
            {
                const int v0 = (lane & 15) * 8, svs = v0 >> 5, c32 = v0 & 31, rr = (om & 3) + 4 * (om >> 3), sh = (om >> 2) & 1;
                const LAS float* p0 = (const LAS float*)(L + XBUF_OFF + svs * 4096) + rr * 64 + sh * 32 + c32;
                const LAS float* p1 = (const LAS float*)(L + XBUF_OFF + (4 + svs) * 4096) + rr * 64 + sh * 32 + c32;
                const f32x4 a0 = *(const LAS f32x4*)p0, a1 = *(const LAS f32x4*)(p0 + 4), b0 = *(const LAS f32x4*)p1, b1 = *(const LAS f32x4*)(p1 + 4);
                const f32x4 o0 = (a0 + b0) * rsc, o1 = (a1 + b1) * rsc;
                float ss = (o0.x * o0.x + o0.y * o0.y) + (o0.z * o0.z + o0.w * o0.w) + (o1.x * o1.x + o1.y * o1.y) + (o1.z * o1.z + o1.w * o1.w);
                ss += __shfl_xor(ss, 1); ss += __shfl_xor(ss, 2); ss += __shfl_xor(ss, 4); ss += __shfl_xor(ss, 8);
                const size_t r0 = step_row0(b, dir, t);
                v4u pk; pk.x = pk2(o0.x, o0.y); pk.y = pk2(o0.z, o0.w); pk.z = pk2(o1.x, o1.y); pk.w = pk2(o1.z, o1.w);
                *(GAS v4u*)(outp + (r0 + om) * 2048 + h * 512 + vq * 128 + v0) = pk;
                if ((lane & 15) == 0) ssqp[(((r0 + om) * RH + h) * 2 + dir) * 4 + vq] = ss;
            }
            asm volatile("s_waitcnt lgkmcnt(0)" ::: "memory");
        }
        asm volatile("s_waitcnt vmcnt(0)" ::: "memory");
#undef RET_ISSUE
    }
    __builtin_amdgcn_s_barrier();
}
}

__device__ __forceinline__ void moe_counts(Frame& F, int (&cnt)[NE]) {
#pragma unroll
    for (int e = 0; e < NE; ++e) cnt[e] = __builtin_amdgcn_readfirstlane((int)__hip_atomic_load((unsigned*)(F.ctl + CW_MOECNT + 64 * e), RLX_AGENT));
}
__device__ __forceinline__ void moe_gather(Frame& F) {
    int cnt[NE]; moe_counts(F, cnt);
    int base[NE]; int acc = 0;
#pragma unroll
    for (int e = 0; e < NE; ++e) { base[e] = acc; acc += (cnt[e] + 255) & ~255; }
    const int* te = (const int*)(F.ws + WS_ROUTE); int* tpos = (int*)(F.ws + WS_ROUTE + (size_t)NLAT * 8);
    const bf16* hb = (const bf16*)(F.ws + WS_H); bf16* hp = (bf16*)(F.ws + WS_HP);
    const int gw = F.vcu * NWAVES + F.wave, NGW = F.G * NWAVES;
    for (int r = gw; r < NLAT; r += NGW) {
        const int e0 = te[2 * r], e1 = te[2 * r + 1]; const int p0 = tpos[2 * r], p1 = tpos[2 * r + 1];
        int b0 = 0, b1 = 0;
#pragma unroll
        for (int e = 0; e < NE; ++e) { b0 = (e0 == e) ? base[e] : b0; b1 = (e1 == e) ? base[e] : b1; }
        const int s0 = b0 + p0, s1 = b1 + p1;
        const v4u x0 = *(const GAS v4u*)((const unsigned char*)hb + (size_t)r * D + F.lane * 16);
        *(GAS v4u*)((unsigned char*)hp + (size_t)s0 * D + F.lane * 16) = x0; *(GAS v4u*)((unsigned char*)hp + (size_t)s1 * D + F.lane * 16) = x0;
        if (F.lane == 0) { tpos[2 * r] = s0; tpos[2 * r + 1] = s1; }
    }
}
__device__ __forceinline__ void moe_order(Frame& F, pg8::MoeOrder& S, int nN) {
    int cnt[NE]; moe_counts(F, cnt);
    int ts[NE + 1]; ts[0] = 0;
#pragma unroll
    for (int e = 0; e < NE; ++e) ts[e + 1] = ts[e] + ((cnt[e] + 255) >> 8);
    S.nM = ts[NE]; S.nN = nN; S.nwg = S.nM * nN; S.G = F.G; S.c = F.cid;
    S.t1 = ts[1]; S.t2 = ts[2]; S.t3 = ts[3]; S.t4 = ts[4]; S.t5 = ts[5]; S.t6 = ts[6]; S.t7 = ts[7];
}

constexpr int N_PHASES = 22;
__global__ void __launch_bounds__(NTHREADS, 2) fwd(Args args) {
    extern __shared__ __attribute__((aligned(16))) unsigned char lds[];
    Frame F;
    F.lds = (LAS unsigned char*)lds; F.MISC = (volatile LAS unsigned*)(F.lds + MISC_OFF);
    F.tid = threadIdx.x; F.lane = F.tid & 63; F.wave = __builtin_amdgcn_readfirstlane(F.tid >> 6);
    F.G = gridDim.x; { const int bx = blockIdx.x; F.vcu = (F.G % 8 == 0) ? (bx % 8) * (F.G / 8) + bx / 8 : bx; F.cid = bx; }
    F.ws = args.ws; F.ctl = (gu32*)(args.ws + WS_CTL);
    for (int u = F.tid; u < 64; u += NTHREADS) ((LAS unsigned*)(F.lds + MISC_OFF))[u] = 0u;
    __syncthreads();
#if MK_PER_PHASE
    XcdBarrier bar; bar.bar = (unsigned*)(F.ctl + CW_BAR); bar.x = 0; bar.st = nullptr;
#define GRID_BAR() do { } while (0)
#else
    XcdBarrier bar = xcd_barrier_post((unsigned*)(F.ctl + CW_BAR), F.MISC + 8);
#define GRID_BAR() xcd_barrier(bar)
    if (F.tid == 0) { const unsigned x = xb_xcc_id(); F.MISC[16] = x; F.MISC[17] = __hip_atomic_fetch_add((unsigned*)(F.ctl + CW_XRANK + 64 * x), 1u, RLX_AGENT); }
#endif
    const int lo = args.ph_lo, hi = args.ph_hi;
#define IN(k) (lo <= (k) && (k) < hi)
#define SEAM(k) do { if (IN(k) && IN((k) + 1)) GRID_BAR(); } while (0)
    unsigned char* ws = args.ws;
    float* modv = (float*)(ws + WS_MODV);
    float* modv1 = modv + 9 * 6 * D;
    bf16* hbuf = (bf16*)(ws + WS_H);
    float* xctx = (float*)(ws + WS_XCTX);
    using pg8::Gemm; using pg8::StaticOrder;

    if (IN(0)) { for (int rep_ = 0; rep_ < ((PROBE_DUP & 1) ? 2 : 1); ++rep_) { p0_prologue(F, args); __syncthreads(); } SEAM(0); }
#if !MK_PER_PHASE
    if (IN(0) && IN(1)) {
        if (F.tid == 0) { const unsigned x = F.MISC[16]; unsigned pre = 0;
            for (unsigned j = 0; j < 16; ++j) { const unsigned c = __hip_atomic_load((unsigned*)(F.ctl + CW_XRANK + 64 * j), RLX_AGENT); pre += (j < x) ? c : 0u; }
            F.MISC[18] = pre + F.MISC[17]; }
        __syncthreads();
        F.vcu = __builtin_amdgcn_readfirstlane((int)F.MISC[18]); F.cid = (F.G % 8 == 0) ? (F.vcu % (F.G / 8)) * 8 + F.vcu / (F.G / 8) : F.vcu;
    }
#endif
    if (IN(1)) { RowPass P{MALL, args.in[I_X], args.in[I_CTX], nullptr, nullptr, nullptr, nullptr, nullptr, args.in[I_L0_NPREMIX], modv + 0 * D, modv + 1 * D, hbuf};
        row_pass<false, false, true, false>(F, args, P); SEAM(1); }
    if (IN(2)) { Gemm g{hbuf, (const bf16*)(ws + WS_W0IN), MALL, 4096, D, D}; StaticOrder S; S.init(MALL, 4096, F.G, F.cid);
        pg8::EpiQKV0 E{(bf16*)(ws + WS_QH0), (bf16*)(ws + WS_KH0), (bf16*)(ws + WS_VQ0), (const float*)(ws + WS_TAB0)};
        for (int rep_ = 0; rep_ < ((PROBE_DUP & 2) ? 2 : 1); ++rep_) { pg8::gemm_phase<pg8::EpiQKV0, StaticOrder, true, true>(F.lds, g, S, E); } if (IN(2) && IN(4)) GRID_BAR(); }
    if (IN(4)) { ret::ret_scores(F); SEAM(4); }
    if (IN(5)) { for (int rep_ = 0; rep_ < ((PROBE_DUP & 8) ? 2 : 1); ++rep_) ret::ret_scan(F, args); SEAM(5); }
    if (IN(6)) { Gemm g{hbuf, (const bf16*)(ws + WS_W0IN) + (size_t)4096 * D, MALL, 4096, D, D}; StaticOrder S; S.init(MALL, 4096, F.G, F.cid);
        pg8::EpiGateMerge E{(bf16*)(ws + WS_OF), (const bf16*)(ws + WS_OB), (const float*)(ws + ret::WS_SSQ)};
        pg8::gemm_phase<pg8::EpiGateMerge, StaticOrder, true, true>(F.lds, g, S, E); if (IN(6) && IN(8)) GRID_BAR(); }
    if (IN(8)) { Gemm g{(const bf16*)(ws + WS_OF), (const bf16*)(ws + WS_W0OUT), MALL, D, 2048, 2048}; pg8::SplitOrder S; S.init(D, F.G, F.cid, USE_SPLITK ? 8 : 0, 4);
        pg8::EpiStoreSplit E{(bf16*)(ws + WS_A), D, (float*)(ws + WS_PART)};
        for (int rep_ = 0; rep_ < ((PROBE_DUP & 32) ? 2 : 1); ++rep_) { pg8::gemm_phase<pg8::EpiStoreSplit, pg8::SplitOrder, true, true>(F.lds, g, S, E); } SEAM(8); }
    if (IN(9)) { RowPass P{MALL, args.in[I_X], args.in[I_CTX], args.out, xctx, (const bf16*)(ws + WS_A), args.in[I_L0_NPOSTMIX], modv + 2 * D, args.in[I_L0_NPREFFN], modv + 3 * D, modv + 4 * D, hbuf, (const float*)(ws + WS_PART)};
        row_pass<true, false, true, false, false, USE_SPLITK ? 8 : 0>(F, args, P); SEAM(9); }
    if (IN(10)) { Gemm g{hbuf, (const bf16*)(ws + WS_W0GU), MALL, 2 * DFF, D, D}; StaticOrder S; S.init(MALL, 2 * DFF, F.G, F.cid);
        pg8::EpiSwiglu E{(bf16*)(ws + WS_B), DFF};
        for (int rep_ = 0; rep_ < ((PROBE_DUP & 2) ? 2 : 1); ++rep_) { pg8::gemm_phase<pg8::EpiSwiglu, StaticOrder, true, true>(F.lds, g, S, E); } SEAM(10); }
    if (IN(11)) { Gemm g{(const bf16*)(ws + WS_B), (const bf16*)(ws + WS_W0DN), MALL, D, DFF, DFF}; pg8::SplitOrder S; S.init(D, F.G, F.cid, USE_SPLITK ? 11 : 0, 4);
        pg8::EpiStoreSplit E{(bf16*)(ws + WS_A), D, (float*)(ws + WS_PART)};
        for (int rep_ = 0; rep_ < ((PROBE_DUP & 32) ? 2 : 1); ++rep_) { pg8::gemm_phase<pg8::EpiStoreSplit, pg8::SplitOrder, true, true>(F.lds, g, S, E); } SEAM(11); }
    if (IN(12)) { RowPass P{MALL, args.out, xctx, args.out, xctx, (const bf16*)(ws + WS_A), args.in[I_L0_NPOSTFFN], modv + 5 * D, args.in[I_L1_NPREMIX], modv1 + 0 * D, modv1 + 1 * D, hbuf, (const float*)(ws + WS_PART)};
        row_pass<true, false, true, false, true, USE_SPLITK ? 11 : 0>(F, args, P); SEAM(12); }
    if (IN(13)) { Gemm g{hbuf, (const bf16*)(ws + WS_W1IN), MALL, 3072, D / 2, D / 2, MOE_SA, MOE_SB}; StaticOrder S; S.init(MALL, 3072, F.G, F.cid);
        pg8::EpiQKV1 E{(bf16*)(ws + WS_QH1), (bf16*)(ws + WS_KH1), (bf16*)(ws + WS_VH1), (const float*)(ws + WS_TAB1)};
        for (int rep_ = 0; rep_ < ((PROBE_DUP & 2) ? 2 : 1); ++rep_) { pg8::gemm_phase<pg8::EpiQKV1, StaticOrder, true, true, true>(F.lds, g, S, E); } if (IN(13) && IN(15)) GRID_BAR(); }
    if (IN(15)) { attn_phase<0>(F, args, (bf16*)(ws + WS_B)); SEAM(15); }
    if (IN(16)) { Gemm g{(const bf16*)(ws + WS_B), (const bf16*)(ws + WS_W1OUT), NLAT, D, D, D}; StaticOrder S; S.init(NLAT, D, F.G, F.cid);
        pg8::EpiStore E{(bf16*)(ws + WS_A), D};
        for (int rep_ = 0; rep_ < ((PROBE_DUP & 2) ? 2 : 1); ++rep_) { pg8::gemm_phase<pg8::EpiStore, StaticOrder, true, true>(F.lds, g, S, E); } SEAM(16); }
    if (IN(17)) { RowPass P{NLAT, args.out, xctx, args.out, xctx, (const bf16*)(ws + WS_A), args.in[I_L1_NPOSTMIX], modv1 + 2 * D, args.in[I_L1_NPREFFN], modv1 + 3 * D, modv1 + 4 * D, hbuf};
        row_pass<true, false, true, true, true>(F, args, P); SEAM(17); }
    if (IN(18)) { moe_gather(F); SEAM(18); }
    if (IN(19)) { Gemm g{(const bf16*)(ws + WS_HP), (const bf16*)(ws + WS_WMGU), MOE_ROWS, 2 * DFE, D / 2, D / 2, MOE_SA, MOE_SB}; pg8::MoeOrder S; moe_order(F, S, 2 * DFE / 256);
        pg8::EpiSwiglu8 E{(unsigned char*)(ws + WS_ACT1), DFE};
        for (int rep_ = 0; rep_ < ((PROBE_DUP & 16) ? 2 : 1); ++rep_) { pg8::gemm_phase<pg8::EpiSwiglu8, pg8::MoeOrder, true, true, true>(F.lds, g, S, E); } SEAM(19); }
    if (IN(20)) { Gemm g{(const bf16*)(ws + WS_ACT1), (const bf16*)(ws + WS_WMDN), MOE_ROWS, D, DFE / 2, DFE / 2, MOE_SA, MOE_SB}; pg8::MoeOrder S; moe_order(F, S, D / 256);
        pg8::EpiStore E{(bf16*)(ws + WS_Y1), D};
        for (int rep_ = 0; rep_ < ((PROBE_DUP & 16) ? 2 : 1); ++rep_) { pg8::gemm_phase<pg8::EpiStore, pg8::MoeOrder, true, true, true>(F.lds, g, S, E); } SEAM(20); }
    if (IN(21)) { RowPass P{NLAT, args.out, xctx, args.out, xctx, (const bf16*)(ws + WS_Y1), args.in[I_L1_NPOSTFFN], modv1 + 5 * D, nullptr, nullptr, nullptr, nullptr};
        row_pass<false, true, false, false>(F, args, P); }
#undef IN
#undef SEAM
}

#ifndef PROBE_ATT
#define PROBE_ATT -1
#endif
#if PROBE_ATT >= 0
__global__ void __launch_bounds__(NTHREADS, 2) probe_k(Args args) {
    extern __shared__ __attribute__((aligned(16))) unsigned char lds[];
    Frame F;
    F.lds = (LAS unsigned char*)lds; F.MISC = (volatile LAS unsigned*)(F.lds + MISC_OFF);
    F.tid = threadIdx.x; F.lane = F.tid & 63; F.wave = __builtin_amdgcn_readfirstlane(F.tid >> 6);
    F.G = gridDim.x; { const int bx = blockIdx.x; F.vcu = (F.G % 8 == 0) ? (bx % 8) * (F.G / 8) + bx / 8 : bx; F.cid = bx; }
    F.ws = args.ws; F.ctl = (gu32*)(args.ws + WS_CTL);
    attn_phase<PROBE_ATT>(F, args, (bf16*)(args.ws + WS_END - 64 * MiB));
}
#endif
extern "C" void kernel_launch(void* const* d_in, const int* in_sizes, int n_in, void* d_out, int out_size, void* d_ws, size_t ws_size, hipStream_t stream) {
    static int grid = 0;
    if (grid == 0) {
        if (n_in != N_IN || out_size != NLAT * D || ws_size < WS_END) { fprintf(stderr, "kernel_launch: unexpected shapes n_in %d out %d ws %zu\n", n_in, out_size, ws_size); grid = -1; return; }
        int dev = 0, cus = 0, per_cu = 0;
        if (hipGetDevice(&dev) != hipSuccess || hipDeviceGetAttribute(&cus, hipDeviceAttributeMultiprocessorCount, dev) != hipSuccess) { grid = -1; return; }
        if (hipFuncSetAttribute((const void*)fwd, hipFuncAttributeMaxDynamicSharedMemorySize, LDS_BYTES) != hipSuccess) { fprintf(stderr, "kernel_launch: hipFuncSetAttribute failed\n"); grid = -1; return; }
        if (hipOccupancyMaxActiveBlocksPerMultiprocessor(&per_cu, (const void*)fwd, NTHREADS, LDS_BYTES) != hipSuccess || per_cu < 1) fprintf(stderr, "kernel_launch: occupancy query says %d\n", per_cu);
        (void)hipGetLastError();
        grid = cus;
    }
    if (grid < 0) return;
    (void)hipMemsetAsync((char*)d_ws + WS_CTL, 0, CTL_ZERO_BYTES, stream);
    Args a{};
    for (int i = 0; i < N_IN; ++i) a.in[i] = (const float*)d_in[i];
    a.out = (float*)d_out; a.ws = (unsigned char*)d_ws;
#if MK_PER_PHASE
    for (int p = 0; p < N_PHASES; ++p) { a.ph_lo = p; a.ph_hi = p + 1; hipLaunchKernelGGL(fwd, dim3(grid), dim3(NTHREADS), LDS_BYTES, stream, a); }
#else
    a.ph_lo = 0; a.ph_hi = N_PHASES; hipLaunchKernelGGL(fwd, dim3(grid), dim3(NTHREADS), LDS_BYTES, stream, a);
#endif
#if PROBE_ATT >= 0
    (void)hipFuncSetAttribute((const void*)probe_k, hipFuncAttributeMaxDynamicSharedMemorySize, LDS_BYTES);
    hipLaunchKernelGGL(probe_k, dim3(grid), dim3(NTHREADS), LDS_BYTES, stream, a);
#endif
}
```

```cpp
#include <hip/hip_runtime.h>
#include <cstdio>
#include <cstdint>
namespace pg8 {
#define PG8_LAS __attribute__((address_space(3)))
typedef unsigned short bf16_t;
typedef short bf16x8 __attribute__((ext_vector_type(8)));
typedef float f32x4 __attribute__((ext_vector_type(4)));
typedef unsigned u32x4 __attribute__((ext_vector_type(4)));
constexpr int BM = 256, BK = 64, HALF = 128, HTB = HALF * BK * 2  , STAGE_BYTES = 8 * HTB, NXCD = 8, WGM = 8;

__host__ __device__ __forceinline__ int lds_byte(int r, int c) { const int st = (r >> 4) * 2 + (c >> 5), rr = r & 15, cc = c & 31, ob = rr * 64 + cc * 2; return st * 1024 + (ob ^ (((ob >> 9) & 1) << 5)); }
__host__ __device__ __forceinline__ void stage_rc(int b, int& R, int& C) { const int st = b / 1024, sb = b % 1024, swz = sb ^ (((sb >> 9) & 1) << 5); R = (st >> 1) * 16 + swz / 64; C = (st & 1) * 32 + (swz % 64) / 2; }
__host__ __device__ __forceinline__ int perm32(int rho) { const int n = rho >> 4, i = rho & 15; return 8 * (i >> 2) + 4 * n + (i & 3); }

struct Unit { int pm, pn, pc, k0, nt, ks; };
struct Gemm { const bf16_t* A; const bf16_t* Bt; int M, N, K, lda; int sA, sB; };

struct StaticOrder {
    int nM, nN, nwg, G, c;
    __host__ __device__ __forceinline__ void init(int M, int N, int G_, int c_) { nM = M / BM; nN = N / BM; nwg = nM * nN; G = G_; c = c_; }
    __host__ __device__ __forceinline__ bool next(int i, Unit& u) const {
        const long L = (long)i * G + c; if (L >= nwg) return false;
        int wgid = (int)L; { const int q = nwg / NXCD, r = nwg % NXCD, xcd = wgid % NXCD, off = wgid / NXCD; wgid = (xcd < r ? xcd * (q + 1) : r * (q + 1) + (xcd - r) * q) + off; }
        const int nig = WGM * nN, gid = wgid / nig, fm = gid * WGM, gsz = (nM - fm) < WGM ? (nM - fm) : WGM;
        u.pm = fm + ((wgid % nig) % gsz); u.pn = (wgid % nig) / gsz; u.pc = u.pn; u.k0 = 0; u.nt = 0; u.ks = -1; return true;
    }
    __device__ __forceinline__ void a_ready(const Unit&) const {}
    __device__ __forceinline__ void done(const Unit&) const {}
};

__device__ __forceinline__ unsigned cvt_pk_bf16(float lo, float hi) { unsigned r; asm volatile("v_cvt_pk_bf16_f32 %0, %1, %2" : "=v"(r) : "v"(lo), "v"(hi)); return r; }
typedef float f32x2 __attribute__((ext_vector_type(2)));
typedef int v4i_t __attribute__((ext_vector_type(4))); typedef int v8i_t __attribute__((ext_vector_type(8)));
template <class Epi, class Sched, bool ALIGN_EPI = false, bool SP2 = false, bool FP8 = false>
__device__ __forceinline__ void gemm_phase(PG8_LAS unsigned char* lds, const Gemm g, const Sched& S, const Epi& E) {
    const int tid = threadIdx.x, wid = __builtin_amdgcn_readfirstlane(tid >> 6), lane = tid & 63, wr = wid >> 2, wc = wid & 3, fr = lane & 15, fq = lane >> 4;
    const int K = g.K; int nt = K / BK;
    unsigned voffA[2], voffB[2];
#pragma unroll
    for (int i = 0; i < 2; ++i) { int R, C; stage_rc(tid * 16 + i * 8192, R, C); const int Rb = Epi::PERM ? ((R & ~31) + perm32(R & 31)) : R;
        voffA[i] = (unsigned)(R * g.lda + C) * 2u; voffB[i] = (unsigned)(Rb * K + C) * 2u; }
    const size_t kstep = (size_t)(BK * 2);
    const size_t hstepA = (size_t)HALF * g.lda * 2, hstepB = (size_t)HALF * K * 2;
    const size_t tstepA = 2 * hstepA, tstepB = 2 * hstepB;
    const unsigned ldsw = (unsigned)wid * 1024u;
    const int aoff = lds_byte(wr * 64 + fr, fq * 8), boff = lds_byte(wc * 32 + fr, fq * 8);
#define PG8_SA(b, h) (((b) * 2 + (h)) * HTB)
#define PG8_SB(b, h) ((4 + (b) * 2 + (h)) * HTB)
#define PG8_STAGE(bufoff, gbase, voff) do { _Pragma("unroll") for (int _i = 0; _i < 2; ++_i) \
        __builtin_amdgcn_global_load_lds((const unsigned*)((const char*)(gbase) + (voff)[_i]), (PG8_LAS unsigned*)(lds + (bufoff) + ldsw + _i * 8192), 16, 0, 0); } while (0)
#define PG8_LDA(dst, b, h) do { if constexpr (FP8) { _Pragma("unroll") for (int m = 0; m < 4; ++m) { const v4i_t lo_ = *(const PG8_LAS v4i_t*)(lds + PG8_SA(b, h) + aoff + m * 2048), hi_ = *(const PG8_LAS v4i_t*)(lds + PG8_SA(b, h) + aoff + m * 2048 + 1024); \
        dst##8[m] = __builtin_shufflevector(lo_, hi_, 0, 1, 2, 3, 4, 5, 6, 7); } } \
    else { _Pragma("unroll") for (int m = 0; m < 4; ++m) _Pragma("unroll") for (int k = 0; k < 2; ++k) dst[m][k] = *(const PG8_LAS bf16x8*)(lds + PG8_SA(b, h) + aoff + m * 2048 + k * 1024); } } while (0)
#define PG8_LDB(dst, b, h) do { if constexpr (FP8) { _Pragma("unroll") for (int n = 0; n < 2; ++n) { const v4i_t lo_ = *(const PG8_LAS v4i_t*)(lds + PG8_SB(b, h) + boff + n * 2048), hi_ = *(const PG8_LAS v4i_t*)(lds + PG8_SB(b, h) + boff + n * 2048 + 1024); \
        dst##8[n] = __builtin_shufflevector(lo_, hi_, 0, 1, 2, 3, 4, 5, 6, 7); } } \
    else { _Pragma("unroll") for (int n = 0; n < 2; ++n) _Pragma("unroll") for (int k = 0; k < 2; ++k) dst[n][k] = *(const PG8_LAS bf16x8*)(lds + PG8_SB(b, h) + boff + n * 2048 + k * 1024); } } while (0)
#define PG8_MMA(ai, bj, At, Bt) do { __builtin_amdgcn_s_setprio(1); _Pragma("unroll") for (int m = 0; m < 4; ++m) _Pragma("unroll") for (int n = 0; n < 2; ++n) { \
        if constexpr (FP8) { asm volatile("v_mfma_scale_f32_16x16x128_f8f6f4 %0, %1, %2, %0, %3, %4 op_sel_hi:[0,0,0]" : "+v"(acc[ai][bj][m][n]) : "v"(Bt##8[n]), "v"(At##8[m]), "v"(sB_), "v"(sA_)); } \
        else { _Pragma("unroll") for (int k = 0; k < 2; ++k) acc[ai][bj][m][n] = __builtin_amdgcn_mfma_f32_16x16x32_bf16(Bt[n][k], At[m][k], acc[ai][bj][m][n], 0, 0, 0); } } \
        __builtin_amdgcn_s_setprio(0); } while (0)
#define PG8_WAIT_V(n) asm volatile("s_waitcnt vmcnt(" #n ")" ::: "memory")
#define PG8_WAIT_L(n) asm volatile("s_waitcnt lgkmcnt(" #n ")" ::: "memory")
#define PG8_BAR __builtin_amdgcn_s_barrier()
#define PG8_SCHED __builtin_amdgcn_sched_barrier(0)
    Unit cur, nxt; int ui = 0;
    if (!S.next(0, cur)) return;
    const int sA_ = g.sA, sB_ = g.sB;
    f32x4 acc[2][2][4][2];
#pragma unroll
    for (int a = 0; a < 2; ++a)
#pragma unroll
        for (int b = 0; b < 2; ++b)
#pragma unroll
            for (int m = 0; m < 4; ++m)
#pragma unroll
                for (int n = 0; n < 2; ++n) acc[a][b][m][n] = (f32x4){0.f, 0.f, 0.f, 0.f};
    bf16x8 At[4][2], B0[2][2], B1[2][2]; v8i_t At8[4], B08[2], B18[2];
    if (cur.nt) nt = cur.nt;
    const char* cA = (const char*)g.A + (size_t)cur.pm * tstepA + (size_t)cur.k0 * 2; const char* cB = (const char*)g.Bt + (size_t)cur.pn * tstepB + (size_t)cur.k0 * 2;
    S.a_ready(cur);
    if constexpr (SP2) {
        PG8_STAGE(PG8_SB(0, 0), cB, voffB); PG8_STAGE(PG8_SB(0, 1), cB + hstepB, voffB); PG8_STAGE(PG8_SA(0, 0), cA, voffA); PG8_STAGE(PG8_SA(0, 1), cA + hstepA, voffA);
        if (wr == 1) PG8_BAR;
        PG8_WAIT_V(2); PG8_BAR;
        PG8_STAGE(PG8_SB(1, 0), cB + kstep, voffB); PG8_STAGE(PG8_SA(1, 0), cA + kstep, voffA); PG8_STAGE(PG8_SB(1, 1), cB + hstepB + kstep, voffB);
        PG8_WAIT_V(6); PG8_BAR;
    } else {
        PG8_STAGE(PG8_SB(0, 0), cB, voffB); PG8_STAGE(PG8_SA(0, 0), cA, voffA); PG8_STAGE(PG8_SB(0, 1), cB + hstepB, voffB); PG8_STAGE(PG8_SA(0, 1), cA + hstepA, voffA);
        if (wr == 1) PG8_BAR;
        PG8_WAIT_V(4); PG8_BAR;
        PG8_STAGE(PG8_SB(1, 0), cB + kstep, voffB); PG8_STAGE(PG8_SA(1, 0), cA + kstep, voffA); PG8_STAGE(PG8_SB(1, 1), cB + hstepB + kstep, voffB);
        PG8_WAIT_V(6); PG8_BAR;
    }
    for (;;) {
        const bool has_next = S.next(ui + 1, nxt);
        const char* nA = has_next ? (const char*)g.A + (size_t)nxt.pm * tstepA + (size_t)nxt.k0 * 2 : cA; const char* nB = has_next ? (const char*)g.Bt + (size_t)nxt.pn * tstepB + (size_t)nxt.k0 * 2 : cB;
#pragma unroll 1
        for (int t = 0; t < nt; t += 2) {
            const bool last = (t == nt - 2);
            const char* a1 = cA + (size_t)(t + 1) * kstep;
            const char* a2 = last ? nA : cA + (size_t)(t + 2) * kstep; const char* b2 = last ? nB : cB + (size_t)(t + 2) * kstep;
            const char* a3 = a2 + kstep; const char* b3 = b2 + kstep;
            if (last && has_next) S.a_ready(nxt);
            if constexpr (SP2) {
            PG8_LDB(B0, 0, 0); PG8_LDB(B1, 0, 1); PG8_SCHED; PG8_LDA(At, 0, 0); PG8_STAGE(PG8_SA(1, 1), a1 + hstepA, voffA);
            PG8_WAIT_V(8); PG8_WAIT_L(0); PG8_BAR; PG8_MMA(0, 0, At, B0); PG8_MMA(0, 1, At, B1); PG8_BAR; PG8_SCHED;
            PG8_LDA(At, 0, 1); PG8_STAGE(PG8_SB(0, 0), b2, voffB); PG8_STAGE(PG8_SB(0, 1), b2 + hstepB, voffB); PG8_STAGE(PG8_SA(0, 0), a2, voffA);
            PG8_WAIT_V(8); PG8_WAIT_L(0); PG8_BAR; PG8_MMA(1, 0, At, B0); PG8_MMA(1, 1, At, B1); PG8_BAR; PG8_SCHED;
            PG8_LDB(B0, 1, 0); PG8_LDB(B1, 1, 1); PG8_SCHED; PG8_LDA(At, 1, 0); PG8_STAGE(PG8_SA(0, 1), a2 + hstepA, voffA);
            PG8_WAIT_V(8); PG8_WAIT_L(0); PG8_BAR; PG8_MMA(0, 0, At, B0); PG8_MMA(0, 1, At, B1); PG8_BAR; PG8_SCHED;
            PG8_LDA(At, 1, 1); PG8_STAGE(PG8_SB(1, 0), b3, voffB); PG8_STAGE(PG8_SB(1, 1), b3 + hstepB, voffB); PG8_STAGE(PG8_SA(1, 0), a3, voffA);
            PG8_WAIT_V(8); PG8_WAIT_L(0); PG8_BAR; PG8_MMA(1, 0, At, B0); PG8_MMA(1, 1, At, B1); PG8_BAR; PG8_SCHED;
            } else {
            PG8_LDB(B0, 0, 0); PG8_SCHED; PG8_LDA(At, 0, 0); PG8_STAGE(PG8_SA(1, 1), a1 + hstepA, voffA);
            PG8_WAIT_L(8); PG8_BAR; PG8_WAIT_L(0); PG8_MMA(0, 0, At, B0); PG8_BAR; PG8_SCHED;
            PG8_LDB(B1, 0, 1); PG8_STAGE(PG8_SB(0, 0), b2, voffB);
            PG8_BAR; PG8_WAIT_L(0); PG8_MMA(0, 1, At, B1); PG8_BAR;
            PG8_LDA(At, 0, 1); PG8_STAGE(PG8_SA(0, 0), a2, voffA);
            PG8_BAR; PG8_WAIT_L(0); PG8_MMA(1, 0, At, B0); PG8_BAR; PG8_SCHED;
            PG8_STAGE(PG8_SB(0, 1), b2 + hstepB, voffB);
            PG8_WAIT_V(6); PG8_BAR; PG8_MMA(1, 1, At, B1); PG8_BAR;
            PG8_LDB(B0, 1, 0); PG8_SCHED; PG8_LDA(At, 1, 0); PG8_STAGE(PG8_SA(0, 1), a2 + hstepA, voffA);
            PG8_WAIT_L(8); PG8_BAR; PG8_WAIT_L(0); PG8_MMA(0, 0, At, B0); PG8_BAR; PG8_SCHED;
            PG8_LDB(B1, 1, 1); PG8_STAGE(PG8_SB(1, 0), b3, voffB);
            PG8_BAR; PG8_WAIT_L(0); PG8_MMA(0, 1, At, B1); PG8_BAR;
            PG8_LDA(At, 1, 1); PG8_STAGE(PG8_SA(1, 0), a3, voffA);
            PG8_BAR; PG8_WAIT_L(0); PG8_MMA(1, 0, At, B0); PG8_BAR; PG8_SCHED;
            PG8_STAGE(PG8_SB(1, 1), b3 + hstepB, voffB);
            PG8_WAIT_V(6); PG8_BAR; PG8_MMA(1, 1, At, B1); PG8_BAR;
            }
        }
        if constexpr (FP8) asm volatile("s_nop 15\n\ts_nop 15" ::: "memory");
        if constexpr (ALIGN_EPI) { if (wr == 0) PG8_BAR; }
        if constexpr (!Epi::AFTER_DRAIN) { E(acc, cur, wr, wc, fr, fq); S.done(cur); }
        if (!has_next) break;
#pragma unroll
        for (int a = 0; a < 2; ++a)
#pragma unroll
            for (int b = 0; b < 2; ++b)
#pragma unroll
                for (int m = 0; m < 4; ++m)
#pragma unroll
                    for (int n = 0; n < 2; ++n) acc[a][b][m][n] = (f32x4){0.f, 0.f, 0.f, 0.f};
        cur = nxt; cA = nA; cB = nB; ++ui; nt = cur.nt ? cur.nt : K / BK;
        if constexpr (ALIGN_EPI) { if (wr == 1) PG8_BAR; }
    }
    PG8_WAIT_V(0);
    if constexpr (!ALIGN_EPI) { if (wr == 0) PG8_BAR; }
    PG8_BAR;
    if constexpr (Epi::AFTER_DRAIN) { E.fused(acc, cur, wr, wc, fr, fq, lds, wid, lane); S.done(cur); }
#undef PG8_SA
#undef PG8_SB
#undef PG8_STAGE
#undef PG8_LDA
#undef PG8_LDB
#undef PG8_MMA
#undef PG8_WAIT_V
#undef PG8_WAIT_L
#undef PG8_BAR
#undef PG8_SCHED
}
}

#ifndef PROBE_DUP
#define PROBE_DUP 0
#endif
#ifndef USE_SPLITK
#define USE_SPLITK 0
#endif
#ifndef MK_PER_PHASE
#define MK_PER_PHASE 0
#endif
constexpr int D = 1024, NBATCH = 8, SEQ = 4096, NLAT = NBATCH * SEQ, CTXL = 256, NCTX = NBATCH * CTXL, MALL = NLAT + NCTX;
constexpr int RH = 4, RQK = 256, RV = 512;
constexpr int DFF = 2816, NE = 8, DFE = 3584;
constexpr float EPS = 1e-6f;
constexpr float LAMBDA_INIT = 0.3555090675909693f;
constexpr float LOG2E = 1.4426950408889634f;
constexpr int NWAVES = 8, NTHREADS = 512;
constexpr float MOE_WSCALE = 64.0f; constexpr int MOE_SB = 0x79797979, MOE_SA = 0x7f7f7f7f;
constexpr int MOE_ROWS = 2 * NLAT + NE * 256;

enum { I_X = 0, I_C, I_CTX, I_CCTX, I_L0_WMOD, I_L0_BMOD, I_L0_NPREMIX, I_L0_NPOSTMIX, I_L0_NPREFFN, I_L0_NPOSTFFN, I_L0_WIN, I_L0_DECAY, I_L0_WOUT, I_L0_WGU, I_L0_WDN,
       I_L1_WMOD, I_L1_BMOD, I_L1_NPREMIX, I_L1_NPOSTMIX, I_L1_NPREFFN, I_L1_NPOSTFFN, I_L1_WIN, I_L1_LAMBDA, I_L1_SUBLN, I_L1_WOUT, I_L1_RW, I_L1_RB, I_L1_MGU, I_L1_MDN, N_IN };

constexpr size_t MiB = 1u << 20;
constexpr size_t WS_CTL = 0, CTL_ZERO_BYTES = 1 * MiB;
constexpr size_t WS_MODV = 1 * MiB;
constexpr size_t WS_TAB0 = 1 * MiB + 512 * 1024;
constexpr size_t WS_TAB1 = WS_TAB0 + 32 * 1024;
constexpr size_t WS_LAM = WS_TAB1 + 8 * 1024;
constexpr size_t WS_ROUTE = 2 * MiB;
constexpr size_t WS_XCTX = 3 * MiB;
constexpr size_t WS_W0IN = 11 * MiB, WS_W0OUT = 27 * MiB, WS_W0GU = 31 * MiB, WS_W0DN = 42 * MiB, WS_W1IN = 48 * MiB, WS_W1OUT = 54 * MiB, WS_WMGU = 56 * MiB, WS_WMDN = 168 * MiB;
constexpr size_t WS_H = 224 * MiB;
constexpr size_t WS_A = 292 * MiB, WS_B = 564 * MiB;
constexpr size_t WS_OF = WS_B, WS_OB = WS_B + 136 * MiB;
constexpr size_t WS_QH0 = WS_A, WS_KH0 = WS_A + 68 * MiB, WS_VQ0 = WS_A + 136 * MiB;
constexpr size_t WS_QH1 = WS_A, WS_KH1 = WS_A + 68 * MiB, WS_VH1 = WS_A + 136 * MiB;
constexpr size_t WS_HP = WS_A, WS_ACT1 = 424 * MiB, WS_Y1 = WS_A;
constexpr size_t WS_X1 = 360 * MiB, WS_X1C = 424 * MiB;
constexpr size_t WS_X2 = 496 * MiB;
constexpr size_t WS_X3 = 700 * MiB;
constexpr size_t WS_PART = WS_A + 136 * MiB;
constexpr size_t WS_END = 886 * MiB;
static_assert(WS_ACT1 + (size_t)MOE_ROWS * DFE * 2 <= WS_END, "ws map");
static_assert(WS_HP + (size_t)MOE_ROWS * D * 2 <= WS_ACT1, "ws map");
constexpr int CW_TMO = 0;
constexpr int CW_BAR = 4096;
constexpr int CW_XRANK = 12288;
constexpr int CW_MOECNT = 16384;

constexpr int RING_BYTES = 131072;
constexpr int LDS_BYTES = 163840;
constexpr int MISC_OFF = LDS_BYTES - 256;

#define GAS __attribute__((address_space(1)))
#define LAS __attribute__((address_space(3)))
typedef unsigned short bf16;
typedef unsigned v4u __attribute__((ext_vector_type(4)));
typedef unsigned v2u __attribute__((ext_vector_type(2)));
typedef float f32x4 __attribute__((ext_vector_type(4)));
typedef float f32x2 __attribute__((ext_vector_type(2)));
typedef short bf16x8 __attribute__((ext_vector_type(8)));
typedef GAS unsigned gu32;
#define RLX_AGENT __ATOMIC_RELAXED, __HIP_MEMORY_SCOPE_AGENT
#define LDS_WAIT() asm volatile("s_waitcnt lgkmcnt(0)" ::: "memory")
#define VM_WAIT() asm volatile("s_waitcnt vmcnt(0)" ::: "memory")
__device__ __forceinline__ unsigned pk2(float lo, float hi);
__device__ __forceinline__ unsigned f2bf(float f) { return pk2(f, 0.f) & 0xffffu; }
typedef float f32x2_cv __attribute__((ext_vector_type(2))); typedef __bf16 bf16x2_cv __attribute__((ext_vector_type(2)));
__device__ __forceinline__ unsigned pk2(float lo, float hi) { f32x2_cv v = {lo, hi}; bf16x2_cv b = __builtin_convertvector(v, bf16x2_cv); return __builtin_bit_cast(unsigned, b); }
__device__ __forceinline__ float bf2f(unsigned b) { return __builtin_bit_cast(float, b << 16); }
__device__ __forceinline__ float bflo(unsigned w) { return __builtin_bit_cast(float, w << 16); }
__device__ __forceinline__ float bfhi(unsigned w) { return __builtin_bit_cast(float, w & 0xffff0000u); }
__device__ __forceinline__ unsigned pk4_fp8(float a, float b, float c, float d) {
    a = __builtin_amdgcn_fmed3f(a, -448.f, 448.f); b = __builtin_amdgcn_fmed3f(b, -448.f, 448.f); c = __builtin_amdgcn_fmed3f(c, -448.f, 448.f); d = __builtin_amdgcn_fmed3f(d, -448.f, 448.f);
    int w = 0; w = __builtin_amdgcn_cvt_pk_fp8_f32(a, b, w, false); w = __builtin_amdgcn_cvt_pk_fp8_f32(c, d, w, true); return (unsigned)w; }
__device__ __forceinline__ float fast_exp2(float x) { return __builtin_amdgcn_exp2f(x); }
__device__ __forceinline__ float silu_f(float g) { return g * __builtin_amdgcn_rcpf(1.0f + __builtin_amdgcn_exp2f(-g * LOG2E)); }
__device__ __forceinline__ float wave_sum(float v) {
#pragma unroll
    for (int o = 1; o < 64; o <<= 1) v += __shfl_xor(v, o);
    return v;
}

#define XB_TMO      128
#define XB_XCNT(j)  (256  + 64 * (j))
#define XB_XSUB(j)  (1280 + 64 * (j))
#define XB_XGEN(j)  (2304 + 64 * (j))
#define XB_TOP      3328
#define XB_TOPGEN   3392
#define XCD_BAR_WORDS 3456
#define XB_SPIN_CAP (1u << 24)

__device__ __forceinline__ unsigned xb_ld(unsigned* p)              { return __hip_atomic_load(p, __ATOMIC_RELAXED, __HIP_MEMORY_SCOPE_AGENT); }
__device__ __forceinline__ unsigned xb_add(unsigned* p, unsigned v) { return __hip_atomic_fetch_add(p, v, __ATOMIC_RELAXED, __HIP_MEMORY_SCOPE_AGENT); }
__device__ __forceinline__ unsigned xb_xcc_id() { return (unsigned)__builtin_amdgcn_s_getreg((3 << 11) | 20) & 0xFu; }
#define XB_SPIN(cond, bar) do { unsigned _sp = 0; while (cond) { __builtin_amdgcn_s_sleep(1); \
    if ((++_sp & 255u) == 0u) { if (xb_ld(&(bar)[XB_TMO])) break; if (_sp > XB_SPIN_CAP) { atomicAdd(&(bar)[XB_TMO], 1u); break; } } } } while (0)

struct XcdBarrier {
    unsigned* bar; unsigned x;
    volatile LAS unsigned* st;
};

__device__ __forceinline__ XcdBarrier xcd_barrier_post(unsigned* bar, volatile LAS unsigned* st) {
    XcdBarrier b; b.bar = bar; b.x = xb_xcc_id(); b.st = st;
    if (threadIdx.x == 0) (void)xb_add(&bar[XB_XCNT(b.x)], 1u);
    return b;
}
__device__ __forceinline__ void xcd_barrier_complete(unsigned* bar, unsigned x, unsigned& nloc, unsigned& nx) {
    const unsigned G = gridDim.x * gridDim.y * gridDim.z;
    unsigned sum, cnt, mine, sp = 0u;
    for (;;) {
        sum = 0u; cnt = 0u; mine = 0u;
#pragma unroll
        for (unsigned j = 0; j < 16; ++j) { const unsigned c = xb_ld(&bar[XB_XCNT(j)]); sum += c; cnt += (c > 0u) ? 1u : 0u; mine = (j == x) ? c : mine; }
        if (sum == G) break;
        __builtin_amdgcn_s_sleep(1);
        if ((++sp & 255u) == 0u) { if (xb_ld(&bar[XB_TMO])) break; if (sp > XB_SPIN_CAP) { atomicAdd(&bar[XB_TMO], 1u); break; } }
    }
    nloc = mine > 0u ? mine : 1u; nx = cnt > 0u ? cnt : 1u;
}

__device__ __forceinline__ void xcd_barrier(const XcdBarrier& b) {
    asm volatile("s_waitcnt vmcnt(0)" ::: "memory");
    __syncthreads();
    if (threadIdx.x == 0) {
        unsigned* bar = b.bar;
        __builtin_amdgcn_s_waitcnt(0);
        unsigned nloc = b.st[0], nx = b.st[1];
        if (nloc == 0u) { xcd_barrier_complete(bar, b.x, nloc, nx); b.st[0] = nloc; b.st[1] = nx; }
        const unsigned old = xb_add(&bar[XB_XSUB(b.x)], 1u);
        const unsigned gen = old / nloc;
        if (old + 1u == (gen + 1u) * nloc) {
            __builtin_amdgcn_fence(__ATOMIC_RELEASE, "agent");
            asm volatile("s_waitcnt vmcnt(0)" ::: "memory");
            const unsigned og = xb_add(&bar[XB_TOP], 1u);
            const unsigned tg = og / nx;
            if (og + 1u == (tg + 1u) * nx) xb_add(&bar[XB_TOPGEN], 1u);
            else XB_SPIN(xb_ld(&bar[XB_TOPGEN]) == tg, bar);
            __builtin_amdgcn_fence(__ATOMIC_ACQUIRE, "agent");
            xb_add(&bar[XB_XGEN(b.x)], 1u);
            asm volatile("s_waitcnt vmcnt(0)" ::: "memory");
        } else {
            XB_SPIN(xb_ld(&bar[XB_XGEN(b.x)]) == gen, bar);
            __builtin_amdgcn_fence(__ATOMIC_ACQUIRE, "agent");
            asm volatile("s_waitcnt vmcnt(0)" ::: "memory");
        }
    }
    __syncthreads();
}


struct Args { const float* in[N_IN]; float* out; unsigned char* ws; int ph_lo, ph_hi; };

struct Frame {
    LAS unsigned char* lds;
    volatile LAS unsigned* MISC;
    gu32* ctl;
    int tid, lane, wave, vcu, G, cid;
    unsigned char* ws;
};

namespace pg8 {
struct EpiStore {
    static constexpr bool PERM = true, AFTER_DRAIN = false;
    bf16_t* O; int ldc;
    __device__ __forceinline__ void operator()(const f32x4 (&acc)[2][2][4][2], const Unit& u, int wr, int wc, int fr, int fq) const {
        const int row0 = u.pm * BM + wr * 64 + fr; const int col0 = u.pc * BM + wc * 32 + 8 * fq;
#pragma unroll
        for (int ai = 0; ai < 2; ++ai)
#pragma unroll
            for (int m = 0; m < 4; ++m) { bf16_t* rowp = O + (size_t)(row0 + ai * HALF + m * 16) * ldc + col0;
#pragma unroll
                for (int bj = 0; bj < 2; ++bj) { const f32x4 v0 = acc[ai][bj][m][0], v1 = acc[ai][bj][m][1];
                    u32x4 w; w.x = cvt_pk_bf16(v0[0], v0[1]); w.y = cvt_pk_bf16(v0[2], v0[3]); w.z = cvt_pk_bf16(v1[0], v1[1]); w.w = cvt_pk_bf16(v1[2], v1[3]);
                    *(u32x4*)(rowp + bj * HALF) = w; } }
    }
};
struct EpiSwiglu {
    static constexpr bool PERM = true, AFTER_DRAIN = false;
    bf16_t* O; int ldc;
    __device__ __forceinline__ void operator()(const f32x4 (&acc)[2][2][4][2], const Unit& u, int wr, int wc, int fr, int fq) const {
        const int row0 = u.pm * BM + wr * 64 + fr; const int col0 = u.pc * HALF + wc * 32 + 8 * fq;
#pragma unroll
        for (int ai = 0; ai < 2; ++ai)
#pragma unroll
            for (int m = 0; m < 4; ++m) { bf16_t* rowp = O + (size_t)(row0 + ai * HALF + m * 16) * ldc + col0;
                f32x4 a0, a1;
#pragma unroll
                for (int e = 0; e < 4; ++e) { a0[e] = silu_f(acc[ai][0][m][0][e]) * acc[ai][1][m][0][e]; a1[e] = silu_f(acc[ai][0][m][1][e]) * acc[ai][1][m][1][e]; }
                u32x4 w; w.x = cvt_pk_bf16(a0[0], a0[1]); w.y = cvt_pk_bf16(a0[2], a0[3]); w.z = cvt_pk_bf16(a1[0], a1[1]); w.w = cvt_pk_bf16(a1[2], a1[3]);
                *(u32x4*)rowp = w; }
    }
};

struct EpiQKV0 {
    static constexpr bool PERM = true, AFTER_DRAIN = false;
    bf16_t* Qh; bf16_t* Kh; bf16_t* Vq; const float* tab;
    __device__ __forceinline__ void operator()(const f32x4 (&acc)[2][2][4][2], const Unit& u, int wr, int wc, int fr, int fq) const {
        const int row0 = u.pm * BM + wr * 64 + fr, pc = u.pc;
        if (pc < 8) {
            bf16_t* base = pc < 4 ? Qh + (size_t)pc * MALL * 256 : Kh + (size_t)(pc - 4) * MALL * 256; const float sc = pc < 4 ? 1.0f : 0.0625f; const bool lat = u.pm < NLAT / BM;
            const int col0 = wc * 32 + 8 * fq;
#pragma unroll
            for (int ai = 0; ai < 2; ++ai)
#pragma unroll
                for (int m = 0; m < 4; ++m) { const int row = row0 + ai * HALF + m * 16, t = row & (SEQ - 1);
#pragma unroll
                    for (int bj = 0; bj < 2; ++bj) { f32x4 v0 = acc[ai][bj][m][0], v1 = acc[ai][bj][m][1];
                        if (lat) { const int pos = bj ? (t & 63) : (t >> 6); const float* tp = tab + (size_t)(pos * 64 + 16 * wc + 4 * fq) * 2;
                            const f32x4 c0 = *(const f32x4*)tp, c1 = *(const f32x4*)(tp + 4);
                            v0 = (f32x4){v0[0] * c0[0] - v0[1] * c0[1], v0[1] * c0[0] + v0[0] * c0[1], v0[2] * c0[2] - v0[3] * c0[3], v0[3] * c0[2] + v0[2] * c0[3]};
                            v1 = (f32x4){v1[0] * c1[0] - v1[1] * c1[1], v1[1] * c1[0] + v1[0] * c1[1], v1[2] * c1[2] - v1[3] * c1[3], v1[3] * c1[2] + v1[2] * c1[3]}; }
                        v0 = v0 * sc; v1 = v1 * sc;
                        u32x4 w; w.x = cvt_pk_bf16(v0[0], v0[1]); w.y = cvt_pk_bf16(v0[2], v0[3]); w.z = cvt_pk_bf16(v1[0], v1[1]); w.w = cvt_pk_bf16(v1[2], v1[3]);
                        *(u32x4*)(base + (size_t)row * 256 + col0 + bj * HALF) = w; } }
        } else {
#pragma unroll
            for (int ai = 0; ai < 2; ++ai)
#pragma unroll
                for (int m = 0; m < 4; ++m) { const int row = row0 + ai * HALF + m * 16;
#pragma unroll
                    for (int bj = 0; bj < 2; ++bj) { const f32x4 v0 = acc[ai][bj][m][0], v1 = acc[ai][bj][m][1];
                        u32x4 w; w.x = cvt_pk_bf16(v0[0], v0[1]); w.y = cvt_pk_bf16(v0[2], v0[3]); w.z = cvt_pk_bf16(v1[0], v1[1]); w.w = cvt_pk_bf16(v1[2], v1[3]);
                        *(u32x4*)(Vq + ((size_t)((pc - 8) * 2 + bj) * MALL + row) * 128 + wc * 32 + 8 * fq) = w; } }
        }
    }
};
struct EpiQKV1 {
    static constexpr bool PERM = true, AFTER_DRAIN = false;
    bf16_t* Qh; bf16_t* Kh; bf16_t* Vh; const float* tab;
    __device__ __forceinline__ void operator()(const f32x4 (&acc)[2][2][4][2], const Unit& u, int wr, int wc, int fr, int fq) const {
        const int row0 = u.pm * BM + wr * 64 + fr, pc = u.pc;
        if (pc < 8) {
            bf16_t* base = pc < 4 ? Qh : Kh; const float sc = pc < 4 ? 0.125f * LOG2E : 1.0f; const bool lat = u.pm < NLAT / BM;
            const int hf = wc & 1, p0 = 32 * hf + 8 * fq;
#pragma unroll
            for (int ai = 0; ai < 2; ++ai)
#pragma unroll
                for (int m = 0; m < 4; ++m) { const int row = row0 + ai * HALF + m * 16, t = row & (SEQ - 1);
                    const int pos = hf ? (t & 63) : (t >> 6); const float* tp = tab + (size_t)(pos * 16 + 4 * fq) * 2;
                    f32x4 c0 = (f32x4){1.f, 0.f, 1.f, 0.f}, c1 = c0;
                    if (lat) { c0 = *(const f32x4*)tp; c1 = *(const f32x4*)(tp + 4); }
#pragma unroll
                    for (int bj = 0; bj < 2; ++bj) { f32x4 v0 = acc[ai][bj][m][0], v1 = acc[ai][bj][m][1];
                        v0 = (f32x4){v0[0] * c0[0] - v0[1] * c0[1], v0[1] * c0[0] + v0[0] * c0[1], v0[2] * c0[2] - v0[3] * c0[3], v0[3] * c0[2] + v0[2] * c0[3]};
                        v1 = (f32x4){v1[0] * c1[0] - v1[1] * c1[1], v1[1] * c1[0] + v1[0] * c1[1], v1[2] * c1[2] - v1[3] * c1[3], v1[3] * c1[2] + v1[2] * c1[3]};
                        v0 = v0 * sc; v1 = v1 * sc;
                        const int head = (pc & 3) * 4 + 2 * bj + (wc >> 1);
                        u32x4 w; w.x = cvt_pk_bf16(v0[0], v0[1]); w.y = cvt_pk_bf16(v0[2], v0[3]); w.z = cvt_pk_bf16(v1[0], v1[1]); w.w = cvt_pk_bf16(v1[2], v1[3]);
                        *(u32x4*)(base + ((size_t)head * MALL + row) * 64 + p0) = w; } }
        } else {
#pragma unroll
            for (int ai = 0; ai < 2; ++ai)
#pragma unroll
                for (int m = 0; m < 4; ++m) { const int row = row0 + ai * HALF + m * 16;
#pragma unroll
                    for (int bj = 0; bj < 2; ++bj) { const f32x4 v0 = acc[ai][bj][m][0], v1 = acc[ai][bj][m][1];
                        u32x4 w; w.x = cvt_pk_bf16(v0[0], v0[1]); w.y = cvt_pk_bf16(v0[2], v0[3]); w.z = cvt_pk_bf16(v1[0], v1[1]); w.w = cvt_pk_bf16(v1[2], v1[3]);
                        *(u32x4*)(Vh + ((size_t)((pc - 8) * 2 + bj) * MALL + row) * 128 + wc * 32 + 8 * fq) = w; } }
        }
    }
};

struct EpiGateMerge {
    static constexpr bool PERM = true, AFTER_DRAIN = false;
    bf16_t* Of; const bf16_t* Ob; const float* ssq;
    __device__ __forceinline__ void operator()(const f32x4 (&acc)[2][2][4][2], const Unit& u, int wr, int wc, int fr, int fq) const {
        const int row0 = u.pm * BM + wr * 64 + fr; const int col0 = u.pc * HALF + wc * 32 + 8 * fq; const int head = u.pc >> 2;
#pragma unroll
        for (int ai = 0; ai < 2; ++ai)
#pragma unroll
            for (int m = 0; m < 4; ++m) { const size_t row = (size_t)(row0 + ai * HALF + m * 16);
                const f32x4 sf = *(const f32x4*)(ssq + (row * RH + head) * 8), sb = *(const f32x4*)(ssq + (row * RH + head) * 8 + 4);
                const float rf = __builtin_amdgcn_rsqf(((sf[0] + sf[1]) + (sf[2] + sf[3])) * (1.0f / RV) + EPS), rb = __builtin_amdgcn_rsqf(((sb[0] + sb[1]) + (sb[2] + sb[3])) * (1.0f / RV) + EPS);
                const u32x4 of = *(const u32x4*)(Of + row * 2048 + col0), ob = *(const u32x4*)(Ob + row * 2048 + col0);
                float y[8];
#pragma unroll
                for (int e = 0; e < 4; ++e) {
                    const float gf0 = acc[ai][0][m][e >> 1][2 * (e & 1)], gf1 = acc[ai][0][m][e >> 1][2 * (e & 1) + 1], gb0 = acc[ai][1][m][e >> 1][2 * (e & 1)], gb1 = acc[ai][1][m][e >> 1][2 * (e & 1) + 1];
                    y[2 * e] = silu_f(gf0) * (bflo(of[e]) * rf) + silu_f(gb0) * (bflo(ob[e]) * rb);
                    y[2 * e + 1] = silu_f(gf1) * (bfhi(of[e]) * rf) + silu_f(gb1) * (bfhi(ob[e]) * rb); }
                u32x4 w; w.x = cvt_pk_bf16(y[0], y[1]); w.y = cvt_pk_bf16(y[2], y[3]); w.z = cvt_pk_bf16(y[4], y[5]); w.w = cvt_pk_bf16(y[6], y[7]);
                *(u32x4*)(Of + row * 2048 + col0) = w; }
    }
};

struct SplitOrder {
    StaticOrder lat; int G, c, KS, ntS, nN, nl;
    __device__ __forceinline__ void init(int N, int G_, int c_, int KS_, int ntS_) { lat.init(KS_ ? NLAT : MALL, N, G_, c_); G = G_; c = c_; KS = KS_; ntS = ntS_; nN = N / BM; nl = (lat.nwg > c_) ? (lat.nwg - 1 - c_) / G_ + 1 : 0; }
    __device__ __forceinline__ bool next(int i, Unit& u) const {
        if (i < nl) return lat.next(i, u);
        const long j = (long)(i - nl) * G + c; if (j >= (long)(NCTX / BM) * nN * KS) return false;
        const int tile = (int)(j / KS), ks = (int)(j % KS);
        u.pm = NLAT / BM + tile / nN; u.pn = tile % nN; u.pc = u.pn; u.k0 = ks * ntS * BK; u.nt = ntS; u.ks = ks; return true;
    }
    __device__ __forceinline__ void a_ready(const Unit&) const {}
    __device__ __forceinline__ void done(const Unit&) const {}
};
struct EpiStoreSplit {
    static constexpr bool PERM = true, AFTER_DRAIN = false;
    bf16_t* O; int ldc; float* P;
    __device__ __forceinline__ void operator()(const f32x4 (&acc)[2][2][4][2], const Unit& u, int wr, int wc, int fr, int fq) const {
        const int row0 = u.pm * BM + wr * 64 + fr; const int col0 = u.pc * BM + wc * 32 + 8 * fq;
        if (u.ks < 0) {
#pragma unroll
            for (int ai = 0; ai < 2; ++ai)
#pragma unroll
                for (int m = 0; m < 4; ++m) { bf16_t* rowp = O + (size_t)(row0 + ai * HALF + m * 16) * ldc + col0;
#pragma unroll
                    for (int bj = 0; bj < 2; ++bj) { const f32x4 v0 = acc[ai][bj][m][0], v1 = acc[ai][bj][m][1];
                        u32x4 w; w.x = cvt_pk_bf16(v0[0], v0[1]); w.y = cvt_pk_bf16(v0[2], v0[3]); w.z = cvt_pk_bf16(v1[0], v1[1]); w.w = cvt_pk_bf16(v1[2], v1[3]);
                        *(u32x4*)(rowp + bj * HALF) = w; } }
        } else {
            float* pb = P + (size_t)u.ks * NCTX * ldc;
#pragma unroll
            for (int ai = 0; ai < 2; ++ai)
#pragma unroll
                for (int m = 0; m < 4; ++m) { float* rowp = pb + (size_t)(row0 - NLAT + ai * HALF + m * 16) * ldc + col0;
#pragma unroll
                    for (int bj = 0; bj < 2; ++bj) { *(f32x4*)(rowp + bj * HALF) = acc[ai][bj][m][0]; *(f32x4*)(rowp + bj * HALF + 4) = acc[ai][bj][m][1]; } }
        }
    }
};
struct EpiSwiglu8 {
    static constexpr bool PERM = true, AFTER_DRAIN = false;
    unsigned char* O; int ldc;
    __device__ __forceinline__ void operator()(const f32x4 (&acc)[2][2][4][2], const Unit& u, int wr, int wc, int fr, int fq) const {
        const int row0 = u.pm * BM + wr * 64 + fr; const int col0 = u.pc * HALF + wc * 32 + 8 * fq;
#pragma unroll
        for (int ai = 0; ai < 2; ++ai)
#pragma unroll
            for (int m = 0; m < 4; ++m) { unsigned char* rowp = O + (size_t)(row0 + ai * HALF + m * 16) * ldc + col0;
                f32x4 a0, a1;
#pragma unroll
                for (int e = 0; e < 4; ++e) { a0[e] = silu_f(acc[ai][0][m][0][e]) * acc[ai][1][m][0][e]; a1[e] = silu_f(acc[ai][0][m][1][e]) * acc[ai][1][m][1][e]; }
                v2u w; w.x = pk4_fp8(a0[0], a0[1], a0[2], a0[3]); w.y = pk4_fp8(a1[0], a1[1], a1[2], a1[3]);
                *(v2u*)rowp = w; }
    }
};
struct MoeOrder {
    int nM, nN, nwg, G, c; int t1, t2, t3, t4, t5, t6, t7;
    __device__ __forceinline__ bool next(int i, Unit& u) const {
        const long L = (long)i * G + c; if (L >= nwg) return false;
        int wgid = (int)L; { const int q = nwg / NXCD, r = nwg % NXCD, xcd = wgid % NXCD, off = wgid / NXCD; wgid = (xcd < r ? xcd * (q + 1) : r * (q + 1) + (xcd - r) * q) + off; }
        const int nig = WGM * nN, gid = wgid / nig, fm = gid * WGM, gsz = (nM - fm) < WGM ? (nM - fm) : WGM;
        u.pm = fm + ((wgid % nig) % gsz); u.pc = (wgid % nig) / gsz;
        const int e = (u.pm >= t1) + (u.pm >= t2) + (u.pm >= t3) + (u.pm >= t4) + (u.pm >= t5) + (u.pm >= t6) + (u.pm >= t7);
        u.pn = e * nN + u.pc; u.k0 = 0; u.nt = 0; u.ks = -1; return true;
    }
    __device__ __forceinline__ void a_ready(const Unit&) const {}
    __device__ __forceinline__ void done(const Unit&) const {}
};
}

__device__ __forceinline__ int swiglu_row(int n, int F) { const int bj = n / F, w = n % F; return 256 * (w >> 7) + 128 * bj + (w & 127); }
__device__ __forceinline__ int w_rowmap(int map, int mapF, int n) {
    if (map == 1) { if (n < 2048) { const int d0 = n & 255, hf = d0 >> 7, e = d0 & 127; return (n - d0) + 2 * (hf * 64 + (e & 63)) + (e >> 6); }
                    if (n >= 4096) return 4096 + swiglu_row(n - 4096, 2048); return n; }
    if (map == 2) { if (n < 2048) { const int d0 = n & 63, hf = d0 >> 5, e = d0 & 31; return (n - d0) + hf * 32 + 2 * (e & 15) + (e >> 4); } return n; }
    if (map == 3) return swiglu_row(n, mapF);
    return n;
}
template <bool FP8> __device__ __forceinline__ void p0_item64(const float* W, int K, int N, void* WT, int map, int mapF, LAS float* scr, int k0, int n0, int lane, float wscale) {
    { const int kq = lane >> 4, n4 = (lane & 15) * 4;
#pragma unroll 4
      for (int i = 0; i < 16; ++i) { const int k = 4 * i + kq; const f32x4 v = *(const GAS f32x4*)(W + (size_t)(k0 + k) * N + n0 + n4);
          LAS float* d = scr + k * 65 + n4; d[0] = v.x; d[1] = v.y; d[2] = v.z; d[3] = v.w; } }
    LDS_WAIT(); asm volatile("" ::: "memory");
    if constexpr (!FP8) {
        const int c = lane & 7;
#pragma unroll
        for (int j = 0; j < 8; ++j) { const int n = (lane >> 3) + 8 * j; const LAS float* sp = scr + (8 * c) * 65 + n;
            v4u o; o.x = pk2(sp[0 * 65], sp[1 * 65]); o.y = pk2(sp[2 * 65], sp[3 * 65]); o.z = pk2(sp[4 * 65], sp[5 * 65]); o.w = pk2(sp[6 * 65], sp[7 * 65]);
            *(GAS v4u*)((bf16*)WT + (size_t)w_rowmap(map, mapF, n0 + n) * K + k0 + 8 * c) = o; }
    } else {
        const int c = lane & 3;
#pragma unroll
        for (int j = 0; j < 4; ++j) { const int n = (lane >> 2) + 16 * j; const LAS float* sp = scr + (16 * c) * 65 + n;
            v4u o;
#pragma unroll
            for (int q = 0; q < 4; ++q) o[q] = pk4_fp8(sp[(4 * q) * 65] * wscale, sp[(4 * q + 1) * 65] * wscale, sp[(4 * q + 2) * 65] * wscale, sp[(4 * q + 3) * 65] * wscale);
            *(GAS v4u*)((unsigned char*)WT + (size_t)w_rowmap(map, mapF, n0 + n) * K + k0 + 16 * c) = o; }
    }
    LDS_WAIT(); asm volatile("" ::: "memory");
}

__device__ __forceinline__ void p0_prologue(Frame& F, const Args& a) {
    LAS float* scr = (LAS float*)(F.lds + F.wave * 16640);
    const int gw = F.vcu * NWAVES + F.wave, NGW = F.G * NWAVES;
    constexpr int I0 = (D / 64) * (8192 / 64), I1 = (2048 / 64) * (D / 64), I2 = (D / 64) * (2 * DFF / 64), I3 = (DFF / 64) * (D / 64), I4 = (D / 64) * (3072 / 64), I5 = (D / 64) * (D / 64);
    constexpr int I6E = (D / 64) * (2 * DFE / 64), I7E = (DFE / 64) * (D / 64);
    constexpr int NITEMS = I0 + I1 + I2 + I3 + I4 + I5 + NE * I6E + NE * I7E;
    for (int it = gw; it < NITEMS; it += NGW) {
        int r = it;
        if (r < I0) { const int nb = r % (8192 / 64), kb = r / (8192 / 64); p0_item64<false>(a.in[I_L0_WIN], D, 8192, F.ws + WS_W0IN, 1, 0, scr, 64 * kb, 64 * nb, F.lane, 1.f); continue; } r -= I0;
        if (r < I1) { const int nb = r % (D / 64), kb = r / (D / 64); p0_item64<false>(a.in[I_L0_WOUT], 2048, D, F.ws + WS_W0OUT, 0, 0, scr, 64 * kb, 64 * nb, F.lane, 1.f); continue; } r -= I1;
        if (r < I2) { const int nb = r % (2 * DFF / 64), kb = r / (2 * DFF / 64); p0_item64<false>(a.in[I_L0_WGU], D, 2 * DFF, F.ws + WS_W0GU, 3, DFF, scr, 64 * kb, 64 * nb, F.lane, 1.f); continue; } r -= I2;
        if (r < I3) { const int nb = r % (D / 64), kb = r / (D / 64); p0_item64<false>(a.in[I_L0_WDN], DFF, D, F.ws + WS_W0DN, 0, 0, scr, 64 * kb, 64 * nb, F.lane, 1.f); continue; } r -= I3;
        if (r < I4) { const int nb = r % (3072 / 64), kb = r / (3072 / 64); p0_item64<true>(a.in[I_L1_WIN], D, 3072, F.ws + WS_W1IN, 2, 0, scr, 64 * kb, 64 * nb, F.lane, MOE_WSCALE); continue; } r -= I4;
        if (r < I5) { const int nb = r % (D / 64), kb = r / (D / 64); p0_item64<false>(a.in[I_L1_WOUT], D, D, F.ws + WS_W1OUT, 0, 0, scr, 64 * kb, 64 * nb, F.lane, 1.f); continue; } r -= I5;
        if (r < NE * I6E) { const int e = r / I6E, rr = r % I6E; const int nb = rr % (2 * DFE / 64), kb = rr / (2 * DFE / 64);
            p0_item64<true>(a.in[I_L1_MGU] + (size_t)e * D * 2 * DFE, D, 2 * DFE, F.ws + WS_WMGU + (size_t)e * 2 * DFE * D, 3, DFE, scr, 64 * kb, 64 * nb, F.lane, MOE_WSCALE); continue; } r -= NE * I6E;
        { const int e = r / I7E, rr = r % I7E; const int nb = rr % (D / 64), kb = rr / (D / 64);
            p0_item64<true>(a.in[I_L1_MDN] + (size_t)e * DFE * D, DFE, D, F.ws + WS_WMDN + (size_t)e * D * DFE, 0, 0, scr, 64 * kb, 64 * nb, F.lane, MOE_WSCALE); }
    }
    __syncthreads();
    {
        LAS float* sc = (LAS float*)F.lds;
        LAS float* part = (LAS float*)(F.lds + 9 * 1024 * 4);
        bool loaded = false;
        for (int grp = F.vcu; grp < 2 * (6 * D / 64); grp += F.G) {
            if (!loaded) { for (int i = F.tid; i < 9 * 1024; i += NTHREADS) { const float cv = (i < 8 * 1024) ? a.in[I_C][i] : a.in[I_CCTX][i - 8 * 1024]; sc[i] = silu_f(cv); } loaded = true; }
            __syncthreads();
            const int layer = grp / (6 * D / 64), cb = (grp % (6 * D / 64)) * 64;
            const float* W = a.in[layer ? I_L1_WMOD : I_L0_WMOD]; const float* bm = a.in[layer ? I_L1_BMOD : I_L0_BMOD];
            const int ks = F.tid >> 6, col = F.tid & 63;
            float acc[9];
#pragma unroll
            for (int b = 0; b < 9; ++b) acc[b] = 0.f;
            for (int k = ks * 128; k < ks * 128 + 128; ++k) { const float w = W[(size_t)k * (6 * D) + cb + col];
#pragma unroll
                for (int b = 0; b < 9; ++b) acc[b] += sc[b * 1024 + k] * w; }
#pragma unroll
            for (int b = 0; b < 9; ++b) part[(ks * 9 + b) * 64 + col] = acc[b];
            __syncthreads();
            for (int o = F.tid; o < 9 * 64; o += NTHREADS) { const int b = o >> 6, cc = o & 63; float s = bm[cb + cc];
#pragma unroll
                for (int k2 = 0; k2 < 8; ++k2) s += part[(k2 * 9 + b) * 64 + cc];
                ((float*)(F.ws + WS_MODV))[((size_t)layer * 9 + b) * (6 * D) + cb + cc] = s; }
            __syncthreads();
        }
    }
    {
        const int gt = F.vcu * NTHREADS + F.tid;
        if (gt < 64 * 64 + 64 * 16) {
            int pos, i; float ex;
            if (gt < 4096) { pos = gt >> 6; i = gt & 63; ex = (float)(2 * i) / 128.0f; } else { const int q = gt - 4096; pos = q >> 4; i = q & 15; ex = (float)(2 * i) / 32.0f; }
            const float freq = __builtin_amdgcn_exp2f(-ex * 13.287712379549449f);
            const float rev = (float)pos * freq * 0.15915494309189535f;
            const float cs = __builtin_amdgcn_cosf(rev), sn = __builtin_amdgcn_sinf(rev);
            f32x2* t = (f32x2*)(F.ws + (gt < 4096 ? WS_TAB0 : WS_TAB1)); t[gt < 4096 ? gt : gt - 4096] = (f32x2){cs, sn};
        }
        if (gt == 0) { const float* lp = a.in[I_L1_LAMBDA]; float s1 = 0.f, s2 = 0.f; for (int i = 0; i < 64; ++i) { s1 += lp[i] * lp[64 + i]; s2 += lp[128 + i] * lp[192 + i]; }
            *(float*)(F.ws + WS_LAM) = __expf(s1) - __expf(s2) + LAMBDA_INIT; }
    }
}

struct RowPass {
    int nrows;
    const float* xin_lat; const float* xin_ctx; float* xout_lat; float* xout_ctx;
    const bf16* br;
    const float* gpost;
    const float* gate;
    const float* gpre;
    const float* shift; const float* scale;
    bf16* hout;
    const float* part;
};
template <bool BR, bool MOEBR, bool WH, bool ROUTE, bool H8 = false, int KSPL = 0, bool XI16 = false, bool XO16 = false>
__device__ __forceinline__ void row_pass(Frame& F, const Args& a, const RowPass& P) {
    const int gw = F.vcu * NWAVES + F.wave, NGW = F.G * NWAVES;
    const int l4 = F.lane * 4;
    for (int r = gw; r < P.nrows; r += NGW) {
        const bool lat = r < NLAT; const int rc = lat ? r : r - NLAT; const int midx = lat ? (r >> 12) : 8;
        const float* xin = (lat ? P.xin_lat : P.xin_ctx) + (size_t)rc * (XI16 ? D / 2 : D);
        float* xout = (lat ? P.xout_lat : P.xout_ctx) + (size_t)rc * (XO16 ? D / 2 : D);
        f32x4 v[4];
        if constexpr (XI16) {
#pragma unroll
            for (int j = 0; j < 4; ++j) { const v2u w = *(const GAS v2u*)((const bf16*)xin + l4 + 256 * j); v[j] = (f32x4){bflo(w.x), bfhi(w.x), bflo(w.y), bfhi(w.y)}; }
        } else {
#pragma unroll
            for (int j = 0; j < 4; ++j) v[j] = *(const GAS f32x4*)(xin + l4 + 256 * j);
        }
        if constexpr (BR || MOEBR) {
            f32x4 y[4];
            if constexpr (BR) {
                if (KSPL > 0 && !lat) {
#pragma unroll
                    for (int j = 0; j < 4; ++j) y[j] = (f32x4){0.f, 0.f, 0.f, 0.f};
                    for (int ks = 0; ks < KSPL; ++ks) { const float* pr = P.part + ((size_t)ks * NCTX + rc) * D + l4;
#pragma unroll
                        for (int j = 0; j < 4; ++j) y[j] = y[j] + *(const GAS f32x4*)(pr + 256 * j); }
                } else {
#pragma unroll
                for (int j = 0; j < 4; ++j) { const v2u w = *(const GAS v2u*)(P.br + (size_t)r * D + l4 + 256 * j); y[j] = (f32x4){bflo(w.x), bfhi(w.x), bflo(w.y), bfhi(w.y)}; }
                }
            } else {
                const int* tpos = (const int*)(F.ws + WS_ROUTE + (size_t)NLAT * 8); const float* tw = (const float*)(F.ws + WS_ROUTE + (size_t)NLAT * 16);
                const int s0 = tpos[2 * r], s1 = tpos[2 * r + 1]; const float w0 = tw[2 * r], w1 = tw[2 * r + 1];
#pragma unroll
                for (int j = 0; j < 4; ++j) { const v2u p = *(const GAS v2u*)(P.br + (size_t)s0 * D + l4 + 256 * j); const v2u q = *(const GAS v2u*)(P.br + (size_t)s1 * D + l4 + 256 * j);
                    y[j] = (f32x4){w0 * bflo(p.x) + w1 * bflo(q.x), w0 * bfhi(p.x) + w1 * bfhi(q.x), w0 * bflo(p.y) + w1 * bflo(q.y), w0 * bfhi(p.y) + w1 * bfhi(q.y)}; }
            }
            float ss = 0.f;
#pragma unroll
            for (int j = 0; j < 4; ++j) ss += (y[j].x * y[j].x + y[j].y * y[j].y) + (y[j].z * y[j].z + y[j].w * y[j].w);
            const float rstd = 1.0f / sqrtf(wave_sum(ss) * (1.0f / D) + EPS);
#pragma unroll
            for (int j = 0; j < 4; ++j) { const f32x4 gp = *(const GAS f32x4*)(P.gpost + l4 + 256 * j); const f32x4 gt = *(const GAS f32x4*)(P.gate + (size_t)midx * 6 * D + l4 + 256 * j);
                v[j] = v[j] + gt * (y[j] * rstd * gp); }
            if ((lat ? P.xout_lat : P.xout_ctx) != nullptr) {
                if constexpr (XO16) {
#pragma unroll
                    for (int j = 0; j < 4; ++j) { v2u w; w.x = pk2(v[j].x, v[j].y); w.y = pk2(v[j].z, v[j].w); *(GAS v2u*)((bf16*)xout + l4 + 256 * j) = w; }
                } else {
#pragma unroll
                    for (int j = 0; j < 4; ++j) *(GAS f32x4*)(xout + l4 + 256 * j) = v[j];
                }
            }
        }
        if constexpr (WH) {
            float ss = 0.f;
#pragma unroll
            for (int j = 0; j < 4; ++j) ss += (v[j].x * v[j].x + v[j].y * v[j].y) + (v[j].z * v[j].z + v[j].w * v[j].w);
            const float rstd = 1.0f / sqrtf(wave_sum(ss) * (1.0f / D) + EPS);
            f32x4 h[4];
#pragma unroll
            for (int j = 0; j < 4; ++j) { const f32x4 gp = *(const GAS f32x4*)(P.gpre + l4 + 256 * j); const f32x4 sc = *(const GAS f32x4*)(P.scale + (size_t)midx * 6 * D + l4 + 256 * j);
                const f32x4 sh = *(const GAS f32x4*)(P.shift + (size_t)midx * 6 * D + l4 + 256 * j);
                h[j] = (v[j] * rstd * gp) * (1.0f + sc) + sh;
                if constexpr (H8) { *(GAS unsigned*)((unsigned char*)P.hout + (size_t)r * D + l4 + 256 * j) = pk4_fp8(h[j].x, h[j].y, h[j].z, h[j].w); }
                else { v2u w; w.x = pk2(h[j].x, h[j].y); w.y = pk2(h[j].z, h[j].w); *(GAS v2u*)(P.hout + (size_t)r * D + l4 + 256 * j) = w; } }
            if constexpr (ROUTE) {
                const float* rw = a.in[I_L1_RW];
                float lg[8];
#pragma unroll
                for (int e = 0; e < 8; ++e) lg[e] = 0.f;
#pragma unroll
                for (int j = 0; j < 4; ++j)
#pragma unroll
                    for (int q = 0; q < 4; ++q) { const int k = l4 + 256 * j + q; const f32x4 wa = *(const GAS f32x4*)(rw + (size_t)k * 8), wb = *(const GAS f32x4*)(rw + (size_t)k * 8 + 4); const float hv = h[j][q];
                        lg[0] += hv * wa.x; lg[1] += hv * wa.y; lg[2] += hv * wa.z; lg[3] += hv * wa.w; lg[4] += hv * wb.x; lg[5] += hv * wb.y; lg[6] += hv * wb.z; lg[7] += hv * wb.w; }
#pragma unroll
                for (int e = 0; e < 8; ++e) lg[e] = wave_sum(lg[e]) + a.in[I_L1_RB][e];
                float v1 = lg[0]; int i1 = 0;
#pragma unroll
                for (int e = 1; e < 8; ++e) if (lg[e] > v1) { v1 = lg[e]; i1 = e; }
                float v2 = -3.0e38f; int i2 = 0;
#pragma unroll
                for (int e = 0; e < 8; ++e) if (e != i1 && lg[e] > v2) { v2 = lg[e]; i2 = e; }
                const float w1 = 1.0f / (1.0f + __expf(v2 - v1)), w2 = 1.0f - w1;
                if (F.lane == 0) {
                    int* te = (int*)(F.ws + WS_ROUTE); int* tpos = (int*)(F.ws + WS_ROUTE + (size_t)NLAT * 8); float* tw = (float*)(F.ws + WS_ROUTE + (size_t)NLAT * 16);
                    const unsigned p1 = __hip_atomic_fetch_add((unsigned*)(F.ctl + CW_MOECNT + 64 * i1), 1u, RLX_AGENT);
                    const unsigned p2 = __hip_atomic_fetch_add((unsigned*)(F.ctl + CW_MOECNT + 64 * i2), 1u, RLX_AGENT);
                    te[2 * r] = i1; te[2 * r + 1] = i2; tpos[2 * r] = (int)p1; tpos[2 * r + 1] = (int)p2; tw[2 * r] = w1; tw[2 * r + 1] = w2;
                }
            }
        }
    }
}


namespace att {
using s16x4  = __attribute__((ext_vector_type(4))) short;
using f32x16 = __attribute__((ext_vector_type(16))) float;
using u32x4  = __attribute__((ext_vector_type(4))) unsigned;
constexpr int KVBLK = 64, NT = (SEQ + CTXL) / KVBLK;
constexpr int SHM_V = KVBLK * 128 * 2, SHM_K = KVBLK * 64 * 2;
constexpr int NSLOT_K = 3, NSLOT_V = 4;
constexpr int OFF_V = 0, OFF_K = NSLOT_V * SHM_V, OFF_WS = OFF_K + NSLOT_K * SHM_K, OFF_O1 = OFF_WS + NWAVES * 64 * 4, ATT_LDS = OFF_O1 + NWAVES * 8192;
constexpr float THR = 8.0f;
#define ATT_SBAR() __builtin_amdgcn_sched_barrier(0)
#define ATT_PIPE_PV() do { __builtin_amdgcn_sched_group_barrier(0x100, 2, 0); \
    _Pragma("unroll") for (int i_ = 0; i_ < 16; ++i_) { __builtin_amdgcn_sched_group_barrier(0x008, 1, 0); __builtin_amdgcn_sched_group_barrier(0x100, 2, 0); __builtin_amdgcn_sched_group_barrier(0x002, 7, 0); } } while (0)
#define KSWZ64(row, colB) ((row) * 128 + ((colB) ^ ((((row) >> 1) & 7) << 4)))
__device__ __forceinline__ int crow(int r, int hi) { return (r & 3) + 8 * (r >> 2) + 4 * hi; }
__device__ __forceinline__ unsigned cvtpk(float lo, float hi) { return pk2(lo, hi); }

template <int VAR = 0> __device__ __forceinline__ void partialSM(f32x16& p0, f32x16& p1, float& m_reg, f32x16& negm, float& alpha) {
    float mx[4];
#pragma unroll
    for (int c = 0; c < 4; ++c) mx[c] = fmaxf(fmaxf(p0[4 * c], p0[4 * c + 1]), fmaxf(p0[4 * c + 2], p0[4 * c + 3]));
#pragma unroll
    for (int c = 0; c < 4; ++c) mx[c] = fmaxf(mx[c], fmaxf(fmaxf(p1[4 * c], p1[4 * c + 1]), fmaxf(p1[4 * c + 2], p1[4 * c + 3])));
    float pmax = fmaxf(fmaxf(mx[0], mx[1]), fmaxf(mx[2], mx[3]));
    { auto rr = __builtin_amdgcn_permlane32_swap(__float_as_uint(pmax), __float_as_uint(pmax), false, false); pmax = fmaxf(__uint_as_float(rr[0]), __uint_as_float(rr[1])); }
    alpha = 1.f; m_reg = pmax;
#pragma unroll
    for (int r = 0; r < 16; ++r) { negm[r] = -pmax; p0[r] = __builtin_amdgcn_exp2f(p0[r] - pmax); p1[r] = __builtin_amdgcn_exp2f(p1[r] - pmax); }
}
template <int VAR = 0> __device__ __forceinline__ void finishSM(f32x16& p0, f32x16& p1, float alpha, float& l_reg, bf16x8& pa0, bf16x8& pa1, bf16x8& pa2, bf16x8& pa3) {
    if (VAR != 2) {
    f32x2 s2[4];
#pragma unroll
    for (int c = 0; c < 4; ++c) s2[c] = (f32x2){p0[4 * c], p0[4 * c + 1]} + (f32x2){p0[4 * c + 2], p0[4 * c + 3]};
#pragma unroll
    for (int c = 0; c < 4; ++c) s2[c] = s2[c] + ((f32x2){p1[4 * c], p1[4 * c + 1]} + (f32x2){p1[4 * c + 2], p1[4 * c + 3]});
    const f32x2 s2t = (s2[0] + s2[1]) + (s2[2] + s2[3]);
    float ps = s2t[0] + s2t[1];
    { auto rr = __builtin_amdgcn_permlane32_swap(__float_as_uint(ps), __float_as_uint(ps), false, false); ps = __uint_as_float(rr[0]) + __uint_as_float(rr[1]); }
    l_reg = l_reg * alpha + ps;
    } else { l_reg = 1.f; }
#define ATT_PK4(P, BASE, OUT) do { u32x4 w = {cvtpk(P[BASE + 0], P[BASE + 1]), cvtpk(P[BASE + 2], P[BASE + 3]), cvtpk(P[BASE + 4], P[BASE + 5]), cvtpk(P[BASE + 6], P[BASE + 7])}; OUT = *reinterpret_cast<bf16x8*>(&w); } while (0)
    ATT_PK4(p0, 0, pa0); ATT_PK4(p0, 8, pa1); ATT_PK4(p1, 0, pa2); ATT_PK4(p1, 8, pa3);
#undef ATT_PK4
}
__device__ __forceinline__ void qkt(f32x16& p0, f32x16& p1, const char* Ks, const bf16x8* qr, const f32x16& negm, int r32, int hi) {
#pragma unroll
    for (int d0 = 0; d0 < 4; ++d0) { const int cb = (d0 * 16 + hi * 8) * 2;
        const bf16x8 b0 = *reinterpret_cast<const bf16x8*>(Ks + KSWZ64(r32, cb));
        const bf16x8 b1 = *reinterpret_cast<const bf16x8*>(Ks + KSWZ64(32 + r32, cb));
        if (d0 == 0) { p0 = __builtin_amdgcn_mfma_f32_32x32x16_bf16(b0, qr[0], negm, 0, 0, 0); p1 = __builtin_amdgcn_mfma_f32_32x32x16_bf16(b1, qr[0], negm, 0, 0, 0); }
        else { p0 = __builtin_amdgcn_mfma_f32_32x32x16_bf16(b0, qr[d0], p0, 0, 0, 0); p1 = __builtin_amdgcn_mfma_f32_32x32x16_bf16(b1, qr[d0], p1, 0, 0, 0); } }
}
__device__ __forceinline__ int v_st(int k, int c) { const int kk = (k & ~0xC) | ((k & 4) << 1) | ((k & 8) >> 1); return ((kk >> 3) * 4 + (c >> 5)) * 512 + ((kk & 7) * 32 + (c & 31)) * 2; }
__device__ __forceinline__ int v_rd_base(int lane) { return ((lane & 3) << 3) | (((lane >> 2) & 3) << 6) | (((lane >> 4) & 1) << 5) | (((lane >> 5) & 1) << 8); }
constexpr int v_rd_off(int d0, int ks, int half) { return d0 * 512 + ks * 4096 + half * 2048; }
typedef short v4i16a_t __attribute__((ext_vector_type(4)));
template <int OFF> __device__ __forceinline__ s16x4 tr_read(int vb) { return __builtin_bit_cast(s16x4, __builtin_amdgcn_ds_read_tr16_b64_v4i16((LAS v4i16a_t*)(unsigned)(vb + OFF))); }
#define ATT_PK(L, H) (bf16x8){L[0], L[1], L[2], L[3], H[0], H[1], H[2], H[3]}
template <int D0> __device__ __forceinline__ void pv_one(f32x16& od, int vb, bf16x8 pa0, bf16x8 pa1, bf16x8 pa2, bf16x8 pa3) {
    const s16x4 l0 = tr_read<v_rd_off(D0, 0, 0)>(vb), h0 = tr_read<v_rd_off(D0, 0, 1)>(vb), l1 = tr_read<v_rd_off(D0, 1, 0)>(vb), h1 = tr_read<v_rd_off(D0, 1, 1)>(vb);
    const s16x4 l2 = tr_read<v_rd_off(D0, 2, 0)>(vb), h2 = tr_read<v_rd_off(D0, 2, 1)>(vb), l3 = tr_read<v_rd_off(D0, 3, 0)>(vb), h3 = tr_read<v_rd_off(D0, 3, 1)>(vb);
    od = __builtin_amdgcn_mfma_f32_32x32x16_bf16(pa0, ATT_PK(l0, h0), od, 0, 0, 0);
    od = __builtin_amdgcn_mfma_f32_32x32x16_bf16(pa1, ATT_PK(l1, h1), od, 0, 0, 0);
    od = __builtin_amdgcn_mfma_f32_32x32x16_bf16(pa2, ATT_PK(l2, h2), od, 0, 0, 0);
    od = __builtin_amdgcn_mfma_f32_32x32x16_bf16(pa3, ATT_PK(l3, h3), od, 0, 0, 0);
}
#undef ATT_PK
__device__ __forceinline__ void pv_d0(f32x16* o, int vb, bf16x8 pa0, bf16x8 pa1, bf16x8 pa2, bf16x8 pa3) {
    pv_one<0>(o[0], vb, pa0, pa1, pa2, pa3); pv_one<1>(o[1], vb, pa0, pa1, pa2, pa3); pv_one<2>(o[2], vb, pa0, pa1, pa2, pa3); pv_one<3>(o[3], vb, pa0, pa1, pa2, pa3);
}
struct VH { bf16x8 k0, k1; };
__device__ __forceinline__ void vhalf(bf16x8& d, s16x4 lo, s16x4 hi) { d = __builtin_shufflevector(lo, hi, 0, 1, 2, 3, 4, 5, 6, 7); }
template <int D0, int KS0> __device__ __forceinline__ void vh_load(VH& f, int vb) {
    vhalf(f.k0, tr_read<v_rd_off(D0, KS0, 0)>(vb), tr_read<v_rd_off(D0, KS0, 1)>(vb)); vhalf(f.k1, tr_read<v_rd_off(D0, KS0 + 1, 0)>(vb), tr_read<v_rd_off(D0, KS0 + 1, 1)>(vb));
}
#define ATT_PKV(L, H) (bf16x8){L[0], L[1], L[2], L[3], H[0], H[1], H[2], H[3]}
#define ATT_E3(P, B) do { P[B] = __builtin_amdgcn_exp2f(P[B]); P[(B) + 1] = __builtin_amdgcn_exp2f(P[(B) + 1]); P[(B) + 2] = __builtin_amdgcn_exp2f(P[(B) + 2]); } while (0)
#define ATT_MM(D, PA, FR) o[D] = __builtin_amdgcn_mfma_f32_32x32x16_bf16(PA, FR, o[D], 0, 0, 0)
#define ATT_PIN(x) asm volatile("" : "+v"(x))
__device__ __forceinline__ void pv_partial(f32x16* o, int vb, bf16x8 pa0, bf16x8 pa1, bf16x8 pa2, bf16x8 pa3, f32x16& p0, f32x16& p1, float& m_reg, f32x16& negm, float& alpha) {
    VH fa, fb; float mx[4];
    vh_load<0, 0>(fa, vb); vh_load<0, 2>(fb, vb);
    ATT_SBAR();
    ATT_MM(0, pa0, fa.k0);
    mx[0] = fmaxf(fmaxf(p0[0], p0[1]), p0[2]); mx[1] = fmaxf(fmaxf(p0[3], p0[4]), p0[5]); mx[2] = fmaxf(fmaxf(p0[6], p0[7]), p0[8]); mx[3] = fmaxf(fmaxf(p0[9], p0[10]), p0[11]); ATT_PIN(mx[0]); ATT_PIN(mx[1]); ATT_PIN(mx[2]); ATT_PIN(mx[3]); ATT_SBAR();
    ATT_MM(0, pa1, fa.k1); vh_load<1, 0>(fa, vb);
    mx[0] = fmaxf(fmaxf(mx[0], p0[12]), p0[13]); mx[1] = fmaxf(fmaxf(mx[1], p0[14]), p0[15]); mx[2] = fmaxf(fmaxf(mx[2], p1[0]), p1[1]); mx[3] = fmaxf(fmaxf(mx[3], p1[2]), p1[3]); ATT_PIN(mx[0]); ATT_PIN(mx[1]); ATT_PIN(mx[2]); ATT_PIN(mx[3]); ATT_SBAR();
    ATT_MM(0, pa2, fb.k0);
    mx[0] = fmaxf(fmaxf(mx[0], p1[4]), p1[5]); mx[1] = fmaxf(fmaxf(mx[1], p1[6]), p1[7]); mx[2] = fmaxf(fmaxf(mx[2], p1[8]), p1[9]); mx[3] = fmaxf(fmaxf(mx[3], p1[10]), p1[11]); ATT_PIN(mx[0]); ATT_PIN(mx[1]); ATT_PIN(mx[2]); ATT_PIN(mx[3]); ATT_SBAR();
    ATT_MM(0, pa3, fb.k1); vh_load<1, 2>(fb, vb);
    mx[0] = fmaxf(fmaxf(mx[0], p1[12]), p1[13]); mx[1] = fmaxf(fmaxf(mx[1], p1[14]), p1[15]); ATT_PIN(mx[0]); ATT_PIN(mx[1]); ATT_SBAR();
    ATT_MM(1, pa0, fa.k0);
    { float pmax = fmaxf(fmaxf(mx[0], mx[1]), fmaxf(mx[2], mx[3]));
      auto rr = __builtin_amdgcn_permlane32_swap(__float_as_uint(pmax), __float_as_uint(pmax), false, false); pmax = fmaxf(__uint_as_float(rr[0]), __uint_as_float(rr[1]));
      const bool need = pmax > THR; alpha = 1.f;
      if (__any(need)) { const float delta = need ? pmax : 0.f; alpha = __builtin_amdgcn_exp2f(-delta); m_reg += delta;
#pragma unroll
          for (int r = 0; r < 16; ++r) { p0[r] -= delta; p1[r] -= delta; negm[r] -= delta; } } } ATT_PIN(alpha); ATT_SBAR();
    ATT_MM(1, pa1, fa.k1); vh_load<2, 0>(fa, vb); ATT_E3(p0, 0); ATT_PIN(p0); ATT_SBAR();
    ATT_MM(1, pa2, fb.k0); ATT_E3(p0, 3); ATT_PIN(p0); ATT_SBAR();
    ATT_MM(1, pa3, fb.k1); vh_load<2, 2>(fb, vb); ATT_E3(p0, 6); ATT_PIN(p0); ATT_SBAR();
    ATT_MM(2, pa0, fa.k0); ATT_E3(p0, 9); ATT_PIN(p0); ATT_SBAR();
    ATT_MM(2, pa1, fa.k1); vh_load<3, 0>(fa, vb); ATT_E3(p0, 12); ATT_PIN(p0); ATT_SBAR();
    ATT_MM(2, pa2, fb.k0); p0[15] = __builtin_amdgcn_exp2f(p0[15]); p1[0] = __builtin_amdgcn_exp2f(p1[0]); p1[1] = __builtin_amdgcn_exp2f(p1[1]); ATT_PIN(p0); ATT_PIN(p1); ATT_SBAR();
    ATT_MM(2, pa3, fb.k1); vh_load<3, 2>(fb, vb); ATT_E3(p1, 2); ATT_PIN(p1); ATT_SBAR();
    ATT_MM(3, pa0, fa.k0); ATT_E3(p1, 5); ATT_PIN(p1); ATT_SBAR();
    ATT_MM(3, pa1, fa.k1); ATT_E3(p1, 8); ATT_PIN(p1); ATT_SBAR();
    ATT_MM(3, pa2, fb.k0); ATT_E3(p1, 11); ATT_PIN(p1); ATT_SBAR();
    ATT_MM(3, pa3, fb.k1); p1[14] = __builtin_amdgcn_exp2f(p1[14]); p1[15] = __builtin_amdgcn_exp2f(p1[15]); ATT_PIN(p1); ATT_SBAR();
}
#undef ATT_MM
#undef ATT_PIN
#undef ATT_E3
#undef ATT_PKV
__device__ __forceinline__ size_t kvrow(int b, int t) { return t < 64 ? (size_t)b * SEQ + (size_t)t * 64 : (size_t)NLAT + (size_t)b * CTXL + (size_t)(t - 64) * 64; }

__device__ __forceinline__ void glds16(const void* gsrc, unsigned lds_dst) { unsigned keep;
    asm volatile("s_mov_b32 %0, m0\n\ts_mov_b32 m0, %2\n\ts_nop 0\n\tglobal_load_lds_dwordx4 %1, off\n\ts_mov_b32 m0, %0" : "=&s"(keep) : "v"(gsrc), "s"(lds_dst) : "memory"); }
template <int VAR> __device__ __forceinline__ void head_pass(const bf16* __restrict__ Q1, const bf16* __restrict__ K1, const bf16* __restrict__ V1, int b, int qh, int hp, size_t qrow0, char* lds, f32x16 (&o)[4], float& l_out) {
    int tid_ = threadIdx.x; asm volatile("" : "+v"(tid_));
    const int tid = tid_, wid = __builtin_amdgcn_readfirstlane(tid >> 6), lane = tid & 63, r32 = lane & 31, hi = lane >> 5;
    char* V_lds = lds + OFF_V; char* K_lds = lds + OFF_K;
    float* wsf = (float*)(lds + OFF_WS) + wid * 64; float* al_l = wsf + 32;
    float m_reg = 0.f, l_reg = 0.f; f32x16 negm = f32x16{};
#pragma unroll
    for (int d = 0; d < 4; ++d) o[d] = f32x16{};
    const bf16* Kh = K1 + (size_t)qh * MALL * 64; const bf16* Vh = V1 + (size_t)hp * MALL * 128;
    const int kr = 8 * wid + (lane >> 3); const unsigned koff = (unsigned)(kr * 128 + (((lane & 7) ^ ((kr >> 1) & 7)) << 4));
    unsigned voff[2];
#pragma unroll
    for (int p = 0; p < 2; ++p) { const int st = 2 * (2 * wid + p) + (lane >> 5), kk = 8 * (st >> 2) + ((lane & 31) >> 2), cch = 32 * (st & 3) + 8 * (lane & 3);
        voff[p] = (unsigned)(kk * 256 + cch * 2); }
    const unsigned lbase = (unsigned)(uintptr_t)lds;
#define ATT_ISSUE(t_, ks_, vs_) do { const size_t rb_ = kvrow(b, (t_)); const char* kb_ = (const char*)(Kh + rb_ * 64); const char* vb_ = (const char*)(Vh + rb_ * 128); \
    glds16(kb_ + koff, (unsigned)__builtin_amdgcn_readfirstlane(lbase + OFF_K + (ks_) * SHM_K + wid * 1024)); \
    glds16(vb_ + voff[0], (unsigned)__builtin_amdgcn_readfirstlane(lbase + OFF_V + (vs_) * SHM_V + (2 * wid) * 1024)); \
    glds16(vb_ + voff[1], (unsigned)__builtin_amdgcn_readfirstlane(lbase + OFF_V + (vs_) * SHM_V + (2 * wid + 1) * 1024)); } while (0)
#define ATT_WAITBAR(N) do { asm volatile("s_waitcnt vmcnt(" #N ")" ::: "memory"); __builtin_amdgcn_s_barrier(); asm volatile("" ::: "memory"); } while (0)
#define ATT_RESC(al) do { if (__any((al) < 1.f)) { if (hi == 0) al_l[r32] = (al); asm volatile("s_waitcnt lgkmcnt(0)" ::: "memory"); \
    _Pragma("unroll") for (int d = 0; d < 4; ++d) _Pragma("unroll") for (int r = 0; r < 16; ++r) o[d][r] *= al_l[crow(r, hi)]; } } while (0)
    bf16x8 qr[4];
    const bf16* Qw = Q1 + ((size_t)qh * MALL + qrow0 + wid * 32 + r32) * 64 + hi * 8;
#pragma unroll
    for (int d0 = 0; d0 < 4; ++d0) qr[d0] = *reinterpret_cast<const bf16x8*>(Qw + d0 * 16);
    const int vb0 = (int)(uintptr_t)V_lds + v_rd_base(lane);
    f32x16 pA0, pA1, pB0, pB1; float alA = 1.f, alB = 1.f; bf16x8 pa0, pa1, pa2, pa3;
    int kq = 1, ki = 2, vA = 0, vB = 3, vi = 2;
#define ATT_ADV() do { kq = ki; ki = (ki == 2) ? 0 : ki + 1; vB = vA; vA = (vA + 1) & 3; vi = (vi + 1) & 3; } while (0)
    ATT_ISSUE(0, 0, 0); ATT_ISSUE(1, 1, 1);
    ATT_WAITBAR(3);
    {
        qkt(pA0, pA1, K_lds, qr, negm, r32, hi); partialSM<VAR>(pA0, pA1, m_reg, negm, alA);
        ATT_WAITBAR(2);
#define ATT_STEP_A(PC0, PC1, ALC, PN0, PN1, ALN, j_) do { \
        ATT_ISSUE((j_) + 2, ki, vi); \
        ATT_SBAR(); qkt(PN0, PN1, K_lds + kq * SHM_K, qr, negm, r32, hi); \
        finishSM<VAR>(PC0, PC1, ALC, l_reg, pa0, pa1, pa2, pa3); ATT_SBAR(); \
        pv_partial(o, vb0 + vA * SHM_V, pa0, pa1, pa2, pa3, PN0, PN1, m_reg, negm, ALN); \
        ATT_RESC(ALN); \
        ATT_WAITBAR(2); ATT_ADV(); } while (0)
        for (int j = 0; j + 2 < NT; j += 2) {
            ATT_STEP_A(pA0, pA1, alA, pB0, pB1, alB, j);
            ATT_STEP_A(pB0, pB1, alB, pA0, pA1, alA, j + 1);
        }
        ATT_SBAR(); qkt(pB0, pB1, K_lds + kq * SHM_K, qr, negm, r32, hi);
        finishSM<VAR>(pA0, pA1, alA, l_reg, pa0, pa1, pa2, pa3); ATT_SBAR();
        pv_partial(o, vb0 + vA * SHM_V, pa0, pa1, pa2, pa3, pB0, pB1, m_reg, negm, alB);
        ATT_RESC(alB);
        ATT_WAITBAR(0);
        finishSM<VAR>(pB0, pB1, alB, l_reg, pa0, pa1, pa2, pa3); ATT_SBAR();
        if (VAR != 1) pv_d0(o, vb0 + ((vA + 1) & 3) * SHM_V, pa0, pa1, pa2, pa3);
#undef ATT_STEP_A
    }
    l_out = l_reg;
    asm volatile("s_waitcnt lgkmcnt(0)" ::: "memory"); __builtin_amdgcn_s_barrier(); asm volatile("" ::: "memory");
#undef ATT_ADV
#undef ATT_ISSUE
#undef ATT_WAITBAR
#undef ATT_RESC
}

template <int VAR> __device__ __forceinline__ void attn_unit(const bf16* __restrict__ Q1, const bf16* __restrict__ K1, const bf16* __restrict__ V1, bf16* __restrict__ ao, int b, int hp, int qb, char* lds, const float* lamp, const float* subln) {
    int tid_ = threadIdx.x; asm volatile("" : "+v"(tid_));
    const int tid = tid_, wid = tid >> 6, lane = tid & 63, r32 = lane & 31, hi = lane >> 5;
    float* wsf = (float*)(lds + OFF_WS) + wid * 64;
    unsigned* o1s = (unsigned*)(lds + OFF_O1 + wid * 8192);
    const size_t qrow0 = (size_t)b * SEQ + (size_t)qb * 256;
    f32x16 o[4]; float l;
    float ssq[16];
#pragma unroll 1
    for (int hh = 0; hh < 2; ++hh) {
        head_pass<VAR>(Q1, K1, V1, b, 2 * hp + hh, hp, qrow0, lds, o, l);
        if (hi == 0) wsf[r32] = l; asm volatile("s_waitcnt lgkmcnt(0)" ::: "memory");
        float rli[16];
#pragma unroll
        for (int r = 0; r < 16; ++r) { rli[r] = __builtin_amdgcn_rcpf(wsf[crow(r, hi)]); ssq[r] = 0.f; }
        if (hh == 0) {
#pragma unroll
            for (int d0 = 0; d0 < 4; ++d0)
#pragma unroll
                for (int r = 0; r < 16; r += 2) o1s[(d0 * 8 + (r >> 1)) * 64 + lane] = cvtpk(o[d0][r] * rli[r], o[d0][r + 1] * rli[r + 1]);
            __syncthreads();
        } else {
            asm volatile("" : "+s"(lamp)); const float lam = *lamp;
#pragma unroll
            for (int d0 = 0; d0 < 4; ++d0)
#pragma unroll
                for (int r = 0; r < 16; r += 2) { const unsigned w = o1s[(d0 * 8 + (r >> 1)) * 64 + lane];
                    const float a0 = bflo(w) - lam * (o[d0][r] * rli[r]), a1 = bfhi(w) - lam * (o[d0][r + 1] * rli[r + 1]);
                    o[d0][r] = a0; o[d0][r + 1] = a1; ssq[r] += a0 * a0; ssq[r + 1] += a1 * a1; }
        }
    }
#pragma unroll
    for (int r = 0; r < 16; ++r) { float s = ssq[r];
        s += __shfl_xor(s, 1); s += __shfl_xor(s, 2); s += __shfl_xor(s, 4); s += __shfl_xor(s, 8); s += __shfl_xor(s, 16);
        ssq[r] = 1.0f / sqrtf(s * (1.0f / 128.0f) + EPS) * (1.0f - LAMBDA_INIT); }
    asm volatile("s_waitcnt lgkmcnt(0)" ::: "memory");
    bf16* stg = (bf16*)o1s;
    asm volatile("" : "+s"(subln));
#pragma unroll
    for (int d0 = 0; d0 < 4; ++d0) { const float g = subln[d0 * 32 + r32];
#pragma unroll
        for (int r = 0; r < 16; ++r) stg[crow(r, hi) * 128 + d0 * 32 + r32] = (bf16)f2bf(o[d0][r] * ssq[r] * g); }
    asm volatile("s_waitcnt lgkmcnt(0)" ::: "memory");
    bf16* Ow = ao + (qrow0 + wid * 32) * D + hp * 128;
#pragma unroll
    for (int i = 0; i < 8; ++i) { const int row = i * 4 + (lane >> 4), ch = lane & 15; const u32x4 v = *(const u32x4*)(stg + row * 128 + ch * 8); *(u32x4*)(Ow + (size_t)row * D + ch * 8) = v; }
    asm volatile("s_waitcnt lgkmcnt(0)" ::: "memory");
    __syncthreads();
}
#undef ATT_SBAR
}

template <int VAR> __device__ __forceinline__ void attn_phase(Frame& F, const Args& a, bf16* ao) {
    const bf16* Q1 = (const bf16*)(F.ws + WS_QH1); const bf16* K1 = (const bf16*)(F.ws + WS_KH1); const bf16* V1 = (const bf16*)(F.ws + WS_VH1);
    const float* lamp = (const float*)(F.ws + WS_LAM);
    for (int unit = F.vcu; unit < NBATCH * 8 * 16; unit += F.G) {
        const int qb = unit & 15, hp = (unit >> 4) & 7, b = unit >> 7;
        att::attn_unit<VAR>(Q1, K1, V1, ao, b, hp, qb, (char*)F.lds, lamp, a.in[I_L1_SUBLN]);
    }
}


namespace ret {
using s16x4  = __attribute__((ext_vector_type(4))) short;
using f32x16 = __attribute__((ext_vector_type(16))) float;
typedef short v4i16_t __attribute__((ext_vector_type(4)));
constexpr int C = 32, NSTEP = (SEQ + CTXL) / C;
constexpr int ST_Q = 0, ST_K = 16384, ST_V = 32768, ST_SC = 40960, ST_BYTES = 43008, NSTAGE = 3;
constexpr int XBUF_OFF = NSTAGE * ST_BYTES, RET_LDS = XBUF_OFF + NWAVES * 4096;
constexpr size_t WS_SSQ = 836 * MiB;
constexpr size_t WS_SC = 842 * MiB;

__device__ __forceinline__ void glds16(const void* gsrc, unsigned lds_dst) { unsigned keep;
    asm volatile("s_mov_b32 %0, m0\n\ts_mov_b32 m0, %2\n\ts_nop 0\n\tglobal_load_lds_dwordx4 %1, off\n\ts_mov_b32 m0, %0" : "=&s"(keep) : "v"(gsrc), "s"(lds_dst) : "memory"); }
__device__ __forceinline__ s16x4 vtr(const LAS char* p) { return __builtin_bit_cast(s16x4, __builtin_amdgcn_ds_read_tr16_b64_v4i16((LAS v4i16_t*)p)); }

__device__ __forceinline__ void ret_scores(Frame& F) {
    const bf16* Qh = (const bf16*)(F.ws + WS_QH0); const bf16* Kh = (const bf16*)(F.ws + WS_KH0); bf16* sc = (bf16*)(F.ws + WS_SC);
    const int gw = F.vcu * NWAVES + F.wave, NGW = F.G * NWAVES;
    const int r32 = F.lane & 31, hh = F.lane >> 5;
    for (int task = gw; task < (MALL / C) * RH; task += NGW) {
        const int h = task & 3, ch = task >> 2;
        const bf16* qp = Qh + ((size_t)h * MALL + (size_t)ch * C + r32) * 256 + hh * 8;
        const bf16* kp = Kh + ((size_t)h * MALL + (size_t)ch * C + r32) * 256 + hh * 8;
        f32x16 acc = f32x16{};
        bf16x8 a[16], b[16];
#pragma unroll
        for (int s = 0; s < 16; ++s) { a[s] = *reinterpret_cast<const bf16x8*>(qp + s * 16); b[s] = *reinterpret_cast<const bf16x8*>(kp + s * 16); }
#pragma unroll
        for (int s = 0; s < 16; ++s) acc = __builtin_amdgcn_mfma_f32_32x32x16_bf16(a[s], b[s], acc, 0, 0, 0);
        bf16* tp = sc + (size_t)task * 1024;
#pragma unroll
        for (int r = 0; r < 16; ++r) { const int i = (r & 3) + 8 * (r >> 2) + 4 * hh; tp[i * 32 + r32] = (bf16)f2bf(acc[r]); }
    }
}

__device__ __forceinline__ size_t step_row0(int b, int dir, int t) {
    if (t < 8) { const int blk = dir ? 7 - t : t; return (size_t)NLAT + (size_t)b * CTXL + (size_t)blk * C; }
    const int blk = dir ? 127 - (t - 8) : (t - 8); return (size_t)b * SEQ + (size_t)blk * C;
}

template <int SV = 0> __device__ __forceinline__ void ret_scan(Frame& F, const Args& a) {
    const char* qb = (const char*)(F.ws + WS_QH0); const char* kb = (const char*)(F.ws + WS_KH0); const char* vb = (const char*)(F.ws + WS_VQ0); const char* scb = (const char*)(F.ws + WS_SC);
    for (int unit = F.vcu; unit < NBATCH * RH * 2 * 4; unit += F.G) {
        int tid_ = threadIdx.x; asm volatile("" : "+v"(tid_));
        const int tid = tid_, lane = tid & 63, w = __builtin_amdgcn_readfirstlane(tid >> 6), dh = w >> 2, vs = w & 3, r32 = lane & 31, hh = lane >> 5;
        const int vq = unit & 3, dir = (unit >> 2) & 1, h = (unit >> 3) & 3, b = unit >> 5;
        const float logit = a.in[I_L0_DECAY][dir * RH + h];
        const float lg2 = -__builtin_amdgcn_logf(1.0f + __builtin_amdgcn_exp2f(-logit * LOG2E));
        const float gC = __builtin_amdgcn_exp2f(lg2 * (float)C), gCi = __builtin_amdgcn_exp2f(-lg2 * (float)C);
        float kd[2][8];
#pragma unroll
        for (int s = 0; s < 2; ++s)
#pragma unroll
            for (int jj = 0; jj < 8; ++jj) { const int j = 16 * s + 8 * hh + jj; kd[s][jj] = __builtin_amdgcn_exp2f(lg2 * (float)(dir ? j : 31 - j)); }
        const int om = 4 * w + (lane >> 4);
        const float rsc = __builtin_amdgcn_exp2f(-lg2 * (float)(dir ? om : 31 - om));
        unsigned pm[4];
#pragma unroll
        for (int e = 0; e < 4; ++e) { const int j0 = 16 * dh + 8 * hh + 2 * e, j1 = j0 + 1; const bool k0 = dir ? (j0 >= r32) : (j0 <= r32), k1 = dir ? (j1 >= r32) : (j1 <= r32);
            pm[e] = (k0 ? 0x0000ffffu : 0u) | (k1 ? 0xffff0000u : 0u); }
        unsigned offq[2], offk[2];
#pragma unroll
        for (int p = 0; p < 2; ++p) { const int i = 2 * (2 * w + p) + (lane >> 5), cp = lane & 31;
            offq[p] = (unsigned)(i * 512 + ((cp ^ (i & 15)) << 4)); offk[p] = (unsigned)(i * 512 + ((cp ^ ((i & 3) << 2)) << 4)); }
        unsigned offv; { const int j = 4 * w + (lane >> 4), cp = lane & 15; offv = (unsigned)(j * 256 + ((cp ^ ((j & 3) << 2)) << 4)); }
        const char* qhb = qb + (size_t)h * MALL * 512; const char* khb = kb + (size_t)h * MALL * 512; const char* vhb = vb + (size_t)(h * 4 + vq) * MALL * 256;
        unsigned offs; { const int i = 16 * (w & 1) + (lane >> 2), cp = lane & 3; offs = (unsigned)(i * 64 + ((cp ^ ((i >> 2) & 3)) << 4)); }
        LAS unsigned char* L = F.lds;
        const unsigned lbase = (unsigned)(uintptr_t)L;
#define RET_ISSUE(t_) do { const int t__ = (t_); const unsigned sb_ = lbase + (unsigned)((t__ % NSTAGE) * ST_BYTES); const size_t r0_ = step_row0(b, dir, t__); const char* gq_ = qhb + r0_ * 512; const char* gk_ = khb + r0_ * 512; const char* gv_ = vhb + r0_ * 256; \
        glds16(gq_ + offq[0], (unsigned)__builtin_amdgcn_readfirstlane(sb_ + ST_Q + (2 * w) * 1024)); \
        glds16(gq_ + offq[1], (unsigned)__builtin_amdgcn_readfirstlane(sb_ + ST_Q + (2 * w + 1) * 1024)); \
        glds16(gk_ + offk[0], (unsigned)__builtin_amdgcn_readfirstlane(sb_ + ST_K + (2 * w) * 1024)); \
        glds16(gk_ + offk[1], (unsigned)__builtin_amdgcn_readfirstlane(sb_ + ST_K + (2 * w + 1) * 1024)); \
        glds16(gv_ + offv, (unsigned)__builtin_amdgcn_readfirstlane(sb_ + ST_V + w * 1024)); \
        if (w < 2) glds16(scb + ((r0_ >> 5) * 4 + h) * 2048 + offs, (unsigned)__builtin_amdgcn_readfirstlane(sb_ + ST_SC + w * 1024)); } while (0)
        const int qrow = ST_Q + r32 * 512; const int qx = r32 & 15;
        const int G = lane >> 4, il = lane & 15, tq = il >> 2, tp = il & 3;
        const int kcolb = (128 * dh + 16 * (G & 1) + 8 * (tp & 1) + 4 * (tp >> 1)) * 2;
        const int vcolb = (32 * vs + 16 * (G & 1) + 4 * tp) * 2;
        f32x16 S[4];
#pragma unroll
        for (int T = 0; T < 4; ++T) S[T] = f32x16{};
        float cinv = 1.0f, cfw = 1.0f;
        bf16* outp = (bf16*)(F.ws + (dir ? WS_OB : WS_OF));
        LAS float* xb_mine = (LAS float*)(L + XBUF_OFF + w * 4096);
        float* ssqp = (float*)(F.ws + WS_SSQ);

        __builtin_amdgcn_s_barrier();
        if (SV != 2 && SV != 3) { RET_ISSUE(0); RET_ISSUE(1); }
        for (int t = 0; t < NSTEP; ++t) {
            if (t == 0) { if (w < 2) asm volatile("s_waitcnt vmcnt(6)" ::: "memory"); else asm volatile("s_waitcnt vmcnt(5)" ::: "memory"); }
            else if (t == NSTEP - 1) asm volatile("s_waitcnt vmcnt(4)" ::: "memory");
            else        { if (w < 2) asm volatile("s_waitcnt vmcnt(8)" ::: "memory"); else asm volatile("s_waitcnt vmcnt(7)" ::: "memory"); }
            __builtin_amdgcn_s_barrier(); asm volatile("" ::: "memory");
            if (SV != 2 && SV != 3) { if (t + 2 < NSTEP) RET_ISSUE(t + 2); }
            const LAS char* sb = (const LAS char*)(L + (t % NSTAGE) * ST_BYTES);
            f32x16 acc = f32x16{};
            if (SV != 1 && SV != 3) {
            cinv *= gCi; cfw *= gC;
            bf16x8 vd[2];
#pragma unroll
            for (int s = 0; s < 2; ++s) {
                const int j0 = 16 * s + 8 * (G >> 1) + tq;
                const int cph = (((vcolb >> 4) ^ (tq << 2)) << 4) + (vcolb & 8);
                const s16x4 lo = vtr(sb + ST_V + j0 * 256 + cph), hi = vtr(sb + ST_V + (j0 + 4) * 256 + cph);
                float f[8];
#pragma unroll
                for (int e = 0; e < 4; ++e) { f[e] = bf2f((unsigned short)lo[e]) * (kd[s][e] * cinv); f[4 + e] = bf2f((unsigned short)hi[e]) * (kd[s][4 + e] * cinv); }
                v4u pk; pk.x = pk2(f[0], f[1]); pk.y = pk2(f[2], f[3]); pk.z = pk2(f[4], f[5]); pk.w = pk2(f[6], f[7]);
                vd[s] = __builtin_bit_cast(bf16x8, pk);
            }
#pragma unroll
            for (int T = 0; T < 4; ++T)
#pragma unroll
                for (int s = 0; s < 2; ++s) {
                    const int cL = 16 * dh + 4 * T + 2 * s + hh;
                    const bf16x8 qa = *(const LAS bf16x8*)(sb + qrow + ((cL ^ qx) << 4));
                    v4u pk; pk.x = pk2(S[T][8 * s + 0], S[T][8 * s + 1]); pk.y = pk2(S[T][8 * s + 2], S[T][8 * s + 3]); pk.z = pk2(S[T][8 * s + 4], S[T][8 * s + 5]); pk.w = pk2(S[T][8 * s + 6], S[T][8 * s + 7]);
                    acc = __builtin_amdgcn_mfma_f32_32x32x16_bf16(qa, __builtin_bit_cast(bf16x8, pk), acc, 0, 0, 0);
                }
            {
                const int cL = 2 * dh + hh;
                v4u pw = *(const LAS v4u*)(sb + ST_SC + r32 * 64 + ((cL ^ ((r32 >> 2) & 3)) << 4));
                pw.x &= pm[0]; pw.y &= pm[1]; pw.z &= pm[2]; pw.w &= pm[3];
                acc = __builtin_amdgcn_mfma_f32_32x32x16_bf16(__builtin_bit_cast(bf16x8, pw), dh ? vd[1] : vd[0], acc, 0, 0, 0);
            }
#pragma unroll
            for (int T = 0; T < 4; ++T)
#pragma unroll
                for (int s = 0; s < 2; ++s) {
                    const int j0 = 16 * s + 8 * (G >> 1) + tq;
                    const int cb = kcolb + 64 * T;
                    const int cph = (((cb >> 4) ^ (tq << 2)) << 4) + (cb & 8);
                    const s16x4 lo = vtr(sb + ST_K + j0 * 512 + cph), hi = vtr(sb + ST_K + (j0 + 4) * 512 + cph);
                    const bf16x8 ka = (bf16x8){lo[0], lo[1], lo[2], lo[3], hi[0], hi[1], hi[2], hi[3]};
                    S[T] = __builtin_amdgcn_mfma_f32_32x32x16_bf16(ka, vd[s], S[T], 0, 0, 0);
                }
            }
            if ((t & 7) == 7) {
#pragma unroll
                for (int T = 0; T < 4; ++T) S[T] = S[T] * cfw;
            }
#pragma unroll
            for (int r = 0; r < 16; ++r) xb_mine[r * 64 + lane] = acc[r];
            asm volatile("s_waitcnt lgkmcnt(0)" ::: "memory");
            __builtin_amdgcn_s_barrier(); asm volatile("" ::: "memory");
            {
                const int v0 = (lane & 15) * 8, svs = v0 >> 5, c32 = v0 & 31, rr = (om & 3) + 4 * (om >> 3), sh = (om >> 2) & 1;
                const LAS float* p0 = (const LAS float*)(L + XBUF_OFF + svs * 4096) + rr * 64 + sh * 32 + c32;
                const LAS float* p1 = (const LAS float*)(L + XBUF_OFF + (4 + svs) * 4096) + rr * 64 + sh * 32 + c32;
                const f32x4 a0 = *(const LAS f32x4*)p0, a1 = *(const LAS f32x4*)(p0 + 4), b0 = *(const LAS f32x4*)p1, b1 = *(const LAS f32x4*)(p1 + 4);
                const float rs_ = rsc * cfw; const f32x4 o0 = (a0 + b0) * rs_, o1 = (a1 + b1) * rs_;
                float ss = (o0.x * o0.x + o0.y * o0.y) + (o0.z * o0.z + o0.w * o0.w) + (o1.x * o1.x + o1.y * o1.y) + (o1.z * o1.z + o1.w * o1.w);
                ss += __shfl_xor(ss, 1); ss += __shfl_xor(ss, 2); ss += __shfl_xor(ss, 4); ss += __shfl_xor(ss, 8);
                const size_t r0 = step_row0(b, dir, t);
                v4u pk; pk.x = pk2(o0.x, o0.y); pk.y = pk2(o0.z, o0.w); pk.z = pk2(o1.x, o1.y); pk.w = pk2(o1.z, o1.w);
                *(GAS v4u*)(outp + (r0 + om) * 2048 + h * 512 + vq * 128 + v0) = pk;
                if ((lane & 15) == 0) ssqp[(((r0 + om) * RH + h) * 2 + dir) * 4 + vq] = ss;
            }
            asm volatile("s_waitcnt lgkmcnt(0)" ::: "memory");
            if ((t & 7) == 7) { cinv = 1.0f; cfw = 1.0f; }
        }
        asm volatile("s_waitcnt vmcnt(0)" ::: "memory");
#undef RET_ISSUE
    }
    __builtin_amdgcn_s_barrier();
}
}

__device__ __forceinline__ void moe_counts(Frame& F, int (&cnt)[NE]) {
#pragma unroll
    for (int e = 0; e < NE; ++e) cnt[e] = __builtin_amdgcn_readfirstlane((int)__hip_atomic_load((unsigned*)(F.ctl + CW_MOECNT + 64 * e), RLX_AGENT));
}
__device__ __forceinline__ void moe_gather(Frame& F) {
    int cnt[NE]; moe_counts(F, cnt);
    int base[NE]; int acc = 0;
#pragma unroll
    for (int e = 0; e < NE; ++e) { base[e] = acc; acc += (cnt[e] + 255) & ~255; }
    const int* te = (const int*)(F.ws + WS_ROUTE); int* tpos = (int*)(F.ws + WS_ROUTE + (size_t)NLAT * 8);
    const bf16* hb = (const bf16*)(F.ws + WS_H); bf16* hp = (bf16*)(F.ws + WS_HP);
    const int gw = F.vcu * NWAVES + F.wave, NGW = F.G * NWAVES;
    for (int r = gw; r < NLAT; r += NGW) {
        const int e0 = te[2 * r], e1 = te[2 * r + 1]; const int p0 = tpos[2 * r], p1 = tpos[2 * r + 1];
        int b0 = 0, b1 = 0;
#pragma unroll
        for (int e = 0; e < NE; ++e) { b0 = (e0 == e) ? base[e] : b0; b1 = (e1 == e) ? base[e] : b1; }
        const int s0 = b0 + p0, s1 = b1 + p1;
        const v4u x0 = *(const GAS v4u*)((const unsigned char*)hb + (size_t)r * D + F.lane * 16);
        *(GAS v4u*)((unsigned char*)hp + (size_t)s0 * D + F.lane * 16) = x0; *(GAS v4u*)((unsigned char*)hp + (size_t)s1 * D + F.lane * 16) = x0;
        if (F.lane == 0) { tpos[2 * r] = s0; tpos[2 * r + 1] = s1; }
    }
}
__device__ __forceinline__ void moe_order(Frame& F, pg8::MoeOrder& S, int nN) {
    int cnt[NE]; moe_counts(F, cnt);
    int ts[NE + 1]; ts[0] = 0;
#pragma unroll
    for (int e = 0; e < NE; ++e) ts[e + 1] = ts[e] + ((cnt[e] + 255) >> 8);
    S.nM = ts[NE]; S.nN = nN; S.nwg = S.nM * nN; S.G = F.G; S.c = F.cid;
    S.t1 = ts[1]; S.t2 = ts[2]; S.t3 = ts[3]; S.t4 = ts[4]; S.t5 = ts[5]; S.t6 = ts[6]; S.t7 = ts[7];
}

constexpr int N_PHASES = 22;
__global__ void __launch_bounds__(NTHREADS, 2) fwd(Args args) {
    extern __shared__ __attribute__((aligned(16))) unsigned char lds[];
    Frame F;
    F.lds = (LAS unsigned char*)lds; F.MISC = (volatile LAS unsigned*)(F.lds + MISC_OFF);
    F.tid = threadIdx.x; F.lane = F.tid & 63; F.wave = __builtin_amdgcn_readfirstlane(F.tid >> 6);
    F.G = gridDim.x; { const int bx = blockIdx.x; F.vcu = (F.G % 8 == 0) ? (bx % 8) * (F.G / 8) + bx / 8 : bx; F.cid = bx; }
    F.ws = args.ws; F.ctl = (gu32*)(args.ws + WS_CTL);
    for (int u = F.tid; u < 64; u += NTHREADS) ((LAS unsigned*)(F.lds + MISC_OFF))[u] = 0u;
    __syncthreads();
#if MK_PER_PHASE
    XcdBarrier bar; bar.bar = (unsigned*)(F.ctl + CW_BAR); bar.x = 0; bar.st = nullptr;
#define GRID_BAR() do { } while (0)
#else
    XcdBarrier bar = xcd_barrier_post((unsigned*)(F.ctl + CW_BAR), F.MISC + 8);
#define GRID_BAR() xcd_barrier(bar)
    if (F.tid == 0) { const unsigned x = xb_xcc_id(); F.MISC[16] = x; F.MISC[17] = __hip_atomic_fetch_add((unsigned*)(F.ctl + CW_XRANK + 64 * x), 1u, RLX_AGENT); }
#endif
    const int lo = args.ph_lo, hi = args.ph_hi;
#define IN(k) (lo <= (k) && (k) < hi)
#define SEAM(k) do { if (IN(k) && IN((k) + 1)) GRID_BAR(); } while (0)
    unsigned char* ws = args.ws;
    float* modv = (float*)(ws + WS_MODV);
    float* modv1 = modv + 9 * 6 * D;
    bf16* hbuf = (bf16*)(ws + WS_H);
    float* xctx = (float*)(ws + WS_XCTX);
    using pg8::Gemm; using pg8::StaticOrder;

    if (IN(0)) { for (int rep_ = 0; rep_ < ((PROBE_DUP & 1) ? 2 : 1); ++rep_) { p0_prologue(F, args); __syncthreads(); } SEAM(0); }
#if !MK_PER_PHASE
    if (IN(0) && IN(1)) {
        if (F.tid == 0) { const unsigned x = F.MISC[16]; unsigned pre = 0;
            for (unsigned j = 0; j < 16; ++j) { const unsigned c = __hip_atomic_load((unsigned*)(F.ctl + CW_XRANK + 64 * j), RLX_AGENT); pre += (j < x) ? c : 0u; }
            F.MISC[18] = pre + F.MISC[17]; }
        __syncthreads();
        F.vcu = __builtin_amdgcn_readfirstlane((int)F.MISC[18]); F.cid = (F.G % 8 == 0) ? (F.vcu % (F.G / 8)) * 8 + F.vcu / (F.G / 8) : F.vcu;
    }
#endif
    if (IN(1)) { RowPass P{MALL, args.in[I_X], args.in[I_CTX], nullptr, nullptr, nullptr, nullptr, nullptr, args.in[I_L0_NPREMIX], modv + 0 * D, modv + 1 * D, hbuf};
        row_pass<false, false, true, false>(F, args, P); SEAM(1); }
    if (IN(2)) { Gemm g{hbuf, (const bf16*)(ws + WS_W0IN), MALL, 4096, D, D}; StaticOrder S; S.init(MALL, 4096, F.G, F.cid);
        pg8::EpiQKV0 E{(bf16*)(ws + WS_QH0), (bf16*)(ws + WS_KH0), (bf16*)(ws + WS_VQ0), (const float*)(ws + WS_TAB0)};
        for (int rep_ = 0; rep_ < ((PROBE_DUP & 2) ? 2 : 1); ++rep_) { pg8::gemm_phase<pg8::EpiQKV0, StaticOrder, true, true>(F.lds, g, S, E); } if (IN(2) && IN(4)) GRID_BAR(); }
    if (IN(4)) { ret::ret_scores(F); SEAM(4); }
    if (IN(5)) { for (int rep_ = 0; rep_ < ((PROBE_DUP & 8) ? 2 : 1); ++rep_) ret::ret_scan<0>(F, args); SEAM(5); }
    if (IN(6)) { Gemm g{hbuf, (const bf16*)(ws + WS_W0IN) + (size_t)4096 * D, MALL, 4096, D, D}; StaticOrder S; S.init(MALL, 4096, F.G, F.cid);
        pg8::EpiGateMerge E{(bf16*)(ws + WS_OF), (const bf16*)(ws + WS_OB), (const float*)(ws + ret::WS_SSQ)};
        pg8::gemm_phase<pg8::EpiGateMerge, StaticOrder, true, true>(F.lds, g, S, E); if (IN(6) && IN(8)) GRID_BAR(); }
    if (IN(8)) { Gemm g{(const bf16*)(ws + WS_OF), (const bf16*)(ws + WS_W0OUT), MALL, D, 2048, 2048}; pg8::SplitOrder S; S.init(D, F.G, F.cid, USE_SPLITK ? 8 : 0, 4);
        pg8::EpiStoreSplit E{(bf16*)(ws + WS_A), D, (float*)(ws + WS_PART)};
        for (int rep_ = 0; rep_ < ((PROBE_DUP & 32) ? 2 : 1); ++rep_) { pg8::gemm_phase<pg8::EpiStoreSplit, pg8::SplitOrder, true, true>(F.lds, g, S, E); } SEAM(8); }
    if (IN(9)) { RowPass P{MALL, args.in[I_X], args.in[I_CTX], (float*)(ws + WS_X1), (float*)(ws + WS_X1C), (const bf16*)(ws + WS_A), args.in[I_L0_NPOSTMIX], modv + 2 * D, args.in[I_L0_NPREFFN], modv + 3 * D, modv + 4 * D, hbuf, (const float*)(ws + WS_PART)};
        row_pass<true, false, true, false, false, USE_SPLITK ? 8 : 0, false, true>(F, args, P); SEAM(9); }
    if (IN(10)) { Gemm g{hbuf, (const bf16*)(ws + WS_W0GU), MALL, 2 * DFF, D, D}; StaticOrder S; S.init(MALL, 2 * DFF, F.G, F.cid);
        pg8::EpiSwiglu E{(bf16*)(ws + WS_B), DFF};
        for (int rep_ = 0; rep_ < ((PROBE_DUP & 2) ? 2 : 1); ++rep_) { pg8::gemm_phase<pg8::EpiSwiglu, StaticOrder, true, true>(F.lds, g, S, E); } SEAM(10); }
    if (IN(11)) { Gemm g{(const bf16*)(ws + WS_B), (const bf16*)(ws + WS_W0DN), MALL, D, DFF, DFF}; pg8::SplitOrder S; S.init(D, F.G, F.cid, USE_SPLITK ? 11 : 0, 4);
        pg8::EpiStoreSplit E{(bf16*)(ws + WS_A), D, (float*)(ws + WS_PART)};
        for (int rep_ = 0; rep_ < ((PROBE_DUP & 32) ? 2 : 1); ++rep_) { pg8::gemm_phase<pg8::EpiStoreSplit, pg8::SplitOrder, true, true>(F.lds, g, S, E); } SEAM(11); }
    if (IN(12)) { RowPass P{MALL, (const float*)(ws + WS_X1), (const float*)(ws + WS_X1C), (float*)(ws + WS_X2), nullptr, (const bf16*)(ws + WS_A), args.in[I_L0_NPOSTFFN], modv + 5 * D, args.in[I_L1_NPREMIX], modv1 + 0 * D, modv1 + 1 * D, hbuf, (const float*)(ws + WS_PART)};
        row_pass<true, false, true, false, true, USE_SPLITK ? 11 : 0, true, true>(F, args, P); SEAM(12); }
    if (IN(13)) { Gemm g{hbuf, (const bf16*)(ws + WS_W1IN), MALL, 3072, D / 2, D / 2, MOE_SA, MOE_SB}; StaticOrder S; S.init(MALL, 3072, F.G, F.cid);
        pg8::EpiQKV1 E{(bf16*)(ws + WS_QH1), (bf16*)(ws + WS_KH1), (bf16*)(ws + WS_VH1), (const float*)(ws + WS_TAB1)};
        for (int rep_ = 0; rep_ < ((PROBE_DUP & 2) ? 2 : 1); ++rep_) { pg8::gemm_phase<pg8::EpiQKV1, StaticOrder, true, true, true>(F.lds, g, S, E); } if (IN(13) && IN(15)) GRID_BAR(); }
    if (IN(15)) { attn_phase<0>(F, args, (bf16*)(ws + WS_B)); SEAM(15); }
    if (IN(16)) { Gemm g{(const bf16*)(ws + WS_B), (const bf16*)(ws + WS_W1OUT), NLAT, D, D, D}; StaticOrder S; S.init(NLAT, D, F.G, F.cid);
        pg8::EpiStore E{(bf16*)(ws + WS_A), D};
        for (int rep_ = 0; rep_ < ((PROBE_DUP & 2) ? 2 : 1); ++rep_) { pg8::gemm_phase<pg8::EpiStore, StaticOrder, true, true>(F.lds, g, S, E); } SEAM(16); }
    if (IN(17)) { RowPass P{NLAT, (const float*)(ws + WS_X2), nullptr, (float*)(ws + WS_X3), nullptr, (const bf16*)(ws + WS_A), args.in[I_L1_NPOSTMIX], modv1 + 2 * D, args.in[I_L1_NPREFFN], modv1 + 3 * D, modv1 + 4 * D, hbuf};
        row_pass<true, false, true, true, true, 0, true, true>(F, args, P); SEAM(17); }
    if (IN(18)) { moe_gather(F); SEAM(18); }
    if (IN(19)) { Gemm g{(const bf16*)(ws + WS_HP), (const bf16*)(ws + WS_WMGU), MOE_ROWS, 2 * DFE, D / 2, D / 2, MOE_SA, MOE_SB}; pg8::MoeOrder S; moe_order(F, S, 2 * DFE / 256);
        pg8::EpiSwiglu8 E{(unsigned char*)(ws + WS_ACT1), DFE};
        for (int rep_ = 0; rep_ < ((PROBE_DUP & 16) ? 2 : 1); ++rep_) { pg8::gemm_phase<pg8::EpiSwiglu8, pg8::MoeOrder, true, true, true>(F.lds, g, S, E); } SEAM(19); }
    if (IN(20)) { Gemm g{(const bf16*)(ws + WS_ACT1), (const bf16*)(ws + WS_WMDN), MOE_ROWS, D, DFE / 2, DFE / 2, MOE_SA, MOE_SB}; pg8::MoeOrder S; moe_order(F, S, D / 256);
        pg8::EpiStore E{(bf16*)(ws + WS_Y1), D};
        for (int rep_ = 0; rep_ < ((PROBE_DUP & 16) ? 2 : 1); ++rep_) { pg8::gemm_phase<pg8::EpiStore, pg8::MoeOrder, true, true, true>(F.lds, g, S, E); } SEAM(20); }
    if (IN(21)) { RowPass P{NLAT, (const float*)(ws + WS_X3), nullptr, args.out, nullptr, (const bf16*)(ws + WS_Y1), args.in[I_L1_NPOSTFFN], modv1 + 5 * D, nullptr, nullptr, nullptr, nullptr};
        row_pass<false, true, false, false, false, 0, true, false>(F, args, P); }
#undef IN
#undef SEAM
}

#ifndef PROBE_ATT
#define PROBE_ATT -1
#endif
#if PROBE_ATT >= 0
__global__ void __launch_bounds__(NTHREADS, 2) probe_k(Args args) {
    extern __shared__ __attribute__((aligned(16))) unsigned char lds[];
    Frame F;
    F.lds = (LAS unsigned char*)lds; F.MISC = (volatile LAS unsigned*)(F.lds + MISC_OFF);
    F.tid = threadIdx.x; F.lane = F.tid & 63; F.wave = __builtin_amdgcn_readfirstlane(F.tid >> 6);
    F.G = gridDim.x; { const int bx = blockIdx.x; F.vcu = (F.G % 8 == 0) ? (bx % 8) * (F.G / 8) + bx / 8 : bx; F.cid = bx; }
    F.ws = args.ws; F.ctl = (gu32*)(args.ws + WS_CTL);
#if PROBE_ATT < 10
    attn_phase<PROBE_ATT>(F, args, (bf16*)(args.ws + WS_END - 64 * MiB));
#else
    ret::ret_scan<PROBE_ATT - 10>(F, args);
#endif
}
#endif
extern "C" void kernel_launch(void* const* d_in, const int* in_sizes, int n_in, void* d_out, int out_size, void* d_ws, size_t ws_size, hipStream_t stream) {
    static int grid = 0;
    if (grid == 0) {
        if (n_in != N_IN || out_size != NLAT * D || ws_size < WS_END) { fprintf(stderr, "kernel_launch: unexpected shapes n_in %d out %d ws %zu\n", n_in, out_size, ws_size); grid = -1; return; }
        int dev = 0, cus = 0, per_cu = 0;
        if (hipGetDevice(&dev) != hipSuccess || hipDeviceGetAttribute(&cus, hipDeviceAttributeMultiprocessorCount, dev) != hipSuccess) { grid = -1; return; }
        if (hipFuncSetAttribute((const void*)fwd, hipFuncAttributeMaxDynamicSharedMemorySize, LDS_BYTES) != hipSuccess) { fprintf(stderr, "kernel_launch: hipFuncSetAttribute failed\n"); grid = -1; return; }
        if (hipOccupancyMaxActiveBlocksPerMultiprocessor(&per_cu, (const void*)fwd, NTHREADS, LDS_BYTES) != hipSuccess || per_cu < 1) fprintf(stderr, "kernel_launch: occupancy query says %d\n", per_cu);
        (void)hipGetLastError();
        grid = cus;
    }
    if (grid < 0) return;
    (void)hipMemsetAsync((char*)d_ws + WS_CTL, 0, CTL_ZERO_BYTES, stream);
    Args a{};
    for (int i = 0; i < N_IN; ++i) a.in[i] = (const float*)d_in[i];
    a.out = (float*)d_out; a.ws = (unsigned char*)d_ws;
#if MK_PER_PHASE
    for (int p = 0; p < N_PHASES; ++p) { a.ph_lo = p; a.ph_hi = p + 1; hipLaunchKernelGGL(fwd, dim3(grid), dim3(NTHREADS), LDS_BYTES, stream, a); }
#else
    a.ph_lo = 0; a.ph_hi = N_PHASES; hipLaunchKernelGGL(fwd, dim3(grid), dim3(NTHREADS), LDS_BYTES, stream, a);
#endif
#if PROBE_ATT >= 0
    (void)hipFuncSetAttribute((const void*)probe_k, hipFuncAttributeMaxDynamicSharedMemorySize, LDS_BYTES);
    hipLaunchKernelGGL(probe_k, dim3(grid), dim3(NTHREADS), LDS_BYTES, stream, a);
#endif
}
```

```cpp
#include <hip/hip_runtime.h>
#include <cstdio>
#include <cstdint>
namespace pg8 {
#define PG8_LAS __attribute__((address_space(3)))
typedef unsigned short bf16_t;
typedef short bf16x8 __attribute__((ext_vector_type(8)));
typedef float f32x4 __attribute__((ext_vector_type(4)));
typedef unsigned u32x4 __attribute__((ext_vector_type(4)));
constexpr int BM = 256, BK = 64, HALF = 128, HTB = HALF * BK * 2  , STAGE_BYTES = 8 * HTB, NXCD = 8, WGM = 8;

__host__ __device__ __forceinline__ int lds_byte(int r, int c) { const int st = (r >> 4) * 2 + (c >> 5), rr = r & 15, cc = c & 31, ob = rr * 64 + cc * 2; return st * 1024 + (ob ^ (((ob >> 9) & 1) << 5)); }
__host__ __device__ __forceinline__ void stage_rc(int b, int& R, int& C) { const int st = b / 1024, sb = b % 1024, swz = sb ^ (((sb >> 9) & 1) << 5); R = (st >> 1) * 16 + swz / 64; C = (st & 1) * 32 + (swz % 64) / 2; }
__host__ __device__ __forceinline__ int perm32(int rho) { const int n = rho >> 4, i = rho & 15; return 8 * (i >> 2) + 4 * n + (i & 3); }

struct Unit { int pm, pn, pc, k0, nt, ks; };
struct Gemm { const bf16_t* A; const bf16_t* Bt; int M, N, K, lda; int sA, sB; };

struct StaticOrder {
    int nM, nN, nwg, G, c;
    __host__ __device__ __forceinline__ void init(int M, int N, int G_, int c_) { nM = M / BM; nN = N / BM; nwg = nM * nN; G = G_; c = c_; }
    __host__ __device__ __forceinline__ bool next(int i, Unit& u) const {
        const long L = (long)i * G + c; if (L >= nwg) return false;
        int wgid = (int)L; { const int q = nwg / NXCD, r = nwg % NXCD, xcd = wgid % NXCD, off = wgid / NXCD; wgid = (xcd < r ? xcd * (q + 1) : r * (q + 1) + (xcd - r) * q) + off; }
        const int nig = WGM * nN, gid = wgid / nig, fm = gid * WGM, gsz = (nM - fm) < WGM ? (nM - fm) : WGM;
        u.pm = fm + ((wgid % nig) % gsz); u.pn = (wgid % nig) / gsz; u.pc = u.pn; u.k0 = 0; u.nt = 0; u.ks = -1; return true;
    }
    __device__ __forceinline__ void a_ready(const Unit&) const {}
    __device__ __forceinline__ void done(const Unit&) const {}
};

__device__ __forceinline__ unsigned cvt_pk_bf16(float lo, float hi) { unsigned r; asm volatile("v_cvt_pk_bf16_f32 %0, %1, %2" : "=v"(r) : "v"(lo), "v"(hi)); return r; }
typedef float f32x2 __attribute__((ext_vector_type(2)));
typedef int v4i_t __attribute__((ext_vector_type(4))); typedef int v8i_t __attribute__((ext_vector_type(8)));
template <class Epi, class Sched, bool ALIGN_EPI = false, bool SP2 = false, bool FP8 = false>
__device__ __forceinline__ void gemm_phase(PG8_LAS unsigned char* lds, const Gemm g, const Sched& S, const Epi& E) {
    const int tid = threadIdx.x, wid = __builtin_amdgcn_readfirstlane(tid >> 6), lane = tid & 63, wr = wid >> 2, wc = wid & 3, fr = lane & 15, fq = lane >> 4;
    const int K = g.K; int nt = K / BK;
    unsigned voffA[2], voffB[2];
#pragma unroll
    for (int i = 0; i < 2; ++i) { int R, C; stage_rc(tid * 16 + i * 8192, R, C); const int Rb = Epi::PERM ? ((R & ~31) + perm32(R & 31)) : R;
        voffA[i] = (unsigned)(R * g.lda + C) * 2u; voffB[i] = (unsigned)(Rb * K + C) * 2u; }
    const size_t kstep = (size_t)(BK * 2);
    const size_t hstepA = (size_t)HALF * g.lda * 2, hstepB = (size_t)HALF * K * 2;
    const size_t tstepA = 2 * hstepA, tstepB = 2 * hstepB;
    const unsigned ldsw = (unsigned)wid * 1024u;
    const int aoff = lds_byte(wr * 64 + fr, fq * 8), boff = lds_byte(wc * 32 + fr, fq * 8);
#define PG8_SA(b, h) (((b) * 2 + (h)) * HTB)
#define PG8_SB(b, h) ((4 + (b) * 2 + (h)) * HTB)
#define PG8_STAGE(bufoff, gbase, voff) do { _Pragma("unroll") for (int _i = 0; _i < 2; ++_i) \
        __builtin_amdgcn_global_load_lds((const unsigned*)((const char*)(gbase) + (voff)[_i]), (PG8_LAS unsigned*)(lds + (bufoff) + ldsw + _i * 8192), 16, 0, 0); } while (0)
#define PG8_LDA(dst, b, h) do { if constexpr (FP8) { _Pragma("unroll") for (int m = 0; m < 4; ++m) { const v4i_t lo_ = *(const PG8_LAS v4i_t*)(lds + PG8_SA(b, h) + aoff + m * 2048), hi_ = *(const PG8_LAS v4i_t*)(lds + PG8_SA(b, h) + aoff + m * 2048 + 1024); \
        dst##8[m] = __builtin_shufflevector(lo_, hi_, 0, 1, 2, 3, 4, 5, 6, 7); } } \
    else { _Pragma("unroll") for (int m = 0; m < 4; ++m) _Pragma("unroll") for (int k = 0; k < 2; ++k) dst[m][k] = *(const PG8_LAS bf16x8*)(lds + PG8_SA(b, h) + aoff + m * 2048 + k * 1024); } } while (0)
#define PG8_LDB(dst, b, h) do { if constexpr (FP8) { _Pragma("unroll") for (int n = 0; n < 2; ++n) { const v4i_t lo_ = *(const PG8_LAS v4i_t*)(lds + PG8_SB(b, h) + boff + n * 2048), hi_ = *(const PG8_LAS v4i_t*)(lds + PG8_SB(b, h) + boff + n * 2048 + 1024); \
        dst##8[n] = __builtin_shufflevector(lo_, hi_, 0, 1, 2, 3, 4, 5, 6, 7); } } \
    else { _Pragma("unroll") for (int n = 0; n < 2; ++n) _Pragma("unroll") for (int k = 0; k < 2; ++k) dst[n][k] = *(const PG8_LAS bf16x8*)(lds + PG8_SB(b, h) + boff + n * 2048 + k * 1024); } } while (0)
#define PG8_MMA(ai, bj, At, Bt) do { __builtin_amdgcn_s_setprio(1); _Pragma("unroll") for (int m = 0; m < 4; ++m) _Pragma("unroll") for (int n = 0; n < 2; ++n) { \
        if constexpr (FP8) { asm volatile("v_mfma_scale_f32_16x16x128_f8f6f4 %0, %1, %2, %0, %3, %4 op_sel_hi:[0,0,0]" : "+v"(acc[ai][bj][m][n]) : "v"(Bt##8[n]), "v"(At##8[m]), "v"(sB_), "v"(sA_)); } \
        else { _Pragma("unroll") for (int k = 0; k < 2; ++k) acc[ai][bj][m][n] = __builtin_amdgcn_mfma_f32_16x16x32_bf16(Bt[n][k], At[m][k], acc[ai][bj][m][n], 0, 0, 0); } } \
        __builtin_amdgcn_s_setprio(0); } while (0)
#define PG8_WAIT_V(n) asm volatile("s_waitcnt vmcnt(" #n ")" ::: "memory")
#define PG8_WAIT_L(n) asm volatile("s_waitcnt lgkmcnt(" #n ")" ::: "memory")
#define PG8_BAR __builtin_amdgcn_s_barrier()
#define PG8_SCHED __builtin_amdgcn_sched_barrier(0)
    Unit cur, nxt; int ui = 0;
    if (!S.next(0, cur)) return;
    const int sA_ = g.sA, sB_ = g.sB;
    f32x4 acc[2][2][4][2];
#pragma unroll
    for (int a = 0; a < 2; ++a)
#pragma unroll
        for (int b = 0; b < 2; ++b)
#pragma unroll
            for (int m = 0; m < 4; ++m)
#pragma unroll
                for (int n = 0; n < 2; ++n) acc[a][b][m][n] = (f32x4){0.f, 0.f, 0.f, 0.f};
    bf16x8 At[4][2], B0[2][2], B1[2][2]; v8i_t At8[4], B08[2], B18[2];
    if (cur.nt) nt = cur.nt;
    const char* cA = (const char*)g.A + (size_t)cur.pm * tstepA + (size_t)cur.k0 * 2; const char* cB = (const char*)g.Bt + (size_t)cur.pn * tstepB + (size_t)cur.k0 * 2;
    S.a_ready(cur);
    if constexpr (SP2) {
        PG8_STAGE(PG8_SB(0, 0), cB, voffB); PG8_STAGE(PG8_SB(0, 1), cB + hstepB, voffB); PG8_STAGE(PG8_SA(0, 0), cA, voffA); PG8_STAGE(PG8_SA(0, 1), cA + hstepA, voffA);
        if (wr == 1) PG8_BAR;
        PG8_WAIT_V(2); PG8_BAR;
        PG8_STAGE(PG8_SB(1, 0), cB + kstep, voffB); PG8_STAGE(PG8_SA(1, 0), cA + kstep, voffA); PG8_STAGE(PG8_SB(1, 1), cB + hstepB + kstep, voffB);
        PG8_WAIT_V(6); PG8_BAR;
    } else {
        PG8_STAGE(PG8_SB(0, 0), cB, voffB); PG8_STAGE(PG8_SA(0, 0), cA, voffA); PG8_STAGE(PG8_SB(0, 1), cB + hstepB, voffB); PG8_STAGE(PG8_SA(0, 1), cA + hstepA, voffA);
        if (wr == 1) PG8_BAR;
        PG8_WAIT_V(4); PG8_BAR;
        PG8_STAGE(PG8_SB(1, 0), cB + kstep, voffB); PG8_STAGE(PG8_SA(1, 0), cA + kstep, voffA); PG8_STAGE(PG8_SB(1, 1), cB + hstepB + kstep, voffB);
        PG8_WAIT_V(6); PG8_BAR;
    }
    for (;;) {
        const bool has_next = S.next(ui + 1, nxt);
        const char* nA = has_next ? (const char*)g.A + (size_t)nxt.pm * tstepA + (size_t)nxt.k0 * 2 : cA; const char* nB = has_next ? (const char*)g.Bt + (size_t)nxt.pn * tstepB + (size_t)nxt.k0 * 2 : cB;
#pragma unroll 1
        for (int t = 0; t < nt; t += 2) {
            const bool last = (t == nt - 2);
            const char* a1 = cA + (size_t)(t + 1) * kstep;
            const char* a2 = last ? nA : cA + (size_t)(t + 2) * kstep; const char* b2 = last ? nB : cB + (size_t)(t + 2) * kstep;
            const char* a3 = a2 + kstep; const char* b3 = b2 + kstep;
            if (last && has_next) S.a_ready(nxt);
            if constexpr (SP2) {
            PG8_LDB(B0, 0, 0); PG8_LDB(B1, 0, 1); PG8_SCHED; PG8_LDA(At, 0, 0); PG8_STAGE(PG8_SA(1, 1), a1 + hstepA, voffA);
            PG8_WAIT_V(8); PG8_WAIT_L(0); PG8_BAR; PG8_MMA(0, 0, At, B0); PG8_MMA(0, 1, At, B1); PG8_BAR; PG8_SCHED;
            PG8_LDA(At, 0, 1); PG8_STAGE(PG8_SB(0, 0), b2, voffB); PG8_STAGE(PG8_SB(0, 1), b2 + hstepB, voffB); PG8_STAGE(PG8_SA(0, 0), a2, voffA);
            PG8_WAIT_V(8); PG8_WAIT_L(0); PG8_BAR; PG8_MMA(1, 0, At, B0); PG8_MMA(1, 1, At, B1); PG8_BAR; PG8_SCHED;
            PG8_LDB(B0, 1, 0); PG8_LDB(B1, 1, 1); PG8_SCHED; PG8_LDA(At, 1, 0); PG8_STAGE(PG8_SA(0, 1), a2 + hstepA, voffA);
            PG8_WAIT_V(8); PG8_WAIT_L(0); PG8_BAR; PG8_MMA(0, 0, At, B0); PG8_MMA(0, 1, At, B1); PG8_BAR; PG8_SCHED;
            PG8_LDA(At, 1, 1); PG8_STAGE(PG8_SB(1, 0), b3, voffB); PG8_STAGE(PG8_SB(1, 1), b3 + hstepB, voffB); PG8_STAGE(PG8_SA(1, 0), a3, voffA);
            PG8_WAIT_V(8); PG8_WAIT_L(0); PG8_BAR; PG8_MMA(1, 0, At, B0); PG8_MMA(1, 1, At, B1); PG8_BAR; PG8_SCHED;
            } else {
            PG8_LDB(B0, 0, 0); PG8_SCHED; PG8_LDA(At, 0, 0); PG8_STAGE(PG8_SA(1, 1), a1 + hstepA, voffA);
            PG8_WAIT_L(8); PG8_BAR; PG8_WAIT_L(0); PG8_MMA(0, 0, At, B0); PG8_BAR; PG8_SCHED;
            PG8_LDB(B1, 0, 1); PG8_STAGE(PG8_SB(0, 0), b2, voffB);
            PG8_BAR; PG8_WAIT_L(0); PG8_MMA(0, 1, At, B1); PG8_BAR;
            PG8_LDA(At, 0, 1); PG8_STAGE(PG8_SA(0, 0), a2, voffA);
            PG8_BAR; PG8_WAIT_L(0); PG8_MMA(1, 0, At, B0); PG8_BAR; PG8_SCHED;
            PG8_STAGE(PG8_SB(0, 1), b2 + hstepB, voffB);
            PG8_WAIT_V(6); PG8_BAR; PG8_MMA(1, 1, At, B1); PG8_BAR;
            PG8_LDB(B0, 1, 0); PG8_SCHED; PG8_LDA(At, 1, 0); PG8_STAGE(PG8_SA(0, 1), a2 + hstepA, voffA);
            PG8_WAIT_L(8); PG8_BAR; PG8_WAIT_L(0); PG8_MMA(0, 0, At, B0); PG8_BAR; PG8_SCHED;
            PG8_LDB(B1, 1, 1); PG8_STAGE(PG8_SB(1, 0), b3, voffB);
            PG8_BAR; PG8_WAIT_L(0); PG8_MMA(0, 1, At, B1); PG8_BAR;
            PG8_LDA(At, 1, 1); PG8_STAGE(PG8_SA(1, 0), a3, voffA);
            PG8_BAR; PG8_WAIT_L(0); PG8_MMA(1, 0, At, B0); PG8_BAR; PG8_SCHED;
            PG8_STAGE(PG8_SB(1, 1), b3 + hstepB, voffB);
            PG8_WAIT_V(6); PG8_BAR; PG8_MMA(1, 1, At, B1); PG8_BAR;
            }
        }
        if constexpr (FP8) asm volatile("s_nop 15\n\ts_nop 15" ::: "memory");
        if constexpr (ALIGN_EPI) { if (wr == 0) PG8_BAR; }
        if constexpr (!Epi::AFTER_DRAIN) { E(acc, cur, wr, wc, fr, fq); S.done(cur); }
        if (!has_next) break;
#pragma unroll
        for (int a = 0; a < 2; ++a)
#pragma unroll
            for (int b = 0; b < 2; ++b)
#pragma unroll
                for (int m = 0; m < 4; ++m)
#pragma unroll
                    for (int n = 0; n < 2; ++n) acc[a][b][m][n] = (f32x4){0.f, 0.f, 0.f, 0.f};
        cur = nxt; cA = nA; cB = nB; ++ui; nt = cur.nt ? cur.nt : K / BK;
        if constexpr (ALIGN_EPI) { if (wr == 1) PG8_BAR; }
    }
    PG8_WAIT_V(0);
    if constexpr (!ALIGN_EPI) { if (wr == 0) PG8_BAR; }
    PG8_BAR;
    if constexpr (Epi::AFTER_DRAIN) { E.fused(acc, cur, wr, wc, fr, fq, lds, wid, lane); S.done(cur); }
#undef PG8_SA
#undef PG8_SB
#undef PG8_STAGE
#undef PG8_LDA
#undef PG8_LDB
#undef PG8_MMA
#undef PG8_WAIT_V
#undef PG8_WAIT_L
#undef PG8_BAR
#undef PG8_SCHED
}
}

#ifndef PROBE_DUP
#define PROBE_DUP 0
#endif
#ifndef USE_SPLITK
#define USE_SPLITK 0
#endif
#ifndef MK_PER_PHASE
#define MK_PER_PHASE 0
#endif
constexpr int D = 1024, NBATCH = 8, SEQ = 4096, NLAT = NBATCH * SEQ, CTXL = 256, NCTX = NBATCH * CTXL, MALL = NLAT + NCTX;
constexpr int RH = 4, RQK = 256, RV = 512;
constexpr int DFF = 2816, NE = 8, DFE = 3584;
constexpr float EPS = 1e-6f;
constexpr float LAMBDA_INIT = 0.3555090675909693f;
constexpr float LOG2E = 1.4426950408889634f;
constexpr int NWAVES = 8, NTHREADS = 512;
constexpr float MOE_WSCALE = 64.0f; constexpr int MOE_SB = 0x79797979, MOE_SA = 0x7f7f7f7f;
constexpr int MOE_ROWS = 2 * NLAT + NE * 256;

enum { I_X = 0, I_C, I_CTX, I_CCTX, I_L0_WMOD, I_L0_BMOD, I_L0_NPREMIX, I_L0_NPOSTMIX, I_L0_NPREFFN, I_L0_NPOSTFFN, I_L0_WIN, I_L0_DECAY, I_L0_WOUT, I_L0_WGU, I_L0_WDN,
       I_L1_WMOD, I_L1_BMOD, I_L1_NPREMIX, I_L1_NPOSTMIX, I_L1_NPREFFN, I_L1_NPOSTFFN, I_L1_WIN, I_L1_LAMBDA, I_L1_SUBLN, I_L1_WOUT, I_L1_RW, I_L1_RB, I_L1_MGU, I_L1_MDN, N_IN };

constexpr size_t MiB = 1u << 20;
constexpr size_t WS_CTL = 0, CTL_ZERO_BYTES = 1 * MiB;
constexpr size_t WS_MODV = 1 * MiB;
constexpr size_t WS_TAB0 = 1 * MiB + 512 * 1024;
constexpr size_t WS_TAB1 = WS_TAB0 + 32 * 1024;
constexpr size_t WS_LAM = WS_TAB1 + 8 * 1024;
constexpr size_t WS_ROUTE = 2 * MiB;
constexpr size_t WS_XCTX = 3 * MiB;
constexpr size_t WS_W0IN = 11 * MiB, WS_W0OUT = 27 * MiB, WS_W0GU = 31 * MiB, WS_W0DN = 42 * MiB, WS_W1IN = 48 * MiB, WS_W1OUT = 54 * MiB, WS_WMGU = 56 * MiB, WS_WMDN = 168 * MiB;
constexpr size_t WS_H = 224 * MiB;
constexpr size_t WS_A = 292 * MiB, WS_B = 564 * MiB;
constexpr size_t WS_OF = WS_B, WS_OB = WS_B + 136 * MiB;
constexpr size_t WS_QH0 = WS_A, WS_KH0 = WS_A + 68 * MiB, WS_VQ0 = WS_A + 136 * MiB;
constexpr size_t WS_QH1 = WS_A, WS_KH1 = WS_A + 68 * MiB, WS_VH1 = WS_A + 136 * MiB;
constexpr size_t WS_HP = WS_A, WS_ACT1 = 424 * MiB, WS_Y1 = WS_A;
constexpr size_t WS_V8 = 640 * MiB;
constexpr size_t WS_X1 = 360 * MiB, WS_X1C = 424 * MiB;
constexpr size_t WS_X2 = 496 * MiB;
constexpr size_t WS_X3 = 700 * MiB;
constexpr size_t WS_PART = WS_A + 136 * MiB;
constexpr size_t WS_END = 886 * MiB;
static_assert(WS_ACT1 + (size_t)MOE_ROWS * DFE * 2 <= WS_END, "ws map");
static_assert(WS_HP + (size_t)MOE_ROWS * D * 2 <= WS_ACT1, "ws map");
constexpr int CW_TMO = 0;
constexpr int CW_BAR = 4096;
constexpr int CW_XRANK = 12288;
constexpr int CW_MOECNT = 16384;

constexpr int RING_BYTES = 131072;
constexpr int LDS_BYTES = 163840;
constexpr int MISC_OFF = LDS_BYTES - 256;

#define GAS __attribute__((address_space(1)))
#define LAS __attribute__((address_space(3)))
typedef unsigned short bf16;
typedef unsigned v4u __attribute__((ext_vector_type(4)));
typedef unsigned v2u __attribute__((ext_vector_type(2)));
typedef float f32x4 __attribute__((ext_vector_type(4)));
typedef float f32x2 __attribute__((ext_vector_type(2)));
typedef short bf16x8 __attribute__((ext_vector_type(8)));
typedef GAS unsigned gu32;
#define RLX_AGENT __ATOMIC_RELAXED, __HIP_MEMORY_SCOPE_AGENT
#define LDS_WAIT() asm volatile("s_waitcnt lgkmcnt(0)" ::: "memory")
#define VM_WAIT() asm volatile("s_waitcnt vmcnt(0)" ::: "memory")
__device__ __forceinline__ unsigned pk2(float lo, float hi);
__device__ __forceinline__ unsigned f2bf(float f) { return pk2(f, 0.f) & 0xffffu; }
typedef float f32x2_cv __attribute__((ext_vector_type(2))); typedef __bf16 bf16x2_cv __attribute__((ext_vector_type(2)));
__device__ __forceinline__ unsigned pk2(float lo, float hi) { f32x2_cv v = {lo, hi}; bf16x2_cv b = __builtin_convertvector(v, bf16x2_cv); return __builtin_bit_cast(unsigned, b); }
__device__ __forceinline__ float bf2f(unsigned b) { return __builtin_bit_cast(float, b << 16); }
__device__ __forceinline__ float bflo(unsigned w) { return __builtin_bit_cast(float, w << 16); }
__device__ __forceinline__ float bfhi(unsigned w) { return __builtin_bit_cast(float, w & 0xffff0000u); }
__device__ __forceinline__ unsigned pk4_fp8(float a, float b, float c, float d) {
    a = __builtin_amdgcn_fmed3f(a, -448.f, 448.f); b = __builtin_amdgcn_fmed3f(b, -448.f, 448.f); c = __builtin_amdgcn_fmed3f(c, -448.f, 448.f); d = __builtin_amdgcn_fmed3f(d, -448.f, 448.f);
    int w = 0; w = __builtin_amdgcn_cvt_pk_fp8_f32(a, b, w, false); w = __builtin_amdgcn_cvt_pk_fp8_f32(c, d, w, true); return (unsigned)w; }
__device__ __forceinline__ float fast_exp2(float x) { return __builtin_amdgcn_exp2f(x); }
__device__ __forceinline__ float silu_f(float g) { return g * __builtin_amdgcn_rcpf(1.0f + __builtin_amdgcn_exp2f(-g * LOG2E)); }
__device__ __forceinline__ float wave_sum(float v) {
#pragma unroll
    for (int o = 1; o < 64; o <<= 1) v += __shfl_xor(v, o);
    return v;
}

#define XB_TMO      128
#define XB_XCNT(j)  (256  + 64 * (j))
#define XB_XSUB(j)  (1280 + 64 * (j))
#define XB_XGEN(j)  (2304 + 64 * (j))
#define XB_TOP      3328
#define XB_TOPGEN   3392
#define XCD_BAR_WORDS 3456
#define XB_SPIN_CAP (1u << 24)

__device__ __forceinline__ unsigned xb_ld(unsigned* p)              { return __hip_atomic_load(p, __ATOMIC_RELAXED, __HIP_MEMORY_SCOPE_AGENT); }
__device__ __forceinline__ unsigned xb_add(unsigned* p, unsigned v) { return __hip_atomic_fetch_add(p, v, __ATOMIC_RELAXED, __HIP_MEMORY_SCOPE_AGENT); }
__device__ __forceinline__ unsigned xb_xcc_id() { return (unsigned)__builtin_amdgcn_s_getreg((3 << 11) | 20) & 0xFu; }
#define XB_SPIN(cond, bar) do { unsigned _sp = 0; while (cond) { __builtin_amdgcn_s_sleep(1); \
    if ((++_sp & 255u) == 0u) { if (xb_ld(&(bar)[XB_TMO])) break; if (_sp > XB_SPIN_CAP) { atomicAdd(&(bar)[XB_TMO], 1u); break; } } } } while (0)

struct XcdBarrier {
    unsigned* bar; unsigned x;
    volatile LAS unsigned* st;
};

__device__ __forceinline__ XcdBarrier xcd_barrier_post(unsigned* bar, volatile LAS unsigned* st) {
    XcdBarrier b; b.bar = bar; b.x = xb_xcc_id(); b.st = st;
    if (threadIdx.x == 0) (void)xb_add(&bar[XB_XCNT(b.x)], 1u);
    return b;
}
__device__ __forceinline__ void xcd_barrier_complete(unsigned* bar, unsigned x, unsigned& nloc, unsigned& nx) {
    const unsigned G = gridDim.x * gridDim.y * gridDim.z;
    unsigned sum, cnt, mine, sp = 0u;
    for (;;) {
        sum = 0u; cnt = 0u; mine = 0u;
#pragma unroll
        for (unsigned j = 0; j < 16; ++j) { const unsigned c = xb_ld(&bar[XB_XCNT(j)]); sum += c; cnt += (c > 0u) ? 1u : 0u; mine = (j == x) ? c : mine; }
        if (sum == G) break;
        __builtin_amdgcn_s_sleep(1);
        if ((++sp & 255u) == 0u) { if (xb_ld(&bar[XB_TMO])) break; if (sp > XB_SPIN_CAP) { atomicAdd(&bar[XB_TMO], 1u); break; } }
    }
    nloc = mine > 0u ? mine : 1u; nx = cnt > 0u ? cnt : 1u;
}

__device__ __forceinline__ void xcd_barrier(const XcdBarrier& b) {
    asm volatile("s_waitcnt vmcnt(0)" ::: "memory");
    __syncthreads();
    if (threadIdx.x == 0) {
        unsigned* bar = b.bar;
        __builtin_amdgcn_s_waitcnt(0);
        unsigned nloc = b.st[0], nx = b.st[1];
        if (nloc == 0u) { xcd_barrier_complete(bar, b.x, nloc, nx); b.st[0] = nloc; b.st[1] = nx; }
        const unsigned old = xb_add(&bar[XB_XSUB(b.x)], 1u);
        const unsigned gen = old / nloc;
        if (old + 1u == (gen + 1u) * nloc) {
            __builtin_amdgcn_fence(__ATOMIC_RELEASE, "agent");
            asm volatile("s_waitcnt vmcnt(0)" ::: "memory");
            const unsigned og = xb_add(&bar[XB_TOP], 1u);
            const unsigned tg = og / nx;
            if (og + 1u == (tg + 1u) * nx) xb_add(&bar[XB_TOPGEN], 1u);
            else XB_SPIN(xb_ld(&bar[XB_TOPGEN]) == tg, bar);
            __builtin_amdgcn_fence(__ATOMIC_ACQUIRE, "agent");
            xb_add(&bar[XB_XGEN(b.x)], 1u);
            asm volatile("s_waitcnt vmcnt(0)" ::: "memory");
        } else {
            XB_SPIN(xb_ld(&bar[XB_XGEN(b.x)]) == gen, bar);
            __builtin_amdgcn_fence(__ATOMIC_ACQUIRE, "agent");
            asm volatile("s_waitcnt vmcnt(0)" ::: "memory");
        }
    }
    __syncthreads();
}


struct Args { const float* in[N_IN]; float* out; unsigned char* ws; int ph_lo, ph_hi; };

struct Frame {
    LAS unsigned char* lds;
    volatile LAS unsigned* MISC;
    gu32* ctl;
    int tid, lane, wave, vcu, G, cid;
    unsigned char* ws;
};

namespace pg8 {
struct EpiStore {
    static constexpr bool PERM = true, AFTER_DRAIN = false;
    bf16_t* O; int ldc;
    __device__ __forceinline__ void operator()(const f32x4 (&acc)[2][2][4][2], const Unit& u, int wr, int wc, int fr, int fq) const {
        const int row0 = u.pm * BM + wr * 64 + fr; const int col0 = u.pc * BM + wc * 32 + 8 * fq;
#pragma unroll
        for (int ai = 0; ai < 2; ++ai)
#pragma unroll
            for (int m = 0; m < 4; ++m) { bf16_t* rowp = O + (size_t)(row0 + ai * HALF + m * 16) * ldc + col0;
#pragma unroll
                for (int bj = 0; bj < 2; ++bj) { const f32x4 v0 = acc[ai][bj][m][0], v1 = acc[ai][bj][m][1];
                    u32x4 w; w.x = cvt_pk_bf16(v0[0], v0[1]); w.y = cvt_pk_bf16(v0[2], v0[3]); w.z = cvt_pk_bf16(v1[0], v1[1]); w.w = cvt_pk_bf16(v1[2], v1[3]);
                    *(u32x4*)(rowp + bj * HALF) = w; } }
    }
};
struct EpiSwiglu {
    static constexpr bool PERM = true, AFTER_DRAIN = false;
    bf16_t* O; int ldc;
    __device__ __forceinline__ void operator()(const f32x4 (&acc)[2][2][4][2], const Unit& u, int wr, int wc, int fr, int fq) const {
        const int row0 = u.pm * BM + wr * 64 + fr; const int col0 = u.pc * HALF + wc * 32 + 8 * fq;
#pragma unroll
        for (int ai = 0; ai < 2; ++ai)
#pragma unroll
            for (int m = 0; m < 4; ++m) { bf16_t* rowp = O + (size_t)(row0 + ai * HALF + m * 16) * ldc + col0;
                f32x4 a0, a1;
#pragma unroll
                for (int e = 0; e < 4; ++e) { a0[e] = silu_f(acc[ai][0][m][0][e]) * acc[ai][1][m][0][e]; a1[e] = silu_f(acc[ai][0][m][1][e]) * acc[ai][1][m][1][e]; }
                u32x4 w; w.x = cvt_pk_bf16(a0[0], a0[1]); w.y = cvt_pk_bf16(a0[2], a0[3]); w.z = cvt_pk_bf16(a1[0], a1[1]); w.w = cvt_pk_bf16(a1[2], a1[3]);
                *(u32x4*)rowp = w; }
    }
};

struct EpiQKV0 {
    static constexpr bool PERM = true, AFTER_DRAIN = false;
    bf16_t* Qh; bf16_t* Kh; bf16_t* Vq; const float* tab;
    __device__ __forceinline__ void operator()(const f32x4 (&acc)[2][2][4][2], const Unit& u, int wr, int wc, int fr, int fq) const {
        const int row0 = u.pm * BM + wr * 64 + fr, pc = u.pc;
        if (pc < 8) {
            bf16_t* base = pc < 4 ? Qh + (size_t)pc * MALL * 256 : Kh + (size_t)(pc - 4) * MALL * 256; const float sc = pc < 4 ? 1.0f : 0.0625f; const bool lat = u.pm < NLAT / BM;
            const int col0 = wc * 32 + 8 * fq;
#pragma unroll
            for (int ai = 0; ai < 2; ++ai)
#pragma unroll
                for (int m = 0; m < 4; ++m) { const int row = row0 + ai * HALF + m * 16, t = row & (SEQ - 1);
#pragma unroll
                    for (int bj = 0; bj < 2; ++bj) { f32x4 v0 = acc[ai][bj][m][0], v1 = acc[ai][bj][m][1];
                        if (lat) { const int pos = bj ? (t & 63) : (t >> 6); const float* tp = tab + (size_t)(pos * 64 + 16 * wc + 4 * fq) * 2;
                            const f32x4 c0 = *(const f32x4*)tp, c1 = *(const f32x4*)(tp + 4);
                            v0 = (f32x4){v0[0] * c0[0] - v0[1] * c0[1], v0[1] * c0[0] + v0[0] * c0[1], v0[2] * c0[2] - v0[3] * c0[3], v0[3] * c0[2] + v0[2] * c0[3]};
                            v1 = (f32x4){v1[0] * c1[0] - v1[1] * c1[1], v1[1] * c1[0] + v1[0] * c1[1], v1[2] * c1[2] - v1[3] * c1[3], v1[3] * c1[2] + v1[2] * c1[3]}; }
                        v0 = v0 * sc; v1 = v1 * sc;
                        u32x4 w; w.x = cvt_pk_bf16(v0[0], v0[1]); w.y = cvt_pk_bf16(v0[2], v0[3]); w.z = cvt_pk_bf16(v1[0], v1[1]); w.w = cvt_pk_bf16(v1[2], v1[3]);
                        *(u32x4*)(base + (size_t)row * 256 + col0 + bj * HALF) = w; } }
        } else {
#pragma unroll
            for (int ai = 0; ai < 2; ++ai)
#pragma unroll
                for (int m = 0; m < 4; ++m) { const int row = row0 + ai * HALF + m * 16;
#pragma unroll
                    for (int bj = 0; bj < 2; ++bj) { const f32x4 v0 = acc[ai][bj][m][0], v1 = acc[ai][bj][m][1];
                        u32x4 w; w.x = cvt_pk_bf16(v0[0], v0[1]); w.y = cvt_pk_bf16(v0[2], v0[3]); w.z = cvt_pk_bf16(v1[0], v1[1]); w.w = cvt_pk_bf16(v1[2], v1[3]);
                        *(u32x4*)(Vq + ((size_t)((pc - 8) * 2 + bj) * MALL + row) * 128 + wc * 32 + 8 * fq) = w; } }
        }
    }
};
struct EpiQKV1 {
    static constexpr bool PERM = true, AFTER_DRAIN = false;
    bf16_t* Qh; bf16_t* Kh; bf16_t* Vh; const float* tab;
    __device__ __forceinline__ void operator()(const f32x4 (&acc)[2][2][4][2], const Unit& u, int wr, int wc, int fr, int fq) const {
        const int row0 = u.pm * BM + wr * 64 + fr, pc = u.pc;
        if (pc < 8) {
            bf16_t* base = pc < 4 ? Qh : Kh; const float sc = pc < 4 ? 0.125f * LOG2E : 1.0f; const bool lat = u.pm < NLAT / BM;
            const int hf = wc & 1, p0 = 32 * hf + 8 * fq;
#pragma unroll
            for (int ai = 0; ai < 2; ++ai)
#pragma unroll
                for (int m = 0; m < 4; ++m) { const int row = row0 + ai * HALF + m * 16, t = row & (SEQ - 1);
                    const int pos = hf ? (t & 63) : (t >> 6); const float* tp = tab + (size_t)(pos * 16 + 4 * fq) * 2;
                    f32x4 c0 = (f32x4){1.f, 0.f, 1.f, 0.f}, c1 = c0;
                    if (lat) { c0 = *(const f32x4*)tp; c1 = *(const f32x4*)(tp + 4); }
#pragma unroll
                    for (int bj = 0; bj < 2; ++bj) { f32x4 v0 = acc[ai][bj][m][0], v1 = acc[ai][bj][m][1];
                        v0 = (f32x4){v0[0] * c0[0] - v0[1] * c0[1], v0[1] * c0[0] + v0[0] * c0[1], v0[2] * c0[2] - v0[3] * c0[3], v0[3] * c0[2] + v0[2] * c0[3]};
                        v1 = (f32x4){v1[0] * c1[0] - v1[1] * c1[1], v1[1] * c1[0] + v1[0] * c1[1], v1[2] * c1[2] - v1[3] * c1[3], v1[3] * c1[2] + v1[2] * c1[3]};
                        v0 = v0 * sc; v1 = v1 * sc;
                        const int head = (pc & 3) * 4 + 2 * bj + (wc >> 1);
                        u32x4 w; w.x = cvt_pk_bf16(v0[0], v0[1]); w.y = cvt_pk_bf16(v0[2], v0[3]); w.z = cvt_pk_bf16(v1[0], v1[1]); w.w = cvt_pk_bf16(v1[2], v1[3]);
                        *(u32x4*)(base + ((size_t)head * MALL + row) * 64 + p0) = w; } }
        } else {
#pragma unroll
            for (int ai = 0; ai < 2; ++ai)
#pragma unroll
                for (int m = 0; m < 4; ++m) { const int row = row0 + ai * HALF + m * 16;
#pragma unroll
                    for (int bj = 0; bj < 2; ++bj) { const f32x4 v0 = acc[ai][bj][m][0], v1 = acc[ai][bj][m][1];
                        u32x4 w; w.x = cvt_pk_bf16(v0[0], v0[1]); w.y = cvt_pk_bf16(v0[2], v0[3]); w.z = cvt_pk_bf16(v1[0], v1[1]); w.w = cvt_pk_bf16(v1[2], v1[3]);
                        *(u32x4*)(Vh + ((size_t)((pc - 8) * 2 + bj) * MALL + row) * 128 + wc * 32 + 8 * fq) = w; } }
        }
    }
};

struct EpiGateMerge {
    static constexpr bool PERM = true, AFTER_DRAIN = false;
    bf16_t* Of; const bf16_t* Ob; const float* ssq;
    __device__ __forceinline__ void operator()(const f32x4 (&acc)[2][2][4][2], const Unit& u, int wr, int wc, int fr, int fq) const {
        const int row0 = u.pm * BM + wr * 64 + fr; const int col0 = u.pc * HALF + wc * 32 + 8 * fq; const int head = u.pc >> 2;
#pragma unroll
        for (int ai = 0; ai < 2; ++ai)
#pragma unroll
            for (int m = 0; m < 4; ++m) { const size_t row = (size_t)(row0 + ai * HALF + m * 16);
                const f32x4 sf = *(const f32x4*)(ssq + (row * RH + head) * 8), sb = *(const f32x4*)(ssq + (row * RH + head) * 8 + 4);
                const float rf = __builtin_amdgcn_rsqf(((sf[0] + sf[1]) + (sf[2] + sf[3])) * (1.0f / RV) + EPS), rb = __builtin_amdgcn_rsqf(((sb[0] + sb[1]) + (sb[2] + sb[3])) * (1.0f / RV) + EPS);
                const u32x4 of = *(const u32x4*)(Of + row * 2048 + col0), ob = *(const u32x4*)(Ob + row * 2048 + col0);
                float y[8];
#pragma unroll
                for (int e = 0; e < 4; ++e) {
                    const float gf0 = acc[ai][0][m][e >> 1][2 * (e & 1)], gf1 = acc[ai][0][m][e >> 1][2 * (e & 1) + 1], gb0 = acc[ai][1][m][e >> 1][2 * (e & 1)], gb1 = acc[ai][1][m][e >> 1][2 * (e & 1) + 1];
                    y[2 * e] = silu_f(gf0) * (bflo(of[e]) * rf) + silu_f(gb0) * (bflo(ob[e]) * rb);
                    y[2 * e + 1] = silu_f(gf1) * (bfhi(of[e]) * rf) + silu_f(gb1) * (bfhi(ob[e]) * rb); }
                u32x4 w; w.x = cvt_pk_bf16(y[0], y[1]); w.y = cvt_pk_bf16(y[2], y[3]); w.z = cvt_pk_bf16(y[4], y[5]); w.w = cvt_pk_bf16(y[6], y[7]);
                *(u32x4*)(Of + row * 2048 + col0) = w; }
    }
};

struct SplitOrder {
    StaticOrder lat; int G, c, KS, ntS, nN, nl;
    __device__ __forceinline__ void init(int N, int G_, int c_, int KS_, int ntS_) { lat.init(KS_ ? NLAT : MALL, N, G_, c_); G = G_; c = c_; KS = KS_; ntS = ntS_; nN = N / BM; nl = (lat.nwg > c_) ? (lat.nwg - 1 - c_) / G_ + 1 : 0; }
    __device__ __forceinline__ bool next(int i, Unit& u) const {
        if (i < nl) return lat.next(i, u);
        const long j = (long)(i - nl) * G + c; if (j >= (long)(NCTX / BM) * nN * KS) return false;
        const int tile = (int)(j / KS), ks = (int)(j % KS);
        u.pm = NLAT / BM + tile / nN; u.pn = tile % nN; u.pc = u.pn; u.k0 = ks * ntS * BK; u.nt = ntS; u.ks = ks; return true;
    }
    __device__ __forceinline__ void a_ready(const Unit&) const {}
    __device__ __forceinline__ void done(const Unit&) const {}
};
struct EpiStoreSplit {
    static constexpr bool PERM = true, AFTER_DRAIN = false;
    bf16_t* O; int ldc; float* P;
    __device__ __forceinline__ void operator()(const f32x4 (&acc)[2][2][4][2], const Unit& u, int wr, int wc, int fr, int fq) const {
        const int row0 = u.pm * BM + wr * 64 + fr; const int col0 = u.pc * BM + wc * 32 + 8 * fq;
        if (u.ks < 0) {
#pragma unroll
            for (int ai = 0; ai < 2; ++ai)
#pragma unroll
                for (int m = 0; m < 4; ++m) { bf16_t* rowp = O + (size_t)(row0 + ai * HALF + m * 16) * ldc + col0;
#pragma unroll
                    for (int bj = 0; bj < 2; ++bj) { const f32x4 v0 = acc[ai][bj][m][0], v1 = acc[ai][bj][m][1];
                        u32x4 w; w.x = cvt_pk_bf16(v0[0], v0[1]); w.y = cvt_pk_bf16(v0[2], v0[3]); w.z = cvt_pk_bf16(v1[0], v1[1]); w.w = cvt_pk_bf16(v1[2], v1[3]);
                        *(u32x4*)(rowp + bj * HALF) = w; } }
        } else {
            float* pb = P + (size_t)u.ks * NCTX * ldc;
#pragma unroll
            for (int ai = 0; ai < 2; ++ai)
#pragma unroll
                for (int m = 0; m < 4; ++m) { float* rowp = pb + (size_t)(row0 - NLAT + ai * HALF + m * 16) * ldc + col0;
#pragma unroll
                    for (int bj = 0; bj < 2; ++bj) { *(f32x4*)(rowp + bj * HALF) = acc[ai][bj][m][0]; *(f32x4*)(rowp + bj * HALF + 4) = acc[ai][bj][m][1]; } }
        }
    }
};
struct EpiSwiglu8 {
    static constexpr bool PERM = true, AFTER_DRAIN = false;
    unsigned char* O; int ldc;
    __device__ __forceinline__ void operator()(const f32x4 (&acc)[2][2][4][2], const Unit& u, int wr, int wc, int fr, int fq) const {
        const int row0 = u.pm * BM + wr * 64 + fr; const int col0 = u.pc * HALF + wc * 32 + 8 * fq;
#pragma unroll
        for (int ai = 0; ai < 2; ++ai)
#pragma unroll
            for (int m = 0; m < 4; ++m) { unsigned char* rowp = O + (size_t)(row0 + ai * HALF + m * 16) * ldc + col0;
                f32x4 a0, a1;
#pragma unroll
                for (int e = 0; e < 4; ++e) { a0[e] = silu_f(acc[ai][0][m][0][e]) * acc[ai][1][m][0][e]; a1[e] = silu_f(acc[ai][0][m][1][e]) * acc[ai][1][m][1][e]; }
                v2u w; w.x = pk4_fp8(a0[0], a0[1], a0[2], a0[3]); w.y = pk4_fp8(a1[0], a1[1], a1[2], a1[3]);
                *(v2u*)rowp = w; }
    }
};
struct MoeOrder {
    int nM, nN, nwg, G, c; int t1, t2, t3, t4, t5, t6, t7;
    __device__ __forceinline__ bool next(int i, Unit& u) const {
        const long L = (long)i * G + c; if (L >= nwg) return false;
        int wgid = (int)L; { const int q = nwg / NXCD, r = nwg % NXCD, xcd = wgid % NXCD, off = wgid / NXCD; wgid = (xcd < r ? xcd * (q + 1) : r * (q + 1) + (xcd - r) * q) + off; }
        const int nig = WGM * nN, gid = wgid / nig, fm = gid * WGM, gsz = (nM - fm) < WGM ? (nM - fm) : WGM;
        u.pm = fm + ((wgid % nig) % gsz); u.pc = (wgid % nig) / gsz;
        const int e = (u.pm >= t1) + (u.pm >= t2) + (u.pm >= t3) + (u.pm >= t4) + (u.pm >= t5) + (u.pm >= t6) + (u.pm >= t7);
        u.pn = e * nN + u.pc; u.k0 = 0; u.nt = 0; u.ks = -1; return true;
    }
    __device__ __forceinline__ void a_ready(const Unit&) const {}
    __device__ __forceinline__ void done(const Unit&) const {}
};
}

__device__ __forceinline__ int swiglu_row(int n, int F) { const int bj = n / F, w = n % F; return 256 * (w >> 7) + 128 * bj + (w & 127); }
__device__ __forceinline__ int w_rowmap(int map, int mapF, int n) {
    if (map == 1) { if (n < 2048) { const int d0 = n & 255, hf = d0 >> 7, e = d0 & 127; return (n - d0) + 2 * (hf * 64 + (e & 63)) + (e >> 6); }
                    if (n >= 4096) return 4096 + swiglu_row(n - 4096, 2048); return n; }
    if (map == 2) { if (n < 2048) { const int d0 = n & 63, hf = d0 >> 5, e = d0 & 31; return (n - d0) + hf * 32 + 2 * (e & 15) + (e >> 4); } return n; }
    if (map == 3) return swiglu_row(n, mapF);
    return n;
}
template <bool FP8> __device__ __forceinline__ void p0_item64(const float* W, int K, int N, void* WT, int map, int mapF, LAS float* scr, int k0, int n0, int lane, float wscale) {
    { const int kq = lane >> 4, n4 = (lane & 15) * 4;
#pragma unroll 4
      for (int i = 0; i < 16; ++i) { const int k = 4 * i + kq; const f32x4 v = *(const GAS f32x4*)(W + (size_t)(k0 + k) * N + n0 + n4);
          LAS float* d = scr + k * 65 + n4; d[0] = v.x; d[1] = v.y; d[2] = v.z; d[3] = v.w; } }
    LDS_WAIT(); asm volatile("" ::: "memory");
    if constexpr (!FP8) {
        const int c = lane & 7;
#pragma unroll
        for (int j = 0; j < 8; ++j) { const int n = (lane >> 3) + 8 * j; const LAS float* sp = scr + (8 * c) * 65 + n;
            v4u o; o.x = pk2(sp[0 * 65], sp[1 * 65]); o.y = pk2(sp[2 * 65], sp[3 * 65]); o.z = pk2(sp[4 * 65], sp[5 * 65]); o.w = pk2(sp[6 * 65], sp[7 * 65]);
            *(GAS v4u*)((bf16*)WT + (size_t)w_rowmap(map, mapF, n0 + n) * K + k0 + 8 * c) = o; }
    } else {
        const int c = lane & 3;
#pragma unroll
        for (int j = 0; j < 4; ++j) { const int n = (lane >> 2) + 16 * j; const LAS float* sp = scr + (16 * c) * 65 + n;
            v4u o;
#pragma unroll
            for (int q = 0; q < 4; ++q) o[q] = pk4_fp8(sp[(4 * q) * 65] * wscale, sp[(4 * q + 1) * 65] * wscale, sp[(4 * q + 2) * 65] * wscale, sp[(4 * q + 3) * 65] * wscale);
            *(GAS v4u*)((unsigned char*)WT + (size_t)w_rowmap(map, mapF, n0 + n) * K + k0 + 16 * c) = o; }
    }
    LDS_WAIT(); asm volatile("" ::: "memory");
}

__device__ __forceinline__ void p0_prologue(Frame& F, const Args& a) {
    LAS float* scr = (LAS float*)(F.lds + F.wave * 16640);
    const int gw = F.vcu * NWAVES + F.wave, NGW = F.G * NWAVES;
    constexpr int I0 = (D / 64) * (8192 / 64), I1 = (2048 / 64) * (D / 64), I2 = (D / 64) * (2 * DFF / 64), I3 = (DFF / 64) * (D / 64), I4 = (D / 64) * (3072 / 64), I5 = (D / 64) * (D / 64);
    constexpr int I6E = (D / 64) * (2 * DFE / 64), I7E = (DFE / 64) * (D / 64);
    constexpr int NITEMS = I0 + I1 + I2 + I3 + I4 + I5 + NE * I6E + NE * I7E;
    for (int it = gw; it < NITEMS; it += NGW) {
        int r = it;
        if (r < I0) { const int nb = r % (8192 / 64), kb = r / (8192 / 64); p0_item64<false>(a.in[I_L0_WIN], D, 8192, F.ws + WS_W0IN, 1, 0, scr, 64 * kb, 64 * nb, F.lane, 1.f); continue; } r -= I0;
        if (r < I1) { const int nb = r % (D / 64), kb = r / (D / 64); p0_item64<false>(a.in[I_L0_WOUT], 2048, D, F.ws + WS_W0OUT, 0, 0, scr, 64 * kb, 64 * nb, F.lane, 1.f); continue; } r -= I1;
        if (r < I2) { const int nb = r % (2 * DFF / 64), kb = r / (2 * DFF / 64); p0_item64<false>(a.in[I_L0_WGU], D, 2 * DFF, F.ws + WS_W0GU, 3, DFF, scr, 64 * kb, 64 * nb, F.lane, 1.f); continue; } r -= I2;
        if (r < I3) { const int nb = r % (D / 64), kb = r / (D / 64); p0_item64<false>(a.in[I_L0_WDN], DFF, D, F.ws + WS_W0DN, 0, 0, scr, 64 * kb, 64 * nb, F.lane, 1.f); continue; } r -= I3;
        if (r < I4) { const int nb = r % (3072 / 64), kb = r / (3072 / 64); p0_item64<true>(a.in[I_L1_WIN], D, 3072, F.ws + WS_W1IN, 2, 0, scr, 64 * kb, 64 * nb, F.lane, MOE_WSCALE); continue; } r -= I4;
        if (r < I5) { const int nb = r % (D / 64), kb = r / (D / 64); p0_item64<false>(a.in[I_L1_WOUT], D, D, F.ws + WS_W1OUT, 0, 0, scr, 64 * kb, 64 * nb, F.lane, 1.f); continue; } r -= I5;
        if (r < NE * I6E) { const int e = r / I6E, rr = r % I6E; const int nb = rr % (2 * DFE / 64), kb = rr / (2 * DFE / 64);
            p0_item64<true>(a.in[I_L1_MGU] + (size_t)e * D * 2 * DFE, D, 2 * DFE, F.ws + WS_WMGU + (size_t)e * 2 * DFE * D, 3, DFE, scr, 64 * kb, 64 * nb, F.lane, MOE_WSCALE); continue; } r -= NE * I6E;
        { const int e = r / I7E, rr = r % I7E; const int nb = rr % (D / 64), kb = rr / (D / 64);
            p0_item64<true>(a.in[I_L1_MDN] + (size_t)e * DFE * D, DFE, D, F.ws + WS_WMDN + (size_t)e * D * DFE, 0, 0, scr, 64 * kb, 64 * nb, F.lane, MOE_WSCALE); }
    }
    __syncthreads();
    {
        LAS float* sc = (LAS float*)F.lds;
        LAS float* part = (LAS float*)(F.lds + 9 * 1024 * 4);
        bool loaded = false;
        for (int grp = F.vcu; grp < 2 * (6 * D / 64); grp += F.G) {
            if (!loaded) { for (int i = F.tid; i < 9 * 1024; i += NTHREADS) { const float cv = (i < 8 * 1024) ? a.in[I_C][i] : a.in[I_CCTX][i - 8 * 1024]; sc[i] = silu_f(cv); } loaded = true; }
            __syncthreads();
            const int layer = grp / (6 * D / 64), cb = (grp % (6 * D / 64)) * 64;
            const float* W = a.in[layer ? I_L1_WMOD : I_L0_WMOD]; const float* bm = a.in[layer ? I_L1_BMOD : I_L0_BMOD];
            const int ks = F.tid >> 6, col = F.tid & 63;
            float acc[9];
#pragma unroll
            for (int b = 0; b < 9; ++b) acc[b] = 0.f;
            for (int k = ks * 128; k < ks * 128 + 128; ++k) { const float w = W[(size_t)k * (6 * D) + cb + col];
#pragma unroll
                for (int b = 0; b < 9; ++b) acc[b] += sc[b * 1024 + k] * w; }
#pragma unroll
            for (int b = 0; b < 9; ++b) part[(ks * 9 + b) * 64 + col] = acc[b];
            __syncthreads();
            for (int o = F.tid; o < 9 * 64; o += NTHREADS) { const int b = o >> 6, cc = o & 63; float s = bm[cb + cc];
#pragma unroll
                for (int k2 = 0; k2 < 8; ++k2) s += part[(k2 * 9 + b) * 64 + cc];
                ((float*)(F.ws + WS_MODV))[((size_t)layer * 9 + b) * (6 * D) + cb + cc] = s; }
            __syncthreads();
        }
    }
    {
        const int gt = F.vcu * NTHREADS + F.tid;
        if (gt < 64 * 64 + 64 * 16) {
            int pos, i; float ex;
            if (gt < 4096) { pos = gt >> 6; i = gt & 63; ex = (float)(2 * i) / 128.0f; } else { const int q = gt - 4096; pos = q >> 4; i = q & 15; ex = (float)(2 * i) / 32.0f; }
            const float freq = __builtin_amdgcn_exp2f(-ex * 13.287712379549449f);
            const float rev = (float)pos * freq * 0.15915494309189535f;
            const float cs = __builtin_amdgcn_cosf(rev), sn = __builtin_amdgcn_sinf(rev);
            f32x2* t = (f32x2*)(F.ws + (gt < 4096 ? WS_TAB0 : WS_TAB1)); t[gt < 4096 ? gt : gt - 4096] = (f32x2){cs, sn};
        }
        if (gt == 0) { const float* lp = a.in[I_L1_LAMBDA]; float s1 = 0.f, s2 = 0.f; for (int i = 0; i < 64; ++i) { s1 += lp[i] * lp[64 + i]; s2 += lp[128 + i] * lp[192 + i]; }
            *(float*)(F.ws + WS_LAM) = __expf(s1) - __expf(s2) + LAMBDA_INIT; }
    }
}

struct RowPass {
    int nrows;
    const float* xin_lat; const float* xin_ctx; float* xout_lat; float* xout_ctx;
    const bf16* br;
    const float* gpost;
    const float* gate;
    const float* gpre;
    const float* shift; const float* scale;
    bf16* hout;
    const float* part;
};
template <bool BR, bool MOEBR, bool WH, bool ROUTE, bool H8 = false, int KSPL = 0, bool XI16 = false, bool XO16 = false>
__device__ __forceinline__ void row_pass(Frame& F, const Args& a, const RowPass& P) {
    const int gw = F.vcu * NWAVES + F.wave, NGW = F.G * NWAVES;
    const int l4 = F.lane * 4;
    for (int r = gw; r < P.nrows; r += NGW) {
        const bool lat = r < NLAT; const int rc = lat ? r : r - NLAT; const int midx = lat ? (r >> 12) : 8;
        const float* xin = (lat ? P.xin_lat : P.xin_ctx) + (size_t)rc * (XI16 ? D / 2 : D);
        float* xout = (lat ? P.xout_lat : P.xout_ctx) + (size_t)rc * (XO16 ? D / 2 : D);
        f32x4 v[4];
        if constexpr (XI16) {
#pragma unroll
            for (int j = 0; j < 4; ++j) { const v2u w = *(const GAS v2u*)((const bf16*)xin + l4 + 256 * j); v[j] = (f32x4){bflo(w.x), bfhi(w.x), bflo(w.y), bfhi(w.y)}; }
        } else {
#pragma unroll
            for (int j = 0; j < 4; ++j) v[j] = *(const GAS f32x4*)(xin + l4 + 256 * j);
        }
        if constexpr (BR || MOEBR) {
            f32x4 y[4];
            if constexpr (BR) {
                if (KSPL > 0 && !lat) {
#pragma unroll
                    for (int j = 0; j < 4; ++j) y[j] = (f32x4){0.f, 0.f, 0.f, 0.f};
                    for (int ks = 0; ks < KSPL; ++ks) { const float* pr = P.part + ((size_t)ks * NCTX + rc) * D + l4;
#pragma unroll
                        for (int j = 0; j < 4; ++j) y[j] = y[j] + *(const GAS f32x4*)(pr + 256 * j); }
                } else {
#pragma unroll
                for (int j = 0; j < 4; ++j) { const v2u w = *(const GAS v2u*)(P.br + (size_t)r * D + l4 + 256 * j); y[j] = (f32x4){bflo(w.x), bfhi(w.x), bflo(w.y), bfhi(w.y)}; }
                }
            } else {
                const int* tpos = (const int*)(F.ws + WS_ROUTE + (size_t)NLAT * 8); const float* tw = (const float*)(F.ws + WS_ROUTE + (size_t)NLAT * 16);
                const int s0 = tpos[2 * r], s1 = tpos[2 * r + 1]; const float w0 = tw[2 * r], w1 = tw[2 * r + 1];
#pragma unroll
                for (int j = 0; j < 4; ++j) { const v2u p = *(const GAS v2u*)(P.br + (size_t)s0 * D + l4 + 256 * j); const v2u q = *(const GAS v2u*)(P.br + (size_t)s1 * D + l4 + 256 * j);
                    y[j] = (f32x4){w0 * bflo(p.x) + w1 * bflo(q.x), w0 * bfhi(p.x) + w1 * bfhi(q.x), w0 * bflo(p.y) + w1 * bflo(q.y), w0 * bfhi(p.y) + w1 * bfhi(q.y)}; }
            }
            float ss = 0.f;
#pragma unroll
            for (int j = 0; j < 4; ++j) ss += (y[j].x * y[j].x + y[j].y * y[j].y) + (y[j].z * y[j].z + y[j].w * y[j].w);
            const float rstd = 1.0f / sqrtf(wave_sum(ss) * (1.0f / D) + EPS);
#pragma unroll
            for (int j = 0; j < 4; ++j) { const f32x4 gp = *(const GAS f32x4*)(P.gpost + l4 + 256 * j); const f32x4 gt = *(const GAS f32x4*)(P.gate + (size_t)midx * 6 * D + l4 + 256 * j);
                v[j] = v[j] + gt * (y[j] * rstd * gp); }
            if ((lat ? P.xout_lat : P.xout_ctx) != nullptr) {
                if constexpr (XO16) {
#pragma unroll
                    for (int j = 0; j < 4; ++j) { v2u w; w.x = pk2(v[j].x, v[j].y); w.y = pk2(v[j].z, v[j].w); *(GAS v2u*)((bf16*)xout + l4 + 256 * j) = w; }
                } else {
#pragma unroll
                    for (int j = 0; j < 4; ++j) *(GAS f32x4*)(xout + l4 + 256 * j) = v[j];
                }
            }
        }
        if constexpr (WH) {
            float ss = 0.f;
#pragma unroll
            for (int j = 0; j < 4; ++j) ss += (v[j].x * v[j].x + v[j].y * v[j].y) + (v[j].z * v[j].z + v[j].w * v[j].w);
            const float rstd = 1.0f / sqrtf(wave_sum(ss) * (1.0f / D) + EPS);
            f32x4 h[4];
#pragma unroll
            for (int j = 0; j < 4; ++j) { const f32x4 gp = *(const GAS f32x4*)(P.gpre + l4 + 256 * j); const f32x4 sc = *(const GAS f32x4*)(P.scale + (size_t)midx * 6 * D + l4 + 256 * j);
                const f32x4 sh = *(const GAS f32x4*)(P.shift + (size_t)midx * 6 * D + l4 + 256 * j);
                h[j] = (v[j] * rstd * gp) * (1.0f + sc) + sh;
                if constexpr (H8) { *(GAS unsigned*)((unsigned char*)P.hout + (size_t)r * D + l4 + 256 * j) = pk4_fp8(h[j].x, h[j].y, h[j].z, h[j].w); }
                else { v2u w; w.x = pk2(h[j].x, h[j].y); w.y = pk2(h[j].z, h[j].w); *(GAS v2u*)(P.hout + (size_t)r * D + l4 + 256 * j) = w; } }
            if constexpr (ROUTE) {
                const float* rw = a.in[I_L1_RW];
                float lg[8];
#pragma unroll
                for (int e = 0; e < 8; ++e) lg[e] = 0.f;
#pragma unroll
                for (int j = 0; j < 4; ++j)
#pragma unroll
                    for (int q = 0; q < 4; ++q) { const int k = l4 + 256 * j + q; const f32x4 wa = *(const GAS f32x4*)(rw + (size_t)k * 8), wb = *(const GAS f32x4*)(rw + (size_t)k * 8 + 4); const float hv = h[j][q];
                        lg[0] += hv * wa.x; lg[1] += hv * wa.y; lg[2] += hv * wa.z; lg[3] += hv * wa.w; lg[4] += hv * wb.x; lg[5] += hv * wb.y; lg[6] += hv * wb.z; lg[7] += hv * wb.w; }
#pragma unroll
                for (int e = 0; e < 8; ++e) lg[e] = wave_sum(lg[e]) + a.in[I_L1_RB][e];
                float v1 = lg[0]; int i1 = 0;
#pragma unroll
                for (int e = 1; e < 8; ++e) if (lg[e] > v1) { v1 = lg[e]; i1 = e; }
                float v2 = -3.0e38f; int i2 = 0;
#pragma unroll
                for (int e = 0; e < 8; ++e) if (e != i1 && lg[e] > v2) { v2 = lg[e]; i2 = e; }
                const float w1 = 1.0f / (1.0f + __expf(v2 - v1)), w2 = 1.0f - w1;
                if (F.lane == 0) {
                    int* te = (int*)(F.ws + WS_ROUTE); int* tpos = (int*)(F.ws + WS_ROUTE + (size_t)NLAT * 8); float* tw = (float*)(F.ws + WS_ROUTE + (size_t)NLAT * 16);
                    const unsigned p1 = __hip_atomic_fetch_add((unsigned*)(F.ctl + CW_MOECNT + 64 * i1), 1u, RLX_AGENT);
                    const unsigned p2 = __hip_atomic_fetch_add((unsigned*)(F.ctl + CW_MOECNT + 64 * i2), 1u, RLX_AGENT);
                    te[2 * r] = i1; te[2 * r + 1] = i2; tpos[2 * r] = (int)p1; tpos[2 * r + 1] = (int)p2; tw[2 * r] = w1; tw[2 * r + 1] = w2;
                }
            }
        }
    }
}


namespace att {
using s16x4  = __attribute__((ext_vector_type(4))) short;
using f32x16 = __attribute__((ext_vector_type(16))) float;
using u32x4  = __attribute__((ext_vector_type(4))) unsigned;
constexpr int KVBLK = 64, NT = (SEQ + CTXL) / KVBLK;
constexpr int SHM_V = KVBLK * 128, SHM_K = KVBLK * 64 * 2;
constexpr int NVTILE = MALL / KVBLK;
constexpr int NSLOT_K = 3, NSLOT_V = 4;
constexpr int OFF_V = 0, OFF_K = NSLOT_V * SHM_V, OFF_WS = OFF_K + NSLOT_K * SHM_K, OFF_O1 = OFF_WS + NWAVES * 64 * 4, ATT_LDS = OFF_O1 + NWAVES * 8192;
constexpr float THR = 8.0f;
#define ATT_SBAR() __builtin_amdgcn_sched_barrier(0)
#define ATT_PIPE_PV() do { __builtin_amdgcn_sched_group_barrier(0x100, 2, 0); \
    _Pragma("unroll") for (int i_ = 0; i_ < 16; ++i_) { __builtin_amdgcn_sched_group_barrier(0x008, 1, 0); __builtin_amdgcn_sched_group_barrier(0x100, 2, 0); __builtin_amdgcn_sched_group_barrier(0x002, 7, 0); } } while (0)
#define KSWZ64(row, colB) ((row) * 128 + ((colB) ^ ((((row) >> 1) & 7) << 4)))
__device__ __forceinline__ int crow(int r, int hi) { return (r & 3) + 8 * (r >> 2) + 4 * hi; }
__device__ __forceinline__ unsigned cvtpk(float lo, float hi) { return pk2(lo, hi); }

template <int VAR = 0> __device__ __forceinline__ void partialSM(f32x16& p0, f32x16& p1, float& m_reg, f32x16& negm, float& alpha) {
    float mx[4];
#pragma unroll
    for (int c = 0; c < 4; ++c) mx[c] = fmaxf(fmaxf(p0[4 * c], p0[4 * c + 1]), fmaxf(p0[4 * c + 2], p0[4 * c + 3]));
#pragma unroll
    for (int c = 0; c < 4; ++c) mx[c] = fmaxf(mx[c], fmaxf(fmaxf(p1[4 * c], p1[4 * c + 1]), fmaxf(p1[4 * c + 2], p1[4 * c + 3])));
    float pmax = fmaxf(fmaxf(mx[0], mx[1]), fmaxf(mx[2], mx[3]));
    { auto rr = __builtin_amdgcn_permlane32_swap(__float_as_uint(pmax), __float_as_uint(pmax), false, false); pmax = fmaxf(__uint_as_float(rr[0]), __uint_as_float(rr[1])); }
    alpha = 1.f; m_reg = pmax;
#pragma unroll
    for (int r = 0; r < 16; ++r) { negm[r] = -pmax; p0[r] = __builtin_amdgcn_exp2f(p0[r] - pmax); p1[r] = __builtin_amdgcn_exp2f(p1[r] - pmax); }
}
template <int VAR = 0> __device__ __forceinline__ void finishSM(f32x16& p0, f32x16& p1, float alpha, float& l_reg, bf16x8& pa0, bf16x8& pa1, bf16x8& pa2, bf16x8& pa3) {
    if (VAR != 2) {
    f32x2 s2[4];
#pragma unroll
    for (int c = 0; c < 4; ++c) s2[c] = (f32x2){p0[4 * c], p0[4 * c + 1]} + (f32x2){p0[4 * c + 2], p0[4 * c + 3]};
#pragma unroll
    for (int c = 0; c < 4; ++c) s2[c] = s2[c] + ((f32x2){p1[4 * c], p1[4 * c + 1]} + (f32x2){p1[4 * c + 2], p1[4 * c + 3]});
    const f32x2 s2t = (s2[0] + s2[1]) + (s2[2] + s2[3]);
    float ps = s2t[0] + s2t[1];
    { auto rr = __builtin_amdgcn_permlane32_swap(__float_as_uint(ps), __float_as_uint(ps), false, false); ps = __uint_as_float(rr[0]) + __uint_as_float(rr[1]); }
    l_reg = l_reg * alpha + ps;
    } else { l_reg = 1.f; }
#define ATT_PK4(P, BASE, OUT) do { u32x4 w = {cvtpk(P[BASE + 0], P[BASE + 1]), cvtpk(P[BASE + 2], P[BASE + 3]), cvtpk(P[BASE + 4], P[BASE + 5]), cvtpk(P[BASE + 6], P[BASE + 7])}; OUT = *reinterpret_cast<bf16x8*>(&w); } while (0)
    ATT_PK4(p0, 0, pa0); ATT_PK4(p0, 8, pa1); ATT_PK4(p1, 0, pa2); ATT_PK4(p1, 8, pa3);
#undef ATT_PK4
}
__device__ __forceinline__ void qkt(f32x16& p0, f32x16& p1, const char* Ks, const bf16x8* qr, const f32x16& negm, int r32, int hi) {
#pragma unroll
    for (int d0 = 0; d0 < 4; ++d0) { const int cb = (d0 * 16 + hi * 8) * 2;
        const bf16x8 b0 = *reinterpret_cast<const bf16x8*>(Ks + KSWZ64(r32, cb));
        const bf16x8 b1 = *reinterpret_cast<const bf16x8*>(Ks + KSWZ64(32 + r32, cb));
        if (d0 == 0) { p0 = __builtin_amdgcn_mfma_f32_32x32x16_bf16(b0, qr[0], negm, 0, 0, 0); p1 = __builtin_amdgcn_mfma_f32_32x32x16_bf16(b1, qr[0], negm, 0, 0, 0); }
        else { p0 = __builtin_amdgcn_mfma_f32_32x32x16_bf16(b0, qr[d0], p0, 0, 0, 0); p1 = __builtin_amdgcn_mfma_f32_32x32x16_bf16(b1, qr[d0], p1, 0, 0, 0); } }
}
__device__ __forceinline__ int v_st(int k, int c) { const int kk = (k & ~0xC) | ((k & 4) << 1) | ((k & 8) >> 1); return ((kk >> 3) * 4 + (c >> 5)) * 512 + ((kk & 7) * 32 + (c & 31)) * 2; }
__device__ __forceinline__ int v_rd_base(int lane) { return ((lane & 3) << 3) | (((lane >> 2) & 3) << 6) | (((lane >> 4) & 1) << 5) | (((lane >> 5) & 1) << 8); }
constexpr int v_rd_off(int d0, int ks, int half) { return d0 * 512 + ks * 4096 + half * 2048; }
typedef short v4i16a_t __attribute__((ext_vector_type(4)));
template <int OFF> __device__ __forceinline__ s16x4 tr_read(int vb) { return __builtin_bit_cast(s16x4, __builtin_amdgcn_ds_read_tr16_b64_v4i16((LAS v4i16a_t*)(unsigned)(vb + OFF))); }
#define ATT_PK(L, H) (bf16x8){L[0], L[1], L[2], L[3], H[0], H[1], H[2], H[3]}
template <int D0> __device__ __forceinline__ void pv_one(f32x16& od, int vb, bf16x8 pa0, bf16x8 pa1, bf16x8 pa2, bf16x8 pa3) {
    const s16x4 l0 = tr_read<v_rd_off(D0, 0, 0)>(vb), h0 = tr_read<v_rd_off(D0, 0, 1)>(vb), l1 = tr_read<v_rd_off(D0, 1, 0)>(vb), h1 = tr_read<v_rd_off(D0, 1, 1)>(vb);
    const s16x4 l2 = tr_read<v_rd_off(D0, 2, 0)>(vb), h2 = tr_read<v_rd_off(D0, 2, 1)>(vb), l3 = tr_read<v_rd_off(D0, 3, 0)>(vb), h3 = tr_read<v_rd_off(D0, 3, 1)>(vb);
    od = __builtin_amdgcn_mfma_f32_32x32x16_bf16(pa0, ATT_PK(l0, h0), od, 0, 0, 0);
    od = __builtin_amdgcn_mfma_f32_32x32x16_bf16(pa1, ATT_PK(l1, h1), od, 0, 0, 0);
    od = __builtin_amdgcn_mfma_f32_32x32x16_bf16(pa2, ATT_PK(l2, h2), od, 0, 0, 0);
    od = __builtin_amdgcn_mfma_f32_32x32x16_bf16(pa3, ATT_PK(l3, h3), od, 0, 0, 0);
}
#undef ATT_PK
__device__ __forceinline__ void pv_d0(f32x16* o, int vb, bf16x8 pa0, bf16x8 pa1, bf16x8 pa2, bf16x8 pa3) {
    pv_one<0>(o[0], vb, pa0, pa1, pa2, pa3); pv_one<1>(o[1], vb, pa0, pa1, pa2, pa3); pv_one<2>(o[2], vb, pa0, pa1, pa2, pa3); pv_one<3>(o[3], vb, pa0, pa1, pa2, pa3);
}
struct VH { bf16x8 k0, k1; };
__device__ __forceinline__ void vhalf(bf16x8& d, s16x4 lo, s16x4 hi) { d = __builtin_shufflevector(lo, hi, 0, 1, 2, 3, 4, 5, 6, 7); }
template <int D0, int KS0> __device__ __forceinline__ void vh_load(VH& f, int vb) {
    vhalf(f.k0, tr_read<v_rd_off(D0, KS0, 0)>(vb), tr_read<v_rd_off(D0, KS0, 1)>(vb)); vhalf(f.k1, tr_read<v_rd_off(D0, KS0 + 1, 0)>(vb), tr_read<v_rd_off(D0, KS0 + 1, 1)>(vb));
}
#define ATT_PKV(L, H) (bf16x8){L[0], L[1], L[2], L[3], H[0], H[1], H[2], H[3]}
#define ATT_E3(P, B) do { P[B] = __builtin_amdgcn_exp2f(P[B]); P[(B) + 1] = __builtin_amdgcn_exp2f(P[(B) + 1]); P[(B) + 2] = __builtin_amdgcn_exp2f(P[(B) + 2]); } while (0)
#define ATT_MM(D, PA, FR) o[D] = __builtin_amdgcn_mfma_f32_32x32x16_bf16(PA, FR, o[D], 0, 0, 0)
#define ATT_PIN(x) asm volatile("" : "+v"(x))
__device__ __forceinline__ void pv_partial(f32x16* o, int vb, bf16x8 pa0, bf16x8 pa1, bf16x8 pa2, bf16x8 pa3, f32x16& p0, f32x16& p1, float& m_reg, f32x16& negm, float& alpha) {
    VH fa, fb; float mx[4];
    vh_load<0, 0>(fa, vb); vh_load<0, 2>(fb, vb);
    ATT_SBAR();
    ATT_MM(0, pa0, fa.k0);
    mx[0] = fmaxf(fmaxf(p0[0], p0[1]), p0[2]); mx[1] = fmaxf(fmaxf(p0[3], p0[4]), p0[5]); mx[2] = fmaxf(fmaxf(p0[6], p0[7]), p0[8]); mx[3] = fmaxf(fmaxf(p0[9], p0[10]), p0[11]); ATT_PIN(mx[0]); ATT_PIN(mx[1]); ATT_PIN(mx[2]); ATT_PIN(mx[3]); ATT_SBAR();
    ATT_MM(0, pa1, fa.k1); vh_load<1, 0>(fa, vb);
    mx[0] = fmaxf(fmaxf(mx[0], p0[12]), p0[13]); mx[1] = fmaxf(fmaxf(mx[1], p0[14]), p0[15]); mx[2] = fmaxf(fmaxf(mx[2], p1[0]), p1[1]); mx[3] = fmaxf(fmaxf(mx[3], p1[2]), p1[3]); ATT_PIN(mx[0]); ATT_PIN(mx[1]); ATT_PIN(mx[2]); ATT_PIN(mx[3]); ATT_SBAR();
    ATT_MM(0, pa2, fb.k0);
    mx[0] = fmaxf(fmaxf(mx[0], p1[4]), p1[5]); mx[1] = fmaxf(fmaxf(mx[1], p1[6]), p1[7]); mx[2] = fmaxf(fmaxf(mx[2], p1[8]), p1[9]); mx[3] = fmaxf(fmaxf(mx[3], p1[10]), p1[11]); ATT_PIN(mx[0]); ATT_PIN(mx[1]); ATT_PIN(mx[2]); ATT_PIN(mx[3]); ATT_SBAR();
    ATT_MM(0, pa3, fb.k1); vh_load<1, 2>(fb, vb);
    mx[0] = fmaxf(fmaxf(mx[0], p1[12]), p1[13]); mx[1] = fmaxf(fmaxf(mx[1], p1[14]), p1[15]); ATT_PIN(mx[0]); ATT_PIN(mx[1]); ATT_SBAR();
    ATT_MM(1, pa0, fa.k0);
    { float pmax = fmaxf(fmaxf(mx[0], mx[1]), fmaxf(mx[2], mx[3]));
      auto rr = __builtin_amdgcn_permlane32_swap(__float_as_uint(pmax), __float_as_uint(pmax), false, false); pmax = fmaxf(__uint_as_float(rr[0]), __uint_as_float(rr[1]));
      const bool need = pmax > THR; alpha = 1.f;
      if (__any(need)) { const float delta = need ? pmax : 0.f; alpha = __builtin_amdgcn_exp2f(-delta); m_reg += delta;
#pragma unroll
          for (int r = 0; r < 16; ++r) { p0[r] -= delta; p1[r] -= delta; negm[r] -= delta; } } } ATT_PIN(alpha); ATT_SBAR();
    ATT_MM(1, pa1, fa.k1); vh_load<2, 0>(fa, vb); ATT_E3(p0, 0); ATT_PIN(p0); ATT_SBAR();
    ATT_MM(1, pa2, fb.k0); ATT_E3(p0, 3); ATT_PIN(p0); ATT_SBAR();
    ATT_MM(1, pa3, fb.k1); vh_load<2, 2>(fb, vb); ATT_E3(p0, 6); ATT_PIN(p0); ATT_SBAR();
    ATT_MM(2, pa0, fa.k0); ATT_E3(p0, 9); ATT_PIN(p0); ATT_SBAR();
    ATT_MM(2, pa1, fa.k1); vh_load<3, 0>(fa, vb); ATT_E3(p0, 12); ATT_PIN(p0); ATT_SBAR();
    ATT_MM(2, pa2, fb.k0); p0[15] = __builtin_amdgcn_exp2f(p0[15]); p1[0] = __builtin_amdgcn_exp2f(p1[0]); p1[1] = __builtin_amdgcn_exp2f(p1[1]); ATT_PIN(p0); ATT_PIN(p1); ATT_SBAR();
    ATT_MM(2, pa3, fb.k1); vh_load<3, 2>(fb, vb); ATT_E3(p1, 2); ATT_PIN(p1); ATT_SBAR();
    ATT_MM(3, pa0, fa.k0); ATT_E3(p1, 5); ATT_PIN(p1); ATT_SBAR();
    ATT_MM(3, pa1, fa.k1); ATT_E3(p1, 8); ATT_PIN(p1); ATT_SBAR();
    ATT_MM(3, pa2, fb.k0); ATT_E3(p1, 11); ATT_PIN(p1); ATT_SBAR();
    ATT_MM(3, pa3, fb.k1); p1[14] = __builtin_amdgcn_exp2f(p1[14]); p1[15] = __builtin_amdgcn_exp2f(p1[15]); ATT_PIN(p1); ATT_SBAR();
}
#undef ATT_MM
#undef ATT_PIN
#undef ATT_E3
#undef ATT_PKV
typedef int v8i_a __attribute__((ext_vector_type(8)));
typedef int v4i_a __attribute__((ext_vector_type(4)));
__device__ __forceinline__ v8i_a v8_frag(unsigned a0, unsigned a1) {
    const v4i_a lo = *(const LAS v4i_a*)a0, hi = *(const LAS v4i_a*)a1; return __builtin_shufflevector(lo, hi, 0, 1, 2, 3, 4, 5, 6, 7); }
#define ATT_MM8(D, FR) asm volatile("v_mfma_scale_f32_32x32x64_f8f6f4 %0, %1, %2, %0, %3, %3 op_sel_hi:[0,0,0]" : "+v"(o[D]) : "v"(pa8), "v"(FR), "v"(one8))
#define ATT_PIN8(x) asm volatile("" : "+v"(x))
#define ATT_EX(P, B) P[B] = __builtin_amdgcn_exp2f(P[B])
__device__ __forceinline__ void pv8_partial(f32x16* o, unsigned va0, unsigned va1, v8i_a pa8, f32x16& p0, f32x16& p1, float& m_reg, f32x16& negm, float& alpha) {
    const int one8 = 0x7f7f7f7f;
    float mx[4];
    const v8i_a f0 = v8_frag(va0, va1), f1 = v8_frag(va0 + 2048, va1 + 2048), f2 = v8_frag(va0 + 4096, va1 + 4096), f3 = v8_frag(va0 + 6144, va1 + 6144);
    ATT_SBAR();
    ATT_MM8(0, f0);
    mx[0] = fmaxf(fmaxf(p0[0], p0[1]), p0[2]); mx[1] = fmaxf(fmaxf(p0[3], p0[4]), p0[5]); mx[2] = fmaxf(fmaxf(p0[6], p0[7]), p0[8]); mx[3] = fmaxf(fmaxf(p0[9], p0[10]), p0[11]);
    mx[0] = fmaxf(fmaxf(mx[0], p0[12]), p0[13]); mx[1] = fmaxf(fmaxf(mx[1], p0[14]), p0[15]); mx[2] = fmaxf(fmaxf(mx[2], p1[0]), p1[1]); mx[3] = fmaxf(fmaxf(mx[3], p1[2]), p1[3]);
    mx[0] = fmaxf(fmaxf(mx[0], p1[4]), p1[5]); mx[1] = fmaxf(fmaxf(mx[1], p1[6]), p1[7]); mx[2] = fmaxf(fmaxf(mx[2], p1[8]), p1[9]); mx[3] = fmaxf(fmaxf(mx[3], p1[10]), p1[11]);
    mx[0] = fmaxf(fmaxf(mx[0], p1[12]), p1[13]); mx[1] = fmaxf(fmaxf(mx[1], p1[14]), p1[15]);
    { float pmax = fmaxf(fmaxf(mx[0], mx[1]), fmaxf(mx[2], mx[3]));
      auto rr = __builtin_amdgcn_permlane32_swap(__float_as_uint(pmax), __float_as_uint(pmax), false, false); pmax = fmaxf(__uint_as_float(rr[0]), __uint_as_float(rr[1]));
      const bool need = pmax > THR; alpha = 1.f;
      if (__any(need)) { const float delta = need ? pmax : 0.f; alpha = __builtin_amdgcn_exp2f(-delta); m_reg += delta;
#pragma unroll
          for (int r = 0; r < 16; ++r) { p0[r] -= delta; p1[r] -= delta; negm[r] -= delta; } } } ATT_PIN8(alpha); ATT_SBAR();
    ATT_MM8(1, f1);
    ATT_EX(p0, 0); ATT_EX(p0, 1); ATT_EX(p0, 2); ATT_EX(p0, 3); ATT_EX(p0, 4); ATT_EX(p0, 5); ATT_EX(p0, 6); ATT_EX(p0, 7); ATT_EX(p0, 8); ATT_EX(p0, 9); ATT_EX(p0, 10); ATT_PIN8(p0); ATT_SBAR();
    ATT_MM8(2, f2);
    ATT_EX(p0, 11); ATT_EX(p0, 12); ATT_EX(p0, 13); ATT_EX(p0, 14); ATT_EX(p0, 15); ATT_EX(p1, 0); ATT_EX(p1, 1); ATT_EX(p1, 2); ATT_EX(p1, 3); ATT_EX(p1, 4); ATT_EX(p1, 5); ATT_PIN8(p0); ATT_PIN8(p1); ATT_SBAR();
    ATT_MM8(3, f3);
    ATT_EX(p1, 6); ATT_EX(p1, 7); ATT_EX(p1, 8); ATT_EX(p1, 9); ATT_EX(p1, 10); ATT_EX(p1, 11); ATT_EX(p1, 12); ATT_EX(p1, 13); ATT_EX(p1, 14); ATT_EX(p1, 15); ATT_PIN8(p1); ATT_SBAR();
    asm volatile("s_nop 15\n\ts_nop 15" ::: "memory");
}
#undef ATT_EX
__device__ __forceinline__ void finishSM8(f32x16& p0, f32x16& p1, float alpha, float& l_reg, v8i_a& pa8) {
    f32x2 s2[4];
#pragma unroll
    for (int c = 0; c < 4; ++c) s2[c] = (f32x2){p0[4 * c], p0[4 * c + 1]} + (f32x2){p0[4 * c + 2], p0[4 * c + 3]};
#pragma unroll
    for (int c = 0; c < 4; ++c) s2[c] = s2[c] + ((f32x2){p1[4 * c], p1[4 * c + 1]} + (f32x2){p1[4 * c + 2], p1[4 * c + 3]});
    const f32x2 s2t = (s2[0] + s2[1]) + (s2[2] + s2[3]);
    float ps = s2t[0] + s2t[1];
    { auto rr = __builtin_amdgcn_permlane32_swap(__float_as_uint(ps), __float_as_uint(ps), false, false); ps = __uint_as_float(rr[0]) + __uint_as_float(rr[1]); }
    l_reg = l_reg * alpha + ps;
#pragma unroll
    for (int q = 0; q < 4; ++q) { int w0 = 0, w1 = 0;
        w0 = __builtin_amdgcn_cvt_pk_fp8_f32(p0[4 * q], p0[4 * q + 1], w0, false); w0 = __builtin_amdgcn_cvt_pk_fp8_f32(p0[4 * q + 2], p0[4 * q + 3], w0, true);
        w1 = __builtin_amdgcn_cvt_pk_fp8_f32(p1[4 * q], p1[4 * q + 1], w1, false); w1 = __builtin_amdgcn_cvt_pk_fp8_f32(p1[4 * q + 2], p1[4 * q + 3], w1, true);
        pa8[q] = w0; pa8[4 + q] = w1; }
}
__device__ __forceinline__ size_t kvrow(int b, int t) { return t < 64 ? (size_t)b * SEQ + (size_t)t * 64 : (size_t)NLAT + (size_t)b * CTXL + (size_t)(t - 64) * 64; }

__device__ __forceinline__ void glds16(const void* gsrc, unsigned lds_dst) { unsigned keep;
    asm volatile("s_mov_b32 %0, m0\n\ts_mov_b32 m0, %2\n\ts_nop 0\n\tglobal_load_lds_dwordx4 %1, off\n\ts_mov_b32 m0, %0" : "=&s"(keep) : "v"(gsrc), "s"(lds_dst) : "memory"); }
template <int VAR> __device__ __forceinline__ void head_pass(const bf16* __restrict__ Q1, const bf16* __restrict__ K1, const unsigned char* __restrict__ V8, int b, int qh, int hp, size_t qrow0, char* lds, f32x16 (&o)[4], float& l_out) {
    int tid_ = threadIdx.x; asm volatile("" : "+v"(tid_));
    const int tid = tid_, wid = __builtin_amdgcn_readfirstlane(tid >> 6), lane = tid & 63, r32 = lane & 31, hi = lane >> 5;
    char* V_lds = lds + OFF_V; char* K_lds = lds + OFF_K;
    float* wsf = (float*)(lds + OFF_WS) + wid * 64; float* al_l = wsf + 32;
    float m_reg = 0.f, l_reg = 0.f; f32x16 negm = f32x16{};
#pragma unroll
    for (int d = 0; d < 4; ++d) o[d] = f32x16{};
    const bf16* Kh = K1 + (size_t)qh * MALL * 64; const unsigned char* Vh = V8 + (size_t)hp * NVTILE * SHM_V;
    const int kr = 8 * wid + (lane >> 3); const unsigned koff = (unsigned)(kr * 128 + (((lane & 7) ^ ((kr >> 1) & 7)) << 4));
    const unsigned lbase = (unsigned)(uintptr_t)lds;
#define ATT_ISSUE(t_, ks_, vs_) do { const int tt_ = (t_); const size_t rb_ = kvrow(b, tt_); const char* kb_ = (const char*)(Kh + rb_ * 64); \
    const unsigned char* vb_ = Vh + (size_t)(tt_ < 64 ? b * 64 + tt_ : 512 + 4 * b + (tt_ - 64)) * SHM_V; \
    glds16(kb_ + koff, (unsigned)__builtin_amdgcn_readfirstlane(lbase + OFF_K + (ks_) * SHM_K + wid * 1024)); \
    glds16(vb_ + wid * 1024 + lane * 16, (unsigned)__builtin_amdgcn_readfirstlane(lbase + OFF_V + (vs_) * SHM_V + wid * 1024)); } while (0)
#define ATT_WAITBAR(N) do { asm volatile("s_waitcnt vmcnt(" #N ")" ::: "memory"); __builtin_amdgcn_s_barrier(); asm volatile("" ::: "memory"); } while (0)
#define ATT_RESC(al) do { if (__any((al) < 1.f)) { if (hi == 0) al_l[r32] = (al); asm volatile("s_waitcnt lgkmcnt(0)" ::: "memory"); \
    _Pragma("unroll") for (int d = 0; d < 4; ++d) _Pragma("unroll") for (int r = 0; r < 16; ++r) o[d][r] *= al_l[crow(r, hi)]; } } while (0)
    bf16x8 qr[4];
    const bf16* Qw = Q1 + ((size_t)qh * MALL + qrow0 + wid * 32 + r32) * 64 + hi * 8;
#pragma unroll
    for (int d0 = 0; d0 < 4; ++d0) qr[d0] = *reinterpret_cast<const bf16x8*>(Qw + d0 * 16);
    const unsigned vsw = (unsigned)((r32 >> 2) & 3);
    const unsigned va0_ = (unsigned)(uintptr_t)V_lds + (unsigned)(r32 * 64) + (((2u * hi) ^ vsw) << 4), va1_ = (unsigned)(uintptr_t)V_lds + (unsigned)(r32 * 64) + (((2u * hi + 1u) ^ vsw) << 4);
    f32x16 pA0, pA1, pB0, pB1; float alA = 1.f, alB = 1.f; v8i_a pa8;
    int kq = 1, ki = 2, vA = 0, vB = 3, vi = 2;
#define ATT_ADV() do { kq = ki; ki = (ki == 2) ? 0 : ki + 1; vB = vA; vA = (vA + 1) & 3; vi = (vi + 1) & 3; } while (0)
    ATT_ISSUE(0, 0, 0); ATT_ISSUE(1, 1, 1);
    ATT_WAITBAR(2);
    {
        qkt(pA0, pA1, K_lds, qr, negm, r32, hi); partialSM<VAR>(pA0, pA1, m_reg, negm, alA);
        ATT_WAITBAR(1);
#define ATT_STEP_A(PC0, PC1, ALC, PN0, PN1, ALN, j_) do { \
        ATT_ISSUE((j_) + 2, ki, vi); \
        ATT_SBAR(); qkt(PN0, PN1, K_lds + kq * SHM_K, qr, negm, r32, hi); \
        finishSM8(PC0, PC1, ALC, l_reg, pa8); ATT_SBAR(); \
        pv8_partial(o, va0_ + vA * SHM_V, va1_ + vA * SHM_V, pa8, PN0, PN1, m_reg, negm, ALN); \
        ATT_RESC(ALN); \
        ATT_WAITBAR(1); ATT_ADV(); } while (0)
        for (int j = 0; j + 2 < NT; j += 2) {
            ATT_STEP_A(pA0, pA1, alA, pB0, pB1, alB, j);
            ATT_STEP_A(pB0, pB1, alB, pA0, pA1, alA, j + 1);
        }
        ATT_SBAR(); qkt(pB0, pB1, K_lds + kq * SHM_K, qr, negm, r32, hi);
        finishSM8(pA0, pA1, alA, l_reg, pa8); ATT_SBAR();
        pv8_partial(o, va0_ + vA * SHM_V, va1_ + vA * SHM_V, pa8, pB0, pB1, m_reg, negm, alB);
        ATT_RESC(alB);
        ATT_WAITBAR(0);
        finishSM8(pB0, pB1, alB, l_reg, pa8); ATT_SBAR();
        { const unsigned s_ = (unsigned)(((vA + 1) & 3) * SHM_V); const int one8 = 0x7f7f7f7f;
          const v8i_a f0 = v8_frag(va0_ + s_, va1_ + s_), f1 = v8_frag(va0_ + s_ + 2048, va1_ + s_ + 2048), f2 = v8_frag(va0_ + s_ + 4096, va1_ + s_ + 4096), f3 = v8_frag(va0_ + s_ + 6144, va1_ + s_ + 6144);
          ATT_SBAR(); ATT_MM8(0, f0); ATT_MM8(1, f1); ATT_MM8(2, f2); ATT_MM8(3, f3); asm volatile("s_nop 15\n\ts_nop 15" ::: "memory"); }
#undef ATT_STEP_A
    }
    l_out = l_reg;
    asm volatile("s_waitcnt lgkmcnt(0)" ::: "memory"); __builtin_amdgcn_s_barrier(); asm volatile("" ::: "memory");
#undef ATT_ADV
#undef ATT_ISSUE
#undef ATT_WAITBAR
#undef ATT_RESC
}

template <int VAR> __device__ __forceinline__ void attn_unit(const bf16* __restrict__ Q1, const bf16* __restrict__ K1, const unsigned char* __restrict__ V1, bf16* __restrict__ ao, int b, int hp, int qb, char* lds, const float* lamp, const float* subln) {
    int tid_ = threadIdx.x; asm volatile("" : "+v"(tid_));
    const int tid = tid_, wid = tid >> 6, lane = tid & 63, r32 = lane & 31, hi = lane >> 5;
    float* wsf = (float*)(lds + OFF_WS) + wid * 64;
    unsigned* o1s = (unsigned*)(lds + OFF_O1 + wid * 8192);
    const size_t qrow0 = (size_t)b * SEQ + (size_t)qb * 256;
    f32x16 o[4]; float l;
    float ssq[16];
#pragma unroll 1
    for (int hh = 0; hh < 2; ++hh) {
        head_pass<VAR>(Q1, K1, V1, b, 2 * hp + hh, hp, qrow0, lds, o, l);
        if (hi == 0) wsf[r32] = l; asm volatile("s_waitcnt lgkmcnt(0)" ::: "memory");
        float rli[16];
#pragma unroll
        for (int r = 0; r < 16; ++r) { rli[r] = __builtin_amdgcn_rcpf(wsf[crow(r, hi)]); ssq[r] = 0.f; }
        if (hh == 0) {
#pragma unroll
            for (int d0 = 0; d0 < 4; ++d0)
#pragma unroll
                for (int r = 0; r < 16; r += 2) o1s[(d0 * 8 + (r >> 1)) * 64 + lane] = cvtpk(o[d0][r] * rli[r], o[d0][r + 1] * rli[r + 1]);
            __syncthreads();
        } else {
            asm volatile("" : "+s"(lamp)); const float lam = *lamp;
#pragma unroll
            for (int d0 = 0; d0 < 4; ++d0)
#pragma unroll
                for (int r = 0; r < 16; r += 2) { const unsigned w = o1s[(d0 * 8 + (r >> 1)) * 64 + lane];
                    const float a0 = bflo(w) - lam * (o[d0][r] * rli[r]), a1 = bfhi(w) - lam * (o[d0][r + 1] * rli[r + 1]);
                    o[d0][r] = a0; o[d0][r + 1] = a1; ssq[r] += a0 * a0; ssq[r + 1] += a1 * a1; }
        }
    }
#pragma unroll
    for (int r = 0; r < 16; ++r) { float s = ssq[r];
        s += __shfl_xor(s, 1); s += __shfl_xor(s, 2); s += __shfl_xor(s, 4); s += __shfl_xor(s, 8); s += __shfl_xor(s, 16);
        ssq[r] = 1.0f / sqrtf(s * (1.0f / 128.0f) + EPS) * (1.0f - LAMBDA_INIT); }
    asm volatile("s_waitcnt lgkmcnt(0)" ::: "memory");
    bf16* stg = (bf16*)o1s;
    asm volatile("" : "+s"(subln));
#pragma unroll
    for (int d0 = 0; d0 < 4; ++d0) { const float g = subln[d0 * 32 + r32];
#pragma unroll
        for (int r = 0; r < 16; ++r) stg[crow(r, hi) * 128 + d0 * 32 + r32] = (bf16)f2bf(o[d0][r] * ssq[r] * g); }
    asm volatile("s_waitcnt lgkmcnt(0)" ::: "memory");
    bf16* Ow = ao + (qrow0 + wid * 32) * D + hp * 128;
#pragma unroll
    for (int i = 0; i < 8; ++i) { const int row = i * 4 + (lane >> 4), ch = lane & 15; const u32x4 v = *(const u32x4*)(stg + row * 128 + ch * 8); *(u32x4*)(Ow + (size_t)row * D + ch * 8) = v; }
    asm volatile("s_waitcnt lgkmcnt(0)" ::: "memory");
    __syncthreads();
}
#undef ATT_SBAR
}

__device__ __forceinline__ void v8_prep(Frame& F) {
    const bf16* V1 = (const bf16*)(F.ws + WS_VH1); unsigned char* V8 = (unsigned char*)(F.ws + WS_V8);
    LAS bf16* buf = (LAS bf16*)(F.lds + F.wave * 16384);
    const int gw = F.vcu * NWAVES + F.wave, NGW = F.G * NWAVES, lane = F.lane;
    for (int it = gw; it < 8 * att::NVTILE; it += NGW) {
        const int hv = it / att::NVTILE, tile = it % att::NVTILE;
        const bf16* src = V1 + ((size_t)hv * MALL + (size_t)tile * 64) * 128;
#pragma unroll
        for (int i = 0; i < 16; ++i) *(LAS v4u*)(buf + i * 512 + lane * 8) = *(const GAS v4u*)(src + i * 512 + lane * 8);
        LDS_WAIT(); asm volatile("" ::: "memory");
        unsigned char* dst = V8 + (size_t)it * att::SHM_V;
#pragma unroll
        for (int cc = 0; cc < 2; ++cc) { const int n = lane + 64 * cc; const int sw = (n >> 2) & 3;
#pragma unroll
            for (int c = 0; c < 4; ++c) { const int kb = c >> 1, half = c & 1; v4u w;
#pragma unroll
                for (int q = 0; q < 4; ++q) { const int key0 = 32 * half + 8 * q + 4 * kb;
                    w[q] = pk4_fp8(bf2f(buf[(key0 + 0) * 128 + n]), bf2f(buf[(key0 + 1) * 128 + n]), bf2f(buf[(key0 + 2) * 128 + n]), bf2f(buf[(key0 + 3) * 128 + n])); }
                *(GAS v4u*)(dst + n * 64 + ((c ^ sw) << 4)) = w; } }
        LDS_WAIT(); asm volatile("" ::: "memory");
    }
}

template <int VAR> __device__ __forceinline__ void attn_phase(Frame& F, const Args& a, bf16* ao) {
    const bf16* Q1 = (const bf16*)(F.ws + WS_QH1); const bf16* K1 = (const bf16*)(F.ws + WS_KH1); const unsigned char* V1 = (const unsigned char*)(F.ws + WS_V8);
    const float* lamp = (const float*)(F.ws + WS_LAM);
    for (int unit = F.vcu; unit < NBATCH * 8 * 16; unit += F.G) {
        const int qb = unit & 15, hp = (unit >> 4) & 7, b = unit >> 7;
        att::attn_unit<VAR>(Q1, K1, V1, ao, b, hp, qb, (char*)F.lds, lamp, a.in[I_L1_SUBLN]);
    }
}


namespace ret {
using s16x4  = __attribute__((ext_vector_type(4))) short;
using f32x16 = __attribute__((ext_vector_type(16))) float;
typedef short v4i16_t __attribute__((ext_vector_type(4)));
constexpr int C = 32, NSTEP = (SEQ + CTXL) / C;
constexpr int ST_Q = 0, ST_K = 16384, ST_V = 32768, ST_SC = 40960, ST_BYTES = 43008, NSTAGE = 3;
constexpr int XBUF_OFF = NSTAGE * ST_BYTES, RET_LDS = XBUF_OFF + NWAVES * 4096;
constexpr size_t WS_SSQ = 836 * MiB;
constexpr size_t WS_SC = 842 * MiB;

__device__ __forceinline__ void glds16(const void* gsrc, unsigned lds_dst) { unsigned keep;
    asm volatile("s_mov_b32 %0, m0\n\ts_mov_b32 m0, %2\n\ts_nop 0\n\tglobal_load_lds_dwordx4 %1, off\n\ts_mov_b32 m0, %0" : "=&s"(keep) : "v"(gsrc), "s"(lds_dst) : "memory"); }
__device__ __forceinline__ s16x4 vtr(const LAS char* p) { return __builtin_bit_cast(s16x4, __builtin_amdgcn_ds_read_tr16_b64_v4i16((LAS v4i16_t*)p)); }

__device__ __forceinline__ void ret_scores(Frame& F) {
    const bf16* Qh = (const bf16*)(F.ws + WS_QH0); const bf16* Kh = (const bf16*)(F.ws + WS_KH0); bf16* sc = (bf16*)(F.ws + WS_SC);
    const int gw = F.vcu * NWAVES + F.wave, NGW = F.G * NWAVES;
    const int r32 = F.lane & 31, hh = F.lane >> 5;
    for (int task = gw; task < (MALL / C) * RH; task += NGW) {
        const int h = task & 3, ch = task >> 2;
        const bf16* qp = Qh + ((size_t)h * MALL + (size_t)ch * C + r32) * 256 + hh * 8;
        const bf16* kp = Kh + ((size_t)h * MALL + (size_t)ch * C + r32) * 256 + hh * 8;
        f32x16 acc = f32x16{};
        bf16x8 a[16], b[16];
#pragma unroll
        for (int s = 0; s < 16; ++s) { a[s] = *reinterpret_cast<const bf16x8*>(qp + s * 16); b[s] = *reinterpret_cast<const bf16x8*>(kp + s * 16); }
#pragma unroll
        for (int s = 0; s < 16; ++s) acc = __builtin_amdgcn_mfma_f32_32x32x16_bf16(a[s], b[s], acc, 0, 0, 0);
        bf16* tp = sc + (size_t)task * 1024;
#pragma unroll
        for (int r = 0; r < 16; ++r) { const int i = (r & 3) + 8 * (r >> 2) + 4 * hh; tp[i * 32 + r32] = (bf16)f2bf(acc[r]); }
    }
}

__device__ __forceinline__ size_t step_row0(int b, int dir, int t) {
    if (t < 8) { const int blk = dir ? 7 - t : t; return (size_t)NLAT + (size_t)b * CTXL + (size_t)blk * C; }
    const int blk = dir ? 127 - (t - 8) : (t - 8); return (size_t)b * SEQ + (size_t)blk * C;
}

template <int SV = 0> __device__ __forceinline__ void ret_scan(Frame& F, const Args& a) {
    const char* qb = (const char*)(F.ws + WS_QH0); const char* kb = (const char*)(F.ws + WS_KH0); const char* vb = (const char*)(F.ws + WS_VQ0); const char* scb = (const char*)(F.ws + WS_SC);
    for (int unit = F.vcu; unit < NBATCH * RH * 2 * 4; unit += F.G) {
        int tid_ = threadIdx.x; asm volatile("" : "+v"(tid_));
        const int tid = tid_, lane = tid & 63, w = __builtin_amdgcn_readfirstlane(tid >> 6), dh = w >> 2, vs = w & 3, r32 = lane & 31, hh = lane >> 5;
        const int vq = unit & 3, dir = (unit >> 2) & 1, h = (unit >> 3) & 3, b = unit >> 5;
        const float logit = a.in[I_L0_DECAY][dir * RH + h];
        const float lg2 = -__builtin_amdgcn_logf(1.0f + __builtin_amdgcn_exp2f(-logit * LOG2E));
        const float gC = __builtin_amdgcn_exp2f(lg2 * (float)C), gCi = __builtin_amdgcn_exp2f(-lg2 * (float)C);
        float kd[2][8];
#pragma unroll
        for (int s = 0; s < 2; ++s)
#pragma unroll
            for (int jj = 0; jj < 8; ++jj) { const int j = 16 * s + 8 * hh + jj; kd[s][jj] = __builtin_amdgcn_exp2f(lg2 * (float)(dir ? j : 31 - j)); }
        const int om = 4 * w + (lane >> 4);
        const float rsc = __builtin_amdgcn_exp2f(-lg2 * (float)(dir ? om : 31 - om));
        unsigned pm[4];
#pragma unroll
        for (int e = 0; e < 4; ++e) { const int j0 = 16 * dh + 8 * hh + 2 * e, j1 = j0 + 1; const bool k0 = dir ? (j0 >= r32) : (j0 <= r32), k1 = dir ? (j1 >= r32) : (j1 <= r32);
            pm[e] = (k0 ? 0x0000ffffu : 0u) | (k1 ? 0xffff0000u : 0u); }
        unsigned offq[2], offk[2];
#pragma unroll
        for (int p = 0; p < 2; ++p) { const int i = 2 * (2 * w + p) + (lane >> 5), cp = lane & 31;
            offq[p] = (unsigned)(i * 512 + ((cp ^ (i & 15)) << 4)); offk[p] = (unsigned)(i * 512 + ((cp ^ ((i & 3) << 2)) << 4)); }
        unsigned offv; { const int j = 4 * w + (lane >> 4), cp = lane & 15; offv = (unsigned)(j * 256 + ((cp ^ ((j & 3) << 2)) << 4)); }
        const char* qhb = qb + (size_t)h * MALL * 512; const char* khb = kb + (size_t)h * MALL * 512; const char* vhb = vb + (size_t)(h * 4 + vq) * MALL * 256;
        unsigned offs; { const int i = 16 * (w & 1) + (lane >> 2), cp = lane & 3; offs = (unsigned)(i * 64 + ((cp ^ ((i >> 2) & 3)) << 4)); }
        LAS unsigned char* L = F.lds;
        const unsigned lbase = (unsigned)(uintptr_t)L;
#define RET_ISSUE(t_) do { const int t__ = (t_); const unsigned sb_ = lbase + (unsigned)((t__ % NSTAGE) * ST_BYTES); const size_t r0_ = step_row0(b, dir, t__); const char* gq_ = qhb + r0_ * 512; const char* gk_ = khb + r0_ * 512; const char* gv_ = vhb + r0_ * 256; \
        glds16(gq_ + offq[0], (unsigned)__builtin_amdgcn_readfirstlane(sb_ + ST_Q + (2 * w) * 1024)); \
        glds16(gq_ + offq[1], (unsigned)__builtin_amdgcn_readfirstlane(sb_ + ST_Q + (2 * w + 1) * 1024)); \
        glds16(gk_ + offk[0], (unsigned)__builtin_amdgcn_readfirstlane(sb_ + ST_K + (2 * w) * 1024)); \
        glds16(gk_ + offk[1], (unsigned)__builtin_amdgcn_readfirstlane(sb_ + ST_K + (2 * w + 1) * 1024)); \
        glds16(gv_ + offv, (unsigned)__builtin_amdgcn_readfirstlane(sb_ + ST_V + w * 1024)); \
        if (w < 2) glds16(scb + ((r0_ >> 5) * 4 + h) * 2048 + offs, (unsigned)__builtin_amdgcn_readfirstlane(sb_ + ST_SC + w * 1024)); } while (0)
        const int qrow = ST_Q + r32 * 512; const int qx = r32 & 15;
        const int G = lane >> 4, il = lane & 15, tq = il >> 2, tp = il & 3;
        const int kcolb = (128 * dh + 16 * (G & 1) + 8 * (tp & 1) + 4 * (tp >> 1)) * 2;
        const int vcolb = (32 * vs + 16 * (G & 1) + 4 * tp) * 2;
        f32x16 S[4];
#pragma unroll
        for (int T = 0; T < 4; ++T) S[T] = f32x16{};
        float cinv = 1.0f, cfw = 1.0f;
        bf16* outp = (bf16*)(F.ws + (dir ? WS_OB : WS_OF));
        LAS float* xb_mine = (LAS float*)(L + XBUF_OFF + w * 4096);
        float* ssqp = (float*)(F.ws + WS_SSQ);

        __builtin_amdgcn_s_barrier();
        if (SV != 2 && SV != 3) { RET_ISSUE(0); RET_ISSUE(1); }
        for (int t = 0; t < NSTEP; ++t) {
            if (t == 0) { if (w < 2) asm volatile("s_waitcnt vmcnt(6)" ::: "memory"); else asm volatile("s_waitcnt vmcnt(5)" ::: "memory"); }
            else if (t == NSTEP - 1) asm volatile("s_waitcnt vmcnt(4)" ::: "memory");
            else        { if (w < 2) asm volatile("s_waitcnt vmcnt(8)" ::: "memory"); else asm volatile("s_waitcnt vmcnt(7)" ::: "memory"); }
            __builtin_amdgcn_s_barrier(); asm volatile("" ::: "memory");
            if (SV != 2 && SV != 3) { if (t + 2 < NSTEP) RET_ISSUE(t + 2); }
            const LAS char* sb = (const LAS char*)(L + (t % NSTAGE) * ST_BYTES);
            f32x16 acc = f32x16{};
            if (SV != 1 && SV != 3) {
            cinv *= gCi; cfw *= gC;
            bf16x8 vd[2];
#pragma unroll
            for (int s = 0; s < 2; ++s) {
                const int j0 = 16 * s + 8 * (G >> 1) + tq;
                const int cph = (((vcolb >> 4) ^ (tq << 2)) << 4) + (vcolb & 8);
                const s16x4 lo = vtr(sb + ST_V + j0 * 256 + cph), hi = vtr(sb + ST_V + (j0 + 4) * 256 + cph);
                float f[8];
#pragma unroll
                for (int e = 0; e < 4; ++e) { f[e] = bf2f((unsigned short)lo[e]) * (kd[s][e] * cinv); f[4 + e] = bf2f((unsigned short)hi[e]) * (kd[s][4 + e] * cinv); }
                v4u pk; pk.x = pk2(f[0], f[1]); pk.y = pk2(f[2], f[3]); pk.z = pk2(f[4], f[5]); pk.w = pk2(f[6], f[7]);
                vd[s] = __builtin_bit_cast(bf16x8, pk);
            }
#pragma unroll
            for (int T = 0; T < 4; ++T)
#pragma unroll
                for (int s = 0; s < 2; ++s) {
                    const int cL = 16 * dh + 4 * T + 2 * s + hh;
                    const bf16x8 qa = *(const LAS bf16x8*)(sb + qrow + ((cL ^ qx) << 4));
                    v4u pk; pk.x = pk2(S[T][8 * s + 0], S[T][8 * s + 1]); pk.y = pk2(S[T][8 * s + 2], S[T][8 * s + 3]); pk.z = pk2(S[T][8 * s + 4], S[T][8 * s + 5]); pk.w = pk2(S[T][8 * s + 6], S[T][8 * s + 7]);
                    acc = __builtin_amdgcn_mfma_f32_32x32x16_bf16(qa, __builtin_bit_cast(bf16x8, pk), acc, 0, 0, 0);
                }
            {
                const int cL = 2 * dh + hh;
                v4u pw = *(const LAS v4u*)(sb + ST_SC + r32 * 64 + ((cL ^ ((r32 >> 2) & 3)) << 4));
                pw.x &= pm[0]; pw.y &= pm[1]; pw.z &= pm[2]; pw.w &= pm[3];
                acc = __builtin_amdgcn_mfma_f32_32x32x16_bf16(__builtin_bit_cast(bf16x8, pw), dh ? vd[1] : vd[0], acc, 0, 0, 0);
            }
#pragma unroll
            for (int T = 0; T < 4; ++T)
#pragma unroll
                for (int s = 0; s < 2; ++s) {
                    const int j0 = 16 * s + 8 * (G >> 1) + tq;
                    const int cb = kcolb + 64 * T;
                    const int cph = (((cb >> 4) ^ (tq << 2)) << 4) + (cb & 8);
                    const s16x4 lo = vtr(sb + ST_K + j0 * 512 + cph), hi = vtr(sb + ST_K + (j0 + 4) * 512 + cph);
                    const bf16x8 ka = (bf16x8){lo[0], lo[1], lo[2], lo[3], hi[0], hi[1], hi[2], hi[3]};
                    S[T] = __builtin_amdgcn_mfma_f32_32x32x16_bf16(ka, vd[s], S[T], 0, 0, 0);
                }
            }
            if ((t & 7) == 7) {
#pragma unroll
                for (int T = 0; T < 4; ++T) S[T] = S[T] * cfw;
            }
#pragma unroll
            for (int r = 0; r < 16; ++r) xb_mine[r * 64 + lane] = acc[r];
            asm volatile("s_waitcnt lgkmcnt(0)" ::: "memory");
            __builtin_amdgcn_s_barrier(); asm volatile("" ::: "memory");
            {
                const int v0 = (lane & 15) * 8, svs = v0 >> 5, c32 = v0 & 31, rr = (om & 3) + 4 * (om >> 3), sh = (om >> 2) & 1;
                const LAS float* p0 = (const LAS float*)(L + XBUF_OFF + svs * 4096) + rr * 64 + sh * 32 + c32;
                const LAS float* p1 = (const LAS float*)(L + XBUF_OFF + (4 + svs) * 4096) + rr * 64 + sh * 32 + c32;
                const f32x4 a0 = *(const LAS f32x4*)p0, a1 = *(const LAS f32x4*)(p0 + 4), b0 = *(const LAS f32x4*)p1, b1 = *(const LAS f32x4*)(p1 + 4);
                const float rs_ = rsc * cfw; const f32x4 o0 = (a0 + b0) * rs_, o1 = (a1 + b1) * rs_;
                float ss = (o0.x * o0.x + o0.y * o0.y) + (o0.z * o0.z + o0.w * o0.w) + (o1.x * o1.x + o1.y * o1.y) + (o1.z * o1.z + o1.w * o1.w);
                ss += __shfl_xor(ss, 1); ss += __shfl_xor(ss, 2); ss += __shfl_xor(ss, 4); ss += __shfl_xor(ss, 8);
                const size_t r0 = step_row0(b, dir, t);
                v4u pk; pk.x = pk2(o0.x, o0.y); pk.y = pk2(o0.z, o0.w); pk.z = pk2(o1.x, o1.y); pk.w = pk2(o1.z, o1.w);
                *(GAS v4u*)(outp + (r0 + om) * 2048 + h * 512 + vq * 128 + v0) = pk;
                if ((lane & 15) == 0) ssqp[(((r0 + om) * RH + h) * 2 + dir) * 4 + vq] = ss;
            }
            asm volatile("s_waitcnt lgkmcnt(0)" ::: "memory");
            if ((t & 7) == 7) { cinv = 1.0f; cfw = 1.0f; }
        }
        asm volatile("s_waitcnt vmcnt(0)" ::: "memory");
#undef RET_ISSUE
    }
    __builtin_amdgcn_s_barrier();
}
}

__device__ __forceinline__ void moe_counts(Frame& F, int (&cnt)[NE]) {
#pragma unroll
    for (int e = 0; e < NE; ++e) cnt[e] = __builtin_amdgcn_readfirstlane((int)__hip_atomic_load((unsigned*)(F.ctl + CW_MOECNT + 64 * e), RLX_AGENT));
}
__device__ __forceinline__ void moe_gather(Frame& F) {
    int cnt[NE]; moe_counts(F, cnt);
    int base[NE]; int acc = 0;
#pragma unroll
    for (int e = 0; e < NE; ++e) { base[e] = acc; acc += (cnt[e] + 255) & ~255; }
    const int* te = (const int*)(F.ws + WS_ROUTE); int* tpos = (int*)(F.ws + WS_ROUTE + (size_t)NLAT * 8);
    const bf16* hb = (const bf16*)(F.ws + WS_H); bf16* hp = (bf16*)(F.ws + WS_HP);
    const int gw = F.vcu * NWAVES + F.wave, NGW = F.G * NWAVES;
    for (int r = gw; r < NLAT; r += NGW) {
        const int e0 = te[2 * r], e1 = te[2 * r + 1]; const int p0 = tpos[2 * r], p1 = tpos[2 * r + 1];
        int b0 = 0, b1 = 0;
#pragma unroll
        for (int e = 0; e < NE; ++e) { b0 = (e0 == e) ? base[e] : b0; b1 = (e1 == e) ? base[e] : b1; }
        const int s0 = b0 + p0, s1 = b1 + p1;
        const v4u x0 = *(const GAS v4u*)((const unsigned char*)hb + (size_t)r * D + F.lane * 16);
        *(GAS v4u*)((unsigned char*)hp + (size_t)s0 * D + F.lane * 16) = x0; *(GAS v4u*)((unsigned char*)hp + (size_t)s1 * D + F.lane * 16) = x0;
        if (F.lane == 0) { tpos[2 * r] = s0; tpos[2 * r + 1] = s1; }
    }
}
__device__ __forceinline__ void moe_order(Frame& F, pg8::MoeOrder& S, int nN) {
    int cnt[NE]; moe_counts(F, cnt);
    int ts[NE + 1]; ts[0] = 0;
#pragma unroll
    for (int e = 0; e < NE; ++e) ts[e + 1] = ts[e] + ((cnt[e] + 255) >> 8);
    S.nM = ts[NE]; S.nN = nN; S.nwg = S.nM * nN; S.G = F.G; S.c = F.cid;
    S.t1 = ts[1]; S.t2 = ts[2]; S.t3 = ts[3]; S.t4 = ts[4]; S.t5 = ts[5]; S.t6 = ts[6]; S.t7 = ts[7];
}

constexpr int N_PHASES = 22;
__global__ void __launch_bounds__(NTHREADS, 2) fwd(Args args) {
    extern __shared__ __attribute__((aligned(16))) unsigned char lds[];
    Frame F;
    F.lds = (LAS unsigned char*)lds; F.MISC = (volatile LAS unsigned*)(F.lds + MISC_OFF);
    F.tid = threadIdx.x; F.lane = F.tid & 63; F.wave = __builtin_amdgcn_readfirstlane(F.tid >> 6);
    F.G = gridDim.x; { const int bx = blockIdx.x; F.vcu = (F.G % 8 == 0) ? (bx % 8) * (F.G / 8) + bx / 8 : bx; F.cid = bx; }
    F.ws = args.ws; F.ctl = (gu32*)(args.ws + WS_CTL);
    for (int u = F.tid; u < 64; u += NTHREADS) ((LAS unsigned*)(F.lds + MISC_OFF))[u] = 0u;
    __syncthreads();
#if MK_PER_PHASE
    XcdBarrier bar; bar.bar = (unsigned*)(F.ctl + CW_BAR); bar.x = 0; bar.st = nullptr;
#define GRID_BAR() do { } while (0)
#else
    XcdBarrier bar = xcd_barrier_post((unsigned*)(F.ctl + CW_BAR), F.MISC + 8);
#define GRID_BAR() xcd_barrier(bar)
    if (F.tid == 0) { const unsigned x = xb_xcc_id(); F.MISC[16] = x; F.MISC[17] = __hip_atomic_fetch_add((unsigned*)(F.ctl + CW_XRANK + 64 * x), 1u, RLX_AGENT); }
#endif
    const int lo = args.ph_lo, hi = args.ph_hi;
#define IN(k) (lo <= (k) && (k) < hi)
#define SEAM(k) do { if (IN(k) && IN((k) + 1)) GRID_BAR(); } while (0)
    unsigned char* ws = args.ws;
    float* modv = (float*)(ws + WS_MODV);
    float* modv1 = modv + 9 * 6 * D;
    bf16* hbuf = (bf16*)(ws + WS_H);
    float* xctx = (float*)(ws + WS_XCTX);
    using pg8::Gemm; using pg8::StaticOrder;

    if (IN(0)) { for (int rep_ = 0; rep_ < ((PROBE_DUP & 1) ? 2 : 1); ++rep_) { p0_prologue(F, args); __syncthreads(); } SEAM(0); }
#if !MK_PER_PHASE
    if (IN(0) && IN(1)) {
        if (F.tid == 0) { const unsigned x = F.MISC[16]; unsigned pre = 0;
            for (unsigned j = 0; j < 16; ++j) { const unsigned c = __hip_atomic_load((unsigned*)(F.ctl + CW_XRANK + 64 * j), RLX_AGENT); pre += (j < x) ? c : 0u; }
            F.MISC[18] = pre + F.MISC[17]; }
        __syncthreads();
        F.vcu = __builtin_amdgcn_readfirstlane((int)F.MISC[18]); F.cid = (F.G % 8 == 0) ? (F.vcu % (F.G / 8)) * 8 + F.vcu / (F.G / 8) : F.vcu;
    }
#endif
    if (IN(1)) { RowPass P{MALL, args.in[I_X], args.in[I_CTX], nullptr, nullptr, nullptr, nullptr, nullptr, args.in[I_L0_NPREMIX], modv + 0 * D, modv + 1 * D, hbuf};
        row_pass<false, false, true, false>(F, args, P); SEAM(1); }
    if (IN(2)) { Gemm g{hbuf, (const bf16*)(ws + WS_W0IN), MALL, 4096, D, D}; StaticOrder S; S.init(MALL, 4096, F.G, F.cid);
        pg8::EpiQKV0 E{(bf16*)(ws + WS_QH0), (bf16*)(ws + WS_KH0), (bf16*)(ws + WS_VQ0), (const float*)(ws + WS_TAB0)};
        for (int rep_ = 0; rep_ < ((PROBE_DUP & 2) ? 2 : 1); ++rep_) { pg8::gemm_phase<pg8::EpiQKV0, StaticOrder, true, true>(F.lds, g, S, E); } if (IN(2) && IN(4)) GRID_BAR(); }
    if (IN(4)) { ret::ret_scores(F); SEAM(4); }
    if (IN(5)) { for (int rep_ = 0; rep_ < ((PROBE_DUP & 8) ? 2 : 1); ++rep_) ret::ret_scan<0>(F, args); SEAM(5); }
    if (IN(6)) { Gemm g{hbuf, (const bf16*)(ws + WS_W0IN) + (size_t)4096 * D, MALL, 4096, D, D}; StaticOrder S; S.init(MALL, 4096, F.G, F.cid);
        pg8::EpiGateMerge E{(bf16*)(ws + WS_OF), (const bf16*)(ws + WS_OB), (const float*)(ws + ret::WS_SSQ)};
        pg8::gemm_phase<pg8::EpiGateMerge, StaticOrder, true, true>(F.lds, g, S, E); if (IN(6) && IN(8)) GRID_BAR(); }
    if (IN(8)) { Gemm g{(const bf16*)(ws + WS_OF), (const bf16*)(ws + WS_W0OUT), MALL, D, 2048, 2048}; pg8::SplitOrder S; S.init(D, F.G, F.cid, USE_SPLITK ? 8 : 0, 4);
        pg8::EpiStoreSplit E{(bf16*)(ws + WS_A), D, (float*)(ws + WS_PART)};
        for (int rep_ = 0; rep_ < ((PROBE_DUP & 32) ? 2 : 1); ++rep_) { pg8::gemm_phase<pg8::EpiStoreSplit, pg8::SplitOrder, true, true>(F.lds, g, S, E); } SEAM(8); }
    if (IN(9)) { RowPass P{MALL, args.in[I_X], args.in[I_CTX], (float*)(ws + WS_X1), (float*)(ws + WS_X1C), (const bf16*)(ws + WS_A), args.in[I_L0_NPOSTMIX], modv + 2 * D, args.in[I_L0_NPREFFN], modv + 3 * D, modv + 4 * D, hbuf, (const float*)(ws + WS_PART)};
        row_pass<true, false, true, false, false, USE_SPLITK ? 8 : 0, false, true>(F, args, P); SEAM(9); }
    if (IN(10)) { Gemm g{hbuf, (const bf16*)(ws + WS_W0GU), MALL, 2 * DFF, D, D}; StaticOrder S; S.init(MALL, 2 * DFF, F.G, F.cid);
        pg8::EpiSwiglu E{(bf16*)(ws + WS_B), DFF};
        for (int rep_ = 0; rep_ < ((PROBE_DUP & 2) ? 2 : 1); ++rep_) { pg8::gemm_phase<pg8::EpiSwiglu, StaticOrder, true, true>(F.lds, g, S, E); } SEAM(10); }
    if (IN(11)) { Gemm g{(const bf16*)(ws + WS_B), (const bf16*)(ws + WS_W0DN), MALL, D, DFF, DFF}; pg8::SplitOrder S; S.init(D, F.G, F.cid, USE_SPLITK ? 11 : 0, 4);
        pg8::EpiStoreSplit E{(bf16*)(ws + WS_A), D, (float*)(ws + WS_PART)};
        for (int rep_ = 0; rep_ < ((PROBE_DUP & 32) ? 2 : 1); ++rep_) { pg8::gemm_phase<pg8::EpiStoreSplit, pg8::SplitOrder, true, true>(F.lds, g, S, E); } SEAM(11); }
    if (IN(12)) { RowPass P{MALL, (const float*)(ws + WS_X1), (const float*)(ws + WS_X1C), (float*)(ws + WS_X2), nullptr, (const bf16*)(ws + WS_A), args.in[I_L0_NPOSTFFN], modv + 5 * D, args.in[I_L1_NPREMIX], modv1 + 0 * D, modv1 + 1 * D, hbuf, (const float*)(ws + WS_PART)};
        row_pass<true, false, true, false, true, USE_SPLITK ? 11 : 0, true, true>(F, args, P); SEAM(12); }
    if (IN(13)) { Gemm g{hbuf, (const bf16*)(ws + WS_W1IN), MALL, 3072, D / 2, D / 2, MOE_SA, MOE_SB}; StaticOrder S; S.init(MALL, 3072, F.G, F.cid);
        pg8::EpiQKV1 E{(bf16*)(ws + WS_QH1), (bf16*)(ws + WS_KH1), (bf16*)(ws + WS_VH1), (const float*)(ws + WS_TAB1)};
        for (int rep_ = 0; rep_ < ((PROBE_DUP & 2) ? 2 : 1); ++rep_) { pg8::gemm_phase<pg8::EpiQKV1, StaticOrder, true, true, true>(F.lds, g, S, E); } SEAM(13); }
    if (IN(14)) { v8_prep(F); SEAM(14); }
    if (IN(15)) { attn_phase<0>(F, args, (bf16*)(ws + WS_B)); SEAM(15); }
    if (IN(16)) { Gemm g{(const bf16*)(ws + WS_B), (const bf16*)(ws + WS_W1OUT), NLAT, D, D, D}; StaticOrder S; S.init(NLAT, D, F.G, F.cid);
        pg8::EpiStore E{(bf16*)(ws + WS_A), D};
        for (int rep_ = 0; rep_ < ((PROBE_DUP & 2) ? 2 : 1); ++rep_) { pg8::gemm_phase<pg8::EpiStore, StaticOrder, true, true>(F.lds, g, S, E); } SEAM(16); }
    if (IN(17)) { RowPass P{NLAT, (const float*)(ws + WS_X2), nullptr, (float*)(ws + WS_X3), nullptr, (const bf16*)(ws + WS_A), args.in[I_L1_NPOSTMIX], modv1 + 2 * D, args.in[I_L1_NPREFFN], modv1 + 3 * D, modv1 + 4 * D, hbuf};
        row_pass<true, false, true, true, true, 0, true, true>(F, args, P); SEAM(17); }
    if (IN(18)) { moe_gather(F); SEAM(18); }
    if (IN(19)) { Gemm g{(const bf16*)(ws + WS_HP), (const bf16*)(ws + WS_WMGU), MOE_ROWS, 2 * DFE, D / 2, D / 2, MOE_SA, MOE_SB}; pg8::MoeOrder S; moe_order(F, S, 2 * DFE / 256);
        pg8::EpiSwiglu8 E{(unsigned char*)(ws + WS_ACT1), DFE};
        for (int rep_ = 0; rep_ < ((PROBE_DUP & 16) ? 2 : 1); ++rep_) { pg8::gemm_phase<pg8::EpiSwiglu8, pg8::MoeOrder, true, true, true>(F.lds, g, S, E); } SEAM(19); }
    if (IN(20)) { Gemm g{(const bf16*)(ws + WS_ACT1), (const bf16*)(ws + WS_WMDN), MOE_ROWS, D, DFE / 2, DFE / 2, MOE_SA, MOE_SB}; pg8::MoeOrder S; moe_order(F, S, D / 256);
        pg8::EpiStore E{(bf16*)(ws + WS_Y1), D};
        for (int rep_ = 0; rep_ < ((PROBE_DUP & 16) ? 2 : 1); ++rep_) { pg8::gemm_phase<pg8::EpiStore, pg8::MoeOrder, true, true, true>(F.lds, g, S, E); } SEAM(20); }
    if (IN(21)) { RowPass P{NLAT, (const float*)(ws + WS_X3), nullptr, args.out, nullptr, (const bf16*)(ws + WS_Y1), args.in[I_L1_NPOSTFFN], modv1 + 5 * D, nullptr, nullptr, nullptr, nullptr};
        row_pass<false, true, false, false, false, 0, true, false>(F, args, P); }
#undef IN
#undef SEAM
}

#ifndef PROBE_ATT
#define PROBE_ATT -1
#endif
#if PROBE_ATT >= 0
__global__ void __launch_bounds__(NTHREADS, 2) probe_k(Args args) {
    extern __shared__ __attribute__((aligned(16))) unsigned char lds[];
    Frame F;
    F.lds = (LAS unsigned char*)lds; F.MISC = (volatile LAS unsigned*)(F.lds + MISC_OFF);
    F.tid = threadIdx.x; F.lane = F.tid & 63; F.wave = __builtin_amdgcn_readfirstlane(F.tid >> 6);
    F.G = gridDim.x; { const int bx = blockIdx.x; F.vcu = (F.G % 8 == 0) ? (bx % 8) * (F.G / 8) + bx / 8 : bx; F.cid = bx; }
    F.ws = args.ws; F.ctl = (gu32*)(args.ws + WS_CTL);
#if PROBE_ATT < 10
    attn_phase<PROBE_ATT>(F, args, (bf16*)(args.ws + WS_END - 64 * MiB));
#else
    ret::ret_scan<PROBE_ATT - 10>(F, args);
#endif
}
#endif
extern "C" void kernel_launch(void* const* d_in, const int* in_sizes, int n_in, void* d_out, int out_size, void* d_ws, size_t ws_size, hipStream_t stream) {
    static int grid = 0;
    if (grid == 0) {
        if (n_in != N_IN || out_size != NLAT * D || ws_size < WS_END) { fprintf(stderr, "kernel_launch: unexpected shapes n_in %d out %d ws %zu\n", n_in, out_size, ws_size); grid = -1; return; }
        int dev = 0, cus = 0, per_cu = 0;
        if (hipGetDevice(&dev) != hipSuccess || hipDeviceGetAttribute(&cus, hipDeviceAttributeMultiprocessorCount, dev) != hipSuccess) { grid = -1; return; }
        if (hipFuncSetAttribute((const void*)fwd, hipFuncAttributeMaxDynamicSharedMemorySize, LDS_BYTES) != hipSuccess) { fprintf(stderr, "kernel_launch: hipFuncSetAttribute failed\n"); grid = -1; return; }
        if (hipOccupancyMaxActiveBlocksPerMultiprocessor(&per_cu, (const void*)fwd, NTHREADS, LDS_BYTES) != hipSuccess || per_cu < 1) fprintf(stderr, "kernel_launch: occupancy query says %d\n", per_cu);
        (void)hipGetLastError();
        grid = cus;
    }
    if (grid < 0) return;
    (void)hipMemsetAsync((char*)d_ws + WS_CTL, 0, CTL_ZERO_BYTES, stream);
    Args a{};
    for (int i = 0; i < N_IN; ++i) a.in[i] = (const float*)d_in[i];
    a.out = (float*)d_out; a.ws = (unsigned char*)d_ws;
#if MK_PER_PHASE
    for (int p = 0; p < N_PHASES; ++p) { a.ph_lo = p; a.ph_hi = p + 1; hipLaunchKernelGGL(fwd, dim3(grid), dim3(NTHREADS), LDS_BYTES, stream, a); }
#else
    a.ph_lo = 0; a.ph_hi = N_PHASES; hipLaunchKernelGGL(fwd, dim3(grid), dim3(NTHREADS), LDS_BYTES, stream, a);
#endif
#if PROBE_ATT >= 0
    (void)hipFuncSetAttribute((const void*)probe_k, hipFuncAttributeMaxDynamicSharedMemorySize, LDS_BYTES);
    hipLaunchKernelGGL(probe_k, dim3(grid), dim3(NTHREADS), LDS_BYTES, stream, a);
#endif
}
```

```cpp
#include <hip/hip_runtime.h>
#include <cstdio>
#include <cstdint>
namespace pg8 {
#define PG8_LAS __attribute__((address_space(3)))
typedef unsigned short bf16_t;
typedef short bf16x8 __attribute__((ext_vector_type(8)));
typedef float f32x4 __attribute__((ext_vector_type(4)));
typedef unsigned u32x4 __attribute__((ext_vector_type(4)));
constexpr int BM = 256, BK = 64, HALF = 128, HTB = HALF * BK * 2  , STAGE_BYTES = 8 * HTB, NXCD = 8, WGM = 8;

__host__ __device__ __forceinline__ int lds_byte(int r, int c) { const int st = (r >> 4) * 2 + (c >> 5), rr = r & 15, cc = c & 31, ob = rr * 64 + cc * 2; return st * 1024 + (ob ^ (((ob >> 9) & 1) << 5)); }
__host__ __device__ __forceinline__ void stage_rc(int b, int& R, int& C) { const int st = b / 1024, sb = b % 1024, swz = sb ^ (((sb >> 9) & 1) << 5); R = (st >> 1) * 16 + swz / 64; C = (st & 1) * 32 + (swz % 64) / 2; }
__host__ __device__ __forceinline__ int perm32(int rho) { const int n = rho >> 4, i = rho & 15; return 8 * (i >> 2) + 4 * n + (i & 3); }

struct Unit { int pm, pn, pc, k0, nt, ks; };
struct Gemm { const bf16_t* A; const bf16_t* Bt; int M, N, K, lda; int sA, sB; };

struct StaticOrder {
    int nM, nN, nwg, G, c;
    __host__ __device__ __forceinline__ void init(int M, int N, int G_, int c_) { nM = M / BM; nN = N / BM; nwg = nM * nN; G = G_; c = c_; }
    __host__ __device__ __forceinline__ bool next(int i, Unit& u) const {
        const long L = (long)i * G + c; if (L >= nwg) return false;
        int wgid = (int)L; { const int q = nwg / NXCD, r = nwg % NXCD, xcd = wgid % NXCD, off = wgid / NXCD; wgid = (xcd < r ? xcd * (q + 1) : r * (q + 1) + (xcd - r) * q) + off; }
        const int nig = WGM * nN, gid = wgid / nig, fm = gid * WGM, gsz = (nM - fm) < WGM ? (nM - fm) : WGM;
        u.pm = fm + ((wgid % nig) % gsz); u.pn = (wgid % nig) / gsz; u.pc = u.pn; u.k0 = 0; u.nt = 0; u.ks = -1; return true;
    }
    __device__ __forceinline__ void a_ready(const Unit&) const {}
    __device__ __forceinline__ void done(const Unit&) const {}
};

__device__ __forceinline__ unsigned cvt_pk_bf16(float lo, float hi) { unsigned r; asm volatile("v_cvt_pk_bf16_f32 %0, %1, %2" : "=v"(r) : "v"(lo), "v"(hi)); return r; }
typedef float f32x2 __attribute__((ext_vector_type(2)));
typedef int v4i_t __attribute__((ext_vector_type(4))); typedef int v8i_t __attribute__((ext_vector_type(8)));
template <class Epi, class Sched, bool ALIGN_EPI = false, bool SP2 = false, bool FP8 = false>
__device__ __forceinline__ void gemm_phase(PG8_LAS unsigned char* lds, const Gemm g, const Sched& S, const Epi& E) {
    const int tid = threadIdx.x, wid = __builtin_amdgcn_readfirstlane(tid >> 6), lane = tid & 63, wr = wid >> 2, wc = wid & 3, fr = lane & 15, fq = lane >> 4;
    const int K = g.K; int nt = K / BK;
    unsigned voffA[2], voffB[2];
#pragma unroll
    for (int i = 0; i < 2; ++i) { int R, C; stage_rc(tid * 16 + i * 8192, R, C); const int Rb = Epi::PERM ? ((R & ~31) + perm32(R & 31)) : R;
        voffA[i] = (unsigned)(R * g.lda + C) * 2u; voffB[i] = (unsigned)(Rb * K + C) * 2u; }
    const size_t kstep = (size_t)(BK * 2);
    const size_t hstepA = (size_t)HALF * g.lda * 2, hstepB = (size_t)HALF * K * 2;
    const size_t tstepA = 2 * hstepA, tstepB = 2 * hstepB;
    const unsigned ldsw = (unsigned)wid * 1024u;
    const int aoff = lds_byte(wr * 64 + fr, fq * 8), boff = lds_byte(wc * 32 + fr, fq * 8);
#define PG8_SA(b, h) (((b) * 2 + (h)) * HTB)
#define PG8_SB(b, h) ((4 + (b) * 2 + (h)) * HTB)
#define PG8_STAGE(bufoff, gbase, voff) do { _Pragma("unroll") for (int _i = 0; _i < 2; ++_i) \
        __builtin_amdgcn_global_load_lds((const unsigned*)((const char*)(gbase) + (voff)[_i]), (PG8_LAS unsigned*)(lds + (bufoff) + ldsw + _i * 8192), 16, 0, 0); } while (0)
#define PG8_LDA(dst, b, h) do { if constexpr (FP8) { _Pragma("unroll") for (int m = 0; m < 4; ++m) { const v4i_t lo_ = *(const PG8_LAS v4i_t*)(lds + PG8_SA(b, h) + aoff + m * 2048), hi_ = *(const PG8_LAS v4i_t*)(lds + PG8_SA(b, h) + aoff + m * 2048 + 1024); \
        dst##8[m] = __builtin_shufflevector(lo_, hi_, 0, 1, 2, 3, 4, 5, 6, 7); } } \
    else { _Pragma("unroll") for (int m = 0; m < 4; ++m) _Pragma("unroll") for (int k = 0; k < 2; ++k) dst[m][k] = *(const PG8_LAS bf16x8*)(lds + PG8_SA(b, h) + aoff + m * 2048 + k * 1024); } } while (0)
#define PG8_LDB(dst, b, h) do { if constexpr (FP8) { _Pragma("unroll") for (int n = 0; n < 2; ++n) { const v4i_t lo_ = *(const PG8_LAS v4i_t*)(lds + PG8_SB(b, h) + boff + n * 2048), hi_ = *(const PG8_LAS v4i_t*)(lds + PG8_SB(b, h) + boff + n * 2048 + 1024); \
        dst##8[n] = __builtin_shufflevector(lo_, hi_, 0, 1, 2, 3, 4, 5, 6, 7); } } \
    else { _Pragma("unroll") for (int n = 0; n < 2; ++n) _Pragma("unroll") for (int k = 0; k < 2; ++k) dst[n][k] = *(const PG8_LAS bf16x8*)(lds + PG8_SB(b, h) + boff + n * 2048 + k * 1024); } } while (0)
#define PG8_MMA(ai, bj, At, Bt) do { __builtin_amdgcn_s_setprio(1); _Pragma("unroll") for (int m = 0; m < 4; ++m) _Pragma("unroll") for (int n = 0; n < 2; ++n) { \
        if constexpr (FP8) { asm volatile("v_mfma_scale_f32_16x16x128_f8f6f4 %0, %1, %2, %0, %3, %4 op_sel_hi:[0,0,0]" : "+v"(acc[ai][bj][m][n]) : "v"(Bt##8[n]), "v"(At##8[m]), "v"(sB_), "v"(sA_)); } \
        else { _Pragma("unroll") for (int k = 0; k < 2; ++k) acc[ai][bj][m][n] = __builtin_amdgcn_mfma_f32_16x16x32_bf16(Bt[n][k], At[m][k], acc[ai][bj][m][n], 0, 0, 0); } } \
        __builtin_amdgcn_s_setprio(0); } while (0)
#define PG8_WAIT_V(n) asm volatile("s_waitcnt vmcnt(" #n ")" ::: "memory")
#define PG8_WAIT_L(n) asm volatile("s_waitcnt lgkmcnt(" #n ")" ::: "memory")
#define PG8_BAR __builtin_amdgcn_s_barrier()
#define PG8_SCHED __builtin_amdgcn_sched_barrier(0)
    Unit cur, nxt; int ui = 0;
    if (!S.next(0, cur)) return;
    const int sA_ = g.sA, sB_ = g.sB;
    f32x4 acc[2][2][4][2];
#pragma unroll
    for (int a = 0; a < 2; ++a)
#pragma unroll
        for (int b = 0; b < 2; ++b)
#pragma unroll
            for (int m = 0; m < 4; ++m)
#pragma unroll
                for (int n = 0; n < 2; ++n) acc[a][b][m][n] = (f32x4){0.f, 0.f, 0.f, 0.f};
    bf16x8 At[4][2], B0[2][2], B1[2][2]; v8i_t At8[4], B08[2], B18[2];
    if (cur.nt) nt = cur.nt;
    const char* cA = (const char*)g.A + (size_t)cur.pm * tstepA + (size_t)cur.k0 * 2; const char* cB = (const char*)g.Bt + (size_t)cur.pn * tstepB + (size_t)cur.k0 * 2;
    S.a_ready(cur);
    if constexpr (SP2) {
        PG8_STAGE(PG8_SB(0, 0), cB, voffB); PG8_STAGE(PG8_SB(0, 1), cB + hstepB, voffB); PG8_STAGE(PG8_SA(0, 0), cA, voffA); PG8_STAGE(PG8_SA(0, 1), cA + hstepA, voffA);
        if (wr == 1) PG8_BAR;
        PG8_WAIT_V(2); PG8_BAR;
        PG8_STAGE(PG8_SB(1, 0), cB + kstep, voffB); PG8_STAGE(PG8_SA(1, 0), cA + kstep, voffA); PG8_STAGE(PG8_SB(1, 1), cB + hstepB + kstep, voffB);
        PG8_WAIT_V(6); PG8_BAR;
    } else {
        PG8_STAGE(PG8_SB(0, 0), cB, voffB); PG8_STAGE(PG8_SA(0, 0), cA, voffA); PG8_STAGE(PG8_SB(0, 1), cB + hstepB, voffB); PG8_STAGE(PG8_SA(0, 1), cA + hstepA, voffA);
        if (wr == 1) PG8_BAR;
        PG8_WAIT_V(4); PG8_BAR;
        PG8_STAGE(PG8_SB(1, 0), cB + kstep, voffB); PG8_STAGE(PG8_SA(1, 0), cA + kstep, voffA); PG8_STAGE(PG8_SB(1, 1), cB + hstepB + kstep, voffB);
        PG8_WAIT_V(6); PG8_BAR;
    }
    for (;;) {
        const bool has_next = S.next(ui + 1, nxt);
        const char* nA = has_next ? (const char*)g.A + (size_t)nxt.pm * tstepA + (size_t)nxt.k0 * 2 : cA; const char* nB = has_next ? (const char*)g.Bt + (size_t)nxt.pn * tstepB + (size_t)nxt.k0 * 2 : cB;
#pragma unroll 1
        for (int t = 0; t < nt; t += 2) {
            const bool last = (t == nt - 2);
            const char* a1 = cA + (size_t)(t + 1) * kstep;
            const char* a2 = last ? nA : cA + (size_t)(t + 2) * kstep; const char* b2 = last ? nB : cB + (size_t)(t + 2) * kstep;
            const char* a3 = a2 + kstep; const char* b3 = b2 + kstep;
            if (last && has_next) S.a_ready(nxt);
            if constexpr (SP2) {
            PG8_LDB(B0, 0, 0); PG8_LDB(B1, 0, 1); PG8_SCHED; PG8_LDA(At, 0, 0); PG8_STAGE(PG8_SA(1, 1), a1 + hstepA, voffA);
            PG8_WAIT_V(8); PG8_WAIT_L(0); PG8_BAR; PG8_MMA(0, 0, At, B0); PG8_MMA(0, 1, At, B1); PG8_BAR; PG8_SCHED;
            PG8_LDA(At, 0, 1); PG8_STAGE(PG8_SB(0, 0), b2, voffB); PG8_STAGE(PG8_SB(0, 1), b2 + hstepB, voffB); PG8_STAGE(PG8_SA(0, 0), a2, voffA);
            PG8_WAIT_V(8); PG8_WAIT_L(0); PG8_BAR; PG8_MMA(1, 0, At, B0); PG8_MMA(1, 1, At, B1); PG8_BAR; PG8_SCHED;
            PG8_LDB(B0, 1, 0); PG8_LDB(B1, 1, 1); PG8_SCHED; PG8_LDA(At, 1, 0); PG8_STAGE(PG8_SA(0, 1), a2 + hstepA, voffA);
            PG8_WAIT_V(8); PG8_WAIT_L(0); PG8_BAR; PG8_MMA(0, 0, At, B0); PG8_MMA(0, 1, At, B1); PG8_BAR; PG8_SCHED;
            PG8_LDA(At, 1, 1); PG8_STAGE(PG8_SB(1, 0), b3, voffB); PG8_STAGE(PG8_SB(1, 1), b3 + hstepB, voffB); PG8_STAGE(PG8_SA(1, 0), a3, voffA);
            PG8_WAIT_V(8); PG8_WAIT_L(0); PG8_BAR; PG8_MMA(1, 0, At, B0); PG8_MMA(1, 1, At, B1); PG8_BAR; PG8_SCHED;
            } else {
            PG8_LDB(B0, 0, 0); PG8_SCHED; PG8_LDA(At, 0, 0); PG8_STAGE(PG8_SA(1, 1), a1 + hstepA, voffA);
            PG8_WAIT_L(8); PG8_BAR; PG8_WAIT_L(0); PG8_MMA(0, 0, At, B0); PG8_BAR; PG8_SCHED;
            PG8_LDB(B1, 0, 1); PG8_STAGE(PG8_SB(0, 0), b2, voffB);
            PG8_BAR; PG8_WAIT_L(0); PG8_MMA(0, 1, At, B1); PG8_BAR;
            PG8_LDA(At, 0, 1); PG8_STAGE(PG8_SA(0, 0), a2, voffA);
            PG8_BAR; PG8_WAIT_L(0); PG8_MMA(1, 0, At, B0); PG8_BAR; PG8_SCHED;
            PG8_STAGE(PG8_SB(0, 1), b2 + hstepB, voffB);
            PG8_WAIT_V(6); PG8_BAR; PG8_MMA(1, 1, At, B1); PG8_BAR;
            PG8_LDB(B0, 1, 0); PG8_SCHED; PG8_LDA(At, 1, 0); PG8_STAGE(PG8_SA(0, 1), a2 + hstepA, voffA);
            PG8_WAIT_L(8); PG8_BAR; PG8_WAIT_L(0); PG8_MMA(0, 0, At, B0); PG8_BAR; PG8_SCHED;
            PG8_LDB(B1, 1, 1); PG8_STAGE(PG8_SB(1, 0), b3, voffB);
            PG8_BAR; PG8_WAIT_L(0); PG8_MMA(0, 1, At, B1); PG8_BAR;
            PG8_LDA(At, 1, 1); PG8_STAGE(PG8_SA(1, 0), a3, voffA);
            PG8_BAR; PG8_WAIT_L(0); PG8_MMA(1, 0, At, B0); PG8_BAR; PG8_SCHED;
            PG8_STAGE(PG8_SB(1, 1), b3 + hstepB, voffB);
            PG8_WAIT_V(6); PG8_BAR; PG8_MMA(1, 1, At, B1); PG8_BAR;
            }
        }
        if constexpr (FP8) asm volatile("s_nop 15\n\ts_nop 15" ::: "memory");
        if constexpr (ALIGN_EPI) { if (wr == 0) PG8_BAR; }
        if constexpr (!Epi::AFTER_DRAIN) { E(acc, cur, wr, wc, fr, fq); S.done(cur); }
        if (!has_next) break;
#pragma unroll
        for (int a = 0; a < 2; ++a)
#pragma unroll
            for (int b = 0; b < 2; ++b)
#pragma unroll
                for (int m = 0; m < 4; ++m)
#pragma unroll
                    for (int n = 0; n < 2; ++n) acc[a][b][m][n] = (f32x4){0.f, 0.f, 0.f, 0.f};
        cur = nxt; cA = nA; cB = nB; ++ui; nt = cur.nt ? cur.nt : K / BK;
        if constexpr (ALIGN_EPI) { if (wr == 1) PG8_BAR; }
    }
    PG8_WAIT_V(0);
    if constexpr (!ALIGN_EPI) { if (wr == 0) PG8_BAR; }
    PG8_BAR;
    if constexpr (Epi::AFTER_DRAIN) { E.fused(acc, cur, wr, wc, fr, fq, lds, wid, lane); S.done(cur); }
#undef PG8_SA
#undef PG8_SB
#undef PG8_STAGE
#undef PG8_LDA
#undef PG8_LDB
#undef PG8_MMA
#undef PG8_WAIT_V
#undef PG8_WAIT_L
#undef PG8_BAR
#undef PG8_SCHED
}
}

#ifndef PROBE_DUP
#define PROBE_DUP 0
#endif
#ifndef USE_SPLITK
#define USE_SPLITK 0
#endif
#ifndef MK_PER_PHASE
#define MK_PER_PHASE 0
#endif
constexpr int D = 1024, NBATCH = 8, SEQ = 4096, NLAT = NBATCH * SEQ, CTXL = 256, NCTX = NBATCH * CTXL, MALL = NLAT + NCTX;
constexpr int RH = 4, RQK = 256, RV = 512;
constexpr int DFF = 2816, NE = 8, DFE = 3584;
constexpr float EPS = 1e-6f;
constexpr float LAMBDA_INIT = 0.3555090675909693f;
constexpr float LOG2E = 1.4426950408889634f;
constexpr int NWAVES = 8, NTHREADS = 512;
constexpr float MOE_WSCALE = 64.0f; constexpr int MOE_SB = 0x79797979, MOE_SA = 0x7f7f7f7f;
constexpr int MOE_ROWS = 2 * NLAT + NE * 256;

enum { I_X = 0, I_C, I_CTX, I_CCTX, I_L0_WMOD, I_L0_BMOD, I_L0_NPREMIX, I_L0_NPOSTMIX, I_L0_NPREFFN, I_L0_NPOSTFFN, I_L0_WIN, I_L0_DECAY, I_L0_WOUT, I_L0_WGU, I_L0_WDN,
       I_L1_WMOD, I_L1_BMOD, I_L1_NPREMIX, I_L1_NPOSTMIX, I_L1_NPREFFN, I_L1_NPOSTFFN, I_L1_WIN, I_L1_LAMBDA, I_L1_SUBLN, I_L1_WOUT, I_L1_RW, I_L1_RB, I_L1_MGU, I_L1_MDN, N_IN };

constexpr size_t MiB = 1u << 20;
constexpr size_t WS_CTL = 0, CTL_ZERO_BYTES = 1 * MiB;
constexpr size_t WS_MODV = 1 * MiB;
constexpr size_t WS_TAB0 = 1 * MiB + 512 * 1024;
constexpr size_t WS_TAB1 = WS_TAB0 + 32 * 1024;
constexpr size_t WS_LAM = WS_TAB1 + 8 * 1024;
constexpr size_t WS_ROUTE = 2 * MiB;
constexpr size_t WS_XCTX = 3 * MiB;
constexpr size_t WS_W0IN = 11 * MiB, WS_W0OUT = 27 * MiB, WS_W0GU = 31 * MiB, WS_W0DN = 42 * MiB, WS_W1IN = 48 * MiB, WS_W1OUT = 54 * MiB, WS_WMGU = 56 * MiB, WS_WMDN = 168 * MiB;
constexpr size_t WS_H = 224 * MiB;
constexpr size_t WS_A = 292 * MiB, WS_B = 564 * MiB;
constexpr size_t WS_OF = WS_B, WS_OB = WS_B + 136 * MiB;
constexpr size_t WS_QH0 = WS_A, WS_KH0 = WS_A + 68 * MiB, WS_VQ0 = WS_A + 136 * MiB;
constexpr size_t WS_QH1 = WS_A, WS_KH1 = WS_A + 68 * MiB, WS_VH1 = WS_A + 136 * MiB;
constexpr size_t WS_HP = WS_A, WS_ACT1 = 424 * MiB, WS_Y1 = WS_A;
constexpr size_t WS_V8 = 640 * MiB;
constexpr size_t WS_X1 = 360 * MiB, WS_X1C = 424 * MiB;
constexpr size_t WS_X2 = 496 * MiB;
constexpr size_t WS_X3 = 700 * MiB;
constexpr size_t WS_PART = WS_A + 136 * MiB;
constexpr size_t WS_END = 886 * MiB;
static_assert(WS_ACT1 + (size_t)MOE_ROWS * DFE * 2 <= WS_END, "ws map");
static_assert(WS_HP + (size_t)MOE_ROWS * D * 2 <= WS_ACT1, "ws map");
constexpr int CW_TMO = 0;
constexpr int CW_BAR = 4096;
constexpr int CW_XRANK = 12288;
constexpr int CW_MOECNT = 16384;

constexpr int RING_BYTES = 131072;
constexpr int LDS_BYTES = 163840;
constexpr int MISC_OFF = LDS_BYTES - 256;

#define GAS __attribute__((address_space(1)))
#define LAS __attribute__((address_space(3)))
typedef unsigned short bf16;
typedef unsigned v4u __attribute__((ext_vector_type(4)));
typedef unsigned v2u __attribute__((ext_vector_type(2)));
typedef float f32x4 __attribute__((ext_vector_type(4)));
typedef float f32x2 __attribute__((ext_vector_type(2)));
typedef short bf16x8 __attribute__((ext_vector_type(8)));
typedef GAS unsigned gu32;
#define RLX_AGENT __ATOMIC_RELAXED, __HIP_MEMORY_SCOPE_AGENT
#define LDS_WAIT() asm volatile("s_waitcnt lgkmcnt(0)" ::: "memory")
#define VM_WAIT() asm volatile("s_waitcnt vmcnt(0)" ::: "memory")
__device__ __forceinline__ unsigned pk2(float lo, float hi);
__device__ __forceinline__ unsigned f2bf(float f) { return pk2(f, 0.f) & 0xffffu; }
typedef float f32x2_cv __attribute__((ext_vector_type(2))); typedef __bf16 bf16x2_cv __attribute__((ext_vector_type(2)));
__device__ __forceinline__ unsigned pk2(float lo, float hi) { f32x2_cv v = {lo, hi}; bf16x2_cv b = __builtin_convertvector(v, bf16x2_cv); return __builtin_bit_cast(unsigned, b); }
__device__ __forceinline__ float bf2f(unsigned b) { return __builtin_bit_cast(float, b << 16); }
__device__ __forceinline__ float bflo(unsigned w) { return __builtin_bit_cast(float, w << 16); }
__device__ __forceinline__ float bfhi(unsigned w) { return __builtin_bit_cast(float, w & 0xffff0000u); }
__device__ __forceinline__ unsigned pk4_fp8(float a, float b, float c, float d) {
    a = __builtin_amdgcn_fmed3f(a, -448.f, 448.f); b = __builtin_amdgcn_fmed3f(b, -448.f, 448.f); c = __builtin_amdgcn_fmed3f(c, -448.f, 448.f); d = __builtin_amdgcn_fmed3f(d, -448.f, 448.f);
    int w = 0; w = __builtin_amdgcn_cvt_pk_fp8_f32(a, b, w, false); w = __builtin_amdgcn_cvt_pk_fp8_f32(c, d, w, true); return (unsigned)w; }
__device__ __forceinline__ float fast_exp2(float x) { return __builtin_amdgcn_exp2f(x); }
__device__ __forceinline__ float silu_f(float g) { return g * __builtin_amdgcn_rcpf(1.0f + __builtin_amdgcn_exp2f(-g * LOG2E)); }
__device__ __forceinline__ float wave_sum(float v) {
#pragma unroll
    for (int o = 1; o < 64; o <<= 1) v += __shfl_xor(v, o);
    return v;
}

#define XB_TMO      128
#define XB_XCNT(j)  (256  + 64 * (j))
#define XB_XSUB(j)  (1280 + 64 * (j))
#define XB_XGEN(j)  (2304 + 64 * (j))
#define XB_TOP      3328
#define XB_TOPGEN   3392
#define XCD_BAR_WORDS 3456
#define XB_SPIN_CAP (1u << 24)

__device__ __forceinline__ unsigned xb_ld(unsigned* p)              { return __hip_atomic_load(p, __ATOMIC_RELAXED, __HIP_MEMORY_SCOPE_AGENT); }
__device__ __forceinline__ unsigned xb_add(unsigned* p, unsigned v) { return __hip_atomic_fetch_add(p, v, __ATOMIC_RELAXED, __HIP_MEMORY_SCOPE_AGENT); }
__device__ __forceinline__ unsigned xb_xcc_id() { return (unsigned)__builtin_amdgcn_s_getreg((3 << 11) | 20) & 0xFu; }
#define XB_SPIN(cond, bar) do { unsigned _sp = 0; while (cond) { __builtin_amdgcn_s_sleep(1); \
    if ((++_sp & 255u) == 0u) { if (xb_ld(&(bar)[XB_TMO])) break; if (_sp > XB_SPIN_CAP) { atomicAdd(&(bar)[XB_TMO], 1u); break; } } } } while (0)

struct XcdBarrier {
    unsigned* bar; unsigned x;
    volatile LAS unsigned* st;
};

__device__ __forceinline__ XcdBarrier xcd_barrier_post(unsigned* bar, volatile LAS unsigned* st) {
    XcdBarrier b; b.bar = bar; b.x = xb_xcc_id(); b.st = st;
    if (threadIdx.x == 0) (void)xb_add(&bar[XB_XCNT(b.x)], 1u);
    return b;
}
__device__ __forceinline__ void xcd_barrier_complete(unsigned* bar, unsigned x, unsigned& nloc, unsigned& nx) {
    const unsigned G = gridDim.x * gridDim.y * gridDim.z;
    unsigned sum, cnt, mine, sp = 0u;
    for (;;) {
        sum = 0u; cnt = 0u; mine = 0u;
#pragma unroll
        for (unsigned j = 0; j < 16; ++j) { const unsigned c = xb_ld(&bar[XB_XCNT(j)]); sum += c; cnt += (c > 0u) ? 1u : 0u; mine = (j == x) ? c : mine; }
        if (sum == G) break;
        __builtin_amdgcn_s_sleep(1);
        if ((++sp & 255u) == 0u) { if (xb_ld(&bar[XB_TMO])) break; if (sp > XB_SPIN_CAP) { atomicAdd(&bar[XB_TMO], 1u); break; } }
    }
    nloc = mine > 0u ? mine : 1u; nx = cnt > 0u ? cnt : 1u;
}

__device__ __forceinline__ void xcd_barrier(const XcdBarrier& b) {
    asm volatile("s_waitcnt vmcnt(0)" ::: "memory");
    __syncthreads();
    if (threadIdx.x == 0) {
        unsigned* bar = b.bar;
        __builtin_amdgcn_s_waitcnt(0);
        unsigned nloc = b.st[0], nx = b.st[1];
        if (nloc == 0u) { xcd_barrier_complete(bar, b.x, nloc, nx); b.st[0] = nloc; b.st[1] = nx; }
        const unsigned old = xb_add(&bar[XB_XSUB(b.x)], 1u);
        const unsigned gen = old / nloc;
        if (old + 1u == (gen + 1u) * nloc) {
            __builtin_amdgcn_fence(__ATOMIC_RELEASE, "agent");
            asm volatile("s_waitcnt vmcnt(0)" ::: "memory");
            const unsigned og = xb_add(&bar[XB_TOP], 1u);
            const unsigned tg = og / nx;
            if (og + 1u == (tg + 1u) * nx) xb_add(&bar[XB_TOPGEN], 1u);
            else XB_SPIN(xb_ld(&bar[XB_TOPGEN]) == tg, bar);
            __builtin_amdgcn_fence(__ATOMIC_ACQUIRE, "agent");
            xb_add(&bar[XB_XGEN(b.x)], 1u);
            asm volatile("s_waitcnt vmcnt(0)" ::: "memory");
        } else {
            XB_SPIN(xb_ld(&bar[XB_XGEN(b.x)]) == gen, bar);
            __builtin_amdgcn_fence(__ATOMIC_ACQUIRE, "agent");
            asm volatile("s_waitcnt vmcnt(0)" ::: "memory");
        }
    }
    __syncthreads();
}


struct Args { const float* in[N_IN]; float* out; unsigned char* ws; int ph_lo, ph_hi; };

struct Frame {
    LAS unsigned char* lds;
    volatile LAS unsigned* MISC;
    gu32* ctl;
    int tid, lane, wave, vcu, G, cid;
    unsigned char* ws;
};

namespace pg8 {
struct EpiStore {
    static constexpr bool PERM = true, AFTER_DRAIN = false;
    bf16_t* O; int ldc;
    __device__ __forceinline__ void operator()(const f32x4 (&acc)[2][2][4][2], const Unit& u, int wr, int wc, int fr, int fq) const {
        const int row0 = u.pm * BM + wr * 64 + fr; const int col0 = u.pc * BM + wc * 32 + 8 * fq;
#pragma unroll
        for (int ai = 0; ai < 2; ++ai)
#pragma unroll
            for (int m = 0; m < 4; ++m) { bf16_t* rowp = O + (size_t)(row0 + ai * HALF + m * 16) * ldc + col0;
#pragma unroll
                for (int bj = 0; bj < 2; ++bj) { const f32x4 v0 = acc[ai][bj][m][0], v1 = acc[ai][bj][m][1];
                    u32x4 w; w.x = cvt_pk_bf16(v0[0], v0[1]); w.y = cvt_pk_bf16(v0[2], v0[3]); w.z = cvt_pk_bf16(v1[0], v1[1]); w.w = cvt_pk_bf16(v1[2], v1[3]);
                    *(u32x4*)(rowp + bj * HALF) = w; } }
    }
};
struct EpiSwiglu {
    static constexpr bool PERM = true, AFTER_DRAIN = false;
    bf16_t* O; int ldc;
    __device__ __forceinline__ void operator()(const f32x4 (&acc)[2][2][4][2], const Unit& u, int wr, int wc, int fr, int fq) const {
        const int row0 = u.pm * BM + wr * 64 + fr; const int col0 = u.pc * HALF + wc * 32 + 8 * fq;
#pragma unroll
        for (int ai = 0; ai < 2; ++ai)
#pragma unroll
            for (int m = 0; m < 4; ++m) { bf16_t* rowp = O + (size_t)(row0 + ai * HALF + m * 16) * ldc + col0;
                f32x4 a0, a1;
#pragma unroll
                for (int e = 0; e < 4; ++e) { a0[e] = silu_f(acc[ai][0][m][0][e]) * acc[ai][1][m][0][e]; a1[e] = silu_f(acc[ai][0][m][1][e]) * acc[ai][1][m][1][e]; }
                u32x4 w; w.x = cvt_pk_bf16(a0[0], a0[1]); w.y = cvt_pk_bf16(a0[2], a0[3]); w.z = cvt_pk_bf16(a1[0], a1[1]); w.w = cvt_pk_bf16(a1[2], a1[3]);
                *(u32x4*)rowp = w; }
    }
};

struct EpiQKV0 {
    static constexpr bool PERM = true, AFTER_DRAIN = false;
    bf16_t* Qh; bf16_t* Kh; bf16_t* Vq; const float* tab;
    __device__ __forceinline__ void operator()(const f32x4 (&acc)[2][2][4][2], const Unit& u, int wr, int wc, int fr, int fq) const {
        const int row0 = u.pm * BM + wr * 64 + fr, pc = u.pc;
        if (pc < 8) {
            bf16_t* base = pc < 4 ? Qh + (size_t)pc * MALL * 256 : Kh + (size_t)(pc - 4) * MALL * 256; const float sc = pc < 4 ? 1.0f : 0.0625f; const bool lat = u.pm < NLAT / BM;
            const int col0 = wc * 32 + 8 * fq;
#pragma unroll
            for (int ai = 0; ai < 2; ++ai)
#pragma unroll
                for (int m = 0; m < 4; ++m) { const int row = row0 + ai * HALF + m * 16, t = row & (SEQ - 1);
#pragma unroll
                    for (int bj = 0; bj < 2; ++bj) { f32x4 v0 = acc[ai][bj][m][0], v1 = acc[ai][bj][m][1];
                        if (lat) { const int pos = bj ? (t & 63) : (t >> 6); const float* tp = tab + (size_t)(pos * 64 + 16 * wc + 4 * fq) * 2;
                            const f32x4 c0 = *(const f32x4*)tp, c1 = *(const f32x4*)(tp + 4);
                            v0 = (f32x4){v0[0] * c0[0] - v0[1] * c0[1], v0[1] * c0[0] + v0[0] * c0[1], v0[2] * c0[2] - v0[3] * c0[3], v0[3] * c0[2] + v0[2] * c0[3]};
                            v1 = (f32x4){v1[0] * c1[0] - v1[1] * c1[1], v1[1] * c1[0] + v1[0] * c1[1], v1[2] * c1[2] - v1[3] * c1[3], v1[3] * c1[2] + v1[2] * c1[3]}; }
                        v0 = v0 * sc; v1 = v1 * sc;
                        u32x4 w; w.x = cvt_pk_bf16(v0[0], v0[1]); w.y = cvt_pk_bf16(v0[2], v0[3]); w.z = cvt_pk_bf16(v1[0], v1[1]); w.w = cvt_pk_bf16(v1[2], v1[3]);
                        *(u32x4*)(base + (size_t)row * 256 + col0 + bj * HALF) = w; } }
        } else {
#pragma unroll
            for (int ai = 0; ai < 2; ++ai)
#pragma unroll
                for (int m = 0; m < 4; ++m) { const int row = row0 + ai * HALF + m * 16;
#pragma unroll
                    for (int bj = 0; bj < 2; ++bj) { const f32x4 v0 = acc[ai][bj][m][0], v1 = acc[ai][bj][m][1];
                        u32x4 w; w.x = cvt_pk_bf16(v0[0], v0[1]); w.y = cvt_pk_bf16(v0[2], v0[3]); w.z = cvt_pk_bf16(v1[0], v1[1]); w.w = cvt_pk_bf16(v1[2], v1[3]);
                        *(u32x4*)(Vq + ((size_t)((pc - 8) * 2 + bj) * MALL + row) * 128 + wc * 32 + 8 * fq) = w; } }
        }
    }
};
struct EpiQKV1 {
    static constexpr bool PERM = true, AFTER_DRAIN = false;
    bf16_t* Qh; bf16_t* Kh; bf16_t* Vh; const float* tab;
    __device__ __forceinline__ void operator()(const f32x4 (&acc)[2][2][4][2], const Unit& u, int wr, int wc, int fr, int fq) const {
        const int row0 = u.pm * BM + wr * 64 + fr, pc = u.pc;
        if (pc < 8) {
            bf16_t* base = pc < 4 ? Qh : Kh; const float sc = pc < 4 ? 0.125f * LOG2E : 1.0f; const bool lat = u.pm < NLAT / BM;
            const int hf = wc & 1, p0 = 32 * hf + 8 * fq;
#pragma unroll
            for (int ai = 0; ai < 2; ++ai)
#pragma unroll
                for (int m = 0; m < 4; ++m) { const int row = row0 + ai * HALF + m * 16, t = row & (SEQ - 1);
                    const int pos = hf ? (t & 63) : (t >> 6); const float* tp = tab + (size_t)(pos * 16 + 4 * fq) * 2;
                    f32x4 c0 = (f32x4){1.f, 0.f, 1.f, 0.f}, c1 = c0;
                    if (lat) { c0 = *(const f32x4*)tp; c1 = *(const f32x4*)(tp + 4); }
#pragma unroll
                    for (int bj = 0; bj < 2; ++bj) { f32x4 v0 = acc[ai][bj][m][0], v1 = acc[ai][bj][m][1];
                        v0 = (f32x4){v0[0] * c0[0] - v0[1] * c0[1], v0[1] * c0[0] + v0[0] * c0[1], v0[2] * c0[2] - v0[3] * c0[3], v0[3] * c0[2] + v0[2] * c0[3]};
                        v1 = (f32x4){v1[0] * c1[0] - v1[1] * c1[1], v1[1] * c1[0] + v1[0] * c1[1], v1[2] * c1[2] - v1[3] * c1[3], v1[3] * c1[2] + v1[2] * c1[3]};
                        v0 = v0 * sc; v1 = v1 * sc;
                        const int head = (pc & 3) * 4 + 2 * bj + (wc >> 1);
                        u32x4 w; w.x = cvt_pk_bf16(v0[0], v0[1]); w.y = cvt_pk_bf16(v0[2], v0[3]); w.z = cvt_pk_bf16(v1[0], v1[1]); w.w = cvt_pk_bf16(v1[2], v1[3]);
                        *(u32x4*)(base + ((size_t)head * MALL + row) * 64 + p0) = w; } }
        } else {
#pragma unroll
            for (int ai = 0; ai < 2; ++ai)
#pragma unroll
                for (int m = 0; m < 4; ++m) { const int row = row0 + ai * HALF + m * 16;
#pragma unroll
                    for (int bj = 0; bj < 2; ++bj) { const f32x4 v0 = acc[ai][bj][m][0], v1 = acc[ai][bj][m][1];
                        u32x4 w; w.x = cvt_pk_bf16(v0[0], v0[1]); w.y = cvt_pk_bf16(v0[2], v0[3]); w.z = cvt_pk_bf16(v1[0], v1[1]); w.w = cvt_pk_bf16(v1[2], v1[3]);
                        *(u32x4*)(Vh + ((size_t)((pc - 8) * 2 + bj) * MALL + row) * 128 + wc * 32 + 8 * fq) = w; } }
        }
    }
};

struct EpiGateMerge {
    static constexpr bool PERM = true, AFTER_DRAIN = false;
    bf16_t* Of; const bf16_t* Ob; const float* ssq;
    __device__ __forceinline__ void operator()(const f32x4 (&acc)[2][2][4][2], const Unit& u, int wr, int wc, int fr, int fq) const {
        const int row0 = u.pm * BM + wr * 64 + fr; const int col0 = u.pc * HALF + wc * 32 + 8 * fq; const int head = u.pc >> 2;
#pragma unroll
        for (int ai = 0; ai < 2; ++ai)
#pragma unroll
            for (int m = 0; m < 4; ++m) { const size_t row = (size_t)(row0 + ai * HALF + m * 16);
                const f32x4 sf = *(const f32x4*)(ssq + (row * RH + head) * 8), sb = *(const f32x4*)(ssq + (row * RH + head) * 8 + 4);
                const float rf = __builtin_amdgcn_rsqf(((sf[0] + sf[1]) + (sf[2] + sf[3])) * (1.0f / RV) + EPS), rb = __builtin_amdgcn_rsqf(((sb[0] + sb[1]) + (sb[2] + sb[3])) * (1.0f / RV) + EPS);
                const u32x4 of = *(const u32x4*)(Of + row * 2048 + col0), ob = *(const u32x4*)(Ob + row * 2048 + col0);
                float y[8];
#pragma unroll
                for (int e = 0; e < 4; ++e) {
                    const float gf0 = acc[ai][0][m][e >> 1][2 * (e & 1)], gf1 = acc[ai][0][m][e >> 1][2 * (e & 1) + 1], gb0 = acc[ai][1][m][e >> 1][2 * (e & 1)], gb1 = acc[ai][1][m][e >> 1][2 * (e & 1) + 1];
                    y[2 * e] = silu_f(gf0) * (bflo(of[e]) * rf) + silu_f(gb0) * (bflo(ob[e]) * rb);
                    y[2 * e + 1] = silu_f(gf1) * (bfhi(of[e]) * rf) + silu_f(gb1) * (bfhi(ob[e]) * rb); }
                u32x4 w; w.x = cvt_pk_bf16(y[0], y[1]); w.y = cvt_pk_bf16(y[2], y[3]); w.z = cvt_pk_bf16(y[4], y[5]); w.w = cvt_pk_bf16(y[6], y[7]);
                *(u32x4*)(Of + row * 2048 + col0) = w; }
    }
};

struct SplitOrder {
    StaticOrder lat; int G, c, KS, ntS, nN, nl;
    __device__ __forceinline__ void init(int N, int G_, int c_, int KS_, int ntS_) { lat.init(KS_ ? NLAT : MALL, N, G_, c_); G = G_; c = c_; KS = KS_; ntS = ntS_; nN = N / BM; nl = (lat.nwg > c_) ? (lat.nwg - 1 - c_) / G_ + 1 : 0; }
    __device__ __forceinline__ bool next(int i, Unit& u) const {
        if (i < nl) return lat.next(i, u);
        const long j = (long)(i - nl) * G + c; if (j >= (long)(NCTX / BM) * nN * KS) return false;
        const int tile = (int)(j / KS), ks = (int)(j % KS);
        u.pm = NLAT / BM + tile / nN; u.pn = tile % nN; u.pc = u.pn; u.k0 = ks * ntS * BK; u.nt = ntS; u.ks = ks; return true;
    }
    __device__ __forceinline__ void a_ready(const Unit&) const {}
    __device__ __forceinline__ void done(const Unit&) const {}
};
struct EpiStoreSplit {
    static constexpr bool PERM = true, AFTER_DRAIN = false;
    bf16_t* O; int ldc; float* P;
    __device__ __forceinline__ void operator()(const f32x4 (&acc)[2][2][4][2], const Unit& u, int wr, int wc, int fr, int fq) const {
        const int row0 = u.pm * BM + wr * 64 + fr; const int col0 = u.pc * BM + wc * 32 + 8 * fq;
        if (u.ks < 0) {
#pragma unroll
            for (int ai = 0; ai < 2; ++ai)
#pragma unroll
                for (int m = 0; m < 4; ++m) { bf16_t* rowp = O + (size_t)(row0 + ai * HALF + m * 16) * ldc + col0;
#pragma unroll
                    for (int bj = 0; bj < 2; ++bj) { const f32x4 v0 = acc[ai][bj][m][0], v1 = acc[ai][bj][m][1];
                        u32x4 w; w.x = cvt_pk_bf16(v0[0], v0[1]); w.y = cvt_pk_bf16(v0[2], v0[3]); w.z = cvt_pk_bf16(v1[0], v1[1]); w.w = cvt_pk_bf16(v1[2], v1[3]);
                        *(u32x4*)(rowp + bj * HALF) = w; } }
        } else {
            float* pb = P + (size_t)u.ks * NCTX * ldc;
#pragma unroll
            for (int ai = 0; ai < 2; ++ai)
#pragma unroll
                for (int m = 0; m < 4; ++m) { float* rowp = pb + (size_t)(row0 - NLAT + ai * HALF + m * 16) * ldc + col0;
#pragma unroll
                    for (int bj = 0; bj < 2; ++bj) { *(f32x4*)(rowp + bj * HALF) = acc[ai][bj][m][0]; *(f32x4*)(rowp + bj * HALF + 4) = acc[ai][bj][m][1]; } }
        }
    }
};
struct EpiSwiglu8 {
    static constexpr bool PERM = true, AFTER_DRAIN = false;
    unsigned char* O; int ldc;
    __device__ __forceinline__ void operator()(const f32x4 (&acc)[2][2][4][2], const Unit& u, int wr, int wc, int fr, int fq) const {
        const int row0 = u.pm * BM + wr * 64 + fr; const int col0 = u.pc * HALF + wc * 32 + 8 * fq;
#pragma unroll
        for (int ai = 0; ai < 2; ++ai)
#pragma unroll
            for (int m = 0; m < 4; ++m) { unsigned char* rowp = O + (size_t)(row0 + ai * HALF + m * 16) * ldc + col0;
                f32x4 a0, a1;
#pragma unroll
                for (int e = 0; e < 4; ++e) { a0[e] = silu_f(acc[ai][0][m][0][e]) * acc[ai][1][m][0][e]; a1[e] = silu_f(acc[ai][0][m][1][e]) * acc[ai][1][m][1][e]; }
                v2u w; w.x = pk4_fp8(a0[0], a0[1], a0[2], a0[3]); w.y = pk4_fp8(a1[0], a1[1], a1[2], a1[3]);
                *(v2u*)rowp = w; }
    }
};
struct MoeOrder {
    int nM, nN, nwg, G, c; int t1, t2, t3, t4, t5, t6, t7;
    __device__ __forceinline__ bool next(int i, Unit& u) const {
        const long L = (long)i * G + c; if (L >= nwg) return false;
        int wgid = (int)L; { const int q = nwg / NXCD, r = nwg % NXCD, xcd = wgid % NXCD, off = wgid / NXCD; wgid = (xcd < r ? xcd * (q + 1) : r * (q + 1) + (xcd - r) * q) + off; }
        const int nig = WGM * nN, gid = wgid / nig, fm = gid * WGM, gsz = (nM - fm) < WGM ? (nM - fm) : WGM;
        u.pm = fm + ((wgid % nig) % gsz); u.pc = (wgid % nig) / gsz;
        const int e = (u.pm >= t1) + (u.pm >= t2) + (u.pm >= t3) + (u.pm >= t4) + (u.pm >= t5) + (u.pm >= t6) + (u.pm >= t7);
        u.pn = e * nN + u.pc; u.k0 = 0; u.nt = 0; u.ks = -1; return true;
    }
    __device__ __forceinline__ void a_ready(const Unit&) const {}
    __device__ __forceinline__ void done(const Unit&) const {}
};
}

__device__ __forceinline__ int swiglu_row(int n, int F) { const int bj = n / F, w = n % F; return 256 * (w >> 7) + 128 * bj + (w & 127); }
__device__ __forceinline__ int w_rowmap(int map, int mapF, int n) {
    if (map == 1) { if (n < 2048) { const int d0 = n & 255, hf = d0 >> 7, e = d0 & 127; return (n - d0) + 2 * (hf * 64 + (e & 63)) + (e >> 6); }
                    if (n >= 4096) return 4096 + swiglu_row(n - 4096, 2048); return n; }
    if (map == 2) { if (n < 2048) { const int d0 = n & 63, hf = d0 >> 5, e = d0 & 31; return (n - d0) + hf * 32 + 2 * (e & 15) + (e >> 4); } return n; }
    if (map == 3) return swiglu_row(n, mapF);
    return n;
}
template <bool FP8> __device__ __forceinline__ void p0_item64(const float* W, int K, int N, void* WT, int map, int mapF, LAS float* scr, int k0, int n0, int lane, float wscale) {
    { const int kq = lane >> 4, n4 = (lane & 15) * 4;
#pragma unroll 4
      for (int i = 0; i < 16; ++i) { const int k = 4 * i + kq; const f32x4 v = *(const GAS f32x4*)(W + (size_t)(k0 + k) * N + n0 + n4);
          LAS float* d = scr + k * 65 + n4; d[0] = v.x; d[1] = v.y; d[2] = v.z; d[3] = v.w; } }
    LDS_WAIT(); asm volatile("" ::: "memory");
    if constexpr (!FP8) {
        const int c = lane & 7;
#pragma unroll
        for (int j = 0; j < 8; ++j) { const int n = (lane >> 3) + 8 * j; const LAS float* sp = scr + (8 * c) * 65 + n;
            v4u o; o.x = pk2(sp[0 * 65], sp[1 * 65]); o.y = pk2(sp[2 * 65], sp[3 * 65]); o.z = pk2(sp[4 * 65], sp[5 * 65]); o.w = pk2(sp[6 * 65], sp[7 * 65]);
            *(GAS v4u*)((bf16*)WT + (size_t)w_rowmap(map, mapF, n0 + n) * K + k0 + 8 * c) = o; }
    } else {
        const int c = lane & 3;
#pragma unroll
        for (int j = 0; j < 4; ++j) { const int n = (lane >> 2) + 16 * j; const LAS float* sp = scr + (16 * c) * 65 + n;
            v4u o;
#pragma unroll
            for (int q = 0; q < 4; ++q) o[q] = pk4_fp8(sp[(4 * q) * 65] * wscale, sp[(4 * q + 1) * 65] * wscale, sp[(4 * q + 2) * 65] * wscale, sp[(4 * q + 3) * 65] * wscale);
            *(GAS v4u*)((unsigned char*)WT + (size_t)w_rowmap(map, mapF, n0 + n) * K + k0 + 16 * c) = o; }
    }
    LDS_WAIT(); asm volatile("" ::: "memory");
}

__device__ __forceinline__ void p0_prologue(Frame& F, const Args& a) {
    LAS float* scr = (LAS float*)(F.lds + F.wave * 16640);
    const int gw = F.vcu * NWAVES + F.wave, NGW = F.G * NWAVES;
    constexpr int I0 = (D / 64) * (8192 / 64), I1 = (2048 / 64) * (D / 64), I2 = (D / 64) * (2 * DFF / 64), I3 = (DFF / 64) * (D / 64), I4 = (D / 64) * (3072 / 64), I5 = (D / 64) * (D / 64);
    constexpr int I6E = (D / 64) * (2 * DFE / 64), I7E = (DFE / 64) * (D / 64);
    constexpr int NITEMS = I0 + I1 + I2 + I3 + I4 + I5 + NE * I6E + NE * I7E;
    for (int it = gw; it < NITEMS; it += NGW) {
        int r = it;
        if (r < I0) { const int nb = r % (8192 / 64), kb = r / (8192 / 64); p0_item64<false>(a.in[I_L0_WIN], D, 8192, F.ws + WS_W0IN, 1, 0, scr, 64 * kb, 64 * nb, F.lane, 1.f); continue; } r -= I0;
        if (r < I1) { const int nb = r % (D / 64), kb = r / (D / 64); p0_item64<false>(a.in[I_L0_WOUT], 2048, D, F.ws + WS_W0OUT, 0, 0, scr, 64 * kb, 64 * nb, F.lane, 1.f); continue; } r -= I1;
        if (r < I2) { const int nb = r % (2 * DFF / 64), kb = r / (2 * DFF / 64); p0_item64<false>(a.in[I_L0_WGU], D, 2 * DFF, F.ws + WS_W0GU, 3, DFF, scr, 64 * kb, 64 * nb, F.lane, 1.f); continue; } r -= I2;
        if (r < I3) { const int nb = r % (D / 64), kb = r / (D / 64); p0_item64<false>(a.in[I_L0_WDN], DFF, D, F.ws + WS_W0DN, 0, 0, scr, 64 * kb, 64 * nb, F.lane, 1.f); continue; } r -= I3;
        if (r < I4) { const int nb = r % (3072 / 64), kb = r / (3072 / 64); p0_item64<true>(a.in[I_L1_WIN], D, 3072, F.ws + WS_W1IN, 2, 0, scr, 64 * kb, 64 * nb, F.lane, MOE_WSCALE); continue; } r -= I4;
        if (r < I5) { const int nb = r % (D / 64), kb = r / (D / 64); p0_item64<false>(a.in[I_L1_WOUT], D, D, F.ws + WS_W1OUT, 0, 0, scr, 64 * kb, 64 * nb, F.lane, 1.f); continue; } r -= I5;
        if (r < NE * I6E) { const int e = r / I6E, rr = r % I6E; const int nb = rr % (2 * DFE / 64), kb = rr / (2 * DFE / 64);
            p0_item64<true>(a.in[I_L1_MGU] + (size_t)e * D * 2 * DFE, D, 2 * DFE, F.ws + WS_WMGU + (size_t)e * 2 * DFE * D, 3, DFE, scr, 64 * kb, 64 * nb, F.lane, MOE_WSCALE); continue; } r -= NE * I6E;
        { const int e = r / I7E, rr = r % I7E; const int nb = rr % (D / 64), kb = rr / (D / 64);
            p0_item64<true>(a.in[I_L1_MDN] + (size_t)e * DFE * D, DFE, D, F.ws + WS_WMDN + (size_t)e * D * DFE, 0, 0, scr, 64 * kb, 64 * nb, F.lane, MOE_WSCALE); }
    }
    __syncthreads();
    {
        LAS float* sc = (LAS float*)F.lds;
        LAS float* part = (LAS float*)(F.lds + 9 * 1024 * 4);
        bool loaded = false;
        for (int grp = F.vcu; grp < 2 * (6 * D / 64); grp += F.G) {
            if (!loaded) { for (int i = F.tid; i < 9 * 1024; i += NTHREADS) { const float cv = (i < 8 * 1024) ? a.in[I_C][i] : a.in[I_CCTX][i - 8 * 1024]; sc[i] = silu_f(cv); } loaded = true; }
            __syncthreads();
            const int layer = grp / (6 * D / 64), cb = (grp % (6 * D / 64)) * 64;
            const float* W = a.in[layer ? I_L1_WMOD : I_L0_WMOD]; const float* bm = a.in[layer ? I_L1_BMOD : I_L0_BMOD];
            const int ks = F.tid >> 6, col = F.tid & 63;
            float acc[9];
#pragma unroll
            for (int b = 0; b < 9; ++b) acc[b] = 0.f;
            for (int k = ks * 128; k < ks * 128 + 128; ++k) { const float w = W[(size_t)k * (6 * D) + cb + col];
#pragma unroll
                for (int b = 0; b < 9; ++b) acc[b] += sc[b * 1024 + k] * w; }
#pragma unroll
            for (int b = 0; b < 9; ++b) part[(ks * 9 + b) * 64 + col] = acc[b];
            __syncthreads();
            for (int o = F.tid; o < 9 * 64; o += NTHREADS) { const int b = o >> 6, cc = o & 63; float s = bm[cb + cc];
#pragma unroll
                for (int k2 = 0; k2 < 8; ++k2) s += part[(k2 * 9 + b) * 64 + cc];
                ((float*)(F.ws + WS_MODV))[((size_t)layer * 9 + b) * (6 * D) + cb + cc] = s; }
            __syncthreads();
        }
    }
    {
        const int gt = F.vcu * NTHREADS + F.tid;
        if (gt < 64 * 64 + 64 * 16) {
            int pos, i; float ex;
            if (gt < 4096) { pos = gt >> 6; i = gt & 63; ex = (float)(2 * i) / 128.0f; } else { const int q = gt - 4096; pos = q >> 4; i = q & 15; ex = (float)(2 * i) / 32.0f; }
            const float freq = __builtin_amdgcn_exp2f(-ex * 13.287712379549449f);
            const float rev = (float)pos * freq * 0.15915494309189535f;
            const float cs = __builtin_amdgcn_cosf(rev), sn = __builtin_amdgcn_sinf(rev);
            f32x2* t = (f32x2*)(F.ws + (gt < 4096 ? WS_TAB0 : WS_TAB1)); t[gt < 4096 ? gt : gt - 4096] = (f32x2){cs, sn};
        }
        if (gt == 0) { const float* lp = a.in[I_L1_LAMBDA]; float s1 = 0.f, s2 = 0.f; for (int i = 0; i < 64; ++i) { s1 += lp[i] * lp[64 + i]; s2 += lp[128 + i] * lp[192 + i]; }
            *(float*)(F.ws + WS_LAM) = __expf(s1) - __expf(s2) + LAMBDA_INIT; }
    }
}

struct RowPass {
    int nrows;
    const float* xin_lat; const float* xin_ctx; float* xout_lat; float* xout_ctx;
    const bf16* br;
    const float* gpost;
    const float* gate;
    const float* gpre;
    const float* shift; const float* scale;
    bf16* hout;
    const float* part;
};
template <bool BR, bool MOEBR, bool WH, bool ROUTE, bool H8 = false, int KSPL = 0, bool XI16 = false, bool XO16 = false>
__device__ __forceinline__ void row_pass(Frame& F, const Args& a, const RowPass& P) {
    const int gw = F.vcu * NWAVES + F.wave, NGW = F.G * NWAVES;
    const int l4 = F.lane * 4;
    for (int r = gw; r < P.nrows; r += NGW) {
        const bool lat = r < NLAT; const int rc = lat ? r : r - NLAT; const int midx = lat ? (r >> 12) : 8;
        const float* xin = (lat ? P.xin_lat : P.xin_ctx) + (size_t)rc * (XI16 ? D / 2 : D);
        float* xout = (lat ? P.xout_lat : P.xout_ctx) + (size_t)rc * (XO16 ? D / 2 : D);
        f32x4 v[4];
        if constexpr (XI16) {
#pragma unroll
            for (int j = 0; j < 4; ++j) { const v2u w = *(const GAS v2u*)((const bf16*)xin + l4 + 256 * j); v[j] = (f32x4){bflo(w.x), bfhi(w.x), bflo(w.y), bfhi(w.y)}; }
        } else {
#pragma unroll
            for (int j = 0; j < 4; ++j) v[j] = *(const GAS f32x4*)(xin + l4 + 256 * j);
        }
        if constexpr (BR || MOEBR) {
            f32x4 y[4];
            if constexpr (BR) {
                if (KSPL > 0 && !lat) {
#pragma unroll
                    for (int j = 0; j < 4; ++j) y[j] = (f32x4){0.f, 0.f, 0.f, 0.f};
                    for (int ks = 0; ks < KSPL; ++ks) { const float* pr = P.part + ((size_t)ks * NCTX + rc) * D + l4;
#pragma unroll
                        for (int j = 0; j < 4; ++j) y[j] = y[j] + *(const GAS f32x4*)(pr + 256 * j); }
                } else {
#pragma unroll
                for (int j = 0; j < 4; ++j) { const v2u w = *(const GAS v2u*)(P.br + (size_t)r * D + l4 + 256 * j); y[j] = (f32x4){bflo(w.x), bfhi(w.x), bflo(w.y), bfhi(w.y)}; }
                }
            } else {
                const int* tpos = (const int*)(F.ws + WS_ROUTE + (size_t)NLAT * 8); const float* tw = (const float*)(F.ws + WS_ROUTE + (size_t)NLAT * 16);
                const int s0 = tpos[2 * r], s1 = tpos[2 * r + 1]; const float w0 = tw[2 * r], w1 = tw[2 * r + 1];
#pragma unroll
                for (int j = 0; j < 4; ++j) { const v2u p = *(const GAS v2u*)(P.br + (size_t)s0 * D + l4 + 256 * j); const v2u q = *(const GAS v2u*)(P.br + (size_t)s1 * D + l4 + 256 * j);
                    y[j] = (f32x4){w0 * bflo(p.x) + w1 * bflo(q.x), w0 * bfhi(p.x) + w1 * bfhi(q.x), w0 * bflo(p.y) + w1 * bflo(q.y), w0 * bfhi(p.y) + w1 * bfhi(q.y)}; }
            }
            float ss = 0.f;
#pragma unroll
            for (int j = 0; j < 4; ++j) ss += (y[j].x * y[j].x + y[j].y * y[j].y) + (y[j].z * y[j].z + y[j].w * y[j].w);
            const float rstd = 1.0f / sqrtf(wave_sum(ss) * (1.0f / D) + EPS);
#pragma unroll
            for (int j = 0; j < 4; ++j) { const f32x4 gp = *(const GAS f32x4*)(P.gpost + l4 + 256 * j); const f32x4 gt = *(const GAS f32x4*)(P.gate + (size_t)midx * 6 * D + l4 + 256 * j);
                v[j] = v[j] + gt * (y[j] * rstd * gp); }
            if ((lat ? P.xout_lat : P.xout_ctx) != nullptr) {
                if constexpr (XO16) {
#pragma unroll
                    for (int j = 0; j < 4; ++j) { v2u w; w.x = pk2(v[j].x, v[j].y); w.y = pk2(v[j].z, v[j].w); *(GAS v2u*)((bf16*)xout + l4 + 256 * j) = w; }
                } else {
#pragma unroll
                    for (int j = 0; j < 4; ++j) *(GAS f32x4*)(xout + l4 + 256 * j) = v[j];
                }
            }
        }
        if constexpr (WH) {
            float ss = 0.f;
#pragma unroll
            for (int j = 0; j < 4; ++j) ss += (v[j].x * v[j].x + v[j].y * v[j].y) + (v[j].z * v[j].z + v[j].w * v[j].w);
            const float rstd = 1.0f / sqrtf(wave_sum(ss) * (1.0f / D) + EPS);
            f32x4 h[4];
#pragma unroll
            for (int j = 0; j < 4; ++j) { const f32x4 gp = *(const GAS f32x4*)(P.gpre + l4 + 256 * j); const f32x4 sc = *(const GAS f32x4*)(P.scale + (size_t)midx * 6 * D + l4 + 256 * j);
                const f32x4 sh = *(const GAS f32x4*)(P.shift + (size_t)midx * 6 * D + l4 + 256 * j);
                h[j] = (v[j] * rstd * gp) * (1.0f + sc) + sh;
                if constexpr (H8) { *(GAS unsigned*)((unsigned char*)P.hout + (size_t)r * D + l4 + 256 * j) = pk4_fp8(h[j].x, h[j].y, h[j].z, h[j].w); }
                else { v2u w; w.x = pk2(h[j].x, h[j].y); w.y = pk2(h[j].z, h[j].w); *(GAS v2u*)(P.hout + (size_t)r * D + l4 + 256 * j) = w; } }
            if constexpr (ROUTE) {
                const float* rw = a.in[I_L1_RW];
                float lg[8];
#pragma unroll
                for (int e = 0; e < 8; ++e) lg[e] = 0.f;
#pragma unroll
                for (int j = 0; j < 4; ++j)
#pragma unroll
                    for (int q = 0; q < 4; ++q) { const int k = l4 + 256 * j + q; const f32x4 wa = *(const GAS f32x4*)(rw + (size_t)k * 8), wb = *(const GAS f32x4*)(rw + (size_t)k * 8 + 4); const float hv = h[j][q];
                        lg[0] += hv * wa.x; lg[1] += hv * wa.y; lg[2] += hv * wa.z; lg[3] += hv * wa.w; lg[4] += hv * wb.x; lg[5] += hv * wb.y; lg[6] += hv * wb.z; lg[7] += hv * wb.w; }
#pragma unroll
                for (int e = 0; e < 8; ++e) lg[e] = wave_sum(lg[e]) + a.in[I_L1_RB][e];
                float v1 = lg[0]; int i1 = 0;
#pragma unroll
                for (int e = 1; e < 8; ++e) if (lg[e] > v1) { v1 = lg[e]; i1 = e; }
                float v2 = -3.0e38f; int i2 = 0;
#pragma unroll
                for (int e = 0; e < 8; ++e) if (e != i1 && lg[e] > v2) { v2 = lg[e]; i2 = e; }
                const float w1 = 1.0f / (1.0f + __expf(v2 - v1)), w2 = 1.0f - w1;
                if (F.lane == 0) {
                    int* te = (int*)(F.ws + WS_ROUTE); int* tpos = (int*)(F.ws + WS_ROUTE + (size_t)NLAT * 8); float* tw = (float*)(F.ws + WS_ROUTE + (size_t)NLAT * 16);
                    const unsigned p1 = __hip_atomic_fetch_add((unsigned*)(F.ctl + CW_MOECNT + 64 * i1), 1u, RLX_AGENT);
                    const unsigned p2 = __hip_atomic_fetch_add((unsigned*)(F.ctl + CW_MOECNT + 64 * i2), 1u, RLX_AGENT);
                    te[2 * r] = i1; te[2 * r + 1] = i2; tpos[2 * r] = (int)p1; tpos[2 * r + 1] = (int)p2; tw[2 * r] = w1; tw[2 * r + 1] = w2;
                }
            }
        }
    }
}


namespace att {
using s16x4  = __attribute__((ext_vector_type(4))) short;
using f32x16 = __attribute__((ext_vector_type(16))) float;
using u32x4  = __attribute__((ext_vector_type(4))) unsigned;
constexpr int KVBLK = 64, NT = (SEQ + CTXL) / KVBLK;
constexpr int SHM_V = KVBLK * 128, SHM_K = KVBLK * 64 * 2;
constexpr int NVTILE = MALL / KVBLK;
constexpr int NSLOT_K = 3, NSLOT_V = 4;
constexpr int OFF_V = 0, OFF_K = NSLOT_V * SHM_V, OFF_WS = OFF_K + NSLOT_K * SHM_K, OFF_O1 = OFF_WS + NWAVES * 64 * 4, ATT_LDS = OFF_O1 + NWAVES * 8192;
constexpr float THR = 8.0f;
#define ATT_SBAR() __builtin_amdgcn_sched_barrier(0)
#define ATT_PIPE_PV() do { __builtin_amdgcn_sched_group_barrier(0x100, 2, 0); \
    _Pragma("unroll") for (int i_ = 0; i_ < 16; ++i_) { __builtin_amdgcn_sched_group_barrier(0x008, 1, 0); __builtin_amdgcn_sched_group_barrier(0x100, 2, 0); __builtin_amdgcn_sched_group_barrier(0x002, 7, 0); } } while (0)
#define KSWZ64(row, colB) ((row) * 128 + ((colB) ^ ((((row) >> 1) & 7) << 4)))
__device__ __forceinline__ int crow(int r, int hi) { return (r & 3) + 8 * (r >> 2) + 4 * hi; }
__device__ __forceinline__ unsigned cvtpk(float lo, float hi) { return pk2(lo, hi); }

template <int VAR = 0> __device__ __forceinline__ void partialSM(f32x16& p0, f32x16& p1, float& m_reg, f32x16& negm, float& alpha) {
    float mx[4];
#pragma unroll
    for (int c = 0; c < 4; ++c) mx[c] = fmaxf(fmaxf(p0[4 * c], p0[4 * c + 1]), fmaxf(p0[4 * c + 2], p0[4 * c + 3]));
#pragma unroll
    for (int c = 0; c < 4; ++c) mx[c] = fmaxf(mx[c], fmaxf(fmaxf(p1[4 * c], p1[4 * c + 1]), fmaxf(p1[4 * c + 2], p1[4 * c + 3])));
    float pmax = fmaxf(fmaxf(mx[0], mx[1]), fmaxf(mx[2], mx[3]));
    { auto rr = __builtin_amdgcn_permlane32_swap(__float_as_uint(pmax), __float_as_uint(pmax), false, false); pmax = fmaxf(__uint_as_float(rr[0]), __uint_as_float(rr[1])); }
    alpha = 1.f; m_reg = pmax;
#pragma unroll
    for (int r = 0; r < 16; ++r) { negm[r] = -pmax; p0[r] = __builtin_amdgcn_exp2f(p0[r] - pmax); p1[r] = __builtin_amdgcn_exp2f(p1[r] - pmax); }
}
template <int VAR = 0> __device__ __forceinline__ void finishSM(f32x16& p0, f32x16& p1, float alpha, float& l_reg, bf16x8& pa0, bf16x8& pa1, bf16x8& pa2, bf16x8& pa3) {
    if (VAR != 2) {
    f32x2 s2[4];
#pragma unroll
    for (int c = 0; c < 4; ++c) s2[c] = (f32x2){p0[4 * c], p0[4 * c + 1]} + (f32x2){p0[4 * c + 2], p0[4 * c + 3]};
#pragma unroll
    for (int c = 0; c < 4; ++c) s2[c] = s2[c] + ((f32x2){p1[4 * c], p1[4 * c + 1]} + (f32x2){p1[4 * c + 2], p1[4 * c + 3]});
    const f32x2 s2t = (s2[0] + s2[1]) + (s2[2] + s2[3]);
    float ps = s2t[0] + s2t[1];
    { auto rr = __builtin_amdgcn_permlane32_swap(__float_as_uint(ps), __float_as_uint(ps), false, false); ps = __uint_as_float(rr[0]) + __uint_as_float(rr[1]); }
    l_reg = l_reg * alpha + ps;
    } else { l_reg = 1.f; }
#define ATT_PK4(P, BASE, OUT) do { u32x4 w = {cvtpk(P[BASE + 0], P[BASE + 1]), cvtpk(P[BASE + 2], P[BASE + 3]), cvtpk(P[BASE + 4], P[BASE + 5]), cvtpk(P[BASE + 6], P[BASE + 7])}; OUT = *reinterpret_cast<bf16x8*>(&w); } while (0)
    ATT_PK4(p0, 0, pa0); ATT_PK4(p0, 8, pa1); ATT_PK4(p1, 0, pa2); ATT_PK4(p1, 8, pa3);
#undef ATT_PK4
}
__device__ __forceinline__ void qkt(f32x16& p0, f32x16& p1, const char* Ks, const bf16x8* qr, const f32x16& negm, int r32, int hi) {
#pragma unroll
    for (int d0 = 0; d0 < 4; ++d0) { const int cb = (d0 * 16 + hi * 8) * 2;
        const bf16x8 b0 = *reinterpret_cast<const bf16x8*>(Ks + KSWZ64(r32, cb));
        const bf16x8 b1 = *reinterpret_cast<const bf16x8*>(Ks + KSWZ64(32 + r32, cb));
        if (d0 == 0) { p0 = __builtin_amdgcn_mfma_f32_32x32x16_bf16(b0, qr[0], negm, 0, 0, 0); p1 = __builtin_amdgcn_mfma_f32_32x32x16_bf16(b1, qr[0], negm, 0, 0, 0); }
        else { p0 = __builtin_amdgcn_mfma_f32_32x32x16_bf16(b0, qr[d0], p0, 0, 0, 0); p1 = __builtin_amdgcn_mfma_f32_32x32x16_bf16(b1, qr[d0], p1, 0, 0, 0); } }
}
__device__ __forceinline__ int v_st(int k, int c) { const int kk = (k & ~0xC) | ((k & 4) << 1) | ((k & 8) >> 1); return ((kk >> 3) * 4 + (c >> 5)) * 512 + ((kk & 7) * 32 + (c & 31)) * 2; }
__device__ __forceinline__ int v_rd_base(int lane) { return ((lane & 3) << 3) | (((lane >> 2) & 3) << 6) | (((lane >> 4) & 1) << 5) | (((lane >> 5) & 1) << 8); }
constexpr int v_rd_off(int d0, int ks, int half) { return d0 * 512 + ks * 4096 + half * 2048; }
typedef short v4i16a_t __attribute__((ext_vector_type(4)));
template <int OFF> __device__ __forceinline__ s16x4 tr_read(int vb) { return __builtin_bit_cast(s16x4, __builtin_amdgcn_ds_read_tr16_b64_v4i16((LAS v4i16a_t*)(unsigned)(vb + OFF))); }
#define ATT_PK(L, H) (bf16x8){L[0], L[1], L[2], L[3], H[0], H[1], H[2], H[3]}
template <int D0> __device__ __forceinline__ void pv_one(f32x16& od, int vb, bf16x8 pa0, bf16x8 pa1, bf16x8 pa2, bf16x8 pa3) {
    const s16x4 l0 = tr_read<v_rd_off(D0, 0, 0)>(vb), h0 = tr_read<v_rd_off(D0, 0, 1)>(vb), l1 = tr_read<v_rd_off(D0, 1, 0)>(vb), h1 = tr_read<v_rd_off(D0, 1, 1)>(vb);
    const s16x4 l2 = tr_read<v_rd_off(D0, 2, 0)>(vb), h2 = tr_read<v_rd_off(D0, 2, 1)>(vb), l3 = tr_read<v_rd_off(D0, 3, 0)>(vb), h3 = tr_read<v_rd_off(D0, 3, 1)>(vb);
    od = __builtin_amdgcn_mfma_f32_32x32x16_bf16(pa0, ATT_PK(l0, h0), od, 0, 0, 0);
    od = __builtin_amdgcn_mfma_f32_32x32x16_bf16(pa1, ATT_PK(l1, h1), od, 0, 0, 0);
    od = __builtin_amdgcn_mfma_f32_32x32x16_bf16(pa2, ATT_PK(l2, h2), od, 0, 0, 0);
    od = __builtin_amdgcn_mfma_f32_32x32x16_bf16(pa3, ATT_PK(l3, h3), od, 0, 0, 0);
}
#undef ATT_PK
__device__ __forceinline__ void pv_d0(f32x16* o, int vb, bf16x8 pa0, bf16x8 pa1, bf16x8 pa2, bf16x8 pa3) {
    pv_one<0>(o[0], vb, pa0, pa1, pa2, pa3); pv_one<1>(o[1], vb, pa0, pa1, pa2, pa3); pv_one<2>(o[2], vb, pa0, pa1, pa2, pa3); pv_one<3>(o[3], vb, pa0, pa1, pa2, pa3);
}
struct VH { bf16x8 k0, k1; };
__device__ __forceinline__ void vhalf(bf16x8& d, s16x4 lo, s16x4 hi) { d = __builtin_shufflevector(lo, hi, 0, 1, 2, 3, 4, 5, 6, 7); }
template <int D0, int KS0> __device__ __forceinline__ void vh_load(VH& f, int vb) {
    vhalf(f.k0, tr_read<v_rd_off(D0, KS0, 0)>(vb), tr_read<v_rd_off(D0, KS0, 1)>(vb)); vhalf(f.k1, tr_read<v_rd_off(D0, KS0 + 1, 0)>(vb), tr_read<v_rd_off(D0, KS0 + 1, 1)>(vb));
}
#define ATT_PKV(L, H) (bf16x8){L[0], L[1], L[2], L[3], H[0], H[1], H[2], H[3]}
#define ATT_E3(P, B) do { P[B] = __builtin_amdgcn_exp2f(P[B]); P[(B) + 1] = __builtin_amdgcn_exp2f(P[(B) + 1]); P[(B) + 2] = __builtin_amdgcn_exp2f(P[(B) + 2]); } while (0)
#define ATT_MM(D, PA, FR) o[D] = __builtin_amdgcn_mfma_f32_32x32x16_bf16(PA, FR, o[D], 0, 0, 0)
#define ATT_PIN(x) asm volatile("" : "+v"(x))
__device__ __forceinline__ void pv_partial(f32x16* o, int vb, bf16x8 pa0, bf16x8 pa1, bf16x8 pa2, bf16x8 pa3, f32x16& p0, f32x16& p1, float& m_reg, f32x16& negm, float& alpha) {
    VH fa, fb; float mx[4];
    vh_load<0, 0>(fa, vb); vh_load<0, 2>(fb, vb);
    ATT_SBAR();
    ATT_MM(0, pa0, fa.k0);
    mx[0] = fmaxf(fmaxf(p0[0], p0[1]), p0[2]); mx[1] = fmaxf(fmaxf(p0[3], p0[4]), p0[5]); mx[2] = fmaxf(fmaxf(p0[6], p0[7]), p0[8]); mx[3] = fmaxf(fmaxf(p0[9], p0[10]), p0[11]); ATT_PIN(mx[0]); ATT_PIN(mx[1]); ATT_PIN(mx[2]); ATT_PIN(mx[3]); ATT_SBAR();
    ATT_MM(0, pa1, fa.k1); vh_load<1, 0>(fa, vb);
    mx[0] = fmaxf(fmaxf(mx[0], p0[12]), p0[13]); mx[1] = fmaxf(fmaxf(mx[1], p0[14]), p0[15]); mx[2] = fmaxf(fmaxf(mx[2], p1[0]), p1[1]); mx[3] = fmaxf(fmaxf(mx[3], p1[2]), p1[3]); ATT_PIN(mx[0]); ATT_PIN(mx[1]); ATT_PIN(mx[2]); ATT_PIN(mx[3]); ATT_SBAR();
    ATT_MM(0, pa2, fb.k0);
    mx[0] = fmaxf(fmaxf(mx[0], p1[4]), p1[5]); mx[1] = fmaxf(fmaxf(mx[1], p1[6]), p1[7]); mx[2] = fmaxf(fmaxf(mx[2], p1[8]), p1[9]); mx[3] = fmaxf(fmaxf(mx[3], p1[10]), p1[11]); ATT_PIN(mx[0]); ATT_PIN(mx[1]); ATT_PIN(mx[2]); ATT_PIN(mx[3]); ATT_SBAR();
    ATT_MM(0, pa3, fb.k1); vh_load<1, 2>(fb, vb);
    mx[0] = fmaxf(fmaxf(mx[0], p1[12]), p1[13]); mx[1] = fmaxf(fmaxf(mx[1], p1[14]), p1[15]); ATT_PIN(mx[0]); ATT_PIN(mx[1]); ATT_SBAR();
    ATT_MM(1, pa0, fa.k0);
    { float pmax = fmaxf(fmaxf(mx[0], mx[1]), fmaxf(mx[2], mx[3]));
      auto rr = __builtin_amdgcn_permlane32_swap(__float_as_uint(pmax), __float_as_uint(pmax), false, false); pmax = fmaxf(__uint_as_float(rr[0]), __uint_as_float(rr[1]));
      const bool need = pmax > THR; alpha = 1.f;
      if (__any(need)) { const float delta = need ? pmax : 0.f; alpha = __builtin_amdgcn_exp2f(-delta); m_reg += delta;
#pragma unroll
          for (int r = 0; r < 16; ++r) { p0[r] -= delta; p1[r] -= delta; negm[r] -= delta; } } } ATT_PIN(alpha); ATT_SBAR();
    ATT_MM(1, pa1, fa.k1); vh_load<2, 0>(fa, vb); ATT_E3(p0, 0); ATT_PIN(p0); ATT_SBAR();
    ATT_MM(1, pa2, fb.k0); ATT_E3(p0, 3); ATT_PIN(p0); ATT_SBAR();
    ATT_MM(1, pa3, fb.k1); vh_load<2, 2>(fb, vb); ATT_E3(p0, 6); ATT_PIN(p0); ATT_SBAR();
    ATT_MM(2, pa0, fa.k0); ATT_E3(p0, 9); ATT_PIN(p0); ATT_SBAR();
    ATT_MM(2, pa1, fa.k1); vh_load<3, 0>(fa, vb); ATT_E3(p0, 12); ATT_PIN(p0); ATT_SBAR();
    ATT_MM(2, pa2, fb.k0); p0[15] = __builtin_amdgcn_exp2f(p0[15]); p1[0] = __builtin_amdgcn_exp2f(p1[0]); p1[1] = __builtin_amdgcn_exp2f(p1[1]); ATT_PIN(p0); ATT_PIN(p1); ATT_SBAR();
    ATT_MM(2, pa3, fb.k1); vh_load<3, 2>(fb, vb); ATT_E3(p1, 2); ATT_PIN(p1); ATT_SBAR();
    ATT_MM(3, pa0, fa.k0); ATT_E3(p1, 5); ATT_PIN(p1); ATT_SBAR();
    ATT_MM(3, pa1, fa.k1); ATT_E3(p1, 8); ATT_PIN(p1); ATT_SBAR();
    ATT_MM(3, pa2, fb.k0); ATT_E3(p1, 11); ATT_PIN(p1); ATT_SBAR();
    ATT_MM(3, pa3, fb.k1); p1[14] = __builtin_amdgcn_exp2f(p1[14]); p1[15] = __builtin_amdgcn_exp2f(p1[15]); ATT_PIN(p1); ATT_SBAR();
}
#undef ATT_MM
#undef ATT_PIN
#undef ATT_E3
#undef ATT_PKV
typedef int v8i_a __attribute__((ext_vector_type(8)));
typedef int v4i_a __attribute__((ext_vector_type(4)));
__device__ __forceinline__ v8i_a v8_frag(unsigned a0, unsigned a1) {
    const v4i_a lo = *(const LAS v4i_a*)a0, hi = *(const LAS v4i_a*)a1; return __builtin_shufflevector(lo, hi, 0, 1, 2, 3, 4, 5, 6, 7); }
#define ATT_MM8(D, FR) asm volatile("v_mfma_scale_f32_32x32x64_f8f6f4 %0, %1, %2, %0, %3, %3 op_sel_hi:[0,0,0]" : "+v"(o[D]) : "v"(pa8), "v"(FR), "v"(one8))
#define ATT_PIN8(x) asm volatile("" : "+v"(x))
#define ATT_EX(P, B) P[B] = __builtin_amdgcn_exp2f(P[B])
__device__ __forceinline__ void pv8_partial(f32x16* o, unsigned va0, unsigned va1, v8i_a pa8, f32x16& p0, f32x16& p1, float& m_reg, f32x16& negm, float& alpha) {
    const int one8 = 0x7f7f7f7f;
    float mx[4];
    const v8i_a f0 = v8_frag(va0, va1), f1 = v8_frag(va0 + 2048, va1 + 2048), f2 = v8_frag(va0 + 4096, va1 + 4096), f3 = v8_frag(va0 + 6144, va1 + 6144);
    ATT_SBAR();
    ATT_MM8(0, f0);
    mx[0] = fmaxf(fmaxf(p0[0], p0[1]), p0[2]); mx[1] = fmaxf(fmaxf(p0[3], p0[4]), p0[5]); mx[2] = fmaxf(fmaxf(p0[6], p0[7]), p0[8]); mx[3] = fmaxf(fmaxf(p0[9], p0[10]), p0[11]);
    mx[0] = fmaxf(fmaxf(mx[0], p0[12]), p0[13]); mx[1] = fmaxf(fmaxf(mx[1], p0[14]), p0[15]); mx[2] = fmaxf(fmaxf(mx[2], p1[0]), p1[1]); mx[3] = fmaxf(fmaxf(mx[3], p1[2]), p1[3]);
    mx[0] = fmaxf(fmaxf(mx[0], p1[4]), p1[5]); mx[1] = fmaxf(fmaxf(mx[1], p1[6]), p1[7]); mx[2] = fmaxf(fmaxf(mx[2], p1[8]), p1[9]); mx[3] = fmaxf(fmaxf(mx[3], p1[10]), p1[11]);
    mx[0] = fmaxf(fmaxf(mx[0], p1[12]), p1[13]); mx[1] = fmaxf(fmaxf(mx[1], p1[14]), p1[15]);
    { float pmax = fmaxf(fmaxf(mx[0], mx[1]), fmaxf(mx[2], mx[3]));
      auto rr = __builtin_amdgcn_permlane32_swap(__float_as_uint(pmax), __float_as_uint(pmax), false, false); pmax = fmaxf(__uint_as_float(rr[0]), __uint_as_float(rr[1]));
      const bool need = pmax > THR; alpha = 1.f;
      if (__any(need)) { const float delta = need ? pmax : 0.f; alpha = __builtin_amdgcn_exp2f(-delta); m_reg += delta;
#pragma unroll
          for (int r = 0; r < 16; ++r) { p0[r] -= delta; p1[r] -= delta; negm[r] -= delta; } } } ATT_PIN8(alpha); ATT_SBAR();
    ATT_MM8(1, f1);
    ATT_EX(p0, 0); ATT_EX(p0, 1); ATT_EX(p0, 2); ATT_EX(p0, 3); ATT_EX(p0, 4); ATT_EX(p0, 5); ATT_EX(p0, 6); ATT_EX(p0, 7); ATT_EX(p0, 8); ATT_EX(p0, 9); ATT_EX(p0, 10); ATT_PIN8(p0); ATT_SBAR();
    ATT_MM8(2, f2);
    ATT_EX(p0, 11); ATT_EX(p0, 12); ATT_EX(p0, 13); ATT_EX(p0, 14); ATT_EX(p0, 15); ATT_EX(p1, 0); ATT_EX(p1, 1); ATT_EX(p1, 2); ATT_EX(p1, 3); ATT_EX(p1, 4); ATT_EX(p1, 5); ATT_PIN8(p0); ATT_PIN8(p1); ATT_SBAR();
    ATT_MM8(3, f3);
    ATT_EX(p1, 6); ATT_EX(p1, 7); ATT_EX(p1, 8); ATT_EX(p1, 9); ATT_EX(p1, 10); ATT_EX(p1, 11); ATT_EX(p1, 12); ATT_EX(p1, 13); ATT_EX(p1, 14); ATT_EX(p1, 15); ATT_PIN8(p1); ATT_SBAR();
    asm volatile("s_nop 15\n\ts_nop 15" ::: "memory");
}
#undef ATT_EX
__device__ __forceinline__ void finishSM8(f32x16& p0, f32x16& p1, float alpha, float& l_reg, v8i_a& pa8) {
    f32x2 s2[4];
#pragma unroll
    for (int c = 0; c < 4; ++c) s2[c] = (f32x2){p0[4 * c], p0[4 * c + 1]} + (f32x2){p0[4 * c + 2], p0[4 * c + 3]};
#pragma unroll
    for (int c = 0; c < 4; ++c) s2[c] = s2[c] + ((f32x2){p1[4 * c], p1[4 * c + 1]} + (f32x2){p1[4 * c + 2], p1[4 * c + 3]});
    const f32x2 s2t = (s2[0] + s2[1]) + (s2[2] + s2[3]);
    float ps = s2t[0] + s2t[1];
    { auto rr = __builtin_amdgcn_permlane32_swap(__float_as_uint(ps), __float_as_uint(ps), false, false); ps = __uint_as_float(rr[0]) + __uint_as_float(rr[1]); }
    l_reg = l_reg * alpha + ps;
#pragma unroll
    for (int q = 0; q < 4; ++q) { int w0 = 0, w1 = 0;
        w0 = __builtin_amdgcn_cvt_pk_fp8_f32(p0[4 * q], p0[4 * q + 1], w0, false); w0 = __builtin_amdgcn_cvt_pk_fp8_f32(p0[4 * q + 2], p0[4 * q + 3], w0, true);
        w1 = __builtin_amdgcn_cvt_pk_fp8_f32(p1[4 * q], p1[4 * q + 1], w1, false); w1 = __builtin_amdgcn_cvt_pk_fp8_f32(p1[4 * q + 2], p1[4 * q + 3], w1, true);
        pa8[q] = w0; pa8[4 + q] = w1; }
}
__device__ __forceinline__ size_t kvrow(int b, int t) { return t < 64 ? (size_t)b * SEQ + (size_t)t * 64 : (size_t)NLAT + (size_t)b * CTXL + (size_t)(t - 64) * 64; }

__device__ __forceinline__ void glds16(const void* gsrc, unsigned lds_dst) { unsigned keep;
    asm volatile("s_mov_b32 %0, m0\n\ts_mov_b32 m0, %2\n\ts_nop 0\n\tglobal_load_lds_dwordx4 %1, off\n\ts_mov_b32 m0, %0" : "=&s"(keep) : "v"(gsrc), "s"(lds_dst) : "memory"); }
template <int VAR> __device__ __forceinline__ void head_pass(const bf16* __restrict__ Q1, const bf16* __restrict__ K1, const unsigned char* __restrict__ V8, int b, int qh, int hp, size_t qrow0, char* lds, f32x16 (&o)[4], float& l_out) {
    int tid_ = threadIdx.x; asm volatile("" : "+v"(tid_));
    const int tid = tid_, wid = __builtin_amdgcn_readfirstlane(tid >> 6), lane = tid & 63, r32 = lane & 31, hi = lane >> 5;
    char* V_lds = lds + OFF_V; char* K_lds = lds + OFF_K;
    float* wsf = (float*)(lds + OFF_WS) + wid * 64; float* al_l = wsf + 32;
    float m_reg = 0.f, l_reg = 0.f; f32x16 negm = f32x16{};
#pragma unroll
    for (int d = 0; d < 4; ++d) o[d] = f32x16{};
    const bf16* Kh = K1 + (size_t)qh * MALL * 64; const unsigned char* Vh = V8 + (size_t)hp * NVTILE * SHM_V;
    const int kr = 8 * wid + (lane >> 3); const unsigned koff = (unsigned)(kr * 128 + (((lane & 7) ^ ((kr >> 1) & 7)) << 4));
    const unsigned lbase = (unsigned)(uintptr_t)lds;
#define ATT_ISSUE(t_, ks_, vs_) do { const int tt_ = (t_); const size_t rb_ = kvrow(b, tt_); const char* kb_ = (const char*)(Kh + rb_ * 64); \
    const unsigned char* vb_ = Vh + (size_t)(tt_ < 64 ? b * 64 + tt_ : 512 + 4 * b + (tt_ - 64)) * SHM_V; \
    glds16(kb_ + koff, (unsigned)__builtin_amdgcn_readfirstlane(lbase + OFF_K + (ks_) * SHM_K + wid * 1024)); \
    glds16(vb_ + wid * 1024 + lane * 16, (unsigned)__builtin_amdgcn_readfirstlane(lbase + OFF_V + (vs_) * SHM_V + wid * 1024)); } while (0)
#define ATT_WAITBAR(N) do { asm volatile("s_waitcnt vmcnt(" #N ")" ::: "memory"); __builtin_amdgcn_s_barrier(); asm volatile("" ::: "memory"); } while (0)
#define ATT_RESC(al) do { if (__any((al) < 1.f)) { if (hi == 0) al_l[r32] = (al); asm volatile("s_waitcnt lgkmcnt(0)" ::: "memory"); \
    _Pragma("unroll") for (int d = 0; d < 4; ++d) _Pragma("unroll") for (int r = 0; r < 16; ++r) o[d][r] *= al_l[crow(r, hi)]; } } while (0)
    bf16x8 qr[4];
    const bf16* Qw = Q1 + ((size_t)qh * MALL + qrow0 + wid * 32 + r32) * 64 + hi * 8;
#pragma unroll
    for (int d0 = 0; d0 < 4; ++d0) qr[d0] = *reinterpret_cast<const bf16x8*>(Qw + d0 * 16);
    const unsigned vsw = (unsigned)((r32 >> 2) & 3);
    const unsigned va0_ = (unsigned)(uintptr_t)V_lds + (unsigned)(r32 * 64) + (((2u * hi) ^ vsw) << 4), va1_ = (unsigned)(uintptr_t)V_lds + (unsigned)(r32 * 64) + (((2u * hi + 1u) ^ vsw) << 4);
    f32x16 pA0, pA1, pB0, pB1; float alA = 1.f, alB = 1.f; v8i_a pa8;
    int kq = 1, ki = 2, vA = 0, vB = 3, vi = 2;
#define ATT_ADV() do { kq = ki; ki = (ki == 2) ? 0 : ki + 1; vB = vA; vA = (vA + 1) & 3; vi = (vi + 1) & 3; } while (0)
    ATT_ISSUE(0, 0, 0); ATT_ISSUE(1, 1, 1);
    ATT_WAITBAR(2);
    {
        qkt(pA0, pA1, K_lds, qr, negm, r32, hi); partialSM<VAR>(pA0, pA1, m_reg, negm, alA);
        ATT_WAITBAR(1);
#define ATT_STEP_A(PC0, PC1, ALC, PN0, PN1, ALN, j_) do { \
        ATT_ISSUE((j_) + 2, ki, vi); \
        ATT_SBAR(); qkt(PN0, PN1, K_lds + kq * SHM_K, qr, negm, r32, hi); \
        finishSM8(PC0, PC1, ALC, l_reg, pa8); ATT_SBAR(); \
        pv8_partial(o, va0_ + vA * SHM_V, va1_ + vA * SHM_V, pa8, PN0, PN1, m_reg, negm, ALN); \
        ATT_RESC(ALN); \
        ATT_WAITBAR(1); ATT_ADV(); } while (0)
        for (int j = 0; j + 2 < NT; j += 2) {
            ATT_STEP_A(pA0, pA1, alA, pB0, pB1, alB, j);
            ATT_STEP_A(pB0, pB1, alB, pA0, pA1, alA, j + 1);
        }
        ATT_SBAR(); qkt(pB0, pB1, K_lds + kq * SHM_K, qr, negm, r32, hi);
        finishSM8(pA0, pA1, alA, l_reg, pa8); ATT_SBAR();
        pv8_partial(o, va0_ + vA * SHM_V, va1_ + vA * SHM_V, pa8, pB0, pB1, m_reg, negm, alB);
        ATT_RESC(alB);
        ATT_WAITBAR(0);
        finishSM8(pB0, pB1, alB, l_reg, pa8); ATT_SBAR();
        { const unsigned s_ = (unsigned)(((vA + 1) & 3) * SHM_V); const int one8 = 0x7f7f7f7f;
          const v8i_a f0 = v8_frag(va0_ + s_, va1_ + s_), f1 = v8_frag(va0_ + s_ + 2048, va1_ + s_ + 2048), f2 = v8_frag(va0_ + s_ + 4096, va1_ + s_ + 4096), f3 = v8_frag(va0_ + s_ + 6144, va1_ + s_ + 6144);
          ATT_SBAR(); ATT_MM8(0, f0); ATT_MM8(1, f1); ATT_MM8(2, f2); ATT_MM8(3, f3); asm volatile("s_nop 15\n\ts_nop 15" ::: "memory"); }
#undef ATT_STEP_A
    }
    l_out = l_reg;
    asm volatile("s_waitcnt lgkmcnt(0)" ::: "memory"); __builtin_amdgcn_s_barrier(); asm volatile("" ::: "memory");
#undef ATT_ADV
#undef ATT_ISSUE
#undef ATT_WAITBAR
#undef ATT_RESC
}

template <int VAR> __device__ __forceinline__ void attn_unit(const bf16* __restrict__ Q1, const bf16* __restrict__ K1, const unsigned char* __restrict__ V1, bf16* __restrict__ ao, int b, int hp, int qb, char* lds, const float* lamp, const float* subln) {
    int tid_ = threadIdx.x; asm volatile("" : "+v"(tid_));
    const int tid = tid_, wid = tid >> 6, lane = tid & 63, r32 = lane & 31, hi = lane >> 5;
    float* wsf = (float*)(lds + OFF_WS) + wid * 64;
    unsigned* o1s = (unsigned*)(lds + OFF_O1 + wid * 8192);
    const size_t qrow0 = (size_t)b * SEQ + (size_t)qb * 256;
    f32x16 o[4]; float l;
    float ssq[16];
#pragma unroll 1
    for (int hh = 0; hh < 2; ++hh) {
        head_pass<VAR>(Q1, K1, V1, b, 2 * hp + hh, hp, qrow0, lds, o, l);
        if (hi == 0) wsf[r32] = l; asm volatile("s_waitcnt lgkmcnt(0)" ::: "memory");
        float rli[16];
#pragma unroll
        for (int r = 0; r < 16; ++r) { rli[r] = __builtin_amdgcn_rcpf(wsf[crow(r, hi)]); ssq[r] = 0.f; }
        if (hh == 0) {
#pragma unroll
            for (int d0 = 0; d0 < 4; ++d0)
#pragma unroll
                for (int r = 0; r < 16; r += 2) o1s[(d0 * 8 + (r >> 1)) * 64 + lane] = cvtpk(o[d0][r] * rli[r], o[d0][r + 1] * rli[r + 1]);
            __syncthreads();
        } else {
            asm volatile("" : "+s"(lamp)); const float lam = *lamp;
#pragma unroll
            for (int d0 = 0; d0 < 4; ++d0)
#pragma unroll
                for (int r = 0; r < 16; r += 2) { const unsigned w = o1s[(d0 * 8 + (r >> 1)) * 64 + lane];
                    const float a0 = bflo(w) - lam * (o[d0][r] * rli[r]), a1 = bfhi(w) - lam * (o[d0][r + 1] * rli[r + 1]);
                    o[d0][r] = a0; o[d0][r + 1] = a1; ssq[r] += a0 * a0; ssq[r + 1] += a1 * a1; }
        }
    }
#pragma unroll
    for (int r = 0; r < 16; ++r) { float s = ssq[r];
        s += __shfl_xor(s, 1); s += __shfl_xor(s, 2); s += __shfl_xor(s, 4); s += __shfl_xor(s, 8); s += __shfl_xor(s, 16);
        ssq[r] = 1.0f / sqrtf(s * (1.0f / 128.0f) + EPS) * (1.0f - LAMBDA_INIT); }
    asm volatile("s_waitcnt lgkmcnt(0)" ::: "memory");
    bf16* stg = (bf16*)o1s;
    asm volatile("" : "+s"(subln));
#pragma unroll
    for (int d0 = 0; d0 < 4; ++d0) { const float g = subln[d0 * 32 + r32];
#pragma unroll
        for (int r = 0; r < 16; ++r) stg[crow(r, hi) * 128 + d0 * 32 + r32] = (bf16)f2bf(o[d0][r] * ssq[r] * g); }
    asm volatile("s_waitcnt lgkmcnt(0)" ::: "memory");
    bf16* Ow = ao + (qrow0 + wid * 32) * D + hp * 128;
#pragma unroll
    for (int i = 0; i < 8; ++i) { const int row = i * 4 + (lane >> 4), ch = lane & 15; const u32x4 v = *(const u32x4*)(stg + row * 128 + ch * 8); *(u32x4*)(Ow + (size_t)row * D + ch * 8) = v; }
    asm volatile("s_waitcnt lgkmcnt(0)" ::: "memory");
    __syncthreads();
}
#undef ATT_SBAR
}

__device__ __forceinline__ void v8_prep(Frame& F) {
    const bf16* V1 = (const bf16*)(F.ws + WS_VH1); unsigned char* V8 = (unsigned char*)(F.ws + WS_V8);
    LAS bf16* buf = (LAS bf16*)(F.lds + F.wave * 16384);
    const int gw = F.vcu * NWAVES + F.wave, NGW = F.G * NWAVES, lane = F.lane;
    for (int it = gw; it < 8 * att::NVTILE; it += NGW) {
        const int hv = it / att::NVTILE, tile = it % att::NVTILE;
        const bf16* src = V1 + ((size_t)hv * MALL + (size_t)tile * 64) * 128;
#pragma unroll
        for (int i = 0; i < 16; ++i) *(LAS v4u*)(buf + i * 512 + lane * 8) = *(const GAS v4u*)(src + i * 512 + lane * 8);
        LDS_WAIT(); asm volatile("" ::: "memory");
        unsigned char* dst = V8 + (size_t)it * att::SHM_V;
#pragma unroll
        for (int cc = 0; cc < 2; ++cc) { const int n = lane + 64 * cc; const int sw = (n >> 2) & 3;
#pragma unroll
            for (int c = 0; c < 4; ++c) { const int kb = c >> 1, half = c & 1; v4u w;
#pragma unroll
                for (int q = 0; q < 4; ++q) { const int key0 = 32 * half + 8 * q + 4 * kb;
                    w[q] = pk4_fp8(bf2f(buf[(key0 + 0) * 128 + n]), bf2f(buf[(key0 + 1) * 128 + n]), bf2f(buf[(key0 + 2) * 128 + n]), bf2f(buf[(key0 + 3) * 128 + n])); }
                *(GAS v4u*)(dst + n * 64 + ((c ^ sw) << 4)) = w; } }
        LDS_WAIT(); asm volatile("" ::: "memory");
    }
}

template <int VAR> __device__ __forceinline__ void attn_phase(Frame& F, const Args& a, bf16* ao) {
    const bf16* Q1 = (const bf16*)(F.ws + WS_QH1); const bf16* K1 = (const bf16*)(F.ws + WS_KH1); const unsigned char* V1 = (const unsigned char*)(F.ws + WS_V8);
    const float* lamp = (const float*)(F.ws + WS_LAM);
    for (int unit = F.vcu; unit < NBATCH * 8 * 16; unit += F.G) {
        const int qb = unit & 15, hp = (unit >> 4) & 7, b = unit >> 7;
        att::attn_unit<VAR>(Q1, K1, V1, ao, b, hp, qb, (char*)F.lds, lamp, a.in[I_L1_SUBLN]);
    }
}


namespace ret {
using s16x4  = __attribute__((ext_vector_type(4))) short;
using f32x16 = __attribute__((ext_vector_type(16))) float;
typedef short v4i16_t __attribute__((ext_vector_type(4)));
constexpr int C = 32, NSTEP = (SEQ + CTXL) / C;
constexpr int ST_Q = 0, ST_K = 16384, ST_V = 32768, ST_SC = 40960, ST_BYTES = 43008, NSTAGE = 3;
constexpr int XBUF_OFF = NSTAGE * ST_BYTES, RET_LDS = XBUF_OFF + NWAVES * 4096;
constexpr size_t WS_SSQ = 836 * MiB;
constexpr size_t WS_SC = 842 * MiB;

__device__ __forceinline__ void glds16(const void* gsrc, unsigned lds_dst) { unsigned keep;
    asm volatile("s_mov_b32 %0, m0\n\ts_mov_b32 m0, %2\n\ts_nop 0\n\tglobal_load_lds_dwordx4 %1, off\n\ts_mov_b32 m0, %0" : "=&s"(keep) : "v"(gsrc), "s"(lds_dst) : "memory"); }
__device__ __forceinline__ s16x4 vtr(const LAS char* p) { return __builtin_bit_cast(s16x4, __builtin_amdgcn_ds_read_tr16_b64_v4i16((LAS v4i16_t*)p)); }

__device__ __forceinline__ void ret_scores(Frame& F) {
    const bf16* Qh = (const bf16*)(F.ws + WS_QH0); const bf16* Kh = (const bf16*)(F.ws + WS_KH0); bf16* sc = (bf16*)(F.ws + WS_SC);
    const int gw = F.vcu * NWAVES + F.wave, NGW = F.G * NWAVES;
    const int r32 = F.lane & 31, hh = F.lane >> 5;
    for (int task = gw; task < (MALL / C) * RH; task += NGW) {
        const int h = task & 3, ch = task >> 2;
        const bf16* qp = Qh + ((size_t)h * MALL + (size_t)ch * C + r32) * 256 + hh * 8;
        const bf16* kp = Kh + ((size_t)h * MALL + (size_t)ch * C + r32) * 256 + hh * 8;
        f32x16 acc = f32x16{};
        bf16x8 a[16], b[16];
#pragma unroll
        for (int s = 0; s < 16; ++s) { a[s] = *reinterpret_cast<const bf16x8*>(qp + s * 16); b[s] = *reinterpret_cast<const bf16x8*>(kp + s * 16); }
#pragma unroll
        for (int s = 0; s < 16; ++s) acc = __builtin_amdgcn_mfma_f32_32x32x16_bf16(a[s], b[s], acc, 0, 0, 0);
        bf16* tp = sc + (size_t)task * 1024;
#pragma unroll
        for (int r = 0; r < 16; ++r) { const int i = (r & 3) + 8 * (r >> 2) + 4 * hh; tp[i * 32 + r32] = (bf16)f2bf(acc[r]); }
    }
}

__device__ __forceinline__ size_t step_row0(int b, int dir, int t) {
    if (t < 8) { const int blk = dir ? 7 - t : t; return (size_t)NLAT + (size_t)b * CTXL + (size_t)blk * C; }
    const int blk = dir ? 127 - (t - 8) : (t - 8); return (size_t)b * SEQ + (size_t)blk * C;
}

template <int SV = 0> __device__ __forceinline__ void ret_scan(Frame& F, const Args& a) {
    const char* qb = (const char*)(F.ws + WS_QH0); const char* kb = (const char*)(F.ws + WS_KH0); const char* vb = (const char*)(F.ws + WS_VQ0); const char* scb = (const char*)(F.ws + WS_SC);
    for (int unit = F.vcu; unit < NBATCH * RH * 2 * 4; unit += F.G) {
        int tid_ = threadIdx.x; asm volatile("" : "+v"(tid_));
        const int tid = tid_, lane = tid & 63, w = __builtin_amdgcn_readfirstlane(tid >> 6), dh = w >> 2, vs = w & 3, r32 = lane & 31, hh = lane >> 5;
        const int vq = unit & 3, dir = (unit >> 2) & 1, h = (unit >> 3) & 3, b = unit >> 5;
        const float logit = a.in[I_L0_DECAY][dir * RH + h];
        const float lg2 = -__builtin_amdgcn_logf(1.0f + __builtin_amdgcn_exp2f(-logit * LOG2E));
        const float gC = __builtin_amdgcn_exp2f(lg2 * (float)C), gCi = __builtin_amdgcn_exp2f(-lg2 * (float)C);
        float kd[2][8];
#pragma unroll
        for (int s = 0; s < 2; ++s)
#pragma unroll
            for (int jj = 0; jj < 8; ++jj) { const int j = 16 * s + 8 * hh + jj; kd[s][jj] = __builtin_amdgcn_exp2f(lg2 * (float)(dir ? j : 31 - j)); }
        const int om = 4 * w + (lane >> 4);
        const float rsc = __builtin_amdgcn_exp2f(-lg2 * (float)(dir ? om : 31 - om));
        unsigned pm[4];
#pragma unroll
        for (int e = 0; e < 4; ++e) { const int j0 = 16 * dh + 8 * hh + 2 * e, j1 = j0 + 1; const bool k0 = dir ? (j0 >= r32) : (j0 <= r32), k1 = dir ? (j1 >= r32) : (j1 <= r32);
            pm[e] = (k0 ? 0x0000ffffu : 0u) | (k1 ? 0xffff0000u : 0u); }
        unsigned offq[2], offk[2];
#pragma unroll
        for (int p = 0; p < 2; ++p) { const int i = 2 * (2 * w + p) + (lane >> 5), cp = lane & 31;
            offq[p] = (unsigned)(i * 512 + ((cp ^ (i & 15)) << 4)); offk[p] = (unsigned)(i * 512 + ((cp ^ ((i & 3) << 2)) << 4)); }
        unsigned offv; { const int j = 4 * w + (lane >> 4), cp = lane & 15; offv = (unsigned)(j * 256 + ((cp ^ ((j & 3) << 2)) << 4)); }
        const char* qhb = qb + (size_t)h * MALL * 512; const char* khb = kb + (size_t)h * MALL * 512; const char* vhb = vb + (size_t)(h * 4 + vq) * MALL * 256;
        unsigned offs; { const int i = 16 * (w & 1) + (lane >> 2), cp = lane & 3; offs = (unsigned)(i * 64 + ((cp ^ ((i >> 2) & 3)) << 4)); }
        LAS unsigned char* L = F.lds;
        const unsigned lbase = (unsigned)(uintptr_t)L;
#define RET_ISSUE(t_) do { const int t__ = (t_); const unsigned sb_ = lbase + (unsigned)((t__ % NSTAGE) * ST_BYTES); const size_t r0_ = step_row0(b, dir, t__); const char* gq_ = qhb + r0_ * 512; const char* gk_ = khb + r0_ * 512; const char* gv_ = vhb + r0_ * 256; \
        glds16(gq_ + offq[0], (unsigned)__builtin_amdgcn_readfirstlane(sb_ + ST_Q + (2 * w) * 1024)); \
        glds16(gq_ + offq[1], (unsigned)__builtin_amdgcn_readfirstlane(sb_ + ST_Q + (2 * w + 1) * 1024)); \
        glds16(gk_ + offk[0], (unsigned)__builtin_amdgcn_readfirstlane(sb_ + ST_K + (2 * w) * 1024)); \
        glds16(gk_ + offk[1], (unsigned)__builtin_amdgcn_readfirstlane(sb_ + ST_K + (2 * w + 1) * 1024)); \
        glds16(gv_ + offv, (unsigned)__builtin_amdgcn_readfirstlane(sb_ + ST_V + w * 1024)); \
        if (w < 2) glds16(scb + ((r0_ >> 5) * 4 + h) * 2048 + offs, (unsigned)__builtin_amdgcn_readfirstlane(sb_ + ST_SC + w * 1024)); } while (0)
        const int qrow = ST_Q + r32 * 512; const int qx = r32 & 15;
        const int G = lane >> 4, il = lane & 15, tq = il >> 2, tp = il & 3;
        const int kcolb = (128 * dh + 16 * (G & 1) + 8 * (tp & 1) + 4 * (tp >> 1)) * 2;
        const int vcolb = (32 * vs + 16 * (G & 1) + 4 * tp) * 2;
        f32x16 S[4];
#pragma unroll
        for (int T = 0; T < 4; ++T) S[T] = f32x16{};
        float cinv = 1.0f, cfw = 1.0f;
        bf16* outp = (bf16*)(F.ws + (dir ? WS_OB : WS_OF));
        float* ssqp = (float*)(F.ws + WS_SSQ);

        __builtin_amdgcn_s_barrier();
        if (SV != 2 && SV != 3) { RET_ISSUE(0); RET_ISSUE(1); }
        for (int t = 0; t < NSTEP; ++t) {
            if (t == 0) { if (w < 2) asm volatile("s_waitcnt vmcnt(6)" ::: "memory"); else asm volatile("s_waitcnt vmcnt(5)" ::: "memory"); }
            else if (t == NSTEP - 1) asm volatile("s_waitcnt vmcnt(4)" ::: "memory");
            else        { if (w < 2) asm volatile("s_waitcnt vmcnt(8)" ::: "memory"); else asm volatile("s_waitcnt vmcnt(7)" ::: "memory"); }
            __builtin_amdgcn_s_barrier(); asm volatile("" ::: "memory");
            if (SV != 2 && SV != 3) { if (t + 2 < NSTEP) RET_ISSUE(t + 2); }
            const LAS char* sb = (const LAS char*)(L + (t % NSTAGE) * ST_BYTES);
            f32x16 acc = f32x16{};
            if (SV != 1 && SV != 3) {
            cinv *= gCi; cfw *= gC;
            bf16x8 vd[2];
#pragma unroll
            for (int s = 0; s < 2; ++s) {
                const int j0 = 16 * s + 8 * (G >> 1) + tq;
                const int cph = (((vcolb >> 4) ^ (tq << 2)) << 4) + (vcolb & 8);
                const s16x4 lo = vtr(sb + ST_V + j0 * 256 + cph), hi = vtr(sb + ST_V + (j0 + 4) * 256 + cph);
                float f[8];
#pragma unroll
                for (int e = 0; e < 4; ++e) { f[e] = bf2f((unsigned short)lo[e]) * (kd[s][e] * cinv); f[4 + e] = bf2f((unsigned short)hi[e]) * (kd[s][4 + e] * cinv); }
                v4u pk; pk.x = pk2(f[0], f[1]); pk.y = pk2(f[2], f[3]); pk.z = pk2(f[4], f[5]); pk.w = pk2(f[6], f[7]);
                vd[s] = __builtin_bit_cast(bf16x8, pk);
            }
#pragma unroll
            for (int T = 0; T < 4; ++T)
#pragma unroll
                for (int s = 0; s < 2; ++s) {
                    const int cL = 16 * dh + 4 * T + 2 * s + hh;
                    const bf16x8 qa = *(const LAS bf16x8*)(sb + qrow + ((cL ^ qx) << 4));
                    v4u pk; pk.x = pk2(S[T][8 * s + 0], S[T][8 * s + 1]); pk.y = pk2(S[T][8 * s + 2], S[T][8 * s + 3]); pk.z = pk2(S[T][8 * s + 4], S[T][8 * s + 5]); pk.w = pk2(S[T][8 * s + 6], S[T][8 * s + 7]);
                    acc = __builtin_amdgcn_mfma_f32_32x32x16_bf16(qa, __builtin_bit_cast(bf16x8, pk), acc, 0, 0, 0);
                }
            {
                const int cL = 2 * dh + hh;
                v4u pw = *(const LAS v4u*)(sb + ST_SC + r32 * 64 + ((cL ^ ((r32 >> 2) & 3)) << 4));
                pw.x &= pm[0]; pw.y &= pm[1]; pw.z &= pm[2]; pw.w &= pm[3];
                acc = __builtin_amdgcn_mfma_f32_32x32x16_bf16(__builtin_bit_cast(bf16x8, pw), dh ? vd[1] : vd[0], acc, 0, 0, 0);
            }
#pragma unroll
            for (int T = 0; T < 4; ++T)
#pragma unroll
                for (int s = 0; s < 2; ++s) {
                    const int j0 = 16 * s + 8 * (G >> 1) + tq;
                    const int cb = kcolb + 64 * T;
                    const int cph = (((cb >> 4) ^ (tq << 2)) << 4) + (cb & 8);
                    const s16x4 lo = vtr(sb + ST_K + j0 * 512 + cph), hi = vtr(sb + ST_K + (j0 + 4) * 512 + cph);
                    const bf16x8 ka = (bf16x8){lo[0], lo[1], lo[2], lo[3], hi[0], hi[1], hi[2], hi[3]};
                    S[T] = __builtin_amdgcn_mfma_f32_32x32x16_bf16(ka, vd[s], S[T], 0, 0, 0);
                }
            }
            if ((t & 7) == 7) {
#pragma unroll
                for (int T = 0; T < 4; ++T) S[T] = S[T] * cfw;
            }
            { LAS float* xw = (LAS float*)(L + XBUF_OFF + dh * 16384) + (4 * hh) * 128 + vs * 32 + r32;
#pragma unroll
              for (int r = 0; r < 16; ++r) xw[((r & 3) + 8 * (r >> 2)) * 128] = acc[r]; }
            asm volatile("s_waitcnt lgkmcnt(0)" ::: "memory");
            __builtin_amdgcn_s_barrier(); asm volatile("" ::: "memory");
            {
                const int v0 = (lane & 15) * 8;
                const LAS float* p0 = (const LAS float*)(L + XBUF_OFF) + om * 128 + v0;
                const LAS float* p1 = (const LAS float*)(L + XBUF_OFF + 16384) + om * 128 + v0;
                const f32x4 a0 = *(const LAS f32x4*)p0, a1 = *(const LAS f32x4*)(p0 + 4), b0 = *(const LAS f32x4*)p1, b1 = *(const LAS f32x4*)(p1 + 4);
                const float rs_ = rsc * cfw; const f32x4 o0 = (a0 + b0) * rs_, o1 = (a1 + b1) * rs_;
                float ss = (o0.x * o0.x + o0.y * o0.y) + (o0.z * o0.z + o0.w * o0.w) + (o1.x * o1.x + o1.y * o1.y) + (o1.z * o1.z + o1.w * o1.w);
                ss += __builtin_bit_cast(float, __builtin_amdgcn_update_dpp(0, __builtin_bit_cast(int, ss), 0xB1, 0xF, 0xF, true));
                ss += __builtin_bit_cast(float, __builtin_amdgcn_update_dpp(0, __builtin_bit_cast(int, ss), 0x4E, 0xF, 0xF, true));
                ss += __builtin_bit_cast(float, __builtin_amdgcn_update_dpp(0, __builtin_bit_cast(int, ss), 0x124, 0xF, 0xF, true));
                ss += __builtin_bit_cast(float, __builtin_amdgcn_update_dpp(0, __builtin_bit_cast(int, ss), 0x128, 0xF, 0xF, true));
                const size_t r0 = step_row0(b, dir, t);
                v4u pk; pk.x = pk2(o0.x, o0.y); pk.y = pk2(o0.z, o0.w); pk.z = pk2(o1.x, o1.y); pk.w = pk2(o1.z, o1.w);
                *(GAS v4u*)(outp + (r0 + om) * 2048 + h * 512 + vq * 128 + v0) = pk;
                if ((lane & 15) == 0) ssqp[(((r0 + om) * RH + h) * 2 + dir) * 4 + vq] = ss;
            }
            asm volatile("s_waitcnt lgkmcnt(0)" ::: "memory");
            if ((t & 7) == 7) { cinv = 1.0f; cfw = 1.0f; }
        }
        asm volatile("s_waitcnt vmcnt(0)" ::: "memory");
#undef RET_ISSUE
    }
    __builtin_amdgcn_s_barrier();
}
}

__device__ __forceinline__ void moe_counts(Frame& F, int (&cnt)[NE]) {
#pragma unroll
    for (int e = 0; e < NE; ++e) cnt[e] = __builtin_amdgcn_readfirstlane((int)__hip_atomic_load((unsigned*)(F.ctl + CW_MOECNT + 64 * e), RLX_AGENT));
}
__device__ __forceinline__ void moe_gather(Frame& F) {
    int cnt[NE]; moe_counts(F, cnt);
    int base[NE]; int acc = 0;
#pragma unroll
    for (int e = 0; e < NE; ++e) { base[e] = acc; acc += (cnt[e] + 255) & ~255; }
    const int* te = (const int*)(F.ws + WS_ROUTE); int* tpos = (int*)(F.ws + WS_ROUTE + (size_t)NLAT * 8);
    const bf16* hb = (const bf16*)(F.ws + WS_H); bf16* hp = (bf16*)(F.ws + WS_HP);
    const int gw = F.vcu * NWAVES + F.wave, NGW = F.G * NWAVES;
    for (int r = gw; r < NLAT; r += NGW) {
        const int e0 = te[2 * r], e1 = te[2 * r + 1]; const int p0 = tpos[2 * r], p1 = tpos[2 * r + 1];
        int b0 = 0, b1 = 0;
#pragma unroll
        for (int e = 0; e < NE; ++e) { b0 = (e0 == e) ? base[e] : b0; b1 = (e1 == e) ? base[e] : b1; }
        const int s0 = b0 + p0, s1 = b1 + p1;
        const v4u x0 = *(const GAS v4u*)((const unsigned char*)hb + (size_t)r * D + F.lane * 16);
        *(GAS v4u*)((unsigned char*)hp + (size_t)s0 * D + F.lane * 16) = x0; *(GAS v4u*)((unsigned char*)hp + (size_t)s1 * D + F.lane * 16) = x0;
        if (F.lane == 0) { tpos[2 * r] = s0; tpos[2 * r + 1] = s1; }
    }
}
__device__ __forceinline__ void moe_order(Frame& F, pg8::MoeOrder& S, int nN) {
    int cnt[NE]; moe_counts(F, cnt);
    int ts[NE + 1]; ts[0] = 0;
#pragma unroll
    for (int e = 0; e < NE; ++e) ts[e + 1] = ts[e] + ((cnt[e] + 255) >> 8);
    S.nM = ts[NE]; S.nN = nN; S.nwg = S.nM * nN; S.G = F.G; S.c = F.cid;
    S.t1 = ts[1]; S.t2 = ts[2]; S.t3 = ts[3]; S.t4 = ts[4]; S.t5 = ts[5]; S.t6 = ts[6]; S.t7 = ts[7];
}

constexpr int N_PHASES = 22;
__global__ void __launch_bounds__(NTHREADS, 2) fwd(Args args) {
    extern __shared__ __attribute__((aligned(16))) unsigned char lds[];
    Frame F;
    F.lds = (LAS unsigned char*)lds; F.MISC = (volatile LAS unsigned*)(F.lds + MISC_OFF);
    F.tid = threadIdx.x; F.lane = F.tid & 63; F.wave = __builtin_amdgcn_readfirstlane(F.tid >> 6);
    F.G = gridDim.x; { const int bx = blockIdx.x; F.vcu = (F.G % 8 == 0) ? (bx % 8) * (F.G / 8) + bx / 8 : bx; F.cid = bx; }
    F.ws = args.ws; F.ctl = (gu32*)(args.ws + WS_CTL);
    for (int u = F.tid; u < 64; u += NTHREADS) ((LAS unsigned*)(F.lds + MISC_OFF))[u] = 0u;
    __syncthreads();
#if MK_PER_PHASE
    XcdBarrier bar; bar.bar = (unsigned*)(F.ctl + CW_BAR); bar.x = 0; bar.st = nullptr;
#define GRID_BAR() do { } while (0)
#else
    XcdBarrier bar = xcd_barrier_post((unsigned*)(F.ctl + CW_BAR), F.MISC + 8);
#define GRID_BAR() xcd_barrier(bar)
    if (F.tid == 0) { const unsigned x = xb_xcc_id(); F.MISC[16] = x; F.MISC[17] = __hip_atomic_fetch_add((unsigned*)(F.ctl + CW_XRANK + 64 * x), 1u, RLX_AGENT); }
#endif
    const int lo = args.ph_lo, hi = args.ph_hi;
#define IN(k) (lo <= (k) && (k) < hi)
#define SEAM(k) do { if (IN(k) && IN((k) + 1)) GRID_BAR(); } while (0)
    unsigned char* ws = args.ws;
    float* modv = (float*)(ws + WS_MODV);
    float* modv1 = modv + 9 * 6 * D;
    bf16* hbuf = (bf16*)(ws + WS_H);
    float* xctx = (float*)(ws + WS_XCTX);
    using pg8::Gemm; using pg8::StaticOrder;

    if (IN(0)) { for (int rep_ = 0; rep_ < ((PROBE_DUP & 1) ? 2 : 1); ++rep_) { p0_prologue(F, args); __syncthreads(); } SEAM(0); }
#if !MK_PER_PHASE
    if (IN(0) && IN(1)) {
        if (F.tid == 0) { const unsigned x = F.MISC[16]; unsigned pre = 0;
            for (unsigned j = 0; j < 16; ++j) { const unsigned c = __hip_atomic_load((unsigned*)(F.ctl + CW_XRANK + 64 * j), RLX_AGENT); pre += (j < x) ? c : 0u; }
            F.MISC[18] = pre + F.MISC[17]; }
        __syncthreads();
        F.vcu = __builtin_amdgcn_readfirstlane((int)F.MISC[18]); F.cid = (F.G % 8 == 0) ? (F.vcu % (F.G / 8)) * 8 + F.vcu / (F.G / 8) : F.vcu;
    }
#endif
    if (IN(1)) { RowPass P{MALL, args.in[I_X], args.in[I_CTX], nullptr, nullptr, nullptr, nullptr, nullptr, args.in[I_L0_NPREMIX], modv + 0 * D, modv + 1 * D, hbuf};
        row_pass<false, false, true, false>(F, args, P); SEAM(1); }
    if (IN(2)) { Gemm g{hbuf, (const bf16*)(ws + WS_W0IN), MALL, 4096, D, D}; StaticOrder S; S.init(MALL, 4096, F.G, F.cid);
        pg8::EpiQKV0 E{(bf16*)(ws + WS_QH0), (bf16*)(ws + WS_KH0), (bf16*)(ws + WS_VQ0), (const float*)(ws + WS_TAB0)};
        for (int rep_ = 0; rep_ < ((PROBE_DUP & 2) ? 2 : 1); ++rep_) { pg8::gemm_phase<pg8::EpiQKV0, StaticOrder, true, true>(F.lds, g, S, E); } if (IN(2) && IN(4)) GRID_BAR(); }
    if (IN(4)) { ret::ret_scores(F); SEAM(4); }
    if (IN(5)) { for (int rep_ = 0; rep_ < ((PROBE_DUP & 8) ? 2 : 1); ++rep_) ret::ret_scan<0>(F, args); SEAM(5); }
    if (IN(6)) { Gemm g{hbuf, (const bf16*)(ws + WS_W0IN) + (size_t)4096 * D, MALL, 4096, D, D}; StaticOrder S; S.init(MALL, 4096, F.G, F.cid);
        pg8::EpiGateMerge E{(bf16*)(ws + WS_OF), (const bf16*)(ws + WS_OB), (const float*)(ws + ret::WS_SSQ)};
        pg8::gemm_phase<pg8::EpiGateMerge, StaticOrder, true, true>(F.lds, g, S, E); if (IN(6) && IN(8)) GRID_BAR(); }
    if (IN(8)) { Gemm g{(const bf16*)(ws + WS_OF), (const bf16*)(ws + WS_W0OUT), MALL, D, 2048, 2048}; pg8::SplitOrder S; S.init(D, F.G, F.cid, USE_SPLITK ? 8 : 0, 4);
        pg8::EpiStoreSplit E{(bf16*)(ws + WS_A), D, (float*)(ws + WS_PART)};
        for (int rep_ = 0; rep_ < ((PROBE_DUP & 32) ? 2 : 1); ++rep_) { pg8::gemm_phase<pg8::EpiStoreSplit, pg8::SplitOrder, true, true>(F.lds, g, S, E); } SEAM(8); }
    if (IN(9)) { RowPass P{MALL, args.in[I_X], args.in[I_CTX], (float*)(ws + WS_X1), (float*)(ws + WS_X1C), (const bf16*)(ws + WS_A), args.in[I_L0_NPOSTMIX], modv + 2 * D, args.in[I_L0_NPREFFN], modv + 3 * D, modv + 4 * D, hbuf, (const float*)(ws + WS_PART)};
        row_pass<true, false, true, false, false, USE_SPLITK ? 8 : 0, false, true>(F, args, P); SEAM(9); }
    if (IN(10)) { Gemm g{hbuf, (const bf16*)(ws + WS_W0GU), MALL, 2 * DFF, D, D}; StaticOrder S; S.init(MALL, 2 * DFF, F.G, F.cid);
        pg8::EpiSwiglu E{(bf16*)(ws + WS_B), DFF};
        for (int rep_ = 0; rep_ < ((PROBE_DUP & 2) ? 2 : 1); ++rep_) { pg8::gemm_phase<pg8::EpiSwiglu, StaticOrder, true, true>(F.lds, g, S, E); } SEAM(10); }
    if (IN(11)) { Gemm g{(const bf16*)(ws + WS_B), (const bf16*)(ws + WS_W0DN), MALL, D, DFF, DFF}; pg8::SplitOrder S; S.init(D, F.G, F.cid, USE_SPLITK ? 11 : 0, 4);
        pg8::EpiStoreSplit E{(bf16*)(ws + WS_A), D, (float*)(ws + WS_PART)};
        for (int rep_ = 0; rep_ < ((PROBE_DUP & 32) ? 2 : 1); ++rep_) { pg8::gemm_phase<pg8::EpiStoreSplit, pg8::SplitOrder, true, true>(F.lds, g, S, E); } SEAM(11); }
    if (IN(12)) { RowPass P{MALL, (const float*)(ws + WS_X1), (const float*)(ws + WS_X1C), (float*)(ws + WS_X2), nullptr, (const bf16*)(ws + WS_A), args.in[I_L0_NPOSTFFN], modv + 5 * D, args.in[I_L1_NPREMIX], modv1 + 0 * D, modv1 + 1 * D, hbuf, (const float*)(ws + WS_PART)};
        row_pass<true, false, true, false, true, USE_SPLITK ? 11 : 0, true, true>(F, args, P); SEAM(12); }
    if (IN(13)) { Gemm g{hbuf, (const bf16*)(ws + WS_W1IN), MALL, 3072, D / 2, D / 2, MOE_SA, MOE_SB}; StaticOrder S; S.init(MALL, 3072, F.G, F.cid);
        pg8::EpiQKV1 E{(bf16*)(ws + WS_QH1), (bf16*)(ws + WS_KH1), (bf16*)(ws + WS_VH1), (const float*)(ws + WS_TAB1)};
        for (int rep_ = 0; rep_ < ((PROBE_DUP & 2) ? 2 : 1); ++rep_) { pg8::gemm_phase<pg8::EpiQKV1, StaticOrder, true, true, true>(F.lds, g, S, E); } SEAM(13); }
    if (IN(14)) { v8_prep(F); SEAM(14); }
    if (IN(15)) { attn_phase<0>(F, args, (bf16*)(ws + WS_B)); SEAM(15); }
    if (IN(16)) { Gemm g{(const bf16*)(ws + WS_B), (const bf16*)(ws + WS_W1OUT), NLAT, D, D, D}; StaticOrder S; S.init(NLAT, D, F.G, F.cid);
        pg8::EpiStore E{(bf16*)(ws + WS_A), D};
        for (int rep_ = 0; rep_ < ((PROBE_DUP & 2) ? 2 : 1); ++rep_) { pg8::gemm_phase<pg8::EpiStore, StaticOrder, true, true>(F.lds, g, S, E); } SEAM(16); }
    if (IN(17)) { RowPass P{NLAT, (const float*)(ws + WS_X2), nullptr, (float*)(ws + WS_X3), nullptr, (const bf16*)(ws + WS_A), args.in[I_L1_NPOSTMIX], modv1 + 2 * D, args.in[I_L1_NPREFFN], modv1 + 3 * D, modv1 + 4 * D, hbuf};
        row_pass<true, false, true, true, true, 0, true, true>(F, args, P); SEAM(17); }
    if (IN(18)) { moe_gather(F); SEAM(18); }
    if (IN(19)) { Gemm g{(const bf16*)(ws + WS_HP), (const bf16*)(ws + WS_WMGU), MOE_ROWS, 2 * DFE, D / 2, D / 2, MOE_SA, MOE_SB}; pg8::MoeOrder S; moe_order(F, S, 2 * DFE / 256);
        pg8::EpiSwiglu8 E{(unsigned char*)(ws + WS_ACT1), DFE};
        for (int rep_ = 0; rep_ < ((PROBE_DUP & 16) ? 2 : 1); ++rep_) { pg8::gemm_phase<pg8::EpiSwiglu8, pg8::MoeOrder, true, true, true>(F.lds, g, S, E); } SEAM(19); }
    if (IN(20)) { Gemm g{(const bf16*)(ws + WS_ACT1), (const bf16*)(ws + WS_WMDN), MOE_ROWS, D, DFE / 2, DFE / 2, MOE_SA, MOE_SB}; pg8::MoeOrder S; moe_order(F, S, D / 256);
        pg8::EpiStore E{(bf16*)(ws + WS_Y1), D};
        for (int rep_ = 0; rep_ < ((PROBE_DUP & 16) ? 2 : 1); ++rep_) { pg8::gemm_phase<pg8::EpiStore, pg8::MoeOrder, true, true, true>(F.lds, g, S, E); } SEAM(20); }
    if (IN(21)) { RowPass P{NLAT, (const float*)(ws + WS_X3), nullptr, args.out, nullptr, (const bf16*)(ws + WS_Y1), args.in[I_L1_NPOSTFFN], modv1 + 5 * D, nullptr, nullptr, nullptr, nullptr};
        row_pass<false, true, false, false, false, 0, true, false>(F, args, P); }
#undef IN
#undef SEAM
}

#ifndef PROBE_ATT
#define PROBE_ATT -1
#endif
#if PROBE_ATT >= 0
__global__ void __launch_bounds__(NTHREADS, 2) probe_k(Args args) {
    extern __shared__ __attribute__((aligned(16))) unsigned char lds[];
    Frame F;
    F.lds = (LAS unsigned char*)lds; F.MISC = (volatile LAS unsigned*)(F.lds + MISC_OFF);
    F.tid = threadIdx.x; F.lane = F.tid & 63; F.wave = __builtin_amdgcn_readfirstlane(F.tid >> 6);
    F.G = gridDim.x; { const int bx = blockIdx.x; F.vcu = (F.G % 8 == 0) ? (bx % 8) * (F.G / 8) + bx / 8 : bx; F.cid = bx; }
    F.ws = args.ws; F.ctl = (gu32*)(args.ws + WS_CTL);
#if PROBE_ATT < 10
    attn_phase<PROBE_ATT>(F, args, (bf16*)(args.ws + WS_END - 64 * MiB));
#else
    ret::ret_scan<PROBE_ATT - 10>(F, args);
#endif
}
#endif
extern "C" void kernel_launch(void* const* d_in, const int* in_sizes, int n_in, void* d_out, int out_size, void* d_ws, size_t ws_size, hipStream_t stream) {
    static int grid = 0;
    if (grid == 0) {
        if (n_in != N_IN || out_size != NLAT * D || ws_size < WS_END) { fprintf(stderr, "kernel_launch: unexpected shapes n_in %d out %d ws %zu\n", n_in, out_size, ws_size); grid = -1; return; }
        int dev = 0, cus = 0, per_cu = 0;
        if (hipGetDevice(&dev) != hipSuccess || hipDeviceGetAttribute(&cus, hipDeviceAttributeMultiprocessorCount, dev) != hipSuccess) { grid = -1; return; }
        if (hipFuncSetAttribute((const void*)fwd, hipFuncAttributeMaxDynamicSharedMemorySize, LDS_BYTES) != hipSuccess) { fprintf(stderr, "kernel_launch: hipFuncSetAttribute failed\n"); grid = -1; return; }
        if (hipOccupancyMaxActiveBlocksPerMultiprocessor(&per_cu, (const void*)fwd, NTHREADS, LDS_BYTES) != hipSuccess || per_cu < 1) fprintf(stderr, "kernel_launch: occupancy query says %d\n", per_cu);
        (void)hipGetLastError();
        grid = cus;
    }
    if (grid < 0) return;
    (void)hipMemsetAsync((char*)d_ws + WS_CTL, 0, CTL_ZERO_BYTES, stream);
    Args a{};
    for (int i = 0; i < N_IN; ++i) a.in[i] = (const float*)d_in[i];
    a.out = (float*)d_out; a.ws = (unsigned char*)d_ws;
#if MK_PER_PHASE
    for (int p = 0; p < N_PHASES; ++p) { a.ph_lo = p; a.ph_hi = p + 1; hipLaunchKernelGGL(fwd, dim3(grid), dim3(NTHREADS), LDS_BYTES, stream, a); }
#else
    a.ph_lo = 0; a.ph_hi = N_PHASES; hipLaunchKernelGGL(fwd, dim3(grid), dim3(NTHREADS), LDS_BYTES, stream, a);
#endif
#if PROBE_ATT >= 0
    (void)hipFuncSetAttribute((const void*)probe_k, hipFuncAttributeMaxDynamicSharedMemorySize, LDS_BYTES);
    hipLaunchKernelGGL(probe_k, dim3(grid), dim3(NTHREADS), LDS_BYTES, stream, a);
#endif
}
```

```cpp
#include <hip/hip_runtime.h>
#include <cstdio>
#include <cstdint>
namespace pg8 {
#define PG8_LAS __attribute__((address_space(3)))
typedef unsigned short bf16_t;
typedef short bf16x8 __attribute__((ext_vector_type(8)));
typedef float f32x4 __attribute__((ext_vector_type(4)));
typedef unsigned u32x4 __attribute__((ext_vector_type(4)));
constexpr int BM = 256, BK = 64, HALF = 128, HTB = HALF * BK * 2  , STAGE_BYTES = 8 * HTB, NXCD = 8, WGM = 8;

__host__ __device__ __forceinline__ int lds_byte(int r, int c) { const int st = (r >> 4) * 2 + (c >> 5), rr = r & 15, cc = c & 31, ob = rr * 64 + cc * 2; return st * 1024 + (ob ^ (((ob >> 9) & 1) << 5)); }
__host__ __device__ __forceinline__ void stage_rc(int b, int& R, int& C) { const int st = b / 1024, sb = b % 1024, swz = sb ^ (((sb >> 9) & 1) << 5); R = (st >> 1) * 16 + swz / 64; C = (st & 1) * 32 + (swz % 64) / 2; }
__host__ __device__ __forceinline__ int perm32(int rho) { const int n = rho >> 4, i = rho & 15; return 8 * (i >> 2) + 4 * n + (i & 3); }

struct Unit { int pm, pn, pc, k0, nt, ks; };
struct Gemm { const bf16_t* A; const bf16_t* Bt; int M, N, K, lda; int sA, sB; const float* rsA; const float* rsB; };

struct StaticOrder {
    int nM, nN, nwg, G, c;
    __host__ __device__ __forceinline__ void init(int M, int N, int G_, int c_) { nM = M / BM; nN = N / BM; nwg = nM * nN; G = G_; c = c_; }
    __host__ __device__ __forceinline__ bool next(int i, Unit& u) const {
        const long L = (long)i * G + c; if (L >= nwg) return false;
        int wgid = (int)L; { const int q = nwg / NXCD, r = nwg % NXCD, xcd = wgid % NXCD, off = wgid / NXCD; wgid = (xcd < r ? xcd * (q + 1) : r * (q + 1) + (xcd - r) * q) + off; }
        const int nig = WGM * nN, gid = wgid / nig, fm = gid * WGM, gsz = (nM - fm) < WGM ? (nM - fm) : WGM;
        u.pm = fm + ((wgid % nig) % gsz); u.pn = (wgid % nig) / gsz; u.pc = u.pn; u.k0 = 0; u.nt = 0; u.ks = -1; return true;
    }
    __device__ __forceinline__ void a_ready(const Unit&) const {}
    __device__ __forceinline__ void done(const Unit&) const {}
};

__device__ __forceinline__ unsigned cvt_pk_bf16(float lo, float hi) { unsigned r; asm volatile("v_cvt_pk_bf16_f32 %0, %1, %2" : "=v"(r) : "v"(lo), "v"(hi)); return r; }
typedef float f32x2 __attribute__((ext_vector_type(2)));
typedef int v4i_t __attribute__((ext_vector_type(4))); typedef int v8i_t __attribute__((ext_vector_type(8)));
template <class Epi, class Sched, bool ALIGN_EPI = false, bool SP2 = false, int MODE = 0>
__device__ __forceinline__ void gemm_phase(PG8_LAS unsigned char* lds, const Gemm g, const Sched& S, const Epi& E) {
    constexpr bool FP8 = (MODE == 1), I8 = (MODE == 2);
    const int tid = threadIdx.x, wid = __builtin_amdgcn_readfirstlane(tid >> 6), lane = tid & 63, wr = wid >> 2, wc = wid & 3, fr = lane & 15, fq = lane >> 4;
    const int K = g.K; int nt = K / BK;
    unsigned voffA[2], voffB[2];
#pragma unroll
    for (int i = 0; i < 2; ++i) { int R, C; stage_rc(tid * 16 + i * 8192, R, C); const int Rb = Epi::PERM ? ((R & ~31) + perm32(R & 31)) : R;
        voffA[i] = (unsigned)(R * g.lda + C) * 2u; voffB[i] = (unsigned)(Rb * K + C) * 2u; }
    const size_t kstep = (size_t)(BK * 2);
    const size_t hstepA = (size_t)HALF * g.lda * 2, hstepB = (size_t)HALF * K * 2;
    const size_t tstepA = 2 * hstepA, tstepB = 2 * hstepB;
    const unsigned ldsw = (unsigned)wid * 1024u;
    const int aoff = lds_byte(wr * 64 + fr, fq * 8), boff = lds_byte(wc * 32 + fr, fq * 8);
#define PG8_SA(b, h) (((b) * 2 + (h)) * HTB)
#define PG8_SB(b, h) ((4 + (b) * 2 + (h)) * HTB)
#define PG8_STAGE(bufoff, gbase, voff) do { _Pragma("unroll") for (int _i = 0; _i < 2; ++_i) \
        __builtin_amdgcn_global_load_lds((const unsigned*)((const char*)(gbase) + (voff)[_i]), (PG8_LAS unsigned*)(lds + (bufoff) + ldsw + _i * 8192), 16, 0, 0); } while (0)
#define PG8_LDA(dst, b, h) do { if constexpr (FP8) { _Pragma("unroll") for (int m = 0; m < 4; ++m) { const v4i_t lo_ = *(const PG8_LAS v4i_t*)(lds + PG8_SA(b, h) + aoff + m * 2048), hi_ = *(const PG8_LAS v4i_t*)(lds + PG8_SA(b, h) + aoff + m * 2048 + 1024); \
        dst##8[m] = __builtin_shufflevector(lo_, hi_, 0, 1, 2, 3, 4, 5, 6, 7); } } \
    else { _Pragma("unroll") for (int m = 0; m < 4; ++m) _Pragma("unroll") for (int k = 0; k < 2; ++k) dst[m][k] = *(const PG8_LAS bf16x8*)(lds + PG8_SA(b, h) + aoff + m * 2048 + k * 1024); } } while (0)
#define PG8_LDB(dst, b, h) do { if constexpr (FP8) { _Pragma("unroll") for (int n = 0; n < 2; ++n) { const v4i_t lo_ = *(const PG8_LAS v4i_t*)(lds + PG8_SB(b, h) + boff + n * 2048), hi_ = *(const PG8_LAS v4i_t*)(lds + PG8_SB(b, h) + boff + n * 2048 + 1024); \
        dst##8[n] = __builtin_shufflevector(lo_, hi_, 0, 1, 2, 3, 4, 5, 6, 7); } } \
    else { _Pragma("unroll") for (int n = 0; n < 2; ++n) _Pragma("unroll") for (int k = 0; k < 2; ++k) dst[n][k] = *(const PG8_LAS bf16x8*)(lds + PG8_SB(b, h) + boff + n * 2048 + k * 1024); } } while (0)
#define PG8_MMA(ai, bj, At, Bt) do { __builtin_amdgcn_s_setprio(1); _Pragma("unroll") for (int m = 0; m < 4; ++m) _Pragma("unroll") for (int n = 0; n < 2; ++n) { \
        if constexpr (FP8) { asm volatile("v_mfma_scale_f32_16x16x128_f8f6f4 %0, %1, %2, %0, %3, %4 op_sel_hi:[0,0,0]" : "+v"(acc[ai][bj][m][n]) : "v"(Bt##8[n]), "v"(At##8[m]), "v"(sB_), "v"(sA_)); } \
        else if constexpr (I8) { _Pragma("unroll") for (int k = 0; k < 2; ++k) acc[ai][bj][m][n] = __builtin_bit_cast(f32x4, __builtin_amdgcn_mfma_i32_16x16x64_i8(__builtin_bit_cast(v4i_t, Bt[n][k]), __builtin_bit_cast(v4i_t, At[m][k]), __builtin_bit_cast(v4i_t, acc[ai][bj][m][n]), 0, 0, 0)); } \
        else { _Pragma("unroll") for (int k = 0; k < 2; ++k) acc[ai][bj][m][n] = __builtin_amdgcn_mfma_f32_16x16x32_bf16(Bt[n][k], At[m][k], acc[ai][bj][m][n], 0, 0, 0); } } \
        __builtin_amdgcn_s_setprio(0); } while (0)
#define PG8_WAIT_V(n) asm volatile("s_waitcnt vmcnt(" #n ")" ::: "memory")
#define PG8_WAIT_L(n) asm volatile("s_waitcnt lgkmcnt(" #n ")" ::: "memory")
#define PG8_BAR __builtin_amdgcn_s_barrier()
#define PG8_SCHED __builtin_amdgcn_sched_barrier(0)
    Unit cur, nxt; int ui = 0;
    if (!S.next(0, cur)) return;
    const int sA_ = g.sA, sB_ = g.sB;
    f32x4 acc[2][2][4][2];
#pragma unroll
    for (int a = 0; a < 2; ++a)
#pragma unroll
        for (int b = 0; b < 2; ++b)
#pragma unroll
            for (int m = 0; m < 4; ++m)
#pragma unroll
                for (int n = 0; n < 2; ++n) acc[a][b][m][n] = (f32x4){0.f, 0.f, 0.f, 0.f};
    bf16x8 At[4][2], B0[2][2], B1[2][2]; v8i_t At8[4], B08[2], B18[2];
    if (cur.nt) nt = cur.nt;
    const char* cA = (const char*)g.A + (size_t)cur.pm * tstepA + (size_t)cur.k0 * 2; const char* cB = (const char*)g.Bt + (size_t)cur.pn * tstepB + (size_t)cur.k0 * 2;
    S.a_ready(cur);
    if constexpr (SP2) {
        PG8_STAGE(PG8_SB(0, 0), cB, voffB); PG8_STAGE(PG8_SB(0, 1), cB + hstepB, voffB); PG8_STAGE(PG8_SA(0, 0), cA, voffA); PG8_STAGE(PG8_SA(0, 1), cA + hstepA, voffA);
        if (wr == 1) PG8_BAR;
        PG8_WAIT_V(2); PG8_BAR;
        PG8_STAGE(PG8_SB(1, 0), cB + kstep, voffB); PG8_STAGE(PG8_SA(1, 0), cA + kstep, voffA); PG8_STAGE(PG8_SB(1, 1), cB + hstepB + kstep, voffB);
        PG8_WAIT_V(6); PG8_BAR;
    } else {
        PG8_STAGE(PG8_SB(0, 0), cB, voffB); PG8_STAGE(PG8_SA(0, 0), cA, voffA); PG8_STAGE(PG8_SB(0, 1), cB + hstepB, voffB); PG8_STAGE(PG8_SA(0, 1), cA + hstepA, voffA);
        if (wr == 1) PG8_BAR;
        PG8_WAIT_V(4); PG8_BAR;
        PG8_STAGE(PG8_SB(1, 0), cB + kstep, voffB); PG8_STAGE(PG8_SA(1, 0), cA + kstep, voffA); PG8_STAGE(PG8_SB(1, 1), cB + hstepB + kstep, voffB);
        PG8_WAIT_V(6); PG8_BAR;
    }
    for (;;) {
        const bool has_next = S.next(ui + 1, nxt);
        const char* nA = has_next ? (const char*)g.A + (size_t)nxt.pm * tstepA + (size_t)nxt.k0 * 2 : cA; const char* nB = has_next ? (const char*)g.Bt + (size_t)nxt.pn * tstepB + (size_t)nxt.k0 * 2 : cB;
#pragma unroll 1
        for (int t = 0; t < nt; t += 2) {
            const bool last = (t == nt - 2);
            const char* a1 = cA + (size_t)(t + 1) * kstep;
            const char* a2 = last ? nA : cA + (size_t)(t + 2) * kstep; const char* b2 = last ? nB : cB + (size_t)(t + 2) * kstep;
            const char* a3 = a2 + kstep; const char* b3 = b2 + kstep;
            if (last && has_next) S.a_ready(nxt);
            if constexpr (SP2) {
            PG8_LDB(B0, 0, 0); PG8_LDB(B1, 0, 1); PG8_SCHED; PG8_LDA(At, 0, 0); PG8_STAGE(PG8_SA(1, 1), a1 + hstepA, voffA);
            PG8_WAIT_V(8); PG8_WAIT_L(0); PG8_BAR; PG8_MMA(0, 0, At, B0); PG8_MMA(0, 1, At, B1); PG8_BAR; PG8_SCHED;
            PG8_LDA(At, 0, 1); PG8_STAGE(PG8_SB(0, 0), b2, voffB); PG8_STAGE(PG8_SB(0, 1), b2 + hstepB, voffB); PG8_STAGE(PG8_SA(0, 0), a2, voffA);
            PG8_WAIT_V(8); PG8_WAIT_L(0); PG8_BAR; PG8_MMA(1, 0, At, B0); PG8_MMA(1, 1, At, B1); PG8_BAR; PG8_SCHED;
            PG8_LDB(B0, 1, 0); PG8_LDB(B1, 1, 1); PG8_SCHED; PG8_LDA(At, 1, 0); PG8_STAGE(PG8_SA(0, 1), a2 + hstepA, voffA);
            PG8_WAIT_V(8); PG8_WAIT_L(0); PG8_BAR; PG8_MMA(0, 0, At, B0); PG8_MMA(0, 1, At, B1); PG8_BAR; PG8_SCHED;
            PG8_LDA(At, 1, 1); PG8_STAGE(PG8_SB(1, 0), b3, voffB); PG8_STAGE(PG8_SB(1, 1), b3 + hstepB, voffB); PG8_STAGE(PG8_SA(1, 0), a3, voffA);
            PG8_WAIT_V(8); PG8_WAIT_L(0); PG8_BAR; PG8_MMA(1, 0, At, B0); PG8_MMA(1, 1, At, B1); PG8_BAR; PG8_SCHED;
            } else {
            PG8_LDB(B0, 0, 0); PG8_SCHED; PG8_LDA(At, 0, 0); PG8_STAGE(PG8_SA(1, 1), a1 + hstepA, voffA);
            PG8_WAIT_L(8); PG8_BAR; PG8_WAIT_L(0); PG8_MMA(0, 0, At, B0); PG8_BAR; PG8_SCHED;
            PG8_LDB(B1, 0, 1); PG8_STAGE(PG8_SB(0, 0), b2, voffB);
            PG8_BAR; PG8_WAIT_L(0); PG8_MMA(0, 1, At, B1); PG8_BAR;
            PG8_LDA(At, 0, 1); PG8_STAGE(PG8_SA(0, 0), a2, voffA);
            PG8_BAR; PG8_WAIT_L(0); PG8_MMA(1, 0, At, B0); PG8_BAR; PG8_SCHED;
            PG8_STAGE(PG8_SB(0, 1), b2 + hstepB, voffB);
            PG8_WAIT_V(6); PG8_BAR; PG8_MMA(1, 1, At, B1); PG8_BAR;
            PG8_LDB(B0, 1, 0); PG8_SCHED; PG8_LDA(At, 1, 0); PG8_STAGE(PG8_SA(0, 1), a2 + hstepA, voffA);
            PG8_WAIT_L(8); PG8_BAR; PG8_WAIT_L(0); PG8_MMA(0, 0, At, B0); PG8_BAR; PG8_SCHED;
            PG8_LDB(B1, 1, 1); PG8_STAGE(PG8_SB(1, 0), b3, voffB);
            PG8_BAR; PG8_WAIT_L(0); PG8_MMA(0, 1, At, B1); PG8_BAR;
            PG8_LDA(At, 1, 1); PG8_STAGE(PG8_SA(1, 0), a3, voffA);
            PG8_BAR; PG8_WAIT_L(0); PG8_MMA(1, 0, At, B0); PG8_BAR; PG8_SCHED;
            PG8_STAGE(PG8_SB(1, 1), b3 + hstepB, voffB);
            PG8_WAIT_V(6); PG8_BAR; PG8_MMA(1, 1, At, B1); PG8_BAR;
            }
        }
        if constexpr (FP8) asm volatile("s_nop 15\n\ts_nop 15" ::: "memory");
        if constexpr (I8) {
            const float* ra = g.rsA + cur.pm * BM + wr * 64 + fr; const float* rb = g.rsB + cur.pn * BM + wc * 32 + 8 * fq;
#pragma unroll
            for (int bj = 0; bj < 2; ++bj) { const f32x4 sb0 = *(const f32x4*)(rb + bj * HALF), sb1 = *(const f32x4*)(rb + bj * HALF + 4);
#pragma unroll
                for (int ai = 0; ai < 2; ++ai)
#pragma unroll
                    for (int m = 0; m < 4; ++m) { const float sa = ra[ai * HALF + m * 16];
                        acc[ai][bj][m][0] = __builtin_convertvector(__builtin_bit_cast(v4i_t, acc[ai][bj][m][0]), f32x4) * (sb0 * sa);
                        acc[ai][bj][m][1] = __builtin_convertvector(__builtin_bit_cast(v4i_t, acc[ai][bj][m][1]), f32x4) * (sb1 * sa); } }
        }
        if constexpr (ALIGN_EPI) { if (wr == 0) PG8_BAR; }
        if constexpr (!Epi::AFTER_DRAIN) { E(acc, cur, wr, wc, fr, fq); S.done(cur); }
        if (!has_next) break;
#pragma unroll
        for (int a = 0; a < 2; ++a)
#pragma unroll
            for (int b = 0; b < 2; ++b)
#pragma unroll
                for (int m = 0; m < 4; ++m)
#pragma unroll
                    for (int n = 0; n < 2; ++n) acc[a][b][m][n] = (f32x4){0.f, 0.f, 0.f, 0.f};
        cur = nxt; cA = nA; cB = nB; ++ui; nt = cur.nt ? cur.nt : K / BK;
        if constexpr (ALIGN_EPI) { if (wr == 1) PG8_BAR; }
    }
    PG8_WAIT_V(0);
    if constexpr (!ALIGN_EPI) { if (wr == 0) PG8_BAR; }
    PG8_BAR;
    if constexpr (Epi::AFTER_DRAIN) { E.fused(acc, cur, wr, wc, fr, fq, lds, wid, lane); S.done(cur); }
#undef PG8_SA
#undef PG8_SB
#undef PG8_STAGE
#undef PG8_LDA
#undef PG8_LDB
#undef PG8_MMA
#undef PG8_WAIT_V
#undef PG8_WAIT_L
#undef PG8_BAR
#undef PG8_SCHED
}
}

#ifndef PROBE_DUP
#define PROBE_DUP 0
#endif
#ifndef USE_SPLITK
#define USE_SPLITK 0
#endif
#ifndef MK_PER_PHASE
#define MK_PER_PHASE 0
#endif
constexpr int D = 1024, NBATCH = 8, SEQ = 4096, NLAT = NBATCH * SEQ, CTXL = 256, NCTX = NBATCH * CTXL, MALL = NLAT + NCTX;
constexpr int RH = 4, RQK = 256, RV = 512;
constexpr int DFF = 2816, NE = 8, DFE = 3584;
constexpr float EPS = 1e-6f;
constexpr float LAMBDA_INIT = 0.3555090675909693f;
constexpr float LOG2E = 1.4426950408889634f;
constexpr int NWAVES = 8, NTHREADS = 512;
constexpr float MOE_WSCALE = 64.0f; constexpr int MOE_SB = 0x79797979, MOE_SA = 0x7f7f7f7f;
constexpr int MOE_ROWS = 2 * NLAT + NE * 256;

enum { I_X = 0, I_C, I_CTX, I_CCTX, I_L0_WMOD, I_L0_BMOD, I_L0_NPREMIX, I_L0_NPOSTMIX, I_L0_NPREFFN, I_L0_NPOSTFFN, I_L0_WIN, I_L0_DECAY, I_L0_WOUT, I_L0_WGU, I_L0_WDN,
       I_L1_WMOD, I_L1_BMOD, I_L1_NPREMIX, I_L1_NPOSTMIX, I_L1_NPREFFN, I_L1_NPOSTFFN, I_L1_WIN, I_L1_LAMBDA, I_L1_SUBLN, I_L1_WOUT, I_L1_RW, I_L1_RB, I_L1_MGU, I_L1_MDN, N_IN };

constexpr size_t MiB = 1u << 20;
constexpr size_t WS_CTL = 0, CTL_ZERO_BYTES = 1 * MiB;
constexpr size_t WS_MODV = 1 * MiB;
constexpr size_t WS_TAB0 = 1 * MiB + 512 * 1024;
constexpr size_t WS_TAB1 = WS_TAB0 + 32 * 1024;
constexpr size_t WS_LAM = WS_TAB1 + 8 * 1024;
constexpr size_t WS_WSC0 = WS_LAM + 4096;
constexpr size_t WS_WSC2 = WS_WSC0 + 8192 * 4;
constexpr size_t WS_RSC = 1 * MiB + 768 * 1024;
constexpr size_t WS_ROUTE = 2 * MiB;
constexpr size_t WS_XCTX = 3 * MiB;
constexpr size_t WS_W0IN = 11 * MiB, WS_W0OUT = 27 * MiB, WS_W0GU = 31 * MiB, WS_W0DN = 42 * MiB, WS_W1IN = 48 * MiB, WS_W1OUT = 54 * MiB, WS_WMGU = 56 * MiB, WS_WMDN = 168 * MiB;
constexpr size_t WS_H = 224 * MiB;
constexpr size_t WS_A = 292 * MiB, WS_B = 564 * MiB;
constexpr size_t WS_OF = WS_B, WS_OB = WS_B + 136 * MiB;
constexpr size_t WS_QH0 = WS_A, WS_KH0 = WS_A + 68 * MiB, WS_VQ0 = WS_A + 136 * MiB;
constexpr size_t WS_QH1 = WS_A, WS_KH1 = WS_A + 68 * MiB, WS_VH1 = WS_A + 136 * MiB;
constexpr size_t WS_HP = WS_A, WS_ACT1 = 424 * MiB, WS_Y1 = WS_A;
constexpr size_t WS_V8 = 640 * MiB;
constexpr size_t WS_X1 = 360 * MiB, WS_X1C = 424 * MiB;
constexpr size_t WS_X2 = 496 * MiB;
constexpr size_t WS_X3 = 700 * MiB;
constexpr size_t WS_PART = WS_A + 136 * MiB;
constexpr size_t WS_END = 886 * MiB;
static_assert(WS_ACT1 + (size_t)MOE_ROWS * DFE * 2 <= WS_END, "ws map");
static_assert(WS_WSC2 + 2 * DFF * 4 <= WS_RSC && WS_RSC + (size_t)MALL * 4 <= WS_ROUTE, "ws map");
static_assert(WS_HP + (size_t)MOE_ROWS * D * 2 <= WS_ACT1, "ws map");
constexpr int CW_TMO = 0;
constexpr int CW_BAR = 4096;
constexpr int CW_XRANK = 12288;
constexpr int CW_MOECNT = 16384;

constexpr int RING_BYTES = 131072;
constexpr int LDS_BYTES = 163840;
constexpr int MISC_OFF = LDS_BYTES - 256;

#define GAS __attribute__((address_space(1)))
#define LAS __attribute__((address_space(3)))
typedef unsigned short bf16;
typedef unsigned v4u __attribute__((ext_vector_type(4)));
typedef unsigned v2u __attribute__((ext_vector_type(2)));
typedef float f32x4 __attribute__((ext_vector_type(4)));
typedef float f32x2 __attribute__((ext_vector_type(2)));
typedef short bf16x8 __attribute__((ext_vector_type(8)));
typedef GAS unsigned gu32;
#define RLX_AGENT __ATOMIC_RELAXED, __HIP_MEMORY_SCOPE_AGENT
#define LDS_WAIT() asm volatile("s_waitcnt lgkmcnt(0)" ::: "memory")
#define VM_WAIT() asm volatile("s_waitcnt vmcnt(0)" ::: "memory")
__device__ __forceinline__ unsigned pk2(float lo, float hi);
__device__ __forceinline__ unsigned f2bf(float f) { return pk2(f, 0.f) & 0xffffu; }
typedef float f32x2_cv __attribute__((ext_vector_type(2))); typedef __bf16 bf16x2_cv __attribute__((ext_vector_type(2)));
__device__ __forceinline__ unsigned pk2(float lo, float hi) { f32x2_cv v = {lo, hi}; bf16x2_cv b = __builtin_convertvector(v, bf16x2_cv); return __builtin_bit_cast(unsigned, b); }
__device__ __forceinline__ float bf2f(unsigned b) { return __builtin_bit_cast(float, b << 16); }
__device__ __forceinline__ float bflo(unsigned w) { return __builtin_bit_cast(float, w << 16); }
__device__ __forceinline__ float bfhi(unsigned w) { return __builtin_bit_cast(float, w & 0xffff0000u); }
__device__ __forceinline__ unsigned pk4_fp8(float a, float b, float c, float d) {
    a = __builtin_amdgcn_fmed3f(a, -448.f, 448.f); b = __builtin_amdgcn_fmed3f(b, -448.f, 448.f); c = __builtin_amdgcn_fmed3f(c, -448.f, 448.f); d = __builtin_amdgcn_fmed3f(d, -448.f, 448.f);
    int w = 0; w = __builtin_amdgcn_cvt_pk_fp8_f32(a, b, w, false); w = __builtin_amdgcn_cvt_pk_fp8_f32(c, d, w, true); return (unsigned)w; }
__device__ __forceinline__ unsigned pk4_i8(float a, float b, float c, float d) {
    const unsigned ua = __builtin_bit_cast(unsigned, a + 12582912.f), ub = __builtin_bit_cast(unsigned, b + 12582912.f), uc = __builtin_bit_cast(unsigned, c + 12582912.f), ud = __builtin_bit_cast(unsigned, d + 12582912.f);
    return __builtin_amdgcn_perm(ub, ua, 0x0c0c0400u) | (__builtin_amdgcn_perm(ud, uc, 0x0c0c0400u) << 16); }
__device__ __forceinline__ float fast_exp2(float x) { return __builtin_amdgcn_exp2f(x); }
__device__ __forceinline__ float silu_f(float g) { return g * __builtin_amdgcn_rcpf(1.0f + __builtin_amdgcn_exp2f(-g * LOG2E)); }
__device__ __forceinline__ float wave_sum(float v) {
#pragma unroll
    for (int o = 1; o < 64; o <<= 1) v += __shfl_xor(v, o);
    return v;
}

__device__ __forceinline__ float wave_max(float v) {
#pragma unroll
    for (int o = 1; o < 64; o <<= 1) v = fmaxf(v, __shfl_xor(v, o));
    return v;
}

#define XB_TMO      128
#define XB_XCNT(j)  (256  + 64 * (j))
#define XB_XSUB(j)  (1280 + 64 * (j))
#define XB_XGEN(j)  (2304 + 64 * (j))
#define XB_TOP      3328
#define XB_TOPGEN   3392
#define XCD_BAR_WORDS 3456
#define XB_SPIN_CAP (1u << 24)

__device__ __forceinline__ unsigned xb_ld(unsigned* p)              { return __hip_atomic_load(p, __ATOMIC_RELAXED, __HIP_MEMORY_SCOPE_AGENT); }
__device__ __forceinline__ unsigned xb_add(unsigned* p, unsigned v) { return __hip_atomic_fetch_add(p, v, __ATOMIC_RELAXED, __HIP_MEMORY_SCOPE_AGENT); }
__device__ __forceinline__ unsigned xb_xcc_id() { return (unsigned)__builtin_amdgcn_s_getreg((3 << 11) | 20) & 0xFu; }
#define XB_SPIN(cond, bar) do { unsigned _sp = 0; while (cond) { __builtin_amdgcn_s_sleep(1); \
    if ((++_sp & 255u) == 0u) { if (xb_ld(&(bar)[XB_TMO])) break; if (_sp > XB_SPIN_CAP) { atomicAdd(&(bar)[XB_TMO], 1u); break; } } } } while (0)

struct XcdBarrier {
    unsigned* bar; unsigned x;
    volatile LAS unsigned* st;
};

__device__ __forceinline__ XcdBarrier xcd_barrier_post(unsigned* bar, volatile LAS unsigned* st) {
    XcdBarrier b; b.bar = bar; b.x = xb_xcc_id(); b.st = st;
    if (threadIdx.x == 0) (void)xb_add(&bar[XB_XCNT(b.x)], 1u);
    return b;
}
__device__ __forceinline__ void xcd_barrier_complete(unsigned* bar, unsigned x, unsigned& nloc, unsigned& nx) {
    const unsigned G = gridDim.x * gridDim.y * gridDim.z;
    unsigned sum, cnt, mine, sp = 0u;
    for (;;) {
        sum = 0u; cnt = 0u; mine = 0u;
#pragma unroll
        for (unsigned j = 0; j < 16; ++j) { const unsigned c = xb_ld(&bar[XB_XCNT(j)]); sum += c; cnt += (c > 0u) ? 1u : 0u; mine = (j == x) ? c : mine; }
        if (sum == G) break;
        __builtin_amdgcn_s_sleep(1);
        if ((++sp & 255u) == 0u) { if (xb_ld(&bar[XB_TMO])) break; if (sp > XB_SPIN_CAP) { atomicAdd(&bar[XB_TMO], 1u); break; } }
    }
    nloc = mine > 0u ? mine : 1u; nx = cnt > 0u ? cnt : 1u;
}

__device__ __forceinline__ void xcd_barrier(const XcdBarrier& b) {
    asm volatile("s_waitcnt vmcnt(0)" ::: "memory");
    __syncthreads();
    if (threadIdx.x == 0) {
        unsigned* bar = b.bar;
        __builtin_amdgcn_s_waitcnt(0);
        unsigned nloc = b.st[0], nx = b.st[1];
        if (nloc == 0u) { xcd_barrier_complete(bar, b.x, nloc, nx); b.st[0] = nloc; b.st[1] = nx; }
        const unsigned old = xb_add(&bar[XB_XSUB(b.x)], 1u);
        const unsigned gen = old / nloc;
        if (old + 1u == (gen + 1u) * nloc) {
            __builtin_amdgcn_fence(__ATOMIC_RELEASE, "agent");
            asm volatile("s_waitcnt vmcnt(0)" ::: "memory");
            const unsigned og = xb_add(&bar[XB_TOP], 1u);
            const unsigned tg = og / nx;
            if (og + 1u == (tg + 1u) * nx) xb_add(&bar[XB_TOPGEN], 1u);
            else XB_SPIN(xb_ld(&bar[XB_TOPGEN]) == tg, bar);
            __builtin_amdgcn_fence(__ATOMIC_ACQUIRE, "agent");
            xb_add(&bar[XB_XGEN(b.x)], 1u);
            asm volatile("s_waitcnt vmcnt(0)" ::: "memory");
        } else {
            XB_SPIN(xb_ld(&bar[XB_XGEN(b.x)]) == gen, bar);
            __builtin_amdgcn_fence(__ATOMIC_ACQUIRE, "agent");
            asm volatile("s_waitcnt vmcnt(0)" ::: "memory");
        }
    }
    __syncthreads();
}


struct Args { const float* in[N_IN]; float* out; unsigned char* ws; int ph_lo, ph_hi; };

struct Frame {
    LAS unsigned char* lds;
    volatile LAS unsigned* MISC;
    gu32* ctl;
    int tid, lane, wave, vcu, G, cid;
    unsigned char* ws;
};

namespace pg8 {
struct EpiStore {
    static constexpr bool PERM = true, AFTER_DRAIN = false;
    bf16_t* O; int ldc;
    __device__ __forceinline__ void operator()(const f32x4 (&acc)[2][2][4][2], const Unit& u, int wr, int wc, int fr, int fq) const {
        const int row0 = u.pm * BM + wr * 64 + fr; const int col0 = u.pc * BM + wc * 32 + 8 * fq;
#pragma unroll
        for (int ai = 0; ai < 2; ++ai)
#pragma unroll
            for (int m = 0; m < 4; ++m) { bf16_t* rowp = O + (size_t)(row0 + ai * HALF + m * 16) * ldc + col0;
#pragma unroll
                for (int bj = 0; bj < 2; ++bj) { const f32x4 v0 = acc[ai][bj][m][0], v1 = acc[ai][bj][m][1];
                    u32x4 w; w.x = cvt_pk_bf16(v0[0], v0[1]); w.y = cvt_pk_bf16(v0[2], v0[3]); w.z = cvt_pk_bf16(v1[0], v1[1]); w.w = cvt_pk_bf16(v1[2], v1[3]);
                    *(u32x4*)(rowp + bj * HALF) = w; } }
    }
};
struct EpiSwiglu {
    static constexpr bool PERM = true, AFTER_DRAIN = false;
    bf16_t* O; int ldc;
    __device__ __forceinline__ void operator()(const f32x4 (&acc)[2][2][4][2], const Unit& u, int wr, int wc, int fr, int fq) const {
        const int row0 = u.pm * BM + wr * 64 + fr; const int col0 = u.pc * HALF + wc * 32 + 8 * fq;
#pragma unroll
        for (int ai = 0; ai < 2; ++ai)
#pragma unroll
            for (int m = 0; m < 4; ++m) { bf16_t* rowp = O + (size_t)(row0 + ai * HALF + m * 16) * ldc + col0;
                f32x4 a0, a1;
#pragma unroll
                for (int e = 0; e < 4; ++e) { a0[e] = silu_f(acc[ai][0][m][0][e]) * acc[ai][1][m][0][e]; a1[e] = silu_f(acc[ai][0][m][1][e]) * acc[ai][1][m][1][e]; }
                u32x4 w; w.x = cvt_pk_bf16(a0[0], a0[1]); w.y = cvt_pk_bf16(a0[2], a0[3]); w.z = cvt_pk_bf16(a1[0], a1[1]); w.w = cvt_pk_bf16(a1[2], a1[3]);
                *(u32x4*)rowp = w; }
    }
};

struct EpiQKV0 {
    static constexpr bool PERM = true, AFTER_DRAIN = false;
    bf16_t* Qh; bf16_t* Kh; bf16_t* Vq; const float* tab;
    __device__ __forceinline__ void operator()(const f32x4 (&acc)[2][2][4][2], const Unit& u, int wr, int wc, int fr, int fq) const {
        const int row0 = u.pm * BM + wr * 64 + fr, pc = u.pc;
        if (pc < 8) {
            bf16_t* base = pc < 4 ? Qh + (size_t)pc * MALL * 256 : Kh + (size_t)(pc - 4) * MALL * 256; const float sc = pc < 4 ? 1.0f : 0.0625f; const bool lat = u.pm < NLAT / BM;
            const int col0 = wc * 32 + 8 * fq;
#pragma unroll
            for (int ai = 0; ai < 2; ++ai)
#pragma unroll
                for (int m = 0; m < 4; ++m) { const int row = row0 + ai * HALF + m * 16, t = row & (SEQ - 1);
#pragma unroll
                    for (int bj = 0; bj < 2; ++bj) { f32x4 v0 = acc[ai][bj][m][0], v1 = acc[ai][bj][m][1];
                        if (lat) { const int pos = bj ? (t & 63) : (t >> 6); const float* tp = tab + (size_t)(pos * 64 + 16 * wc + 4 * fq) * 2;
                            const f32x4 c0 = *(const f32x4*)tp, c1 = *(const f32x4*)(tp + 4);
                            v0 = (f32x4){v0[0] * c0[0] - v0[1] * c0[1], v0[1] * c0[0] + v0[0] * c0[1], v0[2] * c0[2] - v0[3] * c0[3], v0[3] * c0[2] + v0[2] * c0[3]};
                            v1 = (f32x4){v1[0] * c1[0] - v1[1] * c1[1], v1[1] * c1[0] + v1[0] * c1[1], v1[2] * c1[2] - v1[3] * c1[3], v1[3] * c1[2] + v1[2] * c1[3]}; }
                        v0 = v0 * sc; v1 = v1 * sc;
                        u32x4 w; w.x = cvt_pk_bf16(v0[0], v0[1]); w.y = cvt_pk_bf16(v0[2], v0[3]); w.z = cvt_pk_bf16(v1[0], v1[1]); w.w = cvt_pk_bf16(v1[2], v1[3]);
                        *(u32x4*)(base + (size_t)row * 256 + col0 + bj * HALF) = w; } }
        } else {
#pragma unroll
            for (int ai = 0; ai < 2; ++ai)
#pragma unroll
                for (int m = 0; m < 4; ++m) { const int row = row0 + ai * HALF + m * 16;
#pragma unroll
                    for (int bj = 0; bj < 2; ++bj) { const f32x4 v0 = acc[ai][bj][m][0], v1 = acc[ai][bj][m][1];
                        u32x4 w; w.x = cvt_pk_bf16(v0[0], v0[1]); w.y = cvt_pk_bf16(v0[2], v0[3]); w.z = cvt_pk_bf16(v1[0], v1[1]); w.w = cvt_pk_bf16(v1[2], v1[3]);
                        *(u32x4*)(Vq + ((size_t)((pc - 8) * 2 + bj) * MALL + row) * 128 + wc * 32 + 8 * fq) = w; } }
        }
    }
};
struct EpiQKV1 {
    static constexpr bool PERM = true, AFTER_DRAIN = false;
    bf16_t* Qh; bf16_t* Kh; bf16_t* Vh; const float* tab;
    __device__ __forceinline__ void operator()(const f32x4 (&acc)[2][2][4][2], const Unit& u, int wr, int wc, int fr, int fq) const {
        const int row0 = u.pm * BM + wr * 64 + fr, pc = u.pc;
        if (pc < 8) {
            bf16_t* base = pc < 4 ? Qh : Kh; const float sc = pc < 4 ? 0.125f * LOG2E : 1.0f; const bool lat = u.pm < NLAT / BM;
            const int hf = wc & 1, p0 = 32 * hf + 8 * fq;
#pragma unroll
            for (int ai = 0; ai < 2; ++ai)
#pragma unroll
                for (int m = 0; m < 4; ++m) { const int row = row0 + ai * HALF + m * 16, t = row & (SEQ - 1);
                    const int pos = hf ? (t & 63) : (t >> 6); const float* tp = tab + (size_t)(pos * 16 + 4 * fq) * 2;
                    f32x4 c0 = (f32x4){1.f, 0.f, 1.f, 0.f}, c1 = c0;
                    if (lat) { c0 = *(const f32x4*)tp; c1 = *(const f32x4*)(tp + 4); }
#pragma unroll
                    for (int bj = 0; bj < 2; ++bj) { f32x4 v0 = acc[ai][bj][m][0], v1 = acc[ai][bj][m][1];
                        v0 = (f32x4){v0[0] * c0[0] - v0[1] * c0[1], v0[1] * c0[0] + v0[0] * c0[1], v0[2] * c0[2] - v0[3] * c0[3], v0[3] * c0[2] + v0[2] * c0[3]};
                        v1 = (f32x4){v1[0] * c1[0] - v1[1] * c1[1], v1[1] * c1[0] + v1[0] * c1[1], v1[2] * c1[2] - v1[3] * c1[3], v1[3] * c1[2] + v1[2] * c1[3]};
                        v0 = v0 * sc; v1 = v1 * sc;
                        const int head = (pc & 3) * 4 + 2 * bj + (wc >> 1);
                        u32x4 w; w.x = cvt_pk_bf16(v0[0], v0[1]); w.y = cvt_pk_bf16(v0[2], v0[3]); w.z = cvt_pk_bf16(v1[0], v1[1]); w.w = cvt_pk_bf16(v1[2], v1[3]);
                        *(u32x4*)(base + ((size_t)head * MALL + row) * 64 + p0) = w; } }
        } else {
#pragma unroll
            for (int ai = 0; ai < 2; ++ai)
#pragma unroll
                for (int m = 0; m < 4; ++m) { const int row = row0 + ai * HALF + m * 16;
#pragma unroll
                    for (int bj = 0; bj < 2; ++bj) { const f32x4 v0 = acc[ai][bj][m][0], v1 = acc[ai][bj][m][1];
                        u32x4 w; w.x = cvt_pk_bf16(v0[0], v0[1]); w.y = cvt_pk_bf16(v0[2], v0[3]); w.z = cvt_pk_bf16(v1[0], v1[1]); w.w = cvt_pk_bf16(v1[2], v1[3]);
                        *(u32x4*)(Vh + ((size_t)((pc - 8) * 2 + bj) * MALL + row) * 128 + wc * 32 + 8 * fq) = w; } }
        }
    }
};

struct EpiGateMerge {
    static constexpr bool PERM = true, AFTER_DRAIN = false;
    bf16_t* Of; const bf16_t* Ob; const float* ssq;
    __device__ __forceinline__ void operator()(const f32x4 (&acc)[2][2][4][2], const Unit& u, int wr, int wc, int fr, int fq) const {
        const int row0 = u.pm * BM + wr * 64 + fr; const int col0 = u.pc * HALF + wc * 32 + 8 * fq; const int head = u.pc >> 2;
#pragma unroll
        for (int ai = 0; ai < 2; ++ai)
#pragma unroll
            for (int m = 0; m < 4; ++m) { const size_t row = (size_t)(row0 + ai * HALF + m * 16);
                const f32x4 sf = *(const f32x4*)(ssq + (row * RH + head) * 8), sb = *(const f32x4*)(ssq + (row * RH + head) * 8 + 4);
                const float rf = __builtin_amdgcn_rsqf(((sf[0] + sf[1]) + (sf[2] + sf[3])) * (1.0f / RV) + EPS), rb = __builtin_amdgcn_rsqf(((sb[0] + sb[1]) + (sb[2] + sb[3])) * (1.0f / RV) + EPS);
                const u32x4 of = *(const u32x4*)(Of + row * 2048 + col0), ob = *(const u32x4*)(Ob + row * 2048 + col0);
                float y[8];
#pragma unroll
                for (int e = 0; e < 4; ++e) {
                    const float gf0 = acc[ai][0][m][e >> 1][2 * (e & 1)], gf1 = acc[ai][0][m][e >> 1][2 * (e & 1) + 1], gb0 = acc[ai][1][m][e >> 1][2 * (e & 1)], gb1 = acc[ai][1][m][e >> 1][2 * (e & 1) + 1];
                    y[2 * e] = silu_f(gf0) * (bflo(of[e]) * rf) + silu_f(gb0) * (bflo(ob[e]) * rb);
                    y[2 * e + 1] = silu_f(gf1) * (bfhi(of[e]) * rf) + silu_f(gb1) * (bfhi(ob[e]) * rb); }
                u32x4 w; w.x = cvt_pk_bf16(y[0], y[1]); w.y = cvt_pk_bf16(y[2], y[3]); w.z = cvt_pk_bf16(y[4], y[5]); w.w = cvt_pk_bf16(y[6], y[7]);
                *(u32x4*)(Of + row * 2048 + col0) = w; }
    }
};

struct SplitOrder {
    StaticOrder lat; int G, c, KS, ntS, nN, nl;
    __device__ __forceinline__ void init(int N, int G_, int c_, int KS_, int ntS_) { lat.init(KS_ ? NLAT : MALL, N, G_, c_); G = G_; c = c_; KS = KS_; ntS = ntS_; nN = N / BM; nl = (lat.nwg > c_) ? (lat.nwg - 1 - c_) / G_ + 1 : 0; }
    __device__ __forceinline__ bool next(int i, Unit& u) const {
        if (i < nl) return lat.next(i, u);
        const long j = (long)(i - nl) * G + c; if (j >= (long)(NCTX / BM) * nN * KS) return false;
        const int tile = (int)(j / KS), ks = (int)(j % KS);
        u.pm = NLAT / BM + tile / nN; u.pn = tile % nN; u.pc = u.pn; u.k0 = ks * ntS * BK; u.nt = ntS; u.ks = ks; return true;
    }
    __device__ __forceinline__ void a_ready(const Unit&) const {}
    __device__ __forceinline__ void done(const Unit&) const {}
};
struct EpiStoreSplit {
    static constexpr bool PERM = true, AFTER_DRAIN = false;
    bf16_t* O; int ldc; float* P;
    __device__ __forceinline__ void operator()(const f32x4 (&acc)[2][2][4][2], const Unit& u, int wr, int wc, int fr, int fq) const {
        const int row0 = u.pm * BM + wr * 64 + fr; const int col0 = u.pc * BM + wc * 32 + 8 * fq;
        if (u.ks < 0) {
#pragma unroll
            for (int ai = 0; ai < 2; ++ai)
#pragma unroll
                for (int m = 0; m < 4; ++m) { bf16_t* rowp = O + (size_t)(row0 + ai * HALF + m * 16) * ldc + col0;
#pragma unroll
                    for (int bj = 0; bj < 2; ++bj) { const f32x4 v0 = acc[ai][bj][m][0], v1 = acc[ai][bj][m][1];
                        u32x4 w; w.x = cvt_pk_bf16(v0[0], v0[1]); w.y = cvt_pk_bf16(v0[2], v0[3]); w.z = cvt_pk_bf16(v1[0], v1[1]); w.w = cvt_pk_bf16(v1[2], v1[3]);
                        *(u32x4*)(rowp + bj * HALF) = w; } }
        } else {
            float* pb = P + (size_t)u.ks * NCTX * ldc;
#pragma unroll
            for (int ai = 0; ai < 2; ++ai)
#pragma unroll
                for (int m = 0; m < 4; ++m) { float* rowp = pb + (size_t)(row0 - NLAT + ai * HALF + m * 16) * ldc + col0;
#pragma unroll
                    for (int bj = 0; bj < 2; ++bj) { *(f32x4*)(rowp + bj * HALF) = acc[ai][bj][m][0]; *(f32x4*)(rowp + bj * HALF + 4) = acc[ai][bj][m][1]; } }
        }
    }
};
struct EpiSwiglu8 {
    static constexpr bool PERM = true, AFTER_DRAIN = false;
    unsigned char* O; int ldc;
    __device__ __forceinline__ void operator()(const f32x4 (&acc)[2][2][4][2], const Unit& u, int wr, int wc, int fr, int fq) const {
        const int row0 = u.pm * BM + wr * 64 + fr; const int col0 = u.pc * HALF + wc * 32 + 8 * fq;
#pragma unroll
        for (int ai = 0; ai < 2; ++ai)
#pragma unroll
            for (int m = 0; m < 4; ++m) { unsigned char* rowp = O + (size_t)(row0 + ai * HALF + m * 16) * ldc + col0;
                f32x4 a0, a1;
#pragma unroll
                for (int e = 0; e < 4; ++e) { a0[e] = silu_f(acc[ai][0][m][0][e]) * acc[ai][1][m][0][e]; a1[e] = silu_f(acc[ai][0][m][1][e]) * acc[ai][1][m][1][e]; }
                v2u w; w.x = pk4_fp8(a0[0], a0[1], a0[2], a0[3]); w.y = pk4_fp8(a1[0], a1[1], a1[2], a1[3]);
                *(v2u*)rowp = w; }
    }
};
struct MoeOrder {
    int nM, nN, nwg, G, c; int t1, t2, t3, t4, t5, t6, t7;
    __device__ __forceinline__ bool next(int i, Unit& u) const {
        const long L = (long)i * G + c; if (L >= nwg) return false;
        int wgid = (int)L; { const int q = nwg / NXCD, r = nwg % NXCD, xcd = wgid % NXCD, off = wgid / NXCD; wgid = (xcd < r ? xcd * (q + 1) : r * (q + 1) + (xcd - r) * q) + off; }
        const int nig = WGM * nN, gid = wgid / nig, fm = gid * WGM, gsz = (nM - fm) < WGM ? (nM - fm) : WGM;
        u.pm = fm + ((wgid % nig) % gsz); u.pc = (wgid % nig) / gsz;
        const int e = (u.pm >= t1) + (u.pm >= t2) + (u.pm >= t3) + (u.pm >= t4) + (u.pm >= t5) + (u.pm >= t6) + (u.pm >= t7);
        u.pn = e * nN + u.pc; u.k0 = 0; u.nt = 0; u.ks = -1; return true;
    }
    __device__ __forceinline__ void a_ready(const Unit&) const {}
    __device__ __forceinline__ void done(const Unit&) const {}
};
}

__device__ __forceinline__ int swiglu_row(int n, int F) { const int bj = n / F, w = n % F; return 256 * (w >> 7) + 128 * bj + (w & 127); }
__device__ __forceinline__ int w_rowmap(int map, int mapF, int n) {
    if (map == 1) { if (n < 2048) { const int d0 = n & 255, hf = d0 >> 7, e = d0 & 127; return (n - d0) + 2 * (hf * 64 + (e & 63)) + (e >> 6); }
                    if (n >= 4096) return 4096 + swiglu_row(n - 4096, 2048); return n; }
    if (map == 2) { if (n < 2048) { const int d0 = n & 63, hf = d0 >> 5, e = d0 & 31; return (n - d0) + hf * 32 + 2 * (e & 15) + (e >> 4); } return n; }
    if (map == 3) return swiglu_row(n, mapF);
    return n;
}
template <bool FP8> __device__ __forceinline__ void p0_item64(const float* W, int K, int N, void* WT, int map, int mapF, LAS float* scr, int k0, int n0, int lane, float wscale) {
    { const int kq = lane >> 4, n4 = (lane & 15) * 4;
#pragma unroll 4
      for (int i = 0; i < 16; ++i) { const int k = 4 * i + kq; const f32x4 v = *(const GAS f32x4*)(W + (size_t)(k0 + k) * N + n0 + n4);
          LAS float* d = scr + k * 65 + n4; d[0] = v.x; d[1] = v.y; d[2] = v.z; d[3] = v.w; } }
    LDS_WAIT(); asm volatile("" ::: "memory");
    if constexpr (!FP8) {
        const int c = lane & 7;
#pragma unroll
        for (int j = 0; j < 8; ++j) { const int n = (lane >> 3) + 8 * j; const LAS float* sp = scr + (8 * c) * 65 + n;
            v4u o; o.x = pk2(sp[0 * 65], sp[1 * 65]); o.y = pk2(sp[2 * 65], sp[3 * 65]); o.z = pk2(sp[4 * 65], sp[5 * 65]); o.w = pk2(sp[6 * 65], sp[7 * 65]);
            *(GAS v4u*)((bf16*)WT + (size_t)w_rowmap(map, mapF, n0 + n) * K + k0 + 8 * c) = o; }
    } else {
        const int c = lane & 3;
#pragma unroll
        for (int j = 0; j < 4; ++j) { const int n = (lane >> 2) + 16 * j; const LAS float* sp = scr + (16 * c) * 65 + n;
            v4u o;
#pragma unroll
            for (int q = 0; q < 4; ++q) o[q] = pk4_fp8(sp[(4 * q) * 65] * wscale, sp[(4 * q + 1) * 65] * wscale, sp[(4 * q + 2) * 65] * wscale, sp[(4 * q + 3) * 65] * wscale);
            *(GAS v4u*)((unsigned char*)WT + (size_t)w_rowmap(map, mapF, n0 + n) * K + k0 + 16 * c) = o; }
    }
    LDS_WAIT(); asm volatile("" ::: "memory");
}

__device__ __forceinline__ void p0_colitem_i8(Frame& F, const float* W, int N, unsigned char* WT, float* WSC, int map, int mapF, LAS float* scr, int n0) {
    LAS float* mx = (LAS float*)(F.lds + 8 * 16640);
    LAS float* invs = mx + 512 + F.wave * 64;
    const int lane = F.lane, w = F.wave, kq = lane >> 4, n4 = (lane & 15) * 4;
    float m = 0.f;
    for (int h = 0; h < 2; ++h) { const int k0 = 64 * (2 * w + h);
#pragma unroll 4
        for (int i = 0; i < 16; ++i) { const int k = 4 * i + kq; const f32x4 v = *(const GAS f32x4*)(W + (size_t)(k0 + k) * N + n0 + n4);
            LAS float* d = scr + k * 65 + n4; d[0] = v.x; d[1] = v.y; d[2] = v.z; d[3] = v.w; }
        LDS_WAIT(); asm volatile("" ::: "memory");
#pragma unroll 8
        for (int k = 0; k < 64; ++k) m = fmaxf(m, fabsf(scr[k * 65 + lane]));
        LDS_WAIT(); asm volatile("" ::: "memory"); }
    mx[w * 64 + lane] = m; __syncthreads();
    float cm = 0.f;
#pragma unroll
    for (int i = 0; i < 8; ++i) cm = fmaxf(cm, mx[i * 64 + lane]);
    invs[lane] = cm > 0.f ? 127.0f / cm : 0.f;
    if (w == 0) WSC[w_rowmap(map, mapF, n0 + lane)] = cm * (1.0f / 127.0f);
    LDS_WAIT(); asm volatile("" ::: "memory");
    for (int h = 0; h < 2; ++h) { const int k0 = 64 * (2 * w + h);
#pragma unroll 4
        for (int i = 0; i < 16; ++i) { const int k = 4 * i + kq; const f32x4 v = *(const GAS f32x4*)(W + (size_t)(k0 + k) * N + n0 + n4);
            LAS float* d = scr + k * 65 + n4; d[0] = v.x; d[1] = v.y; d[2] = v.z; d[3] = v.w; }
        LDS_WAIT(); asm volatile("" ::: "memory");
        const int c = lane & 3;
#pragma unroll
        for (int j = 0; j < 4; ++j) { const int n = (lane >> 2) + 16 * j; const LAS float* sp = scr + (16 * c) * 65 + n; const float iv = invs[n];
            v4u o;
#pragma unroll
            for (int q = 0; q < 4; ++q) o[q] = pk4_i8(sp[(4 * q) * 65] * iv, sp[(4 * q + 1) * 65] * iv, sp[(4 * q + 2) * 65] * iv, sp[(4 * q + 3) * 65] * iv);
            *(GAS v4u*)(WT + (size_t)w_rowmap(map, mapF, n0 + n) * 1024 + k0 + 16 * c) = o; }
        LDS_WAIT(); asm volatile("" ::: "memory"); }
    __syncthreads();
}

__device__ __forceinline__ void p0_prologue(Frame& F, const Args& a) {
    LAS float* scr = (LAS float*)(F.lds + F.wave * 16640);
    const int gw = F.vcu * NWAVES + F.wave, NGW = F.G * NWAVES;
    constexpr int I1 = (2048 / 64) * (D / 64), I3 = (DFF / 64) * (D / 64), I4 = (D / 64) * (3072 / 64), I5 = (D / 64) * (D / 64);
    constexpr int I6E = (D / 64) * (2 * DFE / 64), I7E = (DFE / 64) * (D / 64);
    constexpr int NITEMS = I1 + I3 + I4 + I5 + NE * I6E + NE * I7E;
    for (int ci = F.vcu; ci < 8192 / 64 + 2 * DFF / 64; ci += F.G) {
        if (ci < 8192 / 64) p0_colitem_i8(F, a.in[I_L0_WIN], 8192, F.ws + WS_W0IN, (float*)(F.ws + WS_WSC0), 1, 0, scr, 64 * ci);
        else p0_colitem_i8(F, a.in[I_L0_WGU], 2 * DFF, F.ws + WS_W0GU, (float*)(F.ws + WS_WSC2), 3, DFF, scr, 64 * (ci - 8192 / 64));
    }
    for (int it = gw; it < NITEMS; it += NGW) {
        int r = it;
        if (r < I1) { const int nb = r % (D / 64), kb = r / (D / 64); p0_item64<false>(a.in[I_L0_WOUT], 2048, D, F.ws + WS_W0OUT, 0, 0, scr, 64 * kb, 64 * nb, F.lane, 1.f); continue; } r -= I1;
        if (r < I3) { const int nb = r % (D / 64), kb = r / (D / 64); p0_item64<false>(a.in[I_L0_WDN], DFF, D, F.ws + WS_W0DN, 0, 0, scr, 64 * kb, 64 * nb, F.lane, 1.f); continue; } r -= I3;
        if (r < I4) { const int nb = r % (3072 / 64), kb = r / (3072 / 64); p0_item64<true>(a.in[I_L1_WIN], D, 3072, F.ws + WS_W1IN, 2, 0, scr, 64 * kb, 64 * nb, F.lane, MOE_WSCALE); continue; } r -= I4;
        if (r < I5) { const int nb = r % (D / 64), kb = r / (D / 64); p0_item64<false>(a.in[I_L1_WOUT], D, D, F.ws + WS_W1OUT, 0, 0, scr, 64 * kb, 64 * nb, F.lane, 1.f); continue; } r -= I5;
        if (r < NE * I6E) { const int e = r / I6E, rr = r % I6E; const int nb = rr % (2 * DFE / 64), kb = rr / (2 * DFE / 64);
            p0_item64<true>(a.in[I_L1_MGU] + (size_t)e * D * 2 * DFE, D, 2 * DFE, F.ws + WS_WMGU + (size_t)e * 2 * DFE * D, 3, DFE, scr, 64 * kb, 64 * nb, F.lane, MOE_WSCALE); continue; } r -= NE * I6E;
        { const int e = r / I7E, rr = r % I7E; const int nb = rr % (D / 64), kb = rr / (D / 64);
            p0_item64<true>(a.in[I_L1_MDN] + (size_t)e * DFE * D, DFE, D, F.ws + WS_WMDN + (size_t)e * D * DFE, 0, 0, scr, 64 * kb, 64 * nb, F.lane, MOE_WSCALE); }
    }
    __syncthreads();
    {
        LAS float* sc = (LAS float*)F.lds;
        LAS float* part = (LAS float*)(F.lds + 9 * 1024 * 4);
        bool loaded = false;
        for (int grp = F.vcu; grp < 2 * (6 * D / 64); grp += F.G) {
            if (!loaded) { for (int i = F.tid; i < 9 * 1024; i += NTHREADS) { const float cv = (i < 8 * 1024) ? a.in[I_C][i] : a.in[I_CCTX][i - 8 * 1024]; sc[i] = silu_f(cv); } loaded = true; }
            __syncthreads();
            const int layer = grp / (6 * D / 64), cb = (grp % (6 * D / 64)) * 64;
            const float* W = a.in[layer ? I_L1_WMOD : I_L0_WMOD]; const float* bm = a.in[layer ? I_L1_BMOD : I_L0_BMOD];
            const int ks = F.tid >> 6, col = F.tid & 63;
            float acc[9];
#pragma unroll
            for (int b = 0; b < 9; ++b) acc[b] = 0.f;
            for (int k = ks * 128; k < ks * 128 + 128; ++k) { const float w = W[(size_t)k * (6 * D) + cb + col];
#pragma unroll
                for (int b = 0; b < 9; ++b) acc[b] += sc[b * 1024 + k] * w; }
#pragma unroll
            for (int b = 0; b < 9; ++b) part[(ks * 9 + b) * 64 + col] = acc[b];
            __syncthreads();
            for (int o = F.tid; o < 9 * 64; o += NTHREADS) { const int b = o >> 6, cc = o & 63; float s = bm[cb + cc];
#pragma unroll
                for (int k2 = 0; k2 < 8; ++k2) s += part[(k2 * 9 + b) * 64 + cc];
                ((float*)(F.ws + WS_MODV))[((size_t)layer * 9 + b) * (6 * D) + cb + cc] = s; }
            __syncthreads();
        }
    }
    {
        const int gt = F.vcu * NTHREADS + F.tid;
        if (gt < 64 * 64 + 64 * 16) {
            int pos, i; float ex;
            if (gt < 4096) { pos = gt >> 6; i = gt & 63; ex = (float)(2 * i) / 128.0f; } else { const int q = gt - 4096; pos = q >> 4; i = q & 15; ex = (float)(2 * i) / 32.0f; }
            const float freq = __builtin_amdgcn_exp2f(-ex * 13.287712379549449f);
            const float rev = (float)pos * freq * 0.15915494309189535f;
            const float cs = __builtin_amdgcn_cosf(rev), sn = __builtin_amdgcn_sinf(rev);
            f32x2* t = (f32x2*)(F.ws + (gt < 4096 ? WS_TAB0 : WS_TAB1)); t[gt < 4096 ? gt : gt - 4096] = (f32x2){cs, sn};
        }
        if (gt == 0) { const float* lp = a.in[I_L1_LAMBDA]; float s1 = 0.f, s2 = 0.f; for (int i = 0; i < 64; ++i) { s1 += lp[i] * lp[64 + i]; s2 += lp[128 + i] * lp[192 + i]; }
            *(float*)(F.ws + WS_LAM) = __expf(s1) - __expf(s2) + LAMBDA_INIT; }
    }
}

struct RowPass {
    int nrows;
    const float* xin_lat; const float* xin_ctx; float* xout_lat; float* xout_ctx;
    const bf16* br;
    const float* gpost;
    const float* gate;
    const float* gpre;
    const float* shift; const float* scale;
    bf16* hout;
    const float* part;
    float* rsc;
};
template <bool BR, bool MOEBR, bool WH, bool ROUTE, int H8 = 0, int KSPL = 0, bool XI16 = false, bool XO16 = false>
__device__ __forceinline__ void row_pass(Frame& F, const Args& a, const RowPass& P) {
    const int gw = F.vcu * NWAVES + F.wave, NGW = F.G * NWAVES;
    const int l4 = F.lane * 4;
    for (int r = gw; r < P.nrows; r += NGW) {
        const bool lat = r < NLAT; const int rc = lat ? r : r - NLAT; const int midx = lat ? (r >> 12) : 8;
        const float* xin = (lat ? P.xin_lat : P.xin_ctx) + (size_t)rc * (XI16 ? D / 2 : D);
        float* xout = (lat ? P.xout_lat : P.xout_ctx) + (size_t)rc * (XO16 ? D / 2 : D);
        f32x4 v[4];
        if constexpr (XI16) {
#pragma unroll
            for (int j = 0; j < 4; ++j) { const v2u w = *(const GAS v2u*)((const bf16*)xin + l4 + 256 * j); v[j] = (f32x4){bflo(w.x), bfhi(w.x), bflo(w.y), bfhi(w.y)}; }
        } else {
#pragma unroll
            for (int j = 0; j < 4; ++j) v[j] = *(const GAS f32x4*)(xin + l4 + 256 * j);
        }
        if constexpr (BR || MOEBR) {
            f32x4 y[4];
            if constexpr (BR) {
                if (KSPL > 0 && !lat) {
#pragma unroll
                    for (int j = 0; j < 4; ++j) y[j] = (f32x4){0.f, 0.f, 0.f, 0.f};
                    for (int ks = 0; ks < KSPL; ++ks) { const float* pr = P.part + ((size_t)ks * NCTX + rc) * D + l4;
#pragma unroll
                        for (int j = 0; j < 4; ++j) y[j] = y[j] + *(const GAS f32x4*)(pr + 256 * j); }
                } else {
#pragma unroll
                for (int j = 0; j < 4; ++j) { const v2u w = *(const GAS v2u*)(P.br + (size_t)r * D + l4 + 256 * j); y[j] = (f32x4){bflo(w.x), bfhi(w.x), bflo(w.y), bfhi(w.y)}; }
                }
            } else {
                const int* tpos = (const int*)(F.ws + WS_ROUTE + (size_t)NLAT * 8); const float* tw = (const float*)(F.ws + WS_ROUTE + (size_t)NLAT * 16);
                const int s0 = tpos[2 * r], s1 = tpos[2 * r + 1]; const float w0 = tw[2 * r], w1 = tw[2 * r + 1];
#pragma unroll
                for (int j = 0; j < 4; ++j) { const v2u p = *(const GAS v2u*)(P.br + (size_t)s0 * D + l4 + 256 * j); const v2u q = *(const GAS v2u*)(P.br + (size_t)s1 * D + l4 + 256 * j);
                    y[j] = (f32x4){w0 * bflo(p.x) + w1 * bflo(q.x), w0 * bfhi(p.x) + w1 * bfhi(q.x), w0 * bflo(p.y) + w1 * bflo(q.y), w0 * bfhi(p.y) + w1 * bfhi(q.y)}; }
            }
            float ss = 0.f;
#pragma unroll
            for (int j = 0; j < 4; ++j) ss += (y[j].x * y[j].x + y[j].y * y[j].y) + (y[j].z * y[j].z + y[j].w * y[j].w);
            const float rstd = 1.0f / sqrtf(wave_sum(ss) * (1.0f / D) + EPS);
#pragma unroll
            for (int j = 0; j < 4; ++j) { const f32x4 gp = *(const GAS f32x4*)(P.gpost + l4 + 256 * j); const f32x4 gt = *(const GAS f32x4*)(P.gate + (size_t)midx * 6 * D + l4 + 256 * j);
                v[j] = v[j] + gt * (y[j] * rstd * gp); }
            if ((lat ? P.xout_lat : P.xout_ctx) != nullptr) {
                if constexpr (XO16) {
#pragma unroll
                    for (int j = 0; j < 4; ++j) { v2u w; w.x = pk2(v[j].x, v[j].y); w.y = pk2(v[j].z, v[j].w); *(GAS v2u*)((bf16*)xout + l4 + 256 * j) = w; }
                } else {
#pragma unroll
                    for (int j = 0; j < 4; ++j) *(GAS f32x4*)(xout + l4 + 256 * j) = v[j];
                }
            }
        }
        if constexpr (WH) {
            float ss = 0.f;
#pragma unroll
            for (int j = 0; j < 4; ++j) ss += (v[j].x * v[j].x + v[j].y * v[j].y) + (v[j].z * v[j].z + v[j].w * v[j].w);
            const float rstd = 1.0f / sqrtf(wave_sum(ss) * (1.0f / D) + EPS);
            f32x4 h[4];
#pragma unroll
            for (int j = 0; j < 4; ++j) { const f32x4 gp = *(const GAS f32x4*)(P.gpre + l4 + 256 * j); const f32x4 sc = *(const GAS f32x4*)(P.scale + (size_t)midx * 6 * D + l4 + 256 * j);
                const f32x4 sh = *(const GAS f32x4*)(P.shift + (size_t)midx * 6 * D + l4 + 256 * j);
                h[j] = (v[j] * rstd * gp) * (1.0f + sc) + sh;
                if constexpr (H8 == 2) { }
                else if constexpr (H8 == 1) { *(GAS unsigned*)((unsigned char*)P.hout + (size_t)r * D + l4 + 256 * j) = pk4_fp8(h[j].x, h[j].y, h[j].z, h[j].w); }
                else { v2u w; w.x = pk2(h[j].x, h[j].y); w.y = pk2(h[j].z, h[j].w); *(GAS v2u*)(P.hout + (size_t)r * D + l4 + 256 * j) = w; } }
            if constexpr (H8 == 2) {
                float am = 0.f;
#pragma unroll
                for (int j = 0; j < 4; ++j) am = fmaxf(fmaxf(am, fmaxf(fabsf(h[j].x), fabsf(h[j].y))), fmaxf(fabsf(h[j].z), fabsf(h[j].w)));
                am = wave_max(am);
                const float iv = am > 0.f ? 127.0f / am : 0.f;
#pragma unroll
                for (int j = 0; j < 4; ++j) *(GAS unsigned*)((unsigned char*)P.hout + (size_t)r * D + l4 + 256 * j) = pk4_i8(h[j].x * iv, h[j].y * iv, h[j].z * iv, h[j].w * iv);
                if (F.lane == 0) P.rsc[r] = am * (1.0f / 127.0f);
            }
            if constexpr (ROUTE) {
                const float* rw = a.in[I_L1_RW];
                float lg[8];
#pragma unroll
                for (int e = 0; e < 8; ++e) lg[e] = 0.f;
#pragma unroll
                for (int j = 0; j < 4; ++j)
#pragma unroll
                    for (int q = 0; q < 4; ++q) { const int k = l4 + 256 * j + q; const f32x4 wa = *(const GAS f32x4*)(rw + (size_t)k * 8), wb = *(const GAS f32x4*)(rw + (size_t)k * 8 + 4); const float hv = h[j][q];
                        lg[0] += hv * wa.x; lg[1] += hv * wa.y; lg[2] += hv * wa.z; lg[3] += hv * wa.w; lg[4] += hv * wb.x; lg[5] += hv * wb.y; lg[6] += hv * wb.z; lg[7] += hv * wb.w; }
#pragma unroll
                for (int e = 0; e < 8; ++e) lg[e] = wave_sum(lg[e]) + a.in[I_L1_RB][e];
                float v1 = lg[0]; int i1 = 0;
#pragma unroll
                for (int e = 1; e < 8; ++e) if (lg[e] > v1) { v1 = lg[e]; i1 = e; }
                float v2 = -3.0e38f; int i2 = 0;
#pragma unroll
                for (int e = 0; e < 8; ++e) if (e != i1 && lg[e] > v2) { v2 = lg[e]; i2 = e; }
                const float w1 = 1.0f / (1.0f + __expf(v2 - v1)), w2 = 1.0f - w1;
                if (F.lane == 0) {
                    int* te = (int*)(F.ws + WS_ROUTE); int* tpos = (int*)(F.ws + WS_ROUTE + (size_t)NLAT * 8); float* tw = (float*)(F.ws + WS_ROUTE + (size_t)NLAT * 16);
                    const unsigned p1 = __hip_atomic_fetch_add((unsigned*)(F.ctl + CW_MOECNT + 64 * i1), 1u, RLX_AGENT);
                    const unsigned p2 = __hip_atomic_fetch_add((unsigned*)(F.ctl + CW_MOECNT + 64 * i2), 1u, RLX_AGENT);
                    te[2 * r] = i1; te[2 * r + 1] = i2; tpos[2 * r] = (int)p1; tpos[2 * r + 1] = (int)p2; tw[2 * r] = w1; tw[2 * r + 1] = w2;
                }
            }
        }
    }
}


namespace att {
using s16x4  = __attribute__((ext_vector_type(4))) short;
using f32x16 = __attribute__((ext_vector_type(16))) float;
using u32x4  = __attribute__((ext_vector_type(4))) unsigned;
constexpr int KVBLK = 64, NT = (SEQ + CTXL) / KVBLK;
constexpr int SHM_V = KVBLK * 128, SHM_K = KVBLK * 64 * 2;
constexpr int NVTILE = MALL / KVBLK;
constexpr int NSLOT_K = 3, NSLOT_V = 4;
constexpr int OFF_V = 0, OFF_K = NSLOT_V * SHM_V, OFF_WS = OFF_K + NSLOT_K * SHM_K, OFF_O1 = OFF_WS + NWAVES * 64 * 4, ATT_LDS = OFF_O1 + NWAVES * 8192;
constexpr float THR = 8.0f;
#define ATT_SBAR() __builtin_amdgcn_sched_barrier(0)
#define ATT_PIPE_PV() do { __builtin_amdgcn_sched_group_barrier(0x100, 2, 0); \
    _Pragma("unroll") for (int i_ = 0; i_ < 16; ++i_) { __builtin_amdgcn_sched_group_barrier(0x008, 1, 0); __builtin_amdgcn_sched_group_barrier(0x100, 2, 0); __builtin_amdgcn_sched_group_barrier(0x002, 7, 0); } } while (0)
#define KSWZ64(row, colB) ((row) * 128 + ((colB) ^ ((((row) >> 1) & 7) << 4)))
__device__ __forceinline__ int crow(int r, int hi) { return (r & 3) + 8 * (r >> 2) + 4 * hi; }
__device__ __forceinline__ unsigned cvtpk(float lo, float hi) { return pk2(lo, hi); }

template <int VAR = 0> __device__ __forceinline__ void partialSM(f32x16& p0, f32x16& p1, float& m_reg, f32x16& negm, float& alpha) {
    float mx[4];
#pragma unroll
    for (int c = 0; c < 4; ++c) mx[c] = fmaxf(fmaxf(p0[4 * c], p0[4 * c + 1]), fmaxf(p0[4 * c + 2], p0[4 * c + 3]));
#pragma unroll
    for (int c = 0; c < 4; ++c) mx[c] = fmaxf(mx[c], fmaxf(fmaxf(p1[4 * c], p1[4 * c + 1]), fmaxf(p1[4 * c + 2], p1[4 * c + 3])));
    float pmax = fmaxf(fmaxf(mx[0], mx[1]), fmaxf(mx[2], mx[3]));
    { auto rr = __builtin_amdgcn_permlane32_swap(__float_as_uint(pmax), __float_as_uint(pmax), false, false); pmax = fmaxf(__uint_as_float(rr[0]), __uint_as_float(rr[1])); }
    alpha = 1.f; m_reg = pmax;
#pragma unroll
    for (int r = 0; r < 16; ++r) { negm[r] = -pmax; p0[r] = __builtin_amdgcn_exp2f(p0[r] - pmax); p1[r] = __builtin_amdgcn_exp2f(p1[r] - pmax); }
}
template <int VAR = 0> __device__ __forceinline__ void finishSM(f32x16& p0, f32x16& p1, float alpha, float& l_reg, bf16x8& pa0, bf16x8& pa1, bf16x8& pa2, bf16x8& pa3) {
    if (VAR != 2) {
    f32x2 s2[4];
#pragma unroll
    for (int c = 0; c < 4; ++c) s2[c] = (f32x2){p0[4 * c], p0[4 * c + 1]} + (f32x2){p0[4 * c + 2], p0[4 * c + 3]};
#pragma unroll
    for (int c = 0; c < 4; ++c) s2[c] = s2[c] + ((f32x2){p1[4 * c], p1[4 * c + 1]} + (f32x2){p1[4 * c + 2], p1[4 * c + 3]});
    const f32x2 s2t = (s2[0] + s2[1]) + (s2[2] + s2[3]);
    float ps = s2t[0] + s2t[1];
    { auto rr = __builtin_amdgcn_permlane32_swap(__float_as_uint(ps), __float_as_uint(ps), false, false); ps = __uint_as_float(rr[0]) + __uint_as_float(rr[1]); }
    l_reg = l_reg * alpha + ps;
    } else { l_reg = 1.f; }
#define ATT_PK4(P, BASE, OUT) do { u32x4 w = {cvtpk(P[BASE + 0], P[BASE + 1]), cvtpk(P[BASE + 2], P[BASE + 3]), cvtpk(P[BASE + 4], P[BASE + 5]), cvtpk(P[BASE + 6], P[BASE + 7])}; OUT = *reinterpret_cast<bf16x8*>(&w); } while (0)
    ATT_PK4(p0, 0, pa0); ATT_PK4(p0, 8, pa1); ATT_PK4(p1, 0, pa2); ATT_PK4(p1, 8, pa3);
#undef ATT_PK4
}
__device__ __forceinline__ void qkt(f32x16& p0, f32x16& p1, const char* Ks, const bf16x8* qr, const f32x16& negm, int r32, int hi) {
#pragma unroll
    for (int d0 = 0; d0 < 4; ++d0) { const int cb = (d0 * 16 + hi * 8) * 2;
        const bf16x8 b0 = *reinterpret_cast<const bf16x8*>(Ks + KSWZ64(r32, cb));
        const bf16x8 b1 = *reinterpret_cast<const bf16x8*>(Ks + KSWZ64(32 + r32, cb));
        if (d0 == 0) { p0 = __builtin_amdgcn_mfma_f32_32x32x16_bf16(b0, qr[0], negm, 0, 0, 0); p1 = __builtin_amdgcn_mfma_f32_32x32x16_bf16(b1, qr[0], negm, 0, 0, 0); }
        else { p0 = __builtin_amdgcn_mfma_f32_32x32x16_bf16(b0, qr[d0], p0, 0, 0, 0); p1 = __builtin_amdgcn_mfma_f32_32x32x16_bf16(b1, qr[d0], p1, 0, 0, 0); } }
}
__device__ __forceinline__ int v_st(int k, int c) { const int kk = (k & ~0xC) | ((k & 4) << 1) | ((k & 8) >> 1); return ((kk >> 3) * 4 + (c >> 5)) * 512 + ((kk & 7) * 32 + (c & 31)) * 2; }
__device__ __forceinline__ int v_rd_base(int lane) { return ((lane & 3) << 3) | (((lane >> 2) & 3) << 6) | (((lane >> 4) & 1) << 5) | (((lane >> 5) & 1) << 8); }
constexpr int v_rd_off(int d0, int ks, int half) { return d0 * 512 + ks * 4096 + half * 2048; }
typedef short v4i16a_t __attribute__((ext_vector_type(4)));
template <int OFF> __device__ __forceinline__ s16x4 tr_read(int vb) { return __builtin_bit_cast(s16x4, __builtin_amdgcn_ds_read_tr16_b64_v4i16((LAS v4i16a_t*)(unsigned)(vb + OFF))); }
#define ATT_PK(L, H) (bf16x8){L[0], L[1], L[2], L[3], H[0], H[1], H[2], H[3]}
template <int D0> __device__ __forceinline__ void pv_one(f32x16& od, int vb, bf16x8 pa0, bf16x8 pa1, bf16x8 pa2, bf16x8 pa3) {
    const s16x4 l0 = tr_read<v_rd_off(D0, 0, 0)>(vb), h0 = tr_read<v_rd_off(D0, 0, 1)>(vb), l1 = tr_read<v_rd_off(D0, 1, 0)>(vb), h1 = tr_read<v_rd_off(D0, 1, 1)>(vb);
    const s16x4 l2 = tr_read<v_rd_off(D0, 2, 0)>(vb), h2 = tr_read<v_rd_off(D0, 2, 1)>(vb), l3 = tr_read<v_rd_off(D0, 3, 0)>(vb), h3 = tr_read<v_rd_off(D0, 3, 1)>(vb);
    od = __builtin_amdgcn_mfma_f32_32x32x16_bf16(pa0, ATT_PK(l0, h0), od, 0, 0, 0);
    od = __builtin_amdgcn_mfma_f32_32x32x16_bf16(pa1, ATT_PK(l1, h1), od, 0, 0, 0);
    od = __builtin_amdgcn_mfma_f32_32x32x16_bf16(pa2, ATT_PK(l2, h2), od, 0, 0, 0);
    od = __builtin_amdgcn_mfma_f32_32x32x16_bf16(pa3, ATT_PK(l3, h3), od, 0, 0, 0);
}
#undef ATT_PK
__device__ __forceinline__ void pv_d0(f32x16* o, int vb, bf16x8 pa0, bf16x8 pa1, bf16x8 pa2, bf16x8 pa3) {
    pv_one<0>(o[0], vb, pa0, pa1, pa2, pa3); pv_one<1>(o[1], vb, pa0, pa1, pa2, pa3); pv_one<2>(o[2], vb, pa0, pa1, pa2, pa3); pv_one<3>(o[3], vb, pa0, pa1, pa2, pa3);
}
struct VH { bf16x8 k0, k1; };
__device__ __forceinline__ void vhalf(bf16x8& d, s16x4 lo, s16x4 hi) { d = __builtin_shufflevector(lo, hi, 0, 1, 2, 3, 4, 5, 6, 7); }
template <int D0, int KS0> __device__ __forceinline__ void vh_load(VH& f, int vb) {
    vhalf(f.k0, tr_read<v_rd_off(D0, KS0, 0)>(vb), tr_read<v_rd_off(D0, KS0, 1)>(vb)); vhalf(f.k1, tr_read<v_rd_off(D0, KS0 + 1, 0)>(vb), tr_read<v_rd_off(D0, KS0 + 1, 1)>(vb));
}
#define ATT_PKV(L, H) (bf16x8){L[0], L[1], L[2], L[3], H[0], H[1], H[2], H[3]}
#define ATT_E3(P, B) do { P[B] = __builtin_amdgcn_exp2f(P[B]); P[(B) + 1] = __builtin_amdgcn_exp2f(P[(B) + 1]); P[(B) + 2] = __builtin_amdgcn_exp2f(P[(B) + 2]); } while (0)
#define ATT_MM(D, PA, FR) o[D] = __builtin_amdgcn_mfma_f32_32x32x16_bf16(PA, FR, o[D], 0, 0, 0)
#define ATT_PIN(x) asm volatile("" : "+v"(x))
__device__ __forceinline__ void pv_partial(f32x16* o, int vb, bf16x8 pa0, bf16x8 pa1, bf16x8 pa2, bf16x8 pa3, f32x16& p0, f32x16& p1, float& m_reg, f32x16& negm, float& alpha) {
    VH fa, fb; float mx[4];
    vh_load<0, 0>(fa, vb); vh_load<0, 2>(fb, vb);
    ATT_SBAR();
    ATT_MM(0, pa0, fa.k0);
    mx[0] = fmaxf(fmaxf(p0[0], p0[1]), p0[2]); mx[1] = fmaxf(fmaxf(p0[3], p0[4]), p0[5]); mx[2] = fmaxf(fmaxf(p0[6], p0[7]), p0[8]); mx[3] = fmaxf(fmaxf(p0[9], p0[10]), p0[11]); ATT_PIN(mx[0]); ATT_PIN(mx[1]); ATT_PIN(mx[2]); ATT_PIN(mx[3]); ATT_SBAR();
    ATT_MM(0, pa1, fa.k1); vh_load<1, 0>(fa, vb);
    mx[0] = fmaxf(fmaxf(mx[0], p0[12]), p0[13]); mx[1] = fmaxf(fmaxf(mx[1], p0[14]), p0[15]); mx[2] = fmaxf(fmaxf(mx[2], p1[0]), p1[1]); mx[3] = fmaxf(fmaxf(mx[3], p1[2]), p1[3]); ATT_PIN(mx[0]); ATT_PIN(mx[1]); ATT_PIN(mx[2]); ATT_PIN(mx[3]); ATT_SBAR();
    ATT_MM(0, pa2, fb.k0);
    mx[0] = fmaxf(fmaxf(mx[0], p1[4]), p1[5]); mx[1] = fmaxf(fmaxf(mx[1], p1[6]), p1[7]); mx[2] = fmaxf(fmaxf(mx[2], p1[8]), p1[9]); mx[3] = fmaxf(fmaxf(mx[3], p1[10]), p1[11]); ATT_PIN(mx[0]); ATT_PIN(mx[1]); ATT_PIN(mx[2]); ATT_PIN(mx[3]); ATT_SBAR();
    ATT_MM(0, pa3, fb.k1); vh_load<1, 2>(fb, vb);
    mx[0] = fmaxf(fmaxf(mx[0], p1[12]), p1[13]); mx[1] = fmaxf(fmaxf(mx[1], p1[14]), p1[15]); ATT_PIN(mx[0]); ATT_PIN(mx[1]); ATT_SBAR();
    ATT_MM(1, pa0, fa.k0);
    { float pmax = fmaxf(fmaxf(mx[0], mx[1]), fmaxf(mx[2], mx[3]));
      auto rr = __builtin_amdgcn_permlane32_swap(__float_as_uint(pmax), __float_as_uint(pmax), false, false); pmax = fmaxf(__uint_as_float(rr[0]), __uint_as_float(rr[1]));
      const bool need = pmax > THR; alpha = 1.f;
      if (__any(need)) { const float delta = need ? pmax : 0.f; alpha = __builtin_amdgcn_exp2f(-delta); m_reg += delta;
#pragma unroll
          for (int r = 0; r < 16; ++r) { p0[r] -= delta; p1[r] -= delta; negm[r] -= delta; } } } ATT_PIN(alpha); ATT_SBAR();
    ATT_MM(1, pa1, fa.k1); vh_load<2, 0>(fa, vb); ATT_E3(p0, 0); ATT_PIN(p0); ATT_SBAR();
    ATT_MM(1, pa2, fb.k0); ATT_E3(p0, 3); ATT_PIN(p0); ATT_SBAR();
    ATT_MM(1, pa3, fb.k1); vh_load<2, 2>(fb, vb); ATT_E3(p0, 6); ATT_PIN(p0); ATT_SBAR();
    ATT_MM(2, pa0, fa.k0); ATT_E3(p0, 9); ATT_PIN(p0); ATT_SBAR();
    ATT_MM(2, pa1, fa.k1); vh_load<3, 0>(fa, vb); ATT_E3(p0, 12); ATT_PIN(p0); ATT_SBAR();
    ATT_MM(2, pa2, fb.k0); p0[15] = __builtin_amdgcn_exp2f(p0[15]); p1[0] = __builtin_amdgcn_exp2f(p1[0]); p1[1] = __builtin_amdgcn_exp2f(p1[1]); ATT_PIN(p0); ATT_PIN(p1); ATT_SBAR();
    ATT_MM(2, pa3, fb.k1); vh_load<3, 2>(fb, vb); ATT_E3(p1, 2); ATT_PIN(p1); ATT_SBAR();
    ATT_MM(3, pa0, fa.k0); ATT_E3(p1, 5); ATT_PIN(p1); ATT_SBAR();
    ATT_MM(3, pa1, fa.k1); ATT_E3(p1, 8); ATT_PIN(p1); ATT_SBAR();
    ATT_MM(3, pa2, fb.k0); ATT_E3(p1, 11); ATT_PIN(p1); ATT_SBAR();
    ATT_MM(3, pa3, fb.k1); p1[14] = __builtin_amdgcn_exp2f(p1[14]); p1[15] = __builtin_amdgcn_exp2f(p1[15]); ATT_PIN(p1); ATT_SBAR();
}
#undef ATT_MM
#undef ATT_PIN
#undef ATT_E3
#undef ATT_PKV
typedef int v8i_a __attribute__((ext_vector_type(8)));
typedef int v4i_a __attribute__((ext_vector_type(4)));
__device__ __forceinline__ v8i_a v8_frag(unsigned a0, unsigned a1) {
    const v4i_a lo = *(const LAS v4i_a*)a0, hi = *(const LAS v4i_a*)a1; return __builtin_shufflevector(lo, hi, 0, 1, 2, 3, 4, 5, 6, 7); }
#define ATT_MM8(D, FR) asm volatile("v_mfma_scale_f32_32x32x64_f8f6f4 %0, %1, %2, %0, %3, %3 op_sel_hi:[0,0,0]" : "+v"(o[D]) : "v"(pa8), "v"(FR), "v"(one8))
#define ATT_PIN8(x) asm volatile("" : "+v"(x))
#define ATT_EX(P, B) P[B] = __builtin_amdgcn_exp2f(P[B])
__device__ __forceinline__ void pv8_partial(f32x16* o, unsigned va0, unsigned va1, v8i_a pa8, f32x16& p0, f32x16& p1, float& m_reg, f32x16& negm, float& alpha) {
    const int one8 = 0x7f7f7f7f;
    float mx[4];
    const v8i_a f0 = v8_frag(va0, va1), f1 = v8_frag(va0 + 2048, va1 + 2048), f2 = v8_frag(va0 + 4096, va1 + 4096), f3 = v8_frag(va0 + 6144, va1 + 6144);
    ATT_SBAR();
    ATT_MM8(0, f0);
    mx[0] = fmaxf(fmaxf(p0[0], p0[1]), p0[2]); mx[1] = fmaxf(fmaxf(p0[3], p0[4]), p0[5]); mx[2] = fmaxf(fmaxf(p0[6], p0[7]), p0[8]); mx[3] = fmaxf(fmaxf(p0[9], p0[10]), p0[11]);
    mx[0] = fmaxf(fmaxf(mx[0], p0[12]), p0[13]); mx[1] = fmaxf(fmaxf(mx[1], p0[14]), p0[15]); mx[2] = fmaxf(fmaxf(mx[2], p1[0]), p1[1]); mx[3] = fmaxf(fmaxf(mx[3], p1[2]), p1[3]);
    mx[0] = fmaxf(fmaxf(mx[0], p1[4]), p1[5]); mx[1] = fmaxf(fmaxf(mx[1], p1[6]), p1[7]); mx[2] = fmaxf(fmaxf(mx[2], p1[8]), p1[9]); mx[3] = fmaxf(fmaxf(mx[3], p1[10]), p1[11]);
    mx[0] = fmaxf(fmaxf(mx[0], p1[12]), p1[13]); mx[1] = fmaxf(fmaxf(mx[1], p1[14]), p1[15]);
    { float pmax = fmaxf(fmaxf(mx[0], mx[1]), fmaxf(mx[2], mx[3]));
      auto rr = __builtin_amdgcn_permlane32_swap(__float_as_uint(pmax), __float_as_uint(pmax), false, false); pmax = fmaxf(__uint_as_float(rr[0]), __uint_as_float(rr[1]));
      const bool need = pmax > THR; alpha = 1.f;
      if (__any(need)) { const float delta = need ? pmax : 0.f; alpha = __builtin_amdgcn_exp2f(-delta); m_reg += delta;
#pragma unroll
          for (int r = 0; r < 16; ++r) { p0[r] -= delta; p1[r] -= delta; negm[r] -= delta; } } } ATT_PIN8(alpha); ATT_SBAR();
    ATT_MM8(1, f1);
    ATT_EX(p0, 0); ATT_EX(p0, 1); ATT_EX(p0, 2); ATT_EX(p0, 3); ATT_EX(p0, 4); ATT_EX(p0, 5); ATT_EX(p0, 6); ATT_EX(p0, 7); ATT_EX(p0, 8); ATT_EX(p0, 9); ATT_EX(p0, 10); ATT_PIN8(p0); ATT_SBAR();
    ATT_MM8(2, f2);
    ATT_EX(p0, 11); ATT_EX(p0, 12); ATT_EX(p0, 13); ATT_EX(p0, 14); ATT_EX(p0, 15); ATT_EX(p1, 0); ATT_EX(p1, 1); ATT_EX(p1, 2); ATT_EX(p1, 3); ATT_EX(p1, 4); ATT_EX(p1, 5); ATT_PIN8(p0); ATT_PIN8(p1); ATT_SBAR();
    ATT_MM8(3, f3);
    ATT_EX(p1, 6); ATT_EX(p1, 7); ATT_EX(p1, 8); ATT_EX(p1, 9); ATT_EX(p1, 10); ATT_EX(p1, 11); ATT_EX(p1, 12); ATT_EX(p1, 13); ATT_EX(p1, 14); ATT_EX(p1, 15); ATT_PIN8(p1); ATT_SBAR();
    asm volatile("s_nop 15\n\ts_nop 15" ::: "memory");
}
#undef ATT_EX
__device__ __forceinline__ void finishSM8(f32x16& p0, f32x16& p1, float alpha, float& l_reg, v8i_a& pa8) {
    f32x2 s2[4];
#pragma unroll
    for (int c = 0; c < 4; ++c) s2[c] = (f32x2){p0[4 * c], p0[4 * c + 1]} + (f32x2){p0[4 * c + 2], p0[4 * c + 3]};
#pragma unroll
    for (int c = 0; c < 4; ++c) s2[c] = s2[c] + ((f32x2){p1[4 * c], p1[4 * c + 1]} + (f32x2){p1[4 * c + 2], p1[4 * c + 3]});
    const f32x2 s2t = (s2[0] + s2[1]) + (s2[2] + s2[3]);
    float ps = s2t[0] + s2t[1];
    { auto rr = __builtin_amdgcn_permlane32_swap(__float_as_uint(ps), __float_as_uint(ps), false, false); ps = __uint_as_float(rr[0]) + __uint_as_float(rr[1]); }
    l_reg = l_reg * alpha + ps;
#pragma unroll
    for (int q = 0; q < 4; ++q) { int w0 = 0, w1 = 0;
        w0 = __builtin_amdgcn_cvt_pk_fp8_f32(p0[4 * q], p0[4 * q + 1], w0, false); w0 = __builtin_amdgcn_cvt_pk_fp8_f32(p0[4 * q + 2], p0[4 * q + 3], w0, true);
        w1 = __builtin_amdgcn_cvt_pk_fp8_f32(p1[4 * q], p1[4 * q + 1], w1, false); w1 = __builtin_amdgcn_cvt_pk_fp8_f32(p1[4 * q + 2], p1[4 * q + 3], w1, true);
        pa8[q] = w0; pa8[4 + q] = w1; }
}
__device__ __forceinline__ size_t kvrow(int b, int t) { return t < 64 ? (size_t)b * SEQ + (size_t)t * 64 : (size_t)NLAT + (size_t)b * CTXL + (size_t)(t - 64) * 64; }

__device__ __forceinline__ void glds16(const void* gsrc, unsigned lds_dst) { unsigned keep;
    asm volatile("s_mov_b32 %0, m0\n\ts_mov_b32 m0, %2\n\ts_nop 0\n\tglobal_load_lds_dwordx4 %1, off\n\ts_mov_b32 m0, %0" : "=&s"(keep) : "v"(gsrc), "s"(lds_dst) : "memory"); }
template <int VAR> __device__ __forceinline__ void head_pass(const bf16* __restrict__ Q1, const bf16* __restrict__ K1, const unsigned char* __restrict__ V8, int b, int qh, int hp, size_t qrow0, char* lds, f32x16 (&o)[4], float& l_out) {
    int tid_ = threadIdx.x; asm volatile("" : "+v"(tid_));
    const int tid = tid_, wid = __builtin_amdgcn_readfirstlane(tid >> 6), lane = tid & 63, r32 = lane & 31, hi = lane >> 5;
    char* V_lds = lds + OFF_V; char* K_lds = lds + OFF_K;
    float* wsf = (float*)(lds + OFF_WS) + wid * 64; float* al_l = wsf + 32;
    float m_reg = 0.f, l_reg = 0.f; f32x16 negm = f32x16{};
#pragma unroll
    for (int d = 0; d < 4; ++d) o[d] = f32x16{};
    const bf16* Kh = K1 + (size_t)qh * MALL * 64; const unsigned char* Vh = V8 + (size_t)hp * NVTILE * SHM_V;
    const int kr = 8 * wid + (lane >> 3); const unsigned koff = (unsigned)(kr * 128 + (((lane & 7) ^ ((kr >> 1) & 7)) << 4));
    const unsigned lbase = (unsigned)(uintptr_t)lds;
#define ATT_ISSUE(t_, ks_, vs_) do { const int tt_ = (t_); const size_t rb_ = kvrow(b, tt_); const char* kb_ = (const char*)(Kh + rb_ * 64); \
    const unsigned char* vb_ = Vh + (size_t)(tt_ < 64 ? b * 64 + tt_ : 512 + 4 * b + (tt_ - 64)) * SHM_V; \
    glds16(kb_ + koff, (unsigned)__builtin_amdgcn_readfirstlane(lbase + OFF_K + (ks_) * SHM_K + wid * 1024)); \
    glds16(vb_ + wid * 1024 + lane * 16, (unsigned)__builtin_amdgcn_readfirstlane(lbase + OFF_V + (vs_) * SHM_V + wid * 1024)); } while (0)
#define ATT_WAITBAR(N) do { asm volatile("s_waitcnt vmcnt(" #N ")" ::: "memory"); __builtin_amdgcn_s_barrier(); asm volatile("" ::: "memory"); } while (0)
#define ATT_RESC(al) do { if (__any((al) < 1.f)) { if (hi == 0) al_l[r32] = (al); asm volatile("s_waitcnt lgkmcnt(0)" ::: "memory"); \
    _Pragma("unroll") for (int d = 0; d < 4; ++d) _Pragma("unroll") for (int r = 0; r < 16; ++r) o[d][r] *= al_l[crow(r, hi)]; } } while (0)
    bf16x8 qr[4];
    const bf16* Qw = Q1 + ((size_t)qh * MALL + qrow0 + wid * 32 + r32) * 64 + hi * 8;
#pragma unroll
    for (int d0 = 0; d0 < 4; ++d0) qr[d0] = *reinterpret_cast<const bf16x8*>(Qw + d0 * 16);
    const unsigned vsw = (unsigned)((r32 >> 2) & 3);
    const unsigned va0_ = (unsigned)(uintptr_t)V_lds + (unsigned)(r32 * 64) + (((2u * hi) ^ vsw) << 4), va1_ = (unsigned)(uintptr_t)V_lds + (unsigned)(r32 * 64) + (((2u * hi + 1u) ^ vsw) << 4);
    f32x16 pA0, pA1, pB0, pB1; float alA = 1.f, alB = 1.f; v8i_a pa8;
    int kq = 1, ki = 2, vA = 0, vB = 3, vi = 2;
#define ATT_ADV() do { kq = ki; ki = (ki == 2) ? 0 : ki + 1; vB = vA; vA = (vA + 1) & 3; vi = (vi + 1) & 3; } while (0)
    ATT_ISSUE(0, 0, 0); ATT_ISSUE(1, 1, 1);
    ATT_WAITBAR(2);
    {
        qkt(pA0, pA1, K_lds, qr, negm, r32, hi); partialSM<VAR>(pA0, pA1, m_reg, negm, alA);
        ATT_WAITBAR(1);
#define ATT_STEP_A(PC0, PC1, ALC, PN0, PN1, ALN, j_) do { \
        ATT_ISSUE((j_) + 2, ki, vi); \
        ATT_SBAR(); qkt(PN0, PN1, K_lds + kq * SHM_K, qr, negm, r32, hi); \
        finishSM8(PC0, PC1, ALC, l_reg, pa8); ATT_SBAR(); \
        pv8_partial(o, va0_ + vA * SHM_V, va1_ + vA * SHM_V, pa8, PN0, PN1, m_reg, negm, ALN); \
        ATT_RESC(ALN); \
        ATT_WAITBAR(1); ATT_ADV(); } while (0)
        for (int j = 0; j + 2 < NT; j += 2) {
            ATT_STEP_A(pA0, pA1, alA, pB0, pB1, alB, j);
            ATT_STEP_A(pB0, pB1, alB, pA0, pA1, alA, j + 1);
        }
        ATT_SBAR(); qkt(pB0, pB1, K_lds + kq * SHM_K, qr, negm, r32, hi);
        finishSM8(pA0, pA1, alA, l_reg, pa8); ATT_SBAR();
        pv8_partial(o, va0_ + vA * SHM_V, va1_ + vA * SHM_V, pa8, pB0, pB1, m_reg, negm, alB);
        ATT_RESC(alB);
        ATT_WAITBAR(0);
        finishSM8(pB0, pB1, alB, l_reg, pa8); ATT_SBAR();
        { const unsigned s_ = (unsigned)(((vA + 1) & 3) * SHM_V); const int one8 = 0x7f7f7f7f;
          const v8i_a f0 = v8_frag(va0_ + s_, va1_ + s_), f1 = v8_frag(va0_ + s_ + 2048, va1_ + s_ + 2048), f2 = v8_frag(va0_ + s_ + 4096, va1_ + s_ + 4096), f3 = v8_frag(va0_ + s_ + 6144, va1_ + s_ + 6144);
          ATT_SBAR(); ATT_MM8(0, f0); ATT_MM8(1, f1); ATT_MM8(2, f2); ATT_MM8(3, f3); asm volatile("s_nop 15\n\ts_nop 15" ::: "memory"); }
#undef ATT_STEP_A
    }
    l_out = l_reg;
    asm volatile("s_waitcnt lgkmcnt(0)" ::: "memory"); __builtin_amdgcn_s_barrier(); asm volatile("" ::: "memory");
#undef ATT_ADV
#undef ATT_ISSUE
#undef ATT_WAITBAR
#undef ATT_RESC
}

template <int VAR> __device__ __forceinline__ void attn_unit(const bf16* __restrict__ Q1, const bf16* __restrict__ K1, const unsigned char* __restrict__ V1, bf16* __restrict__ ao, int b, int hp, int qb, char* lds, const float* lamp, const float* subln) {
    int tid_ = threadIdx.x; asm volatile("" : "+v"(tid_));
    const int tid = tid_, wid = tid >> 6, lane = tid & 63, r32 = lane & 31, hi = lane >> 5;
    float* wsf = (float*)(lds + OFF_WS) + wid * 64;
    unsigned* o1s = (unsigned*)(lds + OFF_O1 + wid * 8192);
    const size_t qrow0 = (size_t)b * SEQ + (size_t)qb * 256;
    f32x16 o[4]; float l;
    float ssq[16];
#pragma unroll 1
    for (int hh = 0; hh < 2; ++hh) {
        head_pass<VAR>(Q1, K1, V1, b, 2 * hp + hh, hp, qrow0, lds, o, l);
        if (hi == 0) wsf[r32] = l; asm volatile("s_waitcnt lgkmcnt(0)" ::: "memory");
        float rli[16];
#pragma unroll
        for (int r = 0; r < 16; ++r) { rli[r] = __builtin_amdgcn_rcpf(wsf[crow(r, hi)]); ssq[r] = 0.f; }
        if (hh == 0) {
#pragma unroll
            for (int d0 = 0; d0 < 4; ++d0)
#pragma unroll
                for (int r = 0; r < 16; r += 2) o1s[(d0 * 8 + (r >> 1)) * 64 + lane] = cvtpk(o[d0][r] * rli[r], o[d0][r + 1] * rli[r + 1]);
            __syncthreads();
        } else {
            asm volatile("" : "+s"(lamp)); const float lam = *lamp;
#pragma unroll
            for (int d0 = 0; d0 < 4; ++d0)
#pragma unroll
                for (int r = 0; r < 16; r += 2) { const unsigned w = o1s[(d0 * 8 + (r >> 1)) * 64 + lane];
                    const float a0 = bflo(w) - lam * (o[d0][r] * rli[r]), a1 = bfhi(w) - lam * (o[d0][r + 1] * rli[r + 1]);
                    o[d0][r] = a0; o[d0][r + 1] = a1; ssq[r] += a0 * a0; ssq[r + 1] += a1 * a1; }
        }
    }
#pragma unroll
    for (int r = 0; r < 16; ++r) { float s = ssq[r];
        s += __shfl_xor(s, 1); s += __shfl_xor(s, 2); s += __shfl_xor(s, 4); s += __shfl_xor(s, 8); s += __shfl_xor(s, 16);
        ssq[r] = 1.0f / sqrtf(s * (1.0f / 128.0f) + EPS) * (1.0f - LAMBDA_INIT); }
    asm volatile("s_waitcnt lgkmcnt(0)" ::: "memory");
    bf16* stg = (bf16*)o1s;
    asm volatile("" : "+s"(subln));
#pragma unroll
    for (int d0 = 0; d0 < 4; ++d0) { const float g = subln[d0 * 32 + r32];
#pragma unroll
        for (int r = 0; r < 16; ++r) stg[crow(r, hi) * 128 + d0 * 32 + r32] = (bf16)f2bf(o[d0][r] * ssq[r] * g); }
    asm volatile("s_waitcnt lgkmcnt(0)" ::: "memory");
    bf16* Ow = ao + (qrow0 + wid * 32) * D + hp * 128;
#pragma unroll
    for (int i = 0; i < 8; ++i) { const int row = i * 4 + (lane >> 4), ch = lane & 15; const u32x4 v = *(const u32x4*)(stg + row * 128 + ch * 8); *(u32x4*)(Ow + (size_t)row * D + ch * 8) = v; }
    asm volatile("s_waitcnt lgkmcnt(0)" ::: "memory");
    __syncthreads();
}
#undef ATT_SBAR
}

__device__ __forceinline__ void v8_prep(Frame& F) {
    const bf16* V1 = (const bf16*)(F.ws + WS_VH1); unsigned char* V8 = (unsigned char*)(F.ws + WS_V8);
    LAS bf16* buf = (LAS bf16*)(F.lds + F.wave * 16384);
    const int gw = F.vcu * NWAVES + F.wave, NGW = F.G * NWAVES, lane = F.lane;
    for (int it = gw; it < 8 * att::NVTILE; it += NGW) {
        const int hv = it / att::NVTILE, tile = it % att::NVTILE;
        const bf16* src = V1 + ((size_t)hv * MALL + (size_t)tile * 64) * 128;
#pragma unroll
        for (int i = 0; i < 16; ++i) *(LAS v4u*)(buf + i * 512 + lane * 8) = *(const GAS v4u*)(src + i * 512 + lane * 8);
        LDS_WAIT(); asm volatile("" ::: "memory");
        unsigned char* dst = V8 + (size_t)it * att::SHM_V;
#pragma unroll
        for (int cc = 0; cc < 2; ++cc) { const int n = lane + 64 * cc; const int sw = (n >> 2) & 3;
#pragma unroll
            for (int c = 0; c < 4; ++c) { const int kb = c >> 1, half = c & 1; v4u w;
#pragma unroll
                for (int q = 0; q < 4; ++q) { const int key0 = 32 * half + 8 * q + 4 * kb;
                    w[q] = pk4_fp8(bf2f(buf[(key0 + 0) * 128 + n]), bf2f(buf[(key0 + 1) * 128 + n]), bf2f(buf[(key0 + 2) * 128 + n]), bf2f(buf[(key0 + 3) * 128 + n])); }
                *(GAS v4u*)(dst + n * 64 + ((c ^ sw) << 4)) = w; } }
        LDS_WAIT(); asm volatile("" ::: "memory");
    }
}

template <int VAR> __device__ __forceinline__ void attn_phase(Frame& F, const Args& a, bf16* ao) {
    const bf16* Q1 = (const bf16*)(F.ws + WS_QH1); const bf16* K1 = (const bf16*)(F.ws + WS_KH1); const unsigned char* V1 = (const unsigned char*)(F.ws + WS_V8);
    const float* lamp = (const float*)(F.ws + WS_LAM);
    for (int unit = F.vcu; unit < NBATCH * 8 * 16; unit += F.G) {
        const int qb = unit & 15, hp = (unit >> 4) & 7, b = unit >> 7;
        att::attn_unit<VAR>(Q1, K1, V1, ao, b, hp, qb, (char*)F.lds, lamp, a.in[I_L1_SUBLN]);
    }
}


namespace ret {
using s16x4  = __attribute__((ext_vector_type(4))) short;
using f32x16 = __attribute__((ext_vector_type(16))) float;
typedef short v4i16_t __attribute__((ext_vector_type(4)));
constexpr int C = 32, NSTEP = (SEQ + CTXL) / C;
constexpr int ST_Q = 0, ST_K = 16384, ST_V = 32768, ST_SC = 40960, ST_BYTES = 43008, NSTAGE = 3;
constexpr int XBUF_OFF = NSTAGE * ST_BYTES, RET_LDS = XBUF_OFF + NWAVES * 4096;
constexpr size_t WS_SSQ = 836 * MiB;
constexpr size_t WS_SC = 842 * MiB;

__device__ __forceinline__ void glds16(const void* gsrc, unsigned lds_dst) { unsigned keep;
    asm volatile("s_mov_b32 %0, m0\n\ts_mov_b32 m0, %2\n\ts_nop 0\n\tglobal_load_lds_dwordx4 %1, off\n\ts_mov_b32 m0, %0" : "=&s"(keep) : "v"(gsrc), "s"(lds_dst) : "memory"); }
__device__ __forceinline__ s16x4 vtr(const LAS char* p) { return __builtin_bit_cast(s16x4, __builtin_amdgcn_ds_read_tr16_b64_v4i16((LAS v4i16_t*)p)); }

__device__ __forceinline__ void ret_scores(Frame& F) {
    const bf16* Qh = (const bf16*)(F.ws + WS_QH0); const bf16* Kh = (const bf16*)(F.ws + WS_KH0); bf16* sc = (bf16*)(F.ws + WS_SC);
    const int gw = F.vcu * NWAVES + F.wave, NGW = F.G * NWAVES;
    const int r32 = F.lane & 31, hh = F.lane >> 5;
    for (int task = gw; task < (MALL / C) * RH; task += NGW) {
        const int h = task & 3, ch = task >> 2;
        const bf16* qp = Qh + ((size_t)h * MALL + (size_t)ch * C + r32) * 256 + hh * 8;
        const bf16* kp = Kh + ((size_t)h * MALL + (size_t)ch * C + r32) * 256 + hh * 8;
        f32x16 acc = f32x16{};
        bf16x8 a[16], b[16];
#pragma unroll
        for (int s = 0; s < 16; ++s) { a[s] = *reinterpret_cast<const bf16x8*>(qp + s * 16); b[s] = *reinterpret_cast<const bf16x8*>(kp + s * 16); }
#pragma unroll
        for (int s = 0; s < 16; ++s) acc = __builtin_amdgcn_mfma_f32_32x32x16_bf16(a[s], b[s], acc, 0, 0, 0);
        bf16* tp = sc + (size_t)task * 1024;
#pragma unroll
        for (int r = 0; r < 16; ++r) { const int i = (r & 3) + 8 * (r >> 2) + 4 * hh; tp[i * 32 + r32] = (bf16)f2bf(acc[r]); }
    }
}

__device__ __forceinline__ size_t step_row0(int b, int dir, int t) {
    if (t < 8) { const int blk = dir ? 7 - t : t; return (size_t)NLAT + (size_t)b * CTXL + (size_t)blk * C; }
    const int blk = dir ? 127 - (t - 8) : (t - 8); return (size_t)b * SEQ + (size_t)blk * C;
}

template <int SV = 0> __device__ __forceinline__ void ret_scan(Frame& F, const Args& a) {
    const char* qb = (const char*)(F.ws + WS_QH0); const char* kb = (const char*)(F.ws + WS_KH0); const char* vb = (const char*)(F.ws + WS_VQ0); const char* scb = (const char*)(F.ws + WS_SC);
    for (int unit = F.vcu; unit < NBATCH * RH * 2 * 4; unit += F.G) {
        int tid_ = threadIdx.x; asm volatile("" : "+v"(tid_));
        const int tid = tid_, lane = tid & 63, w = __builtin_amdgcn_readfirstlane(tid >> 6), dh = w >> 2, vs = w & 3, r32 = lane & 31, hh = lane >> 5;
        const int vq = unit & 3, dir = (unit >> 2) & 1, h = (unit >> 3) & 3, b = unit >> 5;
        const float logit = a.in[I_L0_DECAY][dir * RH + h];
        const float lg2 = -__builtin_amdgcn_logf(1.0f + __builtin_amdgcn_exp2f(-logit * LOG2E));
        const float gC = __builtin_amdgcn_exp2f(lg2 * (float)C), gCi = __builtin_amdgcn_exp2f(-lg2 * (float)C);
        float kd[2][8];
#pragma unroll
        for (int s = 0; s < 2; ++s)
#pragma unroll
            for (int jj = 0; jj < 8; ++jj) { const int j = 16 * s + 8 * hh + jj; kd[s][jj] = __builtin_amdgcn_exp2f(lg2 * (float)(dir ? j : 31 - j)); }
        const int om = 4 * w + (lane >> 4);
        const float rsc = __builtin_amdgcn_exp2f(-lg2 * (float)(dir ? om : 31 - om));
        unsigned pm[4];
#pragma unroll
        for (int e = 0; e < 4; ++e) { const int j0 = 16 * dh + 8 * hh + 2 * e, j1 = j0 + 1; const bool k0 = dir ? (j0 >= r32) : (j0 <= r32), k1 = dir ? (j1 >= r32) : (j1 <= r32);
            pm[e] = (k0 ? 0x0000ffffu : 0u) | (k1 ? 0xffff0000u : 0u); }
        unsigned offq[2], offk[2];
#pragma unroll
        for (int p = 0; p < 2; ++p) { const int i = 2 * (2 * w + p) + (lane >> 5), cp = lane & 31;
            offq[p] = (unsigned)(i * 512 + ((cp ^ (i & 15)) << 4)); offk[p] = (unsigned)(i * 512 + ((cp ^ ((i & 3) << 2)) << 4)); }
        unsigned offv; { const int j = 4 * w + (lane >> 4), cp = lane & 15; offv = (unsigned)(j * 256 + ((cp ^ ((j & 3) << 2)) << 4)); }
        const char* qhb = qb + (size_t)h * MALL * 512; const char* khb = kb + (size_t)h * MALL * 512; const char* vhb = vb + (size_t)(h * 4 + vq) * MALL * 256;
        unsigned offs; { const int i = 16 * (w & 1) + (lane >> 2), cp = lane & 3; offs = (unsigned)(i * 64 + ((cp ^ ((i >> 2) & 3)) << 4)); }
        LAS unsigned char* L = F.lds;
        const unsigned lbase = (unsigned)(uintptr_t)L;
#define RET_ISSUE(t_) do { const int t__ = (t_); const unsigned sb_ = lbase + (unsigned)((t__ % NSTAGE) * ST_BYTES); const size_t r0_ = step_row0(b, dir, t__); const char* gq_ = qhb + r0_ * 512; const char* gk_ = khb + r0_ * 512; const char* gv_ = vhb + r0_ * 256; \
        glds16(gq_ + offq[0], (unsigned)__builtin_amdgcn_readfirstlane(sb_ + ST_Q + (2 * w) * 1024)); \
        glds16(gq_ + offq[1], (unsigned)__builtin_amdgcn_readfirstlane(sb_ + ST_Q + (2 * w + 1) * 1024)); \
        glds16(gk_ + offk[0], (unsigned)__builtin_amdgcn_readfirstlane(sb_ + ST_K + (2 * w) * 1024)); \
        glds16(gk_ + offk[1], (unsigned)__builtin_amdgcn_readfirstlane(sb_ + ST_K + (2 * w + 1) * 1024)); \
        glds16(gv_ + offv, (unsigned)__builtin_amdgcn_readfirstlane(sb_ + ST_V + w * 1024)); \
        if (w < 2) glds16(scb + ((r0_ >> 5) * 4 + h) * 2048 + offs, (unsigned)__builtin_amdgcn_readfirstlane(sb_ + ST_SC + w * 1024)); } while (0)
        const int qrow = ST_Q + r32 * 512; const int qx = r32 & 15;
        const int G = lane >> 4, il = lane & 15, tq = il >> 2, tp = il & 3;
        const int kcolb = (128 * dh + 16 * (G & 1) + 8 * (tp & 1) + 4 * (tp >> 1)) * 2;
        const int vcolb = (32 * vs + 16 * (G & 1) + 4 * tp) * 2;
        f32x16 S[4];
#pragma unroll
        for (int T = 0; T < 4; ++T) S[T] = f32x16{};
        float cinv = 1.0f, cfw = 1.0f;
        bf16* outp = (bf16*)(F.ws + (dir ? WS_OB : WS_OF));
        float* ssqp = (float*)(F.ws + WS_SSQ);

        __builtin_amdgcn_s_barrier();
        if (SV != 2 && SV != 3) { RET_ISSUE(0); RET_ISSUE(1); }
        for (int t = 0; t < NSTEP; ++t) {
            if (t == 0) { if (w < 2) asm volatile("s_waitcnt vmcnt(6)" ::: "memory"); else asm volatile("s_waitcnt vmcnt(5)" ::: "memory"); }
            else if (t == NSTEP - 1) asm volatile("s_waitcnt vmcnt(4)" ::: "memory");
            else        { if (w < 2) asm volatile("s_waitcnt vmcnt(8)" ::: "memory"); else asm volatile("s_waitcnt vmcnt(7)" ::: "memory"); }
            __builtin_amdgcn_s_barrier(); asm volatile("" ::: "memory");
            if (SV != 2 && SV != 3) { if (t + 2 < NSTEP) RET_ISSUE(t + 2); }
            const LAS char* sb = (const LAS char*)(L + (t % NSTAGE) * ST_BYTES);
            f32x16 acc = f32x16{};
            if (SV != 1 && SV != 3) {
            cinv *= gCi; cfw *= gC;
            bf16x8 vd[2];
#pragma unroll
            for (int s = 0; s < 2; ++s) {
                const int j0 = 16 * s + 8 * (G >> 1) + tq;
                const int cph = (((vcolb >> 4) ^ (tq << 2)) << 4) + (vcolb & 8);
                const s16x4 lo = vtr(sb + ST_V + j0 * 256 + cph), hi = vtr(sb + ST_V + (j0 + 4) * 256 + cph);
                float f[8];
#pragma unroll
                for (int e = 0; e < 4; ++e) { f[e] = bf2f((unsigned short)lo[e]) * (kd[s][e] * cinv); f[4 + e] = bf2f((unsigned short)hi[e]) * (kd[s][4 + e] * cinv); }
                v4u pk; pk.x = pk2(f[0], f[1]); pk.y = pk2(f[2], f[3]); pk.z = pk2(f[4], f[5]); pk.w = pk2(f[6], f[7]);
                vd[s] = __builtin_bit_cast(bf16x8, pk);
            }
#pragma unroll
            for (int T = 0; T < 4; ++T)
#pragma unroll
                for (int s = 0; s < 2; ++s) {
                    const int cL = 16 * dh + 4 * T + 2 * s + hh;
                    const bf16x8 qa = *(const LAS bf16x8*)(sb + qrow + ((cL ^ qx) << 4));
                    v4u pk; pk.x = pk2(S[T][8 * s + 0], S[T][8 * s + 1]); pk.y = pk2(S[T][8 * s + 2], S[T][8 * s + 3]); pk.z = pk2(S[T][8 * s + 4], S[T][8 * s + 5]); pk.w = pk2(S[T][8 * s + 6], S[T][8 * s + 7]);
                    acc = __builtin_amdgcn_mfma_f32_32x32x16_bf16(qa, __builtin_bit_cast(bf16x8, pk), acc, 0, 0, 0);
                }
            {
                const int cL = 2 * dh + hh;
                v4u pw = *(const LAS v4u*)(sb + ST_SC + r32 * 64 + ((cL ^ ((r32 >> 2) & 3)) << 4));
                pw.x &= pm[0]; pw.y &= pm[1]; pw.z &= pm[2]; pw.w &= pm[3];
                acc = __builtin_amdgcn_mfma_f32_32x32x16_bf16(__builtin_bit_cast(bf16x8, pw), dh ? vd[1] : vd[0], acc, 0, 0, 0);
            }
#pragma unroll
            for (int T = 0; T < 4; ++T)
#pragma unroll
                for (int s = 0; s < 2; ++s) {
                    const int j0 = 16 * s + 8 * (G >> 1) + tq;
                    const int cb = kcolb + 64 * T;
                    const int cph = (((cb >> 4) ^ (tq << 2)) << 4) + (cb & 8);
                    const s16x4 lo = vtr(sb + ST_K + j0 * 512 + cph), hi = vtr(sb + ST_K + (j0 + 4) * 512 + cph);
                    const bf16x8 ka = (bf16x8){lo[0], lo[1], lo[2], lo[3], hi[0], hi[1], hi[2], hi[3]};
                    S[T] = __builtin_amdgcn_mfma_f32_32x32x16_bf16(ka, vd[s], S[T], 0, 0, 0);
                }
            }
            if ((t & 7) == 7) {
#pragma unroll
                for (int T = 0; T < 4; ++T) S[T] = S[T] * cfw;
            }
            { LAS float* xw = (LAS float*)(L + XBUF_OFF + dh * 16384) + (4 * hh) * 128 + vs * 32 + r32;
#pragma unroll
              for (int r = 0; r < 16; ++r) xw[((r & 3) + 8 * (r >> 2)) * 128] = acc[r]; }
            asm volatile("s_waitcnt lgkmcnt(0)" ::: "memory");
            __builtin_amdgcn_s_barrier(); asm volatile("" ::: "memory");
            {
                const int v0 = (lane & 15) * 8;
                const LAS float* p0 = (const LAS float*)(L + XBUF_OFF) + om * 128 + v0;
                const LAS float* p1 = (const LAS float*)(L + XBUF_OFF + 16384) + om * 128 + v0;
                const f32x4 a0 = *(const LAS f32x4*)p0, a1 = *(const LAS f32x4*)(p0 + 4), b0 = *(const LAS f32x4*)p1, b1 = *(const LAS f32x4*)(p1 + 4);
                const float rs_ = rsc * cfw; const f32x4 o0 = (a0 + b0) * rs_, o1 = (a1 + b1) * rs_;
                float ss = (o0.x * o0.x + o0.y * o0.y) + (o0.z * o0.z + o0.w * o0.w) + (o1.x * o1.x + o1.y * o1.y) + (o1.z * o1.z + o1.w * o1.w);
                ss += __builtin_bit_cast(float, __builtin_amdgcn_update_dpp(0, __builtin_bit_cast(int, ss), 0xB1, 0xF, 0xF, true));
                ss += __builtin_bit_cast(float, __builtin_amdgcn_update_dpp(0, __builtin_bit_cast(int, ss), 0x4E, 0xF, 0xF, true));
                ss += __builtin_bit_cast(float, __builtin_amdgcn_update_dpp(0, __builtin_bit_cast(int, ss), 0x124, 0xF, 0xF, true));
                ss += __builtin_bit_cast(float, __builtin_amdgcn_update_dpp(0, __builtin_bit_cast(int, ss), 0x128, 0xF, 0xF, true));
                const size_t r0 = step_row0(b, dir, t);
                v4u pk; pk.x = pk2(o0.x, o0.y); pk.y = pk2(o0.z, o0.w); pk.z = pk2(o1.x, o1.y); pk.w = pk2(o1.z, o1.w);
                *(GAS v4u*)(outp + (r0 + om) * 2048 + h * 512 + vq * 128 + v0) = pk;
                if ((lane & 15) == 0) ssqp[(((r0 + om) * RH + h) * 2 + dir) * 4 + vq] = ss;
            }
            asm volatile("s_waitcnt lgkmcnt(0)" ::: "memory");
            if ((t & 7) == 7) { cinv = 1.0f; cfw = 1.0f; }
        }
        asm volatile("s_waitcnt vmcnt(0)" ::: "memory");
#undef RET_ISSUE
    }
    __builtin_amdgcn_s_barrier();
}
}

__device__ __forceinline__ void moe_counts(Frame& F, int (&cnt)[NE]) {
#pragma unroll
    for (int e = 0; e < NE; ++e) cnt[e] = __builtin_amdgcn_readfirstlane((int)__hip_atomic_load((unsigned*)(F.ctl + CW_MOECNT + 64 * e), RLX_AGENT));
}
__device__ __forceinline__ void moe_gather(Frame& F) {
    int cnt[NE]; moe_counts(F, cnt);
    int base[NE]; int acc = 0;
#pragma unroll
    for (int e = 0; e < NE; ++e) { base[e] = acc; acc += (cnt[e] + 255) & ~255; }
    const int* te = (const int*)(F.ws + WS_ROUTE); int* tpos = (int*)(F.ws + WS_ROUTE + (size_t)NLAT * 8);
    const bf16* hb = (const bf16*)(F.ws + WS_H); bf16* hp = (bf16*)(F.ws + WS_HP);
    const int gw = F.vcu * NWAVES + F.wave, NGW = F.G * NWAVES;
    for (int r = gw; r < NLAT; r += NGW) {
        const int e0 = te[2 * r], e1 = te[2 * r + 1]; const int p0 = tpos[2 * r], p1 = tpos[2 * r + 1];
        int b0 = 0, b1 = 0;
#pragma unroll
        for (int e = 0; e < NE; ++e) { b0 = (e0 == e) ? base[e] : b0; b1 = (e1 == e) ? base[e] : b1; }
        const int s0 = b0 + p0, s1 = b1 + p1;
        const v4u x0 = *(const GAS v4u*)((const unsigned char*)hb + (size_t)r * D + F.lane * 16);
        *(GAS v4u*)((unsigned char*)hp + (size_t)s0 * D + F.lane * 16) = x0; *(GAS v4u*)((unsigned char*)hp + (size_t)s1 * D + F.lane * 16) = x0;
        if (F.lane == 0) { tpos[2 * r] = s0; tpos[2 * r + 1] = s1; }
    }
}
__device__ __forceinline__ void moe_order(Frame& F, pg8::MoeOrder& S, int nN) {
    int cnt[NE]; moe_counts(F, cnt);
    int ts[NE + 1]; ts[0] = 0;
#pragma unroll
    for (int e = 0; e < NE; ++e) ts[e + 1] = ts[e] + ((cnt[e] + 255) >> 8);
    S.nM = ts[NE]; S.nN = nN; S.nwg = S.nM * nN; S.G = F.G; S.c = F.cid;
    S.t1 = ts[1]; S.t2 = ts[2]; S.t3 = ts[3]; S.t4 = ts[4]; S.t5 = ts[5]; S.t6 = ts[6]; S.t7 = ts[7];
}

constexpr int N_PHASES = 22;
__global__ void __launch_bounds__(NTHREADS, 2) fwd(Args args) {
    extern __shared__ __attribute__((aligned(16))) unsigned char lds[];
    Frame F;
    F.lds = (LAS unsigned char*)lds; F.MISC = (volatile LAS unsigned*)(F.lds + MISC_OFF);
    F.tid = threadIdx.x; F.lane = F.tid & 63; F.wave = __builtin_amdgcn_readfirstlane(F.tid >> 6);
    F.G = gridDim.x; { const int bx = blockIdx.x; F.vcu = (F.G % 8 == 0) ? (bx % 8) * (F.G / 8) + bx / 8 : bx; F.cid = bx; }
    F.ws = args.ws; F.ctl = (gu32*)(args.ws + WS_CTL);
    for (int u = F.tid; u < 64; u += NTHREADS) ((LAS unsigned*)(F.lds + MISC_OFF))[u] = 0u;
    __syncthreads();
#if MK_PER_PHASE
    XcdBarrier bar; bar.bar = (unsigned*)(F.ctl + CW_BAR); bar.x = 0; bar.st = nullptr;
#define GRID_BAR() do { } while (0)
#else
    XcdBarrier bar = xcd_barrier_post((unsigned*)(F.ctl + CW_BAR), F.MISC + 8);
#define GRID_BAR() xcd_barrier(bar)
    if (F.tid == 0) { const unsigned x = xb_xcc_id(); F.MISC[16] = x; F.MISC[17] = __hip_atomic_fetch_add((unsigned*)(F.ctl + CW_XRANK + 64 * x), 1u, RLX_AGENT); }
#endif
    const int lo = args.ph_lo, hi = args.ph_hi;
#define IN(k) (lo <= (k) && (k) < hi)
#define SEAM(k) do { if (IN(k) && IN((k) + 1)) GRID_BAR(); } while (0)
    unsigned char* ws = args.ws;
    float* modv = (float*)(ws + WS_MODV);
    float* modv1 = modv + 9 * 6 * D;
    bf16* hbuf = (bf16*)(ws + WS_H);
    float* xctx = (float*)(ws + WS_XCTX);
    using pg8::Gemm; using pg8::StaticOrder;

    if (IN(0)) { for (int rep_ = 0; rep_ < ((PROBE_DUP & 1) ? 2 : 1); ++rep_) { p0_prologue(F, args); __syncthreads(); } SEAM(0); }
#if !MK_PER_PHASE
    if (IN(0) && IN(1)) {
        if (F.tid == 0) { const unsigned x = F.MISC[16]; unsigned pre = 0;
            for (unsigned j = 0; j < 16; ++j) { const unsigned c = __hip_atomic_load((unsigned*)(F.ctl + CW_XRANK + 64 * j), RLX_AGENT); pre += (j < x) ? c : 0u; }
            F.MISC[18] = pre + F.MISC[17]; }
        __syncthreads();
        F.vcu = __builtin_amdgcn_readfirstlane((int)F.MISC[18]); F.cid = (F.G % 8 == 0) ? (F.vcu % (F.G / 8)) * 8 + F.vcu / (F.G / 8) : F.vcu;
    }
#endif
    float* rsc = (float*)(ws + WS_RSC);
    if (IN(1)) { RowPass P{MALL, args.in[I_X], args.in[I_CTX], nullptr, nullptr, nullptr, nullptr, nullptr, args.in[I_L0_NPREMIX], modv + 0 * D, modv + 1 * D, hbuf, nullptr, rsc};
        row_pass<false, false, true, false, 2>(F, args, P); SEAM(1); }
    if (IN(2)) { Gemm g{hbuf, (const bf16*)(ws + WS_W0IN), MALL, 4096, D / 2, D / 2, 0, 0, rsc, (const float*)(ws + WS_WSC0)}; StaticOrder S; S.init(MALL, 4096, F.G, F.cid);
        pg8::EpiQKV0 E{(bf16*)(ws + WS_QH0), (bf16*)(ws + WS_KH0), (bf16*)(ws + WS_VQ0), (const float*)(ws + WS_TAB0)};
        for (int rep_ = 0; rep_ < ((PROBE_DUP & 2) ? 2 : 1); ++rep_) { pg8::gemm_phase<pg8::EpiQKV0, StaticOrder, true, true, 2>(F.lds, g, S, E); } if (IN(2) && IN(4)) GRID_BAR(); }
    if (IN(4)) { ret::ret_scores(F); SEAM(4); }
    if (IN(5)) { for (int rep_ = 0; rep_ < ((PROBE_DUP & 8) ? 2 : 1); ++rep_) ret::ret_scan<0>(F, args); SEAM(5); }
    if (IN(6)) { Gemm g{hbuf, (const bf16*)(ws + WS_W0IN + (size_t)4096 * D), MALL, 4096, D / 2, D / 2, 0, 0, rsc, (const float*)(ws + WS_WSC0) + 4096}; StaticOrder S; S.init(MALL, 4096, F.G, F.cid);
        pg8::EpiGateMerge E{(bf16*)(ws + WS_OF), (const bf16*)(ws + WS_OB), (const float*)(ws + ret::WS_SSQ)};
        pg8::gemm_phase<pg8::EpiGateMerge, StaticOrder, true, true, 2>(F.lds, g, S, E); if (IN(6) && IN(8)) GRID_BAR(); }
    if (IN(8)) { Gemm g{(const bf16*)(ws + WS_OF), (const bf16*)(ws + WS_W0OUT), MALL, D, 2048, 2048}; pg8::SplitOrder S; S.init(D, F.G, F.cid, USE_SPLITK ? 8 : 0, 4);
        pg8::EpiStoreSplit E{(bf16*)(ws + WS_A), D, (float*)(ws + WS_PART)};
        for (int rep_ = 0; rep_ < ((PROBE_DUP & 32) ? 2 : 1); ++rep_) { pg8::gemm_phase<pg8::EpiStoreSplit, pg8::SplitOrder, true, true>(F.lds, g, S, E); } SEAM(8); }
    if (IN(9)) { RowPass P{MALL, args.in[I_X], args.in[I_CTX], (float*)(ws + WS_X1), (float*)(ws + WS_X1C), (const bf16*)(ws + WS_A), args.in[I_L0_NPOSTMIX], modv + 2 * D, args.in[I_L0_NPREFFN], modv + 3 * D, modv + 4 * D, hbuf, (const float*)(ws + WS_PART), rsc};
        row_pass<true, false, true, false, 2, USE_SPLITK ? 8 : 0, false, true>(F, args, P); SEAM(9); }
    if (IN(10)) { Gemm g{hbuf, (const bf16*)(ws + WS_W0GU), MALL, 2 * DFF, D / 2, D / 2, 0, 0, rsc, (const float*)(ws + WS_WSC2)}; StaticOrder S; S.init(MALL, 2 * DFF, F.G, F.cid);
        pg8::EpiSwiglu E{(bf16*)(ws + WS_B), DFF};
        for (int rep_ = 0; rep_ < ((PROBE_DUP & 2) ? 2 : 1); ++rep_) { pg8::gemm_phase<pg8::EpiSwiglu, StaticOrder, true, true, 2>(F.lds, g, S, E); } SEAM(10); }
    if (IN(11)) { Gemm g{(const bf16*)(ws + WS_B), (const bf16*)(ws + WS_W0DN), MALL, D, DFF, DFF}; pg8::SplitOrder S; S.init(D, F.G, F.cid, USE_SPLITK ? 11 : 0, 4);
        pg8::EpiStoreSplit E{(bf16*)(ws + WS_A), D, (float*)(ws + WS_PART)};
        for (int rep_ = 0; rep_ < ((PROBE_DUP & 32) ? 2 : 1); ++rep_) { pg8::gemm_phase<pg8::EpiStoreSplit, pg8::SplitOrder, true, true>(F.lds, g, S, E); } SEAM(11); }
    if (IN(12)) { RowPass P{MALL, (const float*)(ws + WS_X1), (const float*)(ws + WS_X1C), (float*)(ws + WS_X2), nullptr, (const bf16*)(ws + WS_A), args.in[I_L0_NPOSTFFN], modv + 5 * D, args.in[I_L1_NPREMIX], modv1 + 0 * D, modv1 + 1 * D, hbuf, (const float*)(ws + WS_PART)};
        row_pass<true, false, true, false, 1, USE_SPLITK ? 11 : 0, true, true>(F, args, P); SEAM(12); }
    if (IN(13)) { Gemm g{hbuf, (const bf16*)(ws + WS_W1IN), MALL, 3072, D / 2, D / 2, MOE_SA, MOE_SB}; StaticOrder S; S.init(MALL, 3072, F.G, F.cid);
        pg8::EpiQKV1 E{(bf16*)(ws + WS_QH1), (bf16*)(ws + WS_KH1), (bf16*)(ws + WS_VH1), (const float*)(ws + WS_TAB1)};
        for (int rep_ = 0; rep_ < ((PROBE_DUP & 2) ? 2 : 1); ++rep_) { pg8::gemm_phase<pg8::EpiQKV1, StaticOrder, true, true, true>(F.lds, g, S, E); } SEAM(13); }
    if (IN(14)) { v8_prep(F); SEAM(14); }
    if (IN(15)) { attn_phase<0>(F, args, (bf16*)(ws + WS_B)); SEAM(15); }
    if (IN(16)) { Gemm g{(const bf16*)(ws + WS_B), (const bf16*)(ws + WS_W1OUT), NLAT, D, D, D}; StaticOrder S; S.init(NLAT, D, F.G, F.cid);
        pg8::EpiStore E{(bf16*)(ws + WS_A), D};
        for (int rep_ = 0; rep_ < ((PROBE_DUP & 2) ? 2 : 1); ++rep_) { pg8::gemm_phase<pg8::EpiStore, StaticOrder, true, true>(F.lds, g, S, E); } SEAM(16); }
    if (IN(17)) { RowPass P{NLAT, (const float*)(ws + WS_X2), nullptr, (float*)(ws + WS_X3), nullptr, (const bf16*)(ws + WS_A), args.in[I_L1_NPOSTMIX], modv1 + 2 * D, args.in[I_L1_NPREFFN], modv1 + 3 * D, modv1 + 4 * D, hbuf};
        row_pass<true, false, true, true, 1, 0, true, true>(F, args, P); SEAM(17); }
    if (IN(18)) { moe_gather(F); SEAM(18); }
    if (IN(19)) { Gemm g{(const bf16*)(ws + WS_HP), (const bf16*)(ws + WS_WMGU), MOE_ROWS, 2 * DFE, D / 2, D / 2, MOE_SA, MOE_SB}; pg8::MoeOrder S; moe_order(F, S, 2 * DFE / 256);
        pg8::EpiSwiglu8 E{(unsigned char*)(ws + WS_ACT1), DFE};
        for (int rep_ = 0; rep_ < ((PROBE_DUP & 16) ? 2 : 1); ++rep_) { pg8::gemm_phase<pg8::EpiSwiglu8, pg8::MoeOrder, true, true, true>(F.lds, g, S, E); } SEAM(19); }
    if (IN(20)) { Gemm g{(const bf16*)(ws + WS_ACT1), (const bf16*)(ws + WS_WMDN), MOE_ROWS, D, DFE / 2, DFE / 2, MOE_SA, MOE_SB}; pg8::MoeOrder S; moe_order(F, S, D / 256);
        pg8::EpiStore E{(bf16*)(ws + WS_Y1), D};
        for (int rep_ = 0; rep_ < ((PROBE_DUP & 16) ? 2 : 1); ++rep_) { pg8::gemm_phase<pg8::EpiStore, pg8::MoeOrder, true, true, true>(F.lds, g, S, E); } SEAM(20); }
    if (IN(21)) { RowPass P{NLAT, (const float*)(ws + WS_X3), nullptr, args.out, nullptr, (const bf16*)(ws + WS_Y1), args.in[I_L1_NPOSTFFN], modv1 + 5 * D, nullptr, nullptr, nullptr, nullptr};
        row_pass<false, true, false, false, 0, 0, true, false>(F, args, P); }
#undef IN
#undef SEAM
}

#ifndef PROBE_ATT
#define PROBE_ATT -1
#endif
#if PROBE_ATT >= 0
__global__ void __launch_bounds__(NTHREADS, 2) probe_k(Args args) {
    extern __shared__ __attribute__((aligned(16))) unsigned char lds[];
    Frame F;
    F.lds = (LAS unsigned char*)lds; F.MISC = (volatile LAS unsigned*)(F.lds + MISC_OFF);
    F.tid = threadIdx.x; F.lane = F.tid & 63; F.wave = __builtin_amdgcn_readfirstlane(F.tid >> 6);
    F.G = gridDim.x; { const int bx = blockIdx.x; F.vcu = (F.G % 8 == 0) ? (bx % 8) * (F.G / 8) + bx / 8 : bx; F.cid = bx; }
    F.ws = args.ws; F.ctl = (gu32*)(args.ws + WS_CTL);
#if PROBE_ATT < 10
    attn_phase<PROBE_ATT>(F, args, (bf16*)(args.ws + WS_END - 64 * MiB));
#else
    ret::ret_scan<PROBE_ATT - 10>(F, args);
#endif
}
#endif
extern "C" void kernel_launch(void* const* d_in, const int* in_sizes, int n_in, void* d_out, int out_size, void* d_ws, size_t ws_size, hipStream_t stream) {
    static int grid = 0;
    if (grid == 0) {
        if (n_in != N_IN || out_size != NLAT * D || ws_size < WS_END) { fprintf(stderr, "kernel_launch: unexpected shapes n_in %d out %d ws %zu\n", n_in, out_size, ws_size); grid = -1; return; }
        int dev = 0, cus = 0, per_cu = 0;
        if (hipGetDevice(&dev) != hipSuccess || hipDeviceGetAttribute(&cus, hipDeviceAttributeMultiprocessorCount, dev) != hipSuccess) { grid = -1; return; }
        if (hipFuncSetAttribute((const void*)fwd, hipFuncAttributeMaxDynamicSharedMemorySize, LDS_BYTES) != hipSuccess) { fprintf(stderr, "kernel_launch: hipFuncSetAttribute failed\n"); grid = -1; return; }
        if (hipOccupancyMaxActiveBlocksPerMultiprocessor(&per_cu, (const void*)fwd, NTHREADS, LDS_BYTES) != hipSuccess || per_cu < 1) fprintf(stderr, "kernel_launch: occupancy query says %d\n", per_cu);
        (void)hipGetLastError();
        grid = cus;
    }
    if (grid < 0) return;
    (void)hipMemsetAsync((char*)d_ws + WS_CTL, 0, CTL_ZERO_BYTES, stream);
    Args a{};
    for (int i = 0; i < N_IN; ++i) a.in[i] = (const float*)d_in[i];
    a.out = (float*)d_out; a.ws = (unsigned char*)d_ws;
#if MK_PER_PHASE
    for (int p = 0; p < N_PHASES; ++p) { a.ph_lo = p; a.ph_hi = p + 1; hipLaunchKernelGGL(fwd, dim3(grid), dim3(NTHREADS), LDS_BYTES, stream, a); }
#else
    a.ph_lo = 0; a.ph_hi = N_PHASES; hipLaunchKernelGGL(fwd, dim3(grid), dim3(NTHREADS), LDS_BYTES, stream, a);
#endif
#if PROBE_ATT >= 0
    (void)hipFuncSetAttribute((const void*)probe_k, hipFuncAttributeMaxDynamicSharedMemorySize, LDS_BYTES);
    hipLaunchKernelGGL(probe_k, dim3(grid), dim3(NTHREADS), LDS_BYTES, stream, a);
#endif
}
```

```cpp
#include <hip/hip_runtime.h>
#include <cstdio>
#include <cstdint>
namespace pg8 {
#define PG8_LAS __attribute__((address_space(3)))
typedef unsigned short bf16_t;
typedef short bf16x8 __attribute__((ext_vector_type(8)));
typedef float f32x4 __attribute__((ext_vector_type(4)));
typedef unsigned u32x4 __attribute__((ext_vector_type(4)));
constexpr int BM = 256, BK = 64, HALF = 128, HTB = HALF * BK * 2  , STAGE_BYTES = 8 * HTB, NXCD = 8, WGM = 8;

__host__ __device__ __forceinline__ int lds_byte(int r, int c) { const int st = (r >> 4) * 2 + (c >> 5), rr = r & 15, cc = c & 31, ob = rr * 64 + cc * 2; return st * 1024 + (ob ^ (((ob >> 9) & 1) << 5)); }
__host__ __device__ __forceinline__ void stage_rc(int b, int& R, int& C) { const int st = b / 1024, sb = b % 1024, swz = sb ^ (((sb >> 9) & 1) << 5); R = (st >> 1) * 16 + swz / 64; C = (st & 1) * 32 + (swz % 64) / 2; }
__host__ __device__ __forceinline__ int perm32(int rho) { const int n = rho >> 4, i = rho & 15; return 8 * (i >> 2) + 4 * n + (i & 3); }

struct Unit { int pm, pn, pc, k0, nt, ks; };
struct Gemm { const bf16_t* A; const bf16_t* Bt; int M, N, K, lda; int sA, sB; const float* rsA; const float* rsB; };

struct StaticOrder {
    int nM, nN, nwg, G, c;
    __host__ __device__ __forceinline__ void init(int M, int N, int G_, int c_) { nM = M / BM; nN = N / BM; nwg = nM * nN; G = G_; c = c_; }
    __host__ __device__ __forceinline__ bool next(int i, Unit& u) const {
        const long L = (long)i * G + c; if (L >= nwg) return false;
        int wgid = (int)L; { const int q = nwg / NXCD, r = nwg % NXCD, xcd = wgid % NXCD, off = wgid / NXCD; wgid = (xcd < r ? xcd * (q + 1) : r * (q + 1) + (xcd - r) * q) + off; }
        const int nig = WGM * nN, gid = wgid / nig, fm = gid * WGM, gsz = (nM - fm) < WGM ? (nM - fm) : WGM;
        u.pm = fm + ((wgid % nig) % gsz); u.pn = (wgid % nig) / gsz; u.pc = u.pn; u.k0 = 0; u.nt = 0; u.ks = -1; return true;
    }
    __device__ __forceinline__ void a_ready(const Unit&) const {}
    __device__ __forceinline__ void done(const Unit&) const {}
};

__device__ __forceinline__ unsigned cvt_pk_bf16(float lo, float hi) { unsigned r; asm volatile("v_cvt_pk_bf16_f32 %0, %1, %2" : "=v"(r) : "v"(lo), "v"(hi)); return r; }
typedef float f32x2 __attribute__((ext_vector_type(2)));
typedef int v4i_t __attribute__((ext_vector_type(4))); typedef int v8i_t __attribute__((ext_vector_type(8)));
template <class Epi, class Sched, bool ALIGN_EPI = false, bool SP2 = false, int MODE = 0>
__device__ __forceinline__ void gemm_phase(PG8_LAS unsigned char* lds, const Gemm g, const Sched& S, const Epi& E) {
    constexpr bool FP8 = (MODE == 1), I8 = (MODE == 2);
    const int tid = threadIdx.x, wid = __builtin_amdgcn_readfirstlane(tid >> 6), lane = tid & 63, wr = wid >> 2, wc = wid & 3, fr = lane & 15, fq = lane >> 4;
    const int K = g.K; int nt = K / BK;
    unsigned voffA[2], voffB[2];
#pragma unroll
    for (int i = 0; i < 2; ++i) { int R, C; stage_rc(tid * 16 + i * 8192, R, C); const int Rb = Epi::PERM ? ((R & ~31) + perm32(R & 31)) : R;
        voffA[i] = (unsigned)(R * g.lda + C) * 2u; voffB[i] = (unsigned)(Rb * K + C) * 2u; }
    const size_t kstep = (size_t)(BK * 2);
    const size_t hstepA = (size_t)HALF * g.lda * 2, hstepB = (size_t)HALF * K * 2;
    const size_t tstepA = 2 * hstepA, tstepB = 2 * hstepB;
    const unsigned ldsw = (unsigned)wid * 1024u;
    const int aoff = lds_byte(wr * 64 + fr, fq * 8), boff = lds_byte(wc * 32 + fr, fq * 8);
#define PG8_SA(b, h) (((b) * 2 + (h)) * HTB)
#define PG8_SB(b, h) ((4 + (b) * 2 + (h)) * HTB)
#define PG8_STAGE(bufoff, gbase, voff) do { _Pragma("unroll") for (int _i = 0; _i < 2; ++_i) \
        __builtin_amdgcn_global_load_lds((const unsigned*)((const char*)(gbase) + (voff)[_i]), (PG8_LAS unsigned*)(lds + (bufoff) + ldsw + _i * 8192), 16, 0, 0); } while (0)
#define PG8_LDA(dst, b, h) do { if constexpr (FP8) { _Pragma("unroll") for (int m = 0; m < 4; ++m) { const v4i_t lo_ = *(const PG8_LAS v4i_t*)(lds + PG8_SA(b, h) + aoff + m * 2048), hi_ = *(const PG8_LAS v4i_t*)(lds + PG8_SA(b, h) + aoff + m * 2048 + 1024); \
        dst##8[m] = __builtin_shufflevector(lo_, hi_, 0, 1, 2, 3, 4, 5, 6, 7); } } \
    else { _Pragma("unroll") for (int m = 0; m < 4; ++m) _Pragma("unroll") for (int k = 0; k < 2; ++k) dst[m][k] = *(const PG8_LAS bf16x8*)(lds + PG8_SA(b, h) + aoff + m * 2048 + k * 1024); } } while (0)
#define PG8_LDB(dst, b, h) do { if constexpr (FP8) { _Pragma("unroll") for (int n = 0; n < 2; ++n) { const v4i_t lo_ = *(const PG8_LAS v4i_t*)(lds + PG8_SB(b, h) + boff + n * 2048), hi_ = *(const PG8_LAS v4i_t*)(lds + PG8_SB(b, h) + boff + n * 2048 + 1024); \
        dst##8[n] = __builtin_shufflevector(lo_, hi_, 0, 1, 2, 3, 4, 5, 6, 7); } } \
    else { _Pragma("unroll") for (int n = 0; n < 2; ++n) _Pragma("unroll") for (int k = 0; k < 2; ++k) dst[n][k] = *(const PG8_LAS bf16x8*)(lds + PG8_SB(b, h) + boff + n * 2048 + k * 1024); } } while (0)
#define PG8_MMA(ai, bj, At, Bt) do { __builtin_amdgcn_s_setprio(1); _Pragma("unroll") for (int m = 0; m < 4; ++m) _Pragma("unroll") for (int n = 0; n < 2; ++n) { \
        if constexpr (FP8) { asm volatile("v_mfma_scale_f32_16x16x128_f8f6f4 %0, %1, %2, %0, %3, %4 op_sel_hi:[0,0,0]" : "+v"(acc[ai][bj][m][n]) : "v"(Bt##8[n]), "v"(At##8[m]), "v"(sB_), "v"(sA_)); } \
        else if constexpr (I8) { _Pragma("unroll") for (int k = 0; k < 2; ++k) acc[ai][bj][m][n] = __builtin_bit_cast(f32x4, __builtin_amdgcn_mfma_i32_16x16x64_i8(__builtin_bit_cast(v4i_t, Bt[n][k]), __builtin_bit_cast(v4i_t, At[m][k]), __builtin_bit_cast(v4i_t, acc[ai][bj][m][n]), 0, 0, 0)); } \
        else { _Pragma("unroll") for (int k = 0; k < 2; ++k) acc[ai][bj][m][n] = __builtin_amdgcn_mfma_f32_16x16x32_bf16(Bt[n][k], At[m][k], acc[ai][bj][m][n], 0, 0, 0); } } \
        __builtin_amdgcn_s_setprio(0); } while (0)
#define PG8_WAIT_V(n) asm volatile("s_waitcnt vmcnt(" #n ")" ::: "memory")
#define PG8_WAIT_L(n) asm volatile("s_waitcnt lgkmcnt(" #n ")" ::: "memory")
#define PG8_BAR __builtin_amdgcn_s_barrier()
#define PG8_SCHED __builtin_amdgcn_sched_barrier(0)
    Unit cur, nxt; int ui = 0;
    if (!S.next(0, cur)) return;
    const int sA_ = g.sA, sB_ = g.sB;
    f32x4 acc[2][2][4][2];
#pragma unroll
    for (int a = 0; a < 2; ++a)
#pragma unroll
        for (int b = 0; b < 2; ++b)
#pragma unroll
            for (int m = 0; m < 4; ++m)
#pragma unroll
                for (int n = 0; n < 2; ++n) acc[a][b][m][n] = (f32x4){0.f, 0.f, 0.f, 0.f};
    bf16x8 At[4][2], B0[2][2], B1[2][2]; v8i_t At8[4], B08[2], B18[2];
    if (cur.nt) nt = cur.nt;
    const char* cA = (const char*)g.A + (size_t)cur.pm * tstepA + (size_t)cur.k0 * 2; const char* cB = (const char*)g.Bt + (size_t)cur.pn * tstepB + (size_t)cur.k0 * 2;
    S.a_ready(cur);
    if constexpr (SP2) {
        PG8_STAGE(PG8_SB(0, 0), cB, voffB); PG8_STAGE(PG8_SB(0, 1), cB + hstepB, voffB); PG8_STAGE(PG8_SA(0, 0), cA, voffA); PG8_STAGE(PG8_SA(0, 1), cA + hstepA, voffA);
        if (wr == 1) PG8_BAR;
        PG8_WAIT_V(2); PG8_BAR;
        PG8_STAGE(PG8_SB(1, 0), cB + kstep, voffB); PG8_STAGE(PG8_SA(1, 0), cA + kstep, voffA); PG8_STAGE(PG8_SB(1, 1), cB + hstepB + kstep, voffB);
        PG8_WAIT_V(6); PG8_BAR;
    } else {
        PG8_STAGE(PG8_SB(0, 0), cB, voffB); PG8_STAGE(PG8_SA(0, 0), cA, voffA); PG8_STAGE(PG8_SB(0, 1), cB + hstepB, voffB); PG8_STAGE(PG8_SA(0, 1), cA + hstepA, voffA);
        if (wr == 1) PG8_BAR;
        PG8_WAIT_V(4); PG8_BAR;
        PG8_STAGE(PG8_SB(1, 0), cB + kstep, voffB); PG8_STAGE(PG8_SA(1, 0), cA + kstep, voffA); PG8_STAGE(PG8_SB(1, 1), cB + hstepB + kstep, voffB);
        PG8_WAIT_V(6); PG8_BAR;
    }
    for (;;) {
        const bool has_next = S.next(ui + 1, nxt);
        const char* nA = has_next ? (const char*)g.A + (size_t)nxt.pm * tstepA + (size_t)nxt.k0 * 2 : cA; const char* nB = has_next ? (const char*)g.Bt + (size_t)nxt.pn * tstepB + (size_t)nxt.k0 * 2 : cB;
#pragma unroll 1
        for (int t = 0; t < nt; t += 2) {
            const bool last = (t == nt - 2);
            const char* a1 = cA + (size_t)(t + 1) * kstep;
            const char* a2 = last ? nA : cA + (size_t)(t + 2) * kstep; const char* b2 = last ? nB : cB + (size_t)(t + 2) * kstep;
            const char* a3 = a2 + kstep; const char* b3 = b2 + kstep;
            if (last && has_next) S.a_ready(nxt);
            if constexpr (SP2) {
            PG8_LDB(B0, 0, 0); PG8_LDB(B1, 0, 1); PG8_SCHED; PG8_LDA(At, 0, 0); PG8_STAGE(PG8_SA(1, 1), a1 + hstepA, voffA);
            PG8_WAIT_V(8); PG8_WAIT_L(0); PG8_BAR; PG8_MMA(0, 0, At, B0); PG8_MMA(0, 1, At, B1); PG8_BAR; PG8_SCHED;
            PG8_LDA(At, 0, 1); PG8_STAGE(PG8_SB(0, 0), b2, voffB); PG8_STAGE(PG8_SB(0, 1), b2 + hstepB, voffB); PG8_STAGE(PG8_SA(0, 0), a2, voffA);
            PG8_WAIT_V(8); PG8_WAIT_L(0); PG8_BAR; PG8_MMA(1, 0, At, B0); PG8_MMA(1, 1, At, B1); PG8_BAR; PG8_SCHED;
            PG8_LDB(B0, 1, 0); PG8_LDB(B1, 1, 1); PG8_SCHED; PG8_LDA(At, 1, 0); PG8_STAGE(PG8_SA(0, 1), a2 + hstepA, voffA);
            PG8_WAIT_V(8); PG8_WAIT_L(0); PG8_BAR; PG8_MMA(0, 0, At, B0); PG8_MMA(0, 1, At, B1); PG8_BAR; PG8_SCHED;
            PG8_LDA(At, 1, 1); PG8_STAGE(PG8_SB(1, 0), b3, voffB); PG8_STAGE(PG8_SB(1, 1), b3 + hstepB, voffB); PG8_STAGE(PG8_SA(1, 0), a3, voffA);
            PG8_WAIT_V(8); PG8_WAIT_L(0); PG8_BAR; PG8_MMA(1, 0, At, B0); PG8_MMA(1, 1, At, B1); PG8_BAR; PG8_SCHED;
            } else {
            PG8_LDB(B0, 0, 0); PG8_SCHED; PG8_LDA(At, 0, 0); PG8_STAGE(PG8_SA(1, 1), a1 + hstepA, voffA);
            PG8_WAIT_L(8); PG8_BAR; PG8_WAIT_L(0); PG8_MMA(0, 0, At, B0); PG8_BAR; PG8_SCHED;
            PG8_LDB(B1, 0, 1); PG8_STAGE(PG8_SB(0, 0), b2, voffB);
            PG8_BAR; PG8_WAIT_L(0); PG8_MMA(0, 1, At, B1); PG8_BAR;
            PG8_LDA(At, 0, 1); PG8_STAGE(PG8_SA(0, 0), a2, voffA);
            PG8_BAR; PG8_WAIT_L(0); PG8_MMA(1, 0, At, B0); PG8_BAR; PG8_SCHED;
            PG8_STAGE(PG8_SB(0, 1), b2 + hstepB, voffB);
            PG8_WAIT_V(6); PG8_BAR; PG8_MMA(1, 1, At, B1); PG8_BAR;
            PG8_LDB(B0, 1, 0); PG8_SCHED; PG8_LDA(At, 1, 0); PG8_STAGE(PG8_SA(0, 1), a2 + hstepA, voffA);
            PG8_WAIT_L(8); PG8_BAR; PG8_WAIT_L(0); PG8_MMA(0, 0, At, B0); PG8_BAR; PG8_SCHED;
            PG8_LDB(B1, 1, 1); PG8_STAGE(PG8_SB(1, 0), b3, voffB);
            PG8_BAR; PG8_WAIT_L(0); PG8_MMA(0, 1, At, B1); PG8_BAR;
            PG8_LDA(At, 1, 1); PG8_STAGE(PG8_SA(1, 0), a3, voffA);
            PG8_BAR; PG8_WAIT_L(0); PG8_MMA(1, 0, At, B0); PG8_BAR; PG8_SCHED;
            PG8_STAGE(PG8_SB(1, 1), b3 + hstepB, voffB);
            PG8_WAIT_V(6); PG8_BAR; PG8_MMA(1, 1, At, B1); PG8_BAR;
            }
        }
        if constexpr (FP8) asm volatile("s_nop 15\n\ts_nop 15" ::: "memory");
        if constexpr (I8) {
            const float* ra = g.rsA + cur.pm * BM + wr * 64 + fr; const float* rb = g.rsB + cur.pn * BM + wc * 32 + 8 * fq;
#pragma unroll
            for (int bj = 0; bj < 2; ++bj) { const f32x4 sb0 = *(const f32x4*)(rb + bj * HALF), sb1 = *(const f32x4*)(rb + bj * HALF + 4);
#pragma unroll
                for (int ai = 0; ai < 2; ++ai)
#pragma unroll
                    for (int m = 0; m < 4; ++m) { const float sa = ra[ai * HALF + m * 16];
                        acc[ai][bj][m][0] = __builtin_convertvector(__builtin_bit_cast(v4i_t, acc[ai][bj][m][0]), f32x4) * (sb0 * sa);
                        acc[ai][bj][m][1] = __builtin_convertvector(__builtin_bit_cast(v4i_t, acc[ai][bj][m][1]), f32x4) * (sb1 * sa); } }
        }
        if constexpr (ALIGN_EPI) { if (wr == 0) PG8_BAR; }
        if constexpr (!Epi::AFTER_DRAIN) { E(acc, cur, wr, wc, fr, fq); S.done(cur); }
        if (!has_next) break;
#pragma unroll
        for (int a = 0; a < 2; ++a)
#pragma unroll
            for (int b = 0; b < 2; ++b)
#pragma unroll
                for (int m = 0; m < 4; ++m)
#pragma unroll
                    for (int n = 0; n < 2; ++n) acc[a][b][m][n] = (f32x4){0.f, 0.f, 0.f, 0.f};
        cur = nxt; cA = nA; cB = nB; ++ui; nt = cur.nt ? cur.nt : K / BK;
        if constexpr (ALIGN_EPI) { if (wr == 1) PG8_BAR; }
    }
    PG8_WAIT_V(0);
    if constexpr (!ALIGN_EPI) { if (wr == 0) PG8_BAR; }
    PG8_BAR;
    if constexpr (Epi::AFTER_DRAIN) { E.fused(acc, cur, wr, wc, fr, fq, lds, wid, lane); S.done(cur); }
#undef PG8_SA
#undef PG8_SB
#undef PG8_STAGE
#undef PG8_LDA
#undef PG8_LDB
#undef PG8_MMA
#undef PG8_WAIT_V
#undef PG8_WAIT_L
#undef PG8_BAR
#undef PG8_SCHED
}
}

#ifndef PROBE_DUP
#define PROBE_DUP 0
#endif
#ifndef USE_SPLITK
#define USE_SPLITK 0
#endif
#ifndef MK_PER_PHASE
#define MK_PER_PHASE 0
#endif
constexpr int D = 1024, NBATCH = 8, SEQ = 4096, NLAT = NBATCH * SEQ, CTXL = 256, NCTX = NBATCH * CTXL, MALL = NLAT + NCTX;
constexpr int RH = 4, RQK = 256, RV = 512;
constexpr int DFF = 2816, NE = 8, DFE = 3584;
constexpr float EPS = 1e-6f;
constexpr float LAMBDA_INIT = 0.3555090675909693f;
constexpr float LOG2E = 1.4426950408889634f;
constexpr int NWAVES = 8, NTHREADS = 512;
constexpr float MOE_WSCALE = 64.0f; constexpr int MOE_SB = 0x79797979, MOE_SA = 0x7f7f7f7f;
constexpr int MOE_ROWS = 2 * NLAT + NE * 256;

enum { I_X = 0, I_C, I_CTX, I_CCTX, I_L0_WMOD, I_L0_BMOD, I_L0_NPREMIX, I_L0_NPOSTMIX, I_L0_NPREFFN, I_L0_NPOSTFFN, I_L0_WIN, I_L0_DECAY, I_L0_WOUT, I_L0_WGU, I_L0_WDN,
       I_L1_WMOD, I_L1_BMOD, I_L1_NPREMIX, I_L1_NPOSTMIX, I_L1_NPREFFN, I_L1_NPOSTFFN, I_L1_WIN, I_L1_LAMBDA, I_L1_SUBLN, I_L1_WOUT, I_L1_RW, I_L1_RB, I_L1_MGU, I_L1_MDN, N_IN };

constexpr size_t MiB = 1u << 20;
constexpr size_t WS_CTL = 0, CTL_ZERO_BYTES = 1 * MiB;
constexpr size_t WS_MODV = 1 * MiB;
constexpr size_t WS_TAB0 = 1 * MiB + 512 * 1024;
constexpr size_t WS_TAB1 = WS_TAB0 + 32 * 1024;
constexpr size_t WS_LAM = WS_TAB1 + 8 * 1024;
constexpr size_t WS_WSC0 = WS_LAM + 4096;
constexpr size_t WS_WSC2 = WS_WSC0 + 8192 * 4;
constexpr size_t WS_RSC = 1 * MiB + 768 * 1024;
constexpr size_t WS_ROUTE = 2 * MiB;
constexpr size_t WS_XCTX = 3 * MiB;
constexpr size_t WS_W0IN = 11 * MiB, WS_W0OUT = 27 * MiB, WS_W0GU = 31 * MiB, WS_W0DN = 42 * MiB, WS_W1IN = 48 * MiB, WS_W1OUT = 54 * MiB, WS_WMGU = 56 * MiB, WS_WMDN = 168 * MiB;
constexpr size_t WS_H = 224 * MiB;
constexpr size_t WS_A = 292 * MiB, WS_B = 564 * MiB;
constexpr size_t WS_OF = WS_B, WS_OB = WS_B + 136 * MiB;
constexpr size_t WS_QH0 = WS_A, WS_KH0 = WS_A + 68 * MiB, WS_VQ0 = WS_A + 136 * MiB;
constexpr size_t WS_QH1 = WS_A, WS_KH1 = WS_A + 68 * MiB, WS_VH1 = WS_A + 136 * MiB;
constexpr size_t WS_HP = WS_A, WS_ACT1 = 424 * MiB, WS_Y1 = WS_A;
constexpr size_t WS_V8 = 640 * MiB;
constexpr size_t WS_X1 = 360 * MiB, WS_X1C = 424 * MiB;
constexpr size_t WS_X2 = 496 * MiB;
constexpr size_t WS_X3 = 700 * MiB;
constexpr size_t WS_PART = WS_A + 136 * MiB;
constexpr size_t WS_END = 886 * MiB;
static_assert(WS_ACT1 + (size_t)MOE_ROWS * DFE * 2 <= WS_END, "ws map");
static_assert(WS_WSC2 + 2 * DFF * 4 <= WS_RSC && WS_RSC + (size_t)MALL * 4 <= WS_ROUTE, "ws map");
static_assert(WS_HP + (size_t)MOE_ROWS * D * 2 <= WS_ACT1, "ws map");
constexpr int CW_TMO = 0;
constexpr int CW_BAR = 4096;
constexpr int CW_XRANK = 12288;
constexpr int CW_MOECNT = 16384;

constexpr int RING_BYTES = 131072;
constexpr int LDS_BYTES = 163840;
constexpr int MISC_OFF = LDS_BYTES - 256;

#define GAS __attribute__((address_space(1)))
#define LAS __attribute__((address_space(3)))
typedef unsigned short bf16;
typedef unsigned v4u __attribute__((ext_vector_type(4)));
typedef unsigned v2u __attribute__((ext_vector_type(2)));
typedef float f32x4 __attribute__((ext_vector_type(4)));
typedef float f32x2 __attribute__((ext_vector_type(2)));
typedef short bf16x8 __attribute__((ext_vector_type(8)));
typedef GAS unsigned gu32;
#define RLX_AGENT __ATOMIC_RELAXED, __HIP_MEMORY_SCOPE_AGENT
#define LDS_WAIT() asm volatile("s_waitcnt lgkmcnt(0)" ::: "memory")
#define VM_WAIT() asm volatile("s_waitcnt vmcnt(0)" ::: "memory")
__device__ __forceinline__ unsigned pk2(float lo, float hi);
__device__ __forceinline__ unsigned f2bf(float f) { return pk2(f, 0.f) & 0xffffu; }
typedef float f32x2_cv __attribute__((ext_vector_type(2))); typedef __bf16 bf16x2_cv __attribute__((ext_vector_type(2)));
__device__ __forceinline__ unsigned pk2(float lo, float hi) { f32x2_cv v = {lo, hi}; bf16x2_cv b = __builtin_convertvector(v, bf16x2_cv); return __builtin_bit_cast(unsigned, b); }
__device__ __forceinline__ float bf2f(unsigned b) { return __builtin_bit_cast(float, b << 16); }
__device__ __forceinline__ float bflo(unsigned w) { return __builtin_bit_cast(float, w << 16); }
__device__ __forceinline__ float bfhi(unsigned w) { return __builtin_bit_cast(float, w & 0xffff0000u); }
__device__ __forceinline__ unsigned pk4_fp8(float a, float b, float c, float d) {
    a = __builtin_amdgcn_fmed3f(a, -448.f, 448.f); b = __builtin_amdgcn_fmed3f(b, -448.f, 448.f); c = __builtin_amdgcn_fmed3f(c, -448.f, 448.f); d = __builtin_amdgcn_fmed3f(d, -448.f, 448.f);
    int w = 0; w = __builtin_amdgcn_cvt_pk_fp8_f32(a, b, w, false); w = __builtin_amdgcn_cvt_pk_fp8_f32(c, d, w, true); return (unsigned)w; }
__device__ __forceinline__ unsigned pk4_i8(float a, float b, float c, float d) {
    const unsigned ua = __builtin_bit_cast(unsigned, a + 12582912.f), ub = __builtin_bit_cast(unsigned, b + 12582912.f), uc = __builtin_bit_cast(unsigned, c + 12582912.f), ud = __builtin_bit_cast(unsigned, d + 12582912.f);
    return __builtin_amdgcn_perm(ub, ua, 0x0c0c0400u) | (__builtin_amdgcn_perm(ud, uc, 0x0c0c0400u) << 16); }
__device__ __forceinline__ float fast_exp2(float x) { return __builtin_amdgcn_exp2f(x); }
__device__ __forceinline__ float silu_f(float g) { return g * __builtin_amdgcn_rcpf(1.0f + __builtin_amdgcn_exp2f(-g * LOG2E)); }
__device__ __forceinline__ float wave_sum(float v) {
#pragma unroll
    for (int o = 1; o < 64; o <<= 1) v += __shfl_xor(v, o);
    return v;
}

__device__ __forceinline__ float wave_max(float v) {
#pragma unroll
    for (int o = 1; o < 64; o <<= 1) v = fmaxf(v, __shfl_xor(v, o));
    return v;
}

#define XB_TMO      128
#define XB_XCNT(j)  (256  + 64 * (j))
#define XB_XSUB(j)  (1280 + 64 * (j))
#define XB_XGEN(j)  (2304 + 64 * (j))
#define XB_TOP      3328
#define XB_TOPGEN   3392
#define XCD_BAR_WORDS 3456
#define XB_SPIN_CAP (1u << 24)

__device__ __forceinline__ unsigned xb_ld(unsigned* p)              { return __hip_atomic_load(p, __ATOMIC_RELAXED, __HIP_MEMORY_SCOPE_AGENT); }
__device__ __forceinline__ unsigned xb_add(unsigned* p, unsigned v) { return __hip_atomic_fetch_add(p, v, __ATOMIC_RELAXED, __HIP_MEMORY_SCOPE_AGENT); }
__device__ __forceinline__ unsigned xb_xcc_id() { return (unsigned)__builtin_amdgcn_s_getreg((3 << 11) | 20) & 0xFu; }
#define XB_SPIN(cond, bar) do { unsigned _sp = 0; while (cond) { __builtin_amdgcn_s_sleep(1); \
    if ((++_sp & 255u) == 0u) { if (xb_ld(&(bar)[XB_TMO])) break; if (_sp > XB_SPIN_CAP) { atomicAdd(&(bar)[XB_TMO], 1u); break; } } } } while (0)

struct XcdBarrier {
    unsigned* bar; unsigned x;
    volatile LAS unsigned* st;
};

__device__ __forceinline__ XcdBarrier xcd_barrier_post(unsigned* bar, volatile LAS unsigned* st) {
    XcdBarrier b; b.bar = bar; b.x = xb_xcc_id(); b.st = st;
    if (threadIdx.x == 0) (void)xb_add(&bar[XB_XCNT(b.x)], 1u);
    return b;
}
__device__ __forceinline__ void xcd_barrier_complete(unsigned* bar, unsigned x, unsigned& nloc, unsigned& nx) {
    const unsigned G = gridDim.x * gridDim.y * gridDim.z;
    unsigned sum, cnt, mine, sp = 0u;
    for (;;) {
        sum = 0u; cnt = 0u; mine = 0u;
#pragma unroll
        for (unsigned j = 0; j < 16; ++j) { const unsigned c = xb_ld(&bar[XB_XCNT(j)]); sum += c; cnt += (c > 0u) ? 1u : 0u; mine = (j == x) ? c : mine; }
        if (sum == G) break;
        __builtin_amdgcn_s_sleep(1);
        if ((++sp & 255u) == 0u) { if (xb_ld(&bar[XB_TMO])) break; if (sp > XB_SPIN_CAP) { atomicAdd(&bar[XB_TMO], 1u); break; } }
    }
    nloc = mine > 0u ? mine : 1u; nx = cnt > 0u ? cnt : 1u;
}

__device__ __forceinline__ void xcd_barrier(const XcdBarrier& b) {
    asm volatile("s_waitcnt vmcnt(0)" ::: "memory");
    __syncthreads();
    if (threadIdx.x == 0) {
        unsigned* bar = b.bar;
        __builtin_amdgcn_s_waitcnt(0);
        unsigned nloc = b.st[0], nx = b.st[1];
        if (nloc == 0u) { xcd_barrier_complete(bar, b.x, nloc, nx); b.st[0] = nloc; b.st[1] = nx; }
        const unsigned old = xb_add(&bar[XB_XSUB(b.x)], 1u);
        const unsigned gen = old / nloc;
        if (old + 1u == (gen + 1u) * nloc) {
            __builtin_amdgcn_fence(__ATOMIC_RELEASE, "agent");
            asm volatile("s_waitcnt vmcnt(0)" ::: "memory");
            const unsigned og = xb_add(&bar[XB_TOP], 1u);
            const unsigned tg = og / nx;
            if (og + 1u == (tg + 1u) * nx) xb_add(&bar[XB_TOPGEN], 1u);
            else XB_SPIN(xb_ld(&bar[XB_TOPGEN]) == tg, bar);
            __builtin_amdgcn_fence(__ATOMIC_ACQUIRE, "agent");
            xb_add(&bar[XB_XGEN(b.x)], 1u);
            asm volatile("s_waitcnt vmcnt(0)" ::: "memory");
        } else {
            XB_SPIN(xb_ld(&bar[XB_XGEN(b.x)]) == gen, bar);
            __builtin_amdgcn_fence(__ATOMIC_ACQUIRE, "agent");
            asm volatile("s_waitcnt vmcnt(0)" ::: "memory");
        }
    }
    __syncthreads();
}


struct Args { const float* in[N_IN]; float* out; unsigned char* ws; int ph_lo, ph_hi; };

struct Frame {
    LAS unsigned char* lds;
    volatile LAS unsigned* MISC;
    gu32* ctl;
    int tid, lane, wave, vcu, G, cid;
    unsigned char* ws;
};

namespace pg8 {
struct EpiStore {
    static constexpr bool PERM = true, AFTER_DRAIN = false;
    bf16_t* O; int ldc;
    __device__ __forceinline__ void operator()(const f32x4 (&acc)[2][2][4][2], const Unit& u, int wr, int wc, int fr, int fq) const {
        const int row0 = u.pm * BM + wr * 64 + fr; const int col0 = u.pc * BM + wc * 32 + 8 * fq;
#pragma unroll
        for (int ai = 0; ai < 2; ++ai)
#pragma unroll
            for (int m = 0; m < 4; ++m) { bf16_t* rowp = O + (size_t)(row0 + ai * HALF + m * 16) * ldc + col0;
#pragma unroll
                for (int bj = 0; bj < 2; ++bj) { const f32x4 v0 = acc[ai][bj][m][0], v1 = acc[ai][bj][m][1];
                    u32x4 w; w.x = cvt_pk_bf16(v0[0], v0[1]); w.y = cvt_pk_bf16(v0[2], v0[3]); w.z = cvt_pk_bf16(v1[0], v1[1]); w.w = cvt_pk_bf16(v1[2], v1[3]);
                    *(u32x4*)(rowp + bj * HALF) = w; } }
    }
};
struct EpiSwiglu {
    static constexpr bool PERM = true, AFTER_DRAIN = false;
    bf16_t* O; int ldc;
    __device__ __forceinline__ void operator()(const f32x4 (&acc)[2][2][4][2], const Unit& u, int wr, int wc, int fr, int fq) const {
        const int row0 = u.pm * BM + wr * 64 + fr; const int col0 = u.pc * HALF + wc * 32 + 8 * fq;
#pragma unroll
        for (int ai = 0; ai < 2; ++ai)
#pragma unroll
            for (int m = 0; m < 4; ++m) { bf16_t* rowp = O + (size_t)(row0 + ai * HALF + m * 16) * ldc + col0;
                f32x4 a0, a1;
#pragma unroll
                for (int e = 0; e < 4; ++e) { a0[e] = silu_f(acc[ai][0][m][0][e]) * acc[ai][1][m][0][e]; a1[e] = silu_f(acc[ai][0][m][1][e]) * acc[ai][1][m][1][e]; }
                u32x4 w; w.x = cvt_pk_bf16(a0[0], a0[1]); w.y = cvt_pk_bf16(a0[2], a0[3]); w.z = cvt_pk_bf16(a1[0], a1[1]); w.w = cvt_pk_bf16(a1[2], a1[3]);
                *(u32x4*)rowp = w; }
    }
};

struct EpiQKV0 {
    static constexpr bool PERM = true, AFTER_DRAIN = false;
    bf16_t* Qh; bf16_t* Kh; bf16_t* Vq; const float* tab;
    __device__ __forceinline__ void operator()(const f32x4 (&acc)[2][2][4][2], const Unit& u, int wr, int wc, int fr, int fq) const {
        const int row0 = u.pm * BM + wr * 64 + fr, pc = u.pc;
        if (pc < 8) {
            bf16_t* base = pc < 4 ? Qh + (size_t)pc * MALL * 256 : Kh + (size_t)(pc - 4) * MALL * 256; const float sc = pc < 4 ? 1.0f : 0.0625f; const bool lat = u.pm < NLAT / BM;
            const int col0 = wc * 32 + 8 * fq;
#pragma unroll
            for (int ai = 0; ai < 2; ++ai)
#pragma unroll
                for (int m = 0; m < 4; ++m) { const int row = row0 + ai * HALF + m * 16, t = row & (SEQ - 1);
#pragma unroll
                    for (int bj = 0; bj < 2; ++bj) { f32x4 v0 = acc[ai][bj][m][0], v1 = acc[ai][bj][m][1];
                        if (lat) { const int pos = bj ? (t & 63) : (t >> 6); const float* tp = tab + (size_t)(pos * 64 + 16 * wc + 4 * fq) * 2;
                            const f32x4 c0 = *(const f32x4*)tp, c1 = *(const f32x4*)(tp + 4);
                            v0 = (f32x4){v0[0] * c0[0] - v0[1] * c0[1], v0[1] * c0[0] + v0[0] * c0[1], v0[2] * c0[2] - v0[3] * c0[3], v0[3] * c0[2] + v0[2] * c0[3]};
                            v1 = (f32x4){v1[0] * c1[0] - v1[1] * c1[1], v1[1] * c1[0] + v1[0] * c1[1], v1[2] * c1[2] - v1[3] * c1[3], v1[3] * c1[2] + v1[2] * c1[3]}; }
                        v0 = v0 * sc; v1 = v1 * sc;
                        u32x4 w; w.x = cvt_pk_bf16(v0[0], v0[1]); w.y = cvt_pk_bf16(v0[2], v0[3]); w.z = cvt_pk_bf16(v1[0], v1[1]); w.w = cvt_pk_bf16(v1[2], v1[3]);
                        *(u32x4*)(base + (size_t)row * 256 + col0 + bj * HALF) = w; } }
        } else {
#pragma unroll
            for (int ai = 0; ai < 2; ++ai)
#pragma unroll
                for (int m = 0; m < 4; ++m) { const int row = row0 + ai * HALF + m * 16;
#pragma unroll
                    for (int bj = 0; bj < 2; ++bj) { const f32x4 v0 = acc[ai][bj][m][0], v1 = acc[ai][bj][m][1];
                        u32x4 w; w.x = cvt_pk_bf16(v0[0], v0[1]); w.y = cvt_pk_bf16(v0[2], v0[3]); w.z = cvt_pk_bf16(v1[0], v1[1]); w.w = cvt_pk_bf16(v1[2], v1[3]);
                        *(u32x4*)(Vq + ((size_t)((pc - 8) * 2 + bj) * MALL + row) * 128 + wc * 32 + 8 * fq) = w; } }
        }
    }
};
struct EpiQKV1 {
    static constexpr bool PERM = true, AFTER_DRAIN = false;
    bf16_t* Qh; bf16_t* Kh; bf16_t* Vh; const float* tab;
    __device__ __forceinline__ void operator()(const f32x4 (&acc)[2][2][4][2], const Unit& u, int wr, int wc, int fr, int fq) const {
        const int row0 = u.pm * BM + wr * 64 + fr, pc = u.pc;
        if (pc < 8) {
            bf16_t* base = pc < 4 ? Qh : Kh; const float sc = pc < 4 ? 0.125f * LOG2E : 1.0f; const bool lat = u.pm < NLAT / BM;
            const int hf = wc & 1, p0 = 32 * hf + 8 * fq;
#pragma unroll
            for (int ai = 0; ai < 2; ++ai)
#pragma unroll
                for (int m = 0; m < 4; ++m) { const int row = row0 + ai * HALF + m * 16, t = row & (SEQ - 1);
                    const int pos = hf ? (t & 63) : (t >> 6); const float* tp = tab + (size_t)(pos * 16 + 4 * fq) * 2;
                    f32x4 c0 = (f32x4){1.f, 0.f, 1.f, 0.f}, c1 = c0;
                    if (lat) { c0 = *(const f32x4*)tp; c1 = *(const f32x4*)(tp + 4); }
#pragma unroll
                    for (int bj = 0; bj < 2; ++bj) { f32x4 v0 = acc[ai][bj][m][0], v1 = acc[ai][bj][m][1];
                        v0 = (f32x4){v0[0] * c0[0] - v0[1] * c0[1], v0[1] * c0[0] + v0[0] * c0[1], v0[2] * c0[2] - v0[3] * c0[3], v0[3] * c0[2] + v0[2] * c0[3]};
                        v1 = (f32x4){v1[0] * c1[0] - v1[1] * c1[1], v1[1] * c1[0] + v1[0] * c1[1], v1[2] * c1[2] - v1[3] * c1[3], v1[3] * c1[2] + v1[2] * c1[3]};
                        v0 = v0 * sc; v1 = v1 * sc;
                        const int head = (pc & 3) * 4 + 2 * bj + (wc >> 1);
                        u32x4 w; w.x = cvt_pk_bf16(v0[0], v0[1]); w.y = cvt_pk_bf16(v0[2], v0[3]); w.z = cvt_pk_bf16(v1[0], v1[1]); w.w = cvt_pk_bf16(v1[2], v1[3]);
                        *(u32x4*)(base + ((size_t)head * MALL + row) * 64 + p0) = w; } }
        } else {
#pragma unroll
            for (int ai = 0; ai < 2; ++ai)
#pragma unroll
                for (int m = 0; m < 4; ++m) { const int row = row0 + ai * HALF + m * 16;
#pragma unroll
                    for (int bj = 0; bj < 2; ++bj) { const f32x4 v0 = acc[ai][bj][m][0], v1 = acc[ai][bj][m][1];
                        u32x4 w; w.x = cvt_pk_bf16(v0[0], v0[1]); w.y = cvt_pk_bf16(v0[2], v0[3]); w.z = cvt_pk_bf16(v1[0], v1[1]); w.w = cvt_pk_bf16(v1[2], v1[3]);
                        *(u32x4*)(Vh + ((size_t)((pc - 8) * 2 + bj) * MALL + row) * 128 + wc * 32 + 8 * fq) = w; } }
        }
    }
};

struct EpiGateMerge {
    static constexpr bool PERM = true, AFTER_DRAIN = false;
    bf16_t* Of; const bf16_t* Ob; const float* ssq;
    __device__ __forceinline__ void operator()(const f32x4 (&acc)[2][2][4][2], const Unit& u, int wr, int wc, int fr, int fq) const {
        const int row0 = u.pm * BM + wr * 64 + fr; const int col0 = u.pc * HALF + wc * 32 + 8 * fq; const int head = u.pc >> 2;
#pragma unroll
        for (int ai = 0; ai < 2; ++ai)
#pragma unroll
            for (int m = 0; m < 4; ++m) { const size_t row = (size_t)(row0 + ai * HALF + m * 16);
                const f32x4 sf = *(const f32x4*)(ssq + (row * RH + head) * 8), sb = *(const f32x4*)(ssq + (row * RH + head) * 8 + 4);
                const float rf = __builtin_amdgcn_rsqf(((sf[0] + sf[1]) + (sf[2] + sf[3])) * (1.0f / RV) + EPS), rb = __builtin_amdgcn_rsqf(((sb[0] + sb[1]) + (sb[2] + sb[3])) * (1.0f / RV) + EPS);
                const u32x4 of = *(const u32x4*)(Of + row * 2048 + col0), ob = *(const u32x4*)(Ob + row * 2048 + col0);
                float y[8];
#pragma unroll
                for (int e = 0; e < 4; ++e) {
                    const float gf0 = acc[ai][0][m][e >> 1][2 * (e & 1)], gf1 = acc[ai][0][m][e >> 1][2 * (e & 1) + 1], gb0 = acc[ai][1][m][e >> 1][2 * (e & 1)], gb1 = acc[ai][1][m][e >> 1][2 * (e & 1) + 1];
                    y[2 * e] = silu_f(gf0) * (bflo(of[e]) * rf) + silu_f(gb0) * (bflo(ob[e]) * rb);
                    y[2 * e + 1] = silu_f(gf1) * (bfhi(of[e]) * rf) + silu_f(gb1) * (bfhi(ob[e]) * rb); }
                u32x4 w; w.x = cvt_pk_bf16(y[0], y[1]); w.y = cvt_pk_bf16(y[2], y[3]); w.z = cvt_pk_bf16(y[4], y[5]); w.w = cvt_pk_bf16(y[6], y[7]);
                *(u32x4*)(Of + row * 2048 + col0) = w; }
    }
};

struct SplitOrder {
    StaticOrder lat; int G, c, KS, ntS, nN, nl;
    __device__ __forceinline__ void init(int N, int G_, int c_, int KS_, int ntS_) { lat.init(KS_ ? NLAT : MALL, N, G_, c_); G = G_; c = c_; KS = KS_; ntS = ntS_; nN = N / BM; nl = (lat.nwg > c_) ? (lat.nwg - 1 - c_) / G_ + 1 : 0; }
    __device__ __forceinline__ bool next(int i, Unit& u) const {
        if (i < nl) return lat.next(i, u);
        const long j = (long)(i - nl) * G + c; if (j >= (long)(NCTX / BM) * nN * KS) return false;
        const int tile = (int)(j / KS), ks = (int)(j % KS);
        u.pm = NLAT / BM + tile / nN; u.pn = tile % nN; u.pc = u.pn; u.k0 = ks * ntS * BK; u.nt = ntS; u.ks = ks; return true;
    }
    __device__ __forceinline__ void a_ready(const Unit&) const {}
    __device__ __forceinline__ void done(const Unit&) const {}
};
struct EpiStoreSplit {
    static constexpr bool PERM = true, AFTER_DRAIN = false;
    bf16_t* O; int ldc; float* P;
    __device__ __forceinline__ void operator()(const f32x4 (&acc)[2][2][4][2], const Unit& u, int wr, int wc, int fr, int fq) const {
        const int row0 = u.pm * BM + wr * 64 + fr; const int col0 = u.pc * BM + wc * 32 + 8 * fq;
        if (u.ks < 0) {
#pragma unroll
            for (int ai = 0; ai < 2; ++ai)
#pragma unroll
                for (int m = 0; m < 4; ++m) { bf16_t* rowp = O + (size_t)(row0 + ai * HALF + m * 16) * ldc + col0;
#pragma unroll
                    for (int bj = 0; bj < 2; ++bj) { const f32x4 v0 = acc[ai][bj][m][0], v1 = acc[ai][bj][m][1];
                        u32x4 w; w.x = cvt_pk_bf16(v0[0], v0[1]); w.y = cvt_pk_bf16(v0[2], v0[3]); w.z = cvt_pk_bf16(v1[0], v1[1]); w.w = cvt_pk_bf16(v1[2], v1[3]);
                        *(u32x4*)(rowp + bj * HALF) = w; } }
        } else {
            float* pb = P + (size_t)u.ks * NCTX * ldc;
#pragma unroll
            for (int ai = 0; ai < 2; ++ai)
#pragma unroll
                for (int m = 0; m < 4; ++m) { float* rowp = pb + (size_t)(row0 - NLAT + ai * HALF + m * 16) * ldc + col0;
#pragma unroll
                    for (int bj = 0; bj < 2; ++bj) { *(f32x4*)(rowp + bj * HALF) = acc[ai][bj][m][0]; *(f32x4*)(rowp + bj * HALF + 4) = acc[ai][bj][m][1]; } }
        }
    }
};
struct EpiSwiglu8 {
    static constexpr bool PERM = true, AFTER_DRAIN = false;
    unsigned char* O; int ldc;
    __device__ __forceinline__ void operator()(const f32x4 (&acc)[2][2][4][2], const Unit& u, int wr, int wc, int fr, int fq) const {
        const int row0 = u.pm * BM + wr * 64 + fr; const int col0 = u.pc * HALF + wc * 32 + 8 * fq;
#pragma unroll
        for (int ai = 0; ai < 2; ++ai)
#pragma unroll
            for (int m = 0; m < 4; ++m) { unsigned char* rowp = O + (size_t)(row0 + ai * HALF + m * 16) * ldc + col0;
                f32x4 a0, a1;
#pragma unroll
                for (int e = 0; e < 4; ++e) { a0[e] = silu_f(acc[ai][0][m][0][e]) * acc[ai][1][m][0][e]; a1[e] = silu_f(acc[ai][0][m][1][e]) * acc[ai][1][m][1][e]; }
                v2u w; w.x = pk4_fp8(a0[0], a0[1], a0[2], a0[3]); w.y = pk4_fp8(a1[0], a1[1], a1[2], a1[3]);
                *(v2u*)rowp = w; }
    }
};
struct MoeOrder {
    int nM, nN, nwg, G, c; int t1, t2, t3, t4, t5, t6, t7;
    __device__ __forceinline__ bool next(int i, Unit& u) const {
        const long L = (long)i * G + c; if (L >= nwg) return false;
        int wgid = (int)L; { const int q = nwg / NXCD, r = nwg % NXCD, xcd = wgid % NXCD, off = wgid / NXCD; wgid = (xcd < r ? xcd * (q + 1) : r * (q + 1) + (xcd - r) * q) + off; }
        const int nig = WGM * nN, gid = wgid / nig, fm = gid * WGM, gsz = (nM - fm) < WGM ? (nM - fm) : WGM;
        u.pm = fm + ((wgid % nig) % gsz); u.pc = (wgid % nig) / gsz;
        const int e = (u.pm >= t1) + (u.pm >= t2) + (u.pm >= t3) + (u.pm >= t4) + (u.pm >= t5) + (u.pm >= t6) + (u.pm >= t7);
        u.pn = e * nN + u.pc; u.k0 = 0; u.nt = 0; u.ks = -1; return true;
    }
    __device__ __forceinline__ void a_ready(const Unit&) const {}
    __device__ __forceinline__ void done(const Unit&) const {}
};
}

__device__ __forceinline__ int swiglu_row(int n, int F) { const int bj = n / F, w = n % F; return 256 * (w >> 7) + 128 * bj + (w & 127); }
__device__ __forceinline__ int w_rowmap(int map, int mapF, int n) {
    if (map == 1) { if (n < 2048) { const int d0 = n & 255, hf = d0 >> 7, e = d0 & 127; return (n - d0) + 2 * (hf * 64 + (e & 63)) + (e >> 6); }
                    if (n >= 4096) return 4096 + swiglu_row(n - 4096, 2048); return n; }
    if (map == 2) { if (n < 2048) { const int d0 = n & 63, hf = d0 >> 5, e = d0 & 31; return (n - d0) + hf * 32 + 2 * (e & 15) + (e >> 4); } return n; }
    if (map == 3) return swiglu_row(n, mapF);
    return n;
}
template <bool FP8> __device__ __forceinline__ void p0_item64(const float* W, int K, int N, void* WT, int map, int mapF, LAS float* scr, int k0, int n0, int lane, float wscale) {
    { const int kq = lane >> 4, n4 = (lane & 15) * 4;
#pragma unroll 4
      for (int i = 0; i < 16; ++i) { const int k = 4 * i + kq; const f32x4 v = *(const GAS f32x4*)(W + (size_t)(k0 + k) * N + n0 + n4);
          LAS float* d = scr + k * 65 + n4; d[0] = v.x; d[1] = v.y; d[2] = v.z; d[3] = v.w; } }
    LDS_WAIT(); asm volatile("" ::: "memory");
    if constexpr (!FP8) {
        const int c = lane & 7;
#pragma unroll
        for (int j = 0; j < 8; ++j) { const int n = (lane >> 3) + 8 * j; const LAS float* sp = scr + (8 * c) * 65 + n;
            v4u o; o.x = pk2(sp[0 * 65], sp[1 * 65]); o.y = pk2(sp[2 * 65], sp[3 * 65]); o.z = pk2(sp[4 * 65], sp[5 * 65]); o.w = pk2(sp[6 * 65], sp[7 * 65]);
            *(GAS v4u*)((bf16*)WT + (size_t)w_rowmap(map, mapF, n0 + n) * K + k0 + 8 * c) = o; }
    } else {
        const int c = lane & 3;
#pragma unroll
        for (int j = 0; j < 4; ++j) { const int n = (lane >> 2) + 16 * j; const LAS float* sp = scr + (16 * c) * 65 + n;
            v4u o;
#pragma unroll
            for (int q = 0; q < 4; ++q) o[q] = pk4_fp8(sp[(4 * q) * 65] * wscale, sp[(4 * q + 1) * 65] * wscale, sp[(4 * q + 2) * 65] * wscale, sp[(4 * q + 3) * 65] * wscale);
            *(GAS v4u*)((unsigned char*)WT + (size_t)w_rowmap(map, mapF, n0 + n) * K + k0 + 16 * c) = o; }
    }
    LDS_WAIT(); asm volatile("" ::: "memory");
}

__device__ __forceinline__ void p0_colitem_i8(Frame& F, const float* W, int N, unsigned char* WT, float* WSC, int map, int mapF, LAS float* scr, int n0) {
    LAS float* mx = (LAS float*)(F.lds + 8 * 16640);
    LAS float* invs = mx + 512 + F.wave * 64;
    const int lane = F.lane, w = F.wave, kq = lane >> 4, n4 = (lane & 15) * 4;
    float m = 0.f;
    for (int h = 0; h < 2; ++h) { const int k0 = 64 * (2 * w + h);
#pragma unroll 4
        for (int i = 0; i < 16; ++i) { const int k = 4 * i + kq; const f32x4 v = *(const GAS f32x4*)(W + (size_t)(k0 + k) * N + n0 + n4);
            LAS float* d = scr + k * 65 + n4; d[0] = v.x; d[1] = v.y; d[2] = v.z; d[3] = v.w; }
        LDS_WAIT(); asm volatile("" ::: "memory");
#pragma unroll 8
        for (int k = 0; k < 64; ++k) m = fmaxf(m, fabsf(scr[k * 65 + lane]));
        LDS_WAIT(); asm volatile("" ::: "memory"); }
    mx[w * 64 + lane] = m; __syncthreads();
    float cm = 0.f;
#pragma unroll
    for (int i = 0; i < 8; ++i) cm = fmaxf(cm, mx[i * 64 + lane]);
    invs[lane] = cm > 0.f ? 127.0f / cm : 0.f;
    if (w == 0) WSC[w_rowmap(map, mapF, n0 + lane)] = cm * (1.0f / 127.0f);
    LDS_WAIT(); asm volatile("" ::: "memory");
    for (int h = 0; h < 2; ++h) { const int k0 = 64 * (2 * w + h);
#pragma unroll 4
        for (int i = 0; i < 16; ++i) { const int k = 4 * i + kq; const f32x4 v = *(const GAS f32x4*)(W + (size_t)(k0 + k) * N + n0 + n4);
            LAS float* d = scr + k * 65 + n4; d[0] = v.x; d[1] = v.y; d[2] = v.z; d[3] = v.w; }
        LDS_WAIT(); asm volatile("" ::: "memory");
        const int c = lane & 3;
#pragma unroll
        for (int j = 0; j < 4; ++j) { const int n = (lane >> 2) + 16 * j; const LAS float* sp = scr + (16 * c) * 65 + n; const float iv = invs[n];
            v4u o;
#pragma unroll
            for (int q = 0; q < 4; ++q) o[q] = pk4_i8(sp[(4 * q) * 65] * iv, sp[(4 * q + 1) * 65] * iv, sp[(4 * q + 2) * 65] * iv, sp[(4 * q + 3) * 65] * iv);
            *(GAS v4u*)(WT + (size_t)w_rowmap(map, mapF, n0 + n) * 1024 + k0 + 16 * c) = o; }
        LDS_WAIT(); asm volatile("" ::: "memory"); }
    __syncthreads();
}

__device__ __forceinline__ void p0_prologue(Frame& F, const Args& a) {
    LAS float* scr = (LAS float*)(F.lds + F.wave * 16640);
    const int gw = F.vcu * NWAVES + F.wave, NGW = F.G * NWAVES;
    constexpr int I1 = (2048 / 64) * (D / 64), I3 = (DFF / 64) * (D / 64), I4 = (D / 64) * (3072 / 64), I5 = (D / 64) * (D / 64);
    constexpr int I6E = (D / 64) * (2 * DFE / 64), I7E = (DFE / 64) * (D / 64);
    constexpr int NITEMS = I1 + I3 + I4 + I5 + NE * I6E + NE * I7E;
    for (int ci = F.vcu; ci < 8192 / 64 + 2 * DFF / 64; ci += F.G) {
        if (ci < 8192 / 64) p0_colitem_i8(F, a.in[I_L0_WIN], 8192, F.ws + WS_W0IN, (float*)(F.ws + WS_WSC0), 1, 0, scr, 64 * ci);
        else p0_colitem_i8(F, a.in[I_L0_WGU], 2 * DFF, F.ws + WS_W0GU, (float*)(F.ws + WS_WSC2), 3, DFF, scr, 64 * (ci - 8192 / 64));
    }
    for (int it = gw; it < NITEMS; it += NGW) {
        int r = it;
        if (r < I1) { const int nb = r % (D / 64), kb = r / (D / 64); p0_item64<false>(a.in[I_L0_WOUT], 2048, D, F.ws + WS_W0OUT, 0, 0, scr, 64 * kb, 64 * nb, F.lane, 1.f); continue; } r -= I1;
        if (r < I3) { const int nb = r % (D / 64), kb = r / (D / 64); p0_item64<true>(a.in[I_L0_WDN], DFF, D, F.ws + WS_W0DN, 0, 0, scr, 64 * kb, 64 * nb, F.lane, MOE_WSCALE); continue; } r -= I3;
        if (r < I4) { const int nb = r % (3072 / 64), kb = r / (3072 / 64); p0_item64<true>(a.in[I_L1_WIN], D, 3072, F.ws + WS_W1IN, 2, 0, scr, 64 * kb, 64 * nb, F.lane, MOE_WSCALE); continue; } r -= I4;
        if (r < I5) { const int nb = r % (D / 64), kb = r / (D / 64); p0_item64<false>(a.in[I_L1_WOUT], D, D, F.ws + WS_W1OUT, 0, 0, scr, 64 * kb, 64 * nb, F.lane, 1.f); continue; } r -= I5;
        if (r < NE * I6E) { const int e = r / I6E, rr = r % I6E; const int nb = rr % (2 * DFE / 64), kb = rr / (2 * DFE / 64);
            p0_item64<true>(a.in[I_L1_MGU] + (size_t)e * D * 2 * DFE, D, 2 * DFE, F.ws + WS_WMGU + (size_t)e * 2 * DFE * D, 3, DFE, scr, 64 * kb, 64 * nb, F.lane, MOE_WSCALE); continue; } r -= NE * I6E;
        { const int e = r / I7E, rr = r % I7E; const int nb = rr % (D / 64), kb = rr / (D / 64);
            p0_item64<true>(a.in[I_L1_MDN] + (size_t)e * DFE * D, DFE, D, F.ws + WS_WMDN + (size_t)e * D * DFE, 0, 0, scr, 64 * kb, 64 * nb, F.lane, MOE_WSCALE); }
    }
    __syncthreads();
    {
        LAS float* sc = (LAS float*)F.lds;
        LAS float* part = (LAS float*)(F.lds + 9 * 1024 * 4);
        bool loaded = false;
        for (int grp = F.vcu; grp < 2 * (6 * D / 64); grp += F.G) {
            if (!loaded) { for (int i = F.tid; i < 9 * 1024; i += NTHREADS) { const float cv = (i < 8 * 1024) ? a.in[I_C][i] : a.in[I_CCTX][i - 8 * 1024]; sc[i] = silu_f(cv); } loaded = true; }
            __syncthreads();
            const int layer = grp / (6 * D / 64), cb = (grp % (6 * D / 64)) * 64;
            const float* W = a.in[layer ? I_L1_WMOD : I_L0_WMOD]; const float* bm = a.in[layer ? I_L1_BMOD : I_L0_BMOD];
            const int ks = F.tid >> 6, col = F.tid & 63;
            float acc[9];
#pragma unroll
            for (int b = 0; b < 9; ++b) acc[b] = 0.f;
            for (int k = ks * 128; k < ks * 128 + 128; ++k) { const float w = W[(size_t)k * (6 * D) + cb + col];
#pragma unroll
                for (int b = 0; b < 9; ++b) acc[b] += sc[b * 1024 + k] * w; }
#pragma unroll
            for (int b = 0; b < 9; ++b) part[(ks * 9 + b) * 64 + col] = acc[b];
            __syncthreads();
            for (int o = F.tid; o < 9 * 64; o += NTHREADS) { const int b = o >> 6, cc = o & 63; float s = bm[cb + cc];
#pragma unroll
                for (int k2 = 0; k2 < 8; ++k2) s += part[(k2 * 9 + b) * 64 + cc];
                ((float*)(F.ws + WS_MODV))[((size_t)layer * 9 + b) * (6 * D) + cb + cc] = s; }
            __syncthreads();
        }
    }
    {
        const int gt = F.vcu * NTHREADS + F.tid;
        if (gt < 64 * 64 + 64 * 16) {
            int pos, i; float ex;
            if (gt < 4096) { pos = gt >> 6; i = gt & 63; ex = (float)(2 * i) / 128.0f; } else { const int q = gt - 4096; pos = q >> 4; i = q & 15; ex = (float)(2 * i) / 32.0f; }
            const float freq = __builtin_amdgcn_exp2f(-ex * 13.287712379549449f);
            const float rev = (float)pos * freq * 0.15915494309189535f;
            const float cs = __builtin_amdgcn_cosf(rev), sn = __builtin_amdgcn_sinf(rev);
            f32x2* t = (f32x2*)(F.ws + (gt < 4096 ? WS_TAB0 : WS_TAB1)); t[gt < 4096 ? gt : gt - 4096] = (f32x2){cs, sn};
        }
        if (gt == 0) { const float* lp = a.in[I_L1_LAMBDA]; float s1 = 0.f, s2 = 0.f; for (int i = 0; i < 64; ++i) { s1 += lp[i] * lp[64 + i]; s2 += lp[128 + i] * lp[192 + i]; }
            *(float*)(F.ws + WS_LAM) = __expf(s1) - __expf(s2) + LAMBDA_INIT; }
    }
}

struct RowPass {
    int nrows;
    const float* xin_lat; const float* xin_ctx; float* xout_lat; float* xout_ctx;
    const bf16* br;
    const float* gpost;
    const float* gate;
    const float* gpre;
    const float* shift; const float* scale;
    bf16* hout;
    const float* part;
    float* rsc;
};
template <bool BR, bool MOEBR, bool WH, bool ROUTE, int H8 = 0, int KSPL = 0, bool XI16 = false, bool XO16 = false>
__device__ __forceinline__ void row_pass(Frame& F, const Args& a, const RowPass& P) {
    const int gw = F.vcu * NWAVES + F.wave, NGW = F.G * NWAVES;
    const int l4 = F.lane * 4;
    for (int r = gw; r < P.nrows; r += NGW) {
        const bool lat = r < NLAT; const int rc = lat ? r : r - NLAT; const int midx = lat ? (r >> 12) : 8;
        const float* xin = (lat ? P.xin_lat : P.xin_ctx) + (size_t)rc * (XI16 ? D / 2 : D);
        float* xout = (lat ? P.xout_lat : P.xout_ctx) + (size_t)rc * (XO16 ? D / 2 : D);
        f32x4 v[4];
        if constexpr (XI16) {
#pragma unroll
            for (int j = 0; j < 4; ++j) { const v2u w = *(const GAS v2u*)((const bf16*)xin + l4 + 256 * j); v[j] = (f32x4){bflo(w.x), bfhi(w.x), bflo(w.y), bfhi(w.y)}; }
        } else {
#pragma unroll
            for (int j = 0; j < 4; ++j) v[j] = *(const GAS f32x4*)(xin + l4 + 256 * j);
        }
        if constexpr (BR || MOEBR) {
            f32x4 y[4];
            if constexpr (BR) {
                if (KSPL > 0 && !lat) {
#pragma unroll
                    for (int j = 0; j < 4; ++j) y[j] = (f32x4){0.f, 0.f, 0.f, 0.f};
                    for (int ks = 0; ks < KSPL; ++ks) { const float* pr = P.part + ((size_t)ks * NCTX + rc) * D + l4;
#pragma unroll
                        for (int j = 0; j < 4; ++j) y[j] = y[j] + *(const GAS f32x4*)(pr + 256 * j); }
                } else {
#pragma unroll
                for (int j = 0; j < 4; ++j) { const v2u w = *(const GAS v2u*)(P.br + (size_t)r * D + l4 + 256 * j); y[j] = (f32x4){bflo(w.x), bfhi(w.x), bflo(w.y), bfhi(w.y)}; }
                }
            } else {
                const int* tpos = (const int*)(F.ws + WS_ROUTE + (size_t)NLAT * 8); const float* tw = (const float*)(F.ws + WS_ROUTE + (size_t)NLAT * 16);
                const int s0 = tpos[2 * r], s1 = tpos[2 * r + 1]; const float w0 = tw[2 * r], w1 = tw[2 * r + 1];
#pragma unroll
                for (int j = 0; j < 4; ++j) { const v2u p = *(const GAS v2u*)(P.br + (size_t)s0 * D + l4 + 256 * j); const v2u q = *(const GAS v2u*)(P.br + (size_t)s1 * D + l4 + 256 * j);
                    y[j] = (f32x4){w0 * bflo(p.x) + w1 * bflo(q.x), w0 * bfhi(p.x) + w1 * bfhi(q.x), w0 * bflo(p.y) + w1 * bflo(q.y), w0 * bfhi(p.y) + w1 * bfhi(q.y)}; }
            }
            float ss = 0.f;
#pragma unroll
            for (int j = 0; j < 4; ++j) ss += (y[j].x * y[j].x + y[j].y * y[j].y) + (y[j].z * y[j].z + y[j].w * y[j].w);
            const float rstd = 1.0f / sqrtf(wave_sum(ss) * (1.0f / D) + EPS);
#pragma unroll
            for (int j = 0; j < 4; ++j) { const f32x4 gp = *(const GAS f32x4*)(P.gpost + l4 + 256 * j); const f32x4 gt = *(const GAS f32x4*)(P.gate + (size_t)midx * 6 * D + l4 + 256 * j);
                v[j] = v[j] + gt * (y[j] * rstd * gp); }
            if ((lat ? P.xout_lat : P.xout_ctx) != nullptr) {
                if constexpr (XO16) {
#pragma unroll
                    for (int j = 0; j < 4; ++j) { v2u w; w.x = pk2(v[j].x, v[j].y); w.y = pk2(v[j].z, v[j].w); *(GAS v2u*)((bf16*)xout + l4 + 256 * j) = w; }
                } else {
#pragma unroll
                    for (int j = 0; j < 4; ++j) *(GAS f32x4*)(xout + l4 + 256 * j) = v[j];
                }
            }
        }
        if constexpr (WH) {
            float ss = 0.f;
#pragma unroll
            for (int j = 0; j < 4; ++j) ss += (v[j].x * v[j].x + v[j].y * v[j].y) + (v[j].z * v[j].z + v[j].w * v[j].w);
            const float rstd = 1.0f / sqrtf(wave_sum(ss) * (1.0f / D) + EPS);
            f32x4 h[4];
#pragma unroll
            for (int j = 0; j < 4; ++j) { const f32x4 gp = *(const GAS f32x4*)(P.gpre + l4 + 256 * j); const f32x4 sc = *(const GAS f32x4*)(P.scale + (size_t)midx * 6 * D + l4 + 256 * j);
                const f32x4 sh = *(const GAS f32x4*)(P.shift + (size_t)midx * 6 * D + l4 + 256 * j);
                h[j] = (v[j] * rstd * gp) * (1.0f + sc) + sh;
                if constexpr (H8 == 2) { }
                else if constexpr (H8 == 1) { *(GAS unsigned*)((unsigned char*)P.hout + (size_t)r * D + l4 + 256 * j) = pk4_fp8(h[j].x, h[j].y, h[j].z, h[j].w); }
                else { v2u w; w.x = pk2(h[j].x, h[j].y); w.y = pk2(h[j].z, h[j].w); *(GAS v2u*)(P.hout + (size_t)r * D + l4 + 256 * j) = w; } }
            if constexpr (H8 == 2) {
                float am = 0.f;
#pragma unroll
                for (int j = 0; j < 4; ++j) am = fmaxf(fmaxf(am, fmaxf(fabsf(h[j].x), fabsf(h[j].y))), fmaxf(fabsf(h[j].z), fabsf(h[j].w)));
                am = wave_max(am);
                const float iv = am > 0.f ? 127.0f / am : 0.f;
#pragma unroll
                for (int j = 0; j < 4; ++j) *(GAS unsigned*)((unsigned char*)P.hout + (size_t)r * D + l4 + 256 * j) = pk4_i8(h[j].x * iv, h[j].y * iv, h[j].z * iv, h[j].w * iv);
                if (F.lane == 0) P.rsc[r] = am * (1.0f / 127.0f);
            }
            if constexpr (ROUTE) {
                const float* rw = a.in[I_L1_RW];
                float lg[8];
#pragma unroll
                for (int e = 0; e < 8; ++e) lg[e] = 0.f;
#pragma unroll
                for (int j = 0; j < 4; ++j)
#pragma unroll
                    for (int q = 0; q < 4; ++q) { const int k = l4 + 256 * j + q; const f32x4 wa = *(const GAS f32x4*)(rw + (size_t)k * 8), wb = *(const GAS f32x4*)(rw + (size_t)k * 8 + 4); const float hv = h[j][q];
                        lg[0] += hv * wa.x; lg[1] += hv * wa.y; lg[2] += hv * wa.z; lg[3] += hv * wa.w; lg[4] += hv * wb.x; lg[5] += hv * wb.y; lg[6] += hv * wb.z; lg[7] += hv * wb.w; }
#pragma unroll
                for (int e = 0; e < 8; ++e) lg[e] = wave_sum(lg[e]) + a.in[I_L1_RB][e];
                float v1 = lg[0]; int i1 = 0;
#pragma unroll
                for (int e = 1; e < 8; ++e) if (lg[e] > v1) { v1 = lg[e]; i1 = e; }
                float v2 = -3.0e38f; int i2 = 0;
#pragma unroll
                for (int e = 0; e < 8; ++e) if (e != i1 && lg[e] > v2) { v2 = lg[e]; i2 = e; }
                const float w1 = 1.0f / (1.0f + __expf(v2 - v1)), w2 = 1.0f - w1;
                if (F.lane == 0) {
                    int* te = (int*)(F.ws + WS_ROUTE); int* tpos = (int*)(F.ws + WS_ROUTE + (size_t)NLAT * 8); float* tw = (float*)(F.ws + WS_ROUTE + (size_t)NLAT * 16);
                    const unsigned p1 = __hip_atomic_fetch_add((unsigned*)(F.ctl + CW_MOECNT + 64 * i1), 1u, RLX_AGENT);
                    const unsigned p2 = __hip_atomic_fetch_add((unsigned*)(F.ctl + CW_MOECNT + 64 * i2), 1u, RLX_AGENT);
                    te[2 * r] = i1; te[2 * r + 1] = i2; tpos[2 * r] = (int)p1; tpos[2 * r + 1] = (int)p2; tw[2 * r] = w1; tw[2 * r + 1] = w2;
                }
            }
        }
    }
}


namespace att {
using s16x4  = __attribute__((ext_vector_type(4))) short;
using f32x16 = __attribute__((ext_vector_type(16))) float;
using u32x4  = __attribute__((ext_vector_type(4))) unsigned;
constexpr int KVBLK = 64, NT = (SEQ + CTXL) / KVBLK;
constexpr int SHM_V = KVBLK * 128, SHM_K = KVBLK * 64 * 2;
constexpr int NVTILE = MALL / KVBLK;
constexpr int NSLOT_K = 3, NSLOT_V = 4;
constexpr int OFF_V = 0, OFF_K = NSLOT_V * SHM_V, OFF_WS = OFF_K + NSLOT_K * SHM_K, OFF_O1 = OFF_WS + NWAVES * 64 * 4, ATT_LDS = OFF_O1 + NWAVES * 8192;
constexpr float THR = 8.0f;
#define ATT_SBAR() __builtin_amdgcn_sched_barrier(0)
#define ATT_PIPE_PV() do { __builtin_amdgcn_sched_group_barrier(0x100, 2, 0); \
    _Pragma("unroll") for (int i_ = 0; i_ < 16; ++i_) { __builtin_amdgcn_sched_group_barrier(0x008, 1, 0); __builtin_amdgcn_sched_group_barrier(0x100, 2, 0); __builtin_amdgcn_sched_group_barrier(0x002, 7, 0); } } while (0)
#define KSWZ64(row, colB) ((row) * 128 + ((colB) ^ ((((row) >> 1) & 7) << 4)))
__device__ __forceinline__ int crow(int r, int hi) { return (r & 3) + 8 * (r >> 2) + 4 * hi; }
__device__ __forceinline__ unsigned cvtpk(float lo, float hi) { return pk2(lo, hi); }

template <int VAR = 0> __device__ __forceinline__ void partialSM(f32x16& p0, f32x16& p1, float& m_reg, f32x16& negm, float& alpha) {
    float mx[4];
#pragma unroll
    for (int c = 0; c < 4; ++c) mx[c] = fmaxf(fmaxf(p0[4 * c], p0[4 * c + 1]), fmaxf(p0[4 * c + 2], p0[4 * c + 3]));
#pragma unroll
    for (int c = 0; c < 4; ++c) mx[c] = fmaxf(mx[c], fmaxf(fmaxf(p1[4 * c], p1[4 * c + 1]), fmaxf(p1[4 * c + 2], p1[4 * c + 3])));
    float pmax = fmaxf(fmaxf(mx[0], mx[1]), fmaxf(mx[2], mx[3]));
    { auto rr = __builtin_amdgcn_permlane32_swap(__float_as_uint(pmax), __float_as_uint(pmax), false, false); pmax = fmaxf(__uint_as_float(rr[0]), __uint_as_float(rr[1])); }
    alpha = 1.f; m_reg = pmax;
#pragma unroll
    for (int r = 0; r < 16; ++r) { negm[r] = -pmax; p0[r] = __builtin_amdgcn_exp2f(p0[r] - pmax); p1[r] = __builtin_amdgcn_exp2f(p1[r] - pmax); }
}
template <int VAR = 0> __device__ __forceinline__ void finishSM(f32x16& p0, f32x16& p1, float alpha, float& l_reg, bf16x8& pa0, bf16x8& pa1, bf16x8& pa2, bf16x8& pa3) {
    if (VAR != 2) {
    f32x2 s2[4];
#pragma unroll
    for (int c = 0; c < 4; ++c) s2[c] = (f32x2){p0[4 * c], p0[4 * c + 1]} + (f32x2){p0[4 * c + 2], p0[4 * c + 3]};
#pragma unroll
    for (int c = 0; c < 4; ++c) s2[c] = s2[c] + ((f32x2){p1[4 * c], p1[4 * c + 1]} + (f32x2){p1[4 * c + 2], p1[4 * c + 3]});
    const f32x2 s2t = (s2[0] + s2[1]) + (s2[2] + s2[3]);
    float ps = s2t[0] + s2t[1];
    { auto rr = __builtin_amdgcn_permlane32_swap(__float_as_uint(ps), __float_as_uint(ps), false, false); ps = __uint_as_float(rr[0]) + __uint_as_float(rr[1]); }
    l_reg = l_reg * alpha + ps;
    } else { l_reg = 1.f; }
#define ATT_PK4(P, BASE, OUT) do { u32x4 w = {cvtpk(P[BASE + 0], P[BASE + 1]), cvtpk(P[BASE + 2], P[BASE + 3]), cvtpk(P[BASE + 4], P[BASE + 5]), cvtpk(P[BASE + 6], P[BASE + 7])}; OUT = *reinterpret_cast<bf16x8*>(&w); } while (0)
    ATT_PK4(p0, 0, pa0); ATT_PK4(p0, 8, pa1); ATT_PK4(p1, 0, pa2); ATT_PK4(p1, 8, pa3);
#undef ATT_PK4
}
__device__ __forceinline__ void qkt(f32x16& p0, f32x16& p1, const char* Ks, const bf16x8* qr, const f32x16& negm, int r32, int hi) {
#pragma unroll
    for (int d0 = 0; d0 < 4; ++d0) { const int cb = (d0 * 16 + hi * 8) * 2;
        const bf16x8 b0 = *reinterpret_cast<const bf16x8*>(Ks + KSWZ64(r32, cb));
        const bf16x8 b1 = *reinterpret_cast<const bf16x8*>(Ks + KSWZ64(32 + r32, cb));
        if (d0 == 0) { p0 = __builtin_amdgcn_mfma_f32_32x32x16_bf16(b0, qr[0], negm, 0, 0, 0); p1 = __builtin_amdgcn_mfma_f32_32x32x16_bf16(b1, qr[0], negm, 0, 0, 0); }
        else { p0 = __builtin_amdgcn_mfma_f32_32x32x16_bf16(b0, qr[d0], p0, 0, 0, 0); p1 = __builtin_amdgcn_mfma_f32_32x32x16_bf16(b1, qr[d0], p1, 0, 0, 0); } }
}
__device__ __forceinline__ int v_st(int k, int c) { const int kk = (k & ~0xC) | ((k & 4) << 1) | ((k & 8) >> 1); return ((kk >> 3) * 4 + (c >> 5)) * 512 + ((kk & 7) * 32 + (c & 31)) * 2; }
__device__ __forceinline__ int v_rd_base(int lane) { return ((lane & 3) << 3) | (((lane >> 2) & 3) << 6) | (((lane >> 4) & 1) << 5) | (((lane >> 5) & 1) << 8); }
constexpr int v_rd_off(int d0, int ks, int half) { return d0 * 512 + ks * 4096 + half * 2048; }
typedef short v4i16a_t __attribute__((ext_vector_type(4)));
template <int OFF> __device__ __forceinline__ s16x4 tr_read(int vb) { return __builtin_bit_cast(s16x4, __builtin_amdgcn_ds_read_tr16_b64_v4i16((LAS v4i16a_t*)(unsigned)(vb + OFF))); }
#define ATT_PK(L, H) (bf16x8){L[0], L[1], L[2], L[3], H[0], H[1], H[2], H[3]}
template <int D0> __device__ __forceinline__ void pv_one(f32x16& od, int vb, bf16x8 pa0, bf16x8 pa1, bf16x8 pa2, bf16x8 pa3) {
    const s16x4 l0 = tr_read<v_rd_off(D0, 0, 0)>(vb), h0 = tr_read<v_rd_off(D0, 0, 1)>(vb), l1 = tr_read<v_rd_off(D0, 1, 0)>(vb), h1 = tr_read<v_rd_off(D0, 1, 1)>(vb);
    const s16x4 l2 = tr_read<v_rd_off(D0, 2, 0)>(vb), h2 = tr_read<v_rd_off(D0, 2, 1)>(vb), l3 = tr_read<v_rd_off(D0, 3, 0)>(vb), h3 = tr_read<v_rd_off(D0, 3, 1)>(vb);
    od = __builtin_amdgcn_mfma_f32_32x32x16_bf16(pa0, ATT_PK(l0, h0), od, 0, 0, 0);
    od = __builtin_amdgcn_mfma_f32_32x32x16_bf16(pa1, ATT_PK(l1, h1), od, 0, 0, 0);
    od = __builtin_amdgcn_mfma_f32_32x32x16_bf16(pa2, ATT_PK(l2, h2), od, 0, 0, 0);
    od = __builtin_amdgcn_mfma_f32_32x32x16_bf16(pa3, ATT_PK(l3, h3), od, 0, 0, 0);
}
#undef ATT_PK
__device__ __forceinline__ void pv_d0(f32x16* o, int vb, bf16x8 pa0, bf16x8 pa1, bf16x8 pa2, bf16x8 pa3) {
    pv_one<0>(o[0], vb, pa0, pa1, pa2, pa3); pv_one<1>(o[1], vb, pa0, pa1, pa2, pa3); pv_one<2>(o[2], vb, pa0, pa1, pa2, pa3); pv_one<3>(o[3], vb, pa0, pa1, pa2, pa3);
}
struct VH { bf16x8 k0, k1; };
__device__ __forceinline__ void vhalf(bf16x8& d, s16x4 lo, s16x4 hi) { d = __builtin_shufflevector(lo, hi, 0, 1, 2, 3, 4, 5, 6, 7); }
template <int D0, int KS0> __device__ __forceinline__ void vh_load(VH& f, int vb) {
    vhalf(f.k0, tr_read<v_rd_off(D0, KS0, 0)>(vb), tr_read<v_rd_off(D0, KS0, 1)>(vb)); vhalf(f.k1, tr_read<v_rd_off(D0, KS0 + 1, 0)>(vb), tr_read<v_rd_off(D0, KS0 + 1, 1)>(vb));
}
#define ATT_PKV(L, H) (bf16x8){L[0], L[1], L[2], L[3], H[0], H[1], H[2], H[3]}
#define ATT_E3(P, B) do { P[B] = __builtin_amdgcn_exp2f(P[B]); P[(B) + 1] = __builtin_amdgcn_exp2f(P[(B) + 1]); P[(B) + 2] = __builtin_amdgcn_exp2f(P[(B) + 2]); } while (0)
#define ATT_MM(D, PA, FR) o[D] = __builtin_amdgcn_mfma_f32_32x32x16_bf16(PA, FR, o[D], 0, 0, 0)
#define ATT_PIN(x) asm volatile("" : "+v"(x))
__device__ __forceinline__ void pv_partial(f32x16* o, int vb, bf16x8 pa0, bf16x8 pa1, bf16x8 pa2, bf16x8 pa3, f32x16& p0, f32x16& p1, float& m_reg, f32x16& negm, float& alpha) {
    VH fa, fb; float mx[4];
    vh_load<0, 0>(fa, vb); vh_load<0, 2>(fb, vb);
    ATT_SBAR();
    ATT_MM(0, pa0, fa.k0);
    mx[0] = fmaxf(fmaxf(p0[0], p0[1]), p0[2]); mx[1] = fmaxf(fmaxf(p0[3], p0[4]), p0[5]); mx[2] = fmaxf(fmaxf(p0[6], p0[7]), p0[8]); mx[3] = fmaxf(fmaxf(p0[9], p0[10]), p0[11]); ATT_PIN(mx[0]); ATT_PIN(mx[1]); ATT_PIN(mx[2]); ATT_PIN(mx[3]); ATT_SBAR();
    ATT_MM(0, pa1, fa.k1); vh_load<1, 0>(fa, vb);
    mx[0] = fmaxf(fmaxf(mx[0], p0[12]), p0[13]); mx[1] = fmaxf(fmaxf(mx[1], p0[14]), p0[15]); mx[2] = fmaxf(fmaxf(mx[2], p1[0]), p1[1]); mx[3] = fmaxf(fmaxf(mx[3], p1[2]), p1[3]); ATT_PIN(mx[0]); ATT_PIN(mx[1]); ATT_PIN(mx[2]); ATT_PIN(mx[3]); ATT_SBAR();
    ATT_MM(0, pa2, fb.k0);
    mx[0] = fmaxf(fmaxf(mx[0], p1[4]), p1[5]); mx[1] = fmaxf(fmaxf(mx[1], p1[6]), p1[7]); mx[2] = fmaxf(fmaxf(mx[2], p1[8]), p1[9]); mx[3] = fmaxf(fmaxf(mx[3], p1[10]), p1[11]); ATT_PIN(mx[0]); ATT_PIN(mx[1]); ATT_PIN(mx[2]); ATT_PIN(mx[3]); ATT_SBAR();
    ATT_MM(0, pa3, fb.k1); vh_load<1, 2>(fb, vb);
    mx[0] = fmaxf(fmaxf(mx[0], p1[12]), p1[13]); mx[1] = fmaxf(fmaxf(mx[1], p1[14]), p1[15]); ATT_PIN(mx[0]); ATT_PIN(mx[1]); ATT_SBAR();
    ATT_MM(1, pa0, fa.k0);
    { float pmax = fmaxf(fmaxf(mx[0], mx[1]), fmaxf(mx[2], mx[3]));
      auto rr = __builtin_amdgcn_permlane32_swap(__float_as_uint(pmax), __float_as_uint(pmax), false, false); pmax = fmaxf(__uint_as_float(rr[0]), __uint_as_float(rr[1]));
      const bool need = pmax > THR; alpha = 1.f;
      if (__any(need)) { const float delta = need ? pmax : 0.f; alpha = __builtin_amdgcn_exp2f(-delta); m_reg += delta;
#pragma unroll
          for (int r = 0; r < 16; ++r) { p0[r] -= delta; p1[r] -= delta; negm[r] -= delta; } } } ATT_PIN(alpha); ATT_SBAR();
    ATT_MM(1, pa1, fa.k1); vh_load<2, 0>(fa, vb); ATT_E3(p0, 0); ATT_PIN(p0); ATT_SBAR();
    ATT_MM(1, pa2, fb.k0); ATT_E3(p0, 3); ATT_PIN(p0); ATT_SBAR();
    ATT_MM(1, pa3, fb.k1); vh_load<2, 2>(fb, vb); ATT_E3(p0, 6); ATT_PIN(p0); ATT_SBAR();
    ATT_MM(2, pa0, fa.k0); ATT_E3(p0, 9); ATT_PIN(p0); ATT_SBAR();
    ATT_MM(2, pa1, fa.k1); vh_load<3, 0>(fa, vb); ATT_E3(p0, 12); ATT_PIN(p0); ATT_SBAR();
    ATT_MM(2, pa2, fb.k0); p0[15] = __builtin_amdgcn_exp2f(p0[15]); p1[0] = __builtin_amdgcn_exp2f(p1[0]); p1[1] = __builtin_amdgcn_exp2f(p1[1]); ATT_PIN(p0); ATT_PIN(p1); ATT_SBAR();
    ATT_MM(2, pa3, fb.k1); vh_load<3, 2>(fb, vb); ATT_E3(p1, 2); ATT_PIN(p1); ATT_SBAR();
    ATT_MM(3, pa0, fa.k0); ATT_E3(p1, 5); ATT_PIN(p1); ATT_SBAR();
    ATT_MM(3, pa1, fa.k1); ATT_E3(p1, 8); ATT_PIN(p1); ATT_SBAR();
    ATT_MM(3, pa2, fb.k0); ATT_E3(p1, 11); ATT_PIN(p1); ATT_SBAR();
    ATT_MM(3, pa3, fb.k1); p1[14] = __builtin_amdgcn_exp2f(p1[14]); p1[15] = __builtin_amdgcn_exp2f(p1[15]); ATT_PIN(p1); ATT_SBAR();
}
#undef ATT_MM
#undef ATT_PIN
#undef ATT_E3
#undef ATT_PKV
typedef int v8i_a __attribute__((ext_vector_type(8)));
typedef int v4i_a __attribute__((ext_vector_type(4)));
__device__ __forceinline__ v8i_a v8_frag(unsigned a0, unsigned a1) {
    const v4i_a lo = *(const LAS v4i_a*)a0, hi = *(const LAS v4i_a*)a1; return __builtin_shufflevector(lo, hi, 0, 1, 2, 3, 4, 5, 6, 7); }
#define ATT_MM8(D, FR) asm volatile("v_mfma_scale_f32_32x32x64_f8f6f4 %0, %1, %2, %0, %3, %3 op_sel_hi:[0,0,0]" : "+v"(o[D]) : "v"(pa8), "v"(FR), "v"(one8))
#define ATT_PIN8(x) asm volatile("" : "+v"(x))
#define ATT_EX(P, B) P[B] = __builtin_amdgcn_exp2f(P[B])
__device__ __forceinline__ void pv8_partial(f32x16* o, unsigned va0, unsigned va1, v8i_a pa8, f32x16& p0, f32x16& p1, float& m_reg, f32x16& negm, float& alpha) {
    const int one8 = 0x7f7f7f7f;
    float mx[4];
    const v8i_a f0 = v8_frag(va0, va1), f1 = v8_frag(va0 + 2048, va1 + 2048), f2 = v8_frag(va0 + 4096, va1 + 4096), f3 = v8_frag(va0 + 6144, va1 + 6144);
    ATT_SBAR();
    ATT_MM8(0, f0);
    mx[0] = fmaxf(fmaxf(p0[0], p0[1]), p0[2]); mx[1] = fmaxf(fmaxf(p0[3], p0[4]), p0[5]); mx[2] = fmaxf(fmaxf(p0[6], p0[7]), p0[8]); mx[3] = fmaxf(fmaxf(p0[9], p0[10]), p0[11]);
    mx[0] = fmaxf(fmaxf(mx[0], p0[12]), p0[13]); mx[1] = fmaxf(fmaxf(mx[1], p0[14]), p0[15]); mx[2] = fmaxf(fmaxf(mx[2], p1[0]), p1[1]); mx[3] = fmaxf(fmaxf(mx[3], p1[2]), p1[3]);
    mx[0] = fmaxf(fmaxf(mx[0], p1[4]), p1[5]); mx[1] = fmaxf(fmaxf(mx[1], p1[6]), p1[7]); mx[2] = fmaxf(fmaxf(mx[2], p1[8]), p1[9]); mx[3] = fmaxf(fmaxf(mx[3], p1[10]), p1[11]);
    mx[0] = fmaxf(fmaxf(mx[0], p1[12]), p1[13]); mx[1] = fmaxf(fmaxf(mx[1], p1[14]), p1[15]);
    { float pmax = fmaxf(fmaxf(mx[0], mx[1]), fmaxf(mx[2], mx[3]));
      auto rr = __builtin_amdgcn_permlane32_swap(__float_as_uint(pmax), __float_as_uint(pmax), false, false); pmax = fmaxf(__uint_as_float(rr[0]), __uint_as_float(rr[1]));
      const bool need = pmax > THR; alpha = 1.f;
      if (__any(need)) { const float delta = need ? pmax : 0.f; alpha = __builtin_amdgcn_exp2f(-delta); m_reg += delta;
#pragma unroll
          for (int r = 0; r < 16; ++r) { p0[r] -= delta; p1[r] -= delta; negm[r] -= delta; } } } ATT_PIN8(alpha); ATT_SBAR();
    ATT_MM8(1, f1);
    ATT_EX(p0, 0); ATT_EX(p0, 1); ATT_EX(p0, 2); ATT_EX(p0, 3); ATT_EX(p0, 4); ATT_EX(p0, 5); ATT_EX(p0, 6); ATT_EX(p0, 7); ATT_EX(p0, 8); ATT_EX(p0, 9); ATT_EX(p0, 10); ATT_PIN8(p0); ATT_SBAR();
    ATT_MM8(2, f2);
    ATT_EX(p0, 11); ATT_EX(p0, 12); ATT_EX(p0, 13); ATT_EX(p0, 14); ATT_EX(p0, 15); ATT_EX(p1, 0); ATT_EX(p1, 1); ATT_EX(p1, 2); ATT_EX(p1, 3); ATT_EX(p1, 4); ATT_EX(p1, 5); ATT_PIN8(p0); ATT_PIN8(p1); ATT_SBAR();
    ATT_MM8(3, f3);
    ATT_EX(p1, 6); ATT_EX(p1, 7); ATT_EX(p1, 8); ATT_EX(p1, 9); ATT_EX(p1, 10); ATT_EX(p1, 11); ATT_EX(p1, 12); ATT_EX(p1, 13); ATT_EX(p1, 14); ATT_EX(p1, 15); ATT_PIN8(p1); ATT_SBAR();
    asm volatile("s_nop 15\n\ts_nop 15" ::: "memory");
}
#undef ATT_EX
__device__ __forceinline__ void finishSM8(f32x16& p0, f32x16& p1, float alpha, float& l_reg, v8i_a& pa8) {
    f32x2 s2[4];
#pragma unroll
    for (int c = 0; c < 4; ++c) s2[c] = (f32x2){p0[4 * c], p0[4 * c + 1]} + (f32x2){p0[4 * c + 2], p0[4 * c + 3]};
#pragma unroll
    for (int c = 0; c < 4; ++c) s2[c] = s2[c] + ((f32x2){p1[4 * c], p1[4 * c + 1]} + (f32x2){p1[4 * c + 2], p1[4 * c + 3]});
    const f32x2 s2t = (s2[0] + s2[1]) + (s2[2] + s2[3]);
    float ps = s2t[0] + s2t[1];
    { auto rr = __builtin_amdgcn_permlane32_swap(__float_as_uint(ps), __float_as_uint(ps), false, false); ps = __uint_as_float(rr[0]) + __uint_as_float(rr[1]); }
    l_reg = l_reg * alpha + ps;
#pragma unroll
    for (int q = 0; q < 4; ++q) { int w0 = 0, w1 = 0;
        w0 = __builtin_amdgcn_cvt_pk_fp8_f32(p0[4 * q], p0[4 * q + 1], w0, false); w0 = __builtin_amdgcn_cvt_pk_fp8_f32(p0[4 * q + 2], p0[4 * q + 3], w0, true);
        w1 = __builtin_amdgcn_cvt_pk_fp8_f32(p1[4 * q], p1[4 * q + 1], w1, false); w1 = __builtin_amdgcn_cvt_pk_fp8_f32(p1[4 * q + 2], p1[4 * q + 3], w1, true);
        pa8[q] = w0; pa8[4 + q] = w1; }
}
__device__ __forceinline__ size_t kvrow(int b, int t) { return t < 64 ? (size_t)b * SEQ + (size_t)t * 64 : (size_t)NLAT + (size_t)b * CTXL + (size_t)(t - 64) * 64; }

__device__ __forceinline__ void glds16(const void* gsrc, unsigned lds_dst) { unsigned keep;
    asm volatile("s_mov_b32 %0, m0\n\ts_mov_b32 m0, %2\n\ts_nop 0\n\tglobal_load_lds_dwordx4 %1, off\n\ts_mov_b32 m0, %0" : "=&s"(keep) : "v"(gsrc), "s"(lds_dst) : "memory"); }
template <int VAR> __device__ __forceinline__ void head_pass(const bf16* __restrict__ Q1, const bf16* __restrict__ K1, const unsigned char* __restrict__ V8, int b, int qh, int hp, size_t qrow0, char* lds, f32x16 (&o)[4], float& l_out) {
    int tid_ = threadIdx.x; asm volatile("" : "+v"(tid_));
    const int tid = tid_, wid = __builtin_amdgcn_readfirstlane(tid >> 6), lane = tid & 63, r32 = lane & 31, hi = lane >> 5;
    char* V_lds = lds + OFF_V; char* K_lds = lds + OFF_K;
    float* wsf = (float*)(lds + OFF_WS) + wid * 64; float* al_l = wsf + 32;
    float m_reg = 0.f, l_reg = 0.f; f32x16 negm = f32x16{};
#pragma unroll
    for (int d = 0; d < 4; ++d) o[d] = f32x16{};
    const bf16* Kh = K1 + (size_t)qh * MALL * 64; const unsigned char* Vh = V8 + (size_t)hp * NVTILE * SHM_V;
    const int kr = 8 * wid + (lane >> 3); const unsigned koff = (unsigned)(kr * 128 + (((lane & 7) ^ ((kr >> 1) & 7)) << 4));
    const unsigned lbase = (unsigned)(uintptr_t)lds;
#define ATT_ISSUE(t_, ks_, vs_) do { const int tt_ = (t_); const size_t rb_ = kvrow(b, tt_); const char* kb_ = (const char*)(Kh + rb_ * 64); \
    const unsigned char* vb_ = Vh + (size_t)(tt_ < 64 ? b * 64 + tt_ : 512 + 4 * b + (tt_ - 64)) * SHM_V; \
    glds16(kb_ + koff, (unsigned)__builtin_amdgcn_readfirstlane(lbase + OFF_K + (ks_) * SHM_K + wid * 1024)); \
    glds16(vb_ + wid * 1024 + lane * 16, (unsigned)__builtin_amdgcn_readfirstlane(lbase + OFF_V + (vs_) * SHM_V + wid * 1024)); } while (0)
#define ATT_WAITBAR(N) do { asm volatile("s_waitcnt vmcnt(" #N ")" ::: "memory"); __builtin_amdgcn_s_barrier(); asm volatile("" ::: "memory"); } while (0)
#define ATT_RESC(al) do { if (__any((al) < 1.f)) { if (hi == 0) al_l[r32] = (al); asm volatile("s_waitcnt lgkmcnt(0)" ::: "memory"); \
    _Pragma("unroll") for (int d = 0; d < 4; ++d) _Pragma("unroll") for (int r = 0; r < 16; ++r) o[d][r] *= al_l[crow(r, hi)]; } } while (0)
    bf16x8 qr[4];
    const bf16* Qw = Q1 + ((size_t)qh * MALL + qrow0 + wid * 32 + r32) * 64 + hi * 8;
#pragma unroll
    for (int d0 = 0; d0 < 4; ++d0) qr[d0] = *reinterpret_cast<const bf16x8*>(Qw + d0 * 16);
    const unsigned vsw = (unsigned)((r32 >> 2) & 3);
    const unsigned va0_ = (unsigned)(uintptr_t)V_lds + (unsigned)(r32 * 64) + (((2u * hi) ^ vsw) << 4), va1_ = (unsigned)(uintptr_t)V_lds + (unsigned)(r32 * 64) + (((2u * hi + 1u) ^ vsw) << 4);
    f32x16 pA0, pA1, pB0, pB1; float alA = 1.f, alB = 1.f; v8i_a pa8;
    int kq = 1, ki = 2, vA = 0, vB = 3, vi = 2;
#define ATT_ADV() do { kq = ki; ki = (ki == 2) ? 0 : ki + 1; vB = vA; vA = (vA + 1) & 3; vi = (vi + 1) & 3; } while (0)
    ATT_ISSUE(0, 0, 0); ATT_ISSUE(1, 1, 1);
    ATT_WAITBAR(2);
    {
        qkt(pA0, pA1, K_lds, qr, negm, r32, hi); partialSM<VAR>(pA0, pA1, m_reg, negm, alA);
        ATT_WAITBAR(1);
#define ATT_STEP_A(PC0, PC1, ALC, PN0, PN1, ALN, j_) do { \
        ATT_ISSUE((j_) + 2, ki, vi); \
        ATT_SBAR(); qkt(PN0, PN1, K_lds + kq * SHM_K, qr, negm, r32, hi); \
        finishSM8(PC0, PC1, ALC, l_reg, pa8); ATT_SBAR(); \
        pv8_partial(o, va0_ + vA * SHM_V, va1_ + vA * SHM_V, pa8, PN0, PN1, m_reg, negm, ALN); \
        ATT_RESC(ALN); \
        ATT_WAITBAR(1); ATT_ADV(); } while (0)
        for (int j = 0; j + 2 < NT; j += 2) {
            ATT_STEP_A(pA0, pA1, alA, pB0, pB1, alB, j);
            ATT_STEP_A(pB0, pB1, alB, pA0, pA1, alA, j + 1);
        }
        ATT_SBAR(); qkt(pB0, pB1, K_lds + kq * SHM_K, qr, negm, r32, hi);
        finishSM8(pA0, pA1, alA, l_reg, pa8); ATT_SBAR();
        pv8_partial(o, va0_ + vA * SHM_V, va1_ + vA * SHM_V, pa8, pB0, pB1, m_reg, negm, alB);
        ATT_RESC(alB);
        ATT_WAITBAR(0);
        finishSM8(pB0, pB1, alB, l_reg, pa8); ATT_SBAR();
        { const unsigned s_ = (unsigned)(((vA + 1) & 3) * SHM_V); const int one8 = 0x7f7f7f7f;
          const v8i_a f0 = v8_frag(va0_ + s_, va1_ + s_), f1 = v8_frag(va0_ + s_ + 2048, va1_ + s_ + 2048), f2 = v8_frag(va0_ + s_ + 4096, va1_ + s_ + 4096), f3 = v8_frag(va0_ + s_ + 6144, va1_ + s_ + 6144);
          ATT_SBAR(); ATT_MM8(0, f0); ATT_MM8(1, f1); ATT_MM8(2, f2); ATT_MM8(3, f3); asm volatile("s_nop 15\n\ts_nop 15" ::: "memory"); }
#undef ATT_STEP_A
    }
    l_out = l_reg;
    asm volatile("s_waitcnt lgkmcnt(0)" ::: "memory"); __builtin_amdgcn_s_barrier(); asm volatile("" ::: "memory");
#undef ATT_ADV
#undef ATT_ISSUE
#undef ATT_WAITBAR
#undef ATT_RESC
}

template <int VAR> __device__ __forceinline__ void attn_unit(const bf16* __restrict__ Q1, const bf16* __restrict__ K1, const unsigned char* __restrict__ V1, bf16* __restrict__ ao, int b, int hp, int qb, char* lds, const float* lamp, const float* subln) {
    int tid_ = threadIdx.x; asm volatile("" : "+v"(tid_));
    const int tid = tid_, wid = tid >> 6, lane = tid & 63, r32 = lane & 31, hi = lane >> 5;
    float* wsf = (float*)(lds + OFF_WS) + wid * 64;
    unsigned* o1s = (unsigned*)(lds + OFF_O1 + wid * 8192);
    const size_t qrow0 = (size_t)b * SEQ + (size_t)qb * 256;
    f32x16 o[4]; float l;
    float ssq[16];
#pragma unroll 1
    for (int hh = 0; hh < 2; ++hh) {
        head_pass<VAR>(Q1, K1, V1, b, 2 * hp + hh, hp, qrow0, lds, o, l);
        if (hi == 0) wsf[r32] = l; asm volatile("s_waitcnt lgkmcnt(0)" ::: "memory");
        float rli[16];
#pragma unroll
        for (int r = 0; r < 16; ++r) { rli[r] = __builtin_amdgcn_rcpf(wsf[crow(r, hi)]); ssq[r] = 0.f; }
        if (hh == 0) {
#pragma unroll
            for (int d0 = 0; d0 < 4; ++d0)
#pragma unroll
                for (int r = 0; r < 16; r += 2) o1s[(d0 * 8 + (r >> 1)) * 64 + lane] = cvtpk(o[d0][r] * rli[r], o[d0][r + 1] * rli[r + 1]);
            __syncthreads();
        } else {
            asm volatile("" : "+s"(lamp)); const float lam = *lamp;
#pragma unroll
            for (int d0 = 0; d0 < 4; ++d0)
#pragma unroll
                for (int r = 0; r < 16; r += 2) { const unsigned w = o1s[(d0 * 8 + (r >> 1)) * 64 + lane];
                    const float a0 = bflo(w) - lam * (o[d0][r] * rli[r]), a1 = bfhi(w) - lam * (o[d0][r + 1] * rli[r + 1]);
                    o[d0][r] = a0; o[d0][r + 1] = a1; ssq[r] += a0 * a0; ssq[r + 1] += a1 * a1; }
        }
    }
#pragma unroll
    for (int r = 0; r < 16; ++r) { float s = ssq[r];
        s += __shfl_xor(s, 1); s += __shfl_xor(s, 2); s += __shfl_xor(s, 4); s += __shfl_xor(s, 8); s += __shfl_xor(s, 16);
        ssq[r] = 1.0f / sqrtf(s * (1.0f / 128.0f) + EPS) * (1.0f - LAMBDA_INIT); }
    asm volatile("s_waitcnt lgkmcnt(0)" ::: "memory");
    bf16* stg = (bf16*)o1s;
    asm volatile("" : "+s"(subln));
#pragma unroll
    for (int d0 = 0; d0 < 4; ++d0) { const float g = subln[d0 * 32 + r32];
#pragma unroll
        for (int r = 0; r < 16; ++r) stg[crow(r, hi) * 128 + d0 * 32 + r32] = (bf16)f2bf(o[d0][r] * ssq[r] * g); }
    asm volatile("s_waitcnt lgkmcnt(0)" ::: "memory");
    bf16* Ow = ao + (qrow0 + wid * 32) * D + hp * 128;
#pragma unroll
    for (int i = 0; i < 8; ++i) { const int row = i * 4 + (lane >> 4), ch = lane & 15; const u32x4 v = *(const u32x4*)(stg + row * 128 + ch * 8); *(u32x4*)(Ow + (size_t)row * D + ch * 8) = v; }
    asm volatile("s_waitcnt lgkmcnt(0)" ::: "memory");
    __syncthreads();
}
#undef ATT_SBAR
}

__device__ __forceinline__ void v8_prep(Frame& F) {
    const bf16* V1 = (const bf16*)(F.ws + WS_VH1); unsigned char* V8 = (unsigned char*)(F.ws + WS_V8);
    LAS bf16* buf = (LAS bf16*)(F.lds + F.wave * 16384);
    const int gw = F.vcu * NWAVES + F.wave, NGW = F.G * NWAVES, lane = F.lane;
    for (int it = gw; it < 8 * att::NVTILE; it += NGW) {
        const int hv = it / att::NVTILE, tile = it % att::NVTILE;
        const bf16* src = V1 + ((size_t)hv * MALL + (size_t)tile * 64) * 128;
#pragma unroll
        for (int i = 0; i < 16; ++i) *(LAS v4u*)(buf + i * 512 + lane * 8) = *(const GAS v4u*)(src + i * 512 + lane * 8);
        LDS_WAIT(); asm volatile("" ::: "memory");
        unsigned char* dst = V8 + (size_t)it * att::SHM_V;
#pragma unroll
        for (int cc = 0; cc < 2; ++cc) { const int n = lane + 64 * cc; const int sw = (n >> 2) & 3;
#pragma unroll
            for (int c = 0; c < 4; ++c) { const int kb = c >> 1, half = c & 1; v4u w;
#pragma unroll
                for (int q = 0; q < 4; ++q) { const int key0 = 32 * half + 8 * q + 4 * kb;
                    w[q] = pk4_fp8(bf2f(buf[(key0 + 0) * 128 + n]), bf2f(buf[(key0 + 1) * 128 + n]), bf2f(buf[(key0 + 2) * 128 + n]), bf2f(buf[(key0 + 3) * 128 + n])); }
                *(GAS v4u*)(dst + n * 64 + ((c ^ sw) << 4)) = w; } }
        LDS_WAIT(); asm volatile("" ::: "memory");
    }
}

template <int VAR> __device__ __forceinline__ void attn_phase(Frame& F, const Args& a, bf16* ao) {
    const bf16* Q1 = (const bf16*)(F.ws + WS_QH1); const bf16* K1 = (const bf16*)(F.ws + WS_KH1); const unsigned char* V1 = (const unsigned char*)(F.ws + WS_V8);
    const float* lamp = (const float*)(F.ws + WS_LAM);
    for (int unit = F.vcu; unit < NBATCH * 8 * 16; unit += F.G) {
        const int qb = unit & 15, hp = (unit >> 4) & 7, b = unit >> 7;
        att::attn_unit<VAR>(Q1, K1, V1, ao, b, hp, qb, (char*)F.lds, lamp, a.in[I_L1_SUBLN]);
    }
}


namespace ret {
using s16x4  = __attribute__((ext_vector_type(4))) short;
using f32x16 = __attribute__((ext_vector_type(16))) float;
typedef short v4i16_t __attribute__((ext_vector_type(4)));
constexpr int C = 32, NSTEP = (SEQ + CTXL) / C;
constexpr int ST_Q = 0, ST_K = 16384, ST_V = 32768, ST_SC = 40960, ST_BYTES = 43008, NSTAGE = 3;
constexpr int XBUF_OFF = NSTAGE * ST_BYTES, RET_LDS = XBUF_OFF + NWAVES * 4096;
constexpr size_t WS_SSQ = 836 * MiB;
constexpr size_t WS_SC = 842 * MiB;

__device__ __forceinline__ void glds16(const void* gsrc, unsigned lds_dst) { unsigned keep;
    asm volatile("s_mov_b32 %0, m0\n\ts_mov_b32 m0, %2\n\ts_nop 0\n\tglobal_load_lds_dwordx4 %1, off\n\ts_mov_b32 m0, %0" : "=&s"(keep) : "v"(gsrc), "s"(lds_dst) : "memory"); }
__device__ __forceinline__ s16x4 vtr(const LAS char* p) { return __builtin_bit_cast(s16x4, __builtin_amdgcn_ds_read_tr16_b64_v4i16((LAS v4i16_t*)p)); }

__device__ __forceinline__ void ret_scores(Frame& F) {
    const bf16* Qh = (const bf16*)(F.ws + WS_QH0); const bf16* Kh = (const bf16*)(F.ws + WS_KH0); bf16* sc = (bf16*)(F.ws + WS_SC);
    const int gw = F.vcu * NWAVES + F.wave, NGW = F.G * NWAVES;
    const int r32 = F.lane & 31, hh = F.lane >> 5;
    for (int task = gw; task < (MALL / C) * RH; task += NGW) {
        const int h = task & 3, ch = task >> 2;
        const bf16* qp = Qh + ((size_t)h * MALL + (size_t)ch * C + r32) * 256 + hh * 8;
        const bf16* kp = Kh + ((size_t)h * MALL + (size_t)ch * C + r32) * 256 + hh * 8;
        f32x16 acc = f32x16{};
        bf16x8 a[16], b[16];
#pragma unroll
        for (int s = 0; s < 16; ++s) { a[s] = *reinterpret_cast<const bf16x8*>(qp + s * 16); b[s] = *reinterpret_cast<const bf16x8*>(kp + s * 16); }
#pragma unroll
        for (int s = 0; s < 16; ++s) acc = __builtin_amdgcn_mfma_f32_32x32x16_bf16(a[s], b[s], acc, 0, 0, 0);
        bf16* tp = sc + (size_t)task * 1024;
#pragma unroll
        for (int r = 0; r < 16; ++r) { const int i = (r & 3) + 8 * (r >> 2) + 4 * hh; tp[i * 32 + r32] = (bf16)f2bf(acc[r]); }
    }
}

__device__ __forceinline__ size_t step_row0(int b, int dir, int t) {
    if (t < 8) { const int blk = dir ? 7 - t : t; return (size_t)NLAT + (size_t)b * CTXL + (size_t)blk * C; }
    const int blk = dir ? 127 - (t - 8) : (t - 8); return (size_t)b * SEQ + (size_t)blk * C;
}

template <int SV = 0> __device__ __forceinline__ void ret_scan(Frame& F, const Args& a) {
    const char* qb = (const char*)(F.ws + WS_QH0); const char* kb = (const char*)(F.ws + WS_KH0); const char* vb = (const char*)(F.ws + WS_VQ0); const char* scb = (const char*)(F.ws + WS_SC);
    for (int unit = F.vcu; unit < NBATCH * RH * 2 * 4; unit += F.G) {
        int tid_ = threadIdx.x; asm volatile("" : "+v"(tid_));
        const int tid = tid_, lane = tid & 63, w = __builtin_amdgcn_readfirstlane(tid >> 6), dh = w >> 2, vs = w & 3, r32 = lane & 31, hh = lane >> 5;
        const int vq = unit & 3, dir = (unit >> 2) & 1, h = (unit >> 3) & 3, b = unit >> 5;
        const float logit = a.in[I_L0_DECAY][dir * RH + h];
        const float lg2 = -__builtin_amdgcn_logf(1.0f + __builtin_amdgcn_exp2f(-logit * LOG2E));
        const float gC = __builtin_amdgcn_exp2f(lg2 * (float)C), gCi = __builtin_amdgcn_exp2f(-lg2 * (float)C);
        float kd[2][8];
#pragma unroll
        for (int s = 0; s < 2; ++s)
#pragma unroll
            for (int jj = 0; jj < 8; ++jj) { const int j = 16 * s + 8 * hh + jj; kd[s][jj] = __builtin_amdgcn_exp2f(lg2 * (float)(dir ? j : 31 - j)); }
        const int om = 4 * w + (lane >> 4);
        const float rsc = __builtin_amdgcn_exp2f(-lg2 * (float)(dir ? om : 31 - om));
        unsigned pm[4];
#pragma unroll
        for (int e = 0; e < 4; ++e) { const int j0 = 16 * dh + 8 * hh + 2 * e, j1 = j0 + 1; const bool k0 = dir ? (j0 >= r32) : (j0 <= r32), k1 = dir ? (j1 >= r32) : (j1 <= r32);
            pm[e] = (k0 ? 0x0000ffffu : 0u) | (k1 ? 0xffff0000u : 0u); }
        unsigned offq[2], offk[2];
#pragma unroll
        for (int p = 0; p < 2; ++p) { const int i = 2 * (2 * w + p) + (lane >> 5), cp = lane & 31;
            offq[p] = (unsigned)(i * 512 + ((cp ^ (i & 15)) << 4)); offk[p] = (unsigned)(i * 512 + ((cp ^ ((i & 3) << 2)) << 4)); }
        unsigned offv; { const int j = 4 * w + (lane >> 4), cp = lane & 15; offv = (unsigned)(j * 256 + ((cp ^ ((j & 3) << 2)) << 4)); }
        const char* qhb = qb + (size_t)h * MALL * 512; const char* khb = kb + (size_t)h * MALL * 512; const char* vhb = vb + (size_t)(h * 4 + vq) * MALL * 256;
        unsigned offs; { const int i = 16 * (w & 1) + (lane >> 2), cp = lane & 3; offs = (unsigned)(i * 64 + ((cp ^ ((i >> 2) & 3)) << 4)); }
        LAS unsigned char* L = F.lds;
        const unsigned lbase = (unsigned)(uintptr_t)L;
#define RET_ISSUE(t_) do { const int t__ = (t_); const unsigned sb_ = lbase + (unsigned)((t__ % NSTAGE) * ST_BYTES); const size_t r0_ = step_row0(b, dir, t__); const char* gq_ = qhb + r0_ * 512; const char* gk_ = khb + r0_ * 512; const char* gv_ = vhb + r0_ * 256; \
        glds16(gq_ + offq[0], (unsigned)__builtin_amdgcn_readfirstlane(sb_ + ST_Q + (2 * w) * 1024)); \
        glds16(gq_ + offq[1], (unsigned)__builtin_amdgcn_readfirstlane(sb_ + ST_Q + (2 * w + 1) * 1024)); \
        glds16(gk_ + offk[0], (unsigned)__builtin_amdgcn_readfirstlane(sb_ + ST_K + (2 * w) * 1024)); \
        glds16(gk_ + offk[1], (unsigned)__builtin_amdgcn_readfirstlane(sb_ + ST_K + (2 * w + 1) * 1024)); \
        glds16(gv_ + offv, (unsigned)__builtin_amdgcn_readfirstlane(sb_ + ST_V + w * 1024)); \
        if (w < 2) glds16(scb + ((r0_ >> 5) * 4 + h) * 2048 + offs, (unsigned)__builtin_amdgcn_readfirstlane(sb_ + ST_SC + w * 1024)); } while (0)
        const int qrow = ST_Q + r32 * 512; const int qx = r32 & 15;
        const int G = lane >> 4, il = lane & 15, tq = il >> 2, tp = il & 3;
        const int kcolb = (128 * dh + 16 * (G & 1) + 8 * (tp & 1) + 4 * (tp >> 1)) * 2;
        const int vcolb = (32 * vs + 16 * (G & 1) + 4 * tp) * 2;
        f32x16 S[4];
#pragma unroll
        for (int T = 0; T < 4; ++T) S[T] = f32x16{};
        float cinv = 1.0f, cfw = 1.0f;
        bf16* outp = (bf16*)(F.ws + (dir ? WS_OB : WS_OF));
        float* ssqp = (float*)(F.ws + WS_SSQ);

        __builtin_amdgcn_s_barrier();
        if (SV != 2 && SV != 3) { RET_ISSUE(0); RET_ISSUE(1); }
        for (int t = 0; t < NSTEP; ++t) {
            if (t == 0) { if (w < 2) asm volatile("s_waitcnt vmcnt(6)" ::: "memory"); else asm volatile("s_waitcnt vmcnt(5)" ::: "memory"); }
            else if (t == NSTEP - 1) asm volatile("s_waitcnt vmcnt(4)" ::: "memory");
            else        { if (w < 2) asm volatile("s_waitcnt vmcnt(8)" ::: "memory"); else asm volatile("s_waitcnt vmcnt(7)" ::: "memory"); }
            __builtin_amdgcn_s_barrier(); asm volatile("" ::: "memory");
            if (SV != 2 && SV != 3) { if (t + 2 < NSTEP) RET_ISSUE(t + 2); }
            const LAS char* sb = (const LAS char*)(L + (t % NSTAGE) * ST_BYTES);
            f32x16 acc = f32x16{};
            if (SV != 1 && SV != 3) {
            cinv *= gCi; cfw *= gC;
            bf16x8 vd[2];
#pragma unroll
            for (int s = 0; s < 2; ++s) {
                const int j0 = 16 * s + 8 * (G >> 1) + tq;
                const int cph = (((vcolb >> 4) ^ (tq << 2)) << 4) + (vcolb & 8);
                const s16x4 lo = vtr(sb + ST_V + j0 * 256 + cph), hi = vtr(sb + ST_V + (j0 + 4) * 256 + cph);
                float f[8];
#pragma unroll
                for (int e = 0; e < 4; ++e) { f[e] = bf2f((unsigned short)lo[e]) * (kd[s][e] * cinv); f[4 + e] = bf2f((unsigned short)hi[e]) * (kd[s][4 + e] * cinv); }
                v4u pk; pk.x = pk2(f[0], f[1]); pk.y = pk2(f[2], f[3]); pk.z = pk2(f[4], f[5]); pk.w = pk2(f[6], f[7]);
                vd[s] = __builtin_bit_cast(bf16x8, pk);
            }
#pragma unroll
            for (int T = 0; T < 4; ++T)
#pragma unroll
                for (int s = 0; s < 2; ++s) {
                    const int cL = 16 * dh + 4 * T + 2 * s + hh;
                    const bf16x8 qa = *(const LAS bf16x8*)(sb + qrow + ((cL ^ qx) << 4));
                    v4u pk; pk.x = pk2(S[T][8 * s + 0], S[T][8 * s + 1]); pk.y = pk2(S[T][8 * s + 2], S[T][8 * s + 3]); pk.z = pk2(S[T][8 * s + 4], S[T][8 * s + 5]); pk.w = pk2(S[T][8 * s + 6], S[T][8 * s + 7]);
                    acc = __builtin_amdgcn_mfma_f32_32x32x16_bf16(qa, __builtin_bit_cast(bf16x8, pk), acc, 0, 0, 0);
                }
            {
                const int cL = 2 * dh + hh;
                v4u pw = *(const LAS v4u*)(sb + ST_SC + r32 * 64 + ((cL ^ ((r32 >> 2) & 3)) << 4));
                pw.x &= pm[0]; pw.y &= pm[1]; pw.z &= pm[2]; pw.w &= pm[3];
                acc = __builtin_amdgcn_mfma_f32_32x32x16_bf16(__builtin_bit_cast(bf16x8, pw), dh ? vd[1] : vd[0], acc, 0, 0, 0);
            }
#pragma unroll
            for (int T = 0; T < 4; ++T)
#pragma unroll
                for (int s = 0; s < 2; ++s) {
                    const int j0 = 16 * s + 8 * (G >> 1) + tq;
                    const int cb = kcolb + 64 * T;
                    const int cph = (((cb >> 4) ^ (tq << 2)) << 4) + (cb & 8);
                    const s16x4 lo = vtr(sb + ST_K + j0 * 512 + cph), hi = vtr(sb + ST_K + (j0 + 4) * 512 + cph);
                    const bf16x8 ka = (bf16x8){lo[0], lo[1], lo[2], lo[3], hi[0], hi[1], hi[2], hi[3]};
                    S[T] = __builtin_amdgcn_mfma_f32_32x32x16_bf16(ka, vd[s], S[T], 0, 0, 0);
                }
            }
            if ((t & 7) == 7) {
#pragma unroll
                for (int T = 0; T < 4; ++T) S[T] = S[T] * cfw;
            }
            { LAS float* xw = (LAS float*)(L + XBUF_OFF + dh * 16384) + (4 * hh) * 128 + vs * 32 + r32;
#pragma unroll
              for (int r = 0; r < 16; ++r) xw[((r & 3) + 8 * (r >> 2)) * 128] = acc[r]; }
            asm volatile("s_waitcnt lgkmcnt(0)" ::: "memory");
            __builtin_amdgcn_s_barrier(); asm volatile("" ::: "memory");
            {
                const int v0 = (lane & 15) * 8;
                const LAS float* p0 = (const LAS float*)(L + XBUF_OFF) + om * 128 + v0;
                const LAS float* p1 = (const LAS float*)(L + XBUF_OFF + 16384) + om * 128 + v0;
                const f32x4 a0 = *(const LAS f32x4*)p0, a1 = *(const LAS f32x4*)(p0 + 4), b0 = *(const LAS f32x4*)p1, b1 = *(const LAS f32x4*)(p1 + 4);
                const float rs_ = rsc * cfw; const f32x4 o0 = (a0 + b0) * rs_, o1 = (a1 + b1) * rs_;
                float ss = (o0.x * o0.x + o0.y * o0.y) + (o0.z * o0.z + o0.w * o0.w) + (o1.x * o1.x + o1.y * o1.y) + (o1.z * o1.z + o1.w * o1.w);
                ss += __builtin_bit_cast(float, __builtin_amdgcn_update_dpp(0, __builtin_bit_cast(int, ss), 0xB1, 0xF, 0xF, true));
                ss += __builtin_bit_cast(float, __builtin_amdgcn_update_dpp(0, __builtin_bit_cast(int, ss), 0x4E, 0xF, 0xF, true));
                ss += __builtin_bit_cast(float, __builtin_amdgcn_update_dpp(0, __builtin_bit_cast(int, ss), 0x124, 0xF, 0xF, true));
                ss += __builtin_bit_cast(float, __builtin_amdgcn_update_dpp(0, __builtin_bit_cast(int, ss), 0x128, 0xF, 0xF, true));
                const size_t r0 = step_row0(b, dir, t);
                v4u pk; pk.x = pk2(o0.x, o0.y); pk.y = pk2(o0.z, o0.w); pk.z = pk2(o1.x, o1.y); pk.w = pk2(o1.z, o1.w);
                *(GAS v4u*)(outp + (r0 + om) * 2048 + h * 512 + vq * 128 + v0) = pk;
                if ((lane & 15) == 0) ssqp[(((r0 + om) * RH + h) * 2 + dir) * 4 + vq] = ss;
            }
            asm volatile("s_waitcnt lgkmcnt(0)" ::: "memory");
            if ((t & 7) == 7) { cinv = 1.0f; cfw = 1.0f; }
        }
        asm volatile("s_waitcnt vmcnt(0)" ::: "memory");
#undef RET_ISSUE
    }
    __builtin_amdgcn_s_barrier();
}
}

__device__ __forceinline__ void moe_counts(Frame& F, int (&cnt)[NE]) {
#pragma unroll
    for (int e = 0; e < NE; ++e) cnt[e] = __builtin_amdgcn_readfirstlane((int)__hip_atomic_load((unsigned*)(F.ctl + CW_MOECNT + 64 * e), RLX_AGENT));
}
__device__ __forceinline__ void moe_gather(Frame& F) {
    int cnt[NE]; moe_counts(F, cnt);
    int base[NE]; int acc = 0;
#pragma unroll
    for (int e = 0; e < NE; ++e) { base[e] = acc; acc += (cnt[e] + 255) & ~255; }
    const int* te = (const int*)(F.ws + WS_ROUTE); int* tpos = (int*)(F.ws + WS_ROUTE + (size_t)NLAT * 8);
    const bf16* hb = (const bf16*)(F.ws + WS_H); bf16* hp = (bf16*)(F.ws + WS_HP);
    const int gw = F.vcu * NWAVES + F.wave, NGW = F.G * NWAVES;
    for (int r = gw; r < NLAT; r += NGW) {
        const int e0 = te[2 * r], e1 = te[2 * r + 1]; const int p0 = tpos[2 * r], p1 = tpos[2 * r + 1];
        int b0 = 0, b1 = 0;
#pragma unroll
        for (int e = 0; e < NE; ++e) { b0 = (e0 == e) ? base[e] : b0; b1 = (e1 == e) ? base[e] : b1; }
        const int s0 = b0 + p0, s1 = b1 + p1;
        const v4u x0 = *(const GAS v4u*)((const unsigned char*)hb + (size_t)r * D + F.lane * 16);
        *(GAS v4u*)((unsigned char*)hp + (size_t)s0 * D + F.lane * 16) = x0; *(GAS v4u*)((unsigned char*)hp + (size_t)s1 * D + F.lane * 16) = x0;
        if (F.lane == 0) { tpos[2 * r] = s0; tpos[2 * r + 1] = s1; }
    }
}
__device__ __forceinline__ void moe_order(Frame& F, pg8::MoeOrder& S, int nN) {
    int cnt[NE]; moe_counts(F, cnt);
    int ts[NE + 1]; ts[0] = 0;
#pragma unroll
    for (int e = 0; e < NE; ++e) ts[e + 1] = ts[e] + ((cnt[e] + 255) >> 8);
    S.nM = ts[NE]; S.nN = nN; S.nwg = S.nM * nN; S.G = F.G; S.c = F.cid;
    S.t1 = ts[1]; S.t2 = ts[2]; S.t3 = ts[3]; S.t4 = ts[4]; S.t5 = ts[5]; S.t6 = ts[6]; S.t7 = ts[7];
}

constexpr int N_PHASES = 22;
__global__ void __launch_bounds__(NTHREADS, 2) fwd(Args args) {
    extern __shared__ __attribute__((aligned(16))) unsigned char lds[];
    Frame F;
    F.lds = (LAS unsigned char*)lds; F.MISC = (volatile LAS unsigned*)(F.lds + MISC_OFF);
    F.tid = threadIdx.x; F.lane = F.tid & 63; F.wave = __builtin_amdgcn_readfirstlane(F.tid >> 6);
    F.G = gridDim.x; { const int bx = blockIdx.x; F.vcu = (F.G % 8 == 0) ? (bx % 8) * (F.G / 8) + bx / 8 : bx; F.cid = bx; }
    F.ws = args.ws; F.ctl = (gu32*)(args.ws + WS_CTL);
    for (int u = F.tid; u < 64; u += NTHREADS) ((LAS unsigned*)(F.lds + MISC_OFF))[u] = 0u;
    __syncthreads();
#if MK_PER_PHASE
    XcdBarrier bar; bar.bar = (unsigned*)(F.ctl + CW_BAR); bar.x = 0; bar.st = nullptr;
#define GRID_BAR() do { } while (0)
#else
    XcdBarrier bar = xcd_barrier_post((unsigned*)(F.ctl + CW_BAR), F.MISC + 8);
#define GRID_BAR() xcd_barrier(bar)
    if (F.tid == 0) { const unsigned x = xb_xcc_id(); F.MISC[16] = x; F.MISC[17] = __hip_atomic_fetch_add((unsigned*)(F.ctl + CW_XRANK + 64 * x), 1u, RLX_AGENT); }
#endif
    const int lo = args.ph_lo, hi = args.ph_hi;
#define IN(k) (lo <= (k) && (k) < hi)
#define SEAM(k) do { if (IN(k) && IN((k) + 1)) GRID_BAR(); } while (0)
    unsigned char* ws = args.ws;
    float* modv = (float*)(ws + WS_MODV);
    float* modv1 = modv + 9 * 6 * D;
    bf16* hbuf = (bf16*)(ws + WS_H);
    float* xctx = (float*)(ws + WS_XCTX);
    using pg8::Gemm; using pg8::StaticOrder;

    if (IN(0)) { for (int rep_ = 0; rep_ < ((PROBE_DUP & 1) ? 2 : 1); ++rep_) { p0_prologue(F, args); __syncthreads(); } SEAM(0); }
#if !MK_PER_PHASE
    if (IN(0) && IN(1)) {
        if (F.tid == 0) { const unsigned x = F.MISC[16]; unsigned pre = 0;
            for (unsigned j = 0; j < 16; ++j) { const unsigned c = __hip_atomic_load((unsigned*)(F.ctl + CW_XRANK + 64 * j), RLX_AGENT); pre += (j < x) ? c : 0u; }
            F.MISC[18] = pre + F.MISC[17]; }
        __syncthreads();
        F.vcu = __builtin_amdgcn_readfirstlane((int)F.MISC[18]); F.cid = (F.G % 8 == 0) ? (F.vcu % (F.G / 8)) * 8 + F.vcu / (F.G / 8) : F.vcu;
    }
#endif
    float* rsc = (float*)(ws + WS_RSC);
    if (IN(1)) { RowPass P{MALL, args.in[I_X], args.in[I_CTX], nullptr, nullptr, nullptr, nullptr, nullptr, args.in[I_L0_NPREMIX], modv + 0 * D, modv + 1 * D, hbuf, nullptr, rsc};
        row_pass<false, false, true, false, 2>(F, args, P); SEAM(1); }
    if (IN(2)) { Gemm g{hbuf, (const bf16*)(ws + WS_W0IN), MALL, 4096, D / 2, D / 2, 0, 0, rsc, (const float*)(ws + WS_WSC0)}; StaticOrder S; S.init(MALL, 4096, F.G, F.cid);
        pg8::EpiQKV0 E{(bf16*)(ws + WS_QH0), (bf16*)(ws + WS_KH0), (bf16*)(ws + WS_VQ0), (const float*)(ws + WS_TAB0)};
        for (int rep_ = 0; rep_ < ((PROBE_DUP & 2) ? 2 : 1); ++rep_) { pg8::gemm_phase<pg8::EpiQKV0, StaticOrder, true, true, 2>(F.lds, g, S, E); } if (IN(2) && IN(4)) GRID_BAR(); }
    if (IN(4)) { ret::ret_scores(F); SEAM(4); }
    if (IN(5)) { for (int rep_ = 0; rep_ < ((PROBE_DUP & 8) ? 2 : 1); ++rep_) ret::ret_scan<0>(F, args); SEAM(5); }
    if (IN(6)) { Gemm g{hbuf, (const bf16*)(ws + WS_W0IN + (size_t)4096 * D), MALL, 4096, D / 2, D / 2, 0, 0, rsc, (const float*)(ws + WS_WSC0) + 4096}; StaticOrder S; S.init(MALL, 4096, F.G, F.cid);
        pg8::EpiGateMerge E{(bf16*)(ws + WS_OF), (const bf16*)(ws + WS_OB), (const float*)(ws + ret::WS_SSQ)};
        pg8::gemm_phase<pg8::EpiGateMerge, StaticOrder, true, true, 2>(F.lds, g, S, E); if (IN(6) && IN(8)) GRID_BAR(); }
    if (IN(8)) { Gemm g{(const bf16*)(ws + WS_OF), (const bf16*)(ws + WS_W0OUT), MALL, D, 2048, 2048}; pg8::SplitOrder S; S.init(D, F.G, F.cid, USE_SPLITK ? 8 : 0, 4);
        pg8::EpiStoreSplit E{(bf16*)(ws + WS_A), D, (float*)(ws + WS_PART)};
        for (int rep_ = 0; rep_ < ((PROBE_DUP & 32) ? 2 : 1); ++rep_) { pg8::gemm_phase<pg8::EpiStoreSplit, pg8::SplitOrder, true, true>(F.lds, g, S, E); } SEAM(8); }
    if (IN(9)) { RowPass P{MALL, args.in[I_X], args.in[I_CTX], (float*)(ws + WS_X1), (float*)(ws + WS_X1C), (const bf16*)(ws + WS_A), args.in[I_L0_NPOSTMIX], modv + 2 * D, args.in[I_L0_NPREFFN], modv + 3 * D, modv + 4 * D, hbuf, (const float*)(ws + WS_PART), rsc};
        row_pass<true, false, true, false, 2, USE_SPLITK ? 8 : 0, false, true>(F, args, P); SEAM(9); }
    if (IN(10)) { Gemm g{hbuf, (const bf16*)(ws + WS_W0GU), MALL, 2 * DFF, D / 2, D / 2, 0, 0, rsc, (const float*)(ws + WS_WSC2)}; StaticOrder S; S.init(MALL, 2 * DFF, F.G, F.cid);
        pg8::EpiSwiglu8 E{(unsigned char*)(ws + WS_B), DFF};
        for (int rep_ = 0; rep_ < ((PROBE_DUP & 2) ? 2 : 1); ++rep_) { pg8::gemm_phase<pg8::EpiSwiglu8, StaticOrder, true, true, 2>(F.lds, g, S, E); } SEAM(10); }
    if (IN(11)) { Gemm g{(const bf16*)(ws + WS_B), (const bf16*)(ws + WS_W0DN), MALL, D, DFF / 2, DFF / 2, MOE_SA, MOE_SB}; pg8::SplitOrder S; S.init(D, F.G, F.cid, USE_SPLITK ? 11 : 0, 4);
        pg8::EpiStoreSplit E{(bf16*)(ws + WS_A), D, (float*)(ws + WS_PART)};
        for (int rep_ = 0; rep_ < ((PROBE_DUP & 32) ? 2 : 1); ++rep_) { pg8::gemm_phase<pg8::EpiStoreSplit, pg8::SplitOrder, true, true, 1>(F.lds, g, S, E); } SEAM(11); }
    if (IN(12)) { RowPass P{MALL, (const float*)(ws + WS_X1), (const float*)(ws + WS_X1C), (float*)(ws + WS_X2), nullptr, (const bf16*)(ws + WS_A), args.in[I_L0_NPOSTFFN], modv + 5 * D, args.in[I_L1_NPREMIX], modv1 + 0 * D, modv1 + 1 * D, hbuf, (const float*)(ws + WS_PART)};
        row_pass<true, false, true, false, 1, USE_SPLITK ? 11 : 0, true, true>(F, args, P); SEAM(12); }
    if (IN(13)) { Gemm g{hbuf, (const bf16*)(ws + WS_W1IN), MALL, 3072, D / 2, D / 2, MOE_SA, MOE_SB}; StaticOrder S; S.init(MALL, 3072, F.G, F.cid);
        pg8::EpiQKV1 E{(bf16*)(ws + WS_QH1), (bf16*)(ws + WS_KH1), (bf16*)(ws + WS_VH1), (const float*)(ws + WS_TAB1)};
        for (int rep_ = 0; rep_ < ((PROBE_DUP & 2) ? 2 : 1); ++rep_) { pg8::gemm_phase<pg8::EpiQKV1, StaticOrder, true, true, true>(F.lds, g, S, E); } SEAM(13); }
    if (IN(14)) { v8_prep(F); SEAM(14); }
    if (IN(15)) { attn_phase<0>(F, args, (bf16*)(ws + WS_B)); SEAM(15); }
    if (IN(16)) { Gemm g{(const bf16*)(ws + WS_B), (const bf16*)(ws + WS_W1OUT), NLAT, D, D, D}; StaticOrder S; S.init(NLAT, D, F.G, F.cid);
        pg8::EpiStore E{(bf16*)(ws + WS_A), D};
        for (int rep_ = 0; rep_ < ((PROBE_DUP & 2) ? 2 : 1); ++rep_) { pg8::gemm_phase<pg8::EpiStore, StaticOrder, true, true>(F.lds, g, S, E); } SEAM(16); }
    if (IN(17)) { RowPass P{NLAT, (const float*)(ws + WS_X2), nullptr, (float*)(ws + WS_X3), nullptr, (const bf16*)(ws + WS_A), args.in[I_L1_NPOSTMIX], modv1 + 2 * D, args.in[I_L1_NPREFFN], modv1 + 3 * D, modv1 + 4 * D, hbuf};
        row_pass<true, false, true, true, 1, 0, true, true>(F, args, P); SEAM(17); }
    if (IN(18)) { moe_gather(F); SEAM(18); }
    if (IN(19)) { Gemm g{(const bf16*)(ws + WS_HP), (const bf16*)(ws + WS_WMGU), MOE_ROWS, 2 * DFE, D / 2, D / 2, MOE_SA, MOE_SB}; pg8::MoeOrder S; moe_order(F, S, 2 * DFE / 256);
        pg8::EpiSwiglu8 E{(unsigned char*)(ws + WS_ACT1), DFE};
        for (int rep_ = 0; rep_ < ((PROBE_DUP & 16) ? 2 : 1); ++rep_) { pg8::gemm_phase<pg8::EpiSwiglu8, pg8::MoeOrder, true, true, true>(F.lds, g, S, E); } SEAM(19); }
    if (IN(20)) { Gemm g{(const bf16*)(ws + WS_ACT1), (const bf16*)(ws + WS_WMDN), MOE_ROWS, D, DFE / 2, DFE / 2, MOE_SA, MOE_SB}; pg8::MoeOrder S; moe_order(F, S, D / 256);
        pg8::EpiStore E{(bf16*)(ws + WS_Y1), D};
        for (int rep_ = 0; rep_ < ((PROBE_DUP & 16) ? 2 : 1); ++rep_) { pg8::gemm_phase<pg8::EpiStore, pg8::MoeOrder, true, true, true>(F.lds, g, S, E); } SEAM(20); }
    if (IN(21)) { RowPass P{NLAT, (const float*)(ws + WS_X3), nullptr, args.out, nullptr, (const bf16*)(ws + WS_Y1), args.in[I_L1_NPOSTFFN], modv1 + 5 * D, nullptr, nullptr, nullptr, nullptr};
        row_pass<false, true, false, false, 0, 0, true, false>(F, args, P); }
#undef IN
#undef SEAM
}

#ifndef PROBE_ATT
#define PROBE_ATT -1
#endif
#if PROBE_ATT >= 0
__global__ void __launch_bounds__(NTHREADS, 2) probe_k(Args args) {
    extern __shared__ __attribute__((aligned(16))) unsigned char lds[];
    Frame F;
    F.lds = (LAS unsigned char*)lds; F.MISC = (volatile LAS unsigned*)(F.lds + MISC_OFF);
    F.tid = threadIdx.x; F.lane = F.tid & 63; F.wave = __builtin_amdgcn_readfirstlane(F.tid >> 6);
    F.G = gridDim.x; { const int bx = blockIdx.x; F.vcu = (F.G % 8 == 0) ? (bx % 8) * (F.G / 8) + bx / 8 : bx; F.cid = bx; }
    F.ws = args.ws; F.ctl = (gu32*)(args.ws + WS_CTL);
#if PROBE_ATT < 10
    attn_phase<PROBE_ATT>(F, args, (bf16*)(args.ws + WS_END - 64 * MiB));
#else
    ret::ret_scan<PROBE_ATT - 10>(F, args);
#endif
}
#endif
extern "C" void kernel_launch(void* const* d_in, const int* in_sizes, int n_in, void* d_out, int out_size, void* d_ws, size_t ws_size, hipStream_t stream) {
    static int grid = 0;
    if (grid == 0) {
        if (n_in != N_IN || out_size != NLAT * D || ws_size < WS_END) { fprintf(stderr, "kernel_launch: unexpected shapes n_in %d out %d ws %zu\n", n_in, out_size, ws_size); grid = -1; return; }
        int dev = 0, cus = 0, per_cu = 0;
        if (hipGetDevice(&dev) != hipSuccess || hipDeviceGetAttribute(&cus, hipDeviceAttributeMultiprocessorCount, dev) != hipSuccess) { grid = -1; return; }
        if (hipFuncSetAttribute((const void*)fwd, hipFuncAttributeMaxDynamicSharedMemorySize, LDS_BYTES) != hipSuccess) { fprintf(stderr, "kernel_launch: hipFuncSetAttribute failed\n"); grid = -1; return; }
        if (hipOccupancyMaxActiveBlocksPerMultiprocessor(&per_cu, (const void*)fwd, NTHREADS, LDS_BYTES) != hipSuccess || per_cu < 1) fprintf(stderr, "kernel_launch: occupancy query says %d\n", per_cu);
        (void)hipGetLastError();
        grid = cus;
    }
    if (grid < 0) return;
    (void)hipMemsetAsync((char*)d_ws + WS_CTL, 0, CTL_ZERO_BYTES, stream);
    Args a{};
    for (int i = 0; i < N_IN; ++i) a.in[i] = (const float*)d_in[i];
    a.out = (float*)d_out; a.ws = (unsigned char*)d_ws;
#if MK_PER_PHASE
    for (int p = 0; p < N_PHASES; ++p) { a.ph_lo = p; a.ph_hi = p + 1; hipLaunchKernelGGL(fwd, dim3(grid), dim3(NTHREADS), LDS_BYTES, stream, a); }
#else
    a.ph_lo = 0; a.ph_hi = N_PHASES; hipLaunchKernelGGL(fwd, dim3(grid), dim3(NTHREADS), LDS_BYTES, stream, a);
#endif
#if PROBE_ATT >= 0
    (void)hipFuncSetAttribute((const void*)probe_k, hipFuncAttributeMaxDynamicSharedMemorySize, LDS_BYTES);
    hipLaunchKernelGGL(probe_k, dim3(grid), dim3(NTHREADS), LDS_BYTES, stream, a);
#endif
}
```

```cpp
#include <hip/hip_runtime.h>
#include <cstdio>
#include <cstdint>
namespace pg8 {
#define PG8_LAS __attribute__((address_space(3)))
typedef unsigned short bf16_t;
typedef short bf16x8 __attribute__((ext_vector_type(8)));
typedef float f32x4 __attribute__((ext_vector_type(4)));
typedef unsigned u32x4 __attribute__((ext_vector_type(4)));
constexpr int BM = 256, BK = 64, HALF = 128, HTB = HALF * BK * 2  , STAGE_BYTES = 8 * HTB, NXCD = 8, WGM = 8;

__host__ __device__ __forceinline__ int lds_byte(int r, int c) { const int st = (r >> 4) * 2 + (c >> 5), rr = r & 15, cc = c & 31, ob = rr * 64 + cc * 2; return st * 1024 + (ob ^ (((ob >> 9) & 1) << 5)); }
__host__ __device__ __forceinline__ void stage_rc(int b, int& R, int& C) { const int st = b / 1024, sb = b % 1024, swz = sb ^ (((sb >> 9) & 1) << 5); R = (st >> 1) * 16 + swz / 64; C = (st & 1) * 32 + (swz % 64) / 2; }
__host__ __device__ __forceinline__ int perm32(int rho) { const int n = rho >> 4, i = rho & 15; return 8 * (i >> 2) + 4 * n + (i & 3); }

struct Unit { int pm, pn, pc, k0, nt, ks, pa, sw; };
struct Gemm { const bf16_t* A; const bf16_t* Bt; int M, N, K, lda; int sA, sB; const float* rsA; const float* rsB; };

struct StaticOrder {
    int nM, nN, nwg, G, c, rep;
    __host__ __device__ __forceinline__ void init(int M, int N, int G_, int c_, int rep_ = 1) { nM = M / BM; nN = N / BM; nwg = nM * nN; G = G_; c = c_; rep = rep_; }
    __host__ __device__ __forceinline__ bool next(int i, Unit& u) const {
        long L = (long)i * G + c; if (L >= (long)nwg * rep) return false; if (L >= nwg) L -= nwg;
        int wgid = (int)L; { const int q = nwg / NXCD, r = nwg % NXCD, xcd = wgid % NXCD, off = wgid / NXCD; wgid = (xcd < r ? xcd * (q + 1) : r * (q + 1) + (xcd - r) * q) + off; }
        const int nig = WGM * nN, gid = wgid / nig, fm = gid * WGM, gsz = (nM - fm) < WGM ? (nM - fm) : WGM;
        u.pm = fm + ((wgid % nig) % gsz); u.pn = (wgid % nig) / gsz; u.pc = u.pn; u.k0 = 0; u.nt = 0; u.ks = -1; u.pa = u.pm; u.sw = 0; return true;
    }
    __device__ __forceinline__ void a_ready(const Unit&) const {}
    __device__ __forceinline__ void done(const Unit&) const {}
};

__device__ __forceinline__ unsigned cvt_pk_bf16(float lo, float hi) { unsigned r; asm volatile("v_cvt_pk_bf16_f32 %0, %1, %2" : "=v"(r) : "v"(lo), "v"(hi)); return r; }
typedef float f32x2 __attribute__((ext_vector_type(2)));
typedef int v4i_t __attribute__((ext_vector_type(4))); typedef int v8i_t __attribute__((ext_vector_type(8)));
template <class Epi, class Sched, bool ALIGN_EPI = false, bool SP2 = false, int MODE = 0>
__device__ __forceinline__ void gemm_phase(PG8_LAS unsigned char* lds, const Gemm g, const Sched& S, const Epi& E) {
    constexpr bool FP8 = (MODE == 1), I8 = (MODE == 2);
    const int tid = threadIdx.x, wid = __builtin_amdgcn_readfirstlane(tid >> 6), lane = tid & 63, wr = wid >> 2, wc = wid & 3, fr = lane & 15, fq = lane >> 4;
    const int K = g.K; int nt = K / BK;
    unsigned voffA[2], voffB[2];
#pragma unroll
    for (int i = 0; i < 2; ++i) { int R, C; stage_rc(tid * 16 + i * 8192, R, C); const int Rb = Epi::PERM ? ((R & ~31) + perm32(R & 31)) : R;
        voffA[i] = (unsigned)(R * g.lda + C) * 2u; voffB[i] = (unsigned)(Rb * K + C) * 2u; }
    const size_t kstep = (size_t)(BK * 2);
    const size_t hstepA = (size_t)HALF * g.lda * 2, hstepB = (size_t)HALF * K * 2;
    const size_t tstepA = 2 * hstepA, tstepB = 2 * hstepB;
    const unsigned ldsw = (unsigned)wid * 1024u;
    const int aoff = lds_byte(wr * 64 + fr, fq * 8), boff = lds_byte(wc * 32 + fr, fq * 8);
#define PG8_SA(b, h) (((b) * 2 + (h)) * HTB)
#define PG8_SB(b, h) ((4 + (b) * 2 + (h)) * HTB)
#define PG8_STAGE(bufoff, gbase, voff) do { _Pragma("unroll") for (int _i = 0; _i < 2; ++_i) \
        __builtin_amdgcn_global_load_lds((const unsigned*)((const char*)(gbase) + (voff)[_i]), (PG8_LAS unsigned*)(lds + (bufoff) + ldsw + _i * 8192), 16, 0, 0); } while (0)
#define PG8_LDA(dst, b, h) do { if constexpr (FP8) { _Pragma("unroll") for (int m = 0; m < 4; ++m) { const v4i_t lo_ = *(const PG8_LAS v4i_t*)(lds + PG8_SA(b, h) + aoff + m * 2048), hi_ = *(const PG8_LAS v4i_t*)(lds + PG8_SA(b, h) + aoff + m * 2048 + 1024); \
        dst##8[m] = __builtin_shufflevector(lo_, hi_, 0, 1, 2, 3, 4, 5, 6, 7); } } \
    else { _Pragma("unroll") for (int m = 0; m < 4; ++m) _Pragma("unroll") for (int k = 0; k < 2; ++k) dst[m][k] = *(const PG8_LAS bf16x8*)(lds + PG8_SA(b, h) + aoff + m * 2048 + k * 1024); } } while (0)
#define PG8_LDB(dst, b, h) do { if constexpr (FP8) { _Pragma("unroll") for (int n = 0; n < 2; ++n) { const v4i_t lo_ = *(const PG8_LAS v4i_t*)(lds + PG8_SB(b, h) + boff + n * 2048), hi_ = *(const PG8_LAS v4i_t*)(lds + PG8_SB(b, h) + boff + n * 2048 + 1024); \
        dst##8[n] = __builtin_shufflevector(lo_, hi_, 0, 1, 2, 3, 4, 5, 6, 7); } } \
    else { _Pragma("unroll") for (int n = 0; n < 2; ++n) _Pragma("unroll") for (int k = 0; k < 2; ++k) dst[n][k] = *(const PG8_LAS bf16x8*)(lds + PG8_SB(b, h) + boff + n * 2048 + k * 1024); } } while (0)
#define PG8_MMA(ai, bj, At, Bt) do { __builtin_amdgcn_s_setprio(1); _Pragma("unroll") for (int m = 0; m < 4; ++m) _Pragma("unroll") for (int n = 0; n < 2; ++n) { \
        if constexpr (FP8) { asm volatile("v_mfma_scale_f32_16x16x128_f8f6f4 %0, %1, %2, %0, %3, %4 op_sel_hi:[0,0,0]" : "+v"(acc[ai][bj][m][n]) : "v"(Bt##8[n]), "v"(At##8[m]), "v"(sB_), "v"(sA_)); } \
        else if constexpr (I8) { _Pragma("unroll") for (int k = 0; k < 2; ++k) acc[ai][bj][m][n] = __builtin_bit_cast(f32x4, __builtin_amdgcn_mfma_i32_16x16x64_i8(__builtin_bit_cast(v4i_t, Bt[n][k]), __builtin_bit_cast(v4i_t, At[m][k]), __builtin_bit_cast(v4i_t, acc[ai][bj][m][n]), 0, 0, 0)); } \
        else { _Pragma("unroll") for (int k = 0; k < 2; ++k) acc[ai][bj][m][n] = __builtin_amdgcn_mfma_f32_16x16x32_bf16(Bt[n][k], At[m][k], acc[ai][bj][m][n], 0, 0, 0); } } \
        __builtin_amdgcn_s_setprio(0); } while (0)
#define PG8_WAIT_V(n) asm volatile("s_waitcnt vmcnt(" #n ")" ::: "memory")
#define PG8_WAIT_VR(n) do { if (relax) asm volatile("s_waitcnt vmcnt(%0)" :: "i"((n) + Epi::NST) : "memory"); else asm volatile("s_waitcnt vmcnt(" #n ")" ::: "memory"); } while (0)
#define PG8_WAIT_L(n) asm volatile("s_waitcnt lgkmcnt(" #n ")" ::: "memory")
#define PG8_BAR __builtin_amdgcn_s_barrier()
#define PG8_SCHED __builtin_amdgcn_sched_barrier(0)
#define PG8_SCALES(u, par) do { if constexpr (I8) { if (wid < 2) { const float* gp_ = (wid == 0 ? ((u).sw ? g.rsB : g.rsA) + (u).pa * BM : ((u).sw ? g.rsA : g.rsB) + (u).pn * BM) + lane * 4; \
        __builtin_amdgcn_global_load_lds((const unsigned*)gp_, (PG8_LAS unsigned*)(lds + STAGE_BYTES + (par) * 2048 + wid * 1024), 16, 0, 0); } } } while (0)
    Unit cur, nxt; int ui = 0;
    if (!S.next(0, cur)) return;
    const int sA_ = g.sA, sB_ = g.sB;
    f32x4 acc[2][2][4][2];
#pragma unroll
    for (int a = 0; a < 2; ++a)
#pragma unroll
        for (int b = 0; b < 2; ++b)
#pragma unroll
            for (int m = 0; m < 4; ++m)
#pragma unroll
                for (int n = 0; n < 2; ++n) acc[a][b][m][n] = (f32x4){0.f, 0.f, 0.f, 0.f};
    bf16x8 At[4][2], B0[2][2], B1[2][2]; v8i_t At8[4], B08[2], B18[2];
    if (cur.nt) nt = cur.nt;
    const char* cA = (const char*)(cur.sw ? g.Bt : g.A) + (size_t)cur.pa * tstepA + (size_t)cur.k0 * 2; const char* cB = (const char*)(cur.sw ? g.A : g.Bt) + (size_t)cur.pn * tstepB + (size_t)cur.k0 * 2;
    S.a_ready(cur);
    PG8_SCALES(cur, 0);
    if constexpr (SP2) {
        PG8_STAGE(PG8_SB(0, 0), cB, voffB); PG8_STAGE(PG8_SB(0, 1), cB + hstepB, voffB); PG8_STAGE(PG8_SA(0, 0), cA, voffA); PG8_STAGE(PG8_SA(0, 1), cA + hstepA, voffA);
        PG8_STAGE(PG8_SB(1, 0), cB + kstep, voffB); PG8_STAGE(PG8_SA(1, 0), cA + kstep, voffA); PG8_STAGE(PG8_SB(1, 1), cB + hstepB + kstep, voffB);
        if (wr == 1) PG8_BAR;
        PG8_WAIT_V(8); PG8_BAR;
        PG8_WAIT_V(6); PG8_BAR;
    } else {
        PG8_STAGE(PG8_SB(0, 0), cB, voffB); PG8_STAGE(PG8_SA(0, 0), cA, voffA); PG8_STAGE(PG8_SB(0, 1), cB + hstepB, voffB); PG8_STAGE(PG8_SA(0, 1), cA + hstepA, voffA);
        if (wr == 1) PG8_BAR;
        PG8_WAIT_V(4); PG8_BAR;
        PG8_STAGE(PG8_SB(1, 0), cB + kstep, voffB); PG8_STAGE(PG8_SA(1, 0), cA + kstep, voffA); PG8_STAGE(PG8_SB(1, 1), cB + hstepB + kstep, voffB);
        PG8_WAIT_V(6); PG8_BAR;
    }
    for (;;) {
        const bool has_next = S.next(ui + 1, nxt);
        const char* nA = has_next ? (const char*)(nxt.sw ? g.Bt : g.A) + (size_t)nxt.pa * tstepA + (size_t)nxt.k0 * 2 : cA; const char* nB = has_next ? (const char*)(nxt.sw ? g.A : g.Bt) + (size_t)nxt.pn * tstepB + (size_t)nxt.k0 * 2 : cB;
#pragma unroll 1
        for (int t = 0; t < nt; t += 2) {
            const bool last = (t == nt - 2); const bool relax = (t == 0) && (ui > 0) && !Epi::AFTER_DRAIN;
            const char* a1 = cA + (size_t)(t + 1) * kstep;
            const char* a2 = last ? nA : cA + (size_t)(t + 2) * kstep; const char* b2 = last ? nB : cB + (size_t)(t + 2) * kstep;
            const char* a3 = a2 + kstep; const char* b3 = b2 + kstep;
            if (last && has_next) S.a_ready(nxt);
            if constexpr (SP2) {
            PG8_LDB(B0, 0, 0); PG8_LDB(B1, 0, 1); PG8_SCHED; PG8_LDA(At, 0, 0); PG8_STAGE(PG8_SA(1, 1), a1 + hstepA, voffA);
            PG8_WAIT_VR(8); PG8_WAIT_L(0); PG8_BAR; PG8_MMA(0, 0, At, B0); PG8_MMA(0, 1, At, B1); PG8_BAR; PG8_SCHED;
            PG8_LDA(At, 0, 1); PG8_STAGE(PG8_SB(0, 0), b2, voffB); PG8_STAGE(PG8_SB(0, 1), b2 + hstepB, voffB); PG8_STAGE(PG8_SA(0, 0), a2, voffA);
            PG8_WAIT_VR(8); PG8_WAIT_L(0); PG8_BAR; PG8_MMA(1, 0, At, B0); PG8_MMA(1, 1, At, B1); PG8_BAR; PG8_SCHED;
            PG8_LDB(B0, 1, 0); PG8_LDB(B1, 1, 1); PG8_SCHED; PG8_LDA(At, 1, 0); PG8_STAGE(PG8_SA(0, 1), a2 + hstepA, voffA);
            PG8_WAIT_V(8); PG8_WAIT_L(0); PG8_BAR; PG8_MMA(0, 0, At, B0); PG8_MMA(0, 1, At, B1); PG8_BAR; PG8_SCHED;
            PG8_LDA(At, 1, 1); PG8_STAGE(PG8_SB(1, 0), b3, voffB); PG8_STAGE(PG8_SB(1, 1), b3 + hstepB, voffB); PG8_STAGE(PG8_SA(1, 0), a3, voffA);
            PG8_WAIT_V(8); PG8_WAIT_L(0); PG8_BAR; PG8_MMA(1, 0, At, B0); PG8_MMA(1, 1, At, B1); PG8_BAR; PG8_SCHED;
            } else {
            PG8_LDB(B0, 0, 0); PG8_SCHED; PG8_LDA(At, 0, 0); PG8_STAGE(PG8_SA(1, 1), a1 + hstepA, voffA);
            PG8_WAIT_L(8); PG8_BAR; PG8_WAIT_L(0); PG8_MMA(0, 0, At, B0); PG8_BAR; PG8_SCHED;
            PG8_LDB(B1, 0, 1); PG8_STAGE(PG8_SB(0, 0), b2, voffB);
            PG8_BAR; PG8_WAIT_L(0); PG8_MMA(0, 1, At, B1); PG8_BAR;
            PG8_LDA(At, 0, 1); PG8_STAGE(PG8_SA(0, 0), a2, voffA);
            PG8_BAR; PG8_WAIT_L(0); PG8_MMA(1, 0, At, B0); PG8_BAR; PG8_SCHED;
            PG8_STAGE(PG8_SB(0, 1), b2 + hstepB, voffB);
            PG8_WAIT_V(6); PG8_BAR; PG8_MMA(1, 1, At, B1); PG8_BAR;
            PG8_LDB(B0, 1, 0); PG8_SCHED; PG8_LDA(At, 1, 0); PG8_STAGE(PG8_SA(0, 1), a2 + hstepA, voffA);
            PG8_WAIT_L(8); PG8_BAR; PG8_WAIT_L(0); PG8_MMA(0, 0, At, B0); PG8_BAR; PG8_SCHED;
            PG8_LDB(B1, 1, 1); PG8_STAGE(PG8_SB(1, 0), b3, voffB);
            PG8_BAR; PG8_WAIT_L(0); PG8_MMA(0, 1, At, B1); PG8_BAR;
            PG8_LDA(At, 1, 1); PG8_STAGE(PG8_SA(1, 0), a3, voffA);
            PG8_BAR; PG8_WAIT_L(0); PG8_MMA(1, 0, At, B0); PG8_BAR; PG8_SCHED;
            PG8_STAGE(PG8_SB(1, 1), b3 + hstepB, voffB);
            PG8_WAIT_V(6); PG8_BAR; PG8_MMA(1, 1, At, B1); PG8_BAR;
            }
        }
        if constexpr (FP8) asm volatile("s_nop 15\n\ts_nop 15" ::: "memory");
        if constexpr (I8) {
            const PG8_LAS float* ra = (const PG8_LAS float*)(lds + STAGE_BYTES + (ui & 1) * 2048) + wr * 64 + fr; const PG8_LAS float* rb = (const PG8_LAS float*)(lds + STAGE_BYTES + (ui & 1) * 2048 + 1024) + wc * 32 + 8 * fq;
#pragma unroll
            for (int bj = 0; bj < 2; ++bj) { const f32x4 sb0 = *(const PG8_LAS f32x4*)(rb + bj * HALF), sb1 = *(const PG8_LAS f32x4*)(rb + bj * HALF + 4);
#pragma unroll
                for (int ai = 0; ai < 2; ++ai)
#pragma unroll
                    for (int m = 0; m < 4; ++m) { const float sa = ra[ai * HALF + m * 16];
                        acc[ai][bj][m][0] = __builtin_convertvector(__builtin_bit_cast(v4i_t, acc[ai][bj][m][0]), f32x4) * (sb0 * sa);
                        acc[ai][bj][m][1] = __builtin_convertvector(__builtin_bit_cast(v4i_t, acc[ai][bj][m][1]), f32x4) * (sb1 * sa); } }
        }
        if constexpr (ALIGN_EPI) { if (wr == 0) PG8_BAR; }
        if constexpr (!Epi::AFTER_DRAIN) { E(acc, cur, wr, wc, fr, fq); S.done(cur); }
        if (!has_next) break;
#pragma unroll
        for (int a = 0; a < 2; ++a)
#pragma unroll
            for (int b = 0; b < 2; ++b)
#pragma unroll
                for (int m = 0; m < 4; ++m)
#pragma unroll
                    for (int n = 0; n < 2; ++n) { double z0_, z1_; asm volatile("v_mov_b64 %0, 0\n\tv_mov_b64 %1, 0" : "=v"(z0_), "=v"(z1_));
                        typedef double d2_t __attribute__((ext_vector_type(2))); acc[a][b][m][n] = __builtin_bit_cast(f32x4, (d2_t){z0_, z1_}); }
        cur = nxt; cA = nA; cB = nB; ++ui; nt = cur.nt ? cur.nt : K / BK;
        PG8_SCALES(cur, ui & 1);
        if constexpr (ALIGN_EPI) { if (wr == 1) PG8_BAR; }
    }
    PG8_WAIT_V(0);
    if constexpr (!ALIGN_EPI) { if (wr == 0) PG8_BAR; }
    PG8_BAR;
    if constexpr (Epi::AFTER_DRAIN) { E.fused(acc, cur, wr, wc, fr, fq, lds, wid, lane); S.done(cur); }
#undef PG8_SA
#undef PG8_SCALES
#undef PG8_SB
#undef PG8_STAGE
#undef PG8_LDA
#undef PG8_LDB
#undef PG8_MMA
#undef PG8_WAIT_V
#undef PG8_WAIT_VR
#undef PG8_WAIT_L
#undef PG8_BAR
#undef PG8_SCHED
}
}

#ifndef PROBE_DUP
#define PROBE_DUP 0
#endif
#ifndef USE_SPLITK
#define USE_SPLITK 0
#endif
#ifndef MK_PER_PHASE
#define MK_PER_PHASE 0
#endif
#define DUP(p) ((((PROBE_DUP) >> (p)) & 1) ? 2 : 1)
constexpr int D = 1024, NBATCH = 8, SEQ = 4096, NLAT = NBATCH * SEQ, CTXL = 256, NCTX = NBATCH * CTXL, MALL = NLAT + NCTX;
constexpr int RH = 4, RQK = 256, RV = 512;
constexpr int DFF = 2816, NE = 8, DFE = 3584;
constexpr float EPS = 1e-6f;
constexpr float LAMBDA_INIT = 0.3555090675909693f;
constexpr float LOG2E = 1.4426950408889634f, LN2 = 0.6931471805599453f;
constexpr int NWAVES = 8, NTHREADS = 512;
constexpr float MOE_WSCALE = 64.0f; constexpr int MOE_SB = 0x79797979, MOE_SA = 0x7f7f7f7f;
constexpr int MOE_ROWS = 2 * NLAT + NE * 256;

enum { I_X = 0, I_C, I_CTX, I_CCTX, I_L0_WMOD, I_L0_BMOD, I_L0_NPREMIX, I_L0_NPOSTMIX, I_L0_NPREFFN, I_L0_NPOSTFFN, I_L0_WIN, I_L0_DECAY, I_L0_WOUT, I_L0_WGU, I_L0_WDN,
       I_L1_WMOD, I_L1_BMOD, I_L1_NPREMIX, I_L1_NPOSTMIX, I_L1_NPREFFN, I_L1_NPOSTFFN, I_L1_WIN, I_L1_LAMBDA, I_L1_SUBLN, I_L1_WOUT, I_L1_RW, I_L1_RB, I_L1_MGU, I_L1_MDN, N_IN };

constexpr size_t MiB = 1u << 20;
constexpr size_t WS_CTL = 0, CTL_ZERO_BYTES = 1 * MiB;
constexpr size_t WS_MODV = 1 * MiB;
constexpr size_t WS_TAB0 = 1 * MiB + 512 * 1024;
constexpr size_t WS_TAB1 = WS_TAB0 + 32 * 1024;
constexpr size_t WS_LAM = WS_TAB1 + 8 * 1024;
constexpr size_t WS_WSC0 = WS_LAM + 4096;
constexpr size_t WS_WSC2 = WS_WSC0 + 8192 * 4;
constexpr size_t WS_RSC = 1 * MiB + 768 * 1024;
constexpr size_t WS_ROUTE = 2 * MiB;
constexpr size_t WS_WSC1 = 3 * MiB;
constexpr size_t WS_WSCM = 3 * MiB + 64 * 1024;
constexpr size_t WS_RSCM = 4 * MiB;
constexpr size_t WS_W0IN = 11 * MiB, WS_W0OUT = 27 * MiB, WS_W0GU = 31 * MiB, WS_W0DN = 42 * MiB, WS_W1IN = 48 * MiB, WS_W1OUT = 54 * MiB, WS_WMGU = 56 * MiB, WS_WMDN = 168 * MiB;
constexpr size_t WS_H = 224 * MiB;
constexpr size_t WS_A = 292 * MiB, WS_B = 564 * MiB;
constexpr size_t WS_OF = WS_B, WS_OB = WS_B + 136 * MiB;
constexpr size_t WS_Y8 = WS_A + 136 * MiB;
constexpr size_t WS_QH0 = WS_A, WS_KH0 = WS_A + 68 * MiB, WS_VQ0 = WS_A + 136 * MiB;
constexpr size_t WS_QH1 = WS_A, WS_KH1 = WS_A + 68 * MiB, WS_VH1 = WS_A + 136 * MiB;
constexpr size_t WS_HP = WS_B, WS_ACT1 = WS_A, WS_Y1 = WS_B;
constexpr size_t WS_V8 = 640 * MiB;
constexpr size_t WS_X1 = 360 * MiB, WS_X1C = 424 * MiB;
constexpr size_t WS_X2 = 496 * MiB;
constexpr size_t WS_X3 = 820 * MiB;
constexpr size_t WS_PART = WS_A + 136 * MiB;
constexpr size_t WS_END = 886 * MiB;
static_assert(WS_ACT1 + (size_t)MOE_ROWS * DFE <= WS_HP && WS_HP + (size_t)NE * NLAT * D <= WS_X3 && WS_X3 + (size_t)NLAT * D * 2 <= WS_END, "ws map");
static_assert(WS_WSC2 + 2 * DFF * 4 <= WS_RSC && WS_RSC + (size_t)MALL * 4 <= WS_ROUTE, "ws map");
constexpr int CW_TMO = 0;
constexpr int CW_BAR = 4096;
constexpr int CW_XRANK = 12288;
constexpr int CW_MOECNT = 16384;

constexpr int RING_BYTES = 131072;
constexpr int LDS_BYTES = 163840;
constexpr int MISC_OFF = LDS_BYTES - 256;

#define GAS __attribute__((address_space(1)))
#define LAS __attribute__((address_space(3)))
typedef unsigned short bf16;
typedef unsigned v4u __attribute__((ext_vector_type(4)));
typedef unsigned v2u __attribute__((ext_vector_type(2)));
typedef float f32x4 __attribute__((ext_vector_type(4)));
typedef float f32x2 __attribute__((ext_vector_type(2)));
typedef short bf16x8 __attribute__((ext_vector_type(8)));
typedef GAS unsigned gu32;
#define RLX_AGENT __ATOMIC_RELAXED, __HIP_MEMORY_SCOPE_AGENT
#define LDS_WAIT() asm volatile("s_waitcnt lgkmcnt(0)" ::: "memory")
#define VM_WAIT() asm volatile("s_waitcnt vmcnt(0)" ::: "memory")
__device__ __forceinline__ unsigned pk2(float lo, float hi);
__device__ __forceinline__ unsigned f2bf(float f) { return pk2(f, 0.f) & 0xffffu; }
typedef float f32x2_cv __attribute__((ext_vector_type(2))); typedef __bf16 bf16x2_cv __attribute__((ext_vector_type(2)));
__device__ __forceinline__ unsigned pk2(float lo, float hi) { f32x2_cv v = {lo, hi}; bf16x2_cv b = __builtin_convertvector(v, bf16x2_cv); return __builtin_bit_cast(unsigned, b); }
__device__ __forceinline__ float bf2f(unsigned b) { return __builtin_bit_cast(float, b << 16); }
__device__ __forceinline__ float bflo(unsigned w) { return __builtin_bit_cast(float, w << 16); }
__device__ __forceinline__ float bfhi(unsigned w) { return __builtin_bit_cast(float, w & 0xffff0000u); }
__device__ __forceinline__ unsigned pk4_fp8(float a, float b, float c, float d) {
    a = __builtin_amdgcn_fmed3f(a, -448.f, 448.f); b = __builtin_amdgcn_fmed3f(b, -448.f, 448.f); c = __builtin_amdgcn_fmed3f(c, -448.f, 448.f); d = __builtin_amdgcn_fmed3f(d, -448.f, 448.f);
    int w = 0; w = __builtin_amdgcn_cvt_pk_fp8_f32(a, b, w, false); w = __builtin_amdgcn_cvt_pk_fp8_f32(c, d, w, true); return (unsigned)w; }
__device__ __forceinline__ unsigned pk4_i8(float a, float b, float c, float d) {
    const unsigned ua = __builtin_bit_cast(unsigned, a + 12582912.f), ub = __builtin_bit_cast(unsigned, b + 12582912.f), uc = __builtin_bit_cast(unsigned, c + 12582912.f), ud = __builtin_bit_cast(unsigned, d + 12582912.f);
    return __builtin_amdgcn_perm(ub, ua, 0x0c0c0400u) | (__builtin_amdgcn_perm(ud, uc, 0x0c0c0400u) << 16); }
__device__ __forceinline__ float fast_exp2(float x) { return __builtin_amdgcn_exp2f(x); }
__device__ __forceinline__ float silu_f(float g) { return g * __builtin_amdgcn_rcpf(1.0f + __builtin_amdgcn_exp2f(-g * LOG2E)); }
__device__ __forceinline__ float silu2_f(float x) { return x * __builtin_amdgcn_rcpf(1.0f + __builtin_amdgcn_exp2f(-x)); }
__device__ __forceinline__ f32x2 silu2_pk(f32x2 x) { const f32x2 d = (f32x2){__builtin_amdgcn_exp2f(-x[0]), __builtin_amdgcn_exp2f(-x[1])} + 1.0f;
    return x * (f32x2){__builtin_amdgcn_rcpf(d[0]), __builtin_amdgcn_rcpf(d[1])}; }
#define WR_DPP(x, ctrl) __builtin_bit_cast(float, __builtin_amdgcn_update_dpp(0, __builtin_bit_cast(int, (x)), (ctrl), 0xF, 0xF, true))
__device__ __forceinline__ float wr_lane(float v, int l) { return __int_as_float(__builtin_amdgcn_readlane(__float_as_int(v), l)); }
__device__ __forceinline__ float wave_sum(float v) {
    v += WR_DPP(v, 0xB1); v += WR_DPP(v, 0x4E); v += WR_DPP(v, 0x124); v += WR_DPP(v, 0x128);
    return (wr_lane(v, 0) + wr_lane(v, 16)) + (wr_lane(v, 32) + wr_lane(v, 48));
}
__device__ __forceinline__ float wave_max(float v) {
    v = fmaxf(v, WR_DPP(v, 0xB1)); v = fmaxf(v, WR_DPP(v, 0x4E)); v = fmaxf(v, WR_DPP(v, 0x124)); v = fmaxf(v, WR_DPP(v, 0x128));
    return fmaxf(fmaxf(wr_lane(v, 0), wr_lane(v, 16)), fmaxf(wr_lane(v, 32), wr_lane(v, 48)));
}

#define XB_TMO      128
#define XB_XCNT(j)  (256  + 64 * (j))
#define XB_XSUB(j)  (1280 + 64 * (j))
#define XB_XGEN(j)  (2304 + 64 * (j))
#define XB_TOP      3328
#define XB_TOPGEN   3392
#define XCD_BAR_WORDS 3456
#define XB_SPIN_CAP (1u << 24)

__device__ __forceinline__ unsigned xb_ld(unsigned* p)              { return __hip_atomic_load(p, __ATOMIC_RELAXED, __HIP_MEMORY_SCOPE_AGENT); }
__device__ __forceinline__ unsigned xb_add(unsigned* p, unsigned v) { return __hip_atomic_fetch_add(p, v, __ATOMIC_RELAXED, __HIP_MEMORY_SCOPE_AGENT); }
__device__ __forceinline__ unsigned xb_xcc_id() { return (unsigned)__builtin_amdgcn_s_getreg((3 << 11) | 20) & 0xFu; }
#define XB_SPIN(cond, bar) do { unsigned _sp = 0; while (cond) { __builtin_amdgcn_s_sleep(1); \
    if ((++_sp & 255u) == 0u) { if (xb_ld(&(bar)[XB_TMO])) break; if (_sp > XB_SPIN_CAP) { atomicAdd(&(bar)[XB_TMO], 1u); break; } } } } while (0)

struct XcdBarrier {
    unsigned* bar; unsigned x;
    volatile LAS unsigned* st;
};

__device__ __forceinline__ XcdBarrier xcd_barrier_post(unsigned* bar, volatile LAS unsigned* st) {
    XcdBarrier b; b.bar = bar; b.x = xb_xcc_id(); b.st = st;
    if (threadIdx.x == 0) (void)xb_add(&bar[XB_XCNT(b.x)], 1u);
    return b;
}
__device__ __forceinline__ void xcd_barrier_complete(unsigned* bar, unsigned x, unsigned& nloc, unsigned& nx) {
    const unsigned G = gridDim.x * gridDim.y * gridDim.z;
    unsigned sum, cnt, mine, sp = 0u;
    for (;;) {
        sum = 0u; cnt = 0u; mine = 0u;
#pragma unroll
        for (unsigned j = 0; j < 16; ++j) { const unsigned c = xb_ld(&bar[XB_XCNT(j)]); sum += c; cnt += (c > 0u) ? 1u : 0u; mine = (j == x) ? c : mine; }
        if (sum == G) break;
        __builtin_amdgcn_s_sleep(1);
        if ((++sp & 255u) == 0u) { if (xb_ld(&bar[XB_TMO])) break; if (sp > XB_SPIN_CAP) { atomicAdd(&bar[XB_TMO], 1u); break; } }
    }
    nloc = mine > 0u ? mine : 1u; nx = cnt > 0u ? cnt : 1u;
}

__device__ __forceinline__ void xcd_barrier(const XcdBarrier& b) {
    asm volatile("s_waitcnt vmcnt(0)" ::: "memory");
    __syncthreads();
    if (threadIdx.x == 0) {
        unsigned* bar = b.bar;
        __builtin_amdgcn_s_waitcnt(0);
        unsigned nloc = b.st[0], nx = b.st[1];
        if (nloc == 0u) { xcd_barrier_complete(bar, b.x, nloc, nx); b.st[0] = nloc; b.st[1] = nx; }
        const unsigned old = xb_add(&bar[XB_XSUB(b.x)], 1u);
        const unsigned gen = old / nloc;
        if (old + 1u == (gen + 1u) * nloc) {
            __builtin_amdgcn_fence(__ATOMIC_RELEASE, "agent");
            asm volatile("s_waitcnt vmcnt(0)" ::: "memory");
            const unsigned og = xb_add(&bar[XB_TOP], 1u);
            const unsigned tg = og / nx;
            if (og + 1u == (tg + 1u) * nx) xb_add(&bar[XB_TOPGEN], 1u);
            else XB_SPIN(xb_ld(&bar[XB_TOPGEN]) == tg, bar);
            __builtin_amdgcn_fence(__ATOMIC_ACQUIRE, "agent");
            xb_add(&bar[XB_XGEN(b.x)], 1u);
            asm volatile("s_waitcnt vmcnt(0)" ::: "memory");
        } else {
            XB_SPIN(xb_ld(&bar[XB_XGEN(b.x)]) == gen, bar);
            __builtin_amdgcn_fence(__ATOMIC_ACQUIRE, "agent");
            asm volatile("s_waitcnt vmcnt(0)" ::: "memory");
        }
    }
    __syncthreads();
}


struct Args { const float* in[N_IN]; float* out; unsigned char* ws; int ph_lo, ph_hi; };

struct Frame {
    LAS unsigned char* lds;
    volatile LAS unsigned* MISC;
    gu32* ctl;
    int tid, lane, wave, vcu, G, cid;
    unsigned char* ws;
};

namespace pg8 {
struct EpiStore {
    static constexpr bool PERM = true, AFTER_DRAIN = false; static constexpr int NST = 16;
    bf16_t* O; int ldc;
    __device__ __forceinline__ void operator()(const f32x4 (&acc)[2][2][4][2], const Unit& u, int wr, int wc, int fr, int fq) const {
        const int row0 = u.pm * BM + wr * 64 + fr; const int col0 = u.pc * BM + wc * 32 + 8 * fq;
#pragma unroll
        for (int ai = 0; ai < 2; ++ai)
#pragma unroll
            for (int m = 0; m < 4; ++m) { bf16_t* rowp = O + (size_t)(row0 + ai * HALF + m * 16) * ldc + col0;
#pragma unroll
                for (int bj = 0; bj < 2; ++bj) { const f32x4 v0 = acc[ai][bj][m][0], v1 = acc[ai][bj][m][1];
                    u32x4 w; w.x = cvt_pk_bf16(v0[0], v0[1]); w.y = cvt_pk_bf16(v0[2], v0[3]); w.z = cvt_pk_bf16(v1[0], v1[1]); w.w = cvt_pk_bf16(v1[2], v1[3]);
                    *(u32x4*)(rowp + bj * HALF) = w; } }
    }
};
struct EpiSwiglu {
    static constexpr bool PERM = true, AFTER_DRAIN = false; static constexpr int NST = 8;
    bf16_t* O; int ldc;
    __device__ __forceinline__ void operator()(const f32x4 (&acc)[2][2][4][2], const Unit& u, int wr, int wc, int fr, int fq) const {
        const int row0 = u.pm * BM + wr * 64 + fr; const int col0 = u.pc * HALF + wc * 32 + 8 * fq;
#pragma unroll
        for (int ai = 0; ai < 2; ++ai)
#pragma unroll
            for (int m = 0; m < 4; ++m) { bf16_t* rowp = O + (size_t)(row0 + ai * HALF + m * 16) * ldc + col0;
                f32x4 a0, a1;
#pragma unroll
                for (int e = 0; e < 4; ++e) { a0[e] = silu_f(acc[ai][0][m][0][e]) * acc[ai][1][m][0][e]; a1[e] = silu_f(acc[ai][0][m][1][e]) * acc[ai][1][m][1][e]; }
                u32x4 w; w.x = cvt_pk_bf16(a0[0], a0[1]); w.y = cvt_pk_bf16(a0[2], a0[3]); w.z = cvt_pk_bf16(a1[0], a1[1]); w.w = cvt_pk_bf16(a1[2], a1[3]);
                *(u32x4*)rowp = w; }
    }
};

struct EpiQKV0 {
    static constexpr bool PERM = true, AFTER_DRAIN = false; static constexpr int NST = 16;
    bf16_t* Qh; bf16_t* Kh; bf16_t* Vq; const float* tab;
    __device__ __forceinline__ void operator()(const f32x4 (&acc)[2][2][4][2], const Unit& u, int wr, int wc, int fr, int fq) const {
        const int row0 = u.pm * BM + wr * 64 + fr, pc = u.pc;
        if (pc < 8) {
            bf16_t* base = pc < 4 ? Qh + (size_t)pc * MALL * 256 : Kh + (size_t)(pc - 4) * MALL * 256; const float sc = pc < 4 ? 1.0f : 0.0625f; const bool lat = u.pm < NLAT / BM;
            const int col0 = wc * 32 + 8 * fq;
#pragma unroll
            for (int ai = 0; ai < 2; ++ai)
#pragma unroll
                for (int m = 0; m < 4; ++m) { const int row = row0 + ai * HALF + m * 16, t = row & (SEQ - 1);
#pragma unroll
                    for (int bj = 0; bj < 2; ++bj) { f32x4 v0 = acc[ai][bj][m][0], v1 = acc[ai][bj][m][1];
                        if (lat) { const int pos = bj ? (t & 63) : (t >> 6); const float* tp = tab + (size_t)(pos * 64 + 16 * wc + 4 * fq) * 2;
                            const f32x4 c0 = *(const f32x4*)tp, c1 = *(const f32x4*)(tp + 4);
                            v0 = (f32x4){v0[0] * c0[0] - v0[1] * c0[1], v0[1] * c0[0] + v0[0] * c0[1], v0[2] * c0[2] - v0[3] * c0[3], v0[3] * c0[2] + v0[2] * c0[3]};
                            v1 = (f32x4){v1[0] * c1[0] - v1[1] * c1[1], v1[1] * c1[0] + v1[0] * c1[1], v1[2] * c1[2] - v1[3] * c1[3], v1[3] * c1[2] + v1[2] * c1[3]}; }
                        v0 = v0 * sc; v1 = v1 * sc;
                        u32x4 w; w.x = cvt_pk_bf16(v0[0], v0[1]); w.y = cvt_pk_bf16(v0[2], v0[3]); w.z = cvt_pk_bf16(v1[0], v1[1]); w.w = cvt_pk_bf16(v1[2], v1[3]);
                        *(u32x4*)(base + (size_t)row * 256 + col0 + bj * HALF) = w; } }
        } else {
#pragma unroll
            for (int ai = 0; ai < 2; ++ai)
#pragma unroll
                for (int m = 0; m < 4; ++m) { const int row = row0 + ai * HALF + m * 16;
#pragma unroll
                    for (int bj = 0; bj < 2; ++bj) { const f32x4 v0 = acc[ai][bj][m][0], v1 = acc[ai][bj][m][1];
                        u32x4 w; w.x = cvt_pk_bf16(v0[0], v0[1]); w.y = cvt_pk_bf16(v0[2], v0[3]); w.z = cvt_pk_bf16(v1[0], v1[1]); w.w = cvt_pk_bf16(v1[2], v1[3]);
                        *(u32x4*)(Vq + ((size_t)((pc - 8) * 2 + bj) * MALL + row) * 128 + wc * 32 + 8 * fq) = w; } }
        }
    }
};
struct QkvOrder {
    int G, c;
    __device__ __forceinline__ void init(int G_, int c_, int) { G = G_; c = c_; }
    __device__ __forceinline__ bool next(int i, Unit& u) const {
        constexpr int nM = MALL / BM, nN = 2048 / BM, NQK = nM * nN, NV = nM * 4;
        const int L = i * G + c; if (L >= NQK + NV) return false;
        const bool isv = L >= NQK;
        int wgid = isv ? 0 : L; { const int q = NQK / NXCD, xcd = wgid % NXCD, off = wgid / NXCD; wgid = xcd * q + off; }
        const int nig = WGM * nN, gid = wgid / nig, fm = gid * WGM, gsz = (nM - fm) < WGM ? (nM - fm) : WGM;
        const int qpm = fm + ((wgid % nig) % gsz), qpn = (wgid % nig) / gsz;
        const int v = isv ? L - NQK : 0; const int vv = (v % NXCD) * (NV / NXCD) + v / NXCD;
        u.pm = isv ? (vv >> 2) : qpm; u.pn = isv ? (vv >> 2) : qpn; u.pa = isv ? 8 + (vv & 3) : qpm; u.pc = isv ? 8 + (vv & 3) : qpn;
        u.k0 = 0; u.nt = 0; u.ks = -1; u.sw = isv ? 1 : 0; return true;
    }
    __device__ __forceinline__ void a_ready(const Unit&) const {}
    __device__ __forceinline__ void done(const Unit&) const {}
};
static_assert(((MALL / 256) * 8) % 8 == 0, "QkvOrder");
struct EpiQKV1 {
    static constexpr bool PERM = true, AFTER_DRAIN = false; static constexpr int NST = 16;
    unsigned char* Qh; unsigned char* Kh; unsigned char* V8; const float* tab;
    __device__ __forceinline__ void operator()(const f32x4 (&acc)[2][2][4][2], const Unit& u, int wr, int wc, int fr, int fq) const {
        const int row0 = u.pm * BM + wr * 64 + fr, pc = u.pc;
        if (!u.sw) {
            unsigned char* base = pc < 4 ? Qh : Kh; const float sc = pc < 4 ? LOG2E : 1.0f; const bool lat = u.pm < NLAT / BM;
            const int hf = wc & 1, p0 = 32 * hf + 8 * fq;
#pragma unroll
            for (int ai = 0; ai < 2; ++ai)
#pragma unroll
                for (int m = 0; m < 4; ++m) { const int row = row0 + ai * HALF + m * 16, t = row & (SEQ - 1);
                    const int pos = hf ? (t & 63) : (t >> 6); const float* tp = tab + (size_t)(pos * 16 + 4 * fq) * 2;
                    f32x4 c0 = (f32x4){1.f, 0.f, 1.f, 0.f}, c1 = c0;
                    if (lat) { c0 = *(const f32x4*)tp; c1 = *(const f32x4*)(tp + 4); }
#pragma unroll
                    for (int bj = 0; bj < 2; ++bj) { f32x4 v0 = acc[ai][bj][m][0], v1 = acc[ai][bj][m][1];
                        v0 = (f32x4){v0[0] * c0[0] - v0[1] * c0[1], v0[1] * c0[0] + v0[0] * c0[1], v0[2] * c0[2] - v0[3] * c0[3], v0[3] * c0[2] + v0[2] * c0[3]};
                        v1 = (f32x4){v1[0] * c1[0] - v1[1] * c1[1], v1[1] * c1[0] + v1[0] * c1[1], v1[2] * c1[2] - v1[3] * c1[3], v1[3] * c1[2] + v1[2] * c1[3]};
                        v0 = v0 * sc; v1 = v1 * sc;
                        const int head = (pc & 3) * 4 + 2 * bj + (wc >> 1);
                        v2u w; w.x = pk4_fp8(v0[0], v0[1], v0[2], v0[3]); w.y = pk4_fp8(v1[0], v1[1], v1[2], v1[3]);
                        *(v2u*)(base + ((size_t)head * MALL + row) * 64 + p0) = w; } }
        } else {
            const int k0 = 32 * (wc & 1) + 8 * fq, jb = 16 * (k0 >> 5) + 4 * ((k0 >> 3) & 3);
#pragma unroll
            for (int ai = 0; ai < 2; ++ai)
#pragma unroll
                for (int m = 0; m < 4; ++m) { const int n = (pc - 8) * BM + wr * 64 + fr + ai * HALF + m * 16, head = n >> 7, c = n & 127, swz = (c >> 2) & 3;
#pragma unroll
                    for (int bj = 0; bj < 2; ++bj) { const f32x4 v0 = acc[ai][bj][m][0], v1 = acc[ai][bj][m][1];
                        const size_t tile = (size_t)u.pn * 4 + 2 * bj + (wc >> 1);
                        unsigned char* img = V8 + ((size_t)head * (MALL / 64) + tile) * 8192 + c * 64 + (jb & 15);
                        *(unsigned*)(img + (((jb >> 4) ^ swz) << 4)) = pk4_fp8(v0[0], v0[1], v0[2], v0[3]);
                        *(unsigned*)(img + (((2 + (jb >> 4)) ^ swz) << 4)) = pk4_fp8(v1[0], v1[1], v1[2], v1[3]); } }
        }
    }
};

struct EpiGateMerge {
    static constexpr bool PERM = true, AFTER_DRAIN = false; static constexpr int NST = 8;
    bf16_t* Of; const bf16_t* Ob; const float* ssq;
    __device__ __forceinline__ void operator()(const f32x4 (&acc)[2][2][4][2], const Unit& u, int wr, int wc, int fr, int fq) const {
        const int row0 = u.pm * BM + wr * 64 + fr; const int col0 = u.pc * HALF + wc * 32 + 8 * fq; const int head = u.pc >> 2;
        f32x4 sf[3], sb[3]; u32x4 of[3], ob[3];
#define GM_ROWI(it_) ((size_t)(row0 + ((it_) >> 2) * HALF + ((it_) & 3) * 16))
#define GM_LOAD(it_, s_) do { const size_t row_ = GM_ROWI(it_); sf[s_] = *(const f32x4*)(ssq + (row_ * RH + head) * 8); sb[s_] = *(const f32x4*)(ssq + (row_ * RH + head) * 8 + 4); \
            of[s_] = *(const u32x4*)(Of + row_ * 2048 + col0); ob[s_] = *(const u32x4*)(Ob + row_ * 2048 + col0); } while (0)
        GM_LOAD(0, 0); GM_LOAD(1, 1);
#pragma unroll
        for (int it = 0; it < 8; ++it) { const int ai = it >> 2, m = it & 3, s = it % 3; const size_t row = GM_ROWI(it);
            if (it + 2 < 8) GM_LOAD(it + 2, (it + 2) % 3);
            const float rf = __builtin_amdgcn_rsqf(((sf[s][0] + sf[s][1]) + (sf[s][2] + sf[s][3])) * (1.0f / RV) + EPS) * LN2, rb = __builtin_amdgcn_rsqf(((sb[s][0] + sb[s][1]) + (sb[s][2] + sb[s][3])) * (1.0f / RV) + EPS) * LN2;
            f32x2 y[4];
#pragma unroll
            for (int e = 0; e < 4; ++e) {
                const f32x2 gf = (f32x2){acc[ai][0][m][e >> 1][2 * (e & 1)], acc[ai][0][m][e >> 1][2 * (e & 1) + 1]}, gb = (f32x2){acc[ai][1][m][e >> 1][2 * (e & 1)], acc[ai][1][m][e >> 1][2 * (e & 1) + 1]};
                y[e] = silu2_pk(gf) * ((f32x2){bflo(of[s][e]), bfhi(of[s][e])} * rf) + silu2_pk(gb) * ((f32x2){bflo(ob[s][e]), bfhi(ob[s][e])} * rb); }
            u32x4 w; w.x = cvt_pk_bf16(y[0][0], y[0][1]); w.y = cvt_pk_bf16(y[1][0], y[1][1]); w.z = cvt_pk_bf16(y[2][0], y[2][1]); w.w = cvt_pk_bf16(y[3][0], y[3][1]);
            *(u32x4*)(Of + row * 2048 + col0) = w; }
#undef GM_LOAD
#undef GM_ROWI
    }
};

struct SplitOrder {
    StaticOrder lat; int G, c, KS, ntS, nN, nl;
    __device__ __forceinline__ void init(int N, int G_, int c_, int KS_, int ntS_) { lat.init(KS_ ? NLAT : MALL, N, G_, c_); G = G_; c = c_; KS = KS_; ntS = ntS_; nN = N / BM; nl = (lat.nwg > c_) ? (lat.nwg - 1 - c_) / G_ + 1 : 0; }
    __device__ __forceinline__ bool next(int i, Unit& u) const {
        if (i < nl) return lat.next(i, u);
        const long j = (long)(i - nl) * G + c; if (j >= (long)(NCTX / BM) * nN * KS) return false;
        const int tile = (int)(j / KS), ks = (int)(j % KS);
        u.pm = NLAT / BM + tile / nN; u.pn = tile % nN; u.pc = u.pn; u.k0 = ks * ntS * BK; u.nt = ntS; u.ks = ks; u.pa = u.pm; u.sw = 0; return true;
    }
    __device__ __forceinline__ void a_ready(const Unit&) const {}
    __device__ __forceinline__ void done(const Unit&) const {}
};
struct EpiStoreSplit {
    static constexpr bool PERM = true, AFTER_DRAIN = false; static constexpr int NST = 16;
    bf16_t* O; int ldc; float* P;
    __device__ __forceinline__ void operator()(const f32x4 (&acc)[2][2][4][2], const Unit& u, int wr, int wc, int fr, int fq) const {
        const int row0 = u.pm * BM + wr * 64 + fr; const int col0 = u.pc * BM + wc * 32 + 8 * fq;
        if (u.ks < 0) {
#pragma unroll
            for (int ai = 0; ai < 2; ++ai)
#pragma unroll
                for (int m = 0; m < 4; ++m) { bf16_t* rowp = O + (size_t)(row0 + ai * HALF + m * 16) * ldc + col0;
#pragma unroll
                    for (int bj = 0; bj < 2; ++bj) { const f32x4 v0 = acc[ai][bj][m][0], v1 = acc[ai][bj][m][1];
                        u32x4 w; w.x = cvt_pk_bf16(v0[0], v0[1]); w.y = cvt_pk_bf16(v0[2], v0[3]); w.z = cvt_pk_bf16(v1[0], v1[1]); w.w = cvt_pk_bf16(v1[2], v1[3]);
                        *(u32x4*)(rowp + bj * HALF) = w; } }
        } else {
            float* pb = P + (size_t)u.ks * NCTX * ldc;
#pragma unroll
            for (int ai = 0; ai < 2; ++ai)
#pragma unroll
                for (int m = 0; m < 4; ++m) { float* rowp = pb + (size_t)(row0 - NLAT + ai * HALF + m * 16) * ldc + col0;
#pragma unroll
                    for (int bj = 0; bj < 2; ++bj) { *(f32x4*)(rowp + bj * HALF) = acc[ai][bj][m][0]; *(f32x4*)(rowp + bj * HALF + 4) = acc[ai][bj][m][1]; } }
        }
    }
};
struct EpiSwiglu8 {
    static constexpr bool PERM = true, AFTER_DRAIN = false; static constexpr int NST = 8;
    unsigned char* O; int ldc;
    __device__ __forceinline__ void operator()(const f32x4 (&acc)[2][2][4][2], const Unit& u, int wr, int wc, int fr, int fq) const {
        const int row0 = u.pm * BM + wr * 64 + fr; const int col0 = u.pc * HALF + wc * 32 + 8 * fq;
#pragma unroll
        for (int ai = 0; ai < 2; ++ai)
#pragma unroll
            for (int m = 0; m < 4; ++m) { unsigned char* rowp = O + (size_t)(row0 + ai * HALF + m * 16) * ldc + col0;
                const f32x4 g0 = acc[ai][0][m][0], g1 = acc[ai][0][m][1], u0 = acc[ai][1][m][0], u1 = acc[ai][1][m][1];
                const f32x2 p0 = silu2_pk((f32x2){g0[0], g0[1]}) * (f32x2){u0[0], u0[1]}, p1 = silu2_pk((f32x2){g0[2], g0[3]}) * (f32x2){u0[2], u0[3]};
                const f32x2 p2 = silu2_pk((f32x2){g1[0], g1[1]}) * (f32x2){u1[0], u1[1]}, p3 = silu2_pk((f32x2){g1[2], g1[3]}) * (f32x2){u1[2], u1[3]};
                v2u w; w.x = pk4_fp8(p0[0], p0[1], p1[0], p1[1]); w.y = pk4_fp8(p2[0], p2[1], p3[0], p3[1]);
                *(v2u*)rowp = w; }
    }
};
struct EpiNull {
    static constexpr bool PERM = true, AFTER_DRAIN = false; static constexpr int NST = 1;
    float* O;
    __device__ __forceinline__ void operator()(const f32x4 (&acc)[2][2][4][2], const Unit& u, int wr, int wc, int fr, int fq) const {
#pragma unroll
        for (int ai = 0; ai < 2; ++ai)
#pragma unroll
            for (int bj = 0; bj < 2; ++bj)
#pragma unroll
                for (int m = 0; m < 4; ++m) { asm volatile("" :: "v"(acc[ai][bj][m][0]), "v"(acc[ai][bj][m][1])); }
        const f32x4 s = acc[0][0][0][0];
        O[(size_t)(u.pm & 7) * 65536 + (wr * 4 + wc) * 64 + fr + 16 * fq] = (s[0] + s[1]) + (s[2] + s[3]);
    }
};
struct MoeOrder {
    int nM, nN, nwg, G, c; int t1, t2, t3, t4, t5, t6, t7; int rep, slots;
    __device__ __forceinline__ bool next(int i, Unit& u) const {
        long L = (long)i * G + c; if (L >= (long)nwg * rep) return false; if (L >= nwg) L -= nwg;
        int wgid = (int)L; { const int q = nwg / NXCD, r = nwg % NXCD, xcd = wgid % NXCD, off = wgid / NXCD; wgid = (xcd < r ? xcd * (q + 1) : r * (q + 1) + (xcd - r) * q) + off; }
        const int nig = WGM * nN, gid = wgid / nig, fm = gid * WGM, gsz = (nM - fm) < WGM ? (nM - fm) : WGM;
        u.pm = fm + ((wgid % nig) % gsz); u.pc = (wgid % nig) / gsz;
        const int e = (u.pm >= t1) + (u.pm >= t2) + (u.pm >= t3) + (u.pm >= t4) + (u.pm >= t5) + (u.pm >= t6) + (u.pm >= t7);
        u.pn = e * nN + u.pc; u.k0 = 0; u.nt = 0; u.ks = -1;
        const int te = e == 0 ? 0 : e == 1 ? t1 : e == 2 ? t2 : e == 3 ? t3 : e == 4 ? t4 : e == 5 ? t5 : e == 6 ? t6 : t7;
        u.pa = slots ? e * (NLAT / BM) + (u.pm - te) : u.pm; u.sw = 0; return true;
    }
    __device__ __forceinline__ void a_ready(const Unit&) const {}
    __device__ __forceinline__ void done(const Unit&) const {}
};
}

__device__ __forceinline__ int swiglu_row(int n, int F) { const int bj = n / F, w = n % F; return 256 * (w >> 7) + 128 * bj + (w & 127); }
__device__ __forceinline__ int w_rowmap(int map, int mapF, int n) {
    if (map == 1) { if (n < 2048) { const int d0 = n & 255, hf = d0 >> 7, e = d0 & 127; return (n - d0) + 2 * (hf * 64 + (e & 63)) + (e >> 6); }
                    if (n >= 4096) return 4096 + swiglu_row(n - 4096, 2048); return n; }
    if (map == 2) { if (n < 2048) { const int d0 = n & 63, hf = d0 >> 5, e = d0 & 31; return (n - d0) + hf * 32 + 2 * (e & 15) + (e >> 4); } return n; }
    if (map == 3) return swiglu_row(n, mapF);
    return n;
}
template <bool FP8> __device__ __forceinline__ void p0_item64(const float* W, int K, int N, void* WT, int map, int mapF, LAS float* scr, int k0, int n0, int lane, float wscale) {
    { const int kq = lane >> 4, n4 = (lane & 15) * 4;
#pragma unroll 4
      for (int i = 0; i < 16; ++i) { const int k = 4 * i + kq; const f32x4 v = *(const GAS f32x4*)(W + (size_t)(k0 + k) * N + n0 + n4);
          LAS float* d = scr + k * 65 + n4; d[0] = v.x; d[1] = v.y; d[2] = v.z; d[3] = v.w; } }
    LDS_WAIT(); asm volatile("" ::: "memory");
    if constexpr (!FP8) {
        const int c = lane & 7;
#pragma unroll
        for (int j = 0; j < 8; ++j) { const int n = (lane >> 3) + 8 * j; const LAS float* sp = scr + (8 * c) * 65 + n;
            v4u o; o.x = pk2(sp[0 * 65], sp[1 * 65]); o.y = pk2(sp[2 * 65], sp[3 * 65]); o.z = pk2(sp[4 * 65], sp[5 * 65]); o.w = pk2(sp[6 * 65], sp[7 * 65]);
            *(GAS v4u*)((bf16*)WT + (size_t)w_rowmap(map, mapF, n0 + n) * K + k0 + 8 * c) = o; }
    } else {
        const int c = lane & 3;
#pragma unroll
        for (int j = 0; j < 4; ++j) { const int n = (lane >> 2) + 16 * j; const LAS float* sp = scr + (16 * c) * 65 + n;
            v4u o;
#pragma unroll
            for (int q = 0; q < 4; ++q) o[q] = pk4_fp8(sp[(4 * q) * 65] * wscale, sp[(4 * q + 1) * 65] * wscale, sp[(4 * q + 2) * 65] * wscale, sp[(4 * q + 3) * 65] * wscale);
            *(GAS v4u*)((unsigned char*)WT + (size_t)w_rowmap(map, mapF, n0 + n) * K + k0 + 16 * c) = o; }
    }
    LDS_WAIT(); asm volatile("" ::: "memory");
}

struct ColItem { const float* W; unsigned char* WT; float* WSC; int N, map, mapF, n0; };
__device__ __forceinline__ bool p0_coldesc(const Frame& F, const Args& a, int ci, ColItem& d) {
    constexpr int C0 = 8192 / 32, C1 = 2 * DFF / 32, C2 = 3072 / 32, C3 = 2 * DFE / 32;
    if (ci >= C0 + C1 + C2 + NE * C3) return false;
    int c = ci;
    if (c < C0) { d.W = a.in[I_L0_WIN]; d.N = 8192; d.WT = F.ws + WS_W0IN; d.WSC = (float*)(F.ws + WS_WSC0); d.map = 1; d.mapF = 0; }
    else if ((c -= C0) < C1) { d.W = a.in[I_L0_WGU]; d.N = 2 * DFF; d.WT = F.ws + WS_W0GU; d.WSC = (float*)(F.ws + WS_WSC2); d.map = 3; d.mapF = DFF; }
    else if ((c -= C1) < C2) { d.W = a.in[I_L1_WIN]; d.N = 3072; d.WT = F.ws + WS_W1IN; d.WSC = (float*)(F.ws + WS_WSC1); d.map = 2; d.mapF = 0; }
    else { c -= C2; const int e = c / C3; c = c % C3; d.W = a.in[I_L1_MGU] + (size_t)e * D * 2 * DFE; d.N = 2 * DFE; d.WT = F.ws + WS_WMGU + (size_t)e * 2 * DFE * D; d.WSC = (float*)(F.ws + WS_WSCM) + e * 2 * DFE; d.map = 3; d.mapF = DFE; }
    d.n0 = 32 * c; return true;
}
__device__ __forceinline__ void p0_colpass(Frame& F, const Args& a) {
    LAS float* T = (LAS float*)F.lds;
    LAS float* mx = (LAS float*)(F.lds + 1024 * 33 * 4);
    const int t = F.tid, n4 = (t & 7) * 4, krow = t >> 3;
    const int qn = t & 31, kc = t >> 5;
    ColItem cur, nxt; int ci = F.vcu;
    bool have = p0_coldesc(F, a, ci, cur);
    f32x4 v[16];
#define P0_LOAD(d_) do { const float* wp_ = (d_).W + (size_t)krow * (d_).N + (d_).n0 + n4; _Pragma("unroll") for (int i = 0; i < 16; ++i) v[i] = *(const GAS f32x4*)(wp_ + (size_t)(64 * i) * (d_).N); } while (0)
    if (have) P0_LOAD(cur);
    while (have) {
        f32x4 m4 = (f32x4){0.f, 0.f, 0.f, 0.f};
#pragma unroll
        for (int i = 0; i < 16; ++i) { LAS float* d = T + (64 * i + krow) * 33 + n4; d[0] = v[i].x; d[1] = v[i].y; d[2] = v[i].z; d[3] = v[i].w;
            m4.x = fmaxf(m4.x, fabsf(v[i].x)); m4.y = fmaxf(m4.y, fabsf(v[i].y)); m4.z = fmaxf(m4.z, fabsf(v[i].z)); m4.w = fmaxf(m4.w, fabsf(v[i].w)); }
#pragma unroll
        for (int e = 0; e < 4; ++e) { float x = m4[e]; x = fmaxf(x, __shfl_xor(x, 8)); x = fmaxf(x, __shfl_xor(x, 16)); x = fmaxf(x, __shfl_xor(x, 32)); m4[e] = x; }
        if (F.lane < 8) *(LAS f32x4*)(mx + F.wave * 32 + n4) = m4;
        __syncthreads();
        ci += F.G; const bool hn = p0_coldesc(F, a, ci, nxt); if (hn) P0_LOAD(nxt);
        float cm = 0.f;
#pragma unroll
        for (int j = 0; j < 8; ++j) cm = fmaxf(cm, mx[j * 32 + qn]);
        const float iv = cm > 0.f ? 127.0f / cm : 0.f;
        const int row = w_rowmap(cur.map, cur.mapF, cur.n0 + qn);
        const float wf = cur.map == 3 ? (((row >> 7) & 1) ? LN2 : LOG2E) : (cur.map == 1 && row >= 4096) ? LOG2E : 1.0f;
        if (t < 32) cur.WSC[row] = cm * (1.0f / 127.0f) * wf;
#pragma unroll
        for (int j = 0; j < 4; ++j) { const int k0 = 16 * (kc + 16 * j); const LAS float* sp = T + k0 * 33 + qn;
            v4u o;
#pragma unroll
            for (int q = 0; q < 4; ++q) o[q] = pk4_i8(sp[(4 * q) * 33] * iv, sp[(4 * q + 1) * 33] * iv, sp[(4 * q + 2) * 33] * iv, sp[(4 * q + 3) * 33] * iv);
            *(GAS v4u*)(cur.WT + (size_t)row * 1024 + k0) = o; }
        __syncthreads();
        cur = nxt; have = hn;
    }
#undef P0_LOAD
}

__device__ __forceinline__ void p0_prologue(Frame& F, const Args& a) {
    LAS float* scr = (LAS float*)(F.lds + F.wave * 16640);
    const int gw = F.vcu * NWAVES + F.wave, NGW = F.G * NWAVES;
    constexpr int I1 = (2048 / 64) * (D / 64), I3 = (DFF / 64) * (D / 64), I5 = (D / 64) * (D / 64);
    constexpr int I7E = (DFE / 64) * (D / 64);
    constexpr int NITEMS = I1 + I3 + I5 + NE * I7E;
    for (int rep_ = 0; rep_ < DUP(24); ++rep_) p0_colpass(F, a);
    for (int rep_ = 0; rep_ < DUP(25); ++rep_) {
        struct WItem { const float* W; unsigned char* WT; int K, N, k0, n0, fp8; float ws; };
        auto wdesc = [&](int it, WItem& d) __attribute__((always_inline)) {
            int r = it;
            if (r < I1) { d.W = a.in[I_L0_WOUT]; d.K = 2048; d.N = D; d.WT = F.ws + WS_W0OUT; d.fp8 = 0; d.ws = 1.f; }
            else if ((r -= I1) < I3) { d.W = a.in[I_L0_WDN]; d.K = DFF; d.N = D; d.WT = F.ws + WS_W0DN; d.fp8 = 1; d.ws = MOE_WSCALE; }
            else if ((r -= I3) < I5) { d.W = a.in[I_L1_WOUT]; d.K = D; d.N = D; d.WT = F.ws + WS_W1OUT; d.fp8 = 1; d.ws = MOE_WSCALE; }
            else { r -= I5; const int e = r / I7E; r = r % I7E; d.W = a.in[I_L1_MDN] + (size_t)e * DFE * D; d.K = DFE; d.N = D; d.WT = F.ws + WS_WMDN + (size_t)e * D * DFE; d.fp8 = 1; d.ws = MOE_WSCALE; }
            d.n0 = 64 * (r % (D / 64)); d.k0 = 64 * (r / (D / 64)); };
        const int kq = F.lane >> 4, n4 = (F.lane & 15) * 4;
        auto wload = [&](const WItem& d, f32x4 (&v)[16]) __attribute__((always_inline)) {
#pragma unroll
            for (int i = 0; i < 16; ++i) v[i] = *(const GAS f32x4*)(d.W + (size_t)(d.k0 + 4 * i + kq) * d.N + d.n0 + n4); };
        auto wproc = [&](const WItem& d, const f32x4 (&v)[16]) __attribute__((always_inline)) {
#pragma unroll
            for (int i = 0; i < 16; ++i) { LAS float* q = scr + (4 * i + kq) * 65 + n4; q[0] = v[i].x; q[1] = v[i].y; q[2] = v[i].z; q[3] = v[i].w; }
            LDS_WAIT(); asm volatile("" ::: "memory");
            if (!d.fp8) { const int c = F.lane & 7;
#pragma unroll
                for (int j = 0; j < 8; ++j) { const int n = (F.lane >> 3) + 8 * j; const LAS float* sp = scr + (8 * c) * 65 + n;
                    v4u o; o.x = pk2(sp[0 * 65], sp[1 * 65]); o.y = pk2(sp[2 * 65], sp[3 * 65]); o.z = pk2(sp[4 * 65], sp[5 * 65]); o.w = pk2(sp[6 * 65], sp[7 * 65]);
                    *(GAS v4u*)((bf16*)d.WT + (size_t)(d.n0 + n) * d.K + d.k0 + 8 * c) = o; }
            } else { const int c = F.lane & 3; const float wscale = d.ws;
#pragma unroll
                for (int j = 0; j < 4; ++j) { const int n = (F.lane >> 2) + 16 * j; const LAS float* sp = scr + (16 * c) * 65 + n;
                    v4u o;
#pragma unroll
                    for (int q = 0; q < 4; ++q) o[q] = pk4_fp8(sp[(4 * q) * 65] * wscale, sp[(4 * q + 1) * 65] * wscale, sp[(4 * q + 2) * 65] * wscale, sp[(4 * q + 3) * 65] * wscale);
                    *(GAS v4u*)(d.WT + (size_t)(d.n0 + n) * d.K + d.k0 + 16 * c) = o; }
            }
            LDS_WAIT(); asm volatile("" ::: "memory"); };
        WItem dc, dn; f32x4 vc[16], vn[16];
        int it = gw;
        if (it < NITEMS) { wdesc(it, dc); wload(dc, vc); }
        for (; it < NITEMS; it += NGW) {
            const int itn = it + NGW;
            if (itn < NITEMS) { wdesc(itn, dn); wload(dn, vn); }
            wproc(dc, vc);
            dc = dn;
#pragma unroll
            for (int i = 0; i < 16; ++i) vc[i] = vn[i];
        }
    }
    __syncthreads();
    {
        LAS float* sc = (LAS float*)F.lds;
        LAS float* part = (LAS float*)(F.lds + 9 * 1024 * 4);
        bool loaded = false;
        for (int rep_ = 0; rep_ < DUP(26); ++rep_)
        for (int grp = F.vcu; grp < 2 * (6 * D / 64); grp += F.G) {
            const int layer = grp / (6 * D / 64), cb = (grp % (6 * D / 64)) * 64;
            const float* W = a.in[layer ? I_L1_WMOD : I_L0_WMOD]; const float* bm = a.in[layer ? I_L1_BMOD : I_L0_BMOD];
            const int ks = F.tid >> 6, col = F.tid & 63;
            const float* wp = W + (size_t)(ks * 128) * (6 * D) + cb + col;
            float wv0[16], wv1[16];
#pragma unroll
            for (int i = 0; i < 16; ++i) wv0[i] = wp[(size_t)i * (6 * D)];
#pragma unroll
            for (int i = 0; i < 16; ++i) wv1[i] = wp[(size_t)(16 + i) * (6 * D)];
            if (!loaded) { float cv[18];
#pragma unroll
                for (int j = 0; j < 18; ++j) { const int i = F.tid + j * NTHREADS; cv[j] = (j < 16) ? a.in[I_C][i] : a.in[I_CCTX][i - 8 * 1024]; }
#pragma unroll
                for (int j = 0; j < 18; ++j) sc[F.tid + j * NTHREADS] = silu_f(cv[j]);
                loaded = true; }
            __syncthreads();
            float acc[9];
#pragma unroll
            for (int b = 0; b < 9; ++b) acc[b] = 0.f;
#define P0_MODV_USE(wv_, kk_) do { _Pragma("unroll") for (int i = 0; i < 16; i += 4) _Pragma("unroll") for (int b = 0; b < 9; ++b) { const f32x4 s4 = *(const LAS f32x4*)(sc + b * 1024 + ks * 128 + (kk_) + i); \
                acc[b] += (s4.x * wv_[i] + s4.y * wv_[i + 1]) + (s4.z * wv_[i + 2] + s4.w * wv_[i + 3]); } } while (0)
#pragma unroll
            for (int kb = 0; kb < 8; kb += 2) {
                P0_MODV_USE(wv0, 16 * kb);
                if (kb + 2 < 8) {
#pragma unroll
                    for (int i = 0; i < 16; ++i) wv0[i] = wp[(size_t)(16 * (kb + 2) + i) * (6 * D)]; }
                P0_MODV_USE(wv1, 16 * (kb + 1));
                if (kb + 3 < 8) {
#pragma unroll
                    for (int i = 0; i < 16; ++i) wv1[i] = wp[(size_t)(16 * (kb + 3) + i) * (6 * D)]; }
            }
#undef P0_MODV_USE
#pragma unroll
            for (int b = 0; b < 9; ++b) part[(ks * 9 + b) * 64 + col] = acc[b];
            __syncthreads();
            for (int o = F.tid; o < 9 * 64; o += NTHREADS) { const int b = o >> 6, cc = o & 63; float s = bm[cb + cc];
#pragma unroll
                for (int k2 = 0; k2 < 8; ++k2) s += part[(k2 * 9 + b) * 64 + cc];
                ((float*)(F.ws + WS_MODV))[((size_t)layer * 9 + b) * (6 * D) + cb + cc] = s; }
            __syncthreads();
        }
    }
    {
        const int gt = F.vcu * NTHREADS + F.tid;
        if (gt < 64 * 64 + 64 * 16) {
            int pos, i; float ex;
            if (gt < 4096) { pos = gt >> 6; i = gt & 63; ex = (float)(2 * i) / 128.0f; } else { const int q = gt - 4096; pos = q >> 4; i = q & 15; ex = (float)(2 * i) / 32.0f; }
            const float freq = __builtin_amdgcn_exp2f(-ex * 13.287712379549449f);
            const float rev = (float)pos * freq * 0.15915494309189535f;
            const float cs = __builtin_amdgcn_cosf(rev), sn = __builtin_amdgcn_sinf(rev);
            f32x2* t = (f32x2*)(F.ws + (gt < 4096 ? WS_TAB0 : WS_TAB1)); t[gt < 4096 ? gt : gt - 4096] = (f32x2){cs, sn};
        }
        if (gt < 64) { const float* lp = a.in[I_L1_LAMBDA]; const float s1 = wave_sum(lp[gt] * lp[64 + gt]), s2 = wave_sum(lp[128 + gt] * lp[192 + gt]);
            if (gt == 0) *(float*)(F.ws + WS_LAM) = __expf(s1) - __expf(s2) + LAMBDA_INIT; }
    }
}

struct RowPass {
    int nrows;
    const float* xin_lat; const float* xin_ctx; float* xout_lat; float* xout_ctx;
    const bf16* br;
    const float* gpost;
    const float* gate;
    const float* gpre;
    const float* shift; const float* scale;
    bf16* hout;
    const float* part;
    float* rsc;
};
template <bool BR, bool MOEBR, bool WH, bool ROUTE, int H8 = 0, int KSPL = 0, bool XI16 = false, bool XO16 = false>
__device__ __forceinline__ void row_pass(Frame& F, const Args& a, const RowPass& P) {
    const int gw = F.vcu * NWAVES + F.wave, NGW = F.G * NWAVES;
    const int l4 = F.lane * 4;
    int mbase[NE];
    if constexpr (MOEBR) { int acc_ = 0;
#pragma unroll
        for (int e = 0; e < NE; ++e) { mbase[e] = acc_; acc_ += ((int)__builtin_amdgcn_readfirstlane((int)__hip_atomic_load((unsigned*)(F.ctl + CW_MOECNT + 64 * e), RLX_AGENT)) + 255) & ~255; } }
    static_assert(KSPL == 0, "the split-K partial slabs are not supported by the prefetching row pass");
    struct Raw { f32x4 xf[4]; v2u xh[4], ya[4], yb[4]; float w0, w1; };
    struct Rt { int e0, e1, p0, p1; float w0, w1; };
    auto route_load = [&](int r, Rt& t) __attribute__((always_inline)) {
        const int* te = (const int*)(F.ws + WS_ROUTE); const int* tpos = (const int*)(F.ws + WS_ROUTE + (size_t)NLAT * 8); const float* tw = (const float*)(F.ws + WS_ROUTE + (size_t)NLAT * 16);
        t.e0 = te[2 * r]; t.e1 = te[2 * r + 1]; t.p0 = tpos[2 * r]; t.p1 = tpos[2 * r + 1]; t.w0 = tw[2 * r]; t.w1 = tw[2 * r + 1]; };
    auto raw_load = [&](int r, const Rt& t, Raw& R) __attribute__((always_inline)) {
        const bool lat = r < NLAT; const int rc = lat ? r : r - NLAT;
        const float* xin = (lat ? P.xin_lat : P.xin_ctx) + (size_t)rc * (XI16 ? D / 2 : D);
        if constexpr (XI16) {
#pragma unroll
            for (int j = 0; j < 4; ++j) R.xh[j] = *(const GAS v2u*)((const bf16*)xin + l4 + 256 * j);
        } else {
#pragma unroll
            for (int j = 0; j < 4; ++j) R.xf[j] = *(const GAS f32x4*)(xin + l4 + 256 * j);
        }
        if constexpr (BR) {
#pragma unroll
            for (int j = 0; j < 4; ++j) R.ya[j] = *(const GAS v2u*)(P.br + (size_t)r * D + l4 + 256 * j);
        }
        if constexpr (MOEBR) {
            int b0 = 0, b1 = 0;
#pragma unroll
            for (int e = 0; e < NE; ++e) { b0 = (t.e0 == e) ? mbase[e] : b0; b1 = (t.e1 == e) ? mbase[e] : b1; }
            const int s0 = b0 + t.p0, s1 = b1 + t.p1; R.w0 = t.w0; R.w1 = t.w1;
#pragma unroll
            for (int j = 0; j < 4; ++j) { R.ya[j] = *(const GAS v2u*)(P.br + (size_t)s0 * D + l4 + 256 * j); R.yb[j] = *(const GAS v2u*)(P.br + (size_t)s1 * D + l4 + 256 * j); }
        } };
    LAS float* prm = (LAS float*)(F.lds + 32768);
    {
        if constexpr (BR || MOEBR) { for (int i = F.tid * 4; i < D; i += NTHREADS * 4) *(LAS f32x4*)(prm + i) = *(const GAS f32x4*)(P.gpost + i);
            for (int i = F.tid * 4; i < 9 * D; i += NTHREADS * 4) { const int b_ = i >> 10, c_ = i & (D - 1); *(LAS f32x4*)(prm + 2 * D + i) = *(const GAS f32x4*)(P.gate + (size_t)b_ * 6 * D + c_); } }
        if constexpr (WH) { for (int i = F.tid * 4; i < D; i += NTHREADS * 4) *(LAS f32x4*)(prm + D + i) = *(const GAS f32x4*)(P.gpre + i);
            for (int i = F.tid * 4; i < 9 * D; i += NTHREADS * 4) { const int b_ = i >> 10, c_ = i & (D - 1);
                *(LAS f32x4*)(prm + 11 * D + i) = *(const GAS f32x4*)(P.scale + (size_t)b_ * 6 * D + c_); *(LAS f32x4*)(prm + 20 * D + i) = *(const GAS f32x4*)(P.shift + (size_t)b_ * 6 * D + c_); } }
        __syncthreads();
    }
    LAS float* rwl = (LAS float*)F.lds;
    if constexpr (ROUTE) { const float* rw = a.in[I_L1_RW];
        for (int k = F.tid; k < D; k += NTHREADS) { const f32x4 wa = *(const GAS f32x4*)(rw + (size_t)k * 8), wb = *(const GAS f32x4*)(rw + (size_t)k * 8 + 4);
            rwl[0 * D + k] = wa.x; rwl[1 * D + k] = wa.y; rwl[2 * D + k] = wa.z; rwl[3 * D + k] = wa.w; rwl[4 * D + k] = wb.x; rwl[5 * D + k] = wb.y; rwl[6 * D + k] = wb.z; rwl[7 * D + k] = wb.w; }
        __syncthreads(); }
    unsigned pq_w[4] = {0u, 0u, 0u, 0u}; float pq_s = 0.f; int pq_i1 = 0, pq_i2 = 0, pq_r = -1; unsigned pq_p1 = 0, pq_p2 = 0;
    auto route_flush = [&]() __attribute__((always_inline)) {
        if (pq_r >= 0) {
            const unsigned q1 = (unsigned)__builtin_amdgcn_readfirstlane((int)pq_p1), q2 = (unsigned)__builtin_amdgcn_readfirstlane((int)pq_p2);
            const size_t s1 = (size_t)pq_i1 * NLAT + q1, s2 = (size_t)pq_i2 * NLAT + q2;
            unsigned char* hp = F.ws + WS_HP; float* rs = (float*)(F.ws + WS_RSCM);
#pragma unroll
            for (int j = 0; j < 4; ++j) { *(GAS unsigned*)(hp + s1 * D + l4 + 256 * j) = pq_w[j]; *(GAS unsigned*)(hp + s2 * D + l4 + 256 * j) = pq_w[j]; }
            if (F.lane == 0) { rs[s1] = pq_s; rs[s2] = pq_s; int* tpos = (int*)(F.ws + WS_ROUTE + (size_t)NLAT * 8); tpos[2 * pq_r] = (int)q1; tpos[2 * pq_r + 1] = (int)q2; }
        } };
    Raw cur, nxt, nx2; Rt rtA, rtB;
    if (gw < P.nrows) { if constexpr (MOEBR) route_load(gw, rtA); raw_load(gw, rtA, cur); }
    if (gw + NGW < P.nrows) { if constexpr (MOEBR) route_load(gw + NGW, rtA); raw_load(gw + NGW, rtA, nxt); }
    if constexpr (MOEBR) { if (gw + 2 * NGW < P.nrows) route_load(gw + 2 * NGW, rtA); }
    for (int r = gw; r < P.nrows; r += NGW) {
        const int rn = r + 2 * NGW;
        if (rn < P.nrows) { raw_load(rn, rtA, nx2); if constexpr (MOEBR) { if (rn + NGW < P.nrows) route_load(rn + NGW, rtB); } }
        const bool lat = r < NLAT; const int rc = lat ? r : r - NLAT; const int midx = lat ? (r >> 12) : 8;
        float* xout = (lat ? P.xout_lat : P.xout_ctx) + (size_t)rc * (XO16 ? D / 2 : D);
        f32x4 v[4];
        if constexpr (XI16) {
#pragma unroll
            for (int j = 0; j < 4; ++j) { const v2u w = cur.xh[j]; v[j] = (f32x4){bflo(w.x), bfhi(w.x), bflo(w.y), bfhi(w.y)}; }
        } else {
#pragma unroll
            for (int j = 0; j < 4; ++j) v[j] = cur.xf[j];
        }
        if constexpr (BR || MOEBR) {
            f32x4 y[4];
            if constexpr (BR) {
#pragma unroll
                for (int j = 0; j < 4; ++j) { const v2u w = cur.ya[j]; y[j] = (f32x4){bflo(w.x), bfhi(w.x), bflo(w.y), bfhi(w.y)}; }
            } else {
                const float w0 = cur.w0, w1 = cur.w1;
#pragma unroll
                for (int j = 0; j < 4; ++j) { const v2u p = cur.ya[j]; const v2u q = cur.yb[j];
                    y[j] = (f32x4){w0 * bflo(p.x) + w1 * bflo(q.x), w0 * bfhi(p.x) + w1 * bfhi(q.x), w0 * bflo(p.y) + w1 * bflo(q.y), w0 * bfhi(p.y) + w1 * bfhi(q.y)}; }
            }
            float ss = 0.f;
#pragma unroll
            for (int j = 0; j < 4; ++j) ss += (y[j].x * y[j].x + y[j].y * y[j].y) + (y[j].z * y[j].z + y[j].w * y[j].w);
            const float rstd = __builtin_amdgcn_rsqf(wave_sum(ss) * (1.0f / D) + EPS);
#pragma unroll
            for (int j = 0; j < 4; ++j) { __builtin_amdgcn_sched_barrier(0); const f32x4 gp = *(const LAS f32x4*)(prm + l4 + 256 * j); const f32x4 gt = *(const LAS f32x4*)(prm + (2 + midx) * D + l4 + 256 * j);
                v[j] = v[j] + gt * (y[j] * rstd * gp); }
            if ((lat ? P.xout_lat : P.xout_ctx) != nullptr) {
                if constexpr (XO16) {
#pragma unroll
                    for (int j = 0; j < 4; ++j) { v2u w; w.x = pk2(v[j].x, v[j].y); w.y = pk2(v[j].z, v[j].w); *(GAS v2u*)((bf16*)xout + l4 + 256 * j) = w; }
                } else {
#pragma unroll
                    for (int j = 0; j < 4; ++j) *(GAS f32x4*)(xout + l4 + 256 * j) = v[j];
                }
            }
        }
        if constexpr (WH) {
            float ss = 0.f;
#pragma unroll
            for (int j = 0; j < 4; ++j) ss += (v[j].x * v[j].x + v[j].y * v[j].y) + (v[j].z * v[j].z + v[j].w * v[j].w);
            const float rstd = __builtin_amdgcn_rsqf(wave_sum(ss) * (1.0f / D) + EPS);
            f32x4 h[4];
#pragma unroll
            for (int j = 0; j < 4; ++j) { __builtin_amdgcn_sched_barrier(0); const f32x4 gp = *(const LAS f32x4*)(prm + D + l4 + 256 * j); const f32x4 sc = *(const LAS f32x4*)(prm + (11 + midx) * D + l4 + 256 * j);
                const f32x4 sh = *(const LAS f32x4*)(prm + (20 + midx) * D + l4 + 256 * j);
                h[j] = (v[j] * rstd * gp) * (1.0f + sc) + sh;
                if constexpr (H8 == 2) { }
                else if constexpr (H8 == 1) { *(GAS unsigned*)((unsigned char*)P.hout + (size_t)r * D + l4 + 256 * j) = pk4_fp8(h[j].x, h[j].y, h[j].z, h[j].w); }
                else { v2u w; w.x = pk2(h[j].x, h[j].y); w.y = pk2(h[j].z, h[j].w); *(GAS v2u*)(P.hout + (size_t)r * D + l4 + 256 * j) = w; } }
            unsigned qw[4]; float qs = 0.f;
            if constexpr (H8 == 2) {
                float am = 0.f;
#pragma unroll
                for (int j = 0; j < 4; ++j) am = fmaxf(fmaxf(am, fmaxf(fabsf(h[j].x), fabsf(h[j].y))), fmaxf(fabsf(h[j].z), fabsf(h[j].w)));
                am = wave_max(am);
                const float iv = am > 0.f ? 127.0f / am : 0.f;
#pragma unroll
                for (int j = 0; j < 4; ++j) qw[j] = pk4_i8(h[j].x * iv, h[j].y * iv, h[j].z * iv, h[j].w * iv);
                qs = am * (1.0f / 127.0f);
                if constexpr (!ROUTE) {
#pragma unroll
                    for (int j = 0; j < 4; ++j) *(GAS unsigned*)((unsigned char*)P.hout + (size_t)r * D + l4 + 256 * j) = qw[j];
                    if (F.lane == 0) P.rsc[r] = qs; }
            }
            if constexpr (ROUTE) {
                float lg[8];
#pragma unroll
                for (int e = 0; e < 8; ++e) lg[e] = 0.f;
#pragma unroll
                for (int j = 0; j < 4; ++j)
#pragma unroll
                    for (int e = 0; e < 8; ++e) { const f32x4 w4 = *(const LAS f32x4*)(rwl + e * D + l4 + 256 * j);
                        lg[e] += (h[j].x * w4.x + h[j].y * w4.y) + (h[j].z * w4.z + h[j].w * w4.w); }
#pragma unroll
                for (int e = 0; e < 8; ++e) lg[e] = wave_sum(lg[e]) + a.in[I_L1_RB][e];
                float v1 = lg[0]; int i1 = 0;
#pragma unroll
                for (int e = 1; e < 8; ++e) if (lg[e] > v1) { v1 = lg[e]; i1 = e; }
                float v2 = -3.0e38f; int i2 = 0;
#pragma unroll
                for (int e = 0; e < 8; ++e) if (e != i1 && lg[e] > v2) { v2 = lg[e]; i2 = e; }
                const float w1 = 1.0f / (1.0f + __expf(v2 - v1)), w2 = 1.0f - w1;
                unsigned p1 = 0, p2 = 0;
                if (F.lane == 0) {
                    int* te = (int*)(F.ws + WS_ROUTE); int* tpos = (int*)(F.ws + WS_ROUTE + (size_t)NLAT * 8); float* tw = (float*)(F.ws + WS_ROUTE + (size_t)NLAT * 16);
                    p1 = __hip_atomic_fetch_add((unsigned*)(F.ctl + CW_MOECNT + 64 * i1), 1u, RLX_AGENT);
                    p2 = __hip_atomic_fetch_add((unsigned*)(F.ctl + CW_MOECNT + 64 * i2), 1u, RLX_AGENT);
                    te[2 * r] = i1; te[2 * r + 1] = i2; tw[2 * r] = w1; tw[2 * r + 1] = w2;
                }
                if constexpr (H8 == 2) {
                    route_flush();
#pragma unroll
                    for (int j = 0; j < 4; ++j) pq_w[j] = qw[j];
                    pq_s = qs; pq_i1 = i1; pq_i2 = i2; pq_p1 = p1; pq_p2 = p2; pq_r = r;
                }
            }
        }
        cur = nxt; nxt = nx2; if constexpr (MOEBR) rtA = rtB;
    }
    if constexpr (ROUTE && H8 == 2) route_flush();
}


namespace att {
using s16x4  = __attribute__((ext_vector_type(4))) short;
using f32x16 = __attribute__((ext_vector_type(16))) float;
using u32x4  = __attribute__((ext_vector_type(4))) unsigned;
constexpr int KVBLK = 64, NT = (SEQ + CTXL) / KVBLK;
constexpr int SHM_V = KVBLK * 128, SHM_K = KVBLK * 64;
constexpr int NVTILE = MALL / KVBLK;
constexpr int NSLOT_K = 3, NSLOT_V = 2;
constexpr int OFF_V = 0, OFF_K = NSLOT_V * 2 * SHM_V, OFF_WS = OFF_K + NSLOT_K * 2 * SHM_K, OFF_O1 = OFF_WS + NWAVES * 64 * 4, ATT_LDS = OFF_O1 + NWAVES * 8192;
constexpr float THR = 8.0f;
#define ATT_SBAR() __builtin_amdgcn_sched_barrier(0)
#define ATT_PIPE_PV() do { __builtin_amdgcn_sched_group_barrier(0x100, 2, 0); \
    _Pragma("unroll") for (int i_ = 0; i_ < 16; ++i_) { __builtin_amdgcn_sched_group_barrier(0x008, 1, 0); __builtin_amdgcn_sched_group_barrier(0x100, 2, 0); __builtin_amdgcn_sched_group_barrier(0x002, 7, 0); } } while (0)
#define KSWZ64(row, colB) ((row) * 128 + ((colB) ^ ((((row) >> 1) & 7) << 4)))
__device__ __forceinline__ int crow(int r, int hi) { return (r & 3) + 8 * (r >> 2) + 4 * hi; }
__device__ __forceinline__ unsigned cvtpk(float lo, float hi) { return pk2(lo, hi); }

template <int VAR = 0> __device__ __forceinline__ void partialSM(f32x16& p0, f32x16& p1, float& m_reg, f32x16& negm, float& alpha) {
    float mx[4];
#pragma unroll
    for (int c = 0; c < 4; ++c) mx[c] = fmaxf(fmaxf(p0[4 * c], p0[4 * c + 1]), fmaxf(p0[4 * c + 2], p0[4 * c + 3]));
#pragma unroll
    for (int c = 0; c < 4; ++c) mx[c] = fmaxf(mx[c], fmaxf(fmaxf(p1[4 * c], p1[4 * c + 1]), fmaxf(p1[4 * c + 2], p1[4 * c + 3])));
    float pmax = fmaxf(fmaxf(mx[0], mx[1]), fmaxf(mx[2], mx[3]));
    { auto rr = __builtin_amdgcn_permlane32_swap(__float_as_uint(pmax), __float_as_uint(pmax), false, false); pmax = fmaxf(__uint_as_float(rr[0]), __uint_as_float(rr[1])); }
    alpha = 1.f; m_reg = pmax;
#pragma unroll
    for (int r = 0; r < 16; ++r) { negm[r] = 56.5f - pmax; p0[r] = p0[r] + (56.5f - pmax); p1[r] = p1[r] + (56.5f - pmax); }
}
template <int VAR = 0> __device__ __forceinline__ void finishSM(f32x16& p0, f32x16& p1, float alpha, float& l_reg, bf16x8& pa0, bf16x8& pa1, bf16x8& pa2, bf16x8& pa3) {
    if (VAR != 2) {
    f32x2 s2[4];
#pragma unroll
    for (int c = 0; c < 4; ++c) s2[c] = (f32x2){p0[4 * c], p0[4 * c + 1]} + (f32x2){p0[4 * c + 2], p0[4 * c + 3]};
#pragma unroll
    for (int c = 0; c < 4; ++c) s2[c] = s2[c] + ((f32x2){p1[4 * c], p1[4 * c + 1]} + (f32x2){p1[4 * c + 2], p1[4 * c + 3]});
    const f32x2 s2t = (s2[0] + s2[1]) + (s2[2] + s2[3]);
    float ps = s2t[0] + s2t[1];
    { auto rr = __builtin_amdgcn_permlane32_swap(__float_as_uint(ps), __float_as_uint(ps), false, false); ps = __uint_as_float(rr[0]) + __uint_as_float(rr[1]); }
    l_reg = l_reg * alpha + ps;
    } else { l_reg = 1.f; }
#define ATT_PK4(P, BASE, OUT) do { u32x4 w = {cvtpk(P[BASE + 0], P[BASE + 1]), cvtpk(P[BASE + 2], P[BASE + 3]), cvtpk(P[BASE + 4], P[BASE + 5]), cvtpk(P[BASE + 6], P[BASE + 7])}; OUT = *reinterpret_cast<bf16x8*>(&w); } while (0)
    ATT_PK4(p0, 0, pa0); ATT_PK4(p0, 8, pa1); ATT_PK4(p1, 0, pa2); ATT_PK4(p1, 8, pa3);
#undef ATT_PK4
}
__device__ __forceinline__ void qkt(f32x16& p0, f32x16& p1, const char* Ks, const bf16x8* qr, const f32x16& negm, int r32, int hi) {
#pragma unroll
    for (int d0 = 0; d0 < 4; ++d0) { const int cb = (d0 * 16 + hi * 8) * 2;
        const bf16x8 b0 = *reinterpret_cast<const bf16x8*>(Ks + KSWZ64(r32, cb));
        const bf16x8 b1 = *reinterpret_cast<const bf16x8*>(Ks + KSWZ64(32 + r32, cb));
        if (d0 == 0) { p0 = __builtin_amdgcn_mfma_f32_32x32x16_bf16(b0, qr[0], negm, 0, 0, 0); p1 = __builtin_amdgcn_mfma_f32_32x32x16_bf16(b1, qr[0], negm, 0, 0, 0); }
        else { p0 = __builtin_amdgcn_mfma_f32_32x32x16_bf16(b0, qr[d0], p0, 0, 0, 0); p1 = __builtin_amdgcn_mfma_f32_32x32x16_bf16(b1, qr[d0], p1, 0, 0, 0); } }
}
__device__ __forceinline__ int v_st(int k, int c) { const int kk = (k & ~0xC) | ((k & 4) << 1) | ((k & 8) >> 1); return ((kk >> 3) * 4 + (c >> 5)) * 512 + ((kk & 7) * 32 + (c & 31)) * 2; }
__device__ __forceinline__ int v_rd_base(int lane) { return ((lane & 3) << 3) | (((lane >> 2) & 3) << 6) | (((lane >> 4) & 1) << 5) | (((lane >> 5) & 1) << 8); }
constexpr int v_rd_off(int d0, int ks, int half) { return d0 * 512 + ks * 4096 + half * 2048; }
typedef short v4i16a_t __attribute__((ext_vector_type(4)));
template <int OFF> __device__ __forceinline__ s16x4 tr_read(int vb) { return __builtin_bit_cast(s16x4, __builtin_amdgcn_ds_read_tr16_b64_v4i16((LAS v4i16a_t*)(unsigned)(vb + OFF))); }
#define ATT_PK(L, H) (bf16x8){L[0], L[1], L[2], L[3], H[0], H[1], H[2], H[3]}
template <int D0> __device__ __forceinline__ void pv_one(f32x16& od, int vb, bf16x8 pa0, bf16x8 pa1, bf16x8 pa2, bf16x8 pa3) {
    const s16x4 l0 = tr_read<v_rd_off(D0, 0, 0)>(vb), h0 = tr_read<v_rd_off(D0, 0, 1)>(vb), l1 = tr_read<v_rd_off(D0, 1, 0)>(vb), h1 = tr_read<v_rd_off(D0, 1, 1)>(vb);
    const s16x4 l2 = tr_read<v_rd_off(D0, 2, 0)>(vb), h2 = tr_read<v_rd_off(D0, 2, 1)>(vb), l3 = tr_read<v_rd_off(D0, 3, 0)>(vb), h3 = tr_read<v_rd_off(D0, 3, 1)>(vb);
    od = __builtin_amdgcn_mfma_f32_32x32x16_bf16(pa0, ATT_PK(l0, h0), od, 0, 0, 0);
    od = __builtin_amdgcn_mfma_f32_32x32x16_bf16(pa1, ATT_PK(l1, h1), od, 0, 0, 0);
    od = __builtin_amdgcn_mfma_f32_32x32x16_bf16(pa2, ATT_PK(l2, h2), od, 0, 0, 0);
    od = __builtin_amdgcn_mfma_f32_32x32x16_bf16(pa3, ATT_PK(l3, h3), od, 0, 0, 0);
}
#undef ATT_PK
__device__ __forceinline__ void pv_d0(f32x16* o, int vb, bf16x8 pa0, bf16x8 pa1, bf16x8 pa2, bf16x8 pa3) {
    pv_one<0>(o[0], vb, pa0, pa1, pa2, pa3); pv_one<1>(o[1], vb, pa0, pa1, pa2, pa3); pv_one<2>(o[2], vb, pa0, pa1, pa2, pa3); pv_one<3>(o[3], vb, pa0, pa1, pa2, pa3);
}
struct VH { bf16x8 k0, k1; };
__device__ __forceinline__ void vhalf(bf16x8& d, s16x4 lo, s16x4 hi) { d = __builtin_shufflevector(lo, hi, 0, 1, 2, 3, 4, 5, 6, 7); }
template <int D0, int KS0> __device__ __forceinline__ void vh_load(VH& f, int vb) {
    vhalf(f.k0, tr_read<v_rd_off(D0, KS0, 0)>(vb), tr_read<v_rd_off(D0, KS0, 1)>(vb)); vhalf(f.k1, tr_read<v_rd_off(D0, KS0 + 1, 0)>(vb), tr_read<v_rd_off(D0, KS0 + 1, 1)>(vb));
}
#define ATT_PKV(L, H) (bf16x8){L[0], L[1], L[2], L[3], H[0], H[1], H[2], H[3]}
#define ATT_E3(P, B) do { P[B] = __builtin_amdgcn_exp2f(P[B]); P[(B) + 1] = __builtin_amdgcn_exp2f(P[(B) + 1]); P[(B) + 2] = __builtin_amdgcn_exp2f(P[(B) + 2]); } while (0)
#define ATT_MM(D, PA, FR) o[D] = __builtin_amdgcn_mfma_f32_32x32x16_bf16(PA, FR, o[D], 0, 0, 0)
#define ATT_PIN(x) asm volatile("" : "+v"(x))
__device__ __forceinline__ void pv_partial(f32x16* o, int vb, bf16x8 pa0, bf16x8 pa1, bf16x8 pa2, bf16x8 pa3, f32x16& p0, f32x16& p1, float& m_reg, f32x16& negm, float& alpha) {
    VH fa, fb; float mx[4];
    vh_load<0, 0>(fa, vb); vh_load<0, 2>(fb, vb);
    ATT_SBAR();
    ATT_MM(0, pa0, fa.k0);
    mx[0] = fmaxf(fmaxf(p0[0], p0[1]), p0[2]); mx[1] = fmaxf(fmaxf(p0[3], p0[4]), p0[5]); mx[2] = fmaxf(fmaxf(p0[6], p0[7]), p0[8]); mx[3] = fmaxf(fmaxf(p0[9], p0[10]), p0[11]); ATT_PIN(mx[0]); ATT_PIN(mx[1]); ATT_PIN(mx[2]); ATT_PIN(mx[3]); ATT_SBAR();
    ATT_MM(0, pa1, fa.k1); vh_load<1, 0>(fa, vb);
    mx[0] = fmaxf(fmaxf(mx[0], p0[12]), p0[13]); mx[1] = fmaxf(fmaxf(mx[1], p0[14]), p0[15]); mx[2] = fmaxf(fmaxf(mx[2], p1[0]), p1[1]); mx[3] = fmaxf(fmaxf(mx[3], p1[2]), p1[3]); ATT_PIN(mx[0]); ATT_PIN(mx[1]); ATT_PIN(mx[2]); ATT_PIN(mx[3]); ATT_SBAR();
    ATT_MM(0, pa2, fb.k0);
    mx[0] = fmaxf(fmaxf(mx[0], p1[4]), p1[5]); mx[1] = fmaxf(fmaxf(mx[1], p1[6]), p1[7]); mx[2] = fmaxf(fmaxf(mx[2], p1[8]), p1[9]); mx[3] = fmaxf(fmaxf(mx[3], p1[10]), p1[11]); ATT_PIN(mx[0]); ATT_PIN(mx[1]); ATT_PIN(mx[2]); ATT_PIN(mx[3]); ATT_SBAR();
    ATT_MM(0, pa3, fb.k1); vh_load<1, 2>(fb, vb);
    mx[0] = fmaxf(fmaxf(mx[0], p1[12]), p1[13]); mx[1] = fmaxf(fmaxf(mx[1], p1[14]), p1[15]); ATT_PIN(mx[0]); ATT_PIN(mx[1]); ATT_SBAR();
    ATT_MM(1, pa0, fa.k0);
    { float pmax = fmaxf(fmaxf(mx[0], mx[1]), fmaxf(mx[2], mx[3]));
      auto rr = __builtin_amdgcn_permlane32_swap(__float_as_uint(pmax), __float_as_uint(pmax), false, false); pmax = fmaxf(__uint_as_float(rr[0]), __uint_as_float(rr[1]));
      const bool need = pmax > 8.0f * THR + 56.5f; alpha = 1.f;
      if (__any(need)) { const float delta = need ? pmax - 56.5f : 0.f; alpha = __builtin_amdgcn_exp2f(-0.125f * delta); m_reg += delta;
#pragma unroll
          for (int r = 0; r < 16; ++r) { p0[r] -= delta; p1[r] -= delta; negm[r] -= delta; } } } ATT_PIN(alpha); ATT_SBAR();
    ATT_MM(1, pa1, fa.k1); vh_load<2, 0>(fa, vb); ATT_E3(p0, 0); ATT_PIN(p0); ATT_SBAR();
    ATT_MM(1, pa2, fb.k0); ATT_E3(p0, 3); ATT_PIN(p0); ATT_SBAR();
    ATT_MM(1, pa3, fb.k1); vh_load<2, 2>(fb, vb); ATT_E3(p0, 6); ATT_PIN(p0); ATT_SBAR();
    ATT_MM(2, pa0, fa.k0); ATT_E3(p0, 9); ATT_PIN(p0); ATT_SBAR();
    ATT_MM(2, pa1, fa.k1); vh_load<3, 0>(fa, vb); ATT_E3(p0, 12); ATT_PIN(p0); ATT_SBAR();
    ATT_MM(2, pa2, fb.k0); p0[15] = __builtin_amdgcn_exp2f(p0[15]); p1[0] = __builtin_amdgcn_exp2f(p1[0]); p1[1] = __builtin_amdgcn_exp2f(p1[1]); ATT_PIN(p0); ATT_PIN(p1); ATT_SBAR();
    ATT_MM(2, pa3, fb.k1); vh_load<3, 2>(fb, vb); ATT_E3(p1, 2); ATT_PIN(p1); ATT_SBAR();
    ATT_MM(3, pa0, fa.k0); ATT_E3(p1, 5); ATT_PIN(p1); ATT_SBAR();
    ATT_MM(3, pa1, fa.k1); ATT_E3(p1, 8); ATT_PIN(p1); ATT_SBAR();
    ATT_MM(3, pa2, fb.k0); ATT_E3(p1, 11); ATT_PIN(p1); ATT_SBAR();
    ATT_MM(3, pa3, fb.k1); p1[14] = __builtin_amdgcn_exp2f(p1[14]); p1[15] = __builtin_amdgcn_exp2f(p1[15]); ATT_PIN(p1); ATT_SBAR();
}
#undef ATT_MM
#undef ATT_PIN
#undef ATT_E3
#undef ATT_PKV
typedef int v8i_a __attribute__((ext_vector_type(8)));
typedef int v4i_a __attribute__((ext_vector_type(4)));
__device__ __forceinline__ v8i_a v8_frag(unsigned a0, unsigned a1) {
    const v4i_a lo = *(const LAS v4i_a*)a0, hi = *(const LAS v4i_a*)a1; return __builtin_shufflevector(lo, hi, 0, 1, 2, 3, 4, 5, 6, 7); }
#define ATT_MM8(D, FR) asm volatile("v_mfma_scale_f32_32x32x64_f8f6f4 %0, %1, %2, %0, %3, %3 op_sel_hi:[0,0,0]" : "+v"(o[D]) : "v"(pa8), "v"(FR), "v"(one8))
#define ATT_PIN8(x) asm volatile("" : "+v"(x))
#define ATT_KEEP8(x) asm volatile("" :: "v"(x))
#define ATT_LONGNOP() asm volatile("s_nop 15\n\ts_nop 15\n\ts_nop 15\n\ts_nop 15" ::: "memory")
#define ATT_EX(P, B) P[B] = __builtin_amdgcn_exp2f(P[B])
__device__ __forceinline__ void qkt8(f32x16& p0, f32x16& p1, unsigned ka, const v8i_a& q8, const f32x16& negm, v8i_a& k0, v8i_a& k1) {
    const int sK = 0x7f7f7f7f, sQ = 0x7f7f7f7f;
    const v4i_a a0 = *(const LAS v4i_a*)ka, a1 = *(const LAS v4i_a*)(ka ^ 16u), b0 = *(const LAS v4i_a*)(ka + 2048u), b1 = *(const LAS v4i_a*)((ka ^ 16u) + 2048u);
    k0 = __builtin_shufflevector(a0, a1, 0, 1, 2, 3, 4, 5, 6, 7); k1 = __builtin_shufflevector(b0, b1, 0, 1, 2, 3, 4, 5, 6, 7);
    asm volatile("v_mfma_scale_f32_32x32x64_f8f6f4 %0, %1, %2, %3, %4, %5 op_sel_hi:[0,0,0]" : "=&v"(p0) : "v"(k0), "v"(q8), "v"(negm), "v"(sK), "v"(sQ));
    asm volatile("v_mfma_scale_f32_32x32x64_f8f6f4 %0, %1, %2, %3, %4, %5 op_sel_hi:[0,0,0]" : "=&v"(p1) : "v"(k1), "v"(q8), "v"(negm), "v"(sK), "v"(sQ));
}
#define ATT_MML() asm volatile("v_mfma_scale_f32_32x32x64_f8f6f4 %0, %1, %2, %0, %3, %3 op_sel_hi:[0,0,0]" : "+v"(lsum) : "v"(pa8), "v"(ones8), "v"(one8))
__device__ __forceinline__ void pv8_partial(f32x16* o, f32x16& lsum, const v8i_a& ones8, unsigned va0, unsigned va1, const v8i_a& pa8, f32x16& p0, f32x16& p1, float& m_reg, f32x16& negm, float& alpha, const v8i_a& kf0, const v8i_a& kf1) {
    const int one8 = 0x7f7f7f7f;
    float mx[4];
    const v8i_a f0 = v8_frag(va0, va1), f1 = v8_frag(va0 + 2048, va1 + 2048), f2 = v8_frag(va0 + 4096, va1 + 4096), f3 = v8_frag(va0 + 6144, va1 + 6144);
    ATT_SBAR();
    ATT_MM8(0, f0); ATT_MM8(1, f1); asm volatile("s_nop 7" ::: "memory"); ATT_KEEP8(kf0); ATT_KEEP8(kf1); ATT_SBAR();
    mx[0] = fmaxf(fmaxf(p0[0], p0[1]), p0[2]); mx[1] = fmaxf(fmaxf(p0[3], p0[4]), p0[5]); mx[2] = fmaxf(fmaxf(p0[6], p0[7]), p0[8]); mx[3] = fmaxf(fmaxf(p0[9], p0[10]), p0[11]);
    mx[0] = fmaxf(fmaxf(mx[0], p0[12]), p0[13]); mx[1] = fmaxf(fmaxf(mx[1], p0[14]), p0[15]); mx[2] = fmaxf(fmaxf(mx[2], p1[0]), p1[1]); mx[3] = fmaxf(fmaxf(mx[3], p1[2]), p1[3]);
    mx[0] = fmaxf(fmaxf(mx[0], p1[4]), p1[5]); mx[1] = fmaxf(fmaxf(mx[1], p1[6]), p1[7]); mx[2] = fmaxf(fmaxf(mx[2], p1[8]), p1[9]); mx[3] = fmaxf(fmaxf(mx[3], p1[10]), p1[11]);
    mx[0] = fmaxf(fmaxf(mx[0], p1[12]), p1[13]); mx[1] = fmaxf(fmaxf(mx[1], p1[14]), p1[15]);
    { float pmax = fmaxf(fmaxf(mx[0], mx[1]), fmaxf(mx[2], mx[3]));
      auto rr = __builtin_amdgcn_permlane32_swap(__float_as_uint(pmax), __float_as_uint(pmax), false, false); pmax = fmaxf(__uint_as_float(rr[0]), __uint_as_float(rr[1]));
      const bool need = pmax > 8.0f * THR + 56.5f; alpha = 1.f;
      if (__any(need)) { const float delta = need ? pmax - 56.5f : 0.f; alpha = __builtin_amdgcn_exp2f(-0.125f * delta); m_reg += delta;
#pragma unroll
          for (int r = 0; r < 16; ++r) { p0[r] -= delta; p1[r] -= delta; negm[r] -= delta; } } } ATT_PIN8(alpha); ATT_SBAR();
    ATT_MM8(2, f2); ATT_MM8(3, f3); ATT_MML();
    ATT_KEEP8(f0); ATT_KEEP8(f1); ATT_KEEP8(f2); ATT_KEEP8(f3);
}
#undef ATT_EX
__device__ __forceinline__ void p_bytes(const f32x16& p0, const f32x16& p1, v8i_a& pa8) {
#pragma unroll
    for (int q = 0; q < 4; ++q) {
        unsigned w0 = 0, w1 = 0;
        w0 = __builtin_amdgcn_cvt_pk_u8_f32(p0[4 * q], 0, w0); w1 = __builtin_amdgcn_cvt_pk_u8_f32(p1[4 * q], 0, w1);
        w0 = __builtin_amdgcn_cvt_pk_u8_f32(p0[4 * q + 1], 1, w0); w1 = __builtin_amdgcn_cvt_pk_u8_f32(p1[4 * q + 1], 1, w1);
        w0 = __builtin_amdgcn_cvt_pk_u8_f32(p0[4 * q + 2], 2, w0); w1 = __builtin_amdgcn_cvt_pk_u8_f32(p1[4 * q + 2], 2, w1);
        w0 = __builtin_amdgcn_cvt_pk_u8_f32(p0[4 * q + 3], 3, w0); w1 = __builtin_amdgcn_cvt_pk_u8_f32(p1[4 * q + 3], 3, w1);
        pa8[q] = (int)w0; pa8[4 + q] = (int)w1; }
}
__device__ __forceinline__ size_t kvrow(int b, int t) { return t < 64 ? (size_t)b * SEQ + (size_t)t * 64 : (size_t)NLAT + (size_t)b * CTXL + (size_t)(t - 64) * 64; }

__device__ __forceinline__ void glds16(const void* gsrc, unsigned lds_dst) {
    asm volatile("s_mov_b32 m0, %1\n\ts_nop 0\n\tglobal_load_lds_dwordx4 %0, off" :: "v"(gsrc), "s"(lds_dst) : "memory", "m0"); }
template <int VAR> __device__ __forceinline__ void head_pass(const unsigned char* __restrict__ Q1, const unsigned char* __restrict__ K1, const unsigned char* __restrict__ V8, int b, int qh, int hp, size_t qrow0, char* lds, f32x16 (&o)[4], f32x16& lsum, int (&rot)[4], bool pre, bool has_nxt, int nb, int nqh) {
    int tid_ = threadIdx.x; asm volatile("" : "+v"(tid_));
    const int tid = tid_, wid = __builtin_amdgcn_readfirstlane(tid >> 6), lane = tid & 63, r32 = lane & 31, hi = lane >> 5;
    char* V_lds = lds + OFF_V; char* K_lds = lds + OFF_K;
    float* wsf = (float*)(lds + OFF_WS) + wid * 64; float* al_l = wsf + 32;
    float m_reg = 0.f; f32x16 negm = f32x16{}; lsum = f32x16{};
    v8i_a ones8; { int one_ = 0x38383838; asm volatile("" : "+v"(one_)); ones8 = (v8i_a){one_, one_, one_, one_, one_, one_, one_, one_}; }
#pragma unroll
    for (int d = 0; d < 4; ++d) o[d] = f32x16{};
    const unsigned char* Kh = K1 + (size_t)qh * MALL * 64; const unsigned char* Vh = V8 + (size_t)hp * NVTILE * SHM_V;
    const int kr = 16 * wid + (lane >> 2); const unsigned koff = (unsigned)(kr * 64 + (((lane & 3) ^ ((kr >> 1) & 3)) << 4));
    const unsigned lbase = (unsigned)(uintptr_t)lds;
#define ATT_ISSUE_KX(Khx_, bx_, P_, ks_) do { const size_t rb_ = kvrow((bx_), 2 * (P_)); glds16((const char*)((Khx_) + rb_ * 64) + koff, (unsigned)__builtin_amdgcn_readfirstlane(lbase + OFF_K + (ks_) * 2 * SHM_K + wid * 1024)); } while (0)
#define ATT_ISSUE_K(P_, ks_) ATT_ISSUE_KX(Kh, b, P_, ks_)
#define ATT_ISSUE_V(P_, vs_) ATT_ISSUE_VX(b, P_, vs_)
#define ATT_ISSUE_VX(bx_, P_, vs_) do { const int tt_ = 2 * (P_); const unsigned char* vb_ = Vh + (size_t)(tt_ < 64 ? (bx_) * 64 + tt_ : 512 + 4 * (bx_) + (tt_ - 64)) * SHM_V + wid * 2048 + lane * 16; \
    glds16(vb_, (unsigned)__builtin_amdgcn_readfirstlane(lbase + OFF_V + (vs_) * 2 * SHM_V + wid * 2048)); glds16(vb_ + 1024, (unsigned)__builtin_amdgcn_readfirstlane(lbase + OFF_V + (vs_) * 2 * SHM_V + wid * 2048 + 1024)); } while (0)
#define ATT_WAITBAR() do { asm volatile("s_waitcnt vmcnt(0)" ::: "memory"); __builtin_amdgcn_s_barrier(); asm volatile("" ::: "memory"); } while (0)
#define ATT_RESC(al) do { if (__any((al) < 1.f)) { if (hi == 0) al_l[r32] = (al); ATT_LONGNOP(); asm volatile("s_waitcnt lgkmcnt(0)" ::: "memory");     \
    _Pragma("unroll") for (int r = 0; r < 16; ++r) { const float a_ = al_l[crow(r, hi)]; lsum[r] *= a_; _Pragma("unroll") for (int d = 0; d < 4; ++d) o[d][r] *= a_; } } } while (0)
    v8i_a qr;
    { const unsigned char* Qw = Q1 + ((size_t)qh * MALL + qrow0 + wid * 32 + r32) * 64 + hi * 32;
      const v4i_a q0 = *(const v4i_a*)Qw, q1 = *(const v4i_a*)(Qw + 16); qr = __builtin_shufflevector(q0, q1, 0, 1, 2, 3, 4, 5, 6, 7); }
    const unsigned ka_ = (unsigned)(uintptr_t)K_lds + (unsigned)(r32 * 64) + (((2u * hi) ^ ((unsigned)(r32 >> 1) & 3u)) << 4);
    const unsigned vsw = (unsigned)((r32 >> 2) & 3);
    const unsigned va0_ = (unsigned)(uintptr_t)V_lds + (unsigned)(r32 * 64) + (((2u * hi) ^ vsw) << 4), va1_ = (unsigned)(uintptr_t)V_lds + (unsigned)(r32 * 64) + (((2u * hi + 1u) ^ vsw) << 4);
    f32x16 pA0, pA1, pB0, pB1; float alA = 1.f, alB = 1.f; v8i_a pa8 = {}, kf0, kf1;
    constexpr int NP = NT / 2;
    int k0s = rot[0], k1s = rot[1], k2s = rot[2], vs = rot[3];
    if (!pre) { ATT_ISSUE_K(0, k0s); ATT_ISSUE_V(0, vs); ATT_ISSUE_K(1, k1s); }
    ATT_WAITBAR();
    {
        qkt8(pA0, pA1, ka_ + k0s * 2 * SHM_K, qr, negm, kf0, kf1); ATT_LONGNOP(); ATT_KEEP8(kf0); ATT_KEEP8(kf1); partialSM<VAR>(pA0, pA1, m_reg, negm, alA);
#define ATT_STEP_A(PC0, PC1, ALC, PN0, PN1, ALN, KOFF_, VOFF_) do { \
        ATT_SBAR(); qkt8(PN0, PN1, ka_ + (KOFF_), qr, negm, kf0, kf1); ATT_KEEP8(pa8); ATT_SBAR(); \
        p_bytes(PC0, PC1, pa8); ATT_SBAR(); \
        pv8_partial(o, lsum, ones8, va0_ + (VOFF_), va1_ + (VOFF_), pa8, PN0, PN1, m_reg, negm, ALN, kf0, kf1); \
        ATT_RESC(ALN); } while (0)
        for (int P = 0; P + 1 < NP; ++P) {
            if (P + 2 < NP) ATT_ISSUE_K(P + 2, k2s);
            ATT_ISSUE_V(P + 1, vs ^ 1);
            ATT_STEP_A(pA0, pA1, alA, pB0, pB1, alB, k0s * 2 * SHM_K + SHM_K, vs * 2 * SHM_V);
            ATT_STEP_A(pB0, pB1, alB, pA0, pA1, alA, k1s * 2 * SHM_K, vs * 2 * SHM_V + SHM_V);
            ATT_WAITBAR();
            { const int t_ = k0s; k0s = k1s; k1s = k2s; k2s = t_; vs ^= 1; }
        }
        if (has_nxt) { const unsigned char* nKh = K1 + (size_t)nqh * MALL * 64; ATT_ISSUE_KX(nKh, nb, 0, k1s); ATT_ISSUE_VX(nb, 0, vs ^ 1); ATT_ISSUE_KX(nKh, nb, 1, k2s); }
        rot[0] = k1s; rot[1] = k2s; rot[2] = k0s; rot[3] = vs ^ 1;
        ATT_SBAR(); qkt8(pB0, pB1, ka_ + k0s * 2 * SHM_K + SHM_K, qr, negm, kf0, kf1); ATT_KEEP8(pa8); ATT_SBAR();
        p_bytes(pA0, pA1, pa8); ATT_SBAR();
        pv8_partial(o, lsum, ones8, va0_ + vs * 2 * SHM_V, va1_ + vs * 2 * SHM_V, pa8, pB0, pB1, m_reg, negm, alB, kf0, kf1);
        ATT_RESC(alB);
        ATT_LONGNOP(); p_bytes(pB0, pB1, pa8); ATT_SBAR();
        { const unsigned s_ = (unsigned)(vs * 2 * SHM_V + SHM_V); const int one8 = 0x7f7f7f7f;
          const v8i_a f0 = v8_frag(va0_ + s_, va1_ + s_), f1 = v8_frag(va0_ + s_ + 2048, va1_ + s_ + 2048), f2 = v8_frag(va0_ + s_ + 4096, va1_ + s_ + 4096), f3 = v8_frag(va0_ + s_ + 6144, va1_ + s_ + 6144);
          ATT_SBAR(); ATT_MM8(0, f0); ATT_MM8(1, f1); ATT_MM8(2, f2); ATT_MM8(3, f3); ATT_MML(); ATT_LONGNOP(); ATT_KEEP8(pa8); ATT_KEEP8(f0); ATT_KEEP8(f1); ATT_KEEP8(f2); ATT_KEEP8(f3); }
#undef ATT_STEP_A
    }
    asm volatile("s_waitcnt lgkmcnt(0)" ::: "memory"); __builtin_amdgcn_s_barrier(); asm volatile("" ::: "memory");
#undef ATT_ISSUE_K
#undef ATT_ISSUE_V
#undef ATT_ISSUE_KX
#undef ATT_ISSUE_VX
#undef ATT_WAITBAR
#undef ATT_RESC
}

template <int VAR> __device__ __forceinline__ void attn_unit(const unsigned char* __restrict__ Q1, const unsigned char* __restrict__ K1, const unsigned char* __restrict__ V1, bf16* __restrict__ ao, int b, int hp, int qb, char* lds, const float* lamp, const float* subln, int (&rot)[4], bool& pre, bool more_units, int nb_unit) {
    int tid_ = threadIdx.x; asm volatile("" : "+v"(tid_));
    const int tid = tid_, wid = tid >> 6, lane = tid & 63, r32 = lane & 31, hi = lane >> 5;
    float* wsf = (float*)(lds + OFF_WS) + wid * 64;
    unsigned* o1s = (unsigned*)(lds + OFF_O1 + wid * 8192);
    const size_t qrow0 = (size_t)b * SEQ + (size_t)qb * 256;
    f32x16 o[4]; f32x16 l;
    float ssq[16];
#pragma unroll 1
    for (int hh = 0; hh < 2; ++hh) {
        const bool hn = (hh == 0) || more_units;
        head_pass<VAR>(Q1, K1, V1, b, 2 * hp + hh, hp, qrow0, lds, o, l, rot, pre, hn, hh == 0 ? b : nb_unit, hh == 0 ? 2 * hp + 1 : 2 * hp);
        pre = hn;
        float rli[16];
#pragma unroll
        for (int r = 0; r < 16; ++r) { rli[r] = __builtin_amdgcn_rcpf(l[r]); ssq[r] = 0.f; }
        if (hh == 0) {
#pragma unroll
            for (int d0 = 0; d0 < 4; ++d0)
#pragma unroll
                for (int r = 0; r < 16; r += 2) o1s[(d0 * 8 + (r >> 1)) * 64 + lane] = cvtpk(o[d0][r] * rli[r], o[d0][r + 1] * rli[r + 1]);
            __syncthreads();
        } else {
            asm volatile("" : "+s"(lamp)); const float lam = *lamp;
#pragma unroll
            for (int d0 = 0; d0 < 4; ++d0)
#pragma unroll
                for (int r = 0; r < 16; r += 2) { const unsigned w = o1s[(d0 * 8 + (r >> 1)) * 64 + lane];
                    const float a0 = bflo(w) - lam * (o[d0][r] * rli[r]), a1 = bfhi(w) - lam * (o[d0][r + 1] * rli[r + 1]);
                    o[d0][r] = a0; o[d0][r + 1] = a1; ssq[r] += a0 * a0; ssq[r + 1] += a1 * a1; }
        }
    }
#pragma unroll
    for (int r = 0; r < 16; ++r) { float s = ssq[r];
        s += __shfl_xor(s, 1); s += __shfl_xor(s, 2); s += __shfl_xor(s, 4); s += __shfl_xor(s, 8); s += __shfl_xor(s, 16);
        ssq[r] = __builtin_amdgcn_rsqf(s * (1.0f / 128.0f) + EPS) * (1.0f - LAMBDA_INIT); }
    asm volatile("s_waitcnt lgkmcnt(0)" ::: "memory");
    unsigned char* stg = (unsigned char*)o1s;
    asm volatile("" : "+s"(subln));
#pragma unroll
    for (int d0 = 0; d0 < 4; ++d0) { const float g = subln[d0 * 32 + r32];
#pragma unroll
        for (int r = 0; r < 16; r += 2) { const int w2 = __builtin_amdgcn_cvt_pk_fp8_f32(o[d0][r] * ssq[r] * g, o[d0][r + 1] * ssq[r + 1] * g, 0, false);
            stg[crow(r, hi) * 128 + d0 * 32 + r32] = (unsigned char)(w2 & 0xff); stg[crow(r + 1, hi) * 128 + d0 * 32 + r32] = (unsigned char)((w2 >> 8) & 0xff); } }
    asm volatile("s_waitcnt lgkmcnt(0)" ::: "memory");
    unsigned char* Ow = (unsigned char*)ao + (qrow0 + wid * 32) * D + hp * 128;
#pragma unroll
    for (int i = 0; i < 4; ++i) { const int row = i * 8 + (lane >> 3), ch = lane & 7; const u32x4 v = *(const u32x4*)(stg + row * 128 + ch * 16); *(u32x4*)(Ow + (size_t)row * D + ch * 16) = v; }
    asm volatile("s_waitcnt lgkmcnt(0)" ::: "memory");
    __syncthreads();
}
#undef ATT_SBAR
}

__device__ __forceinline__ void v8_prep(Frame& F) {
    const bf16* V1 = (const bf16*)(F.ws + WS_VH1); unsigned char* V8 = (unsigned char*)(F.ws + WS_V8);
    LAS bf16* buf = (LAS bf16*)(F.lds + F.wave * 16384);
    const int gw = F.vcu * NWAVES + F.wave, NGW = F.G * NWAVES, lane = F.lane;
    for (int it = gw; it < 8 * att::NVTILE; it += NGW) {
        const int hv = it / att::NVTILE, tile = it % att::NVTILE;
        const bf16* src = V1 + ((size_t)hv * MALL + (size_t)tile * 64) * 128;
#pragma unroll
        for (int i = 0; i < 16; ++i) *(LAS v4u*)(buf + i * 512 + lane * 8) = *(const GAS v4u*)(src + i * 512 + lane * 8);
        LDS_WAIT(); asm volatile("" ::: "memory");
        unsigned char* dst = V8 + (size_t)it * att::SHM_V;
#pragma unroll
        for (int cc = 0; cc < 2; ++cc) { const int n = lane + 64 * cc; const int sw = (n >> 2) & 3;
#pragma unroll
            for (int c = 0; c < 4; ++c) { const int kb = c >> 1, half = c & 1; v4u w;
#pragma unroll
                for (int q = 0; q < 4; ++q) { const int key0 = 32 * half + 8 * q + 4 * kb;
                    w[q] = pk4_fp8(bf2f(buf[(key0 + 0) * 128 + n]), bf2f(buf[(key0 + 1) * 128 + n]), bf2f(buf[(key0 + 2) * 128 + n]), bf2f(buf[(key0 + 3) * 128 + n])); }
                *(GAS v4u*)(dst + n * 64 + ((c ^ sw) << 4)) = w; } }
        LDS_WAIT(); asm volatile("" ::: "memory");
    }
}

template <int VAR> __device__ __forceinline__ void attn_phase(Frame& F, const Args& a, bf16* ao) {
    const unsigned char* Q1 = F.ws + WS_QH1; const unsigned char* K1 = F.ws + WS_KH1; const unsigned char* V1 = (const unsigned char*)(F.ws + WS_V8);
    const float* lamp = (const float*)(F.ws + WS_LAM);
    int rot[4] = {0, 1, 2, 0}; bool pre = false;
    for (int unit = F.vcu; unit < NBATCH * 8 * 16; unit += F.G) {
        const int qb = unit & 15, hp = (unit >> 4) & 7, b = unit >> 7;
        const int nu = unit + F.G; const bool more = nu < NBATCH * 8 * 16;
        const bool same_hp = more && (((nu >> 4) & 7) == hp);
        att::attn_unit<VAR>(Q1, K1, V1, ao, b, hp, qb, (char*)F.lds, lamp, a.in[I_L1_SUBLN], rot, pre, same_hp, nu >> 7);
    }
}


namespace ret {
using s16x4  = __attribute__((ext_vector_type(4))) short;
using f32x16 = __attribute__((ext_vector_type(16))) float;
typedef short v4i16_t __attribute__((ext_vector_type(4)));
constexpr int C = 32, NSTEP = (SEQ + CTXL) / C;
constexpr int ST_Q = 0, ST_K = 16384, ST_V = 32768, ST_SC = 40960, ST_BYTES = 43008, NSTAGE = 2;
constexpr int XBUF_OFF = NSTAGE * ST_BYTES, RET_LDS = XBUF_OFF + 2 * NWAVES * 4096;
constexpr size_t WS_SSQ = 836 * MiB;
constexpr size_t WS_SC = 842 * MiB;

__device__ __forceinline__ void glds16(const void* gsrc, unsigned lds_dst) {
    asm volatile("s_mov_b32 m0, %1\n\ts_nop 0\n\tglobal_load_lds_dwordx4 %0, off" :: "v"(gsrc), "s"(lds_dst) : "memory", "m0"); }
__device__ __forceinline__ s16x4 vtr(const LAS char* p) { return __builtin_bit_cast(s16x4, __builtin_amdgcn_ds_read_tr16_b64_v4i16((LAS v4i16_t*)p)); }

__device__ __forceinline__ void ret_scores(Frame& F) {
    const bf16* Qh = (const bf16*)(F.ws + WS_QH0); const bf16* Kh = (const bf16*)(F.ws + WS_KH0); bf16* sc = (bf16*)(F.ws + WS_SC);
    const int gw = F.vcu * NWAVES + F.wave, NGW = F.G * NWAVES;
    const int r32 = F.lane & 31, hh = F.lane >> 5;
    constexpr int NTASK = (MALL / C) * RH;
    bf16x8 a[16], b[16];
#define RS_LOAD(task_, s0_) do { const int h_ = (task_) & 3, ch_ = (task_) >> 2; \
        const bf16* qp_ = Qh + ((size_t)h_ * MALL + (size_t)ch_ * C + r32) * 256 + hh * 8; const bf16* kp_ = Kh + ((size_t)h_ * MALL + (size_t)ch_ * C + r32) * 256 + hh * 8; \
        _Pragma("unroll") for (int s = (s0_); s < (s0_) + 8; ++s) { a[s] = *reinterpret_cast<const bf16x8*>(qp_ + s * 16); b[s] = *reinterpret_cast<const bf16x8*>(kp_ + s * 16); } } while (0)
    if (gw < NTASK) { RS_LOAD(gw, 0); RS_LOAD(gw, 8); }
    for (int task = gw; task < NTASK; task += NGW) {
        const int nxt = task + NGW;
        f32x16 acc = f32x16{};
#pragma unroll
        for (int s = 0; s < 8; ++s) acc = __builtin_amdgcn_mfma_f32_32x32x16_bf16(a[s], b[s], acc, 0, 0, 0);
        if (nxt < NTASK) RS_LOAD(nxt, 0);
#pragma unroll
        for (int s = 8; s < 16; ++s) acc = __builtin_amdgcn_mfma_f32_32x32x16_bf16(a[s], b[s], acc, 0, 0, 0);
        if (nxt < NTASK) RS_LOAD(nxt, 8);
        bf16* tp = sc + (size_t)task * 1024;
#pragma unroll
        for (int r = 0; r < 16; ++r) { const int i = (r & 3) + 8 * (r >> 2) + 4 * hh; tp[i * 32 + r32] = (bf16)f2bf(acc[r]); }
    }
#undef RS_LOAD
}

__device__ __forceinline__ size_t step_row0(int b, int dir, int t) {
    if (t < 8) { const int blk = dir ? 7 - t : t; return (size_t)NLAT + (size_t)b * CTXL + (size_t)blk * C; }
    const int blk = dir ? 127 - (t - 8) : (t - 8); return (size_t)b * SEQ + (size_t)blk * C;
}

template <int SV = 0> __device__ __forceinline__ void ret_scan(Frame& F, const Args& a) {
    const char* qb = (const char*)(F.ws + WS_QH0); const char* kb = (const char*)(F.ws + WS_KH0); const char* vb = (const char*)(F.ws + WS_VQ0); const char* scb = (const char*)(F.ws + WS_SC);
    for (int unit = F.vcu; unit < NBATCH * RH * 2 * 4; unit += F.G) {
        int tid_ = threadIdx.x; asm volatile("" : "+v"(tid_));
        const int tid = tid_, lane = tid & 63, w = __builtin_amdgcn_readfirstlane(tid >> 6), dh = w >> 2, vs = w & 3, r32 = lane & 31, hh = lane >> 5;
        const int vq = unit & 3, dir = (unit >> 2) & 1, h = (unit >> 3) & 3, b = unit >> 5;
        const float logit = a.in[I_L0_DECAY][dir * RH + h];
        const float lg2 = -__builtin_amdgcn_logf(1.0f + __builtin_amdgcn_exp2f(-logit * LOG2E));
        const float gC = __builtin_amdgcn_exp2f(lg2 * (float)C), gCi = __builtin_amdgcn_exp2f(-lg2 * (float)C);
        float kd[2][8];
#pragma unroll
        for (int s = 0; s < 2; ++s)
#pragma unroll
            for (int jj = 0; jj < 8; ++jj) { const int j = 16 * s + 8 * hh + jj; kd[s][jj] = __builtin_amdgcn_exp2f(lg2 * (float)(dir ? j : 31 - j)); }
        const int om = 4 * w + (lane >> 4);
        const float rsc = __builtin_amdgcn_exp2f(-lg2 * (float)(dir ? om : 31 - om));
        unsigned pm[4];
#pragma unroll
        for (int e = 0; e < 4; ++e) { const int j0 = 16 * dh + 8 * hh + 2 * e, j1 = j0 + 1; const bool k0 = dir ? (j0 >= r32) : (j0 <= r32), k1 = dir ? (j1 >= r32) : (j1 <= r32);
            pm[e] = (k0 ? 0x0000ffffu : 0u) | (k1 ? 0xffff0000u : 0u); asm volatile("" : "+v"(pm[e])); }
        unsigned offq[2], offk[2];
#pragma unroll
        for (int p = 0; p < 2; ++p) { const int i = 2 * (2 * w + p) + (lane >> 5), cp = lane & 31;
            offq[p] = (unsigned)(i * 512 + ((cp ^ (i & 15)) << 4)); offk[p] = (unsigned)(i * 512 + ((cp ^ ((i & 3) << 2)) << 4)); }
        unsigned offv; { const int j = 4 * w + (lane >> 4), cp = lane & 15; offv = (unsigned)(j * 256 + ((cp ^ ((j & 3) << 2)) << 4)); }
        const char* qhb = qb + (size_t)h * MALL * 512; const char* khb = kb + (size_t)h * MALL * 512; const char* vhb = vb + (size_t)(h * 4 + vq) * MALL * 256;
        unsigned offs; { const int i = 16 * (w & 1) + (lane >> 2), cp = lane & 3; offs = (unsigned)(i * 64 + ((cp ^ ((i >> 2) & 3)) << 4)); }
        LAS unsigned char* L = F.lds;
        const unsigned lbase = (unsigned)(uintptr_t)L;
#define RET_ISSUE(t_) RET_ISSUE2(t_, (t_) % NSTAGE)
#define RET_ISSUE2(t_, stg_) do { const int t__ = (t_); const unsigned sb_ = lbase + (unsigned)((stg_) * ST_BYTES); const size_t r0_ = step_row0(b, dir, t__); const char* gq_ = qhb + r0_ * 512; const char* gk_ = khb + r0_ * 512; const char* gv_ = vhb + r0_ * 256; \
        glds16(gq_ + offq[0], (unsigned)__builtin_amdgcn_readfirstlane(sb_ + ST_Q + (2 * w) * 1024)); \
        glds16(gq_ + offq[1], (unsigned)__builtin_amdgcn_readfirstlane(sb_ + ST_Q + (2 * w + 1) * 1024)); \
        glds16(gk_ + offk[0], (unsigned)__builtin_amdgcn_readfirstlane(sb_ + ST_K + (2 * w) * 1024)); \
        glds16(gk_ + offk[1], (unsigned)__builtin_amdgcn_readfirstlane(sb_ + ST_K + (2 * w + 1) * 1024)); \
        glds16(gv_ + offv, (unsigned)__builtin_amdgcn_readfirstlane(sb_ + ST_V + w * 1024)); \
        if (w < 2) glds16(scb + ((r0_ >> 5) * 4 + h) * 2048 + offs, (unsigned)__builtin_amdgcn_readfirstlane(sb_ + ST_SC + w * 1024)); } while (0)
        const int qrow = ST_Q + r32 * 512; const int qx = r32 & 15;
        const int G = lane >> 4, il = lane & 15, tq = il >> 2, tp = il & 3;
        const int kcolb = (128 * dh + 16 * (G & 1) + 8 * (tp & 1) + 4 * (tp >> 1)) * 2;
        const int vcolb = (32 * vs + 16 * (G & 1) + 4 * tp) * 2;
        f32x16 S[4];
#pragma unroll
        for (int T = 0; T < 4; ++T) S[T] = f32x16{};
        float cinv = 1.0f, cfw = 1.0f;
        bf16* outp = (bf16*)(F.ws + (dir ? WS_OB : WS_OF));
        float* ssqp = (float*)(F.ws + WS_SSQ);

        __builtin_amdgcn_s_barrier();
        if (SV != 2 && SV != 3) { RET_ISSUE(0); }
        const int v0 = (lane & 15) * 8;
#define RET_FINAL(tp_, rs_) RET_FINAL2((tp_) & 1, tp_, rs_)
#define RET_FINAL2(par_, tp_, rs_) do { const LAS float* p0_ = (const LAS float*)(L + XBUF_OFF + (par_) * 32768) + om * 128 + v0; const LAS float* p1_ = p0_ + 4096; \
            const f32x4 a0 = *(const LAS f32x4*)p0_, a1 = *(const LAS f32x4*)(p0_ + 4), b0 = *(const LAS f32x4*)p1_, b1 = *(const LAS f32x4*)(p1_ + 4); \
            const f32x4 o0 = (a0 + b0) * (rs_), o1 = (a1 + b1) * (rs_); \
            float ss = (o0.x * o0.x + o0.y * o0.y) + (o0.z * o0.z + o0.w * o0.w) + (o1.x * o1.x + o1.y * o1.y) + (o1.z * o1.z + o1.w * o1.w); \
            ss += __builtin_bit_cast(float, __builtin_amdgcn_update_dpp(0, __builtin_bit_cast(int, ss), 0xB1, 0xF, 0xF, true)); \
            ss += __builtin_bit_cast(float, __builtin_amdgcn_update_dpp(0, __builtin_bit_cast(int, ss), 0x4E, 0xF, 0xF, true)); \
            ss += __builtin_bit_cast(float, __builtin_amdgcn_update_dpp(0, __builtin_bit_cast(int, ss), 0x124, 0xF, 0xF, true)); \
            ss += __builtin_bit_cast(float, __builtin_amdgcn_update_dpp(0, __builtin_bit_cast(int, ss), 0x128, 0xF, 0xF, true)); \
            const size_t r0 = step_row0(b, dir, (tp_)); \
            v4u pk; pk.x = pk2(o0.x, o0.y); pk.y = pk2(o0.z, o0.w); pk.z = pk2(o1.x, o1.y); pk.w = pk2(o1.z, o1.w); \
            *(GAS v4u*)(outp + (r0 + om) * 2048 + h * 512 + vq * 128 + v0) = pk; \
            if ((lane & 15) == 0) ssqp[(((r0 + om) * RH + h) * 2 + dir) * 4 + vq] = ss; } while (0)
        float rs_prev = 0.f;
        static_assert(NSTEP % 2 == 0 && NSTAGE == 2, "the step loop is unrolled by the two stages");
        for (int t2 = 0; t2 < NSTEP; t2 += 2)
#pragma unroll
        for (int u_ = 0; u_ < 2; ++u_) { const int t = t2 + u_;
            if (t < 2) asm volatile("s_waitcnt vmcnt(0)" ::: "memory"); else asm volatile("s_waitcnt vmcnt(2)" ::: "memory");
            asm volatile("s_waitcnt lgkmcnt(0)" ::: "memory");
            __builtin_amdgcn_s_barrier(); asm volatile("" ::: "memory");
            if (SV != 2 && SV != 3) { if (t + 1 < NSTEP) RET_ISSUE2(t + 1, 1 - u_); }
            const LAS char* sb = (const LAS char*)(L + u_ * ST_BYTES);
            f32x16 acc = f32x16{};
            if (SV != 1 && SV != 3) {
            cinv *= gCi; cfw *= gC;
            bf16x8 vd[2];
#pragma unroll
            for (int s = 0; s < 2; ++s) {
                const int j0 = 16 * s + 8 * (G >> 1) + tq;
                const int cph = (((vcolb >> 4) ^ (tq << 2)) << 4) + (vcolb & 8);
                const s16x4 lo = vtr(sb + ST_V + j0 * 256 + cph), hi = vtr(sb + ST_V + (j0 + 4) * 256 + cph);
                float f[8];
#pragma unroll
                for (int e = 0; e < 4; ++e) { f[e] = bf2f((unsigned short)lo[e]) * (kd[s][e] * cinv); f[4 + e] = bf2f((unsigned short)hi[e]) * (kd[s][4 + e] * cinv); }
                v4u pk; pk.x = pk2(f[0], f[1]); pk.y = pk2(f[2], f[3]); pk.z = pk2(f[4], f[5]); pk.w = pk2(f[6], f[7]);
                vd[s] = __builtin_bit_cast(bf16x8, pk);
            }
            if (SV != 5)
#pragma unroll
            for (int T = 0; T < 4; ++T)
#pragma unroll
                for (int s = 0; s < 2; ++s) {
                    const int cL = 16 * dh + 4 * T + 2 * s + hh;
                    const bf16x8 qa = *(const LAS bf16x8*)(sb + qrow + ((cL ^ qx) << 4));
                    v4u pk; pk.x = pk2(S[T][8 * s + 0], S[T][8 * s + 1]); pk.y = pk2(S[T][8 * s + 2], S[T][8 * s + 3]); pk.z = pk2(S[T][8 * s + 4], S[T][8 * s + 5]); pk.w = pk2(S[T][8 * s + 6], S[T][8 * s + 7]);
                    acc = __builtin_amdgcn_mfma_f32_32x32x16_bf16(qa, __builtin_bit_cast(bf16x8, pk), acc, 0, 0, 0);
                }
            {
                const int cL = 2 * dh + hh;
                v4u pw = *(const LAS v4u*)(sb + ST_SC + r32 * 64 + ((cL ^ ((r32 >> 2) & 3)) << 4));
                pw.x &= pm[0]; pw.y &= pm[1]; pw.z &= pm[2]; pw.w &= pm[3];
                acc = __builtin_amdgcn_mfma_f32_32x32x16_bf16(__builtin_bit_cast(bf16x8, pw), dh ? vd[1] : vd[0], acc, 0, 0, 0);
            }
            if (SV != 4)
#pragma unroll
            for (int T = 0; T < 4; ++T)
#pragma unroll
                for (int s = 0; s < 2; ++s) {
                    const int j0 = 16 * s + 8 * (G >> 1) + tq;
                    const int cb = kcolb + 64 * T;
                    const int cph = (((cb >> 4) ^ (tq << 2)) << 4) + (cb & 8);
                    const s16x4 lo = vtr(sb + ST_K + j0 * 512 + cph), hi = vtr(sb + ST_K + (j0 + 4) * 512 + cph);
                    const bf16x8 ka = (bf16x8){lo[0], lo[1], lo[2], lo[3], hi[0], hi[1], hi[2], hi[3]};
                    S[T] = __builtin_amdgcn_mfma_f32_32x32x16_bf16(ka, vd[s], S[T], 0, 0, 0);
                }
            }
            const float rs_cur = rsc * cfw;
            if ((t & 7) == 7) {
#pragma unroll
                for (int T = 0; T < 4; ++T) S[T] = S[T] * cfw;
                cinv = 1.0f; cfw = 1.0f;
            }
            if (SV != 6) { LAS float* xw = (LAS float*)(L + XBUF_OFF + u_ * 32768 + dh * 16384) + (4 * hh) * 128 + vs * 32 + r32;
#pragma unroll
              for (int r = 0; r < 16; ++r) xw[((r & 3) + 8 * (r >> 2)) * 128] = acc[r]; }
            if (SV == 6) { asm volatile("" :: "v"(acc)); } else
            if (t > 0) RET_FINAL2(1 - u_, t - 1, rs_prev);
            rs_prev = rs_cur;
        }
        asm volatile("s_waitcnt lgkmcnt(0)" ::: "memory");
        __builtin_amdgcn_s_barrier(); asm volatile("" ::: "memory");
        RET_FINAL(NSTEP - 1, rs_prev);
        asm volatile("s_waitcnt vmcnt(0)\n\ts_waitcnt lgkmcnt(0)" ::: "memory");
#undef RET_FINAL
#undef RET_FINAL2
#undef RET_ISSUE
#undef RET_ISSUE2
    }
    __builtin_amdgcn_s_barrier();
}
}

__device__ __forceinline__ void moe_counts(Frame& F, int (&cnt)[NE]) {
#pragma unroll
    for (int e = 0; e < NE; ++e) cnt[e] = __builtin_amdgcn_readfirstlane((int)__hip_atomic_load((unsigned*)(F.ctl + CW_MOECNT + 64 * e), RLX_AGENT));
}
__device__ __forceinline__ void moe_gather(Frame& F) {
    int cnt[NE]; moe_counts(F, cnt);
    int base[NE]; int acc = 0;
#pragma unroll
    for (int e = 0; e < NE; ++e) { base[e] = acc; acc += (cnt[e] + 255) & ~255; }
    const int* te = (const int*)(F.ws + WS_ROUTE); int* tpos = (int*)(F.ws + WS_ROUTE + (size_t)NLAT * 8);
    const bf16* hb = (const bf16*)(F.ws + WS_H); bf16* hp = (bf16*)(F.ws + WS_HP);
    const int gw = F.vcu * NWAVES + F.wave, NGW = F.G * NWAVES;
    for (int r = gw; r < NLAT; r += NGW) {
        const int e0 = te[2 * r], e1 = te[2 * r + 1]; const int p0 = tpos[2 * r], p1 = tpos[2 * r + 1];
        int b0 = 0, b1 = 0;
#pragma unroll
        for (int e = 0; e < NE; ++e) { b0 = (e0 == e) ? base[e] : b0; b1 = (e1 == e) ? base[e] : b1; }
        const int s0 = b0 + p0, s1 = b1 + p1;
        const v4u x0 = *(const GAS v4u*)((const unsigned char*)hb + (size_t)r * D + F.lane * 16);
        *(GAS v4u*)((unsigned char*)hp + (size_t)s0 * D + F.lane * 16) = x0; *(GAS v4u*)((unsigned char*)hp + (size_t)s1 * D + F.lane * 16) = x0;
        if (F.lane == 0) { tpos[2 * r] = s0; tpos[2 * r + 1] = s1; const float sc = ((const float*)(F.ws + WS_RSC))[r]; ((float*)(F.ws + WS_RSCM))[s0] = sc; ((float*)(F.ws + WS_RSCM))[s1] = sc; }
    }
}
__device__ __forceinline__ void moe_order(Frame& F, pg8::MoeOrder& S, int nN, int slots, int rep = 1) {
    S.rep = rep; S.slots = slots;
    int cnt[NE]; moe_counts(F, cnt);
    int ts[NE + 1]; ts[0] = 0;
#pragma unroll
    for (int e = 0; e < NE; ++e) ts[e + 1] = ts[e] + ((cnt[e] + 255) >> 8);
    S.nM = ts[NE]; S.nN = nN; S.nwg = S.nM * nN; S.G = F.G; S.c = F.cid;
    S.t1 = ts[1]; S.t2 = ts[2]; S.t3 = ts[3]; S.t4 = ts[4]; S.t5 = ts[5]; S.t6 = ts[6]; S.t7 = ts[7];
}

constexpr int N_PHASES = 22;
__global__ void __launch_bounds__(NTHREADS, 2) fwd(Args args) {
    extern __shared__ __attribute__((aligned(16))) unsigned char lds[];
    Frame F;
    F.lds = (LAS unsigned char*)lds; F.MISC = (volatile LAS unsigned*)(F.lds + MISC_OFF);
    F.tid = threadIdx.x; F.lane = F.tid & 63; F.wave = __builtin_amdgcn_readfirstlane(F.tid >> 6);
    F.G = gridDim.x; { const int bx = blockIdx.x; F.vcu = (F.G % 8 == 0) ? (bx % 8) * (F.G / 8) + bx / 8 : bx; F.cid = bx; }
    F.ws = args.ws; F.ctl = (gu32*)(args.ws + WS_CTL);
    for (int u = F.tid; u < 64; u += NTHREADS) ((LAS unsigned*)(F.lds + MISC_OFF))[u] = 0u;
    __syncthreads();
#if MK_PER_PHASE
    XcdBarrier bar; bar.bar = (unsigned*)(F.ctl + CW_BAR); bar.x = 0; bar.st = nullptr;
#define GRID_BAR() do { } while (0)
#else
    XcdBarrier bar = xcd_barrier_post((unsigned*)(F.ctl + CW_BAR), F.MISC + 8);
#define GRID_BAR() xcd_barrier(bar)
    if (F.tid == 0) { const unsigned x = xb_xcc_id(); F.MISC[16] = x; F.MISC[17] = __hip_atomic_fetch_add((unsigned*)(F.ctl + CW_XRANK + 64 * x), 1u, RLX_AGENT); }
#endif
    const int lo = args.ph_lo, hi = args.ph_hi;
#define IN(k) (lo <= (k) && (k) < hi)
#define SEAM(k) do { if (IN(k) && IN((k) + 1)) GRID_BAR(); } while (0)
    unsigned char* ws = args.ws;
    float* modv = (float*)(ws + WS_MODV);
    float* modv1 = modv + 9 * 6 * D;
    bf16* hbuf = (bf16*)(ws + WS_H);
    using pg8::Gemm; using pg8::StaticOrder;

    if (IN(0)) { for (int rep_ = 0; rep_ < DUP(0); ++rep_) { p0_prologue(F, args); __syncthreads(); } SEAM(0); }
#if !MK_PER_PHASE
    if (IN(0) && IN(1)) {
        if (F.tid == 0) { const unsigned x = F.MISC[16]; unsigned pre = 0;
            for (unsigned j = 0; j < 16; ++j) { const unsigned c = __hip_atomic_load((unsigned*)(F.ctl + CW_XRANK + 64 * j), RLX_AGENT); pre += (j < x) ? c : 0u; }
            F.MISC[18] = pre + F.MISC[17]; }
        __syncthreads();
        F.vcu = __builtin_amdgcn_readfirstlane((int)F.MISC[18]); F.cid = (F.G % 8 == 0) ? (F.vcu % (F.G / 8)) * 8 + F.vcu / (F.G / 8) : F.vcu;
    }
#endif
    float* rsc = (float*)(ws + WS_RSC);
    if (IN(1)) { RowPass P{MALL, args.in[I_X], args.in[I_CTX], nullptr, nullptr, nullptr, nullptr, nullptr, args.in[I_L0_NPREMIX], modv + 0 * D, modv + 1 * D, hbuf, nullptr, rsc};
        for (int rep_ = 0; rep_ < DUP(1); ++rep_) row_pass<false, false, true, false, 2>(F, args, P); SEAM(1); }
    if (IN(2)) { Gemm g{hbuf, (const bf16*)(ws + WS_W0IN), MALL, 4096, D / 2, D / 2, 0, 0, rsc, (const float*)(ws + WS_WSC0)}; StaticOrder S; S.init(MALL, 4096, F.G, F.cid, DUP(2));
        pg8::EpiQKV0 E{(bf16*)(ws + WS_QH0), (bf16*)(ws + WS_KH0), (bf16*)(ws + WS_VQ0), (const float*)(ws + WS_TAB0)};
        pg8::gemm_phase<pg8::EpiQKV0, StaticOrder, true, true, 2>(F.lds, g, S, E); if (IN(2) && IN(4)) GRID_BAR(); }
    if (IN(4)) { for (int rep_ = 0; rep_ < DUP(4); ++rep_) ret::ret_scores(F); SEAM(4); }
    if (IN(5)) { for (int rep_ = 0; rep_ < DUP(5); ++rep_) ret::ret_scan<0>(F, args); SEAM(5); }
    if (IN(6)) { Gemm g{hbuf, (const bf16*)(ws + WS_W0IN + (size_t)4096 * D), MALL, 4096, D / 2, D / 2, 0, 0, rsc, (const float*)(ws + WS_WSC0) + 4096}; StaticOrder S; S.init(MALL, 4096, F.G, F.cid);
        pg8::EpiGateMerge E{(bf16*)(ws + WS_OF), (const bf16*)(ws + WS_OB), (const float*)(ws + ret::WS_SSQ)};
        pg8::gemm_phase<pg8::EpiGateMerge, StaticOrder, true, true, 2>(F.lds, g, S, E); if (IN(6) && IN(8)) GRID_BAR(); }
    if (IN(8)) { Gemm g{(const bf16*)(ws + WS_OF), (const bf16*)(ws + WS_W0OUT), MALL, D, 2048, 2048}; StaticOrder S; S.init(MALL, D, F.G, F.cid, DUP(8));
        pg8::EpiStore E{(bf16*)(ws + WS_A), D};
        pg8::gemm_phase<pg8::EpiStore, StaticOrder, true, true>(F.lds, g, S, E); SEAM(8); }
    if (IN(9)) { RowPass P{MALL, args.in[I_X], args.in[I_CTX], (float*)(ws + WS_X1), (float*)(ws + WS_X1C), (const bf16*)(ws + WS_A), args.in[I_L0_NPOSTMIX], modv + 2 * D, args.in[I_L0_NPREFFN], modv + 3 * D, modv + 4 * D, hbuf, (const float*)(ws + WS_PART), rsc};
        for (int rep_ = 0; rep_ < DUP(9); ++rep_) row_pass<true, false, true, false, 2, USE_SPLITK ? 8 : 0, false, true>(F, args, P); SEAM(9); }
    if (IN(10)) { Gemm g{hbuf, (const bf16*)(ws + WS_W0GU), MALL, 2 * DFF, D / 2, D / 2, 0, 0, rsc, (const float*)(ws + WS_WSC2)}; StaticOrder S; S.init(MALL, 2 * DFF, F.G, F.cid, DUP(10));
        pg8::EpiSwiglu8 E{(unsigned char*)(ws + WS_B), DFF};
        pg8::gemm_phase<pg8::EpiSwiglu8, StaticOrder, true, true, 2>(F.lds, g, S, E); SEAM(10); }
    if (IN(11)) { Gemm g{(const bf16*)(ws + WS_B), (const bf16*)(ws + WS_W0DN), MALL, D, DFF / 2, DFF / 2, MOE_SA, MOE_SB}; StaticOrder S; S.init(MALL, D, F.G, F.cid, DUP(11));
        pg8::EpiStore E{(bf16*)(ws + WS_A), D};
        pg8::gemm_phase<pg8::EpiStore, StaticOrder, true, true, 1>(F.lds, g, S, E); SEAM(11); }
    if (IN(12)) { RowPass P{MALL, (const float*)(ws + WS_X1), (const float*)(ws + WS_X1C), (float*)(ws + WS_X2), nullptr, (const bf16*)(ws + WS_A), args.in[I_L0_NPOSTFFN], modv + 5 * D, args.in[I_L1_NPREMIX], modv1 + 0 * D, modv1 + 1 * D, hbuf, (const float*)(ws + WS_PART), rsc};
        for (int rep_ = 0; rep_ < DUP(12); ++rep_) row_pass<true, false, true, false, 2, USE_SPLITK ? 11 : 0, true, true>(F, args, P); SEAM(12); }
    if (IN(13)) { Gemm g{hbuf, (const bf16*)(ws + WS_W1IN), MALL, 3072, D / 2, D / 2, 0, 0, rsc, (const float*)(ws + WS_WSC1)}; pg8::QkvOrder S; S.init(F.G, F.cid, DUP(13));
        pg8::EpiQKV1 E{ws + WS_QH1, ws + WS_KH1, ws + WS_V8, (const float*)(ws + WS_TAB1)};
        pg8::gemm_phase<pg8::EpiQKV1, pg8::QkvOrder, true, true, 2>(F.lds, g, S, E); if (IN(13) && IN(15)) GRID_BAR(); }
    if (IN(15)) { for (int rep_ = 0; rep_ < DUP(15); ++rep_) attn_phase<0>(F, args, (bf16*)(ws + WS_B)); SEAM(15); }
    if (IN(16)) { Gemm g{(const bf16*)(ws + WS_B), (const bf16*)(ws + WS_W1OUT), NLAT, D, D / 2, D / 2, MOE_SA, MOE_SB}; StaticOrder S; S.init(NLAT, D, F.G, F.cid, DUP(16));
        pg8::EpiStore E{(bf16*)(ws + WS_A), D};
        pg8::gemm_phase<pg8::EpiStore, StaticOrder, true, true, 1>(F.lds, g, S, E); SEAM(16); }
    if (IN(17)) { RowPass P{NLAT, (const float*)(ws + WS_X2), nullptr, (float*)(ws + WS_X3), nullptr, (const bf16*)(ws + WS_A), args.in[I_L1_NPOSTMIX], modv1 + 2 * D, args.in[I_L1_NPREFFN], modv1 + 3 * D, modv1 + 4 * D, hbuf, nullptr, rsc};
        row_pass<true, false, true, true, 2, 0, true, true>(F, args, P); if (IN(17) && IN(19)) GRID_BAR(); }
    if (IN(19)) { Gemm g{(const bf16*)(ws + WS_HP), (const bf16*)(ws + WS_WMGU), MOE_ROWS, 2 * DFE, D / 2, D / 2, 0, 0, (const float*)(ws + WS_RSCM), (const float*)(ws + WS_WSCM)}; pg8::MoeOrder S; moe_order(F, S, 2 * DFE / 256, 1, DUP(19));
        pg8::EpiSwiglu8 E{(unsigned char*)(ws + WS_ACT1), DFE};
        pg8::gemm_phase<pg8::EpiSwiglu8, pg8::MoeOrder, true, true, 2>(F.lds, g, S, E); SEAM(19); }
    if (IN(20)) { Gemm g{(const bf16*)(ws + WS_ACT1), (const bf16*)(ws + WS_WMDN), MOE_ROWS, D, DFE / 2, DFE / 2, MOE_SA, MOE_SB}; pg8::MoeOrder S; moe_order(F, S, D / 256, 0, DUP(20));
        pg8::EpiStore E{(bf16*)(ws + WS_Y1), D};
        pg8::gemm_phase<pg8::EpiStore, pg8::MoeOrder, true, true, 1>(F.lds, g, S, E); SEAM(20); }
    if (IN(21)) { RowPass P{NLAT, (const float*)(ws + WS_X3), nullptr, args.out, nullptr, (const bf16*)(ws + WS_Y1), args.in[I_L1_NPOSTFFN], modv1 + 5 * D, nullptr, nullptr, nullptr, nullptr};
        for (int rep_ = 0; rep_ < DUP(21); ++rep_) row_pass<false, true, false, false, 0, 0, true, false>(F, args, P); }
#undef IN
#undef SEAM
}

#ifndef PROBE_ATT
#define PROBE_ATT -1
#endif
#if PROBE_ATT >= 0
__global__ void __launch_bounds__(NTHREADS, 2) probe_k(Args args) {
    extern __shared__ __attribute__((aligned(16))) unsigned char lds[];
    Frame F;
    F.lds = (LAS unsigned char*)lds; F.MISC = (volatile LAS unsigned*)(F.lds + MISC_OFF);
    F.tid = threadIdx.x; F.lane = F.tid & 63; F.wave = __builtin_amdgcn_readfirstlane(F.tid >> 6);
    F.G = gridDim.x; { const int bx = blockIdx.x; F.vcu = (F.G % 8 == 0) ? (bx % 8) * (F.G / 8) + bx / 8 : bx; F.cid = bx; }
    F.ws = args.ws; F.ctl = (gu32*)(args.ws + WS_CTL);
#if PROBE_ATT < 10
    attn_phase<PROBE_ATT>(F, args, (bf16*)(args.ws + WS_END - 64 * MiB));
#elif PROBE_ATT >= 30
    { unsigned char* ws = args.ws; using pg8::Gemm; using pg8::StaticOrder;
      Gemm g{(const bf16*)(ws + WS_OF), (const bf16*)(ws + WS_W0OUT), MALL, D, 2048, 2048}; StaticOrder S; S.init(PROBE_ATT == 30 ? MALL : NLAT, D, F.G, F.cid, 1);
      pg8::EpiStore E{(bf16*)(ws + WS_A), D};
      pg8::gemm_phase<pg8::EpiStore, StaticOrder, true, true>(F.lds, g, S, E); }
#elif PROBE_ATT >= 20
    { unsigned char* ws = args.ws; using pg8::Gemm;
      Gemm g{(const bf16*)(ws + WS_HP), (const bf16*)(ws + WS_WMGU), MOE_ROWS, 2 * DFE, D / 2, D / 2, 0, 0, (const float*)(ws + WS_RSCM), (const float*)(ws + WS_WSCM)}; pg8::MoeOrder S; moe_order(F, S, 2 * DFE / 256, 1);
#if PROBE_ATT == 20
      pg8::EpiSwiglu8 E{(unsigned char*)(ws + WS_ACT1), DFE}; pg8::gemm_phase<pg8::EpiSwiglu8, pg8::MoeOrder, true, true, 2>(F.lds, g, S, E);
#else
      pg8::EpiNull E{(float*)(ws + WS_ACT1)}; pg8::gemm_phase<pg8::EpiNull, pg8::MoeOrder, true, true, 2>(F.lds, g, S, E);
#endif
    }
#else
    ret::ret_scan<PROBE_ATT - 10>(F, args);
#endif
}
#endif
extern "C" void kernel_launch(void* const* d_in, const int* in_sizes, int n_in, void* d_out, int out_size, void* d_ws, size_t ws_size, hipStream_t stream) {
    static int grid = 0;
    if (grid == 0) {
        if (n_in != N_IN || out_size != NLAT * D || ws_size < WS_END) { fprintf(stderr, "kernel_launch: unexpected shapes n_in %d out %d ws %zu\n", n_in, out_size, ws_size); grid = -1; return; }
        int dev = 0, cus = 0, per_cu = 0;
        if (hipGetDevice(&dev) != hipSuccess || hipDeviceGetAttribute(&cus, hipDeviceAttributeMultiprocessorCount, dev) != hipSuccess) { grid = -1; return; }
        if (hipFuncSetAttribute((const void*)fwd, hipFuncAttributeMaxDynamicSharedMemorySize, LDS_BYTES) != hipSuccess) { fprintf(stderr, "kernel_launch: hipFuncSetAttribute failed\n"); grid = -1; return; }
        if (hipOccupancyMaxActiveBlocksPerMultiprocessor(&per_cu, (const void*)fwd, NTHREADS, LDS_BYTES) != hipSuccess || per_cu < 1) fprintf(stderr, "kernel_launch: occupancy query says %d\n", per_cu);
        (void)hipGetLastError();
        grid = cus;
    }
    if (grid < 0) return;
    (void)hipMemsetAsync((char*)d_ws + WS_CTL, 0, CTL_ZERO_BYTES, stream);
    Args a{};
    for (int i = 0; i < N_IN; ++i) a.in[i] = (const float*)d_in[i];
    a.out = (float*)d_out; a.ws = (unsigned char*)d_ws;
#if MK_PER_PHASE
    for (int p = 0; p < N_PHASES; ++p) { a.ph_lo = p; a.ph_hi = p + 1; hipLaunchKernelGGL(fwd, dim3(grid), dim3(NTHREADS), LDS_BYTES, stream, a); }
#else
    a.ph_lo = 0; a.ph_hi = N_PHASES; hipLaunchKernelGGL(fwd, dim3(grid), dim3(NTHREADS), LDS_BYTES, stream, a);
#endif
#if PROBE_ATT >= 0
    (void)hipFuncSetAttribute((const void*)probe_k, hipFuncAttributeMaxDynamicSharedMemorySize, LDS_BYTES);
    hipLaunchKernelGGL(probe_k, dim3(grid), dim3(NTHREADS), LDS_BYTES, stream, a);
#endif
}
```

```cpp
#include <hip/hip_runtime.h>
#include <cstdio>
#include <cstdint>
namespace pg8 {
#define PG8_LAS __attribute__((address_space(3)))
typedef unsigned short bf16_t;
typedef short bf16x8 __attribute__((ext_vector_type(8)));
typedef float f32x4 __attribute__((ext_vector_type(4)));
typedef unsigned u32x4 __attribute__((ext_vector_type(4)));
constexpr int BM = 256, BK = 64, HALF = 128, HTB = HALF * BK * 2  , STAGE_BYTES = 8 * HTB, NXCD = 8, WGM = 8;

__host__ __device__ __forceinline__ int lds_byte(int r, int c) { const int st = (r >> 4) * 2 + (c >> 5), rr = r & 15, cc = c & 31, ob = rr * 64 + cc * 2; return st * 1024 + (ob ^ (((ob >> 9) & 1) << 5)); }
__host__ __device__ __forceinline__ void stage_rc(int b, int& R, int& C) { const int st = b / 1024, sb = b % 1024, swz = sb ^ (((sb >> 9) & 1) << 5); R = (st >> 1) * 16 + swz / 64; C = (st & 1) * 32 + (swz % 64) / 2; }
__host__ __device__ __forceinline__ int perm32(int rho) { const int n = rho >> 4, i = rho & 15; return 8 * (i >> 2) + 4 * n + (i & 3); }

struct Unit { int pm, pn, pc, k0, nt, ks, pa, sw; };
struct Gemm { const bf16_t* A; const bf16_t* Bt; int M, N, K, lda; int sA, sB; const float* rsA; const float* rsB; };

struct StaticOrder {
    int nM, nN, nwg, G, c, rep;
    __host__ __device__ __forceinline__ void init(int M, int N, int G_, int c_, int rep_ = 1) { nM = M / BM; nN = N / BM; nwg = nM * nN; G = G_; c = c_; rep = rep_; }
    __host__ __device__ __forceinline__ bool next(int i, Unit& u) const {
        long L = (long)i * G + c; if (L >= (long)nwg * rep) return false; if (L >= nwg) L -= nwg;
        int wgid = (int)L; { const int q = nwg / NXCD, r = nwg % NXCD, xcd = wgid % NXCD, off = wgid / NXCD; wgid = (xcd < r ? xcd * (q + 1) : r * (q + 1) + (xcd - r) * q) + off; }
        const int nig = WGM * nN, gid = wgid / nig, fm = gid * WGM, gsz = (nM - fm) < WGM ? (nM - fm) : WGM;
        u.pm = fm + ((wgid % nig) % gsz); u.pn = (wgid % nig) / gsz; u.pc = u.pn; u.k0 = 0; u.nt = 0; u.ks = -1; u.pa = u.pm; u.sw = 0; return true;
    }
    __device__ __forceinline__ void a_ready(const Unit&) const {}
    __device__ __forceinline__ void done(const Unit&) const {}
};

__device__ __forceinline__ unsigned cvt_pk_bf16(float lo, float hi) { unsigned r; asm volatile("v_cvt_pk_bf16_f32 %0, %1, %2" : "=v"(r) : "v"(lo), "v"(hi)); return r; }
typedef float f32x2 __attribute__((ext_vector_type(2)));
typedef int v4i_t __attribute__((ext_vector_type(4))); typedef int v8i_t __attribute__((ext_vector_type(8)));
template <class Epi, class Sched, bool ALIGN_EPI = false, bool SP2 = false, int MODE = 0>
__device__ __forceinline__ void gemm_phase(PG8_LAS unsigned char* lds, const Gemm g, const Sched& S, const Epi& E) {
    constexpr bool FP8 = (MODE == 1), I8 = (MODE == 2);
    const int tid = threadIdx.x, wid = __builtin_amdgcn_readfirstlane(tid >> 6), lane = tid & 63, wr = wid >> 2, wc = wid & 3, fr = lane & 15, fq = lane >> 4;
    const int K = g.K; int nt = K / BK;
    unsigned voffA[2], voffB[2];
#pragma unroll
    for (int i = 0; i < 2; ++i) { int R, C; stage_rc(tid * 16 + i * 8192, R, C); const int Rb = Epi::PERM ? ((R & ~31) + perm32(R & 31)) : R;
        voffA[i] = (unsigned)(R * g.lda + C) * 2u; voffB[i] = (unsigned)(Rb * K + C) * 2u; }
    const size_t kstep = (size_t)(BK * 2);
    const size_t hstepA = (size_t)HALF * g.lda * 2, hstepB = (size_t)HALF * K * 2;
    const size_t tstepA = 2 * hstepA, tstepB = 2 * hstepB;
    const unsigned ldsw = (unsigned)wid * 1024u;
    const int aoff = lds_byte(wr * 64 + fr, fq * 8), boff = lds_byte(wc * 32 + fr, fq * 8);
#define PG8_SA(b, h) (((b) * 2 + (h)) * HTB)
#define PG8_SB(b, h) ((4 + (b) * 2 + (h)) * HTB)
#define PG8_STAGE(bufoff, gbase, voff) do { _Pragma("unroll") for (int _i = 0; _i < 2; ++_i) \
        __builtin_amdgcn_global_load_lds((const unsigned*)((const char*)(gbase) + (voff)[_i]), (PG8_LAS unsigned*)(lds + (bufoff) + ldsw + _i * 8192), 16, 0, 0); } while (0)
#define PG8_LDA(dst, b, h) do { if constexpr (FP8) { _Pragma("unroll") for (int m = 0; m < 4; ++m) { const v4i_t lo_ = *(const PG8_LAS v4i_t*)(lds + PG8_SA(b, h) + aoff + m * 2048), hi_ = *(const PG8_LAS v4i_t*)(lds + PG8_SA(b, h) + aoff + m * 2048 + 1024); \
        dst##8[m] = __builtin_shufflevector(lo_, hi_, 0, 1, 2, 3, 4, 5, 6, 7); } } \
    else { _Pragma("unroll") for (int m = 0; m < 4; ++m) _Pragma("unroll") for (int k = 0; k < 2; ++k) dst[m][k] = *(const PG8_LAS bf16x8*)(lds + PG8_SA(b, h) + aoff + m * 2048 + k * 1024); } } while (0)
#define PG8_LDB(dst, b, h) do { if constexpr (FP8) { _Pragma("unroll") for (int n = 0; n < 2; ++n) { const v4i_t lo_ = *(const PG8_LAS v4i_t*)(lds + PG8_SB(b, h) + boff + n * 2048), hi_ = *(const PG8_LAS v4i_t*)(lds + PG8_SB(b, h) + boff + n * 2048 + 1024); \
        dst##8[n] = __builtin_shufflevector(lo_, hi_, 0, 1, 2, 3, 4, 5, 6, 7); } } \
    else { _Pragma("unroll") for (int n = 0; n < 2; ++n) _Pragma("unroll") for (int k = 0; k < 2; ++k) dst[n][k] = *(const PG8_LAS bf16x8*)(lds + PG8_SB(b, h) + boff + n * 2048 + k * 1024); } } while (0)
#define PG8_MMA(ai, bj, At, Bt) do { __builtin_amdgcn_s_setprio(1); _Pragma("unroll") for (int m = 0; m < 4; ++m) _Pragma("unroll") for (int n = 0; n < 2; ++n) { \
        if constexpr (FP8) { asm volatile("v_mfma_scale_f32_16x16x128_f8f6f4 %0, %1, %2, %0, %3, %4 op_sel_hi:[0,0,0]" : "+v"(acc[ai][bj][m][n]) : "v"(Bt##8[n]), "v"(At##8[m]), "v"(sB_), "v"(sA_)); } \
        else if constexpr (I8) { _Pragma("unroll") for (int k = 0; k < 2; ++k) acc[ai][bj][m][n] = __builtin_bit_cast(f32x4, __builtin_amdgcn_mfma_i32_16x16x64_i8(__builtin_bit_cast(v4i_t, Bt[n][k]), __builtin_bit_cast(v4i_t, At[m][k]), __builtin_bit_cast(v4i_t, acc[ai][bj][m][n]), 0, 0, 0)); } \
        else { _Pragma("unroll") for (int k = 0; k < 2; ++k) acc[ai][bj][m][n] = __builtin_amdgcn_mfma_f32_16x16x32_bf16(Bt[n][k], At[m][k], acc[ai][bj][m][n], 0, 0, 0); } } \
        __builtin_amdgcn_s_setprio(0); } while (0)
#define PG8_WAIT_V(n) asm volatile("s_waitcnt vmcnt(" #n ")" ::: "memory")
#define PG8_WAIT_VR(n) do { if (relax) asm volatile("s_waitcnt vmcnt(%0)" :: "i"((n) + Epi::NST) : "memory"); else asm volatile("s_waitcnt vmcnt(" #n ")" ::: "memory"); } while (0)
#define PG8_WAIT_L(n) asm volatile("s_waitcnt lgkmcnt(" #n ")" ::: "memory")
#define PG8_BAR __builtin_amdgcn_s_barrier()
#define PG8_SCHED __builtin_amdgcn_sched_barrier(0)
#define PG8_SCALES(u, par) do { if constexpr (I8) { if (wid < 2) { const float* gp_ = (wid == 0 ? ((u).sw ? g.rsB : g.rsA) + (u).pa * BM : ((u).sw ? g.rsA : g.rsB) + (u).pn * BM) + lane * 4; \
        __builtin_amdgcn_global_load_lds((const unsigned*)gp_, (PG8_LAS unsigned*)(lds + STAGE_BYTES + (par) * 2048 + wid * 1024), 16, 0, 0); } } } while (0)
    Unit cur, nxt; int ui = 0;
    if (!S.next(0, cur)) return;
    const int sA_ = g.sA, sB_ = g.sB;
    f32x4 acc[2][2][4][2];
#pragma unroll
    for (int a = 0; a < 2; ++a)
#pragma unroll
        for (int b = 0; b < 2; ++b)
#pragma unroll
            for (int m = 0; m < 4; ++m)
#pragma unroll
                for (int n = 0; n < 2; ++n) acc[a][b][m][n] = (f32x4){0.f, 0.f, 0.f, 0.f};
    bf16x8 At[4][2], B0[2][2], B1[2][2]; v8i_t At8[4], B08[2], B18[2];
    if (cur.nt) nt = cur.nt;
    const char* cA = (const char*)(cur.sw ? g.Bt : g.A) + (size_t)cur.pa * tstepA + (size_t)cur.k0 * 2; const char* cB = (const char*)(cur.sw ? g.A : g.Bt) + (size_t)cur.pn * tstepB + (size_t)cur.k0 * 2;
    S.a_ready(cur);
    PG8_SCALES(cur, 0);
    if constexpr (SP2) {
        PG8_STAGE(PG8_SB(0, 0), cB, voffB); PG8_STAGE(PG8_SB(0, 1), cB + hstepB, voffB); PG8_STAGE(PG8_SA(0, 0), cA, voffA); PG8_STAGE(PG8_SA(0, 1), cA + hstepA, voffA);
        PG8_STAGE(PG8_SB(1, 0), cB + kstep, voffB); PG8_STAGE(PG8_SA(1, 0), cA + kstep, voffA); PG8_STAGE(PG8_SB(1, 1), cB + hstepB + kstep, voffB);
        if (wr == 1) PG8_BAR;
        PG8_WAIT_V(8); PG8_BAR;
        PG8_WAIT_V(6); PG8_BAR;
    } else {
        PG8_STAGE(PG8_SB(0, 0), cB, voffB); PG8_STAGE(PG8_SA(0, 0), cA, voffA); PG8_STAGE(PG8_SB(0, 1), cB + hstepB, voffB); PG8_STAGE(PG8_SA(0, 1), cA + hstepA, voffA);
        if (wr == 1) PG8_BAR;
        PG8_WAIT_V(4); PG8_BAR;
        PG8_STAGE(PG8_SB(1, 0), cB + kstep, voffB); PG8_STAGE(PG8_SA(1, 0), cA + kstep, voffA); PG8_STAGE(PG8_SB(1, 1), cB + hstepB + kstep, voffB);
        PG8_WAIT_V(6); PG8_BAR;
    }
    for (;;) {
        const bool has_next = S.next(ui + 1, nxt);
        const char* nA = has_next ? (const char*)(nxt.sw ? g.Bt : g.A) + (size_t)nxt.pa * tstepA + (size_t)nxt.k0 * 2 : cA; const char* nB = has_next ? (const char*)(nxt.sw ? g.A : g.Bt) + (size_t)nxt.pn * tstepB + (size_t)nxt.k0 * 2 : cB;
#pragma unroll 1
        for (int t = 0; t < nt; t += 2) {
            const bool last = (t == nt - 2); const bool relax = (t == 0) && (ui > 0) && !Epi::AFTER_DRAIN;
            const char* a1 = cA + (size_t)(t + 1) * kstep;
            const char* a2 = last ? nA : cA + (size_t)(t + 2) * kstep; const char* b2 = last ? nB : cB + (size_t)(t + 2) * kstep;
            const char* a3 = a2 + kstep; const char* b3 = b2 + kstep;
            if (last && has_next) S.a_ready(nxt);
            if constexpr (SP2) {
            PG8_LDB(B0, 0, 0); PG8_LDB(B1, 0, 1); PG8_SCHED; PG8_LDA(At, 0, 0); PG8_STAGE(PG8_SA(1, 1), a1 + hstepA, voffA);
            PG8_WAIT_VR(8); PG8_WAIT_L(0); PG8_BAR; PG8_MMA(0, 0, At, B0); PG8_MMA(0, 1, At, B1); PG8_BAR; PG8_SCHED;
            PG8_LDA(At, 0, 1); PG8_STAGE(PG8_SB(0, 0), b2, voffB); PG8_STAGE(PG8_SB(0, 1), b2 + hstepB, voffB); PG8_STAGE(PG8_SA(0, 0), a2, voffA);
            PG8_WAIT_VR(8); PG8_WAIT_L(0); PG8_BAR; PG8_MMA(1, 0, At, B0); PG8_MMA(1, 1, At, B1); PG8_BAR; PG8_SCHED;
            PG8_LDB(B0, 1, 0); PG8_LDB(B1, 1, 1); PG8_SCHED; PG8_LDA(At, 1, 0); PG8_STAGE(PG8_SA(0, 1), a2 + hstepA, voffA);
            PG8_WAIT_V(8); PG8_WAIT_L(0); PG8_BAR; PG8_MMA(0, 0, At, B0); PG8_MMA(0, 1, At, B1); PG8_BAR; PG8_SCHED;
            PG8_LDA(At, 1, 1); PG8_STAGE(PG8_SB(1, 0), b3, voffB); PG8_STAGE(PG8_SB(1, 1), b3 + hstepB, voffB); PG8_STAGE(PG8_SA(1, 0), a3, voffA);
            PG8_WAIT_V(8); PG8_WAIT_L(0); PG8_BAR; PG8_MMA(1, 0, At, B0); PG8_MMA(1, 1, At, B1); PG8_BAR; PG8_SCHED;
            } else {
            PG8_LDB(B0, 0, 0); PG8_SCHED; PG8_LDA(At, 0, 0); PG8_STAGE(PG8_SA(1, 1), a1 + hstepA, voffA);
            PG8_WAIT_L(8); PG8_BAR; PG8_WAIT_L(0); PG8_MMA(0, 0, At, B0); PG8_BAR; PG8_SCHED;
            PG8_LDB(B1, 0, 1); PG8_STAGE(PG8_SB(0, 0), b2, voffB);
            PG8_BAR; PG8_WAIT_L(0); PG8_MMA(0, 1, At, B1); PG8_BAR;
            PG8_LDA(At, 0, 1); PG8_STAGE(PG8_SA(0, 0), a2, voffA);
            PG8_BAR; PG8_WAIT_L(0); PG8_MMA(1, 0, At, B0); PG8_BAR; PG8_SCHED;
            PG8_STAGE(PG8_SB(0, 1), b2 + hstepB, voffB);
            PG8_WAIT_V(6); PG8_BAR; PG8_MMA(1, 1, At, B1); PG8_BAR;
            PG8_LDB(B0, 1, 0); PG8_SCHED; PG8_LDA(At, 1, 0); PG8_STAGE(PG8_SA(0, 1), a2 + hstepA, voffA);
            PG8_WAIT_L(8); PG8_BAR; PG8_WAIT_L(0); PG8_MMA(0, 0, At, B0); PG8_BAR; PG8_SCHED;
            PG8_LDB(B1, 1, 1); PG8_STAGE(PG8_SB(1, 0), b3, voffB);
            PG8_BAR; PG8_WAIT_L(0); PG8_MMA(0, 1, At, B1); PG8_BAR;
            PG8_LDA(At, 1, 1); PG8_STAGE(PG8_SA(1, 0), a3, voffA);
            PG8_BAR; PG8_WAIT_L(0); PG8_MMA(1, 0, At, B0); PG8_BAR; PG8_SCHED;
            PG8_STAGE(PG8_SB(1, 1), b3 + hstepB, voffB);
            PG8_WAIT_V(6); PG8_BAR; PG8_MMA(1, 1, At, B1); PG8_BAR;
            }
        }
        if constexpr (FP8) asm volatile("s_nop 15\n\ts_nop 15" ::: "memory");
        if constexpr (I8) {
            const PG8_LAS float* ra = (const PG8_LAS float*)(lds + STAGE_BYTES + (ui & 1) * 2048) + wr * 64 + fr; const PG8_LAS float* rb = (const PG8_LAS float*)(lds + STAGE_BYTES + (ui & 1) * 2048 + 1024) + wc * 32 + 8 * fq;
#pragma unroll
            for (int bj = 0; bj < 2; ++bj) { const f32x4 sb0 = *(const PG8_LAS f32x4*)(rb + bj * HALF), sb1 = *(const PG8_LAS f32x4*)(rb + bj * HALF + 4);
#pragma unroll
                for (int ai = 0; ai < 2; ++ai)
#pragma unroll
                    for (int m = 0; m < 4; ++m) { const float sa = ra[ai * HALF + m * 16];
                        acc[ai][bj][m][0] = __builtin_convertvector(__builtin_bit_cast(v4i_t, acc[ai][bj][m][0]), f32x4) * (sb0 * sa);
                        acc[ai][bj][m][1] = __builtin_convertvector(__builtin_bit_cast(v4i_t, acc[ai][bj][m][1]), f32x4) * (sb1 * sa); } }
        }
        if constexpr (ALIGN_EPI) { if (wr == 0) PG8_BAR; }
        if constexpr (!Epi::AFTER_DRAIN) { E(acc, cur, wr, wc, fr, fq); S.done(cur); }
        if (!has_next) break;
#pragma unroll
        for (int a = 0; a < 2; ++a)
#pragma unroll
            for (int b = 0; b < 2; ++b)
#pragma unroll
                for (int m = 0; m < 4; ++m)
#pragma unroll
                    for (int n = 0; n < 2; ++n) { double z0_, z1_; asm volatile("v_mov_b64 %0, 0\n\tv_mov_b64 %1, 0" : "=v"(z0_), "=v"(z1_));
                        typedef double d2_t __attribute__((ext_vector_type(2))); acc[a][b][m][n] = __builtin_bit_cast(f32x4, (d2_t){z0_, z1_}); }
        cur = nxt; cA = nA; cB = nB; ++ui; nt = cur.nt ? cur.nt : K / BK;
        PG8_SCALES(cur, ui & 1);
        if constexpr (ALIGN_EPI) { if (wr == 1) PG8_BAR; }
    }
    PG8_WAIT_V(0);
    if constexpr (!ALIGN_EPI) { if (wr == 0) PG8_BAR; }
    PG8_BAR;
    if constexpr (Epi::AFTER_DRAIN) { E.fused(acc, cur, wr, wc, fr, fq, lds, wid, lane); S.done(cur); }
#undef PG8_SA
#undef PG8_SCALES
#undef PG8_SB
#undef PG8_STAGE
#undef PG8_LDA
#undef PG8_LDB
#undef PG8_MMA
#undef PG8_WAIT_V
#undef PG8_WAIT_VR
#undef PG8_WAIT_L
#undef PG8_BAR
#undef PG8_SCHED
}
}

#ifndef PROBE_DUP
#define PROBE_DUP 0
#endif
#ifndef USE_SPLITK
#define USE_SPLITK 0
#endif
#ifndef MK_PER_PHASE
#define MK_PER_PHASE 0
#endif
#define DUP(p) ((((PROBE_DUP) >> (p)) & 1) ? 2 : 1)
constexpr int D = 1024, NBATCH = 8, SEQ = 4096, NLAT = NBATCH * SEQ, CTXL = 256, NCTX = NBATCH * CTXL, MALL = NLAT + NCTX;
constexpr int RH = 4, RQK = 256, RV = 512;
constexpr int DFF = 2816, NE = 8, DFE = 3584;
constexpr float EPS = 1e-6f;
constexpr float LAMBDA_INIT = 0.3555090675909693f;
constexpr float LOG2E = 1.4426950408889634f, LN2 = 0.6931471805599453f;
constexpr int NWAVES = 8, NTHREADS = 512;
constexpr float MOE_WSCALE = 64.0f; constexpr int MOE_SB = 0x79797979, MOE_SA = 0x7f7f7f7f;
constexpr int MOE_ROWS = 2 * NLAT + NE * 256;

enum { I_X = 0, I_C, I_CTX, I_CCTX, I_L0_WMOD, I_L0_BMOD, I_L0_NPREMIX, I_L0_NPOSTMIX, I_L0_NPREFFN, I_L0_NPOSTFFN, I_L0_WIN, I_L0_DECAY, I_L0_WOUT, I_L0_WGU, I_L0_WDN,
       I_L1_WMOD, I_L1_BMOD, I_L1_NPREMIX, I_L1_NPOSTMIX, I_L1_NPREFFN, I_L1_NPOSTFFN, I_L1_WIN, I_L1_LAMBDA, I_L1_SUBLN, I_L1_WOUT, I_L1_RW, I_L1_RB, I_L1_MGU, I_L1_MDN, N_IN };

constexpr size_t MiB = 1u << 20;
constexpr size_t WS_CTL = 0, CTL_ZERO_BYTES = 1 * MiB;
constexpr size_t WS_MODV = 1 * MiB;
constexpr size_t WS_TAB0 = 1 * MiB + 512 * 1024;
constexpr size_t WS_TAB1 = WS_TAB0 + 32 * 1024;
constexpr size_t WS_LAM = WS_TAB1 + 8 * 1024;
constexpr size_t WS_WSC0 = WS_LAM + 4096;
constexpr size_t WS_WSC2 = WS_WSC0 + 8192 * 4;
constexpr size_t WS_RSC = 1 * MiB + 768 * 1024;
constexpr size_t WS_ROUTE = 2 * MiB;
constexpr size_t WS_WSC1 = 3 * MiB;
constexpr size_t WS_WSCM = 3 * MiB + 64 * 1024;
constexpr size_t WS_RSCM = 4 * MiB;
constexpr size_t WS_W0IN = 11 * MiB, WS_W0OUT = 27 * MiB, WS_W0GU = 31 * MiB, WS_W0DN = 42 * MiB, WS_W1IN = 48 * MiB, WS_W1OUT = 54 * MiB, WS_WMGU = 56 * MiB, WS_WMDN = 168 * MiB;
constexpr size_t WS_H = 224 * MiB;
constexpr size_t WS_A = 292 * MiB, WS_B = 564 * MiB;
constexpr size_t WS_OF = WS_B, WS_OB = WS_B + 136 * MiB;
constexpr size_t WS_Y8 = WS_A + 136 * MiB;
constexpr size_t WS_QH0 = WS_A, WS_KH0 = WS_A + 68 * MiB, WS_VQ0 = WS_A + 136 * MiB;
constexpr size_t WS_QH1 = WS_A, WS_KH1 = WS_A + 68 * MiB, WS_VH1 = WS_A + 136 * MiB;
constexpr size_t WS_HP = WS_B, WS_ACT1 = WS_A, WS_Y1 = WS_B;
constexpr size_t WS_V8 = 640 * MiB;
constexpr size_t WS_X1 = 360 * MiB, WS_X1C = 424 * MiB;
constexpr size_t WS_X2 = 496 * MiB;
constexpr size_t WS_X3 = 820 * MiB;
constexpr size_t WS_PART = WS_A + 136 * MiB;
constexpr size_t WS_END = 886 * MiB;
static_assert(WS_ACT1 + (size_t)MOE_ROWS * DFE <= WS_HP && WS_HP + (size_t)NE * NLAT * D <= WS_X3 && WS_X3 + (size_t)NLAT * D * 2 <= WS_END, "ws map");
static_assert(WS_WSC2 + 2 * DFF * 4 <= WS_RSC && WS_RSC + (size_t)MALL * 4 <= WS_ROUTE, "ws map");
constexpr int CW_TMO = 0;
constexpr int CW_BAR = 4096;
constexpr int CW_XRANK = 12288;
constexpr int CW_MOECNT = 16384;

constexpr int RING_BYTES = 131072;
constexpr int LDS_BYTES = 163840;
constexpr int MISC_OFF = LDS_BYTES - 256;

#define GAS __attribute__((address_space(1)))
#define LAS __attribute__((address_space(3)))
typedef unsigned short bf16;
typedef unsigned v4u __attribute__((ext_vector_type(4)));
typedef unsigned v2u __attribute__((ext_vector_type(2)));
typedef float f32x4 __attribute__((ext_vector_type(4)));
typedef float f32x2 __attribute__((ext_vector_type(2)));
typedef short bf16x8 __attribute__((ext_vector_type(8)));
typedef GAS unsigned gu32;
#define RLX_AGENT __ATOMIC_RELAXED, __HIP_MEMORY_SCOPE_AGENT
#define LDS_WAIT() asm volatile("s_waitcnt lgkmcnt(0)" ::: "memory")
#define VM_WAIT() asm volatile("s_waitcnt vmcnt(0)" ::: "memory")
__device__ __forceinline__ unsigned pk2(float lo, float hi);
__device__ __forceinline__ unsigned f2bf(float f) { return pk2(f, 0.f) & 0xffffu; }
typedef float f32x2_cv __attribute__((ext_vector_type(2))); typedef __bf16 bf16x2_cv __attribute__((ext_vector_type(2)));
__device__ __forceinline__ unsigned pk2(float lo, float hi) { f32x2_cv v = {lo, hi}; bf16x2_cv b = __builtin_convertvector(v, bf16x2_cv); return __builtin_bit_cast(unsigned, b); }
__device__ __forceinline__ float bf2f(unsigned b) { return __builtin_bit_cast(float, b << 16); }
__device__ __forceinline__ float bflo(unsigned w) { return __builtin_bit_cast(float, w << 16); }
__device__ __forceinline__ float bfhi(unsigned w) { return __builtin_bit_cast(float, w & 0xffff0000u); }
__device__ __forceinline__ unsigned pk4_fp8(float a, float b, float c, float d) {
    a = __builtin_amdgcn_fmed3f(a, -448.f, 448.f); b = __builtin_amdgcn_fmed3f(b, -448.f, 448.f); c = __builtin_amdgcn_fmed3f(c, -448.f, 448.f); d = __builtin_amdgcn_fmed3f(d, -448.f, 448.f);
    int w = 0; w = __builtin_amdgcn_cvt_pk_fp8_f32(a, b, w, false); w = __builtin_amdgcn_cvt_pk_fp8_f32(c, d, w, true); return (unsigned)w; }
__device__ __forceinline__ unsigned pk4_i8(float a, float b, float c, float d) {
    const unsigned ua = __builtin_bit_cast(unsigned, a + 12582912.f), ub = __builtin_bit_cast(unsigned, b + 12582912.f), uc = __builtin_bit_cast(unsigned, c + 12582912.f), ud = __builtin_bit_cast(unsigned, d + 12582912.f);
    return __builtin_amdgcn_perm(ub, ua, 0x0c0c0400u) | (__builtin_amdgcn_perm(ud, uc, 0x0c0c0400u) << 16); }
__device__ __forceinline__ float fast_exp2(float x) { return __builtin_amdgcn_exp2f(x); }
__device__ __forceinline__ float silu_f(float g) { return g * __builtin_amdgcn_rcpf(1.0f + __builtin_amdgcn_exp2f(-g * LOG2E)); }
__device__ __forceinline__ float silu2_f(float x) { return x * __builtin_amdgcn_rcpf(1.0f + __builtin_amdgcn_exp2f(-x)); }
__device__ __forceinline__ f32x2 silu2_pk(f32x2 x) { const f32x2 d = (f32x2){__builtin_amdgcn_exp2f(-x[0]), __builtin_amdgcn_exp2f(-x[1])} + 1.0f;
    return x * (f32x2){__builtin_amdgcn_rcpf(d[0]), __builtin_amdgcn_rcpf(d[1])}; }
#define WR_DPP(x, ctrl) __builtin_bit_cast(float, __builtin_amdgcn_update_dpp(0, __builtin_bit_cast(int, (x)), (ctrl), 0xF, 0xF, true))
__device__ __forceinline__ float wr_lane(float v, int l) { return __int_as_float(__builtin_amdgcn_readlane(__float_as_int(v), l)); }
__device__ __forceinline__ float wave_sum(float v) {
    v += WR_DPP(v, 0xB1); v += WR_DPP(v, 0x4E); v += WR_DPP(v, 0x124); v += WR_DPP(v, 0x128);
    return (wr_lane(v, 0) + wr_lane(v, 16)) + (wr_lane(v, 32) + wr_lane(v, 48));
}
__device__ __forceinline__ float wave_max(float v) {
    v = fmaxf(v, WR_DPP(v, 0xB1)); v = fmaxf(v, WR_DPP(v, 0x4E)); v = fmaxf(v, WR_DPP(v, 0x124)); v = fmaxf(v, WR_DPP(v, 0x128));
    return fmaxf(fmaxf(wr_lane(v, 0), wr_lane(v, 16)), fmaxf(wr_lane(v, 32), wr_lane(v, 48)));
}

#define XB_TMO      128
#define XB_XCNT(j)  (256  + 64 * (j))
#define XB_XSUB(j)  (1280 + 64 * (j))
#define XB_XGEN(j)  (2304 + 64 * (j))
#define XB_TOP      3328
#define XB_TOPGEN   3392
#define XCD_BAR_WORDS 3456
#define XB_SPIN_CAP (1u << 24)

__device__ __forceinline__ unsigned xb_ld(unsigned* p)              { return __hip_atomic_load(p, __ATOMIC_RELAXED, __HIP_MEMORY_SCOPE_AGENT); }
__device__ __forceinline__ unsigned xb_add(unsigned* p, unsigned v) { return __hip_atomic_fetch_add(p, v, __ATOMIC_RELAXED, __HIP_MEMORY_SCOPE_AGENT); }
__device__ __forceinline__ unsigned xb_xcc_id() { return (unsigned)__builtin_amdgcn_s_getreg((3 << 11) | 20) & 0xFu; }
#define XB_SPIN(cond, bar) do { unsigned _sp = 0; while (cond) { __builtin_amdgcn_s_sleep(1); \
    if ((++_sp & 255u) == 0u) { if (xb_ld(&(bar)[XB_TMO])) break; if (_sp > XB_SPIN_CAP) { atomicAdd(&(bar)[XB_TMO], 1u); break; } } } } while (0)

struct XcdBarrier {
    unsigned* bar; unsigned x;
    volatile LAS unsigned* st;
};

__device__ __forceinline__ XcdBarrier xcd_barrier_post(unsigned* bar, volatile LAS unsigned* st) {
    XcdBarrier b; b.bar = bar; b.x = xb_xcc_id(); b.st = st;
    if (threadIdx.x == 0) (void)xb_add(&bar[XB_XCNT(b.x)], 1u);
    return b;
}
__device__ __forceinline__ void xcd_barrier_complete(unsigned* bar, unsigned x, unsigned& nloc, unsigned& nx) {
    const unsigned G = gridDim.x * gridDim.y * gridDim.z;
    unsigned sum, cnt, mine, sp = 0u;
    for (;;) {
        sum = 0u; cnt = 0u; mine = 0u;
#pragma unroll
        for (unsigned j = 0; j < 16; ++j) { const unsigned c = xb_ld(&bar[XB_XCNT(j)]); sum += c; cnt += (c > 0u) ? 1u : 0u; mine = (j == x) ? c : mine; }
        if (sum == G) break;
        __builtin_amdgcn_s_sleep(1);
        if ((++sp & 255u) == 0u) { if (xb_ld(&bar[XB_TMO])) break; if (sp > XB_SPIN_CAP) { atomicAdd(&bar[XB_TMO], 1u); break; } }
    }
    nloc = mine > 0u ? mine : 1u; nx = cnt > 0u ? cnt : 1u;
}

__device__ __forceinline__ void xcd_barrier(const XcdBarrier& b) {
    asm volatile("s_waitcnt vmcnt(0)" ::: "memory");
    __syncthreads();
    if (threadIdx.x == 0) {
        unsigned* bar = b.bar;
        __builtin_amdgcn_s_waitcnt(0);
        unsigned nloc = b.st[0], nx = b.st[1];
        if (nloc == 0u) { xcd_barrier_complete(bar, b.x, nloc, nx); b.st[0] = nloc; b.st[1] = nx; }
        const unsigned old = xb_add(&bar[XB_XSUB(b.x)], 1u);
        const unsigned gen = old / nloc;
        if (old + 1u == (gen + 1u) * nloc) {
            __builtin_amdgcn_fence(__ATOMIC_RELEASE, "agent");
            asm volatile("s_waitcnt vmcnt(0)" ::: "memory");
            const unsigned og = xb_add(&bar[XB_TOP], 1u);
            const unsigned tg = og / nx;
            if (og + 1u == (tg + 1u) * nx) xb_add(&bar[XB_TOPGEN], 1u);
            else XB_SPIN(xb_ld(&bar[XB_TOPGEN]) == tg, bar);
            __builtin_amdgcn_fence(__ATOMIC_ACQUIRE, "agent");
            xb_add(&bar[XB_XGEN(b.x)], 1u);
            asm volatile("s_waitcnt vmcnt(0)" ::: "memory");
        } else {
            XB_SPIN(xb_ld(&bar[XB_XGEN(b.x)]) == gen, bar);
            __builtin_amdgcn_fence(__ATOMIC_ACQUIRE, "agent");
            asm volatile("s_waitcnt vmcnt(0)" ::: "memory");
        }
    }
    __syncthreads();
}


struct Args { const float* in[N_IN]; float* out; unsigned char* ws; int ph_lo, ph_hi; };

struct Frame {
    LAS unsigned char* lds;
    volatile LAS unsigned* MISC;
    gu32* ctl;
    int tid, lane, wave, vcu, G, cid;
    unsigned char* ws;
};

namespace pg8 {
struct EpiStore {
    static constexpr bool PERM = true, AFTER_DRAIN = false; static constexpr int NST = 16;
    bf16_t* O; int ldc;
    __device__ __forceinline__ void operator()(const f32x4 (&acc)[2][2][4][2], const Unit& u, int wr, int wc, int fr, int fq) const {
        const int row0 = u.pm * BM + wr * 64 + fr; const int col0 = u.pc * BM + wc * 32 + 8 * fq;
#pragma unroll
        for (int ai = 0; ai < 2; ++ai)
#pragma unroll
            for (int m = 0; m < 4; ++m) { bf16_t* rowp = O + (size_t)(row0 + ai * HALF + m * 16) * ldc + col0;
#pragma unroll
                for (int bj = 0; bj < 2; ++bj) { const f32x4 v0 = acc[ai][bj][m][0], v1 = acc[ai][bj][m][1];
                    u32x4 w; w.x = cvt_pk_bf16(v0[0], v0[1]); w.y = cvt_pk_bf16(v0[2], v0[3]); w.z = cvt_pk_bf16(v1[0], v1[1]); w.w = cvt_pk_bf16(v1[2], v1[3]);
                    *(u32x4*)(rowp + bj * HALF) = w; } }
    }
};
struct EpiSwiglu {
    static constexpr bool PERM = true, AFTER_DRAIN = false; static constexpr int NST = 8;
    bf16_t* O; int ldc;
    __device__ __forceinline__ void operator()(const f32x4 (&acc)[2][2][4][2], const Unit& u, int wr, int wc, int fr, int fq) const {
        const int row0 = u.pm * BM + wr * 64 + fr; const int col0 = u.pc * HALF + wc * 32 + 8 * fq;
#pragma unroll
        for (int ai = 0; ai < 2; ++ai)
#pragma unroll
            for (int m = 0; m < 4; ++m) { bf16_t* rowp = O + (size_t)(row0 + ai * HALF + m * 16) * ldc + col0;
                f32x4 a0, a1;
#pragma unroll
                for (int e = 0; e < 4; ++e) { a0[e] = silu_f(acc[ai][0][m][0][e]) * acc[ai][1][m][0][e]; a1[e] = silu_f(acc[ai][0][m][1][e]) * acc[ai][1][m][1][e]; }
                u32x4 w; w.x = cvt_pk_bf16(a0[0], a0[1]); w.y = cvt_pk_bf16(a0[2], a0[3]); w.z = cvt_pk_bf16(a1[0], a1[1]); w.w = cvt_pk_bf16(a1[2], a1[3]);
                *(u32x4*)rowp = w; }
    }
};

struct EpiQKV0 {
    static constexpr bool PERM = true, AFTER_DRAIN = false; static constexpr int NST = 16;
    bf16_t* Qh; bf16_t* Kh; bf16_t* Vq; const float* tab;
    __device__ __forceinline__ void operator()(const f32x4 (&acc)[2][2][4][2], const Unit& u, int wr, int wc, int fr, int fq) const {
        const int row0 = u.pm * BM + wr * 64 + fr, pc = u.pc;
        if (pc < 8) {
            bf16_t* base = pc < 4 ? Qh + (size_t)pc * MALL * 256 : Kh + (size_t)(pc - 4) * MALL * 256; const float sc = pc < 4 ? 1.0f : 0.0625f; const bool lat = u.pm < NLAT / BM;
            const int col0 = wc * 32 + 8 * fq;
#pragma unroll
            for (int ai = 0; ai < 2; ++ai)
#pragma unroll
                for (int m = 0; m < 4; ++m) { const int row = row0 + ai * HALF + m * 16, t = row & (SEQ - 1);
#pragma unroll
                    for (int bj = 0; bj < 2; ++bj) { f32x4 v0 = acc[ai][bj][m][0], v1 = acc[ai][bj][m][1];
                        if (lat) { const int pos = bj ? (t & 63) : (t >> 6); const float* tp = tab + (size_t)(pos * 64 + 16 * wc + 4 * fq) * 2;
                            const f32x4 c0 = *(const f32x4*)tp, c1 = *(const f32x4*)(tp + 4);
                            v0 = (f32x4){v0[0] * c0[0] - v0[1] * c0[1], v0[1] * c0[0] + v0[0] * c0[1], v0[2] * c0[2] - v0[3] * c0[3], v0[3] * c0[2] + v0[2] * c0[3]};
                            v1 = (f32x4){v1[0] * c1[0] - v1[1] * c1[1], v1[1] * c1[0] + v1[0] * c1[1], v1[2] * c1[2] - v1[3] * c1[3], v1[3] * c1[2] + v1[2] * c1[3]}; }
                        v0 = v0 * sc; v1 = v1 * sc;
                        u32x4 w; w.x = cvt_pk_bf16(v0[0], v0[1]); w.y = cvt_pk_bf16(v0[2], v0[3]); w.z = cvt_pk_bf16(v1[0], v1[1]); w.w = cvt_pk_bf16(v1[2], v1[3]);
                        *(u32x4*)(base + (size_t)row * 256 + col0 + bj * HALF) = w; } }
        } else {
#pragma unroll
            for (int ai = 0; ai < 2; ++ai)
#pragma unroll
                for (int m = 0; m < 4; ++m) { const int row = row0 + ai * HALF + m * 16;
#pragma unroll
                    for (int bj = 0; bj < 2; ++bj) { const f32x4 v0 = acc[ai][bj][m][0], v1 = acc[ai][bj][m][1];
                        u32x4 w; w.x = cvt_pk_bf16(v0[0], v0[1]); w.y = cvt_pk_bf16(v0[2], v0[3]); w.z = cvt_pk_bf16(v1[0], v1[1]); w.w = cvt_pk_bf16(v1[2], v1[3]);
                        *(u32x4*)(Vq + ((size_t)((pc - 8) * 2 + bj) * MALL + row) * 128 + wc * 32 + 8 * fq) = w; } }
        }
    }
};
struct QkvOrder {
    int G, c;
    __device__ __forceinline__ void init(int G_, int c_, int) { G = G_; c = c_; }
    __device__ __forceinline__ bool next(int i, Unit& u) const {
        constexpr int nM = MALL / BM, nN = 2048 / BM, NQK = nM * nN, NV = nM * 4;
        const int L = i * G + c; if (L >= NQK + NV) return false;
        const bool isv = L >= NQK;
        int wgid = isv ? 0 : L; { const int q = NQK / NXCD, xcd = wgid % NXCD, off = wgid / NXCD; wgid = xcd * q + off; }
        const int nig = WGM * nN, gid = wgid / nig, fm = gid * WGM, gsz = (nM - fm) < WGM ? (nM - fm) : WGM;
        const int qpm = fm + ((wgid % nig) % gsz), qpn = (wgid % nig) / gsz;
        const int v = isv ? L - NQK : 0; const int vv = (v % NXCD) * (NV / NXCD) + v / NXCD;
        u.pm = isv ? (vv >> 2) : qpm; u.pn = isv ? (vv >> 2) : qpn; u.pa = isv ? 8 + (vv & 3) : qpm; u.pc = isv ? 8 + (vv & 3) : qpn;
        u.k0 = 0; u.nt = 0; u.ks = -1; u.sw = isv ? 1 : 0; return true;
    }
    __device__ __forceinline__ void a_ready(const Unit&) const {}
    __device__ __forceinline__ void done(const Unit&) const {}
};
static_assert(((MALL / 256) * 8) % 8 == 0, "QkvOrder");
struct EpiQKV1 {
    static constexpr bool PERM = true, AFTER_DRAIN = false; static constexpr int NST = 16;
    unsigned char* Qh; unsigned char* Kh; unsigned char* V8; const float* tab;
    __device__ __forceinline__ void operator()(const f32x4 (&acc)[2][2][4][2], const Unit& u, int wr, int wc, int fr, int fq) const {
        const int row0 = u.pm * BM + wr * 64 + fr, pc = u.pc;
        if (!u.sw) {
            unsigned char* base = pc < 4 ? Qh : Kh; const float sc = pc < 4 ? LOG2E : 1.0f; const bool lat = u.pm < NLAT / BM;
            const int hf = wc & 1, p0 = 32 * hf + 8 * fq;
#pragma unroll
            for (int ai = 0; ai < 2; ++ai)
#pragma unroll
                for (int m = 0; m < 4; ++m) { const int row = row0 + ai * HALF + m * 16, t = row & (SEQ - 1);
                    const int pos = hf ? (t & 63) : (t >> 6); const float* tp = tab + (size_t)(pos * 16 + 4 * fq) * 2;
                    f32x4 c0 = (f32x4){1.f, 0.f, 1.f, 0.f}, c1 = c0;
                    if (lat) { c0 = *(const f32x4*)tp; c1 = *(const f32x4*)(tp + 4); }
#pragma unroll
                    for (int bj = 0; bj < 2; ++bj) { f32x4 v0 = acc[ai][bj][m][0], v1 = acc[ai][bj][m][1];
                        v0 = (f32x4){v0[0] * c0[0] - v0[1] * c0[1], v0[1] * c0[0] + v0[0] * c0[1], v0[2] * c0[2] - v0[3] * c0[3], v0[3] * c0[2] + v0[2] * c0[3]};
                        v1 = (f32x4){v1[0] * c1[0] - v1[1] * c1[1], v1[1] * c1[0] + v1[0] * c1[1], v1[2] * c1[2] - v1[3] * c1[3], v1[3] * c1[2] + v1[2] * c1[3]};
                        v0 = v0 * sc; v1 = v1 * sc;
                        const int head = (pc & 3) * 4 + 2 * bj + (wc >> 1);
                        v2u w; w.x = pk4_fp8(v0[0], v0[1], v0[2], v0[3]); w.y = pk4_fp8(v1[0], v1[1], v1[2], v1[3]);
                        *(v2u*)(base + ((size_t)head * MALL + row) * 64 + p0) = w; } }
        } else {
            const int k0 = 32 * (wc & 1) + 8 * fq, jb = 16 * (k0 >> 5) + 4 * ((k0 >> 3) & 3);
#pragma unroll
            for (int ai = 0; ai < 2; ++ai)
#pragma unroll
                for (int m = 0; m < 4; ++m) { const int n = (pc - 8) * BM + wr * 64 + fr + ai * HALF + m * 16, head = n >> 7, c = n & 127, swz = (c >> 2) & 3;
#pragma unroll
                    for (int bj = 0; bj < 2; ++bj) { const f32x4 v0 = acc[ai][bj][m][0], v1 = acc[ai][bj][m][1];
                        const size_t tile = (size_t)u.pn * 4 + 2 * bj + (wc >> 1);
                        unsigned char* img = V8 + ((size_t)head * (MALL / 64) + tile) * 8192 + c * 64 + (jb & 15);
                        *(unsigned*)(img + (((jb >> 4) ^ swz) << 4)) = pk4_fp8(v0[0], v0[1], v0[2], v0[3]);
                        *(unsigned*)(img + (((2 + (jb >> 4)) ^ swz) << 4)) = pk4_fp8(v1[0], v1[1], v1[2], v1[3]); } }
        }
    }
};

struct EpiGateMerge {
    static constexpr bool PERM = true, AFTER_DRAIN = false; static constexpr int NST = 8;
    bf16_t* Of; const bf16_t* Ob; const float* ssq;
    __device__ __forceinline__ void operator()(const f32x4 (&acc)[2][2][4][2], const Unit& u, int wr, int wc, int fr, int fq) const {
        const int row0 = u.pm * BM + wr * 64 + fr; const int col0 = u.pc * HALF + wc * 32 + 8 * fq; const int head = u.pc >> 2;
#pragma unroll
        for (int ai = 0; ai < 2; ++ai)
#pragma unroll
            for (int m = 0; m < 4; ++m) { const size_t row = (size_t)(row0 + ai * HALF + m * 16);
                const f32x4 sf = *(const f32x4*)(ssq + (row * RH + head) * 8), sb = *(const f32x4*)(ssq + (row * RH + head) * 8 + 4);
                const float rf = __builtin_amdgcn_rsqf(((sf[0] + sf[1]) + (sf[2] + sf[3])) * (1.0f / RV) + EPS) * LN2, rb = __builtin_amdgcn_rsqf(((sb[0] + sb[1]) + (sb[2] + sb[3])) * (1.0f / RV) + EPS) * LN2;
                const u32x4 of = *(const u32x4*)(Of + row * 2048 + col0), ob = *(const u32x4*)(Ob + row * 2048 + col0);
                f32x2 y[4];
#pragma unroll
                for (int e = 0; e < 4; ++e) {
                    const f32x2 gf = (f32x2){acc[ai][0][m][e >> 1][2 * (e & 1)], acc[ai][0][m][e >> 1][2 * (e & 1) + 1]}, gb = (f32x2){acc[ai][1][m][e >> 1][2 * (e & 1)], acc[ai][1][m][e >> 1][2 * (e & 1) + 1]};
                    y[e] = silu2_pk(gf) * ((f32x2){bflo(of[e]), bfhi(of[e])} * rf) + silu2_pk(gb) * ((f32x2){bflo(ob[e]), bfhi(ob[e])} * rb); }
                u32x4 w; w.x = cvt_pk_bf16(y[0][0], y[0][1]); w.y = cvt_pk_bf16(y[1][0], y[1][1]); w.z = cvt_pk_bf16(y[2][0], y[2][1]); w.w = cvt_pk_bf16(y[3][0], y[3][1]);
                *(u32x4*)(Of + row * 2048 + col0) = w; }
    }
};

struct SplitOrder {
    StaticOrder lat; int G, c, KS, ntS, nN, nl;
    __device__ __forceinline__ void init(int N, int G_, int c_, int KS_, int ntS_) { lat.init(KS_ ? NLAT : MALL, N, G_, c_); G = G_; c = c_; KS = KS_; ntS = ntS_; nN = N / BM; nl = (lat.nwg > c_) ? (lat.nwg - 1 - c_) / G_ + 1 : 0; }
    __device__ __forceinline__ bool next(int i, Unit& u) const {
        if (i < nl) return lat.next(i, u);
        const long j = (long)(i - nl) * G + c; if (j >= (long)(NCTX / BM) * nN * KS) return false;
        const int tile = (int)(j / KS), ks = (int)(j % KS);
        u.pm = NLAT / BM + tile / nN; u.pn = tile % nN; u.pc = u.pn; u.k0 = ks * ntS * BK; u.nt = ntS; u.ks = ks; u.pa = u.pm; u.sw = 0; return true;
    }
    __device__ __forceinline__ void a_ready(const Unit&) const {}
    __device__ __forceinline__ void done(const Unit&) const {}
};
struct EpiStoreSplit {
    static constexpr bool PERM = true, AFTER_DRAIN = false; static constexpr int NST = 16;
    bf16_t* O; int ldc; float* P;
    __device__ __forceinline__ void operator()(const f32x4 (&acc)[2][2][4][2], const Unit& u, int wr, int wc, int fr, int fq) const {
        const int row0 = u.pm * BM + wr * 64 + fr; const int col0 = u.pc * BM + wc * 32 + 8 * fq;
        if (u.ks < 0) {
#pragma unroll
            for (int ai = 0; ai < 2; ++ai)
#pragma unroll
                for (int m = 0; m < 4; ++m) { bf16_t* rowp = O + (size_t)(row0 + ai * HALF + m * 16) * ldc + col0;
#pragma unroll
                    for (int bj = 0; bj < 2; ++bj) { const f32x4 v0 = acc[ai][bj][m][0], v1 = acc[ai][bj][m][1];
                        u32x4 w; w.x = cvt_pk_bf16(v0[0], v0[1]); w.y = cvt_pk_bf16(v0[2], v0[3]); w.z = cvt_pk_bf16(v1[0], v1[1]); w.w = cvt_pk_bf16(v1[2], v1[3]);
                        *(u32x4*)(rowp + bj * HALF) = w; } }
        } else {
            float* pb = P + (size_t)u.ks * NCTX * ldc;
#pragma unroll
            for (int ai = 0; ai < 2; ++ai)
#pragma unroll
                for (int m = 0; m < 4; ++m) { float* rowp = pb + (size_t)(row0 - NLAT + ai * HALF + m * 16) * ldc + col0;
#pragma unroll
                    for (int bj = 0; bj < 2; ++bj) { *(f32x4*)(rowp + bj * HALF) = acc[ai][bj][m][0]; *(f32x4*)(rowp + bj * HALF + 4) = acc[ai][bj][m][1]; } }
        }
    }
};
struct EpiSwiglu8 {
    static constexpr bool PERM = true, AFTER_DRAIN = false; static constexpr int NST = 8;
    unsigned char* O; int ldc;
    __device__ __forceinline__ void operator()(const f32x4 (&acc)[2][2][4][2], const Unit& u, int wr, int wc, int fr, int fq) const {
        const int row0 = u.pm * BM + wr * 64 + fr; const int col0 = u.pc * HALF + wc * 32 + 8 * fq;
#pragma unroll
        for (int ai = 0; ai < 2; ++ai)
#pragma unroll
            for (int m = 0; m < 4; ++m) { unsigned char* rowp = O + (size_t)(row0 + ai * HALF + m * 16) * ldc + col0;
                const f32x4 g0 = acc[ai][0][m][0], g1 = acc[ai][0][m][1], u0 = acc[ai][1][m][0], u1 = acc[ai][1][m][1];
                const f32x2 p0 = silu2_pk((f32x2){g0[0], g0[1]}) * (f32x2){u0[0], u0[1]}, p1 = silu2_pk((f32x2){g0[2], g0[3]}) * (f32x2){u0[2], u0[3]};
                const f32x2 p2 = silu2_pk((f32x2){g1[0], g1[1]}) * (f32x2){u1[0], u1[1]}, p3 = silu2_pk((f32x2){g1[2], g1[3]}) * (f32x2){u1[2], u1[3]};
                v2u w; w.x = pk4_fp8(p0[0], p0[1], p1[0], p1[1]); w.y = pk4_fp8(p2[0], p2[1], p3[0], p3[1]);
                *(v2u*)rowp = w; }
    }
};
struct EpiNull {
    static constexpr bool PERM = true, AFTER_DRAIN = false; static constexpr int NST = 1;
    float* O;
    __device__ __forceinline__ void operator()(const f32x4 (&acc)[2][2][4][2], const Unit& u, int wr, int wc, int fr, int fq) const {
#pragma unroll
        for (int ai = 0; ai < 2; ++ai)
#pragma unroll
            for (int bj = 0; bj < 2; ++bj)
#pragma unroll
                for (int m = 0; m < 4; ++m) { asm volatile("" :: "v"(acc[ai][bj][m][0]), "v"(acc[ai][bj][m][1])); }
        const f32x4 s = acc[0][0][0][0];
        O[(size_t)(u.pm & 7) * 65536 + (wr * 4 + wc) * 64 + fr + 16 * fq] = (s[0] + s[1]) + (s[2] + s[3]);
    }
};
struct MoeOrder {
    int nM, nN, nwg, G, c; int t1, t2, t3, t4, t5, t6, t7; int rep, slots;
    __device__ __forceinline__ bool next(int i, Unit& u) const {
        long L = (long)i * G + c; if (L >= (long)nwg * rep) return false; if (L >= nwg) L -= nwg;
        int wgid = (int)L; { const int q = nwg / NXCD, r = nwg % NXCD, xcd = wgid % NXCD, off = wgid / NXCD; wgid = (xcd < r ? xcd * (q + 1) : r * (q + 1) + (xcd - r) * q) + off; }
        const int nig = WGM * nN, gid = wgid / nig, fm = gid * WGM, gsz = (nM - fm) < WGM ? (nM - fm) : WGM;
        u.pm = fm + ((wgid % nig) % gsz); u.pc = (wgid % nig) / gsz;
        const int e = (u.pm >= t1) + (u.pm >= t2) + (u.pm >= t3) + (u.pm >= t4) + (u.pm >= t5) + (u.pm >= t6) + (u.pm >= t7);
        u.pn = e * nN + u.pc; u.k0 = 0; u.nt = 0; u.ks = -1;
        const int te = e == 0 ? 0 : e == 1 ? t1 : e == 2 ? t2 : e == 3 ? t3 : e == 4 ? t4 : e == 5 ? t5 : e == 6 ? t6 : t7;
        u.pa = slots ? e * (NLAT / BM) + (u.pm - te) : u.pm; u.sw = 0; return true;
    }
    __device__ __forceinline__ void a_ready(const Unit&) const {}
    __device__ __forceinline__ void done(const Unit&) const {}
};
}

__device__ __forceinline__ int swiglu_row(int n, int F) { const int bj = n / F, w = n % F; return 256 * (w >> 7) + 128 * bj + (w & 127); }
__device__ __forceinline__ int w_rowmap(int map, int mapF, int n) {
    if (map == 1) { if (n < 2048) { const int d0 = n & 255, hf = d0 >> 7, e = d0 & 127; return (n - d0) + 2 * (hf * 64 + (e & 63)) + (e >> 6); }
                    if (n >= 4096) return 4096 + swiglu_row(n - 4096, 2048); return n; }
    if (map == 2) { if (n < 2048) { const int d0 = n & 63, hf = d0 >> 5, e = d0 & 31; return (n - d0) + hf * 32 + 2 * (e & 15) + (e >> 4); } return n; }
    if (map == 3) return swiglu_row(n, mapF);
    return n;
}
template <bool FP8> __device__ __forceinline__ void p0_item64(const float* W, int K, int N, void* WT, int map, int mapF, LAS float* scr, int k0, int n0, int lane, float wscale) {
    { const int kq = lane >> 4, n4 = (lane & 15) * 4;
#pragma unroll 4
      for (int i = 0; i < 16; ++i) { const int k = 4 * i + kq; const f32x4 v = *(const GAS f32x4*)(W + (size_t)(k0 + k) * N + n0 + n4);
          LAS float* d = scr + k * 65 + n4; d[0] = v.x; d[1] = v.y; d[2] = v.z; d[3] = v.w; } }
    LDS_WAIT(); asm volatile("" ::: "memory");
    if constexpr (!FP8) {
        const int c = lane & 7;
#pragma unroll
        for (int j = 0; j < 8; ++j) { const int n = (lane >> 3) + 8 * j; const LAS float* sp = scr + (8 * c) * 65 + n;
            v4u o; o.x = pk2(sp[0 * 65], sp[1 * 65]); o.y = pk2(sp[2 * 65], sp[3 * 65]); o.z = pk2(sp[4 * 65], sp[5 * 65]); o.w = pk2(sp[6 * 65], sp[7 * 65]);
            *(GAS v4u*)((bf16*)WT + (size_t)w_rowmap(map, mapF, n0 + n) * K + k0 + 8 * c) = o; }
    } else {
        const int c = lane & 3;
#pragma unroll
        for (int j = 0; j < 4; ++j) { const int n = (lane >> 2) + 16 * j; const LAS float* sp = scr + (16 * c) * 65 + n;
            v4u o;
#pragma unroll
            for (int q = 0; q < 4; ++q) o[q] = pk4_fp8(sp[(4 * q) * 65] * wscale, sp[(4 * q + 1) * 65] * wscale, sp[(4 * q + 2) * 65] * wscale, sp[(4 * q + 3) * 65] * wscale);
            *(GAS v4u*)((unsigned char*)WT + (size_t)w_rowmap(map, mapF, n0 + n) * K + k0 + 16 * c) = o; }
    }
    LDS_WAIT(); asm volatile("" ::: "memory");
}

struct ColItem { const float* W; unsigned char* WT; float* WSC; int N, map, mapF, n0; };
__device__ __forceinline__ bool p0_coldesc(const Frame& F, const Args& a, int ci, ColItem& d) {
    constexpr int C0 = 8192 / 32, C1 = 2 * DFF / 32, C2 = 3072 / 32, C3 = 2 * DFE / 32;
    if (ci >= C0 + C1 + C2 + NE * C3) return false;
    int c = ci;
    if (c < C0) { d.W = a.in[I_L0_WIN]; d.N = 8192; d.WT = F.ws + WS_W0IN; d.WSC = (float*)(F.ws + WS_WSC0); d.map = 1; d.mapF = 0; }
    else if ((c -= C0) < C1) { d.W = a.in[I_L0_WGU]; d.N = 2 * DFF; d.WT = F.ws + WS_W0GU; d.WSC = (float*)(F.ws + WS_WSC2); d.map = 3; d.mapF = DFF; }
    else if ((c -= C1) < C2) { d.W = a.in[I_L1_WIN]; d.N = 3072; d.WT = F.ws + WS_W1IN; d.WSC = (float*)(F.ws + WS_WSC1); d.map = 2; d.mapF = 0; }
    else { c -= C2; const int e = c / C3; c = c % C3; d.W = a.in[I_L1_MGU] + (size_t)e * D * 2 * DFE; d.N = 2 * DFE; d.WT = F.ws + WS_WMGU + (size_t)e * 2 * DFE * D; d.WSC = (float*)(F.ws + WS_WSCM) + e * 2 * DFE; d.map = 3; d.mapF = DFE; }
    d.n0 = 32 * c; return true;
}
__device__ __forceinline__ void p0_colpass(Frame& F, const Args& a) {
    LAS float* T = (LAS float*)F.lds;
    LAS float* mx = (LAS float*)(F.lds + 1024 * 33 * 4);
    const int t = F.tid, n4 = (t & 7) * 4, krow = t >> 3;
    const int qn = t & 31, kc = t >> 5;
    ColItem cur, nxt; int ci = F.vcu;
    bool have = p0_coldesc(F, a, ci, cur);
    f32x4 v[16];
#define P0_LOAD(d_) do { const float* wp_ = (d_).W + (size_t)krow * (d_).N + (d_).n0 + n4; _Pragma("unroll") for (int i = 0; i < 16; ++i) v[i] = *(const GAS f32x4*)(wp_ + (size_t)(64 * i) * (d_).N); } while (0)
    if (have) P0_LOAD(cur);
    while (have) {
        f32x4 m4 = (f32x4){0.f, 0.f, 0.f, 0.f};
#pragma unroll
        for (int i = 0; i < 16; ++i) { LAS float* d = T + (64 * i + krow) * 33 + n4; d[0] = v[i].x; d[1] = v[i].y; d[2] = v[i].z; d[3] = v[i].w;
            m4.x = fmaxf(m4.x, fabsf(v[i].x)); m4.y = fmaxf(m4.y, fabsf(v[i].y)); m4.z = fmaxf(m4.z, fabsf(v[i].z)); m4.w = fmaxf(m4.w, fabsf(v[i].w)); }
#pragma unroll
        for (int e = 0; e < 4; ++e) { float x = m4[e]; x = fmaxf(x, __shfl_xor(x, 8)); x = fmaxf(x, __shfl_xor(x, 16)); x = fmaxf(x, __shfl_xor(x, 32)); m4[e] = x; }
        if (F.lane < 8) *(LAS f32x4*)(mx + F.wave * 32 + n4) = m4;
        __syncthreads();
        ci += F.G; const bool hn = p0_coldesc(F, a, ci, nxt); if (hn) P0_LOAD(nxt);
        float cm = 0.f;
#pragma unroll
        for (int j = 0; j < 8; ++j) cm = fmaxf(cm, mx[j * 32 + qn]);
        const float iv = cm > 0.f ? 127.0f / cm : 0.f;
        const int row = w_rowmap(cur.map, cur.mapF, cur.n0 + qn);
        const float wf = cur.map == 3 ? (((row >> 7) & 1) ? LN2 : LOG2E) : (cur.map == 1 && row >= 4096) ? LOG2E : 1.0f;
        if (t < 32) cur.WSC[row] = cm * (1.0f / 127.0f) * wf;
#pragma unroll
        for (int j = 0; j < 4; ++j) { const int k0 = 16 * (kc + 16 * j); const LAS float* sp = T + k0 * 33 + qn;
            v4u o;
#pragma unroll
            for (int q = 0; q < 4; ++q) o[q] = pk4_i8(sp[(4 * q) * 33] * iv, sp[(4 * q + 1) * 33] * iv, sp[(4 * q + 2) * 33] * iv, sp[(4 * q + 3) * 33] * iv);
            *(GAS v4u*)(cur.WT + (size_t)row * 1024 + k0) = o; }
        __syncthreads();
        cur = nxt; have = hn;
    }
#undef P0_LOAD
}

__device__ __forceinline__ void p0_prologue(Frame& F, const Args& a) {
    LAS float* scr = (LAS float*)(F.lds + F.wave * 16640);
    const int gw = F.vcu * NWAVES + F.wave, NGW = F.G * NWAVES;
    constexpr int I1 = (2048 / 64) * (D / 64), I3 = (DFF / 64) * (D / 64), I5 = (D / 64) * (D / 64);
    constexpr int I7E = (DFE / 64) * (D / 64);
    constexpr int NITEMS = I1 + I3 + I5 + NE * I7E;
    for (int rep_ = 0; rep_ < DUP(24); ++rep_) p0_colpass(F, a);
    for (int rep_ = 0; rep_ < DUP(25); ++rep_) {
        struct WItem { const float* W; unsigned char* WT; int K, N, k0, n0, fp8; float ws; };
        auto wdesc = [&](int it, WItem& d) __attribute__((always_inline)) {
            int r = it;
            if (r < I1) { d.W = a.in[I_L0_WOUT]; d.K = 2048; d.N = D; d.WT = F.ws + WS_W0OUT; d.fp8 = 0; d.ws = 1.f; }
            else if ((r -= I1) < I3) { d.W = a.in[I_L0_WDN]; d.K = DFF; d.N = D; d.WT = F.ws + WS_W0DN; d.fp8 = 1; d.ws = MOE_WSCALE; }
            else if ((r -= I3) < I5) { d.W = a.in[I_L1_WOUT]; d.K = D; d.N = D; d.WT = F.ws + WS_W1OUT; d.fp8 = 1; d.ws = MOE_WSCALE; }
            else { r -= I5; const int e = r / I7E; r = r % I7E; d.W = a.in[I_L1_MDN] + (size_t)e * DFE * D; d.K = DFE; d.N = D; d.WT = F.ws + WS_WMDN + (size_t)e * D * DFE; d.fp8 = 1; d.ws = MOE_WSCALE; }
            d.n0 = 64 * (r % (D / 64)); d.k0 = 64 * (r / (D / 64)); };
        const int kq = F.lane >> 4, n4 = (F.lane & 15) * 4;
        auto wload = [&](const WItem& d, f32x4 (&v)[16]) __attribute__((always_inline)) {
#pragma unroll
            for (int i = 0; i < 16; ++i) v[i] = *(const GAS f32x4*)(d.W + (size_t)(d.k0 + 4 * i + kq) * d.N + d.n0 + n4); };
        auto wproc = [&](const WItem& d, const f32x4 (&v)[16]) __attribute__((always_inline)) {
#pragma unroll
            for (int i = 0; i < 16; ++i) { LAS float* q = scr + (4 * i + kq) * 65 + n4; q[0] = v[i].x; q[1] = v[i].y; q[2] = v[i].z; q[3] = v[i].w; }
            LDS_WAIT(); asm volatile("" ::: "memory");
            if (!d.fp8) { const int c = F.lane & 7;
#pragma unroll
                for (int j = 0; j < 8; ++j) { const int n = (F.lane >> 3) + 8 * j; const LAS float* sp = scr + (8 * c) * 65 + n;
                    v4u o; o.x = pk2(sp[0 * 65], sp[1 * 65]); o.y = pk2(sp[2 * 65], sp[3 * 65]); o.z = pk2(sp[4 * 65], sp[5 * 65]); o.w = pk2(sp[6 * 65], sp[7 * 65]);
                    *(GAS v4u*)((bf16*)d.WT + (size_t)(d.n0 + n) * d.K + d.k0 + 8 * c) = o; }
            } else { const int c = F.lane & 3; const float wscale = d.ws;
#pragma unroll
                for (int j = 0; j < 4; ++j) { const int n = (F.lane >> 2) + 16 * j; const LAS float* sp = scr + (16 * c) * 65 + n;
                    v4u o;
#pragma unroll
                    for (int q = 0; q < 4; ++q) o[q] = pk4_fp8(sp[(4 * q) * 65] * wscale, sp[(4 * q + 1) * 65] * wscale, sp[(4 * q + 2) * 65] * wscale, sp[(4 * q + 3) * 65] * wscale);
                    *(GAS v4u*)(d.WT + (size_t)(d.n0 + n) * d.K + d.k0 + 16 * c) = o; }
            }
            LDS_WAIT(); asm volatile("" ::: "memory"); };
        WItem dc, dn; f32x4 vc[16], vn[16];
        int it = gw;
        if (it < NITEMS) { wdesc(it, dc); wload(dc, vc); }
        for (; it < NITEMS; it += NGW) {
            const int itn = it + NGW;
            if (itn < NITEMS) { wdesc(itn, dn); wload(dn, vn); }
            wproc(dc, vc);
            dc = dn;
#pragma unroll
            for (int i = 0; i < 16; ++i) vc[i] = vn[i];
        }
    }
    __syncthreads();
    {
        LAS float* sc = (LAS float*)F.lds;
        LAS float* part = (LAS float*)(F.lds + 9 * 1024 * 4);
        bool loaded = false;
        for (int rep_ = 0; rep_ < DUP(26); ++rep_)
        for (int grp = F.vcu; grp < 2 * (6 * D / 64); grp += F.G) {
            const int layer = grp / (6 * D / 64), cb = (grp % (6 * D / 64)) * 64;
            const float* W = a.in[layer ? I_L1_WMOD : I_L0_WMOD]; const float* bm = a.in[layer ? I_L1_BMOD : I_L0_BMOD];
            const int ks = F.tid >> 6, col = F.tid & 63;
            const float* wp = W + (size_t)(ks * 128) * (6 * D) + cb + col;
            float wv0[16], wv1[16];
#pragma unroll
            for (int i = 0; i < 16; ++i) wv0[i] = wp[(size_t)i * (6 * D)];
#pragma unroll
            for (int i = 0; i < 16; ++i) wv1[i] = wp[(size_t)(16 + i) * (6 * D)];
            if (!loaded) { float cv[18];
#pragma unroll
                for (int j = 0; j < 18; ++j) { const int i = F.tid + j * NTHREADS; cv[j] = (j < 16) ? a.in[I_C][i] : a.in[I_CCTX][i - 8 * 1024]; }
#pragma unroll
                for (int j = 0; j < 18; ++j) sc[F.tid + j * NTHREADS] = silu_f(cv[j]);
                loaded = true; }
            __syncthreads();
            float acc[9];
#pragma unroll
            for (int b = 0; b < 9; ++b) acc[b] = 0.f;
#define P0_MODV_USE(wv_, kk_) do { _Pragma("unroll") for (int i = 0; i < 16; i += 4) _Pragma("unroll") for (int b = 0; b < 9; ++b) { const f32x4 s4 = *(const LAS f32x4*)(sc + b * 1024 + ks * 128 + (kk_) + i); \
                acc[b] += (s4.x * wv_[i] + s4.y * wv_[i + 1]) + (s4.z * wv_[i + 2] + s4.w * wv_[i + 3]); } } while (0)
#pragma unroll
            for (int kb = 0; kb < 8; kb += 2) {
                P0_MODV_USE(wv0, 16 * kb);
                if (kb + 2 < 8) {
#pragma unroll
                    for (int i = 0; i < 16; ++i) wv0[i] = wp[(size_t)(16 * (kb + 2) + i) * (6 * D)]; }
                P0_MODV_USE(wv1, 16 * (kb + 1));
                if (kb + 3 < 8) {
#pragma unroll
                    for (int i = 0; i < 16; ++i) wv1[i] = wp[(size_t)(16 * (kb + 3) + i) * (6 * D)]; }
            }
#undef P0_MODV_USE
#pragma unroll
            for (int b = 0; b < 9; ++b) part[(ks * 9 + b) * 64 + col] = acc[b];
            __syncthreads();
            for (int o = F.tid; o < 9 * 64; o += NTHREADS) { const int b = o >> 6, cc = o & 63; float s = bm[cb + cc];
#pragma unroll
                for (int k2 = 0; k2 < 8; ++k2) s += part[(k2 * 9 + b) * 64 + cc];
                ((float*)(F.ws + WS_MODV))[((size_t)layer * 9 + b) * (6 * D) + cb + cc] = s; }
            __syncthreads();
        }
    }
    {
        const int gt = F.vcu * NTHREADS + F.tid;
        if (gt < 64 * 64 + 64 * 16) {
            int pos, i; float ex;
            if (gt < 4096) { pos = gt >> 6; i = gt & 63; ex = (float)(2 * i) / 128.0f; } else { const int q = gt - 4096; pos = q >> 4; i = q & 15; ex = (float)(2 * i) / 32.0f; }
            const float freq = __builtin_amdgcn_exp2f(-ex * 13.287712379549449f);
            const float rev = (float)pos * freq * 0.15915494309189535f;
            const float cs = __builtin_amdgcn_cosf(rev), sn = __builtin_amdgcn_sinf(rev);
            f32x2* t = (f32x2*)(F.ws + (gt < 4096 ? WS_TAB0 : WS_TAB1)); t[gt < 4096 ? gt : gt - 4096] = (f32x2){cs, sn};
        }
        if (gt < 64) { const float* lp = a.in[I_L1_LAMBDA]; const float s1 = wave_sum(lp[gt] * lp[64 + gt]), s2 = wave_sum(lp[128 + gt] * lp[192 + gt]);
            if (gt == 0) *(float*)(F.ws + WS_LAM) = __expf(s1) - __expf(s2) + LAMBDA_INIT; }
    }
}

struct RowPass {
    int nrows;
    const float* xin_lat; const float* xin_ctx; float* xout_lat; float* xout_ctx;
    const bf16* br;
    const float* gpost;
    const float* gate;
    const float* gpre;
    const float* shift; const float* scale;
    bf16* hout;
    const float* part;
    float* rsc;
};
template <bool BR, bool MOEBR, bool WH, bool ROUTE, int H8 = 0, int KSPL = 0, bool XI16 = false, bool XO16 = false>
__device__ __forceinline__ void row_pass(Frame& F, const Args& a, const RowPass& P) {
    const int gw = F.vcu * NWAVES + F.wave, NGW = F.G * NWAVES;
    const int l4 = F.lane * 4;
    int mbase[NE];
    if constexpr (MOEBR) { int acc_ = 0;
#pragma unroll
        for (int e = 0; e < NE; ++e) { mbase[e] = acc_; acc_ += ((int)__builtin_amdgcn_readfirstlane((int)__hip_atomic_load((unsigned*)(F.ctl + CW_MOECNT + 64 * e), RLX_AGENT)) + 255) & ~255; } }
    static_assert(KSPL == 0, "the split-K partial slabs are not supported by the prefetching row pass");
    struct Raw { f32x4 xf[4]; v2u xh[4], ya[4], yb[4]; float w0, w1; };
    struct Rt { int e0, e1, p0, p1; float w0, w1; };
    auto route_load = [&](int r, Rt& t) __attribute__((always_inline)) {
        const int* te = (const int*)(F.ws + WS_ROUTE); const int* tpos = (const int*)(F.ws + WS_ROUTE + (size_t)NLAT * 8); const float* tw = (const float*)(F.ws + WS_ROUTE + (size_t)NLAT * 16);
        t.e0 = te[2 * r]; t.e1 = te[2 * r + 1]; t.p0 = tpos[2 * r]; t.p1 = tpos[2 * r + 1]; t.w0 = tw[2 * r]; t.w1 = tw[2 * r + 1]; };
    auto raw_load = [&](int r, const Rt& t, Raw& R) __attribute__((always_inline)) {
        const bool lat = r < NLAT; const int rc = lat ? r : r - NLAT;
        const float* xin = (lat ? P.xin_lat : P.xin_ctx) + (size_t)rc * (XI16 ? D / 2 : D);
        if constexpr (XI16) {
#pragma unroll
            for (int j = 0; j < 4; ++j) R.xh[j] = *(const GAS v2u*)((const bf16*)xin + l4 + 256 * j);
        } else {
#pragma unroll
            for (int j = 0; j < 4; ++j) R.xf[j] = *(const GAS f32x4*)(xin + l4 + 256 * j);
        }
        if constexpr (BR) {
#pragma unroll
            for (int j = 0; j < 4; ++j) R.ya[j] = *(const GAS v2u*)(P.br + (size_t)r * D + l4 + 256 * j);
        }
        if constexpr (MOEBR) {
            int b0 = 0, b1 = 0;
#pragma unroll
            for (int e = 0; e < NE; ++e) { b0 = (t.e0 == e) ? mbase[e] : b0; b1 = (t.e1 == e) ? mbase[e] : b1; }
            const int s0 = b0 + t.p0, s1 = b1 + t.p1; R.w0 = t.w0; R.w1 = t.w1;
#pragma unroll
            for (int j = 0; j < 4; ++j) { R.ya[j] = *(const GAS v2u*)(P.br + (size_t)s0 * D + l4 + 256 * j); R.yb[j] = *(const GAS v2u*)(P.br + (size_t)s1 * D + l4 + 256 * j); }
        } };
    LAS float* prm = (LAS float*)(F.lds + 32768);
    {
        if constexpr (BR || MOEBR) { for (int i = F.tid * 4; i < D; i += NTHREADS * 4) *(LAS f32x4*)(prm + i) = *(const GAS f32x4*)(P.gpost + i);
            for (int i = F.tid * 4; i < 9 * D; i += NTHREADS * 4) { const int b_ = i >> 10, c_ = i & (D - 1); *(LAS f32x4*)(prm + 2 * D + i) = *(const GAS f32x4*)(P.gate + (size_t)b_ * 6 * D + c_); } }
        if constexpr (WH) { for (int i = F.tid * 4; i < D; i += NTHREADS * 4) *(LAS f32x4*)(prm + D + i) = *(const GAS f32x4*)(P.gpre + i);
            for (int i = F.tid * 4; i < 9 * D; i += NTHREADS * 4) { const int b_ = i >> 10, c_ = i & (D - 1);
                *(LAS f32x4*)(prm + 11 * D + i) = *(const GAS f32x4*)(P.scale + (size_t)b_ * 6 * D + c_); *(LAS f32x4*)(prm + 20 * D + i) = *(const GAS f32x4*)(P.shift + (size_t)b_ * 6 * D + c_); } }
        __syncthreads();
    }
    LAS float* rwl = (LAS float*)F.lds;
    if constexpr (ROUTE) { const float* rw = a.in[I_L1_RW];
        for (int k = F.tid; k < D; k += NTHREADS) { const f32x4 wa = *(const GAS f32x4*)(rw + (size_t)k * 8), wb = *(const GAS f32x4*)(rw + (size_t)k * 8 + 4);
            rwl[0 * D + k] = wa.x; rwl[1 * D + k] = wa.y; rwl[2 * D + k] = wa.z; rwl[3 * D + k] = wa.w; rwl[4 * D + k] = wb.x; rwl[5 * D + k] = wb.y; rwl[6 * D + k] = wb.z; rwl[7 * D + k] = wb.w; }
        __syncthreads(); }
    unsigned pq_w[4] = {0u, 0u, 0u, 0u}; float pq_s = 0.f; int pq_i1 = 0, pq_i2 = 0, pq_r = -1; unsigned pq_p1 = 0, pq_p2 = 0;
    auto route_flush = [&]() __attribute__((always_inline)) {
        if (pq_r >= 0) {
            const unsigned q1 = (unsigned)__builtin_amdgcn_readfirstlane((int)pq_p1), q2 = (unsigned)__builtin_amdgcn_readfirstlane((int)pq_p2);
            const size_t s1 = (size_t)pq_i1 * NLAT + q1, s2 = (size_t)pq_i2 * NLAT + q2;
            unsigned char* hp = F.ws + WS_HP; float* rs = (float*)(F.ws + WS_RSCM);
#pragma unroll
            for (int j = 0; j < 4; ++j) { *(GAS unsigned*)(hp + s1 * D + l4 + 256 * j) = pq_w[j]; *(GAS unsigned*)(hp + s2 * D + l4 + 256 * j) = pq_w[j]; }
            if (F.lane == 0) { rs[s1] = pq_s; rs[s2] = pq_s; int* tpos = (int*)(F.ws + WS_ROUTE + (size_t)NLAT * 8); tpos[2 * pq_r] = (int)q1; tpos[2 * pq_r + 1] = (int)q2; }
        } };
    Raw cur, nxt, nx2; Rt rtA, rtB;
    if (gw < P.nrows) { if constexpr (MOEBR) route_load(gw, rtA); raw_load(gw, rtA, cur); }
    if (gw + NGW < P.nrows) { if constexpr (MOEBR) route_load(gw + NGW, rtA); raw_load(gw + NGW, rtA, nxt); }
    if constexpr (MOEBR) { if (gw + 2 * NGW < P.nrows) route_load(gw + 2 * NGW, rtA); }
    for (int r = gw; r < P.nrows; r += NGW) {
        const int rn = r + 2 * NGW;
        if (rn < P.nrows) { raw_load(rn, rtA, nx2); if constexpr (MOEBR) { if (rn + NGW < P.nrows) route_load(rn + NGW, rtB); } }
        const bool lat = r < NLAT; const int rc = lat ? r : r - NLAT; const int midx = lat ? (r >> 12) : 8;
        float* xout = (lat ? P.xout_lat : P.xout_ctx) + (size_t)rc * (XO16 ? D / 2 : D);
        f32x4 v[4];
        if constexpr (XI16) {
#pragma unroll
            for (int j = 0; j < 4; ++j) { const v2u w = cur.xh[j]; v[j] = (f32x4){bflo(w.x), bfhi(w.x), bflo(w.y), bfhi(w.y)}; }
        } else {
#pragma unroll
            for (int j = 0; j < 4; ++j) v[j] = cur.xf[j];
        }
        if constexpr (BR || MOEBR) {
            f32x4 y[4];
            if constexpr (BR) {
#pragma unroll
                for (int j = 0; j < 4; ++j) { const v2u w = cur.ya[j]; y[j] = (f32x4){bflo(w.x), bfhi(w.x), bflo(w.y), bfhi(w.y)}; }
            } else {
                const float w0 = cur.w0, w1 = cur.w1;
#pragma unroll
                for (int j = 0; j < 4; ++j) { const v2u p = cur.ya[j]; const v2u q = cur.yb[j];
                    y[j] = (f32x4){w0 * bflo(p.x) + w1 * bflo(q.x), w0 * bfhi(p.x) + w1 * bfhi(q.x), w0 * bflo(p.y) + w1 * bflo(q.y), w0 * bfhi(p.y) + w1 * bfhi(q.y)}; }
            }
            float ss = 0.f;
#pragma unroll
            for (int j = 0; j < 4; ++j) ss += (y[j].x * y[j].x + y[j].y * y[j].y) + (y[j].z * y[j].z + y[j].w * y[j].w);
            const float rstd = __builtin_amdgcn_rsqf(wave_sum(ss) * (1.0f / D) + EPS);
#pragma unroll
            for (int j = 0; j < 4; ++j) { __builtin_amdgcn_sched_barrier(0); const f32x4 gp = *(const LAS f32x4*)(prm + l4 + 256 * j); const f32x4 gt = *(const LAS f32x4*)(prm + (2 + midx) * D + l4 + 256 * j);
                v[j] = v[j] + gt * (y[j] * rstd * gp); }
            if ((lat ? P.xout_lat : P.xout_ctx) != nullptr) {
                if constexpr (XO16) {
#pragma unroll
                    for (int j = 0; j < 4; ++j) { v2u w; w.x = pk2(v[j].x, v[j].y); w.y = pk2(v[j].z, v[j].w); *(GAS v2u*)((bf16*)xout + l4 + 256 * j) = w; }
                } else {
#pragma unroll
                    for (int j = 0; j < 4; ++j) *(GAS f32x4*)(xout + l4 + 256 * j) = v[j];
                }
            }
        }
        if constexpr (WH) {
            float ss = 0.f;
#pragma unroll
            for (int j = 0; j < 4; ++j) ss += (v[j].x * v[j].x + v[j].y * v[j].y) + (v[j].z * v[j].z + v[j].w * v[j].w);
            const float rstd = __builtin_amdgcn_rsqf(wave_sum(ss) * (1.0f / D) + EPS);
            f32x4 h[4];
#pragma unroll
            for (int j = 0; j < 4; ++j) { __builtin_amdgcn_sched_barrier(0); const f32x4 gp = *(const LAS f32x4*)(prm + D + l4 + 256 * j); const f32x4 sc = *(const LAS f32x4*)(prm + (11 + midx) * D + l4 + 256 * j);
                const f32x4 sh = *(const LAS f32x4*)(prm + (20 + midx) * D + l4 + 256 * j);
                h[j] = (v[j] * rstd * gp) * (1.0f + sc) + sh;
                if constexpr (H8 == 2) { }
                else if constexpr (H8 == 1) { *(GAS unsigned*)((unsigned char*)P.hout + (size_t)r * D + l4 + 256 * j) = pk4_fp8(h[j].x, h[j].y, h[j].z, h[j].w); }
                else { v2u w; w.x = pk2(h[j].x, h[j].y); w.y = pk2(h[j].z, h[j].w); *(GAS v2u*)(P.hout + (size_t)r * D + l4 + 256 * j) = w; } }
            unsigned qw[4]; float qs = 0.f;
            if constexpr (H8 == 2) {
                float am = 0.f;
#pragma unroll
                for (int j = 0; j < 4; ++j) am = fmaxf(fmaxf(am, fmaxf(fabsf(h[j].x), fabsf(h[j].y))), fmaxf(fabsf(h[j].z), fabsf(h[j].w)));
                am = wave_max(am);
                const float iv = am > 0.f ? 127.0f / am : 0.f;
#pragma unroll
                for (int j = 0; j < 4; ++j) qw[j] = pk4_i8(h[j].x * iv, h[j].y * iv, h[j].z * iv, h[j].w * iv);
                qs = am * (1.0f / 127.0f);
                if constexpr (!ROUTE) {
#pragma unroll
                    for (int j = 0; j < 4; ++j) *(GAS unsigned*)((unsigned char*)P.hout + (size_t)r * D + l4 + 256 * j) = qw[j];
                    if (F.lane == 0) P.rsc[r] = qs; }
            }
            if constexpr (ROUTE) {
                float lg[8];
#pragma unroll
                for (int e = 0; e < 8; ++e) lg[e] = 0.f;
#pragma unroll
                for (int j = 0; j < 4; ++j)
#pragma unroll
                    for (int e = 0; e < 8; ++e) { const f32x4 w4 = *(const LAS f32x4*)(rwl + e * D + l4 + 256 * j);
                        lg[e] += (h[j].x * w4.x + h[j].y * w4.y) + (h[j].z * w4.z + h[j].w * w4.w); }
#pragma unroll
                for (int e = 0; e < 8; ++e) lg[e] = wave_sum(lg[e]) + a.in[I_L1_RB][e];
                float v1 = lg[0]; int i1 = 0;
#pragma unroll
                for (int e = 1; e < 8; ++e) if (lg[e] > v1) { v1 = lg[e]; i1 = e; }
                float v2 = -3.0e38f; int i2 = 0;
#pragma unroll
                for (int e = 0; e < 8; ++e) if (e != i1 && lg[e] > v2) { v2 = lg[e]; i2 = e; }
                const float w1 = 1.0f / (1.0f + __expf(v2 - v1)), w2 = 1.0f - w1;
                unsigned p1 = 0, p2 = 0;
                if (F.lane == 0) {
                    int* te = (int*)(F.ws + WS_ROUTE); int* tpos = (int*)(F.ws + WS_ROUTE + (size_t)NLAT * 8); float* tw = (float*)(F.ws + WS_ROUTE + (size_t)NLAT * 16);
                    p1 = __hip_atomic_fetch_add((unsigned*)(F.ctl + CW_MOECNT + 64 * i1), 1u, RLX_AGENT);
                    p2 = __hip_atomic_fetch_add((unsigned*)(F.ctl + CW_MOECNT + 64 * i2), 1u, RLX_AGENT);
                    te[2 * r] = i1; te[2 * r + 1] = i2; tw[2 * r] = w1; tw[2 * r + 1] = w2;
                }
                if constexpr (H8 == 2) {
                    route_flush();
#pragma unroll
                    for (int j = 0; j < 4; ++j) pq_w[j] = qw[j];
                    pq_s = qs; pq_i1 = i1; pq_i2 = i2; pq_p1 = p1; pq_p2 = p2; pq_r = r;
                }
            }
        }
        cur = nxt; nxt = nx2; if constexpr (MOEBR) rtA = rtB;
    }
    if constexpr (ROUTE && H8 == 2) route_flush();
}


namespace att {
using s16x4  = __attribute__((ext_vector_type(4))) short;
using f32x16 = __attribute__((ext_vector_type(16))) float;
using u32x4  = __attribute__((ext_vector_type(4))) unsigned;
constexpr int KVBLK = 64, NT = (SEQ + CTXL) / KVBLK;
constexpr int SHM_V = KVBLK * 128, SHM_K = KVBLK * 64;
constexpr int NVTILE = MALL / KVBLK;
constexpr int NSLOT_K = 3, NSLOT_V = 2;
constexpr int OFF_V = 0, OFF_K = NSLOT_V * 2 * SHM_V, OFF_WS = OFF_K + NSLOT_K * 2 * SHM_K, OFF_O1 = OFF_WS + NWAVES * 64 * 4, ATT_LDS = OFF_O1 + NWAVES * 8192;
constexpr float THR = 8.0f;
#define ATT_SBAR() __builtin_amdgcn_sched_barrier(0)
#define ATT_PIPE_PV() do { __builtin_amdgcn_sched_group_barrier(0x100, 2, 0); \
    _Pragma("unroll") for (int i_ = 0; i_ < 16; ++i_) { __builtin_amdgcn_sched_group_barrier(0x008, 1, 0); __builtin_amdgcn_sched_group_barrier(0x100, 2, 0); __builtin_amdgcn_sched_group_barrier(0x002, 7, 0); } } while (0)
#define KSWZ64(row, colB) ((row) * 128 + ((colB) ^ ((((row) >> 1) & 7) << 4)))
__device__ __forceinline__ int crow(int r, int hi) { return (r & 3) + 8 * (r >> 2) + 4 * hi; }
__device__ __forceinline__ unsigned cvtpk(float lo, float hi) { return pk2(lo, hi); }

template <int VAR = 0> __device__ __forceinline__ void partialSM(f32x16& p0, f32x16& p1, float& m_reg, f32x16& negm, float& alpha) {
    float mx[4];
#pragma unroll
    for (int c = 0; c < 4; ++c) mx[c] = fmaxf(fmaxf(p0[4 * c], p0[4 * c + 1]), fmaxf(p0[4 * c + 2], p0[4 * c + 3]));
#pragma unroll
    for (int c = 0; c < 4; ++c) mx[c] = fmaxf(mx[c], fmaxf(fmaxf(p1[4 * c], p1[4 * c + 1]), fmaxf(p1[4 * c + 2], p1[4 * c + 3])));
    float pmax = fmaxf(fmaxf(mx[0], mx[1]), fmaxf(mx[2], mx[3]));
    { auto rr = __builtin_amdgcn_permlane32_swap(__float_as_uint(pmax), __float_as_uint(pmax), false, false); pmax = fmaxf(__uint_as_float(rr[0]), __uint_as_float(rr[1])); }
    alpha = 1.f; m_reg = pmax;
#pragma unroll
    for (int r = 0; r < 16; ++r) { negm[r] = 56.5f - pmax; p0[r] = p0[r] + (56.5f - pmax); p1[r] = p1[r] + (56.5f - pmax); }
}
template <int VAR = 0> __device__ __forceinline__ void finishSM(f32x16& p0, f32x16& p1, float alpha, float& l_reg, bf16x8& pa0, bf16x8& pa1, bf16x8& pa2, bf16x8& pa3) {
    if (VAR != 2) {
    f32x2 s2[4];
#pragma unroll
    for (int c = 0; c < 4; ++c) s2[c] = (f32x2){p0[4 * c], p0[4 * c + 1]} + (f32x2){p0[4 * c + 2], p0[4 * c + 3]};
#pragma unroll
    for (int c = 0; c < 4; ++c) s2[c] = s2[c] + ((f32x2){p1[4 * c], p1[4 * c + 1]} + (f32x2){p1[4 * c + 2], p1[4 * c + 3]});
    const f32x2 s2t = (s2[0] + s2[1]) + (s2[2] + s2[3]);
    float ps = s2t[0] + s2t[1];
    { auto rr = __builtin_amdgcn_permlane32_swap(__float_as_uint(ps), __float_as_uint(ps), false, false); ps = __uint_as_float(rr[0]) + __uint_as_float(rr[1]); }
    l_reg = l_reg * alpha + ps;
    } else { l_reg = 1.f; }
#define ATT_PK4(P, BASE, OUT) do { u32x4 w = {cvtpk(P[BASE + 0], P[BASE + 1]), cvtpk(P[BASE + 2], P[BASE + 3]), cvtpk(P[BASE + 4], P[BASE + 5]), cvtpk(P[BASE + 6], P[BASE + 7])}; OUT = *reinterpret_cast<bf16x8*>(&w); } while (0)
    ATT_PK4(p0, 0, pa0); ATT_PK4(p0, 8, pa1); ATT_PK4(p1, 0, pa2); ATT_PK4(p1, 8, pa3);
#undef ATT_PK4
}
__device__ __forceinline__ void qkt(f32x16& p0, f32x16& p1, const char* Ks, const bf16x8* qr, const f32x16& negm, int r32, int hi) {
#pragma unroll
    for (int d0 = 0; d0 < 4; ++d0) { const int cb = (d0 * 16 + hi * 8) * 2;
        const bf16x8 b0 = *reinterpret_cast<const bf16x8*>(Ks + KSWZ64(r32, cb));
        const bf16x8 b1 = *reinterpret_cast<const bf16x8*>(Ks + KSWZ64(32 + r32, cb));
        if (d0 == 0) { p0 = __builtin_amdgcn_mfma_f32_32x32x16_bf16(b0, qr[0], negm, 0, 0, 0); p1 = __builtin_amdgcn_mfma_f32_32x32x16_bf16(b1, qr[0], negm, 0, 0, 0); }
        else { p0 = __builtin_amdgcn_mfma_f32_32x32x16_bf16(b0, qr[d0], p0, 0, 0, 0); p1 = __builtin_amdgcn_mfma_f32_32x32x16_bf16(b1, qr[d0], p1, 0, 0, 0); } }
}
__device__ __forceinline__ int v_st(int k, int c) { const int kk = (k & ~0xC) | ((k & 4) << 1) | ((k & 8) >> 1); return ((kk >> 3) * 4 + (c >> 5)) * 512 + ((kk & 7) * 32 + (c & 31)) * 2; }
__device__ __forceinline__ int v_rd_base(int lane) { return ((lane & 3) << 3) | (((lane >> 2) & 3) << 6) | (((lane >> 4) & 1) << 5) | (((lane >> 5) & 1) << 8); }
constexpr int v_rd_off(int d0, int ks, int half) { return d0 * 512 + ks * 4096 + half * 2048; }
typedef short v4i16a_t __attribute__((ext_vector_type(4)));
template <int OFF> __device__ __forceinline__ s16x4 tr_read(int vb) { return __builtin_bit_cast(s16x4, __builtin_amdgcn_ds_read_tr16_b64_v4i16((LAS v4i16a_t*)(unsigned)(vb + OFF))); }
#define ATT_PK(L, H) (bf16x8){L[0], L[1], L[2], L[3], H[0], H[1], H[2], H[3]}
template <int D0> __device__ __forceinline__ void pv_one(f32x16& od, int vb, bf16x8 pa0, bf16x8 pa1, bf16x8 pa2, bf16x8 pa3) {
    const s16x4 l0 = tr_read<v_rd_off(D0, 0, 0)>(vb), h0 = tr_read<v_rd_off(D0, 0, 1)>(vb), l1 = tr_read<v_rd_off(D0, 1, 0)>(vb), h1 = tr_read<v_rd_off(D0, 1, 1)>(vb);
    const s16x4 l2 = tr_read<v_rd_off(D0, 2, 0)>(vb), h2 = tr_read<v_rd_off(D0, 2, 1)>(vb), l3 = tr_read<v_rd_off(D0, 3, 0)>(vb), h3 = tr_read<v_rd_off(D0, 3, 1)>(vb);
    od = __builtin_amdgcn_mfma_f32_32x32x16_bf16(pa0, ATT_PK(l0, h0), od, 0, 0, 0);
    od = __builtin_amdgcn_mfma_f32_32x32x16_bf16(pa1, ATT_PK(l1, h1), od, 0, 0, 0);
    od = __builtin_amdgcn_mfma_f32_32x32x16_bf16(pa2, ATT_PK(l2, h2), od, 0, 0, 0);
    od = __builtin_amdgcn_mfma_f32_32x32x16_bf16(pa3, ATT_PK(l3, h3), od, 0, 0, 0);
}
#undef ATT_PK
__device__ __forceinline__ void pv_d0(f32x16* o, int vb, bf16x8 pa0, bf16x8 pa1, bf16x8 pa2, bf16x8 pa3) {
    pv_one<0>(o[0], vb, pa0, pa1, pa2, pa3); pv_one<1>(o[1], vb, pa0, pa1, pa2, pa3); pv_one<2>(o[2], vb, pa0, pa1, pa2, pa3); pv_one<3>(o[3], vb, pa0, pa1, pa2, pa3);
}
struct VH { bf16x8 k0, k1; };
__device__ __forceinline__ void vhalf(bf16x8& d, s16x4 lo, s16x4 hi) { d = __builtin_shufflevector(lo, hi, 0, 1, 2, 3, 4, 5, 6, 7); }
template <int D0, int KS0> __device__ __forceinline__ void vh_load(VH& f, int vb) {
    vhalf(f.k0, tr_read<v_rd_off(D0, KS0, 0)>(vb), tr_read<v_rd_off(D0, KS0, 1)>(vb)); vhalf(f.k1, tr_read<v_rd_off(D0, KS0 + 1, 0)>(vb), tr_read<v_rd_off(D0, KS0 + 1, 1)>(vb));
}
#define ATT_PKV(L, H) (bf16x8){L[0], L[1], L[2], L[3], H[0], H[1], H[2], H[3]}
#define ATT_E3(P, B) do { P[B] = __builtin_amdgcn_exp2f(P[B]); P[(B) + 1] = __builtin_amdgcn_exp2f(P[(B) + 1]); P[(B) + 2] = __builtin_amdgcn_exp2f(P[(B) + 2]); } while (0)
#define ATT_MM(D, PA, FR) o[D] = __builtin_amdgcn_mfma_f32_32x32x16_bf16(PA, FR, o[D], 0, 0, 0)
#define ATT_PIN(x) asm volatile("" : "+v"(x))
__device__ __forceinline__ void pv_partial(f32x16* o, int vb, bf16x8 pa0, bf16x8 pa1, bf16x8 pa2, bf16x8 pa3, f32x16& p0, f32x16& p1, float& m_reg, f32x16& negm, float& alpha) {
    VH fa, fb; float mx[4];
    vh_load<0, 0>(fa, vb); vh_load<0, 2>(fb, vb);
    ATT_SBAR();
    ATT_MM(0, pa0, fa.k0);
    mx[0] = fmaxf(fmaxf(p0[0], p0[1]), p0[2]); mx[1] = fmaxf(fmaxf(p0[3], p0[4]), p0[5]); mx[2] = fmaxf(fmaxf(p0[6], p0[7]), p0[8]); mx[3] = fmaxf(fmaxf(p0[9], p0[10]), p0[11]); ATT_PIN(mx[0]); ATT_PIN(mx[1]); ATT_PIN(mx[2]); ATT_PIN(mx[3]); ATT_SBAR();
    ATT_MM(0, pa1, fa.k1); vh_load<1, 0>(fa, vb);
    mx[0] = fmaxf(fmaxf(mx[0], p0[12]), p0[13]); mx[1] = fmaxf(fmaxf(mx[1], p0[14]), p0[15]); mx[2] = fmaxf(fmaxf(mx[2], p1[0]), p1[1]); mx[3] = fmaxf(fmaxf(mx[3], p1[2]), p1[3]); ATT_PIN(mx[0]); ATT_PIN(mx[1]); ATT_PIN(mx[2]); ATT_PIN(mx[3]); ATT_SBAR();
    ATT_MM(0, pa2, fb.k0);
    mx[0] = fmaxf(fmaxf(mx[0], p1[4]), p1[5]); mx[1] = fmaxf(fmaxf(mx[1], p1[6]), p1[7]); mx[2] = fmaxf(fmaxf(mx[2], p1[8]), p1[9]); mx[3] = fmaxf(fmaxf(mx[3], p1[10]), p1[11]); ATT_PIN(mx[0]); ATT_PIN(mx[1]); ATT_PIN(mx[2]); ATT_PIN(mx[3]); ATT_SBAR();
    ATT_MM(0, pa3, fb.k1); vh_load<1, 2>(fb, vb);
    mx[0] = fmaxf(fmaxf(mx[0], p1[12]), p1[13]); mx[1] = fmaxf(fmaxf(mx[1], p1[14]), p1[15]); ATT_PIN(mx[0]); ATT_PIN(mx[1]); ATT_SBAR();
    ATT_MM(1, pa0, fa.k0);
    { float pmax = fmaxf(fmaxf(mx[0], mx[1]), fmaxf(mx[2], mx[3]));
      auto rr = __builtin_amdgcn_permlane32_swap(__float_as_uint(pmax), __float_as_uint(pmax), false, false); pmax = fmaxf(__uint_as_float(rr[0]), __uint_as_float(rr[1]));
      const bool need = pmax > 8.0f * THR + 56.5f; alpha = 1.f;
      if (__any(need)) { const float delta = need ? pmax - 56.5f : 0.f; alpha = __builtin_amdgcn_exp2f(-0.125f * delta); m_reg += delta;
#pragma unroll
          for (int r = 0; r < 16; ++r) { p0[r] -= delta; p1[r] -= delta; negm[r] -= delta; } } } ATT_PIN(alpha); ATT_SBAR();
    ATT_MM(1, pa1, fa.k1); vh_load<2, 0>(fa, vb); ATT_E3(p0, 0); ATT_PIN(p0); ATT_SBAR();
    ATT_MM(1, pa2, fb.k0); ATT_E3(p0, 3); ATT_PIN(p0); ATT_SBAR();
    ATT_MM(1, pa3, fb.k1); vh_load<2, 2>(fb, vb); ATT_E3(p0, 6); ATT_PIN(p0); ATT_SBAR();
    ATT_MM(2, pa0, fa.k0); ATT_E3(p0, 9); ATT_PIN(p0); ATT_SBAR();
    ATT_MM(2, pa1, fa.k1); vh_load<3, 0>(fa, vb); ATT_E3(p0, 12); ATT_PIN(p0); ATT_SBAR();
    ATT_MM(2, pa2, fb.k0); p0[15] = __builtin_amdgcn_exp2f(p0[15]); p1[0] = __builtin_amdgcn_exp2f(p1[0]); p1[1] = __builtin_amdgcn_exp2f(p1[1]); ATT_PIN(p0); ATT_PIN(p1); ATT_SBAR();
    ATT_MM(2, pa3, fb.k1); vh_load<3, 2>(fb, vb); ATT_E3(p1, 2); ATT_PIN(p1); ATT_SBAR();
    ATT_MM(3, pa0, fa.k0); ATT_E3(p1, 5); ATT_PIN(p1); ATT_SBAR();
    ATT_MM(3, pa1, fa.k1); ATT_E3(p1, 8); ATT_PIN(p1); ATT_SBAR();
    ATT_MM(3, pa2, fb.k0); ATT_E3(p1, 11); ATT_PIN(p1); ATT_SBAR();
    ATT_MM(3, pa3, fb.k1); p1[14] = __builtin_amdgcn_exp2f(p1[14]); p1[15] = __builtin_amdgcn_exp2f(p1[15]); ATT_PIN(p1); ATT_SBAR();
}
#undef ATT_MM
#undef ATT_PIN
#undef ATT_E3
#undef ATT_PKV
typedef int v8i_a __attribute__((ext_vector_type(8)));
typedef int v4i_a __attribute__((ext_vector_type(4)));
__device__ __forceinline__ v8i_a v8_frag(unsigned a0, unsigned a1) {
    const v4i_a lo = *(const LAS v4i_a*)a0, hi = *(const LAS v4i_a*)a1; return __builtin_shufflevector(lo, hi, 0, 1, 2, 3, 4, 5, 6, 7); }
#define ATT_MM8(D, FR) asm volatile("v_mfma_scale_f32_32x32x64_f8f6f4 %0, %1, %2, %0, %3, %3 op_sel_hi:[0,0,0]" : "+v"(o[D]) : "v"(pa8), "v"(FR), "v"(one8))
#define ATT_PIN8(x) asm volatile("" : "+v"(x))
#define ATT_KEEP8(x) asm volatile("" :: "v"(x))
#define ATT_LONGNOP() asm volatile("s_nop 15\n\ts_nop 15\n\ts_nop 15\n\ts_nop 15" ::: "memory")
#define ATT_EX(P, B) P[B] = __builtin_amdgcn_exp2f(P[B])
__device__ __forceinline__ void qkt8(f32x16& p0, f32x16& p1, unsigned ka, const v8i_a& q8, const f32x16& negm, v8i_a& k0, v8i_a& k1) {
    const int sK = 0x7f7f7f7f, sQ = 0x7f7f7f7f;
    const v4i_a a0 = *(const LAS v4i_a*)ka, a1 = *(const LAS v4i_a*)(ka ^ 16u), b0 = *(const LAS v4i_a*)(ka + 2048u), b1 = *(const LAS v4i_a*)((ka ^ 16u) + 2048u);
    k0 = __builtin_shufflevector(a0, a1, 0, 1, 2, 3, 4, 5, 6, 7); k1 = __builtin_shufflevector(b0, b1, 0, 1, 2, 3, 4, 5, 6, 7);
    asm volatile("v_mfma_scale_f32_32x32x64_f8f6f4 %0, %1, %2, %3, %4, %5 op_sel_hi:[0,0,0]" : "=&v"(p0) : "v"(k0), "v"(q8), "v"(negm), "v"(sK), "v"(sQ));
    asm volatile("v_mfma_scale_f32_32x32x64_f8f6f4 %0, %1, %2, %3, %4, %5 op_sel_hi:[0,0,0]" : "=&v"(p1) : "v"(k1), "v"(q8), "v"(negm), "v"(sK), "v"(sQ));
}
#define ATT_MML() asm volatile("v_mfma_scale_f32_32x32x64_f8f6f4 %0, %1, %2, %0, %3, %3 op_sel_hi:[0,0,0]" : "+v"(lsum) : "v"(pa8), "v"(ones8), "v"(one8))
__device__ __forceinline__ void pv8_partial(f32x16* o, f32x16& lsum, const v8i_a& ones8, unsigned va0, unsigned va1, const v8i_a& pa8, f32x16& p0, f32x16& p1, float& m_reg, f32x16& negm, float& alpha, const v8i_a& kf0, const v8i_a& kf1) {
    const int one8 = 0x7f7f7f7f;
    float mx[4];
    const v8i_a f0 = v8_frag(va0, va1), f1 = v8_frag(va0 + 2048, va1 + 2048), f2 = v8_frag(va0 + 4096, va1 + 4096), f3 = v8_frag(va0 + 6144, va1 + 6144);
    ATT_SBAR();
    ATT_MM8(0, f0); ATT_MM8(1, f1); asm volatile("s_nop 7" ::: "memory"); ATT_KEEP8(kf0); ATT_KEEP8(kf1); ATT_SBAR();
    mx[0] = fmaxf(fmaxf(p0[0], p0[1]), p0[2]); mx[1] = fmaxf(fmaxf(p0[3], p0[4]), p0[5]); mx[2] = fmaxf(fmaxf(p0[6], p0[7]), p0[8]); mx[3] = fmaxf(fmaxf(p0[9], p0[10]), p0[11]);
    mx[0] = fmaxf(fmaxf(mx[0], p0[12]), p0[13]); mx[1] = fmaxf(fmaxf(mx[1], p0[14]), p0[15]); mx[2] = fmaxf(fmaxf(mx[2], p1[0]), p1[1]); mx[3] = fmaxf(fmaxf(mx[3], p1[2]), p1[3]);
    mx[0] = fmaxf(fmaxf(mx[0], p1[4]), p1[5]); mx[1] = fmaxf(fmaxf(mx[1], p1[6]), p1[7]); mx[2] = fmaxf(fmaxf(mx[2], p1[8]), p1[9]); mx[3] = fmaxf(fmaxf(mx[3], p1[10]), p1[11]);
    mx[0] = fmaxf(fmaxf(mx[0], p1[12]), p1[13]); mx[1] = fmaxf(fmaxf(mx[1], p1[14]), p1[15]);
    { float pmax = fmaxf(fmaxf(mx[0], mx[1]), fmaxf(mx[2], mx[3]));
      auto rr = __builtin_amdgcn_permlane32_swap(__float_as_uint(pmax), __float_as_uint(pmax), false, false); pmax = fmaxf(__uint_as_float(rr[0]), __uint_as_float(rr[1]));
      const bool need = pmax > 8.0f * THR + 56.5f; alpha = 1.f;
      if (__any(need)) { const float delta = need ? pmax - 56.5f : 0.f; alpha = __builtin_amdgcn_exp2f(-0.125f * delta); m_reg += delta;
#pragma unroll
          for (int r = 0; r < 16; ++r) { p0[r] -= delta; p1[r] -= delta; negm[r] -= delta; } } } ATT_PIN8(alpha); ATT_SBAR();
    ATT_MM8(2, f2); ATT_MM8(3, f3); ATT_MML();
    ATT_KEEP8(f0); ATT_KEEP8(f1); ATT_KEEP8(f2); ATT_KEEP8(f3);
}
#undef ATT_EX
__device__ __forceinline__ void p_bytes(const f32x16& p0, const f32x16& p1, v8i_a& pa8) {
#pragma unroll
    for (int q = 0; q < 4; ++q) {
        unsigned w0 = 0, w1 = 0;
        w0 = __builtin_amdgcn_cvt_pk_u8_f32(p0[4 * q], 0, w0); w1 = __builtin_amdgcn_cvt_pk_u8_f32(p1[4 * q], 0, w1);
        w0 = __builtin_amdgcn_cvt_pk_u8_f32(p0[4 * q + 1], 1, w0); w1 = __builtin_amdgcn_cvt_pk_u8_f32(p1[4 * q + 1], 1, w1);
        w0 = __builtin_amdgcn_cvt_pk_u8_f32(p0[4 * q + 2], 2, w0); w1 = __builtin_amdgcn_cvt_pk_u8_f32(p1[4 * q + 2], 2, w1);
        w0 = __builtin_amdgcn_cvt_pk_u8_f32(p0[4 * q + 3], 3, w0); w1 = __builtin_amdgcn_cvt_pk_u8_f32(p1[4 * q + 3], 3, w1);
        pa8[q] = (int)w0; pa8[4 + q] = (int)w1; }
}
__device__ __forceinline__ size_t kvrow(int b, int t) { return t < 64 ? (size_t)b * SEQ + (size_t)t * 64 : (size_t)NLAT + (size_t)b * CTXL + (size_t)(t - 64) * 64; }

__device__ __forceinline__ void glds16(const void* gsrc, unsigned lds_dst) {
    asm volatile("s_mov_b32 m0, %1\n\ts_nop 0\n\tglobal_load_lds_dwordx4 %0, off" :: "v"(gsrc), "s"(lds_dst) : "memory", "m0"); }
template <int VAR> __device__ __forceinline__ void head_pass(const unsigned char* __restrict__ Q1, const unsigned char* __restrict__ K1, const unsigned char* __restrict__ V8, int b, int qh, int hp, size_t qrow0, char* lds, f32x16 (&o)[4], f32x16& lsum, int (&rot)[4], bool pre, bool has_nxt, int nb, int nqh) {
    int tid_ = threadIdx.x; asm volatile("" : "+v"(tid_));
    const int tid = tid_, wid = __builtin_amdgcn_readfirstlane(tid >> 6), lane = tid & 63, r32 = lane & 31, hi = lane >> 5;
    char* V_lds = lds + OFF_V; char* K_lds = lds + OFF_K;
    float* wsf = (float*)(lds + OFF_WS) + wid * 64; float* al_l = wsf + 32;
    float m_reg = 0.f; f32x16 negm = f32x16{}; lsum = f32x16{};
    v8i_a ones8; { int one_ = 0x38383838; asm volatile("" : "+v"(one_)); ones8 = (v8i_a){one_, one_, one_, one_, one_, one_, one_, one_}; }
#pragma unroll
    for (int d = 0; d < 4; ++d) o[d] = f32x16{};
    const unsigned char* Kh = K1 + (size_t)qh * MALL * 64; const unsigned char* Vh = V8 + (size_t)hp * NVTILE * SHM_V;
    const int kr = 16 * wid + (lane >> 2); const unsigned koff = (unsigned)(kr * 64 + (((lane & 3) ^ ((kr >> 1) & 3)) << 4));
    const unsigned lbase = (unsigned)(uintptr_t)lds;
#define ATT_ISSUE_KX(Khx_, bx_, P_, ks_) do { const size_t rb_ = kvrow((bx_), 2 * (P_)); glds16((const char*)((Khx_) + rb_ * 64) + koff, (unsigned)__builtin_amdgcn_readfirstlane(lbase + OFF_K + (ks_) * 2 * SHM_K + wid * 1024)); } while (0)
#define ATT_ISSUE_K(P_, ks_) ATT_ISSUE_KX(Kh, b, P_, ks_)
#define ATT_ISSUE_V(P_, vs_) ATT_ISSUE_VX(b, P_, vs_)
#define ATT_ISSUE_VX(bx_, P_, vs_) do { const int tt_ = 2 * (P_); const unsigned char* vb_ = Vh + (size_t)(tt_ < 64 ? (bx_) * 64 + tt_ : 512 + 4 * (bx_) + (tt_ - 64)) * SHM_V + wid * 2048 + lane * 16; \
    glds16(vb_, (unsigned)__builtin_amdgcn_readfirstlane(lbase + OFF_V + (vs_) * 2 * SHM_V + wid * 2048)); glds16(vb_ + 1024, (unsigned)__builtin_amdgcn_readfirstlane(lbase + OFF_V + (vs_) * 2 * SHM_V + wid * 2048 + 1024)); } while (0)
#define ATT_WAITBAR() do { asm volatile("s_waitcnt vmcnt(0)" ::: "memory"); __builtin_amdgcn_s_barrier(); asm volatile("" ::: "memory"); } while (0)
#define ATT_RESC(al) do { if (__any((al) < 1.f)) { if (hi == 0) al_l[r32] = (al); ATT_LONGNOP(); asm volatile("s_waitcnt lgkmcnt(0)" ::: "memory");     \
    _Pragma("unroll") for (int r = 0; r < 16; ++r) { const float a_ = al_l[crow(r, hi)]; lsum[r] *= a_; _Pragma("unroll") for (int d = 0; d < 4; ++d) o[d][r] *= a_; } } } while (0)
    v8i_a qr;
    { const unsigned char* Qw = Q1 + ((size_t)qh * MALL + qrow0 + wid * 32 + r32) * 64 + hi * 32;
      const v4i_a q0 = *(const v4i_a*)Qw, q1 = *(const v4i_a*)(Qw + 16); qr = __builtin_shufflevector(q0, q1, 0, 1, 2, 3, 4, 5, 6, 7); }
    const unsigned ka_ = (unsigned)(uintptr_t)K_lds + (unsigned)(r32 * 64) + (((2u * hi) ^ ((unsigned)(r32 >> 1) & 3u)) << 4);
    const unsigned vsw = (unsigned)((r32 >> 2) & 3);
    const unsigned va0_ = (unsigned)(uintptr_t)V_lds + (unsigned)(r32 * 64) + (((2u * hi) ^ vsw) << 4), va1_ = (unsigned)(uintptr_t)V_lds + (unsigned)(r32 * 64) + (((2u * hi + 1u) ^ vsw) << 4);
    f32x16 pA0, pA1, pB0, pB1; float alA = 1.f, alB = 1.f; v8i_a pa8 = {}, kf0, kf1;
    constexpr int NP = NT / 2;
    int k0s = rot[0], k1s = rot[1], k2s = rot[2], vs = rot[3];
    if (!pre) { ATT_ISSUE_K(0, k0s); ATT_ISSUE_V(0, vs); ATT_ISSUE_K(1, k1s); }
    ATT_WAITBAR();
    {
        qkt8(pA0, pA1, ka_ + k0s * 2 * SHM_K, qr, negm, kf0, kf1); ATT_LONGNOP(); ATT_KEEP8(kf0); ATT_KEEP8(kf1); partialSM<VAR>(pA0, pA1, m_reg, negm, alA);
#define ATT_STEP_A(PC0, PC1, ALC, PN0, PN1, ALN, KOFF_, VOFF_) do { \
        ATT_SBAR(); qkt8(PN0, PN1, ka_ + (KOFF_), qr, negm, kf0, kf1); ATT_KEEP8(pa8); ATT_SBAR(); \
        p_bytes(PC0, PC1, pa8); ATT_SBAR(); \
        pv8_partial(o, lsum, ones8, va0_ + (VOFF_), va1_ + (VOFF_), pa8, PN0, PN1, m_reg, negm, ALN, kf0, kf1); \
        ATT_RESC(ALN); } while (0)
        for (int P = 0; P + 1 < NP; ++P) {
            if (P + 2 < NP) ATT_ISSUE_K(P + 2, k2s);
            ATT_ISSUE_V(P + 1, vs ^ 1);
            ATT_STEP_A(pA0, pA1, alA, pB0, pB1, alB, k0s * 2 * SHM_K + SHM_K, vs * 2 * SHM_V);
            ATT_STEP_A(pB0, pB1, alB, pA0, pA1, alA, k1s * 2 * SHM_K, vs * 2 * SHM_V + SHM_V);
            ATT_WAITBAR();
            { const int t_ = k0s; k0s = k1s; k1s = k2s; k2s = t_; vs ^= 1; }
        }
        if (has_nxt) { const unsigned char* nKh = K1 + (size_t)nqh * MALL * 64; ATT_ISSUE_KX(nKh, nb, 0, k1s); ATT_ISSUE_VX(nb, 0, vs ^ 1); ATT_ISSUE_KX(nKh, nb, 1, k2s); }
        rot[0] = k1s; rot[1] = k2s; rot[2] = k0s; rot[3] = vs ^ 1;
        ATT_SBAR(); qkt8(pB0, pB1, ka_ + k0s * 2 * SHM_K + SHM_K, qr, negm, kf0, kf1); ATT_KEEP8(pa8); ATT_SBAR();
        p_bytes(pA0, pA1, pa8); ATT_SBAR();
        pv8_partial(o, lsum, ones8, va0_ + vs * 2 * SHM_V, va1_ + vs * 2 * SHM_V, pa8, pB0, pB1, m_reg, negm, alB, kf0, kf1);
        ATT_RESC(alB);
        ATT_LONGNOP(); p_bytes(pB0, pB1, pa8); ATT_SBAR();
        { const unsigned s_ = (unsigned)(vs * 2 * SHM_V + SHM_V); const int one8 = 0x7f7f7f7f;
          const v8i_a f0 = v8_frag(va0_ + s_, va1_ + s_), f1 = v8_frag(va0_ + s_ + 2048, va1_ + s_ + 2048), f2 = v8_frag(va0_ + s_ + 4096, va1_ + s_ + 4096), f3 = v8_frag(va0_ + s_ + 6144, va1_ + s_ + 6144);
          ATT_SBAR(); ATT_MM8(0, f0); ATT_MM8(1, f1); ATT_MM8(2, f2); ATT_MM8(3, f3); ATT_MML(); ATT_LONGNOP(); ATT_KEEP8(pa8); ATT_KEEP8(f0); ATT_KEEP8(f1); ATT_KEEP8(f2); ATT_KEEP8(f3); }
#undef ATT_STEP_A
    }
    asm volatile("s_waitcnt lgkmcnt(0)" ::: "memory"); __builtin_amdgcn_s_barrier(); asm volatile("" ::: "memory");
#undef ATT_ISSUE_K
#undef ATT_ISSUE_V
#undef ATT_ISSUE_KX
#undef ATT_ISSUE_VX
#undef ATT_WAITBAR
#undef ATT_RESC
}

template <int VAR> __device__ __forceinline__ void attn_unit(const unsigned char* __restrict__ Q1, const unsigned char* __restrict__ K1, const unsigned char* __restrict__ V1, bf16* __restrict__ ao, int b, int hp, int qb, char* lds, const float* lamp, const float* subln, int (&rot)[4], bool& pre, bool more_units, int nb_unit) {
    int tid_ = threadIdx.x; asm volatile("" : "+v"(tid_));
    const int tid = tid_, wid = tid >> 6, lane = tid & 63, r32 = lane & 31, hi = lane >> 5;
    float* wsf = (float*)(lds + OFF_WS) + wid * 64;
    unsigned* o1s = (unsigned*)(lds + OFF_O1 + wid * 8192);
    const size_t qrow0 = (size_t)b * SEQ + (size_t)qb * 256;
    f32x16 o[4]; f32x16 l;
    float ssq[16];
#pragma unroll 1
    for (int hh = 0; hh < 2; ++hh) {
        const bool hn = (hh == 0) || more_units;
        head_pass<VAR>(Q1, K1, V1, b, 2 * hp + hh, hp, qrow0, lds, o, l, rot, pre, hn, hh == 0 ? b : nb_unit, hh == 0 ? 2 * hp + 1 : 2 * hp);
        pre = hn;
        float rli[16];
#pragma unroll
        for (int r = 0; r < 16; ++r) { rli[r] = __builtin_amdgcn_rcpf(l[r]); ssq[r] = 0.f; }
        if (hh == 0) {
#pragma unroll
            for (int d0 = 0; d0 < 4; ++d0)
#pragma unroll
                for (int r = 0; r < 16; r += 2) o1s[(d0 * 8 + (r >> 1)) * 64 + lane] = cvtpk(o[d0][r] * rli[r], o[d0][r + 1] * rli[r + 1]);
            __syncthreads();
        } else {
            asm volatile("" : "+s"(lamp)); const float lam = *lamp;
#pragma unroll
            for (int d0 = 0; d0 < 4; ++d0)
#pragma unroll
                for (int r = 0; r < 16; r += 2) { const unsigned w = o1s[(d0 * 8 + (r >> 1)) * 64 + lane];
                    const float a0 = bflo(w) - lam * (o[d0][r] * rli[r]), a1 = bfhi(w) - lam * (o[d0][r + 1] * rli[r + 1]);
                    o[d0][r] = a0; o[d0][r + 1] = a1; ssq[r] += a0 * a0; ssq[r + 1] += a1 * a1; }
        }
    }
#pragma unroll
    for (int r = 0; r < 16; ++r) { float s = ssq[r];
        s += __shfl_xor(s, 1); s += __shfl_xor(s, 2); s += __shfl_xor(s, 4); s += __shfl_xor(s, 8); s += __shfl_xor(s, 16);
        ssq[r] = __builtin_amdgcn_rsqf(s * (1.0f / 128.0f) + EPS) * (1.0f - LAMBDA_INIT); }
    asm volatile("s_waitcnt lgkmcnt(0)" ::: "memory");
    unsigned char* stg = (unsigned char*)o1s;
    asm volatile("" : "+s"(subln));
#pragma unroll
    for (int d0 = 0; d0 < 4; ++d0) { const float g = subln[d0 * 32 + r32];
#pragma unroll
        for (int r = 0; r < 16; r += 2) { const int w2 = __builtin_amdgcn_cvt_pk_fp8_f32(o[d0][r] * ssq[r] * g, o[d0][r + 1] * ssq[r + 1] * g, 0, false);
            stg[crow(r, hi) * 128 + d0 * 32 + r32] = (unsigned char)(w2 & 0xff); stg[crow(r + 1, hi) * 128 + d0 * 32 + r32] = (unsigned char)((w2 >> 8) & 0xff); } }
    asm volatile("s_waitcnt lgkmcnt(0)" ::: "memory");
    unsigned char* Ow = (unsigned char*)ao + (qrow0 + wid * 32) * D + hp * 128;
#pragma unroll
    for (int i = 0; i < 4; ++i) { const int row = i * 8 + (lane >> 3), ch = lane & 7; const u32x4 v = *(const u32x4*)(stg + row * 128 + ch * 16); *(u32x4*)(Ow + (size_t)row * D + ch * 16) = v; }
    asm volatile("s_waitcnt lgkmcnt(0)" ::: "memory");
    __syncthreads();
}
#undef ATT_SBAR
}

__device__ __forceinline__ void v8_prep(Frame& F) {
    const bf16* V1 = (const bf16*)(F.ws + WS_VH1); unsigned char* V8 = (unsigned char*)(F.ws + WS_V8);
    LAS bf16* buf = (LAS bf16*)(F.lds + F.wave * 16384);
    const int gw = F.vcu * NWAVES + F.wave, NGW = F.G * NWAVES, lane = F.lane;
    for (int it = gw; it < 8 * att::NVTILE; it += NGW) {
        const int hv = it / att::NVTILE, tile = it % att::NVTILE;
        const bf16* src = V1 + ((size_t)hv * MALL + (size_t)tile * 64) * 128;
#pragma unroll
        for (int i = 0; i < 16; ++i) *(LAS v4u*)(buf + i * 512 + lane * 8) = *(const GAS v4u*)(src + i * 512 + lane * 8);
        LDS_WAIT(); asm volatile("" ::: "memory");
        unsigned char* dst = V8 + (size_t)it * att::SHM_V;
#pragma unroll
        for (int cc = 0; cc < 2; ++cc) { const int n = lane + 64 * cc; const int sw = (n >> 2) & 3;
#pragma unroll
            for (int c = 0; c < 4; ++c) { const int kb = c >> 1, half = c & 1; v4u w;
#pragma unroll
                for (int q = 0; q < 4; ++q) { const int key0 = 32 * half + 8 * q + 4 * kb;
                    w[q] = pk4_fp8(bf2f(buf[(key0 + 0) * 128 + n]), bf2f(buf[(key0 + 1) * 128 + n]), bf2f(buf[(key0 + 2) * 128 + n]), bf2f(buf[(key0 + 3) * 128 + n])); }
                *(GAS v4u*)(dst + n * 64 + ((c ^ sw) << 4)) = w; } }
        LDS_WAIT(); asm volatile("" ::: "memory");
    }
}

template <int VAR> __device__ __forceinline__ void attn_phase(Frame& F, const Args& a, bf16* ao) {
    const unsigned char* Q1 = F.ws + WS_QH1; const unsigned char* K1 = F.ws + WS_KH1; const unsigned char* V1 = (const unsigned char*)(F.ws + WS_V8);
    const float* lamp = (const float*)(F.ws + WS_LAM);
    int rot[4] = {0, 1, 2, 0}; bool pre = false;
    for (int unit = F.vcu; unit < NBATCH * 8 * 16; unit += F.G) {
        const int qb = unit & 15, hp = (unit >> 4) & 7, b = unit >> 7;
        const int nu = unit + F.G; const bool more = nu < NBATCH * 8 * 16;
        const bool same_hp = more && (((nu >> 4) & 7) == hp);
        att::attn_unit<VAR>(Q1, K1, V1, ao, b, hp, qb, (char*)F.lds, lamp, a.in[I_L1_SUBLN], rot, pre, same_hp, nu >> 7);
    }
}


namespace ret {
using s16x4  = __attribute__((ext_vector_type(4))) short;
using f32x16 = __attribute__((ext_vector_type(16))) float;
typedef short v4i16_t __attribute__((ext_vector_type(4)));
constexpr int C = 32, NSTEP = (SEQ + CTXL) / C;
constexpr int ST_Q = 0, ST_K = 16384, ST_V = 32768, ST_SC = 40960, ST_BYTES = 43008, NSTAGE = 2;
constexpr int XBUF_OFF = NSTAGE * ST_BYTES, RET_LDS = XBUF_OFF + 2 * NWAVES * 4096;
constexpr size_t WS_SSQ = 836 * MiB;
constexpr size_t WS_SC = 842 * MiB;

__device__ __forceinline__ void glds16(const void* gsrc, unsigned lds_dst) {
    asm volatile("s_mov_b32 m0, %1\n\ts_nop 0\n\tglobal_load_lds_dwordx4 %0, off" :: "v"(gsrc), "s"(lds_dst) : "memory", "m0"); }
__device__ __forceinline__ s16x4 vtr(const LAS char* p) { return __builtin_bit_cast(s16x4, __builtin_amdgcn_ds_read_tr16_b64_v4i16((LAS v4i16_t*)p)); }

__device__ __forceinline__ void ret_scores(Frame& F) {
    const bf16* Qh = (const bf16*)(F.ws + WS_QH0); const bf16* Kh = (const bf16*)(F.ws + WS_KH0); bf16* sc = (bf16*)(F.ws + WS_SC);
    const int gw = F.vcu * NWAVES + F.wave, NGW = F.G * NWAVES;
    const int r32 = F.lane & 31, hh = F.lane >> 5;
    constexpr int NTASK = (MALL / C) * RH;
    bf16x8 a[16], b[16];
#define RS_LOAD(task_, s0_) do { const int h_ = (task_) & 3, ch_ = (task_) >> 2; \
        const bf16* qp_ = Qh + ((size_t)h_ * MALL + (size_t)ch_ * C + r32) * 256 + hh * 8; const bf16* kp_ = Kh + ((size_t)h_ * MALL + (size_t)ch_ * C + r32) * 256 + hh * 8; \
        _Pragma("unroll") for (int s = (s0_); s < (s0_) + 8; ++s) { a[s] = *reinterpret_cast<const bf16x8*>(qp_ + s * 16); b[s] = *reinterpret_cast<const bf16x8*>(kp_ + s * 16); } } while (0)
    if (gw < NTASK) { RS_LOAD(gw, 0); RS_LOAD(gw, 8); }
    for (int task = gw; task < NTASK; task += NGW) {
        const int nxt = task + NGW;
        f32x16 acc = f32x16{};
#pragma unroll
        for (int s = 0; s < 8; ++s) acc = __builtin_amdgcn_mfma_f32_32x32x16_bf16(a[s], b[s], acc, 0, 0, 0);
        if (nxt < NTASK) RS_LOAD(nxt, 0);
#pragma unroll
        for (int s = 8; s < 16; ++s) acc = __builtin_amdgcn_mfma_f32_32x32x16_bf16(a[s], b[s], acc, 0, 0, 0);
        if (nxt < NTASK) RS_LOAD(nxt, 8);
        bf16* tp = sc + (size_t)task * 1024;
#pragma unroll
        for (int r = 0; r < 16; ++r) { const int i = (r & 3) + 8 * (r >> 2) + 4 * hh; tp[i * 32 + r32] = (bf16)f2bf(acc[r]); }
    }
#undef RS_LOAD
}

__device__ __forceinline__ size_t step_row0(int b, int dir, int t) {
    if (t < 8) { const int blk = dir ? 7 - t : t; return (size_t)NLAT + (size_t)b * CTXL + (size_t)blk * C; }
    const int blk = dir ? 127 - (t - 8) : (t - 8); return (size_t)b * SEQ + (size_t)blk * C;
}

template <int SV = 0> __device__ __forceinline__ void ret_scan(Frame& F, const Args& a) {
    const char* qb = (const char*)(F.ws + WS_QH0); const char* kb = (const char*)(F.ws + WS_KH0); const char* vb = (const char*)(F.ws + WS_VQ0); const char* scb = (const char*)(F.ws + WS_SC);
    for (int unit = F.vcu; unit < NBATCH * RH * 2 * 4; unit += F.G) {
        int tid_ = threadIdx.x; asm volatile("" : "+v"(tid_));
        const int tid = tid_, lane = tid & 63, w = __builtin_amdgcn_readfirstlane(tid >> 6), dh = w >> 2, vs = w & 3, r32 = lane & 31, hh = lane >> 5;
        const int vq = unit & 3, dir = (unit >> 2) & 1, h = (unit >> 3) & 3, b = unit >> 5;
        const float logit = a.in[I_L0_DECAY][dir * RH + h];
        const float lg2 = -__builtin_amdgcn_logf(1.0f + __builtin_amdgcn_exp2f(-logit * LOG2E));
        const float gC = __builtin_amdgcn_exp2f(lg2 * (float)C), gCi = __builtin_amdgcn_exp2f(-lg2 * (float)C);
        float kd[2][8];
#pragma unroll
        for (int s = 0; s < 2; ++s)
#pragma unroll
            for (int jj = 0; jj < 8; ++jj) { const int j = 16 * s + 8 * hh + jj; kd[s][jj] = __builtin_amdgcn_exp2f(lg2 * (float)(dir ? j : 31 - j)); }
        const int om = 4 * w + (lane >> 4);
        const float rsc = __builtin_amdgcn_exp2f(-lg2 * (float)(dir ? om : 31 - om));
        unsigned pm[4];
#pragma unroll
        for (int e = 0; e < 4; ++e) { const int j0 = 16 * dh + 8 * hh + 2 * e, j1 = j0 + 1; const bool k0 = dir ? (j0 >= r32) : (j0 <= r32), k1 = dir ? (j1 >= r32) : (j1 <= r32);
            pm[e] = (k0 ? 0x0000ffffu : 0u) | (k1 ? 0xffff0000u : 0u); asm volatile("" : "+v"(pm[e])); }
        unsigned offq[2], offk[2];
#pragma unroll
        for (int p = 0; p < 2; ++p) { const int i = 2 * (2 * w + p) + (lane >> 5), cp = lane & 31;
            offq[p] = (unsigned)(i * 512 + ((cp ^ (i & 15)) << 4)); offk[p] = (unsigned)(i * 512 + ((cp ^ ((i & 3) << 2)) << 4)); }
        unsigned offv; { const int j = 4 * w + (lane >> 4), cp = lane & 15; offv = (unsigned)(j * 256 + ((cp ^ ((j & 3) << 2)) << 4)); }
        const char* qhb = qb + (size_t)h * MALL * 512; const char* khb = kb + (size_t)h * MALL * 512; const char* vhb = vb + (size_t)(h * 4 + vq) * MALL * 256;
        unsigned offs; { const int i = 16 * (w & 1) + (lane >> 2), cp = lane & 3; offs = (unsigned)(i * 64 + ((cp ^ ((i >> 2) & 3)) << 4)); }
        LAS unsigned char* L = F.lds;
        const unsigned lbase = (unsigned)(uintptr_t)L;
#define RET_ISSUE(t_) RET_ISSUE2(t_, (t_) % NSTAGE)
#define RET_ISSUE2(t_, stg_) do { const int t__ = (t_); const unsigned sb_ = lbase + (unsigned)((stg_) * ST_BYTES); const size_t r0_ = step_row0(b, dir, t__); const char* gq_ = qhb + r0_ * 512; const char* gk_ = khb + r0_ * 512; const char* gv_ = vhb + r0_ * 256; \
        glds16(gq_ + offq[0], (unsigned)__builtin_amdgcn_readfirstlane(sb_ + ST_Q + (2 * w) * 1024)); \
        glds16(gq_ + offq[1], (unsigned)__builtin_amdgcn_readfirstlane(sb_ + ST_Q + (2 * w + 1) * 1024)); \
        glds16(gk_ + offk[0], (unsigned)__builtin_amdgcn_readfirstlane(sb_ + ST_K + (2 * w) * 1024)); \
        glds16(gk_ + offk[1], (unsigned)__builtin_amdgcn_readfirstlane(sb_ + ST_K + (2 * w + 1) * 1024)); \
        glds16(gv_ + offv, (unsigned)__builtin_amdgcn_readfirstlane(sb_ + ST_V + w * 1024)); \
        if (w < 2) glds16(scb + ((r0_ >> 5) * 4 + h) * 2048 + offs, (unsigned)__builtin_amdgcn_readfirstlane(sb_ + ST_SC + w * 1024)); } while (0)
        const int qrow = ST_Q + r32 * 512; const int qx = r32 & 15;
        const int G = lane >> 4, il = lane & 15, tq = il >> 2, tp = il & 3;
        const int kcolb = (128 * dh + 16 * (G & 1) + 8 * (tp & 1) + 4 * (tp >> 1)) * 2;
        const int vcolb = (32 * vs + 16 * (G & 1) + 4 * tp) * 2;
        f32x16 S[4];
#pragma unroll
        for (int T = 0; T < 4; ++T) S[T] = f32x16{};
        float cinv = 1.0f, cfw = 1.0f;
        bf16* outp = (bf16*)(F.ws + (dir ? WS_OB : WS_OF));
        float* ssqp = (float*)(F.ws + WS_SSQ);

        __builtin_amdgcn_s_barrier();
        if (SV != 2 && SV != 3) { RET_ISSUE(0); }
        const int v0 = (lane & 15) * 8;
#define RET_FINAL(tp_, rs_) RET_FINAL2((tp_) & 1, tp_, rs_)
#define RET_FINAL2(par_, tp_, rs_) do { const LAS float* p0_ = (const LAS float*)(L + XBUF_OFF + (par_) * 32768) + om * 128 + v0; const LAS float* p1_ = p0_ + 4096; \
            const f32x4 a0 = *(const LAS f32x4*)p0_, a1 = *(const LAS f32x4*)(p0_ + 4), b0 = *(const LAS f32x4*)p1_, b1 = *(const LAS f32x4*)(p1_ + 4); \
            const f32x4 o0 = (a0 + b0) * (rs_), o1 = (a1 + b1) * (rs_); \
            float ss = (o0.x * o0.x + o0.y * o0.y) + (o0.z * o0.z + o0.w * o0.w) + (o1.x * o1.x + o1.y * o1.y) + (o1.z * o1.z + o1.w * o1.w); \
            ss += __builtin_bit_cast(float, __builtin_amdgcn_update_dpp(0, __builtin_bit_cast(int, ss), 0xB1, 0xF, 0xF, true)); \
            ss += __builtin_bit_cast(float, __builtin_amdgcn_update_dpp(0, __builtin_bit_cast(int, ss), 0x4E, 0xF, 0xF, true)); \
            ss += __builtin_bit_cast(float, __builtin_amdgcn_update_dpp(0, __builtin_bit_cast(int, ss), 0x124, 0xF, 0xF, true)); \
            ss += __builtin_bit_cast(float, __builtin_amdgcn_update_dpp(0, __builtin_bit_cast(int, ss), 0x128, 0xF, 0xF, true)); \
            const size_t r0 = step_row0(b, dir, (tp_)); \
            v4u pk; pk.x = pk2(o0.x, o0.y); pk.y = pk2(o0.z, o0.w); pk.z = pk2(o1.x, o1.y); pk.w = pk2(o1.z, o1.w); \
            *(GAS v4u*)(outp + (r0 + om) * 2048 + h * 512 + vq * 128 + v0) = pk; \
            if ((lane & 15) == 0) ssqp[(((r0 + om) * RH + h) * 2 + dir) * 4 + vq] = ss; } while (0)
        float rs_prev = 0.f;
        static_assert(NSTEP % 2 == 0 && NSTAGE == 2, "the step loop is unrolled by the two stages");
        for (int t2 = 0; t2 < NSTEP; t2 += 2)
#pragma unroll
        for (int u_ = 0; u_ < 2; ++u_) { const int t = t2 + u_;
            if (t < 2) asm volatile("s_waitcnt vmcnt(0)" ::: "memory"); else asm volatile("s_waitcnt vmcnt(2)" ::: "memory");
            asm volatile("s_waitcnt lgkmcnt(0)" ::: "memory");
            __builtin_amdgcn_s_barrier(); asm volatile("" ::: "memory");
            if (SV != 2 && SV != 3) { if (t + 1 < NSTEP) RET_ISSUE2(t + 1, 1 - u_); }
            const LAS char* sb = (const LAS char*)(L + u_ * ST_BYTES);
            f32x16 acc = f32x16{};
            if (SV != 1 && SV != 3) {
            cinv *= gCi; cfw *= gC;
            bf16x8 vd[2];
#pragma unroll
            for (int s = 0; s < 2; ++s) {
                const int j0 = 16 * s + 8 * (G >> 1) + tq;
                const int cph = (((vcolb >> 4) ^ (tq << 2)) << 4) + (vcolb & 8);
                const s16x4 lo = vtr(sb + ST_V + j0 * 256 + cph), hi = vtr(sb + ST_V + (j0 + 4) * 256 + cph);
                float f[8];
#pragma unroll
                for (int e = 0; e < 4; ++e) { f[e] = bf2f((unsigned short)lo[e]) * (kd[s][e] * cinv); f[4 + e] = bf2f((unsigned short)hi[e]) * (kd[s][4 + e] * cinv); }
                v4u pk; pk.x = pk2(f[0], f[1]); pk.y = pk2(f[2], f[3]); pk.z = pk2(f[4], f[5]); pk.w = pk2(f[6], f[7]);
                vd[s] = __builtin_bit_cast(bf16x8, pk);
            }
            if (SV != 5) {
            bf16x8 qa[8];
#pragma unroll
            for (int T = 0; T < 4; ++T)
#pragma unroll
                for (int s = 0; s < 2; ++s) { const int cL = 16 * dh + 4 * T + 2 * s + hh; qa[2 * T + s] = *(const LAS bf16x8*)(sb + qrow + ((cL ^ qx) << 4)); }
            __builtin_amdgcn_sched_barrier(0);
#pragma unroll
            for (int T = 0; T < 4; ++T)
#pragma unroll
                for (int s = 0; s < 2; ++s) {
                    v4u pk; pk.x = pk2(S[T][8 * s + 0], S[T][8 * s + 1]); pk.y = pk2(S[T][8 * s + 2], S[T][8 * s + 3]); pk.z = pk2(S[T][8 * s + 4], S[T][8 * s + 5]); pk.w = pk2(S[T][8 * s + 6], S[T][8 * s + 7]);
                    acc = __builtin_amdgcn_mfma_f32_32x32x16_bf16(qa[2 * T + s], __builtin_bit_cast(bf16x8, pk), acc, 0, 0, 0);
                }
            }
            {
                const int cL = 2 * dh + hh;
                v4u pw = *(const LAS v4u*)(sb + ST_SC + r32 * 64 + ((cL ^ ((r32 >> 2) & 3)) << 4));
                pw.x &= pm[0]; pw.y &= pm[1]; pw.z &= pm[2]; pw.w &= pm[3];
                acc = __builtin_amdgcn_mfma_f32_32x32x16_bf16(__builtin_bit_cast(bf16x8, pw), dh ? vd[1] : vd[0], acc, 0, 0, 0);
            }
            if (SV != 4) {
            bf16x8 ka[8];
#pragma unroll
            for (int T = 0; T < 4; ++T)
#pragma unroll
                for (int s = 0; s < 2; ++s) {
                    const int j0 = 16 * s + 8 * (G >> 1) + tq;
                    const int cb = kcolb + 64 * T;
                    const int cph = (((cb >> 4) ^ (tq << 2)) << 4) + (cb & 8);
                    const s16x4 lo = vtr(sb + ST_K + j0 * 512 + cph), hi = vtr(sb + ST_K + (j0 + 4) * 512 + cph);
                    ka[2 * T + s] = (bf16x8){lo[0], lo[1], lo[2], lo[3], hi[0], hi[1], hi[2], hi[3]};
                }
            __builtin_amdgcn_sched_barrier(0);
#pragma unroll
            for (int T = 0; T < 4; ++T)
#pragma unroll
                for (int s = 0; s < 2; ++s) S[T] = __builtin_amdgcn_mfma_f32_32x32x16_bf16(ka[2 * T + s], vd[s], S[T], 0, 0, 0);
            }
            }
            const float rs_cur = rsc * cfw;
            if ((t & 7) == 7) {
#pragma unroll
                for (int T = 0; T < 4; ++T) S[T] = S[T] * cfw;
                cinv = 1.0f; cfw = 1.0f;
            }
            if (SV != 6) { LAS float* xw = (LAS float*)(L + XBUF_OFF + u_ * 32768 + dh * 16384) + (4 * hh) * 128 + vs * 32 + r32;
#pragma unroll
              for (int r = 0; r < 16; ++r) xw[((r & 3) + 8 * (r >> 2)) * 128] = acc[r]; }
            if (SV == 6) { asm volatile("" :: "v"(acc)); } else
            if (t > 0) RET_FINAL2(1 - u_, t - 1, rs_prev);
            rs_prev = rs_cur;
        }
        asm volatile("s_waitcnt lgkmcnt(0)" ::: "memory");
        __builtin_amdgcn_s_barrier(); asm volatile("" ::: "memory");
        RET_FINAL(NSTEP - 1, rs_prev);
        asm volatile("s_waitcnt vmcnt(0)\n\ts_waitcnt lgkmcnt(0)" ::: "memory");
#undef RET_FINAL
#undef RET_FINAL2
#undef RET_ISSUE
#undef RET_ISSUE2
    }
    __builtin_amdgcn_s_barrier();
}
}

__device__ __forceinline__ void moe_counts(Frame& F, int (&cnt)[NE]) {
#pragma unroll
    for (int e = 0; e < NE; ++e) cnt[e] = __builtin_amdgcn_readfirstlane((int)__hip_atomic_load((unsigned*)(F.ctl + CW_MOECNT + 64 * e), RLX_AGENT));
}
__device__ __forceinline__ void moe_gather(Frame& F) {
    int cnt[NE]; moe_counts(F, cnt);
    int base[NE]; int acc = 0;
#pragma unroll
    for (int e = 0; e < NE; ++e) { base[e] = acc; acc += (cnt[e] + 255) & ~255; }
    const int* te = (const int*)(F.ws + WS_ROUTE); int* tpos = (int*)(F.ws + WS_ROUTE + (size_t)NLAT * 8);
    const bf16* hb = (const bf16*)(F.ws + WS_H); bf16* hp = (bf16*)(F.ws + WS_HP);
    const int gw = F.vcu * NWAVES + F.wave, NGW = F.G * NWAVES;
    for (int r = gw; r < NLAT; r += NGW) {
        const int e0 = te[2 * r], e1 = te[2 * r + 1]; const int p0 = tpos[2 * r], p1 = tpos[2 * r + 1];
        int b0 = 0, b1 = 0;
#pragma unroll
        for (int e = 0; e < NE; ++e) { b0 = (e0 == e) ? base[e] : b0; b1 = (e1 == e) ? base[e] : b1; }
        const int s0 = b0 + p0, s1 = b1 + p1;
        const v4u x0 = *(const GAS v4u*)((const unsigned char*)hb + (size_t)r * D + F.lane * 16);
        *(GAS v4u*)((unsigned char*)hp + (size_t)s0 * D + F.lane * 16) = x0; *(GAS v4u*)((unsigned char*)hp + (size_t)s1 * D + F.lane * 16) = x0;
        if (F.lane == 0) { tpos[2 * r] = s0; tpos[2 * r + 1] = s1; const float sc = ((const float*)(F.ws + WS_RSC))[r]; ((float*)(F.ws + WS_RSCM))[s0] = sc; ((float*)(F.ws + WS_RSCM))[s1] = sc; }
    }
}
__device__ __forceinline__ void moe_order(Frame& F, pg8::MoeOrder& S, int nN, int slots, int rep = 1) {
    S.rep = rep; S.slots = slots;
    int cnt[NE]; moe_counts(F, cnt);
    int ts[NE + 1]; ts[0] = 0;
#pragma unroll
    for (int e = 0; e < NE; ++e) ts[e + 1] = ts[e] + ((cnt[e] + 255) >> 8);
    S.nM = ts[NE]; S.nN = nN; S.nwg = S.nM * nN; S.G = F.G; S.c = F.cid;
    S.t1 = ts[1]; S.t2 = ts[2]; S.t3 = ts[3]; S.t4 = ts[4]; S.t5 = ts[5]; S.t6 = ts[6]; S.t7 = ts[7];
}

constexpr int N_PHASES = 22;
__global__ void __launch_bounds__(NTHREADS, 2) fwd(Args args) {
    extern __shared__ __attribute__((aligned(16))) unsigned char lds[];
    Frame F;
    F.lds = (LAS unsigned char*)lds; F.MISC = (volatile LAS unsigned*)(F.lds + MISC_OFF);
    F.tid = threadIdx.x; F.lane = F.tid & 63; F.wave = __builtin_amdgcn_readfirstlane(F.tid >> 6);
    F.G = gridDim.x; { const int bx = blockIdx.x; F.vcu = (F.G % 8 == 0) ? (bx % 8) * (F.G / 8) + bx / 8 : bx; F.cid = bx; }
    F.ws = args.ws; F.ctl = (gu32*)(args.ws + WS_CTL);
    for (int u = F.tid; u < 64; u += NTHREADS) ((LAS unsigned*)(F.lds + MISC_OFF))[u] = 0u;
    __syncthreads();
#if MK_PER_PHASE
    XcdBarrier bar; bar.bar = (unsigned*)(F.ctl + CW_BAR); bar.x = 0; bar.st = nullptr;
#define GRID_BAR() do { } while (0)
#else
    XcdBarrier bar = xcd_barrier_post((unsigned*)(F.ctl + CW_BAR), F.MISC + 8);
#define GRID_BAR() xcd_barrier(bar)
    if (F.tid == 0) { const unsigned x = xb_xcc_id(); F.MISC[16] = x; F.MISC[17] = __hip_atomic_fetch_add((unsigned*)(F.ctl + CW_XRANK + 64 * x), 1u, RLX_AGENT); }
#endif
    const int lo = args.ph_lo, hi = args.ph_hi;
#define IN(k) (lo <= (k) && (k) < hi)
#define SEAM(k) do { if (IN(k) && IN((k) + 1)) GRID_BAR(); } while (0)
    unsigned char* ws = args.ws;
    float* modv = (float*)(ws + WS_MODV);
    float* modv1 = modv + 9 * 6 * D;
    bf16* hbuf = (bf16*)(ws + WS_H);
    using pg8::Gemm; using pg8::StaticOrder;

    if (IN(0)) { for (int rep_ = 0; rep_ < DUP(0); ++rep_) { p0_prologue(F, args); __syncthreads(); } SEAM(0); }
#if !MK_PER_PHASE
    if (IN(0) && IN(1)) {
        if (F.tid == 0) { const unsigned x = F.MISC[16]; unsigned pre = 0;
            for (unsigned j = 0; j < 16; ++j) { const unsigned c = __hip_atomic_load((unsigned*)(F.ctl + CW_XRANK + 64 * j), RLX_AGENT); pre += (j < x) ? c : 0u; }
            F.MISC[18] = pre + F.MISC[17]; }
        __syncthreads();
        F.vcu = __builtin_amdgcn_readfirstlane((int)F.MISC[18]); F.cid = (F.G % 8 == 0) ? (F.vcu % (F.G / 8)) * 8 + F.vcu / (F.G / 8) : F.vcu;
    }
#endif
    float* rsc = (float*)(ws + WS_RSC);
    if (IN(1)) { RowPass P{MALL, args.in[I_X], args.in[I_CTX], nullptr, nullptr, nullptr, nullptr, nullptr, args.in[I_L0_NPREMIX], modv + 0 * D, modv + 1 * D, hbuf, nullptr, rsc};
        for (int rep_ = 0; rep_ < DUP(1); ++rep_) row_pass<false, false, true, false, 2>(F, args, P); SEAM(1); }
    if (IN(2)) { Gemm g{hbuf, (const bf16*)(ws + WS_W0IN), MALL, 4096, D / 2, D / 2, 0, 0, rsc, (const float*)(ws + WS_WSC0)}; StaticOrder S; S.init(MALL, 4096, F.G, F.cid, DUP(2));
        pg8::EpiQKV0 E{(bf16*)(ws + WS_QH0), (bf16*)(ws + WS_KH0), (bf16*)(ws + WS_VQ0), (const float*)(ws + WS_TAB0)};
        pg8::gemm_phase<pg8::EpiQKV0, StaticOrder, true, true, 2>(F.lds, g, S, E); if (IN(2) && IN(4)) GRID_BAR(); }
    if (IN(4)) { for (int rep_ = 0; rep_ < DUP(4); ++rep_) ret::ret_scores(F); SEAM(4); }
    if (IN(5)) { for (int rep_ = 0; rep_ < DUP(5); ++rep_) ret::ret_scan<0>(F, args); SEAM(5); }
    if (IN(6)) { Gemm g{hbuf, (const bf16*)(ws + WS_W0IN + (size_t)4096 * D), MALL, 4096, D / 2, D / 2, 0, 0, rsc, (const float*)(ws + WS_WSC0) + 4096}; StaticOrder S; S.init(MALL, 4096, F.G, F.cid);
        pg8::EpiGateMerge E{(bf16*)(ws + WS_OF), (const bf16*)(ws + WS_OB), (const float*)(ws + ret::WS_SSQ)};
        pg8::gemm_phase<pg8::EpiGateMerge, StaticOrder, true, true, 2>(F.lds, g, S, E); if (IN(6) && IN(8)) GRID_BAR(); }
    if (IN(8)) { Gemm g{(const bf16*)(ws + WS_OF), (const bf16*)(ws + WS_W0OUT), MALL, D, 2048, 2048}; StaticOrder S; S.init(MALL, D, F.G, F.cid, DUP(8));
        pg8::EpiStore E{(bf16*)(ws + WS_A), D};
        pg8::gemm_phase<pg8::EpiStore, StaticOrder, true, true>(F.lds, g, S, E); SEAM(8); }
    if (IN(9)) { RowPass P{MALL, args.in[I_X], args.in[I_CTX], (float*)(ws + WS_X1), (float*)(ws + WS_X1C), (const bf16*)(ws + WS_A), args.in[I_L0_NPOSTMIX], modv + 2 * D, args.in[I_L0_NPREFFN], modv + 3 * D, modv + 4 * D, hbuf, (const float*)(ws + WS_PART), rsc};
        for (int rep_ = 0; rep_ < DUP(9); ++rep_) row_pass<true, false, true, false, 2, USE_SPLITK ? 8 : 0, false, true>(F, args, P); SEAM(9); }
    if (IN(10)) { Gemm g{hbuf, (const bf16*)(ws + WS_W0GU), MALL, 2 * DFF, D / 2, D / 2, 0, 0, rsc, (const float*)(ws + WS_WSC2)}; StaticOrder S; S.init(MALL, 2 * DFF, F.G, F.cid, DUP(10));
        pg8::EpiSwiglu8 E{(unsigned char*)(ws + WS_B), DFF};
        pg8::gemm_phase<pg8::EpiSwiglu8, StaticOrder, true, true, 2>(F.lds, g, S, E); SEAM(10); }
    if (IN(11)) { Gemm g{(const bf16*)(ws + WS_B), (const bf16*)(ws + WS_W0DN), MALL, D, DFF / 2, DFF / 2, MOE_SA, MOE_SB}; StaticOrder S; S.init(MALL, D, F.G, F.cid, DUP(11));
        pg8::EpiStore E{(bf16*)(ws + WS_A), D};
        pg8::gemm_phase<pg8::EpiStore, StaticOrder, true, true, 1>(F.lds, g, S, E); SEAM(11); }
    if (IN(12)) { RowPass P{MALL, (const float*)(ws + WS_X1), (const float*)(ws + WS_X1C), (float*)(ws + WS_X2), nullptr, (const bf16*)(ws + WS_A), args.in[I_L0_NPOSTFFN], modv + 5 * D, args.in[I_L1_NPREMIX], modv1 + 0 * D, modv1 + 1 * D, hbuf, (const float*)(ws + WS_PART), rsc};
        for (int rep_ = 0; rep_ < DUP(12); ++rep_) row_pass<true, false, true, false, 2, USE_SPLITK ? 11 : 0, true, true>(F, args, P); SEAM(12); }
    if (IN(13)) { Gemm g{hbuf, (const bf16*)(ws + WS_W1IN), MALL, 3072, D / 2, D / 2, 0, 0, rsc, (const float*)(ws + WS_WSC1)}; pg8::QkvOrder S; S.init(F.G, F.cid, DUP(13));
        pg8::EpiQKV1 E{ws + WS_QH1, ws + WS_KH1, ws + WS_V8, (const float*)(ws + WS_TAB1)};
        pg8::gemm_phase<pg8::EpiQKV1, pg8::QkvOrder, true, true, 2>(F.lds, g, S, E); if (IN(13) && IN(15)) GRID_BAR(); }
    if (IN(15)) { for (int rep_ = 0; rep_ < DUP(15); ++rep_) attn_phase<0>(F, args, (bf16*)(ws + WS_B)); SEAM(15); }
    if (IN(16)) { Gemm g{(const bf16*)(ws + WS_B), (const bf16*)(ws + WS_W1OUT), NLAT, D, D / 2, D / 2, MOE_SA, MOE_SB}; StaticOrder S; S.init(NLAT, D, F.G, F.cid, DUP(16));
        pg8::EpiStore E{(bf16*)(ws + WS_A), D};
        pg8::gemm_phase<pg8::EpiStore, StaticOrder, true, true, 1>(F.lds, g, S, E); SEAM(16); }
    if (IN(17)) { RowPass P{NLAT, (const float*)(ws + WS_X2), nullptr, (float*)(ws + WS_X3), nullptr, (const bf16*)(ws + WS_A), args.in[I_L1_NPOSTMIX], modv1 + 2 * D, args.in[I_L1_NPREFFN], modv1 + 3 * D, modv1 + 4 * D, hbuf, nullptr, rsc};
        row_pass<true, false, true, true, 2, 0, true, true>(F, args, P); if (IN(17) && IN(19)) GRID_BAR(); }
    if (IN(19)) { Gemm g{(const bf16*)(ws + WS_HP), (const bf16*)(ws + WS_WMGU), MOE_ROWS, 2 * DFE, D / 2, D / 2, 0, 0, (const float*)(ws + WS_RSCM), (const float*)(ws + WS_WSCM)}; pg8::MoeOrder S; moe_order(F, S, 2 * DFE / 256, 1, DUP(19));
        pg8::EpiSwiglu8 E{(unsigned char*)(ws + WS_ACT1), DFE};
        pg8::gemm_phase<pg8::EpiSwiglu8, pg8::MoeOrder, true, true, 2>(F.lds, g, S, E); SEAM(19); }
    if (IN(20)) { Gemm g{(const bf16*)(ws + WS_ACT1), (const bf16*)(ws + WS_WMDN), MOE_ROWS, D, DFE / 2, DFE / 2, MOE_SA, MOE_SB}; pg8::MoeOrder S; moe_order(F, S, D / 256, 0, DUP(20));
        pg8::EpiStore E{(bf16*)(ws + WS_Y1), D};
        pg8::gemm_phase<pg8::EpiStore, pg8::MoeOrder, true, true, 1>(F.lds, g, S, E); SEAM(20); }
    if (IN(21)) { RowPass P{NLAT, (const float*)(ws + WS_X3), nullptr, args.out, nullptr, (const bf16*)(ws + WS_Y1), args.in[I_L1_NPOSTFFN], modv1 + 5 * D, nullptr, nullptr, nullptr, nullptr};
        for (int rep_ = 0; rep_ < DUP(21); ++rep_) row_pass<false, true, false, false, 0, 0, true, false>(F, args, P); }
#undef IN
#undef SEAM
}

#ifndef PROBE_ATT
#define PROBE_ATT -1
#endif
#if PROBE_ATT >= 0
__global__ void __launch_bounds__(NTHREADS, 2) probe_k(Args args) {
    extern __shared__ __attribute__((aligned(16))) unsigned char lds[];
    Frame F;
    F.lds = (LAS unsigned char*)lds; F.MISC = (volatile LAS unsigned*)(F.lds + MISC_OFF);
    F.tid = threadIdx.x; F.lane = F.tid & 63; F.wave = __builtin_amdgcn_readfirstlane(F.tid >> 6);
    F.G = gridDim.x; { const int bx = blockIdx.x; F.vcu = (F.G % 8 == 0) ? (bx % 8) * (F.G / 8) + bx / 8 : bx; F.cid = bx; }
    F.ws = args.ws; F.ctl = (gu32*)(args.ws + WS_CTL);
#if PROBE_ATT < 10
    attn_phase<PROBE_ATT>(F, args, (bf16*)(args.ws + WS_END - 64 * MiB));
#elif PROBE_ATT >= 30
    { unsigned char* ws = args.ws; using pg8::Gemm; using pg8::StaticOrder;
      Gemm g{(const bf16*)(ws + WS_OF), (const bf16*)(ws + WS_W0OUT), MALL, D, 2048, 2048}; StaticOrder S; S.init(PROBE_ATT == 30 ? MALL : NLAT, D, F.G, F.cid, 1);
      pg8::EpiStore E{(bf16*)(ws + WS_A), D};
      pg8::gemm_phase<pg8::EpiStore, StaticOrder, true, true>(F.lds, g, S, E); }
#elif PROBE_ATT >= 20
    { unsigned char* ws = args.ws; using pg8::Gemm;
      Gemm g{(const bf16*)(ws + WS_HP), (const bf16*)(ws + WS_WMGU), MOE_ROWS, 2 * DFE, D / 2, D / 2, 0, 0, (const float*)(ws + WS_RSCM), (const float*)(ws + WS_WSCM)}; pg8::MoeOrder S; moe_order(F, S, 2 * DFE / 256, 1);
#if PROBE_ATT == 20
      pg8::EpiSwiglu8 E{(unsigned char*)(ws + WS_ACT1), DFE}; pg8::gemm_phase<pg8::EpiSwiglu8, pg8::MoeOrder, true, true, 2>(F.lds, g, S, E);
#else
      pg8::EpiNull E{(float*)(ws + WS_ACT1)}; pg8::gemm_phase<pg8::EpiNull, pg8::MoeOrder, true, true, 2>(F.lds, g, S, E);
#endif
    }
#else
    ret::ret_scan<PROBE_ATT - 10>(F, args);
#endif
}
#endif
extern "C" void kernel_launch(void* const* d_in, const int* in_sizes, int n_in, void* d_out, int out_size, void* d_ws, size_t ws_size, hipStream_t stream) {
    static int grid = 0;
    if (grid == 0) {
        if (n_in != N_IN || out_size != NLAT * D || ws_size < WS_END) { fprintf(stderr, "kernel_launch: unexpected shapes n_in %d out %d ws %zu\n", n_in, out_size, ws_size); grid = -1; return; }
        int dev = 0, cus = 0, per_cu = 0;
        if (hipGetDevice(&dev) != hipSuccess || hipDeviceGetAttribute(&cus, hipDeviceAttributeMultiprocessorCount, dev) != hipSuccess) { grid = -1; return; }
        if (hipFuncSetAttribute((const void*)fwd, hipFuncAttributeMaxDynamicSharedMemorySize, LDS_BYTES) != hipSuccess) { fprintf(stderr, "kernel_launch: hipFuncSetAttribute failed\n"); grid = -1; return; }
        if (hipOccupancyMaxActiveBlocksPerMultiprocessor(&per_cu, (const void*)fwd, NTHREADS, LDS_BYTES) != hipSuccess || per_cu < 1) fprintf(stderr, "kernel_launch: occupancy query says %d\n", per_cu);
        (void)hipGetLastError();
        grid = cus;
    }
    if (grid < 0) return;
    (void)hipMemsetAsync((char*)d_ws + WS_CTL, 0, CTL_ZERO_BYTES, stream);
    Args a{};
    for (int i = 0; i < N_IN; ++i) a.in[i] = (const float*)d_in[i];
    a.out = (float*)d_out; a.ws = (unsigned char*)d_ws;
#if MK_PER_PHASE
    for (int p = 0; p < N_PHASES; ++p) { a.ph_lo = p; a.ph_hi = p + 1; hipLaunchKernelGGL(fwd, dim3(grid), dim3(NTHREADS), LDS_BYTES, stream, a); }
#else
    a.ph_lo = 0; a.ph_hi = N_PHASES; hipLaunchKernelGGL(fwd, dim3(grid), dim3(NTHREADS), LDS_BYTES, stream, a);
#endif
#if PROBE_ATT >= 0
    (void)hipFuncSetAttribute((const void*)probe_k, hipFuncAttributeMaxDynamicSharedMemorySize, LDS_BYTES);
    hipLaunchKernelGGL(probe_k, dim3(grid), dim3(NTHREADS), LDS_BYTES, stream, a);
#endif
}
```

```cpp
#include <hip/hip_runtime.h>
#include <cstdio>
#include <cstdint>
namespace pg8 {
#define PG8_LAS __attribute__((address_space(3)))
typedef unsigned short bf16_t;
typedef short bf16x8 __attribute__((ext_vector_type(8)));
typedef float f32x4 __attribute__((ext_vector_type(4)));
typedef unsigned u32x4 __attribute__((ext_vector_type(4)));
constexpr int BM = 256, BK = 64, HALF = 128, HTB = HALF * BK * 2  , STAGE_BYTES = 8 * HTB, NXCD = 8, WGM = 8;

__host__ __device__ __forceinline__ int lds_byte(int r, int c) { const int st = (r >> 4) * 2 + (c >> 5), rr = r & 15, cc = c & 31, ob = rr * 64 + cc * 2; return st * 1024 + (ob ^ (((ob >> 9) & 1) << 5)); }
__host__ __device__ __forceinline__ void stage_rc(int b, int& R, int& C) { const int st = b / 1024, sb = b % 1024, swz = sb ^ (((sb >> 9) & 1) << 5); R = (st >> 1) * 16 + swz / 64; C = (st & 1) * 32 + (swz % 64) / 2; }
__host__ __device__ __forceinline__ int perm32(int rho) { const int n = rho >> 4, i = rho & 15; return 8 * (i >> 2) + 4 * n + (i & 3); }

struct Unit { int pm, pn, pc, k0, nt, ks, pa, sw; };
struct Gemm { const bf16_t* A; const bf16_t* Bt; int M, N, K, lda; int sA, sB; const float* rsA; const float* rsB; };

struct StaticOrder {
    int nM, nN, nwg, G, c, rep;
    __host__ __device__ __forceinline__ void init(int M, int N, int G_, int c_, int rep_ = 1) { nM = M / BM; nN = N / BM; nwg = nM * nN; G = G_; c = c_; rep = rep_; }
    __host__ __device__ __forceinline__ bool next(int i, Unit& u) const {
        long L = (long)i * G + c; if (L >= (long)nwg * rep) return false; if (L >= nwg) L -= nwg;
        int wgid = (int)L; { const int q = nwg / NXCD, r = nwg % NXCD, xcd = wgid % NXCD, off = wgid / NXCD; wgid = (xcd < r ? xcd * (q + 1) : r * (q + 1) + (xcd - r) * q) + off; }
        const int nig = WGM * nN, gid = wgid / nig, fm = gid * WGM, gsz = (nM - fm) < WGM ? (nM - fm) : WGM;
        u.pm = fm + ((wgid % nig) % gsz); u.pn = (wgid % nig) / gsz; u.pc = u.pn; u.k0 = 0; u.nt = 0; u.ks = -1; u.pa = u.pm; u.sw = 0; return true;
    }
    __device__ __forceinline__ void a_ready(const Unit&) const {}
    __device__ __forceinline__ void done(const Unit&) const {}
};

__device__ __forceinline__ unsigned cvt_pk_bf16(float lo, float hi) { unsigned r; asm volatile("v_cvt_pk_bf16_f32 %0, %1, %2" : "=v"(r) : "v"(lo), "v"(hi)); return r; }
typedef float f32x2 __attribute__((ext_vector_type(2)));
typedef int v4i_t __attribute__((ext_vector_type(4))); typedef int v8i_t __attribute__((ext_vector_type(8)));
template <class Epi, class Sched, bool ALIGN_EPI = false, bool SP2 = false, int MODE = 0>
__device__ __forceinline__ void gemm_phase(PG8_LAS unsigned char* lds, const Gemm g, const Sched& S, const Epi& E) {
    constexpr bool FP8 = (MODE == 1), I8 = (MODE == 2);
    const int tid = threadIdx.x, wid = __builtin_amdgcn_readfirstlane(tid >> 6), lane = tid & 63, wr = wid >> 2, wc = wid & 3, fr = lane & 15, fq = lane >> 4;
    const int K = g.K; int nt = K / BK;
    unsigned voffA[2], voffB[2];
#pragma unroll
    for (int i = 0; i < 2; ++i) { int R, C; stage_rc(tid * 16 + i * 8192, R, C); const int Rb = Epi::PERM ? ((R & ~31) + perm32(R & 31)) : R;
        voffA[i] = (unsigned)(R * g.lda + C) * 2u; voffB[i] = (unsigned)(Rb * K + C) * 2u; }
    const size_t kstep = (size_t)(BK * 2);
    const size_t hstepA = (size_t)HALF * g.lda * 2, hstepB = (size_t)HALF * K * 2;
    const size_t tstepA = 2 * hstepA, tstepB = 2 * hstepB;
    const unsigned ldsw = (unsigned)wid * 1024u;
    const int aoff = lds_byte(wr * 64 + fr, fq * 8), boff = lds_byte(wc * 32 + fr, fq * 8);
#define PG8_SA(b, h) (((b) * 2 + (h)) * HTB)
#define PG8_SB(b, h) ((4 + (b) * 2 + (h)) * HTB)
#define PG8_STAGE(bufoff, gbase, voff) do { _Pragma("unroll") for (int _i = 0; _i < 2; ++_i) \
        __builtin_amdgcn_global_load_lds((const unsigned*)((const char*)(gbase) + (voff)[_i]), (PG8_LAS unsigned*)(lds + (bufoff) + ldsw + _i * 8192), 16, 0, 0); } while (0)
#define PG8_LDA(dst, b, h) do { if constexpr (FP8) { _Pragma("unroll") for (int m = 0; m < 4; ++m) { const v4i_t lo_ = *(const PG8_LAS v4i_t*)(lds + PG8_SA(b, h) + aoff + m * 2048), hi_ = *(const PG8_LAS v4i_t*)(lds + PG8_SA(b, h) + aoff + m * 2048 + 1024); \
        dst##8[m] = __builtin_shufflevector(lo_, hi_, 0, 1, 2, 3, 4, 5, 6, 7); } } \
    else { _Pragma("unroll") for (int m = 0; m < 4; ++m) _Pragma("unroll") for (int k = 0; k < 2; ++k) dst[m][k] = *(const PG8_LAS bf16x8*)(lds + PG8_SA(b, h) + aoff + m * 2048 + k * 1024); } } while (0)
#define PG8_LDB(dst, b, h) do { if constexpr (FP8) { _Pragma("unroll") for (int n = 0; n < 2; ++n) { const v4i_t lo_ = *(const PG8_LAS v4i_t*)(lds + PG8_SB(b, h) + boff + n * 2048), hi_ = *(const PG8_LAS v4i_t*)(lds + PG8_SB(b, h) + boff + n * 2048 + 1024); \
        dst##8[n] = __builtin_shufflevector(lo_, hi_, 0, 1, 2, 3, 4, 5, 6, 7); } } \
    else { _Pragma("unroll") for (int n = 0; n < 2; ++n) _Pragma("unroll") for (int k = 0; k < 2; ++k) dst[n][k] = *(const PG8_LAS bf16x8*)(lds + PG8_SB(b, h) + boff + n * 2048 + k * 1024); } } while (0)
#define PG8_MMA(ai, bj, At, Bt) do { __builtin_amdgcn_s_setprio(1); _Pragma("unroll") for (int m = 0; m < 4; ++m) _Pragma("unroll") for (int n = 0; n < 2; ++n) { \
        if constexpr (FP8) { asm volatile("v_mfma_scale_f32_16x16x128_f8f6f4 %0, %1, %2, %0, %3, %4 op_sel_hi:[0,0,0]" : "+v"(acc[ai][bj][m][n]) : "v"(Bt##8[n]), "v"(At##8[m]), "v"(sB_), "v"(sA_)); } \
        else if constexpr (I8) { _Pragma("unroll") for (int k = 0; k < 2; ++k) acc[ai][bj][m][n] = __builtin_bit_cast(f32x4, __builtin_amdgcn_mfma_i32_16x16x64_i8(__builtin_bit_cast(v4i_t, Bt[n][k]), __builtin_bit_cast(v4i_t, At[m][k]), __builtin_bit_cast(v4i_t, acc[ai][bj][m][n]), 0, 0, 0)); } \
        else { _Pragma("unroll") for (int k = 0; k < 2; ++k) acc[ai][bj][m][n] = __builtin_amdgcn_mfma_f32_16x16x32_bf16(Bt[n][k], At[m][k], acc[ai][bj][m][n], 0, 0, 0); } } \
        __builtin_amdgcn_s_setprio(0); } while (0)
#define PG8_WAIT_V(n) asm volatile("s_waitcnt vmcnt(" #n ")" ::: "memory")
#define PG8_WAIT_VR(n) do { if (relax) asm volatile("s_waitcnt vmcnt(%0)" :: "i"((n) + Epi::NST) : "memory"); else asm volatile("s_waitcnt vmcnt(" #n ")" ::: "memory"); } while (0)
#define PG8_WAIT_L(n) asm volatile("s_waitcnt lgkmcnt(" #n ")" ::: "memory")
#define PG8_BAR __builtin_amdgcn_s_barrier()
#define PG8_SCHED __builtin_amdgcn_sched_barrier(0)
#define PG8_SCALES(u, par) do { if constexpr (I8) { if (wid < 2) { const float* gp_ = (wid == 0 ? ((u).sw ? g.rsB : g.rsA) + (u).pa * BM : ((u).sw ? g.rsA : g.rsB) + (u).pn * BM) + lane * 4; \
        __builtin_amdgcn_global_load_lds((const unsigned*)gp_, (PG8_LAS unsigned*)(lds + STAGE_BYTES + (par) * 2048 + wid * 1024), 16, 0, 0); } } } while (0)
    Unit cur, nxt; int ui = 0;
    if (!S.next(0, cur)) return;
    const int sA_ = g.sA, sB_ = g.sB;
    f32x4 acc[2][2][4][2];
#pragma unroll
    for (int a = 0; a < 2; ++a)
#pragma unroll
        for (int b = 0; b < 2; ++b)
#pragma unroll
            for (int m = 0; m < 4; ++m)
#pragma unroll
                for (int n = 0; n < 2; ++n) acc[a][b][m][n] = (f32x4){0.f, 0.f, 0.f, 0.f};
    bf16x8 At[4][2], B0[2][2], B1[2][2]; v8i_t At8[4], B08[2], B18[2];
    if (cur.nt) nt = cur.nt;
    const char* cA = (const char*)(cur.sw ? g.Bt : g.A) + (size_t)cur.pa * tstepA + (size_t)cur.k0 * 2; const char* cB = (const char*)(cur.sw ? g.A : g.Bt) + (size_t)cur.pn * tstepB + (size_t)cur.k0 * 2;
    S.a_ready(cur);
    PG8_SCALES(cur, 0);
    if constexpr (SP2) {
        PG8_STAGE(PG8_SB(0, 0), cB, voffB); PG8_STAGE(PG8_SB(0, 1), cB + hstepB, voffB); PG8_STAGE(PG8_SA(0, 0), cA, voffA); PG8_STAGE(PG8_SA(0, 1), cA + hstepA, voffA);
        PG8_STAGE(PG8_SB(1, 0), cB + kstep, voffB); PG8_STAGE(PG8_SA(1, 0), cA + kstep, voffA); PG8_STAGE(PG8_SB(1, 1), cB + hstepB + kstep, voffB);
        if (wr == 1) PG8_BAR;
        PG8_WAIT_V(8); PG8_BAR;
        PG8_WAIT_V(6); PG8_BAR;
    } else {
        PG8_STAGE(PG8_SB(0, 0), cB, voffB); PG8_STAGE(PG8_SA(0, 0), cA, voffA); PG8_STAGE(PG8_SB(0, 1), cB + hstepB, voffB); PG8_STAGE(PG8_SA(0, 1), cA + hstepA, voffA);
        if (wr == 1) PG8_BAR;
        PG8_WAIT_V(4); PG8_BAR;
        PG8_STAGE(PG8_SB(1, 0), cB + kstep, voffB); PG8_STAGE(PG8_SA(1, 0), cA + kstep, voffA); PG8_STAGE(PG8_SB(1, 1), cB + hstepB + kstep, voffB);
        PG8_WAIT_V(6); PG8_BAR;
    }
    for (;;) {
        const bool has_next = S.next(ui + 1, nxt);
        const char* nA = has_next ? (const char*)(nxt.sw ? g.Bt : g.A) + (size_t)nxt.pa * tstepA + (size_t)nxt.k0 * 2 : cA; const char* nB = has_next ? (const char*)(nxt.sw ? g.A : g.Bt) + (size_t)nxt.pn * tstepB + (size_t)nxt.k0 * 2 : cB;
#pragma unroll 1
        for (int t = 0; t < nt; t += 2) {
            const bool last = (t == nt - 2); const bool relax = (t == 0) && (ui > 0) && !Epi::AFTER_DRAIN;
            const char* a1 = cA + (size_t)(t + 1) * kstep;
            const char* a2 = last ? nA : cA + (size_t)(t + 2) * kstep; const char* b2 = last ? nB : cB + (size_t)(t + 2) * kstep;
            const char* a3 = a2 + kstep; const char* b3 = b2 + kstep;
            if (last && has_next) S.a_ready(nxt);
            if constexpr (SP2) {
            PG8_LDB(B0, 0, 0); PG8_LDB(B1, 0, 1); PG8_SCHED; PG8_LDA(At, 0, 0); PG8_STAGE(PG8_SA(1, 1), a1 + hstepA, voffA);
            PG8_WAIT_VR(8); PG8_WAIT_L(0); PG8_BAR; PG8_MMA(0, 0, At, B0); PG8_MMA(0, 1, At, B1); PG8_BAR; PG8_SCHED;
            PG8_LDA(At, 0, 1); PG8_STAGE(PG8_SB(0, 0), b2, voffB); PG8_STAGE(PG8_SB(0, 1), b2 + hstepB, voffB); PG8_STAGE(PG8_SA(0, 0), a2, voffA);
            PG8_WAIT_VR(8); PG8_WAIT_L(0); PG8_BAR; PG8_MMA(1, 0, At, B0); PG8_MMA(1, 1, At, B1); PG8_BAR; PG8_SCHED;
            PG8_LDB(B0, 1, 0); PG8_LDB(B1, 1, 1); PG8_SCHED; PG8_LDA(At, 1, 0); PG8_STAGE(PG8_SA(0, 1), a2 + hstepA, voffA);
            PG8_WAIT_V(8); PG8_WAIT_L(0); PG8_BAR; PG8_MMA(0, 0, At, B0); PG8_MMA(0, 1, At, B1); PG8_BAR; PG8_SCHED;
            PG8_LDA(At, 1, 1); PG8_STAGE(PG8_SB(1, 0), b3, voffB); PG8_STAGE(PG8_SB(1, 1), b3 + hstepB, voffB); PG8_STAGE(PG8_SA(1, 0), a3, voffA);
            PG8_WAIT_V(8); PG8_WAIT_L(0); PG8_BAR; PG8_MMA(1, 0, At, B0); PG8_MMA(1, 1, At, B1); PG8_BAR; PG8_SCHED;
            } else {
            PG8_LDB(B0, 0, 0); PG8_SCHED; PG8_LDA(At, 0, 0); PG8_STAGE(PG8_SA(1, 1), a1 + hstepA, voffA);
            PG8_WAIT_L(8); PG8_BAR; PG8_WAIT_L(0); PG8_MMA(0, 0, At, B0); PG8_BAR; PG8_SCHED;
            PG8_LDB(B1, 0, 1); PG8_STAGE(PG8_SB(0, 0), b2, voffB);
            PG8_BAR; PG8_WAIT_L(0); PG8_MMA(0, 1, At, B1); PG8_BAR;
            PG8_LDA(At, 0, 1); PG8_STAGE(PG8_SA(0, 0), a2, voffA);
            PG8_BAR; PG8_WAIT_L(0); PG8_MMA(1, 0, At, B0); PG8_BAR; PG8_SCHED;
            PG8_STAGE(PG8_SB(0, 1), b2 + hstepB, voffB);
            PG8_WAIT_V(6); PG8_BAR; PG8_MMA(1, 1, At, B1); PG8_BAR;
            PG8_LDB(B0, 1, 0); PG8_SCHED; PG8_LDA(At, 1, 0); PG8_STAGE(PG8_SA(0, 1), a2 + hstepA, voffA);
            PG8_WAIT_L(8); PG8_BAR; PG8_WAIT_L(0); PG8_MMA(0, 0, At, B0); PG8_BAR; PG8_SCHED;
            PG8_LDB(B1, 1, 1); PG8_STAGE(PG8_SB(1, 0), b3, voffB);
            PG8_BAR; PG8_WAIT_L(0); PG8_MMA(0, 1, At, B1); PG8_BAR;
            PG8_LDA(At, 1, 1); PG8_STAGE(PG8_SA(1, 0), a3, voffA);
            PG8_BAR; PG8_WAIT_L(0); PG8_MMA(1, 0, At, B0); PG8_BAR; PG8_SCHED;
            PG8_STAGE(PG8_SB(1, 1), b3 + hstepB, voffB);
            PG8_WAIT_V(6); PG8_BAR; PG8_MMA(1, 1, At, B1); PG8_BAR;
            }
        }
        if constexpr (FP8) asm volatile("s_nop 15\n\ts_nop 15" ::: "memory");
        if constexpr (I8) {
            const PG8_LAS float* ra = (const PG8_LAS float*)(lds + STAGE_BYTES + (ui & 1) * 2048) + wr * 64 + fr; const PG8_LAS float* rb = (const PG8_LAS float*)(lds + STAGE_BYTES + (ui & 1) * 2048 + 1024) + wc * 32 + 8 * fq;
#pragma unroll
            for (int bj = 0; bj < 2; ++bj) { const f32x4 sb0 = *(const PG8_LAS f32x4*)(rb + bj * HALF), sb1 = *(const PG8_LAS f32x4*)(rb + bj * HALF + 4);
#pragma unroll
                for (int ai = 0; ai < 2; ++ai)
#pragma unroll
                    for (int m = 0; m < 4; ++m) { const float sa = ra[ai * HALF + m * 16];
                        acc[ai][bj][m][0] = __builtin_convertvector(__builtin_bit_cast(v4i_t, acc[ai][bj][m][0]), f32x4) * (sb0 * sa);
                        acc[ai][bj][m][1] = __builtin_convertvector(__builtin_bit_cast(v4i_t, acc[ai][bj][m][1]), f32x4) * (sb1 * sa); } }
        }
        if constexpr (ALIGN_EPI) { if (wr == 0) PG8_BAR; }
        if constexpr (!Epi::AFTER_DRAIN) { E(acc, cur, wr, wc, fr, fq); S.done(cur); }
        if (!has_next) break;
#pragma unroll
        for (int a = 0; a < 2; ++a)
#pragma unroll
            for (int b = 0; b < 2; ++b)
#pragma unroll
                for (int m = 0; m < 4; ++m)
#pragma unroll
                    for (int n = 0; n < 2; ++n) { double z0_, z1_; asm volatile("v_mov_b64 %0, 0\n\tv_mov_b64 %1, 0" : "=v"(z0_), "=v"(z1_));
                        typedef double d2_t __attribute__((ext_vector_type(2))); acc[a][b][m][n] = __builtin_bit_cast(f32x4, (d2_t){z0_, z1_}); }
        cur = nxt; cA = nA; cB = nB; ++ui; nt = cur.nt ? cur.nt : K / BK;
        PG8_SCALES(cur, ui & 1);
        if constexpr (ALIGN_EPI) { if (wr == 1) PG8_BAR; }
    }
    PG8_WAIT_V(0);
    if constexpr (!ALIGN_EPI) { if (wr == 0) PG8_BAR; }
    PG8_BAR;
    if constexpr (Epi::AFTER_DRAIN) { E.fused(acc, cur, wr, wc, fr, fq, lds, wid, lane); S.done(cur); }
#undef PG8_SA
#undef PG8_SCALES
#undef PG8_SB
#undef PG8_STAGE
#undef PG8_LDA
#undef PG8_LDB
#undef PG8_MMA
#undef PG8_WAIT_V
#undef PG8_WAIT_VR
#undef PG8_WAIT_L
#undef PG8_BAR
#undef PG8_SCHED
}
}

#ifndef PROBE_DUP
#define PROBE_DUP 0
#endif
#ifndef USE_SPLITK
#define USE_SPLITK 0
#endif
#ifndef MK_PER_PHASE
#define MK_PER_PHASE 0
#endif
#define DUP(p) ((((PROBE_DUP) >> (p)) & 1) ? 2 : 1)
constexpr int D = 1024, NBATCH = 8, SEQ = 4096, NLAT = NBATCH * SEQ, CTXL = 256, NCTX = NBATCH * CTXL, MALL = NLAT + NCTX;
constexpr int RH = 4, RQK = 256, RV = 512;
constexpr int DFF = 2816, NE = 8, DFE = 3584;
constexpr float EPS = 1e-6f;
constexpr float LAMBDA_INIT = 0.3555090675909693f;
constexpr float LOG2E = 1.4426950408889634f, LN2 = 0.6931471805599453f;
constexpr int NWAVES = 8, NTHREADS = 512;
constexpr float MOE_WSCALE = 64.0f; constexpr int MOE_SB = 0x79797979, MOE_SA = 0x7f7f7f7f;
constexpr int MOE_ROWS = 2 * NLAT + NE * 256;

enum { I_X = 0, I_C, I_CTX, I_CCTX, I_L0_WMOD, I_L0_BMOD, I_L0_NPREMIX, I_L0_NPOSTMIX, I_L0_NPREFFN, I_L0_NPOSTFFN, I_L0_WIN, I_L0_DECAY, I_L0_WOUT, I_L0_WGU, I_L0_WDN,
       I_L1_WMOD, I_L1_BMOD, I_L1_NPREMIX, I_L1_NPOSTMIX, I_L1_NPREFFN, I_L1_NPOSTFFN, I_L1_WIN, I_L1_LAMBDA, I_L1_SUBLN, I_L1_WOUT, I_L1_RW, I_L1_RB, I_L1_MGU, I_L1_MDN, N_IN };

constexpr size_t MiB = 1u << 20;
constexpr size_t WS_CTL = 0, CTL_ZERO_BYTES = 128 * 1024;
constexpr size_t WS_MODV = 1 * MiB;
constexpr size_t WS_TAB0 = 1 * MiB + 512 * 1024;
constexpr size_t WS_TAB1 = WS_TAB0 + 32 * 1024;
constexpr size_t WS_LAM = WS_TAB1 + 8 * 1024;
constexpr size_t WS_WSC0 = WS_LAM + 4096;
constexpr size_t WS_WSC2 = WS_WSC0 + 8192 * 4;
constexpr size_t WS_RSC = 1 * MiB + 768 * 1024;
constexpr size_t WS_ROUTE = 2 * MiB;
constexpr size_t WS_WSC1 = 3 * MiB;
constexpr size_t WS_WSCM = 3 * MiB + 64 * 1024;
constexpr size_t WS_RSCM = 4 * MiB;
constexpr size_t WS_W0IN = 11 * MiB, WS_W0OUT = 27 * MiB, WS_W0GU = 31 * MiB, WS_W0DN = 42 * MiB, WS_W1IN = 48 * MiB, WS_W1OUT = 54 * MiB, WS_WMGU = 56 * MiB, WS_WMDN = 168 * MiB;
constexpr size_t WS_H = 224 * MiB;
constexpr size_t WS_A = 292 * MiB, WS_B = 564 * MiB;
constexpr size_t WS_OF = WS_B, WS_OB = WS_B + 136 * MiB;
constexpr size_t WS_Y8 = WS_A + 136 * MiB;
constexpr size_t WS_QH0 = WS_A, WS_KH0 = WS_A + 68 * MiB, WS_VQ0 = WS_A + 136 * MiB;
constexpr size_t WS_QH1 = WS_A, WS_KH1 = WS_A + 68 * MiB, WS_VH1 = WS_A + 136 * MiB;
constexpr size_t WS_HP = WS_B, WS_ACT1 = WS_A, WS_Y1 = WS_B;
constexpr size_t WS_V8 = 640 * MiB;
constexpr size_t WS_X1 = 360 * MiB, WS_X1C = 424 * MiB;
constexpr size_t WS_X2 = 496 * MiB;
constexpr size_t WS_X3 = 820 * MiB;
constexpr size_t WS_PART = WS_A + 136 * MiB;
constexpr size_t WS_END = 886 * MiB;
static_assert(WS_ACT1 + (size_t)MOE_ROWS * DFE <= WS_HP && WS_HP + (size_t)NE * NLAT * D <= WS_X3 && WS_X3 + (size_t)NLAT * D * 2 <= WS_END, "ws map");
static_assert(WS_WSC2 + 2 * DFF * 4 <= WS_RSC && WS_RSC + (size_t)MALL * 4 <= WS_ROUTE, "ws map");
constexpr int CW_TMO = 0;
constexpr int CW_BAR = 4096;
constexpr int CW_XRANK = 12288;
constexpr int CW_MOECNT = 16384;

constexpr int RING_BYTES = 131072;
constexpr int LDS_BYTES = 163840;
constexpr int MISC_OFF = LDS_BYTES - 256;

#define GAS __attribute__((address_space(1)))
#define LAS __attribute__((address_space(3)))
typedef unsigned short bf16;
typedef unsigned v4u __attribute__((ext_vector_type(4)));
typedef unsigned v2u __attribute__((ext_vector_type(2)));
typedef float f32x4 __attribute__((ext_vector_type(4)));
typedef float f32x2 __attribute__((ext_vector_type(2)));
typedef short bf16x8 __attribute__((ext_vector_type(8)));
typedef GAS unsigned gu32;
#define RLX_AGENT __ATOMIC_RELAXED, __HIP_MEMORY_SCOPE_AGENT
#define LDS_WAIT() asm volatile("s_waitcnt lgkmcnt(0)" ::: "memory")
#define VM_WAIT() asm volatile("s_waitcnt vmcnt(0)" ::: "memory")
__device__ __forceinline__ unsigned pk2(float lo, float hi);
__device__ __forceinline__ unsigned f2bf(float f) { return pk2(f, 0.f) & 0xffffu; }
typedef float f32x2_cv __attribute__((ext_vector_type(2))); typedef __bf16 bf16x2_cv __attribute__((ext_vector_type(2)));
__device__ __forceinline__ unsigned pk2(float lo, float hi) { f32x2_cv v = {lo, hi}; bf16x2_cv b = __builtin_convertvector(v, bf16x2_cv); return __builtin_bit_cast(unsigned, b); }
__device__ __forceinline__ float bf2f(unsigned b) { return __builtin_bit_cast(float, b << 16); }
__device__ __forceinline__ float bflo(unsigned w) { return __builtin_bit_cast(float, w << 16); }
__device__ __forceinline__ float bfhi(unsigned w) { return __builtin_bit_cast(float, w & 0xffff0000u); }
__device__ __forceinline__ unsigned pk4_fp8(float a, float b, float c, float d) {
    a = __builtin_amdgcn_fmed3f(a, -448.f, 448.f); b = __builtin_amdgcn_fmed3f(b, -448.f, 448.f); c = __builtin_amdgcn_fmed3f(c, -448.f, 448.f); d = __builtin_amdgcn_fmed3f(d, -448.f, 448.f);
    int w = 0; w = __builtin_amdgcn_cvt_pk_fp8_f32(a, b, w, false); w = __builtin_amdgcn_cvt_pk_fp8_f32(c, d, w, true); return (unsigned)w; }
__device__ __forceinline__ unsigned pk4_i8(float a, float b, float c, float d) {
    const unsigned ua = __builtin_bit_cast(unsigned, a + 12582912.f), ub = __builtin_bit_cast(unsigned, b + 12582912.f), uc = __builtin_bit_cast(unsigned, c + 12582912.f), ud = __builtin_bit_cast(unsigned, d + 12582912.f);
    return __builtin_amdgcn_perm(ub, ua, 0x0c0c0400u) | (__builtin_amdgcn_perm(ud, uc, 0x0c0c0400u) << 16); }
__device__ __forceinline__ float fast_exp2(float x) { return __builtin_amdgcn_exp2f(x); }
__device__ __forceinline__ float silu_f(float g) { return g * __builtin_amdgcn_rcpf(1.0f + __builtin_amdgcn_exp2f(-g * LOG2E)); }
__device__ __forceinline__ float silu2_f(float x) { return x * __builtin_amdgcn_rcpf(1.0f + __builtin_amdgcn_exp2f(-x)); }
__device__ __forceinline__ f32x2 silu2_pk(f32x2 x) { const f32x2 d = (f32x2){__builtin_amdgcn_exp2f(-x[0]), __builtin_amdgcn_exp2f(-x[1])} + 1.0f;
    return x * (f32x2){__builtin_amdgcn_rcpf(d[0]), __builtin_amdgcn_rcpf(d[1])}; }
#define WR_DPP(x, ctrl) __builtin_bit_cast(float, __builtin_amdgcn_update_dpp(0, __builtin_bit_cast(int, (x)), (ctrl), 0xF, 0xF, true))
__device__ __forceinline__ float wr_lane(float v, int l) { return __int_as_float(__builtin_amdgcn_readlane(__float_as_int(v), l)); }
__device__ __forceinline__ float wave_sum(float v) {
    v += WR_DPP(v, 0xB1); v += WR_DPP(v, 0x4E); v += WR_DPP(v, 0x124); v += WR_DPP(v, 0x128);
    return (wr_lane(v, 0) + wr_lane(v, 16)) + (wr_lane(v, 32) + wr_lane(v, 48));
}
__device__ __forceinline__ float wave_max(float v) {
    v = fmaxf(v, WR_DPP(v, 0xB1)); v = fmaxf(v, WR_DPP(v, 0x4E)); v = fmaxf(v, WR_DPP(v, 0x124)); v = fmaxf(v, WR_DPP(v, 0x128));
    return fmaxf(fmaxf(wr_lane(v, 0), wr_lane(v, 16)), fmaxf(wr_lane(v, 32), wr_lane(v, 48)));
}

#define XB_TMO      128
#define XB_XCNT(j)  (256  + 64 * (j))
#define XB_XSUB(j)  (1280 + 64 * (j))
#define XB_XGEN(j)  (2304 + 64 * (j))
#define XB_TOP      3328
#define XB_TOPGEN   3392
#define XCD_BAR_WORDS 3456
#define XB_SPIN_CAP (1u << 24)

__device__ __forceinline__ unsigned xb_ld(unsigned* p)              { return __hip_atomic_load(p, __ATOMIC_RELAXED, __HIP_MEMORY_SCOPE_AGENT); }
__device__ __forceinline__ unsigned xb_add(unsigned* p, unsigned v) { return __hip_atomic_fetch_add(p, v, __ATOMIC_RELAXED, __HIP_MEMORY_SCOPE_AGENT); }
__device__ __forceinline__ unsigned xb_xcc_id() { return (unsigned)__builtin_amdgcn_s_getreg((3 << 11) | 20) & 0xFu; }
#define XB_SPIN(cond, bar) do { unsigned _sp = 0; while (cond) { __builtin_amdgcn_s_sleep(1); \
    if ((++_sp & 255u) == 0u) { if (xb_ld(&(bar)[XB_TMO])) break; if (_sp > XB_SPIN_CAP) { atomicAdd(&(bar)[XB_TMO], 1u); break; } } } } while (0)

struct XcdBarrier {
    unsigned* bar; unsigned x;
    volatile LAS unsigned* st;
};

__device__ __forceinline__ XcdBarrier xcd_barrier_post(unsigned* bar, volatile LAS unsigned* st) {
    XcdBarrier b; b.bar = bar; b.x = xb_xcc_id(); b.st = st;
    if (threadIdx.x == 0) (void)xb_add(&bar[XB_XCNT(b.x)], 1u);
    return b;
}
__device__ __forceinline__ void xcd_barrier_complete(unsigned* bar, unsigned x, unsigned& nloc, unsigned& nx) {
    const unsigned G = gridDim.x * gridDim.y * gridDim.z;
    unsigned sum, cnt, mine, sp = 0u;
    for (;;) {
        sum = 0u; cnt = 0u; mine = 0u;
#pragma unroll
        for (unsigned j = 0; j < 16; ++j) { const unsigned c = xb_ld(&bar[XB_XCNT(j)]); sum += c; cnt += (c > 0u) ? 1u : 0u; mine = (j == x) ? c : mine; }
        if (sum == G) break;
        __builtin_amdgcn_s_sleep(1);
        if ((++sp & 255u) == 0u) { if (xb_ld(&bar[XB_TMO])) break; if (sp > XB_SPIN_CAP) { atomicAdd(&bar[XB_TMO], 1u); break; } }
    }
    nloc = mine > 0u ? mine : 1u; nx = cnt > 0u ? cnt : 1u;
}

__device__ __forceinline__ void xcd_barrier(const XcdBarrier& b) {
    asm volatile("s_waitcnt vmcnt(0)" ::: "memory");
    __syncthreads();
    if (threadIdx.x == 0) {
        unsigned* bar = b.bar;
        __builtin_amdgcn_s_waitcnt(0);
        unsigned nloc = b.st[0], nx = b.st[1];
        if (nloc == 0u) { xcd_barrier_complete(bar, b.x, nloc, nx); b.st[0] = nloc; b.st[1] = nx; }
        const unsigned old = xb_add(&bar[XB_XSUB(b.x)], 1u);
        const unsigned gen = old / nloc;
        if (old + 1u == (gen + 1u) * nloc) {
            __builtin_amdgcn_fence(__ATOMIC_RELEASE, "agent");
            asm volatile("s_waitcnt vmcnt(0)" ::: "memory");
            const unsigned og = xb_add(&bar[XB_TOP], 1u);
            const unsigned tg = og / nx;
            if (og + 1u == (tg + 1u) * nx) xb_add(&bar[XB_TOPGEN], 1u);
            else XB_SPIN(xb_ld(&bar[XB_TOPGEN]) == tg, bar);
            __builtin_amdgcn_fence(__ATOMIC_ACQUIRE, "agent");
            xb_add(&bar[XB_XGEN(b.x)], 1u);
            asm volatile("s_waitcnt vmcnt(0)" ::: "memory");
        } else {
            XB_SPIN(xb_ld(&bar[XB_XGEN(b.x)]) == gen, bar);
            __builtin_amdgcn_fence(__ATOMIC_ACQUIRE, "agent");
            asm volatile("s_waitcnt vmcnt(0)" ::: "memory");
        }
    }
    __syncthreads();
}


struct Args { const float* in[N_IN]; float* out; unsigned char* ws; int ph_lo, ph_hi; };

struct Frame {
    LAS unsigned char* lds;
    volatile LAS unsigned* MISC;
    gu32* ctl;
    int tid, lane, wave, vcu, G, cid;
    unsigned char* ws;
};

namespace pg8 {
struct EpiStore {
    static constexpr bool PERM = true, AFTER_DRAIN = false; static constexpr int NST = 16;
    bf16_t* O; int ldc;
    __device__ __forceinline__ void operator()(const f32x4 (&acc)[2][2][4][2], const Unit& u, int wr, int wc, int fr, int fq) const {
        const int row0 = u.pm * BM + wr * 64 + fr; const int col0 = u.pc * BM + wc * 32 + 8 * fq;
#pragma unroll
        for (int ai = 0; ai < 2; ++ai)
#pragma unroll
            for (int m = 0; m < 4; ++m) { bf16_t* rowp = O + (size_t)(row0 + ai * HALF + m * 16) * ldc + col0;
#pragma unroll
                for (int bj = 0; bj < 2; ++bj) { const f32x4 v0 = acc[ai][bj][m][0], v1 = acc[ai][bj][m][1];
                    u32x4 w; w.x = cvt_pk_bf16(v0[0], v0[1]); w.y = cvt_pk_bf16(v0[2], v0[3]); w.z = cvt_pk_bf16(v1[0], v1[1]); w.w = cvt_pk_bf16(v1[2], v1[3]);
                    *(u32x4*)(rowp + bj * HALF) = w; } }
    }
};
__device__ __forceinline__ u32x4 widen16(v2u a, v2u b) {
    const auto r0 = __builtin_amdgcn_permlane16_swap(a.x, b.x, false, false); const auto r1 = __builtin_amdgcn_permlane16_swap(a.y, b.y, false, false);
    const unsigned ax = r0[0], bx = r0[1], ay = r1[0], by = r1[1];
    return (u32x4){ax, ay, bx, by}; }
struct EpiStore8 {
    static constexpr bool PERM = true, AFTER_DRAIN = false; static constexpr int NST = 8;
    unsigned char* O; int ldc;
    __device__ __forceinline__ void operator()(const f32x4 (&acc)[2][2][4][2], const Unit& u, int wr, int wc, int fr, int fq) const {
        const int odd = fq & 1;
        const int row0 = u.pm * BM + wr * 64 + fr + 16 * odd; const int col0 = u.pc * BM + wc * 32 + 8 * (fq - odd);
#pragma unroll
        for (int ai = 0; ai < 2; ++ai)
#pragma unroll
            for (int m = 0; m < 4; m += 2) { unsigned char* rowp = O + (size_t)(row0 + ai * HALF + m * 16) * ldc + col0;
#pragma unroll
                for (int bj = 0; bj < 2; ++bj) { const f32x4 a0 = acc[ai][bj][m][0], a1 = acc[ai][bj][m][1], b0 = acc[ai][bj][m + 1][0], b1 = acc[ai][bj][m + 1][1];
                    v2u wa, wb; wa.x = pk4_fp8(a0[0], a0[1], a0[2], a0[3]); wa.y = pk4_fp8(a1[0], a1[1], a1[2], a1[3]); wb.x = pk4_fp8(b0[0], b0[1], b0[2], b0[3]); wb.y = pk4_fp8(b1[0], b1[1], b1[2], b1[3]);
                    *(u32x4*)(rowp + bj * HALF) = widen16(wa, wb); } }
    }
};
struct EpiSwiglu {
    static constexpr bool PERM = true, AFTER_DRAIN = false; static constexpr int NST = 8;
    bf16_t* O; int ldc;
    __device__ __forceinline__ void operator()(const f32x4 (&acc)[2][2][4][2], const Unit& u, int wr, int wc, int fr, int fq) const {
        const int row0 = u.pm * BM + wr * 64 + fr; const int col0 = u.pc * HALF + wc * 32 + 8 * fq;
#pragma unroll
        for (int ai = 0; ai < 2; ++ai)
#pragma unroll
            for (int m = 0; m < 4; ++m) { bf16_t* rowp = O + (size_t)(row0 + ai * HALF + m * 16) * ldc + col0;
                f32x4 a0, a1;
#pragma unroll
                for (int e = 0; e < 4; ++e) { a0[e] = silu_f(acc[ai][0][m][0][e]) * acc[ai][1][m][0][e]; a1[e] = silu_f(acc[ai][0][m][1][e]) * acc[ai][1][m][1][e]; }
                u32x4 w; w.x = cvt_pk_bf16(a0[0], a0[1]); w.y = cvt_pk_bf16(a0[2], a0[3]); w.z = cvt_pk_bf16(a1[0], a1[1]); w.w = cvt_pk_bf16(a1[2], a1[3]);
                *(u32x4*)rowp = w; }
    }
};

struct EpiQKV0 {
    static constexpr bool PERM = true, AFTER_DRAIN = false; static constexpr int NST = 16;
    bf16_t* Qh; bf16_t* Kh; bf16_t* Vq; const float* tab;
    __device__ __forceinline__ void operator()(const f32x4 (&acc)[2][2][4][2], const Unit& u, int wr, int wc, int fr, int fq) const {
        const int row0 = u.pm * BM + wr * 64 + fr, pc = u.pc;
        if (pc < 8) {
            bf16_t* base = pc < 4 ? Qh + (size_t)pc * MALL * 256 : Kh + (size_t)(pc - 4) * MALL * 256; const float sc = pc < 4 ? 1.0f : 0.0625f; const bool lat = u.pm < NLAT / BM;
            const int col0 = wc * 32 + 8 * fq;
#pragma unroll
            for (int ai = 0; ai < 2; ++ai)
#pragma unroll
                for (int m = 0; m < 4; ++m) { const int row = row0 + ai * HALF + m * 16, t = row & (SEQ - 1);
#pragma unroll
                    for (int bj = 0; bj < 2; ++bj) { f32x4 v0 = acc[ai][bj][m][0], v1 = acc[ai][bj][m][1];
                        if (lat) { const int pos = bj ? (t & 63) : (t >> 6); const float* tp = tab + (size_t)(pos * 64 + 16 * wc + 4 * fq) * 2;
                            const f32x4 c0 = *(const f32x4*)tp, c1 = *(const f32x4*)(tp + 4);
                            v0 = (f32x4){v0[0] * c0[0] - v0[1] * c0[1], v0[1] * c0[0] + v0[0] * c0[1], v0[2] * c0[2] - v0[3] * c0[3], v0[3] * c0[2] + v0[2] * c0[3]};
                            v1 = (f32x4){v1[0] * c1[0] - v1[1] * c1[1], v1[1] * c1[0] + v1[0] * c1[1], v1[2] * c1[2] - v1[3] * c1[3], v1[3] * c1[2] + v1[2] * c1[3]}; }
                        v0 = v0 * sc; v1 = v1 * sc;
                        u32x4 w; w.x = cvt_pk_bf16(v0[0], v0[1]); w.y = cvt_pk_bf16(v0[2], v0[3]); w.z = cvt_pk_bf16(v1[0], v1[1]); w.w = cvt_pk_bf16(v1[2], v1[3]);
                        *(u32x4*)(base + (size_t)row * 256 + col0 + bj * HALF) = w; } }
        } else {
#pragma unroll
            for (int ai = 0; ai < 2; ++ai)
#pragma unroll
                for (int m = 0; m < 4; ++m) { const int row = row0 + ai * HALF + m * 16;
#pragma unroll
                    for (int bj = 0; bj < 2; ++bj) { const f32x4 v0 = acc[ai][bj][m][0], v1 = acc[ai][bj][m][1];
                        u32x4 w; w.x = cvt_pk_bf16(v0[0], v0[1]); w.y = cvt_pk_bf16(v0[2], v0[3]); w.z = cvt_pk_bf16(v1[0], v1[1]); w.w = cvt_pk_bf16(v1[2], v1[3]);
                        *(u32x4*)(Vq + ((size_t)((pc - 8) * 2 + bj) * MALL + row) * 128 + wc * 32 + 8 * fq) = w; } }
        }
    }
};
struct QkvOrder {
    int G, c;
    __device__ __forceinline__ void init(int G_, int c_, int) { G = G_; c = c_; }
    __device__ __forceinline__ bool next(int i, Unit& u) const {
        constexpr int nM = MALL / BM, nN = 2048 / BM, NQK = nM * nN, NV = nM * 4;
        const int L = i * G + c; if (L >= NQK + NV) return false;
        const bool isv = L >= NQK;
        int wgid = isv ? 0 : L; { const int q = NQK / NXCD, xcd = wgid % NXCD, off = wgid / NXCD; wgid = xcd * q + off; }
        const int nig = WGM * nN, gid = wgid / nig, fm = gid * WGM, gsz = (nM - fm) < WGM ? (nM - fm) : WGM;
        const int qpm = fm + ((wgid % nig) % gsz), qpn = (wgid % nig) / gsz;
        const int v = isv ? L - NQK : 0; const int vv = (v % NXCD) * (NV / NXCD) + v / NXCD;
        u.pm = isv ? (vv >> 2) : qpm; u.pn = isv ? (vv >> 2) : qpn; u.pa = isv ? 8 + (vv & 3) : qpm; u.pc = isv ? 8 + (vv & 3) : qpn;
        u.k0 = 0; u.nt = 0; u.ks = -1; u.sw = isv ? 1 : 0; return true;
    }
    __device__ __forceinline__ void a_ready(const Unit&) const {}
    __device__ __forceinline__ void done(const Unit&) const {}
};
static_assert(((MALL / 256) * 8) % 8 == 0, "QkvOrder");
struct EpiQKV1 {
    static constexpr bool PERM = true, AFTER_DRAIN = false; static constexpr int NST = 16;
    unsigned char* Qh; unsigned char* Kh; unsigned char* V8; const float* tab;
    __device__ __forceinline__ void operator()(const f32x4 (&acc)[2][2][4][2], const Unit& u, int wr, int wc, int fr, int fq) const {
        const int row0 = u.pm * BM + wr * 64 + fr, pc = u.pc;
        if (!u.sw) {
            unsigned char* base = pc < 4 ? Qh : Kh; const float sc = pc < 4 ? LOG2E : 1.0f; const bool lat = u.pm < NLAT / BM;
            const int hf = wc & 1, p0 = 32 * hf + 8 * fq;
#pragma unroll
            for (int ai = 0; ai < 2; ++ai)
#pragma unroll
                for (int m = 0; m < 4; ++m) { const int row = row0 + ai * HALF + m * 16, t = row & (SEQ - 1);
                    const int pos = hf ? (t & 63) : (t >> 6); const float* tp = tab + (size_t)(pos * 16 + 4 * fq) * 2;
                    f32x4 c0 = (f32x4){1.f, 0.f, 1.f, 0.f}, c1 = c0;
                    if (lat) { c0 = *(const f32x4*)tp; c1 = *(const f32x4*)(tp + 4); }
#pragma unroll
                    for (int bj = 0; bj < 2; ++bj) { f32x4 v0 = acc[ai][bj][m][0], v1 = acc[ai][bj][m][1];
                        v0 = (f32x4){v0[0] * c0[0] - v0[1] * c0[1], v0[1] * c0[0] + v0[0] * c0[1], v0[2] * c0[2] - v0[3] * c0[3], v0[3] * c0[2] + v0[2] * c0[3]};
                        v1 = (f32x4){v1[0] * c1[0] - v1[1] * c1[1], v1[1] * c1[0] + v1[0] * c1[1], v1[2] * c1[2] - v1[3] * c1[3], v1[3] * c1[2] + v1[2] * c1[3]};
                        v0 = v0 * sc; v1 = v1 * sc;
                        const int head = (pc & 3) * 4 + 2 * bj + (wc >> 1);
                        v2u w; w.x = pk4_fp8(v0[0], v0[1], v0[2], v0[3]); w.y = pk4_fp8(v1[0], v1[1], v1[2], v1[3]);
                        *(v2u*)(base + ((size_t)head * MALL + row) * 64 + p0) = w; } }
        } else {
            const int k0 = 32 * (wc & 1) + 8 * fq, jb = 16 * (k0 >> 5) + 4 * ((k0 >> 3) & 3);
#pragma unroll
            for (int ai = 0; ai < 2; ++ai)
#pragma unroll
                for (int m = 0; m < 4; ++m) { const int n = (pc - 8) * BM + wr * 64 + fr + ai * HALF + m * 16, head = n >> 7, c = n & 127, swz = (c >> 2) & 3;
#pragma unroll
                    for (int bj = 0; bj < 2; ++bj) { const f32x4 v0 = acc[ai][bj][m][0], v1 = acc[ai][bj][m][1];
                        const size_t tile = (size_t)u.pn * 4 + 2 * bj + (wc >> 1);
                        unsigned char* img = V8 + ((size_t)head * (MALL / 64) + tile) * 8192 + c * 64 + (jb & 15);
                        *(unsigned*)(img + (((jb >> 4) ^ swz) << 4)) = pk4_fp8(v0[0], v0[1], v0[2], v0[3]);
                        *(unsigned*)(img + (((2 + (jb >> 4)) ^ swz) << 4)) = pk4_fp8(v1[0], v1[1], v1[2], v1[3]); } }
        }
    }
};

struct EpiGateMerge {
    static constexpr bool PERM = true, AFTER_DRAIN = false; static constexpr int NST = 8;
    bf16_t* Of; const bf16_t* Ob; const float* ssq;
    __device__ __forceinline__ void operator()(const f32x4 (&acc)[2][2][4][2], const Unit& u, int wr, int wc, int fr, int fq) const {
        const int row0 = u.pm * BM + wr * 64 + fr; const int col0 = u.pc * HALF + wc * 32 + 8 * fq; const int head = u.pc >> 2;
#pragma unroll
        for (int ai = 0; ai < 2; ++ai)
#pragma unroll
            for (int m = 0; m < 4; ++m) { const size_t row = (size_t)(row0 + ai * HALF + m * 16);
                const f32x4 sf = *(const f32x4*)(ssq + (row * RH + head) * 8), sb = *(const f32x4*)(ssq + (row * RH + head) * 8 + 4);
                const float rf = __builtin_amdgcn_rsqf(((sf[0] + sf[1]) + (sf[2] + sf[3])) * (1.0f / RV) + EPS) * LN2, rb = __builtin_amdgcn_rsqf(((sb[0] + sb[1]) + (sb[2] + sb[3])) * (1.0f / RV) + EPS) * LN2;
                const u32x4 of = *(const u32x4*)(Of + row * 2048 + col0), ob = *(const u32x4*)(Ob + row * 2048 + col0);
                f32x2 y[4];
#pragma unroll
                for (int e = 0; e < 4; ++e) {
                    const f32x2 gf = (f32x2){acc[ai][0][m][e >> 1][2 * (e & 1)], acc[ai][0][m][e >> 1][2 * (e & 1) + 1]}, gb = (f32x2){acc[ai][1][m][e >> 1][2 * (e & 1)], acc[ai][1][m][e >> 1][2 * (e & 1) + 1]};
                    y[e] = silu2_pk(gf) * ((f32x2){bflo(of[e]), bfhi(of[e])} * rf) + silu2_pk(gb) * ((f32x2){bflo(ob[e]), bfhi(ob[e])} * rb); }
                u32x4 w; w.x = cvt_pk_bf16(y[0][0], y[0][1]); w.y = cvt_pk_bf16(y[1][0], y[1][1]); w.z = cvt_pk_bf16(y[2][0], y[2][1]); w.w = cvt_pk_bf16(y[3][0], y[3][1]);
                *(u32x4*)(Of + row * 2048 + col0) = w; }
    }
};

struct SplitOrder {
    StaticOrder lat; int G, c, KS, ntS, nN, nl;
    __device__ __forceinline__ void init(int N, int G_, int c_, int KS_, int ntS_) { lat.init(KS_ ? NLAT : MALL, N, G_, c_); G = G_; c = c_; KS = KS_; ntS = ntS_; nN = N / BM; nl = (lat.nwg > c_) ? (lat.nwg - 1 - c_) / G_ + 1 : 0; }
    __device__ __forceinline__ bool next(int i, Unit& u) const {
        if (i < nl) return lat.next(i, u);
        const long j = (long)(i - nl) * G + c; if (j >= (long)(NCTX / BM) * nN * KS) return false;
        const int tile = (int)(j / KS), ks = (int)(j % KS);
        u.pm = NLAT / BM + tile / nN; u.pn = tile % nN; u.pc = u.pn; u.k0 = ks * ntS * BK; u.nt = ntS; u.ks = ks; u.pa = u.pm; u.sw = 0; return true;
    }
    __device__ __forceinline__ void a_ready(const Unit&) const {}
    __device__ __forceinline__ void done(const Unit&) const {}
};
struct EpiStoreSplit {
    static constexpr bool PERM = true, AFTER_DRAIN = false; static constexpr int NST = 16;
    bf16_t* O; int ldc; float* P;
    __device__ __forceinline__ void operator()(const f32x4 (&acc)[2][2][4][2], const Unit& u, int wr, int wc, int fr, int fq) const {
        const int row0 = u.pm * BM + wr * 64 + fr; const int col0 = u.pc * BM + wc * 32 + 8 * fq;
        if (u.ks < 0) {
#pragma unroll
            for (int ai = 0; ai < 2; ++ai)
#pragma unroll
                for (int m = 0; m < 4; ++m) { bf16_t* rowp = O + (size_t)(row0 + ai * HALF + m * 16) * ldc + col0;
#pragma unroll
                    for (int bj = 0; bj < 2; ++bj) { const f32x4 v0 = acc[ai][bj][m][0], v1 = acc[ai][bj][m][1];
                        u32x4 w; w.x = cvt_pk_bf16(v0[0], v0[1]); w.y = cvt_pk_bf16(v0[2], v0[3]); w.z = cvt_pk_bf16(v1[0], v1[1]); w.w = cvt_pk_bf16(v1[2], v1[3]);
                        *(u32x4*)(rowp + bj * HALF) = w; } }
        } else {
            float* pb = P + (size_t)u.ks * NCTX * ldc;
#pragma unroll
            for (int ai = 0; ai < 2; ++ai)
#pragma unroll
                for (int m = 0; m < 4; ++m) { float* rowp = pb + (size_t)(row0 - NLAT + ai * HALF + m * 16) * ldc + col0;
#pragma unroll
                    for (int bj = 0; bj < 2; ++bj) { *(f32x4*)(rowp + bj * HALF) = acc[ai][bj][m][0]; *(f32x4*)(rowp + bj * HALF + 4) = acc[ai][bj][m][1]; } }
        }
    }
};
struct EpiSwiglu8 {
    static constexpr bool PERM = true, AFTER_DRAIN = false; static constexpr int NST = 4;
    unsigned char* O; int ldc;
    __device__ __forceinline__ void operator()(const f32x4 (&acc)[2][2][4][2], const Unit& u, int wr, int wc, int fr, int fq) const {
        const int odd = fq & 1;
        const int row0 = u.pm * BM + wr * 64 + fr + 16 * odd; const int col0 = u.pc * HALF + wc * 32 + 8 * (fq - odd);
#pragma unroll
        for (int ai = 0; ai < 2; ++ai)
#pragma unroll
            for (int m2 = 0; m2 < 4; m2 += 2) { unsigned char* rowp = O + (size_t)(row0 + ai * HALF + m2 * 16) * ldc + col0;
                v2u wq[2];
#pragma unroll
                for (int mm = 0; mm < 2; ++mm) { const int m = m2 + mm;
                    const f32x4 g0 = acc[ai][0][m][0], g1 = acc[ai][0][m][1], u0 = acc[ai][1][m][0], u1 = acc[ai][1][m][1];
                    const f32x2 p0 = silu2_pk((f32x2){g0[0], g0[1]}) * (f32x2){u0[0], u0[1]}, p1 = silu2_pk((f32x2){g0[2], g0[3]}) * (f32x2){u0[2], u0[3]};
                    const f32x2 p2 = silu2_pk((f32x2){g1[0], g1[1]}) * (f32x2){u1[0], u1[1]}, p3 = silu2_pk((f32x2){g1[2], g1[3]}) * (f32x2){u1[2], u1[3]};
                    wq[mm].x = pk4_fp8(p0[0], p0[1], p1[0], p1[1]); wq[mm].y = pk4_fp8(p2[0], p2[1], p3[0], p3[1]); }
                *(u32x4*)rowp = widen16(wq[0], wq[1]); }
    }
};
struct EpiNull {
    static constexpr bool PERM = true, AFTER_DRAIN = false; static constexpr int NST = 1;
    float* O;
    __device__ __forceinline__ void operator()(const f32x4 (&acc)[2][2][4][2], const Unit& u, int wr, int wc, int fr, int fq) const {
#pragma unroll
        for (int ai = 0; ai < 2; ++ai)
#pragma unroll
            for (int bj = 0; bj < 2; ++bj)
#pragma unroll
                for (int m = 0; m < 4; ++m) { asm volatile("" :: "v"(acc[ai][bj][m][0]), "v"(acc[ai][bj][m][1])); }
        const f32x4 s = acc[0][0][0][0];
        O[(size_t)(u.pm & 7) * 65536 + (wr * 4 + wc) * 64 + fr + 16 * fq] = (s[0] + s[1]) + (s[2] + s[3]);
    }
};
struct MoeOrder {
    int nM, nN, nwg, G, c; int t1, t2, t3, t4, t5, t6, t7; int rep, slots;
    __device__ __forceinline__ bool next(int i, Unit& u) const {
        long L = (long)i * G + c; if (L >= (long)nwg * rep) return false; if (L >= nwg) L -= nwg;
        int wgid = (int)L; { const int q = nwg / NXCD, r = nwg % NXCD, xcd = wgid % NXCD, off = wgid / NXCD; wgid = (xcd < r ? xcd * (q + 1) : r * (q + 1) + (xcd - r) * q) + off; }
        const int nig = WGM * nN, gid = wgid / nig, fm = gid * WGM, gsz = (nM - fm) < WGM ? (nM - fm) : WGM;
        u.pm = fm + ((wgid % nig) % gsz); u.pc = (wgid % nig) / gsz;
        const int e = (u.pm >= t1) + (u.pm >= t2) + (u.pm >= t3) + (u.pm >= t4) + (u.pm >= t5) + (u.pm >= t6) + (u.pm >= t7);
        u.pn = e * nN + u.pc; u.k0 = 0; u.nt = 0; u.ks = -1;
        const int te = e == 0 ? 0 : e == 1 ? t1 : e == 2 ? t2 : e == 3 ? t3 : e == 4 ? t4 : e == 5 ? t5 : e == 6 ? t6 : t7;
        u.pa = slots ? e * (NLAT / BM) + (u.pm - te) : u.pm; u.sw = 0; return true;
    }
    __device__ __forceinline__ void a_ready(const Unit&) const {}
    __device__ __forceinline__ void done(const Unit&) const {}
};
}

__device__ __forceinline__ int swiglu_row(int n, int F) { const int bj = n / F, w = n % F; return 256 * (w >> 7) + 128 * bj + (w & 127); }
__device__ __forceinline__ int w_rowmap(int map, int mapF, int n) {
    if (map == 1) { if (n < 2048) { const int d0 = n & 255, hf = d0 >> 7, e = d0 & 127; return (n - d0) + 2 * (hf * 64 + (e & 63)) + (e >> 6); }
                    if (n >= 4096) return 4096 + swiglu_row(n - 4096, 2048); return n; }
    if (map == 2) { if (n < 2048) { const int d0 = n & 63, hf = d0 >> 5, e = d0 & 31; return (n - d0) + hf * 32 + 2 * (e & 15) + (e >> 4); } return n; }
    if (map == 3) return swiglu_row(n, mapF);
    return n;
}
template <bool FP8> __device__ __forceinline__ void p0_item64(const float* W, int K, int N, void* WT, int map, int mapF, LAS float* scr, int k0, int n0, int lane, float wscale) {
    { const int kq = lane >> 4, n4 = (lane & 15) * 4;
#pragma unroll 4
      for (int i = 0; i < 16; ++i) { const int k = 4 * i + kq; const f32x4 v = *(const GAS f32x4*)(W + (size_t)(k0 + k) * N + n0 + n4);
          LAS float* d = scr + k * 65 + n4; d[0] = v.x; d[1] = v.y; d[2] = v.z; d[3] = v.w; } }
    LDS_WAIT(); asm volatile("" ::: "memory");
    if constexpr (!FP8) {
        const int c = lane & 7;
#pragma unroll
        for (int j = 0; j < 8; ++j) { const int n = (lane >> 3) + 8 * j; const LAS float* sp = scr + (8 * c) * 65 + n;
            v4u o; o.x = pk2(sp[0 * 65], sp[1 * 65]); o.y = pk2(sp[2 * 65], sp[3 * 65]); o.z = pk2(sp[4 * 65], sp[5 * 65]); o.w = pk2(sp[6 * 65], sp[7 * 65]);
            *(GAS v4u*)((bf16*)WT + (size_t)w_rowmap(map, mapF, n0 + n) * K + k0 + 8 * c) = o; }
    } else {
        const int c = lane & 3;
#pragma unroll
        for (int j = 0; j < 4; ++j) { const int n = (lane >> 2) + 16 * j; const LAS float* sp = scr + (16 * c) * 65 + n;
            v4u o;
#pragma unroll
            for (int q = 0; q < 4; ++q) o[q] = pk4_fp8(sp[(4 * q) * 65] * wscale, sp[(4 * q + 1) * 65] * wscale, sp[(4 * q + 2) * 65] * wscale, sp[(4 * q + 3) * 65] * wscale);
            *(GAS v4u*)((unsigned char*)WT + (size_t)w_rowmap(map, mapF, n0 + n) * K + k0 + 16 * c) = o; }
    }
    LDS_WAIT(); asm volatile("" ::: "memory");
}

struct ColItem { const float* W; unsigned char* WT; float* WSC; int N, map, mapF, n0, f8; };
__device__ __forceinline__ bool p0_coldesc(const Frame& F, const Args& a, int ci, ColItem& d) {
    constexpr int C0 = 8192 / 32, C1 = 2 * DFF / 32, C2 = 3072 / 32, C3 = 2 * DFE / 32;
    if (ci >= C0 + C1 + C2 + NE * C3) return false;
    int c = ci;
    if (c < C0) { d.W = a.in[I_L0_WIN]; d.N = 8192; d.WT = F.ws + WS_W0IN; d.WSC = (float*)(F.ws + WS_WSC0); d.map = 1; d.mapF = 0; d.f8 = 0; }
    else if ((c -= C0) < C1) { d.W = a.in[I_L0_WGU]; d.N = 2 * DFF; d.WT = F.ws + WS_W0GU; d.WSC = (float*)(F.ws + WS_WSC2); d.map = 3; d.mapF = DFF; d.f8 = 0; }
    else if ((c -= C1) < C2) { d.W = a.in[I_L1_WIN]; d.N = 3072; d.WT = F.ws + WS_W1IN; d.WSC = (float*)(F.ws + WS_WSC1); d.map = 2; d.mapF = 0; d.f8 = 0; }
    else { c -= C2; const int e = c / C3; c = c % C3; d.W = a.in[I_L1_MGU] + (size_t)e * D * 2 * DFE; d.N = 2 * DFE; d.WT = F.ws + WS_WMGU + (size_t)e * 2 * DFE * D; d.WSC = (float*)(F.ws + WS_WSCM) + e * 2 * DFE; d.map = 3; d.mapF = DFE; d.f8 = 1; }
    d.n0 = 32 * c; return true;
}
__device__ __forceinline__ void p0_colpass(Frame& F, const Args& a) {
    LAS float* mx = (LAS float*)(F.lds + 8 * 16640);
    const int t = F.tid, n4 = (t & 7) * 4, kg = t >> 3;
    ColItem cur, nxt; int ci = F.vcu, par = 0;
    bool have = p0_coldesc(F, a, ci, cur);
    f32x4 vc[16], vn[16];
#define P0_LOAD(d_, v_) do { const float* wp_ = (d_).W + (size_t)(16 * kg) * (d_).N + (d_).n0 + n4; _Pragma("unroll") for (int i = 0; i < 16; ++i) v_[i] = *(const GAS f32x4*)(wp_ + (size_t)i * (d_).N); } while (0)
    if (have) P0_LOAD(cur, vc);
    while (have) {
        ci += F.G; const bool hn = p0_coldesc(F, a, ci, nxt); if (hn) P0_LOAD(nxt, vn);
        f32x4 cm = (f32x4){0.f, 0.f, 0.f, 0.f};
        if (!cur.f8) {
        f32x4 m4 = (f32x4){0.f, 0.f, 0.f, 0.f};
#pragma unroll
        for (int i = 0; i < 16; ++i) { m4.x = fmaxf(m4.x, fabsf(vc[i].x)); m4.y = fmaxf(m4.y, fabsf(vc[i].y)); m4.z = fmaxf(m4.z, fabsf(vc[i].z)); m4.w = fmaxf(m4.w, fabsf(vc[i].w)); }
#pragma unroll
        for (int e = 0; e < 4; ++e) { float x = m4[e]; x = fmaxf(x, __shfl_xor(x, 8)); x = fmaxf(x, __shfl_xor(x, 16)); x = fmaxf(x, __shfl_xor(x, 32)); m4[e] = x; }
        if (F.lane < 8) *(LAS f32x4*)(mx + par * 256 + F.wave * 32 + n4) = m4;
        __syncthreads();
#pragma unroll
        for (int j = 0; j < 8; ++j) { const f32x4 p = *(const LAS f32x4*)(mx + par * 256 + j * 32 + n4); cm.x = fmaxf(cm.x, p.x); cm.y = fmaxf(cm.y, p.y); cm.z = fmaxf(cm.z, p.z); cm.w = fmaxf(cm.w, p.w); }
        par ^= 1;
        }
#pragma unroll
        for (int c = 0; c < 4; ++c) {
            const int row = w_rowmap(cur.map, cur.mapF, cur.n0 + n4 + c);
            const float wf = cur.map == 3 ? (((row >> 7) & 1) ? LN2 : LOG2E) : (cur.map == 1 && row >= 4096) ? LOG2E : 1.0f;
            const float iv = cur.f8 ? MOE_WSCALE * wf : (cm[c] > 0.f ? 127.0f / cm[c] : 0.f);
            if (kg == 0 && !cur.f8) cur.WSC[row] = cm[c] * (1.0f / 127.0f) * wf;
            v4u o;
            if (cur.f8) {
#pragma unroll
                for (int q = 0; q < 4; ++q) o[q] = pk4_fp8(vc[4 * q][c] * iv, vc[4 * q + 1][c] * iv, vc[4 * q + 2][c] * iv, vc[4 * q + 3][c] * iv);
            } else {
#pragma unroll
                for (int q = 0; q < 4; ++q) o[q] = pk4_i8(vc[4 * q][c] * iv, vc[4 * q + 1][c] * iv, vc[4 * q + 2][c] * iv, vc[4 * q + 3][c] * iv);
            }
            *(GAS v4u*)(cur.WT + (size_t)row * 1024 + 16 * kg) = o; }
        cur = nxt; have = hn;
#pragma unroll
        for (int i = 0; i < 16; ++i) vc[i] = vn[i];
    }
#undef P0_LOAD
}

__device__ __forceinline__ void p0_prologue(Frame& F, const Args& a) {
    LAS float* scr = (LAS float*)(F.lds + F.wave * 16640);
    const int gw = F.vcu * NWAVES + F.wave, NGW = F.G * NWAVES;
    constexpr int I1 = (2048 / 64) * (D / 64), I3 = (DFF / 64) * (D / 64), I5 = (D / 64) * (D / 64);
    constexpr int I7E = (DFE / 64) * (D / 64);
    constexpr int NITEMS = I1 + I3 + I5 + NE * I7E;
    static_assert(NITEMS == 8640, "the balanced quotas below assume 8640 items");
    for (int rep_ = 0; rep_ < DUP(24); ++rep_) p0_colpass(F, a);
    for (int rep_ = 0; rep_ < DUP(25); ++rep_) {
        struct WItem { const float* W; unsigned char* WT; int K, N, k0, n0, fp8; float ws; };
        auto wdesc = [&](int it, WItem& d) __attribute__((always_inline)) {
            int r = it;
            if (r < I1) { d.W = a.in[I_L0_WOUT]; d.K = 2048; d.N = D; d.WT = F.ws + WS_W0OUT; d.fp8 = 0; d.ws = 1.f; }
            else if ((r -= I1) < I3) { d.W = a.in[I_L0_WDN]; d.K = DFF; d.N = D; d.WT = F.ws + WS_W0DN; d.fp8 = 1; d.ws = MOE_WSCALE; }
            else if ((r -= I3) < I5) { d.W = a.in[I_L1_WOUT]; d.K = D; d.N = D; d.WT = F.ws + WS_W1OUT; d.fp8 = 1; d.ws = MOE_WSCALE; }
            else { r -= I5; const int e = r / I7E; r = r % I7E; d.W = a.in[I_L1_MDN] + (size_t)e * DFE * D; d.K = DFE; d.N = D; d.WT = F.ws + WS_WMDN + (size_t)e * D * DFE; d.fp8 = 1; d.ws = MOE_WSCALE; }
            d.n0 = 64 * (r % (D / 64)); d.k0 = 64 * (r / (D / 64)); };
        const int kq = F.lane >> 4, n4 = (F.lane & 15) * 4;
        auto wload = [&](const WItem& d, f32x4 (&v)[16]) __attribute__((always_inline)) {
#pragma unroll
            for (int i = 0; i < 16; ++i) v[i] = *(const GAS f32x4*)(d.W + (size_t)(d.k0 + (d.fp8 ? 16 * kq + i : 4 * i + kq)) * d.N + d.n0 + n4); };
        auto wproc = [&](const WItem& d, const f32x4 (&v)[16]) __attribute__((always_inline)) {
            if (d.fp8) {
                const float wscale = d.ws;
#pragma unroll
                for (int c = 0; c < 4; ++c) { v4u o;
#pragma unroll
                    for (int q = 0; q < 4; ++q) o[q] = pk4_fp8(v[4 * q][c] * wscale, v[4 * q + 1][c] * wscale, v[4 * q + 2][c] * wscale, v[4 * q + 3][c] * wscale);
                    *(GAS v4u*)(d.WT + (size_t)(d.n0 + n4 + c) * d.K + d.k0 + 16 * kq) = o; }
                return; }
#pragma unroll
            for (int i = 0; i < 16; ++i) { LAS float* q = scr + (4 * i + kq) * 65 + n4; q[0] = v[i].x; q[1] = v[i].y; q[2] = v[i].z; q[3] = v[i].w; }
            LDS_WAIT(); asm volatile("" ::: "memory");
            if (!d.fp8) { const int c = F.lane & 7;
#pragma unroll
                for (int j = 0; j < 8; ++j) { const int n = (F.lane >> 3) + 8 * j; const LAS float* sp = scr + (8 * c) * 65 + n;
                    v4u o; o.x = pk2(sp[0 * 65], sp[1 * 65]); o.y = pk2(sp[2 * 65], sp[3 * 65]); o.z = pk2(sp[4 * 65], sp[5 * 65]); o.w = pk2(sp[6 * 65], sp[7 * 65]);
                    *(GAS v4u*)((bf16*)d.WT + (size_t)(d.n0 + n) * d.K + d.k0 + 8 * c) = o; }
            } else { const int c = F.lane & 3; const float wscale = d.ws;
#pragma unroll
                for (int j = 0; j < 4; ++j) { const int n = (F.lane >> 2) + 16 * j; const LAS float* sp = scr + (16 * c) * 65 + n;
                    v4u o;
#pragma unroll
                    for (int q = 0; q < 4; ++q) o[q] = pk4_fp8(sp[(4 * q) * 65] * wscale, sp[(4 * q + 1) * 65] * wscale, sp[(4 * q + 2) * 65] * wscale, sp[(4 * q + 3) * 65] * wscale);
                    *(GAS v4u*)(d.WT + (size_t)(d.n0 + n) * d.K + d.k0 + 16 * c) = o; }
            }
            LDS_WAIT(); asm volatile("" ::: "memory"); };
        WItem dc, dn; f32x4 vc[16], vn[16];
        int it = gw, iend = NITEMS, istep = NGW;
        if (F.G == 256) { const int v = F.vcu; int i0, cnt; if (v < 16) { i0 = 39 * v; cnt = 39; } else if (v < 64) { i0 = 624 + 47 * (v - 16); cnt = 47; } else { i0 = 2880 + 30 * (v - 64); cnt = 30; }
            it = i0 + F.wave; iend = i0 + cnt; istep = NWAVES; }
        if (it < iend) { wdesc(it, dc); wload(dc, vc); }
        for (; it < iend; it += istep) {
            const int itn = it + istep;
            if (itn < iend) { wdesc(itn, dn); wload(dn, vn); }
            wproc(dc, vc);
            dc = dn;
#pragma unroll
            for (int i = 0; i < 16; ++i) vc[i] = vn[i];
        }
    }
    __syncthreads();
    {
        LAS float* sc = (LAS float*)F.lds;
        LAS float* part = (LAS float*)(F.lds + 9 * 1024 * 4);
        bool loaded = false;
        for (int rep_ = 0; rep_ < DUP(26); ++rep_)
        for (int grp = F.G - 1 - F.vcu; grp < 2 * (6 * D / 64); grp += F.G) {
            const int layer = grp / (6 * D / 64), cb = (grp % (6 * D / 64)) * 64;
            const float* W = a.in[layer ? I_L1_WMOD : I_L0_WMOD]; const float* bm = a.in[layer ? I_L1_BMOD : I_L0_BMOD];
            const int ks = F.tid >> 6, col = F.tid & 63;
            const float* wp = W + (size_t)(ks * 128) * (6 * D) + cb + col;
            float wv0[16], wv1[16];
#pragma unroll
            for (int i = 0; i < 16; ++i) wv0[i] = wp[(size_t)i * (6 * D)];
#pragma unroll
            for (int i = 0; i < 16; ++i) wv1[i] = wp[(size_t)(16 + i) * (6 * D)];
            if (!loaded) { float cv[18];
#pragma unroll
                for (int j = 0; j < 18; ++j) { const int i = F.tid + j * NTHREADS; cv[j] = (j < 16) ? a.in[I_C][i] : a.in[I_CCTX][i - 8 * 1024]; }
#pragma unroll
                for (int j = 0; j < 18; ++j) sc[F.tid + j * NTHREADS] = silu_f(cv[j]);
                loaded = true; }
            __syncthreads();
            float acc[9];
#pragma unroll
            for (int b = 0; b < 9; ++b) acc[b] = 0.f;
#define P0_MODV_USE(wv_, kk_) do { _Pragma("unroll") for (int i = 0; i < 16; i += 4) _Pragma("unroll") for (int b = 0; b < 9; ++b) { const f32x4 s4 = *(const LAS f32x4*)(sc + b * 1024 + ks * 128 + (kk_) + i); \
                acc[b] += (s4.x * wv_[i] + s4.y * wv_[i + 1]) + (s4.z * wv_[i + 2] + s4.w * wv_[i + 3]); } } while (0)
#pragma unroll
            for (int kb = 0; kb < 8; kb += 2) {
                P0_MODV_USE(wv0, 16 * kb);
                if (kb + 2 < 8) {
#pragma unroll
                    for (int i = 0; i < 16; ++i) wv0[i] = wp[(size_t)(16 * (kb + 2) + i) * (6 * D)]; }
                P0_MODV_USE(wv1, 16 * (kb + 1));
                if (kb + 3 < 8) {
#pragma unroll
                    for (int i = 0; i < 16; ++i) wv1[i] = wp[(size_t)(16 * (kb + 3) + i) * (6 * D)]; }
            }
#undef P0_MODV_USE
#pragma unroll
            for (int b = 0; b < 9; ++b) part[(ks * 9 + b) * 64 + col] = acc[b];
            __syncthreads();
            for (int o = F.tid; o < 9 * 64; o += NTHREADS) { const int b = o >> 6, cc = o & 63; float s = bm[cb + cc];
#pragma unroll
                for (int k2 = 0; k2 < 8; ++k2) s += part[(k2 * 9 + b) * 64 + cc];
                ((float*)(F.ws + WS_MODV))[((size_t)layer * 9 + b) * (6 * D) + cb + cc] = s; }
            __syncthreads();
        }
    }
    {
        const int gt = F.vcu * NTHREADS + F.tid;
        if (gt < 64 * 64 + 64 * 16) {
            int pos, i; float ex;
            if (gt < 4096) { pos = gt >> 6; i = gt & 63; ex = (float)(2 * i) / 128.0f; } else { const int q = gt - 4096; pos = q >> 4; i = q & 15; ex = (float)(2 * i) / 32.0f; }
            const float freq = __builtin_amdgcn_exp2f(-ex * 13.287712379549449f);
            const float rev = (float)pos * freq * 0.15915494309189535f;
            const float cs = __builtin_amdgcn_cosf(rev), sn = __builtin_amdgcn_sinf(rev);
            f32x2* t = (f32x2*)(F.ws + (gt < 4096 ? WS_TAB0 : WS_TAB1)); t[gt < 4096 ? gt : gt - 4096] = (f32x2){cs, sn};
        }
        if (gt < 64) { const float* lp = a.in[I_L1_LAMBDA]; const float s1 = wave_sum(lp[gt] * lp[64 + gt]), s2 = wave_sum(lp[128 + gt] * lp[192 + gt]);
            if (gt == 0) *(float*)(F.ws + WS_LAM) = __expf(s1) - __expf(s2) + LAMBDA_INIT; }
    }
}

struct RowPass {
    int nrows;
    const float* xin_lat; const float* xin_ctx; float* xout_lat; float* xout_ctx;
    const bf16* br;
    const float* gpost;
    const float* gate;
    const float* gpre;
    const float* shift; const float* scale;
    bf16* hout;
    const float* part;
    float* rsc;
};
template <bool BR, bool MOEBR, bool WH, bool ROUTE, int H8 = 0, int KSPL = 0, bool XI16 = false, bool XO16 = false, bool Y8 = false, bool HF8 = false>
__device__ __forceinline__ void row_pass(Frame& F, const Args& a, const RowPass& P) {
    const int gw = F.vcu * NWAVES + F.wave, NGW = F.G * NWAVES;
    const int l4 = F.lane * 4;
    int mbase[NE];
    if constexpr (MOEBR) { int acc_ = 0;
#pragma unroll
        for (int e = 0; e < NE; ++e) { mbase[e] = acc_; acc_ += ((int)__builtin_amdgcn_readfirstlane((int)__hip_atomic_load((unsigned*)(F.ctl + CW_MOECNT + 64 * e), RLX_AGENT)) + 255) & ~255; } }
    static_assert(KSPL == 0, "the split-K partial slabs are not supported by the prefetching row pass");
    struct Raw { f32x4 xf[4]; v2u xh[4], ya[4], yb[4]; float w0, w1; };
    struct Rt { int e0, e1, p0, p1; float w0, w1; };
    auto route_load = [&](int r, Rt& t) __attribute__((always_inline)) {
        const int* te = (const int*)(F.ws + WS_ROUTE); const int* tpos = (const int*)(F.ws + WS_ROUTE + (size_t)NLAT * 8); const float* tw = (const float*)(F.ws + WS_ROUTE + (size_t)NLAT * 16);
        t.e0 = te[2 * r]; t.e1 = te[2 * r + 1]; t.p0 = tpos[2 * r]; t.p1 = tpos[2 * r + 1]; t.w0 = tw[2 * r]; t.w1 = tw[2 * r + 1]; };
    auto raw_load = [&](int r, const Rt& t, Raw& R) __attribute__((always_inline)) {
        const bool lat = r < NLAT; const int rc = lat ? r : r - NLAT;
        const float* xin = (lat ? P.xin_lat : P.xin_ctx) + (size_t)rc * (XI16 ? D / 2 : D);
        if constexpr (XI16) {
#pragma unroll
            for (int j = 0; j < 4; ++j) R.xh[j] = *(const GAS v2u*)((const bf16*)xin + l4 + 256 * j);
        } else {
#pragma unroll
            for (int j = 0; j < 4; ++j) R.xf[j] = *(const GAS f32x4*)(xin + l4 + 256 * j);
        }
        if constexpr (BR) {
#pragma unroll
            for (int j = 0; j < 4; ++j) R.ya[j] = *(const GAS v2u*)(P.br + (size_t)r * D + l4 + 256 * j);
        }
        if constexpr (MOEBR) {
            int b0 = 0, b1 = 0;
#pragma unroll
            for (int e = 0; e < NE; ++e) { b0 = (t.e0 == e) ? mbase[e] : b0; b1 = (t.e1 == e) ? mbase[e] : b1; }
            const int s0 = b0 + t.p0, s1 = b1 + t.p1; R.w0 = t.w0; R.w1 = t.w1;
#pragma unroll
            for (int j = 0; j < 4; ++j) {
                if constexpr (Y8) { R.ya[j].x = *(const GAS unsigned*)((const unsigned char*)P.br + (size_t)s0 * D + l4 + 256 * j); R.yb[j].x = *(const GAS unsigned*)((const unsigned char*)P.br + (size_t)s1 * D + l4 + 256 * j); }
                else { R.ya[j] = *(const GAS v2u*)(P.br + (size_t)s0 * D + l4 + 256 * j); R.yb[j] = *(const GAS v2u*)(P.br + (size_t)s1 * D + l4 + 256 * j); } }
        } };
    LAS float* prm = (LAS float*)(F.lds + 32768);
    {
        static_assert(D == 1024 && NTHREADS == 512, "staging index arithmetic");
        const int t4 = F.tid * 4; const bool lo = F.tid < 256;
        f32x4 sg0 = {}, sg1 = {}, sgt[5], ssc[5], ssh[5];
        size_t mo[5];
#pragma unroll
        for (int k = 0; k < 5; ++k) { const int i = t4 + k * 2048, ic = i < 9 * D ? i : 9 * D - 4; mo[k] = (size_t)(ic >> 10) * 6 * D + (ic & (D - 1)); }
        if constexpr (BR || MOEBR) { sg0 = *(const GAS f32x4*)(P.gpost + (lo ? t4 : 0));
#pragma unroll
            for (int k = 0; k < 5; ++k) sgt[k] = *(const GAS f32x4*)(P.gate + mo[k]); }
        if constexpr (WH) { sg1 = *(const GAS f32x4*)(P.gpre + (lo ? t4 : 0));
#pragma unroll
            for (int k = 0; k < 5; ++k) { ssc[k] = *(const GAS f32x4*)(P.scale + mo[k]); ssh[k] = *(const GAS f32x4*)(P.shift + mo[k]); } }
        if constexpr (BR || MOEBR) { if (lo) *(LAS f32x4*)(prm + t4) = sg0;
#pragma unroll
            for (int k = 0; k < 5; ++k) if (k < 4 || lo) *(LAS f32x4*)(prm + 2 * D + t4 + k * 2048) = sgt[k]; }
        if constexpr (WH) { if (lo) *(LAS f32x4*)(prm + D + t4) = sg1;
#pragma unroll
            for (int k = 0; k < 5; ++k) if (k < 4 || lo) { *(LAS f32x4*)(prm + 11 * D + t4 + k * 2048) = ssc[k]; *(LAS f32x4*)(prm + 20 * D + t4 + k * 2048) = ssh[k]; } }
        __syncthreads();
    }
    LAS float* rwl = (LAS float*)F.lds;
    if constexpr (ROUTE) { const float* rw = a.in[I_L1_RW];
        f32x4 wa[2], wb[2];
#pragma unroll
        for (int q = 0; q < 2; ++q) { const int k = F.tid + q * NTHREADS; wa[q] = *(const GAS f32x4*)(rw + (size_t)k * 8); wb[q] = *(const GAS f32x4*)(rw + (size_t)k * 8 + 4); }
#pragma unroll
        for (int q = 0; q < 2; ++q) { const int k = F.tid + q * NTHREADS;
            rwl[0 * D + k] = wa[q].x; rwl[1 * D + k] = wa[q].y; rwl[2 * D + k] = wa[q].z; rwl[3 * D + k] = wa[q].w; rwl[4 * D + k] = wb[q].x; rwl[5 * D + k] = wb[q].y; rwl[6 * D + k] = wb[q].z; rwl[7 * D + k] = wb[q].w; }
        __syncthreads(); }
    unsigned pq_w[4] = {0u, 0u, 0u, 0u}; float pq_s = 0.f; int pq_i1 = 0, pq_i2 = 0, pq_r = -1; unsigned pq_p1 = 0, pq_p2 = 0;
    auto route_flush = [&]() __attribute__((always_inline)) {
        if (pq_r >= 0) {
            const unsigned q1 = (unsigned)__builtin_amdgcn_readfirstlane((int)pq_p1), q2 = (unsigned)__builtin_amdgcn_readfirstlane((int)pq_p2);
            const size_t s1 = (size_t)pq_i1 * NLAT + q1, s2 = (size_t)pq_i2 * NLAT + q2;
            unsigned char* hp = F.ws + WS_HP; float* rs = (float*)(F.ws + WS_RSCM);
#pragma unroll
            for (int j = 0; j < 4; ++j) { *(GAS unsigned*)(hp + s1 * D + l4 + 256 * j) = pq_w[j]; *(GAS unsigned*)(hp + s2 * D + l4 + 256 * j) = pq_w[j]; }
            if (F.lane == 0) { if constexpr (!HF8) { rs[s1] = pq_s; rs[s2] = pq_s; }     int* tpos = (int*)(F.ws + WS_ROUTE + (size_t)NLAT * 8); tpos[2 * pq_r] = (int)q1; tpos[2 * pq_r + 1] = (int)q2; }
        } };
    Raw cur, nxt, nx2; Rt rtA, rtB;
    if (gw < P.nrows) { if constexpr (MOEBR) route_load(gw, rtA); raw_load(gw, rtA, cur); }
    if (gw + NGW < P.nrows) { if constexpr (MOEBR) route_load(gw + NGW, rtA); raw_load(gw + NGW, rtA, nxt); }
    if constexpr (MOEBR) { if (gw + 2 * NGW < P.nrows) route_load(gw + 2 * NGW, rtA); }
    for (int r = gw; r < P.nrows; r += NGW) {
        const int rn = r + 2 * NGW;
        if (rn < P.nrows) { raw_load(rn, rtA, nx2); if constexpr (MOEBR) { if (rn + NGW < P.nrows) route_load(rn + NGW, rtB); } }
        const bool lat = r < NLAT; const int rc = lat ? r : r - NLAT; const int midx = lat ? (r >> 12) : 8;
        float* xout = (lat ? P.xout_lat : P.xout_ctx) + (size_t)rc * (XO16 ? D / 2 : D);
        f32x4 v[4];
        if constexpr (XI16) {
#pragma unroll
            for (int j = 0; j < 4; ++j) { const v2u w = cur.xh[j]; v[j] = (f32x4){bflo(w.x), bfhi(w.x), bflo(w.y), bfhi(w.y)}; }
        } else {
#pragma unroll
            for (int j = 0; j < 4; ++j) v[j] = cur.xf[j];
        }
        if constexpr (BR || MOEBR) {
            f32x4 y[4];
            if constexpr (BR) {
#pragma unroll
                for (int j = 0; j < 4; ++j) { const v2u w = cur.ya[j]; y[j] = (f32x4){bflo(w.x), bfhi(w.x), bflo(w.y), bfhi(w.y)}; }
            } else {
                const float w0 = cur.w0, w1 = cur.w1;
#pragma unroll
                for (int j = 0; j < 4; ++j) { const v2u p = cur.ya[j]; const v2u q = cur.yb[j];
                    if constexpr (Y8) { const f32x2 pa = __builtin_amdgcn_cvt_pk_f32_fp8((int)p.x, false), pb = __builtin_amdgcn_cvt_pk_f32_fp8((int)p.x, true), qa = __builtin_amdgcn_cvt_pk_f32_fp8((int)q.x, false), qb = __builtin_amdgcn_cvt_pk_f32_fp8((int)q.x, true);
                        y[j] = (f32x4){w0 * pa.x + w1 * qa.x, w0 * pa.y + w1 * qa.y, w0 * pb.x + w1 * qb.x, w0 * pb.y + w1 * qb.y}; }
                    else y[j] = (f32x4){w0 * bflo(p.x) + w1 * bflo(q.x), w0 * bfhi(p.x) + w1 * bfhi(q.x), w0 * bflo(p.y) + w1 * bflo(q.y), w0 * bfhi(p.y) + w1 * bfhi(q.y)}; }
            }
            float ss = 0.f;
#pragma unroll
            for (int j = 0; j < 4; ++j) ss += (y[j].x * y[j].x + y[j].y * y[j].y) + (y[j].z * y[j].z + y[j].w * y[j].w);
            const float rstd = __builtin_amdgcn_rsqf(wave_sum(ss) * (1.0f / D) + EPS);
#pragma unroll
            for (int j = 0; j < 4; ++j) { __builtin_amdgcn_sched_barrier(0); const f32x4 gp = *(const LAS f32x4*)(prm + l4 + 256 * j); const f32x4 gt = *(const LAS f32x4*)(prm + (2 + midx) * D + l4 + 256 * j);
                v[j] = v[j] + gt * (y[j] * rstd * gp); }
            if ((lat ? P.xout_lat : P.xout_ctx) != nullptr) {
                if constexpr (XO16) {
#pragma unroll
                    for (int j = 0; j < 4; ++j) { v2u w; w.x = pk2(v[j].x, v[j].y); w.y = pk2(v[j].z, v[j].w); *(GAS v2u*)((bf16*)xout + l4 + 256 * j) = w; }
                } else {
#pragma unroll
                    for (int j = 0; j < 4; ++j) *(GAS f32x4*)(xout + l4 + 256 * j) = v[j];
                }
            }
        }
        if constexpr (WH) {
            float ss = 0.f;
#pragma unroll
            for (int j = 0; j < 4; ++j) ss += (v[j].x * v[j].x + v[j].y * v[j].y) + (v[j].z * v[j].z + v[j].w * v[j].w);
            const float rstd = __builtin_amdgcn_rsqf(wave_sum(ss) * (1.0f / D) + EPS);
            f32x4 h[4];
#pragma unroll
            for (int j = 0; j < 4; ++j) { __builtin_amdgcn_sched_barrier(0); const f32x4 gp = *(const LAS f32x4*)(prm + D + l4 + 256 * j); const f32x4 sc = *(const LAS f32x4*)(prm + (11 + midx) * D + l4 + 256 * j);
                const f32x4 sh = *(const LAS f32x4*)(prm + (20 + midx) * D + l4 + 256 * j);
                h[j] = (v[j] * rstd * gp) * (1.0f + sc) + sh;
                if constexpr (H8 == 2) { }
                else if constexpr (H8 == 1) { *(GAS unsigned*)((unsigned char*)P.hout + (size_t)r * D + l4 + 256 * j) = pk4_fp8(h[j].x, h[j].y, h[j].z, h[j].w); }
                else { v2u w; w.x = pk2(h[j].x, h[j].y); w.y = pk2(h[j].z, h[j].w); *(GAS v2u*)(P.hout + (size_t)r * D + l4 + 256 * j) = w; } }
            unsigned qw[4]; float qs = 0.f;
            if constexpr (H8 == 2 && HF8) {
#pragma unroll
                for (int j = 0; j < 4; ++j) qw[j] = pk4_fp8(h[j].x, h[j].y, h[j].z, h[j].w);
                qs = 1.0f;
            } else if constexpr (H8 == 2) {
                float am = 0.f;
#pragma unroll
                for (int j = 0; j < 4; ++j) am = fmaxf(fmaxf(am, fmaxf(fabsf(h[j].x), fabsf(h[j].y))), fmaxf(fabsf(h[j].z), fabsf(h[j].w)));
                am = wave_max(am);
                const float iv = am > 0.f ? 127.0f / am : 0.f;
#pragma unroll
                for (int j = 0; j < 4; ++j) qw[j] = pk4_i8(h[j].x * iv, h[j].y * iv, h[j].z * iv, h[j].w * iv);
                qs = am * (1.0f / 127.0f);
                if constexpr (!ROUTE) {
#pragma unroll
                    for (int j = 0; j < 4; ++j) *(GAS unsigned*)((unsigned char*)P.hout + (size_t)r * D + l4 + 256 * j) = qw[j];
                    if (F.lane == 0) P.rsc[r] = qs; }
            }
            if constexpr (ROUTE) {
                float lg[8];
#pragma unroll
                for (int e = 0; e < 8; ++e) lg[e] = 0.f;
#pragma unroll
                for (int j = 0; j < 4; ++j)
#pragma unroll
                    for (int e = 0; e < 8; ++e) { const f32x4 w4 = *(const LAS f32x4*)(rwl + e * D + l4 + 256 * j);
                        lg[e] += (h[j].x * w4.x + h[j].y * w4.y) + (h[j].z * w4.z + h[j].w * w4.w); }
#pragma unroll
                for (int e = 0; e < 8; ++e) lg[e] = wave_sum(lg[e]) + a.in[I_L1_RB][e];
                float v1 = lg[0]; int i1 = 0;
#pragma unroll
                for (int e = 1; e < 8; ++e) if (lg[e] > v1) { v1 = lg[e]; i1 = e; }
                float v2 = -3.0e38f; int i2 = 0;
#pragma unroll
                for (int e = 0; e < 8; ++e) if (e != i1 && lg[e] > v2) { v2 = lg[e]; i2 = e; }
                const float w1 = 1.0f / (1.0f + __expf(v2 - v1)), w2 = 1.0f - w1;
                unsigned p1 = 0, p2 = 0;
                if (F.lane == 0) {
                    int* te = (int*)(F.ws + WS_ROUTE); int* tpos = (int*)(F.ws + WS_ROUTE + (size_t)NLAT * 8); float* tw = (float*)(F.ws + WS_ROUTE + (size_t)NLAT * 16);
                    p1 = __hip_atomic_fetch_add((unsigned*)(F.ctl + CW_MOECNT + 64 * i1), 1u, RLX_AGENT);
                    p2 = __hip_atomic_fetch_add((unsigned*)(F.ctl + CW_MOECNT + 64 * i2), 1u, RLX_AGENT);
                    te[2 * r] = i1; te[2 * r + 1] = i2; tw[2 * r] = w1; tw[2 * r + 1] = w2;
                }
                if constexpr (H8 == 2) {
                    route_flush();
#pragma unroll
                    for (int j = 0; j < 4; ++j) pq_w[j] = qw[j];
                    pq_s = qs; pq_i1 = i1; pq_i2 = i2; pq_p1 = p1; pq_p2 = p2; pq_r = r;
                }
            }
        }
        cur = nxt; nxt = nx2; if constexpr (MOEBR) rtA = rtB;
    }
    if constexpr (ROUTE && H8 == 2) route_flush();
}


namespace att {
using s16x4  = __attribute__((ext_vector_type(4))) short;
using f32x16 = __attribute__((ext_vector_type(16))) float;
using u32x4  = __attribute__((ext_vector_type(4))) unsigned;
constexpr int KVBLK = 64, NT = (SEQ + CTXL) / KVBLK;
constexpr int SHM_V = KVBLK * 128, SHM_K = KVBLK * 64;
constexpr int NVTILE = MALL / KVBLK;
constexpr int NSLOT_K = 3, NSLOT_V = 2;
constexpr int OFF_V = 0, OFF_K = NSLOT_V * 2 * SHM_V, OFF_WS = OFF_K + NSLOT_K * 2 * SHM_K, OFF_O1 = OFF_WS + NWAVES * 64 * 4, ATT_LDS = OFF_O1 + NWAVES * 8192;
constexpr float THR = 8.0f;
#define ATT_SBAR() __builtin_amdgcn_sched_barrier(0)
#define ATT_PIPE_PV() do { __builtin_amdgcn_sched_group_barrier(0x100, 2, 0); \
    _Pragma("unroll") for (int i_ = 0; i_ < 16; ++i_) { __builtin_amdgcn_sched_group_barrier(0x008, 1, 0); __builtin_amdgcn_sched_group_barrier(0x100, 2, 0); __builtin_amdgcn_sched_group_barrier(0x002, 7, 0); } } while (0)
#define KSWZ64(row, colB) ((row) * 128 + ((colB) ^ ((((row) >> 1) & 7) << 4)))
__device__ __forceinline__ int crow(int r, int hi) { return (r & 3) + 8 * (r >> 2) + 4 * hi; }
__device__ __forceinline__ unsigned cvtpk(float lo, float hi) { return pk2(lo, hi); }

template <int VAR = 0> __device__ __forceinline__ void partialSM(f32x16& p0, f32x16& p1, float& m_reg, f32x16& negm, float& alpha) {
    float mx[4];
#pragma unroll
    for (int c = 0; c < 4; ++c) mx[c] = fmaxf(fmaxf(p0[4 * c], p0[4 * c + 1]), fmaxf(p0[4 * c + 2], p0[4 * c + 3]));
#pragma unroll
    for (int c = 0; c < 4; ++c) mx[c] = fmaxf(mx[c], fmaxf(fmaxf(p1[4 * c], p1[4 * c + 1]), fmaxf(p1[4 * c + 2], p1[4 * c + 3])));
    float pmax = fmaxf(fmaxf(mx[0], mx[1]), fmaxf(mx[2], mx[3]));
    { auto rr = __builtin_amdgcn_permlane32_swap(__float_as_uint(pmax), __float_as_uint(pmax), false, false); pmax = fmaxf(__uint_as_float(rr[0]), __uint_as_float(rr[1])); }
    alpha = 1.f; m_reg = pmax;
#pragma unroll
    for (int r = 0; r < 16; ++r) { negm[r] = 56.5f - pmax; p0[r] = p0[r] + (56.5f - pmax); p1[r] = p1[r] + (56.5f - pmax); }
}
template <int VAR = 0> __device__ __forceinline__ void finishSM(f32x16& p0, f32x16& p1, float alpha, float& l_reg, bf16x8& pa0, bf16x8& pa1, bf16x8& pa2, bf16x8& pa3) {
    if (VAR != 2) {
    f32x2 s2[4];
#pragma unroll
    for (int c = 0; c < 4; ++c) s2[c] = (f32x2){p0[4 * c], p0[4 * c + 1]} + (f32x2){p0[4 * c + 2], p0[4 * c + 3]};
#pragma unroll
    for (int c = 0; c < 4; ++c) s2[c] = s2[c] + ((f32x2){p1[4 * c], p1[4 * c + 1]} + (f32x2){p1[4 * c + 2], p1[4 * c + 3]});
    const f32x2 s2t = (s2[0] + s2[1]) + (s2[2] + s2[3]);
    float ps = s2t[0] + s2t[1];
    { auto rr = __builtin_amdgcn_permlane32_swap(__float_as_uint(ps), __float_as_uint(ps), false, false); ps = __uint_as_float(rr[0]) + __uint_as_float(rr[1]); }
    l_reg = l_reg * alpha + ps;
    } else { l_reg = 1.f; }
#define ATT_PK4(P, BASE, OUT) do { u32x4 w = {cvtpk(P[BASE + 0], P[BASE + 1]), cvtpk(P[BASE + 2], P[BASE + 3]), cvtpk(P[BASE + 4], P[BASE + 5]), cvtpk(P[BASE + 6], P[BASE + 7])}; OUT = *reinterpret_cast<bf16x8*>(&w); } while (0)
    ATT_PK4(p0, 0, pa0); ATT_PK4(p0, 8, pa1); ATT_PK4(p1, 0, pa2); ATT_PK4(p1, 8, pa3);
#undef ATT_PK4
}
__device__ __forceinline__ void qkt(f32x16& p0, f32x16& p1, const char* Ks, const bf16x8* qr, const f32x16& negm, int r32, int hi) {
#pragma unroll
    for (int d0 = 0; d0 < 4; ++d0) { const int cb = (d0 * 16 + hi * 8) * 2;
        const bf16x8 b0 = *reinterpret_cast<const bf16x8*>(Ks + KSWZ64(r32, cb));
        const bf16x8 b1 = *reinterpret_cast<const bf16x8*>(Ks + KSWZ64(32 + r32, cb));
        if (d0 == 0) { p0 = __builtin_amdgcn_mfma_f32_32x32x16_bf16(b0, qr[0], negm, 0, 0, 0); p1 = __builtin_amdgcn_mfma_f32_32x32x16_bf16(b1, qr[0], negm, 0, 0, 0); }
        else { p0 = __builtin_amdgcn_mfma_f32_32x32x16_bf16(b0, qr[d0], p0, 0, 0, 0); p1 = __builtin_amdgcn_mfma_f32_32x32x16_bf16(b1, qr[d0], p1, 0, 0, 0); } }
}
__device__ __forceinline__ int v_st(int k, int c) { const int kk = (k & ~0xC) | ((k & 4) << 1) | ((k & 8) >> 1); return ((kk >> 3) * 4 + (c >> 5)) * 512 + ((kk & 7) * 32 + (c & 31)) * 2; }
__device__ __forceinline__ int v_rd_base(int lane) { return ((lane & 3) << 3) | (((lane >> 2) & 3) << 6) | (((lane >> 4) & 1) << 5) | (((lane >> 5) & 1) << 8); }
constexpr int v_rd_off(int d0, int ks, int half) { return d0 * 512 + ks * 4096 + half * 2048; }
typedef short v4i16a_t __attribute__((ext_vector_type(4)));
template <int OFF> __device__ __forceinline__ s16x4 tr_read(int vb) { return __builtin_bit_cast(s16x4, __builtin_amdgcn_ds_read_tr16_b64_v4i16((LAS v4i16a_t*)(unsigned)(vb + OFF))); }
#define ATT_PK(L, H) (bf16x8){L[0], L[1], L[2], L[3], H[0], H[1], H[2], H[3]}
template <int D0> __device__ __forceinline__ void pv_one(f32x16& od, int vb, bf16x8 pa0, bf16x8 pa1, bf16x8 pa2, bf16x8 pa3) {
    const s16x4 l0 = tr_read<v_rd_off(D0, 0, 0)>(vb), h0 = tr_read<v_rd_off(D0, 0, 1)>(vb), l1 = tr_read<v_rd_off(D0, 1, 0)>(vb), h1 = tr_read<v_rd_off(D0, 1, 1)>(vb);
    const s16x4 l2 = tr_read<v_rd_off(D0, 2, 0)>(vb), h2 = tr_read<v_rd_off(D0, 2, 1)>(vb), l3 = tr_read<v_rd_off(D0, 3, 0)>(vb), h3 = tr_read<v_rd_off(D0, 3, 1)>(vb);
    od = __builtin_amdgcn_mfma_f32_32x32x16_bf16(pa0, ATT_PK(l0, h0), od, 0, 0, 0);
    od = __builtin_amdgcn_mfma_f32_32x32x16_bf16(pa1, ATT_PK(l1, h1), od, 0, 0, 0);
    od = __builtin_amdgcn_mfma_f32_32x32x16_bf16(pa2, ATT_PK(l2, h2), od, 0, 0, 0);
    od = __builtin_amdgcn_mfma_f32_32x32x16_bf16(pa3, ATT_PK(l3, h3), od, 0, 0, 0);
}
#undef ATT_PK
__device__ __forceinline__ void pv_d0(f32x16* o, int vb, bf16x8 pa0, bf16x8 pa1, bf16x8 pa2, bf16x8 pa3) {
    pv_one<0>(o[0], vb, pa0, pa1, pa2, pa3); pv_one<1>(o[1], vb, pa0, pa1, pa2, pa3); pv_one<2>(o[2], vb, pa0, pa1, pa2, pa3); pv_one<3>(o[3], vb, pa0, pa1, pa2, pa3);
}
struct VH { bf16x8 k0, k1; };
__device__ __forceinline__ void vhalf(bf16x8& d, s16x4 lo, s16x4 hi) { d = __builtin_shufflevector(lo, hi, 0, 1, 2, 3, 4, 5, 6, 7); }
template <int D0, int KS0> __device__ __forceinline__ void vh_load(VH& f, int vb) {
    vhalf(f.k0, tr_read<v_rd_off(D0, KS0, 0)>(vb), tr_read<v_rd_off(D0, KS0, 1)>(vb)); vhalf(f.k1, tr_read<v_rd_off(D0, KS0 + 1, 0)>(vb), tr_read<v_rd_off(D0, KS0 + 1, 1)>(vb));
}
#define ATT_PKV(L, H) (bf16x8){L[0], L[1], L[2], L[3], H[0], H[1], H[2], H[3]}
#define ATT_E3(P, B) do { P[B] = __builtin_amdgcn_exp2f(P[B]); P[(B) + 1] = __builtin_amdgcn_exp2f(P[(B) + 1]); P[(B) + 2] = __builtin_amdgcn_exp2f(P[(B) + 2]); } while (0)
#define ATT_MM(D, PA, FR) o[D] = __builtin_amdgcn_mfma_f32_32x32x16_bf16(PA, FR, o[D], 0, 0, 0)
#define ATT_PIN(x) asm volatile("" : "+v"(x))
__device__ __forceinline__ void pv_partial(f32x16* o, int vb, bf16x8 pa0, bf16x8 pa1, bf16x8 pa2, bf16x8 pa3, f32x16& p0, f32x16& p1, float& m_reg, f32x16& negm, float& alpha) {
    VH fa, fb; float mx[4];
    vh_load<0, 0>(fa, vb); vh_load<0, 2>(fb, vb);
    ATT_SBAR();
    ATT_MM(0, pa0, fa.k0);
    mx[0] = fmaxf(fmaxf(p0[0], p0[1]), p0[2]); mx[1] = fmaxf(fmaxf(p0[3], p0[4]), p0[5]); mx[2] = fmaxf(fmaxf(p0[6], p0[7]), p0[8]); mx[3] = fmaxf(fmaxf(p0[9], p0[10]), p0[11]); ATT_PIN(mx[0]); ATT_PIN(mx[1]); ATT_PIN(mx[2]); ATT_PIN(mx[3]); ATT_SBAR();
    ATT_MM(0, pa1, fa.k1); vh_load<1, 0>(fa, vb);
    mx[0] = fmaxf(fmaxf(mx[0], p0[12]), p0[13]); mx[1] = fmaxf(fmaxf(mx[1], p0[14]), p0[15]); mx[2] = fmaxf(fmaxf(mx[2], p1[0]), p1[1]); mx[3] = fmaxf(fmaxf(mx[3], p1[2]), p1[3]); ATT_PIN(mx[0]); ATT_PIN(mx[1]); ATT_PIN(mx[2]); ATT_PIN(mx[3]); ATT_SBAR();
    ATT_MM(0, pa2, fb.k0);
    mx[0] = fmaxf(fmaxf(mx[0], p1[4]), p1[5]); mx[1] = fmaxf(fmaxf(mx[1], p1[6]), p1[7]); mx[2] = fmaxf(fmaxf(mx[2], p1[8]), p1[9]); mx[3] = fmaxf(fmaxf(mx[3], p1[10]), p1[11]); ATT_PIN(mx[0]); ATT_PIN(mx[1]); ATT_PIN(mx[2]); ATT_PIN(mx[3]); ATT_SBAR();
    ATT_MM(0, pa3, fb.k1); vh_load<1, 2>(fb, vb);
    mx[0] = fmaxf(fmaxf(mx[0], p1[12]), p1[13]); mx[1] = fmaxf(fmaxf(mx[1], p1[14]), p1[15]); ATT_PIN(mx[0]); ATT_PIN(mx[1]); ATT_SBAR();
    ATT_MM(1, pa0, fa.k0);
    { float pmax = fmaxf(fmaxf(mx[0], mx[1]), fmaxf(mx[2], mx[3]));
      auto rr = __builtin_amdgcn_permlane32_swap(__float_as_uint(pmax), __float_as_uint(pmax), false, false); pmax = fmaxf(__uint_as_float(rr[0]), __uint_as_float(rr[1]));
      const bool need = pmax > 8.0f * THR + 56.5f; alpha = 1.f;
      if (__any(need)) { const float delta = need ? pmax - 56.5f : 0.f; alpha = __builtin_amdgcn_exp2f(-0.125f * delta); m_reg += delta;
#pragma unroll
          for (int r = 0; r < 16; ++r) { p0[r] -= delta; p1[r] -= delta; negm[r] -= delta; } } } ATT_PIN(alpha); ATT_SBAR();
    ATT_MM(1, pa1, fa.k1); vh_load<2, 0>(fa, vb); ATT_E3(p0, 0); ATT_PIN(p0); ATT_SBAR();
    ATT_MM(1, pa2, fb.k0); ATT_E3(p0, 3); ATT_PIN(p0); ATT_SBAR();
    ATT_MM(1, pa3, fb.k1); vh_load<2, 2>(fb, vb); ATT_E3(p0, 6); ATT_PIN(p0); ATT_SBAR();
    ATT_MM(2, pa0, fa.k0); ATT_E3(p0, 9); ATT_PIN(p0); ATT_SBAR();
    ATT_MM(2, pa1, fa.k1); vh_load<3, 0>(fa, vb); ATT_E3(p0, 12); ATT_PIN(p0); ATT_SBAR();
    ATT_MM(2, pa2, fb.k0); p0[15] = __builtin_amdgcn_exp2f(p0[15]); p1[0] = __builtin_amdgcn_exp2f(p1[0]); p1[1] = __builtin_amdgcn_exp2f(p1[1]); ATT_PIN(p0); ATT_PIN(p1); ATT_SBAR();
    ATT_MM(2, pa3, fb.k1); vh_load<3, 2>(fb, vb); ATT_E3(p1, 2); ATT_PIN(p1); ATT_SBAR();
    ATT_MM(3, pa0, fa.k0); ATT_E3(p1, 5); ATT_PIN(p1); ATT_SBAR();
    ATT_MM(3, pa1, fa.k1); ATT_E3(p1, 8); ATT_PIN(p1); ATT_SBAR();
    ATT_MM(3, pa2, fb.k0); ATT_E3(p1, 11); ATT_PIN(p1); ATT_SBAR();
    ATT_MM(3, pa3, fb.k1); p1[14] = __builtin_amdgcn_exp2f(p1[14]); p1[15] = __builtin_amdgcn_exp2f(p1[15]); ATT_PIN(p1); ATT_SBAR();
}
#undef ATT_MM
#undef ATT_PIN
#undef ATT_E3
#undef ATT_PKV
typedef int v8i_a __attribute__((ext_vector_type(8)));
typedef int v4i_a __attribute__((ext_vector_type(4)));
__device__ __forceinline__ v8i_a v8_frag(unsigned a0, unsigned a1) {
    const v4i_a lo = *(const LAS v4i_a*)a0, hi = *(const LAS v4i_a*)a1; return __builtin_shufflevector(lo, hi, 0, 1, 2, 3, 4, 5, 6, 7); }
#define ATT_MM8(D, FR) asm volatile("v_mfma_scale_f32_32x32x64_f8f6f4 %0, %1, %2, %0, %3, %3 op_sel_hi:[0,0,0]" : "+v"(o[D]) : "v"(pa8), "v"(FR), "v"(one8))
#define ATT_PIN8(x) asm volatile("" : "+v"(x))
#define ATT_KEEP8(x) asm volatile("" :: "v"(x))
#define ATT_LONGNOP() asm volatile("s_nop 15\n\ts_nop 15\n\ts_nop 15\n\ts_nop 15" ::: "memory")
#define ATT_EX(P, B) P[B] = __builtin_amdgcn_exp2f(P[B])
__device__ __forceinline__ void qkt8(f32x16& p0, f32x16& p1, unsigned ka, const v8i_a& q8, const f32x16& negm, v8i_a& k0, v8i_a& k1) {
    const int sK = 0x7f7f7f7f, sQ = 0x7f7f7f7f;
    const v4i_a a0 = *(const LAS v4i_a*)ka, a1 = *(const LAS v4i_a*)(ka ^ 16u), b0 = *(const LAS v4i_a*)(ka + 2048u), b1 = *(const LAS v4i_a*)((ka ^ 16u) + 2048u);
    k0 = __builtin_shufflevector(a0, a1, 0, 1, 2, 3, 4, 5, 6, 7); k1 = __builtin_shufflevector(b0, b1, 0, 1, 2, 3, 4, 5, 6, 7);
    asm volatile("v_mfma_scale_f32_32x32x64_f8f6f4 %0, %1, %2, %3, %4, %5 op_sel_hi:[0,0,0]" : "=&v"(p0) : "v"(k0), "v"(q8), "v"(negm), "v"(sK), "v"(sQ));
    asm volatile("v_mfma_scale_f32_32x32x64_f8f6f4 %0, %1, %2, %3, %4, %5 op_sel_hi:[0,0,0]" : "=&v"(p1) : "v"(k1), "v"(q8), "v"(negm), "v"(sK), "v"(sQ));
}
#define ATT_MML() asm volatile("v_mfma_scale_f32_32x32x64_f8f6f4 %0, %1, %2, %0, %3, %3 op_sel_hi:[0,0,0]" : "+v"(lsum) : "v"(pa8), "v"(ones8), "v"(one8))
__device__ __forceinline__ void pv8_partial(f32x16* o, f32x16& lsum, const v8i_a& ones8, unsigned va0, unsigned va1, const v8i_a& pa8, f32x16& p0, f32x16& p1, float& m_reg, f32x16& negm, float& alpha, const v8i_a& kf0, const v8i_a& kf1) {
    const int one8 = 0x7f7f7f7f;
    float mx[4];
    const v8i_a f0 = v8_frag(va0, va1), f1 = v8_frag(va0 + 2048, va1 + 2048), f2 = v8_frag(va0 + 4096, va1 + 4096), f3 = v8_frag(va0 + 6144, va1 + 6144);
    ATT_SBAR();
    ATT_MM8(0, f0); ATT_MM8(1, f1); asm volatile("s_nop 7" ::: "memory"); ATT_KEEP8(kf0); ATT_KEEP8(kf1); ATT_SBAR();
    mx[0] = fmaxf(fmaxf(p0[0], p0[1]), p0[2]); mx[1] = fmaxf(fmaxf(p0[3], p0[4]), p0[5]); mx[2] = fmaxf(fmaxf(p0[6], p0[7]), p0[8]); mx[3] = fmaxf(fmaxf(p0[9], p0[10]), p0[11]);
    mx[0] = fmaxf(fmaxf(mx[0], p0[12]), p0[13]); mx[1] = fmaxf(fmaxf(mx[1], p0[14]), p0[15]); mx[2] = fmaxf(fmaxf(mx[2], p1[0]), p1[1]); mx[3] = fmaxf(fmaxf(mx[3], p1[2]), p1[3]);
    mx[0] = fmaxf(fmaxf(mx[0], p1[4]), p1[5]); mx[1] = fmaxf(fmaxf(mx[1], p1[6]), p1[7]); mx[2] = fmaxf(fmaxf(mx[2], p1[8]), p1[9]); mx[3] = fmaxf(fmaxf(mx[3], p1[10]), p1[11]);
    mx[0] = fmaxf(fmaxf(mx[0], p1[12]), p1[13]); mx[1] = fmaxf(fmaxf(mx[1], p1[14]), p1[15]);
    { float pmax = fmaxf(fmaxf(mx[0], mx[1]), fmaxf(mx[2], mx[3]));
      auto rr = __builtin_amdgcn_permlane32_swap(__float_as_uint(pmax), __float_as_uint(pmax), false, false); pmax = fmaxf(__uint_as_float(rr[0]), __uint_as_float(rr[1]));
      const bool need = pmax > 8.0f * THR + 56.5f; alpha = 1.f;
      if (__any(need)) { const float delta = need ? pmax - 56.5f : 0.f; alpha = __builtin_amdgcn_exp2f(-0.125f * delta); m_reg += delta;
#pragma unroll
          for (int r = 0; r < 16; ++r) { p0[r] -= delta; p1[r] -= delta; negm[r] -= delta; } } } ATT_PIN8(alpha); ATT_SBAR();
    ATT_MM8(2, f2); ATT_MM8(3, f3); ATT_MML();
    ATT_KEEP8(f0); ATT_KEEP8(f1); ATT_KEEP8(f2); ATT_KEEP8(f3);
}
#undef ATT_EX
__device__ __forceinline__ void p_bytes(const f32x16& p0, const f32x16& p1, v8i_a& pa8) {
#pragma unroll
    for (int q = 0; q < 4; ++q) {
        unsigned w0 = 0, w1 = 0;
        w0 = __builtin_amdgcn_cvt_pk_u8_f32(p0[4 * q], 0, w0); w1 = __builtin_amdgcn_cvt_pk_u8_f32(p1[4 * q], 0, w1);
        w0 = __builtin_amdgcn_cvt_pk_u8_f32(p0[4 * q + 1], 1, w0); w1 = __builtin_amdgcn_cvt_pk_u8_f32(p1[4 * q + 1], 1, w1);
        w0 = __builtin_amdgcn_cvt_pk_u8_f32(p0[4 * q + 2], 2, w0); w1 = __builtin_amdgcn_cvt_pk_u8_f32(p1[4 * q + 2], 2, w1);
        w0 = __builtin_amdgcn_cvt_pk_u8_f32(p0[4 * q + 3], 3, w0); w1 = __builtin_amdgcn_cvt_pk_u8_f32(p1[4 * q + 3], 3, w1);
        pa8[q] = (int)w0; pa8[4 + q] = (int)w1; }
}
__device__ __forceinline__ size_t kvrow(int b, int t) { return t < 64 ? (size_t)b * SEQ + (size_t)t * 64 : (size_t)NLAT + (size_t)b * CTXL + (size_t)(t - 64) * 64; }

__device__ __forceinline__ void glds16(const void* gsrc, unsigned lds_dst) {
    asm volatile("s_mov_b32 m0, %1\n\ts_nop 0\n\tglobal_load_lds_dwordx4 %0, off" :: "v"(gsrc), "s"(lds_dst) : "memory", "m0"); }
template <int VAR> __device__ __forceinline__ void head_pass(const unsigned char* __restrict__ Q1, const unsigned char* __restrict__ K1, const unsigned char* __restrict__ V8, int b, int qh, int hp, size_t qrow0, char* lds, f32x16 (&o)[4], f32x16& lsum, int (&rot)[4], bool pre, bool has_nxt, int nb, int nqh) {
    int tid_ = threadIdx.x; asm volatile("" : "+v"(tid_));
    const int tid = tid_, wid = __builtin_amdgcn_readfirstlane(tid >> 6), lane = tid & 63, r32 = lane & 31, hi = lane >> 5;
    char* V_lds = lds + OFF_V; char* K_lds = lds + OFF_K;
    float* wsf = (float*)(lds + OFF_WS) + wid * 64; float* al_l = wsf + 32;
    float m_reg = 0.f; f32x16 negm = f32x16{}; lsum = f32x16{};
    v8i_a ones8; { int one_ = 0x38383838; asm volatile("" : "+v"(one_)); ones8 = (v8i_a){one_, one_, one_, one_, one_, one_, one_, one_}; }
#pragma unroll
    for (int d = 0; d < 4; ++d) o[d] = f32x16{};
    const unsigned char* Kh = K1 + (size_t)qh * MALL * 64; const unsigned char* Vh = V8 + (size_t)hp * NVTILE * SHM_V;
    const int kr = 16 * wid + (lane >> 2); const unsigned koff = (unsigned)(kr * 64 + (((lane & 3) ^ ((kr >> 2) & 3)) << 4));
    const unsigned lbase = (unsigned)(uintptr_t)lds;
#define ATT_ISSUE_KX(Khx_, bx_, P_, ks_) do { const size_t rb_ = kvrow((bx_), 2 * (P_)); glds16((const char*)((Khx_) + rb_ * 64) + koff, (unsigned)__builtin_amdgcn_readfirstlane(lbase + OFF_K + (ks_) * 2 * SHM_K + wid * 1024)); } while (0)
#define ATT_ISSUE_K(P_, ks_) ATT_ISSUE_KX(Kh, b, P_, ks_)
#define ATT_ISSUE_V(P_, vs_) ATT_ISSUE_VX(b, P_, vs_)
#define ATT_ISSUE_VX(bx_, P_, vs_) do { const int tt_ = 2 * (P_); const unsigned char* vb_ = Vh + (size_t)(tt_ < 64 ? (bx_) * 64 + tt_ : 512 + 4 * (bx_) + (tt_ - 64)) * SHM_V + wid * 2048 + lane * 16; \
    glds16(vb_, (unsigned)__builtin_amdgcn_readfirstlane(lbase + OFF_V + (vs_) * 2 * SHM_V + wid * 2048)); glds16(vb_ + 1024, (unsigned)__builtin_amdgcn_readfirstlane(lbase + OFF_V + (vs_) * 2 * SHM_V + wid * 2048 + 1024)); } while (0)
#define ATT_WAITBAR() do { asm volatile("s_waitcnt vmcnt(0)" ::: "memory"); __builtin_amdgcn_s_barrier(); asm volatile("" ::: "memory"); } while (0)
#define ATT_RESC(al) do { if (__any((al) < 1.f)) { if (hi == 0) al_l[r32] = (al); ATT_LONGNOP(); asm volatile("s_waitcnt lgkmcnt(0)" ::: "memory");     \
    _Pragma("unroll") for (int r = 0; r < 16; ++r) { const float a_ = al_l[crow(r, hi)]; lsum[r] *= a_; _Pragma("unroll") for (int d = 0; d < 4; ++d) o[d][r] *= a_; } } } while (0)
    v8i_a qr;
    { const unsigned char* Qw = Q1 + ((size_t)qh * MALL + qrow0 + wid * 32 + r32) * 64 + hi * 32;
      const v4i_a q0 = *(const v4i_a*)Qw, q1 = *(const v4i_a*)(Qw + 16); qr = __builtin_shufflevector(q0, q1, 0, 1, 2, 3, 4, 5, 6, 7); }
    const unsigned ka_ = (unsigned)(uintptr_t)K_lds + (unsigned)(r32 * 64) + (((2u * hi) ^ ((unsigned)(r32 >> 2) & 3u)) << 4);
    const unsigned vsw = (unsigned)((r32 >> 2) & 3);
    const unsigned va0_ = (unsigned)(uintptr_t)V_lds + (unsigned)(r32 * 64) + (((2u * hi) ^ vsw) << 4), va1_ = (unsigned)(uintptr_t)V_lds + (unsigned)(r32 * 64) + (((2u * hi + 1u) ^ vsw) << 4);
    f32x16 pA0, pA1, pB0, pB1; float alA = 1.f, alB = 1.f; v8i_a pa8 = {}, kf0, kf1;
    constexpr int NP = NT / 2;
    int k0s = rot[0], k1s = rot[1], k2s = rot[2], vs = rot[3];
    if (!pre) { ATT_ISSUE_K(0, k0s); ATT_ISSUE_V(0, vs); ATT_ISSUE_K(1, k1s); }
    ATT_WAITBAR();
    {
        qkt8(pA0, pA1, ka_ + k0s * 2 * SHM_K, qr, negm, kf0, kf1); ATT_LONGNOP(); ATT_KEEP8(kf0); ATT_KEEP8(kf1); partialSM<VAR>(pA0, pA1, m_reg, negm, alA);
#define ATT_STEP_A(PC0, PC1, ALC, PN0, PN1, ALN, KOFF_, VOFF_) do { \
        ATT_SBAR(); qkt8(PN0, PN1, ka_ + (KOFF_), qr, negm, kf0, kf1); ATT_KEEP8(pa8); ATT_SBAR(); \
        p_bytes(PC0, PC1, pa8); ATT_SBAR(); \
        pv8_partial(o, lsum, ones8, va0_ + (VOFF_), va1_ + (VOFF_), pa8, PN0, PN1, m_reg, negm, ALN, kf0, kf1); \
        ATT_RESC(ALN); } while (0)
        for (int P = 0; P + 1 < NP; ++P) {
            if (P + 2 < NP) ATT_ISSUE_K(P + 2, k2s);
            ATT_ISSUE_V(P + 1, vs ^ 1);
            ATT_STEP_A(pA0, pA1, alA, pB0, pB1, alB, k0s * 2 * SHM_K + SHM_K, vs * 2 * SHM_V);
            ATT_STEP_A(pB0, pB1, alB, pA0, pA1, alA, k1s * 2 * SHM_K, vs * 2 * SHM_V + SHM_V);
            ATT_WAITBAR();
            { const int t_ = k0s; k0s = k1s; k1s = k2s; k2s = t_; vs ^= 1; }
        }
        if (has_nxt) { const unsigned char* nKh = K1 + (size_t)nqh * MALL * 64; ATT_ISSUE_KX(nKh, nb, 0, k1s); ATT_ISSUE_VX(nb, 0, vs ^ 1); ATT_ISSUE_KX(nKh, nb, 1, k2s); }
        rot[0] = k1s; rot[1] = k2s; rot[2] = k0s; rot[3] = vs ^ 1;
        ATT_SBAR(); qkt8(pB0, pB1, ka_ + k0s * 2 * SHM_K + SHM_K, qr, negm, kf0, kf1); ATT_KEEP8(pa8); ATT_SBAR();
        p_bytes(pA0, pA1, pa8); ATT_SBAR();
        pv8_partial(o, lsum, ones8, va0_ + vs * 2 * SHM_V, va1_ + vs * 2 * SHM_V, pa8, pB0, pB1, m_reg, negm, alB, kf0, kf1);
        ATT_RESC(alB);
        ATT_LONGNOP(); p_bytes(pB0, pB1, pa8); ATT_SBAR();
        { const unsigned s_ = (unsigned)(vs * 2 * SHM_V + SHM_V); const int one8 = 0x7f7f7f7f;
          const v8i_a f0 = v8_frag(va0_ + s_, va1_ + s_), f1 = v8_frag(va0_ + s_ + 2048, va1_ + s_ + 2048), f2 = v8_frag(va0_ + s_ + 4096, va1_ + s_ + 4096), f3 = v8_frag(va0_ + s_ + 6144, va1_ + s_ + 6144);
          ATT_SBAR(); ATT_MM8(0, f0); ATT_MM8(1, f1); ATT_MM8(2, f2); ATT_MM8(3, f3); ATT_MML(); ATT_LONGNOP(); ATT_KEEP8(pa8); ATT_KEEP8(f0); ATT_KEEP8(f1); ATT_KEEP8(f2); ATT_KEEP8(f3); }
#undef ATT_STEP_A
    }
    asm volatile("s_waitcnt lgkmcnt(0)" ::: "memory"); __builtin_amdgcn_s_barrier(); asm volatile("" ::: "memory");
#undef ATT_ISSUE_K
#undef ATT_ISSUE_V
#undef ATT_ISSUE_KX
#undef ATT_ISSUE_VX
#undef ATT_WAITBAR
#undef ATT_RESC
}

template <int VAR> __device__ __forceinline__ void attn_unit(const unsigned char* __restrict__ Q1, const unsigned char* __restrict__ K1, const unsigned char* __restrict__ V1, bf16* __restrict__ ao, int b, int hp, int qb, char* lds, const float* lamp, const float* subln, int (&rot)[4], bool& pre, bool more_units, int nb_unit) {
    int tid_ = threadIdx.x; asm volatile("" : "+v"(tid_));
    const int tid = tid_, wid = tid >> 6, lane = tid & 63, r32 = lane & 31, hi = lane >> 5;
    float* wsf = (float*)(lds + OFF_WS) + wid * 64;
    unsigned* o1s = (unsigned*)(lds + OFF_O1 + wid * 8192);
    const size_t qrow0 = (size_t)b * SEQ + (size_t)qb * 256;
    f32x16 o[4]; f32x16 l;
    float ssq[16];
#pragma unroll 1
    for (int hh = 0; hh < 2; ++hh) {
        const bool hn = (hh == 0) || more_units;
        head_pass<VAR>(Q1, K1, V1, b, 2 * hp + hh, hp, qrow0, lds, o, l, rot, pre, hn, hh == 0 ? b : nb_unit, hh == 0 ? 2 * hp + 1 : 2 * hp);
        pre = hn;
        float rli[16];
#pragma unroll
        for (int r = 0; r < 16; ++r) { rli[r] = __builtin_amdgcn_rcpf(l[r]); ssq[r] = 0.f; }
        if (hh == 0) {
#pragma unroll
            for (int d0 = 0; d0 < 4; ++d0)
#pragma unroll
                for (int r = 0; r < 16; r += 2) o1s[(d0 * 8 + (r >> 1)) * 64 + lane] = cvtpk(o[d0][r] * rli[r], o[d0][r + 1] * rli[r + 1]);
            __syncthreads();
        } else {
            asm volatile("" : "+s"(lamp)); const float lam = *lamp;
#pragma unroll
            for (int d0 = 0; d0 < 4; ++d0)
#pragma unroll
                for (int r = 0; r < 16; r += 2) { const unsigned w = o1s[(d0 * 8 + (r >> 1)) * 64 + lane];
                    const float a0 = bflo(w) - lam * (o[d0][r] * rli[r]), a1 = bfhi(w) - lam * (o[d0][r + 1] * rli[r + 1]);
                    o[d0][r] = a0; o[d0][r + 1] = a1; ssq[r] += a0 * a0; ssq[r + 1] += a1 * a1; }
        }
    }
#pragma unroll
    for (int r = 0; r < 16; ++r) { float s = ssq[r];
        s += __shfl_xor(s, 1); s += __shfl_xor(s, 2); s += __shfl_xor(s, 4); s += __shfl_xor(s, 8); s += __shfl_xor(s, 16);
        ssq[r] = __builtin_amdgcn_rsqf(s * (1.0f / 128.0f) + EPS) * (1.0f - LAMBDA_INIT); }
    asm volatile("s_waitcnt lgkmcnt(0)" ::: "memory");
    unsigned char* stg = (unsigned char*)o1s;
    asm volatile("" : "+s"(subln));
#pragma unroll
    for (int d0 = 0; d0 < 4; ++d0) { const float g = subln[d0 * 32 + r32];
#pragma unroll
        for (int r = 0; r < 16; r += 2) { const int w2 = __builtin_amdgcn_cvt_pk_fp8_f32(o[d0][r] * ssq[r] * g, o[d0][r + 1] * ssq[r + 1] * g, 0, false);
            stg[crow(r, hi) * 128 + d0 * 32 + r32] = (unsigned char)(w2 & 0xff); stg[crow(r + 1, hi) * 128 + d0 * 32 + r32] = (unsigned char)((w2 >> 8) & 0xff); } }
    asm volatile("s_waitcnt lgkmcnt(0)" ::: "memory");
    unsigned char* Ow = (unsigned char*)ao + (qrow0 + wid * 32) * D + hp * 128;
#pragma unroll
    for (int i = 0; i < 4; ++i) { const int row = i * 8 + (lane >> 3), ch = lane & 7; const u32x4 v = *(const u32x4*)(stg + row * 128 + ch * 16); *(u32x4*)(Ow + (size_t)row * D + ch * 16) = v; }
    asm volatile("s_waitcnt lgkmcnt(0)" ::: "memory");
    __syncthreads();
}
#undef ATT_SBAR
}

__device__ __forceinline__ void v8_prep(Frame& F) {
    const bf16* V1 = (const bf16*)(F.ws + WS_VH1); unsigned char* V8 = (unsigned char*)(F.ws + WS_V8);
    LAS bf16* buf = (LAS bf16*)(F.lds + F.wave * 16384);
    const int gw = F.vcu * NWAVES + F.wave, NGW = F.G * NWAVES, lane = F.lane;
    for (int it = gw; it < 8 * att::NVTILE; it += NGW) {
        const int hv = it / att::NVTILE, tile = it % att::NVTILE;
        const bf16* src = V1 + ((size_t)hv * MALL + (size_t)tile * 64) * 128;
#pragma unroll
        for (int i = 0; i < 16; ++i) *(LAS v4u*)(buf + i * 512 + lane * 8) = *(const GAS v4u*)(src + i * 512 + lane * 8);
        LDS_WAIT(); asm volatile("" ::: "memory");
        unsigned char* dst = V8 + (size_t)it * att::SHM_V;
#pragma unroll
        for (int cc = 0; cc < 2; ++cc) { const int n = lane + 64 * cc; const int sw = (n >> 2) & 3;
#pragma unroll
            for (int c = 0; c < 4; ++c) { const int kb = c >> 1, half = c & 1; v4u w;
#pragma unroll
                for (int q = 0; q < 4; ++q) { const int key0 = 32 * half + 8 * q + 4 * kb;
                    w[q] = pk4_fp8(bf2f(buf[(key0 + 0) * 128 + n]), bf2f(buf[(key0 + 1) * 128 + n]), bf2f(buf[(key0 + 2) * 128 + n]), bf2f(buf[(key0 + 3) * 128 + n])); }
                *(GAS v4u*)(dst + n * 64 + ((c ^ sw) << 4)) = w; } }
        LDS_WAIT(); asm volatile("" ::: "memory");
    }
}

template <int VAR> __device__ __forceinline__ void attn_phase(Frame& F, const Args& a, bf16* ao) {
    const unsigned char* Q1 = F.ws + WS_QH1; const unsigned char* K1 = F.ws + WS_KH1; const unsigned char* V1 = (const unsigned char*)(F.ws + WS_V8);
    const float* lamp = (const float*)(F.ws + WS_LAM);
    int rot[4] = {0, 1, 2, 0}; bool pre = false;
    for (int unit = F.vcu; unit < NBATCH * 8 * 16; unit += F.G) {
        const int qb = unit & 15, hp = (unit >> 4) & 7, b = unit >> 7;
        const int nu = unit + F.G; const bool more = nu < NBATCH * 8 * 16;
        const bool same_hp = more && (((nu >> 4) & 7) == hp);
        att::attn_unit<VAR>(Q1, K1, V1, ao, b, hp, qb, (char*)F.lds, lamp, a.in[I_L1_SUBLN], rot, pre, same_hp, nu >> 7);
    }
}


namespace ret {
using s16x4  = __attribute__((ext_vector_type(4))) short;
using f32x16 = __attribute__((ext_vector_type(16))) float;
typedef short v4i16_t __attribute__((ext_vector_type(4)));
constexpr int C = 32, NSTEP = (SEQ + CTXL) / C;
constexpr int ST_Q = 0, ST_K = 16384, ST_V = 32768, ST_SC = 40960, ST_BYTES = 43008, NSTAGE = 2;
constexpr int XBUF_OFF = NSTAGE * ST_BYTES, RET_LDS = XBUF_OFF + 2 * NWAVES * 4096;
constexpr size_t WS_SSQ = 836 * MiB;
constexpr size_t WS_SC = 842 * MiB;

__device__ __forceinline__ void glds16(const void* gsrc, unsigned lds_dst) {
    asm volatile("s_mov_b32 m0, %1\n\ts_nop 0\n\tglobal_load_lds_dwordx4 %0, off" :: "v"(gsrc), "s"(lds_dst) : "memory", "m0"); }
__device__ __forceinline__ s16x4 vtr(const LAS char* p) { return __builtin_bit_cast(s16x4, __builtin_amdgcn_ds_read_tr16_b64_v4i16((LAS v4i16_t*)p)); }

__device__ __forceinline__ void ret_scores(Frame& F) {
    const bf16* Qh = (const bf16*)(F.ws + WS_QH0); const bf16* Kh = (const bf16*)(F.ws + WS_KH0); bf16* sc = (bf16*)(F.ws + WS_SC);
    const int gw = F.vcu * NWAVES + F.wave, NGW = F.G * NWAVES;
    const int r32 = F.lane & 31, hh = F.lane >> 5;
    constexpr int NTASK = (MALL / C) * RH;
    bf16x8 a[16], b[16];
#define RS_LOAD(task_, s0_) do { const int h_ = (task_) & 3, ch_ = (task_) >> 2; \
        const bf16* qp_ = Qh + ((size_t)h_ * MALL + (size_t)ch_ * C + r32) * 256 + hh * 8; const bf16* kp_ = Kh + ((size_t)h_ * MALL + (size_t)ch_ * C + r32) * 256 + hh * 8; \
        _Pragma("unroll") for (int s = (s0_); s < (s0_) + 8; ++s) { a[s] = *reinterpret_cast<const bf16x8*>(qp_ + s * 16); b[s] = *reinterpret_cast<const bf16x8*>(kp_ + s * 16); } } while (0)
    if (gw < NTASK) { RS_LOAD(gw, 0); RS_LOAD(gw, 8); }
    for (int task = gw; task < NTASK; task += NGW) {
        const int nxt = task + NGW;
        f32x16 acc = f32x16{};
#pragma unroll
        for (int s = 0; s < 8; ++s) acc = __builtin_amdgcn_mfma_f32_32x32x16_bf16(a[s], b[s], acc, 0, 0, 0);
        if (nxt < NTASK) RS_LOAD(nxt, 0);
#pragma unroll
        for (int s = 8; s < 16; ++s) acc = __builtin_amdgcn_mfma_f32_32x32x16_bf16(a[s], b[s], acc, 0, 0, 0);
        if (nxt < NTASK) RS_LOAD(nxt, 8);
        bf16* tp = sc + (size_t)task * 1024;
#pragma unroll
        for (int r = 0; r < 16; ++r) { const int i = (r & 3) + 8 * (r >> 2) + 4 * hh; tp[i * 32 + r32] = (bf16)f2bf(acc[r]); }
    }
#undef RS_LOAD
}

__device__ __forceinline__ size_t step_row0(int b, int dir, int t) {
    if (t < 8) { const int blk = dir ? 7 - t : t; return (size_t)NLAT + (size_t)b * CTXL + (size_t)blk * C; }
    const int blk = dir ? 127 - (t - 8) : (t - 8); return (size_t)b * SEQ + (size_t)blk * C;
}

template <int SV = 0> __device__ __forceinline__ void ret_scan(Frame& F, const Args& a) {
    const char* qb = (const char*)(F.ws + WS_QH0); const char* kb = (const char*)(F.ws + WS_KH0); const char* vb = (const char*)(F.ws + WS_VQ0); const char* scb = (const char*)(F.ws + WS_SC);
    for (int unit = F.vcu; unit < NBATCH * RH * 2 * 4; unit += F.G) {
        int tid_ = threadIdx.x; asm volatile("" : "+v"(tid_));
        const int tid = tid_, lane = tid & 63, w = __builtin_amdgcn_readfirstlane(tid >> 6), dh = w >> 2, vs = w & 3, r32 = lane & 31, hh = lane >> 5;
        const int vq = unit & 3, dir = (unit >> 2) & 1, h = (unit >> 3) & 3, b = unit >> 5;
        const float logit = a.in[I_L0_DECAY][dir * RH + h];
        const float lg2 = -__builtin_amdgcn_logf(1.0f + __builtin_amdgcn_exp2f(-logit * LOG2E));
        const float gC = __builtin_amdgcn_exp2f(lg2 * (float)C), gCi = __builtin_amdgcn_exp2f(-lg2 * (float)C);
        float kd[2][8];
#pragma unroll
        for (int s = 0; s < 2; ++s)
#pragma unroll
            for (int jj = 0; jj < 8; ++jj) { const int j = 16 * s + 8 * hh + jj; kd[s][jj] = __builtin_amdgcn_exp2f(lg2 * (float)(dir ? j : 31 - j)); }
        const int om = 4 * w + (lane >> 4);
        const float rsc = __builtin_amdgcn_exp2f(-lg2 * (float)(dir ? om : 31 - om));
        unsigned pm[4];
#pragma unroll
        for (int e = 0; e < 4; ++e) { const int j0 = 16 * dh + 8 * hh + 2 * e, j1 = j0 + 1; const bool k0 = dir ? (j0 >= r32) : (j0 <= r32), k1 = dir ? (j1 >= r32) : (j1 <= r32);
            pm[e] = (k0 ? 0x0000ffffu : 0u) | (k1 ? 0xffff0000u : 0u); asm volatile("" : "+v"(pm[e])); }
        unsigned offq[2], offk[2];
#pragma unroll
        for (int p = 0; p < 2; ++p) { const int i = 2 * (2 * w + p) + (lane >> 5), cp = lane & 31;
            offq[p] = (unsigned)(i * 512 + ((cp ^ (i & 15)) << 4)); offk[p] = (unsigned)(i * 512 + ((cp ^ ((i & 3) << 2)) << 4)); }
        unsigned offv; { const int j = 4 * w + (lane >> 4), cp = lane & 15; offv = (unsigned)(j * 256 + ((cp ^ ((j & 3) << 2)) << 4)); }
        const char* qhb = qb + (size_t)h * MALL * 512; const char* khb = kb + (size_t)h * MALL * 512; const char* vhb = vb + (size_t)(h * 4 + vq) * MALL * 256;
        unsigned offs; { const int i = 16 * (w & 1) + (lane >> 2), cp = lane & 3; offs = (unsigned)(i * 64 + ((cp ^ ((i >> 2) & 3)) << 4)); }
        LAS unsigned char* L = F.lds;
        const unsigned lbase = (unsigned)(uintptr_t)L;
#define RET_ISSUE(t_) RET_ISSUE2(t_, (t_) % NSTAGE)
#define RET_ISSUE2(t_, stg_) do { const int t__ = (t_); const unsigned sb_ = lbase + (unsigned)((stg_) * ST_BYTES); const size_t r0_ = step_row0(b, dir, t__); const char* gq_ = qhb + r0_ * 512; const char* gk_ = khb + r0_ * 512; const char* gv_ = vhb + r0_ * 256; \
        glds16(gq_ + offq[0], (unsigned)__builtin_amdgcn_readfirstlane(sb_ + ST_Q + (2 * w) * 1024)); \
        glds16(gq_ + offq[1], (unsigned)__builtin_amdgcn_readfirstlane(sb_ + ST_Q + (2 * w + 1) * 1024)); \
        glds16(gk_ + offk[0], (unsigned)__builtin_amdgcn_readfirstlane(sb_ + ST_K + (2 * w) * 1024)); \
        glds16(gk_ + offk[1], (unsigned)__builtin_amdgcn_readfirstlane(sb_ + ST_K + (2 * w + 1) * 1024)); \
        glds16(gv_ + offv, (unsigned)__builtin_amdgcn_readfirstlane(sb_ + ST_V + w * 1024)); \
        if (w < 2) glds16(scb + ((r0_ >> 5) * 4 + h) * 2048 + offs, (unsigned)__builtin_amdgcn_readfirstlane(sb_ + ST_SC + w * 1024)); } while (0)
        const int qrow = ST_Q + r32 * 512; const int qx = r32 & 15;
        const int G = lane >> 4, il = lane & 15, tq = il >> 2, tp = il & 3;
        const int kcolb = (128 * dh + 16 * (G & 1) + 8 * (tp & 1) + 4 * (tp >> 1)) * 2;
        const int vcolb = (32 * vs + 16 * (G & 1) + 4 * tp) * 2;
        f32x16 S[4];
#pragma unroll
        for (int T = 0; T < 4; ++T) S[T] = f32x16{};
        float cinv = 1.0f, cfw = 1.0f;
        bf16* outp = (bf16*)(F.ws + (dir ? WS_OB : WS_OF));
        float* ssqp = (float*)(F.ws + WS_SSQ);

        __builtin_amdgcn_s_barrier();
        if (w < 4) __builtin_amdgcn_s_setprio(2);
        if (SV != 2 && SV != 3) { RET_ISSUE(0); }
        const int v0 = (lane & 15) * 8;
#define RET_FINAL(tp_, rs_) RET_FINAL2((tp_) & 1, tp_, rs_)
#define RET_FINAL2(par_, tp_, rs_) do { const LAS float* p0_ = (const LAS float*)(L + XBUF_OFF + (par_) * 32768) + om * 128 + v0; const LAS float* p1_ = p0_ + 4096; \
            const f32x4 a0 = *(const LAS f32x4*)p0_, a1 = *(const LAS f32x4*)(p0_ + 4), b0 = *(const LAS f32x4*)p1_, b1 = *(const LAS f32x4*)(p1_ + 4); \
            const f32x4 o0 = (a0 + b0) * (rs_), o1 = (a1 + b1) * (rs_); \
            float ss = (o0.x * o0.x + o0.y * o0.y) + (o0.z * o0.z + o0.w * o0.w) + (o1.x * o1.x + o1.y * o1.y) + (o1.z * o1.z + o1.w * o1.w); \
            ss += __builtin_bit_cast(float, __builtin_amdgcn_update_dpp(0, __builtin_bit_cast(int, ss), 0xB1, 0xF, 0xF, true)); \
            ss += __builtin_bit_cast(float, __builtin_amdgcn_update_dpp(0, __builtin_bit_cast(int, ss), 0x4E, 0xF, 0xF, true)); \
            ss += __builtin_bit_cast(float, __builtin_amdgcn_update_dpp(0, __builtin_bit_cast(int, ss), 0x124, 0xF, 0xF, true)); \
            ss += __builtin_bit_cast(float, __builtin_amdgcn_update_dpp(0, __builtin_bit_cast(int, ss), 0x128, 0xF, 0xF, true)); \
            const size_t r0 = step_row0(b, dir, (tp_)); \
            v4u pk; pk.x = pk2(o0.x, o0.y); pk.y = pk2(o0.z, o0.w); pk.z = pk2(o1.x, o1.y); pk.w = pk2(o1.z, o1.w); \
            *(GAS v4u*)(outp + (r0 + om) * 2048 + h * 512 + vq * 128 + v0) = pk; \
            if ((lane & 15) == 0) ssqp[(((r0 + om) * RH + h) * 2 + dir) * 4 + vq] = ss; } while (0)
        float rs_prev = 0.f;
        static_assert(NSTEP % 2 == 0 && NSTAGE == 2, "the step loop is unrolled by the two stages");
        for (int t2 = 0; t2 < NSTEP; t2 += 2)
#pragma unroll
        for (int u_ = 0; u_ < 2; ++u_) { const int t = t2 + u_;
            if (t < 2) asm volatile("s_waitcnt vmcnt(0)" ::: "memory"); else asm volatile("s_waitcnt vmcnt(2)" ::: "memory");
            asm volatile("s_waitcnt lgkmcnt(0)" ::: "memory");
            __builtin_amdgcn_s_barrier(); asm volatile("" ::: "memory");
            if (SV != 2 && SV != 3) { if (t + 1 < NSTEP) RET_ISSUE2(t + 1, 1 - u_); }
            const LAS char* sb = (const LAS char*)(L + u_ * ST_BYTES);
            f32x16 acc = f32x16{};
            if (SV != 1 && SV != 3) {
            cinv *= gCi; cfw *= gC;
            bf16x8 vd[2];
#pragma unroll
            for (int s = 0; s < 2; ++s) {
                const int j0 = 16 * s + 8 * (G >> 1) + tq;
                const int cph = (((vcolb >> 4) ^ (tq << 2)) << 4) + (vcolb & 8);
                const s16x4 lo = vtr(sb + ST_V + j0 * 256 + cph), hi = vtr(sb + ST_V + (j0 + 4) * 256 + cph);
                float f[8];
#pragma unroll
                for (int e = 0; e < 4; ++e) { f[e] = bf2f((unsigned short)lo[e]) * (kd[s][e] * cinv); f[4 + e] = bf2f((unsigned short)hi[e]) * (kd[s][4 + e] * cinv); }
                v4u pk; pk.x = pk2(f[0], f[1]); pk.y = pk2(f[2], f[3]); pk.z = pk2(f[4], f[5]); pk.w = pk2(f[6], f[7]);
                vd[s] = __builtin_bit_cast(bf16x8, pk);
            }
            if (SV != 5)
#pragma unroll
            for (int T = 0; T < 4; ++T)
#pragma unroll
                for (int s = 0; s < 2; ++s) {
                    const int cL = 16 * dh + 4 * T + 2 * s + hh;
                    const bf16x8 qa = *(const LAS bf16x8*)(sb + qrow + ((cL ^ qx) << 4));
                    v4u pk; pk.x = pk2(S[T][8 * s + 0], S[T][8 * s + 1]); pk.y = pk2(S[T][8 * s + 2], S[T][8 * s + 3]); pk.z = pk2(S[T][8 * s + 4], S[T][8 * s + 5]); pk.w = pk2(S[T][8 * s + 6], S[T][8 * s + 7]);
                    acc = __builtin_amdgcn_mfma_f32_32x32x16_bf16(qa, __builtin_bit_cast(bf16x8, pk), acc, 0, 0, 0);
                }
            {
                const int cL = 2 * dh + hh;
                v4u pw = *(const LAS v4u*)(sb + ST_SC + r32 * 64 + ((cL ^ ((r32 >> 2) & 3)) << 4));
                pw.x &= pm[0]; pw.y &= pm[1]; pw.z &= pm[2]; pw.w &= pm[3];
                acc = __builtin_amdgcn_mfma_f32_32x32x16_bf16(__builtin_bit_cast(bf16x8, pw), dh ? vd[1] : vd[0], acc, 0, 0, 0);
            }
            if (SV != 4)
#pragma unroll
            for (int T = 0; T < 4; ++T)
#pragma unroll
                for (int s = 0; s < 2; ++s) {
                    const int j0 = 16 * s + 8 * (G >> 1) + tq;
                    const int cb = kcolb + 64 * T;
                    const int cph = (((cb >> 4) ^ (tq << 2)) << 4) + (cb & 8);
                    const s16x4 lo = vtr(sb + ST_K + j0 * 512 + cph), hi = vtr(sb + ST_K + (j0 + 4) * 512 + cph);
                    const bf16x8 ka = (bf16x8){lo[0], lo[1], lo[2], lo[3], hi[0], hi[1], hi[2], hi[3]};
                    S[T] = __builtin_amdgcn_mfma_f32_32x32x16_bf16(ka, vd[s], S[T], 0, 0, 0);
                }
            }
            const float rs_cur = rsc * cfw;
            if ((t & 7) == 7) {
#pragma unroll
                for (int T = 0; T < 4; ++T) S[T] = S[T] * cfw;
                cinv = 1.0f; cfw = 1.0f;
            }
            if (SV != 6) { LAS float* xw = (LAS float*)(L + XBUF_OFF + u_ * 32768 + dh * 16384) + (4 * hh) * 128 + vs * 32 + r32;
#pragma unroll
              for (int r = 0; r < 16; ++r) xw[((r & 3) + 8 * (r >> 2)) * 128] = acc[r]; }
            if (SV == 6) { asm volatile("" :: "v"(acc)); } else
            if (t > 0) RET_FINAL2(1 - u_, t - 1, rs_prev);
            rs_prev = rs_cur;
        }
        asm volatile("s_waitcnt lgkmcnt(0)" ::: "memory");
        __builtin_amdgcn_s_barrier(); asm volatile("" ::: "memory");
        RET_FINAL(NSTEP - 1, rs_prev);
        asm volatile("s_waitcnt vmcnt(0)\n\ts_waitcnt lgkmcnt(0)" ::: "memory");
        __builtin_amdgcn_s_setprio(0);
#undef RET_FINAL
#undef RET_FINAL2
#undef RET_ISSUE
#undef RET_ISSUE2
    }
    __builtin_amdgcn_s_barrier();
}
}

__device__ __forceinline__ void moe_counts(Frame& F, int (&cnt)[NE]) {
#pragma unroll
    for (int e = 0; e < NE; ++e) cnt[e] = __builtin_amdgcn_readfirstlane((int)__hip_atomic_load((unsigned*)(F.ctl + CW_MOECNT + 64 * e), RLX_AGENT));
}
__device__ __forceinline__ void moe_gather(Frame& F) {
    int cnt[NE]; moe_counts(F, cnt);
    int base[NE]; int acc = 0;
#pragma unroll
    for (int e = 0; e < NE; ++e) { base[e] = acc; acc += (cnt[e] + 255) & ~255; }
    const int* te = (const int*)(F.ws + WS_ROUTE); int* tpos = (int*)(F.ws + WS_ROUTE + (size_t)NLAT * 8);
    const bf16* hb = (const bf16*)(F.ws + WS_H); bf16* hp = (bf16*)(F.ws + WS_HP);
    const int gw = F.vcu * NWAVES + F.wave, NGW = F.G * NWAVES;
    for (int r = gw; r < NLAT; r += NGW) {
        const int e0 = te[2 * r], e1 = te[2 * r + 1]; const int p0 = tpos[2 * r], p1 = tpos[2 * r + 1];
        int b0 = 0, b1 = 0;
#pragma unroll
        for (int e = 0; e < NE; ++e) { b0 = (e0 == e) ? base[e] : b0; b1 = (e1 == e) ? base[e] : b1; }
        const int s0 = b0 + p0, s1 = b1 + p1;
        const v4u x0 = *(const GAS v4u*)((const unsigned char*)hb + (size_t)r * D + F.lane * 16);
        *(GAS v4u*)((unsigned char*)hp + (size_t)s0 * D + F.lane * 16) = x0; *(GAS v4u*)((unsigned char*)hp + (size_t)s1 * D + F.lane * 16) = x0;
        if (F.lane == 0) { tpos[2 * r] = s0; tpos[2 * r + 1] = s1; const float sc = ((const float*)(F.ws + WS_RSC))[r]; ((float*)(F.ws + WS_RSCM))[s0] = sc; ((float*)(F.ws + WS_RSCM))[s1] = sc; }
    }
}
__device__ __forceinline__ void moe_order(Frame& F, pg8::MoeOrder& S, int nN, int slots, int rep = 1) {
    S.rep = rep; S.slots = slots;
    int cnt[NE]; moe_counts(F, cnt);
    int ts[NE + 1]; ts[0] = 0;
#pragma unroll
    for (int e = 0; e < NE; ++e) ts[e + 1] = ts[e] + ((cnt[e] + 255) >> 8);
    S.nM = ts[NE]; S.nN = nN; S.nwg = S.nM * nN; S.G = F.G; S.c = F.cid;
    S.t1 = ts[1]; S.t2 = ts[2]; S.t3 = ts[3]; S.t4 = ts[4]; S.t5 = ts[5]; S.t6 = ts[6]; S.t7 = ts[7];
}

constexpr int N_PHASES = 22;
__global__ void __launch_bounds__(NTHREADS, 2) fwd(Args args) {
    extern __shared__ __attribute__((aligned(16))) unsigned char lds[];
    Frame F;
    F.lds = (LAS unsigned char*)lds; F.MISC = (volatile LAS unsigned*)(F.lds + MISC_OFF);
    F.tid = threadIdx.x; F.lane = F.tid & 63; F.wave = __builtin_amdgcn_readfirstlane(F.tid >> 6);
    F.G = gridDim.x; { const int bx = blockIdx.x; F.vcu = (F.G % 8 == 0) ? (bx % 8) * (F.G / 8) + bx / 8 : bx; F.cid = bx; }
    F.ws = args.ws; F.ctl = (gu32*)(args.ws + WS_CTL);
    for (int u = F.tid; u < 64; u += NTHREADS) ((LAS unsigned*)(F.lds + MISC_OFF))[u] = 0u;
    __syncthreads();
#if MK_PER_PHASE
    XcdBarrier bar; bar.bar = (unsigned*)(F.ctl + CW_BAR); bar.x = 0; bar.st = nullptr;
#define GRID_BAR() do { } while (0)
#else
    XcdBarrier bar = xcd_barrier_post((unsigned*)(F.ctl + CW_BAR), F.MISC + 8);
#define GRID_BAR() xcd_barrier(bar)
    if (F.tid == 0) { const unsigned x = xb_xcc_id(); F.MISC[16] = x; F.MISC[17] = __hip_atomic_fetch_add((unsigned*)(F.ctl + CW_XRANK + 64 * x), 1u, RLX_AGENT); }
#endif
    const int lo = args.ph_lo, hi = args.ph_hi;
#define IN(k) (lo <= (k) && (k) < hi)
#define SEAM(k) do { if (IN(k) && IN((k) + 1)) GRID_BAR(); } while (0)
    unsigned char* ws = args.ws;
    float* modv = (float*)(ws + WS_MODV);
    float* modv1 = modv + 9 * 6 * D;
    bf16* hbuf = (bf16*)(ws + WS_H);
    using pg8::Gemm; using pg8::StaticOrder;

    if (IN(0)) { for (int rep_ = 0; rep_ < DUP(0); ++rep_) { p0_prologue(F, args); __syncthreads(); } SEAM(0); }
#if !MK_PER_PHASE
    if (IN(0) && IN(1)) {
        if (F.tid == 0) { const unsigned x = F.MISC[16]; unsigned pre = 0;
            for (unsigned j = 0; j < 16; ++j) { const unsigned c = __hip_atomic_load((unsigned*)(F.ctl + CW_XRANK + 64 * j), RLX_AGENT); pre += (j < x) ? c : 0u; }
            F.MISC[18] = pre + F.MISC[17]; }
        __syncthreads();
        F.vcu = __builtin_amdgcn_readfirstlane((int)F.MISC[18]); F.cid = (F.G % 8 == 0) ? (F.vcu % (F.G / 8)) * 8 + F.vcu / (F.G / 8) : F.vcu;
    }
#endif
    float* rsc = (float*)(ws + WS_RSC);
    if (IN(1)) { RowPass P{MALL, args.in[I_X], args.in[I_CTX], nullptr, nullptr, nullptr, nullptr, nullptr, args.in[I_L0_NPREMIX], modv + 0 * D, modv + 1 * D, hbuf, nullptr, rsc};
        for (int rep_ = 0; rep_ < DUP(1); ++rep_) row_pass<false, false, true, false, 2>(F, args, P); SEAM(1); }
    if (IN(2)) { Gemm g{hbuf, (const bf16*)(ws + WS_W0IN), MALL, 4096, D / 2, D / 2, 0, 0, rsc, (const float*)(ws + WS_WSC0)}; StaticOrder S; S.init(MALL, 4096, F.G, F.cid, DUP(2));
        pg8::EpiQKV0 E{(bf16*)(ws + WS_QH0), (bf16*)(ws + WS_KH0), (bf16*)(ws + WS_VQ0), (const float*)(ws + WS_TAB0)};
        pg8::gemm_phase<pg8::EpiQKV0, StaticOrder, true, true, 2>(F.lds, g, S, E); if (IN(2) && IN(4)) GRID_BAR(); }
    if (IN(4)) { for (int rep_ = 0; rep_ < DUP(4); ++rep_) ret::ret_scores(F); SEAM(4); }
    if (IN(5)) { for (int rep_ = 0; rep_ < DUP(5); ++rep_) ret::ret_scan<0>(F, args); SEAM(5); }
    if (IN(6)) { Gemm g{hbuf, (const bf16*)(ws + WS_W0IN + (size_t)4096 * D), MALL, 4096, D / 2, D / 2, 0, 0, rsc, (const float*)(ws + WS_WSC0) + 4096}; StaticOrder S; S.init(MALL, 4096, F.G, F.cid);
        pg8::EpiGateMerge E{(bf16*)(ws + WS_OF), (const bf16*)(ws + WS_OB), (const float*)(ws + ret::WS_SSQ)};
        pg8::gemm_phase<pg8::EpiGateMerge, StaticOrder, true, true, 2>(F.lds, g, S, E); if (IN(6) && IN(8)) GRID_BAR(); }
    if (IN(8)) { Gemm g{(const bf16*)(ws + WS_OF), (const bf16*)(ws + WS_W0OUT), MALL, D, 2048, 2048}; StaticOrder S; S.init(MALL, D, F.G, F.cid, DUP(8));
        pg8::EpiStore E{(bf16*)(ws + WS_A), D};
        pg8::gemm_phase<pg8::EpiStore, StaticOrder, true, true>(F.lds, g, S, E); SEAM(8); }
    if (IN(9)) { RowPass P{MALL, args.in[I_X], args.in[I_CTX], (float*)(ws + WS_X1), (float*)(ws + WS_X1C), (const bf16*)(ws + WS_A), args.in[I_L0_NPOSTMIX], modv + 2 * D, args.in[I_L0_NPREFFN], modv + 3 * D, modv + 4 * D, hbuf, (const float*)(ws + WS_PART), rsc};
        for (int rep_ = 0; rep_ < DUP(9); ++rep_) row_pass<true, false, true, false, 2, USE_SPLITK ? 8 : 0, false, true>(F, args, P); SEAM(9); }
    if (IN(10)) { Gemm g{hbuf, (const bf16*)(ws + WS_W0GU), MALL, 2 * DFF, D / 2, D / 2, 0, 0, rsc, (const float*)(ws + WS_WSC2)}; StaticOrder S; S.init(MALL, 2 * DFF, F.G, F.cid, DUP(10));
        pg8::EpiSwiglu8 E{(unsigned char*)(ws + WS_B), DFF};
        pg8::gemm_phase<pg8::EpiSwiglu8, StaticOrder, true, true, 2>(F.lds, g, S, E); SEAM(10); }
    if (IN(11)) { Gemm g{(const bf16*)(ws + WS_B), (const bf16*)(ws + WS_W0DN), MALL, D, DFF / 2, DFF / 2, MOE_SA, MOE_SB}; StaticOrder S; S.init(MALL, D, F.G, F.cid, DUP(11));
        pg8::EpiStore E{(bf16*)(ws + WS_A), D};
        pg8::gemm_phase<pg8::EpiStore, StaticOrder, true, true, 1>(F.lds, g, S, E); SEAM(11); }
    if (IN(12)) { RowPass P{MALL, (const float*)(ws + WS_X1), (const float*)(ws + WS_X1C), (float*)(ws + WS_X2), nullptr, (const bf16*)(ws + WS_A), args.in[I_L0_NPOSTFFN], modv + 5 * D, args.in[I_L1_NPREMIX], modv1 + 0 * D, modv1 + 1 * D, hbuf, (const float*)(ws + WS_PART), rsc};
        for (int rep_ = 0; rep_ < DUP(12); ++rep_) row_pass<true, false, true, false, 2, USE_SPLITK ? 11 : 0, true, true>(F, args, P); SEAM(12); }
    if (IN(13)) { Gemm g{hbuf, (const bf16*)(ws + WS_W1IN), MALL, 3072, D / 2, D / 2, 0, 0, rsc, (const float*)(ws + WS_WSC1)}; pg8::QkvOrder S; S.init(F.G, F.cid, DUP(13));
        pg8::EpiQKV1 E{ws + WS_QH1, ws + WS_KH1, ws + WS_V8, (const float*)(ws + WS_TAB1)};
        pg8::gemm_phase<pg8::EpiQKV1, pg8::QkvOrder, true, true, 2>(F.lds, g, S, E); if (IN(13) && IN(15)) GRID_BAR(); }
    if (IN(15)) { for (int rep_ = 0; rep_ < DUP(15); ++rep_) attn_phase<0>(F, args, (bf16*)(ws + WS_B)); SEAM(15); }
    if (IN(16)) { Gemm g{(const bf16*)(ws + WS_B), (const bf16*)(ws + WS_W1OUT), NLAT, D, D / 2, D / 2, MOE_SA, MOE_SB}; StaticOrder S; S.init(NLAT, D, F.G, F.cid, DUP(16));
        pg8::EpiStore E{(bf16*)(ws + WS_A), D};
        pg8::gemm_phase<pg8::EpiStore, StaticOrder, true, true, 1>(F.lds, g, S, E); SEAM(16); }
    if (IN(17)) { RowPass P{NLAT, (const float*)(ws + WS_X2), nullptr, (float*)(ws + WS_X3), nullptr, (const bf16*)(ws + WS_A), args.in[I_L1_NPOSTMIX], modv1 + 2 * D, args.in[I_L1_NPREFFN], modv1 + 3 * D, modv1 + 4 * D, hbuf, nullptr, rsc};
        row_pass<true, false, true, true, 2, 0, true, true, false, true>(F, args, P); if (IN(17) && IN(19)) GRID_BAR(); }
    if (IN(19)) { Gemm g{(const bf16*)(ws + WS_HP), (const bf16*)(ws + WS_WMGU), MOE_ROWS, 2 * DFE, D / 2, D / 2, MOE_SA, MOE_SB}; pg8::MoeOrder S; moe_order(F, S, 2 * DFE / 256, 1, DUP(19));
        pg8::EpiSwiglu8 E{(unsigned char*)(ws + WS_ACT1), DFE};
        pg8::gemm_phase<pg8::EpiSwiglu8, pg8::MoeOrder, true, true, 1>(F.lds, g, S, E); SEAM(19); }
    if (IN(20)) { Gemm g{(const bf16*)(ws + WS_ACT1), (const bf16*)(ws + WS_WMDN), MOE_ROWS, D, DFE / 2, DFE / 2, MOE_SA, MOE_SB}; pg8::MoeOrder S; moe_order(F, S, D / 256, 0, DUP(20));
        pg8::EpiStore8 E{(unsigned char*)(ws + WS_Y1), D};
        pg8::gemm_phase<pg8::EpiStore8, pg8::MoeOrder, true, true, 1>(F.lds, g, S, E); SEAM(20); }
    if (IN(21)) { RowPass P{NLAT, (const float*)(ws + WS_X3), nullptr, args.out, nullptr, (const bf16*)(ws + WS_Y1), args.in[I_L1_NPOSTFFN], modv1 + 5 * D, nullptr, nullptr, nullptr, nullptr};
        for (int rep_ = 0; rep_ < DUP(21); ++rep_) row_pass<false, true, false, false, 0, 0, true, false, true>(F, args, P); }
#undef IN
#undef SEAM
}

#ifndef PROBE_ATT
#define PROBE_ATT -1
#endif
#if PROBE_ATT >= 0
__global__ void __launch_bounds__(NTHREADS, 2) probe_k(Args args) {
    extern __shared__ __attribute__((aligned(16))) unsigned char lds[];
    Frame F;
    F.lds = (LAS unsigned char*)lds; F.MISC = (volatile LAS unsigned*)(F.lds + MISC_OFF);
    F.tid = threadIdx.x; F.lane = F.tid & 63; F.wave = __builtin_amdgcn_readfirstlane(F.tid >> 6);
    F.G = gridDim.x; { const int bx = blockIdx.x; F.vcu = (F.G % 8 == 0) ? (bx % 8) * (F.G / 8) + bx / 8 : bx; F.cid = bx; }
    F.ws = args.ws; F.ctl = (gu32*)(args.ws + WS_CTL);
#if PROBE_ATT < 10
    attn_phase<PROBE_ATT>(F, args, (bf16*)(args.ws + WS_END - 64 * MiB));
#elif PROBE_ATT >= 30
    { unsigned char* ws = args.ws; using pg8::Gemm; using pg8::StaticOrder;
      Gemm g{(const bf16*)(ws + WS_OF), (const bf16*)(ws + WS_W0OUT), MALL, D, 2048, 2048}; StaticOrder S; S.init(PROBE_ATT == 30 ? MALL : NLAT, D, F.G, F.cid, 1);
      pg8::EpiStore E{(bf16*)(ws + WS_A), D};
      pg8::gemm_phase<pg8::EpiStore, StaticOrder, true, true>(F.lds, g, S, E); }
#elif PROBE_ATT >= 20
    { unsigned char* ws = args.ws; using pg8::Gemm;
      Gemm g{(const bf16*)(ws + WS_HP), (const bf16*)(ws + WS_WMGU), MOE_ROWS, 2 * DFE, D / 2, D / 2, 0, 0, (const float*)(ws + WS_RSCM), (const float*)(ws + WS_WSCM)}; pg8::MoeOrder S; moe_order(F, S, 2 * DFE / 256, 1);
#if PROBE_ATT == 20
      pg8::EpiSwiglu8 E{(unsigned char*)(ws + WS_ACT1), DFE}; pg8::gemm_phase<pg8::EpiSwiglu8, pg8::MoeOrder, true, true, 2>(F.lds, g, S, E);
#else
      pg8::EpiNull E{(float*)(ws + WS_ACT1)}; pg8::gemm_phase<pg8::EpiNull, pg8::MoeOrder, true, true, 2>(F.lds, g, S, E);
#endif
    }
#else
    ret::ret_scan<PROBE_ATT - 10>(F, args);
#endif
}
#endif
extern "C" void kernel_launch(void* const* d_in, const int* in_sizes, int n_in, void* d_out, int out_size, void* d_ws, size_t ws_size, hipStream_t stream) {
    static int grid = 0;
    if (grid == 0) {
        if (n_in != N_IN || out_size != NLAT * D || ws_size < WS_END) { fprintf(stderr, "kernel_launch: unexpected shapes n_in %d out %d ws %zu\n", n_in, out_size, ws_size); grid = -1; return; }
        int dev = 0, cus = 0, per_cu = 0;
        if (hipGetDevice(&dev) != hipSuccess || hipDeviceGetAttribute(&cus, hipDeviceAttributeMultiprocessorCount, dev) != hipSuccess) { grid = -1; return; }
        if (hipFuncSetAttribute((const void*)fwd, hipFuncAttributeMaxDynamicSharedMemorySize, LDS_BYTES) != hipSuccess) { fprintf(stderr, "kernel_launch: hipFuncSetAttribute failed\n"); grid = -1; return; }
        if (hipOccupancyMaxActiveBlocksPerMultiprocessor(&per_cu, (const void*)fwd, NTHREADS, LDS_BYTES) != hipSuccess || per_cu < 1) fprintf(stderr, "kernel_launch: occupancy query says %d\n", per_cu);
        (void)hipGetLastError();
        grid = cus;
    }
    if (grid < 0) return;
    (void)hipMemsetAsync((char*)d_ws + WS_CTL, 0, CTL_ZERO_BYTES, stream);
    Args a{};
    for (int i = 0; i < N_IN; ++i) a.in[i] = (const float*)d_in[i];
    a.out = (float*)d_out; a.ws = (unsigned char*)d_ws;
#if MK_PER_PHASE
    for (int p = 0; p < N_PHASES; ++p) { a.ph_lo = p; a.ph_hi = p + 1; hipLaunchKernelGGL(fwd, dim3(grid), dim3(NTHREADS), LDS_BYTES, stream, a); }
#else
    a.ph_lo = 0; a.ph_hi = N_PHASES; hipLaunchKernelGGL(fwd, dim3(grid), dim3(NTHREADS), LDS_BYTES, stream, a);
#endif
#if PROBE_ATT >= 0
    (void)hipFuncSetAttribute((const void*)probe_k, hipFuncAttributeMaxDynamicSharedMemorySize, LDS_BYTES);
    hipLaunchKernelGGL(probe_k, dim3(grid), dim3(NTHREADS), LDS_BYTES, stream, a);
#endif
}
```
